# Optimizing an MI355X kernel written in HIP

```python
import math
import jax, jax.numpy as jnp
from jax import lax
import numpy as np

D_MODEL = 1024
BATCH = 4
SEQ = 8192
DEPTH = 1

CHUNK = 64
Q_BLOCK = 128
HEAD_DIM = 64
RMS_EPS = 1e-6
ROPE_THETA = 10000.0
DIFF_HEADS = 4
DIFF_V_DIM = 2 * HEAD_DIM
DIFF_QK_WIDTH = DIFF_HEADS * 2 * HEAD_DIM
DIFF_V_WIDTH = DIFF_HEADS * DIFF_V_DIM
POOL_GROUPS = 4
POOL_WINDOWS = (2, 4, 8, 16)
POOL_WIDTH = D_MODEL // 4
POOL_GROUP_DIM = POOL_WIDTH // POOL_GROUPS
MEM_HEADS = 4
MEM_LEN = 256
MEM_WIDTH = MEM_HEADS * HEAD_DIM
N_BRANCHES = 3
Q_OFF = 0
K_OFF = Q_OFF + DIFF_QK_WIDTH
V_OFF = K_OFF + DIFF_QK_WIDTH
POOL_OFF = V_OFF + DIFF_V_WIDTH
MQ_OFF = POOL_OFF + POOL_WIDTH
GATE_OFF = MQ_OFF + MEM_WIDTH
IN_WIDTH = GATE_OFF + N_BRANCHES * D_MODEL
N_EXPERTS = 32
TOP_K = 4
D_EXPERT = D_MODEL
SWIGLU_LIMIT = 7.0
SWIGLU_ALPHA = 1.702
EXPERT_BLOCK = 128
NEG_INF = -1e30

kernel_name = 'hybrid_diffattn_pool_mem_moe_block'


def rms_norm(x, gain):
    xf = x.astype(jnp.float32)
    y = xf * lax.rsqrt(jnp.mean(xf * xf, axis=-1, keepdims=True) + RMS_EPS)
    return (y * gain.astype(jnp.float32)).astype(x.dtype)


def rope_tables(seq):
    inv_freq = 1.0 / (ROPE_THETA ** (jnp.arange(0, HEAD_DIM, 2, dtype=jnp.float32) / HEAD_DIM))
    ang = jnp.arange(seq, dtype=jnp.float32)[:, None] * inv_freq[None, :]
    return jnp.cos(ang), jnp.sin(ang)


def apply_rope(t, cos, sin):
    half = HEAD_DIM // 2
    tf = t.astype(jnp.float32)
    t1, t2 = tf[..., :half], tf[..., half:]
    return jnp.concatenate([t1 * cos - t2 * sin, t2 * cos + t1 * sin], axis=-1).astype(t.dtype)


def diff_attention(q, k, v, lam, sub_gain, lam_init):
    B, S = q.shape[0], q.shape[1]
    nqb = S // Q_BLOCK
    kt = k.transpose(0, 2, 3, 1, 4)
    vt = v.transpose(0, 2, 1, 3)
    qb = q.reshape(B, nqb, Q_BLOCK, 2, DIFF_HEADS, HEAD_DIM).transpose(1, 0, 3, 4, 2, 5)
    key_chunk = jnp.arange(S) // CHUNK
    scale = HEAD_DIM ** -0.5

    def block(args):
        q_blk, i = args
        s = jnp.einsum('bchqd,bchkd->bchqk', q_blk, kt).astype(jnp.float32) * scale
        q_chunk = (i * Q_BLOCK + jnp.arange(Q_BLOCK)) // CHUNK
        allowed = key_chunk[None, :] <= q_chunk[:, None]
        s = jnp.where(allowed, s, NEG_INF)
        p = jax.nn.softmax(s, axis=-1)
        a = p[:, 0] - lam * p[:, 1]
        return jnp.einsum('bhqk,bhkd->bhqd', a.astype(vt.dtype), vt)

    o = lax.map(block, (qb, jnp.arange(nqb)))
    o = o.transpose(1, 0, 3, 2, 4).reshape(B, S, DIFF_HEADS, DIFF_V_DIM)
    o = rms_norm(o, sub_gain) * (1.0 - lam_init)
    return o.reshape(B, S, DIFF_V_WIDTH)


def pool_mixer(u, w_group, scale):
    B, S, _ = u.shape
    uf = u.astype(jnp.float32).reshape(B, S, POOL_GROUPS, POOL_GROUP_DIM)
    c = jnp.cumsum(uf, axis=1)
    t1 = jnp.arange(1, S + 1, dtype=jnp.float32)
    outs = []
    for g, w in enumerate(POOL_WINDOWS):
        cg = c[:, :, g]
        lag = jnp.pad(cg, ((0, 0), (w, 0), (0, 0)))[:, :S]
        mean = (cg - lag) / jnp.minimum(t1, float(w))[None, :, None]
        outs.append(mean - uf[:, :, g])
    pooled = jnp.stack(outs, axis=2)
    mixed = jnp.einsum('bsgc,gcd->bsgd', pooled, w_group.astype(jnp.float32))
    return (mixed.reshape(B, S, POOL_WIDTH) * scale.astype(jnp.float32)).astype(u.dtype)


def memory_attention(mq, mem_n, w_mem_kv, mk_gain):
    B, S = mq.shape[0], mq.shape[1]
    M = mem_n.shape[1]
    kv = mem_n @ w_mem_kv
    mk = rms_norm(kv[..., :MEM_WIDTH].reshape(B, M, MEM_HEADS, HEAD_DIM), mk_gain)
    mv = kv[..., MEM_WIDTH:].reshape(B, M, MEM_HEADS, HEAD_DIM)
    s = jnp.einsum('bshd,bmhd->bhsm', mq, mk).astype(jnp.float32) * HEAD_DIM ** -0.5
    p = jax.nn.softmax(s, axis=-1)
    o = jnp.einsum('bhsm,bmhd->bshd', p.astype(mv.dtype), mv)
    return o.reshape(B, S, MEM_WIDTH)


def moe(h, w_router, b_router, w_gate_up, b_gate_up, w_down, b_down):
    Bt, S, D = h.shape
    T = Bt * S
    xf = h.reshape(T, D)
    logits = (xf @ w_router + b_router).astype(jnp.float32)
    top_val, top_idx = lax.top_k(logits, TOP_K)
    gate_w = jax.nn.softmax(top_val, axis=-1)
    A = T * TOP_K
    e_flat = top_idx.reshape(A).astype(jnp.int32)
    tok_flat = jnp.arange(A, dtype=jnp.int32) // TOP_K
    w_flat = gate_w.reshape(A)
    order = jnp.argsort(e_flat)
    e_sorted = e_flat[order]
    counts = jnp.bincount(e_flat, length=N_EXPERTS).astype(jnp.int32)
    padded = ((counts + EXPERT_BLOCK - 1) // EXPERT_BLOCK) * EXPERT_BLOCK
    pend = jnp.cumsum(padded)
    pstart = pend - padded
    ustart = jnp.cumsum(counts) - counts
    dest = pstart[e_sorted] + (jnp.arange(A, dtype=jnp.int32) - ustart[e_sorted])
    P = A + N_EXPERTS * EXPERT_BLOCK
    NB = P // EXPERT_BLOCK
    row_tok = jnp.full((P,), T, dtype=jnp.int32).at[dest].set(tok_flat[order])
    row_w = jnp.zeros((P,), jnp.float32).at[dest].set(w_flat[order])
    blk_exp = jnp.minimum(jnp.searchsorted(pend, jnp.arange(NB, dtype=jnp.int32) * EXPERT_BLOCK, side='right'),
                          N_EXPERTS - 1)
    xpad = jnp.concatenate([xf, jnp.zeros((1, D), xf.dtype)], axis=0)

    def expert_block(args):
        tok, e = args
        xb = xpad[tok]
        gu = (xb @ w_gate_up[e] + b_gate_up[e]).astype(jnp.float32)
        gate, up = gu[:, :D_EXPERT], gu[:, D_EXPERT:]
        gate = jnp.minimum(gate, SWIGLU_LIMIT)
        up = jnp.clip(up, -SWIGLU_LIMIT, SWIGLU_LIMIT)
        act = gate * jax.nn.sigmoid(SWIGLU_ALPHA * gate) * (up + 1.0)
        return act.astype(xb.dtype) @ w_down[e] + b_down[e]

    yb = lax.map(expert_block, (row_tok.reshape(NB, EXPERT_BLOCK), blk_exp))
    y = jnp.zeros((T + 1, D), jnp.float32).at[row_tok].add(yb.reshape(P, D).astype(jnp.float32) * row_w[:, None])
    return y[:T].reshape(Bt, S, D).astype(h.dtype)


def setup_inputs(seed: int = 0) -> dict:
    key = jax.random.key(seed)
    ks = jax.random.split(key, 32)
    L, D, E, F = DEPTH, D_MODEL, N_EXPERTS, D_EXPERT

    def nrm(k, shape, fan_in):
        return jax.random.normal(k, shape, jnp.float32) * (float(fan_in) ** -0.5)

    def gain(k, shape):
        return 1.0 + 0.02 * jax.random.normal(k, shape, jnp.float32)

    def small(k, shape, s):
        return s * jax.random.normal(k, shape, jnp.float32)

    return {
        'x': jax.random.normal(ks[0], (BATCH, SEQ, D), jnp.float32),
        'mem': jax.random.normal(ks[1], (BATCH, MEM_LEN, D), jnp.float32),
        'norm1': gain(ks[2], (L, D)),
        'w_in': nrm(ks[3], (L, D, IN_WIDTH), D),
        'b_gate': small(ks[4], (L, N_BRANCHES * D), 0.02),
        'q_norm': gain(ks[5], (L, HEAD_DIM)),
        'k_norm': gain(ks[6], (L, HEAD_DIM)),
        'lambda_q1': small(ks[7], (L, HEAD_DIM), 0.1),
        'lambda_k1': small(ks[8], (L, HEAD_DIM), 0.1),
        'lambda_q2': small(ks[9], (L, HEAD_DIM), 0.1),
        'lambda_k2': small(ks[10], (L, HEAD_DIM), 0.1),
        'diff_subln': gain(ks[11], (L, DIFF_V_DIM)),
        'w_pool': nrm(ks[12], (L, POOL_GROUPS, POOL_GROUP_DIM, POOL_GROUP_DIM), POOL_GROUP_DIM),
        'pool_scale': gain(ks[13], (L, POOL_WIDTH)),
        'mem_norm': gain(ks[14], (L, D)),
        'w_mem_kv': nrm(ks[15], (L, D, 2 * MEM_WIDTH), D),
        'mq_norm': gain(ks[16], (L, HEAD_DIM)),
        'mk_norm': gain(ks[17], (L, HEAD_DIM)),
        'w_br_diff': nrm(ks[18], (L, DIFF_V_WIDTH, D), DIFF_V_WIDTH),
        'w_br_pool': nrm(ks[19], (L, POOL_WIDTH, D), POOL_WIDTH),
        'w_br_mem': nrm(ks[20], (L, MEM_WIDTH, D), MEM_WIDTH),
        'w_out': nrm(ks[21], (L, D, D), D),
        'norm2': gain(ks[22], (L, D)),
        'w_router': nrm(ks[23], (L, D, E), D),
        'b_router': small(ks[24], (L, E), 0.01),
        'w_gate_up': nrm(ks[25], (L, E, D, 2 * F), D),
        'b_gate_up': small(ks[26], (L, E, 2 * F), 0.01),
        'w_down': nrm(ks[27], (L, E, F, D), F),
        'b_down': small(ks[28], (L, E, D), 0.01),
    }


def reference(x, mem, norm1, w_in, b_gate, q_norm, k_norm, lambda_q1, lambda_k1, lambda_q2, lambda_k2,
              diff_subln, w_pool, pool_scale, mem_norm, w_mem_kv, mq_norm, mk_norm, w_br_diff, w_br_pool,
              w_br_mem, w_out, norm2, w_router, b_router, w_gate_up, b_gate_up, w_down, b_down):
    B, S, D = x.shape
    cos, sin = rope_tables(S)
    cos_q, sin_q = cos[None, :, None, None, :], sin[None, :, None, None, :]
    for l in range(DEPTH):
        lam_init = 0.8 - 0.6 * math.exp(-0.3 * l)
        h = rms_norm(x, norm1[l])
        z = h @ w_in[l]
        q = z[..., Q_OFF:K_OFF].reshape(B, S, 2, DIFF_HEADS, HEAD_DIM)
        k = z[..., K_OFF:V_OFF].reshape(B, S, 2, DIFF_HEADS, HEAD_DIM)
        v = z[..., V_OFF:POOL_OFF].reshape(B, S, DIFF_HEADS, DIFF_V_DIM)
        q = apply_rope(rms_norm(q, q_norm[l]), cos_q, sin_q)
        k = apply_rope(rms_norm(k, k_norm[l]), cos_q, sin_q)
        lam = (jnp.exp(jnp.sum(lambda_q1[l].astype(jnp.float32) * lambda_k1[l].astype(jnp.float32)))
               - jnp.exp(jnp.sum(lambda_q2[l].astype(jnp.float32) * lambda_k2[l].astype(jnp.float32)))
               + lam_init)
        y_a = diff_attention(q, k, v, lam, diff_subln[l], lam_init)
        y_b = pool_mixer(z[..., POOL_OFF:MQ_OFF], w_pool[l], pool_scale[l])
        mq = rms_norm(z[..., MQ_OFF:GATE_OFF].reshape(B, S, MEM_HEADS, HEAD_DIM), mq_norm[l])
        y_c = memory_attention(mq, rms_norm(mem, mem_norm[l]), w_mem_kv[l], mk_norm[l])
        gates = jax.nn.sigmoid((z[..., GATE_OFF:] + b_gate[l]).astype(jnp.float32)).reshape(B, S, N_BRANCHES, D)
        merged = (gates[:, :, 0] * (y_a @ w_br_diff[l]).astype(jnp.float32)
                  + gates[:, :, 1] * (y_b @ w_br_pool[l]).astype(jnp.float32)
                  + gates[:, :, 2] * (y_c @ w_br_mem[l]).astype(jnp.float32))
        x = x + merged.astype(x.dtype) @ w_out[l]
        h2 = rms_norm(x, norm2[l])
        x = x + moe(h2, w_router[l], b_router[l], w_gate_up[l], b_gate_up[l], w_down[l], b_down[l])
    return x
```

```cpp
#include <hip/hip_runtime.h>
#include <hip/hip_cooperative_groups.h>
#include <hip/hip_bf16.h>
#include <cstdio>
#include <cstdint>
#include <cmath>
namespace cg = cooperative_groups;

#define LAS __attribute__((address_space(3)))
#define GAS __attribute__((address_space(1)))
typedef unsigned short bf16_t;
typedef short bf16x8 __attribute__((ext_vector_type(8)));
typedef float f32x4 __attribute__((ext_vector_type(4)));
typedef float f32x2 __attribute__((ext_vector_type(2)));
typedef float f32x16 __attribute__((ext_vector_type(16)));
typedef unsigned u32x4 __attribute__((ext_vector_type(4)));
typedef unsigned u32x2 __attribute__((ext_vector_type(2)));

#define PH_HI 10
#define PHMASK 0x3ff
constexpr int BATCH = 4, SEQ = 8192, DMODEL = 1024, T = BATCH * SEQ, INW = 5120, NEXP = 32, MEMLEN = 256;
constexpr float RMS_EPS = 1e-6f;
constexpr float C2 = 0.125f * 1.4426950408889634f;
constexpr int CAP = T;

constexpr size_t MiB = 1u << 20;
constexpr size_t WS_CTL = 0, CTL_ZERO_BYTES = 16384;
constexpr size_t WS_ROUTEW = 1 * MiB;
constexpr size_t WS_LAM = 1 * MiB + 768 * 1024;
constexpr size_t WS_ROPE = 2 * MiB;
constexpr size_t WS_WR2 = 4 * MiB;
constexpr size_t WS_MEMN = 5 * MiB;
constexpr size_t WS_MKV = 7 * MiB;
constexpr size_t WS_WIN_T = 8 * MiB;
constexpr size_t WS_WBRD_T = 18 * MiB;
constexpr size_t WS_WBRP_T = 19 * MiB;
constexpr size_t WS_WBRM_T = 19 * MiB + 512 * 1024;
constexpr size_t WS_WOUT_T = 20 * MiB;
constexpr size_t WS_WMKV_T = 22 * MiB;
constexpr size_t WS_WGU_T = 24 * MiB;
constexpr size_t WS_WD_T = 152 * MiB;
constexpr size_t WS_A = 216 * MiB;
constexpr size_t WS_XN = WS_A;
constexpr size_t WS_Q = WS_A + 64 * MiB, WS_K = WS_A + 96 * MiB, WS_V = WS_A + 128 * MiB;
constexpr size_t WS_U = WS_A + 160 * MiB, WS_MQ = WS_A + 176 * MiB;
constexpr size_t WS_OC = WS_A + 192 * MiB;
constexpr size_t WS_B = 488 * MiB;
constexpr size_t WS_GATES = WS_B;
constexpr size_t WS_YCAT = WS_B + 192 * MiB;
constexpr size_t WS_MERGF = 760 * MiB;
constexpr size_t WS_MERGB = 888 * MiB;
constexpr size_t WS_XG = 952 * MiB;
constexpr size_t WS_LIST = 1016 * MiB;
constexpr size_t WS_END = 1024 * MiB;

typedef __bf16 bf16x2_v __attribute__((ext_vector_type(2)));
__device__ __forceinline__ unsigned cvt_pk_bf16(float lo, float hi) { f32x2 v = {lo, hi}; bf16x2_v b = __builtin_convertvector(v, bf16x2_v); return __builtin_bit_cast(unsigned, b); }
__device__ __forceinline__ float bf_lo(unsigned w) { return __uint_as_float(w << 16); }
__device__ __forceinline__ float bf_hi(unsigned w) { return __uint_as_float(w & 0xffff0000u); }
__device__ __forceinline__ float wave_sum(float v) {
#pragma unroll
    for (int o = 1; o < 64; o <<= 1) v += __shfl_xor(v, o);
    return v;
}
#define LDS_WAIT() asm volatile("s_waitcnt lgkmcnt(0)" ::: "memory")

namespace pg8 {
constexpr int BM = 256, BK = 64, HALF = 128, HTB = HALF * BK * 2, STAGE_BYTES = 8 * HTB, NXCD = 8, WGM = 8;
__host__ __device__ __forceinline__ int lds_byte(int r, int c) { const int st = (r >> 4) * 2 + (c >> 5), rr = r & 15, cc = c & 31, ob = rr * 64 + cc * 2; return st * 1024 + (ob ^ (((ob >> 9) & 1) << 5)); }
__host__ __device__ __forceinline__ void stage_rc(int b, int& R, int& C) { const int st = b / 1024, sb = b % 1024, swz = sb ^ (((sb >> 9) & 1) << 5); R = (st >> 1) * 16 + swz / 64; C = (st & 1) * 32 + (swz % 64) / 2; }
__host__ __device__ __forceinline__ int perm32(int rho) { const int n = rho >> 4, i = rho & 15; return 8 * (i >> 2) + 4 * n + (i & 3); }

struct Unit { int pm, pn, e, mt, cnt; };

template <int BMAP> __device__ __forceinline__ int brow(int R) { return BMAP == 0 ? ((R >> 5) * 64 + perm32(R & 31)) : ((R & ~31) + perm32(R & 31)); }

struct StaticOrder {
    int nM, nN, nwg, G, c;
    __device__ void init(int M, int N, int G_, int c_) { nM = M / BM; nN = N / BM; nwg = nM * nN; G = G_; c = c_; }
    __device__ bool next(int i, Unit& u) const {
        const long L = (long)i * G + c; if (L >= nwg) return false;
        int wgid = (int)L; { const int q = nwg / NXCD, r = nwg % NXCD, xcd = wgid % NXCD, off = wgid / NXCD; wgid = (xcd < r ? xcd * (q + 1) : r * (q + 1) + (xcd - r) * q) + off; }
        const int nig = WGM * nN, gid = wgid / nig, fm = gid * WGM, gsz = (nM - fm) < WGM ? (nM - fm) : WGM;
        u.pm = fm + ((wgid % nig) % gsz); u.pn = (wgid % nig) / gsz; u.e = 0; u.mt = 0; u.cnt = 0; return true;
    }
};
struct GroupedOrder {
    const LAS int* tp; const LAS int* cn; int NTN, G, c;
    __device__ bool next(int i, Unit& u) const {
        const int nwg = tp[NEXP] * NTN; const long L = (long)i * G + c; if (L >= nwg) return false;
        int wgid = (int)L; { const int q = nwg / NXCD, r = nwg % NXCD, xcd = wgid % NXCD, off = wgid / NXCD; wgid = (xcd < r ? xcd * (q + 1) : r * (q + 1) + (xcd - r) * q) + off; }
        int e = 0; while (e < NEXP - 1 && wgid >= tp[e + 1] * NTN) ++e;
        const int idx = wgid - tp[e] * NTN, tiles = tp[e + 1] - tp[e];
        const int nig = 4 * NTN, gid = idx / nig, fm = gid * 4, gsz = (tiles - fm) < 4 ? (tiles - fm) : 4;
        const int mt = fm + ((idx % nig) % gsz), pn = (idx % nig) / gsz;
        u.e = __builtin_amdgcn_readfirstlane(e); u.mt = __builtin_amdgcn_readfirstlane(mt); u.pm = __builtin_amdgcn_readfirstlane(tp[e] + mt);
        u.pn = __builtin_amdgcn_readfirstlane(pn); u.cnt = __builtin_amdgcn_readfirstlane(cn[e]); return true;
    }
};

struct DenseProb {
    static constexpr bool GATHER = false; static constexpr int BMAP = 0;
    const bf16_t* A; const bf16_t* Bt; int lda, ldb, K;
    __device__ __forceinline__ const char* a_base(const Unit& u) const { return (const char*)(A + (size_t)u.pm * BM * lda); }
    __device__ __forceinline__ const char* b_base(const Unit& u) const { return (const char*)(Bt + (size_t)u.pn * BM * ldb); }
    __device__ __forceinline__ size_t bhstep() const { return (size_t)32 * ldb * 2; }
    __device__ __forceinline__ unsigned a_off(const Unit&, int, int) const { return 0u; }
};
struct GuProb {
    static constexpr bool GATHER = true; static constexpr int BMAP = 1;
    const bf16_t* XG; const bf16_t* Wt; const u32x2* list; int lda, ldb, K;
    __device__ __forceinline__ const char* a_base(const Unit&) const { return (const char*)XG; }
    __device__ __forceinline__ const char* b_base(const Unit& u) const { return (const char*)(Wt + ((size_t)u.e * 2048 + 128 * u.pn) * 1024); }
    __device__ __forceinline__ size_t bhstep() const { return (size_t)1024 * 1024 * 2; }
    __device__ __forceinline__ unsigned a_off(const Unit& u, int r, int C) const {
        const int rr = u.mt * BM + r; unsigned tok = 0u;
        if (rr < u.cnt) tok = list[(size_t)u.e * CAP + rr].x >> 2;
        return tok * 2048u + (unsigned)C * 2u;
    }
};
struct DownProb {
    static constexpr bool GATHER = false; static constexpr int BMAP = 0;
    const bf16_t* A; const bf16_t* Wt; int lda, ldb, K;
    __device__ __forceinline__ const char* a_base(const Unit& u) const { return (const char*)(A + (size_t)u.pm * BM * lda); }
    __device__ __forceinline__ const char* b_base(const Unit& u) const { return (const char*)(Wt + ((size_t)u.e * 1024 + 256 * u.pn) * 1024); }
    __device__ __forceinline__ size_t bhstep() const { return (size_t)32 * ldb * 2; }
    __device__ __forceinline__ unsigned a_off(const Unit&, int, int) const { return 0u; }
};

template <class Prob> __device__ __forceinline__ void calc_aoff(const Prob& P, const Unit& u, const int (&Rr)[2], const int (&Cc)[2], unsigned (&o)[2][2]) {
#pragma unroll
    for (int h = 0; h < 2; ++h)
#pragma unroll
        for (int i = 0; i < 2; ++i) {
            if constexpr (Prob::GATHER) o[h][i] = P.a_off(u, h * HALF + Rr[i], Cc[i]);
            else o[h][i] = (unsigned)((h * HALF + Rr[i]) * P.lda + Cc[i]) * 2u;
        }
}

template <class Epi, class Prob, class Sched, bool ALIGN_EPI>
__device__ __forceinline__ void gemm_phase(LAS unsigned char* lds, const Prob& P, const Sched& S, const Epi& E) {
    const int tid = threadIdx.x, wid = __builtin_amdgcn_readfirstlane(tid >> 6), lane = tid & 63, wr = wid >> 2, wc = wid & 3, fr = lane & 15, fq = lane >> 4;
    const int K = P.K, nt = K / BK;
    int Rr[2], Cc[2]; unsigned voffB[2];
#pragma unroll
    for (int i = 0; i < 2; ++i) { stage_rc(tid * 16 + i * 8192, Rr[i], Cc[i]); voffB[i] = (unsigned)(brow<Prob::BMAP>(Rr[i]) * P.ldb + Cc[i]) * 2u; }
    const size_t kstep = (size_t)(BK * 2);
    const size_t bhstep = P.bhstep();
    const unsigned ldsw = (unsigned)wid * 1024u;
    const int aoff = lds_byte(wr * 64 + fr, fq * 8), boff = lds_byte(wc * 32 + fr, fq * 8);
#define PG8_SA(b, h) (((b) * 2 + (h)) * HTB)
#define PG8_SB(b, h) ((4 + (b) * 2 + (h)) * HTB)
#define PG8_STG(bufoff, gptr, v0, v1) do { \
        __builtin_amdgcn_global_load_lds((const unsigned*)((const char*)(gptr) + (v0)), (LAS unsigned*)(lds + (bufoff) + ldsw), 16, 0, 0); \
        __builtin_amdgcn_global_load_lds((const unsigned*)((const char*)(gptr) + (v1)), (LAS unsigned*)(lds + (bufoff) + ldsw + 8192), 16, 0, 0); } while (0)
#define PG8_STGB(bufoff, gptr) PG8_STG(bufoff, gptr, voffB[0], voffB[1])
#define PG8_LDA(dst, b, h) do { _Pragma("unroll") for (int m = 0; m < 4; ++m) _Pragma("unroll") for (int k = 0; k < 2; ++k) dst[m][k] = *(const LAS bf16x8*)(lds + PG8_SA(b, h) + aoff + m * 2048 + k * 1024); } while (0)
#define PG8_LDB(dst, b, h) do { _Pragma("unroll") for (int n = 0; n < 2; ++n) _Pragma("unroll") for (int k = 0; k < 2; ++k) dst[n][k] = *(const LAS bf16x8*)(lds + PG8_SB(b, h) + boff + n * 2048 + k * 1024); } while (0)
#define PG8_MMA(ai, bj, At, Bt) do { __builtin_amdgcn_s_setprio(1); _Pragma("unroll") for (int m = 0; m < 4; ++m) _Pragma("unroll") for (int n = 0; n < 2; ++n) _Pragma("unroll") for (int k = 0; k < 2; ++k) \
        acc[ai][bj][m][n] = __builtin_amdgcn_mfma_f32_16x16x32_bf16(Bt[n][k], At[m][k], acc[ai][bj][m][n], 0, 0, 0); __builtin_amdgcn_s_setprio(0); } while (0)
#define PG8_WAIT_V(n) asm volatile("s_waitcnt vmcnt(" #n ")" ::: "memory")
#define PG8_WAIT_L(n) asm volatile("s_waitcnt lgkmcnt(" #n ")" ::: "memory")
#define PG8_BAR __builtin_amdgcn_s_barrier()
#define PG8_SCHED __builtin_amdgcn_sched_barrier(0)
    Unit cur, nxt; int ui = 0;
    if (!S.next(0, cur)) return;
    unsigned vo[2][2], nvo[2][2];
    calc_aoff(P, cur, Rr, Cc, vo);
    bool has_next = S.next(1, nxt);
    if constexpr (Prob::GATHER) { if (has_next) calc_aoff(P, nxt, Rr, Cc, nvo); else {
#pragma unroll
        for (int h = 0; h < 2; ++h)
#pragma unroll
            for (int i = 0; i < 2; ++i) nvo[h][i] = vo[h][i]; } }
    f32x4 acc[2][2][4][2];
#pragma unroll
    for (int a = 0; a < 2; ++a)
#pragma unroll
        for (int b = 0; b < 2; ++b)
#pragma unroll
            for (int m = 0; m < 4; ++m)
#pragma unroll
                for (int n = 0; n < 2; ++n) acc[a][b][m][n] = (f32x4){0.f, 0.f, 0.f, 0.f};
    bf16x8 At[4][2], B0[2][2], B1[2][2];
    const char* cA = P.a_base(cur); const char* cB = P.b_base(cur);
    PG8_STGB(PG8_SB(0, 0), cB); PG8_STGB(PG8_SB(0, 1), cB + bhstep); PG8_STG(PG8_SA(0, 0), cA, vo[0][0], vo[0][1]); PG8_STG(PG8_SA(0, 1), cA, vo[1][0], vo[1][1]);
    if (wr == 1) PG8_BAR;
    PG8_WAIT_V(2); PG8_BAR;
    PG8_STGB(PG8_SB(1, 0), cB + kstep); PG8_STG(PG8_SA(1, 0), cA + kstep, vo[0][0], vo[0][1]); PG8_STGB(PG8_SB(1, 1), cB + bhstep + kstep);
    PG8_WAIT_V(6); PG8_BAR;
    for (;;) {
        const char* nA = has_next ? P.a_base(nxt) : cA; const char* nB = has_next ? P.b_base(nxt) : cB;
        for (int t = 0; t < nt; t += 2) {
            const bool last = (t == nt - 2);
            const char* a1 = cA + (size_t)(t + 1) * kstep;
            const char* a2 = last ? nA : cA + (size_t)(t + 2) * kstep; const char* b2 = last ? nB : cB + (size_t)(t + 2) * kstep;
            const char* a3 = a2 + kstep; const char* b3 = b2 + kstep;
            unsigned x00 = vo[0][0], x01 = vo[0][1], x10 = vo[1][0], x11 = vo[1][1];
            if constexpr (Prob::GATHER) { if (last) { x00 = nvo[0][0]; x01 = nvo[0][1]; x10 = nvo[1][0]; x11 = nvo[1][1]; } }
            PG8_LDB(B0, 0, 0); PG8_LDB(B1, 0, 1); PG8_SCHED; PG8_LDA(At, 0, 0); PG8_STG(PG8_SA(1, 1), a1, vo[1][0], vo[1][1]);
            PG8_WAIT_V(8); PG8_WAIT_L(0); PG8_BAR; PG8_MMA(0, 0, At, B0); PG8_MMA(0, 1, At, B1); PG8_BAR; PG8_SCHED;
            PG8_LDA(At, 0, 1); PG8_STGB(PG8_SB(0, 0), b2); PG8_STGB(PG8_SB(0, 1), b2 + bhstep); PG8_STG(PG8_SA(0, 0), a2, x00, x01);
            PG8_WAIT_V(8); PG8_WAIT_L(0); PG8_BAR; PG8_MMA(1, 0, At, B0); PG8_MMA(1, 1, At, B1); PG8_BAR; PG8_SCHED;
            PG8_LDB(B0, 1, 0); PG8_LDB(B1, 1, 1); PG8_SCHED; PG8_LDA(At, 1, 0); PG8_STG(PG8_SA(0, 1), a2, x10, x11);
            PG8_WAIT_V(8); PG8_WAIT_L(0); PG8_BAR; PG8_MMA(0, 0, At, B0); PG8_MMA(0, 1, At, B1); PG8_BAR; PG8_SCHED;
            PG8_LDA(At, 1, 1); PG8_STGB(PG8_SB(1, 0), b3); PG8_STGB(PG8_SB(1, 1), b3 + bhstep); PG8_STG(PG8_SA(1, 0), a3, x00, x01);
            PG8_WAIT_V(8); PG8_WAIT_L(0); PG8_BAR; PG8_MMA(1, 0, At, B0); PG8_MMA(1, 1, At, B1); PG8_BAR; PG8_SCHED;
        }
        if constexpr (ALIGN_EPI) { if (wr == 0) PG8_BAR; }
        E(acc, cur, wr, wc, fr, fq);
        if (!has_next) break;
#pragma unroll
        for (int a = 0; a < 2; ++a)
#pragma unroll
            for (int b = 0; b < 2; ++b)
#pragma unroll
                for (int m = 0; m < 4; ++m)
#pragma unroll
                    for (int n = 0; n < 2; ++n) acc[a][b][m][n] = (f32x4){0.f, 0.f, 0.f, 0.f};
        cur = nxt; cA = nA; cB = nB; ++ui;
        if constexpr (Prob::GATHER) {
#pragma unroll
            for (int h = 0; h < 2; ++h)
#pragma unroll
                for (int i = 0; i < 2; ++i) vo[h][i] = nvo[h][i];
        }
        has_next = S.next(ui + 1, nxt);
        if constexpr (Prob::GATHER) { if (has_next) { calc_aoff(P, nxt, Rr, Cc, nvo); asm volatile("" : "+v"(nvo[0][0]), "+v"(nvo[0][1]), "+v"(nvo[1][0]), "+v"(nvo[1][1])); } }
        if constexpr (ALIGN_EPI) { if (wr == 1) PG8_BAR; }
    }
    PG8_WAIT_V(0);
    if constexpr (!ALIGN_EPI) { if (wr == 0) PG8_BAR; }
    PG8_BAR;
#undef PG8_SA
#undef PG8_SB
#undef PG8_STG
#undef PG8_STGB
#undef PG8_LDA
#undef PG8_LDB
#undef PG8_MMA
#undef PG8_WAIT_V
#undef PG8_WAIT_L
#undef PG8_BAR
#undef PG8_SCHED
}

typedef const f32x4 (&AccRef)[2][2][4][2];

__device__ __forceinline__ void store8(bf16_t* p, const f32x4& a, const f32x4& b) {
    u32x4 w; w.x = cvt_pk_bf16(a[0], a[1]); w.y = cvt_pk_bf16(a[2], a[3]); w.z = cvt_pk_bf16(b[0], b[1]); w.w = cvt_pk_bf16(b[2], b[3]); *(u32x4*)p = w;
}
__device__ __forceinline__ float sigmoidf_(float v) { return __builtin_amdgcn_rcpf(1.0f + __builtin_amdgcn_exp2f(-1.4426950408889634f * v)); }

struct EpiInProj {
    bf16_t *Q, *Kb, *V, *U, *MQ, *GT; const float *qn, *kn, *mqn, *bg; const f32x2* rope;
    __device__ __forceinline__ void operator()(AccRef acc, const Unit& u, int wr, int wc, int fr, int fq) const {
        const int pn = u.pn; const int row0 = u.pm * BM + wr * 64 + fr;
        bf16_t* const Q_ = Q; bf16_t* const K_ = Kb; bf16_t* const V_ = V; bf16_t* const U_ = U; bf16_t* const MQ_ = MQ; const float* const qn_ = qn; const float* const kn_ = kn; const float* const mqn_ = mqn;
        if (pn < 4 || pn == 7) {
            const bool rope_on = pn < 4; const float* gn = pn < 2 ? qn_ : (pn < 4 ? kn_ : mqn_);
            const float sc = (pn < 2 || pn == 7) ? C2 : 1.0f;
            bf16_t* O; int pitch, colb;
            if (pn < 2) { O = Q_; pitch = 512; colb = (pn * 4 + wc) * 64; } else if (pn < 4) { O = K_; pitch = 512; colb = ((pn - 2) * 4 + wc) * 64; } else { O = MQ_; pitch = 256; colb = wc * 64; }
            const f32x4 g00 = *(const f32x4*)(gn + 8 * fq), g01 = *(const f32x4*)(gn + 8 * fq + 4), g10 = *(const f32x4*)(gn + 32 + 8 * fq), g11 = *(const f32x4*)(gn + 32 + 8 * fq + 4);
#pragma unroll
            for (int ai = 0; ai < 2; ++ai)
#pragma unroll
                for (int m = 0; m < 4; ++m) {
                    const f32x4 a0 = acc[ai][0][m][0], a1 = acc[ai][0][m][1], b0 = acc[ai][1][m][0], b1 = acc[ai][1][m][1];
                    float ss = 0.f;
#pragma unroll
                    for (int j = 0; j < 4; ++j) ss += a0[j] * a0[j] + a1[j] * a1[j] + b0[j] * b0[j] + b1[j] * b1[j];
                    ss += __shfl_xor(ss, 16); ss += __shfl_xor(ss, 32);
                    const float rstd = 1.0f / sqrtf(ss * (1.0f / 64.0f) + RMS_EPS);
                    const int row = row0 + ai * HALF + m * 16;
                    f32x4 t10 = a0 * rstd * g00, t11 = a1 * rstd * g01, t20 = b0 * rstd * g10, t21 = b1 * rstd * g11;
                    f32x4 o10, o11, o20, o21;
                    if (rope_on) {
                        const f32x4* rp = (const f32x4*)(rope + (size_t)(row & (SEQ - 1)) * 32 + 8 * fq);
                        const f32x4 r0 = rp[0], r1 = rp[1], r2 = rp[2], r3 = rp[3];
                        const f32x4 cs0 = {r0[0], r0[2], r1[0], r1[2]}, sn0 = {r0[1], r0[3], r1[1], r1[3]}, cs1 = {r2[0], r2[2], r3[0], r3[2]}, sn1 = {r2[1], r2[3], r3[1], r3[3]};
                        o10 = (t10 * cs0 - t20 * sn0) * sc; o11 = (t11 * cs1 - t21 * sn1) * sc; o20 = (t20 * cs0 + t10 * sn0) * sc; o21 = (t21 * cs1 + t11 * sn1) * sc;
                    } else { o10 = t10 * sc; o11 = t11 * sc; o20 = t20 * sc; o21 = t21 * sc; }
                    bf16_t* rowp = O + (size_t)row * pitch + colb + 8 * fq;
                    store8(rowp, o10, o11); store8(rowp + 32, o20, o21);
                }
        } else if (pn < 7) {
            bf16_t* O; int pitch, colb;
            if (pn < 6) { O = V_; pitch = 512; colb = (pn - 4) * 256 + wc * 64; } else { O = U_; pitch = 256; colb = wc * 64; }
#pragma unroll
            for (int ai = 0; ai < 2; ++ai)
#pragma unroll
                for (int m = 0; m < 4; ++m) { bf16_t* rowp = O + (size_t)(row0 + ai * HALF + m * 16) * pitch + colb + 8 * fq;
                    store8(rowp, acc[ai][0][m][0], acc[ai][0][m][1]); store8(rowp + 32, acc[ai][1][m][0], acc[ai][1][m][1]); }
        } else {
            const int gc = (pn - 8) * 256 + wc * 64 + 8 * fq;
            f32x4 bv[2][2];
#pragma unroll
            for (int bj = 0; bj < 2; ++bj)
#pragma unroll
                for (int n = 0; n < 2; ++n) bv[bj][n] = *(const f32x4*)(bg + gc + 32 * bj + 4 * n);
#pragma unroll
            for (int ai = 0; ai < 2; ++ai)
#pragma unroll
                for (int m = 0; m < 4; ++m) { bf16_t* rowp = GT + (size_t)(row0 + ai * HALF + m * 16) * 3072 + gc;
#pragma unroll
                    for (int bj = 0; bj < 2; ++bj) { f32x4 v0 = acc[ai][bj][m][0] + bv[bj][0], v1 = acc[ai][bj][m][1] + bv[bj][1];
#pragma unroll
                        for (int j = 0; j < 4; ++j) { v0[j] = sigmoidf_(v0[j]); v1[j] = sigmoidf_(v1[j]); }
                        store8(rowp + 32 * bj, v0, v1); } }
        }
    }
};
struct EpiMemKV {
    bf16_t* MKV; const float* mkn;
    __device__ __forceinline__ void operator()(AccRef acc, const Unit& u, int wr, int wc, int fr, int fq) const {
        const int row0 = u.pm * BM + wr * 64 + fr;
        f32x4 g00 = {1.f, 1.f, 1.f, 1.f}, g01 = g00, g10 = g00, g11 = g00;
        if (u.pn == 0) { g00 = *(const f32x4*)(mkn + 8 * fq); g01 = *(const f32x4*)(mkn + 8 * fq + 4); g10 = *(const f32x4*)(mkn + 32 + 8 * fq); g11 = *(const f32x4*)(mkn + 32 + 8 * fq + 4); }
#pragma unroll
        for (int ai = 0; ai < 2; ++ai)
#pragma unroll
            for (int m = 0; m < 4; ++m) {
                const f32x4 a0 = acc[ai][0][m][0], a1 = acc[ai][0][m][1], b0 = acc[ai][1][m][0], b1 = acc[ai][1][m][1];
                float rstd = 1.0f;
                if (u.pn == 0) { float ss = 0.f;
#pragma unroll
                    for (int j = 0; j < 4; ++j) ss += a0[j] * a0[j] + a1[j] * a1[j] + b0[j] * b0[j] + b1[j] * b1[j];
                    ss += __shfl_xor(ss, 16); ss += __shfl_xor(ss, 32); rstd = 1.0f / sqrtf(ss * (1.0f / 64.0f) + RMS_EPS); }
                bf16_t* rowp = MKV + (size_t)(row0 + ai * HALF + m * 16) * 512 + u.pn * 256 + wc * 64 + 8 * fq;
                store8(rowp, a0 * rstd * g00, a1 * rstd * g01); store8(rowp + 32, b0 * rstd * g10, b1 * rstd * g11);
            }
    }
};
template <int STAGE> struct EpiMerge {
    const bf16_t* GT; float* MF; bf16_t* MB;
    __device__ __forceinline__ void operator()(AccRef acc, const Unit& u, int wr, int wc, int fr, int fq) const {
        const int row0 = u.pm * BM + wr * 64 + fr, col0 = u.pn * BM + wc * 64 + 8 * fq;
#pragma unroll
        for (int ai = 0; ai < 2; ++ai)
#pragma unroll
            for (int m = 0; m < 4; ++m) { const size_t row = (size_t)(row0 + ai * HALF + m * 16);
#pragma unroll
                for (int bj = 0; bj < 2; ++bj) { const int col = col0 + 32 * bj;
                    const u32x4 g = *(const u32x4*)(GT + row * 3072 + STAGE * 1024 + col);
                    const f32x4 ga = {bf_lo(g.x), bf_hi(g.x), bf_lo(g.y), bf_hi(g.y)}, gb = {bf_lo(g.z), bf_hi(g.z), bf_lo(g.w), bf_hi(g.w)};
                    f32x4 v0 = acc[ai][bj][m][0] * ga, v1 = acc[ai][bj][m][1] * gb;
                    float* mp = MF + row * 1024 + col;
                    if (STAGE > 0) { v0 += *(const f32x4*)mp; v1 += *(const f32x4*)(mp + 4); }
                    if (STAGE < 2) { *(f32x4*)mp = v0; *(f32x4*)(mp + 4) = v1; } else store8(MB + row * 1024 + col, v0, v1); }
                if (m & 1) asm volatile("" ::: "memory"); }
    }
};
struct EpiWout {
    const float* X; float* X2; bf16_t* XG; const float* n2;
    __device__ __forceinline__ void operator()(AccRef acc, const Unit& u, int wr, int wc, int fr, int fq) const {
        const int row0 = u.pm * BM + wr * 64 + fr, col0 = u.pn * BM + wc * 64 + 8 * fq;
        f32x4 nv[2][2];
#pragma unroll
        for (int bj = 0; bj < 2; ++bj)
#pragma unroll
            for (int n = 0; n < 2; ++n) nv[bj][n] = *(const f32x4*)(n2 + col0 + 32 * bj + 4 * n);
#pragma unroll
        for (int ai = 0; ai < 2; ++ai)
#pragma unroll
            for (int m = 0; m < 4; ++m) { const size_t off = (size_t)(row0 + ai * HALF + m * 16) * 1024 + col0;
#pragma unroll
                for (int bj = 0; bj < 2; ++bj) { const f32x4 x0 = *(const f32x4*)(X + off + 32 * bj) + acc[ai][bj][m][0], x1 = *(const f32x4*)(X + off + 32 * bj + 4) + acc[ai][bj][m][1];
                    *(f32x4*)(X2 + off + 32 * bj) = x0; *(f32x4*)(X2 + off + 32 * bj + 4) = x1;
                    store8(XG + off + 32 * bj, x0 * nv[bj][0], x1 * nv[bj][1]); }
                if (m & 1) asm volatile("" ::: "memory"); }
    }
};
struct EpiSwiglu {
    bf16_t* ACT; const u32x2* list; const float* bgu;
    __device__ __forceinline__ void operator()(AccRef acc, const Unit& u, int wr, int wc, int fr, int fq) const {
        const int col = 128 * u.pn + 32 * wc + 8 * fq; const float* bp = bgu + (size_t)u.e * 2048 + col;
        const f32x4 bg0 = *(const f32x4*)bp, bg1 = *(const f32x4*)(bp + 4), bu0 = *(const f32x4*)(bp + 1024), bu1 = *(const f32x4*)(bp + 1028);
#pragma unroll
        for (int ai = 0; ai < 2; ++ai)
#pragma unroll
            for (int m = 0; m < 4; ++m) { const int r = ai * HALF + wr * 64 + m * 16 + fr, rr = u.mt * BM + r;
                float rstd = 0.f; if (rr < u.cnt) rstd = __uint_as_float(list[(size_t)u.e * CAP + rr].y);
                f32x4 o[2];
#pragma unroll
                for (int n = 0; n < 2; ++n) { const f32x4 g = acc[ai][0][m][n] * rstd + (n ? bg1 : bg0), up = acc[ai][1][m][n] * rstd + (n ? bu1 : bu0);
#pragma unroll
                    for (int j = 0; j < 4; ++j) { const float gg = fminf(g[j], 7.0f), uu = fminf(fmaxf(up[j], -7.0f), 7.0f);
                        o[n][j] = gg * __builtin_amdgcn_rcpf(1.0f + __builtin_amdgcn_exp2f(-1.702f * 1.4426950408889634f * gg)) * (uu + 1.0f); } }
                store8(ACT + (size_t)(u.pm * BM + r) * 1024 + col, o[0], o[1]); }
    }
};
struct EpiDown {
    bf16_t* Y4; const u32x2* list; const float* bd;
    __device__ __forceinline__ void operator()(AccRef acc, const Unit& u, int wr, int wc, int fr, int fq) const {
        const int col0 = u.pn * BM + wc * 64 + 8 * fq; const float* bp = bd + (size_t)u.e * 1024 + col0;
        f32x4 bv[2][2];
#pragma unroll
        for (int bj = 0; bj < 2; ++bj)
#pragma unroll
            for (int n = 0; n < 2; ++n) bv[bj][n] = *(const f32x4*)(bp + 32 * bj + 4 * n);
#pragma unroll
        for (int ai = 0; ai < 2; ++ai)
#pragma unroll
            for (int m = 0; m < 4; ++m) { const int rr = u.mt * BM + ai * HALF + wr * 64 + m * 16 + fr;
                if (rr < u.cnt) { const unsigned tk = list[(size_t)u.e * CAP + rr].x; bf16_t* rowp = Y4 + (size_t)tk * 1024 + col0;
#pragma unroll
                    for (int bj = 0; bj < 2; ++bj) store8(rowp + 32 * bj, acc[ai][bj][m][0] + bv[bj][0], acc[ai][bj][m][1] + bv[bj][1]); } }
    }
};
struct EpiPlain {
    bf16_t* Z; int ldz;
    __device__ __forceinline__ void operator()(AccRef acc, const Unit& u, int wr, int wc, int fr, int fq) const {
        const int row0 = u.pm * BM + wr * 64 + fr, col0 = u.pn * BM + wc * 64 + 8 * fq;
#pragma unroll
        for (int ai = 0; ai < 2; ++ai)
#pragma unroll
            for (int m = 0; m < 4; ++m) { bf16_t* rowp = Z + (size_t)(row0 + ai * HALF + m * 16) * ldz + col0;
                store8(rowp, acc[ai][0][m][0], acc[ai][0][m][1]); store8(rowp + 32, acc[ai][1][m][0], acc[ai][1][m][1]); }
    }
};
}

namespace attn_body {
using bf16 = __hip_bfloat16;
using s16x4 = __attribute__((ext_vector_type(4))) short;
constexpr int NW = 8, QBLK = 32, QB = QBLK * NW, KVBLK = 64, D = 64;
__device__ __forceinline__ int crow(int r, int hi) { return (r & 3) + 8 * (r >> 2) + 4 * hi; }
#define SBAR() __builtin_amdgcn_sched_barrier(0)
constexpr int NSLOT = 3, SLOTB = 8192;
constexpr int LDS_K = 0, LDS_V = NSLOT * SLOTB, LDS_WS = 2 * NSLOT * SLOTB, LDS_OST = LDS_WS + NW * 64 * 4, LDS_BYTES = LDS_OST + NW * 4096;
__device__ __forceinline__ void glds16(const void* gsrc, unsigned lds_dst) { unsigned keep;
    asm volatile("s_mov_b32 %0, m0\n\ts_mov_b32 m0, %2\n\ts_nop 0\n\tglobal_load_lds_dwordx4 %1, off\n\ts_mov_b32 m0, %0" : "=&s"(keep) : "v"(gsrc), "s"(lds_dst) : "memory"); }
__device__ __forceinline__ float max3f(float a, float b, float c) { float r; asm("v_max3_f32 %0, %1, %2, %3" : "=v"(r) : "v"(a), "v"(b), "v"(c)); return r; }
__device__ __forceinline__ float max2f(float a, float b) { float r; asm("v_max_f32_e32 %0, %1, %2" : "=v"(r) : "v"(a), "v"(b)); return r; }
__device__ __forceinline__ float fadd_s(float a, float b) { float r; asm("v_add_f32_e32 %0, %1, %2" : "=v"(r) : "v"(a), "v"(b)); return r; }
__device__ __forceinline__ float fsub_s(float a, float b) { float r; asm("v_sub_f32_e32 %0, %1, %2" : "=v"(r) : "v"(a), "v"(b)); return r; }
typedef float f32x2_t __attribute__((ext_vector_type(2))); typedef __bf16 bf16x2_t __attribute__((ext_vector_type(2)));
__device__ __forceinline__ unsigned cvtpk_s(float lo, float hi) { f32x2_t v = {lo, hi}; bf16x2_t b = __builtin_convertvector(v, bf16x2_t); return __builtin_bit_cast(unsigned, b); }
#define WAIT_BAR(N) asm volatile("s_waitcnt vmcnt(" #N ") lgkmcnt(0)\n\ts_barrier" ::: "memory")

__device__ __forceinline__ void qkt(f32x16& p0, f32x16& p1, const char* Kslot, const bf16x8* qr, const f32x16& negm, int r32, int hi) {
    const char* kb = Kslot + hi * 1024 + r32 * 16;
#pragma unroll
    for (int d0 = 0; d0 < 4; ++d0) {
        const bf16x8 b0 = *reinterpret_cast<const bf16x8*>(kb + d0 * 2048);
        const bf16x8 b1 = *reinterpret_cast<const bf16x8*>(kb + d0 * 2048 + 512);
        if (d0 == 0) { p0 = __builtin_amdgcn_mfma_f32_32x32x16_bf16(b0, qr[0], negm, 0, 0, 0); p1 = __builtin_amdgcn_mfma_f32_32x32x16_bf16(b1, qr[0], negm, 0, 0, 0); }
        else { p0 = __builtin_amdgcn_mfma_f32_32x32x16_bf16(b0, qr[d0], p0, 0, 0, 0); p1 = __builtin_amdgcn_mfma_f32_32x32x16_bf16(b1, qr[d0], p1, 0, 0, 0); } }
}
typedef __attribute__((address_space(3))) const char* lds_cptr;
typedef short v4i16_t __attribute__((ext_vector_type(4)));
__device__ __forceinline__ void kload8(bf16x8* kf, lds_cptr kp) {
    kf[0] = *(const __attribute__((address_space(3))) bf16x8*)(kp);        kf[1] = *(const __attribute__((address_space(3))) bf16x8*)(kp + 512);
    kf[2] = *(const __attribute__((address_space(3))) bf16x8*)(kp + 2048); kf[3] = *(const __attribute__((address_space(3))) bf16x8*)(kp + 2560);
    kf[4] = *(const __attribute__((address_space(3))) bf16x8*)(kp + 4096); kf[5] = *(const __attribute__((address_space(3))) bf16x8*)(kp + 4608);
    kf[6] = *(const __attribute__((address_space(3))) bf16x8*)(kp + 6144); kf[7] = *(const __attribute__((address_space(3))) bf16x8*)(kp + 6656);
}
__device__ __forceinline__ void kload2(bf16x8* kf, lds_cptr kp, int j) { kf[2 * j] = *(const __attribute__((address_space(3))) bf16x8*)(kp + j * 2048); kf[2 * j + 1] = *(const __attribute__((address_space(3))) bf16x8*)(kp + j * 2048 + 512); }
__device__ __forceinline__ s16x4 vtr(lds_cptr p) { return __builtin_bit_cast(s16x4, __builtin_amdgcn_ds_read_tr16_b64_v4i16((__attribute__((address_space(3))) v4i16_t*)p)); }
__device__ __forceinline__ float rowmax(const f32x16& p0, const f32x16& p1) {
    float a = max3f(p0[0], p0[1], p1[0]), b = max3f(p0[2], p0[3], p1[1]); a = max3f(a, p1[2], p1[3]);
#pragma unroll
    for (int r = 4; r < 16; r += 4) { a = max3f(a, p0[r], p0[r + 1]); b = max3f(b, p0[r + 2], p0[r + 3]); a = max3f(a, p1[r], p1[r + 1]); b = max3f(b, p1[r + 2], p1[r + 3]); }
    const float m = max2f(a, b);
    auto rr = __builtin_amdgcn_permlane32_swap(__float_as_uint(m), __float_as_uint(m), false, false);
    return max2f(__uint_as_float(rr[0]), __uint_as_float(rr[1]));
}
__device__ __forceinline__ void pv(f32x16* o, int vb, bf16x8 pa0, bf16x8 pa1, bf16x8 pa2, bf16x8 pa3) {
#pragma unroll
    for (int d0 = 0; d0 < 2; ++d0) { s16x4 lo[4], hi[4];
#pragma unroll
        for (int ks = 0; ks < 4; ++ks) {
            asm volatile("ds_read_b64_tr_b16 %0,%1 offset:%c2" : "=&v"(lo[ks]) : "v"(vb), "i"(d0 * 4096 + ks * 1024) : "memory");
            asm volatile("ds_read_b64_tr_b16 %0,%1 offset:%c2" : "=&v"(hi[ks]) : "v"(vb), "i"(d0 * 4096 + ks * 1024 + 512) : "memory"); }
        asm volatile("s_waitcnt lgkmcnt(0)" ::: "memory"); SBAR();
#define PK(k) (bf16x8){lo[k][0], lo[k][1], lo[k][2], lo[k][3], hi[k][0], hi[k][1], hi[k][2], hi[k][3]}
        o[d0] = __builtin_amdgcn_mfma_f32_32x32x16_bf16(pa0, PK(0), o[d0], 0, 0, 0);
        o[d0] = __builtin_amdgcn_mfma_f32_32x32x16_bf16(pa1, PK(1), o[d0], 0, 0, 0);
        o[d0] = __builtin_amdgcn_mfma_f32_32x32x16_bf16(pa2, PK(2), o[d0], 0, 0, 0);
        o[d0] = __builtin_amdgcn_mfma_f32_32x32x16_bf16(pa3, PK(3), o[d0], 0, 0, 0);
#undef PK
    }
}
__device__ __forceinline__ void cmask(f32x16& p0, f32x16& p1, int jb, int wid) {
    if (jb > (wid >> 1)) {
#pragma unroll
        for (int r = 0; r < 16; ++r) { p0[r] = -INFINITY; p1[r] = -INFINITY; } }
}
template <int THRL, bool MASK> __device__ __forceinline__ void attn_unit(int q0, int NT, const bf16* Qh, int qp, const bf16* __restrict__ Kh, int kp, const bf16* __restrict__ Vh, int vp, bf16* Oh, int op, char* shm) {
    const int tid = threadIdx.x, lane = tid & 63, r32 = lane & 31, hi = lane >> 5; const int wid = __builtin_amdgcn_readfirstlane(tid >> 6);
    const bf16* Qw = Qh + (long)(q0 + wid * QBLK) * qp;
    const unsigned lds0 = (unsigned)(uintptr_t)shm;
    float* wsf = (float*)(shm + LDS_WS) + wid * 64;
    const bf16* ksrc = Kh + (long)lane * kp + wid * 8;
    const bf16* vsrc = Vh + (long)(16 * (wid & 3) + (lane >> 2)) * vp + (wid >> 2) * 32 + (lane & 3) * 8;
    const unsigned kdst = lds0 + LDS_K + wid * 1024, vdst = lds0 + LDS_V + wid * 1024;
#define DMA_K(t, slot) glds16(ksrc + (long)(t) * KVBLK * kp, (unsigned)__builtin_amdgcn_readfirstlane(kdst + (slot)))
#define DMA_V(t, slot) glds16(vsrc + (long)(t) * KVBLK * vp, (unsigned)__builtin_amdgcn_readfirstlane(vdst + (slot)))
    const int vb0 = (int)(lds0 + LDS_V) + ((lane >> 4) & 1) * 32 + (lane & 3) * 8 + (4 * hi + ((lane & 15) >> 2)) * 64;
    const char* Kbase = shm + LDS_K; bf16x8 kf[8];
    const lds_cptr shm3 = (lds_cptr)shm; const lds_cptr kp0 = shm3 + LDS_K + hi * 1024 + r32 * 16; const lds_cptr vp0 = shm3 + LDS_V + ((lane >> 4) & 1) * 32 + (lane & 3) * 8 + (4 * hi + ((lane & 15) >> 2)) * 64;
    DMA_K(0, 0); DMA_V(0, 0); DMA_K(1, SLOTB);
    bf16x8 qr[4];
#pragma unroll
    for (int d0 = 0; d0 < 4; ++d0) qr[d0] = *reinterpret_cast<const bf16x8*>(&Qw[(long)r32 * qp + d0 * 16 + hi * 8]);
    float mhat = 0.f, l_reg = 0.f; f32x16 o[2]; o[0] = f32x16{}; o[1] = f32x16{}; f32x16 negm = f32x16{}; asm volatile("" : "+v"(negm));
#define CMASK(P0, P1, t) do { if (MASK) { int jb_ = (t) - (NT - 4); if (jb_ >= 0) cmask(P0, P1, jb_, wid); } } while (0)
    bool resc = false;
#define START(P0, P1) do { const float rm = rowmax(P0, P1); resc = false; \
    { const float dl = rm; mhat = fadd_s(mhat, dl); \
      _Pragma("unroll") for (int r = 0; r < 16; ++r) { P0[r] = fsub_s(P0[r], dl); P1[r] = fsub_s(P1[r], dl); } \
      _Pragma("unroll") for (int r = 0; r < 16; ++r) negm[r] = -mhat; asm volatile("" : "+v"(negm)); } \
    _Pragma("unroll") for (int r = 0; r < 16; ++r) P0[r] = __builtin_amdgcn_exp2f(P0[r]); } while (0)
#define RESC() do { if (resc) { asm volatile("s_waitcnt lgkmcnt(0)" ::: "memory"); \
      _Pragma("unroll") for (int d_ = 0; d_ < 2; ++d_) _Pragma("unroll") for (int r = 0; r < 16; ++r) o[d_][r] *= wsf[crow(r, hi)]; } } while (0)
    f32x16 pA0, pA1, pB0, pB1;
    int sl_prev = 0, sl_cur = 0, sl_next = SLOTB;
#define ROT() do { sl_prev = sl_cur; sl_cur = sl_next; sl_next = (sl_next == (NSLOT - 1) * SLOTB) ? 0 : sl_next + SLOTB; } while (0)
    DMA_K(2, 2 * SLOTB);
    WAIT_BAR(3);
    qkt(pA0, pA1, Kbase, qr, negm, r32, hi); asm volatile("s_nop 15\n\ts_nop 7" : "+v"(pA0), "+v"(pA1)); CMASK(pA0, pA1, 0);
    START(pA0, pA1);
    _Pragma("unroll") for (int r = 0; r < 16; ++r) pA1[r] = __builtin_amdgcn_exp2f(pA1[r]);
    WAIT_BAR(0);
    DMA_K(3, 0); DMA_V(1, SLOTB);
    ROT();
    kload8(kf, kp0 + sl_cur);
    WAIT_BAR(2);
    s16x4 vlo[8], vhi[8]; u32x4 pw0, pw1, pw2, pw3;
#define PKW(P, B) cvtpk_s(P[B], P[B + 1])
#define PAF(k) __builtin_bit_cast(bf16x8, pw##k)
#define VFR(i) (bf16x8){vlo[i][0], vlo[i][1], vlo[i][2], vlo[i][3], vhi[i][0], vhi[i][1], vhi[i][2], vhi[i][3]}
#define PIN(x) asm volatile("" : "+v"(x))
#define MX3(a, b, c) __builtin_fmaxf(__builtin_fmaxf((a), (b)), (c))
#define GAPA(MF, A0, A1, A2, A3, W0, W1, PW) do { MF; sacc += A0; sacc += A1; sacc += A2; sacc += A3; PIN(sacc); W0; W1; PIN(PW); SBAR(); } while (0)
#define EX(v) __builtin_amdgcn_exp2f(v)
#define GAPB(MF, X, B) do { MF; X[B] = EX(X[B]); X[B + 1] = EX(X[B + 1]); X[B + 2] = EX(X[B + 2]); X[B + 3] = EX(X[B + 3]); PIN(X); SBAR(); } while (0)
#define VRD(i) do { vlo[i] = vtr(vp_ + (((i) >> 2) * 4096 + ((i) & 3) * 1024)); vhi[i] = vtr(vp_ + (((i) >> 2) * 4096 + ((i) & 3) * 1024 + 512)); } while (0)
#define KRD(G, j) do { if (G) { kload2(kf, kp0 + sl_next, j); SBAR(); } } while (0)
#define STEP(C0, C1, P0, P1, t, GK, GV, GL) do { SBAR(); \
    const lds_cptr vp_ = vp0 + sl_prev; \
    VRD(0); SBAR(); float sacc = (P0[0] + P0[1]); \
    GAPA(C0 = __builtin_amdgcn_mfma_f32_32x32x16_bf16(kf[0], qr[0], negm, 0, 0, 0), P0[2], P0[3], P0[4], P0[5],     pw0[0] = PKW(P0, 0), pw0[1] = PKW(P0, 2), pw0); \
    VRD(4); SBAR(); GAPA(C1 = __builtin_amdgcn_mfma_f32_32x32x16_bf16(kf[1], qr[0], negm, 0, 0, 0), P0[6], P0[7], P0[8], P0[9],     pw0[2] = PKW(P0, 4), pw0[3] = PKW(P0, 6), pw0); \
    VRD(1); SBAR(); GAPA(C0 = __builtin_amdgcn_mfma_f32_32x32x16_bf16(kf[2], qr[1], C0, 0, 0, 0),   P0[10], P0[11], P0[12], P0[13], pw1[0] = PKW(P0, 8), pw1[1] = PKW(P0, 10), pw1); \
    VRD(5); SBAR(); GAPA(C1 = __builtin_amdgcn_mfma_f32_32x32x16_bf16(kf[3], qr[1], C1, 0, 0, 0),   P0[14], P0[15], P1[0], P1[1],   pw1[2] = PKW(P0, 12), pw1[3] = PKW(P0, 14), pw1); \
    VRD(2); SBAR(); GAPA(C0 = __builtin_amdgcn_mfma_f32_32x32x16_bf16(kf[4], qr[2], C0, 0, 0, 0),   P1[2], P1[3], P1[4], P1[5],     pw2[0] = PKW(P1, 0), pw2[1] = PKW(P1, 2), pw2); \
    VRD(6); SBAR(); GAPA(C1 = __builtin_amdgcn_mfma_f32_32x32x16_bf16(kf[5], qr[2], C1, 0, 0, 0),   P1[6], P1[7], P1[8], P1[9],     pw2[2] = PKW(P1, 4), pw2[3] = PKW(P1, 6), pw2); \
    VRD(3); SBAR(); GAPA(C0 = __builtin_amdgcn_mfma_f32_32x32x16_bf16(kf[6], qr[3], C0, 0, 0, 0),   P1[10], P1[11], P1[12], P1[13], pw3[0] = PKW(P1, 8), pw3[1] = PKW(P1, 10), pw3); \
    VRD(7); SBAR(); GAPA(C1 = __builtin_amdgcn_mfma_f32_32x32x16_bf16(kf[7], qr[3], C1, 0, 0, 0),   P1[14], P1[15], 0.f, 0.f,       pw3[2] = PKW(P1, 12), pw3[3] = PKW(P1, 14), pw3); \
    l_reg += sacc; \
    if (GK) { DMA_K((t) + 3, sl_cur); } if (GV) { DMA_V((t) + 1, sl_next); } \
    CMASK(C0, C1, t); \
    { float a = MX3(C0[0], C0[1], C1[0]), b = MX3(C0[2], C0[3], C1[1]); a = MX3(a, C1[2], C1[3]); \
      _Pragma("unroll") for (int r = 4; r < 16; r += 4) { a = MX3(a, C0[r], C0[r + 1]); b = MX3(b, C0[r + 2], C0[r + 3]); a = MX3(a, C1[r], C1[r + 1]); b = MX3(b, C1[r + 2], C1[r + 3]); } \
      float rm = __builtin_fmaxf(a, b); { auto rr = __builtin_amdgcn_permlane32_swap(__float_as_uint(rm), __float_as_uint(rm), false, false); rm = __builtin_fmaxf(__uint_as_float(rr[0]), __uint_as_float(rr[1])); } \
      resc = false; \
      if (__builtin_expect(__any(rm > (float)THRL), 0)) { const float dl = __builtin_fmaxf(rm, 0.f); mhat += dl; \
        _Pragma("unroll") for (int r = 0; r < 16; ++r) { C0[r] -= dl; C1[r] -= dl; } \
        _Pragma("unroll") for (int r = 0; r < 16; ++r) negm[r] = -mhat; asm volatile("" : "+v"(negm)); \
        const float f = __builtin_amdgcn_exp2f(-dl); l_reg *= f; if (hi == 0) wsf[r32] = f; resc = true; } } \
    SBAR(); \
    GAPB(o[0] = __builtin_amdgcn_mfma_f32_32x32x16_bf16(PAF(0), VFR(0), o[0], 0, 0, 0), C0, 0); \
    GAPB(o[1] = __builtin_amdgcn_mfma_f32_32x32x16_bf16(PAF(0), VFR(4), o[1], 0, 0, 0), C0, 4); \
    KRD(GL, 0); GAPB(o[0] = __builtin_amdgcn_mfma_f32_32x32x16_bf16(PAF(1), VFR(1), o[0], 0, 0, 0), C0, 8); \
    KRD(GL, 1); GAPB(o[1] = __builtin_amdgcn_mfma_f32_32x32x16_bf16(PAF(1), VFR(5), o[1], 0, 0, 0), C0, 12); \
    KRD(GL, 2); GAPB(o[0] = __builtin_amdgcn_mfma_f32_32x32x16_bf16(PAF(2), VFR(2), o[0], 0, 0, 0), C1, 0); \
    KRD(GL, 3); GAPB(o[1] = __builtin_amdgcn_mfma_f32_32x32x16_bf16(PAF(2), VFR(6), o[1], 0, 0, 0), C1, 4); \
    GAPB(o[0] = __builtin_amdgcn_mfma_f32_32x32x16_bf16(PAF(3), VFR(3), o[0], 0, 0, 0), C1, 8); \
    GAPB(o[1] = __builtin_amdgcn_mfma_f32_32x32x16_bf16(PAF(3), VFR(7), o[1], 0, 0, 0), C1, 12); \
    } while (0)
    int t = 1;
#undef CMASK
#define CMASK(P0, P1, t) do {} while (0)
    for (; t + 5 < NT; t += 2) {
        STEP(pB0, pB1, pA0, pA1, t, true, true, true);     WAIT_BAR(2); RESC(); ROT();
        STEP(pA0, pA1, pB0, pB1, t + 1, true, true, true); WAIT_BAR(2); RESC(); ROT();
    }
#undef CMASK
#define CMASK(P0, P1, t) do { if (MASK) { int jb_ = (t) - (NT - 4); if (jb_ >= 0) cmask(P0, P1, jb_, wid); } } while (0)
#define ENDW(tt) do { if ((tt) + 3 < NT) { WAIT_BAR(2); } else if ((tt) + 2 < NT) { WAIT_BAR(1); } else { WAIT_BAR(0); } } while (0)
    for (; t + 1 < NT; t += 2) {
        STEP(pB0, pB1, pA0, pA1, t, (t + 3 < NT), (t + 1 < NT), (t + 1 < NT));       ENDW(t);     RESC(); ROT();
        STEP(pA0, pA1, pB0, pB1, t + 1, (t + 4 < NT), (t + 2 < NT), (t + 2 < NT));   ENDW(t + 1); RESC(); ROT();
    }
    STEP(pB0, pB1, pA0, pA1, NT - 1, false, false, false); RESC();
    { float sacc = pB0[0] + pB0[1]; _Pragma("unroll") for (int r = 2; r < 16; ++r) sacc += pB0[r]; _Pragma("unroll") for (int r = 0; r < 16; ++r) sacc += pB1[r]; l_reg += sacc;
      pw0 = (u32x4){PKW(pB0, 0), PKW(pB0, 2), PKW(pB0, 4), PKW(pB0, 6)}; pw1 = (u32x4){PKW(pB0, 8), PKW(pB0, 10), PKW(pB0, 12), PKW(pB0, 14)}; pw2 = (u32x4){PKW(pB1, 0), PKW(pB1, 2), PKW(pB1, 4), PKW(pB1, 6)}; pw3 = (u32x4){PKW(pB1, 8), PKW(pB1, 10), PKW(pB1, 12), PKW(pB1, 14)};
      SBAR(); pv(o, vb0 + sl_cur, PAF(0), PAF(1), PAF(2), PAF(3)); }
#undef PKW
#undef PAF
#undef VFR
#undef PIN
#undef MX3
#undef GAPA
#undef GAPB
#undef EX
#undef VRD
#undef KRD
#undef STEP
#undef ENDW
    { auto rr = __builtin_amdgcn_permlane32_swap(__float_as_uint(l_reg), __float_as_uint(l_reg), false, false); l_reg = __uint_as_float(rr[0]) + __uint_as_float(rr[1]); }
    if (hi == 0) wsf[32 + r32] = l_reg; asm volatile("s_waitcnt lgkmcnt(0)" ::: "memory");
    float rli[16];
#pragma unroll
    for (int r = 0; r < 16; ++r) rli[r] = __builtin_amdgcn_rcpf(wsf[32 + crow(r, hi)]);
    bf16* Ow = Oh + (long)(q0 + wid * QBLK) * op;
    { bf16* stg = (bf16*)(shm + LDS_OST) + wid * 2048;
#pragma unroll
      for (int r = 0; r < 16; ++r) { const int orow = crow(r, hi);
#pragma unroll
        for (int d0 = 0; d0 < 2; ++d0) stg[orow * 64 + d0 * 32 + r32] = __float2bfloat16(o[d0][r] * rli[r]); }
      asm volatile("s_waitcnt lgkmcnt(0)" ::: "memory");
#pragma unroll
      for (int i = 0; i < 4; ++i) { const int row = i * 8 + (lane >> 3), ch = lane & 7; const u32x4 v = *(const u32x4*)(stg + row * 64 + ch * 8); *(u32x4*)(Ow + (long)row * op + ch * 8) = v; } }
    asm volatile("s_waitcnt lgkmcnt(0)\n\ts_barrier" ::: "memory");
#undef DMA_K
#undef DMA_V
#undef CMASK
#undef START
#undef RESC
#undef ROT
}
#undef SBAR
#undef WAIT_BAR
}

constexpr int RING_BYTES = 131072;
constexpr int MISC_OFF = RING_BYTES;
constexpr int LDS_BYTES = 147456;
constexpr int NWAVES = 8;

struct Args {
    const float* in[29]; float* out; unsigned char* ws; int ph_lo, ph_hi;
};
enum { I_X = 0, I_MEM, I_NORM1, I_WIN, I_BGATE, I_QN, I_KN, I_LQ1, I_LK1, I_LQ2, I_LK2, I_SUBLN, I_WPOOL, I_PSCALE, I_MEMNORM, I_WMKV, I_MQN, I_MKN, I_WBRD, I_WBRP, I_WBRM, I_WOUT, I_NORM2,
       I_WROUTER, I_BROUTER, I_WGU, I_BGU, I_WD, I_BD };

__device__ __forceinline__ unsigned f2bf(float f) { unsigned u = __builtin_bit_cast(unsigned, f); return (u + 0x7fffu + ((u >> 16) & 1u)) >> 16; }
__device__ __forceinline__ unsigned pk2(float lo, float hi) { return f2bf(lo) | (f2bf(hi) << 16); }
__device__ __forceinline__ void p0_transpose_item(const float* W, int K, int N, bf16_t* WT, LAS float* scr, int item, int lane) {
    const int nblk = N / 32, kb = item / nblk, nb = item % nblk, k0 = 64 * kb, n0 = 32 * nb;
#pragma unroll 8
    for (int i = 0; i < 32; ++i) { const int kk = 2 * i + (lane >> 5); scr[kk * 33 + (lane & 31)] = W[(size_t)(k0 + kk) * N + n0 + (lane & 31)]; }
    LDS_WAIT(); asm volatile("" ::: "memory");
    const int c = lane & 7;
#pragma unroll
    for (int j = 0; j < 4; ++j) { const int n = (lane >> 3) + 8 * j; const LAS float* s = scr + (8 * c) * 33 + n;
        u32x4 o; o.x = pk2(s[0 * 33], s[1 * 33]); o.y = pk2(s[2 * 33], s[3 * 33]); o.z = pk2(s[4 * 33], s[5 * 33]); o.w = pk2(s[6 * 33], s[7 * 33]);
        *(u32x4*)(WT + (size_t)(n0 + n) * K + k0 + 8 * c) = o; }
    LDS_WAIT(); asm volatile("" ::: "memory");
}
__device__ __forceinline__ void rms_row_to_bf16(const float* xrow, const float* gain, bf16_t* orow, int lane) {
    const f32x4* xr = (const f32x4*)xrow + lane; const f32x4* gr = (const f32x4*)gain + lane;
    f32x4 v[4]; float s = 0.f;
#pragma unroll
    for (int j = 0; j < 4; ++j) { v[j] = xr[64 * j]; s += (v[j].x * v[j].x + v[j].y * v[j].y) + (v[j].z * v[j].z + v[j].w * v[j].w); }
    const float rstd = 1.f / sqrtf(wave_sum(s) * (1.f / 1024.f) + RMS_EPS);
    u32x2* o8 = (u32x2*)orow + lane;
#pragma unroll
    for (int j = 0; j < 4; ++j) { const f32x4 g = gr[64 * j]; u32x2 w; w.x = pk2(v[j].x * rstd * g.x, v[j].y * rstd * g.y); w.y = pk2(v[j].z * rstd * g.z, v[j].w * rstd * g.w); o8[64 * j] = w; }
}

struct Args;
typedef __attribute__((address_space(4))) const Args* kargs_t;
__device__ __forceinline__ kargs_t kargs() { kargs_t p = (kargs_t)__builtin_amdgcn_kernarg_segment_ptr(); asm volatile("" : "+s"(p)); return p; }
__global__ void __launch_bounds__(NWAVES * 64, 2) fwd_kernel(Args args) {
    extern __shared__ __attribute__((aligned(16))) unsigned char lds_raw[];
    cg::grid_group grid = cg::this_grid();
    LAS unsigned char* lds = (LAS unsigned char*)lds_raw;
    const int tid = threadIdx.x, lane = tid & 63, wave = __builtin_amdgcn_readfirstlane(tid >> 6);
    const int G = gridDim.x, bx = blockIdx.x; const int vcu = (G % 8 == 0) ? (bx % 8) * (G / 8) + bx / 8 : bx;
    const int gw = vcu * NWAVES + wave, NGW = G * NWAVES;
    const int lo = args.ph_lo, hi = args.ph_hi;
#ifndef PHMASK
#define PHMASK 0x3ff
#endif
#define IN(k) (((PHMASK >> (k)) & 1) && lo <= (k) && (k) < hi)
#define GSYNC() do { asm volatile("s_waitcnt vmcnt(0) lgkmcnt(0)" ::: "memory"); __syncthreads(); grid.sync(); asm volatile("s_waitcnt vmcnt(0)" ::: "memory"); __syncthreads(); } while (0)
#define SEAM(k) do { if (lo <= (k) && (k) + 1 < hi) GSYNC(); } while (0)
#define WSP(TY, off) ((TY*)(ka->ws + (off)))
#define WIN_T WSP(bf16_t, WS_WIN_T)
#define WBRD_T WSP(bf16_t, WS_WBRD_T)
#define WBRP_T WSP(bf16_t, WS_WBRP_T)
#define WBRM_T WSP(bf16_t, WS_WBRM_T)
#define WOUT_T WSP(bf16_t, WS_WOUT_T)
#define WMKV_T WSP(bf16_t, WS_WMKV_T)
#define WGU_T WSP(bf16_t, WS_WGU_T)
#define WD_T WSP(bf16_t, WS_WD_T)
#define XN WSP(bf16_t, WS_XN)
#define Qb WSP(bf16_t, WS_Q)
#define Kb WSP(bf16_t, WS_K)
#define Vb WSP(bf16_t, WS_V)
#define Ub WSP(bf16_t, WS_U)
#define MQb WSP(bf16_t, WS_MQ)
#define OC WSP(bf16_t, WS_OC)
#define GATES WSP(bf16_t, WS_GATES)
#define YCAT WSP(bf16_t, WS_YCAT)
#define MERGF WSP(float, WS_MERGF)
#define MERGB WSP(bf16_t, WS_MERGB)
#define XG WSP(bf16_t, WS_XG)
#define ACT WSP(bf16_t, WS_A)
#define Y4 WSP(bf16_t, WS_B)
#define MEMN WSP(bf16_t, WS_MEMN)
#define MKV WSP(bf16_t, WS_MKV)
#define ROPE WSP(f32x2, WS_ROPE)
#define WR2 WSP(float, WS_WR2)
#define ROUTEW WSP(float, WS_ROUTEW)
#define LAMP WSP(float, WS_LAM)
#define LIST WSP(u32x2, WS_LIST)
#define CNT WSP(unsigned, WS_CTL)
#define OUT (ka->out)
#define KA const kargs_t ka = kargs()

    if (IN(0)) { KA;
        LAS float* scr = (LAS float*)(lds + wave * 16384);
        constexpr int I0 = 16 * 160, I1 = 8 * 32, I2 = 4 * 32, I3 = 4 * 32, I4 = 16 * 32, I5 = 16 * 16, I6 = 32 * 1024, I7 = 32 * 512;
        constexpr int NITEMS = I0 + I1 + I2 + I3 + I4 + I5 + I6 + I7;
        for (int it = gw; it < NITEMS; it += NGW) {
            int r = it;
            if (r < I0) { p0_transpose_item(ka->in[I_WIN], 1024, 5120, WIN_T, scr, r, lane); continue; } r -= I0;
            if (r < I1) { p0_transpose_item(ka->in[I_WBRD], 512, 1024, WBRD_T, scr, r, lane); continue; } r -= I1;
            if (r < I2) { p0_transpose_item(ka->in[I_WBRP], 256, 1024, WBRP_T, scr, r, lane); continue; } r -= I2;
            if (r < I3) { p0_transpose_item(ka->in[I_WBRM], 256, 1024, WBRM_T, scr, r, lane); continue; } r -= I3;
            if (r < I4) { p0_transpose_item(ka->in[I_WOUT], 1024, 1024, WOUT_T, scr, r, lane); continue; } r -= I4;
            if (r < I5) { p0_transpose_item(ka->in[I_WMKV], 1024, 512, WMKV_T, scr, r, lane); continue; } r -= I5;
            if (r < I6) { const int e = r >> 10; p0_transpose_item(ka->in[I_WGU] + (size_t)e * 1024 * 2048, 1024, 2048, WGU_T + (size_t)e * 2048 * 1024, scr, r & 1023, lane); continue; } r -= I6;
            { const int e = r >> 9; p0_transpose_item(ka->in[I_WD] + (size_t)e * 1024 * 1024, 1024, 1024, WD_T + (size_t)e * 1024 * 1024, scr, r & 511, lane); }
        }
        for (int m = gw; m < T; m += NGW) rms_row_to_bf16(ka->in[I_X] + (size_t)m * 1024, ka->in[I_NORM1], XN + (size_t)m * 1024, lane);
        for (int m = gw; m < BATCH * MEMLEN; m += NGW) rms_row_to_bf16(ka->in[I_MEM] + (size_t)m * 1024, ka->in[I_MEMNORM], MEMN + (size_t)m * 1024, lane);
        for (int i = bx * 512 + tid; i < SEQ * 32; i += G * 512) { const int pos = i >> 5, j = i & 31;
            const float inv = 1.0f / powf(10000.0f, (float)(2 * j) / 64.0f); const float ang = (float)pos * inv;
            const double a = (double)ang; const double k = rint(a * 0.15915494309189535); const float red = (float)(a - k * 6.283185307179586);
            ROPE[i] = (f32x2){cosf(red), sinf(red)}; }
        for (int i = bx * 512 + tid; i < 1024 * 32; i += G * 512) { const int ii = i & 3, e = (i >> 2) & 15, kq = (i >> 6) & 3, eb = (i >> 8) & 1, s = i >> 9; const int k = 16 * s + 4 * kq + ii;
            WR2[i] = ka->in[I_NORM2][k] * ka->in[I_WROUTER][k * 32 + eb * 16 + e]; }
        if (bx == 0 && wave == 0) { const float s1 = wave_sum(ka->in[I_LQ1][lane] * ka->in[I_LK1][lane]), s2 = wave_sum(ka->in[I_LQ2][lane] * ka->in[I_LK2][lane]);
            if (lane == 0) LAMP[0] = expf(s1) - expf(s2) + 0.2f; }
    }
    SEAM(0);
    if (IN(1)) { KA;
#if defined(TAP) && TAP == 6
        { pg8::DenseProb P{XN, WIN_T, 1024, 1024, 1024}; pg8::StaticOrder S; S.init(T, INW, G, bx);
          pg8::EpiPlain E{WSP(bf16_t, WS_B), 5120};
          pg8::gemm_phase<pg8::EpiPlain, pg8::DenseProb, pg8::StaticOrder, true>(lds, P, S, E); }
#else
        { pg8::DenseProb P{XN, WIN_T, 1024, 1024, 1024}; pg8::StaticOrder S; S.init(T, INW, G, bx);
          pg8::EpiInProj E{Qb, Kb, Vb, Ub, MQb, GATES, ka->in[I_QN], ka->in[I_KN], ka->in[I_MQN], ka->in[I_BGATE], ROPE};
          pg8::gemm_phase<pg8::EpiInProj, pg8::DenseProb, pg8::StaticOrder, true>(lds, P, S, E); }
#endif
        { pg8::DenseProb P{MEMN, WMKV_T, 1024, 1024, 1024}; pg8::StaticOrder S; S.init(BATCH * MEMLEN, 512, G, bx);
          pg8::EpiMemKV E{MKV, ka->in[I_MKN]};
          pg8::gemm_phase<pg8::EpiMemKV, pg8::DenseProb, pg8::StaticOrder, true>(lds, P, S, E); }
    }
    SEAM(1);
    if (IN(2)) { KA;
        using abf = attn_body::bf16;
        {
            const int bh = vcu >> 4, b = bh >> 2, h = bh & 3, c = (vcu >> 3) & 1, s = vcu & 7;
            for (int i = 0; i < 8; ++i) { const int vh = i >> 2, ii = i & 3; const int qb = (ii == 0) ? s : (ii == 1) ? 15 - s : (ii == 2) ? 16 + s : 31 - s;
                const size_t rb = (size_t)b * SEQ;
                attn_body::attn_unit<8, true>(qb * 256, 4 * qb + 4, (const abf*)Qb + rb * 512 + (c * 4 + h) * 64, 512, (const abf*)Kb + rb * 512 + (c * 4 + h) * 64, 512,
                                              (const abf*)Vb + rb * 512 + h * 128 + vh * 64, 512, (abf*)OC + rb * 1024 + (c * 4 + h) * 128 + vh * 64, 1024, (char*)lds_raw); }
        }
        {
            for (int i = 0; i < 2; ++i) { const int idx = vcu * 2 + i; if (idx >= 512) break; const int b = idx >> 7, h = (idx >> 5) & 3, qb = idx & 31;
                attn_body::attn_unit<8, false>(qb * 256, 4, (const abf*)MQb + (size_t)b * SEQ * 256 + h * 64, 256, (const abf*)MKV + (size_t)b * MEMLEN * 512 + h * 64, 512,
                                               (const abf*)MKV + (size_t)b * MEMLEN * 512 + 256 + h * 64, 512, (abf*)YCAT + (size_t)b * SEQ * 1024 + 768 + h * 64, 1024, (char*)lds_raw); }
        }
        {
            LAS bf16_t* ul = (LAS bf16_t*)lds;
            LAS float* pt = (LAS float*)(lds + 24576);
            const int col = tid & 255, half = tid >> 8, g = col >> 6, dd = col & 63, w = 2 << g;
            float wreg[64];
#pragma unroll
            for (int cc = 0; cc < 64; ++cc) wreg[cc] = ka->in[I_WPOOL][(g * 64 + cc) * 64 + dd];
            const float psc = ka->in[I_PSCALE][col];
            for (int tile = vcu; tile < T / 32; tile += G) {
                const int t0 = tile * 32, p0 = t0 & (SEQ - 1);
                __syncthreads();
                for (int pc = tid; pc < 47 * 32; pc += 512) { const int r = pc >> 5, ch = pc & 31; const int pos = p0 - 15 + r;
                    u32x4 v = {0u, 0u, 0u, 0u}; if (pos >= 0) v = *(const u32x4*)(Ub + (size_t)(t0 - 15 + r) * 256 + ch * 8);
                    *(LAS u32x4*)(ul + r * 256 + ch * 8) = v; }
                __syncthreads();
                {
                    float sum = 0.f; const int rbase = 15 + 16 * half;
                    for (int i = 1; i < w; ++i) sum += __uint_as_float((unsigned)ul[(rbase - i) * 256 + col] << 16);
                    float pl[16];
#pragma unroll
                    for (int tk = 0; tk < 16; ++tk) { const float ucur = __uint_as_float((unsigned)ul[(rbase + tk) * 256 + col] << 16); sum += ucur;
                        const int pos = p0 + 16 * half + tk; const float cnt = (float)((pos + 1 < w) ? pos + 1 : w);
                        pl[tk] = sum / cnt - ucur;
                        sum -= __uint_as_float((unsigned)ul[(rbase + tk - (w - 1)) * 256 + col] << 16); }
#pragma unroll
                    for (int q4 = 0; q4 < 4; ++q4) *(LAS f32x4*)(pt + col * 36 + half * 16 + q4 * 4) = (f32x4){pl[4 * q4], pl[4 * q4 + 1], pl[4 * q4 + 2], pl[4 * q4 + 3]};
                }
                __syncthreads();
                float acc[16];
#pragma unroll
                for (int tk = 0; tk < 16; ++tk) acc[tk] = 0.f;
#pragma unroll
                for (int cc = 0; cc < 64; ++cc) { const LAS f32x4* pp = (const LAS f32x4*)(pt + (g * 64 + cc) * 36 + half * 16);
#pragma unroll
                    for (int q4 = 0; q4 < 4; ++q4) { const f32x4 p = pp[q4]; acc[4 * q4] += p[0] * wreg[cc]; acc[4 * q4 + 1] += p[1] * wreg[cc]; acc[4 * q4 + 2] += p[2] * wreg[cc]; acc[4 * q4 + 3] += p[3] * wreg[cc]; } }
#pragma unroll
                for (int tk = 0; tk < 16; ++tk) YCAT[(size_t)(t0 + 16 * half + tk) * 1024 + 512 + col] = (bf16_t)f2bf(acc[tk] * psc);
            }
            __syncthreads();
        }
    }
    SEAM(2);
    if (IN(3)) { KA;
        const float lam = LAMP[0]; const int h = lane >> 4, d8 = (lane & 15) * 8;
        const f32x4 s0 = *(const f32x4*)(ka->in[I_SUBLN] + d8), s1 = *(const f32x4*)(ka->in[I_SUBLN] + d8 + 4);
        for (int m = gw; m < T; m += NGW) {
            const u32x4 a = *(const u32x4*)(OC + (size_t)m * 1024 + h * 128 + d8), b = *(const u32x4*)(OC + (size_t)m * 1024 + (4 + h) * 128 + d8);
            f32x4 y0 = {bf_lo(a.x) - lam * bf_lo(b.x), bf_hi(a.x) - lam * bf_hi(b.x), bf_lo(a.y) - lam * bf_lo(b.y), bf_hi(a.y) - lam * bf_hi(b.y)};
            f32x4 y1 = {bf_lo(a.z) - lam * bf_lo(b.z), bf_hi(a.z) - lam * bf_hi(b.z), bf_lo(a.w) - lam * bf_lo(b.w), bf_hi(a.w) - lam * bf_hi(b.w)};
            float ss = 0.f;
#pragma unroll
            for (int j = 0; j < 4; ++j) ss += y0[j] * y0[j] + y1[j] * y1[j];
            ss += __shfl_xor(ss, 1); ss += __shfl_xor(ss, 2); ss += __shfl_xor(ss, 4); ss += __shfl_xor(ss, 8);
            const float rstd = 0.8f / sqrtf(ss * (1.0f / 128.0f) + RMS_EPS);
            pg8::store8(YCAT + (size_t)m * 1024 + h * 128 + d8, y0 * rstd * s0, y1 * rstd * s1);
        }
    }
    SEAM(3);
    if (IN(4)) { KA;
        pg8::StaticOrder S; S.init(T, 1024, G, bx);
        { pg8::DenseProb P{YCAT, WBRD_T, 1024, 512, 512}; pg8::EpiMerge<0> E{GATES, MERGF, MERGB}; pg8::gemm_phase<pg8::EpiMerge<0>, pg8::DenseProb, pg8::StaticOrder, true>(lds, P, S, E); }
        { pg8::DenseProb P{YCAT + 512, WBRP_T, 1024, 256, 256}; pg8::EpiMerge<1> E{GATES, MERGF, MERGB}; pg8::gemm_phase<pg8::EpiMerge<1>, pg8::DenseProb, pg8::StaticOrder, true>(lds, P, S, E); }
        { pg8::DenseProb P{YCAT + 768, WBRM_T, 1024, 256, 256}; pg8::EpiMerge<2> E{GATES, MERGF, MERGB}; pg8::gemm_phase<pg8::EpiMerge<2>, pg8::DenseProb, pg8::StaticOrder, true>(lds, P, S, E); }
    }
    SEAM(4);
    if (IN(5)) { KA;
        pg8::DenseProb P{MERGB, WOUT_T, 1024, 1024, 1024}; pg8::StaticOrder S; S.init(T, 1024, G, bx);
        pg8::EpiWout E{ka->in[I_X], OUT, XG, ka->in[I_NORM2]};
        pg8::gemm_phase<pg8::EpiWout, pg8::DenseProb, pg8::StaticOrder, true>(lds, P, S, E);
    }
    SEAM(5);
    if (IN(6)) { KA;
        LAS int* lcnt = (LAS int*)(lds + MISC_OFF); LAS int* lbase = lcnt + 32;
        const int ngroups = T / 16, rounds = (ngroups + NGW - 1) / NGW;
        for (int rd = 0; rd < rounds; ++rd) {
            const int grp = rd * NGW + gw; const bool valid = grp < ngroups;
            if (tid < 32) lcnt[tid] = 0;
            __syncthreads();
            int e_sel = 0, rank = 0; float w_sel = 0.f, rstd = 0.f; const int q = lane >> 4, tok = grp * 16 + (lane & 15);
            if (valid) {
                f32x4 d0 = {0.f, 0.f, 0.f, 0.f}, d1 = {0.f, 0.f, 0.f, 0.f}; float ss = 0.f;
                const float* xrow = OUT + (size_t)tok * 1024 + 4 * q; const f32x4* wr2 = (const f32x4*)WR2 + lane;
#pragma unroll 4
                for (int s = 0; s < 64; ++s) { const f32x4 xv = *(const f32x4*)(xrow + 16 * s); const f32x4 wa = wr2[(s * 2) * 64], wb = wr2[(s * 2 + 1) * 64];
                    ss += (xv[0] * xv[0] + xv[1] * xv[1]) + (xv[2] * xv[2] + xv[3] * xv[3]);
#pragma unroll
                    for (int j = 0; j < 4; ++j) { d0 = __builtin_amdgcn_mfma_f32_16x16x4f32(wa[j], xv[j], d0, 0, 0, 0); d1 = __builtin_amdgcn_mfma_f32_16x16x4f32(wb[j], xv[j], d1, 0, 0, 0); } }
                ss += __shfl_xor(ss, 16); ss += __shfl_xor(ss, 32);
                rstd = 1.0f / sqrtf(ss * (1.0f / 1024.f) + RMS_EPS);
                unsigned key[8];
#pragma unroll
                for (int r = 0; r < 8; ++r) { const int e = (r >> 2) * 16 + 4 * q + (r & 3); const float lg = ((r < 4) ? d0[r & 3] : d1[r & 3]) * rstd + ka->in[I_BROUTER][e];
                    unsigned u = __float_as_uint(lg); u ^= (u >> 31) ? 0xffffffffu : 0x80000000u; key[r] = (u & ~31u) | (unsigned)(31 - e); }
                unsigned win[4];
#pragma unroll
                for (int r = 0; r < 4; ++r) { unsigned m = key[0];
#pragma unroll
                    for (int j = 1; j < 8; ++j) m = m > key[j] ? m : key[j];
                    unsigned o = (unsigned)__shfl_xor((int)m, 16); m = m > o ? m : o; o = (unsigned)__shfl_xor((int)m, 32); m = m > o ? m : o; win[r] = m;
#pragma unroll
                    for (int j = 0; j < 8; ++j) key[j] = (key[j] == m) ? 0u : key[j]; }
                float val[4];
#pragma unroll
                for (int r = 0; r < 4; ++r) { unsigned u = win[r] & ~31u; u ^= (u >> 31) ? 0x80000000u : 0xffffffffu; val[r] = __uint_as_float(u); }
                const float p1 = expf(val[1] - val[0]), p2 = expf(val[2] - val[0]), p3 = expf(val[3] - val[0]); const float inv = 1.0f / (1.0f + p1 + p2 + p3);
                const unsigned wk = (q == 0) ? win[0] : (q == 1) ? win[1] : (q == 2) ? win[2] : win[3];
                w_sel = ((q == 0) ? 1.0f : (q == 1) ? p1 : (q == 2) ? p2 : p3) * inv; e_sel = 31 - (int)(wk & 31u);
                rank = __hip_atomic_fetch_add((int*)(lcnt + e_sel), 1, __ATOMIC_RELAXED, __HIP_MEMORY_SCOPE_WORKGROUP);
            }
            __syncthreads();
            if (tid < 32) lbase[tid] = (int)__hip_atomic_fetch_add(CNT + 64 * tid, (unsigned)lcnt[tid], __ATOMIC_RELAXED, __HIP_MEMORY_SCOPE_AGENT);
            __syncthreads();
            if (valid) { const int pos = lbase[e_sel] + rank; LIST[(size_t)e_sel * CAP + pos] = (u32x2){(unsigned)(tok * 4 + q), __float_as_uint(rstd)}; ROUTEW[tok * 4 + q] = w_sel; }
            __syncthreads();
        }
    }
    SEAM(6);
    if (IN(7) || IN(8)) { KA;
        LAS int* tp = (LAS int*)(lds + MISC_OFF + 256); LAS int* cn = tp + 40;
        if (tid == 0) { int acc = 0; for (int e = 0; e < NEXP; ++e) { const int c = (int)__hip_atomic_load(CNT + 64 * e, __ATOMIC_RELAXED, __HIP_MEMORY_SCOPE_AGENT); cn[e] = c; tp[e] = acc; acc += (c + 255) >> 8; } tp[NEXP] = acc; }
        __syncthreads();
        if (IN(7)) {
            pg8::GuProb P{XG, WGU_T, LIST, 1024, 1024, 1024}; pg8::GroupedOrder S{tp, cn, 8, G, bx};
            pg8::EpiSwiglu E{ACT, LIST, ka->in[I_BGU]};
            pg8::gemm_phase<pg8::EpiSwiglu, pg8::GuProb, pg8::GroupedOrder, true>(lds, P, S, E);
        }
        SEAM(7);
        if (IN(8)) {
            pg8::DownProb P{ACT, WD_T, 1024, 1024, 1024}; pg8::GroupedOrder S{tp, cn, 4, G, bx};
            pg8::EpiDown E{Y4, LIST, ka->in[I_BD]};
            pg8::gemm_phase<pg8::EpiDown, pg8::DownProb, pg8::GroupedOrder, true>(lds, P, S, E);
        }
    }
    SEAM(8);
    if (IN(9)) { KA;
        for (int i = bx * 512 + tid; i < T * 128; i += G * 512) { const int tok = i >> 7, c8 = (i & 127) * 8;
            const f32x4 w = *(const f32x4*)(ROUTEW + tok * 4); float* op = OUT + (size_t)tok * 1024 + c8;
            f32x4 o0 = *(const f32x4*)op, o1 = *(const f32x4*)(op + 4);
#pragma unroll
            for (int k = 0; k < 4; ++k) { const u32x4 y = *(const u32x4*)(Y4 + ((size_t)tok * 4 + k) * 1024 + c8); const float wk = w[k];
                o0[0] += wk * bf_lo(y.x); o0[1] += wk * bf_hi(y.x); o0[2] += wk * bf_lo(y.y); o0[3] += wk * bf_hi(y.y);
                o1[0] += wk * bf_lo(y.z); o1[1] += wk * bf_hi(y.z); o1[2] += wk * bf_lo(y.w); o1[3] += wk * bf_hi(y.w); }
            *(f32x4*)op = o0; *(f32x4*)(op + 4) = o1; }
    }
#ifdef TAP
    if (lo <= 10 && 10 < hi) { KA; GSYNC();
        for (int i = bx * 512 + tid; i < T * 1024; i += G * 512) { const int t = i >> 10, c = i & 1023; float v = 0.f;
#define BFV(buf, pitch, col) __uint_as_float((unsigned)(buf)[(size_t)t * (pitch) + (col)] << 16)
            if (TAP == 1) v = BFV(Qb, 512, c & 511) + 2.f * BFV(Kb, 512, c & 511) + 4.f * BFV(Vb, 512, c & 511) + 8.f * BFV(Ub, 256, c & 255) + 16.f * BFV(MQb, 256, c & 255)
                            + 32.f * BFV(GATES, 3072, c) + 64.f * BFV(GATES, 3072, 1024 + c) + 128.f * BFV(GATES, 3072, 2048 + c);
            if (TAP == 2) v = BFV(OC, 1024, c) + 2.f * BFV(YCAT, 1024, c);
            if (TAP == 3) v = BFV(MERGB, 1024, c);
            if (TAP == 4) v = BFV(XN, 1024, c);
            if (TAP == 6) { const bf16_t* z = WSP(bf16_t, WS_B) + (size_t)t * 5120 + c; v = __uint_as_float((unsigned)z[0] << 16) + 2.f * __uint_as_float((unsigned)z[1024] << 16) + 4.f * __uint_as_float((unsigned)z[2048] << 16) + 8.f * __uint_as_float((unsigned)z[3072] << 16) + 16.f * __uint_as_float((unsigned)z[4096] << 16); }
            if (TAP == 5) { const bf16_t* wt = WIN_T; const int tt = t % 5120; v = __uint_as_float((unsigned)wt[(size_t)tt * 1024 + c] << 16) + ROPE[(t & 8191) * 32 + (c & 31)].x + 2.f * ROPE[(t & 8191) * 32 + (c & 31)].y; }
            OUT[i] = v; }
    }
#endif
#undef IN
#undef SEAM
}

extern "C" void kernel_launch(void* const* d_in, const int* in_sizes, int n_in, void* d_out, int out_size, void* d_ws, size_t ws_size, hipStream_t stream) {
    static int grid = 0;
    if (grid == 0) {
        if (n_in != 29 || in_sizes[0] != T * DMODEL || out_size != T * DMODEL || ws_size < WS_END) {
            fprintf(stderr, "kernel_launch: unexpected shapes: n_in %d in0 %d out %d ws %zu (need %zu)\n", n_in, n_in > 0 ? in_sizes[0] : -1, out_size, ws_size, (size_t)WS_END); grid = -1; return; }
        int dev = 0, cus = 0, per_cu = 0;
        (void)hipGetDevice(&dev); (void)hipDeviceGetAttribute(&cus, hipDeviceAttributeMultiprocessorCount, dev);
        (void)hipFuncSetAttribute((const void*)fwd_kernel, hipFuncAttributeMaxDynamicSharedMemorySize, LDS_BYTES);
        (void)hipOccupancyMaxActiveBlocksPerMultiprocessor(&per_cu, (const void*)fwd_kernel, NWAVES * 64, LDS_BYTES);
        (void)hipGetLastError();
        grid = cus;
        fprintf(stderr, "kernel_launch: cus %d occupancy %d/CU grid %d\n", cus, per_cu, grid);
        if (per_cu < 1) fprintf(stderr, "kernel_launch: occupancy query says the kernel does not fit\n");
    }
    if (grid < 0) return;
    (void)hipMemsetAsync((char*)d_ws + WS_CTL, 0, CTL_ZERO_BYTES, stream);
    Args a{};
    for (int i = 0; i < 29; ++i) a.in[i] = (const float*)d_in[i];
    a.out = (float*)d_out; a.ws = (unsigned char*)d_ws; a.ph_lo = 0; a.ph_hi = PH_HI;
    void* args[] = {&a};
    hipError_t e = hipLaunchCooperativeKernel((const void*)fwd_kernel, dim3(grid), dim3(NWAVES * 64), args, LDS_BYTES, stream);
    if (e != hipSuccess) fprintf(stderr, "cooperative launch failed: %s (grid %d)\n", hipGetErrorString(e), grid);
}
```

```cpp
#include <hip/hip_runtime.h>
#include <hip/hip_cooperative_groups.h>
#include <hip/hip_bf16.h>
#include <cstdio>
#include <cstdint>
#include <cmath>
namespace cg = cooperative_groups;

#define LAS __attribute__((address_space(3)))
#define GAS __attribute__((address_space(1)))
typedef unsigned short bf16_t;
typedef short bf16x8 __attribute__((ext_vector_type(8)));
typedef float f32x4 __attribute__((ext_vector_type(4)));
typedef float f32x2 __attribute__((ext_vector_type(2)));
typedef float f32x16 __attribute__((ext_vector_type(16)));
typedef unsigned u32x4 __attribute__((ext_vector_type(4)));
typedef unsigned u32x2 __attribute__((ext_vector_type(2)));

#define PH_HI 10
#define PHMASK 0x3ff
#define REPEAT_MASK 0x000
constexpr int BATCH = 4, SEQ = 8192, DMODEL = 1024, T = BATCH * SEQ, INW = 5120, NEXP = 32, MEMLEN = 256;
constexpr float RMS_EPS = 1e-6f;
constexpr float C2 = 0.125f * 1.4426950408889634f;
constexpr int CAP = T;

constexpr size_t MiB = 1u << 20;
constexpr size_t WS_CTL = 0, CTL_ZERO_BYTES = 32768;
constexpr int CW_BAR = 4096;
constexpr size_t WS_ROUTEW = 1 * MiB;
constexpr size_t WS_LAM = 1 * MiB + 768 * 1024;
constexpr size_t WS_ROPE = 2 * MiB;
constexpr size_t WS_WR2 = 4 * MiB;
constexpr size_t WS_MEMN = 5 * MiB;
constexpr size_t WS_MKV = 7 * MiB;
constexpr size_t WS_WIN_T = 8 * MiB;
constexpr size_t WS_WBRD_T = 18 * MiB;
constexpr size_t WS_WBRP_T = 19 * MiB;
constexpr size_t WS_WBRM_T = 19 * MiB + 512 * 1024;
constexpr size_t WS_WOUT_T = 20 * MiB;
constexpr size_t WS_WMKV_T = 22 * MiB;
constexpr size_t WS_WGU_T = 24 * MiB;
constexpr size_t WS_WD_T = 152 * MiB;
constexpr size_t WS_A = 216 * MiB;
constexpr size_t WS_XN = WS_A;
constexpr size_t WS_Q = WS_A + 64 * MiB, WS_K = WS_A + 96 * MiB, WS_V = WS_A + 128 * MiB;
constexpr size_t WS_U = WS_A + 160 * MiB, WS_MQ = WS_A + 176 * MiB;
constexpr size_t WS_OC = WS_A + 192 * MiB;
constexpr size_t WS_B = 488 * MiB;
constexpr size_t WS_GATES = WS_B;
constexpr size_t WS_YCAT = WS_B + 192 * MiB;
constexpr size_t WS_MERGF = 760 * MiB;
constexpr size_t WS_MERGB = 888 * MiB;
constexpr size_t WS_XG = 952 * MiB;
constexpr size_t WS_LIST = 1016 * MiB;
constexpr size_t WS_END = 1024 * MiB;

typedef __bf16 bf16x2_v __attribute__((ext_vector_type(2)));
__device__ __forceinline__ unsigned cvt_pk_bf16(float lo, float hi) { f32x2 v = {lo, hi}; bf16x2_v b = __builtin_convertvector(v, bf16x2_v); return __builtin_bit_cast(unsigned, b); }
__device__ __forceinline__ float bf_lo(unsigned w) { return __uint_as_float(w << 16); }
__device__ __forceinline__ float bf_hi(unsigned w) { return __uint_as_float(w & 0xffff0000u); }
__device__ __forceinline__ float wave_sum(float v) {
#pragma unroll
    for (int o = 1; o < 64; o <<= 1) v += __shfl_xor(v, o);
    return v;
}
#define LDS_WAIT() asm volatile("s_waitcnt lgkmcnt(0)" ::: "memory")

namespace pg8 {
constexpr int BM = 256, BK = 64, HALF = 128, HTB = HALF * BK * 2, STAGE_BYTES = 8 * HTB, NXCD = 8, WGM = 8;
__host__ __device__ __forceinline__ int lds_byte(int r, int c) { const int st = (r >> 4) * 2 + (c >> 5), rr = r & 15, cc = c & 31, ob = rr * 64 + cc * 2; return st * 1024 + (ob ^ (((ob >> 9) & 1) << 5)); }
__host__ __device__ __forceinline__ void stage_rc(int b, int& R, int& C) { const int st = b / 1024, sb = b % 1024, swz = sb ^ (((sb >> 9) & 1) << 5); R = (st >> 1) * 16 + swz / 64; C = (st & 1) * 32 + (swz % 64) / 2; }
__host__ __device__ __forceinline__ int perm32(int rho) { const int n = rho >> 4, i = rho & 15; return 8 * (i >> 2) + 4 * n + (i & 3); }

struct Unit { int pm, pn, e, mt, cnt; };

template <int BMAP> __device__ __forceinline__ int brow(int R) { return BMAP == 0 ? ((R >> 5) * 64 + perm32(R & 31)) : ((R & ~31) + perm32(R & 31)); }

struct StaticOrder {
    int nM, nN, nwg, G, c;
    __device__ void init(int M, int N, int G_, int c_) { nM = M / BM; nN = N / BM; nwg = nM * nN; G = G_; c = c_; }
    __device__ bool next(int i, Unit& u) const {
        const long L = (long)i * G + c; if (L >= nwg) return false;
        int wgid = (int)L; { const int q = nwg / NXCD, r = nwg % NXCD, xcd = wgid % NXCD, off = wgid / NXCD; wgid = (xcd < r ? xcd * (q + 1) : r * (q + 1) + (xcd - r) * q) + off; }
        const int nig = WGM * nN, gid = wgid / nig, fm = gid * WGM, gsz = (nM - fm) < WGM ? (nM - fm) : WGM;
        u.pm = fm + ((wgid % nig) % gsz); u.pn = (wgid % nig) / gsz; u.e = 0; u.mt = 0; u.cnt = 0; return true;
    }
};
struct GroupedOrder {
    const LAS int* tp; const LAS int* cn; int NTN, G, c;
    __device__ bool next(int i, Unit& u) const {
        const int nwg = tp[NEXP] * NTN; const long L = (long)i * G + c; if (L >= nwg) return false;
        int wgid = (int)L; { const int q = nwg / NXCD, r = nwg % NXCD, xcd = wgid % NXCD, off = wgid / NXCD; wgid = (xcd < r ? xcd * (q + 1) : r * (q + 1) + (xcd - r) * q) + off; }
        int e = 0; while (e < NEXP - 1 && wgid >= tp[e + 1] * NTN) ++e;
        const int idx = wgid - tp[e] * NTN, tiles = tp[e + 1] - tp[e];
        const int nig = 4 * NTN, gid = idx / nig, fm = gid * 4, gsz = (tiles - fm) < 4 ? (tiles - fm) : 4;
        const int mt = fm + ((idx % nig) % gsz), pn = (idx % nig) / gsz;
        u.e = __builtin_amdgcn_readfirstlane(e); u.mt = __builtin_amdgcn_readfirstlane(mt); u.pm = __builtin_amdgcn_readfirstlane(tp[e] + mt);
        u.pn = __builtin_amdgcn_readfirstlane(pn); u.cnt = __builtin_amdgcn_readfirstlane(cn[e]); return true;
    }
};

struct DenseProb {
    static constexpr bool GATHER = false; static constexpr int BMAP = 0;
    const bf16_t* A; const bf16_t* Bt; int lda, ldb, K;
    __device__ __forceinline__ const char* a_base(const Unit& u) const { return (const char*)(A + (size_t)u.pm * BM * lda); }
    __device__ __forceinline__ const char* b_base(const Unit& u) const { return (const char*)(Bt + (size_t)u.pn * BM * ldb); }
    __device__ __forceinline__ size_t bhstep() const { return (size_t)32 * ldb * 2; }
    __device__ __forceinline__ unsigned a_off(const Unit&, int, int) const { return 0u; }
};
struct GuProb {
    static constexpr bool GATHER = true; static constexpr int BMAP = 1;
    const bf16_t* XG; const bf16_t* Wt; const u32x2* list; int lda, ldb, K;
    __device__ __forceinline__ const char* a_base(const Unit&) const { return (const char*)XG; }
    __device__ __forceinline__ const char* b_base(const Unit& u) const { return (const char*)(Wt + ((size_t)u.e * 2048 + 128 * u.pn) * 1024); }
    __device__ __forceinline__ size_t bhstep() const { return (size_t)1024 * 1024 * 2; }
    __device__ __forceinline__ unsigned a_off(const Unit& u, int r, int C) const {
        const int rr = u.mt * BM + r; unsigned tok = 0u;
        if (rr < u.cnt) tok = list[(size_t)u.e * CAP + rr].x >> 2;
        return tok * 2048u + (unsigned)C * 2u;
    }
};
struct DownProb {
    static constexpr bool GATHER = false; static constexpr int BMAP = 0;
    const bf16_t* A; const bf16_t* Wt; int lda, ldb, K;
    __device__ __forceinline__ const char* a_base(const Unit& u) const { return (const char*)(A + (size_t)u.pm * BM * lda); }
    __device__ __forceinline__ const char* b_base(const Unit& u) const { return (const char*)(Wt + ((size_t)u.e * 1024 + 256 * u.pn) * 1024); }
    __device__ __forceinline__ size_t bhstep() const { return (size_t)32 * ldb * 2; }
    __device__ __forceinline__ unsigned a_off(const Unit&, int, int) const { return 0u; }
};

template <class Prob> __device__ __forceinline__ void calc_aoff(const Prob& P, const Unit& u, const int (&Rr)[2], const int (&Cc)[2], unsigned (&o)[2][2]) {
#pragma unroll
    for (int h = 0; h < 2; ++h)
#pragma unroll
        for (int i = 0; i < 2; ++i) {
            if constexpr (Prob::GATHER) o[h][i] = P.a_off(u, h * HALF + Rr[i], Cc[i]);
            else o[h][i] = (unsigned)((h * HALF + Rr[i]) * P.lda + Cc[i]) * 2u;
        }
}

template <class Epi, class Prob, class Sched, bool ALIGN_EPI>
__device__ __forceinline__ void gemm_phase(LAS unsigned char* lds, const Prob& P, const Sched& S, const Epi& E) {
    const int tid = threadIdx.x, wid = __builtin_amdgcn_readfirstlane(tid >> 6), lane = tid & 63, wr = wid >> 2, wc = wid & 3, fr = lane & 15, fq = lane >> 4;
    const int K = P.K, nt = K / BK;
    int Rr[2], Cc[2]; unsigned voffB[2];
#pragma unroll
    for (int i = 0; i < 2; ++i) { stage_rc(tid * 16 + i * 8192, Rr[i], Cc[i]); voffB[i] = (unsigned)(brow<Prob::BMAP>(Rr[i]) * P.ldb + Cc[i]) * 2u; }
    const size_t kstep = (size_t)(BK * 2);
    const size_t bhstep = P.bhstep();
    const unsigned ldsw = (unsigned)wid * 1024u;
    const int aoff = lds_byte(wr * 64 + fr, fq * 8), boff = lds_byte(wc * 32 + fr, fq * 8);
#define PG8_SA(b, h) (((b) * 2 + (h)) * HTB)
#define PG8_SB(b, h) ((4 + (b) * 2 + (h)) * HTB)
#define PG8_STG(bufoff, gptr, v0, v1) do { \
        __builtin_amdgcn_global_load_lds((const unsigned*)((const char*)(gptr) + (v0)), (LAS unsigned*)(lds + (bufoff) + ldsw), 16, 0, 0); \
        __builtin_amdgcn_global_load_lds((const unsigned*)((const char*)(gptr) + (v1)), (LAS unsigned*)(lds + (bufoff) + ldsw + 8192), 16, 0, 0); } while (0)
#define PG8_STGB(bufoff, gptr) PG8_STG(bufoff, gptr, voffB[0], voffB[1])
#define PG8_LDA(dst, b, h) do { _Pragma("unroll") for (int m = 0; m < 4; ++m) _Pragma("unroll") for (int k = 0; k < 2; ++k) dst[m][k] = *(const LAS bf16x8*)(lds + PG8_SA(b, h) + aoff + m * 2048 + k * 1024); } while (0)
#define PG8_LDB(dst, b, h) do { _Pragma("unroll") for (int n = 0; n < 2; ++n) _Pragma("unroll") for (int k = 0; k < 2; ++k) dst[n][k] = *(const LAS bf16x8*)(lds + PG8_SB(b, h) + boff + n * 2048 + k * 1024); } while (0)
#define PG8_MMA(ai, bj, At, Bt) do { __builtin_amdgcn_s_setprio(1); _Pragma("unroll") for (int m = 0; m < 4; ++m) _Pragma("unroll") for (int n = 0; n < 2; ++n) _Pragma("unroll") for (int k = 0; k < 2; ++k) \
        acc[ai][bj][m][n] = __builtin_amdgcn_mfma_f32_16x16x32_bf16(Bt[n][k], At[m][k], acc[ai][bj][m][n], 0, 0, 0); __builtin_amdgcn_s_setprio(0); } while (0)
#define PG8_WAIT_V(n) asm volatile("s_waitcnt vmcnt(" #n ")" ::: "memory")
#define PG8_WAIT_L(n) asm volatile("s_waitcnt lgkmcnt(" #n ")" ::: "memory")
#define PG8_BAR __builtin_amdgcn_s_barrier()
#define PG8_SCHED __builtin_amdgcn_sched_barrier(0)
    Unit cur, nxt; int ui = 0;
    if (!S.next(0, cur)) return;
    unsigned vo[2][2], nvo[2][2];
    calc_aoff(P, cur, Rr, Cc, vo);
    bool has_next = S.next(1, nxt);
    if constexpr (Prob::GATHER) { if (has_next) calc_aoff(P, nxt, Rr, Cc, nvo); else {
#pragma unroll
        for (int h = 0; h < 2; ++h)
#pragma unroll
            for (int i = 0; i < 2; ++i) nvo[h][i] = vo[h][i]; } }
    f32x4 acc[2][2][4][2];
#pragma unroll
    for (int a = 0; a < 2; ++a)
#pragma unroll
        for (int b = 0; b < 2; ++b)
#pragma unroll
            for (int m = 0; m < 4; ++m)
#pragma unroll
                for (int n = 0; n < 2; ++n) acc[a][b][m][n] = (f32x4){0.f, 0.f, 0.f, 0.f};
    bf16x8 At[4][2], B0[2][2], B1[2][2];
    const char* cA = P.a_base(cur); const char* cB = P.b_base(cur);
    PG8_STGB(PG8_SB(0, 0), cB); PG8_STGB(PG8_SB(0, 1), cB + bhstep); PG8_STG(PG8_SA(0, 0), cA, vo[0][0], vo[0][1]); PG8_STG(PG8_SA(0, 1), cA, vo[1][0], vo[1][1]);
    if (wr == 1) PG8_BAR;
    PG8_WAIT_V(2); PG8_BAR;
    PG8_STGB(PG8_SB(1, 0), cB + kstep); PG8_STG(PG8_SA(1, 0), cA + kstep, vo[0][0], vo[0][1]); PG8_STGB(PG8_SB(1, 1), cB + bhstep + kstep);
    PG8_WAIT_V(6); PG8_BAR;
    for (;;) {
        const char* nA = has_next ? P.a_base(nxt) : cA; const char* nB = has_next ? P.b_base(nxt) : cB;
        for (int t = 0; t < nt; t += 2) {
            const bool last = (t == nt - 2);
            const char* a1 = cA + (size_t)(t + 1) * kstep;
            const char* a2 = last ? nA : cA + (size_t)(t + 2) * kstep; const char* b2 = last ? nB : cB + (size_t)(t + 2) * kstep;
            const char* a3 = a2 + kstep; const char* b3 = b2 + kstep;
            unsigned x00 = vo[0][0], x01 = vo[0][1], x10 = vo[1][0], x11 = vo[1][1];
            if constexpr (Prob::GATHER) { if (last) { x00 = nvo[0][0]; x01 = nvo[0][1]; x10 = nvo[1][0]; x11 = nvo[1][1]; } }
            PG8_LDB(B0, 0, 0); PG8_LDB(B1, 0, 1); PG8_SCHED; PG8_LDA(At, 0, 0); PG8_STG(PG8_SA(1, 1), a1, vo[1][0], vo[1][1]);
            PG8_WAIT_V(8); PG8_WAIT_L(0); PG8_BAR; PG8_MMA(0, 0, At, B0); PG8_MMA(0, 1, At, B1); PG8_BAR; PG8_SCHED;
            PG8_LDA(At, 0, 1); PG8_STGB(PG8_SB(0, 0), b2); PG8_STGB(PG8_SB(0, 1), b2 + bhstep); PG8_STG(PG8_SA(0, 0), a2, x00, x01);
            PG8_WAIT_V(8); PG8_WAIT_L(0); PG8_BAR; PG8_MMA(1, 0, At, B0); PG8_MMA(1, 1, At, B1); PG8_BAR; PG8_SCHED;
            PG8_LDB(B0, 1, 0); PG8_LDB(B1, 1, 1); PG8_SCHED; PG8_LDA(At, 1, 0); PG8_STG(PG8_SA(0, 1), a2, x10, x11);
            PG8_WAIT_V(8); PG8_WAIT_L(0); PG8_BAR; PG8_MMA(0, 0, At, B0); PG8_MMA(0, 1, At, B1); PG8_BAR; PG8_SCHED;
            PG8_LDA(At, 1, 1); PG8_STGB(PG8_SB(1, 0), b3); PG8_STGB(PG8_SB(1, 1), b3 + bhstep); PG8_STG(PG8_SA(1, 0), a3, x00, x01);
            PG8_WAIT_V(8); PG8_WAIT_L(0); PG8_BAR; PG8_MMA(1, 0, At, B0); PG8_MMA(1, 1, At, B1); PG8_BAR; PG8_SCHED;
        }
        if constexpr (ALIGN_EPI) { if (wr == 0) PG8_BAR; }
        E(acc, cur, wr, wc, fr, fq);
        if (!has_next) break;
#pragma unroll
        for (int a = 0; a < 2; ++a)
#pragma unroll
            for (int b = 0; b < 2; ++b)
#pragma unroll
                for (int m = 0; m < 4; ++m)
#pragma unroll
                    for (int n = 0; n < 2; ++n) acc[a][b][m][n] = (f32x4){0.f, 0.f, 0.f, 0.f};
        cur = nxt; cA = nA; cB = nB; ++ui;
        if constexpr (Prob::GATHER) {
#pragma unroll
            for (int h = 0; h < 2; ++h)
#pragma unroll
                for (int i = 0; i < 2; ++i) vo[h][i] = nvo[h][i];
        }
        has_next = S.next(ui + 1, nxt);
        if constexpr (Prob::GATHER) { if (has_next) { calc_aoff(P, nxt, Rr, Cc, nvo); asm volatile("" : "+v"(nvo[0][0]), "+v"(nvo[0][1]), "+v"(nvo[1][0]), "+v"(nvo[1][1])); } }
        if constexpr (ALIGN_EPI) { if (wr == 1) PG8_BAR; }
    }
    PG8_WAIT_V(0);
    if constexpr (!ALIGN_EPI) { if (wr == 0) PG8_BAR; }
    PG8_BAR;
#undef PG8_SA
#undef PG8_SB
#undef PG8_STG
#undef PG8_STGB
#undef PG8_LDA
#undef PG8_LDB
#undef PG8_MMA
#undef PG8_WAIT_V
#undef PG8_WAIT_L
#undef PG8_BAR
#undef PG8_SCHED
}

typedef const f32x4 (&AccRef)[2][2][4][2];

__device__ __forceinline__ void store8(bf16_t* p, const f32x4& a, const f32x4& b) {
    u32x4 w; w.x = cvt_pk_bf16(a[0], a[1]); w.y = cvt_pk_bf16(a[2], a[3]); w.z = cvt_pk_bf16(b[0], b[1]); w.w = cvt_pk_bf16(b[2], b[3]); *(u32x4*)p = w;
}
__device__ __forceinline__ float sigmoidf_(float v) { return __builtin_amdgcn_rcpf(1.0f + __builtin_amdgcn_exp2f(-1.4426950408889634f * v)); }

struct EpiInProj {
    bf16_t *Q, *Kb, *V, *U, *MQ, *GT; const float *qn, *kn, *mqn, *bg; const f32x2* rope;
    __device__ __forceinline__ void operator()(AccRef acc, const Unit& u, int wr, int wc, int fr, int fq) const {
        const int pn = u.pn; const int row0 = u.pm * BM + wr * 64 + fr;
        bf16_t* const Q_ = Q; bf16_t* const K_ = Kb; bf16_t* const V_ = V; bf16_t* const U_ = U; bf16_t* const MQ_ = MQ; const float* const qn_ = qn; const float* const kn_ = kn; const float* const mqn_ = mqn;
        if (pn < 4 || pn == 7) {
            const bool rope_on = pn < 4; const float* gn = pn < 2 ? qn_ : (pn < 4 ? kn_ : mqn_);
            const float sc = (pn < 2 || pn == 7) ? C2 : 1.0f;
            bf16_t* O; int pitch, colb;
            if (pn < 2) { O = Q_; pitch = 512; colb = (pn * 4 + wc) * 64; } else if (pn < 4) { O = K_; pitch = 512; colb = ((pn - 2) * 4 + wc) * 64; } else { O = MQ_; pitch = 256; colb = wc * 64; }
            const f32x4 g00 = *(const f32x4*)(gn + 8 * fq), g01 = *(const f32x4*)(gn + 8 * fq + 4), g10 = *(const f32x4*)(gn + 32 + 8 * fq), g11 = *(const f32x4*)(gn + 32 + 8 * fq + 4);
#pragma unroll
            for (int ai = 0; ai < 2; ++ai)
#pragma unroll
                for (int m = 0; m < 4; ++m) {
                    const f32x4 a0 = acc[ai][0][m][0], a1 = acc[ai][0][m][1], b0 = acc[ai][1][m][0], b1 = acc[ai][1][m][1];
                    float ss = 0.f;
#pragma unroll
                    for (int j = 0; j < 4; ++j) ss += a0[j] * a0[j] + a1[j] * a1[j] + b0[j] * b0[j] + b1[j] * b1[j];
                    ss += __shfl_xor(ss, 16); ss += __shfl_xor(ss, 32);
                    const float rstd = 1.0f / sqrtf(ss * (1.0f / 64.0f) + RMS_EPS);
                    const int row = row0 + ai * HALF + m * 16;
                    f32x4 t10 = a0 * rstd * g00, t11 = a1 * rstd * g01, t20 = b0 * rstd * g10, t21 = b1 * rstd * g11;
                    f32x4 o10, o11, o20, o21;
                    if (rope_on) {
                        const f32x4* rp = (const f32x4*)(rope + (size_t)(row & (SEQ - 1)) * 32 + 8 * fq);
                        const f32x4 r0 = rp[0], r1 = rp[1], r2 = rp[2], r3 = rp[3];
                        const f32x4 cs0 = {r0[0], r0[2], r1[0], r1[2]}, sn0 = {r0[1], r0[3], r1[1], r1[3]}, cs1 = {r2[0], r2[2], r3[0], r3[2]}, sn1 = {r2[1], r2[3], r3[1], r3[3]};
                        o10 = (t10 * cs0 - t20 * sn0) * sc; o11 = (t11 * cs1 - t21 * sn1) * sc; o20 = (t20 * cs0 + t10 * sn0) * sc; o21 = (t21 * cs1 + t11 * sn1) * sc;
                    } else { o10 = t10 * sc; o11 = t11 * sc; o20 = t20 * sc; o21 = t21 * sc; }
                    bf16_t* rowp = O + (size_t)row * pitch + colb + 8 * fq;
                    store8(rowp, o10, o11); store8(rowp + 32, o20, o21);
                }
        } else if (pn < 7) {
            bf16_t* O; int pitch, colb;
            if (pn < 6) { O = V_; pitch = 512; colb = (pn - 4) * 256 + wc * 64; } else { O = U_; pitch = 256; colb = wc * 64; }
#pragma unroll
            for (int ai = 0; ai < 2; ++ai)
#pragma unroll
                for (int m = 0; m < 4; ++m) { bf16_t* rowp = O + (size_t)(row0 + ai * HALF + m * 16) * pitch + colb + 8 * fq;
                    store8(rowp, acc[ai][0][m][0], acc[ai][0][m][1]); store8(rowp + 32, acc[ai][1][m][0], acc[ai][1][m][1]); }
        } else {
            const int gc = (pn - 8) * 256 + wc * 64 + 8 * fq;
            f32x4 bv[2][2];
#pragma unroll
            for (int bj = 0; bj < 2; ++bj)
#pragma unroll
                for (int n = 0; n < 2; ++n) bv[bj][n] = *(const f32x4*)(bg + gc + 32 * bj + 4 * n);
#pragma unroll
            for (int ai = 0; ai < 2; ++ai)
#pragma unroll
                for (int m = 0; m < 4; ++m) { bf16_t* rowp = GT + (size_t)(row0 + ai * HALF + m * 16) * 3072 + gc;
#pragma unroll
                    for (int bj = 0; bj < 2; ++bj) { f32x4 v0 = acc[ai][bj][m][0] + bv[bj][0], v1 = acc[ai][bj][m][1] + bv[bj][1];
#pragma unroll
                        for (int j = 0; j < 4; ++j) { v0[j] = sigmoidf_(v0[j]); v1[j] = sigmoidf_(v1[j]); }
                        store8(rowp + 32 * bj, v0, v1); } }
        }
    }
};
struct EpiMemKV {
    bf16_t* MKV; const float* mkn;
    __device__ __forceinline__ void operator()(AccRef acc, const Unit& u, int wr, int wc, int fr, int fq) const {
        const int row0 = u.pm * BM + wr * 64 + fr;
        f32x4 g00 = {1.f, 1.f, 1.f, 1.f}, g01 = g00, g10 = g00, g11 = g00;
        if (u.pn == 0) { g00 = *(const f32x4*)(mkn + 8 * fq); g01 = *(const f32x4*)(mkn + 8 * fq + 4); g10 = *(const f32x4*)(mkn + 32 + 8 * fq); g11 = *(const f32x4*)(mkn + 32 + 8 * fq + 4); }
#pragma unroll
        for (int ai = 0; ai < 2; ++ai)
#pragma unroll
            for (int m = 0; m < 4; ++m) {
                const f32x4 a0 = acc[ai][0][m][0], a1 = acc[ai][0][m][1], b0 = acc[ai][1][m][0], b1 = acc[ai][1][m][1];
                float rstd = 1.0f;
                if (u.pn == 0) { float ss = 0.f;
#pragma unroll
                    for (int j = 0; j < 4; ++j) ss += a0[j] * a0[j] + a1[j] * a1[j] + b0[j] * b0[j] + b1[j] * b1[j];
                    ss += __shfl_xor(ss, 16); ss += __shfl_xor(ss, 32); rstd = 1.0f / sqrtf(ss * (1.0f / 64.0f) + RMS_EPS); }
                bf16_t* rowp = MKV + (size_t)(row0 + ai * HALF + m * 16) * 512 + u.pn * 256 + wc * 64 + 8 * fq;
                store8(rowp, a0 * rstd * g00, a1 * rstd * g01); store8(rowp + 32, b0 * rstd * g10, b1 * rstd * g11);
            }
    }
};
template <int STAGE> struct EpiMerge {
    const bf16_t* GT; float* MF; bf16_t* MB;
    __device__ __forceinline__ void operator()(AccRef acc, const Unit& u, int wr, int wc, int fr, int fq) const {
        const int row0 = u.pm * BM + wr * 64 + fr, col0 = u.pn * BM + wc * 64 + 8 * fq;
#pragma unroll
        for (int ai = 0; ai < 2; ++ai)
#pragma unroll
            for (int m = 0; m < 4; ++m) { const size_t row = (size_t)(row0 + ai * HALF + m * 16);
#pragma unroll
                for (int bj = 0; bj < 2; ++bj) { const int col = col0 + 32 * bj;
                    const u32x4 g = *(const u32x4*)(GT + row * 3072 + STAGE * 1024 + col);
                    const f32x4 ga = {bf_lo(g.x), bf_hi(g.x), bf_lo(g.y), bf_hi(g.y)}, gb = {bf_lo(g.z), bf_hi(g.z), bf_lo(g.w), bf_hi(g.w)};
                    f32x4 v0 = acc[ai][bj][m][0] * ga, v1 = acc[ai][bj][m][1] * gb;
                    float* mp = MF + row * 1024 + col;
                    if (STAGE > 0) { v0 += *(const f32x4*)mp; v1 += *(const f32x4*)(mp + 4); }
                    if (STAGE < 2) { *(f32x4*)mp = v0; *(f32x4*)(mp + 4) = v1; } else store8(MB + row * 1024 + col, v0, v1); }
                if (m & 1) asm volatile("" ::: "memory"); }
    }
};
struct EpiWout {
    const float* X; float* X2; bf16_t* XG; const float* n2;
    __device__ __forceinline__ void operator()(AccRef acc, const Unit& u, int wr, int wc, int fr, int fq) const {
        const int row0 = u.pm * BM + wr * 64 + fr, col0 = u.pn * BM + wc * 64 + 8 * fq;
        f32x4 nv[2][2];
#pragma unroll
        for (int bj = 0; bj < 2; ++bj)
#pragma unroll
            for (int n = 0; n < 2; ++n) nv[bj][n] = *(const f32x4*)(n2 + col0 + 32 * bj + 4 * n);
#pragma unroll
        for (int ai = 0; ai < 2; ++ai)
#pragma unroll
            for (int m = 0; m < 4; ++m) { const size_t off = (size_t)(row0 + ai * HALF + m * 16) * 1024 + col0;
#pragma unroll
                for (int bj = 0; bj < 2; ++bj) { const f32x4 x0 = *(const f32x4*)(X + off + 32 * bj) + acc[ai][bj][m][0], x1 = *(const f32x4*)(X + off + 32 * bj + 4) + acc[ai][bj][m][1];
                    *(f32x4*)(X2 + off + 32 * bj) = x0; *(f32x4*)(X2 + off + 32 * bj + 4) = x1;
                    store8(XG + off + 32 * bj, x0 * nv[bj][0], x1 * nv[bj][1]); }
                if (m & 1) asm volatile("" ::: "memory"); }
    }
};
struct EpiSwiglu {
    bf16_t* ACT; const u32x2* list; const float* bgu;
    __device__ __forceinline__ void operator()(AccRef acc, const Unit& u, int wr, int wc, int fr, int fq) const {
        const int col = 128 * u.pn + 32 * wc + 8 * fq; const float* bp = bgu + (size_t)u.e * 2048 + col;
        const f32x4 bg0 = *(const f32x4*)bp, bg1 = *(const f32x4*)(bp + 4), bu0 = *(const f32x4*)(bp + 1024), bu1 = *(const f32x4*)(bp + 1028);
#pragma unroll
        for (int ai = 0; ai < 2; ++ai)
#pragma unroll
            for (int m = 0; m < 4; ++m) { const int r = ai * HALF + wr * 64 + m * 16 + fr, rr = u.mt * BM + r;
                float rstd = 0.f; if (rr < u.cnt) rstd = __uint_as_float(list[(size_t)u.e * CAP + rr].y);
                f32x4 o[2];
#pragma unroll
                for (int n = 0; n < 2; ++n) { const f32x4 g = acc[ai][0][m][n] * rstd + (n ? bg1 : bg0), up = acc[ai][1][m][n] * rstd + (n ? bu1 : bu0);
#pragma unroll
                    for (int j = 0; j < 4; ++j) { const float gg = fminf(g[j], 7.0f), uu = fminf(fmaxf(up[j], -7.0f), 7.0f);
                        o[n][j] = gg * __builtin_amdgcn_rcpf(1.0f + __builtin_amdgcn_exp2f(-1.702f * 1.4426950408889634f * gg)) * (uu + 1.0f); } }
                store8(ACT + (size_t)(u.pm * BM + r) * 1024 + col, o[0], o[1]); }
    }
};
struct EpiDown {
    bf16_t* Y4; const u32x2* list; const float* bd;
    __device__ __forceinline__ void operator()(AccRef acc, const Unit& u, int wr, int wc, int fr, int fq) const {
        const int col0 = u.pn * BM + wc * 64 + 8 * fq; const float* bp = bd + (size_t)u.e * 1024 + col0;
        f32x4 bv[2][2];
#pragma unroll
        for (int bj = 0; bj < 2; ++bj)
#pragma unroll
            for (int n = 0; n < 2; ++n) bv[bj][n] = *(const f32x4*)(bp + 32 * bj + 4 * n);
#pragma unroll
        for (int ai = 0; ai < 2; ++ai)
#pragma unroll
            for (int m = 0; m < 4; ++m) { const int rr = u.mt * BM + ai * HALF + wr * 64 + m * 16 + fr;
                if (rr < u.cnt) { const unsigned tk = list[(size_t)u.e * CAP + rr].x; bf16_t* rowp = Y4 + (size_t)tk * 1024 + col0;
#pragma unroll
                    for (int bj = 0; bj < 2; ++bj) store8(rowp + 32 * bj, acc[ai][bj][m][0] + bv[bj][0], acc[ai][bj][m][1] + bv[bj][1]); } }
    }
};
struct EpiPlain {
    bf16_t* Z; int ldz;
    __device__ __forceinline__ void operator()(AccRef acc, const Unit& u, int wr, int wc, int fr, int fq) const {
        const int row0 = u.pm * BM + wr * 64 + fr, col0 = u.pn * BM + wc * 64 + 8 * fq;
#pragma unroll
        for (int ai = 0; ai < 2; ++ai)
#pragma unroll
            for (int m = 0; m < 4; ++m) { bf16_t* rowp = Z + (size_t)(row0 + ai * HALF + m * 16) * ldz + col0;
                store8(rowp, acc[ai][0][m][0], acc[ai][0][m][1]); store8(rowp + 32, acc[ai][1][m][0], acc[ai][1][m][1]); }
    }
};
}

namespace attn_body {
using bf16 = __hip_bfloat16;
using s16x4 = __attribute__((ext_vector_type(4))) short;
constexpr int NW = 8, QBLK = 32, QB = QBLK * NW, KVBLK = 64, D = 64;
__device__ __forceinline__ int crow(int r, int hi) { return (r & 3) + 8 * (r >> 2) + 4 * hi; }
#define SBAR() __builtin_amdgcn_sched_barrier(0)
constexpr int NSLOT = 3, SLOTB = 8192;
constexpr int LDS_K = 0, LDS_V = NSLOT * SLOTB, LDS_WS = 2 * NSLOT * SLOTB, LDS_OST = LDS_WS + NW * 64 * 4, LDS_BYTES = LDS_OST + NW * 4096;
__device__ __forceinline__ void glds16(const void* gsrc, unsigned lds_dst) { unsigned keep;
    asm volatile("s_mov_b32 %0, m0\n\ts_mov_b32 m0, %2\n\ts_nop 0\n\tglobal_load_lds_dwordx4 %1, off\n\ts_mov_b32 m0, %0" : "=&s"(keep) : "v"(gsrc), "s"(lds_dst) : "memory"); }
__device__ __forceinline__ float max3f(float a, float b, float c) { float r; asm("v_max3_f32 %0, %1, %2, %3" : "=v"(r) : "v"(a), "v"(b), "v"(c)); return r; }
__device__ __forceinline__ float max2f(float a, float b) { float r; asm("v_max_f32_e32 %0, %1, %2" : "=v"(r) : "v"(a), "v"(b)); return r; }
__device__ __forceinline__ float fadd_s(float a, float b) { float r; asm("v_add_f32_e32 %0, %1, %2" : "=v"(r) : "v"(a), "v"(b)); return r; }
__device__ __forceinline__ float fsub_s(float a, float b) { float r; asm("v_sub_f32_e32 %0, %1, %2" : "=v"(r) : "v"(a), "v"(b)); return r; }
typedef float f32x2_t __attribute__((ext_vector_type(2))); typedef __bf16 bf16x2_t __attribute__((ext_vector_type(2)));
__device__ __forceinline__ unsigned cvtpk_s(float lo, float hi) { f32x2_t v = {lo, hi}; bf16x2_t b = __builtin_convertvector(v, bf16x2_t); return __builtin_bit_cast(unsigned, b); }
#define WAIT_BAR(N) asm volatile("s_waitcnt vmcnt(" #N ") lgkmcnt(0)\n\ts_barrier" ::: "memory")

__device__ __forceinline__ void qkt(f32x16& p0, f32x16& p1, const char* Kslot, const bf16x8* qr, const f32x16& negm, int r32, int hi) {
    const char* kb = Kslot + hi * 1024 + r32 * 16;
#pragma unroll
    for (int d0 = 0; d0 < 4; ++d0) {
        const bf16x8 b0 = *reinterpret_cast<const bf16x8*>(kb + d0 * 2048);
        const bf16x8 b1 = *reinterpret_cast<const bf16x8*>(kb + d0 * 2048 + 512);
        if (d0 == 0) { p0 = __builtin_amdgcn_mfma_f32_32x32x16_bf16(b0, qr[0], negm, 0, 0, 0); p1 = __builtin_amdgcn_mfma_f32_32x32x16_bf16(b1, qr[0], negm, 0, 0, 0); }
        else { p0 = __builtin_amdgcn_mfma_f32_32x32x16_bf16(b0, qr[d0], p0, 0, 0, 0); p1 = __builtin_amdgcn_mfma_f32_32x32x16_bf16(b1, qr[d0], p1, 0, 0, 0); } }
}
typedef __attribute__((address_space(3))) const char* lds_cptr;
typedef short v4i16_t __attribute__((ext_vector_type(4)));
__device__ __forceinline__ void kload8(bf16x8* kf, lds_cptr kp) {
    kf[0] = *(const __attribute__((address_space(3))) bf16x8*)(kp);        kf[1] = *(const __attribute__((address_space(3))) bf16x8*)(kp + 512);
    kf[2] = *(const __attribute__((address_space(3))) bf16x8*)(kp + 2048); kf[3] = *(const __attribute__((address_space(3))) bf16x8*)(kp + 2560);
    kf[4] = *(const __attribute__((address_space(3))) bf16x8*)(kp + 4096); kf[5] = *(const __attribute__((address_space(3))) bf16x8*)(kp + 4608);
    kf[6] = *(const __attribute__((address_space(3))) bf16x8*)(kp + 6144); kf[7] = *(const __attribute__((address_space(3))) bf16x8*)(kp + 6656);
}
__device__ __forceinline__ void kload2(bf16x8* kf, lds_cptr kp, int j) { kf[2 * j] = *(const __attribute__((address_space(3))) bf16x8*)(kp + j * 2048); kf[2 * j + 1] = *(const __attribute__((address_space(3))) bf16x8*)(kp + j * 2048 + 512); }
__device__ __forceinline__ s16x4 vtr(lds_cptr p) { return __builtin_bit_cast(s16x4, __builtin_amdgcn_ds_read_tr16_b64_v4i16((__attribute__((address_space(3))) v4i16_t*)p)); }
__device__ __forceinline__ float rowmax(const f32x16& p0, const f32x16& p1) {
    float a = max3f(p0[0], p0[1], p1[0]), b = max3f(p0[2], p0[3], p1[1]); a = max3f(a, p1[2], p1[3]);
#pragma unroll
    for (int r = 4; r < 16; r += 4) { a = max3f(a, p0[r], p0[r + 1]); b = max3f(b, p0[r + 2], p0[r + 3]); a = max3f(a, p1[r], p1[r + 1]); b = max3f(b, p1[r + 2], p1[r + 3]); }
    const float m = max2f(a, b);
    auto rr = __builtin_amdgcn_permlane32_swap(__float_as_uint(m), __float_as_uint(m), false, false);
    return max2f(__uint_as_float(rr[0]), __uint_as_float(rr[1]));
}
__device__ __forceinline__ void pv(f32x16* o, int vb, bf16x8 pa0, bf16x8 pa1, bf16x8 pa2, bf16x8 pa3) {
#pragma unroll
    for (int d0 = 0; d0 < 2; ++d0) { s16x4 lo[4], hi[4];
#pragma unroll
        for (int ks = 0; ks < 4; ++ks) {
            asm volatile("ds_read_b64_tr_b16 %0,%1 offset:%c2" : "=&v"(lo[ks]) : "v"(vb), "i"(d0 * 4096 + ks * 1024) : "memory");
            asm volatile("ds_read_b64_tr_b16 %0,%1 offset:%c2" : "=&v"(hi[ks]) : "v"(vb), "i"(d0 * 4096 + ks * 1024 + 512) : "memory"); }
        asm volatile("s_waitcnt lgkmcnt(0)" ::: "memory"); SBAR();
#define PK(k) (bf16x8){lo[k][0], lo[k][1], lo[k][2], lo[k][3], hi[k][0], hi[k][1], hi[k][2], hi[k][3]}
        o[d0] = __builtin_amdgcn_mfma_f32_32x32x16_bf16(pa0, PK(0), o[d0], 0, 0, 0);
        o[d0] = __builtin_amdgcn_mfma_f32_32x32x16_bf16(pa1, PK(1), o[d0], 0, 0, 0);
        o[d0] = __builtin_amdgcn_mfma_f32_32x32x16_bf16(pa2, PK(2), o[d0], 0, 0, 0);
        o[d0] = __builtin_amdgcn_mfma_f32_32x32x16_bf16(pa3, PK(3), o[d0], 0, 0, 0);
#undef PK
    }
}
__device__ __forceinline__ void cmask(f32x16& p0, f32x16& p1, int jb, int wid) {
    if (jb > (wid >> 1)) {
#pragma unroll
        for (int r = 0; r < 16; ++r) { p0[r] = -INFINITY; p1[r] = -INFINITY; } }
}
template <int THRL, bool MASK> __device__ __forceinline__ void attn_unit(int q0, int NT, const bf16* Qh, int qp, const bf16* __restrict__ Kh, int kp, const bf16* __restrict__ Vh, int vp, bf16* Oh, int op, char* shm) {
    const int tid = threadIdx.x, lane = tid & 63, r32 = lane & 31, hi = lane >> 5; const int wid = __builtin_amdgcn_readfirstlane(tid >> 6);
    const bf16* Qw = Qh + (long)(q0 + wid * QBLK) * qp;
    const unsigned lds0 = (unsigned)(uintptr_t)shm;
    float* wsf = (float*)(shm + LDS_WS) + wid * 64;
    const bf16* ksrc = Kh + (long)lane * kp + wid * 8;
    const bf16* vsrc = Vh + (long)(16 * (wid & 3) + (lane >> 2)) * vp + (wid >> 2) * 32 + (lane & 3) * 8;
    const unsigned kdst = lds0 + LDS_K + wid * 1024, vdst = lds0 + LDS_V + wid * 1024;
#define DMA_K(t, slot) glds16(ksrc + (long)(t) * KVBLK * kp, (unsigned)__builtin_amdgcn_readfirstlane(kdst + (slot)))
#define DMA_V(t, slot) glds16(vsrc + (long)(t) * KVBLK * vp, (unsigned)__builtin_amdgcn_readfirstlane(vdst + (slot)))
    const int vb0 = (int)(lds0 + LDS_V) + ((lane >> 4) & 1) * 32 + (lane & 3) * 8 + (4 * hi + ((lane & 15) >> 2)) * 64;
    const char* Kbase = shm + LDS_K; bf16x8 kf[8];
    const lds_cptr shm3 = (lds_cptr)shm; const lds_cptr kp0 = shm3 + LDS_K + hi * 1024 + r32 * 16; const lds_cptr vp0 = shm3 + LDS_V + ((lane >> 4) & 1) * 32 + (lane & 3) * 8 + (4 * hi + ((lane & 15) >> 2)) * 64;
    DMA_K(0, 0); DMA_V(0, 0); DMA_K(1, SLOTB);
    bf16x8 qr[4];
#pragma unroll
    for (int d0 = 0; d0 < 4; ++d0) qr[d0] = *reinterpret_cast<const bf16x8*>(&Qw[(long)r32 * qp + d0 * 16 + hi * 8]);
    float mhat = 0.f, l_reg = 0.f; f32x16 o[2]; o[0] = f32x16{}; o[1] = f32x16{}; f32x16 negm = f32x16{}; asm volatile("" : "+v"(negm));
#define CMASK(P0, P1, t) do { if (MASK) { int jb_ = (t) - (NT - 4); if (jb_ >= 0) cmask(P0, P1, jb_, wid); } } while (0)
    bool resc = false;
#define START(P0, P1) do { const float rm = rowmax(P0, P1); resc = false; \
    { const float dl = rm; mhat = fadd_s(mhat, dl); \
      _Pragma("unroll") for (int r = 0; r < 16; ++r) { P0[r] = fsub_s(P0[r], dl); P1[r] = fsub_s(P1[r], dl); } \
      _Pragma("unroll") for (int r = 0; r < 16; ++r) negm[r] = -mhat; asm volatile("" : "+v"(negm)); } \
    _Pragma("unroll") for (int r = 0; r < 16; ++r) P0[r] = __builtin_amdgcn_exp2f(P0[r]); } while (0)
#define RESC() do { if (resc) { asm volatile("s_waitcnt lgkmcnt(0)" ::: "memory"); \
      _Pragma("unroll") for (int d_ = 0; d_ < 2; ++d_) _Pragma("unroll") for (int r = 0; r < 16; ++r) o[d_][r] *= wsf[crow(r, hi)]; } } while (0)
    f32x16 pA0, pA1, pB0, pB1;
    int sl_prev = 0, sl_cur = 0, sl_next = SLOTB;
#define ROT() do { sl_prev = sl_cur; sl_cur = sl_next; sl_next = (sl_next == (NSLOT - 1) * SLOTB) ? 0 : sl_next + SLOTB; } while (0)
    DMA_K(2, 2 * SLOTB);
    WAIT_BAR(3);
    qkt(pA0, pA1, Kbase, qr, negm, r32, hi); asm volatile("s_nop 15\n\ts_nop 7" : "+v"(pA0), "+v"(pA1)); CMASK(pA0, pA1, 0);
    START(pA0, pA1);
    _Pragma("unroll") for (int r = 0; r < 16; ++r) pA1[r] = __builtin_amdgcn_exp2f(pA1[r]);
    WAIT_BAR(0);
    DMA_K(3, 0); DMA_V(1, SLOTB);
    ROT();
    kload8(kf, kp0 + sl_cur);
    WAIT_BAR(2);
    s16x4 vlo[8], vhi[8]; u32x4 pw0, pw1, pw2, pw3;
#define PKW(P, B) cvtpk_s(P[B], P[B + 1])
#define PAF(k) __builtin_bit_cast(bf16x8, pw##k)
#define VFR(i) (bf16x8){vlo[i][0], vlo[i][1], vlo[i][2], vlo[i][3], vhi[i][0], vhi[i][1], vhi[i][2], vhi[i][3]}
#define PIN(x) asm volatile("" : "+v"(x))
#define MX3(a, b, c) __builtin_fmaxf(__builtin_fmaxf((a), (b)), (c))
#define GAPA(MF, A0, A1, A2, A3, W0, W1, PW) do { MF; sacc += A0; sacc += A1; sacc += A2; sacc += A3; PIN(sacc); W0; W1; PIN(PW); SBAR(); } while (0)
#define EX(v) __builtin_amdgcn_exp2f(v)
#define GAPB(MF, X, B) do { MF; X[B] = EX(X[B]); X[B + 1] = EX(X[B + 1]); X[B + 2] = EX(X[B + 2]); X[B + 3] = EX(X[B + 3]); PIN(X); SBAR(); } while (0)
#define VRD(i) do { vlo[i] = vtr(vp_ + (((i) >> 2) * 4096 + ((i) & 3) * 1024)); vhi[i] = vtr(vp_ + (((i) >> 2) * 4096 + ((i) & 3) * 1024 + 512)); } while (0)
#define KRD(G, j) do { if (G) { kload2(kf, kp0 + sl_next, j); SBAR(); } } while (0)
#define STEP(C0, C1, P0, P1, t, GK, GV, GL) do { SBAR(); \
    const lds_cptr vp_ = vp0 + sl_prev; \
    VRD(0); SBAR(); float sacc = (P0[0] + P0[1]); \
    GAPA(C0 = __builtin_amdgcn_mfma_f32_32x32x16_bf16(kf[0], qr[0], negm, 0, 0, 0), P0[2], P0[3], P0[4], P0[5],     pw0[0] = PKW(P0, 0), pw0[1] = PKW(P0, 2), pw0); \
    VRD(4); SBAR(); GAPA(C1 = __builtin_amdgcn_mfma_f32_32x32x16_bf16(kf[1], qr[0], negm, 0, 0, 0), P0[6], P0[7], P0[8], P0[9],     pw0[2] = PKW(P0, 4), pw0[3] = PKW(P0, 6), pw0); \
    VRD(1); SBAR(); GAPA(C0 = __builtin_amdgcn_mfma_f32_32x32x16_bf16(kf[2], qr[1], C0, 0, 0, 0),   P0[10], P0[11], P0[12], P0[13], pw1[0] = PKW(P0, 8), pw1[1] = PKW(P0, 10), pw1); \
    VRD(5); SBAR(); GAPA(C1 = __builtin_amdgcn_mfma_f32_32x32x16_bf16(kf[3], qr[1], C1, 0, 0, 0),   P0[14], P0[15], P1[0], P1[1],   pw1[2] = PKW(P0, 12), pw1[3] = PKW(P0, 14), pw1); \
    VRD(2); SBAR(); GAPA(C0 = __builtin_amdgcn_mfma_f32_32x32x16_bf16(kf[4], qr[2], C0, 0, 0, 0),   P1[2], P1[3], P1[4], P1[5],     pw2[0] = PKW(P1, 0), pw2[1] = PKW(P1, 2), pw2); \
    VRD(6); SBAR(); GAPA(C1 = __builtin_amdgcn_mfma_f32_32x32x16_bf16(kf[5], qr[2], C1, 0, 0, 0),   P1[6], P1[7], P1[8], P1[9],     pw2[2] = PKW(P1, 4), pw2[3] = PKW(P1, 6), pw2); \
    VRD(3); SBAR(); GAPA(C0 = __builtin_amdgcn_mfma_f32_32x32x16_bf16(kf[6], qr[3], C0, 0, 0, 0),   P1[10], P1[11], P1[12], P1[13], pw3[0] = PKW(P1, 8), pw3[1] = PKW(P1, 10), pw3); \
    VRD(7); SBAR(); GAPA(C1 = __builtin_amdgcn_mfma_f32_32x32x16_bf16(kf[7], qr[3], C1, 0, 0, 0),   P1[14], P1[15], 0.f, 0.f,       pw3[2] = PKW(P1, 12), pw3[3] = PKW(P1, 14), pw3); \
    l_reg += sacc; \
    if (GK) { DMA_K((t) + 3, sl_cur); } if (GV) { DMA_V((t) + 1, sl_next); } \
    CMASK(C0, C1, t); \
    { float a = MX3(C0[0], C0[1], C1[0]), b = MX3(C0[2], C0[3], C1[1]); a = MX3(a, C1[2], C1[3]); \
      _Pragma("unroll") for (int r = 4; r < 16; r += 4) { a = MX3(a, C0[r], C0[r + 1]); b = MX3(b, C0[r + 2], C0[r + 3]); a = MX3(a, C1[r], C1[r + 1]); b = MX3(b, C1[r + 2], C1[r + 3]); } \
      float rm = __builtin_fmaxf(a, b); { auto rr = __builtin_amdgcn_permlane32_swap(__float_as_uint(rm), __float_as_uint(rm), false, false); rm = __builtin_fmaxf(__uint_as_float(rr[0]), __uint_as_float(rr[1])); } \
      resc = false; \
      if (__builtin_expect(__any(rm > (float)THRL), 0)) { const float dl = __builtin_fmaxf(rm, 0.f); mhat += dl; \
        _Pragma("unroll") for (int r = 0; r < 16; ++r) { C0[r] -= dl; C1[r] -= dl; } \
        _Pragma("unroll") for (int r = 0; r < 16; ++r) negm[r] = -mhat; asm volatile("" : "+v"(negm)); \
        const float f = __builtin_amdgcn_exp2f(-dl); l_reg *= f; if (hi == 0) wsf[r32] = f; resc = true; } } \
    SBAR(); \
    GAPB(o[0] = __builtin_amdgcn_mfma_f32_32x32x16_bf16(PAF(0), VFR(0), o[0], 0, 0, 0), C0, 0); \
    GAPB(o[1] = __builtin_amdgcn_mfma_f32_32x32x16_bf16(PAF(0), VFR(4), o[1], 0, 0, 0), C0, 4); \
    KRD(GL, 0); GAPB(o[0] = __builtin_amdgcn_mfma_f32_32x32x16_bf16(PAF(1), VFR(1), o[0], 0, 0, 0), C0, 8); \
    KRD(GL, 1); GAPB(o[1] = __builtin_amdgcn_mfma_f32_32x32x16_bf16(PAF(1), VFR(5), o[1], 0, 0, 0), C0, 12); \
    KRD(GL, 2); GAPB(o[0] = __builtin_amdgcn_mfma_f32_32x32x16_bf16(PAF(2), VFR(2), o[0], 0, 0, 0), C1, 0); \
    KRD(GL, 3); GAPB(o[1] = __builtin_amdgcn_mfma_f32_32x32x16_bf16(PAF(2), VFR(6), o[1], 0, 0, 0), C1, 4); \
    GAPB(o[0] = __builtin_amdgcn_mfma_f32_32x32x16_bf16(PAF(3), VFR(3), o[0], 0, 0, 0), C1, 8); \
    GAPB(o[1] = __builtin_amdgcn_mfma_f32_32x32x16_bf16(PAF(3), VFR(7), o[1], 0, 0, 0), C1, 12); \
    } while (0)
    int t = 1;
#undef CMASK
#define CMASK(P0, P1, t) do {} while (0)
    for (; t + 5 < NT; t += 2) {
        STEP(pB0, pB1, pA0, pA1, t, true, true, true);     WAIT_BAR(2); RESC(); ROT();
        STEP(pA0, pA1, pB0, pB1, t + 1, true, true, true); WAIT_BAR(2); RESC(); ROT();
    }
#undef CMASK
#define CMASK(P0, P1, t) do { if (MASK) { int jb_ = (t) - (NT - 4); if (jb_ >= 0) cmask(P0, P1, jb_, wid); } } while (0)
#define ENDW(tt) do { if ((tt) + 3 < NT) { WAIT_BAR(2); } else if ((tt) + 2 < NT) { WAIT_BAR(1); } else { WAIT_BAR(0); } } while (0)
    for (; t + 1 < NT; t += 2) {
        STEP(pB0, pB1, pA0, pA1, t, (t + 3 < NT), (t + 1 < NT), (t + 1 < NT));       ENDW(t);     RESC(); ROT();
        STEP(pA0, pA1, pB0, pB1, t + 1, (t + 4 < NT), (t + 2 < NT), (t + 2 < NT));   ENDW(t + 1); RESC(); ROT();
    }
    STEP(pB0, pB1, pA0, pA1, NT - 1, false, false, false); RESC();
    { float sacc = pB0[0] + pB0[1]; _Pragma("unroll") for (int r = 2; r < 16; ++r) sacc += pB0[r]; _Pragma("unroll") for (int r = 0; r < 16; ++r) sacc += pB1[r]; l_reg += sacc;
      pw0 = (u32x4){PKW(pB0, 0), PKW(pB0, 2), PKW(pB0, 4), PKW(pB0, 6)}; pw1 = (u32x4){PKW(pB0, 8), PKW(pB0, 10), PKW(pB0, 12), PKW(pB0, 14)}; pw2 = (u32x4){PKW(pB1, 0), PKW(pB1, 2), PKW(pB1, 4), PKW(pB1, 6)}; pw3 = (u32x4){PKW(pB1, 8), PKW(pB1, 10), PKW(pB1, 12), PKW(pB1, 14)};
      SBAR(); pv(o, vb0 + sl_cur, PAF(0), PAF(1), PAF(2), PAF(3)); }
#undef PKW
#undef PAF
#undef VFR
#undef PIN
#undef MX3
#undef GAPA
#undef GAPB
#undef EX
#undef VRD
#undef KRD
#undef STEP
#undef ENDW
    { auto rr = __builtin_amdgcn_permlane32_swap(__float_as_uint(l_reg), __float_as_uint(l_reg), false, false); l_reg = __uint_as_float(rr[0]) + __uint_as_float(rr[1]); }
    if (hi == 0) wsf[32 + r32] = l_reg; asm volatile("s_waitcnt lgkmcnt(0)" ::: "memory");
    float rli[16];
#pragma unroll
    for (int r = 0; r < 16; ++r) rli[r] = __builtin_amdgcn_rcpf(wsf[32 + crow(r, hi)]);
    bf16* Ow = Oh + (long)(q0 + wid * QBLK) * op;
    { bf16* stg = (bf16*)(shm + LDS_OST) + wid * 2048;
#pragma unroll
      for (int r = 0; r < 16; ++r) { const int orow = crow(r, hi);
#pragma unroll
        for (int d0 = 0; d0 < 2; ++d0) stg[orow * 64 + d0 * 32 + r32] = __float2bfloat16(o[d0][r] * rli[r]); }
      asm volatile("s_waitcnt lgkmcnt(0)" ::: "memory");
#pragma unroll
      for (int i = 0; i < 4; ++i) { const int row = i * 8 + (lane >> 3), ch = lane & 7; const u32x4 v = *(const u32x4*)(stg + row * 64 + ch * 8); *(u32x4*)(Ow + (long)row * op + ch * 8) = v; } }
    asm volatile("s_waitcnt lgkmcnt(0)\n\ts_barrier" ::: "memory");
#undef DMA_K
#undef DMA_V
#undef CMASK
#undef START
#undef RESC
#undef ROT
}

constexpr int L2_K = 0, L2_V = 3 * 8192, L2_WS = L2_V + 3 * 16384, L2_OST = L2_WS + NW * 64 * 4, L2_BYTES = L2_OST + NW * 4096;
template <bool MASK> __device__ __forceinline__ void attn_unit2(int q0, int NT, const bf16* Qh, int qp, const bf16* __restrict__ Kh, int kp, const bf16* __restrict__ Vh, int vp, bf16* Oh, int op, char* shm) {
    const int tid = threadIdx.x, lane = tid & 63, r32 = lane & 31, hi = lane >> 5; const int wid = __builtin_amdgcn_readfirstlane(tid >> 6);
    const bf16* Qw = Qh + (long)(q0 + wid * QBLK) * qp;
    const unsigned lds0 = (unsigned)(uintptr_t)shm;
    float* wsf = (float*)(shm + L2_WS) + wid * 64;
    const bf16* ksrc = Kh + (long)lane * kp + wid * 8;
    const bf16* vsrc = Vh + (long)(16 * (wid & 3) + (lane >> 2)) * vp + (wid >> 2) * 32 + (lane & 3) * 8;
    const unsigned kdst = lds0 + L2_K + wid * 1024, vdst = lds0 + L2_V + wid * 1024;
#define DMA_K(t, slot) glds16(ksrc + (long)(t) * KVBLK * kp, (unsigned)__builtin_amdgcn_readfirstlane(kdst + (slot)))
#define DMA_V(t, slot) do { glds16(vsrc + (long)(t) * KVBLK * vp, (unsigned)__builtin_amdgcn_readfirstlane(vdst + 2 * (slot))); \
                            glds16(vsrc + (long)(t) * KVBLK * vp + 64, (unsigned)__builtin_amdgcn_readfirstlane(vdst + 2 * (slot) + 8192)); } while (0)
    const int vb0 = (int)(lds0 + L2_V) + ((lane >> 4) & 1) * 32 + (lane & 3) * 8 + (4 * hi + ((lane & 15) >> 2)) * 64;
    const char* Kbase = shm + L2_K; bf16x8 kf[8];
    const lds_cptr shm3 = (lds_cptr)shm; const lds_cptr kp0 = shm3 + L2_K + hi * 1024 + r32 * 16; const lds_cptr vp0 = shm3 + L2_V + ((lane >> 4) & 1) * 32 + (lane & 3) * 8 + (4 * hi + ((lane & 15) >> 2)) * 64;
    DMA_K(0, 0); DMA_V(0, 0); DMA_K(1, SLOTB);
    bf16x8 qr[4];
#pragma unroll
    for (int d0 = 0; d0 < 4; ++d0) qr[d0] = *reinterpret_cast<const bf16x8*>(&Qw[(long)r32 * qp + d0 * 16 + hi * 8]);
    float l_reg = 0.f; f32x16 o[4]; o[0] = f32x16{}; o[1] = f32x16{}; o[2] = f32x16{}; o[3] = f32x16{};
    const f32x16 zero16 = f32x16{};
#define CMASK(P0, P1, t) do { if (MASK) { int jb_ = (t) - (NT - 4); if (jb_ >= 0) cmask(P0, P1, jb_, wid); } } while (0)
    f32x16 pA0, pA1, pB0, pB1;
    int sl_prev = 0, sl_cur = 0, sl_next = SLOTB;
#define ROT() do { sl_prev = sl_cur; sl_cur = sl_next; sl_next = (sl_next == (NSLOT - 1) * SLOTB) ? 0 : sl_next + SLOTB; } while (0)
    DMA_K(2, 2 * SLOTB);
    WAIT_BAR(4);
    qkt(pA0, pA1, Kbase, qr, zero16, r32, hi); CMASK(pA0, pA1, 0);
    _Pragma("unroll") for (int r = 0; r < 16; ++r) { pA0[r] = __builtin_amdgcn_exp2f(pA0[r]); pA1[r] = __builtin_amdgcn_exp2f(pA1[r]); }
    WAIT_BAR(0);
    DMA_K(3, 0); DMA_V(1, SLOTB);
    ROT();
    kload8(kf, kp0 + sl_cur);
    WAIT_BAR(3);
    s16x4 f0lo, f0hi, f1lo, f1hi, f2lo, f2hi, f3lo, f3hi; u32x4 pw0, pw1, pw2, pw3;
#define PKW(P, B) cvtpk_s(P[B], P[B + 1])
#define PAF(k) __builtin_bit_cast(bf16x8, pw##k)
#define PIN(x) asm volatile("" : "+v"(x))
#define EX(v) __builtin_amdgcn_exp2f(v)
#define VOFF(id) ((((id) >> 2) * 4096) + (((id) & 3) * 1024))
#define VRD2(F, id) do { F##lo = vtr(vp_ + VOFF(id)); F##hi = vtr(vp_ + VOFF(id) + 512); } while (0)
#define VFR2(F) (bf16x8){F##lo[0], F##lo[1], F##lo[2], F##lo[3], F##hi[0], F##hi[1], F##hi[2], F##hi[3]}
#define GAPA(MF, A0, A1, A2, A3, W0, W1, PW) do { MF; sacc += A0; sacc += A1; sacc += A2; sacc += A3; PIN(sacc); W0; W1; PIN(PW); SBAR(); } while (0)
#define GAPB(MF, RD, X, B) do { MF; RD; X[B] = EX(X[B]); X[B + 1] = EX(X[B + 1]); PIN(X); SBAR(); } while (0)
#define KRD(G, j) do { if (G) { kload2(kf, kp0 + sl_next, j); SBAR(); } } while (0)
#define MF32(a, b, c) __builtin_amdgcn_mfma_f32_32x32x16_bf16(a, b, c, 0, 0, 0)
#define STEP(C0, C1, P0, P1, t, GK, GV, GL) do { SBAR(); \
    const lds_cptr vp_ = vp0 + 2 * sl_prev; \
    float sacc = (P0[0] + P0[1]); \
    GAPA(C0 = MF32(kf[0], qr[0], zero16), P0[2], P0[3], P0[4], P0[5],     pw0[0] = PKW(P0, 0), pw0[1] = PKW(P0, 2), pw0); \
    GAPA(C1 = MF32(kf[1], qr[0], zero16), P0[6], P0[7], P0[8], P0[9],     pw0[2] = PKW(P0, 4), pw0[3] = PKW(P0, 6), pw0); \
    GAPA(C0 = MF32(kf[2], qr[1], C0),     P0[10], P0[11], P0[12], P0[13], pw1[0] = PKW(P0, 8), pw1[1] = PKW(P0, 10), pw1); \
    GAPA(C1 = MF32(kf[3], qr[1], C1),     P0[14], P0[15], P1[0], P1[1],   pw1[2] = PKW(P0, 12), pw1[3] = PKW(P0, 14), pw1); \
    VRD2(f0, 0); SBAR();  GAPA(C0 = MF32(kf[4], qr[2], C0), P1[2], P1[3], P1[4], P1[5],     pw2[0] = PKW(P1, 0), pw2[1] = PKW(P1, 2), pw2); \
    VRD2(f1, 4); SBAR();  GAPA(C1 = MF32(kf[5], qr[2], C1), P1[6], P1[7], P1[8], P1[9],     pw2[2] = PKW(P1, 4), pw2[3] = PKW(P1, 6), pw2); \
    VRD2(f2, 8); SBAR();  GAPA(C0 = MF32(kf[6], qr[3], C0), P1[10], P1[11], P1[12], P1[13], pw3[0] = PKW(P1, 8), pw3[1] = PKW(P1, 10), pw3); \
    VRD2(f3, 12); SBAR(); GAPA(C1 = MF32(kf[7], qr[3], C1), P1[14], P1[15], 0.f, 0.f,       pw3[2] = PKW(P1, 12), pw3[3] = PKW(P1, 14), pw3); \
    l_reg += sacc; \
    if (GK) { DMA_K((t) + 3, sl_cur); } if (GV) { DMA_V((t) + 1, sl_next); } \
    CMASK(C0, C1, t); \
    SBAR(); \
    GAPB(o[0] = MF32(PAF(0), VFR2(f0), o[0]), VRD2(f0, 1),  C0, 0); \
    GAPB(o[1] = MF32(PAF(0), VFR2(f1), o[1]), VRD2(f1, 5),  C0, 2); \
    GAPB(o[2] = MF32(PAF(0), VFR2(f2), o[2]), VRD2(f2, 9),  C0, 4); \
    GAPB(o[3] = MF32(PAF(0), VFR2(f3), o[3]), VRD2(f3, 13), C0, 6); \
    KRD(GL, 0); GAPB(o[0] = MF32(PAF(1), VFR2(f0), o[0]), VRD2(f0, 2),  C0, 8); \
    GAPB(o[1] = MF32(PAF(1), VFR2(f1), o[1]), VRD2(f1, 6),  C0, 10); \
    KRD(GL, 1); GAPB(o[2] = MF32(PAF(1), VFR2(f2), o[2]), VRD2(f2, 10), C0, 12); \
    GAPB(o[3] = MF32(PAF(1), VFR2(f3), o[3]), VRD2(f3, 14), C0, 14); \
    KRD(GL, 2); GAPB(o[0] = MF32(PAF(2), VFR2(f0), o[0]), VRD2(f0, 3),  C1, 0); \
    GAPB(o[1] = MF32(PAF(2), VFR2(f1), o[1]), VRD2(f1, 7),  C1, 2); \
    KRD(GL, 3); GAPB(o[2] = MF32(PAF(2), VFR2(f2), o[2]), VRD2(f2, 11), C1, 4); \
    GAPB(o[3] = MF32(PAF(2), VFR2(f3), o[3]), VRD2(f3, 15), C1, 6); \
    GAPB(o[0] = MF32(PAF(3), VFR2(f0), o[0]), (void)0, C1, 8); \
    GAPB(o[1] = MF32(PAF(3), VFR2(f1), o[1]), (void)0, C1, 10); \
    GAPB(o[2] = MF32(PAF(3), VFR2(f2), o[2]), (void)0, C1, 12); \
    GAPB(o[3] = MF32(PAF(3), VFR2(f3), o[3]), (void)0, C1, 14); \
    } while (0)
    int t = 1;
#undef CMASK
#define CMASK(P0, P1, t) do {} while (0)
    for (; t + 5 < NT; t += 2) {
        STEP(pB0, pB1, pA0, pA1, t, true, true, true);     WAIT_BAR(3); ROT();
        STEP(pA0, pA1, pB0, pB1, t + 1, true, true, true); WAIT_BAR(3); ROT();
    }
#undef CMASK
#define CMASK(P0, P1, t) do { if (MASK) { int jb_ = (t) - (NT - 4); if (jb_ >= 0) cmask(P0, P1, jb_, wid); } } while (0)
#define ENDW(tt) do { if ((tt) + 3 < NT) { WAIT_BAR(3); } else if ((tt) + 2 < NT) { WAIT_BAR(2); } else { WAIT_BAR(0); } } while (0)
    for (; t + 1 < NT; t += 2) {
        STEP(pB0, pB1, pA0, pA1, t, (t + 3 < NT), (t + 1 < NT), (t + 1 < NT));       ENDW(t);     ROT();
        STEP(pA0, pA1, pB0, pB1, t + 1, (t + 4 < NT), (t + 2 < NT), (t + 2 < NT));   ENDW(t + 1); ROT();
    }
    STEP(pB0, pB1, pA0, pA1, NT - 1, false, false, false);
    { float sacc = pB0[0] + pB0[1]; _Pragma("unroll") for (int r = 2; r < 16; ++r) sacc += pB0[r]; _Pragma("unroll") for (int r = 0; r < 16; ++r) sacc += pB1[r]; l_reg += sacc;
      pw0 = (u32x4){PKW(pB0, 0), PKW(pB0, 2), PKW(pB0, 4), PKW(pB0, 6)}; pw1 = (u32x4){PKW(pB0, 8), PKW(pB0, 10), PKW(pB0, 12), PKW(pB0, 14)}; pw2 = (u32x4){PKW(pB1, 0), PKW(pB1, 2), PKW(pB1, 4), PKW(pB1, 6)}; pw3 = (u32x4){PKW(pB1, 8), PKW(pB1, 10), PKW(pB1, 12), PKW(pB1, 14)};
      SBAR();
      const lds_cptr vp_ = vp0 + 2 * sl_cur;
#pragma unroll
      for (int db = 0; db < 4; ++db) { VRD2(f0, db * 4 + 0); VRD2(f1, db * 4 + 1); VRD2(f2, db * 4 + 2); VRD2(f3, db * 4 + 3);
          o[db] = MF32(PAF(0), VFR2(f0), o[db]); o[db] = MF32(PAF(1), VFR2(f1), o[db]); o[db] = MF32(PAF(2), VFR2(f2), o[db]); o[db] = MF32(PAF(3), VFR2(f3), o[db]); } }
#undef PKW
#undef PAF
#undef PIN
#undef EX
#undef VOFF
#undef VRD2
#undef VFR2
#undef GAPA
#undef GAPB
#undef KRD
#undef MF32
#undef STEP
#undef ENDW
    { auto rr = __builtin_amdgcn_permlane32_swap(__float_as_uint(l_reg), __float_as_uint(l_reg), false, false); l_reg = __uint_as_float(rr[0]) + __uint_as_float(rr[1]); }
    if (hi == 0) wsf[32 + r32] = l_reg; asm volatile("s_waitcnt lgkmcnt(0)" ::: "memory");
    float rli[16];
#pragma unroll
    for (int r = 0; r < 16; ++r) rli[r] = __builtin_amdgcn_rcpf(wsf[32 + crow(r, hi)]);
    bf16* Ow = Oh + (long)(q0 + wid * QBLK) * op;
    { bf16* stg = (bf16*)(shm + L2_OST) + wid * 2048;
#pragma unroll
      for (int dh = 0; dh < 2; ++dh) {
#pragma unroll
        for (int r = 0; r < 16; ++r) { const int orow = crow(r, hi);
#pragma unroll
          for (int d0 = 0; d0 < 2; ++d0) stg[orow * 64 + d0 * 32 + r32] = __float2bfloat16(o[dh * 2 + d0][r] * rli[r]); }
        asm volatile("s_waitcnt lgkmcnt(0)" ::: "memory");
#pragma unroll
        for (int i = 0; i < 4; ++i) { const int row = i * 8 + (lane >> 3), ch = lane & 7; const u32x4 v = *(const u32x4*)(stg + row * 64 + ch * 8); *(u32x4*)(Ow + (long)row * op + dh * 64 + ch * 8) = v; }
        asm volatile("s_waitcnt lgkmcnt(0)" ::: "memory"); } }
    asm volatile("s_waitcnt lgkmcnt(0)\n\ts_barrier" ::: "memory");
#undef DMA_K
#undef DMA_V
#undef CMASK
#undef ROT
}
#undef SBAR
#undef WAIT_BAR
}

#define XB_TMO      128
#define XB_XCNT(j)  (256  + 64 * (j))
#define XB_XSUB(j)  (1280 + 64 * (j))
#define XB_XGEN(j)  (2304 + 64 * (j))
#define XB_TOP      3328
#define XB_TOPGEN   3392
#define XCD_BAR_WORDS 3456
#define XB_SPIN_CAP (1u << 22)
__device__ __forceinline__ unsigned xb_ld(unsigned* p)              { return __hip_atomic_load(p, __ATOMIC_RELAXED, __HIP_MEMORY_SCOPE_AGENT); }
__device__ __forceinline__ unsigned xb_add(unsigned* p, unsigned v) { return __hip_atomic_fetch_add(p, v, __ATOMIC_RELAXED, __HIP_MEMORY_SCOPE_AGENT); }
__device__ __forceinline__ unsigned xb_xcc_id() { return (unsigned)__builtin_amdgcn_s_getreg((3 << 11) | 20) & 0xFu; }
#define XB_SPIN(cond, bar) do { unsigned _sp = 0; while (cond) { __builtin_amdgcn_s_sleep(1); \
    if ((++_sp & 255u) == 0u) { if (xb_ld(&(bar)[XB_TMO])) break; if (_sp > XB_SPIN_CAP) { atomicAdd(&(bar)[XB_TMO], 1u); break; } } } } while (0)
struct XcdBarrier { unsigned* bar; unsigned x; volatile LAS unsigned* st; };
__device__ __forceinline__ XcdBarrier xcd_barrier_post(unsigned* bar, volatile LAS unsigned* st) {
    XcdBarrier b; b.bar = bar; b.x = xb_xcc_id(); b.st = st;
    if (threadIdx.x == 0) (void)xb_add(&bar[XB_XCNT(b.x)], 1u);
    return b;
}
__device__ __forceinline__ void xcd_barrier_complete(unsigned* bar, unsigned x, unsigned& nloc, unsigned& nx) {
    const unsigned G = gridDim.x * gridDim.y * gridDim.z;
    unsigned sum, cnt, mine, sp = 0u;
    for (;;) {
        sum = 0u; cnt = 0u; mine = 0u;
#pragma unroll
        for (unsigned j = 0; j < 16; ++j) { const unsigned c = xb_ld(&bar[XB_XCNT(j)]); sum += c; cnt += (c > 0u) ? 1u : 0u; mine = (j == x) ? c : mine; }
        if (sum == G) break;
        __builtin_amdgcn_s_sleep(1);
        if ((++sp & 255u) == 0u) { if (xb_ld(&bar[XB_TMO])) break; if (sp > XB_SPIN_CAP) { atomicAdd(&bar[XB_TMO], 1u); break; } }
    }
    nloc = mine > 0u ? mine : 1u; nx = cnt > 0u ? cnt : 1u;
}
__device__ __forceinline__ void xcd_barrier(const XcdBarrier& b) {
    asm volatile("s_waitcnt vmcnt(0)" ::: "memory");
    __syncthreads();
    if (threadIdx.x == 0) {
        unsigned* bar = b.bar;
        __builtin_amdgcn_s_waitcnt(0);
        unsigned nloc = b.st[0], nx = b.st[1];
        if (nloc == 0u) { xcd_barrier_complete(bar, b.x, nloc, nx); b.st[0] = nloc; b.st[1] = nx; }
        const unsigned old = xb_add(&bar[XB_XSUB(b.x)], 1u);
        const unsigned gen = old / nloc;
        if (old + 1u == (gen + 1u) * nloc) {
            __builtin_amdgcn_fence(__ATOMIC_RELEASE, "agent");
            asm volatile("s_waitcnt vmcnt(0)" ::: "memory");
            const unsigned og = xb_add(&bar[XB_TOP], 1u);
            const unsigned tg = og / nx;
            if (og + 1u == (tg + 1u) * nx) xb_add(&bar[XB_TOPGEN], 1u);
            else XB_SPIN(xb_ld(&bar[XB_TOPGEN]) == tg, bar);
            __builtin_amdgcn_fence(__ATOMIC_ACQUIRE, "agent");
            xb_add(&bar[XB_XGEN(b.x)], 1u);
            asm volatile("s_waitcnt vmcnt(0)" ::: "memory");
        } else {
            XB_SPIN(xb_ld(&bar[XB_XGEN(b.x)]) == gen, bar);
            __builtin_amdgcn_fence(__ATOMIC_ACQUIRE, "agent");
            asm volatile("s_waitcnt vmcnt(0)" ::: "memory");
        }
    }
    __syncthreads();
}

constexpr int RING_BYTES = 131072;
constexpr int MISC_OFF = RING_BYTES;
constexpr int LDS_BYTES = 147456;
constexpr int NWAVES = 8;

struct Args {
    const float* in[29]; float* out; unsigned char* ws; int ph_lo, ph_hi;
};
enum { I_X = 0, I_MEM, I_NORM1, I_WIN, I_BGATE, I_QN, I_KN, I_LQ1, I_LK1, I_LQ2, I_LK2, I_SUBLN, I_WPOOL, I_PSCALE, I_MEMNORM, I_WMKV, I_MQN, I_MKN, I_WBRD, I_WBRP, I_WBRM, I_WOUT, I_NORM2,
       I_WROUTER, I_BROUTER, I_WGU, I_BGU, I_WD, I_BD };

__device__ __forceinline__ unsigned f2bf(float f) { unsigned u = __builtin_bit_cast(unsigned, f); return (u + 0x7fffu + ((u >> 16) & 1u)) >> 16; }
__device__ __forceinline__ unsigned pk2(float lo, float hi) { return f2bf(lo) | (f2bf(hi) << 16); }
__device__ __forceinline__ void p0_transpose_item(const float* W, int K, int N, bf16_t* WT, LAS float* scr, int item, int lane) {
    const int nblk = N / 64, kb = item / nblk, nb = item % nblk, k0 = 64 * kb, n0 = 64 * nb;
    const int kr = lane >> 3, n4 = (lane & 7) * 4;
    f32x4 v[16];
#pragma unroll
    for (int i = 0; i < 16; ++i) v[i] = *(const f32x4*)(W + (size_t)(k0 + 8 * (i & 7) + kr) * N + n0 + 32 * (i >> 3) + n4);
#pragma unroll
    for (int h = 0; h < 2; ++h) {
#pragma unroll
        for (int i = 0; i < 8; ++i)
#pragma unroll
            for (int j = 0; j < 4; ++j) scr[(n4 + j) * 68 + 8 * i + kr] = v[h * 8 + i][j];
        LDS_WAIT(); asm volatile("" ::: "memory");
        const int c = lane & 7;
#pragma unroll
        for (int jj = 0; jj < 4; ++jj) { const int nrow = 8 * jj + (lane >> 3); const LAS f32x4* sp = (const LAS f32x4*)(scr + nrow * 68 + 8 * c);
            const f32x4 a = sp[0], b = sp[1];
            u32x4 o; o.x = pk2(a[0], a[1]); o.y = pk2(a[2], a[3]); o.z = pk2(b[0], b[1]); o.w = pk2(b[2], b[3]);
            *(u32x4*)(WT + (size_t)(n0 + 32 * h + nrow) * K + k0 + 8 * c) = o; }
        LDS_WAIT(); asm volatile("" ::: "memory");
    }
}
__device__ __forceinline__ void rms_row_to_bf16(const float* xrow, const float* gain, bf16_t* orow, int lane) {
    const f32x4* xr = (const f32x4*)xrow + lane; const f32x4* gr = (const f32x4*)gain + lane;
    f32x4 v[4]; float s = 0.f;
#pragma unroll
    for (int j = 0; j < 4; ++j) { v[j] = xr[64 * j]; s += (v[j].x * v[j].x + v[j].y * v[j].y) + (v[j].z * v[j].z + v[j].w * v[j].w); }
    const float rstd = 1.f / sqrtf(wave_sum(s) * (1.f / 1024.f) + RMS_EPS);
    u32x2* o8 = (u32x2*)orow + lane;
#pragma unroll
    for (int j = 0; j < 4; ++j) { const f32x4 g = gr[64 * j]; u32x2 w; w.x = pk2(v[j].x * rstd * g.x, v[j].y * rstd * g.y); w.y = pk2(v[j].z * rstd * g.z, v[j].w * rstd * g.w); o8[64 * j] = w; }
}

struct Args;
typedef __attribute__((address_space(4))) const Args* kargs_t;
__device__ __forceinline__ kargs_t kargs() { kargs_t p = (kargs_t)__builtin_amdgcn_kernarg_segment_ptr(); asm volatile("" : "+s"(p)); return p; }
__global__ void __launch_bounds__(NWAVES * 64, 2) fwd_kernel(Args args) {
    extern __shared__ __attribute__((aligned(16))) unsigned char lds_raw[];
    cg::grid_group grid = cg::this_grid();
    LAS unsigned char* lds = (LAS unsigned char*)lds_raw;
    const int tid = threadIdx.x, lane = tid & 63, wave = __builtin_amdgcn_readfirstlane(tid >> 6);
    const int G = gridDim.x, bx = blockIdx.x; const int vcu = (G % 8 == 0) ? (bx % 8) * (G / 8) + bx / 8 : bx;
    const int gw = vcu * NWAVES + wave, NGW = G * NWAVES;
    const int lo = args.ph_lo, hi = args.ph_hi;
    if (tid < 64) ((LAS unsigned*)(lds + MISC_OFF + 1024))[tid] = 0u;
    __syncthreads();
    const XcdBarrier xbar = xcd_barrier_post((unsigned*)(args.ws + WS_CTL) + CW_BAR, (volatile LAS unsigned*)(lds + MISC_OFF + 1024));
#ifndef PHMASK
#define PHMASK 0x3ff
#endif
#define IN(k) (((PHMASK >> (k)) & 1) && lo <= (k) && (k) < hi)
#define GSYNC() do { asm volatile("s_waitcnt vmcnt(0) lgkmcnt(0)" ::: "memory"); __syncthreads(); grid.sync(); asm volatile("s_waitcnt vmcnt(0)" ::: "memory"); __syncthreads(); } while (0)
#define SEAM(k) do { if (lo <= (k) && (k) + 1 < hi) { if ((k) == 0) GSYNC(); else xcd_barrier(xbar); } } while (0)
#define WSP(TY, off) ((TY*)(ka->ws + (off)))
#define WIN_T WSP(bf16_t, WS_WIN_T)
#define WBRD_T WSP(bf16_t, WS_WBRD_T)
#define WBRP_T WSP(bf16_t, WS_WBRP_T)
#define WBRM_T WSP(bf16_t, WS_WBRM_T)
#define WOUT_T WSP(bf16_t, WS_WOUT_T)
#define WMKV_T WSP(bf16_t, WS_WMKV_T)
#define WGU_T WSP(bf16_t, WS_WGU_T)
#define WD_T WSP(bf16_t, WS_WD_T)
#define XN WSP(bf16_t, WS_XN)
#define Qb WSP(bf16_t, WS_Q)
#define Kb WSP(bf16_t, WS_K)
#define Vb WSP(bf16_t, WS_V)
#define Ub WSP(bf16_t, WS_U)
#define MQb WSP(bf16_t, WS_MQ)
#define OC WSP(bf16_t, WS_OC)
#define GATES WSP(bf16_t, WS_GATES)
#define YCAT WSP(bf16_t, WS_YCAT)
#define MERGF WSP(float, WS_MERGF)
#define MERGB WSP(bf16_t, WS_MERGB)
#define XG WSP(bf16_t, WS_XG)
#define ACT WSP(bf16_t, WS_A)
#define Y4 WSP(bf16_t, WS_B)
#define MEMN WSP(bf16_t, WS_MEMN)
#define MKV WSP(bf16_t, WS_MKV)
#define ROPE WSP(f32x2, WS_ROPE)
#define WR2 WSP(float, WS_WR2)
#define ROUTEW WSP(float, WS_ROUTEW)
#define LAMP WSP(float, WS_LAM)
#define LIST WSP(u32x2, WS_LIST)
#define CNT WSP(unsigned, WS_CTL)
#define OUT (ka->out)
#define KA const kargs_t ka = kargs()

    if (IN(0)) for (int rep_ = 0; rep_ < 1 + ((REPEAT_MASK >> 0) & 1); ++rep_) { KA; if (rep_) __syncthreads();
        LAS float* scr = (LAS float*)(lds + wave * 16384);
        constexpr int I0 = 16 * 80, I1 = 8 * 16, I2 = 4 * 16, I3 = 4 * 16, I4 = 16 * 16, I5 = 16 * 8, I6 = 32 * 512, I7 = 32 * 256;
        constexpr int NITEMS = I0 + I1 + I2 + I3 + I4 + I5 + I6 + I7;
        for (int it = gw; it < NITEMS; it += NGW) {
            int r = it;
            if (r < I0) { p0_transpose_item(ka->in[I_WIN], 1024, 5120, WIN_T, scr, r, lane); continue; } r -= I0;
            if (r < I1) { p0_transpose_item(ka->in[I_WBRD], 512, 1024, WBRD_T, scr, r, lane); continue; } r -= I1;
            if (r < I2) { p0_transpose_item(ka->in[I_WBRP], 256, 1024, WBRP_T, scr, r, lane); continue; } r -= I2;
            if (r < I3) { p0_transpose_item(ka->in[I_WBRM], 256, 1024, WBRM_T, scr, r, lane); continue; } r -= I3;
            if (r < I4) { p0_transpose_item(ka->in[I_WOUT], 1024, 1024, WOUT_T, scr, r, lane); continue; } r -= I4;
            if (r < I5) { p0_transpose_item(ka->in[I_WMKV], 1024, 512, WMKV_T, scr, r, lane); continue; } r -= I5;
            if (r < I6) { const int e = r >> 9; p0_transpose_item(ka->in[I_WGU] + (size_t)e * 1024 * 2048, 1024, 2048, WGU_T + (size_t)e * 2048 * 1024, scr, r & 511, lane); continue; } r -= I6;
            { const int e = r >> 8; p0_transpose_item(ka->in[I_WD] + (size_t)e * 1024 * 1024, 1024, 1024, WD_T + (size_t)e * 1024 * 1024, scr, r & 255, lane); }
        }
        for (int m = gw; m < T; m += NGW) rms_row_to_bf16(ka->in[I_X] + (size_t)m * 1024, ka->in[I_NORM1], XN + (size_t)m * 1024, lane);
        for (int m = gw; m < BATCH * MEMLEN; m += NGW) rms_row_to_bf16(ka->in[I_MEM] + (size_t)m * 1024, ka->in[I_MEMNORM], MEMN + (size_t)m * 1024, lane);
        for (int i = bx * 512 + tid; i < SEQ * 32; i += G * 512) { const int pos = i >> 5, j = i & 31;
            const float inv = 1.0f / powf(10000.0f, (float)(2 * j) / 64.0f); const float ang = (float)pos * inv;
            const double a = (double)ang; const double k = rint(a * 0.15915494309189535); const float red = (float)(a - k * 6.283185307179586);
            ROPE[i] = (f32x2){cosf(red), sinf(red)}; }
        for (int i = bx * 512 + tid; i < 1024 * 32; i += G * 512) { const int ii = i & 3, e = (i >> 2) & 15, kq = (i >> 6) & 3, eb = (i >> 8) & 1, s = i >> 9; const int k = 16 * s + 4 * kq + ii;
            WR2[i] = ka->in[I_NORM2][k] * ka->in[I_WROUTER][k * 32 + eb * 16 + e]; }
        if (bx == 0 && wave == 0) { const float s1 = wave_sum(ka->in[I_LQ1][lane] * ka->in[I_LK1][lane]), s2 = wave_sum(ka->in[I_LQ2][lane] * ka->in[I_LK2][lane]);
            if (lane == 0) LAMP[0] = expf(s1) - expf(s2) + 0.2f; }
    }
    SEAM(0);
    if (IN(1)) for (int rep_ = 0; rep_ < 1 + ((REPEAT_MASK >> 1) & 1); ++rep_) { KA; if (rep_) __syncthreads();
#if defined(TAP) && TAP == 6
        { pg8::DenseProb P{XN, WIN_T, 1024, 1024, 1024}; pg8::StaticOrder S; S.init(T, INW, G, bx);
          pg8::EpiPlain E{WSP(bf16_t, WS_B), 5120};
          pg8::gemm_phase<pg8::EpiPlain, pg8::DenseProb, pg8::StaticOrder, true>(lds, P, S, E); }
#else
        { pg8::DenseProb P{XN, WIN_T, 1024, 1024, 1024}; pg8::StaticOrder S; S.init(T, INW, G, bx);
          pg8::EpiInProj E{Qb, Kb, Vb, Ub, MQb, GATES, ka->in[I_QN], ka->in[I_KN], ka->in[I_MQN], ka->in[I_BGATE], ROPE};
          pg8::gemm_phase<pg8::EpiInProj, pg8::DenseProb, pg8::StaticOrder, true>(lds, P, S, E); }
#endif
        { pg8::DenseProb P{MEMN, WMKV_T, 1024, 1024, 1024}; pg8::StaticOrder S; S.init(BATCH * MEMLEN, 512, G, bx);
          pg8::EpiMemKV E{MKV, ka->in[I_MKN]};
          pg8::gemm_phase<pg8::EpiMemKV, pg8::DenseProb, pg8::StaticOrder, true>(lds, P, S, E); }
    }
    SEAM(1);
    if (IN(2)) for (int rep_ = 0; rep_ < 1 + ((REPEAT_MASK >> 2) & 1); ++rep_) { KA; if (rep_) __syncthreads();
        using abf = attn_body::bf16;
        {
            const int bhc = vcu >> 3, b = bhc >> 3, h = (bhc >> 1) & 3, c = bhc & 1, s = vcu & 7;
            for (int i2 = 0; i2 < 4 * (1 + ((REPEAT_MASK >> 10) & 1)); ++i2) { const int ii = i2 & 3; const int qb = (ii == 0) ? s : (ii == 1) ? 15 - s : (ii == 2) ? 16 + s : 31 - s;
                const size_t rb = (size_t)b * SEQ;
                attn_body::attn_unit2<true>(qb * 256, 4 * qb + 4, (const abf*)Qb + rb * 512 + (c * 4 + h) * 64, 512, (const abf*)Kb + rb * 512 + (c * 4 + h) * 64, 512,
                                            (const abf*)Vb + rb * 512 + h * 128, 512, (abf*)OC + rb * 1024 + (c * 4 + h) * 128, 1024, (char*)lds_raw); }
        }
        {
            for (int i = 0; i < 2; ++i) { const int idx = vcu * 2 + i; if (idx >= 512) break; const int b = idx >> 7, h = (idx >> 5) & 3, qb = idx & 31;
                attn_body::attn_unit<8, false>(qb * 256, 4, (const abf*)MQb + (size_t)b * SEQ * 256 + h * 64, 256, (const abf*)MKV + (size_t)b * MEMLEN * 512 + h * 64, 512,
                                               (const abf*)MKV + (size_t)b * MEMLEN * 512 + 256 + h * 64, 512, (abf*)YCAT + (size_t)b * SEQ * 1024 + 768 + h * 64, 1024, (char*)lds_raw); }
        }
        {
            LAS bf16_t* ul = (LAS bf16_t*)lds;
            LAS float* pt = (LAS float*)(lds + 24576);
            const int col = tid & 255, half = tid >> 8, g = col >> 6, dd = col & 63, w = 2 << g;
            float wreg[64];
#pragma unroll
            for (int cc = 0; cc < 64; ++cc) wreg[cc] = ka->in[I_WPOOL][(g * 64 + cc) * 64 + dd];
            const float psc = ka->in[I_PSCALE][col];
            for (int tile = vcu; tile < T / 32; tile += G) {
                const int t0 = tile * 32, p0 = t0 & (SEQ - 1);
                __syncthreads();
                for (int pc = tid; pc < 47 * 32; pc += 512) { const int r = pc >> 5, ch = pc & 31; const int pos = p0 - 15 + r;
                    u32x4 v = {0u, 0u, 0u, 0u}; if (pos >= 0) v = *(const u32x4*)(Ub + (size_t)(t0 - 15 + r) * 256 + ch * 8);
                    *(LAS u32x4*)(ul + r * 256 + ch * 8) = v; }
                __syncthreads();
                {
                    float sum = 0.f; const int rbase = 15 + 16 * half;
                    for (int i = 1; i < w; ++i) sum += __uint_as_float((unsigned)ul[(rbase - i) * 256 + col] << 16);
                    float pl[16];
#pragma unroll
                    for (int tk = 0; tk < 16; ++tk) { const float ucur = __uint_as_float((unsigned)ul[(rbase + tk) * 256 + col] << 16); sum += ucur;
                        const int pos = p0 + 16 * half + tk; const float cnt = (float)((pos + 1 < w) ? pos + 1 : w);
                        pl[tk] = sum / cnt - ucur;
                        sum -= __uint_as_float((unsigned)ul[(rbase + tk - (w - 1)) * 256 + col] << 16); }
#pragma unroll
                    for (int q4 = 0; q4 < 4; ++q4) *(LAS f32x4*)(pt + col * 36 + half * 16 + q4 * 4) = (f32x4){pl[4 * q4], pl[4 * q4 + 1], pl[4 * q4 + 2], pl[4 * q4 + 3]};
                }
                __syncthreads();
                float acc[16];
#pragma unroll
                for (int tk = 0; tk < 16; ++tk) acc[tk] = 0.f;
#pragma unroll
                for (int cc = 0; cc < 64; ++cc) { const LAS f32x4* pp = (const LAS f32x4*)(pt + (g * 64 + cc) * 36 + half * 16);
#pragma unroll
                    for (int q4 = 0; q4 < 4; ++q4) { const f32x4 p = pp[q4]; acc[4 * q4] += p[0] * wreg[cc]; acc[4 * q4 + 1] += p[1] * wreg[cc]; acc[4 * q4 + 2] += p[2] * wreg[cc]; acc[4 * q4 + 3] += p[3] * wreg[cc]; } }
#pragma unroll
                for (int tk = 0; tk < 16; ++tk) YCAT[(size_t)(t0 + 16 * half + tk) * 1024 + 512 + col] = (bf16_t)f2bf(acc[tk] * psc);
            }
            __syncthreads();
        }
    }
    SEAM(2);
    if (IN(3)) for (int rep_ = 0; rep_ < 1 + ((REPEAT_MASK >> 3) & 1); ++rep_) { KA; if (rep_) __syncthreads();
        const float lam = LAMP[0]; const int h = lane >> 4, d8 = (lane & 15) * 8;
        const f32x4 s0 = *(const f32x4*)(ka->in[I_SUBLN] + d8), s1 = *(const f32x4*)(ka->in[I_SUBLN] + d8 + 4);
        for (int m = gw; m < T; m += NGW) {
            const u32x4 a = *(const u32x4*)(OC + (size_t)m * 1024 + h * 128 + d8), b = *(const u32x4*)(OC + (size_t)m * 1024 + (4 + h) * 128 + d8);
            f32x4 y0 = {bf_lo(a.x) - lam * bf_lo(b.x), bf_hi(a.x) - lam * bf_hi(b.x), bf_lo(a.y) - lam * bf_lo(b.y), bf_hi(a.y) - lam * bf_hi(b.y)};
            f32x4 y1 = {bf_lo(a.z) - lam * bf_lo(b.z), bf_hi(a.z) - lam * bf_hi(b.z), bf_lo(a.w) - lam * bf_lo(b.w), bf_hi(a.w) - lam * bf_hi(b.w)};
            float ss = 0.f;
#pragma unroll
            for (int j = 0; j < 4; ++j) ss += y0[j] * y0[j] + y1[j] * y1[j];
            ss += __shfl_xor(ss, 1); ss += __shfl_xor(ss, 2); ss += __shfl_xor(ss, 4); ss += __shfl_xor(ss, 8);
            const float rstd = 0.8f / sqrtf(ss * (1.0f / 128.0f) + RMS_EPS);
            pg8::store8(YCAT + (size_t)m * 1024 + h * 128 + d8, y0 * rstd * s0, y1 * rstd * s1);
        }
    }
    SEAM(3);
    if (IN(4)) for (int rep_ = 0; rep_ < 1 + ((REPEAT_MASK >> 4) & 1); ++rep_) { KA; if (rep_) __syncthreads();
        pg8::StaticOrder S; S.init(T, 1024, G, bx);
        { pg8::DenseProb P{YCAT, WBRD_T, 1024, 512, 512}; pg8::EpiMerge<0> E{GATES, MERGF, MERGB}; pg8::gemm_phase<pg8::EpiMerge<0>, pg8::DenseProb, pg8::StaticOrder, true>(lds, P, S, E); }
        { pg8::DenseProb P{YCAT + 512, WBRP_T, 1024, 256, 256}; pg8::EpiMerge<1> E{GATES, MERGF, MERGB}; pg8::gemm_phase<pg8::EpiMerge<1>, pg8::DenseProb, pg8::StaticOrder, true>(lds, P, S, E); }
        { pg8::DenseProb P{YCAT + 768, WBRM_T, 1024, 256, 256}; pg8::EpiMerge<2> E{GATES, MERGF, MERGB}; pg8::gemm_phase<pg8::EpiMerge<2>, pg8::DenseProb, pg8::StaticOrder, true>(lds, P, S, E); }
    }
    SEAM(4);
    if (IN(5)) for (int rep_ = 0; rep_ < 1 + ((REPEAT_MASK >> 5) & 1); ++rep_) { KA; if (rep_) __syncthreads();
        pg8::DenseProb P{MERGB, WOUT_T, 1024, 1024, 1024}; pg8::StaticOrder S; S.init(T, 1024, G, bx);
        pg8::EpiWout E{ka->in[I_X], OUT, XG, ka->in[I_NORM2]};
        pg8::gemm_phase<pg8::EpiWout, pg8::DenseProb, pg8::StaticOrder, true>(lds, P, S, E);
    }
    SEAM(5);
    if (IN(6)) { KA;
        LAS int* lcnt = (LAS int*)(lds + MISC_OFF); LAS int* lbase = lcnt + 32;
        const int ngroups = T / 16, rounds = (ngroups + NGW - 1) / NGW;
        for (int rd = 0; rd < rounds; ++rd) {
            const int grp = rd * NGW + gw; const bool valid = grp < ngroups;
            if (tid < 32) lcnt[tid] = 0;
            __syncthreads();
            int e_sel = 0, rank = 0; float w_sel = 0.f, rstd = 0.f; const int q = lane >> 4, tok = grp * 16 + (lane & 15);
            if (valid) {
                f32x4 d0 = {0.f, 0.f, 0.f, 0.f}, d1 = {0.f, 0.f, 0.f, 0.f}; float ss = 0.f;
                const float* xrow = OUT + (size_t)tok * 1024 + 4 * q; const f32x4* wr2 = (const f32x4*)WR2 + lane;
#pragma unroll 4
                for (int s = 0; s < 64; ++s) { const f32x4 xv = *(const f32x4*)(xrow + 16 * s); const f32x4 wa = wr2[(s * 2) * 64], wb = wr2[(s * 2 + 1) * 64];
                    ss += (xv[0] * xv[0] + xv[1] * xv[1]) + (xv[2] * xv[2] + xv[3] * xv[3]);
#pragma unroll
                    for (int j = 0; j < 4; ++j) { d0 = __builtin_amdgcn_mfma_f32_16x16x4f32(wa[j], xv[j], d0, 0, 0, 0); d1 = __builtin_amdgcn_mfma_f32_16x16x4f32(wb[j], xv[j], d1, 0, 0, 0); } }
                ss += __shfl_xor(ss, 16); ss += __shfl_xor(ss, 32);
                rstd = 1.0f / sqrtf(ss * (1.0f / 1024.f) + RMS_EPS);
                unsigned key[8];
#pragma unroll
                for (int r = 0; r < 8; ++r) { const int e = (r >> 2) * 16 + 4 * q + (r & 3); const float lg = ((r < 4) ? d0[r & 3] : d1[r & 3]) * rstd + ka->in[I_BROUTER][e];
                    unsigned u = __float_as_uint(lg); u ^= (u >> 31) ? 0xffffffffu : 0x80000000u; key[r] = (u & ~31u) | (unsigned)(31 - e); }
                unsigned win[4];
#pragma unroll
                for (int r = 0; r < 4; ++r) { unsigned m = key[0];
#pragma unroll
                    for (int j = 1; j < 8; ++j) m = m > key[j] ? m : key[j];
                    unsigned o = (unsigned)__shfl_xor((int)m, 16); m = m > o ? m : o; o = (unsigned)__shfl_xor((int)m, 32); m = m > o ? m : o; win[r] = m;
#pragma unroll
                    for (int j = 0; j < 8; ++j) key[j] = (key[j] == m) ? 0u : key[j]; }
                float val[4];
#pragma unroll
                for (int r = 0; r < 4; ++r) { unsigned u = win[r] & ~31u; u ^= (u >> 31) ? 0x80000000u : 0xffffffffu; val[r] = __uint_as_float(u); }
                const float p1 = expf(val[1] - val[0]), p2 = expf(val[2] - val[0]), p3 = expf(val[3] - val[0]); const float inv = 1.0f / (1.0f + p1 + p2 + p3);
                const unsigned wk = (q == 0) ? win[0] : (q == 1) ? win[1] : (q == 2) ? win[2] : win[3];
                w_sel = ((q == 0) ? 1.0f : (q == 1) ? p1 : (q == 2) ? p2 : p3) * inv; e_sel = 31 - (int)(wk & 31u);
                rank = __hip_atomic_fetch_add((int*)(lcnt + e_sel), 1, __ATOMIC_RELAXED, __HIP_MEMORY_SCOPE_WORKGROUP);
            }
            __syncthreads();
            if (tid < 32) lbase[tid] = (int)__hip_atomic_fetch_add(CNT + 64 * tid, (unsigned)lcnt[tid], __ATOMIC_RELAXED, __HIP_MEMORY_SCOPE_AGENT);
            __syncthreads();
            if (valid) { const int pos = lbase[e_sel] + rank; LIST[(size_t)e_sel * CAP + pos] = (u32x2){(unsigned)(tok * 4 + q), __float_as_uint(rstd)}; ROUTEW[tok * 4 + q] = w_sel; }
            __syncthreads();
        }
    }
    SEAM(6);
    if (IN(7) || IN(8)) { KA;
        LAS int* tp = (LAS int*)(lds + MISC_OFF + 256); LAS int* cn = tp + 40;
        if (tid == 0) { int acc = 0; for (int e = 0; e < NEXP; ++e) { const int c = (int)__hip_atomic_load(CNT + 64 * e, __ATOMIC_RELAXED, __HIP_MEMORY_SCOPE_AGENT); cn[e] = c; tp[e] = acc; acc += (c + 255) >> 8; } tp[NEXP] = acc; }
        __syncthreads();
        if (IN(7)) for (int rep_ = 0; rep_ < 1 + ((REPEAT_MASK >> 7) & 1); ++rep_) {
            pg8::GuProb P{XG, WGU_T, LIST, 1024, 1024, 1024}; pg8::GroupedOrder S{tp, cn, 8, G, bx};
            pg8::EpiSwiglu E{ACT, LIST, ka->in[I_BGU]};
            pg8::gemm_phase<pg8::EpiSwiglu, pg8::GuProb, pg8::GroupedOrder, true>(lds, P, S, E);
        }
        SEAM(7);
        if (IN(8)) for (int rep_ = 0; rep_ < 1 + ((REPEAT_MASK >> 8) & 1); ++rep_) {
            pg8::DownProb P{ACT, WD_T, 1024, 1024, 1024}; pg8::GroupedOrder S{tp, cn, 4, G, bx};
            pg8::EpiDown E{Y4, LIST, ka->in[I_BD]};
            pg8::gemm_phase<pg8::EpiDown, pg8::DownProb, pg8::GroupedOrder, true>(lds, P, S, E);
        }
    }
    SEAM(8);
    if (IN(9)) { KA;
        for (int i = bx * 512 + tid; i < T * 128; i += G * 512) { const int tok = i >> 7, c8 = (i & 127) * 8;
            const f32x4 w = *(const f32x4*)(ROUTEW + tok * 4); float* op = OUT + (size_t)tok * 1024 + c8;
            f32x4 o0 = *(const f32x4*)op, o1 = *(const f32x4*)(op + 4);
#pragma unroll
            for (int k = 0; k < 4; ++k) { const u32x4 y = *(const u32x4*)(Y4 + ((size_t)tok * 4 + k) * 1024 + c8); const float wk = w[k];
                o0[0] += wk * bf_lo(y.x); o0[1] += wk * bf_hi(y.x); o0[2] += wk * bf_lo(y.y); o0[3] += wk * bf_hi(y.y);
                o1[0] += wk * bf_lo(y.z); o1[1] += wk * bf_hi(y.z); o1[2] += wk * bf_lo(y.w); o1[3] += wk * bf_hi(y.w); }
            *(f32x4*)op = o0; *(f32x4*)(op + 4) = o1; }
    }
#ifdef TAP
    if (lo <= 10 && 10 < hi) { KA; GSYNC();
        for (int i = bx * 512 + tid; i < T * 1024; i += G * 512) { const int t = i >> 10, c = i & 1023; float v = 0.f;
#define BFV(buf, pitch, col) __uint_as_float((unsigned)(buf)[(size_t)t * (pitch) + (col)] << 16)
            if (TAP == 1) v = BFV(Qb, 512, c & 511) + 2.f * BFV(Kb, 512, c & 511) + 4.f * BFV(Vb, 512, c & 511) + 8.f * BFV(Ub, 256, c & 255) + 16.f * BFV(MQb, 256, c & 255)
                            + 32.f * BFV(GATES, 3072, c) + 64.f * BFV(GATES, 3072, 1024 + c) + 128.f * BFV(GATES, 3072, 2048 + c);
            if (TAP == 2) v = BFV(OC, 1024, c) + 2.f * BFV(YCAT, 1024, c);
            if (TAP == 3) v = BFV(MERGB, 1024, c);
            if (TAP == 4) v = BFV(XN, 1024, c);
            if (TAP == 6) { const bf16_t* z = WSP(bf16_t, WS_B) + (size_t)t * 5120 + c; v = __uint_as_float((unsigned)z[0] << 16) + 2.f * __uint_as_float((unsigned)z[1024] << 16) + 4.f * __uint_as_float((unsigned)z[2048] << 16) + 8.f * __uint_as_float((unsigned)z[3072] << 16) + 16.f * __uint_as_float((unsigned)z[4096] << 16); }
            if (TAP == 5) { const bf16_t* wt = WIN_T; const int tt = t % 5120; v = __uint_as_float((unsigned)wt[(size_t)tt * 1024 + c] << 16) + ROPE[(t & 8191) * 32 + (c & 31)].x + 2.f * ROPE[(t & 8191) * 32 + (c & 31)].y; }
            OUT[i] = v; }
    }
#endif
#undef IN
#undef SEAM
}

extern "C" void kernel_launch(void* const* d_in, const int* in_sizes, int n_in, void* d_out, int out_size, void* d_ws, size_t ws_size, hipStream_t stream) {
    static int grid = 0;
    if (grid == 0) {
        if (n_in != 29 || in_sizes[0] != T * DMODEL || out_size != T * DMODEL || ws_size < WS_END) {
            fprintf(stderr, "kernel_launch: unexpected shapes: n_in %d in0 %d out %d ws %zu (need %zu)\n", n_in, n_in > 0 ? in_sizes[0] : -1, out_size, ws_size, (size_t)WS_END); grid = -1; return; }
        int dev = 0, cus = 0, per_cu = 0;
        (void)hipGetDevice(&dev); (void)hipDeviceGetAttribute(&cus, hipDeviceAttributeMultiprocessorCount, dev);
        (void)hipFuncSetAttribute((const void*)fwd_kernel, hipFuncAttributeMaxDynamicSharedMemorySize, LDS_BYTES);
        (void)hipOccupancyMaxActiveBlocksPerMultiprocessor(&per_cu, (const void*)fwd_kernel, NWAVES * 64, LDS_BYTES);
        (void)hipGetLastError();
        grid = cus;
        fprintf(stderr, "kernel_launch: cus %d occupancy %d/CU grid %d\n", cus, per_cu, grid);
        if (per_cu < 1) fprintf(stderr, "kernel_launch: occupancy query says the kernel does not fit\n");
    }
    if (grid < 0) return;
    (void)hipMemsetAsync((char*)d_ws + WS_CTL, 0, CTL_ZERO_BYTES, stream);
    Args a{};
    for (int i = 0; i < 29; ++i) a.in[i] = (const float*)d_in[i];
    a.out = (float*)d_out; a.ws = (unsigned char*)d_ws; a.ph_lo = 0; a.ph_hi = PH_HI;
    void* args[] = {&a};
    hipError_t e = hipLaunchCooperativeKernel((const void*)fwd_kernel, dim3(grid), dim3(NWAVES * 64), args, LDS_BYTES, stream);
    if (e != hipSuccess) fprintf(stderr, "cooperative launch failed: %s (grid %d)\n", hipGetErrorString(e), grid);
}
```

```cpp
#include <hip/hip_runtime.h>
#include <hip/hip_cooperative_groups.h>
#include <hip/hip_bf16.h>
#include <cstdio>
#include <cstdint>
#include <cmath>
namespace cg = cooperative_groups;

#define LAS __attribute__((address_space(3)))
#define GAS __attribute__((address_space(1)))
typedef unsigned short bf16_t;
typedef short bf16x8 __attribute__((ext_vector_type(8)));
typedef float f32x4 __attribute__((ext_vector_type(4)));
typedef float f32x2 __attribute__((ext_vector_type(2)));
typedef float f32x16 __attribute__((ext_vector_type(16)));
typedef unsigned u32x4 __attribute__((ext_vector_type(4)));
typedef unsigned u32x2 __attribute__((ext_vector_type(2)));

#define PH_HI 10
#ifndef PHMASK
#define PHMASK 0x3ff
#endif
#define REPEAT_MASK 0x000
constexpr int BATCH = 4, SEQ = 8192, DMODEL = 1024, T = BATCH * SEQ, INW = 5120, NEXP = 32, MEMLEN = 256;
constexpr float RMS_EPS = 1e-6f;
constexpr float C2 = 0.125f * 1.4426950408889634f;
constexpr int CAP = T;

constexpr size_t MiB = 1u << 20;
constexpr size_t WS_CTL = 0, CTL_ZERO_BYTES = 32768;
constexpr int CW_BAR = 4096;
constexpr size_t WS_ROUTEW = 1 * MiB;
constexpr size_t WS_LAM = 1 * MiB + 768 * 1024;
constexpr size_t WS_ROPE = 2 * MiB;
constexpr size_t WS_WR2 = 4 * MiB;
constexpr size_t WS_MEMN = 5 * MiB;
constexpr size_t WS_MKV = 7 * MiB;
constexpr size_t WS_WIN_T = 8 * MiB;
constexpr size_t WS_WBRD_T = 18 * MiB;
constexpr size_t WS_WBRP_T = 19 * MiB;
constexpr size_t WS_WBRM_T = 19 * MiB + 512 * 1024;
constexpr size_t WS_WOUT_T = 20 * MiB;
constexpr size_t WS_WMKV_T = 22 * MiB;
constexpr size_t WS_WGU_T = 24 * MiB;
constexpr size_t WS_WD_T = 152 * MiB;
constexpr size_t WS_A = 216 * MiB;
constexpr size_t WS_XN = WS_A;
constexpr size_t WS_Q = WS_A + 64 * MiB, WS_K = WS_A + 96 * MiB, WS_V = WS_A + 128 * MiB;
constexpr size_t WS_U = WS_A + 160 * MiB, WS_MQ = WS_A + 176 * MiB;
constexpr size_t WS_OC = WS_A + 192 * MiB;
constexpr size_t WS_B = 488 * MiB;
constexpr size_t WS_GATES = WS_B;
constexpr size_t WS_YCAT = WS_B + 192 * MiB;
constexpr size_t WS_MERGF = 760 * MiB;
constexpr size_t WS_MERGB = 888 * MiB;
constexpr size_t WS_XG = 952 * MiB;
constexpr size_t WS_LIST = 1016 * MiB;
constexpr size_t WS_END = 1024 * MiB;

typedef __bf16 bf16x2_v __attribute__((ext_vector_type(2)));
__device__ __forceinline__ unsigned cvt_pk_bf16(float lo, float hi) { f32x2 v = {lo, hi}; bf16x2_v b = __builtin_convertvector(v, bf16x2_v); return __builtin_bit_cast(unsigned, b); }
__device__ __forceinline__ float bf_lo(unsigned w) { return __uint_as_float(w << 16); }
__device__ __forceinline__ float bf_hi(unsigned w) { return __uint_as_float(w & 0xffff0000u); }
__device__ __forceinline__ float wave_sum(float v) {
#pragma unroll
    for (int o = 1; o < 64; o <<= 1) v += __shfl_xor(v, o);
    return v;
}
#define LDS_WAIT() asm volatile("s_waitcnt lgkmcnt(0)" ::: "memory")

namespace pg8 {
constexpr int BM = 256, BK = 64, HALF = 128, HTB = HALF * BK * 2, STAGE_BYTES = 8 * HTB, NXCD = 8, WGM = 8;
__host__ __device__ __forceinline__ int lds_byte(int r, int c) { const int st = (r >> 4) * 2 + (c >> 5), rr = r & 15, cc = c & 31, ob = rr * 64 + cc * 2; return st * 1024 + (ob ^ (((ob >> 9) & 1) << 5)); }
__host__ __device__ __forceinline__ void stage_rc(int b, int& R, int& C) { const int st = b / 1024, sb = b % 1024, swz = sb ^ (((sb >> 9) & 1) << 5); R = (st >> 1) * 16 + swz / 64; C = (st & 1) * 32 + (swz % 64) / 2; }
__host__ __device__ __forceinline__ int perm32(int rho) { const int n = rho >> 4, i = rho & 15; return 8 * (i >> 2) + 4 * n + (i & 3); }

struct Unit { int pm, pn, e, mt, cnt; };

template <int BMAP> __device__ __forceinline__ int brow(int R) { return BMAP == 0 ? ((R >> 5) * 64 + perm32(R & 31)) : ((R & ~31) + perm32(R & 31)); }

struct StaticOrder {
    int nM, nN, nwg, G, c;
    __device__ void init(int M, int N, int G_, int c_) { nM = M / BM; nN = N / BM; nwg = nM * nN; G = G_; c = c_; }
    __device__ bool next(int i, Unit& u) const {
        const long L = (long)i * G + c; if (L >= nwg) return false;
        int wgid = (int)L; { const int q = nwg / NXCD, r = nwg % NXCD, xcd = wgid % NXCD, off = wgid / NXCD; wgid = (xcd < r ? xcd * (q + 1) : r * (q + 1) + (xcd - r) * q) + off; }
        const int nig = WGM * nN, gid = wgid / nig, fm = gid * WGM, gsz = (nM - fm) < WGM ? (nM - fm) : WGM;
        u.pm = fm + ((wgid % nig) % gsz); u.pn = (wgid % nig) / gsz; u.e = 0; u.mt = 0; u.cnt = 0; return true;
    }
    __device__ bool next_lane(int i, Unit& u) const { return next(i, u); }
};
struct GroupedOrder {
    const LAS int* tp; const LAS int* cn; int NTN, G, c;
    __device__ bool next_lane(int i, Unit& u) const {
        const int nwg = tp[NEXP] * NTN; const long L = (long)i * G + c; if (L >= nwg) return false;
        int wgid = (int)L; { const int q = nwg / NXCD, r = nwg % NXCD, xcd = wgid % NXCD, off = wgid / NXCD; wgid = (xcd < r ? xcd * (q + 1) : r * (q + 1) + (xcd - r) * q) + off; }
        int e = 0; while (e < NEXP - 1 && wgid >= tp[e + 1] * NTN) ++e;
        const int idx = wgid - tp[e] * NTN, tiles = tp[e + 1] - tp[e];
        const int nig = 4 * NTN, gid = idx / nig, fm = gid * 4, gsz = (tiles - fm) < 4 ? (tiles - fm) : 4;
        u.mt = fm + ((idx % nig) % gsz); u.pn = (idx % nig) / gsz; u.e = e; u.pm = tp[e] + u.mt; u.cnt = cn[e]; return true;
    }
};
struct TableOrder {
    const LAS int* tab; int n;
    __device__ __forceinline__ bool next(int i, Unit& u) const {
        if (i >= n) return false;
        const LAS int* t = tab + i * 8;
        u.pm = __builtin_amdgcn_readfirstlane(t[0]); u.pn = __builtin_amdgcn_readfirstlane(t[1]); u.e = __builtin_amdgcn_readfirstlane(t[2]);
        u.mt = __builtin_amdgcn_readfirstlane(t[3]); u.cnt = __builtin_amdgcn_readfirstlane(t[4]); return true;
    }
};
template <class Sched> __device__ __forceinline__ TableOrder build_unit_table(const Sched& S, LAS int* tab) {
    __syncthreads();
    if (threadIdx.x < 32) { Unit u; const bool ok = S.next_lane((int)threadIdx.x, u);
        if (ok) { LAS int* t = tab + threadIdx.x * 8; t[0] = u.pm; t[1] = u.pn; t[2] = u.e; t[3] = u.mt; t[4] = u.cnt; }
        const unsigned long long m = __ballot(ok); if (threadIdx.x == 0) tab[256] = __popcll(m); }
    __syncthreads();
    TableOrder T; T.tab = tab; T.n = __builtin_amdgcn_readfirstlane(tab[256]); return T;
}
struct DenseProb {
    static constexpr bool GATHER = false; static constexpr int BMAP = 0;
    const bf16_t* A; const bf16_t* Bt; int lda, ldb, K;
    __device__ __forceinline__ const char* a_base(const Unit& u) const { return (const char*)(A + (size_t)u.pm * BM * lda); }
    __device__ __forceinline__ const char* b_base(const Unit& u) const { return (const char*)(Bt + (size_t)u.pn * BM * ldb); }
    __device__ __forceinline__ size_t bhstep() const { return (size_t)32 * ldb * 2; }
    __device__ __forceinline__ unsigned a_off(const Unit&, int, int) const { return 0u; }
    __device__ __forceinline__ unsigned a_raw(const Unit&, int) const { return 0u; }
};
struct GuProb {
    static constexpr bool GATHER = true; static constexpr int BMAP = 1;
    const bf16_t* XG; const bf16_t* Wt; const u32x2* list; int lda, ldb, K;
    __device__ __forceinline__ const char* a_base(const Unit&) const { return (const char*)XG; }
    __device__ __forceinline__ const char* b_base(const Unit& u) const { return (const char*)(Wt + ((size_t)u.e * 2048 + 128 * u.pn) * 1024); }
    __device__ __forceinline__ size_t bhstep() const { return (size_t)1024 * 1024 * 2; }
    __device__ __forceinline__ unsigned a_raw(const Unit& u, int r) const { const int rr = u.mt * BM + r, rc = rr < u.cnt ? rr : u.cnt - 1; return list[(size_t)u.e * CAP + rc].x; }
    __device__ __forceinline__ unsigned a_off(const Unit& u, int r, int C) const {
        const int rr = u.mt * BM + r, rc = rr < u.cnt ? rr : u.cnt - 1;
        const unsigned tok = list[(size_t)u.e * CAP + rc].x >> 2;
        return tok * 2048u + (unsigned)C * 2u;
    }
};
struct DownProb {
    static constexpr bool GATHER = false; static constexpr int BMAP = 0;
    const bf16_t* A; const bf16_t* Wt; int lda, ldb, K;
    __device__ __forceinline__ const char* a_base(const Unit& u) const { return (const char*)(A + (size_t)u.pm * BM * lda); }
    __device__ __forceinline__ const char* b_base(const Unit& u) const { return (const char*)(Wt + ((size_t)u.e * 1024 + 256 * u.pn) * 1024); }
    __device__ __forceinline__ size_t bhstep() const { return (size_t)32 * ldb * 2; }
    __device__ __forceinline__ unsigned a_off(const Unit&, int, int) const { return 0u; }
    __device__ __forceinline__ unsigned a_raw(const Unit&, int) const { return 0u; }
};

template <class Prob> __device__ __forceinline__ void calc_aoff(const Prob& P, const Unit& u, const int (&Rr)[2], const int (&Cc)[2], unsigned (&o)[2][2]) {
#pragma unroll
    for (int h = 0; h < 2; ++h)
#pragma unroll
        for (int i = 0; i < 2; ++i) {
            if constexpr (Prob::GATHER) o[h][i] = P.a_off(u, h * HALF + Rr[i], Cc[i]);
            else o[h][i] = (unsigned)((h * HALF + Rr[i]) * P.lda + Cc[i]) * 2u;
        }
}

template <class Epi, class Prob, class Sched, bool ALIGN_EPI>
__device__ __forceinline__ void gemm_phase(LAS unsigned char* lds, const Prob& P, const Sched& S, const Epi& E) {
    const int tid = threadIdx.x, wid = __builtin_amdgcn_readfirstlane(tid >> 6), lane = tid & 63, wr = wid >> 2, wc = wid & 3, fr = lane & 15, fq = lane >> 4;
    const int K = P.K, nt = K / BK;
    int Rr[2], Cc[2]; unsigned voffB[2];
#pragma unroll
    for (int i = 0; i < 2; ++i) { stage_rc(tid * 16 + i * 8192, Rr[i], Cc[i]); voffB[i] = (unsigned)(brow<Prob::BMAP>(Rr[i]) * P.ldb + Cc[i]) * 2u; }
    const size_t kstep = (size_t)(BK * 2);
    const size_t bhstep = P.bhstep();
    const unsigned ldsw = (unsigned)wid * 1024u;
    const int aoff = lds_byte(wr * 64 + fr, fq * 8), boff = lds_byte(wc * 32 + fr, fq * 8);
#define PG8_SA(b, h) (((b) * 2 + (h)) * HTB)
#define PG8_SB(b, h) ((4 + (b) * 2 + (h)) * HTB)
#define PG8_STG(bufoff, gptr, v0, v1) do { \
        __builtin_amdgcn_global_load_lds((const unsigned*)((const char*)(gptr) + (v0)), (LAS unsigned*)(lds + (bufoff) + ldsw), 16, 0, 0); \
        __builtin_amdgcn_global_load_lds((const unsigned*)((const char*)(gptr) + (v1)), (LAS unsigned*)(lds + (bufoff) + ldsw + 8192), 16, 0, 0); } while (0)
#define PG8_STGB(bufoff, gptr) PG8_STG(bufoff, gptr, voffB[0], voffB[1])
#define PG8_LDA(dst, b, h) do { _Pragma("unroll") for (int m = 0; m < 4; ++m) _Pragma("unroll") for (int k = 0; k < 2; ++k) dst[m][k] = *(const LAS bf16x8*)(lds + PG8_SA(b, h) + aoff + m * 2048 + k * 1024); } while (0)
#define PG8_LDB(dst, b, h) do { _Pragma("unroll") for (int n = 0; n < 2; ++n) _Pragma("unroll") for (int k = 0; k < 2; ++k) dst[n][k] = *(const LAS bf16x8*)(lds + PG8_SB(b, h) + boff + n * 2048 + k * 1024); } while (0)
#define PG8_MMA(ai, bj, At, Bt) do { __builtin_amdgcn_s_setprio(1); _Pragma("unroll") for (int m = 0; m < 4; ++m) _Pragma("unroll") for (int n = 0; n < 2; ++n) _Pragma("unroll") for (int k = 0; k < 2; ++k) \
        acc[ai][bj][m][n] = __builtin_amdgcn_mfma_f32_16x16x32_bf16(Bt[n][k], At[m][k], acc[ai][bj][m][n], 0, 0, 0); __builtin_amdgcn_s_setprio(0); } while (0)
#define PG8_WAIT_V(n) asm volatile("s_waitcnt vmcnt(" #n ")" ::: "memory")
#define PG8_WAIT_L(n) asm volatile("s_waitcnt lgkmcnt(" #n ")" ::: "memory")
#define PG8_BAR __builtin_amdgcn_s_barrier()
#define PG8_SCHED __builtin_amdgcn_sched_barrier(0)
    Unit cur, nxt; int ui = 0;
    if (!S.next(0, cur)) return;
    unsigned vo[2][2], nvo[2][2];
    calc_aoff(P, cur, Rr, Cc, vo);
    bool has_next = S.next(1, nxt);
    if constexpr (Prob::GATHER) { if (has_next) calc_aoff(P, nxt, Rr, Cc, nvo); else {
#pragma unroll
        for (int h = 0; h < 2; ++h)
#pragma unroll
            for (int i = 0; i < 2; ++i) nvo[h][i] = vo[h][i]; } }
    f32x4 acc[2][2][4][2];
#pragma unroll
    for (int a = 0; a < 2; ++a)
#pragma unroll
        for (int b = 0; b < 2; ++b)
#pragma unroll
            for (int m = 0; m < 4; ++m)
#pragma unroll
                for (int n = 0; n < 2; ++n) acc[a][b][m][n] = (f32x4){0.f, 0.f, 0.f, 0.f};
    bf16x8 At[4][2], B0[2][2], B1[2][2];
    const char* cA = P.a_base(cur); const char* cB = P.b_base(cur);
    PG8_STGB(PG8_SB(0, 0), cB); PG8_STGB(PG8_SB(0, 1), cB + bhstep); PG8_STG(PG8_SA(0, 0), cA, vo[0][0], vo[0][1]); PG8_STG(PG8_SA(0, 1), cA, vo[1][0], vo[1][1]);
    if (wr == 1) PG8_BAR;
    PG8_WAIT_V(2); PG8_BAR;
    PG8_STGB(PG8_SB(1, 0), cB + kstep); PG8_STG(PG8_SA(1, 0), cA + kstep, vo[0][0], vo[0][1]); PG8_STGB(PG8_SB(1, 1), cB + bhstep + kstep);
    PG8_WAIT_V(6); PG8_BAR;
    for (;;) {
        const char* nA = has_next ? P.a_base(nxt) : cA; const char* nB = has_next ? P.b_base(nxt) : cB;
        for (int t = 0; t < nt; t += 2) {
            const bool last = (t == nt - 2);
            if constexpr (Epi::HAS_MID) { if (t == Epi::MID_T0 || t == Epi::MID_T1) { E.mid(acc, cur, wr, wc, fr, fq, t == Epi::MID_T0 ? 0 : 1); PG8_SCHED; } }
            const char* a1 = cA + (size_t)(t + 1) * kstep;
            const char* a2 = last ? nA : cA + (size_t)(t + 2) * kstep; const char* b2 = last ? nB : cB + (size_t)(t + 2) * kstep;
            const char* a3 = a2 + kstep; const char* b3 = b2 + kstep;
            unsigned x00 = vo[0][0], x01 = vo[0][1], x10 = vo[1][0], x11 = vo[1][1];
            if constexpr (Prob::GATHER) { if (last) { x00 = nvo[0][0]; x01 = nvo[0][1]; x10 = nvo[1][0]; x11 = nvo[1][1]; } }
            PG8_LDB(B0, 0, 0); PG8_LDB(B1, 0, 1); PG8_SCHED; PG8_LDA(At, 0, 0); PG8_STG(PG8_SA(1, 1), a1, vo[1][0], vo[1][1]);
            PG8_WAIT_V(8); PG8_WAIT_L(0); PG8_BAR; PG8_MMA(0, 0, At, B0); PG8_MMA(0, 1, At, B1); PG8_BAR; PG8_SCHED;
            PG8_LDA(At, 0, 1); PG8_STGB(PG8_SB(0, 0), b2); PG8_STGB(PG8_SB(0, 1), b2 + bhstep); PG8_STG(PG8_SA(0, 0), a2, x00, x01);
            PG8_WAIT_V(8); PG8_WAIT_L(0); PG8_BAR; PG8_MMA(1, 0, At, B0); PG8_MMA(1, 1, At, B1); PG8_BAR; PG8_SCHED;
            PG8_LDB(B0, 1, 0); PG8_LDB(B1, 1, 1); PG8_SCHED; PG8_LDA(At, 1, 0); PG8_STG(PG8_SA(0, 1), a2, x10, x11);
            PG8_WAIT_V(8); PG8_WAIT_L(0); PG8_BAR; PG8_MMA(0, 0, At, B0); PG8_MMA(0, 1, At, B1); PG8_BAR; PG8_SCHED;
            PG8_LDA(At, 1, 1); PG8_STGB(PG8_SB(1, 0), b3); PG8_STGB(PG8_SB(1, 1), b3 + bhstep); PG8_STG(PG8_SA(1, 0), a3, x00, x01);
            PG8_WAIT_V(8); PG8_WAIT_L(0); PG8_BAR; PG8_MMA(1, 0, At, B0); PG8_MMA(1, 1, At, B1); PG8_BAR; PG8_SCHED;
        }
        if constexpr (ALIGN_EPI) { if (wr == 0) PG8_BAR; }
        Unit nn; const bool has_nn = has_next && S.next(ui + 2, nn);
        if constexpr (Prob::GATHER) {
#pragma unroll
            for (int h = 0; h < 2; ++h)
#pragma unroll
                for (int i = 0; i < 2; ++i) vo[h][i] = nvo[h][i];
            if (has_nn) {
#pragma unroll
                for (int h = 0; h < 2; ++h)
#pragma unroll
                    for (int i = 0; i < 2; ++i) nvo[h][i] = P.a_raw(nn, h * HALF + Rr[i]); } }
        E(acc, cur, wr, wc, fr, fq);
        if (!has_next) break;
#pragma unroll
        for (int a = 0; a < 2; ++a)
#pragma unroll
            for (int b = 0; b < 2; ++b)
#pragma unroll
                for (int m = 0; m < 4; ++m)
#pragma unroll
                    for (int n = 0; n < 2; ++n) acc[a][b][m][n] = (f32x4){0.f, 0.f, 0.f, 0.f};
        cur = nxt; cA = nA; cB = nB; ++ui;
        has_next = has_nn; nxt = nn;
        if constexpr (Prob::GATHER) { if (has_next) {
#pragma unroll
            for (int h = 0; h < 2; ++h)
#pragma unroll
                for (int i = 0; i < 2; ++i) nvo[h][i] = (nvo[h][i] >> 2) * 2048u + (unsigned)Cc[i] * 2u;
            asm volatile("" : "+v"(nvo[0][0]), "+v"(nvo[0][1]), "+v"(nvo[1][0]), "+v"(nvo[1][1])); } }
        if constexpr (ALIGN_EPI) { if (wr == 1) PG8_BAR; }
    }
    PG8_WAIT_V(0);
    if constexpr (!ALIGN_EPI) { if (wr == 0) PG8_BAR; }
    PG8_BAR;
#undef PG8_SA
#undef PG8_SB
#undef PG8_STG
#undef PG8_STGB
#undef PG8_LDA
#undef PG8_LDB
#undef PG8_MMA
#undef PG8_WAIT_V
#undef PG8_WAIT_L
#undef PG8_BAR
#undef PG8_SCHED
}

typedef const f32x4 (&AccRef)[2][2][4][2];

__device__ __forceinline__ void store8(bf16_t* p, const f32x4& a, const f32x4& b) {
    u32x4 w; w.x = cvt_pk_bf16(a[0], a[1]); w.y = cvt_pk_bf16(a[2], a[3]); w.z = cvt_pk_bf16(b[0], b[1]); w.w = cvt_pk_bf16(b[2], b[3]); *(u32x4*)p = w;
}
__device__ __forceinline__ float sigmoidf_(float v) { return __builtin_amdgcn_rcpf(1.0f + __builtin_amdgcn_exp2f(-1.4426950408889634f * v)); }

struct EpiInProj {
    static constexpr bool HAS_MID = false;
    bf16_t *Q, *Kb, *V, *U, *MQ, *GT; const float *qn, *kn, *mqn, *bg; const f32x2* rope;
    __device__ __forceinline__ void operator()(AccRef acc, const Unit& u, int wr, int wc, int fr, int fq) const {
        const int pn = u.pn; const int row0 = u.pm * BM + wr * 64 + fr;
        bf16_t* const Q_ = Q; bf16_t* const K_ = Kb; bf16_t* const V_ = V; bf16_t* const U_ = U; bf16_t* const MQ_ = MQ; const float* const qn_ = qn; const float* const kn_ = kn; const float* const mqn_ = mqn;
        if (pn < 4 || pn == 7) {
            const bool rope_on = pn < 4; const float* gn = pn < 2 ? qn_ : (pn < 4 ? kn_ : mqn_);
            const float sc = (pn < 2 || pn == 7) ? C2 : 1.0f;
            bf16_t* O; int pitch, colb;
            if (pn < 2) { O = Q_; pitch = 512; colb = (pn * 4 + wc) * 64; } else if (pn < 4) { O = K_; pitch = 512; colb = ((pn - 2) * 4 + wc) * 64; } else { O = MQ_; pitch = 256; colb = wc * 64; }
            const f32x4 g00 = *(const f32x4*)(gn + 8 * fq), g01 = *(const f32x4*)(gn + 8 * fq + 4), g10 = *(const f32x4*)(gn + 32 + 8 * fq), g11 = *(const f32x4*)(gn + 32 + 8 * fq + 4);
#pragma unroll
            for (int ai = 0; ai < 2; ++ai)
#pragma unroll
                for (int m = 0; m < 4; ++m) {
                    const f32x4 a0 = acc[ai][0][m][0], a1 = acc[ai][0][m][1], b0 = acc[ai][1][m][0], b1 = acc[ai][1][m][1];
                    float ss = 0.f;
#pragma unroll
                    for (int j = 0; j < 4; ++j) ss += a0[j] * a0[j] + a1[j] * a1[j] + b0[j] * b0[j] + b1[j] * b1[j];
                    ss += __shfl_xor(ss, 16); ss += __shfl_xor(ss, 32);
                    const float rstd = 1.0f / sqrtf(ss * (1.0f / 64.0f) + RMS_EPS);
                    const int row = row0 + ai * HALF + m * 16;
                    f32x4 t10 = a0 * rstd * g00, t11 = a1 * rstd * g01, t20 = b0 * rstd * g10, t21 = b1 * rstd * g11;
                    f32x4 o10, o11, o20, o21;
                    if (rope_on) {
                        const f32x4* rp = (const f32x4*)(rope + (size_t)(row & (SEQ - 1)) * 32 + 8 * fq);
                        const f32x4 r0 = rp[0], r1 = rp[1], r2 = rp[2], r3 = rp[3];
                        const f32x4 cs0 = {r0[0], r0[2], r1[0], r1[2]}, sn0 = {r0[1], r0[3], r1[1], r1[3]}, cs1 = {r2[0], r2[2], r3[0], r3[2]}, sn1 = {r2[1], r2[3], r3[1], r3[3]};
                        o10 = (t10 * cs0 - t20 * sn0) * sc; o11 = (t11 * cs1 - t21 * sn1) * sc; o20 = (t20 * cs0 + t10 * sn0) * sc; o21 = (t21 * cs1 + t11 * sn1) * sc;
                    } else { o10 = t10 * sc; o11 = t11 * sc; o20 = t20 * sc; o21 = t21 * sc; }
                    bf16_t* rowp = O + (size_t)row * pitch + colb + 8 * fq;
                    store8(rowp, o10, o11); store8(rowp + 32, o20, o21);
                }
        } else if (pn < 7) {
            bf16_t* O; int pitch, colb;
            if (pn < 6) { O = V_; pitch = 512; colb = (pn - 4) * 256 + wc * 64; } else { O = U_; pitch = 256; colb = wc * 64; }
#pragma unroll
            for (int ai = 0; ai < 2; ++ai)
#pragma unroll
                for (int m = 0; m < 4; ++m) { bf16_t* rowp = O + (size_t)(row0 + ai * HALF + m * 16) * pitch + colb + 8 * fq;
                    store8(rowp, acc[ai][0][m][0], acc[ai][0][m][1]); store8(rowp + 32, acc[ai][1][m][0], acc[ai][1][m][1]); }
        } else {
            const int gc = (pn - 8) * 256 + wc * 64 + 8 * fq;
            f32x4 bv[2][2];
#pragma unroll
            for (int bj = 0; bj < 2; ++bj)
#pragma unroll
                for (int n = 0; n < 2; ++n) bv[bj][n] = *(const f32x4*)(bg + gc + 32 * bj + 4 * n);
#pragma unroll
            for (int ai = 0; ai < 2; ++ai)
#pragma unroll
                for (int m = 0; m < 4; ++m) { bf16_t* rowp = GT + (size_t)(row0 + ai * HALF + m * 16) * 3072 + gc;
#pragma unroll
                    for (int bj = 0; bj < 2; ++bj) { f32x4 v0 = acc[ai][bj][m][0] + bv[bj][0], v1 = acc[ai][bj][m][1] + bv[bj][1];
#pragma unroll
                        for (int j = 0; j < 4; ++j) { v0[j] = sigmoidf_(v0[j]); v1[j] = sigmoidf_(v1[j]); }
                        store8(rowp + 32 * bj, v0, v1); } }
        }
    }
};
struct EpiMemKV {
    static constexpr bool HAS_MID = false;
    bf16_t* MKV; const float* mkn;
    __device__ __forceinline__ void operator()(AccRef acc, const Unit& u, int wr, int wc, int fr, int fq) const {
        const int row0 = u.pm * BM + wr * 64 + fr;
        f32x4 g00 = {1.f, 1.f, 1.f, 1.f}, g01 = g00, g10 = g00, g11 = g00;
        if (u.pn == 0) { g00 = *(const f32x4*)(mkn + 8 * fq); g01 = *(const f32x4*)(mkn + 8 * fq + 4); g10 = *(const f32x4*)(mkn + 32 + 8 * fq); g11 = *(const f32x4*)(mkn + 32 + 8 * fq + 4); }
#pragma unroll
        for (int ai = 0; ai < 2; ++ai)
#pragma unroll
            for (int m = 0; m < 4; ++m) {
                const f32x4 a0 = acc[ai][0][m][0], a1 = acc[ai][0][m][1], b0 = acc[ai][1][m][0], b1 = acc[ai][1][m][1];
                float rstd = 1.0f;
                if (u.pn == 0) { float ss = 0.f;
#pragma unroll
                    for (int j = 0; j < 4; ++j) ss += a0[j] * a0[j] + a1[j] * a1[j] + b0[j] * b0[j] + b1[j] * b1[j];
                    ss += __shfl_xor(ss, 16); ss += __shfl_xor(ss, 32); rstd = 1.0f / sqrtf(ss * (1.0f / 64.0f) + RMS_EPS); }
                bf16_t* rowp = MKV + (size_t)(row0 + ai * HALF + m * 16) * 512 + u.pn * 256 + wc * 64 + 8 * fq;
                store8(rowp, a0 * rstd * g00, a1 * rstd * g01); store8(rowp + 32, b0 * rstd * g10, b1 * rstd * g11);
            }
    }
};
template <int STAGE> struct EpiMerge {
    static constexpr bool HAS_MID = false;
    const bf16_t* GT; float* MF; bf16_t* MB;
    __device__ __forceinline__ void operator()(AccRef acc, const Unit& u, int wr, int wc, int fr, int fq) const {
        const int row0 = u.pm * BM + wr * 64 + fr, col0 = u.pn * BM + wc * 64 + 8 * fq;
#pragma unroll
        for (int ai = 0; ai < 2; ++ai)
#pragma unroll
            for (int m = 0; m < 4; ++m) { const size_t row = (size_t)(row0 + ai * HALF + m * 16);
#pragma unroll
                for (int bj = 0; bj < 2; ++bj) { const int col = col0 + 32 * bj;
                    const u32x4 g = *(const u32x4*)(GT + row * 3072 + STAGE * 1024 + col);
                    const f32x4 ga = {bf_lo(g.x), bf_hi(g.x), bf_lo(g.y), bf_hi(g.y)}, gb = {bf_lo(g.z), bf_hi(g.z), bf_lo(g.w), bf_hi(g.w)};
                    f32x4 v0 = acc[ai][bj][m][0] * ga, v1 = acc[ai][bj][m][1] * gb;
                    float* mp = MF + row * 1024 + col;
                    if (STAGE > 0) { v0 += *(const f32x4*)mp; v1 += *(const f32x4*)(mp + 4); }
                    if (STAGE < 2) { *(f32x4*)mp = v0; *(f32x4*)(mp + 4) = v1; } else store8(MB + row * 1024 + col, v0, v1); }
                if (m & 1) asm volatile("" ::: "memory"); }
    }
};
struct EpiWout {
    static constexpr bool HAS_MID = false;
    const float* X; float* X2; bf16_t* XG; const float* n2;
    __device__ __forceinline__ void operator()(AccRef acc, const Unit& u, int wr, int wc, int fr, int fq) const {
        const int row0 = u.pm * BM + wr * 64 + fr, col0 = u.pn * BM + wc * 64 + 8 * fq;
        f32x4 nv[2][2];
#pragma unroll
        for (int bj = 0; bj < 2; ++bj)
#pragma unroll
            for (int n = 0; n < 2; ++n) nv[bj][n] = *(const f32x4*)(n2 + col0 + 32 * bj + 4 * n);
#pragma unroll
        for (int ai = 0; ai < 2; ++ai)
#pragma unroll
            for (int m = 0; m < 4; ++m) { const size_t off = (size_t)(row0 + ai * HALF + m * 16) * 1024 + col0;
#pragma unroll
                for (int bj = 0; bj < 2; ++bj) { const f32x4 x0 = *(const f32x4*)(X + off + 32 * bj) + acc[ai][bj][m][0], x1 = *(const f32x4*)(X + off + 32 * bj + 4) + acc[ai][bj][m][1];
                    *(f32x4*)(X2 + off + 32 * bj) = x0; *(f32x4*)(X2 + off + 32 * bj + 4) = x1;
                    store8(XG + off + 32 * bj, x0 * nv[bj][0], x1 * nv[bj][1]); }
                if (m & 1) asm volatile("" ::: "memory"); }
    }
};
struct EpiSwiglu {
    static constexpr bool HAS_MID = false;
    bf16_t* ACT; const u32x2* list; const float* bgu;
    __device__ __forceinline__ void operator()(AccRef acc, const Unit& u, int wr, int wc, int fr, int fq) const {
        int z = 0; asm volatile("" : "+v"(z));
        const int col = 128 * u.pn + 32 * wc + 8 * fq + z; const float* bp = bgu + (size_t)u.e * 2048 + col;
        const f32x4 bg0 = *(const f32x4*)bp, bg1 = *(const f32x4*)(bp + 4), bu0 = *(const f32x4*)(bp + 1024), bu1 = *(const f32x4*)(bp + 1028);
#pragma unroll
        for (int ai = 0; ai < 2; ++ai)
#pragma unroll
            for (int m = 0; m < 4; ++m) { const int r = ai * HALF + wr * 64 + m * 16 + fr, rr = u.mt * BM + r, rc = rr < u.cnt ? rr : u.cnt - 1;
                const float rstd = __uint_as_float(list[(size_t)u.e * CAP + rc].y);
                f32x4 o[2];
#pragma unroll
                for (int n = 0; n < 2; ++n) { const f32x4 g = acc[ai][0][m][n] * rstd + (n ? bg1 : bg0), up = acc[ai][1][m][n] * rstd + (n ? bu1 : bu0);
#pragma unroll
                    for (int j = 0; j < 4; ++j) { const float gg = fminf(g[j], 7.0f), uu = fminf(fmaxf(up[j], -7.0f), 7.0f);
                        o[n][j] = gg * __builtin_amdgcn_rcpf(1.0f + __builtin_amdgcn_exp2f(-1.702f * 1.4426950408889634f * gg)) * (uu + 1.0f); } }
                store8(ACT + (size_t)(u.pm * BM + r) * 1024 + col, o[0], o[1]); }
    }
};
struct EpiDown {
    static constexpr bool HAS_MID = false;
    bf16_t* Y4; const u32x2* list; const float* bd;
    __device__ __forceinline__ void operator()(AccRef acc, const Unit& u, int wr, int wc, int fr, int fq) const {
        int z = 0; asm volatile("" : "+v"(z));
        const int col0 = u.pn * BM + wc * 64 + 8 * fq + z; const float* bp = bd + (size_t)u.e * 1024 + col0;
        f32x4 bv[2][2];
#pragma unroll
        for (int bj = 0; bj < 2; ++bj)
#pragma unroll
            for (int n = 0; n < 2; ++n) bv[bj][n] = *(const f32x4*)(bp + 32 * bj + 4 * n);
        unsigned tkv[8];
#pragma unroll
        for (int ai = 0; ai < 2; ++ai)
#pragma unroll
            for (int m = 0; m < 4; ++m) { const int rr = u.mt * BM + ai * HALF + wr * 64 + m * 16 + fr, rc = rr < u.cnt ? rr : u.cnt - 1;
                tkv[ai * 4 + m] = list[(size_t)u.e * CAP + rc].x; }
#pragma unroll
        for (int ai = 0; ai < 2; ++ai)
#pragma unroll
            for (int m = 0; m < 4; ++m) { const int rr = u.mt * BM + ai * HALF + wr * 64 + m * 16 + fr;
                if (rr < u.cnt) { bf16_t* rowp = Y4 + (size_t)tkv[ai * 4 + m] * 1024 + col0;
#pragma unroll
                    for (int bj = 0; bj < 2; ++bj) store8(rowp + 32 * bj, acc[ai][bj][m][0] + bv[bj][0], acc[ai][bj][m][1] + bv[bj][1]); } }
    }
};
struct EpiMergeR {
    static constexpr bool HAS_MID = true; static constexpr int MID_T0 = 8, MID_T1 = 12;
    const bf16_t* GT; bf16_t* MB;
    __device__ __forceinline__ void mid(f32x4 (&acc)[2][2][4][2], const Unit& u, int wr, int wc, int fr, int fq, int seam) const {
        int z = 0; asm volatile("" : "+v"(z));
        const bf16_t* gp0 = GT + (size_t)(u.pm * BM + wr * 64 + fr + z) * 3072 + seam * 1024 + u.pn * BM + wc * 64 + 8 * fq;
#pragma unroll
        for (int ai = 0; ai < 2; ++ai)
#pragma unroll
            for (int m = 0; m < 4; ++m) { const bf16_t* gp = gp0 + (size_t)(ai * HALF + m * 16) * 3072;
#pragma unroll
                for (int bj = 0; bj < 2; ++bj) { const u32x4 gn = *(const u32x4*)(gp + 32 * bj), gd = *(const u32x4*)(gp + 1024 + 32 * bj);
                    const unsigned nn[4] = {gn.x, gn.y, gn.z, gn.w}, dd[4] = {gd.x, gd.y, gd.z, gd.w};
#pragma unroll
                    for (int j = 0; j < 4; ++j) { const float r0 = bf_lo(nn[j]) * __builtin_amdgcn_rcpf(fmaxf(bf_lo(dd[j]), 8.67e-19f)), r1 = bf_hi(nn[j]) * __builtin_amdgcn_rcpf(fmaxf(bf_hi(dd[j]), 8.67e-19f));
                        acc[ai][bj][m][j >> 1][(j & 1) * 2] *= r0; acc[ai][bj][m][j >> 1][(j & 1) * 2 + 1] *= r1; } }
                if (m & 1) asm volatile("" ::: "memory"); }
    }
    __device__ __forceinline__ void operator()(AccRef acc, const Unit& u, int wr, int wc, int fr, int fq) const {
        int z = 0; asm volatile("" : "+v"(z));
        const size_t off0 = (size_t)(u.pm * BM + wr * 64 + fr + z) * 1024 + u.pn * BM + wc * 64 + 8 * fq;
#pragma unroll
        for (int ai = 0; ai < 2; ++ai)
#pragma unroll
            for (int m = 0; m < 4; ++m) { const size_t ro = off0 + (size_t)(ai * HALF + m * 16) * 1024;
#pragma unroll
                for (int bj = 0; bj < 2; ++bj) {
                    const u32x4 g = *(const u32x4*)(GT + ro * 3 + 2048 - 2 * (ro & 1023) + 32 * bj);
                    const f32x4 ga = {bf_lo(g.x), bf_hi(g.x), bf_lo(g.y), bf_hi(g.y)}, gb = {bf_lo(g.z), bf_hi(g.z), bf_lo(g.w), bf_hi(g.w)};
                    store8(MB + ro + 32 * bj, acc[ai][bj][m][0] * ga, acc[ai][bj][m][1] * gb); } }
    }
};
struct EpiPlain {
    static constexpr bool HAS_MID = false;
    bf16_t* Z; int ldz;
    __device__ __forceinline__ void operator()(AccRef acc, const Unit& u, int wr, int wc, int fr, int fq) const {
        const int row0 = u.pm * BM + wr * 64 + fr, col0 = u.pn * BM + wc * 64 + 8 * fq;
#pragma unroll
        for (int ai = 0; ai < 2; ++ai)
#pragma unroll
            for (int m = 0; m < 4; ++m) { bf16_t* rowp = Z + (size_t)(row0 + ai * HALF + m * 16) * ldz + col0;
                store8(rowp, acc[ai][0][m][0], acc[ai][0][m][1]); store8(rowp + 32, acc[ai][1][m][0], acc[ai][1][m][1]); }
    }
};
}

namespace attn_body {
using bf16 = __hip_bfloat16;
using s16x4 = __attribute__((ext_vector_type(4))) short;
constexpr int NW = 8, QBLK = 32, QB = QBLK * NW, KVBLK = 64, D = 64;
__device__ __forceinline__ int crow(int r, int hi) { return (r & 3) + 8 * (r >> 2) + 4 * hi; }
#define SBAR() __builtin_amdgcn_sched_barrier(0)
constexpr int NSLOT = 3, SLOTB = 8192;
constexpr int LDS_K = 0, LDS_V = NSLOT * SLOTB, LDS_WS = 2 * NSLOT * SLOTB, LDS_OST = LDS_WS + NW * 64 * 4, LDS_BYTES = LDS_OST + NW * 4096;
__device__ __forceinline__ void glds16(const void* gsrc, unsigned lds_dst) { unsigned keep;
    asm volatile("s_mov_b32 %0, m0\n\ts_mov_b32 m0, %2\n\ts_nop 0\n\tglobal_load_lds_dwordx4 %1, off\n\ts_mov_b32 m0, %0" : "=&s"(keep) : "v"(gsrc), "s"(lds_dst) : "memory"); }
__device__ __forceinline__ float max3f(float a, float b, float c) { float r; asm("v_max3_f32 %0, %1, %2, %3" : "=v"(r) : "v"(a), "v"(b), "v"(c)); return r; }
__device__ __forceinline__ float max2f(float a, float b) { float r; asm("v_max_f32_e32 %0, %1, %2" : "=v"(r) : "v"(a), "v"(b)); return r; }
__device__ __forceinline__ float fadd_s(float a, float b) { float r; asm("v_add_f32_e32 %0, %1, %2" : "=v"(r) : "v"(a), "v"(b)); return r; }
__device__ __forceinline__ float fsub_s(float a, float b) { float r; asm("v_sub_f32_e32 %0, %1, %2" : "=v"(r) : "v"(a), "v"(b)); return r; }
typedef float f32x2_t __attribute__((ext_vector_type(2))); typedef __bf16 bf16x2_t __attribute__((ext_vector_type(2)));
__device__ __forceinline__ unsigned cvtpk_s(float lo, float hi) { f32x2_t v = {lo, hi}; bf16x2_t b = __builtin_convertvector(v, bf16x2_t); return __builtin_bit_cast(unsigned, b); }
#define WAIT_BAR(N) asm volatile("s_waitcnt vmcnt(" #N ") lgkmcnt(0)\n\ts_barrier" ::: "memory")

__device__ __forceinline__ void qkt(f32x16& p0, f32x16& p1, const char* Kslot, const bf16x8* qr, const f32x16& negm, int r32, int hi) {
    const char* kb = Kslot + hi * 1024 + r32 * 16;
#pragma unroll
    for (int d0 = 0; d0 < 4; ++d0) {
        const bf16x8 b0 = *reinterpret_cast<const bf16x8*>(kb + d0 * 2048);
        const bf16x8 b1 = *reinterpret_cast<const bf16x8*>(kb + d0 * 2048 + 512);
        if (d0 == 0) { p0 = __builtin_amdgcn_mfma_f32_32x32x16_bf16(b0, qr[0], negm, 0, 0, 0); p1 = __builtin_amdgcn_mfma_f32_32x32x16_bf16(b1, qr[0], negm, 0, 0, 0); }
        else { p0 = __builtin_amdgcn_mfma_f32_32x32x16_bf16(b0, qr[d0], p0, 0, 0, 0); p1 = __builtin_amdgcn_mfma_f32_32x32x16_bf16(b1, qr[d0], p1, 0, 0, 0); } }
}
typedef __attribute__((address_space(3))) const char* lds_cptr;
typedef short v4i16_t __attribute__((ext_vector_type(4)));
__device__ __forceinline__ void kload8(bf16x8* kf, lds_cptr kp) {
    kf[0] = *(const __attribute__((address_space(3))) bf16x8*)(kp);        kf[1] = *(const __attribute__((address_space(3))) bf16x8*)(kp + 512);
    kf[2] = *(const __attribute__((address_space(3))) bf16x8*)(kp + 2048); kf[3] = *(const __attribute__((address_space(3))) bf16x8*)(kp + 2560);
    kf[4] = *(const __attribute__((address_space(3))) bf16x8*)(kp + 4096); kf[5] = *(const __attribute__((address_space(3))) bf16x8*)(kp + 4608);
    kf[6] = *(const __attribute__((address_space(3))) bf16x8*)(kp + 6144); kf[7] = *(const __attribute__((address_space(3))) bf16x8*)(kp + 6656);
}
__device__ __forceinline__ void kload2(bf16x8* kf, lds_cptr kp, int j) { kf[2 * j] = *(const __attribute__((address_space(3))) bf16x8*)(kp + j * 2048); kf[2 * j + 1] = *(const __attribute__((address_space(3))) bf16x8*)(kp + j * 2048 + 512); }
__device__ __forceinline__ s16x4 vtr(lds_cptr p) { return __builtin_bit_cast(s16x4, __builtin_amdgcn_ds_read_tr16_b64_v4i16((__attribute__((address_space(3))) v4i16_t*)p)); }
__device__ __forceinline__ float rowmax(const f32x16& p0, const f32x16& p1) {
    float a = max3f(p0[0], p0[1], p1[0]), b = max3f(p0[2], p0[3], p1[1]); a = max3f(a, p1[2], p1[3]);
#pragma unroll
    for (int r = 4; r < 16; r += 4) { a = max3f(a, p0[r], p0[r + 1]); b = max3f(b, p0[r + 2], p0[r + 3]); a = max3f(a, p1[r], p1[r + 1]); b = max3f(b, p1[r + 2], p1[r + 3]); }
    const float m = max2f(a, b);
    auto rr = __builtin_amdgcn_permlane32_swap(__float_as_uint(m), __float_as_uint(m), false, false);
    return max2f(__uint_as_float(rr[0]), __uint_as_float(rr[1]));
}
__device__ __forceinline__ void pv(f32x16* o, int vb, bf16x8 pa0, bf16x8 pa1, bf16x8 pa2, bf16x8 pa3) {
#pragma unroll
    for (int d0 = 0; d0 < 2; ++d0) { s16x4 lo[4], hi[4];
#pragma unroll
        for (int ks = 0; ks < 4; ++ks) {
            asm volatile("ds_read_b64_tr_b16 %0,%1 offset:%c2" : "=&v"(lo[ks]) : "v"(vb), "i"(d0 * 4096 + ks * 1024) : "memory");
            asm volatile("ds_read_b64_tr_b16 %0,%1 offset:%c2" : "=&v"(hi[ks]) : "v"(vb), "i"(d0 * 4096 + ks * 1024 + 512) : "memory"); }
        asm volatile("s_waitcnt lgkmcnt(0)" ::: "memory"); SBAR();
#define PK(k) (bf16x8){lo[k][0], lo[k][1], lo[k][2], lo[k][3], hi[k][0], hi[k][1], hi[k][2], hi[k][3]}
        o[d0] = __builtin_amdgcn_mfma_f32_32x32x16_bf16(pa0, PK(0), o[d0], 0, 0, 0);
        o[d0] = __builtin_amdgcn_mfma_f32_32x32x16_bf16(pa1, PK(1), o[d0], 0, 0, 0);
        o[d0] = __builtin_amdgcn_mfma_f32_32x32x16_bf16(pa2, PK(2), o[d0], 0, 0, 0);
        o[d0] = __builtin_amdgcn_mfma_f32_32x32x16_bf16(pa3, PK(3), o[d0], 0, 0, 0);
#undef PK
    }
}
__device__ __forceinline__ void cmask(f32x16& p0, f32x16& p1, int jb, int wid) {
    if (jb > (wid >> 1)) {
#pragma unroll
        for (int r = 0; r < 16; ++r) { p0[r] = -INFINITY; p1[r] = -INFINITY; } }
}
template <int THRL, bool MASK> __device__ __forceinline__ void attn_unit(int q0, int NT, const bf16* Qh, int qp, const bf16* __restrict__ Kh, int kp, const bf16* __restrict__ Vh, int vp, bf16* Oh, int op, char* shm) {
    const int tid = threadIdx.x, lane = tid & 63, r32 = lane & 31, hi = lane >> 5; const int wid = __builtin_amdgcn_readfirstlane(tid >> 6);
    const bf16* Qw = Qh + (long)(q0 + wid * QBLK) * qp;
    const unsigned lds0 = (unsigned)(uintptr_t)shm;
    float* wsf = (float*)(shm + LDS_WS) + wid * 64;
    const bf16* ksrc = Kh + (long)lane * kp + wid * 8;
    const bf16* vsrc = Vh + (long)(16 * (wid & 3) + (lane >> 2)) * vp + (wid >> 2) * 32 + (lane & 3) * 8;
    const unsigned kdst = lds0 + LDS_K + wid * 1024, vdst = lds0 + LDS_V + wid * 1024;
#define DMA_K(t, slot) glds16(ksrc + (long)(t) * KVBLK * kp, (unsigned)__builtin_amdgcn_readfirstlane(kdst + (slot)))
#define DMA_V(t, slot) glds16(vsrc + (long)(t) * KVBLK * vp, (unsigned)__builtin_amdgcn_readfirstlane(vdst + (slot)))
    const int vb0 = (int)(lds0 + LDS_V) + ((lane >> 4) & 1) * 32 + (lane & 3) * 8 + (4 * hi + ((lane & 15) >> 2)) * 64;
    const char* Kbase = shm + LDS_K; bf16x8 kf[8];
    const lds_cptr shm3 = (lds_cptr)shm; const lds_cptr kp0 = shm3 + LDS_K + hi * 1024 + r32 * 16; const lds_cptr vp0 = shm3 + LDS_V + ((lane >> 4) & 1) * 32 + (lane & 3) * 8 + (4 * hi + ((lane & 15) >> 2)) * 64;
    DMA_K(0, 0); DMA_V(0, 0); DMA_K(1, SLOTB);
    bf16x8 qr[4];
#pragma unroll
    for (int d0 = 0; d0 < 4; ++d0) qr[d0] = *reinterpret_cast<const bf16x8*>(&Qw[(long)r32 * qp + d0 * 16 + hi * 8]);
    float mhat = 0.f, l_reg = 0.f; f32x16 o[2]; o[0] = f32x16{}; o[1] = f32x16{}; f32x16 negm = f32x16{}; asm volatile("" : "+v"(negm));
#define CMASK(P0, P1, t) do { if (MASK) { int jb_ = (t) - (NT - 4); if (jb_ >= 0) cmask(P0, P1, jb_, wid); } } while (0)
    bool resc = false;
#define START(P0, P1) do { const float rm = rowmax(P0, P1); resc = false; \
    { const float dl = rm; mhat = fadd_s(mhat, dl); \
      _Pragma("unroll") for (int r = 0; r < 16; ++r) { P0[r] = fsub_s(P0[r], dl); P1[r] = fsub_s(P1[r], dl); } \
      _Pragma("unroll") for (int r = 0; r < 16; ++r) negm[r] = -mhat; asm volatile("" : "+v"(negm)); } \
    _Pragma("unroll") for (int r = 0; r < 16; ++r) P0[r] = __builtin_amdgcn_exp2f(P0[r]); } while (0)
#define RESC() do { if (resc) { asm volatile("s_waitcnt lgkmcnt(0)" ::: "memory"); \
      _Pragma("unroll") for (int d_ = 0; d_ < 2; ++d_) _Pragma("unroll") for (int r = 0; r < 16; ++r) o[d_][r] *= wsf[crow(r, hi)]; } } while (0)
    f32x16 pA0, pA1, pB0, pB1;
    int sl_prev = 0, sl_cur = 0, sl_next = SLOTB;
#define ROT() do { sl_prev = sl_cur; sl_cur = sl_next; sl_next = (sl_next == (NSLOT - 1) * SLOTB) ? 0 : sl_next + SLOTB; } while (0)
    DMA_K(2, 2 * SLOTB);
    WAIT_BAR(3);
    qkt(pA0, pA1, Kbase, qr, negm, r32, hi); asm volatile("s_nop 15\n\ts_nop 7" : "+v"(pA0), "+v"(pA1)); CMASK(pA0, pA1, 0);
    START(pA0, pA1);
    _Pragma("unroll") for (int r = 0; r < 16; ++r) pA1[r] = __builtin_amdgcn_exp2f(pA1[r]);
    WAIT_BAR(0);
    DMA_K(3, 0); DMA_V(1, SLOTB);
    ROT();
    kload8(kf, kp0 + sl_cur);
    WAIT_BAR(2);
    s16x4 vlo[8], vhi[8]; u32x4 pw0, pw1, pw2, pw3;
#define PKW(P, B) cvtpk_s(P[B], P[B + 1])
#define PAF(k) __builtin_bit_cast(bf16x8, pw##k)
#define VFR(i) (bf16x8){vlo[i][0], vlo[i][1], vlo[i][2], vlo[i][3], vhi[i][0], vhi[i][1], vhi[i][2], vhi[i][3]}
#define PIN(x) asm volatile("" : "+v"(x))
#define MX3(a, b, c) __builtin_fmaxf(__builtin_fmaxf((a), (b)), (c))
#define GAPA(MF, A0, A1, A2, A3, W0, W1, PW) do { MF; sacc += A0; sacc += A1; sacc += A2; sacc += A3; PIN(sacc); W0; W1; PIN(PW); SBAR(); } while (0)
#define EX(v) __builtin_amdgcn_exp2f(v)
#define GAPB(MF, X, B) do { MF; X[B] = EX(X[B]); X[B + 1] = EX(X[B + 1]); X[B + 2] = EX(X[B + 2]); X[B + 3] = EX(X[B + 3]); PIN(X); SBAR(); } while (0)
#define VRD(i) do { vlo[i] = vtr(vp_ + (((i) >> 2) * 4096 + ((i) & 3) * 1024)); vhi[i] = vtr(vp_ + (((i) >> 2) * 4096 + ((i) & 3) * 1024 + 512)); } while (0)
#define KRD(G, j) do { if (G) { kload2(kf, kp0 + sl_next, j); SBAR(); } } while (0)
#define STEP(C0, C1, P0, P1, t, GK, GV, GL) do { SBAR(); \
    const lds_cptr vp_ = vp0 + sl_prev; \
    VRD(0); SBAR(); float sacc = (P0[0] + P0[1]); \
    GAPA(C0 = __builtin_amdgcn_mfma_f32_32x32x16_bf16(kf[0], qr[0], negm, 0, 0, 0), P0[2], P0[3], P0[4], P0[5],     pw0[0] = PKW(P0, 0), pw0[1] = PKW(P0, 2), pw0); \
    VRD(4); SBAR(); GAPA(C1 = __builtin_amdgcn_mfma_f32_32x32x16_bf16(kf[1], qr[0], negm, 0, 0, 0), P0[6], P0[7], P0[8], P0[9],     pw0[2] = PKW(P0, 4), pw0[3] = PKW(P0, 6), pw0); \
    VRD(1); SBAR(); GAPA(C0 = __builtin_amdgcn_mfma_f32_32x32x16_bf16(kf[2], qr[1], C0, 0, 0, 0),   P0[10], P0[11], P0[12], P0[13], pw1[0] = PKW(P0, 8), pw1[1] = PKW(P0, 10), pw1); \
    VRD(5); SBAR(); GAPA(C1 = __builtin_amdgcn_mfma_f32_32x32x16_bf16(kf[3], qr[1], C1, 0, 0, 0),   P0[14], P0[15], P1[0], P1[1],   pw1[2] = PKW(P0, 12), pw1[3] = PKW(P0, 14), pw1); \
    VRD(2); SBAR(); GAPA(C0 = __builtin_amdgcn_mfma_f32_32x32x16_bf16(kf[4], qr[2], C0, 0, 0, 0),   P1[2], P1[3], P1[4], P1[5],     pw2[0] = PKW(P1, 0), pw2[1] = PKW(P1, 2), pw2); \
    VRD(6); SBAR(); GAPA(C1 = __builtin_amdgcn_mfma_f32_32x32x16_bf16(kf[5], qr[2], C1, 0, 0, 0),   P1[6], P1[7], P1[8], P1[9],     pw2[2] = PKW(P1, 4), pw2[3] = PKW(P1, 6), pw2); \
    VRD(3); SBAR(); GAPA(C0 = __builtin_amdgcn_mfma_f32_32x32x16_bf16(kf[6], qr[3], C0, 0, 0, 0),   P1[10], P1[11], P1[12], P1[13], pw3[0] = PKW(P1, 8), pw3[1] = PKW(P1, 10), pw3); \
    VRD(7); SBAR(); GAPA(C1 = __builtin_amdgcn_mfma_f32_32x32x16_bf16(kf[7], qr[3], C1, 0, 0, 0),   P1[14], P1[15], 0.f, 0.f,       pw3[2] = PKW(P1, 12), pw3[3] = PKW(P1, 14), pw3); \
    l_reg += sacc; \
    if (GK) { DMA_K((t) + 3, sl_cur); } if (GV) { DMA_V((t) + 1, sl_next); } \
    CMASK(C0, C1, t); \
    { float a = MX3(C0[0], C0[1], C1[0]), b = MX3(C0[2], C0[3], C1[1]); a = MX3(a, C1[2], C1[3]); \
      _Pragma("unroll") for (int r = 4; r < 16; r += 4) { a = MX3(a, C0[r], C0[r + 1]); b = MX3(b, C0[r + 2], C0[r + 3]); a = MX3(a, C1[r], C1[r + 1]); b = MX3(b, C1[r + 2], C1[r + 3]); } \
      float rm = __builtin_fmaxf(a, b); { auto rr = __builtin_amdgcn_permlane32_swap(__float_as_uint(rm), __float_as_uint(rm), false, false); rm = __builtin_fmaxf(__uint_as_float(rr[0]), __uint_as_float(rr[1])); } \
      resc = false; \
      if (__builtin_expect(__any(rm > (float)THRL), 0)) { const float dl = __builtin_fmaxf(rm, 0.f); mhat += dl; \
        _Pragma("unroll") for (int r = 0; r < 16; ++r) { C0[r] -= dl; C1[r] -= dl; } \
        _Pragma("unroll") for (int r = 0; r < 16; ++r) negm[r] = -mhat; asm volatile("" : "+v"(negm)); \
        const float f = __builtin_amdgcn_exp2f(-dl); l_reg *= f; if (hi == 0) wsf[r32] = f; resc = true; } } \
    SBAR(); \
    GAPB(o[0] = __builtin_amdgcn_mfma_f32_32x32x16_bf16(PAF(0), VFR(0), o[0], 0, 0, 0), C0, 0); \
    GAPB(o[1] = __builtin_amdgcn_mfma_f32_32x32x16_bf16(PAF(0), VFR(4), o[1], 0, 0, 0), C0, 4); \
    KRD(GL, 0); GAPB(o[0] = __builtin_amdgcn_mfma_f32_32x32x16_bf16(PAF(1), VFR(1), o[0], 0, 0, 0), C0, 8); \
    KRD(GL, 1); GAPB(o[1] = __builtin_amdgcn_mfma_f32_32x32x16_bf16(PAF(1), VFR(5), o[1], 0, 0, 0), C0, 12); \
    KRD(GL, 2); GAPB(o[0] = __builtin_amdgcn_mfma_f32_32x32x16_bf16(PAF(2), VFR(2), o[0], 0, 0, 0), C1, 0); \
    KRD(GL, 3); GAPB(o[1] = __builtin_amdgcn_mfma_f32_32x32x16_bf16(PAF(2), VFR(6), o[1], 0, 0, 0), C1, 4); \
    GAPB(o[0] = __builtin_amdgcn_mfma_f32_32x32x16_bf16(PAF(3), VFR(3), o[0], 0, 0, 0), C1, 8); \
    GAPB(o[1] = __builtin_amdgcn_mfma_f32_32x32x16_bf16(PAF(3), VFR(7), o[1], 0, 0, 0), C1, 12); \
    } while (0)
    int t = 1;
#undef CMASK
#define CMASK(P0, P1, t) do {} while (0)
    for (; t + 5 < NT; t += 2) {
        STEP(pB0, pB1, pA0, pA1, t, true, true, true);     WAIT_BAR(2); RESC(); ROT();
        STEP(pA0, pA1, pB0, pB1, t + 1, true, true, true); WAIT_BAR(2); RESC(); ROT();
    }
#undef CMASK
#define CMASK(P0, P1, t) do { if (MASK) { int jb_ = (t) - (NT - 4); if (jb_ >= 0) cmask(P0, P1, jb_, wid); } } while (0)
#define ENDW(tt) do { if ((tt) + 3 < NT) { WAIT_BAR(2); } else if ((tt) + 2 < NT) { WAIT_BAR(1); } else { WAIT_BAR(0); } } while (0)
    for (; t + 1 < NT; t += 2) {
        STEP(pB0, pB1, pA0, pA1, t, (t + 3 < NT), (t + 1 < NT), (t + 1 < NT));       ENDW(t);     RESC(); ROT();
        STEP(pA0, pA1, pB0, pB1, t + 1, (t + 4 < NT), (t + 2 < NT), (t + 2 < NT));   ENDW(t + 1); RESC(); ROT();
    }
    STEP(pB0, pB1, pA0, pA1, NT - 1, false, false, false); RESC();
    { float sacc = pB0[0] + pB0[1]; _Pragma("unroll") for (int r = 2; r < 16; ++r) sacc += pB0[r]; _Pragma("unroll") for (int r = 0; r < 16; ++r) sacc += pB1[r]; l_reg += sacc;
      pw0 = (u32x4){PKW(pB0, 0), PKW(pB0, 2), PKW(pB0, 4), PKW(pB0, 6)}; pw1 = (u32x4){PKW(pB0, 8), PKW(pB0, 10), PKW(pB0, 12), PKW(pB0, 14)}; pw2 = (u32x4){PKW(pB1, 0), PKW(pB1, 2), PKW(pB1, 4), PKW(pB1, 6)}; pw3 = (u32x4){PKW(pB1, 8), PKW(pB1, 10), PKW(pB1, 12), PKW(pB1, 14)};
      SBAR(); pv(o, vb0 + sl_cur, PAF(0), PAF(1), PAF(2), PAF(3)); }
#undef PKW
#undef PAF
#undef VFR
#undef PIN
#undef MX3
#undef GAPA
#undef GAPB
#undef EX
#undef VRD
#undef KRD
#undef STEP
#undef ENDW
    { auto rr = __builtin_amdgcn_permlane32_swap(__float_as_uint(l_reg), __float_as_uint(l_reg), false, false); l_reg = __uint_as_float(rr[0]) + __uint_as_float(rr[1]); }
    if (hi == 0) wsf[32 + r32] = l_reg; asm volatile("s_waitcnt lgkmcnt(0)" ::: "memory");
    float rli[16];
#pragma unroll
    for (int r = 0; r < 16; ++r) rli[r] = __builtin_amdgcn_rcpf(wsf[32 + crow(r, hi)]);
    bf16* Ow = Oh + (long)(q0 + wid * QBLK) * op;
    { bf16* stg = (bf16*)(shm + LDS_OST) + wid * 2048;
#pragma unroll
      for (int r = 0; r < 16; ++r) { const int orow = crow(r, hi);
#pragma unroll
        for (int d0 = 0; d0 < 2; ++d0) stg[orow * 64 + d0 * 32 + r32] = __float2bfloat16(o[d0][r] * rli[r]); }
      asm volatile("s_waitcnt lgkmcnt(0)" ::: "memory");
#pragma unroll
      for (int i = 0; i < 4; ++i) { const int row = i * 8 + (lane >> 3), ch = lane & 7; const u32x4 v = *(const u32x4*)(stg + row * 64 + ch * 8); *(u32x4*)(Ow + (long)row * op + ch * 8) = v; } }
    asm volatile("s_waitcnt lgkmcnt(0)\n\ts_barrier" ::: "memory");
#undef DMA_K
#undef DMA_V
#undef CMASK
#undef START
#undef RESC
#undef ROT
}

constexpr int L2_K = 0, L2_V = 3 * 8192, L2_WS = L2_V + 3 * 16384, L2_OST = L2_WS + NW * 64 * 4, L2_BYTES = L2_OST + NW * 4096;
template <bool MASK> __device__ __forceinline__ void attn_unit2(int q0, int NT, const bf16* Qh, int qp, const bf16* __restrict__ Kh, int kp, const bf16* __restrict__ Vh, int vp, bf16* Oh, int op, char* shm) {
    const int tid = threadIdx.x, lane = tid & 63, r32 = lane & 31, hi = lane >> 5; const int wid = __builtin_amdgcn_readfirstlane(tid >> 6);
    const bf16* Qw = Qh + (long)(q0 + wid * QBLK) * qp;
    const unsigned lds0 = (unsigned)(uintptr_t)shm;
    float* wsf = (float*)(shm + L2_WS) + wid * 64;
    const bf16* ksrc = Kh + (long)lane * kp + wid * 8;
    const bf16* vsrc = Vh + (long)(16 * (wid & 3) + (lane >> 2)) * vp + (wid >> 2) * 32 + (lane & 3) * 8;
    const unsigned kdst = lds0 + L2_K + wid * 1024, vdst = lds0 + L2_V + wid * 1024;
#define DMA_K(t, slot) glds16(ksrc + (long)(t) * KVBLK * kp, (unsigned)__builtin_amdgcn_readfirstlane(kdst + (slot)))
#define DMA_V(t, slot) do { glds16(vsrc + (long)(t) * KVBLK * vp, (unsigned)__builtin_amdgcn_readfirstlane(vdst + 2 * (slot))); \
                            glds16(vsrc + (long)(t) * KVBLK * vp + 64, (unsigned)__builtin_amdgcn_readfirstlane(vdst + 2 * (slot) + 8192)); } while (0)
    const int vb0 = (int)(lds0 + L2_V) + ((lane >> 4) & 1) * 32 + (lane & 3) * 8 + (4 * hi + ((lane & 15) >> 2)) * 64;
    const char* Kbase = shm + L2_K; bf16x8 kf[8];
    const lds_cptr shm3 = (lds_cptr)shm; const lds_cptr kp0 = shm3 + L2_K + hi * 1024 + r32 * 16; const lds_cptr vp0 = shm3 + L2_V + ((lane >> 4) & 1) * 32 + (lane & 3) * 8 + (4 * hi + ((lane & 15) >> 2)) * 64;
    DMA_K(0, 0); DMA_V(0, 0); DMA_K(1, SLOTB);
    bf16x8 qr[4];
#pragma unroll
    for (int d0 = 0; d0 < 4; ++d0) qr[d0] = *reinterpret_cast<const bf16x8*>(&Qw[(long)r32 * qp + d0 * 16 + hi * 8]);
    float l_reg = 0.f; f32x16 o[4]; o[0] = f32x16{}; o[1] = f32x16{}; o[2] = f32x16{}; o[3] = f32x16{};
    const f32x16 zero16 = f32x16{};
#define CMASK(P0, P1, t) do { if (MASK) { int jb_ = (t) - (NT - 4); if (jb_ >= 0) cmask(P0, P1, jb_, wid); } } while (0)
    f32x16 pA0, pA1, pB0, pB1;
    int sl_prev = 0, sl_cur = 0, sl_next = SLOTB;
#define ROT() do { sl_prev = sl_cur; sl_cur = sl_next; sl_next = (sl_next == (NSLOT - 1) * SLOTB) ? 0 : sl_next + SLOTB; } while (0)
    DMA_K(2, 2 * SLOTB);
    WAIT_BAR(4);
    qkt(pA0, pA1, Kbase, qr, zero16, r32, hi); CMASK(pA0, pA1, 0);
    _Pragma("unroll") for (int r = 0; r < 16; ++r) { pA0[r] = __builtin_amdgcn_exp2f(pA0[r]); pA1[r] = __builtin_amdgcn_exp2f(pA1[r]); }
    WAIT_BAR(0);
    DMA_K(3, 0); DMA_V(1, SLOTB);
    ROT();
    kload8(kf, kp0 + sl_cur);
    WAIT_BAR(3);
    s16x4 f0lo, f0hi, f1lo, f1hi, f2lo, f2hi, f3lo, f3hi; u32x4 pw0, pw1, pw2, pw3;
#define PKW(P, B) cvtpk_s(P[B], P[B + 1])
#define PAF(k) __builtin_bit_cast(bf16x8, pw##k)
#define PIN(x) asm volatile("" : "+v"(x))
#define EX(v) __builtin_amdgcn_exp2f(v)
#define VOFF(id) ((((id) >> 2) * 4096) + (((id) & 3) * 1024))
#define VRD2(F, id) do { F##lo = vtr(vp_ + VOFF(id)); F##hi = vtr(vp_ + VOFF(id) + 512); } while (0)
#define VFR2(F) (bf16x8){F##lo[0], F##lo[1], F##lo[2], F##lo[3], F##hi[0], F##hi[1], F##hi[2], F##hi[3]}
#define GAPA(MF, A0, A1, A2, A3, W0, W1, PW) do { MF; sacc += A0; sacc += A1; sacc += A2; sacc += A3; PIN(sacc); W0; W1; PIN(PW); SBAR(); } while (0)
#define GAPB(MF, RD, X, B) do { MF; RD; X[B] = EX(X[B]); X[B + 1] = EX(X[B + 1]); PIN(X); SBAR(); } while (0)
#define KRD(G, j) do { if (G) { kload2(kf, kp0 + sl_next, j); SBAR(); } } while (0)
#define MF32(a, b, c) __builtin_amdgcn_mfma_f32_32x32x16_bf16(a, b, c, 0, 0, 0)
#define STEP(C0, C1, P0, P1, t, GK, GV, GL) do { SBAR(); \
    const lds_cptr vp_ = vp0 + 2 * sl_prev; \
    float sacc = (P0[0] + P0[1]); \
    GAPA(C0 = MF32(kf[0], qr[0], zero16), P0[2], P0[3], P0[4], P0[5],     pw0[0] = PKW(P0, 0), pw0[1] = PKW(P0, 2), pw0); \
    GAPA(C1 = MF32(kf[1], qr[0], zero16), P0[6], P0[7], P0[8], P0[9],     pw0[2] = PKW(P0, 4), pw0[3] = PKW(P0, 6), pw0); \
    GAPA(C0 = MF32(kf[2], qr[1], C0),     P0[10], P0[11], P0[12], P0[13], pw1[0] = PKW(P0, 8), pw1[1] = PKW(P0, 10), pw1); \
    GAPA(C1 = MF32(kf[3], qr[1], C1),     P0[14], P0[15], P1[0], P1[1],   pw1[2] = PKW(P0, 12), pw1[3] = PKW(P0, 14), pw1); \
    VRD2(f0, 0); SBAR();  GAPA(C0 = MF32(kf[4], qr[2], C0), P1[2], P1[3], P1[4], P1[5],     pw2[0] = PKW(P1, 0), pw2[1] = PKW(P1, 2), pw2); \
    VRD2(f1, 4); SBAR();  GAPA(C1 = MF32(kf[5], qr[2], C1), P1[6], P1[7], P1[8], P1[9],     pw2[2] = PKW(P1, 4), pw2[3] = PKW(P1, 6), pw2); \
    VRD2(f2, 8); SBAR();  GAPA(C0 = MF32(kf[6], qr[3], C0), P1[10], P1[11], P1[12], P1[13], pw3[0] = PKW(P1, 8), pw3[1] = PKW(P1, 10), pw3); \
    VRD2(f3, 12); SBAR(); GAPA(C1 = MF32(kf[7], qr[3], C1), P1[14], P1[15], 0.f, 0.f,       pw3[2] = PKW(P1, 12), pw3[3] = PKW(P1, 14), pw3); \
    l_reg += sacc; \
    if (GK) { DMA_K((t) + 3, sl_cur); } if (GV) { DMA_V((t) + 1, sl_next); } \
    CMASK(C0, C1, t); \
    SBAR(); \
    GAPB(o[0] = MF32(PAF(0), VFR2(f0), o[0]), VRD2(f0, 1),  C0, 0); \
    GAPB(o[1] = MF32(PAF(0), VFR2(f1), o[1]), VRD2(f1, 5),  C0, 2); \
    GAPB(o[2] = MF32(PAF(0), VFR2(f2), o[2]), VRD2(f2, 9),  C0, 4); \
    GAPB(o[3] = MF32(PAF(0), VFR2(f3), o[3]), VRD2(f3, 13), C0, 6); \
    KRD(GL, 0); GAPB(o[0] = MF32(PAF(1), VFR2(f0), o[0]), VRD2(f0, 2),  C0, 8); \
    GAPB(o[1] = MF32(PAF(1), VFR2(f1), o[1]), VRD2(f1, 6),  C0, 10); \
    KRD(GL, 1); GAPB(o[2] = MF32(PAF(1), VFR2(f2), o[2]), VRD2(f2, 10), C0, 12); \
    GAPB(o[3] = MF32(PAF(1), VFR2(f3), o[3]), VRD2(f3, 14), C0, 14); \
    KRD(GL, 2); GAPB(o[0] = MF32(PAF(2), VFR2(f0), o[0]), VRD2(f0, 3),  C1, 0); \
    GAPB(o[1] = MF32(PAF(2), VFR2(f1), o[1]), VRD2(f1, 7),  C1, 2); \
    KRD(GL, 3); GAPB(o[2] = MF32(PAF(2), VFR2(f2), o[2]), VRD2(f2, 11), C1, 4); \
    GAPB(o[3] = MF32(PAF(2), VFR2(f3), o[3]), VRD2(f3, 15), C1, 6); \
    GAPB(o[0] = MF32(PAF(3), VFR2(f0), o[0]), (void)0, C1, 8); \
    GAPB(o[1] = MF32(PAF(3), VFR2(f1), o[1]), (void)0, C1, 10); \
    GAPB(o[2] = MF32(PAF(3), VFR2(f2), o[2]), (void)0, C1, 12); \
    GAPB(o[3] = MF32(PAF(3), VFR2(f3), o[3]), (void)0, C1, 14); \
    } while (0)
    int t = 1;
#undef CMASK
#define CMASK(P0, P1, t) do {} while (0)
    for (; t + 5 < NT; t += 2) {
        STEP(pB0, pB1, pA0, pA1, t, true, true, true);     WAIT_BAR(3); ROT();
        STEP(pA0, pA1, pB0, pB1, t + 1, true, true, true); WAIT_BAR(3); ROT();
    }
#undef CMASK
#define CMASK(P0, P1, t) do { if (MASK) { int jb_ = (t) - (NT - 4); if (jb_ >= 0) cmask(P0, P1, jb_, wid); } } while (0)
#define ENDW(tt) do { if ((tt) + 3 < NT) { WAIT_BAR(3); } else if ((tt) + 2 < NT) { WAIT_BAR(2); } else { WAIT_BAR(0); } } while (0)
    for (; t + 1 < NT; t += 2) {
        STEP(pB0, pB1, pA0, pA1, t, (t + 3 < NT), (t + 1 < NT), (t + 1 < NT));       ENDW(t);     ROT();
        STEP(pA0, pA1, pB0, pB1, t + 1, (t + 4 < NT), (t + 2 < NT), (t + 2 < NT));   ENDW(t + 1); ROT();
    }
    STEP(pB0, pB1, pA0, pA1, NT - 1, false, false, false);
    { float sacc = pB0[0] + pB0[1]; _Pragma("unroll") for (int r = 2; r < 16; ++r) sacc += pB0[r]; _Pragma("unroll") for (int r = 0; r < 16; ++r) sacc += pB1[r]; l_reg += sacc;
      pw0 = (u32x4){PKW(pB0, 0), PKW(pB0, 2), PKW(pB0, 4), PKW(pB0, 6)}; pw1 = (u32x4){PKW(pB0, 8), PKW(pB0, 10), PKW(pB0, 12), PKW(pB0, 14)}; pw2 = (u32x4){PKW(pB1, 0), PKW(pB1, 2), PKW(pB1, 4), PKW(pB1, 6)}; pw3 = (u32x4){PKW(pB1, 8), PKW(pB1, 10), PKW(pB1, 12), PKW(pB1, 14)};
      SBAR();
      const lds_cptr vp_ = vp0 + 2 * sl_cur;
#pragma unroll
      for (int db = 0; db < 4; ++db) { VRD2(f0, db * 4 + 0); VRD2(f1, db * 4 + 1); VRD2(f2, db * 4 + 2); VRD2(f3, db * 4 + 3);
          o[db] = MF32(PAF(0), VFR2(f0), o[db]); o[db] = MF32(PAF(1), VFR2(f1), o[db]); o[db] = MF32(PAF(2), VFR2(f2), o[db]); o[db] = MF32(PAF(3), VFR2(f3), o[db]); } }
#undef PKW
#undef PAF
#undef PIN
#undef EX
#undef VOFF
#undef VRD2
#undef VFR2
#undef GAPA
#undef GAPB
#undef KRD
#undef MF32
#undef STEP
#undef ENDW
    { auto rr = __builtin_amdgcn_permlane32_swap(__float_as_uint(l_reg), __float_as_uint(l_reg), false, false); l_reg = __uint_as_float(rr[0]) + __uint_as_float(rr[1]); }
    if (hi == 0) wsf[32 + r32] = l_reg; asm volatile("s_waitcnt lgkmcnt(0)" ::: "memory");
    float rli[16];
#pragma unroll
    for (int r = 0; r < 16; ++r) rli[r] = __builtin_amdgcn_rcpf(wsf[32 + crow(r, hi)]);
    bf16* Ow = Oh + (long)(q0 + wid * QBLK) * op;
    { bf16* stg = (bf16*)(shm + L2_OST) + wid * 2048;
#pragma unroll
      for (int dh = 0; dh < 2; ++dh) {
#pragma unroll
        for (int r = 0; r < 16; ++r) { const int orow = crow(r, hi);
#pragma unroll
          for (int d0 = 0; d0 < 2; ++d0) stg[orow * 64 + d0 * 32 + r32] = __float2bfloat16(o[dh * 2 + d0][r] * rli[r]); }
        asm volatile("s_waitcnt lgkmcnt(0)" ::: "memory");
#pragma unroll
        for (int i = 0; i < 4; ++i) { const int row = i * 8 + (lane >> 3), ch = lane & 7; const u32x4 v = *(const u32x4*)(stg + row * 64 + ch * 8); *(u32x4*)(Ow + (long)row * op + dh * 64 + ch * 8) = v; }
        asm volatile("s_waitcnt lgkmcnt(0)" ::: "memory"); } }
    asm volatile("s_waitcnt lgkmcnt(0)\n\ts_barrier" ::: "memory");
#undef DMA_K
#undef DMA_V
#undef CMASK
#undef ROT
}
#undef SBAR
#undef WAIT_BAR
}

#define XB_TMO      128
#define XB_XCNT(j)  (256  + 64 * (j))
#define XB_XSUB(j)  (1280 + 64 * (j))
#define XB_XGEN(j)  (2304 + 64 * (j))
#define XB_TOP      3328
#define XB_TOPGEN   3392
#define XCD_BAR_WORDS 3456
#define XB_SPIN_CAP (1u << 22)
__device__ __forceinline__ unsigned xb_ld(unsigned* p)              { return __hip_atomic_load(p, __ATOMIC_RELAXED, __HIP_MEMORY_SCOPE_AGENT); }
__device__ __forceinline__ unsigned xb_add(unsigned* p, unsigned v) { return __hip_atomic_fetch_add(p, v, __ATOMIC_RELAXED, __HIP_MEMORY_SCOPE_AGENT); }
__device__ __forceinline__ unsigned xb_xcc_id() { return (unsigned)__builtin_amdgcn_s_getreg((3 << 11) | 20) & 0xFu; }
#define XB_SPIN(cond, bar) do { unsigned _sp = 0; while (cond) { __builtin_amdgcn_s_sleep(1); \
    if ((++_sp & 255u) == 0u) { if (xb_ld(&(bar)[XB_TMO])) break; if (_sp > XB_SPIN_CAP) { atomicAdd(&(bar)[XB_TMO], 1u); break; } } } } while (0)
struct XcdBarrier { unsigned* bar; unsigned x; volatile LAS unsigned* st; };
__device__ __forceinline__ XcdBarrier xcd_barrier_post(unsigned* bar, volatile LAS unsigned* st) {
    XcdBarrier b; b.bar = bar; b.x = xb_xcc_id(); b.st = st;
    if (threadIdx.x == 0) (void)xb_add(&bar[XB_XCNT(b.x)], 1u);
    return b;
}
__device__ __forceinline__ void xcd_barrier_complete(unsigned* bar, unsigned x, unsigned& nloc, unsigned& nx) {
    const unsigned G = gridDim.x * gridDim.y * gridDim.z;
    unsigned sum, cnt, mine, sp = 0u;
    for (;;) {
        sum = 0u; cnt = 0u; mine = 0u;
#pragma unroll
        for (unsigned j = 0; j < 16; ++j) { const unsigned c = xb_ld(&bar[XB_XCNT(j)]); sum += c; cnt += (c > 0u) ? 1u : 0u; mine = (j == x) ? c : mine; }
        if (sum == G) break;
        __builtin_amdgcn_s_sleep(1);
        if ((++sp & 255u) == 0u) { if (xb_ld(&bar[XB_TMO])) break; if (sp > XB_SPIN_CAP) { atomicAdd(&bar[XB_TMO], 1u); break; } }
    }
    nloc = mine > 0u ? mine : 1u; nx = cnt > 0u ? cnt : 1u;
}
__device__ __forceinline__ void xcd_barrier(const XcdBarrier& b) {
    asm volatile("s_waitcnt vmcnt(0)" ::: "memory");
    __syncthreads();
    if (threadIdx.x == 0) {
        unsigned* bar = b.bar;
        __builtin_amdgcn_s_waitcnt(0);
        unsigned nloc = b.st[0], nx = b.st[1];
        if (nloc == 0u) { xcd_barrier_complete(bar, b.x, nloc, nx); b.st[0] = nloc; b.st[1] = nx; }
        const unsigned old = xb_add(&bar[XB_XSUB(b.x)], 1u);
        const unsigned gen = old / nloc;
        if (old + 1u == (gen + 1u) * nloc) {
            __builtin_amdgcn_fence(__ATOMIC_RELEASE, "agent");
            asm volatile("s_waitcnt vmcnt(0)" ::: "memory");
            const unsigned og = xb_add(&bar[XB_TOP], 1u);
            const unsigned tg = og / nx;
            if (og + 1u == (tg + 1u) * nx) xb_add(&bar[XB_TOPGEN], 1u);
            else XB_SPIN(xb_ld(&bar[XB_TOPGEN]) == tg, bar);
            __builtin_amdgcn_fence(__ATOMIC_ACQUIRE, "agent");
            xb_add(&bar[XB_XGEN(b.x)], 1u);
            asm volatile("s_waitcnt vmcnt(0)" ::: "memory");
        } else {
            XB_SPIN(xb_ld(&bar[XB_XGEN(b.x)]) == gen, bar);
            __builtin_amdgcn_fence(__ATOMIC_ACQUIRE, "agent");
            asm volatile("s_waitcnt vmcnt(0)" ::: "memory");
        }
    }
    __syncthreads();
}

constexpr int RING_BYTES = 131072;
constexpr int MISC_OFF = RING_BYTES;
constexpr int LDS_BYTES = 147456;
constexpr int NWAVES = 8;

struct Args {
    const float* in[29]; float* out; unsigned char* ws; int ph_lo, ph_hi;
};
enum { I_X = 0, I_MEM, I_NORM1, I_WIN, I_BGATE, I_QN, I_KN, I_LQ1, I_LK1, I_LQ2, I_LK2, I_SUBLN, I_WPOOL, I_PSCALE, I_MEMNORM, I_WMKV, I_MQN, I_MKN, I_WBRD, I_WBRP, I_WBRM, I_WOUT, I_NORM2,
       I_WROUTER, I_BROUTER, I_WGU, I_BGU, I_WD, I_BD };

__device__ __forceinline__ unsigned f2bf(float f) { unsigned u = __builtin_bit_cast(unsigned, f); return (u + 0x7fffu + ((u >> 16) & 1u)) >> 16; }
__device__ __forceinline__ unsigned pk2(float lo, float hi) { return f2bf(lo) | (f2bf(hi) << 16); }
__device__ __forceinline__ void p0_transpose_item(const float* W, int K, int N, bf16_t* WT, LAS float* scr, int item, int lane, int ldo = 0) {
    if (ldo == 0) ldo = K;
    const int nblk = N / 64, kb = item / nblk, nb = item % nblk, k0 = 64 * kb, n0 = 64 * nb;
    const int kr = lane >> 3, n4 = (lane & 7) * 4;
    f32x4 v[16];
#pragma unroll
    for (int i = 0; i < 16; ++i) v[i] = *(const f32x4*)(W + (size_t)(k0 + 8 * (i & 7) + kr) * N + n0 + 32 * (i >> 3) + n4);
#pragma unroll
    for (int h = 0; h < 2; ++h) {
#pragma unroll
        for (int i = 0; i < 8; ++i)
#pragma unroll
            for (int j = 0; j < 4; ++j) scr[(n4 + j) * 68 + 8 * i + kr] = v[h * 8 + i][j];
        LDS_WAIT(); asm volatile("" ::: "memory");
        const int c = lane & 7;
#pragma unroll
        for (int jj = 0; jj < 4; ++jj) { const int nrow = 8 * jj + (lane >> 3); const LAS f32x4* sp = (const LAS f32x4*)(scr + nrow * 68 + 8 * c);
            const f32x4 a = sp[0], b = sp[1];
            u32x4 o; o.x = pk2(a[0], a[1]); o.y = pk2(a[2], a[3]); o.z = pk2(b[0], b[1]); o.w = pk2(b[2], b[3]);
            *(u32x4*)(WT + (size_t)(n0 + 32 * h + nrow) * ldo + k0 + 8 * c) = o; }
        LDS_WAIT(); asm volatile("" ::: "memory");
    }
}
__device__ __forceinline__ void rms_row_to_bf16(const float* xrow, const float* gain, bf16_t* orow, int lane) {
    const f32x4* xr = (const f32x4*)xrow + lane; const f32x4* gr = (const f32x4*)gain + lane;
    f32x4 v[4]; float s = 0.f;
#pragma unroll
    for (int j = 0; j < 4; ++j) { v[j] = xr[64 * j]; s += (v[j].x * v[j].x + v[j].y * v[j].y) + (v[j].z * v[j].z + v[j].w * v[j].w); }
    const float rstd = 1.f / sqrtf(wave_sum(s) * (1.f / 1024.f) + RMS_EPS);
    u32x2* o8 = (u32x2*)orow + lane;
#pragma unroll
    for (int j = 0; j < 4; ++j) { const f32x4 g = gr[64 * j]; u32x2 w; w.x = pk2(v[j].x * rstd * g.x, v[j].y * rstd * g.y); w.y = pk2(v[j].z * rstd * g.z, v[j].w * rstd * g.w); o8[64 * j] = w; }
}

struct Args;
typedef __attribute__((address_space(4))) const Args* kargs_t;
__device__ __forceinline__ kargs_t kargs() { kargs_t p = (kargs_t)__builtin_amdgcn_kernarg_segment_ptr(); asm volatile("" : "+s"(p)); return p; }
__global__ void __launch_bounds__(NWAVES * 64, 2) fwd_kernel(Args args) {
    extern __shared__ __attribute__((aligned(16))) unsigned char lds_raw[];
    cg::grid_group grid = cg::this_grid();
    LAS unsigned char* lds = (LAS unsigned char*)lds_raw;
    const int tid = threadIdx.x, lane = tid & 63, wave = __builtin_amdgcn_readfirstlane(tid >> 6);
    const int G = gridDim.x, bx = blockIdx.x; const int vcu = (G % 8 == 0) ? (bx % 8) * (G / 8) + bx / 8 : bx;
    const int gw = vcu * NWAVES + wave, NGW = G * NWAVES;
    const int lo = args.ph_lo, hi = args.ph_hi;
    if (tid < 64) ((LAS unsigned*)(lds + MISC_OFF + 1024))[tid] = 0u;
    __syncthreads();
    const XcdBarrier xbar = xcd_barrier_post((unsigned*)(args.ws + WS_CTL) + CW_BAR, (volatile LAS unsigned*)(lds + MISC_OFF + 1024));
#ifndef PHMASK
#define PHMASK 0x3ff
#endif
#define IN(k) (((PHMASK >> (k)) & 1) && lo <= (k) && (k) < hi)
#define GSYNC() do { asm volatile("s_waitcnt vmcnt(0) lgkmcnt(0)" ::: "memory"); __syncthreads(); grid.sync(); asm volatile("s_waitcnt vmcnt(0)" ::: "memory"); __syncthreads(); } while (0)
#define SEAM(k) do { if (lo <= (k) && (k) + 1 < hi) { xcd_barrier(xbar); } } while (0)
#define WSP(TY, off) ((TY*)(ka->ws + (off)))
#define WIN_T WSP(bf16_t, WS_WIN_T)
#define WBRD_T WSP(bf16_t, WS_WBRD_T)
#define WBRP_T WSP(bf16_t, WS_WBRP_T)
#define WBRM_T WSP(bf16_t, WS_WBRM_T)
#define WOUT_T WSP(bf16_t, WS_WOUT_T)
#define WMKV_T WSP(bf16_t, WS_WMKV_T)
#define WGU_T WSP(bf16_t, WS_WGU_T)
#define WD_T WSP(bf16_t, WS_WD_T)
#define XN WSP(bf16_t, WS_XN)
#define Qb WSP(bf16_t, WS_Q)
#define Kb WSP(bf16_t, WS_K)
#define Vb WSP(bf16_t, WS_V)
#define Ub WSP(bf16_t, WS_U)
#define MQb WSP(bf16_t, WS_MQ)
#define OC WSP(bf16_t, WS_OC)
#define GATES WSP(bf16_t, WS_GATES)
#define YCAT WSP(bf16_t, WS_YCAT)
#define MERGF WSP(float, WS_MERGF)
#define MERGB WSP(bf16_t, WS_MERGB)
#define XG WSP(bf16_t, WS_XG)
#define ACT WSP(bf16_t, WS_A)
#define Y4 WSP(bf16_t, WS_B)
#define MEMN WSP(bf16_t, WS_MEMN)
#define MKV WSP(bf16_t, WS_MKV)
#define ROPE WSP(f32x2, WS_ROPE)
#define WR2 WSP(float, WS_WR2)
#define ROUTEW WSP(float, WS_ROUTEW)
#define LAMP WSP(float, WS_LAM)
#define LIST WSP(u32x2, WS_LIST)
#define CNT WSP(unsigned, WS_CTL)
#define OUT (ka->out)
#define KA const kargs_t ka = kargs()

    if (lo > 1000) GSYNC();
    if (IN(0)) for (int rep_ = 0; rep_ < 1 + ((REPEAT_MASK >> 0) & 1); ++rep_) { KA; if (rep_) __syncthreads();
        LAS float* scr = (LAS float*)(lds + wave * 16384);
        constexpr int I0 = 16 * 80, I1 = 8 * 16, I2 = 4 * 16, I3 = 4 * 16, I4 = 16 * 16, I5 = 16 * 8, I6 = 32 * 512, I7 = 32 * 256;
        constexpr int NITEMS = I0 + I1 + I2 + I3 + I4 + I5 + I6 + I7;
        for (int it = gw; it < NITEMS; it += NGW) {
            int r = it;
            if (r < I0) { p0_transpose_item(ka->in[I_WIN], 1024, 5120, WIN_T, scr, r, lane); continue; } r -= I0;
            if (r < I1) { p0_transpose_item(ka->in[I_WBRD], 512, 1024, WBRD_T, scr, r, lane, 1024); continue; } r -= I1;
            if (r < I2) { p0_transpose_item(ka->in[I_WBRP], 256, 1024, WBRD_T + 512, scr, r, lane, 1024); continue; } r -= I2;
            if (r < I3) { p0_transpose_item(ka->in[I_WBRM], 256, 1024, WBRD_T + 768, scr, r, lane, 1024); continue; } r -= I3;
            if (r < I4) { p0_transpose_item(ka->in[I_WOUT], 1024, 1024, WOUT_T, scr, r, lane); continue; } r -= I4;
            if (r < I5) { p0_transpose_item(ka->in[I_WMKV], 1024, 512, WMKV_T, scr, r, lane); continue; } r -= I5;
            if (r < I6) { const int e = r >> 9; p0_transpose_item(ka->in[I_WGU] + (size_t)e * 1024 * 2048, 1024, 2048, WGU_T + (size_t)e * 2048 * 1024, scr, r & 511, lane); continue; } r -= I6;
            { const int e = r >> 8; p0_transpose_item(ka->in[I_WD] + (size_t)e * 1024 * 1024, 1024, 1024, WD_T + (size_t)e * 1024 * 1024, scr, r & 255, lane); }
        }
        for (int m = gw; m < T; m += NGW) rms_row_to_bf16(ka->in[I_X] + (size_t)m * 1024, ka->in[I_NORM1], XN + (size_t)m * 1024, lane);
        for (int m = gw; m < BATCH * MEMLEN; m += NGW) rms_row_to_bf16(ka->in[I_MEM] + (size_t)m * 1024, ka->in[I_MEMNORM], MEMN + (size_t)m * 1024, lane);
        for (int i = bx * 512 + tid; i < SEQ * 32; i += G * 512) { const int pos = i >> 5, j = i & 31;
            const float inv = 1.0f / powf(10000.0f, (float)(2 * j) / 64.0f); const float ang = (float)pos * inv;
            const double a = (double)ang; const double k = rint(a * 0.15915494309189535); const float red = (float)(a - k * 6.283185307179586);
            ROPE[i] = (f32x2){cosf(red), sinf(red)}; }
        for (int i = bx * 512 + tid; i < 1024 * 32; i += G * 512) { const int ii = i & 3, e = (i >> 2) & 15, kq = (i >> 6) & 3, eb = (i >> 8) & 1, s = i >> 9; const int k = 16 * s + 4 * kq + ii;
            WR2[i] = ka->in[I_NORM2][k] * ka->in[I_WROUTER][k * 32 + eb * 16 + e]; }
        if (bx == 0 && wave == 0) { const float s1 = wave_sum(ka->in[I_LQ1][lane] * ka->in[I_LK1][lane]), s2 = wave_sum(ka->in[I_LQ2][lane] * ka->in[I_LK2][lane]);
            if (lane == 0) LAMP[0] = expf(s1) - expf(s2) + 0.2f; }
    }
    SEAM(0);
    if (IN(1)) for (int rep_ = 0; rep_ < 1 + ((REPEAT_MASK >> 1) & 1); ++rep_) { KA; if (rep_) __syncthreads();
#if defined(TAP) && TAP == 6
        { pg8::DenseProb P{XN, WIN_T, 1024, 1024, 1024}; pg8::StaticOrder S; S.init(T, INW, G, bx);
          pg8::EpiPlain E{WSP(bf16_t, WS_B), 5120};
          pg8::gemm_phase<pg8::EpiPlain, pg8::DenseProb, pg8::StaticOrder, true>(lds, P, S, E); }
#else
        { pg8::DenseProb P{XN, WIN_T, 1024, 1024, 1024}; pg8::StaticOrder S0; S0.init(T, INW, G, bx); const pg8::TableOrder S = pg8::build_unit_table(S0, (LAS int*)(lds + MISC_OFF + 2048));
          pg8::EpiInProj E{Qb, Kb, Vb, Ub, MQb, GATES, ka->in[I_QN], ka->in[I_KN], ka->in[I_MQN], ka->in[I_BGATE], ROPE};
          pg8::gemm_phase<pg8::EpiInProj, pg8::DenseProb, pg8::TableOrder, true>(lds, P, S, E); }
#endif
        { pg8::DenseProb P{MEMN, WMKV_T, 1024, 1024, 1024}; pg8::StaticOrder S; S.init(BATCH * MEMLEN, 512, G, bx);
          pg8::EpiMemKV E{MKV, ka->in[I_MKN]};
          pg8::gemm_phase<pg8::EpiMemKV, pg8::DenseProb, pg8::StaticOrder, true>(lds, P, S, E); }
    }
    SEAM(1);
    if (IN(2)) for (int rep_ = 0; rep_ < 1 + ((REPEAT_MASK >> 2) & 1); ++rep_) { KA; if (rep_) __syncthreads();
        using abf = attn_body::bf16;
        {
            const int bhc = vcu >> 3, b = bhc >> 3, h = (bhc >> 1) & 3, c = bhc & 1, s = vcu & 7;
            for (int i2 = 0; i2 < 4 * (1 + ((REPEAT_MASK >> 10) & 1)); ++i2) { const int ii = i2 & 3; const int qb = (ii == 0) ? s : (ii == 1) ? 15 - s : (ii == 2) ? 16 + s : 31 - s;
                const size_t rb = (size_t)b * SEQ;
                attn_body::attn_unit2<true>(qb * 256, 4 * qb + 4, (const abf*)Qb + rb * 512 + (c * 4 + h) * 64, 512, (const abf*)Kb + rb * 512 + (c * 4 + h) * 64, 512,
                                            (const abf*)Vb + rb * 512 + h * 128, 512, (abf*)OC + rb * 1024 + (c * 4 + h) * 128, 1024, (char*)lds_raw); }
        }
        {
            for (int i = 0; i < 2; ++i) { const int idx = vcu * 2 + i; if (idx >= 512) break; const int b = idx >> 7, h = (idx >> 5) & 3, qb = idx & 31;
                attn_body::attn_unit<8, false>(qb * 256, 4, (const abf*)MQb + (size_t)b * SEQ * 256 + h * 64, 256, (const abf*)MKV + (size_t)b * MEMLEN * 512 + h * 64, 512,
                                               (const abf*)MKV + (size_t)b * MEMLEN * 512 + 256 + h * 64, 512, (abf*)YCAT + (size_t)b * SEQ * 1024 + 768 + h * 64, 1024, (char*)lds_raw); }
        }
        {
            LAS bf16_t* ul = (LAS bf16_t*)lds;
            LAS float* pt = (LAS float*)(lds + 24576);
            const int col = tid & 255, half = tid >> 8, g = col >> 6, dd = col & 63, w = 2 << g;
            float wreg[64];
#pragma unroll
            for (int cc = 0; cc < 64; ++cc) wreg[cc] = ka->in[I_WPOOL][(g * 64 + cc) * 64 + dd];
            const float psc = ka->in[I_PSCALE][col];
            for (int tile = vcu; tile < T / 32; tile += G) {
                const int t0 = tile * 32, p0 = t0 & (SEQ - 1);
                __syncthreads();
                for (int pc = tid; pc < 47 * 32; pc += 512) { const int r = pc >> 5, ch = pc & 31; const int pos = p0 - 15 + r;
                    u32x4 v = {0u, 0u, 0u, 0u}; if (pos >= 0) v = *(const u32x4*)(Ub + (size_t)(t0 - 15 + r) * 256 + ch * 8);
                    *(LAS u32x4*)(ul + r * 256 + ch * 8) = v; }
                __syncthreads();
                {
                    float sum = 0.f; const int rbase = 15 + 16 * half;
                    for (int i = 1; i < w; ++i) sum += __uint_as_float((unsigned)ul[(rbase - i) * 256 + col] << 16);
                    float pl[16];
#pragma unroll
                    for (int tk = 0; tk < 16; ++tk) { const float ucur = __uint_as_float((unsigned)ul[(rbase + tk) * 256 + col] << 16); sum += ucur;
                        const int pos = p0 + 16 * half + tk; const float cnt = (float)((pos + 1 < w) ? pos + 1 : w);
                        pl[tk] = sum / cnt - ucur;
                        sum -= __uint_as_float((unsigned)ul[(rbase + tk - (w - 1)) * 256 + col] << 16); }
#pragma unroll
                    for (int q4 = 0; q4 < 4; ++q4) *(LAS f32x4*)(pt + col * 36 + half * 16 + q4 * 4) = (f32x4){pl[4 * q4], pl[4 * q4 + 1], pl[4 * q4 + 2], pl[4 * q4 + 3]};
                }
                __syncthreads();
                float acc[16];
#pragma unroll
                for (int tk = 0; tk < 16; ++tk) acc[tk] = 0.f;
#pragma unroll
                for (int cc = 0; cc < 64; ++cc) { const LAS f32x4* pp = (const LAS f32x4*)(pt + (g * 64 + cc) * 36 + half * 16);
#pragma unroll
                    for (int q4 = 0; q4 < 4; ++q4) { const f32x4 p = pp[q4]; acc[4 * q4] += p[0] * wreg[cc]; acc[4 * q4 + 1] += p[1] * wreg[cc]; acc[4 * q4 + 2] += p[2] * wreg[cc]; acc[4 * q4 + 3] += p[3] * wreg[cc]; } }
#pragma unroll
                for (int tk = 0; tk < 16; ++tk) YCAT[(size_t)(t0 + 16 * half + tk) * 1024 + 512 + col] = (bf16_t)f2bf(acc[tk] * psc);
            }
            __syncthreads();
        }
    }
    SEAM(2);
    if (IN(3)) for (int rep_ = 0; rep_ < 1 + ((REPEAT_MASK >> 3) & 1); ++rep_) { KA; if (rep_) __syncthreads();
        const float lam = LAMP[0]; const int h = lane >> 4, d8 = (lane & 15) * 8;
        const f32x4 s0 = *(const f32x4*)(ka->in[I_SUBLN] + d8), s1 = *(const f32x4*)(ka->in[I_SUBLN] + d8 + 4);
        for (int m = gw; m < T; m += NGW) {
            const u32x4 a = *(const u32x4*)(OC + (size_t)m * 1024 + h * 128 + d8), b = *(const u32x4*)(OC + (size_t)m * 1024 + (4 + h) * 128 + d8);
            f32x4 y0 = {bf_lo(a.x) - lam * bf_lo(b.x), bf_hi(a.x) - lam * bf_hi(b.x), bf_lo(a.y) - lam * bf_lo(b.y), bf_hi(a.y) - lam * bf_hi(b.y)};
            f32x4 y1 = {bf_lo(a.z) - lam * bf_lo(b.z), bf_hi(a.z) - lam * bf_hi(b.z), bf_lo(a.w) - lam * bf_lo(b.w), bf_hi(a.w) - lam * bf_hi(b.w)};
            float ss = 0.f;
#pragma unroll
            for (int j = 0; j < 4; ++j) ss += y0[j] * y0[j] + y1[j] * y1[j];
            ss += __shfl_xor(ss, 1); ss += __shfl_xor(ss, 2); ss += __shfl_xor(ss, 4); ss += __shfl_xor(ss, 8);
            const float rstd = 0.8f / sqrtf(ss * (1.0f / 128.0f) + RMS_EPS);
            pg8::store8(YCAT + (size_t)m * 1024 + h * 128 + d8, y0 * rstd * s0, y1 * rstd * s1);
        }
    }
    SEAM(3);
    if (IN(4)) for (int rep_ = 0; rep_ < 1 + ((REPEAT_MASK >> 4) & 1); ++rep_) { KA; if (rep_) __syncthreads();
        pg8::StaticOrder S0; S0.init(T, 1024, G, bx); const pg8::TableOrder S = pg8::build_unit_table(S0, (LAS int*)(lds + MISC_OFF + 2048));
        pg8::DenseProb P{YCAT, WBRD_T, 1024, 1024, 1024}; pg8::EpiMergeR E{GATES, MERGB};
        pg8::gemm_phase<pg8::EpiMergeR, pg8::DenseProb, pg8::TableOrder, true>(lds, P, S, E);
    }
    SEAM(4);
    if (IN(5)) for (int rep_ = 0; rep_ < 1 + ((REPEAT_MASK >> 5) & 1); ++rep_) { KA; if (rep_) __syncthreads();
        pg8::DenseProb P{MERGB, WOUT_T, 1024, 1024, 1024}; pg8::StaticOrder S0; S0.init(T, 1024, G, bx); const pg8::TableOrder S = pg8::build_unit_table(S0, (LAS int*)(lds + MISC_OFF + 2048));
        pg8::EpiWout E{ka->in[I_X], OUT, XG, ka->in[I_NORM2]};
        pg8::gemm_phase<pg8::EpiWout, pg8::DenseProb, pg8::TableOrder, true>(lds, P, S, E);
    }
    SEAM(5);
    if (IN(6)) { KA;
        LAS int* lcnt = (LAS int*)(lds + MISC_OFF); LAS int* lbase = lcnt + 32;
        const int ngroups = T / 16, rounds = (ngroups + NGW - 1) / NGW;
        for (int rd = 0; rd < rounds; ++rd) {
            const int grp = rd * NGW + gw; const bool valid = grp < ngroups;
            if (tid < 32) lcnt[tid] = 0;
            __syncthreads();
            int e_sel = 0, rank = 0; float w_sel = 0.f, rstd = 0.f; const int q = lane >> 4, tok = grp * 16 + (lane & 15);
            if (valid) {
                f32x4 d0 = {0.f, 0.f, 0.f, 0.f}, d1 = {0.f, 0.f, 0.f, 0.f}; float ss = 0.f;
                const float* xrow = OUT + (size_t)tok * 1024 + 4 * q; const f32x4* wr2 = (const f32x4*)WR2 + lane;
#pragma unroll 4
                for (int s = 0; s < 64; ++s) { const f32x4 xv = *(const f32x4*)(xrow + 16 * s); const f32x4 wa = wr2[(s * 2) * 64], wb = wr2[(s * 2 + 1) * 64];
                    ss += (xv[0] * xv[0] + xv[1] * xv[1]) + (xv[2] * xv[2] + xv[3] * xv[3]);
#pragma unroll
                    for (int j = 0; j < 4; ++j) { d0 = __builtin_amdgcn_mfma_f32_16x16x4f32(wa[j], xv[j], d0, 0, 0, 0); d1 = __builtin_amdgcn_mfma_f32_16x16x4f32(wb[j], xv[j], d1, 0, 0, 0); } }
                ss += __shfl_xor(ss, 16); ss += __shfl_xor(ss, 32);
                rstd = 1.0f / sqrtf(ss * (1.0f / 1024.f) + RMS_EPS);
                unsigned key[8];
#pragma unroll
                for (int r = 0; r < 8; ++r) { const int e = (r >> 2) * 16 + 4 * q + (r & 3); const float lg = ((r < 4) ? d0[r & 3] : d1[r & 3]) * rstd + ka->in[I_BROUTER][e];
                    unsigned u = __float_as_uint(lg); u ^= (u >> 31) ? 0xffffffffu : 0x80000000u; key[r] = (u & ~31u) | (unsigned)(31 - e); }
                unsigned win[4];
#pragma unroll
                for (int r = 0; r < 4; ++r) { unsigned m = key[0];
#pragma unroll
                    for (int j = 1; j < 8; ++j) m = m > key[j] ? m : key[j];
                    unsigned o = (unsigned)__shfl_xor((int)m, 16); m = m > o ? m : o; o = (unsigned)__shfl_xor((int)m, 32); m = m > o ? m : o; win[r] = m;
#pragma unroll
                    for (int j = 0; j < 8; ++j) key[j] = (key[j] == m) ? 0u : key[j]; }
                float val[4];
#pragma unroll
                for (int r = 0; r < 4; ++r) { unsigned u = win[r] & ~31u; u ^= (u >> 31) ? 0x80000000u : 0xffffffffu; val[r] = __uint_as_float(u); }
                const float p1 = expf(val[1] - val[0]), p2 = expf(val[2] - val[0]), p3 = expf(val[3] - val[0]); const float inv = 1.0f / (1.0f + p1 + p2 + p3);
                const unsigned wk = (q == 0) ? win[0] : (q == 1) ? win[1] : (q == 2) ? win[2] : win[3];
                w_sel = ((q == 0) ? 1.0f : (q == 1) ? p1 : (q == 2) ? p2 : p3) * inv; e_sel = 31 - (int)(wk & 31u);
                rank = __hip_atomic_fetch_add((int*)(lcnt + e_sel), 1, __ATOMIC_RELAXED, __HIP_MEMORY_SCOPE_WORKGROUP);
            }
            __syncthreads();
            if (tid < 32) lbase[tid] = (int)__hip_atomic_fetch_add(CNT + 64 * tid, (unsigned)lcnt[tid], __ATOMIC_RELAXED, __HIP_MEMORY_SCOPE_AGENT);
            __syncthreads();
            if (valid) { const int pos = lbase[e_sel] + rank; LIST[(size_t)e_sel * CAP + pos] = (u32x2){(unsigned)(tok * 4 + q), __float_as_uint(rstd)}; ROUTEW[tok * 4 + q] = w_sel; }
            __syncthreads();
        }
    }
    SEAM(6);
    if (IN(7) || IN(8)) { KA;
        LAS int* tp = (LAS int*)(lds + MISC_OFF + 256); LAS int* cn = tp + 40;
        if (tid == 0) { int acc = 0; for (int e = 0; e < NEXP; ++e) { const int c = (int)__hip_atomic_load(CNT + 64 * e, __ATOMIC_RELAXED, __HIP_MEMORY_SCOPE_AGENT); cn[e] = c; tp[e] = acc; acc += (c + 255) >> 8; } tp[NEXP] = acc; }
        __syncthreads();
        if (IN(7)) for (int rep_ = 0; rep_ < 1 + ((REPEAT_MASK >> 7) & 1); ++rep_) {
            pg8::GuProb P{XG, WGU_T, LIST, 1024, 1024, 1024}; pg8::GroupedOrder S0{tp, cn, 8, G, bx}; const pg8::TableOrder S = pg8::build_unit_table(S0, (LAS int*)(lds + MISC_OFF + 2048));
            pg8::EpiSwiglu E{ACT, LIST, ka->in[I_BGU]};
            pg8::gemm_phase<pg8::EpiSwiglu, pg8::GuProb, pg8::TableOrder, true>(lds, P, S, E);
        }
        SEAM(7);
        if (IN(8)) for (int rep_ = 0; rep_ < 1 + ((REPEAT_MASK >> 8) & 1); ++rep_) {
            pg8::DownProb P{ACT, WD_T, 1024, 1024, 1024}; pg8::GroupedOrder S0{tp, cn, 4, G, bx}; const pg8::TableOrder S = pg8::build_unit_table(S0, (LAS int*)(lds + MISC_OFF + 2048));
            pg8::EpiDown E{Y4, LIST, ka->in[I_BD]};
            pg8::gemm_phase<pg8::EpiDown, pg8::DownProb, pg8::TableOrder, true>(lds, P, S, E);
        }
    }
    SEAM(8);
    if (IN(9)) { KA;
        for (int i = bx * 512 + tid; i < T * 128; i += G * 512) { const int tok = i >> 7, c8 = (i & 127) * 8;
            const f32x4 w = *(const f32x4*)(ROUTEW + tok * 4); float* op = OUT + (size_t)tok * 1024 + c8;
            f32x4 o0 = *(const f32x4*)op, o1 = *(const f32x4*)(op + 4);
#pragma unroll
            for (int k = 0; k < 4; ++k) { const u32x4 y = *(const u32x4*)(Y4 + ((size_t)tok * 4 + k) * 1024 + c8); const float wk = w[k];
                o0[0] += wk * bf_lo(y.x); o0[1] += wk * bf_hi(y.x); o0[2] += wk * bf_lo(y.y); o0[3] += wk * bf_hi(y.y);
                o1[0] += wk * bf_lo(y.z); o1[1] += wk * bf_hi(y.z); o1[2] += wk * bf_lo(y.w); o1[3] += wk * bf_hi(y.w); }
            *(f32x4*)op = o0; *(f32x4*)(op + 4) = o1; }
    }
#ifdef TAP
    if (lo <= 10 && 10 < hi) { KA; GSYNC();
        for (int i = bx * 512 + tid; i < T * 1024; i += G * 512) { const int t = i >> 10, c = i & 1023; float v = 0.f;
#define BFV(buf, pitch, col) __uint_as_float((unsigned)(buf)[(size_t)t * (pitch) + (col)] << 16)
            if (TAP == 1) v = BFV(Qb, 512, c & 511) + 2.f * BFV(Kb, 512, c & 511) + 4.f * BFV(Vb, 512, c & 511) + 8.f * BFV(Ub, 256, c & 255) + 16.f * BFV(MQb, 256, c & 255)
                            + 32.f * BFV(GATES, 3072, c) + 64.f * BFV(GATES, 3072, 1024 + c) + 128.f * BFV(GATES, 3072, 2048 + c);
            if (TAP == 2) v = BFV(OC, 1024, c) + 2.f * BFV(YCAT, 1024, c);
            if (TAP == 3) v = BFV(MERGB, 1024, c);
            if (TAP == 4) v = BFV(XN, 1024, c);
            if (TAP == 6) { const bf16_t* z = WSP(bf16_t, WS_B) + (size_t)t * 5120 + c; v = __uint_as_float((unsigned)z[0] << 16) + 2.f * __uint_as_float((unsigned)z[1024] << 16) + 4.f * __uint_as_float((unsigned)z[2048] << 16) + 8.f * __uint_as_float((unsigned)z[3072] << 16) + 16.f * __uint_as_float((unsigned)z[4096] << 16); }
            if (TAP == 5) { const bf16_t* wt = WIN_T; const int tt = t % 5120; v = __uint_as_float((unsigned)wt[(size_t)tt * 1024 + c] << 16) + ROPE[(t & 8191) * 32 + (c & 31)].x + 2.f * ROPE[(t & 8191) * 32 + (c & 31)].y; }
            OUT[i] = v; }
    }
#endif
#undef IN
#undef SEAM
}

extern "C" void kernel_launch(void* const* d_in, const int* in_sizes, int n_in, void* d_out, int out_size, void* d_ws, size_t ws_size, hipStream_t stream) {
    static int grid = 0;
    if (grid == 0) {
        if (n_in != 29 || in_sizes[0] != T * DMODEL || out_size != T * DMODEL || ws_size < WS_END) {
            fprintf(stderr, "kernel_launch: unexpected shapes: n_in %d in0 %d out %d ws %zu (need %zu)\n", n_in, n_in > 0 ? in_sizes[0] : -1, out_size, ws_size, (size_t)WS_END); grid = -1; return; }
        int dev = 0, cus = 0, per_cu = 0;
        (void)hipGetDevice(&dev); (void)hipDeviceGetAttribute(&cus, hipDeviceAttributeMultiprocessorCount, dev);
        (void)hipFuncSetAttribute((const void*)fwd_kernel, hipFuncAttributeMaxDynamicSharedMemorySize, LDS_BYTES);
        (void)hipOccupancyMaxActiveBlocksPerMultiprocessor(&per_cu, (const void*)fwd_kernel, NWAVES * 64, LDS_BYTES);
        (void)hipGetLastError();
        grid = cus;
        fprintf(stderr, "kernel_launch: cus %d occupancy %d/CU grid %d\n", cus, per_cu, grid);
        if (per_cu < 1) fprintf(stderr, "kernel_launch: occupancy query says the kernel does not fit\n");
    }
    if (grid < 0) return;
    (void)hipMemsetAsync((char*)d_ws + WS_CTL, 0, CTL_ZERO_BYTES, stream);
    Args a{};
    for (int i = 0; i < 29; ++i) a.in[i] = (const float*)d_in[i];
    a.out = (float*)d_out; a.ws = (unsigned char*)d_ws; a.ph_lo = 0; a.ph_hi = PH_HI;
    void* args[] = {&a};
    hipError_t e = hipLaunchCooperativeKernel((const void*)fwd_kernel, dim3(grid), dim3(NWAVES * 64), args, LDS_BYTES, stream);
    if (e != hipSuccess) fprintf(stderr, "cooperative launch failed: %s (grid %d)\n", hipGetErrorString(e), grid);
}
```

```cpp
#include <hip/hip_runtime.h>
#include <hip/hip_cooperative_groups.h>
#include <hip/hip_bf16.h>
#include <cstdio>
#include <cstdint>
#include <cmath>
namespace cg = cooperative_groups;

#define LAS __attribute__((address_space(3)))
#define GAS __attribute__((address_space(1)))
typedef unsigned short bf16_t;
typedef short bf16x8 __attribute__((ext_vector_type(8)));
typedef float f32x4 __attribute__((ext_vector_type(4)));
typedef float f32x2 __attribute__((ext_vector_type(2)));
typedef float f32x16 __attribute__((ext_vector_type(16)));
typedef unsigned u32x4 __attribute__((ext_vector_type(4)));
typedef unsigned u32x2 __attribute__((ext_vector_type(2)));

#define PH_HI 10
#define ALIGN_EPI_SEL true
#define USE_SETPRIO 1
#define ATTN_PRIO_A 1
#define ATTN_PRIO_B 1
#ifndef PHMASK
#define PHMASK 0x3ff
#endif
#define REPEAT_MASK 0x000
constexpr int BATCH = 4, SEQ = 8192, DMODEL = 1024, T = BATCH * SEQ, INW = 5120, NEXP = 32, MEMLEN = 256;
constexpr float RMS_EPS = 1e-6f;
constexpr float C2 = 0.125f * 1.4426950408889634f;
constexpr int CAP = T;

constexpr size_t MiB = 1u << 20;
constexpr size_t WS_CTL = 0, CTL_ZERO_BYTES = 32768;
constexpr int CW_BAR = 4096;
constexpr size_t WS_ROUTEW = 1 * MiB;
constexpr size_t WS_LAM = 1 * MiB + 768 * 1024;
constexpr size_t WS_ROPE = 2 * MiB;
constexpr size_t WS_WR2 = 4 * MiB;
constexpr size_t WS_MEMN = 5 * MiB;
constexpr size_t WS_MKV = 7 * MiB;
constexpr size_t WS_WIN_T = 8 * MiB;
constexpr size_t WS_WBRD_T = 18 * MiB;
constexpr size_t WS_WBRP_T = 19 * MiB;
constexpr size_t WS_WBRM_T = 19 * MiB + 512 * 1024;
constexpr size_t WS_WOUT_T = 20 * MiB;
constexpr size_t WS_WMKV_T = 22 * MiB;
constexpr size_t WS_WGU_T = 24 * MiB;
constexpr size_t WS_WD_T = 152 * MiB;
constexpr size_t WS_A = 216 * MiB;
constexpr size_t WS_XN = WS_A;
constexpr size_t WS_Q = WS_A + 64 * MiB, WS_K = WS_A + 96 * MiB, WS_V = WS_A + 128 * MiB;
constexpr size_t WS_U = WS_A + 160 * MiB, WS_MQ = WS_A + 176 * MiB;
constexpr size_t WS_OC = WS_A + 192 * MiB;
constexpr size_t WS_B = 488 * MiB;
constexpr size_t WS_GATES = WS_B;
constexpr size_t WS_YCAT = WS_B + 192 * MiB;
constexpr size_t WS_MERGF = 760 * MiB;
constexpr size_t WS_MERGB = 888 * MiB;
constexpr size_t WS_XG = 952 * MiB;
constexpr size_t WS_LIST = 1016 * MiB;
constexpr size_t WS_END = 1024 * MiB;

typedef __bf16 bf16x2_v __attribute__((ext_vector_type(2)));
__device__ __forceinline__ unsigned cvt_pk_bf16(float lo, float hi) { f32x2 v = {lo, hi}; bf16x2_v b = __builtin_convertvector(v, bf16x2_v); return __builtin_bit_cast(unsigned, b); }
__device__ __forceinline__ float bf_lo(unsigned w) { return __uint_as_float(w << 16); }
__device__ __forceinline__ float bf_hi(unsigned w) { return __uint_as_float(w & 0xffff0000u); }
__device__ __forceinline__ float wave_sum(float v) {
#pragma unroll
    for (int o = 1; o < 64; o <<= 1) v += __shfl_xor(v, o);
    return v;
}
#define LDS_WAIT() asm volatile("s_waitcnt lgkmcnt(0)" ::: "memory")

namespace pg8 {
constexpr int BM = 256, BK = 64, HALF = 128, HTB = HALF * BK * 2, STAGE_BYTES = 8 * HTB, NXCD = 8, WGM = 8;
__host__ __device__ __forceinline__ int lds_byte(int r, int c) { const int st = (r >> 4) * 2 + (c >> 5), rr = r & 15, cc = c & 31, ob = rr * 64 + cc * 2; return st * 1024 + (ob ^ (((ob >> 9) & 1) << 5)); }
__host__ __device__ __forceinline__ void stage_rc(int b, int& R, int& C) { const int st = b / 1024, sb = b % 1024, swz = sb ^ (((sb >> 9) & 1) << 5); R = (st >> 1) * 16 + swz / 64; C = (st & 1) * 32 + (swz % 64) / 2; }
__host__ __device__ __forceinline__ int perm32(int rho) { const int n = rho >> 4, i = rho & 15; return 8 * (i >> 2) + 4 * n + (i & 3); }

struct Unit { int pm, pn, e, mt, cnt; };

template <int BMAP> __device__ __forceinline__ int brow(int R) { return BMAP == 0 ? ((R >> 5) * 64 + perm32(R & 31)) : ((R & ~31) + perm32(R & 31)); }

struct StaticOrder {
    int nM, nN, nwg, G, c;
    __device__ void init(int M, int N, int G_, int c_) { nM = M / BM; nN = N / BM; nwg = nM * nN; G = G_; c = c_; }
    __device__ bool next(int i, Unit& u) const {
        const long L = (long)i * G + c; if (L >= nwg) return false;
        int wgid = (int)L; { const int q = nwg / NXCD, r = nwg % NXCD, xcd = wgid % NXCD, off = wgid / NXCD; wgid = (xcd < r ? xcd * (q + 1) : r * (q + 1) + (xcd - r) * q) + off; }
        const int nig = WGM * nN, gid = wgid / nig, fm = gid * WGM, gsz = (nM - fm) < WGM ? (nM - fm) : WGM;
        u.pm = fm + ((wgid % nig) % gsz); u.pn = (wgid % nig) / gsz; u.e = 0; u.mt = 0; u.cnt = 0; return true;
    }
    __device__ bool next_lane(int i, Unit& u) const { return next(i, u); }
};
struct GroupedOrder {
    const LAS int* tp; const LAS int* cn; int NTN, G, c;
    __device__ bool next_lane(int i, Unit& u) const {
        const int nwg = tp[NEXP] * NTN; const long L = (long)i * G + c; if (L >= nwg) return false;
        int wgid = (int)L; { const int q = nwg / NXCD, r = nwg % NXCD, xcd = wgid % NXCD, off = wgid / NXCD; wgid = (xcd < r ? xcd * (q + 1) : r * (q + 1) + (xcd - r) * q) + off; }
        int e = 0; while (e < NEXP - 1 && wgid >= tp[e + 1] * NTN) ++e;
        const int idx = wgid - tp[e] * NTN, tiles = tp[e + 1] - tp[e];
        const int nig = 4 * NTN, gid = idx / nig, fm = gid * 4, gsz = (tiles - fm) < 4 ? (tiles - fm) : 4;
        u.mt = fm + ((idx % nig) % gsz); u.pn = (idx % nig) / gsz; u.e = e; u.pm = tp[e] + u.mt; u.cnt = cn[e]; return true;
    }
};
struct TableOrder {
    const LAS int* tab; int n;
    __device__ __forceinline__ bool next(int i, Unit& u) const {
        if (i >= n) return false;
        const LAS int* t = tab + i * 8;
        u.pm = __builtin_amdgcn_readfirstlane(t[0]); u.pn = __builtin_amdgcn_readfirstlane(t[1]); u.e = __builtin_amdgcn_readfirstlane(t[2]);
        u.mt = __builtin_amdgcn_readfirstlane(t[3]); u.cnt = __builtin_amdgcn_readfirstlane(t[4]); return true;
    }
};
template <class Sched> __device__ __forceinline__ TableOrder build_unit_table(const Sched& S, LAS int* tab) {
    __syncthreads();
    if (threadIdx.x < 32) { Unit u; const bool ok = S.next_lane((int)threadIdx.x, u);
        if (ok) { LAS int* t = tab + threadIdx.x * 8; t[0] = u.pm; t[1] = u.pn; t[2] = u.e; t[3] = u.mt; t[4] = u.cnt; }
        const unsigned long long m = __ballot(ok); if (threadIdx.x == 0) tab[256] = __popcll(m); }
    __syncthreads();
    TableOrder T; T.tab = tab; T.n = __builtin_amdgcn_readfirstlane(tab[256]); return T;
}
struct DenseProb {
    static constexpr bool GATHER = false; static constexpr int BMAP = 0;
    const bf16_t* A; const bf16_t* Bt; int lda, ldb, K;
    __device__ __forceinline__ const char* a_base(const Unit& u) const { return (const char*)(A + (size_t)u.pm * BM * lda); }
    __device__ __forceinline__ const char* b_base(const Unit& u) const { return (const char*)(Bt + (size_t)u.pn * BM * ldb); }
    __device__ __forceinline__ size_t bhstep() const { return (size_t)32 * ldb * 2; }
    __device__ __forceinline__ unsigned a_off(const Unit&, int, int) const { return 0u; }
    __device__ __forceinline__ unsigned a_raw(const Unit&, int) const { return 0u; }
};
struct GuProb {
    static constexpr bool GATHER = true; static constexpr int BMAP = 1;
    const bf16_t* XG; const bf16_t* Wt; const u32x2* list; int lda, ldb, K;
    __device__ __forceinline__ const char* a_base(const Unit&) const { return (const char*)XG; }
    __device__ __forceinline__ const char* b_base(const Unit& u) const { return (const char*)(Wt + ((size_t)u.e * 2048 + 128 * u.pn) * 1024); }
    __device__ __forceinline__ size_t bhstep() const { return (size_t)1024 * 1024 * 2; }
    __device__ __forceinline__ unsigned a_raw(const Unit& u, int r) const { const int rr = u.mt * BM + r, rc = rr < u.cnt ? rr : u.cnt - 1; return list[(size_t)u.e * CAP + rc].x; }
    __device__ __forceinline__ unsigned a_off(const Unit& u, int r, int C) const {
        const int rr = u.mt * BM + r, rc = rr < u.cnt ? rr : u.cnt - 1;
        const unsigned tok = list[(size_t)u.e * CAP + rc].x >> 2;
        return tok * 2048u + (unsigned)C * 2u;
    }
};
struct DownProb {
    static constexpr bool GATHER = false; static constexpr int BMAP = 0;
    const bf16_t* A; const bf16_t* Wt; int lda, ldb, K;
    __device__ __forceinline__ const char* a_base(const Unit& u) const { return (const char*)(A + (size_t)u.pm * BM * lda); }
    __device__ __forceinline__ const char* b_base(const Unit& u) const { return (const char*)(Wt + ((size_t)u.e * 1024 + 256 * u.pn) * 1024); }
    __device__ __forceinline__ size_t bhstep() const { return (size_t)32 * ldb * 2; }
    __device__ __forceinline__ unsigned a_off(const Unit&, int, int) const { return 0u; }
    __device__ __forceinline__ unsigned a_raw(const Unit&, int) const { return 0u; }
};

template <class Prob> __device__ __forceinline__ void calc_aoff(const Prob& P, const Unit& u, const int (&Rr)[2], const int (&Cc)[2], unsigned (&o)[2][2]) {
#pragma unroll
    for (int h = 0; h < 2; ++h)
#pragma unroll
        for (int i = 0; i < 2; ++i) {
            if constexpr (Prob::GATHER) o[h][i] = P.a_off(u, h * HALF + Rr[i], Cc[i]);
            else o[h][i] = (unsigned)((h * HALF + Rr[i]) * P.lda + Cc[i]) * 2u;
        }
}

template <class Epi, class Prob, class Sched, bool ALIGN_EPI>
__device__ __forceinline__ void gemm_phase(LAS unsigned char* lds, const Prob& P, const Sched& S, const Epi& E) {
    const int tid = threadIdx.x, wid = __builtin_amdgcn_readfirstlane(tid >> 6), lane = tid & 63, wr = wid >> 2, wc = wid & 3, fr = lane & 15, fq = lane >> 4;
    const int K = P.K, nt = K / BK;
    int Rr[2], Cc[2]; unsigned voffB[2];
#pragma unroll
    for (int i = 0; i < 2; ++i) { stage_rc(tid * 16 + i * 8192, Rr[i], Cc[i]); voffB[i] = (unsigned)(brow<Prob::BMAP>(Rr[i]) * P.ldb + Cc[i]) * 2u; }
    const size_t kstep = (size_t)(BK * 2);
    const size_t bhstep = P.bhstep();
    const unsigned ldsw = (unsigned)wid * 1024u;
    const int aoff = lds_byte(wr * 64 + fr, fq * 8), boff = lds_byte(wc * 32 + fr, fq * 8);
#define PG8_SA(b, h) (((b) * 2 + (h)) * HTB)
#define PG8_SB(b, h) ((4 + (b) * 2 + (h)) * HTB)
#define PG8_STG(bufoff, gptr, v0, v1) do { \
        __builtin_amdgcn_global_load_lds((const unsigned*)((const char*)(gptr) + (v0)), (LAS unsigned*)(lds + (bufoff) + ldsw), 16, 0, 0); \
        __builtin_amdgcn_global_load_lds((const unsigned*)((const char*)(gptr) + (v1)), (LAS unsigned*)(lds + (bufoff) + ldsw + 8192), 16, 0, 0); } while (0)
#define PG8_STGB(bufoff, gptr) PG8_STG(bufoff, gptr, voffB[0], voffB[1])
#define PG8_LDA(dst, b, h) do { _Pragma("unroll") for (int m = 0; m < 4; ++m) _Pragma("unroll") for (int k = 0; k < 2; ++k) dst[m][k] = *(const LAS bf16x8*)(lds + PG8_SA(b, h) + aoff + m * 2048 + k * 1024); } while (0)
#define PG8_LDB(dst, b, h) do { _Pragma("unroll") for (int n = 0; n < 2; ++n) _Pragma("unroll") for (int k = 0; k < 2; ++k) dst[n][k] = *(const LAS bf16x8*)(lds + PG8_SB(b, h) + boff + n * 2048 + k * 1024); } while (0)
#define PG8_MMA(ai, bj, At, Bt) do { if (USE_SETPRIO) __builtin_amdgcn_s_setprio(USE_SETPRIO); _Pragma("unroll") for (int m = 0; m < 4; ++m) _Pragma("unroll") for (int n = 0; n < 2; ++n) _Pragma("unroll") for (int k = 0; k < 2; ++k) \
        acc[ai][bj][m][n] = __builtin_amdgcn_mfma_f32_16x16x32_bf16(Bt[n][k], At[m][k], acc[ai][bj][m][n], 0, 0, 0); if (USE_SETPRIO) __builtin_amdgcn_s_setprio(0); } while (0)
#define PG8_WAIT_V(n) asm volatile("s_waitcnt vmcnt(" #n ")" ::: "memory")
#define PG8_WAIT_L(n) asm volatile("s_waitcnt lgkmcnt(" #n ")" ::: "memory")
#define PG8_BAR __builtin_amdgcn_s_barrier()
#define PG8_SCHED __builtin_amdgcn_sched_barrier(0)
    Unit cur, nxt; int ui = 0;
    if (!S.next(0, cur)) return;
    unsigned vo[2][2], nvo[2][2];
    calc_aoff(P, cur, Rr, Cc, vo);
    bool has_next = S.next(1, nxt);
    if constexpr (Prob::GATHER) { if (has_next) calc_aoff(P, nxt, Rr, Cc, nvo); else {
#pragma unroll
        for (int h = 0; h < 2; ++h)
#pragma unroll
            for (int i = 0; i < 2; ++i) nvo[h][i] = vo[h][i]; } }
    f32x4 acc[2][2][4][2];
#pragma unroll
    for (int a = 0; a < 2; ++a)
#pragma unroll
        for (int b = 0; b < 2; ++b)
#pragma unroll
            for (int m = 0; m < 4; ++m)
#pragma unroll
                for (int n = 0; n < 2; ++n) acc[a][b][m][n] = (f32x4){0.f, 0.f, 0.f, 0.f};
    bf16x8 At[4][2], B0[2][2], B1[2][2];
    const char* cA = P.a_base(cur); const char* cB = P.b_base(cur);
    PG8_STGB(PG8_SB(0, 0), cB); PG8_STGB(PG8_SB(0, 1), cB + bhstep); PG8_STG(PG8_SA(0, 0), cA, vo[0][0], vo[0][1]); PG8_STG(PG8_SA(0, 1), cA, vo[1][0], vo[1][1]);
    if (wr == 1) PG8_BAR;
    PG8_WAIT_V(2); PG8_BAR;
    PG8_STGB(PG8_SB(1, 0), cB + kstep); PG8_STG(PG8_SA(1, 0), cA + kstep, vo[0][0], vo[0][1]); PG8_STGB(PG8_SB(1, 1), cB + bhstep + kstep);
    PG8_WAIT_V(6); PG8_BAR;
    for (;;) {
        const char* nA = has_next ? P.a_base(nxt) : cA; const char* nB = has_next ? P.b_base(nxt) : cB;
        for (int t = 0; t < nt; t += 2) {
            const bool last = (t == nt - 2);
            if constexpr (Epi::HAS_MID) { if (t == Epi::MID_T0 || t == Epi::MID_T1) { E.mid(acc, cur, wr, wc, fr, fq, t == Epi::MID_T0 ? 0 : 1); PG8_SCHED; } }
            const char* a1 = cA + (size_t)(t + 1) * kstep;
            const char* a2 = last ? nA : cA + (size_t)(t + 2) * kstep; const char* b2 = last ? nB : cB + (size_t)(t + 2) * kstep;
            const char* a3 = a2 + kstep; const char* b3 = b2 + kstep;
            unsigned x00 = vo[0][0], x01 = vo[0][1], x10 = vo[1][0], x11 = vo[1][1];
            if constexpr (Prob::GATHER) { if (last) { x00 = nvo[0][0]; x01 = nvo[0][1]; x10 = nvo[1][0]; x11 = nvo[1][1]; } }
            PG8_LDB(B0, 0, 0); PG8_LDB(B1, 0, 1); PG8_SCHED; PG8_LDA(At, 0, 0); PG8_STG(PG8_SA(1, 1), a1, vo[1][0], vo[1][1]);
            PG8_WAIT_V(8); PG8_WAIT_L(0); PG8_BAR; PG8_MMA(0, 0, At, B0); PG8_MMA(0, 1, At, B1); PG8_BAR; PG8_SCHED;
            PG8_LDA(At, 0, 1); PG8_STGB(PG8_SB(0, 0), b2); PG8_STGB(PG8_SB(0, 1), b2 + bhstep); PG8_STG(PG8_SA(0, 0), a2, x00, x01);
            PG8_WAIT_V(8); PG8_WAIT_L(0); PG8_BAR; PG8_MMA(1, 0, At, B0); PG8_MMA(1, 1, At, B1); PG8_BAR; PG8_SCHED;
            PG8_LDB(B0, 1, 0); PG8_LDB(B1, 1, 1); PG8_SCHED; PG8_LDA(At, 1, 0); PG8_STG(PG8_SA(0, 1), a2, x10, x11);
            PG8_WAIT_V(8); PG8_WAIT_L(0); PG8_BAR; PG8_MMA(0, 0, At, B0); PG8_MMA(0, 1, At, B1); PG8_BAR; PG8_SCHED;
            PG8_LDA(At, 1, 1); PG8_STGB(PG8_SB(1, 0), b3); PG8_STGB(PG8_SB(1, 1), b3 + bhstep); PG8_STG(PG8_SA(1, 0), a3, x00, x01);
            PG8_WAIT_V(8); PG8_WAIT_L(0); PG8_BAR; PG8_MMA(1, 0, At, B0); PG8_MMA(1, 1, At, B1); PG8_BAR; PG8_SCHED;
        }
        if constexpr (ALIGN_EPI) { if (wr == 0) PG8_BAR; }
        Unit nn; const bool has_nn = has_next && S.next(ui + 2, nn);
        if constexpr (Prob::GATHER) {
#pragma unroll
            for (int h = 0; h < 2; ++h)
#pragma unroll
                for (int i = 0; i < 2; ++i) vo[h][i] = nvo[h][i];
            if (has_nn) {
#pragma unroll
                for (int h = 0; h < 2; ++h)
#pragma unroll
                    for (int i = 0; i < 2; ++i) nvo[h][i] = P.a_raw(nn, h * HALF + Rr[i]); } }
        E(acc, cur, wr, wc, fr, fq);
        if (!has_next) break;
#pragma unroll
        for (int a = 0; a < 2; ++a)
#pragma unroll
            for (int b = 0; b < 2; ++b)
#pragma unroll
                for (int m = 0; m < 4; ++m)
#pragma unroll
                    for (int n = 0; n < 2; ++n) acc[a][b][m][n] = (f32x4){0.f, 0.f, 0.f, 0.f};
        cur = nxt; cA = nA; cB = nB; ++ui;
        has_next = has_nn; nxt = nn;
        if constexpr (Prob::GATHER) { if (has_next) {
#pragma unroll
            for (int h = 0; h < 2; ++h)
#pragma unroll
                for (int i = 0; i < 2; ++i) nvo[h][i] = (nvo[h][i] >> 2) * 2048u + (unsigned)Cc[i] * 2u;
            asm volatile("" : "+v"(nvo[0][0]), "+v"(nvo[0][1]), "+v"(nvo[1][0]), "+v"(nvo[1][1])); } }
        if constexpr (ALIGN_EPI) { if (wr == 1) PG8_BAR; }
    }
    PG8_WAIT_V(0);
    if constexpr (!ALIGN_EPI) { if (wr == 0) PG8_BAR; }
    PG8_BAR;
#undef PG8_SA
#undef PG8_SB
#undef PG8_STG
#undef PG8_STGB
#undef PG8_LDA
#undef PG8_LDB
#undef PG8_MMA
#undef PG8_WAIT_V
#undef PG8_WAIT_L
#undef PG8_BAR
#undef PG8_SCHED
}

typedef const f32x4 (&AccRef)[2][2][4][2];

__device__ __forceinline__ void store8(bf16_t* p, const f32x4& a, const f32x4& b) {
    u32x4 w; w.x = cvt_pk_bf16(a[0], a[1]); w.y = cvt_pk_bf16(a[2], a[3]); w.z = cvt_pk_bf16(b[0], b[1]); w.w = cvt_pk_bf16(b[2], b[3]); *(u32x4*)p = w;
}
__device__ __forceinline__ float sigmoidf_(float v) { return __builtin_amdgcn_rcpf(1.0f + __builtin_amdgcn_exp2f(-1.4426950408889634f * v)); }

struct EpiInProj {
    static constexpr bool HAS_MID = false;
    bf16_t *Q, *Kb, *V, *U, *MQ, *GT; const float *qn, *kn, *mqn, *bg; const f32x2* rope;
    __device__ __forceinline__ void operator()(AccRef acc, const Unit& u, int wr, int wc, int fr, int fq) const {
        const int pn = u.pn; const int row0 = u.pm * BM + wr * 64 + fr;
        bf16_t* const Q_ = Q; bf16_t* const K_ = Kb; bf16_t* const V_ = V; bf16_t* const U_ = U; bf16_t* const MQ_ = MQ; const float* const qn_ = qn; const float* const kn_ = kn; const float* const mqn_ = mqn;
        if (pn < 4 || pn == 7) {
            const bool rope_on = pn < 4; const float* gn = pn < 2 ? qn_ : (pn < 4 ? kn_ : mqn_);
            const float sc = (pn < 2 || pn == 7) ? C2 : 1.0f;
            bf16_t* O; int pitch, colb;
            if (pn < 2) { O = Q_; pitch = 512; colb = (pn * 4 + wc) * 64; } else if (pn < 4) { O = K_; pitch = 512; colb = ((pn - 2) * 4 + wc) * 64; } else { O = MQ_; pitch = 256; colb = wc * 64; }
            const f32x4 g00 = *(const f32x4*)(gn + 8 * fq), g01 = *(const f32x4*)(gn + 8 * fq + 4), g10 = *(const f32x4*)(gn + 32 + 8 * fq), g11 = *(const f32x4*)(gn + 32 + 8 * fq + 4);
#pragma unroll
            for (int ai = 0; ai < 2; ++ai)
#pragma unroll
                for (int m = 0; m < 4; ++m) {
                    const f32x4 a0 = acc[ai][0][m][0], a1 = acc[ai][0][m][1], b0 = acc[ai][1][m][0], b1 = acc[ai][1][m][1];
                    float ss = 0.f;
#pragma unroll
                    for (int j = 0; j < 4; ++j) ss += a0[j] * a0[j] + a1[j] * a1[j] + b0[j] * b0[j] + b1[j] * b1[j];
                    ss += __shfl_xor(ss, 16); ss += __shfl_xor(ss, 32);
                    const float rstd = 1.0f / sqrtf(ss * (1.0f / 64.0f) + RMS_EPS);
                    const int row = row0 + ai * HALF + m * 16;
                    f32x4 t10 = a0 * rstd * g00, t11 = a1 * rstd * g01, t20 = b0 * rstd * g10, t21 = b1 * rstd * g11;
                    f32x4 o10, o11, o20, o21;
                    if (rope_on) {
                        const f32x4* rp = (const f32x4*)(rope + (size_t)(row & (SEQ - 1)) * 32 + 8 * fq);
                        const f32x4 r0 = rp[0], r1 = rp[1], r2 = rp[2], r3 = rp[3];
                        const f32x4 cs0 = {r0[0], r0[2], r1[0], r1[2]}, sn0 = {r0[1], r0[3], r1[1], r1[3]}, cs1 = {r2[0], r2[2], r3[0], r3[2]}, sn1 = {r2[1], r2[3], r3[1], r3[3]};
                        o10 = (t10 * cs0 - t20 * sn0) * sc; o11 = (t11 * cs1 - t21 * sn1) * sc; o20 = (t20 * cs0 + t10 * sn0) * sc; o21 = (t21 * cs1 + t11 * sn1) * sc;
                    } else { o10 = t10 * sc; o11 = t11 * sc; o20 = t20 * sc; o21 = t21 * sc; }
                    bf16_t* rowp = O + (size_t)row * pitch + colb + 8 * fq;
                    store8(rowp, o10, o11); store8(rowp + 32, o20, o21);
                }
        } else if (pn < 7) {
            bf16_t* O; int pitch, colb;
            if (pn < 6) { O = V_; pitch = 512; colb = (pn - 4) * 256 + wc * 64; } else { O = U_; pitch = 256; colb = wc * 64; }
#pragma unroll
            for (int ai = 0; ai < 2; ++ai)
#pragma unroll
                for (int m = 0; m < 4; ++m) { bf16_t* rowp = O + (size_t)(row0 + ai * HALF + m * 16) * pitch + colb + 8 * fq;
                    store8(rowp, acc[ai][0][m][0], acc[ai][0][m][1]); store8(rowp + 32, acc[ai][1][m][0], acc[ai][1][m][1]); }
        } else {
            const int gc = (pn - 8) * 256 + wc * 64 + 8 * fq;
            f32x4 bv[2][2];
#pragma unroll
            for (int bj = 0; bj < 2; ++bj)
#pragma unroll
                for (int n = 0; n < 2; ++n) bv[bj][n] = *(const f32x4*)(bg + gc + 32 * bj + 4 * n);
#pragma unroll
            for (int ai = 0; ai < 2; ++ai)
#pragma unroll
                for (int m = 0; m < 4; ++m) { bf16_t* rowp = GT + (size_t)(row0 + ai * HALF + m * 16) * 3072 + gc;
#pragma unroll
                    for (int bj = 0; bj < 2; ++bj) { f32x4 v0 = acc[ai][bj][m][0] + bv[bj][0], v1 = acc[ai][bj][m][1] + bv[bj][1];
#pragma unroll
                        for (int j = 0; j < 4; ++j) { v0[j] = sigmoidf_(v0[j]); v1[j] = sigmoidf_(v1[j]); }
                        store8(rowp + 32 * bj, v0, v1); } }
        }
    }
};
struct EpiMemKV {
    static constexpr bool HAS_MID = false;
    bf16_t* MKV; const float* mkn;
    __device__ __forceinline__ void operator()(AccRef acc, const Unit& u, int wr, int wc, int fr, int fq) const {
        const int row0 = u.pm * BM + wr * 64 + fr;
        f32x4 g00 = {1.f, 1.f, 1.f, 1.f}, g01 = g00, g10 = g00, g11 = g00;
        if (u.pn == 0) { g00 = *(const f32x4*)(mkn + 8 * fq); g01 = *(const f32x4*)(mkn + 8 * fq + 4); g10 = *(const f32x4*)(mkn + 32 + 8 * fq); g11 = *(const f32x4*)(mkn + 32 + 8 * fq + 4); }
#pragma unroll
        for (int ai = 0; ai < 2; ++ai)
#pragma unroll
            for (int m = 0; m < 4; ++m) {
                const f32x4 a0 = acc[ai][0][m][0], a1 = acc[ai][0][m][1], b0 = acc[ai][1][m][0], b1 = acc[ai][1][m][1];
                float rstd = 1.0f;
                if (u.pn == 0) { float ss = 0.f;
#pragma unroll
                    for (int j = 0; j < 4; ++j) ss += a0[j] * a0[j] + a1[j] * a1[j] + b0[j] * b0[j] + b1[j] * b1[j];
                    ss += __shfl_xor(ss, 16); ss += __shfl_xor(ss, 32); rstd = 1.0f / sqrtf(ss * (1.0f / 64.0f) + RMS_EPS); }
                bf16_t* rowp = MKV + (size_t)(row0 + ai * HALF + m * 16) * 512 + u.pn * 256 + wc * 64 + 8 * fq;
                store8(rowp, a0 * rstd * g00, a1 * rstd * g01); store8(rowp + 32, b0 * rstd * g10, b1 * rstd * g11);
            }
    }
};
template <int STAGE> struct EpiMerge {
    static constexpr bool HAS_MID = false;
    const bf16_t* GT; float* MF; bf16_t* MB;
    __device__ __forceinline__ void operator()(AccRef acc, const Unit& u, int wr, int wc, int fr, int fq) const {
        const int row0 = u.pm * BM + wr * 64 + fr, col0 = u.pn * BM + wc * 64 + 8 * fq;
#pragma unroll
        for (int ai = 0; ai < 2; ++ai)
#pragma unroll
            for (int m = 0; m < 4; ++m) { const size_t row = (size_t)(row0 + ai * HALF + m * 16);
#pragma unroll
                for (int bj = 0; bj < 2; ++bj) { const int col = col0 + 32 * bj;
                    const u32x4 g = *(const u32x4*)(GT + row * 3072 + STAGE * 1024 + col);
                    const f32x4 ga = {bf_lo(g.x), bf_hi(g.x), bf_lo(g.y), bf_hi(g.y)}, gb = {bf_lo(g.z), bf_hi(g.z), bf_lo(g.w), bf_hi(g.w)};
                    f32x4 v0 = acc[ai][bj][m][0] * ga, v1 = acc[ai][bj][m][1] * gb;
                    float* mp = MF + row * 1024 + col;
                    if (STAGE > 0) { v0 += *(const f32x4*)mp; v1 += *(const f32x4*)(mp + 4); }
                    if (STAGE < 2) { *(f32x4*)mp = v0; *(f32x4*)(mp + 4) = v1; } else store8(MB + row * 1024 + col, v0, v1); }
                if (m & 1) asm volatile("" ::: "memory"); }
    }
};
struct EpiWout {
    static constexpr bool HAS_MID = false;
    const float* X; float* X2; bf16_t* XG; const float* n2;
    __device__ __forceinline__ void operator()(AccRef acc, const Unit& u, int wr, int wc, int fr, int fq) const {
        const int row0 = u.pm * BM + wr * 64 + fr, col0 = u.pn * BM + wc * 64 + 8 * fq;
        f32x4 nv[2][2];
#pragma unroll
        for (int bj = 0; bj < 2; ++bj)
#pragma unroll
            for (int n = 0; n < 2; ++n) nv[bj][n] = *(const f32x4*)(n2 + col0 + 32 * bj + 4 * n);
#pragma unroll
        for (int ai = 0; ai < 2; ++ai)
#pragma unroll
            for (int m = 0; m < 4; ++m) { const size_t off = (size_t)(row0 + ai * HALF + m * 16) * 1024 + col0;
#pragma unroll
                for (int bj = 0; bj < 2; ++bj) { const f32x4 x0 = *(const f32x4*)(X + off + 32 * bj) + acc[ai][bj][m][0], x1 = *(const f32x4*)(X + off + 32 * bj + 4) + acc[ai][bj][m][1];
                    *(f32x4*)(X2 + off + 32 * bj) = x0; *(f32x4*)(X2 + off + 32 * bj + 4) = x1;
                    store8(XG + off + 32 * bj, x0 * nv[bj][0], x1 * nv[bj][1]); }
                if (m & 1) asm volatile("" ::: "memory"); }
    }
};
struct EpiSwiglu {
    static constexpr bool HAS_MID = false;
    bf16_t* ACT; const u32x2* list; const float* bgu;
    __device__ __forceinline__ void operator()(AccRef acc, const Unit& u, int wr, int wc, int fr, int fq) const {
        int z = 0; asm volatile("" : "+v"(z));
        const int col = 128 * u.pn + 32 * wc + 8 * fq + z; const float* bp = bgu + (size_t)u.e * 2048 + col;
        const f32x4 bg0 = *(const f32x4*)bp, bg1 = *(const f32x4*)(bp + 4), bu0 = *(const f32x4*)(bp + 1024), bu1 = *(const f32x4*)(bp + 1028);
#pragma unroll
        for (int ai = 0; ai < 2; ++ai)
#pragma unroll
            for (int m = 0; m < 4; ++m) { const int r = ai * HALF + wr * 64 + m * 16 + fr, rr = u.mt * BM + r, rc = rr < u.cnt ? rr : u.cnt - 1;
                const float rstd = __uint_as_float(list[(size_t)u.e * CAP + rc].y);
                f32x4 o[2];
#pragma unroll
                for (int n = 0; n < 2; ++n) { const f32x4 g = acc[ai][0][m][n] * rstd + (n ? bg1 : bg0), up = acc[ai][1][m][n] * rstd + (n ? bu1 : bu0);
#pragma unroll
                    for (int j = 0; j < 4; ++j) { const float gg = fminf(g[j], 7.0f), uu = fminf(fmaxf(up[j], -7.0f), 7.0f);
                        o[n][j] = gg * __builtin_amdgcn_rcpf(1.0f + __builtin_amdgcn_exp2f(-1.702f * 1.4426950408889634f * gg)) * (uu + 1.0f); } }
                store8(ACT + (size_t)(u.pm * BM + r) * 1024 + col, o[0], o[1]); }
    }
};
struct EpiDown {
    static constexpr bool HAS_MID = false;
    bf16_t* Y4; const u32x2* list; const float* bd;
    __device__ __forceinline__ void operator()(AccRef acc, const Unit& u, int wr, int wc, int fr, int fq) const {
        int z = 0; asm volatile("" : "+v"(z));
        const int col0 = u.pn * BM + wc * 64 + 8 * fq + z; const float* bp = bd + (size_t)u.e * 1024 + col0;
        f32x4 bv[2][2];
#pragma unroll
        for (int bj = 0; bj < 2; ++bj)
#pragma unroll
            for (int n = 0; n < 2; ++n) bv[bj][n] = *(const f32x4*)(bp + 32 * bj + 4 * n);
        unsigned tkv[8];
#pragma unroll
        for (int ai = 0; ai < 2; ++ai)
#pragma unroll
            for (int m = 0; m < 4; ++m) { const int rr = u.mt * BM + ai * HALF + wr * 64 + m * 16 + fr, rc = rr < u.cnt ? rr : u.cnt - 1;
                tkv[ai * 4 + m] = list[(size_t)u.e * CAP + rc].x; }
#pragma unroll
        for (int ai = 0; ai < 2; ++ai)
#pragma unroll
            for (int m = 0; m < 4; ++m) { const int rr = u.mt * BM + ai * HALF + wr * 64 + m * 16 + fr;
                if (rr < u.cnt) { bf16_t* rowp = Y4 + (size_t)tkv[ai * 4 + m] * 1024 + col0;
#pragma unroll
                    for (int bj = 0; bj < 2; ++bj) store8(rowp + 32 * bj, acc[ai][bj][m][0] + bv[bj][0], acc[ai][bj][m][1] + bv[bj][1]); } }
    }
};
struct EpiMergeR {
    static constexpr bool HAS_MID = true; static constexpr int MID_T0 = 8, MID_T1 = 12;
    const bf16_t* GT; bf16_t* MB;
    __device__ __forceinline__ void mid(f32x4 (&acc)[2][2][4][2], const Unit& u, int wr, int wc, int fr, int fq, int seam) const {
        int z = 0; asm volatile("" : "+v"(z));
        const bf16_t* gp0 = GT + (size_t)(u.pm * BM + wr * 64 + fr + z) * 3072 + seam * 1024 + u.pn * BM + wc * 64 + 8 * fq;
#pragma unroll
        for (int ai = 0; ai < 2; ++ai)
#pragma unroll
            for (int m = 0; m < 4; ++m) { const bf16_t* gp = gp0 + (size_t)(ai * HALF + m * 16) * 3072;
#pragma unroll
                for (int bj = 0; bj < 2; ++bj) { const u32x4 gn = *(const u32x4*)(gp + 32 * bj), gd = *(const u32x4*)(gp + 1024 + 32 * bj);
                    const unsigned nn[4] = {gn.x, gn.y, gn.z, gn.w}, dd[4] = {gd.x, gd.y, gd.z, gd.w};
#pragma unroll
                    for (int j = 0; j < 4; ++j) { const float r0 = bf_lo(nn[j]) * __builtin_amdgcn_rcpf(fmaxf(bf_lo(dd[j]), 8.67e-19f)), r1 = bf_hi(nn[j]) * __builtin_amdgcn_rcpf(fmaxf(bf_hi(dd[j]), 8.67e-19f));
                        acc[ai][bj][m][j >> 1][(j & 1) * 2] *= r0; acc[ai][bj][m][j >> 1][(j & 1) * 2 + 1] *= r1; } }
                if (m & 1) asm volatile("" ::: "memory"); }
    }
    __device__ __forceinline__ void operator()(AccRef acc, const Unit& u, int wr, int wc, int fr, int fq) const {
        int z = 0; asm volatile("" : "+v"(z));
        const size_t off0 = (size_t)(u.pm * BM + wr * 64 + fr + z) * 1024 + u.pn * BM + wc * 64 + 8 * fq;
#pragma unroll
        for (int ai = 0; ai < 2; ++ai)
#pragma unroll
            for (int m = 0; m < 4; ++m) { const size_t ro = off0 + (size_t)(ai * HALF + m * 16) * 1024;
#pragma unroll
                for (int bj = 0; bj < 2; ++bj) {
                    const u32x4 g = *(const u32x4*)(GT + ro * 3 + 2048 - 2 * (ro & 1023) + 32 * bj);
                    const f32x4 ga = {bf_lo(g.x), bf_hi(g.x), bf_lo(g.y), bf_hi(g.y)}, gb = {bf_lo(g.z), bf_hi(g.z), bf_lo(g.w), bf_hi(g.w)};
                    store8(MB + ro + 32 * bj, acc[ai][bj][m][0] * ga, acc[ai][bj][m][1] * gb); } }
    }
};
struct EpiPlain {
    static constexpr bool HAS_MID = false;
    bf16_t* Z; int ldz;
    __device__ __forceinline__ void operator()(AccRef acc, const Unit& u, int wr, int wc, int fr, int fq) const {
        const int row0 = u.pm * BM + wr * 64 + fr, col0 = u.pn * BM + wc * 64 + 8 * fq;
#pragma unroll
        for (int ai = 0; ai < 2; ++ai)
#pragma unroll
            for (int m = 0; m < 4; ++m) { bf16_t* rowp = Z + (size_t)(row0 + ai * HALF + m * 16) * ldz + col0;
                store8(rowp, acc[ai][0][m][0], acc[ai][0][m][1]); store8(rowp + 32, acc[ai][1][m][0], acc[ai][1][m][1]); }
    }
};
}

namespace attn_body {
using bf16 = __hip_bfloat16;
using s16x4 = __attribute__((ext_vector_type(4))) short;
constexpr int NW = 8, QBLK = 32, QB = QBLK * NW, KVBLK = 64, D = 64;
__device__ __forceinline__ int crow(int r, int hi) { return (r & 3) + 8 * (r >> 2) + 4 * hi; }
#define SBAR() __builtin_amdgcn_sched_barrier(0)
constexpr int NSLOT = 3, SLOTB = 8192;
constexpr int LDS_K = 0, LDS_V = NSLOT * SLOTB, LDS_WS = 2 * NSLOT * SLOTB, LDS_OST = LDS_WS + NW * 64 * 4, LDS_BYTES = LDS_OST + NW * 4096;
__device__ __forceinline__ void glds16(const void* gsrc, unsigned lds_dst) { unsigned keep;
    asm volatile("s_mov_b32 %0, m0\n\ts_mov_b32 m0, %2\n\ts_nop 0\n\tglobal_load_lds_dwordx4 %1, off\n\ts_mov_b32 m0, %0" : "=&s"(keep) : "v"(gsrc), "s"(lds_dst) : "memory"); }
__device__ __forceinline__ float max3f(float a, float b, float c) { float r; asm("v_max3_f32 %0, %1, %2, %3" : "=v"(r) : "v"(a), "v"(b), "v"(c)); return r; }
__device__ __forceinline__ float max2f(float a, float b) { float r; asm("v_max_f32_e32 %0, %1, %2" : "=v"(r) : "v"(a), "v"(b)); return r; }
__device__ __forceinline__ float fadd_s(float a, float b) { float r; asm("v_add_f32_e32 %0, %1, %2" : "=v"(r) : "v"(a), "v"(b)); return r; }
__device__ __forceinline__ float fsub_s(float a, float b) { float r; asm("v_sub_f32_e32 %0, %1, %2" : "=v"(r) : "v"(a), "v"(b)); return r; }
typedef float f32x2_t __attribute__((ext_vector_type(2))); typedef __bf16 bf16x2_t __attribute__((ext_vector_type(2)));
__device__ __forceinline__ unsigned cvtpk_s(float lo, float hi) { f32x2_t v = {lo, hi}; bf16x2_t b = __builtin_convertvector(v, bf16x2_t); return __builtin_bit_cast(unsigned, b); }
#define WAIT_BAR(N) asm volatile("s_waitcnt vmcnt(" #N ") lgkmcnt(0)\n\ts_barrier" ::: "memory")

__device__ __forceinline__ void qkt(f32x16& p0, f32x16& p1, const char* Kslot, const bf16x8* qr, const f32x16& negm, int r32, int hi) {
    const char* kb = Kslot + hi * 1024 + r32 * 16;
#pragma unroll
    for (int d0 = 0; d0 < 4; ++d0) {
        const bf16x8 b0 = *reinterpret_cast<const bf16x8*>(kb + d0 * 2048);
        const bf16x8 b1 = *reinterpret_cast<const bf16x8*>(kb + d0 * 2048 + 512);
        if (d0 == 0) { p0 = __builtin_amdgcn_mfma_f32_32x32x16_bf16(b0, qr[0], negm, 0, 0, 0); p1 = __builtin_amdgcn_mfma_f32_32x32x16_bf16(b1, qr[0], negm, 0, 0, 0); }
        else { p0 = __builtin_amdgcn_mfma_f32_32x32x16_bf16(b0, qr[d0], p0, 0, 0, 0); p1 = __builtin_amdgcn_mfma_f32_32x32x16_bf16(b1, qr[d0], p1, 0, 0, 0); } }
}
typedef __attribute__((address_space(3))) const char* lds_cptr;
typedef short v4i16_t __attribute__((ext_vector_type(4)));
__device__ __forceinline__ void kload8(bf16x8* kf, lds_cptr kp) {
    kf[0] = *(const __attribute__((address_space(3))) bf16x8*)(kp);        kf[1] = *(const __attribute__((address_space(3))) bf16x8*)(kp + 512);
    kf[2] = *(const __attribute__((address_space(3))) bf16x8*)(kp + 2048); kf[3] = *(const __attribute__((address_space(3))) bf16x8*)(kp + 2560);
    kf[4] = *(const __attribute__((address_space(3))) bf16x8*)(kp + 4096); kf[5] = *(const __attribute__((address_space(3))) bf16x8*)(kp + 4608);
    kf[6] = *(const __attribute__((address_space(3))) bf16x8*)(kp + 6144); kf[7] = *(const __attribute__((address_space(3))) bf16x8*)(kp + 6656);
}
__device__ __forceinline__ void kload2(bf16x8* kf, lds_cptr kp, int j) { kf[2 * j] = *(const __attribute__((address_space(3))) bf16x8*)(kp + j * 2048); kf[2 * j + 1] = *(const __attribute__((address_space(3))) bf16x8*)(kp + j * 2048 + 512); }
__device__ __forceinline__ s16x4 vtr(lds_cptr p) { return __builtin_bit_cast(s16x4, __builtin_amdgcn_ds_read_tr16_b64_v4i16((__attribute__((address_space(3))) v4i16_t*)p)); }
__device__ __forceinline__ float rowmax(const f32x16& p0, const f32x16& p1) {
    float a = max3f(p0[0], p0[1], p1[0]), b = max3f(p0[2], p0[3], p1[1]); a = max3f(a, p1[2], p1[3]);
#pragma unroll
    for (int r = 4; r < 16; r += 4) { a = max3f(a, p0[r], p0[r + 1]); b = max3f(b, p0[r + 2], p0[r + 3]); a = max3f(a, p1[r], p1[r + 1]); b = max3f(b, p1[r + 2], p1[r + 3]); }
    const float m = max2f(a, b);
    auto rr = __builtin_amdgcn_permlane32_swap(__float_as_uint(m), __float_as_uint(m), false, false);
    return max2f(__uint_as_float(rr[0]), __uint_as_float(rr[1]));
}
__device__ __forceinline__ void pv(f32x16* o, int vb, bf16x8 pa0, bf16x8 pa1, bf16x8 pa2, bf16x8 pa3) {
#pragma unroll
    for (int d0 = 0; d0 < 2; ++d0) { s16x4 lo[4], hi[4];
#pragma unroll
        for (int ks = 0; ks < 4; ++ks) {
            asm volatile("ds_read_b64_tr_b16 %0,%1 offset:%c2" : "=&v"(lo[ks]) : "v"(vb), "i"(d0 * 4096 + ks * 1024) : "memory");
            asm volatile("ds_read_b64_tr_b16 %0,%1 offset:%c2" : "=&v"(hi[ks]) : "v"(vb), "i"(d0 * 4096 + ks * 1024 + 512) : "memory"); }
        asm volatile("s_waitcnt lgkmcnt(0)" ::: "memory"); SBAR();
#define PK(k) (bf16x8){lo[k][0], lo[k][1], lo[k][2], lo[k][3], hi[k][0], hi[k][1], hi[k][2], hi[k][3]}
        o[d0] = __builtin_amdgcn_mfma_f32_32x32x16_bf16(pa0, PK(0), o[d0], 0, 0, 0);
        o[d0] = __builtin_amdgcn_mfma_f32_32x32x16_bf16(pa1, PK(1), o[d0], 0, 0, 0);
        o[d0] = __builtin_amdgcn_mfma_f32_32x32x16_bf16(pa2, PK(2), o[d0], 0, 0, 0);
        o[d0] = __builtin_amdgcn_mfma_f32_32x32x16_bf16(pa3, PK(3), o[d0], 0, 0, 0);
#undef PK
    }
}
__device__ __forceinline__ void cmask(f32x16& p0, f32x16& p1, int jb, int wid) {
    if (jb > (wid >> 1)) {
#pragma unroll
        for (int r = 0; r < 16; ++r) { p0[r] = -INFINITY; p1[r] = -INFINITY; } }
}
template <int THRL, bool MASK> __device__ __forceinline__ void attn_unit(int q0, int NT, const bf16* Qh, int qp, const bf16* __restrict__ Kh, int kp, const bf16* __restrict__ Vh, int vp, bf16* Oh, int op, char* shm) {
    const int tid = threadIdx.x, lane = tid & 63, r32 = lane & 31, hi = lane >> 5; const int wid = __builtin_amdgcn_readfirstlane(tid >> 6);
    const bf16* Qw = Qh + (long)(q0 + wid * QBLK) * qp;
    const unsigned lds0 = (unsigned)(uintptr_t)shm;
    float* wsf = (float*)(shm + LDS_WS) + wid * 64;
    const bf16* ksrc = Kh + (long)lane * kp + wid * 8;
    const bf16* vsrc = Vh + (long)(16 * (wid & 3) + (lane >> 2)) * vp + (wid >> 2) * 32 + (lane & 3) * 8;
    const unsigned kdst = lds0 + LDS_K + wid * 1024, vdst = lds0 + LDS_V + wid * 1024;
#define DMA_K(t, slot) glds16(ksrc + (long)(t) * KVBLK * kp, (unsigned)__builtin_amdgcn_readfirstlane(kdst + (slot)))
#define DMA_V(t, slot) glds16(vsrc + (long)(t) * KVBLK * vp, (unsigned)__builtin_amdgcn_readfirstlane(vdst + (slot)))
    const int vb0 = (int)(lds0 + LDS_V) + ((lane >> 4) & 1) * 32 + (lane & 3) * 8 + (4 * hi + ((lane & 15) >> 2)) * 64;
    const char* Kbase = shm + LDS_K; bf16x8 kf[8];
    const lds_cptr shm3 = (lds_cptr)shm; const lds_cptr kp0 = shm3 + LDS_K + hi * 1024 + r32 * 16; const lds_cptr vp0 = shm3 + LDS_V + ((lane >> 4) & 1) * 32 + (lane & 3) * 8 + (4 * hi + ((lane & 15) >> 2)) * 64;
    DMA_K(0, 0); DMA_V(0, 0); DMA_K(1, SLOTB);
    bf16x8 qr[4];
#pragma unroll
    for (int d0 = 0; d0 < 4; ++d0) qr[d0] = *reinterpret_cast<const bf16x8*>(&Qw[(long)r32 * qp + d0 * 16 + hi * 8]);
    float mhat = 0.f, l_reg = 0.f; f32x16 o[2]; o[0] = f32x16{}; o[1] = f32x16{}; f32x16 negm = f32x16{}; asm volatile("" : "+v"(negm));
#define CMASK(P0, P1, t) do { if (MASK) { int jb_ = (t) - (NT - 4); if (jb_ >= 0) cmask(P0, P1, jb_, wid); } } while (0)
    bool resc = false;
#define START(P0, P1) do { const float rm = rowmax(P0, P1); resc = false; \
    { const float dl = rm; mhat = fadd_s(mhat, dl); \
      _Pragma("unroll") for (int r = 0; r < 16; ++r) { P0[r] = fsub_s(P0[r], dl); P1[r] = fsub_s(P1[r], dl); } \
      _Pragma("unroll") for (int r = 0; r < 16; ++r) negm[r] = -mhat; asm volatile("" : "+v"(negm)); } \
    _Pragma("unroll") for (int r = 0; r < 16; ++r) P0[r] = __builtin_amdgcn_exp2f(P0[r]); } while (0)
#define RESC() do { if (resc) { asm volatile("s_waitcnt lgkmcnt(0)" ::: "memory"); \
      _Pragma("unroll") for (int d_ = 0; d_ < 2; ++d_) _Pragma("unroll") for (int r = 0; r < 16; ++r) o[d_][r] *= wsf[crow(r, hi)]; } } while (0)
    f32x16 pA0, pA1, pB0, pB1;
    int sl_prev = 0, sl_cur = 0, sl_next = SLOTB;
#define ROT() do { sl_prev = sl_cur; sl_cur = sl_next; sl_next = (sl_next == (NSLOT - 1) * SLOTB) ? 0 : sl_next + SLOTB; } while (0)
    DMA_K(2, 2 * SLOTB);
    WAIT_BAR(3);
    qkt(pA0, pA1, Kbase, qr, negm, r32, hi); asm volatile("s_nop 15\n\ts_nop 7" : "+v"(pA0), "+v"(pA1)); CMASK(pA0, pA1, 0);
    START(pA0, pA1);
    _Pragma("unroll") for (int r = 0; r < 16; ++r) pA1[r] = __builtin_amdgcn_exp2f(pA1[r]);
    WAIT_BAR(0);
    DMA_K(3, 0); DMA_V(1, SLOTB);
    ROT();
    kload8(kf, kp0 + sl_cur);
    WAIT_BAR(2);
    s16x4 vlo[8], vhi[8]; u32x4 pw0, pw1, pw2, pw3;
#define PKW(P, B) cvtpk_s(P[B], P[B + 1])
#define PAF(k) __builtin_bit_cast(bf16x8, pw##k)
#define VFR(i) (bf16x8){vlo[i][0], vlo[i][1], vlo[i][2], vlo[i][3], vhi[i][0], vhi[i][1], vhi[i][2], vhi[i][3]}
#define PIN(x) asm volatile("" : "+v"(x))
#define MX3(a, b, c) __builtin_fmaxf(__builtin_fmaxf((a), (b)), (c))
#define GAPA(MF, A0, A1, A2, A3, W0, W1, PW) do { MF; sacc += A0; sacc += A1; sacc += A2; sacc += A3; PIN(sacc); W0; W1; PIN(PW); SBAR(); } while (0)
#define EX(v) __builtin_amdgcn_exp2f(v)
#define GAPB(MF, X, B) do { MF; X[B] = EX(X[B]); X[B + 1] = EX(X[B + 1]); X[B + 2] = EX(X[B + 2]); X[B + 3] = EX(X[B + 3]); PIN(X); SBAR(); } while (0)
#define VRD(i) do { vlo[i] = vtr(vp_ + (((i) >> 2) * 4096 + ((i) & 3) * 1024)); vhi[i] = vtr(vp_ + (((i) >> 2) * 4096 + ((i) & 3) * 1024 + 512)); } while (0)
#define KRD(G, j) do { if (G) { kload2(kf, kp0 + sl_next, j); SBAR(); } } while (0)
#define STEP(C0, C1, P0, P1, t, GK, GV, GL) do { SBAR(); \
    const lds_cptr vp_ = vp0 + sl_prev; \
    VRD(0); SBAR(); float sacc = (P0[0] + P0[1]); \
    GAPA(C0 = __builtin_amdgcn_mfma_f32_32x32x16_bf16(kf[0], qr[0], negm, 0, 0, 0), P0[2], P0[3], P0[4], P0[5],     pw0[0] = PKW(P0, 0), pw0[1] = PKW(P0, 2), pw0); \
    VRD(4); SBAR(); GAPA(C1 = __builtin_amdgcn_mfma_f32_32x32x16_bf16(kf[1], qr[0], negm, 0, 0, 0), P0[6], P0[7], P0[8], P0[9],     pw0[2] = PKW(P0, 4), pw0[3] = PKW(P0, 6), pw0); \
    VRD(1); SBAR(); GAPA(C0 = __builtin_amdgcn_mfma_f32_32x32x16_bf16(kf[2], qr[1], C0, 0, 0, 0),   P0[10], P0[11], P0[12], P0[13], pw1[0] = PKW(P0, 8), pw1[1] = PKW(P0, 10), pw1); \
    VRD(5); SBAR(); GAPA(C1 = __builtin_amdgcn_mfma_f32_32x32x16_bf16(kf[3], qr[1], C1, 0, 0, 0),   P0[14], P0[15], P1[0], P1[1],   pw1[2] = PKW(P0, 12), pw1[3] = PKW(P0, 14), pw1); \
    VRD(2); SBAR(); GAPA(C0 = __builtin_amdgcn_mfma_f32_32x32x16_bf16(kf[4], qr[2], C0, 0, 0, 0),   P1[2], P1[3], P1[4], P1[5],     pw2[0] = PKW(P1, 0), pw2[1] = PKW(P1, 2), pw2); \
    VRD(6); SBAR(); GAPA(C1 = __builtin_amdgcn_mfma_f32_32x32x16_bf16(kf[5], qr[2], C1, 0, 0, 0),   P1[6], P1[7], P1[8], P1[9],     pw2[2] = PKW(P1, 4), pw2[3] = PKW(P1, 6), pw2); \
    VRD(3); SBAR(); GAPA(C0 = __builtin_amdgcn_mfma_f32_32x32x16_bf16(kf[6], qr[3], C0, 0, 0, 0),   P1[10], P1[11], P1[12], P1[13], pw3[0] = PKW(P1, 8), pw3[1] = PKW(P1, 10), pw3); \
    VRD(7); SBAR(); GAPA(C1 = __builtin_amdgcn_mfma_f32_32x32x16_bf16(kf[7], qr[3], C1, 0, 0, 0),   P1[14], P1[15], 0.f, 0.f,       pw3[2] = PKW(P1, 12), pw3[3] = PKW(P1, 14), pw3); \
    l_reg += sacc; \
    if (GK) { DMA_K((t) + 3, sl_cur); } if (GV) { DMA_V((t) + 1, sl_next); } \
    CMASK(C0, C1, t); \
    { float a = MX3(C0[0], C0[1], C1[0]), b = MX3(C0[2], C0[3], C1[1]); a = MX3(a, C1[2], C1[3]); \
      _Pragma("unroll") for (int r = 4; r < 16; r += 4) { a = MX3(a, C0[r], C0[r + 1]); b = MX3(b, C0[r + 2], C0[r + 3]); a = MX3(a, C1[r], C1[r + 1]); b = MX3(b, C1[r + 2], C1[r + 3]); } \
      float rm = __builtin_fmaxf(a, b); { auto rr = __builtin_amdgcn_permlane32_swap(__float_as_uint(rm), __float_as_uint(rm), false, false); rm = __builtin_fmaxf(__uint_as_float(rr[0]), __uint_as_float(rr[1])); } \
      resc = false; \
      if (__builtin_expect(__any(rm > (float)THRL), 0)) { const float dl = __builtin_fmaxf(rm, 0.f); mhat += dl; \
        _Pragma("unroll") for (int r = 0; r < 16; ++r) { C0[r] -= dl; C1[r] -= dl; } \
        _Pragma("unroll") for (int r = 0; r < 16; ++r) negm[r] = -mhat; asm volatile("" : "+v"(negm)); \
        const float f = __builtin_amdgcn_exp2f(-dl); l_reg *= f; if (hi == 0) wsf[r32] = f; resc = true; } } \
    SBAR(); \
    GAPB(o[0] = __builtin_amdgcn_mfma_f32_32x32x16_bf16(PAF(0), VFR(0), o[0], 0, 0, 0), C0, 0); \
    GAPB(o[1] = __builtin_amdgcn_mfma_f32_32x32x16_bf16(PAF(0), VFR(4), o[1], 0, 0, 0), C0, 4); \
    KRD(GL, 0); GAPB(o[0] = __builtin_amdgcn_mfma_f32_32x32x16_bf16(PAF(1), VFR(1), o[0], 0, 0, 0), C0, 8); \
    KRD(GL, 1); GAPB(o[1] = __builtin_amdgcn_mfma_f32_32x32x16_bf16(PAF(1), VFR(5), o[1], 0, 0, 0), C0, 12); \
    KRD(GL, 2); GAPB(o[0] = __builtin_amdgcn_mfma_f32_32x32x16_bf16(PAF(2), VFR(2), o[0], 0, 0, 0), C1, 0); \
    KRD(GL, 3); GAPB(o[1] = __builtin_amdgcn_mfma_f32_32x32x16_bf16(PAF(2), VFR(6), o[1], 0, 0, 0), C1, 4); \
    GAPB(o[0] = __builtin_amdgcn_mfma_f32_32x32x16_bf16(PAF(3), VFR(3), o[0], 0, 0, 0), C1, 8); \
    GAPB(o[1] = __builtin_amdgcn_mfma_f32_32x32x16_bf16(PAF(3), VFR(7), o[1], 0, 0, 0), C1, 12); \
    } while (0)
    int t = 1;
#undef CMASK
#define CMASK(P0, P1, t) do {} while (0)
    for (; t + 5 < NT; t += 2) {
        STEP(pB0, pB1, pA0, pA1, t, true, true, true);     WAIT_BAR(2); RESC(); ROT();
        STEP(pA0, pA1, pB0, pB1, t + 1, true, true, true); WAIT_BAR(2); RESC(); ROT();
    }
#undef CMASK
#define CMASK(P0, P1, t) do { if (MASK) { int jb_ = (t) - (NT - 4); if (jb_ >= 0) cmask(P0, P1, jb_, wid); } } while (0)
#define ENDW(tt) do { if ((tt) + 3 < NT) { WAIT_BAR(2); } else if ((tt) + 2 < NT) { WAIT_BAR(1); } else { WAIT_BAR(0); } } while (0)
    for (; t + 1 < NT; t += 2) {
        STEP(pB0, pB1, pA0, pA1, t, (t + 3 < NT), (t + 1 < NT), (t + 1 < NT));       ENDW(t);     RESC(); ROT();
        STEP(pA0, pA1, pB0, pB1, t + 1, (t + 4 < NT), (t + 2 < NT), (t + 2 < NT));   ENDW(t + 1); RESC(); ROT();
    }
    STEP(pB0, pB1, pA0, pA1, NT - 1, false, false, false); RESC();
    { float sacc = pB0[0] + pB0[1]; _Pragma("unroll") for (int r = 2; r < 16; ++r) sacc += pB0[r]; _Pragma("unroll") for (int r = 0; r < 16; ++r) sacc += pB1[r]; l_reg += sacc;
      pw0 = (u32x4){PKW(pB0, 0), PKW(pB0, 2), PKW(pB0, 4), PKW(pB0, 6)}; pw1 = (u32x4){PKW(pB0, 8), PKW(pB0, 10), PKW(pB0, 12), PKW(pB0, 14)}; pw2 = (u32x4){PKW(pB1, 0), PKW(pB1, 2), PKW(pB1, 4), PKW(pB1, 6)}; pw3 = (u32x4){PKW(pB1, 8), PKW(pB1, 10), PKW(pB1, 12), PKW(pB1, 14)};
      SBAR(); pv(o, vb0 + sl_cur, PAF(0), PAF(1), PAF(2), PAF(3)); }
#undef PKW
#undef PAF
#undef VFR
#undef PIN
#undef MX3
#undef GAPA
#undef GAPB
#undef EX
#undef VRD
#undef KRD
#undef STEP
#undef ENDW
    { auto rr = __builtin_amdgcn_permlane32_swap(__float_as_uint(l_reg), __float_as_uint(l_reg), false, false); l_reg = __uint_as_float(rr[0]) + __uint_as_float(rr[1]); }
    if (hi == 0) wsf[32 + r32] = l_reg; asm volatile("s_waitcnt lgkmcnt(0)" ::: "memory");
    float rli[16];
#pragma unroll
    for (int r = 0; r < 16; ++r) rli[r] = __builtin_amdgcn_rcpf(wsf[32 + crow(r, hi)]);
    bf16* Ow = Oh + (long)(q0 + wid * QBLK) * op;
    { bf16* stg = (bf16*)(shm + LDS_OST) + wid * 2048;
#pragma unroll
      for (int r = 0; r < 16; ++r) { const int orow = crow(r, hi);
#pragma unroll
        for (int d0 = 0; d0 < 2; ++d0) stg[orow * 64 + d0 * 32 + r32] = __float2bfloat16(o[d0][r] * rli[r]); }
      asm volatile("s_waitcnt lgkmcnt(0)" ::: "memory");
#pragma unroll
      for (int i = 0; i < 4; ++i) { const int row = i * 8 + (lane >> 3), ch = lane & 7; const u32x4 v = *(const u32x4*)(stg + row * 64 + ch * 8); *(u32x4*)(Ow + (long)row * op + ch * 8) = v; } }
    asm volatile("s_waitcnt lgkmcnt(0)\n\ts_barrier" ::: "memory");
#undef DMA_K
#undef DMA_V
#undef CMASK
#undef START
#undef RESC
#undef ROT
}

constexpr int L2_K = 0, L2_V = 3 * 8192, L2_WS = L2_V + 4 * 16384, L2_OST = L2_WS + NW * 64 * 4, L2_BYTES = L2_OST + NW * 4096;
template <bool MASK> __device__ __forceinline__ void attn_unit2(int q0, int NT, const bf16* Qh, int qp, const bf16* __restrict__ Kh, int kp, const bf16* __restrict__ Vh, int vp, bf16* Oh, int op, char* shm) {
    const int tid = threadIdx.x, lane = tid & 63, r32 = lane & 31, hi = lane >> 5; const int wid = __builtin_amdgcn_readfirstlane(tid >> 6);
    const bf16* Qw = Qh + (long)(q0 + wid * QBLK) * qp;
    const unsigned lds0 = (unsigned)(uintptr_t)shm;
    float* wsf = (float*)(shm + L2_WS) + wid * 64;
    const bf16* ksrc = Kh + (long)lane * kp + wid * 8;
    const bf16* vsrc = Vh + (long)(16 * (wid & 3) + (lane >> 2)) * vp + (wid >> 2) * 32 + (lane & 3) * 8;
    const unsigned kdst = lds0 + L2_K + wid * 1024, vdst = lds0 + L2_V + wid * 1024;
#define DMA_K(t, slot) glds16(ksrc + (long)(t) * KVBLK * kp, (unsigned)__builtin_amdgcn_readfirstlane(kdst + (slot)))
#define DMA_V(t, vslot) do { glds16(vsrc + (long)(t) * KVBLK * vp, (unsigned)__builtin_amdgcn_readfirstlane(vdst + (vslot))); \
                            glds16(vsrc + (long)(t) * KVBLK * vp + 64, (unsigned)__builtin_amdgcn_readfirstlane(vdst + (vslot) + 8192)); } while (0)
    const int vb0 = (int)(lds0 + L2_V) + ((lane >> 4) & 1) * 32 + (lane & 3) * 8 + (4 * hi + ((lane & 15) >> 2)) * 64;
    const char* Kbase = shm + L2_K; bf16x8 kf[8];
    const lds_cptr shm3 = (lds_cptr)shm; const lds_cptr kp0 = shm3 + L2_K + hi * 1024 + r32 * 16; const lds_cptr vp0 = shm3 + L2_V + ((lane >> 4) & 1) * 32 + (lane & 3) * 8 + (4 * hi + ((lane & 15) >> 2)) * 64;
    DMA_K(0, 0); DMA_V(0, 0); DMA_K(1, SLOTB);
    bf16x8 qr[4];
#pragma unroll
    for (int d0 = 0; d0 < 4; ++d0) qr[d0] = *reinterpret_cast<const bf16x8*>(&Qw[(long)r32 * qp + d0 * 16 + hi * 8]);
    float l_reg = 0.f; f32x16 o[4]; o[0] = f32x16{}; o[1] = f32x16{}; o[2] = f32x16{}; o[3] = f32x16{};
    const f32x16 zero16 = f32x16{};
#define CMASK(P0, P1, t) do { if (MASK) { int jb_ = (t) - (NT - 4); if (jb_ >= 0) cmask(P0, P1, jb_, wid); } } while (0)
    f32x16 pA0, pA1, pB0, pB1;
    int sl_prev = 0, sl_cur = 0, sl_next = SLOTB;
    int vs_rd = 0, vs_wr = 3 * 16384;
#define ROT() do { sl_prev = sl_cur; sl_cur = sl_next; sl_next = (sl_next == (NSLOT - 1) * SLOTB) ? 0 : sl_next + SLOTB; vs_rd = (vs_rd + 16384) & 65535; vs_wr = (vs_wr + 16384) & 65535; } while (0)
    DMA_K(2, 2 * SLOTB); DMA_V(1, 16384);
    WAIT_BAR(6);
    qkt(pA0, pA1, Kbase, qr, zero16, r32, hi); CMASK(pA0, pA1, 0);
    _Pragma("unroll") for (int r = 0; r < 16; ++r) { pA0[r] = __builtin_amdgcn_exp2f(pA0[r]); pA1[r] = __builtin_amdgcn_exp2f(pA1[r]); }
    WAIT_BAR(2);
    DMA_K(3, 0); DMA_V(2, 2 * 16384);
    sl_prev = sl_cur; sl_cur = sl_next; sl_next = 2 * SLOTB;
    kload8(kf, kp0 + sl_cur);
    WAIT_BAR(5);
    s16x4 f0lo, f0hi, f1lo, f1hi, f2lo, f2hi, f3lo, f3hi; u32x4 pw0, pw1, pw2, pw3;
#define PKW(P, B) cvtpk_s(P[B], P[B + 1])
#define PAF(k) __builtin_bit_cast(bf16x8, pw##k)
#define PIN(x) asm volatile("" : "+v"(x))
#define EX(v) __builtin_amdgcn_exp2f(v)
#define VOFF(id) ((((id) >> 2) * 4096) + (((id) & 3) * 1024))
#define VRD2(F, id) do { F##lo = vtr(vp_ + VOFF(id)); F##hi = vtr(vp_ + VOFF(id) + 512); } while (0)
#define VFR2(F) (bf16x8){F##lo[0], F##lo[1], F##lo[2], F##lo[3], F##hi[0], F##hi[1], F##hi[2], F##hi[3]}
#define GAPA(MF, A0, A1, A2, A3, W0, W1, PW) do { MF; sacc += A0; sacc += A1; sacc += A2; sacc += A3; PIN(sacc); W0; W1; PIN(PW); SBAR(); } while (0)
#define GAPB(MF, RD, X, B) do { MF; RD; X[B] = EX(X[B]); X[B + 1] = EX(X[B + 1]); PIN(X); SBAR(); } while (0)
#define KRD(G, j) do { if (G) { kload2(kf, kp0 + sl_next, j); SBAR(); } } while (0)
#define MF32(a, b, c) __builtin_amdgcn_mfma_f32_32x32x16_bf16(a, b, c, 0, 0, 0)
#define STEP(C0, C1, P0, P1, t, GK, GV, GL) do { SBAR(); __builtin_amdgcn_s_setprio(ATTN_PRIO_A); \
    const lds_cptr vp_ = vp0 + vs_rd; \
    float sacc = (P0[0] + P0[1]); \
    GAPA(C0 = MF32(kf[0], qr[0], zero16), P0[2], P0[3], P0[4], P0[5],     pw0[0] = PKW(P0, 0), pw0[1] = PKW(P0, 2), pw0); \
    GAPA(C1 = MF32(kf[1], qr[0], zero16), P0[6], P0[7], P0[8], P0[9],     pw0[2] = PKW(P0, 4), pw0[3] = PKW(P0, 6), pw0); \
    GAPA(C0 = MF32(kf[2], qr[1], C0),     P0[10], P0[11], P0[12], P0[13], pw1[0] = PKW(P0, 8), pw1[1] = PKW(P0, 10), pw1); \
    GAPA(C1 = MF32(kf[3], qr[1], C1),     P0[14], P0[15], P1[0], P1[1],   pw1[2] = PKW(P0, 12), pw1[3] = PKW(P0, 14), pw1); \
    VRD2(f0, 0); SBAR();  GAPA(C0 = MF32(kf[4], qr[2], C0), P1[2], P1[3], P1[4], P1[5],     pw2[0] = PKW(P1, 0), pw2[1] = PKW(P1, 2), pw2); \
    VRD2(f1, 4); SBAR();  GAPA(C1 = MF32(kf[5], qr[2], C1), P1[6], P1[7], P1[8], P1[9],     pw2[2] = PKW(P1, 4), pw2[3] = PKW(P1, 6), pw2); \
    VRD2(f2, 8); SBAR();  GAPA(C0 = MF32(kf[6], qr[3], C0), P1[10], P1[11], P1[12], P1[13], pw3[0] = PKW(P1, 8), pw3[1] = PKW(P1, 10), pw3); \
    VRD2(f3, 12); SBAR(); GAPA(C1 = MF32(kf[7], qr[3], C1), P1[14], P1[15], 0.f, 0.f,       pw3[2] = PKW(P1, 12), pw3[3] = PKW(P1, 14), pw3); \
    l_reg += sacc; __builtin_amdgcn_s_setprio(0); \
    if (GK) { DMA_K((t) + 3, sl_cur); } if (GV) { DMA_V((t) + 2, vs_wr); } \
    CMASK(C0, C1, t); \
    SBAR(); __builtin_amdgcn_s_setprio(ATTN_PRIO_B); \
    GAPB(o[0] = MF32(PAF(0), VFR2(f0), o[0]), VRD2(f0, 1),  C0, 0); \
    GAPB(o[1] = MF32(PAF(0), VFR2(f1), o[1]), VRD2(f1, 5),  C0, 2); \
    GAPB(o[2] = MF32(PAF(0), VFR2(f2), o[2]), VRD2(f2, 9),  C0, 4); \
    GAPB(o[3] = MF32(PAF(0), VFR2(f3), o[3]), VRD2(f3, 13), C0, 6); \
    KRD(GL, 0); GAPB(o[0] = MF32(PAF(1), VFR2(f0), o[0]), VRD2(f0, 2),  C0, 8); \
    GAPB(o[1] = MF32(PAF(1), VFR2(f1), o[1]), VRD2(f1, 6),  C0, 10); \
    KRD(GL, 1); GAPB(o[2] = MF32(PAF(1), VFR2(f2), o[2]), VRD2(f2, 10), C0, 12); \
    GAPB(o[3] = MF32(PAF(1), VFR2(f3), o[3]), VRD2(f3, 14), C0, 14); \
    KRD(GL, 2); GAPB(o[0] = MF32(PAF(2), VFR2(f0), o[0]), VRD2(f0, 3),  C1, 0); \
    GAPB(o[1] = MF32(PAF(2), VFR2(f1), o[1]), VRD2(f1, 7),  C1, 2); \
    KRD(GL, 3); GAPB(o[2] = MF32(PAF(2), VFR2(f2), o[2]), VRD2(f2, 11), C1, 4); \
    GAPB(o[3] = MF32(PAF(2), VFR2(f3), o[3]), VRD2(f3, 15), C1, 6); \
    GAPB(o[0] = MF32(PAF(3), VFR2(f0), o[0]), (void)0, C1, 8); \
    GAPB(o[1] = MF32(PAF(3), VFR2(f1), o[1]), (void)0, C1, 10); \
    GAPB(o[2] = MF32(PAF(3), VFR2(f2), o[2]), (void)0, C1, 12); \
    GAPB(o[3] = MF32(PAF(3), VFR2(f3), o[3]), (void)0, C1, 14); __builtin_amdgcn_s_setprio(0); \
    } while (0)
    int t = 1;
#undef CMASK
#define CMASK(P0, P1, t) do {} while (0)
    for (; t + 5 < NT; t += 2) {
        STEP(pB0, pB1, pA0, pA1, t, true, true, true);     WAIT_BAR(5); ROT();
        STEP(pA0, pA1, pB0, pB1, t + 1, true, true, true); WAIT_BAR(5); ROT();
    }
#undef CMASK
#define CMASK(P0, P1, t) do { if (MASK) { int jb_ = (t) - (NT - 4); if (jb_ >= 0) cmask(P0, P1, jb_, wid); } } while (0)
#define ENDW(tt) do { if ((tt) + 3 < NT) { WAIT_BAR(5); } else if ((tt) + 2 < NT) { WAIT_BAR(4); } else { WAIT_BAR(0); } } while (0)
    for (; t + 1 < NT; t += 2) {
        STEP(pB0, pB1, pA0, pA1, t, (t + 3 < NT), (t + 2 < NT), (t + 1 < NT));       ENDW(t);     ROT();
        STEP(pA0, pA1, pB0, pB1, t + 1, (t + 4 < NT), (t + 3 < NT), (t + 2 < NT));   ENDW(t + 1); ROT();
    }
    STEP(pB0, pB1, pA0, pA1, NT - 1, false, false, false);
    { float sacc = pB0[0] + pB0[1]; _Pragma("unroll") for (int r = 2; r < 16; ++r) sacc += pB0[r]; _Pragma("unroll") for (int r = 0; r < 16; ++r) sacc += pB1[r]; l_reg += sacc;
      pw0 = (u32x4){PKW(pB0, 0), PKW(pB0, 2), PKW(pB0, 4), PKW(pB0, 6)}; pw1 = (u32x4){PKW(pB0, 8), PKW(pB0, 10), PKW(pB0, 12), PKW(pB0, 14)}; pw2 = (u32x4){PKW(pB1, 0), PKW(pB1, 2), PKW(pB1, 4), PKW(pB1, 6)}; pw3 = (u32x4){PKW(pB1, 8), PKW(pB1, 10), PKW(pB1, 12), PKW(pB1, 14)};
      SBAR();
      const lds_cptr vp_ = vp0 + ((vs_rd + 16384) & 65535);
#pragma unroll
      for (int db = 0; db < 4; ++db) { VRD2(f0, db * 4 + 0); VRD2(f1, db * 4 + 1); VRD2(f2, db * 4 + 2); VRD2(f3, db * 4 + 3);
          o[db] = MF32(PAF(0), VFR2(f0), o[db]); o[db] = MF32(PAF(1), VFR2(f1), o[db]); o[db] = MF32(PAF(2), VFR2(f2), o[db]); o[db] = MF32(PAF(3), VFR2(f3), o[db]); } }
#undef PKW
#undef PAF
#undef PIN
#undef EX
#undef VOFF
#undef VRD2
#undef VFR2
#undef GAPA
#undef GAPB
#undef KRD
#undef MF32
#undef STEP
#undef ENDW
    { auto rr = __builtin_amdgcn_permlane32_swap(__float_as_uint(l_reg), __float_as_uint(l_reg), false, false); l_reg = __uint_as_float(rr[0]) + __uint_as_float(rr[1]); }
    if (hi == 0) wsf[32 + r32] = l_reg; asm volatile("s_waitcnt lgkmcnt(0)" ::: "memory");
    float rli[16];
#pragma unroll
    for (int r = 0; r < 16; ++r) rli[r] = __builtin_amdgcn_rcpf(wsf[32 + crow(r, hi)]);
    bf16* Ow = Oh + (long)(q0 + wid * QBLK) * op;
    { bf16* stg = (bf16*)(shm + L2_OST) + wid * 2048;
#pragma unroll
      for (int dh = 0; dh < 2; ++dh) {
#pragma unroll
        for (int r = 0; r < 16; ++r) { const int orow = crow(r, hi);
#pragma unroll
          for (int d0 = 0; d0 < 2; ++d0) stg[orow * 64 + d0 * 32 + r32] = __float2bfloat16(o[dh * 2 + d0][r] * rli[r]); }
        asm volatile("s_waitcnt lgkmcnt(0)" ::: "memory");
#pragma unroll
        for (int i = 0; i < 4; ++i) { const int row = i * 8 + (lane >> 3), ch = lane & 7; const u32x4 v = *(const u32x4*)(stg + row * 64 + ch * 8); *(u32x4*)(Ow + (long)row * op + dh * 64 + ch * 8) = v; }
        asm volatile("s_waitcnt lgkmcnt(0)" ::: "memory"); } }
    asm volatile("s_waitcnt lgkmcnt(0)\n\ts_barrier" ::: "memory");
#undef DMA_K
#undef DMA_V
#undef CMASK
#undef ROT
}
#undef SBAR
#undef WAIT_BAR
}

#define XB_TMO      128
#define XB_XCNT(j)  (256  + 64 * (j))
#define XB_XSUB(j)  (1280 + 64 * (j))
#define XB_XGEN(j)  (2304 + 64 * (j))
#define XB_TOP      3328
#define XB_TOPGEN   3392
#define XCD_BAR_WORDS 3456
#define XB_SPIN_CAP (1u << 22)
__device__ __forceinline__ unsigned xb_ld(unsigned* p)              { return __hip_atomic_load(p, __ATOMIC_RELAXED, __HIP_MEMORY_SCOPE_AGENT); }
__device__ __forceinline__ unsigned xb_add(unsigned* p, unsigned v) { return __hip_atomic_fetch_add(p, v, __ATOMIC_RELAXED, __HIP_MEMORY_SCOPE_AGENT); }
__device__ __forceinline__ unsigned xb_xcc_id() { return (unsigned)__builtin_amdgcn_s_getreg((3 << 11) | 20) & 0xFu; }
#define XB_SPIN(cond, bar) do { unsigned _sp = 0; while (cond) { __builtin_amdgcn_s_sleep(1); \
    if ((++_sp & 255u) == 0u) { if (xb_ld(&(bar)[XB_TMO])) break; if (_sp > XB_SPIN_CAP) { atomicAdd(&(bar)[XB_TMO], 1u); break; } } } } while (0)
struct XcdBarrier { unsigned* bar; unsigned x; volatile LAS unsigned* st; };
__device__ __forceinline__ XcdBarrier xcd_barrier_post(unsigned* bar, volatile LAS unsigned* st) {
    XcdBarrier b; b.bar = bar; b.x = xb_xcc_id(); b.st = st;
    if (threadIdx.x == 0) (void)xb_add(&bar[XB_XCNT(b.x)], 1u);
    return b;
}
__device__ __forceinline__ void xcd_barrier_complete(unsigned* bar, unsigned x, unsigned& nloc, unsigned& nx) {
    const unsigned G = gridDim.x * gridDim.y * gridDim.z;
    unsigned sum, cnt, mine, sp = 0u;
    for (;;) {
        sum = 0u; cnt = 0u; mine = 0u;
#pragma unroll
        for (unsigned j = 0; j < 16; ++j) { const unsigned c = xb_ld(&bar[XB_XCNT(j)]); sum += c; cnt += (c > 0u) ? 1u : 0u; mine = (j == x) ? c : mine; }
        if (sum == G) break;
        __builtin_amdgcn_s_sleep(1);
        if ((++sp & 255u) == 0u) { if (xb_ld(&bar[XB_TMO])) break; if (sp > XB_SPIN_CAP) { atomicAdd(&bar[XB_TMO], 1u); break; } }
    }
    nloc = mine > 0u ? mine : 1u; nx = cnt > 0u ? cnt : 1u;
}
__device__ __forceinline__ void xcd_barrier(const XcdBarrier& b) {
    asm volatile("s_waitcnt vmcnt(0)" ::: "memory");
    __syncthreads();
    if (threadIdx.x == 0) {
        unsigned* bar = b.bar;
        __builtin_amdgcn_s_waitcnt(0);
        unsigned nloc = b.st[0], nx = b.st[1];
        if (nloc == 0u) { xcd_barrier_complete(bar, b.x, nloc, nx); b.st[0] = nloc; b.st[1] = nx; }
        const unsigned old = xb_add(&bar[XB_XSUB(b.x)], 1u);
        const unsigned gen = old / nloc;
        if (old + 1u == (gen + 1u) * nloc) {
            __builtin_amdgcn_fence(__ATOMIC_RELEASE, "agent");
            asm volatile("s_waitcnt vmcnt(0)" ::: "memory");
            const unsigned og = xb_add(&bar[XB_TOP], 1u);
            const unsigned tg = og / nx;
            if (og + 1u == (tg + 1u) * nx) xb_add(&bar[XB_TOPGEN], 1u);
            else XB_SPIN(xb_ld(&bar[XB_TOPGEN]) == tg, bar);
            __builtin_amdgcn_fence(__ATOMIC_ACQUIRE, "agent");
            xb_add(&bar[XB_XGEN(b.x)], 1u);
            asm volatile("s_waitcnt vmcnt(0)" ::: "memory");
        } else {
            XB_SPIN(xb_ld(&bar[XB_XGEN(b.x)]) == gen, bar);
            __builtin_amdgcn_fence(__ATOMIC_ACQUIRE, "agent");
            asm volatile("s_waitcnt vmcnt(0)" ::: "memory");
        }
    }
    __syncthreads();
}

constexpr int RING_BYTES = 131072;
constexpr int MISC_OFF = RING_BYTES;
constexpr int LDS_BYTES = 147456;
constexpr int NWAVES = 8;

struct Args {
    const float* in[29]; float* out; unsigned char* ws; int ph_lo, ph_hi;
};
enum { I_X = 0, I_MEM, I_NORM1, I_WIN, I_BGATE, I_QN, I_KN, I_LQ1, I_LK1, I_LQ2, I_LK2, I_SUBLN, I_WPOOL, I_PSCALE, I_MEMNORM, I_WMKV, I_MQN, I_MKN, I_WBRD, I_WBRP, I_WBRM, I_WOUT, I_NORM2,
       I_WROUTER, I_BROUTER, I_WGU, I_BGU, I_WD, I_BD };

__device__ __forceinline__ unsigned f2bf(float f) { unsigned u = __builtin_bit_cast(unsigned, f); return (u + 0x7fffu + ((u >> 16) & 1u)) >> 16; }
__device__ __forceinline__ unsigned pk2(float lo, float hi) { return f2bf(lo) | (f2bf(hi) << 16); }
__device__ __forceinline__ void p0_transpose_item(const float* W, int K, int N, bf16_t* WT, LAS float* scr, int item, int lane, int ldo = 0) {
    if (ldo == 0) ldo = K;
    const int nblk = N / 64, kb = item / nblk, nb = item % nblk, k0 = 64 * kb, n0 = 64 * nb;
    const int kr = lane >> 3, n4 = (lane & 7) * 4;
    f32x4 v[16];
#pragma unroll
    for (int i = 0; i < 16; ++i) v[i] = *(const f32x4*)(W + (size_t)(k0 + 8 * (i & 7) + kr) * N + n0 + 32 * (i >> 3) + n4);
#pragma unroll
    for (int h = 0; h < 2; ++h) {
#pragma unroll
        for (int i = 0; i < 8; ++i)
#pragma unroll
            for (int j = 0; j < 4; ++j) scr[(n4 + j) * 68 + 8 * i + kr] = v[h * 8 + i][j];
        LDS_WAIT(); asm volatile("" ::: "memory");
        const int c = lane & 7;
#pragma unroll
        for (int jj = 0; jj < 4; ++jj) { const int nrow = 8 * jj + (lane >> 3); const LAS f32x4* sp = (const LAS f32x4*)(scr + nrow * 68 + 8 * c);
            const f32x4 a = sp[0], b = sp[1];
            u32x4 o; o.x = pk2(a[0], a[1]); o.y = pk2(a[2], a[3]); o.z = pk2(b[0], b[1]); o.w = pk2(b[2], b[3]);
            *(u32x4*)(WT + (size_t)(n0 + 32 * h + nrow) * ldo + k0 + 8 * c) = o; }
        LDS_WAIT(); asm volatile("" ::: "memory");
    }
}
__device__ __forceinline__ void rms_row_to_bf16(const float* xrow, const float* gain, bf16_t* orow, int lane) {
    const f32x4* xr = (const f32x4*)xrow + lane; const f32x4* gr = (const f32x4*)gain + lane;
    f32x4 v[4]; float s = 0.f;
#pragma unroll
    for (int j = 0; j < 4; ++j) { v[j] = xr[64 * j]; s += (v[j].x * v[j].x + v[j].y * v[j].y) + (v[j].z * v[j].z + v[j].w * v[j].w); }
    const float rstd = 1.f / sqrtf(wave_sum(s) * (1.f / 1024.f) + RMS_EPS);
    u32x2* o8 = (u32x2*)orow + lane;
#pragma unroll
    for (int j = 0; j < 4; ++j) { const f32x4 g = gr[64 * j]; u32x2 w; w.x = pk2(v[j].x * rstd * g.x, v[j].y * rstd * g.y); w.y = pk2(v[j].z * rstd * g.z, v[j].w * rstd * g.w); o8[64 * j] = w; }
}

struct Args;
typedef __attribute__((address_space(4))) const Args* kargs_t;
__device__ __forceinline__ kargs_t kargs() { kargs_t p = (kargs_t)__builtin_amdgcn_kernarg_segment_ptr(); asm volatile("" : "+s"(p)); return p; }
__global__ void __launch_bounds__(NWAVES * 64, 2) fwd_kernel(Args args) {
    extern __shared__ __attribute__((aligned(16))) unsigned char lds_raw[];
    cg::grid_group grid = cg::this_grid();
    LAS unsigned char* lds = (LAS unsigned char*)lds_raw;
    const int tid = threadIdx.x, lane = tid & 63, wave = __builtin_amdgcn_readfirstlane(tid >> 6);
    const int G = gridDim.x, bx = blockIdx.x; const int vcu = (G % 8 == 0) ? (bx % 8) * (G / 8) + bx / 8 : bx;
    const int gw = vcu * NWAVES + wave, NGW = G * NWAVES;
    const int lo = args.ph_lo, hi = args.ph_hi;
    if (tid < 64) ((LAS unsigned*)(lds + MISC_OFF + 1024))[tid] = 0u;
    __syncthreads();
    const XcdBarrier xbar = xcd_barrier_post((unsigned*)(args.ws + WS_CTL) + CW_BAR, (volatile LAS unsigned*)(lds + MISC_OFF + 1024));
#ifndef PHMASK
#define PHMASK 0x3ff
#endif
#define IN(k) (((PHMASK >> (k)) & 1) && lo <= (k) && (k) < hi)
#define GSYNC() do { asm volatile("s_waitcnt vmcnt(0) lgkmcnt(0)" ::: "memory"); __syncthreads(); grid.sync(); asm volatile("s_waitcnt vmcnt(0)" ::: "memory"); __syncthreads(); } while (0)
#define SEAM(k) do { if (lo <= (k) && (k) + 1 < hi) { xcd_barrier(xbar); } } while (0)
#define WSP(TY, off) ((TY*)(ka->ws + (off)))
#define WIN_T WSP(bf16_t, WS_WIN_T)
#define WBRD_T WSP(bf16_t, WS_WBRD_T)
#define WBRP_T WSP(bf16_t, WS_WBRP_T)
#define WBRM_T WSP(bf16_t, WS_WBRM_T)
#define WOUT_T WSP(bf16_t, WS_WOUT_T)
#define WMKV_T WSP(bf16_t, WS_WMKV_T)
#define WGU_T WSP(bf16_t, WS_WGU_T)
#define WD_T WSP(bf16_t, WS_WD_T)
#define XN WSP(bf16_t, WS_XN)
#define Qb WSP(bf16_t, WS_Q)
#define Kb WSP(bf16_t, WS_K)
#define Vb WSP(bf16_t, WS_V)
#define Ub WSP(bf16_t, WS_U)
#define MQb WSP(bf16_t, WS_MQ)
#define OC WSP(bf16_t, WS_OC)
#define GATES WSP(bf16_t, WS_GATES)
#define YCAT WSP(bf16_t, WS_YCAT)
#define MERGF WSP(float, WS_MERGF)
#define MERGB WSP(bf16_t, WS_MERGB)
#define XG WSP(bf16_t, WS_XG)
#define ACT WSP(bf16_t, WS_A)
#define Y4 WSP(bf16_t, WS_B)
#define MEMN WSP(bf16_t, WS_MEMN)
#define MKV WSP(bf16_t, WS_MKV)
#define ROPE WSP(f32x2, WS_ROPE)
#define WR2 WSP(float, WS_WR2)
#define ROUTEW WSP(float, WS_ROUTEW)
#define LAMP WSP(float, WS_LAM)
#define LIST WSP(u32x2, WS_LIST)
#define CNT WSP(unsigned, WS_CTL)
#define OUT (ka->out)
#define KA const kargs_t ka = kargs()

    if (lo > 1000) GSYNC();
    if (IN(0)) for (int rep_ = 0; rep_ < 1 + ((REPEAT_MASK >> 0) & 1); ++rep_) { KA; if (rep_) __syncthreads();
        LAS float* scr = (LAS float*)(lds + wave * 16384);
        constexpr int I0 = 16 * 80, I1 = 8 * 16, I2 = 4 * 16, I3 = 4 * 16, I4 = 16 * 16, I5 = 16 * 8, I6 = 32 * 512, I7 = 32 * 256;
        constexpr int NITEMS = I0 + I1 + I2 + I3 + I4 + I5 + I6 + I7;
        for (int it = gw; it < NITEMS; it += NGW) {
            int r = it;
            if (r < I0) { p0_transpose_item(ka->in[I_WIN], 1024, 5120, WIN_T, scr, r, lane); continue; } r -= I0;
            if (r < I1) { p0_transpose_item(ka->in[I_WBRD], 512, 1024, WBRD_T, scr, r, lane, 1024); continue; } r -= I1;
            if (r < I2) { p0_transpose_item(ka->in[I_WBRP], 256, 1024, WBRD_T + 512, scr, r, lane, 1024); continue; } r -= I2;
            if (r < I3) { p0_transpose_item(ka->in[I_WBRM], 256, 1024, WBRD_T + 768, scr, r, lane, 1024); continue; } r -= I3;
            if (r < I4) { p0_transpose_item(ka->in[I_WOUT], 1024, 1024, WOUT_T, scr, r, lane); continue; } r -= I4;
            if (r < I5) { p0_transpose_item(ka->in[I_WMKV], 1024, 512, WMKV_T, scr, r, lane); continue; } r -= I5;
            if (r < I6) { const int e = r >> 9; p0_transpose_item(ka->in[I_WGU] + (size_t)e * 1024 * 2048, 1024, 2048, WGU_T + (size_t)e * 2048 * 1024, scr, r & 511, lane); continue; } r -= I6;
            { const int e = r >> 8; p0_transpose_item(ka->in[I_WD] + (size_t)e * 1024 * 1024, 1024, 1024, WD_T + (size_t)e * 1024 * 1024, scr, r & 255, lane); }
        }
        for (int m = gw; m < T; m += NGW) rms_row_to_bf16(ka->in[I_X] + (size_t)m * 1024, ka->in[I_NORM1], XN + (size_t)m * 1024, lane);
        for (int m = gw; m < BATCH * MEMLEN; m += NGW) rms_row_to_bf16(ka->in[I_MEM] + (size_t)m * 1024, ka->in[I_MEMNORM], MEMN + (size_t)m * 1024, lane);
        for (int i = bx * 512 + tid; i < SEQ * 32; i += G * 512) { const int pos = i >> 5, j = i & 31;
            const float inv = 1.0f / powf(10000.0f, (float)(2 * j) / 64.0f); const float ang = (float)pos * inv;
            const double a = (double)ang; const double k = rint(a * 0.15915494309189535); const float red = (float)(a - k * 6.283185307179586);
            ROPE[i] = (f32x2){cosf(red), sinf(red)}; }
        for (int i = bx * 512 + tid; i < 1024 * 32; i += G * 512) { const int ii = i & 3, e = (i >> 2) & 15, kq = (i >> 6) & 3, eb = (i >> 8) & 1, s = i >> 9; const int k = 16 * s + 4 * kq + ii;
            WR2[i] = ka->in[I_NORM2][k] * ka->in[I_WROUTER][k * 32 + eb * 16 + e]; }
        if (bx == 0 && wave == 0) { const float s1 = wave_sum(ka->in[I_LQ1][lane] * ka->in[I_LK1][lane]), s2 = wave_sum(ka->in[I_LQ2][lane] * ka->in[I_LK2][lane]);
            if (lane == 0) LAMP[0] = expf(s1) - expf(s2) + 0.2f; }
    }
    SEAM(0);
    if (IN(1)) for (int rep_ = 0; rep_ < 1 + ((REPEAT_MASK >> 1) & 1); ++rep_) { KA; if (rep_) __syncthreads();
#if defined(TAP) && TAP == 6
        { pg8::DenseProb P{XN, WIN_T, 1024, 1024, 1024}; pg8::StaticOrder S; S.init(T, INW, G, bx);
          pg8::EpiPlain E{WSP(bf16_t, WS_B), 5120};
          pg8::gemm_phase<pg8::EpiPlain, pg8::DenseProb, pg8::StaticOrder, true>(lds, P, S, E); }
#else
        { pg8::DenseProb P{XN, WIN_T, 1024, 1024, 1024}; pg8::StaticOrder S0; S0.init(T, INW, G, bx); const pg8::TableOrder S = pg8::build_unit_table(S0, (LAS int*)(lds + MISC_OFF + 2048));
          pg8::EpiInProj E{Qb, Kb, Vb, Ub, MQb, GATES, ka->in[I_QN], ka->in[I_KN], ka->in[I_MQN], ka->in[I_BGATE], ROPE};
          pg8::gemm_phase<pg8::EpiInProj, pg8::DenseProb, pg8::TableOrder, ALIGN_EPI_SEL>(lds, P, S, E); }
#endif
        { pg8::DenseProb P{MEMN, WMKV_T, 1024, 1024, 1024}; pg8::StaticOrder S; S.init(BATCH * MEMLEN, 512, G, bx);
          pg8::EpiMemKV E{MKV, ka->in[I_MKN]};
          pg8::gemm_phase<pg8::EpiMemKV, pg8::DenseProb, pg8::StaticOrder, true>(lds, P, S, E); }
    }
    SEAM(1);
    if (IN(2)) for (int rep_ = 0; rep_ < 1 + ((REPEAT_MASK >> 2) & 1); ++rep_) { KA; if (rep_) __syncthreads();
        using abf = attn_body::bf16;
        {
            const int bh = vcu >> 4, b = bh >> 2, h = bh & 3, s = vcu & 15; const size_t rb = (size_t)b * SEQ;
            const float lam = LAMP[0];
            for (int i2 = 0; i2 < 4 * (1 + ((REPEAT_MASK >> 10) & 1)); ++i2) { const int ii = i2 & 3, c = ii & 1; const int qb = (ii < 2) ? s : 31 - s;
                attn_body::attn_unit2<true>(qb * 256, 4 * qb + 4, (const abf*)Qb + rb * 512 + (c * 4 + h) * 64, 512, (const abf*)Kb + rb * 512 + (c * 4 + h) * 64, 512,
                                            (const abf*)Vb + rb * 512 + h * 128, 512, (abf*)OC + rb * 1024 + (c * 4 + h) * 128, 1024, (char*)lds_raw);
                if (c == 1) {
                    asm volatile("s_waitcnt vmcnt(0)" ::: "memory");
#pragma unroll 1
                    for (int ps = 0; ps < 2; ++ps) {
                    const int row = ps * 16 + (lane >> 2), dq = (lane & 3) * 32; const size_t t = rb + (size_t)qb * 256 + wave * 32 + row;
                    const bf16_t* p0 = OC + t * 1024 + h * 128 + dq; const bf16_t* p1 = p0 + 512;
                    u32x4 a[4], bb[4];
#pragma unroll
                    for (int j = 0; j < 4; ++j) { a[j] = *(const u32x4*)(p0 + 8 * j); bb[j] = *(const u32x4*)(p1 + 8 * j); }
                    float ss = 0.f; f32x4 y[4][2];
#pragma unroll
                    for (int j = 0; j < 4; ++j) {
                        y[j][0] = (f32x4){bf_lo(a[j].x) - lam * bf_lo(bb[j].x), bf_hi(a[j].x) - lam * bf_hi(bb[j].x), bf_lo(a[j].y) - lam * bf_lo(bb[j].y), bf_hi(a[j].y) - lam * bf_hi(bb[j].y)};
                        y[j][1] = (f32x4){bf_lo(a[j].z) - lam * bf_lo(bb[j].z), bf_hi(a[j].z) - lam * bf_hi(bb[j].z), bf_lo(a[j].w) - lam * bf_lo(bb[j].w), bf_hi(a[j].w) - lam * bf_hi(bb[j].w)};
#pragma unroll
                        for (int q = 0; q < 4; ++q) ss += y[j][0][q] * y[j][0][q] + y[j][1][q] * y[j][1][q]; }
                    ss += __shfl_xor(ss, 1); ss += __shfl_xor(ss, 2);
                    const float rstd = 0.8f / sqrtf(ss * (1.0f / 128.0f) + RMS_EPS);
                    const float* sg = ka->in[I_SUBLN] + dq; bf16_t* yo = YCAT + t * 1024 + h * 128 + dq;
#pragma unroll
                    for (int j = 0; j < 4; ++j) { const f32x4 s0 = *(const f32x4*)(sg + 8 * j), s1 = *(const f32x4*)(sg + 8 * j + 4); pg8::store8(yo + 8 * j, y[j][0] * rstd * s0, y[j][1] * rstd * s1); }
                    }
                }
            }
        }
        {
            for (int i = 0; i < 2; ++i) { const int idx = vcu * 2 + i; if (idx >= 512) break; const int b = idx >> 7, h = (idx >> 5) & 3, qb = idx & 31;
                attn_body::attn_unit<8, false>(qb * 256, 4, (const abf*)MQb + (size_t)b * SEQ * 256 + h * 64, 256, (const abf*)MKV + (size_t)b * MEMLEN * 512 + h * 64, 512,
                                               (const abf*)MKV + (size_t)b * MEMLEN * 512 + 256 + h * 64, 512, (abf*)YCAT + (size_t)b * SEQ * 1024 + 768 + h * 64, 1024, (char*)lds_raw); }
        }
        {
            LAS bf16_t* ul = (LAS bf16_t*)lds;
            LAS bf16_t* pb = (LAS bf16_t*)(lds + 24576);
            const int col = tid & 255, half = tid >> 8, w = 2 << (col >> 6);
            const int mg = wave & 3, mdh = wave >> 2, r32 = lane & 31, hh = lane >> 5;
            bf16x8 bw[4];
#pragma unroll
            for (int sx = 0; sx < 4; ++sx) { const float* wp = ka->in[I_WPOOL] + (size_t)(mg * 64 + 16 * sx + 8 * hh) * 64 + mdh * 32 + r32;
                u32x4 pk; pk.x = pk2(wp[0], wp[64]); pk.y = pk2(wp[128], wp[192]); pk.z = pk2(wp[256], wp[320]); pk.w = pk2(wp[384], wp[448]); bw[sx] = __builtin_bit_cast(bf16x8, pk); }
            const int ocol = mg * 64 + mdh * 32 + r32; const float psc = ka->in[I_PSCALE][ocol];
            for (int tile = vcu; tile < T / 32; tile += G) {
                const int t0 = tile * 32, p0 = t0 & (SEQ - 1);
                __syncthreads();
                for (int pc = tid; pc < 47 * 32; pc += 512) { const int r = pc >> 5, ch = pc & 31; const int pos = p0 - 15 + r;
                    u32x4 v = {0u, 0u, 0u, 0u}; if (pos >= 0) v = *(const u32x4*)(Ub + (size_t)(t0 - 15 + r) * 256 + ch * 8);
                    *(LAS u32x4*)(ul + r * 256 + ch * 8) = v; }
                __syncthreads();
                {
                    float sum = 0.f; const int rbase = 15 + 16 * half;
                    for (int i = 1; i < w; ++i) sum += __uint_as_float((unsigned)ul[(rbase - i) * 256 + col] << 16);
#pragma unroll
                    for (int tk = 0; tk < 16; ++tk) { const float ucur = __uint_as_float((unsigned)ul[(rbase + tk) * 256 + col] << 16); sum += ucur;
                        const int pos = p0 + 16 * half + tk; const float cnt = (float)((pos + 1 < w) ? pos + 1 : w);
                        pb[(16 * half + tk) * 264 + col] = (bf16_t)f2bf(sum / cnt - ucur);
                        sum -= __uint_as_float((unsigned)ul[(rbase + tk - (w - 1)) * 256 + col] << 16); }
                }
                __syncthreads();
                f32x16 acc = f32x16{};
#pragma unroll
                for (int sx = 0; sx < 4; ++sx) { const bf16x8 af = *(const LAS bf16x8*)(pb + r32 * 264 + mg * 64 + 16 * sx + 8 * hh);
                    acc = __builtin_amdgcn_mfma_f32_32x32x16_bf16(af, bw[sx], acc, 0, 0, 0); }
#pragma unroll
                for (int r = 0; r < 16; ++r) { const int tok = t0 + (r & 3) + 8 * (r >> 2) + 4 * hh; YCAT[(size_t)tok * 1024 + 512 + ocol] = (bf16_t)f2bf(acc[r] * psc); }
            }
            __syncthreads();
        }
    }
    SEAM(2);
    if (IN(4)) for (int rep_ = 0; rep_ < 1 + ((REPEAT_MASK >> 4) & 1); ++rep_) { KA; if (rep_) __syncthreads();
        pg8::StaticOrder S0; S0.init(T, 1024, G, bx); const pg8::TableOrder S = pg8::build_unit_table(S0, (LAS int*)(lds + MISC_OFF + 2048));
        pg8::DenseProb P{YCAT, WBRD_T, 1024, 1024, 1024}; pg8::EpiMergeR E{GATES, MERGB};
        pg8::gemm_phase<pg8::EpiMergeR, pg8::DenseProb, pg8::TableOrder, ALIGN_EPI_SEL>(lds, P, S, E);
    }
    SEAM(4);
    if (IN(5)) for (int rep_ = 0; rep_ < 1 + ((REPEAT_MASK >> 5) & 1); ++rep_) { KA; if (rep_) __syncthreads();
        pg8::DenseProb P{MERGB, WOUT_T, 1024, 1024, 1024}; pg8::StaticOrder S0; S0.init(T, 1024, G, bx); const pg8::TableOrder S = pg8::build_unit_table(S0, (LAS int*)(lds + MISC_OFF + 2048));
        pg8::EpiWout E{ka->in[I_X], OUT, XG, ka->in[I_NORM2]};
        pg8::gemm_phase<pg8::EpiWout, pg8::DenseProb, pg8::TableOrder, ALIGN_EPI_SEL>(lds, P, S, E);
    }
    SEAM(5);
    if (IN(6)) { KA;
        LAS int* lcnt = (LAS int*)(lds + MISC_OFF); LAS int* lbase = lcnt + 32;
        const int ngroups = T / 16, rounds = (ngroups + NGW - 1) / NGW;
        for (int rd = 0; rd < rounds; ++rd) {
            const int grp = rd * NGW + gw; const bool valid = grp < ngroups;
            if (tid < 32) lcnt[tid] = 0;
            __syncthreads();
            int e_sel = 0, rank = 0; float w_sel = 0.f, rstd = 0.f; const int q = lane >> 4, tok = grp * 16 + (lane & 15);
            if (valid) {
                f32x4 d0 = {0.f, 0.f, 0.f, 0.f}, d1 = {0.f, 0.f, 0.f, 0.f}; float ss = 0.f;
                const float* xrow = OUT + (size_t)tok * 1024 + 4 * q; const f32x4* wr2 = (const f32x4*)WR2 + lane;
#pragma unroll 4
                for (int s = 0; s < 64; ++s) { const f32x4 xv = *(const f32x4*)(xrow + 16 * s); const f32x4 wa = wr2[(s * 2) * 64], wb = wr2[(s * 2 + 1) * 64];
                    ss += (xv[0] * xv[0] + xv[1] * xv[1]) + (xv[2] * xv[2] + xv[3] * xv[3]);
#pragma unroll
                    for (int j = 0; j < 4; ++j) { d0 = __builtin_amdgcn_mfma_f32_16x16x4f32(wa[j], xv[j], d0, 0, 0, 0); d1 = __builtin_amdgcn_mfma_f32_16x16x4f32(wb[j], xv[j], d1, 0, 0, 0); } }
                ss += __shfl_xor(ss, 16); ss += __shfl_xor(ss, 32);
                rstd = 1.0f / sqrtf(ss * (1.0f / 1024.f) + RMS_EPS);
                unsigned key[8];
#pragma unroll
                for (int r = 0; r < 8; ++r) { const int e = (r >> 2) * 16 + 4 * q + (r & 3); const float lg = ((r < 4) ? d0[r & 3] : d1[r & 3]) * rstd + ka->in[I_BROUTER][e];
                    unsigned u = __float_as_uint(lg); u ^= (u >> 31) ? 0xffffffffu : 0x80000000u; key[r] = (u & ~31u) | (unsigned)(31 - e); }
                unsigned win[4];
#pragma unroll
                for (int r = 0; r < 4; ++r) { unsigned m = key[0];
#pragma unroll
                    for (int j = 1; j < 8; ++j) m = m > key[j] ? m : key[j];
                    unsigned o = (unsigned)__shfl_xor((int)m, 16); m = m > o ? m : o; o = (unsigned)__shfl_xor((int)m, 32); m = m > o ? m : o; win[r] = m;
#pragma unroll
                    for (int j = 0; j < 8; ++j) key[j] = (key[j] == m) ? 0u : key[j]; }
                float val[4];
#pragma unroll
                for (int r = 0; r < 4; ++r) { unsigned u = win[r] & ~31u; u ^= (u >> 31) ? 0x80000000u : 0xffffffffu; val[r] = __uint_as_float(u); }
                const float p1 = expf(val[1] - val[0]), p2 = expf(val[2] - val[0]), p3 = expf(val[3] - val[0]); const float inv = 1.0f / (1.0f + p1 + p2 + p3);
                const unsigned wk = (q == 0) ? win[0] : (q == 1) ? win[1] : (q == 2) ? win[2] : win[3];
                w_sel = ((q == 0) ? 1.0f : (q == 1) ? p1 : (q == 2) ? p2 : p3) * inv; e_sel = 31 - (int)(wk & 31u);
                rank = __hip_atomic_fetch_add((int*)(lcnt + e_sel), 1, __ATOMIC_RELAXED, __HIP_MEMORY_SCOPE_WORKGROUP);
            }
            __syncthreads();
            if (tid < 32) lbase[tid] = (int)__hip_atomic_fetch_add(CNT + 64 * tid, (unsigned)lcnt[tid], __ATOMIC_RELAXED, __HIP_MEMORY_SCOPE_AGENT);
            __syncthreads();
            if (valid) { const int pos = lbase[e_sel] + rank; LIST[(size_t)e_sel * CAP + pos] = (u32x2){(unsigned)(tok * 4 + q), __float_as_uint(rstd)}; ROUTEW[tok * 4 + q] = w_sel; }
            __syncthreads();
        }
    }
    SEAM(6);
    if (IN(7) || IN(8)) { KA;
        LAS int* tp = (LAS int*)(lds + MISC_OFF + 256); LAS int* cn = tp + 40;
        if (tid == 0) { int acc = 0; for (int e = 0; e < NEXP; ++e) { const int c = (int)__hip_atomic_load(CNT + 64 * e, __ATOMIC_RELAXED, __HIP_MEMORY_SCOPE_AGENT); cn[e] = c; tp[e] = acc; acc += (c + 255) >> 8; } tp[NEXP] = acc; }
        __syncthreads();
        if (IN(7)) for (int rep_ = 0; rep_ < 1 + ((REPEAT_MASK >> 7) & 1); ++rep_) {
            pg8::GuProb P{XG, WGU_T, LIST, 1024, 1024, 1024}; pg8::GroupedOrder S0{tp, cn, 8, G, bx}; const pg8::TableOrder S = pg8::build_unit_table(S0, (LAS int*)(lds + MISC_OFF + 2048));
            pg8::EpiSwiglu E{ACT, LIST, ka->in[I_BGU]};
            pg8::gemm_phase<pg8::EpiSwiglu, pg8::GuProb, pg8::TableOrder, ALIGN_EPI_SEL>(lds, P, S, E);
        }
        SEAM(7);
        if (IN(8)) for (int rep_ = 0; rep_ < 1 + ((REPEAT_MASK >> 8) & 1); ++rep_) {
            pg8::DownProb P{ACT, WD_T, 1024, 1024, 1024}; pg8::GroupedOrder S0{tp, cn, 4, G, bx}; const pg8::TableOrder S = pg8::build_unit_table(S0, (LAS int*)(lds + MISC_OFF + 2048));
            pg8::EpiDown E{Y4, LIST, ka->in[I_BD]};
            pg8::gemm_phase<pg8::EpiDown, pg8::DownProb, pg8::TableOrder, ALIGN_EPI_SEL>(lds, P, S, E);
        }
    }
    SEAM(8);
    if (IN(9)) { KA;
        for (int i = bx * 512 + tid; i < T * 128; i += G * 512) { const int tok = i >> 7, c8 = (i & 127) * 8;
            const f32x4 w = *(const f32x4*)(ROUTEW + tok * 4); float* op = OUT + (size_t)tok * 1024 + c8;
            f32x4 o0 = *(const f32x4*)op, o1 = *(const f32x4*)(op + 4);
#pragma unroll
            for (int k = 0; k < 4; ++k) { const u32x4 y = *(const u32x4*)(Y4 + ((size_t)tok * 4 + k) * 1024 + c8); const float wk = w[k];
                o0[0] += wk * bf_lo(y.x); o0[1] += wk * bf_hi(y.x); o0[2] += wk * bf_lo(y.y); o0[3] += wk * bf_hi(y.y);
                o1[0] += wk * bf_lo(y.z); o1[1] += wk * bf_hi(y.z); o1[2] += wk * bf_lo(y.w); o1[3] += wk * bf_hi(y.w); }
            *(f32x4*)op = o0; *(f32x4*)(op + 4) = o1; }
    }
#ifdef TAP
    if (lo <= 10 && 10 < hi) { KA; GSYNC();
        for (int i = bx * 512 + tid; i < T * 1024; i += G * 512) { const int t = i >> 10, c = i & 1023; float v = 0.f;
#define BFV(buf, pitch, col) __uint_as_float((unsigned)(buf)[(size_t)t * (pitch) + (col)] << 16)
            if (TAP == 1) v = BFV(Qb, 512, c & 511) + 2.f * BFV(Kb, 512, c & 511) + 4.f * BFV(Vb, 512, c & 511) + 8.f * BFV(Ub, 256, c & 255) + 16.f * BFV(MQb, 256, c & 255)
                            + 32.f * BFV(GATES, 3072, c) + 64.f * BFV(GATES, 3072, 1024 + c) + 128.f * BFV(GATES, 3072, 2048 + c);
            if (TAP == 2) v = BFV(OC, 1024, c) + 2.f * BFV(YCAT, 1024, c);
            if (TAP == 3) v = BFV(MERGB, 1024, c);
            if (TAP == 4) v = BFV(XN, 1024, c);
            if (TAP == 6) { const bf16_t* z = WSP(bf16_t, WS_B) + (size_t)t * 5120 + c; v = __uint_as_float((unsigned)z[0] << 16) + 2.f * __uint_as_float((unsigned)z[1024] << 16) + 4.f * __uint_as_float((unsigned)z[2048] << 16) + 8.f * __uint_as_float((unsigned)z[3072] << 16) + 16.f * __uint_as_float((unsigned)z[4096] << 16); }
            if (TAP == 5) { const bf16_t* wt = WIN_T; const int tt = t % 5120; v = __uint_as_float((unsigned)wt[(size_t)tt * 1024 + c] << 16) + ROPE[(t & 8191) * 32 + (c & 31)].x + 2.f * ROPE[(t & 8191) * 32 + (c & 31)].y; }
            OUT[i] = v; }
    }
#endif
#undef IN
#undef SEAM
}

extern "C" void kernel_launch(void* const* d_in, const int* in_sizes, int n_in, void* d_out, int out_size, void* d_ws, size_t ws_size, hipStream_t stream) {
    static int grid = 0;
    if (grid == 0) {
        if (n_in != 29 || in_sizes[0] != T * DMODEL || out_size != T * DMODEL || ws_size < WS_END) {
            fprintf(stderr, "kernel_launch: unexpected shapes: n_in %d in0 %d out %d ws %zu (need %zu)\n", n_in, n_in > 0 ? in_sizes[0] : -1, out_size, ws_size, (size_t)WS_END); grid = -1; return; }
        int dev = 0, cus = 0, per_cu = 0;
        (void)hipGetDevice(&dev); (void)hipDeviceGetAttribute(&cus, hipDeviceAttributeMultiprocessorCount, dev);
        (void)hipFuncSetAttribute((const void*)fwd_kernel, hipFuncAttributeMaxDynamicSharedMemorySize, LDS_BYTES);
        (void)hipOccupancyMaxActiveBlocksPerMultiprocessor(&per_cu, (const void*)fwd_kernel, NWAVES * 64, LDS_BYTES);
        (void)hipGetLastError();
        grid = cus;
        fprintf(stderr, "kernel_launch: cus %d occupancy %d/CU grid %d\n", cus, per_cu, grid);
        if (per_cu < 1) fprintf(stderr, "kernel_launch: occupancy query says the kernel does not fit\n");
    }
    if (grid < 0) return;
    (void)hipMemsetAsync((char*)d_ws + WS_CTL, 0, CTL_ZERO_BYTES, stream);
    Args a{};
    for (int i = 0; i < 29; ++i) a.in[i] = (const float*)d_in[i];
    a.out = (float*)d_out; a.ws = (unsigned char*)d_ws; a.ph_lo = 0; a.ph_hi = PH_HI;
    void* args[] = {&a};
    hipError_t e = hipLaunchCooperativeKernel((const void*)fwd_kernel, dim3(grid), dim3(NWAVES * 64), args, LDS_BYTES, stream);
    if (e != hipSuccess) fprintf(stderr, "cooperative launch failed: %s (grid %d)\n", hipGetErrorString(e), grid);
}
```

```cpp
#include <hip/hip_runtime.h>
#include <hip/hip_cooperative_groups.h>
#include <hip/hip_bf16.h>
#include <cstdio>
#include <cstdint>
#include <cmath>
namespace cg = cooperative_groups;

#define LAS __attribute__((address_space(3)))
#define GAS __attribute__((address_space(1)))
typedef unsigned short bf16_t;
typedef short bf16x8 __attribute__((ext_vector_type(8)));
typedef float f32x4 __attribute__((ext_vector_type(4)));
typedef float f32x2 __attribute__((ext_vector_type(2)));
typedef float f32x16 __attribute__((ext_vector_type(16)));
typedef unsigned u32x4 __attribute__((ext_vector_type(4)));
typedef unsigned u32x2 __attribute__((ext_vector_type(2)));

#define PH_HI 10
#define ALIGN_EPI_SEL true
#define F8MODE 1
#define USE_SETPRIO 1
#define ATTN_PRIO_A 1
#define ATTN_PRIO_B 1
#ifndef PHMASK
#define PHMASK 0x3ff
#endif
#define REPEAT_MASK 0x000
constexpr int BATCH = 4, SEQ = 8192, DMODEL = 1024, T = BATCH * SEQ, INW = 5120, NEXP = 32, MEMLEN = 256;
constexpr float RMS_EPS = 1e-6f;
constexpr float C2 = 0.125f * 1.4426950408889634f;
constexpr int CAP = T;

constexpr size_t MiB = 1u << 20;
constexpr size_t WS_CTL = 0, CTL_ZERO_BYTES = 32768;
constexpr int CW_BAR = 4096;
constexpr size_t WS_ROUTEW = 1 * MiB;
constexpr size_t WS_LAM = 1 * MiB + 768 * 1024;
constexpr size_t WS_ROPE = 2 * MiB;
constexpr size_t WS_WR2 = 4 * MiB;
constexpr size_t WS_MEMN = 5 * MiB;
constexpr size_t WS_MKV = 7 * MiB;
constexpr size_t WS_WIN_T = 8 * MiB;
constexpr size_t WS_WBRD_T = 18 * MiB;
constexpr size_t WS_WBRP_T = 19 * MiB;
constexpr size_t WS_WBRM_T = 19 * MiB + 512 * 1024;
constexpr size_t WS_WOUT_T = 20 * MiB;
constexpr size_t WS_WMKV_T = 22 * MiB;
constexpr size_t WS_WGU_T = 24 * MiB;
constexpr size_t WS_WD_T = 152 * MiB;
constexpr size_t WS_A = 216 * MiB;
constexpr size_t WS_XN = WS_A;
constexpr size_t WS_Q = WS_A + 64 * MiB, WS_K = WS_A + 96 * MiB, WS_V = WS_A + 128 * MiB;
constexpr size_t WS_U = WS_A + 160 * MiB, WS_MQ = WS_A + 176 * MiB;
constexpr size_t WS_OC = WS_A + 192 * MiB;
constexpr size_t WS_B = 488 * MiB;
constexpr size_t WS_GATES = WS_B;
constexpr size_t WS_YCAT = WS_B + 192 * MiB;
constexpr size_t WS_MERGF = 760 * MiB;
constexpr size_t WS_MERGB = 888 * MiB;
constexpr size_t WS_XG = 952 * MiB;
constexpr size_t WS_LIST = 1016 * MiB;
constexpr size_t WS_END = 1024 * MiB;

typedef __bf16 bf16x2_v __attribute__((ext_vector_type(2)));
__device__ __forceinline__ unsigned cvt_pk_bf16(float lo, float hi) { f32x2 v = {lo, hi}; bf16x2_v b = __builtin_convertvector(v, bf16x2_v); return __builtin_bit_cast(unsigned, b); }
__device__ __forceinline__ unsigned pk4_fp8(float a, float b, float c, float d) {
    a = fminf(fmaxf(a, -448.f), 448.f); b = fminf(fmaxf(b, -448.f), 448.f); c = fminf(fmaxf(c, -448.f), 448.f); d = fminf(fmaxf(d, -448.f), 448.f);
    int r = __builtin_amdgcn_cvt_pk_fp8_f32(a, b, 0, false); r = __builtin_amdgcn_cvt_pk_fp8_f32(c, d, r, true); return (unsigned)r; }
constexpr float W8_SCALE = 64.0f;
constexpr float A8_SCALE = 8.0f;
__device__ __forceinline__ float bf_lo(unsigned w) { return __uint_as_float(w << 16); }
__device__ __forceinline__ float bf_hi(unsigned w) { return __uint_as_float(w & 0xffff0000u); }
__device__ __forceinline__ float wave_sum(float v) {
#pragma unroll
    for (int o = 1; o < 64; o <<= 1) v += __shfl_xor(v, o);
    return v;
}
#define LDS_WAIT() asm volatile("s_waitcnt lgkmcnt(0)" ::: "memory")

namespace pg8 {
constexpr int BM = 256, BK = 64, HALF = 128, HTB = HALF * BK * 2, STAGE_BYTES = 8 * HTB, NXCD = 8, WGM = 8;
__host__ __device__ __forceinline__ int lds_byte(int r, int c) { const int st = (r >> 4) * 2 + (c >> 5), rr = r & 15, cc = c & 31, ob = rr * 64 + cc * 2; return st * 1024 + (ob ^ (((ob >> 9) & 1) << 5)); }
__host__ __device__ __forceinline__ void stage_rc(int b, int& R, int& C) { const int st = b / 1024, sb = b % 1024, swz = sb ^ (((sb >> 9) & 1) << 5); R = (st >> 1) * 16 + swz / 64; C = (st & 1) * 32 + (swz % 64) / 2; }
__host__ __device__ __forceinline__ int perm32(int rho) { const int n = rho >> 4, i = rho & 15; return 8 * (i >> 2) + 4 * n + (i & 3); }

typedef int i32x4_t __attribute__((ext_vector_type(4)));
typedef int i32x8_t __attribute__((ext_vector_type(8)));
typedef long i64x2_t __attribute__((ext_vector_type(2)));
struct Unit { int pm, pn, e, mt, cnt; };

template <int BMAP> __device__ __forceinline__ int brow(int R) { return BMAP == 0 ? ((R >> 5) * 64 + perm32(R & 31)) : ((R & ~31) + perm32(R & 31)); }

struct StaticOrder {
    int nM, nN, nwg, G, c;
    __device__ void init(int M, int N, int G_, int c_) { nM = M / BM; nN = N / BM; nwg = nM * nN; G = G_; c = c_; }
    __device__ bool next(int i, Unit& u) const {
        const long L = (long)i * G + c; if (L >= nwg) return false;
        int wgid = (int)L; { const int q = nwg / NXCD, r = nwg % NXCD, xcd = wgid % NXCD, off = wgid / NXCD; wgid = (xcd < r ? xcd * (q + 1) : r * (q + 1) + (xcd - r) * q) + off; }
        const int nig = WGM * nN, gid = wgid / nig, fm = gid * WGM, gsz = (nM - fm) < WGM ? (nM - fm) : WGM;
        u.pm = fm + ((wgid % nig) % gsz); u.pn = (wgid % nig) / gsz; u.e = 0; u.mt = 0; u.cnt = 0; return true;
    }
    __device__ bool next_lane(int i, Unit& u) const { return next(i, u); }
};
struct GroupedOrder {
    const LAS int* tp; const LAS int* cn; int NTN, G, c;
    __device__ bool next_lane(int i, Unit& u) const {
        const int nwg = tp[NEXP] * NTN; const long L = (long)i * G + c; if (L >= nwg) return false;
        int wgid = (int)L; { const int q = nwg / NXCD, r = nwg % NXCD, xcd = wgid % NXCD, off = wgid / NXCD; wgid = (xcd < r ? xcd * (q + 1) : r * (q + 1) + (xcd - r) * q) + off; }
        int e = 0; while (e < NEXP - 1 && wgid >= tp[e + 1] * NTN) ++e;
        const int idx = wgid - tp[e] * NTN, tiles = tp[e + 1] - tp[e];
        const int nig = 4 * NTN, gid = idx / nig, fm = gid * 4, gsz = (tiles - fm) < 4 ? (tiles - fm) : 4;
        u.mt = fm + ((idx % nig) % gsz); u.pn = (idx % nig) / gsz; u.e = e; u.pm = tp[e] + u.mt; u.cnt = cn[e]; return true;
    }
};
struct TableOrder {
    const LAS int* tab; int n;
    __device__ __forceinline__ bool next(int i, Unit& u) const {
        if (i >= n) return false;
        const LAS int* t = tab + i * 8;
        u.pm = __builtin_amdgcn_readfirstlane(t[0]); u.pn = __builtin_amdgcn_readfirstlane(t[1]); u.e = __builtin_amdgcn_readfirstlane(t[2]);
        u.mt = __builtin_amdgcn_readfirstlane(t[3]); u.cnt = __builtin_amdgcn_readfirstlane(t[4]); return true;
    }
};
template <class Sched> __device__ __forceinline__ TableOrder build_unit_table(const Sched& S, LAS int* tab) {
    __syncthreads();
    if (threadIdx.x < 32) { Unit u; const bool ok = S.next_lane((int)threadIdx.x, u);
        if (ok) { LAS int* t = tab + threadIdx.x * 8; t[0] = u.pm; t[1] = u.pn; t[2] = u.e; t[3] = u.mt; t[4] = u.cnt; }
        const unsigned long long m = __ballot(ok); if (threadIdx.x == 0) tab[256] = __popcll(m); }
    __syncthreads();
    TableOrder T; T.tab = tab; T.n = __builtin_amdgcn_readfirstlane(tab[256]); return T;
}
struct DenseProb {
    static constexpr bool GATHER = false; static constexpr int BMAP = 0; static constexpr bool F8 = false;
    const bf16_t* A; const bf16_t* Bt; int lda, ldb, K;
    __device__ __forceinline__ const char* a_base(const Unit& u) const { return (const char*)(A + (size_t)u.pm * BM * lda); }
    __device__ __forceinline__ const char* b_base(const Unit& u) const { return (const char*)(Bt + (size_t)u.pn * BM * ldb); }
    __device__ __forceinline__ size_t bhstep() const { return (size_t)32 * ldb * 2; }
    __device__ __forceinline__ unsigned a_off(const Unit&, int, int) const { return 0u; }
    __device__ __forceinline__ unsigned a_raw(const Unit&, int) const { return 0u; }
};
struct GuProb {
    static constexpr bool GATHER = true; static constexpr int BMAP = 1; static constexpr bool F8 = true;
    const unsigned char* XG; const unsigned char* Wt; const u32x2* list; int lda, ldb, K;
    __device__ __forceinline__ const char* a_base(const Unit&) const { return (const char*)XG; }
    __device__ __forceinline__ const char* b_base(const Unit& u) const { return (const char*)(Wt + ((size_t)u.e * 2048 + 128 * u.pn) * 1024); }
    __device__ __forceinline__ size_t bhstep() const { return (size_t)1024 * 1024; }
    __device__ __forceinline__ unsigned a_raw(const Unit& u, int r) const { const int rr = u.mt * BM + r, rc = rr < u.cnt ? rr : u.cnt - 1; return list[(size_t)u.e * CAP + rc].x; }
    __device__ __forceinline__ unsigned a_off(const Unit& u, int r, int C) const {
        const int rr = u.mt * BM + r, rc = rr < u.cnt ? rr : u.cnt - 1;
        const unsigned tok = list[(size_t)u.e * CAP + rc].x >> 2;
        return tok * 1024u + (unsigned)C * 2u;
    }
};
struct DownProb {
    static constexpr bool GATHER = false; static constexpr int BMAP = 0; static constexpr bool F8 = true;
    const unsigned char* A; const unsigned char* Wt; int lda, ldb, K;
    __device__ __forceinline__ const char* a_base(const Unit& u) const { return (const char*)(A + (size_t)u.pm * BM * lda); }
    __device__ __forceinline__ const char* b_base(const Unit& u) const { return (const char*)(Wt + ((size_t)u.e * 1024 + 256 * u.pn) * 1024); }
    __device__ __forceinline__ size_t bhstep() const { return (size_t)32 * ldb; }
    __device__ __forceinline__ unsigned a_off(const Unit&, int, int) const { return 0u; }
    __device__ __forceinline__ unsigned a_raw(const Unit&, int) const { return 0u; }
};

template <class Prob> __device__ __forceinline__ void calc_aoff(const Prob& P, const Unit& u, const int (&Rr)[2], const int (&Cc)[2], unsigned (&o)[2][2]) {
#pragma unroll
    for (int h = 0; h < 2; ++h)
#pragma unroll
        for (int i = 0; i < 2; ++i) {
            if constexpr (Prob::GATHER) o[h][i] = P.a_off(u, h * HALF + Rr[i], Cc[i]);
            else o[h][i] = Prob::F8 ? (unsigned)((h * HALF + Rr[i]) * P.lda + Cc[i] * 2) : (unsigned)((h * HALF + Rr[i]) * P.lda + Cc[i]) * 2u;
        }
}

template <class Epi, class Prob, class Sched, bool ALIGN_EPI>
__device__ __forceinline__ void gemm_phase(LAS unsigned char* lds, const Prob& P, const Sched& S, const Epi& E) {
    const int tid = threadIdx.x, wid = __builtin_amdgcn_readfirstlane(tid >> 6), lane = tid & 63, wr = wid >> 2, wc = wid & 3, fr = lane & 15, fq = lane >> 4;
    const int K = P.K, nt = Prob::F8 ? K / 128 : K / BK;
    int Rr[2], Cc[2]; unsigned voffB[2];
#pragma unroll
    for (int i = 0; i < 2; ++i) { stage_rc(tid * 16 + i * 8192, Rr[i], Cc[i]); voffB[i] = Prob::F8 ? (unsigned)(brow<Prob::BMAP>(Rr[i]) * P.ldb + Cc[i] * 2) : (unsigned)(brow<Prob::BMAP>(Rr[i]) * P.ldb + Cc[i]) * 2u; }
    const size_t kstep = (size_t)(BK * 2);
    const size_t bhstep = P.bhstep();
    const unsigned ldsw = (unsigned)wid * 1024u;
    const int aoff = lds_byte(wr * 64 + fr, fq * 8), boff = lds_byte(wc * 32 + fr, fq * 8);
#define PG8_SA(b, h) (((b) * 2 + (h)) * HTB)
#define PG8_SB(b, h) ((4 + (b) * 2 + (h)) * HTB)
#define PG8_STG(bufoff, gptr, v0, v1) do { \
        __builtin_amdgcn_global_load_lds((const unsigned*)((const char*)(gptr) + (v0)), (LAS unsigned*)(lds + (bufoff) + ldsw), 16, 0, 0); \
        __builtin_amdgcn_global_load_lds((const unsigned*)((const char*)(gptr) + (v1)), (LAS unsigned*)(lds + (bufoff) + ldsw + 8192), 16, 0, 0); } while (0)
#define PG8_STGB(bufoff, gptr) PG8_STG(bufoff, gptr, voffB[0], voffB[1])
#define PG8_LDA(dst, b, h) do { _Pragma("unroll") for (int m = 0; m < 4; ++m) _Pragma("unroll") for (int k = 0; k < 2; ++k) dst[m][k] = *(const LAS bf16x8*)(lds + PG8_SA(b, h) + aoff + m * 2048 + k * 1024); } while (0)
#define PG8_LDB(dst, b, h) do { _Pragma("unroll") for (int n = 0; n < 2; ++n) _Pragma("unroll") for (int k = 0; k < 2; ++k) dst[n][k] = *(const LAS bf16x8*)(lds + PG8_SB(b, h) + boff + n * 2048 + k * 1024); } while (0)
#define PG8_MMAB(ai, bj, At, Bt) do { _Pragma("unroll") for (int m = 0; m < 4; ++m) _Pragma("unroll") for (int n = 0; n < 2; ++n) _Pragma("unroll") for (int k = 0; k < 2; ++k) \
        acc[ai][bj][m][n] = __builtin_amdgcn_mfma_f32_16x16x32_bf16(Bt[n][k], At[m][k], acc[ai][bj][m][n], 0, 0, 0); } while (0)
#define PG8_MMAQ(ai, bj, At, Bt) do { _Pragma("unroll") for (int m = 0; m < 4; ++m) _Pragma("unroll") for (int n = 0; n < 2; ++n) _Pragma("unroll") for (int k = 0; k < 2; ++k) { \
        const i64x2_t bq = __builtin_bit_cast(i64x2_t, Bt[n][k]), aq = __builtin_bit_cast(i64x2_t, At[m][k]); \
        acc[ai][bj][m][n] = __builtin_amdgcn_mfma_f32_16x16x32_fp8_fp8(bq[0], aq[0], acc[ai][bj][m][n], 0, 0, 0); \
        acc[ai][bj][m][n] = __builtin_amdgcn_mfma_f32_16x16x32_fp8_fp8(bq[1], aq[1], acc[ai][bj][m][n], 0, 0, 0); } } while (0)
#define PG8_MMA8(ai, bj, A8, B8) do { _Pragma("unroll") for (int m = 0; m < 4; ++m) _Pragma("unroll") for (int n = 0; n < 2; ++n) \
        acc[ai][bj][m][n] = __builtin_amdgcn_mfma_scale_f32_16x16x128_f8f6f4(B8[n], A8[m], acc[ai][bj][m][n], 0, 0, 0, 0, 0, 0); } while (0)
#define PG8_LDA8(dst, b, h) do { _Pragma("unroll") for (int m = 0; m < 4; ++m) { dst[m].lo = *(const LAS i32x4_t*)(lds + PG8_SA(b, h) + aoff + m * 2048); dst[m].hi = *(const LAS i32x4_t*)(lds + PG8_SA(b, h) + aoff + m * 2048 + 1024); } } while (0)
#define PG8_LDB8(dst, b, h) do { _Pragma("unroll") for (int n = 0; n < 2; ++n) { dst[n].lo = *(const LAS i32x4_t*)(lds + PG8_SB(b, h) + boff + n * 2048); dst[n].hi = *(const LAS i32x4_t*)(lds + PG8_SB(b, h) + boff + n * 2048 + 1024); } } while (0)
#define PG8_XLDA(b, h)  do { if constexpr (Prob::F8 && F8MODE == 2) PG8_LDA8(At8, b, h); else PG8_LDA(At, b, h); } while (0)
#define PG8_XLDB0(b, h) do { if constexpr (Prob::F8 && F8MODE == 2) PG8_LDB8(B08, b, h); else PG8_LDB(B0, b, h); } while (0)
#define PG8_XLDB1(b, h) do { if constexpr (Prob::F8 && F8MODE == 2) PG8_LDB8(B18, b, h); else PG8_LDB(B1, b, h); } while (0)
#define PG8_XMMA0(ai, bj) do { if (USE_SETPRIO) __builtin_amdgcn_s_setprio(USE_SETPRIO); if constexpr (Prob::F8 && F8MODE == 2) PG8_MMA8(ai, bj, At8, B08); else if constexpr (Prob::F8) PG8_MMAQ(ai, bj, At, B0); else PG8_MMAB(ai, bj, At, B0); if (USE_SETPRIO) __builtin_amdgcn_s_setprio(0); } while (0)
#define PG8_XMMA1(ai, bj) do { if (USE_SETPRIO) __builtin_amdgcn_s_setprio(USE_SETPRIO); if constexpr (Prob::F8 && F8MODE == 2) PG8_MMA8(ai, bj, At8, B18); else if constexpr (Prob::F8) PG8_MMAQ(ai, bj, At, B1); else PG8_MMAB(ai, bj, At, B1); if (USE_SETPRIO) __builtin_amdgcn_s_setprio(0); } while (0)
#define PG8_WAIT_V(n) asm volatile("s_waitcnt vmcnt(" #n ")" ::: "memory")
#define PG8_WAIT_L(n) asm volatile("s_waitcnt lgkmcnt(" #n ")" ::: "memory")
#define PG8_BAR __builtin_amdgcn_s_barrier()
#define PG8_SCHED __builtin_amdgcn_sched_barrier(0)
    Unit cur, nxt; int ui = 0;
    if (!S.next(0, cur)) return;
    unsigned vo[2][2], nvo[2][2];
    calc_aoff(P, cur, Rr, Cc, vo);
    bool has_next = S.next(1, nxt);
    if constexpr (Prob::GATHER) { if (has_next) calc_aoff(P, nxt, Rr, Cc, nvo); else {
#pragma unroll
        for (int h = 0; h < 2; ++h)
#pragma unroll
            for (int i = 0; i < 2; ++i) nvo[h][i] = vo[h][i]; } }
    f32x4 acc[2][2][4][2];
#pragma unroll
    for (int a = 0; a < 2; ++a)
#pragma unroll
        for (int b = 0; b < 2; ++b)
#pragma unroll
            for (int m = 0; m < 4; ++m)
#pragma unroll
                for (int n = 0; n < 2; ++n) acc[a][b][m][n] = (f32x4){0.f, 0.f, 0.f, 0.f};
    bf16x8 At[4][2], B0[2][2], B1[2][2]; i32x8_t At8[4], B08[2], B18[2];
    const char* cA = P.a_base(cur); const char* cB = P.b_base(cur);
    PG8_STGB(PG8_SB(0, 0), cB); PG8_STGB(PG8_SB(0, 1), cB + bhstep); PG8_STG(PG8_SA(0, 0), cA, vo[0][0], vo[0][1]); PG8_STG(PG8_SA(0, 1), cA, vo[1][0], vo[1][1]);
    if (wr == 1) PG8_BAR;
    PG8_WAIT_V(2); PG8_BAR;
    PG8_STGB(PG8_SB(1, 0), cB + kstep); PG8_STG(PG8_SA(1, 0), cA + kstep, vo[0][0], vo[0][1]); PG8_STGB(PG8_SB(1, 1), cB + bhstep + kstep);
    PG8_WAIT_V(6); PG8_BAR;
    for (;;) {
        const char* nA = has_next ? P.a_base(nxt) : cA; const char* nB = has_next ? P.b_base(nxt) : cB;
        for (int t = 0; t < nt; t += 2) {
            const bool last = (t == nt - 2);
            if constexpr (Epi::HAS_MID) { if (t == Epi::MID_T0 || t == Epi::MID_T1) { E.mid(acc, cur, wr, wc, fr, fq, t == Epi::MID_T0 ? 0 : 1); PG8_SCHED; } }
            const char* a1 = cA + (size_t)(t + 1) * kstep;
            const char* a2 = last ? nA : cA + (size_t)(t + 2) * kstep; const char* b2 = last ? nB : cB + (size_t)(t + 2) * kstep;
            const char* a3 = a2 + kstep; const char* b3 = b2 + kstep;
            unsigned x00 = vo[0][0], x01 = vo[0][1], x10 = vo[1][0], x11 = vo[1][1];
            if constexpr (Prob::GATHER) { if (last) { x00 = nvo[0][0]; x01 = nvo[0][1]; x10 = nvo[1][0]; x11 = nvo[1][1]; } }
            PG8_XLDB0(0, 0); PG8_XLDB1(0, 1); PG8_SCHED; PG8_XLDA(0, 0); PG8_STG(PG8_SA(1, 1), a1, vo[1][0], vo[1][1]);
            PG8_WAIT_V(8); PG8_WAIT_L(0); PG8_BAR; PG8_XMMA0(0, 0); PG8_XMMA1(0, 1); PG8_BAR; PG8_SCHED;
            PG8_XLDA(0, 1); PG8_STGB(PG8_SB(0, 0), b2); PG8_STGB(PG8_SB(0, 1), b2 + bhstep); PG8_STG(PG8_SA(0, 0), a2, x00, x01);
            PG8_WAIT_V(8); PG8_WAIT_L(0); PG8_BAR; PG8_XMMA0(1, 0); PG8_XMMA1(1, 1); PG8_BAR; PG8_SCHED;
            PG8_XLDB0(1, 0); PG8_XLDB1(1, 1); PG8_SCHED; PG8_XLDA(1, 0); PG8_STG(PG8_SA(0, 1), a2, x10, x11);
            PG8_WAIT_V(8); PG8_WAIT_L(0); PG8_BAR; PG8_XMMA0(0, 0); PG8_XMMA1(0, 1); PG8_BAR; PG8_SCHED;
            PG8_XLDA(1, 1); PG8_STGB(PG8_SB(1, 0), b3); PG8_STGB(PG8_SB(1, 1), b3 + bhstep); PG8_STG(PG8_SA(1, 0), a3, x00, x01);
            PG8_WAIT_V(8); PG8_WAIT_L(0); PG8_BAR; PG8_XMMA0(1, 0); PG8_XMMA1(1, 1); PG8_BAR; PG8_SCHED;
        }
        if constexpr (ALIGN_EPI) { if (wr == 0) PG8_BAR; }
        Unit nn; const bool has_nn = has_next && S.next(ui + 2, nn);
        if constexpr (Prob::GATHER) {
#pragma unroll
            for (int h = 0; h < 2; ++h)
#pragma unroll
                for (int i = 0; i < 2; ++i) vo[h][i] = nvo[h][i];
            if (has_nn) {
#pragma unroll
                for (int h = 0; h < 2; ++h)
#pragma unroll
                    for (int i = 0; i < 2; ++i) nvo[h][i] = P.a_raw(nn, h * HALF + Rr[i]); } }
        E(acc, cur, wr, wc, fr, fq);
        if (!has_next) break;
#pragma unroll
        for (int a = 0; a < 2; ++a)
#pragma unroll
            for (int b = 0; b < 2; ++b)
#pragma unroll
                for (int m = 0; m < 4; ++m)
#pragma unroll
                    for (int n = 0; n < 2; ++n) acc[a][b][m][n] = (f32x4){0.f, 0.f, 0.f, 0.f};
        cur = nxt; cA = nA; cB = nB; ++ui;
        has_next = has_nn; nxt = nn;
        if constexpr (Prob::GATHER) { if (has_next) {
#pragma unroll
            for (int h = 0; h < 2; ++h)
#pragma unroll
                for (int i = 0; i < 2; ++i) nvo[h][i] = (nvo[h][i] >> 2) * (Prob::F8 ? 1024u : 2048u) + (unsigned)Cc[i] * 2u;
            asm volatile("" : "+v"(nvo[0][0]), "+v"(nvo[0][1]), "+v"(nvo[1][0]), "+v"(nvo[1][1])); } }
        if constexpr (ALIGN_EPI) { if (wr == 1) PG8_BAR; }
    }
    PG8_WAIT_V(0);
    if constexpr (!ALIGN_EPI) { if (wr == 0) PG8_BAR; }
    PG8_BAR;
#undef PG8_SA
#undef PG8_SB
#undef PG8_STG
#undef PG8_STGB
#undef PG8_LDA
#undef PG8_LDB
#undef PG8_MMAB
#undef PG8_MMAQ
#undef PG8_MMA8
#undef PG8_LDA8
#undef PG8_LDB8
#undef PG8_XLDA
#undef PG8_XLDB0
#undef PG8_XLDB1
#undef PG8_XMMA0
#undef PG8_XMMA1
#undef PG8_WAIT_V
#undef PG8_WAIT_L
#undef PG8_BAR
#undef PG8_SCHED
}

typedef const f32x4 (&AccRef)[2][2][4][2];

__device__ __forceinline__ void store8(bf16_t* p, const f32x4& a, const f32x4& b) {
    u32x4 w; w.x = cvt_pk_bf16(a[0], a[1]); w.y = cvt_pk_bf16(a[2], a[3]); w.z = cvt_pk_bf16(b[0], b[1]); w.w = cvt_pk_bf16(b[2], b[3]); *(u32x4*)p = w;
}
__device__ __forceinline__ float sigmoidf_(float v) { return __builtin_amdgcn_rcpf(1.0f + __builtin_amdgcn_exp2f(-1.4426950408889634f * v)); }

struct EpiInProj {
    static constexpr bool HAS_MID = false;
    bf16_t *Q, *Kb, *V, *U, *MQ, *GT; const float *qn, *kn, *mqn, *bg; const f32x2* rope;
    __device__ __forceinline__ void operator()(AccRef acc, const Unit& u, int wr, int wc, int fr, int fq) const {
        const int pn = u.pn; const int row0 = u.pm * BM + wr * 64 + fr;
        bf16_t* const Q_ = Q; bf16_t* const K_ = Kb; bf16_t* const V_ = V; bf16_t* const U_ = U; bf16_t* const MQ_ = MQ; const float* const qn_ = qn; const float* const kn_ = kn; const float* const mqn_ = mqn;
        if (pn < 4 || pn == 7) {
            const bool rope_on = pn < 4; const float* gn = pn < 2 ? qn_ : (pn < 4 ? kn_ : mqn_);
            const float sc = (pn < 2 || pn == 7) ? C2 : 1.0f;
            bf16_t* O; int pitch, colb;
            if (pn < 2) { O = Q_; pitch = 512; colb = (pn * 4 + wc) * 64; } else if (pn < 4) { O = K_; pitch = 512; colb = ((pn - 2) * 4 + wc) * 64; } else { O = MQ_; pitch = 256; colb = wc * 64; }
            const f32x4 g00 = *(const f32x4*)(gn + 8 * fq), g01 = *(const f32x4*)(gn + 8 * fq + 4), g10 = *(const f32x4*)(gn + 32 + 8 * fq), g11 = *(const f32x4*)(gn + 32 + 8 * fq + 4);
#pragma unroll
            for (int ai = 0; ai < 2; ++ai)
#pragma unroll
                for (int m = 0; m < 4; ++m) {
                    const f32x4 a0 = acc[ai][0][m][0], a1 = acc[ai][0][m][1], b0 = acc[ai][1][m][0], b1 = acc[ai][1][m][1];
                    float ss = 0.f;
#pragma unroll
                    for (int j = 0; j < 4; ++j) ss += a0[j] * a0[j] + a1[j] * a1[j] + b0[j] * b0[j] + b1[j] * b1[j];
                    ss += __shfl_xor(ss, 16); ss += __shfl_xor(ss, 32);
                    const float rstd = 1.0f / sqrtf(ss * (1.0f / 64.0f) + RMS_EPS);
                    const int row = row0 + ai * HALF + m * 16;
                    f32x4 t10 = a0 * rstd * g00, t11 = a1 * rstd * g01, t20 = b0 * rstd * g10, t21 = b1 * rstd * g11;
                    f32x4 o10, o11, o20, o21;
                    if (rope_on) {
                        const f32x4* rp = (const f32x4*)(rope + (size_t)(row & (SEQ - 1)) * 32 + 8 * fq);
                        const f32x4 r0 = rp[0], r1 = rp[1], r2 = rp[2], r3 = rp[3];
                        const f32x4 cs0 = {r0[0], r0[2], r1[0], r1[2]}, sn0 = {r0[1], r0[3], r1[1], r1[3]}, cs1 = {r2[0], r2[2], r3[0], r3[2]}, sn1 = {r2[1], r2[3], r3[1], r3[3]};
                        o10 = (t10 * cs0 - t20 * sn0) * sc; o11 = (t11 * cs1 - t21 * sn1) * sc; o20 = (t20 * cs0 + t10 * sn0) * sc; o21 = (t21 * cs1 + t11 * sn1) * sc;
                    } else { o10 = t10 * sc; o11 = t11 * sc; o20 = t20 * sc; o21 = t21 * sc; }
                    bf16_t* rowp = O + (size_t)row * pitch + colb + 8 * fq;
                    store8(rowp, o10, o11); store8(rowp + 32, o20, o21);
                }
        } else if (pn < 7) {
            bf16_t* O; int pitch, colb;
            if (pn < 6) { O = V_; pitch = 512; colb = (pn - 4) * 256 + wc * 64; } else { O = U_; pitch = 256; colb = wc * 64; }
#pragma unroll
            for (int ai = 0; ai < 2; ++ai)
#pragma unroll
                for (int m = 0; m < 4; ++m) { bf16_t* rowp = O + (size_t)(row0 + ai * HALF + m * 16) * pitch + colb + 8 * fq;
                    store8(rowp, acc[ai][0][m][0], acc[ai][0][m][1]); store8(rowp + 32, acc[ai][1][m][0], acc[ai][1][m][1]); }
        } else {
            const int gc = (pn - 8) * 256 + wc * 64 + 8 * fq;
            f32x4 bv[2][2];
#pragma unroll
            for (int bj = 0; bj < 2; ++bj)
#pragma unroll
                for (int n = 0; n < 2; ++n) bv[bj][n] = *(const f32x4*)(bg + gc + 32 * bj + 4 * n);
#pragma unroll
            for (int ai = 0; ai < 2; ++ai)
#pragma unroll
                for (int m = 0; m < 4; ++m) { bf16_t* rowp = GT + (size_t)(row0 + ai * HALF + m * 16) * 3072 + gc;
#pragma unroll
                    for (int bj = 0; bj < 2; ++bj) { f32x4 v0 = acc[ai][bj][m][0] + bv[bj][0], v1 = acc[ai][bj][m][1] + bv[bj][1];
#pragma unroll
                        for (int j = 0; j < 4; ++j) { v0[j] = sigmoidf_(v0[j]); v1[j] = sigmoidf_(v1[j]); }
                        store8(rowp + 32 * bj, v0, v1); } }
        }
    }
};
struct EpiMemKV {
    static constexpr bool HAS_MID = false;
    bf16_t* MKV; const float* mkn;
    __device__ __forceinline__ void operator()(AccRef acc, const Unit& u, int wr, int wc, int fr, int fq) const {
        const int row0 = u.pm * BM + wr * 64 + fr;
        f32x4 g00 = {1.f, 1.f, 1.f, 1.f}, g01 = g00, g10 = g00, g11 = g00;
        if (u.pn == 0) { g00 = *(const f32x4*)(mkn + 8 * fq); g01 = *(const f32x4*)(mkn + 8 * fq + 4); g10 = *(const f32x4*)(mkn + 32 + 8 * fq); g11 = *(const f32x4*)(mkn + 32 + 8 * fq + 4); }
#pragma unroll
        for (int ai = 0; ai < 2; ++ai)
#pragma unroll
            for (int m = 0; m < 4; ++m) {
                const f32x4 a0 = acc[ai][0][m][0], a1 = acc[ai][0][m][1], b0 = acc[ai][1][m][0], b1 = acc[ai][1][m][1];
                float rstd = 1.0f;
                if (u.pn == 0) { float ss = 0.f;
#pragma unroll
                    for (int j = 0; j < 4; ++j) ss += a0[j] * a0[j] + a1[j] * a1[j] + b0[j] * b0[j] + b1[j] * b1[j];
                    ss += __shfl_xor(ss, 16); ss += __shfl_xor(ss, 32); rstd = 1.0f / sqrtf(ss * (1.0f / 64.0f) + RMS_EPS); }
                bf16_t* rowp = MKV + (size_t)(row0 + ai * HALF + m * 16) * 512 + u.pn * 256 + wc * 64 + 8 * fq;
                store8(rowp, a0 * rstd * g00, a1 * rstd * g01); store8(rowp + 32, b0 * rstd * g10, b1 * rstd * g11);
            }
    }
};
template <int STAGE> struct EpiMerge {
    static constexpr bool HAS_MID = false;
    const bf16_t* GT; float* MF; bf16_t* MB;
    __device__ __forceinline__ void operator()(AccRef acc, const Unit& u, int wr, int wc, int fr, int fq) const {
        const int row0 = u.pm * BM + wr * 64 + fr, col0 = u.pn * BM + wc * 64 + 8 * fq;
#pragma unroll
        for (int ai = 0; ai < 2; ++ai)
#pragma unroll
            for (int m = 0; m < 4; ++m) { const size_t row = (size_t)(row0 + ai * HALF + m * 16);
#pragma unroll
                for (int bj = 0; bj < 2; ++bj) { const int col = col0 + 32 * bj;
                    const u32x4 g = *(const u32x4*)(GT + row * 3072 + STAGE * 1024 + col);
                    const f32x4 ga = {bf_lo(g.x), bf_hi(g.x), bf_lo(g.y), bf_hi(g.y)}, gb = {bf_lo(g.z), bf_hi(g.z), bf_lo(g.w), bf_hi(g.w)};
                    f32x4 v0 = acc[ai][bj][m][0] * ga, v1 = acc[ai][bj][m][1] * gb;
                    float* mp = MF + row * 1024 + col;
                    if (STAGE > 0) { v0 += *(const f32x4*)mp; v1 += *(const f32x4*)(mp + 4); }
                    if (STAGE < 2) { *(f32x4*)mp = v0; *(f32x4*)(mp + 4) = v1; } else store8(MB + row * 1024 + col, v0, v1); }
                if (m & 1) asm volatile("" ::: "memory"); }
    }
};
struct EpiWout {
    static constexpr bool HAS_MID = false;
    const float* X; float* X2; unsigned char* XG; const float* n2;
    __device__ __forceinline__ void operator()(AccRef acc, const Unit& u, int wr, int wc, int fr, int fq) const {
        const int row0 = u.pm * BM + wr * 64 + fr, col0 = u.pn * BM + wc * 64 + 8 * fq;
        f32x4 nv[2][2];
#pragma unroll
        for (int bj = 0; bj < 2; ++bj)
#pragma unroll
            for (int n = 0; n < 2; ++n) nv[bj][n] = *(const f32x4*)(n2 + col0 + 32 * bj + 4 * n);
#pragma unroll
        for (int ai = 0; ai < 2; ++ai)
#pragma unroll
            for (int m = 0; m < 4; ++m) { const size_t off = (size_t)(row0 + ai * HALF + m * 16) * 1024 + col0;
#pragma unroll
                for (int bj = 0; bj < 2; ++bj) { const f32x4 x0 = *(const f32x4*)(X + off + 32 * bj) + acc[ai][bj][m][0], x1 = *(const f32x4*)(X + off + 32 * bj + 4) + acc[ai][bj][m][1];
                    *(f32x4*)(X2 + off + 32 * bj) = x0; *(f32x4*)(X2 + off + 32 * bj + 4) = x1;
                    { const f32x4 y0 = x0 * nv[bj][0], y1 = x1 * nv[bj][1]; u32x2 w8; w8.x = pk4_fp8(y0[0], y0[1], y0[2], y0[3]); w8.y = pk4_fp8(y1[0], y1[1], y1[2], y1[3]); *(u32x2*)(XG + off + 32 * bj) = w8; } }
                if (m & 1) asm volatile("" ::: "memory"); }
    }
};
struct EpiSwiglu {
    static constexpr bool HAS_MID = false;
    unsigned char* ACT; const u32x2* list; const float* bgu;
    __device__ __forceinline__ void operator()(AccRef acc, const Unit& u, int wr, int wc, int fr, int fq) const {
        int z = 0; asm volatile("" : "+v"(z));
        const int col = 128 * u.pn + 32 * wc + 8 * fq + z; const float* bp = bgu + (size_t)u.e * 2048 + col;
        const f32x4 bg0 = *(const f32x4*)bp, bg1 = *(const f32x4*)(bp + 4), bu0 = *(const f32x4*)(bp + 1024), bu1 = *(const f32x4*)(bp + 1028);
#pragma unroll
        for (int ai = 0; ai < 2; ++ai)
#pragma unroll
            for (int m = 0; m < 4; ++m) { const int r = ai * HALF + wr * 64 + m * 16 + fr, rr = u.mt * BM + r, rc = rr < u.cnt ? rr : u.cnt - 1;
                const float rstd = __uint_as_float(list[(size_t)u.e * CAP + rc].y) * (1.0f / W8_SCALE);
                f32x4 o[2];
#pragma unroll
                for (int n = 0; n < 2; ++n) { const f32x4 g = acc[ai][0][m][n] * rstd + (n ? bg1 : bg0), up = acc[ai][1][m][n] * rstd + (n ? bu1 : bu0);
#pragma unroll
                    for (int j = 0; j < 4; ++j) { const float gg = fminf(g[j], 7.0f), uu = fminf(fmaxf(up[j], -7.0f), 7.0f);
                        o[n][j] = gg * __builtin_amdgcn_rcpf(1.0f + __builtin_amdgcn_exp2f(-1.702f * 1.4426950408889634f * gg)) * (uu + 1.0f); } }
                { const f32x4 q0 = o[0] * A8_SCALE, q1 = o[1] * A8_SCALE; u32x2 w8; w8.x = pk4_fp8(q0[0], q0[1], q0[2], q0[3]); w8.y = pk4_fp8(q1[0], q1[1], q1[2], q1[3]); *(u32x2*)(ACT + (size_t)(u.pm * BM + r) * 1024 + col) = w8; } }
    }
};
struct EpiDown {
    static constexpr bool HAS_MID = false;
    bf16_t* Y4; const u32x2* list; const float* bd;
    __device__ __forceinline__ void operator()(AccRef acc, const Unit& u, int wr, int wc, int fr, int fq) const {
        int z = 0; asm volatile("" : "+v"(z));
        const int col0 = u.pn * BM + wc * 64 + 8 * fq + z; const float* bp = bd + (size_t)u.e * 1024 + col0;
        f32x4 bv[2][2];
#pragma unroll
        for (int bj = 0; bj < 2; ++bj)
#pragma unroll
            for (int n = 0; n < 2; ++n) bv[bj][n] = *(const f32x4*)(bp + 32 * bj + 4 * n);
        unsigned tkv[8];
#pragma unroll
        for (int ai = 0; ai < 2; ++ai)
#pragma unroll
            for (int m = 0; m < 4; ++m) { const int rr = u.mt * BM + ai * HALF + wr * 64 + m * 16 + fr, rc = rr < u.cnt ? rr : u.cnt - 1;
                tkv[ai * 4 + m] = list[(size_t)u.e * CAP + rc].x; }
#pragma unroll
        for (int ai = 0; ai < 2; ++ai)
#pragma unroll
            for (int m = 0; m < 4; ++m) { const int rr = u.mt * BM + ai * HALF + wr * 64 + m * 16 + fr;
                if (rr < u.cnt) { bf16_t* rowp = Y4 + (size_t)tkv[ai * 4 + m] * 1024 + col0;
#pragma unroll
                    for (int bj = 0; bj < 2; ++bj) store8(rowp + 32 * bj, acc[ai][bj][m][0] * (1.0f / (W8_SCALE * A8_SCALE)) + bv[bj][0], acc[ai][bj][m][1] * (1.0f / (W8_SCALE * A8_SCALE)) + bv[bj][1]); } }
    }
};
struct EpiMergeR {
    static constexpr bool HAS_MID = true; static constexpr int MID_T0 = 8, MID_T1 = 12;
    const bf16_t* GT; bf16_t* MB;
    __device__ __forceinline__ void mid(f32x4 (&acc)[2][2][4][2], const Unit& u, int wr, int wc, int fr, int fq, int seam) const {
        int z = 0; asm volatile("" : "+v"(z));
        const bf16_t* gp0 = GT + (size_t)(u.pm * BM + wr * 64 + fr + z) * 3072 + seam * 1024 + u.pn * BM + wc * 64 + 8 * fq;
#pragma unroll
        for (int ai = 0; ai < 2; ++ai)
#pragma unroll
            for (int m = 0; m < 4; ++m) { const bf16_t* gp = gp0 + (size_t)(ai * HALF + m * 16) * 3072;
#pragma unroll
                for (int bj = 0; bj < 2; ++bj) { const u32x4 gn = *(const u32x4*)(gp + 32 * bj), gd = *(const u32x4*)(gp + 1024 + 32 * bj);
                    const unsigned nn[4] = {gn.x, gn.y, gn.z, gn.w}, dd[4] = {gd.x, gd.y, gd.z, gd.w};
#pragma unroll
                    for (int j = 0; j < 4; ++j) { const float r0 = bf_lo(nn[j]) * __builtin_amdgcn_rcpf(fmaxf(bf_lo(dd[j]), 8.67e-19f)), r1 = bf_hi(nn[j]) * __builtin_amdgcn_rcpf(fmaxf(bf_hi(dd[j]), 8.67e-19f));
                        acc[ai][bj][m][j >> 1][(j & 1) * 2] *= r0; acc[ai][bj][m][j >> 1][(j & 1) * 2 + 1] *= r1; } }
                if (m & 1) asm volatile("" ::: "memory"); }
    }
    __device__ __forceinline__ void operator()(AccRef acc, const Unit& u, int wr, int wc, int fr, int fq) const {
        int z = 0; asm volatile("" : "+v"(z));
        const size_t off0 = (size_t)(u.pm * BM + wr * 64 + fr + z) * 1024 + u.pn * BM + wc * 64 + 8 * fq;
#pragma unroll
        for (int ai = 0; ai < 2; ++ai)
#pragma unroll
            for (int m = 0; m < 4; ++m) { const size_t ro = off0 + (size_t)(ai * HALF + m * 16) * 1024;
#pragma unroll
                for (int bj = 0; bj < 2; ++bj) {
                    const u32x4 g = *(const u32x4*)(GT + ro * 3 + 2048 - 2 * (ro & 1023) + 32 * bj);
                    const f32x4 ga = {bf_lo(g.x), bf_hi(g.x), bf_lo(g.y), bf_hi(g.y)}, gb = {bf_lo(g.z), bf_hi(g.z), bf_lo(g.w), bf_hi(g.w)};
                    store8(MB + ro + 32 * bj, acc[ai][bj][m][0] * ga, acc[ai][bj][m][1] * gb); } }
    }
};
struct EpiPlain {
    static constexpr bool HAS_MID = false;
    bf16_t* Z; int ldz;
    __device__ __forceinline__ void operator()(AccRef acc, const Unit& u, int wr, int wc, int fr, int fq) const {
        const int row0 = u.pm * BM + wr * 64 + fr, col0 = u.pn * BM + wc * 64 + 8 * fq;
#pragma unroll
        for (int ai = 0; ai < 2; ++ai)
#pragma unroll
            for (int m = 0; m < 4; ++m) { bf16_t* rowp = Z + (size_t)(row0 + ai * HALF + m * 16) * ldz + col0;
                store8(rowp, acc[ai][0][m][0], acc[ai][0][m][1]); store8(rowp + 32, acc[ai][1][m][0], acc[ai][1][m][1]); }
    }
};
}

namespace attn_body {
using bf16 = __hip_bfloat16;
using s16x4 = __attribute__((ext_vector_type(4))) short;
constexpr int NW = 8, QBLK = 32, QB = QBLK * NW, KVBLK = 64, D = 64;
__device__ __forceinline__ int crow(int r, int hi) { return (r & 3) + 8 * (r >> 2) + 4 * hi; }
#define SBAR() __builtin_amdgcn_sched_barrier(0)
constexpr int NSLOT = 3, SLOTB = 8192;
constexpr int LDS_K = 0, LDS_V = NSLOT * SLOTB, LDS_WS = 2 * NSLOT * SLOTB, LDS_OST = LDS_WS + NW * 64 * 4, LDS_BYTES = LDS_OST + NW * 4096;
__device__ __forceinline__ void glds16(const void* gsrc, unsigned lds_dst) { unsigned keep;
    asm volatile("s_mov_b32 %0, m0\n\ts_mov_b32 m0, %2\n\ts_nop 0\n\tglobal_load_lds_dwordx4 %1, off\n\ts_mov_b32 m0, %0" : "=&s"(keep) : "v"(gsrc), "s"(lds_dst) : "memory"); }
__device__ __forceinline__ float max3f(float a, float b, float c) { float r; asm("v_max3_f32 %0, %1, %2, %3" : "=v"(r) : "v"(a), "v"(b), "v"(c)); return r; }
__device__ __forceinline__ float max2f(float a, float b) { float r; asm("v_max_f32_e32 %0, %1, %2" : "=v"(r) : "v"(a), "v"(b)); return r; }
__device__ __forceinline__ float fadd_s(float a, float b) { float r; asm("v_add_f32_e32 %0, %1, %2" : "=v"(r) : "v"(a), "v"(b)); return r; }
__device__ __forceinline__ float fsub_s(float a, float b) { float r; asm("v_sub_f32_e32 %0, %1, %2" : "=v"(r) : "v"(a), "v"(b)); return r; }
typedef float f32x2_t __attribute__((ext_vector_type(2))); typedef __bf16 bf16x2_t __attribute__((ext_vector_type(2)));
__device__ __forceinline__ unsigned cvtpk_s(float lo, float hi) { f32x2_t v = {lo, hi}; bf16x2_t b = __builtin_convertvector(v, bf16x2_t); return __builtin_bit_cast(unsigned, b); }
#define WAIT_BAR(N) asm volatile("s_waitcnt vmcnt(" #N ") lgkmcnt(0)\n\ts_barrier" ::: "memory")

__device__ __forceinline__ void qkt(f32x16& p0, f32x16& p1, const char* Kslot, const bf16x8* qr, const f32x16& negm, int r32, int hi) {
    const char* kb = Kslot + hi * 1024 + r32 * 16;
#pragma unroll
    for (int d0 = 0; d0 < 4; ++d0) {
        const bf16x8 b0 = *reinterpret_cast<const bf16x8*>(kb + d0 * 2048);
        const bf16x8 b1 = *reinterpret_cast<const bf16x8*>(kb + d0 * 2048 + 512);
        if (d0 == 0) { p0 = __builtin_amdgcn_mfma_f32_32x32x16_bf16(b0, qr[0], negm, 0, 0, 0); p1 = __builtin_amdgcn_mfma_f32_32x32x16_bf16(b1, qr[0], negm, 0, 0, 0); }
        else { p0 = __builtin_amdgcn_mfma_f32_32x32x16_bf16(b0, qr[d0], p0, 0, 0, 0); p1 = __builtin_amdgcn_mfma_f32_32x32x16_bf16(b1, qr[d0], p1, 0, 0, 0); } }
}
typedef __attribute__((address_space(3))) const char* lds_cptr;
typedef short v4i16_t __attribute__((ext_vector_type(4)));
__device__ __forceinline__ void kload8(bf16x8* kf, lds_cptr kp) {
    kf[0] = *(const __attribute__((address_space(3))) bf16x8*)(kp);        kf[1] = *(const __attribute__((address_space(3))) bf16x8*)(kp + 512);
    kf[2] = *(const __attribute__((address_space(3))) bf16x8*)(kp + 2048); kf[3] = *(const __attribute__((address_space(3))) bf16x8*)(kp + 2560);
    kf[4] = *(const __attribute__((address_space(3))) bf16x8*)(kp + 4096); kf[5] = *(const __attribute__((address_space(3))) bf16x8*)(kp + 4608);
    kf[6] = *(const __attribute__((address_space(3))) bf16x8*)(kp + 6144); kf[7] = *(const __attribute__((address_space(3))) bf16x8*)(kp + 6656);
}
__device__ __forceinline__ void kload2(bf16x8* kf, lds_cptr kp, int j) { kf[2 * j] = *(const __attribute__((address_space(3))) bf16x8*)(kp + j * 2048); kf[2 * j + 1] = *(const __attribute__((address_space(3))) bf16x8*)(kp + j * 2048 + 512); }
__device__ __forceinline__ s16x4 vtr(lds_cptr p) { return __builtin_bit_cast(s16x4, __builtin_amdgcn_ds_read_tr16_b64_v4i16((__attribute__((address_space(3))) v4i16_t*)p)); }
__device__ __forceinline__ float rowmax(const f32x16& p0, const f32x16& p1) {
    float a = max3f(p0[0], p0[1], p1[0]), b = max3f(p0[2], p0[3], p1[1]); a = max3f(a, p1[2], p1[3]);
#pragma unroll
    for (int r = 4; r < 16; r += 4) { a = max3f(a, p0[r], p0[r + 1]); b = max3f(b, p0[r + 2], p0[r + 3]); a = max3f(a, p1[r], p1[r + 1]); b = max3f(b, p1[r + 2], p1[r + 3]); }
    const float m = max2f(a, b);
    auto rr = __builtin_amdgcn_permlane32_swap(__float_as_uint(m), __float_as_uint(m), false, false);
    return max2f(__uint_as_float(rr[0]), __uint_as_float(rr[1]));
}
__device__ __forceinline__ void pv(f32x16* o, int vb, bf16x8 pa0, bf16x8 pa1, bf16x8 pa2, bf16x8 pa3) {
#pragma unroll
    for (int d0 = 0; d0 < 2; ++d0) { s16x4 lo[4], hi[4];
#pragma unroll
        for (int ks = 0; ks < 4; ++ks) {
            asm volatile("ds_read_b64_tr_b16 %0,%1 offset:%c2" : "=&v"(lo[ks]) : "v"(vb), "i"(d0 * 4096 + ks * 1024) : "memory");
            asm volatile("ds_read_b64_tr_b16 %0,%1 offset:%c2" : "=&v"(hi[ks]) : "v"(vb), "i"(d0 * 4096 + ks * 1024 + 512) : "memory"); }
        asm volatile("s_waitcnt lgkmcnt(0)" ::: "memory"); SBAR();
#define PK(k) (bf16x8){lo[k][0], lo[k][1], lo[k][2], lo[k][3], hi[k][0], hi[k][1], hi[k][2], hi[k][3]}
        o[d0] = __builtin_amdgcn_mfma_f32_32x32x16_bf16(pa0, PK(0), o[d0], 0, 0, 0);
        o[d0] = __builtin_amdgcn_mfma_f32_32x32x16_bf16(pa1, PK(1), o[d0], 0, 0, 0);
        o[d0] = __builtin_amdgcn_mfma_f32_32x32x16_bf16(pa2, PK(2), o[d0], 0, 0, 0);
        o[d0] = __builtin_amdgcn_mfma_f32_32x32x16_bf16(pa3, PK(3), o[d0], 0, 0, 0);
#undef PK
    }
}
__device__ __forceinline__ void cmask(f32x16& p0, f32x16& p1, int jb, int wid) {
    if (jb > (wid >> 1)) {
#pragma unroll
        for (int r = 0; r < 16; ++r) { p0[r] = -INFINITY; p1[r] = -INFINITY; } }
}
template <int THRL, bool MASK> __device__ __forceinline__ void attn_unit(int q0, int NT, const bf16* Qh, int qp, const bf16* __restrict__ Kh, int kp, const bf16* __restrict__ Vh, int vp, bf16* Oh, int op, char* shm) {
    const int tid = threadIdx.x, lane = tid & 63, r32 = lane & 31, hi = lane >> 5; const int wid = __builtin_amdgcn_readfirstlane(tid >> 6);
    const bf16* Qw = Qh + (long)(q0 + wid * QBLK) * qp;
    const unsigned lds0 = (unsigned)(uintptr_t)shm;
    float* wsf = (float*)(shm + LDS_WS) + wid * 64;
    const bf16* ksrc = Kh + (long)lane * kp + wid * 8;
    const bf16* vsrc = Vh + (long)(16 * (wid & 3) + (lane >> 2)) * vp + (wid >> 2) * 32 + (lane & 3) * 8;
    const unsigned kdst = lds0 + LDS_K + wid * 1024, vdst = lds0 + LDS_V + wid * 1024;
#define DMA_K(t, slot) glds16(ksrc + (long)(t) * KVBLK * kp, (unsigned)__builtin_amdgcn_readfirstlane(kdst + (slot)))
#define DMA_V(t, slot) glds16(vsrc + (long)(t) * KVBLK * vp, (unsigned)__builtin_amdgcn_readfirstlane(vdst + (slot)))
    const int vb0 = (int)(lds0 + LDS_V) + ((lane >> 4) & 1) * 32 + (lane & 3) * 8 + (4 * hi + ((lane & 15) >> 2)) * 64;
    const char* Kbase = shm + LDS_K; bf16x8 kf[8];
    const lds_cptr shm3 = (lds_cptr)shm; const lds_cptr kp0 = shm3 + LDS_K + hi * 1024 + r32 * 16; const lds_cptr vp0 = shm3 + LDS_V + ((lane >> 4) & 1) * 32 + (lane & 3) * 8 + (4 * hi + ((lane & 15) >> 2)) * 64;
    DMA_K(0, 0); DMA_V(0, 0); DMA_K(1, SLOTB);
    bf16x8 qr[4];
#pragma unroll
    for (int d0 = 0; d0 < 4; ++d0) qr[d0] = *reinterpret_cast<const bf16x8*>(&Qw[(long)r32 * qp + d0 * 16 + hi * 8]);
    float mhat = 0.f, l_reg = 0.f; f32x16 o[2]; o[0] = f32x16{}; o[1] = f32x16{}; f32x16 negm = f32x16{}; asm volatile("" : "+v"(negm));
#define CMASK(P0, P1, t) do { if (MASK) { int jb_ = (t) - (NT - 4); if (jb_ >= 0) cmask(P0, P1, jb_, wid); } } while (0)
    bool resc = false;
#define START(P0, P1) do { const float rm = rowmax(P0, P1); resc = false; \
    { const float dl = rm; mhat = fadd_s(mhat, dl); \
      _Pragma("unroll") for (int r = 0; r < 16; ++r) { P0[r] = fsub_s(P0[r], dl); P1[r] = fsub_s(P1[r], dl); } \
      _Pragma("unroll") for (int r = 0; r < 16; ++r) negm[r] = -mhat; asm volatile("" : "+v"(negm)); } \
    _Pragma("unroll") for (int r = 0; r < 16; ++r) P0[r] = __builtin_amdgcn_exp2f(P0[r]); } while (0)
#define RESC() do { if (resc) { asm volatile("s_waitcnt lgkmcnt(0)" ::: "memory"); \
      _Pragma("unroll") for (int d_ = 0; d_ < 2; ++d_) _Pragma("unroll") for (int r = 0; r < 16; ++r) o[d_][r] *= wsf[crow(r, hi)]; } } while (0)
    f32x16 pA0, pA1, pB0, pB1;
    int sl_prev = 0, sl_cur = 0, sl_next = SLOTB;
#define ROT() do { sl_prev = sl_cur; sl_cur = sl_next; sl_next = (sl_next == (NSLOT - 1) * SLOTB) ? 0 : sl_next + SLOTB; } while (0)
    DMA_K(2, 2 * SLOTB);
    WAIT_BAR(3);
    qkt(pA0, pA1, Kbase, qr, negm, r32, hi); asm volatile("s_nop 15\n\ts_nop 7" : "+v"(pA0), "+v"(pA1)); CMASK(pA0, pA1, 0);
    START(pA0, pA1);
    _Pragma("unroll") for (int r = 0; r < 16; ++r) pA1[r] = __builtin_amdgcn_exp2f(pA1[r]);
    WAIT_BAR(0);
    DMA_K(3, 0); DMA_V(1, SLOTB);
    ROT();
    kload8(kf, kp0 + sl_cur);
    WAIT_BAR(2);
    s16x4 vlo[8], vhi[8]; u32x4 pw0, pw1, pw2, pw3;
#define PKW(P, B) cvtpk_s(P[B], P[B + 1])
#define PAF(k) __builtin_bit_cast(bf16x8, pw##k)
#define VFR(i) (bf16x8){vlo[i][0], vlo[i][1], vlo[i][2], vlo[i][3], vhi[i][0], vhi[i][1], vhi[i][2], vhi[i][3]}
#define PIN(x) asm volatile("" : "+v"(x))
#define MX3(a, b, c) __builtin_fmaxf(__builtin_fmaxf((a), (b)), (c))
#define GAPA(MF, A0, A1, A2, A3, W0, W1, PW) do { MF; sacc += A0; sacc += A1; sacc += A2; sacc += A3; PIN(sacc); W0; W1; PIN(PW); SBAR(); } while (0)
#define EX(v) __builtin_amdgcn_exp2f(v)
#define GAPB(MF, X, B) do { MF; X[B] = EX(X[B]); X[B + 1] = EX(X[B + 1]); X[B + 2] = EX(X[B + 2]); X[B + 3] = EX(X[B + 3]); PIN(X); SBAR(); } while (0)
#define VRD(i) do { vlo[i] = vtr(vp_ + (((i) >> 2) * 4096 + ((i) & 3) * 1024)); vhi[i] = vtr(vp_ + (((i) >> 2) * 4096 + ((i) & 3) * 1024 + 512)); } while (0)
#define KRD(G, j) do { if (G) { kload2(kf, kp0 + sl_next, j); SBAR(); } } while (0)
#define STEP(C0, C1, P0, P1, t, GK, GV, GL) do { SBAR(); \
    const lds_cptr vp_ = vp0 + sl_prev; \
    VRD(0); SBAR(); float sacc = (P0[0] + P0[1]); \
    GAPA(C0 = __builtin_amdgcn_mfma_f32_32x32x16_bf16(kf[0], qr[0], negm, 0, 0, 0), P0[2], P0[3], P0[4], P0[5],     pw0[0] = PKW(P0, 0), pw0[1] = PKW(P0, 2), pw0); \
    VRD(4); SBAR(); GAPA(C1 = __builtin_amdgcn_mfma_f32_32x32x16_bf16(kf[1], qr[0], negm, 0, 0, 0), P0[6], P0[7], P0[8], P0[9],     pw0[2] = PKW(P0, 4), pw0[3] = PKW(P0, 6), pw0); \
    VRD(1); SBAR(); GAPA(C0 = __builtin_amdgcn_mfma_f32_32x32x16_bf16(kf[2], qr[1], C0, 0, 0, 0),   P0[10], P0[11], P0[12], P0[13], pw1[0] = PKW(P0, 8), pw1[1] = PKW(P0, 10), pw1); \
    VRD(5); SBAR(); GAPA(C1 = __builtin_amdgcn_mfma_f32_32x32x16_bf16(kf[3], qr[1], C1, 0, 0, 0),   P0[14], P0[15], P1[0], P1[1],   pw1[2] = PKW(P0, 12), pw1[3] = PKW(P0, 14), pw1); \
    VRD(2); SBAR(); GAPA(C0 = __builtin_amdgcn_mfma_f32_32x32x16_bf16(kf[4], qr[2], C0, 0, 0, 0),   P1[2], P1[3], P1[4], P1[5],     pw2[0] = PKW(P1, 0), pw2[1] = PKW(P1, 2), pw2); \
    VRD(6); SBAR(); GAPA(C1 = __builtin_amdgcn_mfma_f32_32x32x16_bf16(kf[5], qr[2], C1, 0, 0, 0),   P1[6], P1[7], P1[8], P1[9],     pw2[2] = PKW(P1, 4), pw2[3] = PKW(P1, 6), pw2); \
    VRD(3); SBAR(); GAPA(C0 = __builtin_amdgcn_mfma_f32_32x32x16_bf16(kf[6], qr[3], C0, 0, 0, 0),   P1[10], P1[11], P1[12], P1[13], pw3[0] = PKW(P1, 8), pw3[1] = PKW(P1, 10), pw3); \
    VRD(7); SBAR(); GAPA(C1 = __builtin_amdgcn_mfma_f32_32x32x16_bf16(kf[7], qr[3], C1, 0, 0, 0),   P1[14], P1[15], 0.f, 0.f,       pw3[2] = PKW(P1, 12), pw3[3] = PKW(P1, 14), pw3); \
    l_reg += sacc; \
    if (GK) { DMA_K((t) + 3, sl_cur); } if (GV) { DMA_V((t) + 1, sl_next); } \
    CMASK(C0, C1, t); \
    { float a = MX3(C0[0], C0[1], C1[0]), b = MX3(C0[2], C0[3], C1[1]); a = MX3(a, C1[2], C1[3]); \
      _Pragma("unroll") for (int r = 4; r < 16; r += 4) { a = MX3(a, C0[r], C0[r + 1]); b = MX3(b, C0[r + 2], C0[r + 3]); a = MX3(a, C1[r], C1[r + 1]); b = MX3(b, C1[r + 2], C1[r + 3]); } \
      float rm = __builtin_fmaxf(a, b); { auto rr = __builtin_amdgcn_permlane32_swap(__float_as_uint(rm), __float_as_uint(rm), false, false); rm = __builtin_fmaxf(__uint_as_float(rr[0]), __uint_as_float(rr[1])); } \
      resc = false; \
      if (__builtin_expect(__any(rm > (float)THRL), 0)) { const float dl = __builtin_fmaxf(rm, 0.f); mhat += dl; \
        _Pragma("unroll") for (int r = 0; r < 16; ++r) { C0[r] -= dl; C1[r] -= dl; } \
        _Pragma("unroll") for (int r = 0; r < 16; ++r) negm[r] = -mhat; asm volatile("" : "+v"(negm)); \
        const float f = __builtin_amdgcn_exp2f(-dl); l_reg *= f; if (hi == 0) wsf[r32] = f; resc = true; } } \
    SBAR(); \
    GAPB(o[0] = __builtin_amdgcn_mfma_f32_32x32x16_bf16(PAF(0), VFR(0), o[0], 0, 0, 0), C0, 0); \
    GAPB(o[1] = __builtin_amdgcn_mfma_f32_32x32x16_bf16(PAF(0), VFR(4), o[1], 0, 0, 0), C0, 4); \
    KRD(GL, 0); GAPB(o[0] = __builtin_amdgcn_mfma_f32_32x32x16_bf16(PAF(1), VFR(1), o[0], 0, 0, 0), C0, 8); \
    KRD(GL, 1); GAPB(o[1] = __builtin_amdgcn_mfma_f32_32x32x16_bf16(PAF(1), VFR(5), o[1], 0, 0, 0), C0, 12); \
    KRD(GL, 2); GAPB(o[0] = __builtin_amdgcn_mfma_f32_32x32x16_bf16(PAF(2), VFR(2), o[0], 0, 0, 0), C1, 0); \
    KRD(GL, 3); GAPB(o[1] = __builtin_amdgcn_mfma_f32_32x32x16_bf16(PAF(2), VFR(6), o[1], 0, 0, 0), C1, 4); \
    GAPB(o[0] = __builtin_amdgcn_mfma_f32_32x32x16_bf16(PAF(3), VFR(3), o[0], 0, 0, 0), C1, 8); \
    GAPB(o[1] = __builtin_amdgcn_mfma_f32_32x32x16_bf16(PAF(3), VFR(7), o[1], 0, 0, 0), C1, 12); \
    } while (0)
    int t = 1;
#undef CMASK
#define CMASK(P0, P1, t) do {} while (0)
    for (; t + 5 < NT; t += 2) {
        STEP(pB0, pB1, pA0, pA1, t, true, true, true);     WAIT_BAR(2); RESC(); ROT();
        STEP(pA0, pA1, pB0, pB1, t + 1, true, true, true); WAIT_BAR(2); RESC(); ROT();
    }
#undef CMASK
#define CMASK(P0, P1, t) do { if (MASK) { int jb_ = (t) - (NT - 4); if (jb_ >= 0) cmask(P0, P1, jb_, wid); } } while (0)
#define ENDW(tt) do { if ((tt) + 3 < NT) { WAIT_BAR(2); } else if ((tt) + 2 < NT) { WAIT_BAR(1); } else { WAIT_BAR(0); } } while (0)
    for (; t + 1 < NT; t += 2) {
        STEP(pB0, pB1, pA0, pA1, t, (t + 3 < NT), (t + 1 < NT), (t + 1 < NT));       ENDW(t);     RESC(); ROT();
        STEP(pA0, pA1, pB0, pB1, t + 1, (t + 4 < NT), (t + 2 < NT), (t + 2 < NT));   ENDW(t + 1); RESC(); ROT();
    }
    STEP(pB0, pB1, pA0, pA1, NT - 1, false, false, false); RESC();
    { float sacc = pB0[0] + pB0[1]; _Pragma("unroll") for (int r = 2; r < 16; ++r) sacc += pB0[r]; _Pragma("unroll") for (int r = 0; r < 16; ++r) sacc += pB1[r]; l_reg += sacc;
      pw0 = (u32x4){PKW(pB0, 0), PKW(pB0, 2), PKW(pB0, 4), PKW(pB0, 6)}; pw1 = (u32x4){PKW(pB0, 8), PKW(pB0, 10), PKW(pB0, 12), PKW(pB0, 14)}; pw2 = (u32x4){PKW(pB1, 0), PKW(pB1, 2), PKW(pB1, 4), PKW(pB1, 6)}; pw3 = (u32x4){PKW(pB1, 8), PKW(pB1, 10), PKW(pB1, 12), PKW(pB1, 14)};
      SBAR(); pv(o, vb0 + sl_cur, PAF(0), PAF(1), PAF(2), PAF(3)); }
#undef PKW
#undef PAF
#undef VFR
#undef PIN
#undef MX3
#undef GAPA
#undef GAPB
#undef EX
#undef VRD
#undef KRD
#undef STEP
#undef ENDW
    { auto rr = __builtin_amdgcn_permlane32_swap(__float_as_uint(l_reg), __float_as_uint(l_reg), false, false); l_reg = __uint_as_float(rr[0]) + __uint_as_float(rr[1]); }
    if (hi == 0) wsf[32 + r32] = l_reg; asm volatile("s_waitcnt lgkmcnt(0)" ::: "memory");
    float rli[16];
#pragma unroll
    for (int r = 0; r < 16; ++r) rli[r] = __builtin_amdgcn_rcpf(wsf[32 + crow(r, hi)]);
    bf16* Ow = Oh + (long)(q0 + wid * QBLK) * op;
    { bf16* stg = (bf16*)(shm + LDS_OST) + wid * 2048;
#pragma unroll
      for (int r = 0; r < 16; ++r) { const int orow = crow(r, hi);
#pragma unroll
        for (int d0 = 0; d0 < 2; ++d0) stg[orow * 64 + d0 * 32 + r32] = __float2bfloat16(o[d0][r] * rli[r]); }
      asm volatile("s_waitcnt lgkmcnt(0)" ::: "memory");
#pragma unroll
      for (int i = 0; i < 4; ++i) { const int row = i * 8 + (lane >> 3), ch = lane & 7; const u32x4 v = *(const u32x4*)(stg + row * 64 + ch * 8); *(u32x4*)(Ow + (long)row * op + ch * 8) = v; } }
    asm volatile("s_waitcnt lgkmcnt(0)\n\ts_barrier" ::: "memory");
#undef DMA_K
#undef DMA_V
#undef CMASK
#undef START
#undef RESC
#undef ROT
}

constexpr int L2_K = 0, L2_V = 3 * 8192, L2_WS = L2_V + 4 * 16384, L2_OST = L2_WS + NW * 64 * 4, L2_BYTES = L2_OST + NW * 4096;
template <bool MASK> __device__ __forceinline__ void attn_unit2(int q0, int NT, const bf16* Qh, int qp, const bf16* __restrict__ Kh, int kp, const bf16* __restrict__ Vh, int vp, bf16* Oh, int op, char* shm) {
    const int tid = threadIdx.x, lane = tid & 63, r32 = lane & 31, hi = lane >> 5; const int wid = __builtin_amdgcn_readfirstlane(tid >> 6);
    const bf16* Qw = Qh + (long)(q0 + wid * QBLK) * qp;
    const unsigned lds0 = (unsigned)(uintptr_t)shm;
    float* wsf = (float*)(shm + L2_WS) + wid * 64;
    const bf16* ksrc = Kh + (long)lane * kp + wid * 8;
    const bf16* vsrc = Vh + (long)(16 * (wid & 3) + (lane >> 2)) * vp + (wid >> 2) * 32 + (lane & 3) * 8;
    const unsigned kdst = lds0 + L2_K + wid * 1024, vdst = lds0 + L2_V + wid * 1024;
#define DMA_K(t, slot) glds16(ksrc + (long)(t) * KVBLK * kp, (unsigned)__builtin_amdgcn_readfirstlane(kdst + (slot)))
#define DMA_V(t, vslot) do { glds16(vsrc + (long)(t) * KVBLK * vp, (unsigned)__builtin_amdgcn_readfirstlane(vdst + (vslot))); \
                            glds16(vsrc + (long)(t) * KVBLK * vp + 64, (unsigned)__builtin_amdgcn_readfirstlane(vdst + (vslot) + 8192)); } while (0)
    const int vb0 = (int)(lds0 + L2_V) + ((lane >> 4) & 1) * 32 + (lane & 3) * 8 + (4 * hi + ((lane & 15) >> 2)) * 64;
    const char* Kbase = shm + L2_K; bf16x8 kf[8];
    const lds_cptr shm3 = (lds_cptr)shm; const lds_cptr kp0 = shm3 + L2_K + hi * 1024 + r32 * 16; const lds_cptr vp0 = shm3 + L2_V + ((lane >> 4) & 1) * 32 + (lane & 3) * 8 + (4 * hi + ((lane & 15) >> 2)) * 64;
    DMA_K(0, 0); DMA_V(0, 0); DMA_K(1, SLOTB);
    bf16x8 qr[4];
#pragma unroll
    for (int d0 = 0; d0 < 4; ++d0) qr[d0] = *reinterpret_cast<const bf16x8*>(&Qw[(long)r32 * qp + d0 * 16 + hi * 8]);
    float l_reg = 0.f; f32x16 o[4]; o[0] = f32x16{}; o[1] = f32x16{}; o[2] = f32x16{}; o[3] = f32x16{};
    const f32x16 zero16 = f32x16{};
#define CMASK(P0, P1, t) do { if (MASK) { int jb_ = (t) - (NT - 4); if (jb_ >= 0) cmask(P0, P1, jb_, wid); } } while (0)
    f32x16 pA0, pA1, pB0, pB1;
    int sl_prev = 0, sl_cur = 0, sl_next = SLOTB;
    int vs_rd = 0, vs_wr = 3 * 16384;
#define ROT() do { sl_prev = sl_cur; sl_cur = sl_next; sl_next = (sl_next == (NSLOT - 1) * SLOTB) ? 0 : sl_next + SLOTB; vs_rd = (vs_rd + 16384) & 65535; vs_wr = (vs_wr + 16384) & 65535; } while (0)
    DMA_K(2, 2 * SLOTB); DMA_V(1, 16384);
    WAIT_BAR(6);
    qkt(pA0, pA1, Kbase, qr, zero16, r32, hi); CMASK(pA0, pA1, 0);
    _Pragma("unroll") for (int r = 0; r < 16; ++r) { pA0[r] = __builtin_amdgcn_exp2f(pA0[r]); pA1[r] = __builtin_amdgcn_exp2f(pA1[r]); }
    WAIT_BAR(2);
    DMA_K(3, 0); DMA_V(2, 2 * 16384);
    sl_prev = sl_cur; sl_cur = sl_next; sl_next = 2 * SLOTB;
    kload8(kf, kp0 + sl_cur);
    WAIT_BAR(5);
    s16x4 f0lo, f0hi, f1lo, f1hi, f2lo, f2hi, f3lo, f3hi; u32x4 pw0, pw1, pw2, pw3;
#define PKW(P, B) cvtpk_s(P[B], P[B + 1])
#define PAF(k) __builtin_bit_cast(bf16x8, pw##k)
#define PIN(x) asm volatile("" : "+v"(x))
#define EX(v) __builtin_amdgcn_exp2f(v)
#define VOFF(id) ((((id) >> 2) * 4096) + (((id) & 3) * 1024))
#define VRD2(F, id) do { F##lo = vtr(vp_ + VOFF(id)); F##hi = vtr(vp_ + VOFF(id) + 512); } while (0)
#define VFR2(F) (bf16x8){F##lo[0], F##lo[1], F##lo[2], F##lo[3], F##hi[0], F##hi[1], F##hi[2], F##hi[3]}
#define GAPA(MF, A0, A1, A2, A3, W0, W1, PW) do { MF; sacc += A0; sacc += A1; sacc += A2; sacc += A3; PIN(sacc); W0; W1; PIN(PW); SBAR(); } while (0)
#define GAPB(MF, RD, X, B) do { MF; RD; X[B] = EX(X[B]); X[B + 1] = EX(X[B + 1]); PIN(X); SBAR(); } while (0)
#define KRD(G, j) do { if (G) { kload2(kf, kp0 + sl_next, j); SBAR(); } } while (0)
#define MF32(a, b, c) __builtin_amdgcn_mfma_f32_32x32x16_bf16(a, b, c, 0, 0, 0)
#define STEP(C0, C1, P0, P1, t, GK, GV, GL) do { SBAR(); __builtin_amdgcn_s_setprio(ATTN_PRIO_A); \
    const lds_cptr vp_ = vp0 + vs_rd; \
    float sacc = (P0[0] + P0[1]); \
    GAPA(C0 = MF32(kf[0], qr[0], zero16), P0[2], P0[3], P0[4], P0[5],     pw0[0] = PKW(P0, 0), pw0[1] = PKW(P0, 2), pw0); \
    GAPA(C1 = MF32(kf[1], qr[0], zero16), P0[6], P0[7], P0[8], P0[9],     pw0[2] = PKW(P0, 4), pw0[3] = PKW(P0, 6), pw0); \
    GAPA(C0 = MF32(kf[2], qr[1], C0),     P0[10], P0[11], P0[12], P0[13], pw1[0] = PKW(P0, 8), pw1[1] = PKW(P0, 10), pw1); \
    GAPA(C1 = MF32(kf[3], qr[1], C1),     P0[14], P0[15], P1[0], P1[1],   pw1[2] = PKW(P0, 12), pw1[3] = PKW(P0, 14), pw1); \
    VRD2(f0, 0); SBAR();  GAPA(C0 = MF32(kf[4], qr[2], C0), P1[2], P1[3], P1[4], P1[5],     pw2[0] = PKW(P1, 0), pw2[1] = PKW(P1, 2), pw2); \
    VRD2(f1, 4); SBAR();  GAPA(C1 = MF32(kf[5], qr[2], C1), P1[6], P1[7], P1[8], P1[9],     pw2[2] = PKW(P1, 4), pw2[3] = PKW(P1, 6), pw2); \
    VRD2(f2, 8); SBAR();  GAPA(C0 = MF32(kf[6], qr[3], C0), P1[10], P1[11], P1[12], P1[13], pw3[0] = PKW(P1, 8), pw3[1] = PKW(P1, 10), pw3); \
    VRD2(f3, 12); SBAR(); GAPA(C1 = MF32(kf[7], qr[3], C1), P1[14], P1[15], 0.f, 0.f,       pw3[2] = PKW(P1, 12), pw3[3] = PKW(P1, 14), pw3); \
    l_reg += sacc; __builtin_amdgcn_s_setprio(0); \
    if (GK) { DMA_K((t) + 3, sl_cur); } if (GV) { DMA_V((t) + 2, vs_wr); } \
    CMASK(C0, C1, t); \
    SBAR(); __builtin_amdgcn_s_setprio(ATTN_PRIO_B); \
    GAPB(o[0] = MF32(PAF(0), VFR2(f0), o[0]), VRD2(f0, 1),  C0, 0); \
    GAPB(o[1] = MF32(PAF(0), VFR2(f1), o[1]), VRD2(f1, 5),  C0, 2); \
    GAPB(o[2] = MF32(PAF(0), VFR2(f2), o[2]), VRD2(f2, 9),  C0, 4); \
    GAPB(o[3] = MF32(PAF(0), VFR2(f3), o[3]), VRD2(f3, 13), C0, 6); \
    KRD(GL, 0); GAPB(o[0] = MF32(PAF(1), VFR2(f0), o[0]), VRD2(f0, 2),  C0, 8); \
    GAPB(o[1] = MF32(PAF(1), VFR2(f1), o[1]), VRD2(f1, 6),  C0, 10); \
    KRD(GL, 1); GAPB(o[2] = MF32(PAF(1), VFR2(f2), o[2]), VRD2(f2, 10), C0, 12); \
    GAPB(o[3] = MF32(PAF(1), VFR2(f3), o[3]), VRD2(f3, 14), C0, 14); \
    KRD(GL, 2); GAPB(o[0] = MF32(PAF(2), VFR2(f0), o[0]), VRD2(f0, 3),  C1, 0); \
    GAPB(o[1] = MF32(PAF(2), VFR2(f1), o[1]), VRD2(f1, 7),  C1, 2); \
    KRD(GL, 3); GAPB(o[2] = MF32(PAF(2), VFR2(f2), o[2]), VRD2(f2, 11), C1, 4); \
    GAPB(o[3] = MF32(PAF(2), VFR2(f3), o[3]), VRD2(f3, 15), C1, 6); \
    GAPB(o[0] = MF32(PAF(3), VFR2(f0), o[0]), (void)0, C1, 8); \
    GAPB(o[1] = MF32(PAF(3), VFR2(f1), o[1]), (void)0, C1, 10); \
    GAPB(o[2] = MF32(PAF(3), VFR2(f2), o[2]), (void)0, C1, 12); \
    GAPB(o[3] = MF32(PAF(3), VFR2(f3), o[3]), (void)0, C1, 14); __builtin_amdgcn_s_setprio(0); \
    } while (0)
    int t = 1;
#undef CMASK
#define CMASK(P0, P1, t) do {} while (0)
    for (; t + 5 < NT; t += 2) {
        STEP(pB0, pB1, pA0, pA1, t, true, true, true);     WAIT_BAR(5); ROT();
        STEP(pA0, pA1, pB0, pB1, t + 1, true, true, true); WAIT_BAR(5); ROT();
    }
#undef CMASK
#define CMASK(P0, P1, t) do { if (MASK) { int jb_ = (t) - (NT - 4); if (jb_ >= 0) cmask(P0, P1, jb_, wid); } } while (0)
#define ENDW(tt) do { if ((tt) + 3 < NT) { WAIT_BAR(5); } else if ((tt) + 2 < NT) { WAIT_BAR(4); } else { WAIT_BAR(0); } } while (0)
    for (; t + 1 < NT; t += 2) {
        STEP(pB0, pB1, pA0, pA1, t, (t + 3 < NT), (t + 2 < NT), (t + 1 < NT));       ENDW(t);     ROT();
        STEP(pA0, pA1, pB0, pB1, t + 1, (t + 4 < NT), (t + 3 < NT), (t + 2 < NT));   ENDW(t + 1); ROT();
    }
    STEP(pB0, pB1, pA0, pA1, NT - 1, false, false, false);
    { float sacc = pB0[0] + pB0[1]; _Pragma("unroll") for (int r = 2; r < 16; ++r) sacc += pB0[r]; _Pragma("unroll") for (int r = 0; r < 16; ++r) sacc += pB1[r]; l_reg += sacc;
      pw0 = (u32x4){PKW(pB0, 0), PKW(pB0, 2), PKW(pB0, 4), PKW(pB0, 6)}; pw1 = (u32x4){PKW(pB0, 8), PKW(pB0, 10), PKW(pB0, 12), PKW(pB0, 14)}; pw2 = (u32x4){PKW(pB1, 0), PKW(pB1, 2), PKW(pB1, 4), PKW(pB1, 6)}; pw3 = (u32x4){PKW(pB1, 8), PKW(pB1, 10), PKW(pB1, 12), PKW(pB1, 14)};
      SBAR();
      const lds_cptr vp_ = vp0 + ((vs_rd + 16384) & 65535);
#pragma unroll
      for (int db = 0; db < 4; ++db) { VRD2(f0, db * 4 + 0); VRD2(f1, db * 4 + 1); VRD2(f2, db * 4 + 2); VRD2(f3, db * 4 + 3);
          o[db] = MF32(PAF(0), VFR2(f0), o[db]); o[db] = MF32(PAF(1), VFR2(f1), o[db]); o[db] = MF32(PAF(2), VFR2(f2), o[db]); o[db] = MF32(PAF(3), VFR2(f3), o[db]); } }
#undef PKW
#undef PAF
#undef PIN
#undef EX
#undef VOFF
#undef VRD2
#undef VFR2
#undef GAPA
#undef GAPB
#undef KRD
#undef MF32
#undef STEP
#undef ENDW
    { auto rr = __builtin_amdgcn_permlane32_swap(__float_as_uint(l_reg), __float_as_uint(l_reg), false, false); l_reg = __uint_as_float(rr[0]) + __uint_as_float(rr[1]); }
    if (hi == 0) wsf[32 + r32] = l_reg; asm volatile("s_waitcnt lgkmcnt(0)" ::: "memory");
    float rli[16];
#pragma unroll
    for (int r = 0; r < 16; ++r) rli[r] = __builtin_amdgcn_rcpf(wsf[32 + crow(r, hi)]);
    bf16* Ow = Oh + (long)(q0 + wid * QBLK) * op;
    { bf16* stg = (bf16*)(shm + L2_OST) + wid * 2048;
#pragma unroll
      for (int dh = 0; dh < 2; ++dh) {
#pragma unroll
        for (int r = 0; r < 16; ++r) { const int orow = crow(r, hi);
#pragma unroll
          for (int d0 = 0; d0 < 2; ++d0) stg[orow * 64 + d0 * 32 + r32] = __float2bfloat16(o[dh * 2 + d0][r] * rli[r]); }
        asm volatile("s_waitcnt lgkmcnt(0)" ::: "memory");
#pragma unroll
        for (int i = 0; i < 4; ++i) { const int row = i * 8 + (lane >> 3), ch = lane & 7; const u32x4 v = *(const u32x4*)(stg + row * 64 + ch * 8); *(u32x4*)(Ow + (long)row * op + dh * 64 + ch * 8) = v; }
        asm volatile("s_waitcnt lgkmcnt(0)" ::: "memory"); } }
    asm volatile("s_waitcnt lgkmcnt(0)\n\ts_barrier" ::: "memory");
#undef DMA_K
#undef DMA_V
#undef CMASK
#undef ROT
}
#undef SBAR
#undef WAIT_BAR
}

#define XB_TMO      128
#define XB_XCNT(j)  (256  + 64 * (j))
#define XB_XSUB(j)  (1280 + 64 * (j))
#define XB_XGEN(j)  (2304 + 64 * (j))
#define XB_TOP      3328
#define XB_TOPGEN   3392
#define XCD_BAR_WORDS 3456
#define XB_SPIN_CAP (1u << 22)
__device__ __forceinline__ unsigned xb_ld(unsigned* p)              { return __hip_atomic_load(p, __ATOMIC_RELAXED, __HIP_MEMORY_SCOPE_AGENT); }
__device__ __forceinline__ unsigned xb_add(unsigned* p, unsigned v) { return __hip_atomic_fetch_add(p, v, __ATOMIC_RELAXED, __HIP_MEMORY_SCOPE_AGENT); }
__device__ __forceinline__ unsigned xb_xcc_id() { return (unsigned)__builtin_amdgcn_s_getreg((3 << 11) | 20) & 0xFu; }
#define XB_SPIN(cond, bar) do { unsigned _sp = 0; while (cond) { __builtin_amdgcn_s_sleep(1); \
    if ((++_sp & 255u) == 0u) { if (xb_ld(&(bar)[XB_TMO])) break; if (_sp > XB_SPIN_CAP) { atomicAdd(&(bar)[XB_TMO], 1u); break; } } } } while (0)
struct XcdBarrier { unsigned* bar; unsigned x; volatile LAS unsigned* st; };
__device__ __forceinline__ XcdBarrier xcd_barrier_post(unsigned* bar, volatile LAS unsigned* st) {
    XcdBarrier b; b.bar = bar; b.x = xb_xcc_id(); b.st = st;
    if (threadIdx.x == 0) (void)xb_add(&bar[XB_XCNT(b.x)], 1u);
    return b;
}
__device__ __forceinline__ void xcd_barrier_complete(unsigned* bar, unsigned x, unsigned& nloc, unsigned& nx) {
    const unsigned G = gridDim.x * gridDim.y * gridDim.z;
    unsigned sum, cnt, mine, sp = 0u;
    for (;;) {
        sum = 0u; cnt = 0u; mine = 0u;
#pragma unroll
        for (unsigned j = 0; j < 16; ++j) { const unsigned c = xb_ld(&bar[XB_XCNT(j)]); sum += c; cnt += (c > 0u) ? 1u : 0u; mine = (j == x) ? c : mine; }
        if (sum == G) break;
        __builtin_amdgcn_s_sleep(1);
        if ((++sp & 255u) == 0u) { if (xb_ld(&bar[XB_TMO])) break; if (sp > XB_SPIN_CAP) { atomicAdd(&bar[XB_TMO], 1u); break; } }
    }
    nloc = mine > 0u ? mine : 1u; nx = cnt > 0u ? cnt : 1u;
}
__device__ __forceinline__ void xcd_barrier(const XcdBarrier& b) {
    asm volatile("s_waitcnt vmcnt(0)" ::: "memory");
    __syncthreads();
    if (threadIdx.x == 0) {
        unsigned* bar = b.bar;
        __builtin_amdgcn_s_waitcnt(0);
        unsigned nloc = b.st[0], nx = b.st[1];
        if (nloc == 0u) { xcd_barrier_complete(bar, b.x, nloc, nx); b.st[0] = nloc; b.st[1] = nx; }
        const unsigned old = xb_add(&bar[XB_XSUB(b.x)], 1u);
        const unsigned gen = old / nloc;
        if (old + 1u == (gen + 1u) * nloc) {
            __builtin_amdgcn_fence(__ATOMIC_RELEASE, "agent");
            asm volatile("s_waitcnt vmcnt(0)" ::: "memory");
            const unsigned og = xb_add(&bar[XB_TOP], 1u);
            const unsigned tg = og / nx;
            if (og + 1u == (tg + 1u) * nx) xb_add(&bar[XB_TOPGEN], 1u);
            else XB_SPIN(xb_ld(&bar[XB_TOPGEN]) == tg, bar);
            __builtin_amdgcn_fence(__ATOMIC_ACQUIRE, "agent");
            xb_add(&bar[XB_XGEN(b.x)], 1u);
            asm volatile("s_waitcnt vmcnt(0)" ::: "memory");
        } else {
            XB_SPIN(xb_ld(&bar[XB_XGEN(b.x)]) == gen, bar);
            __builtin_amdgcn_fence(__ATOMIC_ACQUIRE, "agent");
            asm volatile("s_waitcnt vmcnt(0)" ::: "memory");
        }
    }
    __syncthreads();
}

constexpr int RING_BYTES = 131072;
constexpr int MISC_OFF = RING_BYTES;
constexpr int LDS_BYTES = 147456;
constexpr int NWAVES = 8;

struct Args {
    const float* in[29]; float* out; unsigned char* ws; int ph_lo, ph_hi;
};
enum { I_X = 0, I_MEM, I_NORM1, I_WIN, I_BGATE, I_QN, I_KN, I_LQ1, I_LK1, I_LQ2, I_LK2, I_SUBLN, I_WPOOL, I_PSCALE, I_MEMNORM, I_WMKV, I_MQN, I_MKN, I_WBRD, I_WBRP, I_WBRM, I_WOUT, I_NORM2,
       I_WROUTER, I_BROUTER, I_WGU, I_BGU, I_WD, I_BD };

__device__ __forceinline__ unsigned f2bf(float f) { unsigned u = __builtin_bit_cast(unsigned, f); return (u + 0x7fffu + ((u >> 16) & 1u)) >> 16; }
__device__ __forceinline__ unsigned pk2(float lo, float hi) { return f2bf(lo) | (f2bf(hi) << 16); }
__device__ __forceinline__ void p0_transpose_item(const float* W, int K, int N, bf16_t* WT, LAS float* scr, int item, int lane, int ldo = 0) {
    if (ldo == 0) ldo = K;
    const int nblk = N / 64, kb = item / nblk, nb = item % nblk, k0 = 64 * kb, n0 = 64 * nb;
    const int kr = lane >> 3, n4 = (lane & 7) * 4;
    f32x4 v[16];
#pragma unroll
    for (int i = 0; i < 16; ++i) v[i] = *(const f32x4*)(W + (size_t)(k0 + 8 * (i & 7) + kr) * N + n0 + 32 * (i >> 3) + n4);
#pragma unroll
    for (int h = 0; h < 2; ++h) {
#pragma unroll
        for (int i = 0; i < 8; ++i)
#pragma unroll
            for (int j = 0; j < 4; ++j) scr[(n4 + j) * 68 + 8 * i + kr] = v[h * 8 + i][j];
        LDS_WAIT(); asm volatile("" ::: "memory");
        const int c = lane & 7;
#pragma unroll
        for (int jj = 0; jj < 4; ++jj) { const int nrow = 8 * jj + (lane >> 3); const LAS f32x4* sp = (const LAS f32x4*)(scr + nrow * 68 + 8 * c);
            const f32x4 a = sp[0], b = sp[1];
            u32x4 o; o.x = pk2(a[0], a[1]); o.y = pk2(a[2], a[3]); o.z = pk2(b[0], b[1]); o.w = pk2(b[2], b[3]);
            *(u32x4*)(WT + (size_t)(n0 + 32 * h + nrow) * ldo + k0 + 8 * c) = o; }
        LDS_WAIT(); asm volatile("" ::: "memory");
    }
}
__device__ __forceinline__ void p0_transpose_item_f8(const float* W, int K, int N, unsigned char* WT, LAS float* scr, int item, int lane) {
    const int nblk = N / 64, kb = item / nblk, nb = item % nblk, k0 = 64 * kb, n0 = 64 * nb;
    const int kr = lane >> 3, n4 = (lane & 7) * 4;
    f32x4 v[16];
#pragma unroll
    for (int i = 0; i < 16; ++i) v[i] = *(const f32x4*)(W + (size_t)(k0 + 8 * (i & 7) + kr) * N + n0 + 32 * (i >> 3) + n4);
#pragma unroll
    for (int h = 0; h < 2; ++h) {
#pragma unroll
        for (int i = 0; i < 8; ++i)
#pragma unroll
            for (int j = 0; j < 4; ++j) scr[(n4 + j) * 68 + 8 * i + kr] = v[h * 8 + i][j];
        LDS_WAIT(); asm volatile("" ::: "memory");
        const int c = lane & 7;
#pragma unroll
        for (int jj = 0; jj < 4; ++jj) { const int nrow = 8 * jj + (lane >> 3); const LAS f32x4* sp = (const LAS f32x4*)(scr + nrow * 68 + 8 * c);
            const f32x4 a = sp[0] * W8_SCALE, b = sp[1] * W8_SCALE;
            u32x2 o; o.x = pk4_fp8(a[0], a[1], a[2], a[3]); o.y = pk4_fp8(b[0], b[1], b[2], b[3]);
            *(u32x2*)(WT + (size_t)(n0 + 32 * h + nrow) * K + k0 + 8 * c) = o; }
        LDS_WAIT(); asm volatile("" ::: "memory");
    }
}
__device__ __forceinline__ void rms_row_to_bf16(const float* xrow, const float* gain, bf16_t* orow, int lane) {
    const f32x4* xr = (const f32x4*)xrow + lane; const f32x4* gr = (const f32x4*)gain + lane;
    f32x4 v[4]; float s = 0.f;
#pragma unroll
    for (int j = 0; j < 4; ++j) { v[j] = xr[64 * j]; s += (v[j].x * v[j].x + v[j].y * v[j].y) + (v[j].z * v[j].z + v[j].w * v[j].w); }
    const float rstd = 1.f / sqrtf(wave_sum(s) * (1.f / 1024.f) + RMS_EPS);
    u32x2* o8 = (u32x2*)orow + lane;
#pragma unroll
    for (int j = 0; j < 4; ++j) { const f32x4 g = gr[64 * j]; u32x2 w; w.x = pk2(v[j].x * rstd * g.x, v[j].y * rstd * g.y); w.y = pk2(v[j].z * rstd * g.z, v[j].w * rstd * g.w); o8[64 * j] = w; }
}

struct Args;
typedef __attribute__((address_space(4))) const Args* kargs_t;
__device__ __forceinline__ kargs_t kargs() { kargs_t p = (kargs_t)__builtin_amdgcn_kernarg_segment_ptr(); asm volatile("" : "+s"(p)); return p; }
__global__ void __launch_bounds__(NWAVES * 64, 2) fwd_kernel(Args args) {
    extern __shared__ __attribute__((aligned(16))) unsigned char lds_raw[];
    cg::grid_group grid = cg::this_grid();
    LAS unsigned char* lds = (LAS unsigned char*)lds_raw;
    const int tid = threadIdx.x, lane = tid & 63, wave = __builtin_amdgcn_readfirstlane(tid >> 6);
    const int G = gridDim.x, bx = blockIdx.x; const int vcu = (G % 8 == 0) ? (bx % 8) * (G / 8) + bx / 8 : bx;
    const int gw = vcu * NWAVES + wave, NGW = G * NWAVES;
    const int lo = args.ph_lo, hi = args.ph_hi;
    if (tid < 64) ((LAS unsigned*)(lds + MISC_OFF + 1024))[tid] = 0u;
    __syncthreads();
    const XcdBarrier xbar = xcd_barrier_post((unsigned*)(args.ws + WS_CTL) + CW_BAR, (volatile LAS unsigned*)(lds + MISC_OFF + 1024));
#ifndef PHMASK
#define PHMASK 0x3ff
#endif
#define IN(k) (((PHMASK >> (k)) & 1) && lo <= (k) && (k) < hi)
#define GSYNC() do { asm volatile("s_waitcnt vmcnt(0) lgkmcnt(0)" ::: "memory"); __syncthreads(); grid.sync(); asm volatile("s_waitcnt vmcnt(0)" ::: "memory"); __syncthreads(); } while (0)
#define SEAM(k) do { if (lo <= (k) && (k) + 1 < hi) { xcd_barrier(xbar); } } while (0)
#define WSP(TY, off) ((TY*)(ka->ws + (off)))
#define WIN_T WSP(bf16_t, WS_WIN_T)
#define WBRD_T WSP(bf16_t, WS_WBRD_T)
#define WBRP_T WSP(bf16_t, WS_WBRP_T)
#define WBRM_T WSP(bf16_t, WS_WBRM_T)
#define WOUT_T WSP(bf16_t, WS_WOUT_T)
#define WMKV_T WSP(bf16_t, WS_WMKV_T)
#define WGU_T WSP(bf16_t, WS_WGU_T)
#define WD_T WSP(bf16_t, WS_WD_T)
#define XN WSP(bf16_t, WS_XN)
#define Qb WSP(bf16_t, WS_Q)
#define Kb WSP(bf16_t, WS_K)
#define Vb WSP(bf16_t, WS_V)
#define Ub WSP(bf16_t, WS_U)
#define MQb WSP(bf16_t, WS_MQ)
#define OC WSP(bf16_t, WS_OC)
#define GATES WSP(bf16_t, WS_GATES)
#define YCAT WSP(bf16_t, WS_YCAT)
#define MERGF WSP(float, WS_MERGF)
#define MERGB WSP(bf16_t, WS_MERGB)
#define XG WSP(bf16_t, WS_XG)
#define ACT WSP(bf16_t, WS_A)
#define Y4 WSP(bf16_t, WS_B)
#define MEMN WSP(bf16_t, WS_MEMN)
#define MKV WSP(bf16_t, WS_MKV)
#define ROPE WSP(f32x2, WS_ROPE)
#define WR2 WSP(float, WS_WR2)
#define ROUTEW WSP(float, WS_ROUTEW)
#define LAMP WSP(float, WS_LAM)
#define LIST WSP(u32x2, WS_LIST)
#define CNT WSP(unsigned, WS_CTL)
#define OUT (ka->out)
#define KA const kargs_t ka = kargs()

    if (lo > 1000) GSYNC();
    if (IN(0)) for (int rep_ = 0; rep_ < 1 + ((REPEAT_MASK >> 0) & 1); ++rep_) { KA; if (rep_) __syncthreads();
        LAS float* scr = (LAS float*)(lds + wave * 16384);
        constexpr int I0 = 16 * 80, I1 = 8 * 16, I2 = 4 * 16, I3 = 4 * 16, I4 = 16 * 16, I5 = 16 * 8, I6 = 32 * 512, I7 = 32 * 256;
        constexpr int NITEMS = I0 + I1 + I2 + I3 + I4 + I5 + I6 + I7;
        for (int it = gw; it < NITEMS; it += NGW) {
            int r = it;
            if (r < I0) { p0_transpose_item(ka->in[I_WIN], 1024, 5120, WIN_T, scr, r, lane); continue; } r -= I0;
            if (r < I1) { p0_transpose_item(ka->in[I_WBRD], 512, 1024, WBRD_T, scr, r, lane, 1024); continue; } r -= I1;
            if (r < I2) { p0_transpose_item(ka->in[I_WBRP], 256, 1024, WBRD_T + 512, scr, r, lane, 1024); continue; } r -= I2;
            if (r < I3) { p0_transpose_item(ka->in[I_WBRM], 256, 1024, WBRD_T + 768, scr, r, lane, 1024); continue; } r -= I3;
            if (r < I4) { p0_transpose_item(ka->in[I_WOUT], 1024, 1024, WOUT_T, scr, r, lane); continue; } r -= I4;
            if (r < I5) { p0_transpose_item(ka->in[I_WMKV], 1024, 512, WMKV_T, scr, r, lane); continue; } r -= I5;
            if (r < I6) { const int e = r >> 9; p0_transpose_item_f8(ka->in[I_WGU] + (size_t)e * 1024 * 2048, 1024, 2048, (unsigned char*)WGU_T + (size_t)e * 2048 * 1024, scr, r & 511, lane); continue; } r -= I6;
            { const int e = r >> 8; p0_transpose_item_f8(ka->in[I_WD] + (size_t)e * 1024 * 1024, 1024, 1024, (unsigned char*)WD_T + (size_t)e * 1024 * 1024, scr, r & 255, lane); }
        }
        for (int m = gw; m < T; m += NGW) rms_row_to_bf16(ka->in[I_X] + (size_t)m * 1024, ka->in[I_NORM1], XN + (size_t)m * 1024, lane);
        for (int m = gw; m < BATCH * MEMLEN; m += NGW) rms_row_to_bf16(ka->in[I_MEM] + (size_t)m * 1024, ka->in[I_MEMNORM], MEMN + (size_t)m * 1024, lane);
        for (int i = bx * 512 + tid; i < SEQ * 32; i += G * 512) { const int pos = i >> 5, j = i & 31;
            const float inv = 1.0f / powf(10000.0f, (float)(2 * j) / 64.0f); const float ang = (float)pos * inv;
            const double a = (double)ang; const double k = rint(a * 0.15915494309189535); const float red = (float)(a - k * 6.283185307179586);
            ROPE[i] = (f32x2){cosf(red), sinf(red)}; }
        for (int i = bx * 512 + tid; i < 1024 * 32; i += G * 512) { const int ii = i & 3, e = (i >> 2) & 15, kq = (i >> 6) & 3, eb = (i >> 8) & 1, s = i >> 9; const int k = 16 * s + 4 * kq + ii;
            WR2[i] = ka->in[I_NORM2][k] * ka->in[I_WROUTER][k * 32 + eb * 16 + e]; }
        if (bx == 0 && wave == 0) { const float s1 = wave_sum(ka->in[I_LQ1][lane] * ka->in[I_LK1][lane]), s2 = wave_sum(ka->in[I_LQ2][lane] * ka->in[I_LK2][lane]);
            if (lane == 0) LAMP[0] = expf(s1) - expf(s2) + 0.2f; }
    }
    SEAM(0);
    if (IN(1)) for (int rep_ = 0; rep_ < 1 + ((REPEAT_MASK >> 1) & 1); ++rep_) { KA; if (rep_) __syncthreads();
#if defined(TAP) && TAP == 6
        { pg8::DenseProb P{XN, WIN_T, 1024, 1024, 1024}; pg8::StaticOrder S; S.init(T, INW, G, bx);
          pg8::EpiPlain E{WSP(bf16_t, WS_B), 5120};
          pg8::gemm_phase<pg8::EpiPlain, pg8::DenseProb, pg8::StaticOrder, true>(lds, P, S, E); }
#else
        { pg8::DenseProb P{XN, WIN_T, 1024, 1024, 1024}; pg8::StaticOrder S0; S0.init(T, INW, G, bx); const pg8::TableOrder S = pg8::build_unit_table(S0, (LAS int*)(lds + MISC_OFF + 2048));
          pg8::EpiInProj E{Qb, Kb, Vb, Ub, MQb, GATES, ka->in[I_QN], ka->in[I_KN], ka->in[I_MQN], ka->in[I_BGATE], ROPE};
          pg8::gemm_phase<pg8::EpiInProj, pg8::DenseProb, pg8::TableOrder, ALIGN_EPI_SEL>(lds, P, S, E); }
#endif
        { pg8::DenseProb P{MEMN, WMKV_T, 1024, 1024, 1024}; pg8::StaticOrder S; S.init(BATCH * MEMLEN, 512, G, bx);
          pg8::EpiMemKV E{MKV, ka->in[I_MKN]};
          pg8::gemm_phase<pg8::EpiMemKV, pg8::DenseProb, pg8::StaticOrder, true>(lds, P, S, E); }
    }
    SEAM(1);
    if (IN(2)) for (int rep_ = 0; rep_ < 1 + ((REPEAT_MASK >> 2) & 1); ++rep_) { KA; if (rep_) __syncthreads();
        using abf = attn_body::bf16;
        {
            const int bh = vcu >> 4, b = bh >> 2, h = bh & 3, s = vcu & 15; const size_t rb = (size_t)b * SEQ;
            const float lam = LAMP[0];
            for (int i2 = 0; i2 < 4 * (1 + ((REPEAT_MASK >> 10) & 1)); ++i2) { const int ii = i2 & 3, c = ii & 1; const int qb = (ii < 2) ? s : 31 - s;
                attn_body::attn_unit2<true>(qb * 256, 4 * qb + 4, (const abf*)Qb + rb * 512 + (c * 4 + h) * 64, 512, (const abf*)Kb + rb * 512 + (c * 4 + h) * 64, 512,
                                            (const abf*)Vb + rb * 512 + h * 128, 512, (abf*)OC + rb * 1024 + (c * 4 + h) * 128, 1024, (char*)lds_raw);
                if (c == 1) {
                    asm volatile("s_waitcnt vmcnt(0)" ::: "memory");
#pragma unroll 1
                    for (int ps = 0; ps < 2; ++ps) {
                    const int row = ps * 16 + (lane >> 2), dq = (lane & 3) * 32; const size_t t = rb + (size_t)qb * 256 + wave * 32 + row;
                    const bf16_t* p0 = OC + t * 1024 + h * 128 + dq; const bf16_t* p1 = p0 + 512;
                    u32x4 a[4], bb[4];
#pragma unroll
                    for (int j = 0; j < 4; ++j) { a[j] = *(const u32x4*)(p0 + 8 * j); bb[j] = *(const u32x4*)(p1 + 8 * j); }
                    float ss = 0.f; f32x4 y[4][2];
#pragma unroll
                    for (int j = 0; j < 4; ++j) {
                        y[j][0] = (f32x4){bf_lo(a[j].x) - lam * bf_lo(bb[j].x), bf_hi(a[j].x) - lam * bf_hi(bb[j].x), bf_lo(a[j].y) - lam * bf_lo(bb[j].y), bf_hi(a[j].y) - lam * bf_hi(bb[j].y)};
                        y[j][1] = (f32x4){bf_lo(a[j].z) - lam * bf_lo(bb[j].z), bf_hi(a[j].z) - lam * bf_hi(bb[j].z), bf_lo(a[j].w) - lam * bf_lo(bb[j].w), bf_hi(a[j].w) - lam * bf_hi(bb[j].w)};
#pragma unroll
                        for (int q = 0; q < 4; ++q) ss += y[j][0][q] * y[j][0][q] + y[j][1][q] * y[j][1][q]; }
                    ss += __shfl_xor(ss, 1); ss += __shfl_xor(ss, 2);
                    const float rstd = 0.8f / sqrtf(ss * (1.0f / 128.0f) + RMS_EPS);
                    const float* sg = ka->in[I_SUBLN] + dq; bf16_t* yo = YCAT + t * 1024 + h * 128 + dq;
#pragma unroll
                    for (int j = 0; j < 4; ++j) { const f32x4 s0 = *(const f32x4*)(sg + 8 * j), s1 = *(const f32x4*)(sg + 8 * j + 4); pg8::store8(yo + 8 * j, y[j][0] * rstd * s0, y[j][1] * rstd * s1); }
                    }
                }
            }
        }
        {
            for (int i = 0; i < 2; ++i) { const int idx = vcu * 2 + i; if (idx >= 512) break; const int b = idx >> 7, h = (idx >> 5) & 3, qb = idx & 31;
                attn_body::attn_unit<8, false>(qb * 256, 4, (const abf*)MQb + (size_t)b * SEQ * 256 + h * 64, 256, (const abf*)MKV + (size_t)b * MEMLEN * 512 + h * 64, 512,
                                               (const abf*)MKV + (size_t)b * MEMLEN * 512 + 256 + h * 64, 512, (abf*)YCAT + (size_t)b * SEQ * 1024 + 768 + h * 64, 1024, (char*)lds_raw); }
        }
        {
            LAS bf16_t* ul = (LAS bf16_t*)lds;
            LAS bf16_t* pb = (LAS bf16_t*)(lds + 24576);
            const int col = tid & 255, half = tid >> 8, w = 2 << (col >> 6);
            const int mg = wave & 3, mdh = wave >> 2, r32 = lane & 31, hh = lane >> 5;
            bf16x8 bw[4];
#pragma unroll
            for (int sx = 0; sx < 4; ++sx) { const float* wp = ka->in[I_WPOOL] + (size_t)(mg * 64 + 16 * sx + 8 * hh) * 64 + mdh * 32 + r32;
                u32x4 pk; pk.x = pk2(wp[0], wp[64]); pk.y = pk2(wp[128], wp[192]); pk.z = pk2(wp[256], wp[320]); pk.w = pk2(wp[384], wp[448]); bw[sx] = __builtin_bit_cast(bf16x8, pk); }
            const int ocol = mg * 64 + mdh * 32 + r32; const float psc = ka->in[I_PSCALE][ocol];
            for (int tile = vcu; tile < T / 32; tile += G) {
                const int t0 = tile * 32, p0 = t0 & (SEQ - 1);
                __syncthreads();
                for (int pc = tid; pc < 47 * 32; pc += 512) { const int r = pc >> 5, ch = pc & 31; const int pos = p0 - 15 + r;
                    u32x4 v = {0u, 0u, 0u, 0u}; if (pos >= 0) v = *(const u32x4*)(Ub + (size_t)(t0 - 15 + r) * 256 + ch * 8);
                    *(LAS u32x4*)(ul + r * 256 + ch * 8) = v; }
                __syncthreads();
                {
                    float sum = 0.f; const int rbase = 15 + 16 * half;
                    for (int i = 1; i < w; ++i) sum += __uint_as_float((unsigned)ul[(rbase - i) * 256 + col] << 16);
#pragma unroll
                    for (int tk = 0; tk < 16; ++tk) { const float ucur = __uint_as_float((unsigned)ul[(rbase + tk) * 256 + col] << 16); sum += ucur;
                        const int pos = p0 + 16 * half + tk; const float cnt = (float)((pos + 1 < w) ? pos + 1 : w);
                        pb[(16 * half + tk) * 264 + col] = (bf16_t)f2bf(sum / cnt - ucur);
                        sum -= __uint_as_float((unsigned)ul[(rbase + tk - (w - 1)) * 256 + col] << 16); }
                }
                __syncthreads();
                f32x16 acc = f32x16{};
#pragma unroll
                for (int sx = 0; sx < 4; ++sx) { const bf16x8 af = *(const LAS bf16x8*)(pb + r32 * 264 + mg * 64 + 16 * sx + 8 * hh);
                    acc = __builtin_amdgcn_mfma_f32_32x32x16_bf16(af, bw[sx], acc, 0, 0, 0); }
#pragma unroll
                for (int r = 0; r < 16; ++r) { const int tok = t0 + (r & 3) + 8 * (r >> 2) + 4 * hh; YCAT[(size_t)tok * 1024 + 512 + ocol] = (bf16_t)f2bf(acc[r] * psc); }
            }
            __syncthreads();
        }
    }
    SEAM(2);
    if (IN(4)) for (int rep_ = 0; rep_ < 1 + ((REPEAT_MASK >> 4) & 1); ++rep_) { KA; if (rep_) __syncthreads();
        pg8::StaticOrder S0; S0.init(T, 1024, G, bx); const pg8::TableOrder S = pg8::build_unit_table(S0, (LAS int*)(lds + MISC_OFF + 2048));
        pg8::DenseProb P{YCAT, WBRD_T, 1024, 1024, 1024}; pg8::EpiMergeR E{GATES, MERGB};
        pg8::gemm_phase<pg8::EpiMergeR, pg8::DenseProb, pg8::TableOrder, ALIGN_EPI_SEL>(lds, P, S, E);
    }
    SEAM(4);
    if (IN(5)) for (int rep_ = 0; rep_ < 1 + ((REPEAT_MASK >> 5) & 1); ++rep_) { KA; if (rep_) __syncthreads();
        pg8::DenseProb P{MERGB, WOUT_T, 1024, 1024, 1024}; pg8::StaticOrder S0; S0.init(T, 1024, G, bx); const pg8::TableOrder S = pg8::build_unit_table(S0, (LAS int*)(lds + MISC_OFF + 2048));
        pg8::EpiWout E{ka->in[I_X], OUT, (unsigned char*)XG, ka->in[I_NORM2]};
        pg8::gemm_phase<pg8::EpiWout, pg8::DenseProb, pg8::TableOrder, ALIGN_EPI_SEL>(lds, P, S, E);
    }
    SEAM(5);
    if (IN(6)) { KA;
        LAS int* lcnt = (LAS int*)(lds + MISC_OFF); LAS int* lbase = lcnt + 32;
        const int ngroups = T / 16, rounds = (ngroups + NGW - 1) / NGW;
        for (int rd = 0; rd < rounds; ++rd) {
            const int grp = rd * NGW + gw; const bool valid = grp < ngroups;
            if (tid < 32) lcnt[tid] = 0;
            __syncthreads();
            int e_sel = 0, rank = 0; float w_sel = 0.f, rstd = 0.f; const int q = lane >> 4, tok = grp * 16 + (lane & 15);
            if (valid) {
                f32x4 d0 = {0.f, 0.f, 0.f, 0.f}, d1 = {0.f, 0.f, 0.f, 0.f}; float ss = 0.f;
                const float* xrow = OUT + (size_t)tok * 1024 + 4 * q; const f32x4* wr2 = (const f32x4*)WR2 + lane;
#pragma unroll 4
                for (int s = 0; s < 64; ++s) { const f32x4 xv = *(const f32x4*)(xrow + 16 * s); const f32x4 wa = wr2[(s * 2) * 64], wb = wr2[(s * 2 + 1) * 64];
                    ss += (xv[0] * xv[0] + xv[1] * xv[1]) + (xv[2] * xv[2] + xv[3] * xv[3]);
#pragma unroll
                    for (int j = 0; j < 4; ++j) { d0 = __builtin_amdgcn_mfma_f32_16x16x4f32(wa[j], xv[j], d0, 0, 0, 0); d1 = __builtin_amdgcn_mfma_f32_16x16x4f32(wb[j], xv[j], d1, 0, 0, 0); } }
                ss += __shfl_xor(ss, 16); ss += __shfl_xor(ss, 32);
                rstd = 1.0f / sqrtf(ss * (1.0f / 1024.f) + RMS_EPS);
                unsigned key[8];
#pragma unroll
                for (int r = 0; r < 8; ++r) { const int e = (r >> 2) * 16 + 4 * q + (r & 3); const float lg = ((r < 4) ? d0[r & 3] : d1[r & 3]) * rstd + ka->in[I_BROUTER][e];
                    unsigned u = __float_as_uint(lg); u ^= (u >> 31) ? 0xffffffffu : 0x80000000u; key[r] = (u & ~31u) | (unsigned)(31 - e); }
                unsigned win[4];
#pragma unroll
                for (int r = 0; r < 4; ++r) { unsigned m = key[0];
#pragma unroll
                    for (int j = 1; j < 8; ++j) m = m > key[j] ? m : key[j];
                    unsigned o = (unsigned)__shfl_xor((int)m, 16); m = m > o ? m : o; o = (unsigned)__shfl_xor((int)m, 32); m = m > o ? m : o; win[r] = m;
#pragma unroll
                    for (int j = 0; j < 8; ++j) key[j] = (key[j] == m) ? 0u : key[j]; }
                float val[4];
#pragma unroll
                for (int r = 0; r < 4; ++r) { unsigned u = win[r] & ~31u; u ^= (u >> 31) ? 0x80000000u : 0xffffffffu; val[r] = __uint_as_float(u); }
                const float p1 = expf(val[1] - val[0]), p2 = expf(val[2] - val[0]), p3 = expf(val[3] - val[0]); const float inv = 1.0f / (1.0f + p1 + p2 + p3);
                const unsigned wk = (q == 0) ? win[0] : (q == 1) ? win[1] : (q == 2) ? win[2] : win[3];
                w_sel = ((q == 0) ? 1.0f : (q == 1) ? p1 : (q == 2) ? p2 : p3) * inv; e_sel = 31 - (int)(wk & 31u);
                rank = __hip_atomic_fetch_add((int*)(lcnt + e_sel), 1, __ATOMIC_RELAXED, __HIP_MEMORY_SCOPE_WORKGROUP);
            }
            __syncthreads();
            if (tid < 32) lbase[tid] = (int)__hip_atomic_fetch_add(CNT + 64 * tid, (unsigned)lcnt[tid], __ATOMIC_RELAXED, __HIP_MEMORY_SCOPE_AGENT);
            __syncthreads();
            if (valid) { const int pos = lbase[e_sel] + rank; LIST[(size_t)e_sel * CAP + pos] = (u32x2){(unsigned)(tok * 4 + q), __float_as_uint(rstd)}; ROUTEW[tok * 4 + q] = w_sel; }
            __syncthreads();
        }
    }
    SEAM(6);
    if (IN(7) || IN(8)) { KA;
        LAS int* tp = (LAS int*)(lds + MISC_OFF + 256); LAS int* cn = tp + 40;
        if (tid == 0) { int acc = 0; for (int e = 0; e < NEXP; ++e) { const int c = (int)__hip_atomic_load(CNT + 64 * e, __ATOMIC_RELAXED, __HIP_MEMORY_SCOPE_AGENT); cn[e] = c; tp[e] = acc; acc += (c + 255) >> 8; } tp[NEXP] = acc; }
        __syncthreads();
        if (IN(7)) for (int rep_ = 0; rep_ < 1 + ((REPEAT_MASK >> 7) & 1); ++rep_) {
            pg8::GuProb P{(const unsigned char*)XG, (const unsigned char*)WGU_T, LIST, 1024, 1024, 1024}; pg8::GroupedOrder S0{tp, cn, 8, G, bx}; const pg8::TableOrder S = pg8::build_unit_table(S0, (LAS int*)(lds + MISC_OFF + 2048));
            pg8::EpiSwiglu E{(unsigned char*)ACT, LIST, ka->in[I_BGU]};
            pg8::gemm_phase<pg8::EpiSwiglu, pg8::GuProb, pg8::TableOrder, ALIGN_EPI_SEL>(lds, P, S, E);
        }
        SEAM(7);
        if (IN(8)) for (int rep_ = 0; rep_ < 1 + ((REPEAT_MASK >> 8) & 1); ++rep_) {
            pg8::DownProb P{(const unsigned char*)ACT, (const unsigned char*)WD_T, 1024, 1024, 1024}; pg8::GroupedOrder S0{tp, cn, 4, G, bx}; const pg8::TableOrder S = pg8::build_unit_table(S0, (LAS int*)(lds + MISC_OFF + 2048));
            pg8::EpiDown E{Y4, LIST, ka->in[I_BD]};
            pg8::gemm_phase<pg8::EpiDown, pg8::DownProb, pg8::TableOrder, ALIGN_EPI_SEL>(lds, P, S, E);
        }
    }
    SEAM(8);
    if (IN(9)) { KA;
        for (int i = bx * 512 + tid; i < T * 128; i += G * 512) { const int tok = i >> 7, c8 = (i & 127) * 8;
            const f32x4 w = *(const f32x4*)(ROUTEW + tok * 4); float* op = OUT + (size_t)tok * 1024 + c8;
            f32x4 o0 = *(const f32x4*)op, o1 = *(const f32x4*)(op + 4);
#pragma unroll
            for (int k = 0; k < 4; ++k) { const u32x4 y = *(const u32x4*)(Y4 + ((size_t)tok * 4 + k) * 1024 + c8); const float wk = w[k];
                o0[0] += wk * bf_lo(y.x); o0[1] += wk * bf_hi(y.x); o0[2] += wk * bf_lo(y.y); o0[3] += wk * bf_hi(y.y);
                o1[0] += wk * bf_lo(y.z); o1[1] += wk * bf_hi(y.z); o1[2] += wk * bf_lo(y.w); o1[3] += wk * bf_hi(y.w); }
            *(f32x4*)op = o0; *(f32x4*)(op + 4) = o1; }
    }
#ifdef TAP
    if (lo <= 10 && 10 < hi) { KA; GSYNC();
        for (int i = bx * 512 + tid; i < T * 1024; i += G * 512) { const int t = i >> 10, c = i & 1023; float v = 0.f;
#define BFV(buf, pitch, col) __uint_as_float((unsigned)(buf)[(size_t)t * (pitch) + (col)] << 16)
            if (TAP == 1) v = BFV(Qb, 512, c & 511) + 2.f * BFV(Kb, 512, c & 511) + 4.f * BFV(Vb, 512, c & 511) + 8.f * BFV(Ub, 256, c & 255) + 16.f * BFV(MQb, 256, c & 255)
                            + 32.f * BFV(GATES, 3072, c) + 64.f * BFV(GATES, 3072, 1024 + c) + 128.f * BFV(GATES, 3072, 2048 + c);
            if (TAP == 2) v = BFV(OC, 1024, c) + 2.f * BFV(YCAT, 1024, c);
            if (TAP == 3) v = BFV(MERGB, 1024, c);
            if (TAP == 4) v = BFV(XN, 1024, c);
            if (TAP == 6) { const bf16_t* z = WSP(bf16_t, WS_B) + (size_t)t * 5120 + c; v = __uint_as_float((unsigned)z[0] << 16) + 2.f * __uint_as_float((unsigned)z[1024] << 16) + 4.f * __uint_as_float((unsigned)z[2048] << 16) + 8.f * __uint_as_float((unsigned)z[3072] << 16) + 16.f * __uint_as_float((unsigned)z[4096] << 16); }
            if (TAP == 5) { const bf16_t* wt = WIN_T; const int tt = t % 5120; v = __uint_as_float((unsigned)wt[(size_t)tt * 1024 + c] << 16) + ROPE[(t & 8191) * 32 + (c & 31)].x + 2.f * ROPE[(t & 8191) * 32 + (c & 31)].y; }
            OUT[i] = v; }
    }
#endif
#undef IN
#undef SEAM
}

extern "C" void kernel_launch(void* const* d_in, const int* in_sizes, int n_in, void* d_out, int out_size, void* d_ws, size_t ws_size, hipStream_t stream) {
    static int grid = 0;
    if (grid == 0) {
        if (n_in != 29 || in_sizes[0] != T * DMODEL || out_size != T * DMODEL || ws_size < WS_END) {
            fprintf(stderr, "kernel_launch: unexpected shapes: n_in %d in0 %d out %d ws %zu (need %zu)\n", n_in, n_in > 0 ? in_sizes[0] : -1, out_size, ws_size, (size_t)WS_END); grid = -1; return; }
        int dev = 0, cus = 0, per_cu = 0;
        (void)hipGetDevice(&dev); (void)hipDeviceGetAttribute(&cus, hipDeviceAttributeMultiprocessorCount, dev);
        (void)hipFuncSetAttribute((const void*)fwd_kernel, hipFuncAttributeMaxDynamicSharedMemorySize, LDS_BYTES);
        (void)hipOccupancyMaxActiveBlocksPerMultiprocessor(&per_cu, (const void*)fwd_kernel, NWAVES * 64, LDS_BYTES);
        (void)hipGetLastError();
        grid = cus;
        fprintf(stderr, "kernel_launch: cus %d occupancy %d/CU grid %d\n", cus, per_cu, grid);
        if (per_cu < 1) fprintf(stderr, "kernel_launch: occupancy query says the kernel does not fit\n");
    }
    if (grid < 0) return;
    (void)hipMemsetAsync((char*)d_ws + WS_CTL, 0, CTL_ZERO_BYTES, stream);
    Args a{};
    for (int i = 0; i < 29; ++i) a.in[i] = (const float*)d_in[i];
    a.out = (float*)d_out; a.ws = (unsigned char*)d_ws; a.ph_lo = 0; a.ph_hi = PH_HI;
    void* args[] = {&a};
    hipError_t e = hipLaunchCooperativeKernel((const void*)fwd_kernel, dim3(grid), dim3(NWAVES * 64), args, LDS_BYTES, stream);
    if (e != hipSuccess) fprintf(stderr, "cooperative launch failed: %s (grid %d)\n", hipGetErrorString(e), grid);
}
```

```cpp
#include <hip/hip_runtime.h>
#include <hip/hip_cooperative_groups.h>
#include <hip/hip_bf16.h>
#include <cstdio>
#include <cstdint>
#include <cmath>
namespace cg = cooperative_groups;

#define LAS __attribute__((address_space(3)))
#define GAS __attribute__((address_space(1)))
typedef unsigned short bf16_t;
typedef short bf16x8 __attribute__((ext_vector_type(8)));
typedef float f32x4 __attribute__((ext_vector_type(4)));
typedef float f32x2 __attribute__((ext_vector_type(2)));
typedef float f32x16 __attribute__((ext_vector_type(16)));
typedef unsigned u32x4 __attribute__((ext_vector_type(4)));
typedef unsigned u32x2 __attribute__((ext_vector_type(2)));

#define PH_HI 10
#define ALIGN_EPI_SEL true
#define F8MODE 2
#define USE_SETPRIO 1
#define ATTN_PRIO_A 1
#define ATTN_PRIO_B 1
#ifndef PHMASK
#define PHMASK 0x3ff
#endif
#define REPEAT_MASK 0x000
constexpr int BATCH = 4, SEQ = 8192, DMODEL = 1024, T = BATCH * SEQ, INW = 5120, NEXP = 32, MEMLEN = 256;
constexpr float RMS_EPS = 1e-6f;
constexpr float C2 = 0.125f * 1.4426950408889634f;
constexpr int CAP = T;

constexpr size_t MiB = 1u << 20;
constexpr size_t WS_CTL = 0, CTL_ZERO_BYTES = 32768;
constexpr int CW_BAR = 4096;
constexpr size_t WS_ROUTEW = 1 * MiB;
constexpr size_t WS_LAM = 1 * MiB + 768 * 1024;
constexpr size_t WS_ROPE = 2 * MiB;
constexpr size_t WS_WR2 = 4 * MiB;
constexpr size_t WS_MEMN = 5 * MiB;
constexpr size_t WS_MKV = 7 * MiB;
constexpr size_t WS_WIN_T = 8 * MiB;
constexpr size_t WS_WBRD_T = 18 * MiB;
constexpr size_t WS_WBRP_T = 19 * MiB;
constexpr size_t WS_WBRM_T = 19 * MiB + 512 * 1024;
constexpr size_t WS_WOUT_T = 20 * MiB;
constexpr size_t WS_WMKV_T = 22 * MiB;
constexpr size_t WS_WGU_T = 24 * MiB;
constexpr size_t WS_WD_T = 152 * MiB;
constexpr size_t WS_A = 216 * MiB;
constexpr size_t WS_XN = WS_A;
constexpr size_t WS_Q = WS_A + 64 * MiB, WS_K = WS_A + 96 * MiB, WS_V = WS_A + 128 * MiB;
constexpr size_t WS_U = WS_A + 160 * MiB, WS_MQ = WS_A + 176 * MiB;
constexpr size_t WS_OC = WS_A + 192 * MiB;
constexpr size_t WS_B = 488 * MiB;
constexpr size_t WS_GATES = WS_B;
constexpr size_t WS_YCAT = WS_B + 192 * MiB;
constexpr size_t WS_MERGF = 760 * MiB;
constexpr size_t WS_MERGB = 888 * MiB;
constexpr size_t WS_XG = 952 * MiB;
constexpr size_t WS_LIST = 1016 * MiB;
constexpr size_t WS_END = 1024 * MiB;

typedef __bf16 bf16x2_v __attribute__((ext_vector_type(2)));
__device__ __forceinline__ unsigned cvt_pk_bf16(float lo, float hi) { f32x2 v = {lo, hi}; bf16x2_v b = __builtin_convertvector(v, bf16x2_v); return __builtin_bit_cast(unsigned, b); }
__device__ __forceinline__ unsigned pk4_fp8(float a, float b, float c, float d) {
    a = fminf(fmaxf(a, -448.f), 448.f); b = fminf(fmaxf(b, -448.f), 448.f); c = fminf(fmaxf(c, -448.f), 448.f); d = fminf(fmaxf(d, -448.f), 448.f);
    int r = __builtin_amdgcn_cvt_pk_fp8_f32(a, b, 0, false); r = __builtin_amdgcn_cvt_pk_fp8_f32(c, d, r, true); return (unsigned)r; }
constexpr float W8_SCALE = 64.0f;
constexpr float A8_SCALE = 8.0f;
__device__ __forceinline__ float bf_lo(unsigned w) { return __uint_as_float(w << 16); }
__device__ __forceinline__ float bf_hi(unsigned w) { return __uint_as_float(w & 0xffff0000u); }
__device__ __forceinline__ float wave_sum(float v) {
#pragma unroll
    for (int o = 1; o < 64; o <<= 1) v += __shfl_xor(v, o);
    return v;
}
#define LDS_WAIT() asm volatile("s_waitcnt lgkmcnt(0)" ::: "memory")

namespace pg8 {
constexpr int BM = 256, BK = 64, HALF = 128, HTB = HALF * BK * 2, STAGE_BYTES = 8 * HTB, NXCD = 8, WGM = 8;
__host__ __device__ __forceinline__ int lds_byte(int r, int c) { const int st = (r >> 4) * 2 + (c >> 5), rr = r & 15, cc = c & 31, ob = rr * 64 + cc * 2; return st * 1024 + (ob ^ (((ob >> 9) & 1) << 5)); }
__host__ __device__ __forceinline__ void stage_rc(int b, int& R, int& C) { const int st = b / 1024, sb = b % 1024, swz = sb ^ (((sb >> 9) & 1) << 5); R = (st >> 1) * 16 + swz / 64; C = (st & 1) * 32 + (swz % 64) / 2; }
__host__ __device__ __forceinline__ int perm32(int rho) { const int n = rho >> 4, i = rho & 15; return 8 * (i >> 2) + 4 * n + (i & 3); }

typedef int i32x4_t __attribute__((ext_vector_type(4)));
typedef int i32x8_t __attribute__((ext_vector_type(8)));
typedef long i64x2_t __attribute__((ext_vector_type(2)));
struct Unit { int pm, pn, e, mt, cnt; };

template <int BMAP> __device__ __forceinline__ int brow(int R) { return BMAP == 0 ? ((R >> 5) * 64 + perm32(R & 31)) : ((R & ~31) + perm32(R & 31)); }

struct StaticOrder {
    int nM, nN, nwg, G, c;
    __device__ void init(int M, int N, int G_, int c_) { nM = M / BM; nN = N / BM; nwg = nM * nN; G = G_; c = c_; }
    __device__ bool next(int i, Unit& u) const {
        const long L = (long)i * G + c; if (L >= nwg) return false;
        int wgid = (int)L; { const int q = nwg / NXCD, r = nwg % NXCD, xcd = wgid % NXCD, off = wgid / NXCD; wgid = (xcd < r ? xcd * (q + 1) : r * (q + 1) + (xcd - r) * q) + off; }
        const int nig = WGM * nN, gid = wgid / nig, fm = gid * WGM, gsz = (nM - fm) < WGM ? (nM - fm) : WGM;
        u.pm = fm + ((wgid % nig) % gsz); u.pn = (wgid % nig) / gsz; u.e = 0; u.mt = 0; u.cnt = 0; return true;
    }
    __device__ bool next_lane(int i, Unit& u) const { return next(i, u); }
};
struct GroupedOrder {
    const LAS int* tp; const LAS int* cn; int NTN, G, c;
    __device__ bool next_lane(int i, Unit& u) const {
        const int nwg = tp[NEXP] * NTN; const long L = (long)i * G + c; if (L >= nwg) return false;
        int wgid = (int)L; { const int q = nwg / NXCD, r = nwg % NXCD, xcd = wgid % NXCD, off = wgid / NXCD; wgid = (xcd < r ? xcd * (q + 1) : r * (q + 1) + (xcd - r) * q) + off; }
        int e = 0; while (e < NEXP - 1 && wgid >= tp[e + 1] * NTN) ++e;
        const int idx = wgid - tp[e] * NTN, tiles = tp[e + 1] - tp[e];
        const int nig = 4 * NTN, gid = idx / nig, fm = gid * 4, gsz = (tiles - fm) < 4 ? (tiles - fm) : 4;
        u.mt = fm + ((idx % nig) % gsz); u.pn = (idx % nig) / gsz; u.e = e; u.pm = tp[e] + u.mt; u.cnt = cn[e]; return true;
    }
};
struct TableOrder {
    const LAS int* tab; int n;
    __device__ __forceinline__ bool next(int i, Unit& u) const {
        if (i >= n) return false;
        const LAS int* t = tab + i * 8;
        u.pm = __builtin_amdgcn_readfirstlane(t[0]); u.pn = __builtin_amdgcn_readfirstlane(t[1]); u.e = __builtin_amdgcn_readfirstlane(t[2]);
        u.mt = __builtin_amdgcn_readfirstlane(t[3]); u.cnt = __builtin_amdgcn_readfirstlane(t[4]); return true;
    }
};
template <class Sched> __device__ __forceinline__ TableOrder build_unit_table(const Sched& S, LAS int* tab) {
    __syncthreads();
    if (threadIdx.x < 32) { Unit u; const bool ok = S.next_lane((int)threadIdx.x, u);
        if (ok) { LAS int* t = tab + threadIdx.x * 8; t[0] = u.pm; t[1] = u.pn; t[2] = u.e; t[3] = u.mt; t[4] = u.cnt; }
        const unsigned long long m = __ballot(ok); if (threadIdx.x == 0) tab[256] = __popcll(m); }
    __syncthreads();
    TableOrder T; T.tab = tab; T.n = __builtin_amdgcn_readfirstlane(tab[256]); return T;
}
struct DenseProb {
    static constexpr bool GATHER = false; static constexpr int BMAP = 0; static constexpr bool F8 = false;
    const bf16_t* A; const bf16_t* Bt; int lda, ldb, K;
    __device__ __forceinline__ const char* a_base(const Unit& u) const { return (const char*)(A + (size_t)u.pm * BM * lda); }
    __device__ __forceinline__ const char* b_base(const Unit& u) const { return (const char*)(Bt + (size_t)u.pn * BM * ldb); }
    __device__ __forceinline__ size_t bhstep() const { return (size_t)32 * ldb * 2; }
    __device__ __forceinline__ unsigned a_off(const Unit&, int, int) const { return 0u; }
    __device__ __forceinline__ unsigned a_raw(const Unit&, int) const { return 0u; }
};
struct GuProb {
    static constexpr bool GATHER = true; static constexpr int BMAP = 1; static constexpr bool F8 = true;
    const unsigned char* XG; const unsigned char* Wt; const u32x2* list; int lda, ldb, K;
    __device__ __forceinline__ const char* a_base(const Unit&) const { return (const char*)XG; }
    __device__ __forceinline__ const char* b_base(const Unit& u) const { return (const char*)(Wt + ((size_t)u.e * 2048 + 128 * u.pn) * 1024); }
    __device__ __forceinline__ size_t bhstep() const { return (size_t)1024 * 1024; }
    __device__ __forceinline__ unsigned a_raw(const Unit& u, int r) const { const int rr = u.mt * BM + r, rc = rr < u.cnt ? rr : u.cnt - 1; return list[(size_t)u.e * CAP + rc].x; }
    __device__ __forceinline__ unsigned a_off(const Unit& u, int r, int C) const {
        const int rr = u.mt * BM + r, rc = rr < u.cnt ? rr : u.cnt - 1;
        const unsigned tok = list[(size_t)u.e * CAP + rc].x >> 2;
        return tok * 1024u + (unsigned)C * 2u;
    }
};
struct DownProb {
    static constexpr bool GATHER = false; static constexpr int BMAP = 0; static constexpr bool F8 = true;
    const unsigned char* A; const unsigned char* Wt; int lda, ldb, K;
    __device__ __forceinline__ const char* a_base(const Unit& u) const { return (const char*)(A + (size_t)u.pm * BM * lda); }
    __device__ __forceinline__ const char* b_base(const Unit& u) const { return (const char*)(Wt + ((size_t)u.e * 1024 + 256 * u.pn) * 1024); }
    __device__ __forceinline__ size_t bhstep() const { return (size_t)32 * ldb; }
    __device__ __forceinline__ unsigned a_off(const Unit&, int, int) const { return 0u; }
    __device__ __forceinline__ unsigned a_raw(const Unit&, int) const { return 0u; }
};

template <class Prob> __device__ __forceinline__ void calc_aoff(const Prob& P, const Unit& u, const int (&Rr)[2], const int (&Cc)[2], unsigned (&o)[2][2]) {
#pragma unroll
    for (int h = 0; h < 2; ++h)
#pragma unroll
        for (int i = 0; i < 2; ++i) {
            if constexpr (Prob::GATHER) o[h][i] = P.a_off(u, h * HALF + Rr[i], Cc[i]);
            else o[h][i] = Prob::F8 ? (unsigned)((h * HALF + Rr[i]) * P.lda + Cc[i] * 2) : (unsigned)((h * HALF + Rr[i]) * P.lda + Cc[i]) * 2u;
        }
}

template <class Epi, class Prob, class Sched, bool ALIGN_EPI>
__device__ __forceinline__ void gemm_phase(LAS unsigned char* lds, const Prob& P, const Sched& S, const Epi& E) {
    const int tid = threadIdx.x, wid = __builtin_amdgcn_readfirstlane(tid >> 6), lane = tid & 63, wr = wid >> 2, wc = wid & 3, fr = lane & 15, fq = lane >> 4;
    const int K = P.K, nt = Prob::F8 ? K / 128 : K / BK;
    int Rr[2], Cc[2]; unsigned voffB[2];
#pragma unroll
    for (int i = 0; i < 2; ++i) { stage_rc(tid * 16 + i * 8192, Rr[i], Cc[i]); voffB[i] = Prob::F8 ? (unsigned)(brow<Prob::BMAP>(Rr[i]) * P.ldb + Cc[i] * 2) : (unsigned)(brow<Prob::BMAP>(Rr[i]) * P.ldb + Cc[i]) * 2u; }
    const size_t kstep = (size_t)(BK * 2);
    const size_t bhstep = P.bhstep();
    const unsigned ldsw = (unsigned)wid * 1024u;
    const int aoff = lds_byte(wr * 64 + fr, fq * 8), boff = lds_byte(wc * 32 + fr, fq * 8);
#define PG8_SA(b, h) (((b) * 2 + (h)) * HTB)
#define PG8_SB(b, h) ((4 + (b) * 2 + (h)) * HTB)
#define PG8_STG(bufoff, gptr, v0, v1) do { \
        __builtin_amdgcn_global_load_lds((const unsigned*)((const char*)(gptr) + (v0)), (LAS unsigned*)(lds + (bufoff) + ldsw), 16, 0, 0); \
        __builtin_amdgcn_global_load_lds((const unsigned*)((const char*)(gptr) + (v1)), (LAS unsigned*)(lds + (bufoff) + ldsw + 8192), 16, 0, 0); } while (0)
#define PG8_STGB(bufoff, gptr) PG8_STG(bufoff, gptr, voffB[0], voffB[1])
#define PG8_LDA(dst, b, h) do { _Pragma("unroll") for (int m = 0; m < 4; ++m) _Pragma("unroll") for (int k = 0; k < 2; ++k) dst[m][k] = *(const LAS bf16x8*)(lds + PG8_SA(b, h) + aoff + m * 2048 + k * 1024); } while (0)
#define PG8_LDB(dst, b, h) do { _Pragma("unroll") for (int n = 0; n < 2; ++n) _Pragma("unroll") for (int k = 0; k < 2; ++k) dst[n][k] = *(const LAS bf16x8*)(lds + PG8_SB(b, h) + boff + n * 2048 + k * 1024); } while (0)
#define PG8_MMAB(ai, bj, At, Bt) do { _Pragma("unroll") for (int m = 0; m < 4; ++m) _Pragma("unroll") for (int n = 0; n < 2; ++n) _Pragma("unroll") for (int k = 0; k < 2; ++k) \
        acc[ai][bj][m][n] = __builtin_amdgcn_mfma_f32_16x16x32_bf16(Bt[n][k], At[m][k], acc[ai][bj][m][n], 0, 0, 0); } while (0)
#define PG8_MMAQ(ai, bj, At, Bt) do { _Pragma("unroll") for (int m = 0; m < 4; ++m) _Pragma("unroll") for (int n = 0; n < 2; ++n) _Pragma("unroll") for (int k = 0; k < 2; ++k) { \
        const i64x2_t bq = __builtin_bit_cast(i64x2_t, Bt[n][k]), aq = __builtin_bit_cast(i64x2_t, At[m][k]); \
        acc[ai][bj][m][n] = __builtin_amdgcn_mfma_f32_16x16x32_fp8_fp8(bq[0], aq[0], acc[ai][bj][m][n], 0, 0, 0); \
        acc[ai][bj][m][n] = __builtin_amdgcn_mfma_f32_16x16x32_fp8_fp8(bq[1], aq[1], acc[ai][bj][m][n], 0, 0, 0); } } while (0)
#define PG8_MMA8(ai, bj, A8, B8) do { _Pragma("unroll") for (int m = 0; m < 4; ++m) _Pragma("unroll") for (int n = 0; n < 2; ++n) \
        asm volatile("v_mfma_f32_16x16x128_f8f6f4 %0, %1, %2, %0" : "+v"(acc[ai][bj][m][n]) : "v"(B8[n]), "v"(A8[m])); } while (0)
#define PG8_LDA8(dst, b, h) do { _Pragma("unroll") for (int m = 0; m < 4; ++m) { dst[m].lo = *(const LAS i32x4_t*)(lds + PG8_SA(b, h) + aoff + m * 2048); dst[m].hi = *(const LAS i32x4_t*)(lds + PG8_SA(b, h) + aoff + m * 2048 + 1024); } } while (0)
#define PG8_LDB8(dst, b, h) do { _Pragma("unroll") for (int n = 0; n < 2; ++n) { dst[n].lo = *(const LAS i32x4_t*)(lds + PG8_SB(b, h) + boff + n * 2048); dst[n].hi = *(const LAS i32x4_t*)(lds + PG8_SB(b, h) + boff + n * 2048 + 1024); } } while (0)
#define PG8_XLDA(b, h)  do { if constexpr (Prob::F8 && F8MODE == 2) PG8_LDA8(At8, b, h); else PG8_LDA(At, b, h); } while (0)
#define PG8_XLDB0(b, h) do { if constexpr (Prob::F8 && F8MODE == 2) PG8_LDB8(B08, b, h); else PG8_LDB(B0, b, h); } while (0)
#define PG8_XLDB1(b, h) do { if constexpr (Prob::F8 && F8MODE == 2) PG8_LDB8(B18, b, h); else PG8_LDB(B1, b, h); } while (0)
#define PG8_XMMA0(ai, bj) do { if (USE_SETPRIO) __builtin_amdgcn_s_setprio(USE_SETPRIO); if constexpr (Prob::F8 && F8MODE == 2) PG8_MMA8(ai, bj, At8, B08); else if constexpr (Prob::F8) PG8_MMAQ(ai, bj, At, B0); else PG8_MMAB(ai, bj, At, B0); if (USE_SETPRIO) __builtin_amdgcn_s_setprio(0); } while (0)
#define PG8_XMMA1(ai, bj) do { if (USE_SETPRIO) __builtin_amdgcn_s_setprio(USE_SETPRIO); if constexpr (Prob::F8 && F8MODE == 2) PG8_MMA8(ai, bj, At8, B18); else if constexpr (Prob::F8) PG8_MMAQ(ai, bj, At, B1); else PG8_MMAB(ai, bj, At, B1); if (USE_SETPRIO) __builtin_amdgcn_s_setprio(0); } while (0)
#define PG8_WAIT_V(n) asm volatile("s_waitcnt vmcnt(" #n ")" ::: "memory")
#define PG8_WAIT_L(n) asm volatile("s_waitcnt lgkmcnt(" #n ")" ::: "memory")
#define PG8_BAR __builtin_amdgcn_s_barrier()
#define PG8_SCHED __builtin_amdgcn_sched_barrier(0)
    Unit cur, nxt; int ui = 0;
    if (!S.next(0, cur)) return;
    unsigned vo[2][2], nvo[2][2];
    calc_aoff(P, cur, Rr, Cc, vo);
    bool has_next = S.next(1, nxt);
    if constexpr (Prob::GATHER) { if (has_next) calc_aoff(P, nxt, Rr, Cc, nvo); else {
#pragma unroll
        for (int h = 0; h < 2; ++h)
#pragma unroll
            for (int i = 0; i < 2; ++i) nvo[h][i] = vo[h][i]; } }
    f32x4 acc[2][2][4][2];
#pragma unroll
    for (int a = 0; a < 2; ++a)
#pragma unroll
        for (int b = 0; b < 2; ++b)
#pragma unroll
            for (int m = 0; m < 4; ++m)
#pragma unroll
                for (int n = 0; n < 2; ++n) acc[a][b][m][n] = (f32x4){0.f, 0.f, 0.f, 0.f};
    bf16x8 At[4][2], B0[2][2], B1[2][2]; i32x8_t At8[4], B08[2], B18[2];
    const char* cA = P.a_base(cur); const char* cB = P.b_base(cur);
    PG8_STGB(PG8_SB(0, 0), cB); PG8_STGB(PG8_SB(0, 1), cB + bhstep); PG8_STG(PG8_SA(0, 0), cA, vo[0][0], vo[0][1]); PG8_STG(PG8_SA(0, 1), cA, vo[1][0], vo[1][1]);
    if (wr == 1) PG8_BAR;
    PG8_WAIT_V(2); PG8_BAR;
    PG8_STGB(PG8_SB(1, 0), cB + kstep); PG8_STG(PG8_SA(1, 0), cA + kstep, vo[0][0], vo[0][1]); PG8_STGB(PG8_SB(1, 1), cB + bhstep + kstep);
    PG8_WAIT_V(6); PG8_BAR;
    for (;;) {
        const char* nA = has_next ? P.a_base(nxt) : cA; const char* nB = has_next ? P.b_base(nxt) : cB;
        for (int t = 0; t < nt; t += 2) {
            const bool last = (t == nt - 2);
            if constexpr (Epi::HAS_MID) { if (t == Epi::MID_T0 || t == Epi::MID_T1) { E.mid(acc, cur, wr, wc, fr, fq, t == Epi::MID_T0 ? 0 : 1); PG8_SCHED; } }
            const char* a1 = cA + (size_t)(t + 1) * kstep;
            const char* a2 = last ? nA : cA + (size_t)(t + 2) * kstep; const char* b2 = last ? nB : cB + (size_t)(t + 2) * kstep;
            const char* a3 = a2 + kstep; const char* b3 = b2 + kstep;
            unsigned x00 = vo[0][0], x01 = vo[0][1], x10 = vo[1][0], x11 = vo[1][1];
            if constexpr (Prob::GATHER) { if (last) { x00 = nvo[0][0]; x01 = nvo[0][1]; x10 = nvo[1][0]; x11 = nvo[1][1]; } }
            PG8_XLDB0(0, 0); PG8_XLDB1(0, 1); PG8_SCHED; PG8_XLDA(0, 0); PG8_STG(PG8_SA(1, 1), a1, vo[1][0], vo[1][1]);
            PG8_WAIT_V(8); PG8_WAIT_L(0); PG8_BAR; PG8_XMMA0(0, 0); PG8_XMMA1(0, 1); PG8_BAR; PG8_SCHED;
            PG8_XLDA(0, 1); PG8_STGB(PG8_SB(0, 0), b2); PG8_STGB(PG8_SB(0, 1), b2 + bhstep); PG8_STG(PG8_SA(0, 0), a2, x00, x01);
            PG8_WAIT_V(8); PG8_WAIT_L(0); PG8_BAR; PG8_XMMA0(1, 0); PG8_XMMA1(1, 1); PG8_BAR; PG8_SCHED;
            PG8_XLDB0(1, 0); PG8_XLDB1(1, 1); PG8_SCHED; PG8_XLDA(1, 0); PG8_STG(PG8_SA(0, 1), a2, x10, x11);
            PG8_WAIT_V(8); PG8_WAIT_L(0); PG8_BAR; PG8_XMMA0(0, 0); PG8_XMMA1(0, 1); PG8_BAR; PG8_SCHED;
            PG8_XLDA(1, 1); PG8_STGB(PG8_SB(1, 0), b3); PG8_STGB(PG8_SB(1, 1), b3 + bhstep); PG8_STG(PG8_SA(1, 0), a3, x00, x01);
            PG8_WAIT_V(8); PG8_WAIT_L(0); PG8_BAR; PG8_XMMA0(1, 0); PG8_XMMA1(1, 1); PG8_BAR; PG8_SCHED;
        }
        if constexpr (ALIGN_EPI) { if (wr == 0) PG8_BAR; }
        if constexpr (Prob::F8 && F8MODE == 2) asm volatile("s_nop 15\n\ts_nop 15" ::: "memory");
        Unit nn; const bool has_nn = has_next && S.next(ui + 2, nn);
        if constexpr (Prob::GATHER) {
#pragma unroll
            for (int h = 0; h < 2; ++h)
#pragma unroll
                for (int i = 0; i < 2; ++i) vo[h][i] = nvo[h][i];
            if (has_nn) {
#pragma unroll
                for (int h = 0; h < 2; ++h)
#pragma unroll
                    for (int i = 0; i < 2; ++i) nvo[h][i] = P.a_raw(nn, h * HALF + Rr[i]); } }
        E(acc, cur, wr, wc, fr, fq);
        if (!has_next) break;
#pragma unroll
        for (int a = 0; a < 2; ++a)
#pragma unroll
            for (int b = 0; b < 2; ++b)
#pragma unroll
                for (int m = 0; m < 4; ++m)
#pragma unroll
                    for (int n = 0; n < 2; ++n) acc[a][b][m][n] = (f32x4){0.f, 0.f, 0.f, 0.f};
        cur = nxt; cA = nA; cB = nB; ++ui;
        has_next = has_nn; nxt = nn;
        if constexpr (Prob::GATHER) { if (has_next) {
#pragma unroll
            for (int h = 0; h < 2; ++h)
#pragma unroll
                for (int i = 0; i < 2; ++i) nvo[h][i] = (nvo[h][i] >> 2) * (Prob::F8 ? 1024u : 2048u) + (unsigned)Cc[i] * 2u;
            asm volatile("" : "+v"(nvo[0][0]), "+v"(nvo[0][1]), "+v"(nvo[1][0]), "+v"(nvo[1][1])); } }
        if constexpr (ALIGN_EPI) { if (wr == 1) PG8_BAR; }
    }
    PG8_WAIT_V(0);
    if constexpr (!ALIGN_EPI) { if (wr == 0) PG8_BAR; }
    PG8_BAR;
#undef PG8_SA
#undef PG8_SB
#undef PG8_STG
#undef PG8_STGB
#undef PG8_LDA
#undef PG8_LDB
#undef PG8_MMAB
#undef PG8_MMAQ
#undef PG8_MMA8
#undef PG8_LDA8
#undef PG8_LDB8
#undef PG8_XLDA
#undef PG8_XLDB0
#undef PG8_XLDB1
#undef PG8_XMMA0
#undef PG8_XMMA1
#undef PG8_WAIT_V
#undef PG8_WAIT_L
#undef PG8_BAR
#undef PG8_SCHED
}

typedef const f32x4 (&AccRef)[2][2][4][2];

__device__ __forceinline__ void store8(bf16_t* p, const f32x4& a, const f32x4& b) {
    u32x4 w; w.x = cvt_pk_bf16(a[0], a[1]); w.y = cvt_pk_bf16(a[2], a[3]); w.z = cvt_pk_bf16(b[0], b[1]); w.w = cvt_pk_bf16(b[2], b[3]); *(u32x4*)p = w;
}
__device__ __forceinline__ float sigmoidf_(float v) { return __builtin_amdgcn_rcpf(1.0f + __builtin_amdgcn_exp2f(-1.4426950408889634f * v)); }

struct EpiInProj {
    static constexpr bool HAS_MID = false;
    bf16_t *Q, *Kb, *V, *U, *MQ, *GT; const float *qn, *kn, *mqn, *bg; const f32x2* rope;
    __device__ __forceinline__ void operator()(AccRef acc, const Unit& u, int wr, int wc, int fr, int fq) const {
        const int pn = u.pn; const int row0 = u.pm * BM + wr * 64 + fr;
        bf16_t* const Q_ = Q; bf16_t* const K_ = Kb; bf16_t* const V_ = V; bf16_t* const U_ = U; bf16_t* const MQ_ = MQ; const float* const qn_ = qn; const float* const kn_ = kn; const float* const mqn_ = mqn;
        if (pn < 4 || pn == 7) {
            const bool rope_on = pn < 4; const float* gn = pn < 2 ? qn_ : (pn < 4 ? kn_ : mqn_);
            const float sc = (pn < 2 || pn == 7) ? C2 : 1.0f;
            bf16_t* O; int pitch, colb;
            if (pn < 2) { O = Q_; pitch = 512; colb = (pn * 4 + wc) * 64; } else if (pn < 4) { O = K_; pitch = 512; colb = ((pn - 2) * 4 + wc) * 64; } else { O = MQ_; pitch = 256; colb = wc * 64; }
            const f32x4 g00 = *(const f32x4*)(gn + 8 * fq), g01 = *(const f32x4*)(gn + 8 * fq + 4), g10 = *(const f32x4*)(gn + 32 + 8 * fq), g11 = *(const f32x4*)(gn + 32 + 8 * fq + 4);
#pragma unroll
            for (int ai = 0; ai < 2; ++ai)
#pragma unroll
                for (int m = 0; m < 4; ++m) {
                    const f32x4 a0 = acc[ai][0][m][0], a1 = acc[ai][0][m][1], b0 = acc[ai][1][m][0], b1 = acc[ai][1][m][1];
                    float ss = 0.f;
#pragma unroll
                    for (int j = 0; j < 4; ++j) ss += a0[j] * a0[j] + a1[j] * a1[j] + b0[j] * b0[j] + b1[j] * b1[j];
                    ss += __shfl_xor(ss, 16); ss += __shfl_xor(ss, 32);
                    const float rstd = 1.0f / sqrtf(ss * (1.0f / 64.0f) + RMS_EPS);
                    const int row = row0 + ai * HALF + m * 16;
                    f32x4 t10 = a0 * rstd * g00, t11 = a1 * rstd * g01, t20 = b0 * rstd * g10, t21 = b1 * rstd * g11;
                    f32x4 o10, o11, o20, o21;
                    if (rope_on) {
                        const f32x4* rp = (const f32x4*)(rope + (size_t)(row & (SEQ - 1)) * 32 + 8 * fq);
                        const f32x4 r0 = rp[0], r1 = rp[1], r2 = rp[2], r3 = rp[3];
                        const f32x4 cs0 = {r0[0], r0[2], r1[0], r1[2]}, sn0 = {r0[1], r0[3], r1[1], r1[3]}, cs1 = {r2[0], r2[2], r3[0], r3[2]}, sn1 = {r2[1], r2[3], r3[1], r3[3]};
                        o10 = (t10 * cs0 - t20 * sn0) * sc; o11 = (t11 * cs1 - t21 * sn1) * sc; o20 = (t20 * cs0 + t10 * sn0) * sc; o21 = (t21 * cs1 + t11 * sn1) * sc;
                    } else { o10 = t10 * sc; o11 = t11 * sc; o20 = t20 * sc; o21 = t21 * sc; }
                    bf16_t* rowp = O + (size_t)row * pitch + colb + 8 * fq;
                    store8(rowp, o10, o11); store8(rowp + 32, o20, o21);
                }
        } else if (pn < 7) {
            bf16_t* O; int pitch, colb;
            if (pn < 6) { O = V_; pitch = 512; colb = (pn - 4) * 256 + wc * 64; } else { O = U_; pitch = 256; colb = wc * 64; }
#pragma unroll
            for (int ai = 0; ai < 2; ++ai)
#pragma unroll
                for (int m = 0; m < 4; ++m) { bf16_t* rowp = O + (size_t)(row0 + ai * HALF + m * 16) * pitch + colb + 8 * fq;
                    store8(rowp, acc[ai][0][m][0], acc[ai][0][m][1]); store8(rowp + 32, acc[ai][1][m][0], acc[ai][1][m][1]); }
        } else {
            const int gc = (pn - 8) * 256 + wc * 64 + 8 * fq;
            f32x4 bv[2][2];
#pragma unroll
            for (int bj = 0; bj < 2; ++bj)
#pragma unroll
                for (int n = 0; n < 2; ++n) bv[bj][n] = *(const f32x4*)(bg + gc + 32 * bj + 4 * n);
#pragma unroll
            for (int ai = 0; ai < 2; ++ai)
#pragma unroll
                for (int m = 0; m < 4; ++m) { bf16_t* rowp = GT + (size_t)(row0 + ai * HALF + m * 16) * 3072 + gc;
#pragma unroll
                    for (int bj = 0; bj < 2; ++bj) { f32x4 v0 = acc[ai][bj][m][0] + bv[bj][0], v1 = acc[ai][bj][m][1] + bv[bj][1];
#pragma unroll
                        for (int j = 0; j < 4; ++j) { v0[j] = sigmoidf_(v0[j]); v1[j] = sigmoidf_(v1[j]); }
                        store8(rowp + 32 * bj, v0, v1); } }
        }
    }
};
struct EpiMemKV {
    static constexpr bool HAS_MID = false;
    bf16_t* MKV; const float* mkn;
    __device__ __forceinline__ void operator()(AccRef acc, const Unit& u, int wr, int wc, int fr, int fq) const {
        const int row0 = u.pm * BM + wr * 64 + fr;
        f32x4 g00 = {1.f, 1.f, 1.f, 1.f}, g01 = g00, g10 = g00, g11 = g00;
        if (u.pn == 0) { g00 = *(const f32x4*)(mkn + 8 * fq); g01 = *(const f32x4*)(mkn + 8 * fq + 4); g10 = *(const f32x4*)(mkn + 32 + 8 * fq); g11 = *(const f32x4*)(mkn + 32 + 8 * fq + 4); }
#pragma unroll
        for (int ai = 0; ai < 2; ++ai)
#pragma unroll
            for (int m = 0; m < 4; ++m) {
                const f32x4 a0 = acc[ai][0][m][0], a1 = acc[ai][0][m][1], b0 = acc[ai][1][m][0], b1 = acc[ai][1][m][1];
                float rstd = 1.0f;
                if (u.pn == 0) { float ss = 0.f;
#pragma unroll
                    for (int j = 0; j < 4; ++j) ss += a0[j] * a0[j] + a1[j] * a1[j] + b0[j] * b0[j] + b1[j] * b1[j];
                    ss += __shfl_xor(ss, 16); ss += __shfl_xor(ss, 32); rstd = 1.0f / sqrtf(ss * (1.0f / 64.0f) + RMS_EPS); }
                bf16_t* rowp = MKV + (size_t)(row0 + ai * HALF + m * 16) * 512 + u.pn * 256 + wc * 64 + 8 * fq;
                store8(rowp, a0 * rstd * g00, a1 * rstd * g01); store8(rowp + 32, b0 * rstd * g10, b1 * rstd * g11);
            }
    }
};
template <int STAGE> struct EpiMerge {
    static constexpr bool HAS_MID = false;
    const bf16_t* GT; float* MF; bf16_t* MB;
    __device__ __forceinline__ void operator()(AccRef acc, const Unit& u, int wr, int wc, int fr, int fq) const {
        const int row0 = u.pm * BM + wr * 64 + fr, col0 = u.pn * BM + wc * 64 + 8 * fq;
#pragma unroll
        for (int ai = 0; ai < 2; ++ai)
#pragma unroll
            for (int m = 0; m < 4; ++m) { const size_t row = (size_t)(row0 + ai * HALF + m * 16);
#pragma unroll
                for (int bj = 0; bj < 2; ++bj) { const int col = col0 + 32 * bj;
                    const u32x4 g = *(const u32x4*)(GT + row * 3072 + STAGE * 1024 + col);
                    const f32x4 ga = {bf_lo(g.x), bf_hi(g.x), bf_lo(g.y), bf_hi(g.y)}, gb = {bf_lo(g.z), bf_hi(g.z), bf_lo(g.w), bf_hi(g.w)};
                    f32x4 v0 = acc[ai][bj][m][0] * ga, v1 = acc[ai][bj][m][1] * gb;
                    float* mp = MF + row * 1024 + col;
                    if (STAGE > 0) { v0 += *(const f32x4*)mp; v1 += *(const f32x4*)(mp + 4); }
                    if (STAGE < 2) { *(f32x4*)mp = v0; *(f32x4*)(mp + 4) = v1; } else store8(MB + row * 1024 + col, v0, v1); }
                if (m & 1) asm volatile("" ::: "memory"); }
    }
};
struct EpiWout {
    static constexpr bool HAS_MID = false;
    const float* X; float* X2; unsigned char* XG; const float* n2;
    __device__ __forceinline__ void operator()(AccRef acc, const Unit& u, int wr, int wc, int fr, int fq) const {
        const int row0 = u.pm * BM + wr * 64 + fr, col0 = u.pn * BM + wc * 64 + 8 * fq;
        f32x4 nv[2][2];
#pragma unroll
        for (int bj = 0; bj < 2; ++bj)
#pragma unroll
            for (int n = 0; n < 2; ++n) nv[bj][n] = *(const f32x4*)(n2 + col0 + 32 * bj + 4 * n);
#pragma unroll
        for (int ai = 0; ai < 2; ++ai)
#pragma unroll
            for (int m = 0; m < 4; ++m) { const size_t off = (size_t)(row0 + ai * HALF + m * 16) * 1024 + col0;
#pragma unroll
                for (int bj = 0; bj < 2; ++bj) { const f32x4 x0 = *(const f32x4*)(X + off + 32 * bj) + acc[ai][bj][m][0], x1 = *(const f32x4*)(X + off + 32 * bj + 4) + acc[ai][bj][m][1];
                    *(f32x4*)(X2 + off + 32 * bj) = x0; *(f32x4*)(X2 + off + 32 * bj + 4) = x1;
                    { const f32x4 y0 = x0 * nv[bj][0], y1 = x1 * nv[bj][1]; u32x2 w8; w8.x = pk4_fp8(y0[0], y0[1], y0[2], y0[3]); w8.y = pk4_fp8(y1[0], y1[1], y1[2], y1[3]); *(u32x2*)(XG + off + 32 * bj) = w8; } }
                if (m & 1) asm volatile("" ::: "memory"); }
    }
};
struct EpiSwiglu {
    static constexpr bool HAS_MID = false;
    unsigned char* ACT; const u32x2* list; const float* bgu;
    __device__ __forceinline__ void operator()(AccRef acc, const Unit& u, int wr, int wc, int fr, int fq) const {
        int z = 0; asm volatile("" : "+v"(z));
        const int col = 128 * u.pn + 32 * wc + 8 * fq + z; const float* bp = bgu + (size_t)u.e * 2048 + col;
        const f32x4 bg0 = *(const f32x4*)bp, bg1 = *(const f32x4*)(bp + 4), bu0 = *(const f32x4*)(bp + 1024), bu1 = *(const f32x4*)(bp + 1028);
#pragma unroll
        for (int ai = 0; ai < 2; ++ai)
#pragma unroll
            for (int m = 0; m < 4; ++m) { const int r = ai * HALF + wr * 64 + m * 16 + fr, rr = u.mt * BM + r, rc = rr < u.cnt ? rr : u.cnt - 1;
                const float rstd = __uint_as_float(list[(size_t)u.e * CAP + rc].y) * (1.0f / W8_SCALE);
                f32x4 o[2];
#pragma unroll
                for (int n = 0; n < 2; ++n) { const f32x4 g = acc[ai][0][m][n] * rstd + (n ? bg1 : bg0), up = acc[ai][1][m][n] * rstd + (n ? bu1 : bu0);
#pragma unroll
                    for (int j = 0; j < 4; ++j) { const float gg = fminf(g[j], 7.0f), uu = fminf(fmaxf(up[j], -7.0f), 7.0f);
                        o[n][j] = gg * __builtin_amdgcn_rcpf(1.0f + __builtin_amdgcn_exp2f(-1.702f * 1.4426950408889634f * gg)) * (uu + 1.0f); } }
                { const f32x4 q0 = o[0] * A8_SCALE, q1 = o[1] * A8_SCALE; u32x2 w8; w8.x = pk4_fp8(q0[0], q0[1], q0[2], q0[3]); w8.y = pk4_fp8(q1[0], q1[1], q1[2], q1[3]); *(u32x2*)(ACT + (size_t)(u.pm * BM + r) * 1024 + col) = w8; } }
    }
};
struct EpiDown {
    static constexpr bool HAS_MID = false;
    bf16_t* Y4; const u32x2* list; const float* bd;
    __device__ __forceinline__ void operator()(AccRef acc, const Unit& u, int wr, int wc, int fr, int fq) const {
        int z = 0; asm volatile("" : "+v"(z));
        const int col0 = u.pn * BM + wc * 64 + 8 * fq + z; const float* bp = bd + (size_t)u.e * 1024 + col0;
        f32x4 bv[2][2];
#pragma unroll
        for (int bj = 0; bj < 2; ++bj)
#pragma unroll
            for (int n = 0; n < 2; ++n) bv[bj][n] = *(const f32x4*)(bp + 32 * bj + 4 * n);
        unsigned tkv[8];
#pragma unroll
        for (int ai = 0; ai < 2; ++ai)
#pragma unroll
            for (int m = 0; m < 4; ++m) { const int rr = u.mt * BM + ai * HALF + wr * 64 + m * 16 + fr, rc = rr < u.cnt ? rr : u.cnt - 1;
                tkv[ai * 4 + m] = list[(size_t)u.e * CAP + rc].x; }
#pragma unroll
        for (int ai = 0; ai < 2; ++ai)
#pragma unroll
            for (int m = 0; m < 4; ++m) { const int rr = u.mt * BM + ai * HALF + wr * 64 + m * 16 + fr;
                if (rr < u.cnt) { bf16_t* rowp = Y4 + (size_t)tkv[ai * 4 + m] * 1024 + col0;
#pragma unroll
                    for (int bj = 0; bj < 2; ++bj) store8(rowp + 32 * bj, acc[ai][bj][m][0] * (1.0f / (W8_SCALE * A8_SCALE)) + bv[bj][0], acc[ai][bj][m][1] * (1.0f / (W8_SCALE * A8_SCALE)) + bv[bj][1]); } }
    }
};
struct EpiMergeR {
    static constexpr bool HAS_MID = true; static constexpr int MID_T0 = 8, MID_T1 = 12;
    const bf16_t* GT; bf16_t* MB;
    __device__ __forceinline__ void mid(f32x4 (&acc)[2][2][4][2], const Unit& u, int wr, int wc, int fr, int fq, int seam) const {
        int z = 0; asm volatile("" : "+v"(z));
        const bf16_t* gp0 = GT + (size_t)(u.pm * BM + wr * 64 + fr + z) * 3072 + seam * 1024 + u.pn * BM + wc * 64 + 8 * fq;
#pragma unroll
        for (int ai = 0; ai < 2; ++ai)
#pragma unroll
            for (int m = 0; m < 4; ++m) { const bf16_t* gp = gp0 + (size_t)(ai * HALF + m * 16) * 3072;
#pragma unroll
                for (int bj = 0; bj < 2; ++bj) { const u32x4 gn = *(const u32x4*)(gp + 32 * bj), gd = *(const u32x4*)(gp + 1024 + 32 * bj);
                    const unsigned nn[4] = {gn.x, gn.y, gn.z, gn.w}, dd[4] = {gd.x, gd.y, gd.z, gd.w};
#pragma unroll
                    for (int j = 0; j < 4; ++j) { const float r0 = bf_lo(nn[j]) * __builtin_amdgcn_rcpf(fmaxf(bf_lo(dd[j]), 8.67e-19f)), r1 = bf_hi(nn[j]) * __builtin_amdgcn_rcpf(fmaxf(bf_hi(dd[j]), 8.67e-19f));
                        acc[ai][bj][m][j >> 1][(j & 1) * 2] *= r0; acc[ai][bj][m][j >> 1][(j & 1) * 2 + 1] *= r1; } }
                if (m & 1) asm volatile("" ::: "memory"); }
    }
    __device__ __forceinline__ void operator()(AccRef acc, const Unit& u, int wr, int wc, int fr, int fq) const {
        int z = 0; asm volatile("" : "+v"(z));
        const size_t off0 = (size_t)(u.pm * BM + wr * 64 + fr + z) * 1024 + u.pn * BM + wc * 64 + 8 * fq;
#pragma unroll
        for (int ai = 0; ai < 2; ++ai)
#pragma unroll
            for (int m = 0; m < 4; ++m) { const size_t ro = off0 + (size_t)(ai * HALF + m * 16) * 1024;
#pragma unroll
                for (int bj = 0; bj < 2; ++bj) {
                    const u32x4 g = *(const u32x4*)(GT + ro * 3 + 2048 - 2 * (ro & 1023) + 32 * bj);
                    const f32x4 ga = {bf_lo(g.x), bf_hi(g.x), bf_lo(g.y), bf_hi(g.y)}, gb = {bf_lo(g.z), bf_hi(g.z), bf_lo(g.w), bf_hi(g.w)};
                    store8(MB + ro + 32 * bj, acc[ai][bj][m][0] * ga, acc[ai][bj][m][1] * gb); } }
    }
};
struct EpiPlain {
    static constexpr bool HAS_MID = false;
    bf16_t* Z; int ldz;
    __device__ __forceinline__ void operator()(AccRef acc, const Unit& u, int wr, int wc, int fr, int fq) const {
        const int row0 = u.pm * BM + wr * 64 + fr, col0 = u.pn * BM + wc * 64 + 8 * fq;
#pragma unroll
        for (int ai = 0; ai < 2; ++ai)
#pragma unroll
            for (int m = 0; m < 4; ++m) { bf16_t* rowp = Z + (size_t)(row0 + ai * HALF + m * 16) * ldz + col0;
                store8(rowp, acc[ai][0][m][0], acc[ai][0][m][1]); store8(rowp + 32, acc[ai][1][m][0], acc[ai][1][m][1]); }
    }
};
}

namespace attn_body {
using bf16 = __hip_bfloat16;
using s16x4 = __attribute__((ext_vector_type(4))) short;
constexpr int NW = 8, QBLK = 32, QB = QBLK * NW, KVBLK = 64, D = 64;
__device__ __forceinline__ int crow(int r, int hi) { return (r & 3) + 8 * (r >> 2) + 4 * hi; }
#define SBAR() __builtin_amdgcn_sched_barrier(0)
constexpr int NSLOT = 3, SLOTB = 8192;
constexpr int LDS_K = 0, LDS_V = NSLOT * SLOTB, LDS_WS = 2 * NSLOT * SLOTB, LDS_OST = LDS_WS + NW * 64 * 4, LDS_BYTES = LDS_OST + NW * 4096;
__device__ __forceinline__ void glds16(const void* gsrc, unsigned lds_dst) { unsigned keep;
    asm volatile("s_mov_b32 %0, m0\n\ts_mov_b32 m0, %2\n\ts_nop 0\n\tglobal_load_lds_dwordx4 %1, off\n\ts_mov_b32 m0, %0" : "=&s"(keep) : "v"(gsrc), "s"(lds_dst) : "memory"); }
__device__ __forceinline__ float max3f(float a, float b, float c) { float r; asm("v_max3_f32 %0, %1, %2, %3" : "=v"(r) : "v"(a), "v"(b), "v"(c)); return r; }
__device__ __forceinline__ float max2f(float a, float b) { float r; asm("v_max_f32_e32 %0, %1, %2" : "=v"(r) : "v"(a), "v"(b)); return r; }
__device__ __forceinline__ float fadd_s(float a, float b) { float r; asm("v_add_f32_e32 %0, %1, %2" : "=v"(r) : "v"(a), "v"(b)); return r; }
__device__ __forceinline__ float fsub_s(float a, float b) { float r; asm("v_sub_f32_e32 %0, %1, %2" : "=v"(r) : "v"(a), "v"(b)); return r; }
typedef float f32x2_t __attribute__((ext_vector_type(2))); typedef __bf16 bf16x2_t __attribute__((ext_vector_type(2)));
__device__ __forceinline__ unsigned cvtpk_s(float lo, float hi) { f32x2_t v = {lo, hi}; bf16x2_t b = __builtin_convertvector(v, bf16x2_t); return __builtin_bit_cast(unsigned, b); }
#define WAIT_BAR(N) asm volatile("s_waitcnt vmcnt(" #N ") lgkmcnt(0)\n\ts_barrier" ::: "memory")

__device__ __forceinline__ void qkt(f32x16& p0, f32x16& p1, const char* Kslot, const bf16x8* qr, const f32x16& negm, int r32, int hi) {
    const char* kb = Kslot + hi * 1024 + r32 * 16;
#pragma unroll
    for (int d0 = 0; d0 < 4; ++d0) {
        const bf16x8 b0 = *reinterpret_cast<const bf16x8*>(kb + d0 * 2048);
        const bf16x8 b1 = *reinterpret_cast<const bf16x8*>(kb + d0 * 2048 + 512);
        if (d0 == 0) { p0 = __builtin_amdgcn_mfma_f32_32x32x16_bf16(b0, qr[0], negm, 0, 0, 0); p1 = __builtin_amdgcn_mfma_f32_32x32x16_bf16(b1, qr[0], negm, 0, 0, 0); }
        else { p0 = __builtin_amdgcn_mfma_f32_32x32x16_bf16(b0, qr[d0], p0, 0, 0, 0); p1 = __builtin_amdgcn_mfma_f32_32x32x16_bf16(b1, qr[d0], p1, 0, 0, 0); } }
}
typedef __attribute__((address_space(3))) const char* lds_cptr;
typedef short v4i16_t __attribute__((ext_vector_type(4)));
__device__ __forceinline__ void kload8(bf16x8* kf, lds_cptr kp) {
    kf[0] = *(const __attribute__((address_space(3))) bf16x8*)(kp);        kf[1] = *(const __attribute__((address_space(3))) bf16x8*)(kp + 512);
    kf[2] = *(const __attribute__((address_space(3))) bf16x8*)(kp + 2048); kf[3] = *(const __attribute__((address_space(3))) bf16x8*)(kp + 2560);
    kf[4] = *(const __attribute__((address_space(3))) bf16x8*)(kp + 4096); kf[5] = *(const __attribute__((address_space(3))) bf16x8*)(kp + 4608);
    kf[6] = *(const __attribute__((address_space(3))) bf16x8*)(kp + 6144); kf[7] = *(const __attribute__((address_space(3))) bf16x8*)(kp + 6656);
}
__device__ __forceinline__ void kload2(bf16x8* kf, lds_cptr kp, int j) { kf[2 * j] = *(const __attribute__((address_space(3))) bf16x8*)(kp + j * 2048); kf[2 * j + 1] = *(const __attribute__((address_space(3))) bf16x8*)(kp + j * 2048 + 512); }
__device__ __forceinline__ s16x4 vtr(lds_cptr p) { return __builtin_bit_cast(s16x4, __builtin_amdgcn_ds_read_tr16_b64_v4i16((__attribute__((address_space(3))) v4i16_t*)p)); }
__device__ __forceinline__ float rowmax(const f32x16& p0, const f32x16& p1) {
    float a = max3f(p0[0], p0[1], p1[0]), b = max3f(p0[2], p0[3], p1[1]); a = max3f(a, p1[2], p1[3]);
#pragma unroll
    for (int r = 4; r < 16; r += 4) { a = max3f(a, p0[r], p0[r + 1]); b = max3f(b, p0[r + 2], p0[r + 3]); a = max3f(a, p1[r], p1[r + 1]); b = max3f(b, p1[r + 2], p1[r + 3]); }
    const float m = max2f(a, b);
    auto rr = __builtin_amdgcn_permlane32_swap(__float_as_uint(m), __float_as_uint(m), false, false);
    return max2f(__uint_as_float(rr[0]), __uint_as_float(rr[1]));
}
__device__ __forceinline__ void pv(f32x16* o, int vb, bf16x8 pa0, bf16x8 pa1, bf16x8 pa2, bf16x8 pa3) {
#pragma unroll
    for (int d0 = 0; d0 < 2; ++d0) { s16x4 lo[4], hi[4];
#pragma unroll
        for (int ks = 0; ks < 4; ++ks) {
            asm volatile("ds_read_b64_tr_b16 %0,%1 offset:%c2" : "=&v"(lo[ks]) : "v"(vb), "i"(d0 * 4096 + ks * 1024) : "memory");
            asm volatile("ds_read_b64_tr_b16 %0,%1 offset:%c2" : "=&v"(hi[ks]) : "v"(vb), "i"(d0 * 4096 + ks * 1024 + 512) : "memory"); }
        asm volatile("s_waitcnt lgkmcnt(0)" ::: "memory"); SBAR();
#define PK(k) (bf16x8){lo[k][0], lo[k][1], lo[k][2], lo[k][3], hi[k][0], hi[k][1], hi[k][2], hi[k][3]}
        o[d0] = __builtin_amdgcn_mfma_f32_32x32x16_bf16(pa0, PK(0), o[d0], 0, 0, 0);
        o[d0] = __builtin_amdgcn_mfma_f32_32x32x16_bf16(pa1, PK(1), o[d0], 0, 0, 0);
        o[d0] = __builtin_amdgcn_mfma_f32_32x32x16_bf16(pa2, PK(2), o[d0], 0, 0, 0);
        o[d0] = __builtin_amdgcn_mfma_f32_32x32x16_bf16(pa3, PK(3), o[d0], 0, 0, 0);
#undef PK
    }
}
__device__ __forceinline__ void cmask(f32x16& p0, f32x16& p1, int jb, int wid) {
    if (jb > (wid >> 1)) {
#pragma unroll
        for (int r = 0; r < 16; ++r) { p0[r] = -INFINITY; p1[r] = -INFINITY; } }
}
template <int THRL, bool MASK> __device__ __forceinline__ void attn_unit(int q0, int NT, const bf16* Qh, int qp, const bf16* __restrict__ Kh, int kp, const bf16* __restrict__ Vh, int vp, bf16* Oh, int op, char* shm) {
    const int tid = threadIdx.x, lane = tid & 63, r32 = lane & 31, hi = lane >> 5; const int wid = __builtin_amdgcn_readfirstlane(tid >> 6);
    const bf16* Qw = Qh + (long)(q0 + wid * QBLK) * qp;
    const unsigned lds0 = (unsigned)(uintptr_t)shm;
    float* wsf = (float*)(shm + LDS_WS) + wid * 64;
    const bf16* ksrc = Kh + (long)lane * kp + wid * 8;
    const bf16* vsrc = Vh + (long)(16 * (wid & 3) + (lane >> 2)) * vp + (wid >> 2) * 32 + (lane & 3) * 8;
    const unsigned kdst = lds0 + LDS_K + wid * 1024, vdst = lds0 + LDS_V + wid * 1024;
#define DMA_K(t, slot) glds16(ksrc + (long)(t) * KVBLK * kp, (unsigned)__builtin_amdgcn_readfirstlane(kdst + (slot)))
#define DMA_V(t, slot) glds16(vsrc + (long)(t) * KVBLK * vp, (unsigned)__builtin_amdgcn_readfirstlane(vdst + (slot)))
    const int vb0 = (int)(lds0 + LDS_V) + ((lane >> 4) & 1) * 32 + (lane & 3) * 8 + (4 * hi + ((lane & 15) >> 2)) * 64;
    const char* Kbase = shm + LDS_K; bf16x8 kf[8];
    const lds_cptr shm3 = (lds_cptr)shm; const lds_cptr kp0 = shm3 + LDS_K + hi * 1024 + r32 * 16; const lds_cptr vp0 = shm3 + LDS_V + ((lane >> 4) & 1) * 32 + (lane & 3) * 8 + (4 * hi + ((lane & 15) >> 2)) * 64;
    DMA_K(0, 0); DMA_V(0, 0); DMA_K(1, SLOTB);
    bf16x8 qr[4];
#pragma unroll
    for (int d0 = 0; d0 < 4; ++d0) qr[d0] = *reinterpret_cast<const bf16x8*>(&Qw[(long)r32 * qp + d0 * 16 + hi * 8]);
    float mhat = 0.f, l_reg = 0.f; f32x16 o[2]; o[0] = f32x16{}; o[1] = f32x16{}; f32x16 negm = f32x16{}; asm volatile("" : "+v"(negm));
#define CMASK(P0, P1, t) do { if (MASK) { int jb_ = (t) - (NT - 4); if (jb_ >= 0) cmask(P0, P1, jb_, wid); } } while (0)
    bool resc = false;
#define START(P0, P1) do { const float rm = rowmax(P0, P1); resc = false; \
    { const float dl = rm; mhat = fadd_s(mhat, dl); \
      _Pragma("unroll") for (int r = 0; r < 16; ++r) { P0[r] = fsub_s(P0[r], dl); P1[r] = fsub_s(P1[r], dl); } \
      _Pragma("unroll") for (int r = 0; r < 16; ++r) negm[r] = -mhat; asm volatile("" : "+v"(negm)); } \
    _Pragma("unroll") for (int r = 0; r < 16; ++r) P0[r] = __builtin_amdgcn_exp2f(P0[r]); } while (0)
#define RESC() do { if (resc) { asm volatile("s_waitcnt lgkmcnt(0)" ::: "memory"); \
      _Pragma("unroll") for (int d_ = 0; d_ < 2; ++d_) _Pragma("unroll") for (int r = 0; r < 16; ++r) o[d_][r] *= wsf[crow(r, hi)]; } } while (0)
    f32x16 pA0, pA1, pB0, pB1;
    int sl_prev = 0, sl_cur = 0, sl_next = SLOTB;
#define ROT() do { sl_prev = sl_cur; sl_cur = sl_next; sl_next = (sl_next == (NSLOT - 1) * SLOTB) ? 0 : sl_next + SLOTB; } while (0)
    DMA_K(2, 2 * SLOTB);
    WAIT_BAR(3);
    qkt(pA0, pA1, Kbase, qr, negm, r32, hi); asm volatile("s_nop 15\n\ts_nop 7" : "+v"(pA0), "+v"(pA1)); CMASK(pA0, pA1, 0);
    START(pA0, pA1);
    _Pragma("unroll") for (int r = 0; r < 16; ++r) pA1[r] = __builtin_amdgcn_exp2f(pA1[r]);
    WAIT_BAR(0);
    DMA_K(3, 0); DMA_V(1, SLOTB);
    ROT();
    kload8(kf, kp0 + sl_cur);
    WAIT_BAR(2);
    s16x4 vlo[8], vhi[8]; u32x4 pw0, pw1, pw2, pw3;
#define PKW(P, B) cvtpk_s(P[B], P[B + 1])
#define PAF(k) __builtin_bit_cast(bf16x8, pw##k)
#define VFR(i) (bf16x8){vlo[i][0], vlo[i][1], vlo[i][2], vlo[i][3], vhi[i][0], vhi[i][1], vhi[i][2], vhi[i][3]}
#define PIN(x) asm volatile("" : "+v"(x))
#define MX3(a, b, c) __builtin_fmaxf(__builtin_fmaxf((a), (b)), (c))
#define GAPA(MF, A0, A1, A2, A3, W0, W1, PW) do { MF; sacc += A0; sacc += A1; sacc += A2; sacc += A3; PIN(sacc); W0; W1; PIN(PW); SBAR(); } while (0)
#define EX(v) __builtin_amdgcn_exp2f(v)
#define GAPB(MF, X, B) do { MF; X[B] = EX(X[B]); X[B + 1] = EX(X[B + 1]); X[B + 2] = EX(X[B + 2]); X[B + 3] = EX(X[B + 3]); PIN(X); SBAR(); } while (0)
#define VRD(i) do { vlo[i] = vtr(vp_ + (((i) >> 2) * 4096 + ((i) & 3) * 1024)); vhi[i] = vtr(vp_ + (((i) >> 2) * 4096 + ((i) & 3) * 1024 + 512)); } while (0)
#define KRD(G, j) do { if (G) { kload2(kf, kp0 + sl_next, j); SBAR(); } } while (0)
#define STEP(C0, C1, P0, P1, t, GK, GV, GL) do { SBAR(); \
    const lds_cptr vp_ = vp0 + sl_prev; \
    VRD(0); SBAR(); float sacc = (P0[0] + P0[1]); \
    GAPA(C0 = __builtin_amdgcn_mfma_f32_32x32x16_bf16(kf[0], qr[0], negm, 0, 0, 0), P0[2], P0[3], P0[4], P0[5],     pw0[0] = PKW(P0, 0), pw0[1] = PKW(P0, 2), pw0); \
    VRD(4); SBAR(); GAPA(C1 = __builtin_amdgcn_mfma_f32_32x32x16_bf16(kf[1], qr[0], negm, 0, 0, 0), P0[6], P0[7], P0[8], P0[9],     pw0[2] = PKW(P0, 4), pw0[3] = PKW(P0, 6), pw0); \
    VRD(1); SBAR(); GAPA(C0 = __builtin_amdgcn_mfma_f32_32x32x16_bf16(kf[2], qr[1], C0, 0, 0, 0),   P0[10], P0[11], P0[12], P0[13], pw1[0] = PKW(P0, 8), pw1[1] = PKW(P0, 10), pw1); \
    VRD(5); SBAR(); GAPA(C1 = __builtin_amdgcn_mfma_f32_32x32x16_bf16(kf[3], qr[1], C1, 0, 0, 0),   P0[14], P0[15], P1[0], P1[1],   pw1[2] = PKW(P0, 12), pw1[3] = PKW(P0, 14), pw1); \
    VRD(2); SBAR(); GAPA(C0 = __builtin_amdgcn_mfma_f32_32x32x16_bf16(kf[4], qr[2], C0, 0, 0, 0),   P1[2], P1[3], P1[4], P1[5],     pw2[0] = PKW(P1, 0), pw2[1] = PKW(P1, 2), pw2); \
    VRD(6); SBAR(); GAPA(C1 = __builtin_amdgcn_mfma_f32_32x32x16_bf16(kf[5], qr[2], C1, 0, 0, 0),   P1[6], P1[7], P1[8], P1[9],     pw2[2] = PKW(P1, 4), pw2[3] = PKW(P1, 6), pw2); \
    VRD(3); SBAR(); GAPA(C0 = __builtin_amdgcn_mfma_f32_32x32x16_bf16(kf[6], qr[3], C0, 0, 0, 0),   P1[10], P1[11], P1[12], P1[13], pw3[0] = PKW(P1, 8), pw3[1] = PKW(P1, 10), pw3); \
    VRD(7); SBAR(); GAPA(C1 = __builtin_amdgcn_mfma_f32_32x32x16_bf16(kf[7], qr[3], C1, 0, 0, 0),   P1[14], P1[15], 0.f, 0.f,       pw3[2] = PKW(P1, 12), pw3[3] = PKW(P1, 14), pw3); \
    l_reg += sacc; \
    if (GK) { DMA_K((t) + 3, sl_cur); } if (GV) { DMA_V((t) + 1, sl_next); } \
    CMASK(C0, C1, t); \
    { float a = MX3(C0[0], C0[1], C1[0]), b = MX3(C0[2], C0[3], C1[1]); a = MX3(a, C1[2], C1[3]); \
      _Pragma("unroll") for (int r = 4; r < 16; r += 4) { a = MX3(a, C0[r], C0[r + 1]); b = MX3(b, C0[r + 2], C0[r + 3]); a = MX3(a, C1[r], C1[r + 1]); b = MX3(b, C1[r + 2], C1[r + 3]); } \
      float rm = __builtin_fmaxf(a, b); { auto rr = __builtin_amdgcn_permlane32_swap(__float_as_uint(rm), __float_as_uint(rm), false, false); rm = __builtin_fmaxf(__uint_as_float(rr[0]), __uint_as_float(rr[1])); } \
      resc = false; \
      if (__builtin_expect(__any(rm > (float)THRL), 0)) { const float dl = __builtin_fmaxf(rm, 0.f); mhat += dl; \
        _Pragma("unroll") for (int r = 0; r < 16; ++r) { C0[r] -= dl; C1[r] -= dl; } \
        _Pragma("unroll") for (int r = 0; r < 16; ++r) negm[r] = -mhat; asm volatile("" : "+v"(negm)); \
        const float f = __builtin_amdgcn_exp2f(-dl); l_reg *= f; if (hi == 0) wsf[r32] = f; resc = true; } } \
    SBAR(); \
    GAPB(o[0] = __builtin_amdgcn_mfma_f32_32x32x16_bf16(PAF(0), VFR(0), o[0], 0, 0, 0), C0, 0); \
    GAPB(o[1] = __builtin_amdgcn_mfma_f32_32x32x16_bf16(PAF(0), VFR(4), o[1], 0, 0, 0), C0, 4); \
    KRD(GL, 0); GAPB(o[0] = __builtin_amdgcn_mfma_f32_32x32x16_bf16(PAF(1), VFR(1), o[0], 0, 0, 0), C0, 8); \
    KRD(GL, 1); GAPB(o[1] = __builtin_amdgcn_mfma_f32_32x32x16_bf16(PAF(1), VFR(5), o[1], 0, 0, 0), C0, 12); \
    KRD(GL, 2); GAPB(o[0] = __builtin_amdgcn_mfma_f32_32x32x16_bf16(PAF(2), VFR(2), o[0], 0, 0, 0), C1, 0); \
    KRD(GL, 3); GAPB(o[1] = __builtin_amdgcn_mfma_f32_32x32x16_bf16(PAF(2), VFR(6), o[1], 0, 0, 0), C1, 4); \
    GAPB(o[0] = __builtin_amdgcn_mfma_f32_32x32x16_bf16(PAF(3), VFR(3), o[0], 0, 0, 0), C1, 8); \
    GAPB(o[1] = __builtin_amdgcn_mfma_f32_32x32x16_bf16(PAF(3), VFR(7), o[1], 0, 0, 0), C1, 12); \
    } while (0)
    int t = 1;
#undef CMASK
#define CMASK(P0, P1, t) do {} while (0)
    for (; t + 5 < NT; t += 2) {
        STEP(pB0, pB1, pA0, pA1, t, true, true, true);     WAIT_BAR(2); RESC(); ROT();
        STEP(pA0, pA1, pB0, pB1, t + 1, true, true, true); WAIT_BAR(2); RESC(); ROT();
    }
#undef CMASK
#define CMASK(P0, P1, t) do { if (MASK) { int jb_ = (t) - (NT - 4); if (jb_ >= 0) cmask(P0, P1, jb_, wid); } } while (0)
#define ENDW(tt) do { if ((tt) + 3 < NT) { WAIT_BAR(2); } else if ((tt) + 2 < NT) { WAIT_BAR(1); } else { WAIT_BAR(0); } } while (0)
    for (; t + 1 < NT; t += 2) {
        STEP(pB0, pB1, pA0, pA1, t, (t + 3 < NT), (t + 1 < NT), (t + 1 < NT));       ENDW(t);     RESC(); ROT();
        STEP(pA0, pA1, pB0, pB1, t + 1, (t + 4 < NT), (t + 2 < NT), (t + 2 < NT));   ENDW(t + 1); RESC(); ROT();
    }
    STEP(pB0, pB1, pA0, pA1, NT - 1, false, false, false); RESC();
    { float sacc = pB0[0] + pB0[1]; _Pragma("unroll") for (int r = 2; r < 16; ++r) sacc += pB0[r]; _Pragma("unroll") for (int r = 0; r < 16; ++r) sacc += pB1[r]; l_reg += sacc;
      pw0 = (u32x4){PKW(pB0, 0), PKW(pB0, 2), PKW(pB0, 4), PKW(pB0, 6)}; pw1 = (u32x4){PKW(pB0, 8), PKW(pB0, 10), PKW(pB0, 12), PKW(pB0, 14)}; pw2 = (u32x4){PKW(pB1, 0), PKW(pB1, 2), PKW(pB1, 4), PKW(pB1, 6)}; pw3 = (u32x4){PKW(pB1, 8), PKW(pB1, 10), PKW(pB1, 12), PKW(pB1, 14)};
      SBAR(); pv(o, vb0 + sl_cur, PAF(0), PAF(1), PAF(2), PAF(3)); }
#undef PKW
#undef PAF
#undef VFR
#undef PIN
#undef MX3
#undef GAPA
#undef GAPB
#undef EX
#undef VRD
#undef KRD
#undef STEP
#undef ENDW
    { auto rr = __builtin_amdgcn_permlane32_swap(__float_as_uint(l_reg), __float_as_uint(l_reg), false, false); l_reg = __uint_as_float(rr[0]) + __uint_as_float(rr[1]); }
    if (hi == 0) wsf[32 + r32] = l_reg; asm volatile("s_waitcnt lgkmcnt(0)" ::: "memory");
    float rli[16];
#pragma unroll
    for (int r = 0; r < 16; ++r) rli[r] = __builtin_amdgcn_rcpf(wsf[32 + crow(r, hi)]);
    bf16* Ow = Oh + (long)(q0 + wid * QBLK) * op;
    { bf16* stg = (bf16*)(shm + LDS_OST) + wid * 2048;
#pragma unroll
      for (int r = 0; r < 16; ++r) { const int orow = crow(r, hi);
#pragma unroll
        for (int d0 = 0; d0 < 2; ++d0) stg[orow * 64 + d0 * 32 + r32] = __float2bfloat16(o[d0][r] * rli[r]); }
      asm volatile("s_waitcnt lgkmcnt(0)" ::: "memory");
#pragma unroll
      for (int i = 0; i < 4; ++i) { const int row = i * 8 + (lane >> 3), ch = lane & 7; const u32x4 v = *(const u32x4*)(stg + row * 64 + ch * 8); *(u32x4*)(Ow + (long)row * op + ch * 8) = v; } }
    asm volatile("s_waitcnt lgkmcnt(0)\n\ts_barrier" ::: "memory");
#undef DMA_K
#undef DMA_V
#undef CMASK
#undef START
#undef RESC
#undef ROT
}

constexpr int L2_K = 0, L2_V = 3 * 8192, L2_WS = L2_V + 4 * 16384, L2_OST = L2_WS + NW * 64 * 4, L2_BYTES = L2_OST + NW * 4096;
template <bool MASK> __device__ __forceinline__ void attn_unit2(int q0, int NT, const bf16* Qh, int qp, const bf16* __restrict__ Kh, int kp, const bf16* __restrict__ Vh, int vp, bf16* Oh, int op, char* shm) {
    const int tid = threadIdx.x, lane = tid & 63, r32 = lane & 31, hi = lane >> 5; const int wid = __builtin_amdgcn_readfirstlane(tid >> 6);
    const bf16* Qw = Qh + (long)(q0 + wid * QBLK) * qp;
    const unsigned lds0 = (unsigned)(uintptr_t)shm;
    float* wsf = (float*)(shm + L2_WS) + wid * 64;
    const bf16* ksrc = Kh + (long)lane * kp + wid * 8;
    const bf16* vsrc = Vh + (long)(16 * (wid & 3) + (lane >> 2)) * vp + (wid >> 2) * 32 + (lane & 3) * 8;
    const unsigned kdst = lds0 + L2_K + wid * 1024, vdst = lds0 + L2_V + wid * 1024;
#define DMA_K(t, slot) glds16(ksrc + (long)(t) * KVBLK * kp, (unsigned)__builtin_amdgcn_readfirstlane(kdst + (slot)))
#define DMA_V(t, vslot) do { glds16(vsrc + (long)(t) * KVBLK * vp, (unsigned)__builtin_amdgcn_readfirstlane(vdst + (vslot))); \
                            glds16(vsrc + (long)(t) * KVBLK * vp + 64, (unsigned)__builtin_amdgcn_readfirstlane(vdst + (vslot) + 8192)); } while (0)
    const int vb0 = (int)(lds0 + L2_V) + ((lane >> 4) & 1) * 32 + (lane & 3) * 8 + (4 * hi + ((lane & 15) >> 2)) * 64;
    const char* Kbase = shm + L2_K; bf16x8 kf[8];
    const lds_cptr shm3 = (lds_cptr)shm; const lds_cptr kp0 = shm3 + L2_K + hi * 1024 + r32 * 16; const lds_cptr vp0 = shm3 + L2_V + ((lane >> 4) & 1) * 32 + (lane & 3) * 8 + (4 * hi + ((lane & 15) >> 2)) * 64;
    DMA_K(0, 0); DMA_V(0, 0); DMA_K(1, SLOTB);
    bf16x8 qr[4];
#pragma unroll
    for (int d0 = 0; d0 < 4; ++d0) qr[d0] = *reinterpret_cast<const bf16x8*>(&Qw[(long)r32 * qp + d0 * 16 + hi * 8]);
    float l_reg = 0.f; f32x16 o[4]; o[0] = f32x16{}; o[1] = f32x16{}; o[2] = f32x16{}; o[3] = f32x16{};
    const f32x16 zero16 = f32x16{};
#define CMASK(P0, P1, t) do { if (MASK) { int jb_ = (t) - (NT - 4); if (jb_ >= 0) cmask(P0, P1, jb_, wid); } } while (0)
    f32x16 pA0, pA1, pB0, pB1;
    int sl_prev = 0, sl_cur = 0, sl_next = SLOTB;
    int vs_rd = 0, vs_wr = 3 * 16384;
#define ROT() do { sl_prev = sl_cur; sl_cur = sl_next; sl_next = (sl_next == (NSLOT - 1) * SLOTB) ? 0 : sl_next + SLOTB; vs_rd = (vs_rd + 16384) & 65535; vs_wr = (vs_wr + 16384) & 65535; } while (0)
    DMA_K(2, 2 * SLOTB); DMA_V(1, 16384);
    WAIT_BAR(6);
    qkt(pA0, pA1, Kbase, qr, zero16, r32, hi); CMASK(pA0, pA1, 0);
    _Pragma("unroll") for (int r = 0; r < 16; ++r) { pA0[r] = __builtin_amdgcn_exp2f(pA0[r]); pA1[r] = __builtin_amdgcn_exp2f(pA1[r]); }
    WAIT_BAR(2);
    DMA_K(3, 0); DMA_V(2, 2 * 16384);
    sl_prev = sl_cur; sl_cur = sl_next; sl_next = 2 * SLOTB;
    kload8(kf, kp0 + sl_cur);
    WAIT_BAR(5);
    s16x4 f0lo, f0hi, f1lo, f1hi, f2lo, f2hi, f3lo, f3hi; u32x4 pw0, pw1, pw2, pw3;
#define PKW(P, B) cvtpk_s(P[B], P[B + 1])
#define PAF(k) __builtin_bit_cast(bf16x8, pw##k)
#define PIN(x) asm volatile("" : "+v"(x))
#define EX(v) __builtin_amdgcn_exp2f(v)
#define VOFF(id) ((((id) >> 2) * 4096) + (((id) & 3) * 1024))
#define VRD2(F, id) do { F##lo = vtr(vp_ + VOFF(id)); F##hi = vtr(vp_ + VOFF(id) + 512); } while (0)
#define VFR2(F) (bf16x8){F##lo[0], F##lo[1], F##lo[2], F##lo[3], F##hi[0], F##hi[1], F##hi[2], F##hi[3]}
#define GAPA(MF, A0, A1, A2, A3, W0, W1, PW) do { MF; sacc += A0; sacc += A1; sacc += A2; sacc += A3; PIN(sacc); W0; W1; PIN(PW); SBAR(); } while (0)
#define GAPB(MF, RD, X, B) do { MF; RD; X[B] = EX(X[B]); X[B + 1] = EX(X[B + 1]); PIN(X); SBAR(); } while (0)
#define KRD(G, j) do { if (G) { kload2(kf, kp0 + sl_next, j); SBAR(); } } while (0)
#define MF32(a, b, c) __builtin_amdgcn_mfma_f32_32x32x16_bf16(a, b, c, 0, 0, 0)
#define STEP(C0, C1, P0, P1, t, GK, GV, GL) do { SBAR(); __builtin_amdgcn_s_setprio(ATTN_PRIO_A); \
    const lds_cptr vp_ = vp0 + vs_rd; \
    float sacc = (P0[0] + P0[1]); \
    GAPA(C0 = MF32(kf[0], qr[0], zero16), P0[2], P0[3], P0[4], P0[5],     pw0[0] = PKW(P0, 0), pw0[1] = PKW(P0, 2), pw0); \
    GAPA(C1 = MF32(kf[1], qr[0], zero16), P0[6], P0[7], P0[8], P0[9],     pw0[2] = PKW(P0, 4), pw0[3] = PKW(P0, 6), pw0); \
    GAPA(C0 = MF32(kf[2], qr[1], C0),     P0[10], P0[11], P0[12], P0[13], pw1[0] = PKW(P0, 8), pw1[1] = PKW(P0, 10), pw1); \
    GAPA(C1 = MF32(kf[3], qr[1], C1),     P0[14], P0[15], P1[0], P1[1],   pw1[2] = PKW(P0, 12), pw1[3] = PKW(P0, 14), pw1); \
    VRD2(f0, 0); SBAR();  GAPA(C0 = MF32(kf[4], qr[2], C0), P1[2], P1[3], P1[4], P1[5],     pw2[0] = PKW(P1, 0), pw2[1] = PKW(P1, 2), pw2); \
    VRD2(f1, 4); SBAR();  GAPA(C1 = MF32(kf[5], qr[2], C1), P1[6], P1[7], P1[8], P1[9],     pw2[2] = PKW(P1, 4), pw2[3] = PKW(P1, 6), pw2); \
    VRD2(f2, 8); SBAR();  GAPA(C0 = MF32(kf[6], qr[3], C0), P1[10], P1[11], P1[12], P1[13], pw3[0] = PKW(P1, 8), pw3[1] = PKW(P1, 10), pw3); \
    VRD2(f3, 12); SBAR(); GAPA(C1 = MF32(kf[7], qr[3], C1), P1[14], P1[15], 0.f, 0.f,       pw3[2] = PKW(P1, 12), pw3[3] = PKW(P1, 14), pw3); \
    l_reg += sacc; __builtin_amdgcn_s_setprio(0); \
    if (GK) { DMA_K((t) + 3, sl_cur); } if (GV) { DMA_V((t) + 2, vs_wr); } \
    CMASK(C0, C1, t); \
    SBAR(); __builtin_amdgcn_s_setprio(ATTN_PRIO_B); \
    GAPB(o[0] = MF32(PAF(0), VFR2(f0), o[0]), VRD2(f0, 1),  C0, 0); \
    GAPB(o[1] = MF32(PAF(0), VFR2(f1), o[1]), VRD2(f1, 5),  C0, 2); \
    GAPB(o[2] = MF32(PAF(0), VFR2(f2), o[2]), VRD2(f2, 9),  C0, 4); \
    GAPB(o[3] = MF32(PAF(0), VFR2(f3), o[3]), VRD2(f3, 13), C0, 6); \
    KRD(GL, 0); GAPB(o[0] = MF32(PAF(1), VFR2(f0), o[0]), VRD2(f0, 2),  C0, 8); \
    GAPB(o[1] = MF32(PAF(1), VFR2(f1), o[1]), VRD2(f1, 6),  C0, 10); \
    KRD(GL, 1); GAPB(o[2] = MF32(PAF(1), VFR2(f2), o[2]), VRD2(f2, 10), C0, 12); \
    GAPB(o[3] = MF32(PAF(1), VFR2(f3), o[3]), VRD2(f3, 14), C0, 14); \
    KRD(GL, 2); GAPB(o[0] = MF32(PAF(2), VFR2(f0), o[0]), VRD2(f0, 3),  C1, 0); \
    GAPB(o[1] = MF32(PAF(2), VFR2(f1), o[1]), VRD2(f1, 7),  C1, 2); \
    KRD(GL, 3); GAPB(o[2] = MF32(PAF(2), VFR2(f2), o[2]), VRD2(f2, 11), C1, 4); \
    GAPB(o[3] = MF32(PAF(2), VFR2(f3), o[3]), VRD2(f3, 15), C1, 6); \
    GAPB(o[0] = MF32(PAF(3), VFR2(f0), o[0]), (void)0, C1, 8); \
    GAPB(o[1] = MF32(PAF(3), VFR2(f1), o[1]), (void)0, C1, 10); \
    GAPB(o[2] = MF32(PAF(3), VFR2(f2), o[2]), (void)0, C1, 12); \
    GAPB(o[3] = MF32(PAF(3), VFR2(f3), o[3]), (void)0, C1, 14); __builtin_amdgcn_s_setprio(0); \
    } while (0)
    int t = 1;
#undef CMASK
#define CMASK(P0, P1, t) do {} while (0)
    for (; t + 5 < NT; t += 2) {
        STEP(pB0, pB1, pA0, pA1, t, true, true, true);     WAIT_BAR(5); ROT();
        STEP(pA0, pA1, pB0, pB1, t + 1, true, true, true); WAIT_BAR(5); ROT();
    }
#undef CMASK
#define CMASK(P0, P1, t) do { if (MASK) { int jb_ = (t) - (NT - 4); if (jb_ >= 0) cmask(P0, P1, jb_, wid); } } while (0)
#define ENDW(tt) do { if ((tt) + 3 < NT) { WAIT_BAR(5); } else if ((tt) + 2 < NT) { WAIT_BAR(4); } else { WAIT_BAR(0); } } while (0)
    for (; t + 1 < NT; t += 2) {
        STEP(pB0, pB1, pA0, pA1, t, (t + 3 < NT), (t + 2 < NT), (t + 1 < NT));       ENDW(t);     ROT();
        STEP(pA0, pA1, pB0, pB1, t + 1, (t + 4 < NT), (t + 3 < NT), (t + 2 < NT));   ENDW(t + 1); ROT();
    }
    STEP(pB0, pB1, pA0, pA1, NT - 1, false, false, false);
    { float sacc = pB0[0] + pB0[1]; _Pragma("unroll") for (int r = 2; r < 16; ++r) sacc += pB0[r]; _Pragma("unroll") for (int r = 0; r < 16; ++r) sacc += pB1[r]; l_reg += sacc;
      pw0 = (u32x4){PKW(pB0, 0), PKW(pB0, 2), PKW(pB0, 4), PKW(pB0, 6)}; pw1 = (u32x4){PKW(pB0, 8), PKW(pB0, 10), PKW(pB0, 12), PKW(pB0, 14)}; pw2 = (u32x4){PKW(pB1, 0), PKW(pB1, 2), PKW(pB1, 4), PKW(pB1, 6)}; pw3 = (u32x4){PKW(pB1, 8), PKW(pB1, 10), PKW(pB1, 12), PKW(pB1, 14)};
      SBAR();
      const lds_cptr vp_ = vp0 + ((vs_rd + 16384) & 65535);
#pragma unroll
      for (int db = 0; db < 4; ++db) { VRD2(f0, db * 4 + 0); VRD2(f1, db * 4 + 1); VRD2(f2, db * 4 + 2); VRD2(f3, db * 4 + 3);
          o[db] = MF32(PAF(0), VFR2(f0), o[db]); o[db] = MF32(PAF(1), VFR2(f1), o[db]); o[db] = MF32(PAF(2), VFR2(f2), o[db]); o[db] = MF32(PAF(3), VFR2(f3), o[db]); } }
#undef PKW
#undef PAF
#undef PIN
#undef EX
#undef VOFF
#undef VRD2
#undef VFR2
#undef GAPA
#undef GAPB
#undef KRD
#undef MF32
#undef STEP
#undef ENDW
    { auto rr = __builtin_amdgcn_permlane32_swap(__float_as_uint(l_reg), __float_as_uint(l_reg), false, false); l_reg = __uint_as_float(rr[0]) + __uint_as_float(rr[1]); }
    if (hi == 0) wsf[32 + r32] = l_reg; asm volatile("s_waitcnt lgkmcnt(0)" ::: "memory");
    float rli[16];
#pragma unroll
    for (int r = 0; r < 16; ++r) rli[r] = __builtin_amdgcn_rcpf(wsf[32 + crow(r, hi)]);
    bf16* Ow = Oh + (long)(q0 + wid * QBLK) * op;
    { bf16* stg = (bf16*)(shm + L2_OST) + wid * 2048;
#pragma unroll
      for (int dh = 0; dh < 2; ++dh) {
#pragma unroll
        for (int r = 0; r < 16; ++r) { const int orow = crow(r, hi);
#pragma unroll
          for (int d0 = 0; d0 < 2; ++d0) stg[orow * 64 + d0 * 32 + r32] = __float2bfloat16(o[dh * 2 + d0][r] * rli[r]); }
        asm volatile("s_waitcnt lgkmcnt(0)" ::: "memory");
#pragma unroll
        for (int i = 0; i < 4; ++i) { const int row = i * 8 + (lane >> 3), ch = lane & 7; const u32x4 v = *(const u32x4*)(stg + row * 64 + ch * 8); *(u32x4*)(Ow + (long)row * op + dh * 64 + ch * 8) = v; }
        asm volatile("s_waitcnt lgkmcnt(0)" ::: "memory"); } }
    asm volatile("s_waitcnt lgkmcnt(0)\n\ts_barrier" ::: "memory");
#undef DMA_K
#undef DMA_V
#undef CMASK
#undef ROT
}
#undef SBAR
#undef WAIT_BAR
}

#define XB_TMO      128
#define XB_XCNT(j)  (256  + 64 * (j))
#define XB_XSUB(j)  (1280 + 64 * (j))
#define XB_XGEN(j)  (2304 + 64 * (j))
#define XB_TOP      3328
#define XB_TOPGEN   3392
#define XCD_BAR_WORDS 3456
#define XB_SPIN_CAP (1u << 22)
__device__ __forceinline__ unsigned xb_ld(unsigned* p)              { return __hip_atomic_load(p, __ATOMIC_RELAXED, __HIP_MEMORY_SCOPE_AGENT); }
__device__ __forceinline__ unsigned xb_add(unsigned* p, unsigned v) { return __hip_atomic_fetch_add(p, v, __ATOMIC_RELAXED, __HIP_MEMORY_SCOPE_AGENT); }
__device__ __forceinline__ unsigned xb_xcc_id() { return (unsigned)__builtin_amdgcn_s_getreg((3 << 11) | 20) & 0xFu; }
#define XB_SPIN(cond, bar) do { unsigned _sp = 0; while (cond) { __builtin_amdgcn_s_sleep(1); \
    if ((++_sp & 255u) == 0u) { if (xb_ld(&(bar)[XB_TMO])) break; if (_sp > XB_SPIN_CAP) { atomicAdd(&(bar)[XB_TMO], 1u); break; } } } } while (0)
struct XcdBarrier { unsigned* bar; unsigned x; volatile LAS unsigned* st; };
__device__ __forceinline__ XcdBarrier xcd_barrier_post(unsigned* bar, volatile LAS unsigned* st) {
    XcdBarrier b; b.bar = bar; b.x = xb_xcc_id(); b.st = st;
    if (threadIdx.x == 0) (void)xb_add(&bar[XB_XCNT(b.x)], 1u);
    return b;
}
__device__ __forceinline__ void xcd_barrier_complete(unsigned* bar, unsigned x, unsigned& nloc, unsigned& nx) {
    const unsigned G = gridDim.x * gridDim.y * gridDim.z;
    unsigned sum, cnt, mine, sp = 0u;
    for (;;) {
        sum = 0u; cnt = 0u; mine = 0u;
#pragma unroll
        for (unsigned j = 0; j < 16; ++j) { const unsigned c = xb_ld(&bar[XB_XCNT(j)]); sum += c; cnt += (c > 0u) ? 1u : 0u; mine = (j == x) ? c : mine; }
        if (sum == G) break;
        __builtin_amdgcn_s_sleep(1);
        if ((++sp & 255u) == 0u) { if (xb_ld(&bar[XB_TMO])) break; if (sp > XB_SPIN_CAP) { atomicAdd(&bar[XB_TMO], 1u); break; } }
    }
    nloc = mine > 0u ? mine : 1u; nx = cnt > 0u ? cnt : 1u;
}
__device__ __forceinline__ void xcd_barrier(const XcdBarrier& b) {
    asm volatile("s_waitcnt vmcnt(0)" ::: "memory");
    __syncthreads();
    if (threadIdx.x == 0) {
        unsigned* bar = b.bar;
        __builtin_amdgcn_s_waitcnt(0);
        unsigned nloc = b.st[0], nx = b.st[1];
        if (nloc == 0u) { xcd_barrier_complete(bar, b.x, nloc, nx); b.st[0] = nloc; b.st[1] = nx; }
        const unsigned old = xb_add(&bar[XB_XSUB(b.x)], 1u);
        const unsigned gen = old / nloc;
        if (old + 1u == (gen + 1u) * nloc) {
            __builtin_amdgcn_fence(__ATOMIC_RELEASE, "agent");
            asm volatile("s_waitcnt vmcnt(0)" ::: "memory");
            const unsigned og = xb_add(&bar[XB_TOP], 1u);
            const unsigned tg = og / nx;
            if (og + 1u == (tg + 1u) * nx) xb_add(&bar[XB_TOPGEN], 1u);
            else XB_SPIN(xb_ld(&bar[XB_TOPGEN]) == tg, bar);
            __builtin_amdgcn_fence(__ATOMIC_ACQUIRE, "agent");
            xb_add(&bar[XB_XGEN(b.x)], 1u);
            asm volatile("s_waitcnt vmcnt(0)" ::: "memory");
        } else {
            XB_SPIN(xb_ld(&bar[XB_XGEN(b.x)]) == gen, bar);
            __builtin_amdgcn_fence(__ATOMIC_ACQUIRE, "agent");
            asm volatile("s_waitcnt vmcnt(0)" ::: "memory");
        }
    }
    __syncthreads();
}

constexpr int RING_BYTES = 131072;
constexpr int MISC_OFF = RING_BYTES;
constexpr int LDS_BYTES = 147456;
constexpr int NWAVES = 8;

struct Args {
    const float* in[29]; float* out; unsigned char* ws; int ph_lo, ph_hi;
};
enum { I_X = 0, I_MEM, I_NORM1, I_WIN, I_BGATE, I_QN, I_KN, I_LQ1, I_LK1, I_LQ2, I_LK2, I_SUBLN, I_WPOOL, I_PSCALE, I_MEMNORM, I_WMKV, I_MQN, I_MKN, I_WBRD, I_WBRP, I_WBRM, I_WOUT, I_NORM2,
       I_WROUTER, I_BROUTER, I_WGU, I_BGU, I_WD, I_BD };

__device__ __forceinline__ unsigned f2bf(float f) { unsigned u = __builtin_bit_cast(unsigned, f); return (u + 0x7fffu + ((u >> 16) & 1u)) >> 16; }
__device__ __forceinline__ unsigned pk2(float lo, float hi) { return f2bf(lo) | (f2bf(hi) << 16); }
__device__ __forceinline__ void p0_transpose_item(const float* W, int K, int N, bf16_t* WT, LAS float* scr, int item, int lane, int ldo = 0) {
    if (ldo == 0) ldo = K;
    const int nblk = N / 64, kb = item / nblk, nb = item % nblk, k0 = 64 * kb, n0 = 64 * nb;
    const int kr = lane >> 3, n4 = (lane & 7) * 4;
    f32x4 v[16];
#pragma unroll
    for (int i = 0; i < 16; ++i) v[i] = *(const f32x4*)(W + (size_t)(k0 + 8 * (i & 7) + kr) * N + n0 + 32 * (i >> 3) + n4);
#pragma unroll
    for (int h = 0; h < 2; ++h) {
#pragma unroll
        for (int i = 0; i < 8; ++i)
#pragma unroll
            for (int j = 0; j < 4; ++j) scr[(n4 + j) * 68 + 8 * i + kr] = v[h * 8 + i][j];
        LDS_WAIT(); asm volatile("" ::: "memory");
        const int c = lane & 7;
#pragma unroll
        for (int jj = 0; jj < 4; ++jj) { const int nrow = 8 * jj + (lane >> 3); const LAS f32x4* sp = (const LAS f32x4*)(scr + nrow * 68 + 8 * c);
            const f32x4 a = sp[0], b = sp[1];
            u32x4 o; o.x = pk2(a[0], a[1]); o.y = pk2(a[2], a[3]); o.z = pk2(b[0], b[1]); o.w = pk2(b[2], b[3]);
            *(u32x4*)(WT + (size_t)(n0 + 32 * h + nrow) * ldo + k0 + 8 * c) = o; }
        LDS_WAIT(); asm volatile("" ::: "memory");
    }
}
__device__ __forceinline__ void p0_transpose_item_f8(const float* W, int K, int N, unsigned char* WT, LAS float* scr, int item, int lane) {
    const int nblk = N / 64, kb = item / nblk, nb = item % nblk, k0 = 64 * kb, n0 = 64 * nb;
    const int kr = lane >> 3, n4 = (lane & 7) * 4;
    f32x4 v[16];
#pragma unroll
    for (int i = 0; i < 16; ++i) v[i] = *(const f32x4*)(W + (size_t)(k0 + 8 * (i & 7) + kr) * N + n0 + 32 * (i >> 3) + n4);
#pragma unroll
    for (int h = 0; h < 2; ++h) {
#pragma unroll
        for (int i = 0; i < 8; ++i)
#pragma unroll
            for (int j = 0; j < 4; ++j) scr[(n4 + j) * 68 + 8 * i + kr] = v[h * 8 + i][j];
        LDS_WAIT(); asm volatile("" ::: "memory");
        const int c = lane & 7;
#pragma unroll
        for (int jj = 0; jj < 4; ++jj) { const int nrow = 8 * jj + (lane >> 3); const LAS f32x4* sp = (const LAS f32x4*)(scr + nrow * 68 + 8 * c);
            const f32x4 a = sp[0] * W8_SCALE, b = sp[1] * W8_SCALE;
            u32x2 o; o.x = pk4_fp8(a[0], a[1], a[2], a[3]); o.y = pk4_fp8(b[0], b[1], b[2], b[3]);
            *(u32x2*)(WT + (size_t)(n0 + 32 * h + nrow) * K + k0 + 8 * c) = o; }
        LDS_WAIT(); asm volatile("" ::: "memory");
    }
}
__device__ __forceinline__ void rms_row_to_bf16(const float* xrow, const float* gain, bf16_t* orow, int lane) {
    const f32x4* xr = (const f32x4*)xrow + lane; const f32x4* gr = (const f32x4*)gain + lane;
    f32x4 v[4]; float s = 0.f;
#pragma unroll
    for (int j = 0; j < 4; ++j) { v[j] = xr[64 * j]; s += (v[j].x * v[j].x + v[j].y * v[j].y) + (v[j].z * v[j].z + v[j].w * v[j].w); }
    const float rstd = 1.f / sqrtf(wave_sum(s) * (1.f / 1024.f) + RMS_EPS);
    u32x2* o8 = (u32x2*)orow + lane;
#pragma unroll
    for (int j = 0; j < 4; ++j) { const f32x4 g = gr[64 * j]; u32x2 w; w.x = pk2(v[j].x * rstd * g.x, v[j].y * rstd * g.y); w.y = pk2(v[j].z * rstd * g.z, v[j].w * rstd * g.w); o8[64 * j] = w; }
}

struct Args;
typedef __attribute__((address_space(4))) const Args* kargs_t;
__device__ __forceinline__ kargs_t kargs() { kargs_t p = (kargs_t)__builtin_amdgcn_kernarg_segment_ptr(); asm volatile("" : "+s"(p)); return p; }
__global__ void __launch_bounds__(NWAVES * 64, 2) fwd_kernel(Args args) {
    extern __shared__ __attribute__((aligned(16))) unsigned char lds_raw[];
    cg::grid_group grid = cg::this_grid();
    LAS unsigned char* lds = (LAS unsigned char*)lds_raw;
    const int tid = threadIdx.x, lane = tid & 63, wave = __builtin_amdgcn_readfirstlane(tid >> 6);
    const int G = gridDim.x, bx = blockIdx.x; const int vcu = (G % 8 == 0) ? (bx % 8) * (G / 8) + bx / 8 : bx;
    const int gw = vcu * NWAVES + wave, NGW = G * NWAVES;
    const int lo = args.ph_lo, hi = args.ph_hi;
    if (tid < 64) ((LAS unsigned*)(lds + MISC_OFF + 1024))[tid] = 0u;
    __syncthreads();
    const XcdBarrier xbar = xcd_barrier_post((unsigned*)(args.ws + WS_CTL) + CW_BAR, (volatile LAS unsigned*)(lds + MISC_OFF + 1024));
#ifndef PHMASK
#define PHMASK 0x3ff
#endif
#define IN(k) (((PHMASK >> (k)) & 1) && lo <= (k) && (k) < hi)
#define GSYNC() do { asm volatile("s_waitcnt vmcnt(0) lgkmcnt(0)" ::: "memory"); __syncthreads(); grid.sync(); asm volatile("s_waitcnt vmcnt(0)" ::: "memory"); __syncthreads(); } while (0)
#define SEAM(k) do { if (lo <= (k) && (k) + 1 < hi) { xcd_barrier(xbar); } } while (0)
#define WSP(TY, off) ((TY*)(ka->ws + (off)))
#define WIN_T WSP(bf16_t, WS_WIN_T)
#define WBRD_T WSP(bf16_t, WS_WBRD_T)
#define WBRP_T WSP(bf16_t, WS_WBRP_T)
#define WBRM_T WSP(bf16_t, WS_WBRM_T)
#define WOUT_T WSP(bf16_t, WS_WOUT_T)
#define WMKV_T WSP(bf16_t, WS_WMKV_T)
#define WGU_T WSP(bf16_t, WS_WGU_T)
#define WD_T WSP(bf16_t, WS_WD_T)
#define XN WSP(bf16_t, WS_XN)
#define Qb WSP(bf16_t, WS_Q)
#define Kb WSP(bf16_t, WS_K)
#define Vb WSP(bf16_t, WS_V)
#define Ub WSP(bf16_t, WS_U)
#define MQb WSP(bf16_t, WS_MQ)
#define OC WSP(bf16_t, WS_OC)
#define GATES WSP(bf16_t, WS_GATES)
#define YCAT WSP(bf16_t, WS_YCAT)
#define MERGF WSP(float, WS_MERGF)
#define MERGB WSP(bf16_t, WS_MERGB)
#define XG WSP(bf16_t, WS_XG)
#define ACT WSP(bf16_t, WS_A)
#define Y4 WSP(bf16_t, WS_B)
#define MEMN WSP(bf16_t, WS_MEMN)
#define MKV WSP(bf16_t, WS_MKV)
#define ROPE WSP(f32x2, WS_ROPE)
#define WR2 WSP(float, WS_WR2)
#define ROUTEW WSP(float, WS_ROUTEW)
#define LAMP WSP(float, WS_LAM)
#define LIST WSP(u32x2, WS_LIST)
#define CNT WSP(unsigned, WS_CTL)
#define OUT (ka->out)
#define KA const kargs_t ka = kargs()

    if (lo > 1000) GSYNC();
    if (IN(0)) for (int rep_ = 0; rep_ < 1 + ((REPEAT_MASK >> 0) & 1); ++rep_) { KA; if (rep_) __syncthreads();
        LAS float* scr = (LAS float*)(lds + wave * 16384);
        constexpr int I0 = 16 * 80, I1 = 8 * 16, I2 = 4 * 16, I3 = 4 * 16, I4 = 16 * 16, I5 = 16 * 8, I6 = 32 * 512, I7 = 32 * 256;
        constexpr int NITEMS = I0 + I1 + I2 + I3 + I4 + I5 + I6 + I7;
        for (int it = gw; it < NITEMS; it += NGW) {
            int r = it;
            if (r < I0) { p0_transpose_item(ka->in[I_WIN], 1024, 5120, WIN_T, scr, r, lane); continue; } r -= I0;
            if (r < I1) { p0_transpose_item(ka->in[I_WBRD], 512, 1024, WBRD_T, scr, r, lane, 1024); continue; } r -= I1;
            if (r < I2) { p0_transpose_item(ka->in[I_WBRP], 256, 1024, WBRD_T + 512, scr, r, lane, 1024); continue; } r -= I2;
            if (r < I3) { p0_transpose_item(ka->in[I_WBRM], 256, 1024, WBRD_T + 768, scr, r, lane, 1024); continue; } r -= I3;
            if (r < I4) { p0_transpose_item(ka->in[I_WOUT], 1024, 1024, WOUT_T, scr, r, lane); continue; } r -= I4;
            if (r < I5) { p0_transpose_item(ka->in[I_WMKV], 1024, 512, WMKV_T, scr, r, lane); continue; } r -= I5;
            if (r < I6) { const int e = r >> 9; p0_transpose_item_f8(ka->in[I_WGU] + (size_t)e * 1024 * 2048, 1024, 2048, (unsigned char*)WGU_T + (size_t)e * 2048 * 1024, scr, r & 511, lane); continue; } r -= I6;
            { const int e = r >> 8; p0_transpose_item_f8(ka->in[I_WD] + (size_t)e * 1024 * 1024, 1024, 1024, (unsigned char*)WD_T + (size_t)e * 1024 * 1024, scr, r & 255, lane); }
        }
        for (int m = gw; m < T; m += NGW) rms_row_to_bf16(ka->in[I_X] + (size_t)m * 1024, ka->in[I_NORM1], XN + (size_t)m * 1024, lane);
        for (int m = gw; m < BATCH * MEMLEN; m += NGW) rms_row_to_bf16(ka->in[I_MEM] + (size_t)m * 1024, ka->in[I_MEMNORM], MEMN + (size_t)m * 1024, lane);
        for (int i = bx * 512 + tid; i < SEQ * 32; i += G * 512) { const int pos = i >> 5, j = i & 31;
            const float inv = 1.0f / powf(10000.0f, (float)(2 * j) / 64.0f); const float ang = (float)pos * inv;
            const double a = (double)ang; const double k = rint(a * 0.15915494309189535); const float red = (float)(a - k * 6.283185307179586);
            ROPE[i] = (f32x2){cosf(red), sinf(red)}; }
        for (int i = bx * 512 + tid; i < 1024 * 32; i += G * 512) { const int ii = i & 3, e = (i >> 2) & 15, kq = (i >> 6) & 3, eb = (i >> 8) & 1, s = i >> 9; const int k = 16 * s + 4 * kq + ii;
            WR2[i] = ka->in[I_NORM2][k] * ka->in[I_WROUTER][k * 32 + eb * 16 + e]; }
        if (bx == 0 && wave == 0) { const float s1 = wave_sum(ka->in[I_LQ1][lane] * ka->in[I_LK1][lane]), s2 = wave_sum(ka->in[I_LQ2][lane] * ka->in[I_LK2][lane]);
            if (lane == 0) LAMP[0] = expf(s1) - expf(s2) + 0.2f; }
    }
    SEAM(0);
    if (IN(1)) for (int rep_ = 0; rep_ < 1 + ((REPEAT_MASK >> 1) & 1); ++rep_) { KA; if (rep_) __syncthreads();
#if defined(TAP) && TAP == 6
        { pg8::DenseProb P{XN, WIN_T, 1024, 1024, 1024}; pg8::StaticOrder S; S.init(T, INW, G, bx);
          pg8::EpiPlain E{WSP(bf16_t, WS_B), 5120};
          pg8::gemm_phase<pg8::EpiPlain, pg8::DenseProb, pg8::StaticOrder, true>(lds, P, S, E); }
#else
        { pg8::DenseProb P{XN, WIN_T, 1024, 1024, 1024}; pg8::StaticOrder S0; S0.init(T, INW, G, bx); const pg8::TableOrder S = pg8::build_unit_table(S0, (LAS int*)(lds + MISC_OFF + 2048));
          pg8::EpiInProj E{Qb, Kb, Vb, Ub, MQb, GATES, ka->in[I_QN], ka->in[I_KN], ka->in[I_MQN], ka->in[I_BGATE], ROPE};
          pg8::gemm_phase<pg8::EpiInProj, pg8::DenseProb, pg8::TableOrder, ALIGN_EPI_SEL>(lds, P, S, E); }
#endif
        { pg8::DenseProb P{MEMN, WMKV_T, 1024, 1024, 1024}; pg8::StaticOrder S; S.init(BATCH * MEMLEN, 512, G, bx);
          pg8::EpiMemKV E{MKV, ka->in[I_MKN]};
          pg8::gemm_phase<pg8::EpiMemKV, pg8::DenseProb, pg8::StaticOrder, true>(lds, P, S, E); }
    }
    SEAM(1);
    if (IN(2)) for (int rep_ = 0; rep_ < 1 + ((REPEAT_MASK >> 2) & 1); ++rep_) { KA; if (rep_) __syncthreads();
        using abf = attn_body::bf16;
        {
            const int bh = vcu >> 4, b = bh >> 2, h = bh & 3, s = vcu & 15; const size_t rb = (size_t)b * SEQ;
            const float lam = LAMP[0];
            for (int i2 = 0; i2 < 4 * (1 + ((REPEAT_MASK >> 10) & 1)); ++i2) { const int ii = i2 & 3, c = ii & 1; const int qb = (ii < 2) ? s : 31 - s;
                attn_body::attn_unit2<true>(qb * 256, 4 * qb + 4, (const abf*)Qb + rb * 512 + (c * 4 + h) * 64, 512, (const abf*)Kb + rb * 512 + (c * 4 + h) * 64, 512,
                                            (const abf*)Vb + rb * 512 + h * 128, 512, (abf*)OC + rb * 1024 + (c * 4 + h) * 128, 1024, (char*)lds_raw);
                if (c == 1) {
                    asm volatile("s_waitcnt vmcnt(0)" ::: "memory");
#pragma unroll 1
                    for (int ps = 0; ps < 2; ++ps) {
                    const int row = ps * 16 + (lane >> 2), dq = (lane & 3) * 32; const size_t t = rb + (size_t)qb * 256 + wave * 32 + row;
                    const bf16_t* p0 = OC + t * 1024 + h * 128 + dq; const bf16_t* p1 = p0 + 512;
                    u32x4 a[4], bb[4];
#pragma unroll
                    for (int j = 0; j < 4; ++j) { a[j] = *(const u32x4*)(p0 + 8 * j); bb[j] = *(const u32x4*)(p1 + 8 * j); }
                    float ss = 0.f; f32x4 y[4][2];
#pragma unroll
                    for (int j = 0; j < 4; ++j) {
                        y[j][0] = (f32x4){bf_lo(a[j].x) - lam * bf_lo(bb[j].x), bf_hi(a[j].x) - lam * bf_hi(bb[j].x), bf_lo(a[j].y) - lam * bf_lo(bb[j].y), bf_hi(a[j].y) - lam * bf_hi(bb[j].y)};
                        y[j][1] = (f32x4){bf_lo(a[j].z) - lam * bf_lo(bb[j].z), bf_hi(a[j].z) - lam * bf_hi(bb[j].z), bf_lo(a[j].w) - lam * bf_lo(bb[j].w), bf_hi(a[j].w) - lam * bf_hi(bb[j].w)};
#pragma unroll
                        for (int q = 0; q < 4; ++q) ss += y[j][0][q] * y[j][0][q] + y[j][1][q] * y[j][1][q]; }
                    ss += __shfl_xor(ss, 1); ss += __shfl_xor(ss, 2);
                    const float rstd = 0.8f / sqrtf(ss * (1.0f / 128.0f) + RMS_EPS);
                    const float* sg = ka->in[I_SUBLN] + dq; bf16_t* yo = YCAT + t * 1024 + h * 128 + dq;
#pragma unroll
                    for (int j = 0; j < 4; ++j) { const f32x4 s0 = *(const f32x4*)(sg + 8 * j), s1 = *(const f32x4*)(sg + 8 * j + 4); pg8::store8(yo + 8 * j, y[j][0] * rstd * s0, y[j][1] * rstd * s1); }
                    }
                }
            }
        }
        {
            for (int i = 0; i < 2; ++i) { const int idx = vcu * 2 + i; if (idx >= 512) break; const int b = idx >> 7, h = (idx >> 5) & 3, qb = idx & 31;
                attn_body::attn_unit<8, false>(qb * 256, 4, (const abf*)MQb + (size_t)b * SEQ * 256 + h * 64, 256, (const abf*)MKV + (size_t)b * MEMLEN * 512 + h * 64, 512,
                                               (const abf*)MKV + (size_t)b * MEMLEN * 512 + 256 + h * 64, 512, (abf*)YCAT + (size_t)b * SEQ * 1024 + 768 + h * 64, 1024, (char*)lds_raw); }
        }
        {
            LAS bf16_t* ul = (LAS bf16_t*)lds;
            LAS bf16_t* pb = (LAS bf16_t*)(lds + 24576);
            const int col = tid & 255, half = tid >> 8, w = 2 << (col >> 6);
            const int mg = wave & 3, mdh = wave >> 2, r32 = lane & 31, hh = lane >> 5;
            bf16x8 bw[4];
#pragma unroll
            for (int sx = 0; sx < 4; ++sx) { const float* wp = ka->in[I_WPOOL] + (size_t)(mg * 64 + 16 * sx + 8 * hh) * 64 + mdh * 32 + r32;
                u32x4 pk; pk.x = pk2(wp[0], wp[64]); pk.y = pk2(wp[128], wp[192]); pk.z = pk2(wp[256], wp[320]); pk.w = pk2(wp[384], wp[448]); bw[sx] = __builtin_bit_cast(bf16x8, pk); }
            const int ocol = mg * 64 + mdh * 32 + r32; const float psc = ka->in[I_PSCALE][ocol];
            for (int tile = vcu; tile < T / 32; tile += G) {
                const int t0 = tile * 32, p0 = t0 & (SEQ - 1);
                __syncthreads();
                for (int pc = tid; pc < 47 * 32; pc += 512) { const int r = pc >> 5, ch = pc & 31; const int pos = p0 - 15 + r;
                    u32x4 v = {0u, 0u, 0u, 0u}; if (pos >= 0) v = *(const u32x4*)(Ub + (size_t)(t0 - 15 + r) * 256 + ch * 8);
                    *(LAS u32x4*)(ul + r * 256 + ch * 8) = v; }
                __syncthreads();
                {
                    float sum = 0.f; const int rbase = 15 + 16 * half;
                    for (int i = 1; i < w; ++i) sum += __uint_as_float((unsigned)ul[(rbase - i) * 256 + col] << 16);
#pragma unroll
                    for (int tk = 0; tk < 16; ++tk) { const float ucur = __uint_as_float((unsigned)ul[(rbase + tk) * 256 + col] << 16); sum += ucur;
                        const int pos = p0 + 16 * half + tk; const float cnt = (float)((pos + 1 < w) ? pos + 1 : w);
                        pb[(16 * half + tk) * 264 + col] = (bf16_t)f2bf(sum / cnt - ucur);
                        sum -= __uint_as_float((unsigned)ul[(rbase + tk - (w - 1)) * 256 + col] << 16); }
                }
                __syncthreads();
                f32x16 acc = f32x16{};
#pragma unroll
                for (int sx = 0; sx < 4; ++sx) { const bf16x8 af = *(const LAS bf16x8*)(pb + r32 * 264 + mg * 64 + 16 * sx + 8 * hh);
                    acc = __builtin_amdgcn_mfma_f32_32x32x16_bf16(af, bw[sx], acc, 0, 0, 0); }
#pragma unroll
                for (int r = 0; r < 16; ++r) { const int tok = t0 + (r & 3) + 8 * (r >> 2) + 4 * hh; YCAT[(size_t)tok * 1024 + 512 + ocol] = (bf16_t)f2bf(acc[r] * psc); }
            }
            __syncthreads();
        }
    }
    SEAM(2);
    if (IN(4)) for (int rep_ = 0; rep_ < 1 + ((REPEAT_MASK >> 4) & 1); ++rep_) { KA; if (rep_) __syncthreads();
        pg8::StaticOrder S0; S0.init(T, 1024, G, bx); const pg8::TableOrder S = pg8::build_unit_table(S0, (LAS int*)(lds + MISC_OFF + 2048));
        pg8::DenseProb P{YCAT, WBRD_T, 1024, 1024, 1024}; pg8::EpiMergeR E{GATES, MERGB};
        pg8::gemm_phase<pg8::EpiMergeR, pg8::DenseProb, pg8::TableOrder, ALIGN_EPI_SEL>(lds, P, S, E);
    }
    SEAM(4);
    if (IN(5)) for (int rep_ = 0; rep_ < 1 + ((REPEAT_MASK >> 5) & 1); ++rep_) { KA; if (rep_) __syncthreads();
        pg8::DenseProb P{MERGB, WOUT_T, 1024, 1024, 1024}; pg8::StaticOrder S0; S0.init(T, 1024, G, bx); const pg8::TableOrder S = pg8::build_unit_table(S0, (LAS int*)(lds + MISC_OFF + 2048));
        pg8::EpiWout E{ka->in[I_X], OUT, (unsigned char*)XG, ka->in[I_NORM2]};
        pg8::gemm_phase<pg8::EpiWout, pg8::DenseProb, pg8::TableOrder, ALIGN_EPI_SEL>(lds, P, S, E);
    }
    SEAM(5);
    if (IN(6)) { KA;
        LAS int* lcnt = (LAS int*)(lds + MISC_OFF); LAS int* lbase = lcnt + 32;
        const int ngroups = T / 16, rounds = (ngroups + NGW - 1) / NGW;
        for (int rd = 0; rd < rounds; ++rd) {
            const int grp = rd * NGW + gw; const bool valid = grp < ngroups;
            if (tid < 32) lcnt[tid] = 0;
            __syncthreads();
            int e_sel = 0, rank = 0; float w_sel = 0.f, rstd = 0.f; const int q = lane >> 4, tok = grp * 16 + (lane & 15);
            if (valid) {
                f32x4 d0 = {0.f, 0.f, 0.f, 0.f}, d1 = {0.f, 0.f, 0.f, 0.f}; float ss = 0.f;
                const float* xrow = OUT + (size_t)tok * 1024 + 4 * q; const f32x4* wr2 = (const f32x4*)WR2 + lane;
#pragma unroll 4
                for (int s = 0; s < 64; ++s) { const f32x4 xv = *(const f32x4*)(xrow + 16 * s); const f32x4 wa = wr2[(s * 2) * 64], wb = wr2[(s * 2 + 1) * 64];
                    ss += (xv[0] * xv[0] + xv[1] * xv[1]) + (xv[2] * xv[2] + xv[3] * xv[3]);
#pragma unroll
                    for (int j = 0; j < 4; ++j) { d0 = __builtin_amdgcn_mfma_f32_16x16x4f32(wa[j], xv[j], d0, 0, 0, 0); d1 = __builtin_amdgcn_mfma_f32_16x16x4f32(wb[j], xv[j], d1, 0, 0, 0); } }
                ss += __shfl_xor(ss, 16); ss += __shfl_xor(ss, 32);
                rstd = 1.0f / sqrtf(ss * (1.0f / 1024.f) + RMS_EPS);
                unsigned key[8];
#pragma unroll
                for (int r = 0; r < 8; ++r) { const int e = (r >> 2) * 16 + 4 * q + (r & 3); const float lg = ((r < 4) ? d0[r & 3] : d1[r & 3]) * rstd + ka->in[I_BROUTER][e];
                    unsigned u = __float_as_uint(lg); u ^= (u >> 31) ? 0xffffffffu : 0x80000000u; key[r] = (u & ~31u) | (unsigned)(31 - e); }
                unsigned win[4];
#pragma unroll
                for (int r = 0; r < 4; ++r) { unsigned m = key[0];
#pragma unroll
                    for (int j = 1; j < 8; ++j) m = m > key[j] ? m : key[j];
                    unsigned o = (unsigned)__shfl_xor((int)m, 16); m = m > o ? m : o; o = (unsigned)__shfl_xor((int)m, 32); m = m > o ? m : o; win[r] = m;
#pragma unroll
                    for (int j = 0; j < 8; ++j) key[j] = (key[j] == m) ? 0u : key[j]; }
                float val[4];
#pragma unroll
                for (int r = 0; r < 4; ++r) { unsigned u = win[r] & ~31u; u ^= (u >> 31) ? 0x80000000u : 0xffffffffu; val[r] = __uint_as_float(u); }
                const float p1 = expf(val[1] - val[0]), p2 = expf(val[2] - val[0]), p3 = expf(val[3] - val[0]); const float inv = 1.0f / (1.0f + p1 + p2 + p3);
                const unsigned wk = (q == 0) ? win[0] : (q == 1) ? win[1] : (q == 2) ? win[2] : win[3];
                w_sel = ((q == 0) ? 1.0f : (q == 1) ? p1 : (q == 2) ? p2 : p3) * inv; e_sel = 31 - (int)(wk & 31u);
                rank = __hip_atomic_fetch_add((int*)(lcnt + e_sel), 1, __ATOMIC_RELAXED, __HIP_MEMORY_SCOPE_WORKGROUP);
            }
            __syncthreads();
            if (tid < 32) lbase[tid] = (int)__hip_atomic_fetch_add(CNT + 64 * tid, (unsigned)lcnt[tid], __ATOMIC_RELAXED, __HIP_MEMORY_SCOPE_AGENT);
            __syncthreads();
            if (valid) { const int pos = lbase[e_sel] + rank; LIST[(size_t)e_sel * CAP + pos] = (u32x2){(unsigned)(tok * 4 + q), __float_as_uint(rstd)}; ROUTEW[tok * 4 + q] = w_sel; }
            __syncthreads();
        }
    }
    SEAM(6);
    if (IN(7) || IN(8)) { KA;
        LAS int* tp = (LAS int*)(lds + MISC_OFF + 256); LAS int* cn = tp + 40;
        if (tid == 0) { int acc = 0; for (int e = 0; e < NEXP; ++e) { const int c = (int)__hip_atomic_load(CNT + 64 * e, __ATOMIC_RELAXED, __HIP_MEMORY_SCOPE_AGENT); cn[e] = c; tp[e] = acc; acc += (c + 255) >> 8; } tp[NEXP] = acc; }
        __syncthreads();
        if (IN(7)) for (int rep_ = 0; rep_ < 1 + ((REPEAT_MASK >> 7) & 1); ++rep_) {
            pg8::GuProb P{(const unsigned char*)XG, (const unsigned char*)WGU_T, LIST, 1024, 1024, 1024}; pg8::GroupedOrder S0{tp, cn, 8, G, bx}; const pg8::TableOrder S = pg8::build_unit_table(S0, (LAS int*)(lds + MISC_OFF + 2048));
            pg8::EpiSwiglu E{(unsigned char*)ACT, LIST, ka->in[I_BGU]};
            pg8::gemm_phase<pg8::EpiSwiglu, pg8::GuProb, pg8::TableOrder, ALIGN_EPI_SEL>(lds, P, S, E);
        }
        SEAM(7);
        if (IN(8)) for (int rep_ = 0; rep_ < 1 + ((REPEAT_MASK >> 8) & 1); ++rep_) {
            pg8::DownProb P{(const unsigned char*)ACT, (const unsigned char*)WD_T, 1024, 1024, 1024}; pg8::GroupedOrder S0{tp, cn, 4, G, bx}; const pg8::TableOrder S = pg8::build_unit_table(S0, (LAS int*)(lds + MISC_OFF + 2048));
            pg8::EpiDown E{Y4, LIST, ka->in[I_BD]};
            pg8::gemm_phase<pg8::EpiDown, pg8::DownProb, pg8::TableOrder, ALIGN_EPI_SEL>(lds, P, S, E);
        }
    }
    SEAM(8);
    if (IN(9)) { KA;
        for (int i = bx * 512 + tid; i < T * 128; i += G * 512) { const int tok = i >> 7, c8 = (i & 127) * 8;
            const f32x4 w = *(const f32x4*)(ROUTEW + tok * 4); float* op = OUT + (size_t)tok * 1024 + c8;
            f32x4 o0 = *(const f32x4*)op, o1 = *(const f32x4*)(op + 4);
#pragma unroll
            for (int k = 0; k < 4; ++k) { const u32x4 y = *(const u32x4*)(Y4 + ((size_t)tok * 4 + k) * 1024 + c8); const float wk = w[k];
                o0[0] += wk * bf_lo(y.x); o0[1] += wk * bf_hi(y.x); o0[2] += wk * bf_lo(y.y); o0[3] += wk * bf_hi(y.y);
                o1[0] += wk * bf_lo(y.z); o1[1] += wk * bf_hi(y.z); o1[2] += wk * bf_lo(y.w); o1[3] += wk * bf_hi(y.w); }
            *(f32x4*)op = o0; *(f32x4*)(op + 4) = o1; }
    }
#ifdef TAP
    if (lo <= 10 && 10 < hi) { KA; GSYNC();
        for (int i = bx * 512 + tid; i < T * 1024; i += G * 512) { const int t = i >> 10, c = i & 1023; float v = 0.f;
#define BFV(buf, pitch, col) __uint_as_float((unsigned)(buf)[(size_t)t * (pitch) + (col)] << 16)
            if (TAP == 1) v = BFV(Qb, 512, c & 511) + 2.f * BFV(Kb, 512, c & 511) + 4.f * BFV(Vb, 512, c & 511) + 8.f * BFV(Ub, 256, c & 255) + 16.f * BFV(MQb, 256, c & 255)
                            + 32.f * BFV(GATES, 3072, c) + 64.f * BFV(GATES, 3072, 1024 + c) + 128.f * BFV(GATES, 3072, 2048 + c);
            if (TAP == 2) v = BFV(OC, 1024, c) + 2.f * BFV(YCAT, 1024, c);
            if (TAP == 3) v = BFV(MERGB, 1024, c);
            if (TAP == 4) v = BFV(XN, 1024, c);
            if (TAP == 6) { const bf16_t* z = WSP(bf16_t, WS_B) + (size_t)t * 5120 + c; v = __uint_as_float((unsigned)z[0] << 16) + 2.f * __uint_as_float((unsigned)z[1024] << 16) + 4.f * __uint_as_float((unsigned)z[2048] << 16) + 8.f * __uint_as_float((unsigned)z[3072] << 16) + 16.f * __uint_as_float((unsigned)z[4096] << 16); }
            if (TAP == 5) { const bf16_t* wt = WIN_T; const int tt = t % 5120; v = __uint_as_float((unsigned)wt[(size_t)tt * 1024 + c] << 16) + ROPE[(t & 8191) * 32 + (c & 31)].x + 2.f * ROPE[(t & 8191) * 32 + (c & 31)].y; }
            OUT[i] = v; }
    }
#endif
#undef IN
#undef SEAM
}

extern "C" void kernel_launch(void* const* d_in, const int* in_sizes, int n_in, void* d_out, int out_size, void* d_ws, size_t ws_size, hipStream_t stream) {
    static int grid = 0;
    if (grid == 0) {
        if (n_in != 29 || in_sizes[0] != T * DMODEL || out_size != T * DMODEL || ws_size < WS_END) {
            fprintf(stderr, "kernel_launch: unexpected shapes: n_in %d in0 %d out %d ws %zu (need %zu)\n", n_in, n_in > 0 ? in_sizes[0] : -1, out_size, ws_size, (size_t)WS_END); grid = -1; return; }
        int dev = 0, cus = 0, per_cu = 0;
        (void)hipGetDevice(&dev); (void)hipDeviceGetAttribute(&cus, hipDeviceAttributeMultiprocessorCount, dev);
        (void)hipFuncSetAttribute((const void*)fwd_kernel, hipFuncAttributeMaxDynamicSharedMemorySize, LDS_BYTES);
        (void)hipOccupancyMaxActiveBlocksPerMultiprocessor(&per_cu, (const void*)fwd_kernel, NWAVES * 64, LDS_BYTES);
        (void)hipGetLastError();
        grid = cus;
        fprintf(stderr, "kernel_launch: cus %d occupancy %d/CU grid %d\n", cus, per_cu, grid);
        if (per_cu < 1) fprintf(stderr, "kernel_launch: occupancy query says the kernel does not fit\n");
    }
    if (grid < 0) return;
    (void)hipMemsetAsync((char*)d_ws + WS_CTL, 0, CTL_ZERO_BYTES, stream);
    Args a{};
    for (int i = 0; i < 29; ++i) a.in[i] = (const float*)d_in[i];
    a.out = (float*)d_out; a.ws = (unsigned char*)d_ws; a.ph_lo = 0; a.ph_hi = PH_HI;
    void* args[] = {&a};
    hipError_t e = hipLaunchCooperativeKernel((const void*)fwd_kernel, dim3(grid), dim3(NWAVES * 64), args, LDS_BYTES, stream);
    if (e != hipSuccess) fprintf(stderr, "cooperative launch failed: %s (grid %d)\n", hipGetErrorString(e), grid);
}
```

```cpp
#include <hip/hip_runtime.h>
#include <hip/hip_cooperative_groups.h>
#include <hip/hip_bf16.h>
#include <cstdio>
#include <cstdint>
#include <cmath>
namespace cg = cooperative_groups;

#define LAS __attribute__((address_space(3)))
#define GAS __attribute__((address_space(1)))
typedef unsigned short bf16_t;
typedef short bf16x8 __attribute__((ext_vector_type(8)));
typedef float f32x4 __attribute__((ext_vector_type(4)));
typedef float f32x2 __attribute__((ext_vector_type(2)));
typedef float f32x16 __attribute__((ext_vector_type(16)));
typedef unsigned u32x4 __attribute__((ext_vector_type(4)));
typedef unsigned u32x2 __attribute__((ext_vector_type(2)));

#define PH_HI 10
#define ALIGN_EPI_SEL true
#define F8MODE 2
#define USE_SETPRIO 1
#define ATTN_PRIO_A 1
#define ATTN_PRIO_B 1
#ifndef PHMASK
#define PHMASK 0x3ff
#endif
#define REPEAT_MASK 0x000
constexpr int BATCH = 4, SEQ = 8192, DMODEL = 1024, T = BATCH * SEQ, INW = 5120, NEXP = 32, MEMLEN = 256;
constexpr float RMS_EPS = 1e-6f;
constexpr float C2 = 0.125f * 1.4426950408889634f;
constexpr int CAP = T;

constexpr size_t MiB = 1u << 20;
constexpr size_t WS_CTL = 0, CTL_ZERO_BYTES = 32768;
constexpr int CW_BAR = 4096;
constexpr size_t WS_ROUTEW = 1 * MiB;
constexpr size_t WS_LAM = 1 * MiB + 768 * 1024;
constexpr size_t WS_ROPE = 2 * MiB;
constexpr size_t WS_WR2 = 4 * MiB;
constexpr size_t WS_MEMN = 5 * MiB;
constexpr size_t WS_MKV = 7 * MiB;
constexpr size_t WS_WIN_T = 8 * MiB;
constexpr size_t WS_WBRD_T = 18 * MiB;
constexpr size_t WS_WBRP_T = 19 * MiB;
constexpr size_t WS_WBRM_T = 19 * MiB + 512 * 1024;
constexpr size_t WS_WOUT_T = 20 * MiB;
constexpr size_t WS_WMKV_T = 22 * MiB;
constexpr size_t WS_WGU_T = 24 * MiB;
constexpr size_t WS_WD_T = 152 * MiB;
constexpr size_t WS_A = 216 * MiB;
constexpr size_t WS_XN = WS_A;
constexpr size_t WS_Q = WS_A + 64 * MiB, WS_K = WS_A + 96 * MiB, WS_V = WS_A + 128 * MiB;
constexpr size_t WS_U = WS_A + 160 * MiB, WS_MQ = WS_A + 176 * MiB;
constexpr size_t WS_OC = WS_A + 192 * MiB;
constexpr size_t WS_B = 488 * MiB;
constexpr size_t WS_GATES = WS_B;
constexpr size_t WS_YCAT = WS_B + 192 * MiB;
constexpr size_t WS_MERGF = 760 * MiB;
constexpr size_t WS_MERGB = 888 * MiB;
constexpr size_t WS_XG = 952 * MiB;
constexpr size_t WS_LIST = 1016 * MiB;
constexpr size_t WS_END = 1024 * MiB;

typedef __bf16 bf16x2_v __attribute__((ext_vector_type(2)));
__device__ __forceinline__ unsigned cvt_pk_bf16(float lo, float hi) { f32x2 v = {lo, hi}; bf16x2_v b = __builtin_convertvector(v, bf16x2_v); return __builtin_bit_cast(unsigned, b); }
__device__ __forceinline__ unsigned pk4_fp8(float a, float b, float c, float d) {
    a = fminf(fmaxf(a, -448.f), 448.f); b = fminf(fmaxf(b, -448.f), 448.f); c = fminf(fmaxf(c, -448.f), 448.f); d = fminf(fmaxf(d, -448.f), 448.f);
    int r = __builtin_amdgcn_cvt_pk_fp8_f32(a, b, 0, false); r = __builtin_amdgcn_cvt_pk_fp8_f32(c, d, r, true); return (unsigned)r; }
constexpr float W8_SCALE = 64.0f;
constexpr float A8_SCALE = 8.0f;
__device__ __forceinline__ float bf_lo(unsigned w) { return __uint_as_float(w << 16); }
__device__ __forceinline__ float bf_hi(unsigned w) { return __uint_as_float(w & 0xffff0000u); }
__device__ __forceinline__ float wave_sum(float v) {
#pragma unroll
    for (int o = 1; o < 64; o <<= 1) v += __shfl_xor(v, o);
    return v;
}
#define LDS_WAIT() asm volatile("s_waitcnt lgkmcnt(0)" ::: "memory")

namespace pg8 {
constexpr int BM = 256, BK = 64, HALF = 128, HTB = HALF * BK * 2, STAGE_BYTES = 8 * HTB, NXCD = 8, WGM = 8;
__host__ __device__ __forceinline__ int lds_byte(int r, int c) { const int st = (r >> 4) * 2 + (c >> 5), rr = r & 15, cc = c & 31, ob = rr * 64 + cc * 2; return st * 1024 + (ob ^ (((ob >> 9) & 1) << 5)); }
__host__ __device__ __forceinline__ void stage_rc(int b, int& R, int& C) { const int st = b / 1024, sb = b % 1024, swz = sb ^ (((sb >> 9) & 1) << 5); R = (st >> 1) * 16 + swz / 64; C = (st & 1) * 32 + (swz % 64) / 2; }
__host__ __device__ __forceinline__ int perm32(int rho) { const int n = rho >> 4, i = rho & 15; return 8 * (i >> 2) + 4 * n + (i & 3); }

typedef int i32x4_t __attribute__((ext_vector_type(4)));
typedef int i32x8_t __attribute__((ext_vector_type(8)));
typedef long i64x2_t __attribute__((ext_vector_type(2)));
struct Unit { int pm, pn, e, mt, cnt; };

template <int BMAP> __device__ __forceinline__ int brow(int R) { return BMAP == 0 ? ((R >> 5) * 64 + perm32(R & 31)) : ((R & ~31) + perm32(R & 31)); }

struct StaticOrder {
    int nM, nN, nwg, G, c;
    __device__ void init(int M, int N, int G_, int c_) { nM = M / BM; nN = N / BM; nwg = nM * nN; G = G_; c = c_; }
    __device__ bool next(int i, Unit& u) const {
        const long L = (long)i * G + c; if (L >= nwg) return false;
        int wgid = (int)L; { const int q = nwg / NXCD, r = nwg % NXCD, xcd = wgid % NXCD, off = wgid / NXCD; wgid = (xcd < r ? xcd * (q + 1) : r * (q + 1) + (xcd - r) * q) + off; }
        const int nig = WGM * nN, gid = wgid / nig, fm = gid * WGM, gsz = (nM - fm) < WGM ? (nM - fm) : WGM;
        u.pm = fm + ((wgid % nig) % gsz); u.pn = (wgid % nig) / gsz; u.e = 0; u.mt = 0; u.cnt = 0; return true;
    }
    __device__ bool next_lane(int i, Unit& u) const { return next(i, u); }
};
struct GroupedOrder {
    const LAS int* tp; const LAS int* cn; int NTN, G, c;
    __device__ bool next_lane(int i, Unit& u) const {
        const int nwg = tp[NEXP] * NTN; const long L = (long)i * G + c; if (L >= nwg) return false;
        int wgid = (int)L; { const int q = nwg / NXCD, r = nwg % NXCD, xcd = wgid % NXCD, off = wgid / NXCD; wgid = (xcd < r ? xcd * (q + 1) : r * (q + 1) + (xcd - r) * q) + off; }
        int e = 0; while (e < NEXP - 1 && wgid >= tp[e + 1] * NTN) ++e;
        const int idx = wgid - tp[e] * NTN, tiles = tp[e + 1] - tp[e];
        const int nig = 4 * NTN, gid = idx / nig, fm = gid * 4, gsz = (tiles - fm) < 4 ? (tiles - fm) : 4;
        u.mt = fm + ((idx % nig) % gsz); u.pn = (idx % nig) / gsz; u.e = e; u.pm = tp[e] + u.mt; u.cnt = cn[e]; return true;
    }
};
struct TableOrder {
    const LAS int* tab; int n;
    __device__ __forceinline__ bool next(int i, Unit& u) const {
        if (i >= n) return false;
        const LAS int* t = tab + i * 8;
        u.pm = __builtin_amdgcn_readfirstlane(t[0]); u.pn = __builtin_amdgcn_readfirstlane(t[1]); u.e = __builtin_amdgcn_readfirstlane(t[2]);
        u.mt = __builtin_amdgcn_readfirstlane(t[3]); u.cnt = __builtin_amdgcn_readfirstlane(t[4]); return true;
    }
};
template <class Sched> __device__ __forceinline__ TableOrder build_unit_table(const Sched& S, LAS int* tab) {
    __syncthreads();
    if (threadIdx.x < 32) { Unit u; const bool ok = S.next_lane((int)threadIdx.x, u);
        if (ok) { LAS int* t = tab + threadIdx.x * 8; t[0] = u.pm; t[1] = u.pn; t[2] = u.e; t[3] = u.mt; t[4] = u.cnt; }
        const unsigned long long m = __ballot(ok); if (threadIdx.x == 0) tab[256] = __popcll(m); }
    __syncthreads();
    TableOrder T; T.tab = tab; T.n = __builtin_amdgcn_readfirstlane(tab[256]); return T;
}
struct DenseProb {
    static constexpr bool GATHER = false; static constexpr int BMAP = 0; static constexpr bool F8 = false;
    const bf16_t* A; const bf16_t* Bt; int lda, ldb, K;
    __device__ __forceinline__ const char* a_base(const Unit& u) const { return (const char*)(A + (size_t)u.pm * BM * lda); }
    __device__ __forceinline__ const char* b_base(const Unit& u) const { return (const char*)(Bt + (size_t)u.pn * BM * ldb); }
    __device__ __forceinline__ size_t bhstep() const { return (size_t)32 * ldb * 2; }
    __device__ __forceinline__ unsigned a_off(const Unit&, int, int) const { return 0u; }
    __device__ __forceinline__ unsigned a_raw(const Unit&, int) const { return 0u; }
};
struct GuProb {
    static constexpr bool GATHER = true; static constexpr int BMAP = 1; static constexpr bool F8 = true;
    const unsigned char* XG; const unsigned char* Wt; const u32x2* list; int lda, ldb, K;
    __device__ __forceinline__ const char* a_base(const Unit&) const { return (const char*)XG; }
    __device__ __forceinline__ const char* b_base(const Unit& u) const { return (const char*)(Wt + ((size_t)u.e * 2048 + 128 * u.pn) * 1024); }
    __device__ __forceinline__ size_t bhstep() const { return (size_t)1024 * 1024; }
    __device__ __forceinline__ unsigned a_raw(const Unit& u, int r) const { const int rr = u.mt * BM + r, rc = rr < u.cnt ? rr : u.cnt - 1; return list[(size_t)u.e * CAP + rc].x; }
    __device__ __forceinline__ unsigned a_off(const Unit& u, int r, int C) const {
        const int rr = u.mt * BM + r, rc = rr < u.cnt ? rr : u.cnt - 1;
        const unsigned tok = list[(size_t)u.e * CAP + rc].x >> 2;
        return tok * 1024u + (unsigned)C * 2u;
    }
};
struct DownProb {
    static constexpr bool GATHER = false; static constexpr int BMAP = 0; static constexpr bool F8 = true;
    const unsigned char* A; const unsigned char* Wt; int lda, ldb, K;
    __device__ __forceinline__ const char* a_base(const Unit& u) const { return (const char*)(A + (size_t)u.pm * BM * lda); }
    __device__ __forceinline__ const char* b_base(const Unit& u) const { return (const char*)(Wt + ((size_t)u.e * 1024 + 256 * u.pn) * 1024); }
    __device__ __forceinline__ size_t bhstep() const { return (size_t)32 * ldb; }
    __device__ __forceinline__ unsigned a_off(const Unit&, int, int) const { return 0u; }
    __device__ __forceinline__ unsigned a_raw(const Unit&, int) const { return 0u; }
};

template <class Prob> __device__ __forceinline__ void calc_aoff(const Prob& P, const Unit& u, const int (&Rr)[2], const int (&Cc)[2], unsigned (&o)[2][2]) {
#pragma unroll
    for (int h = 0; h < 2; ++h)
#pragma unroll
        for (int i = 0; i < 2; ++i) {
            if constexpr (Prob::GATHER) o[h][i] = P.a_off(u, h * HALF + Rr[i], Cc[i]);
            else o[h][i] = Prob::F8 ? (unsigned)((h * HALF + Rr[i]) * P.lda + Cc[i] * 2) : (unsigned)((h * HALF + Rr[i]) * P.lda + Cc[i]) * 2u;
        }
}

struct NoPost { __device__ __forceinline__ void operator()(int) const {} };
template <class Epi, class Prob, class Sched, bool ALIGN_EPI, class Post = NoPost>
__device__ __forceinline__ void gemm_phase(LAS unsigned char* lds, const Prob& P, const Sched& S, const Epi& E, const Post& PU = Post()) {
    const int tid = threadIdx.x, wid = __builtin_amdgcn_readfirstlane(tid >> 6), lane = tid & 63, wr = wid >> 2, wc = wid & 3, fr = lane & 15, fq = lane >> 4;
    const int K = P.K, nt = Prob::F8 ? K / 128 : K / BK;
    int Rr[2], Cc[2]; unsigned voffB[2];
#pragma unroll
    for (int i = 0; i < 2; ++i) { stage_rc(tid * 16 + i * 8192, Rr[i], Cc[i]); voffB[i] = Prob::F8 ? (unsigned)(brow<Prob::BMAP>(Rr[i]) * P.ldb + Cc[i] * 2) : (unsigned)(brow<Prob::BMAP>(Rr[i]) * P.ldb + Cc[i]) * 2u; }
    const size_t kstep = (size_t)(BK * 2);
    const size_t bhstep = P.bhstep();
    const unsigned ldsw = (unsigned)wid * 1024u;
    const int aoff = lds_byte(wr * 64 + fr, fq * 8), boff = lds_byte(wc * 32 + fr, fq * 8);
#define PG8_SA(b, h) (((b) * 2 + (h)) * HTB)
#define PG8_SB(b, h) ((4 + (b) * 2 + (h)) * HTB)
#define PG8_STG(bufoff, gptr, v0, v1) do { \
        __builtin_amdgcn_global_load_lds((const unsigned*)((const char*)(gptr) + (v0)), (LAS unsigned*)(lds + (bufoff) + ldsw), 16, 0, 0); \
        __builtin_amdgcn_global_load_lds((const unsigned*)((const char*)(gptr) + (v1)), (LAS unsigned*)(lds + (bufoff) + ldsw + 8192), 16, 0, 0); } while (0)
#define PG8_STGB(bufoff, gptr) PG8_STG(bufoff, gptr, voffB[0], voffB[1])
#define PG8_LDA(dst, b, h) do { _Pragma("unroll") for (int m = 0; m < 4; ++m) _Pragma("unroll") for (int k = 0; k < 2; ++k) dst[m][k] = *(const LAS bf16x8*)(lds + PG8_SA(b, h) + aoff + m * 2048 + k * 1024); } while (0)
#define PG8_LDB(dst, b, h) do { _Pragma("unroll") for (int n = 0; n < 2; ++n) _Pragma("unroll") for (int k = 0; k < 2; ++k) dst[n][k] = *(const LAS bf16x8*)(lds + PG8_SB(b, h) + boff + n * 2048 + k * 1024); } while (0)
#define PG8_MMAB(ai, bj, At, Bt) do { _Pragma("unroll") for (int m = 0; m < 4; ++m) _Pragma("unroll") for (int n = 0; n < 2; ++n) _Pragma("unroll") for (int k = 0; k < 2; ++k) \
        acc[ai][bj][m][n] = __builtin_amdgcn_mfma_f32_16x16x32_bf16(Bt[n][k], At[m][k], acc[ai][bj][m][n], 0, 0, 0); } while (0)
#define PG8_MMAQ(ai, bj, At, Bt) do { _Pragma("unroll") for (int m = 0; m < 4; ++m) _Pragma("unroll") for (int n = 0; n < 2; ++n) _Pragma("unroll") for (int k = 0; k < 2; ++k) { \
        const i64x2_t bq = __builtin_bit_cast(i64x2_t, Bt[n][k]), aq = __builtin_bit_cast(i64x2_t, At[m][k]); \
        acc[ai][bj][m][n] = __builtin_amdgcn_mfma_f32_16x16x32_fp8_fp8(bq[0], aq[0], acc[ai][bj][m][n], 0, 0, 0); \
        acc[ai][bj][m][n] = __builtin_amdgcn_mfma_f32_16x16x32_fp8_fp8(bq[1], aq[1], acc[ai][bj][m][n], 0, 0, 0); } } while (0)
#define PG8_MMA8(ai, bj, A8, B8) do { _Pragma("unroll") for (int m = 0; m < 4; ++m) _Pragma("unroll") for (int n = 0; n < 2; ++n) \
        asm volatile("v_mfma_f32_16x16x128_f8f6f4 %0, %1, %2, %0" : "+v"(acc[ai][bj][m][n]) : "v"(B8[n]), "v"(A8[m])); } while (0)
#define PG8_LDA8(dst, b, h) do { _Pragma("unroll") for (int m = 0; m < 4; ++m) { dst[m].lo = *(const LAS i32x4_t*)(lds + PG8_SA(b, h) + aoff + m * 2048); dst[m].hi = *(const LAS i32x4_t*)(lds + PG8_SA(b, h) + aoff + m * 2048 + 1024); } } while (0)
#define PG8_LDB8(dst, b, h) do { _Pragma("unroll") for (int n = 0; n < 2; ++n) { dst[n].lo = *(const LAS i32x4_t*)(lds + PG8_SB(b, h) + boff + n * 2048); dst[n].hi = *(const LAS i32x4_t*)(lds + PG8_SB(b, h) + boff + n * 2048 + 1024); } } while (0)
#define PG8_XLDA(b, h)  do { if constexpr (Prob::F8 && F8MODE == 2) PG8_LDA8(At8, b, h); else PG8_LDA(At, b, h); } while (0)
#define PG8_XLDB0(b, h) do { if constexpr (Prob::F8 && F8MODE == 2) PG8_LDB8(B08, b, h); else PG8_LDB(B0, b, h); } while (0)
#define PG8_XLDB1(b, h) do { if constexpr (Prob::F8 && F8MODE == 2) PG8_LDB8(B18, b, h); else PG8_LDB(B1, b, h); } while (0)
#define PG8_XMMA0(ai, bj) do { if (USE_SETPRIO) __builtin_amdgcn_s_setprio(USE_SETPRIO); if constexpr (Prob::F8 && F8MODE == 2) PG8_MMA8(ai, bj, At8, B08); else if constexpr (Prob::F8) PG8_MMAQ(ai, bj, At, B0); else PG8_MMAB(ai, bj, At, B0); if (USE_SETPRIO) __builtin_amdgcn_s_setprio(0); } while (0)
#define PG8_XMMA1(ai, bj) do { if (USE_SETPRIO) __builtin_amdgcn_s_setprio(USE_SETPRIO); if constexpr (Prob::F8 && F8MODE == 2) PG8_MMA8(ai, bj, At8, B18); else if constexpr (Prob::F8) PG8_MMAQ(ai, bj, At, B1); else PG8_MMAB(ai, bj, At, B1); if (USE_SETPRIO) __builtin_amdgcn_s_setprio(0); } while (0)
#define PG8_WAIT_V(n) asm volatile("s_waitcnt vmcnt(" #n ")" ::: "memory")
#define PG8_WAIT_L(n) asm volatile("s_waitcnt lgkmcnt(" #n ")" ::: "memory")
#define PG8_BAR __builtin_amdgcn_s_barrier()
#define PG8_SCHED __builtin_amdgcn_sched_barrier(0)
    Unit cur, nxt; int ui = 0;
    if (!S.next(0, cur)) return;
    unsigned vo[2][2], nvo[2][2];
    calc_aoff(P, cur, Rr, Cc, vo);
    bool has_next = S.next(1, nxt);
    if constexpr (Prob::GATHER) { if (has_next) calc_aoff(P, nxt, Rr, Cc, nvo); else {
#pragma unroll
        for (int h = 0; h < 2; ++h)
#pragma unroll
            for (int i = 0; i < 2; ++i) nvo[h][i] = vo[h][i]; } }
    f32x4 acc[2][2][4][2];
#pragma unroll
    for (int a = 0; a < 2; ++a)
#pragma unroll
        for (int b = 0; b < 2; ++b)
#pragma unroll
            for (int m = 0; m < 4; ++m)
#pragma unroll
                for (int n = 0; n < 2; ++n) acc[a][b][m][n] = (f32x4){0.f, 0.f, 0.f, 0.f};
    bf16x8 At[4][2], B0[2][2], B1[2][2]; i32x8_t At8[4], B08[2], B18[2];
    const char* cA = P.a_base(cur); const char* cB = P.b_base(cur);
    PG8_STGB(PG8_SB(0, 0), cB); PG8_STGB(PG8_SB(0, 1), cB + bhstep); PG8_STG(PG8_SA(0, 0), cA, vo[0][0], vo[0][1]); PG8_STG(PG8_SA(0, 1), cA, vo[1][0], vo[1][1]);
    if (wr == 1) PG8_BAR;
    PG8_WAIT_V(2); PG8_BAR;
    PG8_STGB(PG8_SB(1, 0), cB + kstep); PG8_STG(PG8_SA(1, 0), cA + kstep, vo[0][0], vo[0][1]); PG8_STGB(PG8_SB(1, 1), cB + bhstep + kstep);
    PG8_WAIT_V(6); PG8_BAR;
    for (;;) {
        const char* nA = has_next ? P.a_base(nxt) : cA; const char* nB = has_next ? P.b_base(nxt) : cB;
        for (int t = 0; t < nt; t += 2) {
            const bool last = (t == nt - 2);
            if constexpr (Epi::HAS_MID) { if (t == Epi::MID_T0 || t == Epi::MID_T1) { E.mid(acc, cur, wr, wc, fr, fq, t == Epi::MID_T0 ? 0 : 1); PG8_SCHED; } }
            const char* a1 = cA + (size_t)(t + 1) * kstep;
            const char* a2 = last ? nA : cA + (size_t)(t + 2) * kstep; const char* b2 = last ? nB : cB + (size_t)(t + 2) * kstep;
            const char* a3 = a2 + kstep; const char* b3 = b2 + kstep;
            unsigned x00 = vo[0][0], x01 = vo[0][1], x10 = vo[1][0], x11 = vo[1][1];
            if constexpr (Prob::GATHER) { if (last) { x00 = nvo[0][0]; x01 = nvo[0][1]; x10 = nvo[1][0]; x11 = nvo[1][1]; } }
            PG8_XLDB0(0, 0); PG8_XLDB1(0, 1); PG8_SCHED; PG8_XLDA(0, 0); PG8_STG(PG8_SA(1, 1), a1, vo[1][0], vo[1][1]);
            PG8_WAIT_V(8); PG8_WAIT_L(0); PG8_BAR; PG8_XMMA0(0, 0); PG8_XMMA1(0, 1); PG8_BAR; PG8_SCHED;
            PG8_XLDA(0, 1); PG8_STGB(PG8_SB(0, 0), b2); PG8_STGB(PG8_SB(0, 1), b2 + bhstep); PG8_STG(PG8_SA(0, 0), a2, x00, x01);
            PG8_WAIT_V(8); PG8_WAIT_L(0); PG8_BAR; PG8_XMMA0(1, 0); PG8_XMMA1(1, 1); PG8_BAR; PG8_SCHED;
            PG8_XLDB0(1, 0); PG8_XLDB1(1, 1); PG8_SCHED; PG8_XLDA(1, 0); PG8_STG(PG8_SA(0, 1), a2, x10, x11);
            PG8_WAIT_V(8); PG8_WAIT_L(0); PG8_BAR; PG8_XMMA0(0, 0); PG8_XMMA1(0, 1); PG8_BAR; PG8_SCHED;
            PG8_XLDA(1, 1); PG8_STGB(PG8_SB(1, 0), b3); PG8_STGB(PG8_SB(1, 1), b3 + bhstep); PG8_STG(PG8_SA(1, 0), a3, x00, x01);
            PG8_WAIT_V(8); PG8_WAIT_L(0); PG8_BAR; PG8_XMMA0(1, 0); PG8_XMMA1(1, 1); PG8_BAR; PG8_SCHED;
        }
        if constexpr (ALIGN_EPI) { if (wr == 0) PG8_BAR; }
        if constexpr (Prob::F8 && F8MODE == 2) asm volatile("s_nop 15\n\ts_nop 15" ::: "memory");
        Unit nn; const bool has_nn = has_next && S.next(ui + 2, nn);
        if constexpr (Prob::GATHER) {
#pragma unroll
            for (int h = 0; h < 2; ++h)
#pragma unroll
                for (int i = 0; i < 2; ++i) vo[h][i] = nvo[h][i];
            if (has_nn) {
#pragma unroll
                for (int h = 0; h < 2; ++h)
#pragma unroll
                    for (int i = 0; i < 2; ++i) nvo[h][i] = P.a_raw(nn, h * HALF + Rr[i]); } }
        E(acc, cur, wr, wc, fr, fq);
        PU(ui);
        if (!has_next) break;
#pragma unroll
        for (int a = 0; a < 2; ++a)
#pragma unroll
            for (int b = 0; b < 2; ++b)
#pragma unroll
                for (int m = 0; m < 4; ++m)
#pragma unroll
                    for (int n = 0; n < 2; ++n) acc[a][b][m][n] = (f32x4){0.f, 0.f, 0.f, 0.f};
        cur = nxt; cA = nA; cB = nB; ++ui;
        has_next = has_nn; nxt = nn;
        if constexpr (Prob::GATHER) { if (has_next) {
#pragma unroll
            for (int h = 0; h < 2; ++h)
#pragma unroll
                for (int i = 0; i < 2; ++i) nvo[h][i] = (nvo[h][i] >> 2) * (Prob::F8 ? 1024u : 2048u) + (unsigned)Cc[i] * 2u;
            asm volatile("" : "+v"(nvo[0][0]), "+v"(nvo[0][1]), "+v"(nvo[1][0]), "+v"(nvo[1][1])); } }
        if constexpr (ALIGN_EPI) { if (wr == 1) PG8_BAR; }
    }
    PG8_WAIT_V(0);
    if constexpr (!ALIGN_EPI) { if (wr == 0) PG8_BAR; }
    PG8_BAR;
#undef PG8_SA
#undef PG8_SB
#undef PG8_STG
#undef PG8_STGB
#undef PG8_LDA
#undef PG8_LDB
#undef PG8_MMAB
#undef PG8_MMAQ
#undef PG8_MMA8
#undef PG8_LDA8
#undef PG8_LDB8
#undef PG8_XLDA
#undef PG8_XLDB0
#undef PG8_XLDB1
#undef PG8_XMMA0
#undef PG8_XMMA1
#undef PG8_WAIT_V
#undef PG8_WAIT_L
#undef PG8_BAR
#undef PG8_SCHED
}

typedef const f32x4 (&AccRef)[2][2][4][2];

__device__ __forceinline__ void store8(bf16_t* p, const f32x4& a, const f32x4& b) {
    u32x4 w; w.x = cvt_pk_bf16(a[0], a[1]); w.y = cvt_pk_bf16(a[2], a[3]); w.z = cvt_pk_bf16(b[0], b[1]); w.w = cvt_pk_bf16(b[2], b[3]); *(u32x4*)p = w;
}
__device__ __forceinline__ float sigmoidf_(float v) { return __builtin_amdgcn_rcpf(1.0f + __builtin_amdgcn_exp2f(-1.4426950408889634f * v)); }

struct EpiInProj {
    static constexpr bool HAS_MID = false;
    bf16_t *Q, *Kb, *V, *U, *MQ, *GT; const float *qn, *kn, *mqn, *bg; const f32x2* rope;
    __device__ __forceinline__ void operator()(AccRef acc, const Unit& u, int wr, int wc, int fr, int fq) const {
        const int pn = u.pn; const int row0 = u.pm * BM + wr * 64 + fr;
        bf16_t* const Q_ = Q; bf16_t* const K_ = Kb; bf16_t* const V_ = V; bf16_t* const U_ = U; bf16_t* const MQ_ = MQ; const float* const qn_ = qn; const float* const kn_ = kn; const float* const mqn_ = mqn;
        if (pn < 4 || pn == 7) {
            const bool rope_on = pn < 4; const float* gn = pn < 2 ? qn_ : (pn < 4 ? kn_ : mqn_);
            const float sc = (pn < 2 || pn == 7) ? C2 : 1.0f;
            bf16_t* O; int pitch, colb;
            if (pn < 2) { O = Q_; pitch = 512; colb = (pn * 4 + wc) * 64; } else if (pn < 4) { O = K_; pitch = 512; colb = ((pn - 2) * 4 + wc) * 64; } else { O = MQ_; pitch = 256; colb = wc * 64; }
            const f32x4 g00 = *(const f32x4*)(gn + 8 * fq), g01 = *(const f32x4*)(gn + 8 * fq + 4), g10 = *(const f32x4*)(gn + 32 + 8 * fq), g11 = *(const f32x4*)(gn + 32 + 8 * fq + 4);
#pragma unroll
            for (int ai = 0; ai < 2; ++ai)
#pragma unroll
                for (int m = 0; m < 4; ++m) {
                    const f32x4 a0 = acc[ai][0][m][0], a1 = acc[ai][0][m][1], b0 = acc[ai][1][m][0], b1 = acc[ai][1][m][1];
                    float ss = 0.f;
#pragma unroll
                    for (int j = 0; j < 4; ++j) ss += a0[j] * a0[j] + a1[j] * a1[j] + b0[j] * b0[j] + b1[j] * b1[j];
                    ss += __shfl_xor(ss, 16); ss += __shfl_xor(ss, 32);
                    const float rstd = 1.0f / sqrtf(ss * (1.0f / 64.0f) + RMS_EPS);
                    const int row = row0 + ai * HALF + m * 16;
                    f32x4 t10 = a0 * rstd * g00, t11 = a1 * rstd * g01, t20 = b0 * rstd * g10, t21 = b1 * rstd * g11;
                    f32x4 o10, o11, o20, o21;
                    if (rope_on) {
                        const f32x4* rp = (const f32x4*)(rope + (size_t)(row & (SEQ - 1)) * 32 + 8 * fq);
                        const f32x4 r0 = rp[0], r1 = rp[1], r2 = rp[2], r3 = rp[3];
                        const f32x4 cs0 = {r0[0], r0[2], r1[0], r1[2]}, sn0 = {r0[1], r0[3], r1[1], r1[3]}, cs1 = {r2[0], r2[2], r3[0], r3[2]}, sn1 = {r2[1], r2[3], r3[1], r3[3]};
                        o10 = (t10 * cs0 - t20 * sn0) * sc; o11 = (t11 * cs1 - t21 * sn1) * sc; o20 = (t20 * cs0 + t10 * sn0) * sc; o21 = (t21 * cs1 + t11 * sn1) * sc;
                    } else { o10 = t10 * sc; o11 = t11 * sc; o20 = t20 * sc; o21 = t21 * sc; }
                    bf16_t* rowp = O + (size_t)row * pitch + colb + 8 * fq;
                    store8(rowp, o10, o11); store8(rowp + 32, o20, o21);
                }
        } else if (pn < 7) {
            bf16_t* O; int pitch, colb;
            if (pn < 6) { O = V_; pitch = 512; colb = (pn - 4) * 256 + wc * 64; } else { O = U_; pitch = 256; colb = wc * 64; }
#pragma unroll
            for (int ai = 0; ai < 2; ++ai)
#pragma unroll
                for (int m = 0; m < 4; ++m) { bf16_t* rowp = O + (size_t)(row0 + ai * HALF + m * 16) * pitch + colb + 8 * fq;
                    store8(rowp, acc[ai][0][m][0], acc[ai][0][m][1]); store8(rowp + 32, acc[ai][1][m][0], acc[ai][1][m][1]); }
        } else {
            const int gc = (pn - 8) * 256 + wc * 64 + 8 * fq;
            f32x4 bv[2][2];
#pragma unroll
            for (int bj = 0; bj < 2; ++bj)
#pragma unroll
                for (int n = 0; n < 2; ++n) bv[bj][n] = *(const f32x4*)(bg + gc + 32 * bj + 4 * n);
#pragma unroll
            for (int ai = 0; ai < 2; ++ai)
#pragma unroll
                for (int m = 0; m < 4; ++m) { bf16_t* rowp = GT + (size_t)(row0 + ai * HALF + m * 16) * 3072 + gc;
#pragma unroll
                    for (int bj = 0; bj < 2; ++bj) { f32x4 v0 = acc[ai][bj][m][0] + bv[bj][0], v1 = acc[ai][bj][m][1] + bv[bj][1];
#pragma unroll
                        for (int j = 0; j < 4; ++j) { v0[j] = sigmoidf_(v0[j]); v1[j] = sigmoidf_(v1[j]); }
                        store8(rowp + 32 * bj, v0, v1); } }
        }
    }
};
struct EpiMemKV {
    static constexpr bool HAS_MID = false;
    bf16_t* MKV; const float* mkn;
    __device__ __forceinline__ void operator()(AccRef acc, const Unit& u, int wr, int wc, int fr, int fq) const {
        const int row0 = u.pm * BM + wr * 64 + fr;
        f32x4 g00 = {1.f, 1.f, 1.f, 1.f}, g01 = g00, g10 = g00, g11 = g00;
        if (u.pn == 0) { g00 = *(const f32x4*)(mkn + 8 * fq); g01 = *(const f32x4*)(mkn + 8 * fq + 4); g10 = *(const f32x4*)(mkn + 32 + 8 * fq); g11 = *(const f32x4*)(mkn + 32 + 8 * fq + 4); }
#pragma unroll
        for (int ai = 0; ai < 2; ++ai)
#pragma unroll
            for (int m = 0; m < 4; ++m) {
                const f32x4 a0 = acc[ai][0][m][0], a1 = acc[ai][0][m][1], b0 = acc[ai][1][m][0], b1 = acc[ai][1][m][1];
                float rstd = 1.0f;
                if (u.pn == 0) { float ss = 0.f;
#pragma unroll
                    for (int j = 0; j < 4; ++j) ss += a0[j] * a0[j] + a1[j] * a1[j] + b0[j] * b0[j] + b1[j] * b1[j];
                    ss += __shfl_xor(ss, 16); ss += __shfl_xor(ss, 32); rstd = 1.0f / sqrtf(ss * (1.0f / 64.0f) + RMS_EPS); }
                bf16_t* rowp = MKV + (size_t)(row0 + ai * HALF + m * 16) * 512 + u.pn * 256 + wc * 64 + 8 * fq;
                store8(rowp, a0 * rstd * g00, a1 * rstd * g01); store8(rowp + 32, b0 * rstd * g10, b1 * rstd * g11);
            }
    }
};
template <int STAGE> struct EpiMerge {
    static constexpr bool HAS_MID = false;
    const bf16_t* GT; float* MF; bf16_t* MB;
    __device__ __forceinline__ void operator()(AccRef acc, const Unit& u, int wr, int wc, int fr, int fq) const {
        const int row0 = u.pm * BM + wr * 64 + fr, col0 = u.pn * BM + wc * 64 + 8 * fq;
#pragma unroll
        for (int ai = 0; ai < 2; ++ai)
#pragma unroll
            for (int m = 0; m < 4; ++m) { const size_t row = (size_t)(row0 + ai * HALF + m * 16);
#pragma unroll
                for (int bj = 0; bj < 2; ++bj) { const int col = col0 + 32 * bj;
                    const u32x4 g = *(const u32x4*)(GT + row * 3072 + STAGE * 1024 + col);
                    const f32x4 ga = {bf_lo(g.x), bf_hi(g.x), bf_lo(g.y), bf_hi(g.y)}, gb = {bf_lo(g.z), bf_hi(g.z), bf_lo(g.w), bf_hi(g.w)};
                    f32x4 v0 = acc[ai][bj][m][0] * ga, v1 = acc[ai][bj][m][1] * gb;
                    float* mp = MF + row * 1024 + col;
                    if (STAGE > 0) { v0 += *(const f32x4*)mp; v1 += *(const f32x4*)(mp + 4); }
                    if (STAGE < 2) { *(f32x4*)mp = v0; *(f32x4*)(mp + 4) = v1; } else store8(MB + row * 1024 + col, v0, v1); }
                if (m & 1) asm volatile("" ::: "memory"); }
    }
};
struct EpiWout {
    static constexpr bool HAS_MID = false;
    const float* X; float* X2; unsigned char* XG; const float* n2;
    __device__ __forceinline__ void operator()(AccRef acc, const Unit& u, int wr, int wc, int fr, int fq) const {
        const int row0 = u.pm * BM + wr * 64 + fr, col0 = u.pn * BM + wc * 64 + 8 * fq;
        f32x4 nv[2][2];
#pragma unroll
        for (int bj = 0; bj < 2; ++bj)
#pragma unroll
            for (int n = 0; n < 2; ++n) nv[bj][n] = *(const f32x4*)(n2 + col0 + 32 * bj + 4 * n);
#pragma unroll
        for (int ai = 0; ai < 2; ++ai)
#pragma unroll
            for (int m = 0; m < 4; ++m) { const size_t off = (size_t)(row0 + ai * HALF + m * 16) * 1024 + col0;
#pragma unroll
                for (int bj = 0; bj < 2; ++bj) { const f32x4 x0 = *(const f32x4*)(X + off + 32 * bj) + acc[ai][bj][m][0], x1 = *(const f32x4*)(X + off + 32 * bj + 4) + acc[ai][bj][m][1];
                    *(f32x4*)(X2 + off + 32 * bj) = x0; *(f32x4*)(X2 + off + 32 * bj + 4) = x1;
                    { const f32x4 y0 = x0 * nv[bj][0], y1 = x1 * nv[bj][1]; u32x2 w8; w8.x = pk4_fp8(y0[0], y0[1], y0[2], y0[3]); w8.y = pk4_fp8(y1[0], y1[1], y1[2], y1[3]); *(u32x2*)(XG + off + 32 * bj) = w8; } }
                if (m & 1) asm volatile("" ::: "memory"); }
    }
};
struct EpiSwiglu {
    static constexpr bool HAS_MID = false;
    unsigned char* ACT; const u32x2* list; const float* bgu;
    __device__ __forceinline__ void operator()(AccRef acc, const Unit& u, int wr, int wc, int fr, int fq) const {
        int z = 0; asm volatile("" : "+v"(z));
        const int col = 128 * u.pn + 32 * wc + 8 * fq + z; const float* bp = bgu + (size_t)u.e * 2048 + col;
        const f32x4 bg0 = *(const f32x4*)bp, bg1 = *(const f32x4*)(bp + 4), bu0 = *(const f32x4*)(bp + 1024), bu1 = *(const f32x4*)(bp + 1028);
#pragma unroll
        for (int ai = 0; ai < 2; ++ai)
#pragma unroll
            for (int m = 0; m < 4; ++m) { const int r = ai * HALF + wr * 64 + m * 16 + fr, rr = u.mt * BM + r, rc = rr < u.cnt ? rr : u.cnt - 1;
                const float rstd = __uint_as_float(list[(size_t)u.e * CAP + rc].y) * (1.0f / W8_SCALE);
                f32x4 o[2];
#pragma unroll
                for (int n = 0; n < 2; ++n) { const f32x4 g = acc[ai][0][m][n] * rstd + (n ? bg1 : bg0), up = acc[ai][1][m][n] * rstd + (n ? bu1 : bu0);
#pragma unroll
                    for (int j = 0; j < 4; ++j) { const float gg = fminf(g[j], 7.0f), uu = fminf(fmaxf(up[j], -7.0f), 7.0f);
                        o[n][j] = gg * __builtin_amdgcn_rcpf(1.0f + __builtin_amdgcn_exp2f(-1.702f * 1.4426950408889634f * gg)) * (uu + 1.0f); } }
                { const f32x4 q0 = o[0] * A8_SCALE, q1 = o[1] * A8_SCALE; u32x2 w8; w8.x = pk4_fp8(q0[0], q0[1], q0[2], q0[3]); w8.y = pk4_fp8(q1[0], q1[1], q1[2], q1[3]); *(u32x2*)(ACT + (size_t)(u.pm * BM + r) * 1024 + col) = w8; } }
    }
};
struct EpiDown {
    static constexpr bool HAS_MID = false;
    bf16_t* Y4; const u32x2* list; const float* bd;
    __device__ __forceinline__ void operator()(AccRef acc, const Unit& u, int wr, int wc, int fr, int fq) const {
        int z = 0; asm volatile("" : "+v"(z));
        const int col0 = u.pn * BM + wc * 64 + 8 * fq + z; const float* bp = bd + (size_t)u.e * 1024 + col0;
        f32x4 bv[2][2];
#pragma unroll
        for (int bj = 0; bj < 2; ++bj)
#pragma unroll
            for (int n = 0; n < 2; ++n) bv[bj][n] = *(const f32x4*)(bp + 32 * bj + 4 * n);
        unsigned tkv[8];
#pragma unroll
        for (int ai = 0; ai < 2; ++ai)
#pragma unroll
            for (int m = 0; m < 4; ++m) { const int rr = u.mt * BM + ai * HALF + wr * 64 + m * 16 + fr, rc = rr < u.cnt ? rr : u.cnt - 1;
                tkv[ai * 4 + m] = list[(size_t)u.e * CAP + rc].x; }
#pragma unroll
        for (int ai = 0; ai < 2; ++ai)
#pragma unroll
            for (int m = 0; m < 4; ++m) { const int rr = u.mt * BM + ai * HALF + wr * 64 + m * 16 + fr;
                if (rr < u.cnt) { bf16_t* rowp = Y4 + (size_t)tkv[ai * 4 + m] * 1024 + col0;
#pragma unroll
                    for (int bj = 0; bj < 2; ++bj) store8(rowp + 32 * bj, acc[ai][bj][m][0] * (1.0f / (W8_SCALE * A8_SCALE)) + bv[bj][0], acc[ai][bj][m][1] * (1.0f / (W8_SCALE * A8_SCALE)) + bv[bj][1]); } }
    }
};
struct EpiMergeR {
    static constexpr bool HAS_MID = true; static constexpr int MID_T0 = 8, MID_T1 = 12;
    const bf16_t* GT; bf16_t* MB;
    __device__ __forceinline__ void mid(f32x4 (&acc)[2][2][4][2], const Unit& u, int wr, int wc, int fr, int fq, int seam) const {
        int z = 0; asm volatile("" : "+v"(z));
        const bf16_t* gp0 = GT + (size_t)(u.pm * BM + wr * 64 + fr + z) * 3072 + seam * 1024 + u.pn * BM + wc * 64 + 8 * fq;
#pragma unroll
        for (int ai = 0; ai < 2; ++ai)
#pragma unroll
            for (int m = 0; m < 4; ++m) { const bf16_t* gp = gp0 + (size_t)(ai * HALF + m * 16) * 3072;
#pragma unroll
                for (int bj = 0; bj < 2; ++bj) { const u32x4 gn = *(const u32x4*)(gp + 32 * bj), gd = *(const u32x4*)(gp + 1024 + 32 * bj);
                    const unsigned nn[4] = {gn.x, gn.y, gn.z, gn.w}, dd[4] = {gd.x, gd.y, gd.z, gd.w};
#pragma unroll
                    for (int j = 0; j < 4; ++j) { const float r0 = bf_lo(nn[j]) * __builtin_amdgcn_rcpf(fmaxf(bf_lo(dd[j]), 8.67e-19f)), r1 = bf_hi(nn[j]) * __builtin_amdgcn_rcpf(fmaxf(bf_hi(dd[j]), 8.67e-19f));
                        acc[ai][bj][m][j >> 1][(j & 1) * 2] *= r0; acc[ai][bj][m][j >> 1][(j & 1) * 2 + 1] *= r1; } }
                if (m & 1) asm volatile("" ::: "memory"); }
    }
    __device__ __forceinline__ void operator()(AccRef acc, const Unit& u, int wr, int wc, int fr, int fq) const {
        int z = 0; asm volatile("" : "+v"(z));
        const size_t off0 = (size_t)(u.pm * BM + wr * 64 + fr + z) * 1024 + u.pn * BM + wc * 64 + 8 * fq;
#pragma unroll
        for (int ai = 0; ai < 2; ++ai)
#pragma unroll
            for (int m = 0; m < 4; ++m) { const size_t ro = off0 + (size_t)(ai * HALF + m * 16) * 1024;
#pragma unroll
                for (int bj = 0; bj < 2; ++bj) {
                    const u32x4 g = *(const u32x4*)(GT + ro * 3 + 2048 - 2 * (ro & 1023) + 32 * bj);
                    const f32x4 ga = {bf_lo(g.x), bf_hi(g.x), bf_lo(g.y), bf_hi(g.y)}, gb = {bf_lo(g.z), bf_hi(g.z), bf_lo(g.w), bf_hi(g.w)};
                    store8(MB + ro + 32 * bj, acc[ai][bj][m][0] * ga, acc[ai][bj][m][1] * gb); } }
    }
};
struct EpiPlain {
    static constexpr bool HAS_MID = false;
    bf16_t* Z; int ldz;
    __device__ __forceinline__ void operator()(AccRef acc, const Unit& u, int wr, int wc, int fr, int fq) const {
        const int row0 = u.pm * BM + wr * 64 + fr, col0 = u.pn * BM + wc * 64 + 8 * fq;
#pragma unroll
        for (int ai = 0; ai < 2; ++ai)
#pragma unroll
            for (int m = 0; m < 4; ++m) { bf16_t* rowp = Z + (size_t)(row0 + ai * HALF + m * 16) * ldz + col0;
                store8(rowp, acc[ai][0][m][0], acc[ai][0][m][1]); store8(rowp + 32, acc[ai][1][m][0], acc[ai][1][m][1]); }
    }
};
}

namespace attn_body {
using bf16 = __hip_bfloat16;
using s16x4 = __attribute__((ext_vector_type(4))) short;
constexpr int NW = 8, QBLK = 32, QB = QBLK * NW, KVBLK = 64, D = 64;
__device__ __forceinline__ int crow(int r, int hi) { return (r & 3) + 8 * (r >> 2) + 4 * hi; }
#define SBAR() __builtin_amdgcn_sched_barrier(0)
constexpr int NSLOT = 3, SLOTB = 8192;
constexpr int LDS_K = 0, LDS_V = NSLOT * SLOTB, LDS_WS = 2 * NSLOT * SLOTB, LDS_OST = LDS_WS + NW * 64 * 4, LDS_BYTES = LDS_OST + NW * 4096;
__device__ __forceinline__ void glds16(const void* gsrc, unsigned lds_dst) { unsigned keep;
    asm volatile("s_mov_b32 %0, m0\n\ts_mov_b32 m0, %2\n\ts_nop 0\n\tglobal_load_lds_dwordx4 %1, off\n\ts_mov_b32 m0, %0" : "=&s"(keep) : "v"(gsrc), "s"(lds_dst) : "memory"); }
__device__ __forceinline__ float max3f(float a, float b, float c) { float r; asm("v_max3_f32 %0, %1, %2, %3" : "=v"(r) : "v"(a), "v"(b), "v"(c)); return r; }
__device__ __forceinline__ float max2f(float a, float b) { float r; asm("v_max_f32_e32 %0, %1, %2" : "=v"(r) : "v"(a), "v"(b)); return r; }
__device__ __forceinline__ float fadd_s(float a, float b) { float r; asm("v_add_f32_e32 %0, %1, %2" : "=v"(r) : "v"(a), "v"(b)); return r; }
__device__ __forceinline__ float fsub_s(float a, float b) { float r; asm("v_sub_f32_e32 %0, %1, %2" : "=v"(r) : "v"(a), "v"(b)); return r; }
typedef float f32x2_t __attribute__((ext_vector_type(2))); typedef __bf16 bf16x2_t __attribute__((ext_vector_type(2)));
__device__ __forceinline__ unsigned cvtpk_s(float lo, float hi) { f32x2_t v = {lo, hi}; bf16x2_t b = __builtin_convertvector(v, bf16x2_t); return __builtin_bit_cast(unsigned, b); }
#define WAIT_BAR(N) asm volatile("s_waitcnt vmcnt(" #N ") lgkmcnt(0)\n\ts_barrier" ::: "memory")

__device__ __forceinline__ void qkt(f32x16& p0, f32x16& p1, const char* Kslot, const bf16x8* qr, const f32x16& negm, int r32, int hi) {
    const char* kb = Kslot + hi * 1024 + r32 * 16;
#pragma unroll
    for (int d0 = 0; d0 < 4; ++d0) {
        const bf16x8 b0 = *reinterpret_cast<const bf16x8*>(kb + d0 * 2048);
        const bf16x8 b1 = *reinterpret_cast<const bf16x8*>(kb + d0 * 2048 + 512);
        if (d0 == 0) { p0 = __builtin_amdgcn_mfma_f32_32x32x16_bf16(b0, qr[0], negm, 0, 0, 0); p1 = __builtin_amdgcn_mfma_f32_32x32x16_bf16(b1, qr[0], negm, 0, 0, 0); }
        else { p0 = __builtin_amdgcn_mfma_f32_32x32x16_bf16(b0, qr[d0], p0, 0, 0, 0); p1 = __builtin_amdgcn_mfma_f32_32x32x16_bf16(b1, qr[d0], p1, 0, 0, 0); } }
}
typedef __attribute__((address_space(3))) const char* lds_cptr;
typedef short v4i16_t __attribute__((ext_vector_type(4)));
__device__ __forceinline__ void kload8(bf16x8* kf, lds_cptr kp) {
    kf[0] = *(const __attribute__((address_space(3))) bf16x8*)(kp);        kf[1] = *(const __attribute__((address_space(3))) bf16x8*)(kp + 512);
    kf[2] = *(const __attribute__((address_space(3))) bf16x8*)(kp + 2048); kf[3] = *(const __attribute__((address_space(3))) bf16x8*)(kp + 2560);
    kf[4] = *(const __attribute__((address_space(3))) bf16x8*)(kp + 4096); kf[5] = *(const __attribute__((address_space(3))) bf16x8*)(kp + 4608);
    kf[6] = *(const __attribute__((address_space(3))) bf16x8*)(kp + 6144); kf[7] = *(const __attribute__((address_space(3))) bf16x8*)(kp + 6656);
}
__device__ __forceinline__ void kload2(bf16x8* kf, lds_cptr kp, int j) { kf[2 * j] = *(const __attribute__((address_space(3))) bf16x8*)(kp + j * 2048); kf[2 * j + 1] = *(const __attribute__((address_space(3))) bf16x8*)(kp + j * 2048 + 512); }
__device__ __forceinline__ s16x4 vtr(lds_cptr p) { return __builtin_bit_cast(s16x4, __builtin_amdgcn_ds_read_tr16_b64_v4i16((__attribute__((address_space(3))) v4i16_t*)p)); }
__device__ __forceinline__ float rowmax(const f32x16& p0, const f32x16& p1) {
    float a = max3f(p0[0], p0[1], p1[0]), b = max3f(p0[2], p0[3], p1[1]); a = max3f(a, p1[2], p1[3]);
#pragma unroll
    for (int r = 4; r < 16; r += 4) { a = max3f(a, p0[r], p0[r + 1]); b = max3f(b, p0[r + 2], p0[r + 3]); a = max3f(a, p1[r], p1[r + 1]); b = max3f(b, p1[r + 2], p1[r + 3]); }
    const float m = max2f(a, b);
    auto rr = __builtin_amdgcn_permlane32_swap(__float_as_uint(m), __float_as_uint(m), false, false);
    return max2f(__uint_as_float(rr[0]), __uint_as_float(rr[1]));
}
__device__ __forceinline__ void pv(f32x16* o, int vb, bf16x8 pa0, bf16x8 pa1, bf16x8 pa2, bf16x8 pa3) {
#pragma unroll
    for (int d0 = 0; d0 < 2; ++d0) { s16x4 lo[4], hi[4];
#pragma unroll
        for (int ks = 0; ks < 4; ++ks) {
            asm volatile("ds_read_b64_tr_b16 %0,%1 offset:%c2" : "=&v"(lo[ks]) : "v"(vb), "i"(d0 * 4096 + ks * 1024) : "memory");
            asm volatile("ds_read_b64_tr_b16 %0,%1 offset:%c2" : "=&v"(hi[ks]) : "v"(vb), "i"(d0 * 4096 + ks * 1024 + 512) : "memory"); }
        asm volatile("s_waitcnt lgkmcnt(0)" ::: "memory"); SBAR();
#define PK(k) (bf16x8){lo[k][0], lo[k][1], lo[k][2], lo[k][3], hi[k][0], hi[k][1], hi[k][2], hi[k][3]}
        o[d0] = __builtin_amdgcn_mfma_f32_32x32x16_bf16(pa0, PK(0), o[d0], 0, 0, 0);
        o[d0] = __builtin_amdgcn_mfma_f32_32x32x16_bf16(pa1, PK(1), o[d0], 0, 0, 0);
        o[d0] = __builtin_amdgcn_mfma_f32_32x32x16_bf16(pa2, PK(2), o[d0], 0, 0, 0);
        o[d0] = __builtin_amdgcn_mfma_f32_32x32x16_bf16(pa3, PK(3), o[d0], 0, 0, 0);
#undef PK
    }
}
__device__ __forceinline__ void cmask(f32x16& p0, f32x16& p1, int jb, int wid) {
    if (jb > (wid >> 1)) {
#pragma unroll
        for (int r = 0; r < 16; ++r) { p0[r] = -INFINITY; p1[r] = -INFINITY; } }
}
template <int THRL, bool MASK> __device__ __forceinline__ void attn_unit(int q0, int NT, const bf16* Qh, int qp, const bf16* __restrict__ Kh, int kp, const bf16* __restrict__ Vh, int vp, bf16* Oh, int op, char* shm) {
    const int tid = threadIdx.x, lane = tid & 63, r32 = lane & 31, hi = lane >> 5; const int wid = __builtin_amdgcn_readfirstlane(tid >> 6);
    const bf16* Qw = Qh + (long)(q0 + wid * QBLK) * qp;
    const unsigned lds0 = (unsigned)(uintptr_t)shm;
    float* wsf = (float*)(shm + LDS_WS) + wid * 64;
    const bf16* ksrc = Kh + (long)lane * kp + wid * 8;
    const bf16* vsrc = Vh + (long)(16 * (wid & 3) + (lane >> 2)) * vp + (wid >> 2) * 32 + (lane & 3) * 8;
    const unsigned kdst = lds0 + LDS_K + wid * 1024, vdst = lds0 + LDS_V + wid * 1024;
#define DMA_K(t, slot) glds16(ksrc + (long)(t) * KVBLK * kp, (unsigned)__builtin_amdgcn_readfirstlane(kdst + (slot)))
#define DMA_V(t, slot) glds16(vsrc + (long)(t) * KVBLK * vp, (unsigned)__builtin_amdgcn_readfirstlane(vdst + (slot)))
    const int vb0 = (int)(lds0 + LDS_V) + ((lane >> 4) & 1) * 32 + (lane & 3) * 8 + (4 * hi + ((lane & 15) >> 2)) * 64;
    const char* Kbase = shm + LDS_K; bf16x8 kf[8];
    const lds_cptr shm3 = (lds_cptr)shm; const lds_cptr kp0 = shm3 + LDS_K + hi * 1024 + r32 * 16; const lds_cptr vp0 = shm3 + LDS_V + ((lane >> 4) & 1) * 32 + (lane & 3) * 8 + (4 * hi + ((lane & 15) >> 2)) * 64;
    DMA_K(0, 0); DMA_V(0, 0); DMA_K(1, SLOTB);
    bf16x8 qr[4];
#pragma unroll
    for (int d0 = 0; d0 < 4; ++d0) qr[d0] = *reinterpret_cast<const bf16x8*>(&Qw[(long)r32 * qp + d0 * 16 + hi * 8]);
    float mhat = 0.f, l_reg = 0.f; f32x16 o[2]; o[0] = f32x16{}; o[1] = f32x16{}; f32x16 negm = f32x16{}; asm volatile("" : "+v"(negm));
#define CMASK(P0, P1, t) do { if (MASK) { int jb_ = (t) - (NT - 4); if (jb_ >= 0) cmask(P0, P1, jb_, wid); } } while (0)
    bool resc = false;
#define START(P0, P1) do { const float rm = rowmax(P0, P1); resc = false; \
    { const float dl = rm; mhat = fadd_s(mhat, dl); \
      _Pragma("unroll") for (int r = 0; r < 16; ++r) { P0[r] = fsub_s(P0[r], dl); P1[r] = fsub_s(P1[r], dl); } \
      _Pragma("unroll") for (int r = 0; r < 16; ++r) negm[r] = -mhat; asm volatile("" : "+v"(negm)); } \
    _Pragma("unroll") for (int r = 0; r < 16; ++r) P0[r] = __builtin_amdgcn_exp2f(P0[r]); } while (0)
#define RESC() do { if (resc) { asm volatile("s_waitcnt lgkmcnt(0)" ::: "memory"); \
      _Pragma("unroll") for (int d_ = 0; d_ < 2; ++d_) _Pragma("unroll") for (int r = 0; r < 16; ++r) o[d_][r] *= wsf[crow(r, hi)]; } } while (0)
    f32x16 pA0, pA1, pB0, pB1;
    int sl_prev = 0, sl_cur = 0, sl_next = SLOTB;
#define ROT() do { sl_prev = sl_cur; sl_cur = sl_next; sl_next = (sl_next == (NSLOT - 1) * SLOTB) ? 0 : sl_next + SLOTB; } while (0)
    DMA_K(2, 2 * SLOTB);
    WAIT_BAR(3);
    qkt(pA0, pA1, Kbase, qr, negm, r32, hi); asm volatile("s_nop 15\n\ts_nop 7" : "+v"(pA0), "+v"(pA1)); CMASK(pA0, pA1, 0);
    START(pA0, pA1);
    _Pragma("unroll") for (int r = 0; r < 16; ++r) pA1[r] = __builtin_amdgcn_exp2f(pA1[r]);
    WAIT_BAR(0);
    DMA_K(3, 0); DMA_V(1, SLOTB);
    ROT();
    kload8(kf, kp0 + sl_cur);
    WAIT_BAR(2);
    s16x4 vlo[8], vhi[8]; u32x4 pw0, pw1, pw2, pw3;
#define PKW(P, B) cvtpk_s(P[B], P[B + 1])
#define PAF(k) __builtin_bit_cast(bf16x8, pw##k)
#define VFR(i) (bf16x8){vlo[i][0], vlo[i][1], vlo[i][2], vlo[i][3], vhi[i][0], vhi[i][1], vhi[i][2], vhi[i][3]}
#define PIN(x) asm volatile("" : "+v"(x))
#define MX3(a, b, c) __builtin_fmaxf(__builtin_fmaxf((a), (b)), (c))
#define GAPA(MF, A0, A1, A2, A3, W0, W1, PW) do { MF; sacc += A0; sacc += A1; sacc += A2; sacc += A3; PIN(sacc); W0; W1; PIN(PW); SBAR(); } while (0)
#define EX(v) __builtin_amdgcn_exp2f(v)
#define GAPB(MF, X, B) do { MF; X[B] = EX(X[B]); X[B + 1] = EX(X[B + 1]); X[B + 2] = EX(X[B + 2]); X[B + 3] = EX(X[B + 3]); PIN(X); SBAR(); } while (0)
#define VRD(i) do { vlo[i] = vtr(vp_ + (((i) >> 2) * 4096 + ((i) & 3) * 1024)); vhi[i] = vtr(vp_ + (((i) >> 2) * 4096 + ((i) & 3) * 1024 + 512)); } while (0)
#define KRD(G, j) do { if (G) { kload2(kf, kp0 + sl_next, j); SBAR(); } } while (0)
#define STEP(C0, C1, P0, P1, t, GK, GV, GL) do { SBAR(); \
    const lds_cptr vp_ = vp0 + sl_prev; \
    VRD(0); SBAR(); float sacc = (P0[0] + P0[1]); \
    GAPA(C0 = __builtin_amdgcn_mfma_f32_32x32x16_bf16(kf[0], qr[0], negm, 0, 0, 0), P0[2], P0[3], P0[4], P0[5],     pw0[0] = PKW(P0, 0), pw0[1] = PKW(P0, 2), pw0); \
    VRD(4); SBAR(); GAPA(C1 = __builtin_amdgcn_mfma_f32_32x32x16_bf16(kf[1], qr[0], negm, 0, 0, 0), P0[6], P0[7], P0[8], P0[9],     pw0[2] = PKW(P0, 4), pw0[3] = PKW(P0, 6), pw0); \
    VRD(1); SBAR(); GAPA(C0 = __builtin_amdgcn_mfma_f32_32x32x16_bf16(kf[2], qr[1], C0, 0, 0, 0),   P0[10], P0[11], P0[12], P0[13], pw1[0] = PKW(P0, 8), pw1[1] = PKW(P0, 10), pw1); \
    VRD(5); SBAR(); GAPA(C1 = __builtin_amdgcn_mfma_f32_32x32x16_bf16(kf[3], qr[1], C1, 0, 0, 0),   P0[14], P0[15], P1[0], P1[1],   pw1[2] = PKW(P0, 12), pw1[3] = PKW(P0, 14), pw1); \
    VRD(2); SBAR(); GAPA(C0 = __builtin_amdgcn_mfma_f32_32x32x16_bf16(kf[4], qr[2], C0, 0, 0, 0),   P1[2], P1[3], P1[4], P1[5],     pw2[0] = PKW(P1, 0), pw2[1] = PKW(P1, 2), pw2); \
    VRD(6); SBAR(); GAPA(C1 = __builtin_amdgcn_mfma_f32_32x32x16_bf16(kf[5], qr[2], C1, 0, 0, 0),   P1[6], P1[7], P1[8], P1[9],     pw2[2] = PKW(P1, 4), pw2[3] = PKW(P1, 6), pw2); \
    VRD(3); SBAR(); GAPA(C0 = __builtin_amdgcn_mfma_f32_32x32x16_bf16(kf[6], qr[3], C0, 0, 0, 0),   P1[10], P1[11], P1[12], P1[13], pw3[0] = PKW(P1, 8), pw3[1] = PKW(P1, 10), pw3); \
    VRD(7); SBAR(); GAPA(C1 = __builtin_amdgcn_mfma_f32_32x32x16_bf16(kf[7], qr[3], C1, 0, 0, 0),   P1[14], P1[15], 0.f, 0.f,       pw3[2] = PKW(P1, 12), pw3[3] = PKW(P1, 14), pw3); \
    l_reg += sacc; \
    if (GK) { DMA_K((t) + 3, sl_cur); } if (GV) { DMA_V((t) + 1, sl_next); } \
    CMASK(C0, C1, t); \
    { float a = MX3(C0[0], C0[1], C1[0]), b = MX3(C0[2], C0[3], C1[1]); a = MX3(a, C1[2], C1[3]); \
      _Pragma("unroll") for (int r = 4; r < 16; r += 4) { a = MX3(a, C0[r], C0[r + 1]); b = MX3(b, C0[r + 2], C0[r + 3]); a = MX3(a, C1[r], C1[r + 1]); b = MX3(b, C1[r + 2], C1[r + 3]); } \
      float rm = __builtin_fmaxf(a, b); { auto rr = __builtin_amdgcn_permlane32_swap(__float_as_uint(rm), __float_as_uint(rm), false, false); rm = __builtin_fmaxf(__uint_as_float(rr[0]), __uint_as_float(rr[1])); } \
      resc = false; \
      if (__builtin_expect(__any(rm > (float)THRL), 0)) { const float dl = __builtin_fmaxf(rm, 0.f); mhat += dl; \
        _Pragma("unroll") for (int r = 0; r < 16; ++r) { C0[r] -= dl; C1[r] -= dl; } \
        _Pragma("unroll") for (int r = 0; r < 16; ++r) negm[r] = -mhat; asm volatile("" : "+v"(negm)); \
        const float f = __builtin_amdgcn_exp2f(-dl); l_reg *= f; if (hi == 0) wsf[r32] = f; resc = true; } } \
    SBAR(); \
    GAPB(o[0] = __builtin_amdgcn_mfma_f32_32x32x16_bf16(PAF(0), VFR(0), o[0], 0, 0, 0), C0, 0); \
    GAPB(o[1] = __builtin_amdgcn_mfma_f32_32x32x16_bf16(PAF(0), VFR(4), o[1], 0, 0, 0), C0, 4); \
    KRD(GL, 0); GAPB(o[0] = __builtin_amdgcn_mfma_f32_32x32x16_bf16(PAF(1), VFR(1), o[0], 0, 0, 0), C0, 8); \
    KRD(GL, 1); GAPB(o[1] = __builtin_amdgcn_mfma_f32_32x32x16_bf16(PAF(1), VFR(5), o[1], 0, 0, 0), C0, 12); \
    KRD(GL, 2); GAPB(o[0] = __builtin_amdgcn_mfma_f32_32x32x16_bf16(PAF(2), VFR(2), o[0], 0, 0, 0), C1, 0); \
    KRD(GL, 3); GAPB(o[1] = __builtin_amdgcn_mfma_f32_32x32x16_bf16(PAF(2), VFR(6), o[1], 0, 0, 0), C1, 4); \
    GAPB(o[0] = __builtin_amdgcn_mfma_f32_32x32x16_bf16(PAF(3), VFR(3), o[0], 0, 0, 0), C1, 8); \
    GAPB(o[1] = __builtin_amdgcn_mfma_f32_32x32x16_bf16(PAF(3), VFR(7), o[1], 0, 0, 0), C1, 12); \
    } while (0)
    int t = 1;
#undef CMASK
#define CMASK(P0, P1, t) do {} while (0)
    for (; t + 5 < NT; t += 2) {
        STEP(pB0, pB1, pA0, pA1, t, true, true, true);     WAIT_BAR(2); RESC(); ROT();
        STEP(pA0, pA1, pB0, pB1, t + 1, true, true, true); WAIT_BAR(2); RESC(); ROT();
    }
#undef CMASK
#define CMASK(P0, P1, t) do { if (MASK) { int jb_ = (t) - (NT - 4); if (jb_ >= 0) cmask(P0, P1, jb_, wid); } } while (0)
#define ENDW(tt) do { if ((tt) + 3 < NT) { WAIT_BAR(2); } else if ((tt) + 2 < NT) { WAIT_BAR(1); } else { WAIT_BAR(0); } } while (0)
    for (; t + 1 < NT; t += 2) {
        STEP(pB0, pB1, pA0, pA1, t, (t + 3 < NT), (t + 1 < NT), (t + 1 < NT));       ENDW(t);     RESC(); ROT();
        STEP(pA0, pA1, pB0, pB1, t + 1, (t + 4 < NT), (t + 2 < NT), (t + 2 < NT));   ENDW(t + 1); RESC(); ROT();
    }
    STEP(pB0, pB1, pA0, pA1, NT - 1, false, false, false); RESC();
    { float sacc = pB0[0] + pB0[1]; _Pragma("unroll") for (int r = 2; r < 16; ++r) sacc += pB0[r]; _Pragma("unroll") for (int r = 0; r < 16; ++r) sacc += pB1[r]; l_reg += sacc;
      pw0 = (u32x4){PKW(pB0, 0), PKW(pB0, 2), PKW(pB0, 4), PKW(pB0, 6)}; pw1 = (u32x4){PKW(pB0, 8), PKW(pB0, 10), PKW(pB0, 12), PKW(pB0, 14)}; pw2 = (u32x4){PKW(pB1, 0), PKW(pB1, 2), PKW(pB1, 4), PKW(pB1, 6)}; pw3 = (u32x4){PKW(pB1, 8), PKW(pB1, 10), PKW(pB1, 12), PKW(pB1, 14)};
      SBAR(); pv(o, vb0 + sl_cur, PAF(0), PAF(1), PAF(2), PAF(3)); }
#undef PKW
#undef PAF
#undef VFR
#undef PIN
#undef MX3
#undef GAPA
#undef GAPB
#undef EX
#undef VRD
#undef KRD
#undef STEP
#undef ENDW
    { auto rr = __builtin_amdgcn_permlane32_swap(__float_as_uint(l_reg), __float_as_uint(l_reg), false, false); l_reg = __uint_as_float(rr[0]) + __uint_as_float(rr[1]); }
    if (hi == 0) wsf[32 + r32] = l_reg; asm volatile("s_waitcnt lgkmcnt(0)" ::: "memory");
    float rli[16];
#pragma unroll
    for (int r = 0; r < 16; ++r) rli[r] = __builtin_amdgcn_rcpf(wsf[32 + crow(r, hi)]);
    bf16* Ow = Oh + (long)(q0 + wid * QBLK) * op;
    { bf16* stg = (bf16*)(shm + LDS_OST) + wid * 2048;
#pragma unroll
      for (int r = 0; r < 16; ++r) { const int orow = crow(r, hi);
#pragma unroll
        for (int d0 = 0; d0 < 2; ++d0) stg[orow * 64 + d0 * 32 + r32] = __float2bfloat16(o[d0][r] * rli[r]); }
      asm volatile("s_waitcnt lgkmcnt(0)" ::: "memory");
#pragma unroll
      for (int i = 0; i < 4; ++i) { const int row = i * 8 + (lane >> 3), ch = lane & 7; const u32x4 v = *(const u32x4*)(stg + row * 64 + ch * 8); *(u32x4*)(Ow + (long)row * op + ch * 8) = v; } }
    asm volatile("s_waitcnt lgkmcnt(0)\n\ts_barrier" ::: "memory");
#undef DMA_K
#undef DMA_V
#undef CMASK
#undef START
#undef RESC
#undef ROT
}

constexpr int L2_K = 0, L2_V = 3 * 8192, L2_WS = L2_V + 4 * 16384, L2_OST = L2_WS + NW * 64 * 4, L2_BYTES = L2_OST + NW * 4096;
template <bool MASK> __device__ __forceinline__ void attn_unit2(int q0, int NT, const bf16* Qh, int qp, const bf16* __restrict__ Kh, int kp, const bf16* __restrict__ Vh, int vp, bf16* Oh, int op, char* shm) {
    const int tid = threadIdx.x, lane = tid & 63, r32 = lane & 31, hi = lane >> 5; const int wid = __builtin_amdgcn_readfirstlane(tid >> 6);
    const bf16* Qw = Qh + (long)(q0 + wid * QBLK) * qp;
    const unsigned lds0 = (unsigned)(uintptr_t)shm;
    float* wsf = (float*)(shm + L2_WS) + wid * 64;
    const bf16* ksrc = Kh + (long)lane * kp + wid * 8;
    const bf16* vsrc = Vh + (long)(16 * (wid & 3) + (lane >> 2)) * vp + (wid >> 2) * 32 + (lane & 3) * 8;
    const unsigned kdst = lds0 + L2_K + wid * 1024, vdst = lds0 + L2_V + wid * 1024;
#define DMA_K(t, slot) glds16(ksrc + (long)(t) * KVBLK * kp, (unsigned)__builtin_amdgcn_readfirstlane(kdst + (slot)))
#define DMA_V(t, vslot) do { glds16(vsrc + (long)(t) * KVBLK * vp, (unsigned)__builtin_amdgcn_readfirstlane(vdst + (vslot))); \
                            glds16(vsrc + (long)(t) * KVBLK * vp + 64, (unsigned)__builtin_amdgcn_readfirstlane(vdst + (vslot) + 8192)); } while (0)
    const int vb0 = (int)(lds0 + L2_V) + ((lane >> 4) & 1) * 32 + (lane & 3) * 8 + (4 * hi + ((lane & 15) >> 2)) * 64;
    const char* Kbase = shm + L2_K; bf16x8 kf[8];
    const lds_cptr shm3 = (lds_cptr)shm; const lds_cptr kp0 = shm3 + L2_K + hi * 1024 + r32 * 16; const lds_cptr vp0 = shm3 + L2_V + ((lane >> 4) & 1) * 32 + (lane & 3) * 8 + (4 * hi + ((lane & 15) >> 2)) * 64;
    DMA_K(0, 0); DMA_V(0, 0); DMA_K(1, SLOTB);
    bf16x8 qr[4];
#pragma unroll
    for (int d0 = 0; d0 < 4; ++d0) qr[d0] = *reinterpret_cast<const bf16x8*>(&Qw[(long)r32 * qp + d0 * 16 + hi * 8]);
    float l_reg = 0.f; f32x16 o[4]; o[0] = f32x16{}; o[1] = f32x16{}; o[2] = f32x16{}; o[3] = f32x16{};
    const f32x16 zero16 = f32x16{};
#define CMASK(P0, P1, t) do { if (MASK) { int jb_ = (t) - (NT - 4); if (jb_ >= 0) cmask(P0, P1, jb_, wid); } } while (0)
    f32x16 pA0, pA1, pB0, pB1;
    int sl_prev = 0, sl_cur = 0, sl_next = SLOTB;
    int vs_rd = 0, vs_wr = 3 * 16384;
#define ROT() do { sl_prev = sl_cur; sl_cur = sl_next; sl_next = (sl_next == (NSLOT - 1) * SLOTB) ? 0 : sl_next + SLOTB; vs_rd = (vs_rd + 16384) & 65535; vs_wr = (vs_wr + 16384) & 65535; } while (0)
    DMA_K(2, 2 * SLOTB); DMA_V(1, 16384);
    WAIT_BAR(6);
    qkt(pA0, pA1, Kbase, qr, zero16, r32, hi); CMASK(pA0, pA1, 0);
    _Pragma("unroll") for (int r = 0; r < 16; ++r) { pA0[r] = __builtin_amdgcn_exp2f(pA0[r]); pA1[r] = __builtin_amdgcn_exp2f(pA1[r]); }
    WAIT_BAR(2);
    DMA_K(3, 0); DMA_V(2, 2 * 16384);
    sl_prev = sl_cur; sl_cur = sl_next; sl_next = 2 * SLOTB;
    kload8(kf, kp0 + sl_cur);
    WAIT_BAR(5);
    s16x4 f0lo, f0hi, f1lo, f1hi, f2lo, f2hi, f3lo, f3hi; u32x4 pw0, pw1, pw2, pw3;
#define PKW(P, B) cvtpk_s(P[B], P[B + 1])
#define PAF(k) __builtin_bit_cast(bf16x8, pw##k)
#define PIN(x) asm volatile("" : "+v"(x))
#define EX(v) __builtin_amdgcn_exp2f(v)
#define VOFF(id) ((((id) >> 2) * 4096) + (((id) & 3) * 1024))
#define VRD2(F, id) do { F##lo = vtr(vp_ + VOFF(id)); F##hi = vtr(vp_ + VOFF(id) + 512); } while (0)
#define VFR2(F) (bf16x8){F##lo[0], F##lo[1], F##lo[2], F##lo[3], F##hi[0], F##hi[1], F##hi[2], F##hi[3]}
#define GAPA(MF, A0, A1, A2, A3, W0, W1, PW) do { MF; sacc += A0; sacc += A1; sacc += A2; sacc += A3; PIN(sacc); W0; W1; PIN(PW); SBAR(); } while (0)
#define GAPB(MF, RD, X, B) do { MF; RD; X[B] = EX(X[B]); X[B + 1] = EX(X[B + 1]); PIN(X); SBAR(); } while (0)
#define KRD(G, j) do { if (G) { kload2(kf, kp0 + sl_next, j); SBAR(); } } while (0)
#define MF32(a, b, c) __builtin_amdgcn_mfma_f32_32x32x16_bf16(a, b, c, 0, 0, 0)
#define STEP(C0, C1, P0, P1, t, GK, GV, GL) do { SBAR(); __builtin_amdgcn_s_setprio(ATTN_PRIO_A); \
    const lds_cptr vp_ = vp0 + vs_rd; \
    float sacc = (P0[0] + P0[1]); \
    GAPA(C0 = MF32(kf[0], qr[0], zero16), P0[2], P0[3], P0[4], P0[5],     pw0[0] = PKW(P0, 0), pw0[1] = PKW(P0, 2), pw0); \
    GAPA(C1 = MF32(kf[1], qr[0], zero16), P0[6], P0[7], P0[8], P0[9],     pw0[2] = PKW(P0, 4), pw0[3] = PKW(P0, 6), pw0); \
    GAPA(C0 = MF32(kf[2], qr[1], C0),     P0[10], P0[11], P0[12], P0[13], pw1[0] = PKW(P0, 8), pw1[1] = PKW(P0, 10), pw1); \
    GAPA(C1 = MF32(kf[3], qr[1], C1),     P0[14], P0[15], P1[0], P1[1],   pw1[2] = PKW(P0, 12), pw1[3] = PKW(P0, 14), pw1); \
    VRD2(f0, 0); SBAR();  GAPA(C0 = MF32(kf[4], qr[2], C0), P1[2], P1[3], P1[4], P1[5],     pw2[0] = PKW(P1, 0), pw2[1] = PKW(P1, 2), pw2); \
    VRD2(f1, 4); SBAR();  GAPA(C1 = MF32(kf[5], qr[2], C1), P1[6], P1[7], P1[8], P1[9],     pw2[2] = PKW(P1, 4), pw2[3] = PKW(P1, 6), pw2); \
    VRD2(f2, 8); SBAR();  GAPA(C0 = MF32(kf[6], qr[3], C0), P1[10], P1[11], P1[12], P1[13], pw3[0] = PKW(P1, 8), pw3[1] = PKW(P1, 10), pw3); \
    VRD2(f3, 12); SBAR(); GAPA(C1 = MF32(kf[7], qr[3], C1), P1[14], P1[15], 0.f, 0.f,       pw3[2] = PKW(P1, 12), pw3[3] = PKW(P1, 14), pw3); \
    l_reg += sacc; __builtin_amdgcn_s_setprio(0); \
    if (GK) { DMA_K((t) + 3, sl_cur); } if (GV) { DMA_V((t) + 2, vs_wr); } \
    CMASK(C0, C1, t); \
    SBAR(); __builtin_amdgcn_s_setprio(ATTN_PRIO_B); \
    GAPB(o[0] = MF32(PAF(0), VFR2(f0), o[0]), VRD2(f0, 1),  C0, 0); \
    GAPB(o[1] = MF32(PAF(0), VFR2(f1), o[1]), VRD2(f1, 5),  C0, 2); \
    GAPB(o[2] = MF32(PAF(0), VFR2(f2), o[2]), VRD2(f2, 9),  C0, 4); \
    GAPB(o[3] = MF32(PAF(0), VFR2(f3), o[3]), VRD2(f3, 13), C0, 6); \
    KRD(GL, 0); GAPB(o[0] = MF32(PAF(1), VFR2(f0), o[0]), VRD2(f0, 2),  C0, 8); \
    GAPB(o[1] = MF32(PAF(1), VFR2(f1), o[1]), VRD2(f1, 6),  C0, 10); \
    KRD(GL, 1); GAPB(o[2] = MF32(PAF(1), VFR2(f2), o[2]), VRD2(f2, 10), C0, 12); \
    GAPB(o[3] = MF32(PAF(1), VFR2(f3), o[3]), VRD2(f3, 14), C0, 14); \
    KRD(GL, 2); GAPB(o[0] = MF32(PAF(2), VFR2(f0), o[0]), VRD2(f0, 3),  C1, 0); \
    GAPB(o[1] = MF32(PAF(2), VFR2(f1), o[1]), VRD2(f1, 7),  C1, 2); \
    KRD(GL, 3); GAPB(o[2] = MF32(PAF(2), VFR2(f2), o[2]), VRD2(f2, 11), C1, 4); \
    GAPB(o[3] = MF32(PAF(2), VFR2(f3), o[3]), VRD2(f3, 15), C1, 6); \
    GAPB(o[0] = MF32(PAF(3), VFR2(f0), o[0]), (void)0, C1, 8); \
    GAPB(o[1] = MF32(PAF(3), VFR2(f1), o[1]), (void)0, C1, 10); \
    GAPB(o[2] = MF32(PAF(3), VFR2(f2), o[2]), (void)0, C1, 12); \
    GAPB(o[3] = MF32(PAF(3), VFR2(f3), o[3]), (void)0, C1, 14); __builtin_amdgcn_s_setprio(0); \
    } while (0)
    int t = 1;
#undef CMASK
#define CMASK(P0, P1, t) do {} while (0)
    for (; t + 5 < NT; t += 2) {
        STEP(pB0, pB1, pA0, pA1, t, true, true, true);     WAIT_BAR(5); ROT();
        STEP(pA0, pA1, pB0, pB1, t + 1, true, true, true); WAIT_BAR(5); ROT();
    }
#undef CMASK
#define CMASK(P0, P1, t) do { if (MASK) { int jb_ = (t) - (NT - 4); if (jb_ >= 0) cmask(P0, P1, jb_, wid); } } while (0)
#define ENDW(tt) do { if ((tt) + 3 < NT) { WAIT_BAR(5); } else if ((tt) + 2 < NT) { WAIT_BAR(4); } else { WAIT_BAR(0); } } while (0)
    for (; t + 1 < NT; t += 2) {
        STEP(pB0, pB1, pA0, pA1, t, (t + 3 < NT), (t + 2 < NT), (t + 1 < NT));       ENDW(t);     ROT();
        STEP(pA0, pA1, pB0, pB1, t + 1, (t + 4 < NT), (t + 3 < NT), (t + 2 < NT));   ENDW(t + 1); ROT();
    }
    STEP(pB0, pB1, pA0, pA1, NT - 1, false, false, false);
    { float sacc = pB0[0] + pB0[1]; _Pragma("unroll") for (int r = 2; r < 16; ++r) sacc += pB0[r]; _Pragma("unroll") for (int r = 0; r < 16; ++r) sacc += pB1[r]; l_reg += sacc;
      pw0 = (u32x4){PKW(pB0, 0), PKW(pB0, 2), PKW(pB0, 4), PKW(pB0, 6)}; pw1 = (u32x4){PKW(pB0, 8), PKW(pB0, 10), PKW(pB0, 12), PKW(pB0, 14)}; pw2 = (u32x4){PKW(pB1, 0), PKW(pB1, 2), PKW(pB1, 4), PKW(pB1, 6)}; pw3 = (u32x4){PKW(pB1, 8), PKW(pB1, 10), PKW(pB1, 12), PKW(pB1, 14)};
      SBAR();
      const lds_cptr vp_ = vp0 + ((vs_rd + 16384) & 65535);
#pragma unroll
      for (int db = 0; db < 4; ++db) { VRD2(f0, db * 4 + 0); VRD2(f1, db * 4 + 1); VRD2(f2, db * 4 + 2); VRD2(f3, db * 4 + 3);
          o[db] = MF32(PAF(0), VFR2(f0), o[db]); o[db] = MF32(PAF(1), VFR2(f1), o[db]); o[db] = MF32(PAF(2), VFR2(f2), o[db]); o[db] = MF32(PAF(3), VFR2(f3), o[db]); } }
#undef PKW
#undef PAF
#undef PIN
#undef EX
#undef VOFF
#undef VRD2
#undef VFR2
#undef GAPA
#undef GAPB
#undef KRD
#undef MF32
#undef STEP
#undef ENDW
    { auto rr = __builtin_amdgcn_permlane32_swap(__float_as_uint(l_reg), __float_as_uint(l_reg), false, false); l_reg = __uint_as_float(rr[0]) + __uint_as_float(rr[1]); }
    if (hi == 0) wsf[32 + r32] = l_reg; asm volatile("s_waitcnt lgkmcnt(0)" ::: "memory");
    float rli[16];
#pragma unroll
    for (int r = 0; r < 16; ++r) rli[r] = __builtin_amdgcn_rcpf(wsf[32 + crow(r, hi)]);
    bf16* Ow = Oh + (long)(q0 + wid * QBLK) * op;
    { bf16* stg = (bf16*)(shm + L2_OST) + wid * 2048;
#pragma unroll
      for (int dh = 0; dh < 2; ++dh) {
#pragma unroll
        for (int r = 0; r < 16; ++r) { const int orow = crow(r, hi);
#pragma unroll
          for (int d0 = 0; d0 < 2; ++d0) stg[orow * 64 + d0 * 32 + r32] = __float2bfloat16(o[dh * 2 + d0][r] * rli[r]); }
        asm volatile("s_waitcnt lgkmcnt(0)" ::: "memory");
#pragma unroll
        for (int i = 0; i < 4; ++i) { const int row = i * 8 + (lane >> 3), ch = lane & 7; const u32x4 v = *(const u32x4*)(stg + row * 64 + ch * 8); *(u32x4*)(Ow + (long)row * op + dh * 64 + ch * 8) = v; }
        asm volatile("s_waitcnt lgkmcnt(0)" ::: "memory"); } }
    asm volatile("s_waitcnt lgkmcnt(0)\n\ts_barrier" ::: "memory");
#undef DMA_K
#undef DMA_V
#undef CMASK
#undef ROT
}
#undef SBAR
#undef WAIT_BAR
}

#define XB_TMO      128
#define XB_XCNT(j)  (256  + 64 * (j))
#define XB_XSUB(j)  (1280 + 64 * (j))
#define XB_XGEN(j)  (2304 + 64 * (j))
#define XB_TOP      3328
#define XB_TOPGEN   3392
#define XCD_BAR_WORDS 3456
#define XB_SPIN_CAP (1u << 22)
__device__ __forceinline__ unsigned xb_ld(unsigned* p)              { return __hip_atomic_load(p, __ATOMIC_RELAXED, __HIP_MEMORY_SCOPE_AGENT); }
__device__ __forceinline__ unsigned xb_add(unsigned* p, unsigned v) { return __hip_atomic_fetch_add(p, v, __ATOMIC_RELAXED, __HIP_MEMORY_SCOPE_AGENT); }
__device__ __forceinline__ unsigned xb_xcc_id() { return (unsigned)__builtin_amdgcn_s_getreg((3 << 11) | 20) & 0xFu; }
#define XB_SPIN(cond, bar) do { unsigned _sp = 0; while (cond) { __builtin_amdgcn_s_sleep(1); \
    if ((++_sp & 255u) == 0u) { if (xb_ld(&(bar)[XB_TMO])) break; if (_sp > XB_SPIN_CAP) { atomicAdd(&(bar)[XB_TMO], 1u); break; } } } } while (0)
struct XcdBarrier { unsigned* bar; unsigned x; volatile LAS unsigned* st; };
__device__ __forceinline__ XcdBarrier xcd_barrier_post(unsigned* bar, volatile LAS unsigned* st) {
    XcdBarrier b; b.bar = bar; b.x = xb_xcc_id(); b.st = st;
    if (threadIdx.x == 0) (void)xb_add(&bar[XB_XCNT(b.x)], 1u);
    return b;
}
__device__ __forceinline__ void xcd_barrier_complete(unsigned* bar, unsigned x, unsigned& nloc, unsigned& nx) {
    const unsigned G = gridDim.x * gridDim.y * gridDim.z;
    unsigned sum, cnt, mine, sp = 0u;
    for (;;) {
        sum = 0u; cnt = 0u; mine = 0u;
#pragma unroll
        for (unsigned j = 0; j < 16; ++j) { const unsigned c = xb_ld(&bar[XB_XCNT(j)]); sum += c; cnt += (c > 0u) ? 1u : 0u; mine = (j == x) ? c : mine; }
        if (sum == G) break;
        __builtin_amdgcn_s_sleep(1);
        if ((++sp & 255u) == 0u) { if (xb_ld(&bar[XB_TMO])) break; if (sp > XB_SPIN_CAP) { atomicAdd(&bar[XB_TMO], 1u); break; } }
    }
    nloc = mine > 0u ? mine : 1u; nx = cnt > 0u ? cnt : 1u;
}
__device__ __forceinline__ void xcd_barrier(const XcdBarrier& b) {
    asm volatile("s_waitcnt vmcnt(0)" ::: "memory");
    __syncthreads();
    if (threadIdx.x == 0) {
        unsigned* bar = b.bar;
        __builtin_amdgcn_s_waitcnt(0);
        unsigned nloc = b.st[0], nx = b.st[1];
        if (nloc == 0u) { xcd_barrier_complete(bar, b.x, nloc, nx); b.st[0] = nloc; b.st[1] = nx; }
        const unsigned old = xb_add(&bar[XB_XSUB(b.x)], 1u);
        const unsigned gen = old / nloc;
        if (old + 1u == (gen + 1u) * nloc) {
            __builtin_amdgcn_fence(__ATOMIC_RELEASE, "agent");
            asm volatile("s_waitcnt vmcnt(0)" ::: "memory");
            const unsigned og = xb_add(&bar[XB_TOP], 1u);
            const unsigned tg = og / nx;
            if (og + 1u == (tg + 1u) * nx) xb_add(&bar[XB_TOPGEN], 1u);
            else XB_SPIN(xb_ld(&bar[XB_TOPGEN]) == tg, bar);
            __builtin_amdgcn_fence(__ATOMIC_ACQUIRE, "agent");
            xb_add(&bar[XB_XGEN(b.x)], 1u);
            asm volatile("s_waitcnt vmcnt(0)" ::: "memory");
        } else {
            XB_SPIN(xb_ld(&bar[XB_XGEN(b.x)]) == gen, bar);
            __builtin_amdgcn_fence(__ATOMIC_ACQUIRE, "agent");
            asm volatile("s_waitcnt vmcnt(0)" ::: "memory");
        }
    }
    __syncthreads();
}

constexpr int RING_BYTES = 131072;
constexpr int MISC_OFF = RING_BYTES;
constexpr int LDS_BYTES = 147456;
constexpr int NWAVES = 8;

struct Args {
    const float* in[29]; float* out; unsigned char* ws; int ph_lo, ph_hi;
};
enum { I_X = 0, I_MEM, I_NORM1, I_WIN, I_BGATE, I_QN, I_KN, I_LQ1, I_LK1, I_LQ2, I_LK2, I_SUBLN, I_WPOOL, I_PSCALE, I_MEMNORM, I_WMKV, I_MQN, I_MKN, I_WBRD, I_WBRP, I_WBRM, I_WOUT, I_NORM2,
       I_WROUTER, I_BROUTER, I_WGU, I_BGU, I_WD, I_BD };

__device__ __forceinline__ unsigned f2bf(float f) { unsigned u = __builtin_bit_cast(unsigned, f); return (u + 0x7fffu + ((u >> 16) & 1u)) >> 16; }
__device__ __forceinline__ unsigned pk2(float lo, float hi) { return f2bf(lo) | (f2bf(hi) << 16); }
__device__ __forceinline__ void p0_transpose_item(const float* W, int K, int N, bf16_t* WT, LAS float* scr, int item, int lane, int ldo = 0) {
    if (ldo == 0) ldo = K;
    const int nblk = N / 64, kb = item / nblk, nb = item % nblk, k0 = 64 * kb, n0 = 64 * nb;
    const int kr = lane >> 3, n4 = (lane & 7) * 4;
    f32x4 v[16];
#pragma unroll
    for (int i = 0; i < 16; ++i) v[i] = *(const f32x4*)(W + (size_t)(k0 + 8 * (i & 7) + kr) * N + n0 + 32 * (i >> 3) + n4);
#pragma unroll
    for (int h = 0; h < 2; ++h) {
#pragma unroll
        for (int i = 0; i < 8; ++i)
#pragma unroll
            for (int j = 0; j < 4; ++j) scr[(n4 + j) * 68 + 8 * i + kr] = v[h * 8 + i][j];
        LDS_WAIT(); asm volatile("" ::: "memory");
        const int c = lane & 7;
#pragma unroll
        for (int jj = 0; jj < 4; ++jj) { const int nrow = 8 * jj + (lane >> 3); const LAS f32x4* sp = (const LAS f32x4*)(scr + nrow * 68 + 8 * c);
            const f32x4 a = sp[0], b = sp[1];
            u32x4 o; o.x = pk2(a[0], a[1]); o.y = pk2(a[2], a[3]); o.z = pk2(b[0], b[1]); o.w = pk2(b[2], b[3]);
            *(u32x4*)(WT + (size_t)(n0 + 32 * h + nrow) * ldo + k0 + 8 * c) = o; }
        LDS_WAIT(); asm volatile("" ::: "memory");
    }
}
__device__ __forceinline__ void p0_transpose_item_f8(const float* W, int K, int N, unsigned char* WT, LAS float* scr, int item, int lane) {
    const int nblk = N / 64, kb = item / nblk, nb = item % nblk, k0 = 64 * kb, n0 = 64 * nb;
    const int kr = lane >> 3, n4 = (lane & 7) * 4;
    f32x4 v[16];
#pragma unroll
    for (int i = 0; i < 16; ++i) v[i] = *(const f32x4*)(W + (size_t)(k0 + 8 * (i & 7) + kr) * N + n0 + 32 * (i >> 3) + n4);
#pragma unroll
    for (int h = 0; h < 2; ++h) {
#pragma unroll
        for (int i = 0; i < 8; ++i)
#pragma unroll
            for (int j = 0; j < 4; ++j) scr[(n4 + j) * 68 + 8 * i + kr] = v[h * 8 + i][j];
        LDS_WAIT(); asm volatile("" ::: "memory");
        const int c = lane & 7;
#pragma unroll
        for (int jj = 0; jj < 4; ++jj) { const int nrow = 8 * jj + (lane >> 3); const LAS f32x4* sp = (const LAS f32x4*)(scr + nrow * 68 + 8 * c);
            const f32x4 a = sp[0] * W8_SCALE, b = sp[1] * W8_SCALE;
            u32x2 o; o.x = pk4_fp8(a[0], a[1], a[2], a[3]); o.y = pk4_fp8(b[0], b[1], b[2], b[3]);
            *(u32x2*)(WT + (size_t)(n0 + 32 * h + nrow) * K + k0 + 8 * c) = o; }
        LDS_WAIT(); asm volatile("" ::: "memory");
    }
}
__device__ __forceinline__ void rms_row_to_bf16(const float* xrow, const float* gain, bf16_t* orow, int lane) {
    const f32x4* xr = (const f32x4*)xrow + lane; const f32x4* gr = (const f32x4*)gain + lane;
    f32x4 v[4]; float s = 0.f;
#pragma unroll
    for (int j = 0; j < 4; ++j) { v[j] = xr[64 * j]; s += (v[j].x * v[j].x + v[j].y * v[j].y) + (v[j].z * v[j].z + v[j].w * v[j].w); }
    const float rstd = 1.f / sqrtf(wave_sum(s) * (1.f / 1024.f) + RMS_EPS);
    u32x2* o8 = (u32x2*)orow + lane;
#pragma unroll
    for (int j = 0; j < 4; ++j) { const f32x4 g = gr[64 * j]; u32x2 w; w.x = pk2(v[j].x * rstd * g.x, v[j].y * rstd * g.y); w.y = pk2(v[j].z * rstd * g.z, v[j].w * rstd * g.w); o8[64 * j] = w; }
}

__device__ __forceinline__ void cvt_item64_f8(const float* W, int K, int N, unsigned char* WT, int item, int lane) {
    const int nblk = N / 64, kb = item / nblk, nb = item % nblk, k0 = 64 * kb, n0 = 64 * nb;
    const char* base = (const char*)(W + (size_t)k0 * N + n0);
    unsigned off = (unsigned)lane * 4u; const unsigned rstep = (unsigned)N * 4u;
    float v[64];
#pragma unroll
    for (int j = 0; j < 64; ++j) { v[j] = *(const float*)(base + off); off += rstep; }
    unsigned char* dst = WT + (size_t)(n0 + lane) * K + k0;
#pragma unroll
    for (int c = 0; c < 4; ++c) { u32x4 o;
#pragma unroll
        for (int q = 0; q < 4; ++q) { int r = __builtin_amdgcn_cvt_pk_fp8_f32(v[16 * c + 4 * q] * W8_SCALE, v[16 * c + 4 * q + 1] * W8_SCALE, 0, false);
            r = __builtin_amdgcn_cvt_pk_fp8_f32(v[16 * c + 4 * q + 2] * W8_SCALE, v[16 * c + 4 * q + 3] * W8_SCALE, r, true); o[q] = (unsigned)r; }
        *(u32x4*)(dst + 16 * c) = o; }
}
struct CvtJob {
    const float* wgu; const float* wd; unsigned char* wgu_t; unsigned char* wd_t; int ngw, gw, lane;
    __device__ __forceinline__ void item(int j) const {
        const int it = gw + j * ngw; if (it >= 24576) return;
        const bool gu = it < 16384; const int r = gu ? it : it - 16384, e = gu ? (r >> 9) : (r >> 8), idx = gu ? (r & 511) : (r & 255), N = gu ? 2048 : 1024;
        const float* W = gu ? wgu + (size_t)e * 1024 * 2048 : wd + (size_t)e * 1024 * 1024; unsigned char* WT = gu ? wgu_t + (size_t)e * 2048 * 1024 : wd_t + (size_t)e * 1024 * 1024;
        cvt_item64_f8(W, 1024, N, WT, idx, lane);
    }
};
struct PostCvt { CvtJob J; int jbase, jend; __device__ __forceinline__ void operator()(int ui) const { const int j = jbase + ui; if (j < jend) J.item(j); } };
struct Args;
typedef __attribute__((address_space(4))) const Args* kargs_t;
__device__ __forceinline__ kargs_t kargs() { kargs_t p = (kargs_t)__builtin_amdgcn_kernarg_segment_ptr(); asm volatile("" : "+s"(p)); return p; }
__global__ void __launch_bounds__(NWAVES * 64, 2) fwd_kernel(Args args) {
    extern __shared__ __attribute__((aligned(16))) unsigned char lds_raw[];
    cg::grid_group grid = cg::this_grid();
    LAS unsigned char* lds = (LAS unsigned char*)lds_raw;
    const int tid = threadIdx.x, lane = tid & 63, wave = __builtin_amdgcn_readfirstlane(tid >> 6);
    const int G = gridDim.x, bx = blockIdx.x; const int vcu = (G % 8 == 0) ? (bx % 8) * (G / 8) + bx / 8 : bx;
    const int gw = vcu * NWAVES + wave, NGW = G * NWAVES;
    const int lo = args.ph_lo, hi = args.ph_hi;
    if (tid < 64) ((LAS unsigned*)(lds + MISC_OFF + 1024))[tid] = 0u;
    __syncthreads();
    const XcdBarrier xbar = xcd_barrier_post((unsigned*)(args.ws + WS_CTL) + CW_BAR, (volatile LAS unsigned*)(lds + MISC_OFF + 1024));
#ifndef PHMASK
#define PHMASK 0x3ff
#endif
#define IN(k) (((PHMASK >> (k)) & 1) && lo <= (k) && (k) < hi)
#define GSYNC() do { asm volatile("s_waitcnt vmcnt(0) lgkmcnt(0)" ::: "memory"); __syncthreads(); grid.sync(); asm volatile("s_waitcnt vmcnt(0)" ::: "memory"); __syncthreads(); } while (0)
#define SEAM(k) do { if (lo <= (k) && (k) + 1 < hi) { xcd_barrier(xbar); } } while (0)
#define WSP(TY, off) ((TY*)(ka->ws + (off)))
#define WIN_T WSP(bf16_t, WS_WIN_T)
#define WBRD_T WSP(bf16_t, WS_WBRD_T)
#define WBRP_T WSP(bf16_t, WS_WBRP_T)
#define WBRM_T WSP(bf16_t, WS_WBRM_T)
#define WOUT_T WSP(bf16_t, WS_WOUT_T)
#define WMKV_T WSP(bf16_t, WS_WMKV_T)
#define WGU_T WSP(bf16_t, WS_WGU_T)
#define WD_T WSP(bf16_t, WS_WD_T)
#define XN WSP(bf16_t, WS_XN)
#define Qb WSP(bf16_t, WS_Q)
#define Kb WSP(bf16_t, WS_K)
#define Vb WSP(bf16_t, WS_V)
#define Ub WSP(bf16_t, WS_U)
#define MQb WSP(bf16_t, WS_MQ)
#define OC WSP(bf16_t, WS_OC)
#define GATES WSP(bf16_t, WS_GATES)
#define YCAT WSP(bf16_t, WS_YCAT)
#define MERGF WSP(float, WS_MERGF)
#define MERGB WSP(bf16_t, WS_MERGB)
#define XG WSP(bf16_t, WS_XG)
#define ACT WSP(bf16_t, WS_A)
#define Y4 WSP(bf16_t, WS_B)
#define MEMN WSP(bf16_t, WS_MEMN)
#define MKV WSP(bf16_t, WS_MKV)
#define ROPE WSP(f32x2, WS_ROPE)
#define WR2 WSP(float, WS_WR2)
#define ROUTEW WSP(float, WS_ROUTEW)
#define LAMP WSP(float, WS_LAM)
#define LIST WSP(u32x2, WS_LIST)
#define CNT WSP(unsigned, WS_CTL)
#define OUT (ka->out)
#define KA const kargs_t ka = kargs()

    if (lo > 1000) GSYNC();
    if (IN(0)) for (int rep_ = 0; rep_ < 1 + ((REPEAT_MASK >> 0) & 1); ++rep_) { KA; if (rep_) __syncthreads();
        LAS float* scr = (LAS float*)(lds + wave * 16384);
        constexpr int I0 = 16 * 80, I1 = 8 * 16, I2 = 4 * 16, I3 = 4 * 16, I4 = 16 * 16, I5 = 16 * 8, I6 = 0, I7 = 0;
        constexpr int NITEMS = I0 + I1 + I2 + I3 + I4 + I5 + I6 + I7;
        for (int it = gw; it < NITEMS; it += NGW) {
            int r = it;
            if (r < I0) { p0_transpose_item(ka->in[I_WIN], 1024, 5120, WIN_T, scr, r, lane); continue; } r -= I0;
            if (r < I1) { p0_transpose_item(ka->in[I_WBRD], 512, 1024, WBRD_T, scr, r, lane, 1024); continue; } r -= I1;
            if (r < I2) { p0_transpose_item(ka->in[I_WBRP], 256, 1024, WBRD_T + 512, scr, r, lane, 1024); continue; } r -= I2;
            if (r < I3) { p0_transpose_item(ka->in[I_WBRM], 256, 1024, WBRD_T + 768, scr, r, lane, 1024); continue; } r -= I3;
            if (r < I4) { p0_transpose_item(ka->in[I_WOUT], 1024, 1024, WOUT_T, scr, r, lane); continue; } r -= I4;
            p0_transpose_item(ka->in[I_WMKV], 1024, 512, WMKV_T, scr, r, lane);
        }
        for (int m = gw; m < T; m += NGW) rms_row_to_bf16(ka->in[I_X] + (size_t)m * 1024, ka->in[I_NORM1], XN + (size_t)m * 1024, lane);
        for (int m = gw; m < BATCH * MEMLEN; m += NGW) rms_row_to_bf16(ka->in[I_MEM] + (size_t)m * 1024, ka->in[I_MEMNORM], MEMN + (size_t)m * 1024, lane);
        for (int i = bx * 512 + tid; i < SEQ * 32; i += G * 512) { const int pos = i >> 5, j = i & 31;
            const float inv = 1.0f / powf(10000.0f, (float)(2 * j) / 64.0f); const float ang = (float)pos * inv;
            const double a = (double)ang; const double k = rint(a * 0.15915494309189535); const float red = (float)(a - k * 6.283185307179586);
            ROPE[i] = (f32x2){cosf(red), sinf(red)}; }
        for (int i = bx * 512 + tid; i < 1024 * 32; i += G * 512) { const int ii = i & 3, e = (i >> 2) & 15, kq = (i >> 6) & 3, eb = (i >> 8) & 1, s = i >> 9; const int k = 16 * s + 4 * kq + ii;
            WR2[i] = ka->in[I_NORM2][k] * ka->in[I_WROUTER][k * 32 + eb * 16 + e]; }
        if (bx == 0 && wave == 0) { const float s1 = wave_sum(ka->in[I_LQ1][lane] * ka->in[I_LK1][lane]), s2 = wave_sum(ka->in[I_LQ2][lane] * ka->in[I_LK2][lane]);
            if (lane == 0) LAMP[0] = expf(s1) - expf(s2) + 0.2f; }
    }
    SEAM(0);
    if (IN(1)) for (int rep_ = 0; rep_ < 1 + ((REPEAT_MASK >> 1) & 1); ++rep_) { KA; if (rep_) __syncthreads();
#if defined(TAP) && TAP == 6
        { pg8::DenseProb P{XN, WIN_T, 1024, 1024, 1024}; pg8::StaticOrder S; S.init(T, INW, G, bx);
          pg8::EpiPlain E{WSP(bf16_t, WS_B), 5120};
          pg8::gemm_phase<pg8::EpiPlain, pg8::DenseProb, pg8::StaticOrder, true>(lds, P, S, E); }
#else
        const CvtJob J{ka->in[I_WGU], ka->in[I_WD], (unsigned char*)WGU_T, (unsigned char*)WD_T, NGW, gw, lane};
        const int kpre = bx & 7;
        for (int j = 0; j < kpre; ++j) J.item(j);
        { pg8::DenseProb P{XN, WIN_T, 1024, 1024, 1024}; pg8::StaticOrder S0; S0.init(T, INW, G, bx); const pg8::TableOrder S = pg8::build_unit_table(S0, (LAS int*)(lds + MISC_OFF + 2048));
          pg8::EpiInProj E{Qb, Kb, Vb, Ub, MQb, GATES, ka->in[I_QN], ka->in[I_KN], ka->in[I_MQN], ka->in[I_BGATE], ROPE};
          const PostCvt PU{J, kpre, 12};
          pg8::gemm_phase<pg8::EpiInProj, pg8::DenseProb, pg8::TableOrder, ALIGN_EPI_SEL, PostCvt>(lds, P, S, E, PU); }
        for (int j = kpre + 10; j < 12; ++j) J.item(j);
#endif
        { pg8::DenseProb P{MEMN, WMKV_T, 1024, 1024, 1024}; pg8::StaticOrder S; S.init(BATCH * MEMLEN, 512, G, bx);
          pg8::EpiMemKV E{MKV, ka->in[I_MKN]};
          pg8::gemm_phase<pg8::EpiMemKV, pg8::DenseProb, pg8::StaticOrder, true>(lds, P, S, E); }
    }
    SEAM(1);
    if (IN(2)) for (int rep_ = 0; rep_ < 1 + ((REPEAT_MASK >> 2) & 1); ++rep_) { KA; if (rep_) __syncthreads();
        using abf = attn_body::bf16;
        {
            const int bh = vcu >> 4, b = bh >> 2, h = bh & 3, s = vcu & 15; const size_t rb = (size_t)b * SEQ;
            const float lam = LAMP[0];
            for (int i2 = 0; i2 < 4 * (1 + ((REPEAT_MASK >> 10) & 1)); ++i2) { const int ii = i2 & 3, c = ii & 1; const int qb = (ii < 2) ? s : 31 - s;
                attn_body::attn_unit2<true>(qb * 256, 4 * qb + 4, (const abf*)Qb + rb * 512 + (c * 4 + h) * 64, 512, (const abf*)Kb + rb * 512 + (c * 4 + h) * 64, 512,
                                            (const abf*)Vb + rb * 512 + h * 128, 512, (abf*)OC + rb * 1024 + (c * 4 + h) * 128, 1024, (char*)lds_raw);
                if (c == 1) {
                    asm volatile("s_waitcnt vmcnt(0)" ::: "memory");
#pragma unroll 1
                    for (int ps = 0; ps < 2; ++ps) {
                    const int row = ps * 16 + (lane >> 2), dq = (lane & 3) * 32; const size_t t = rb + (size_t)qb * 256 + wave * 32 + row;
                    const bf16_t* p0 = OC + t * 1024 + h * 128 + dq; const bf16_t* p1 = p0 + 512;
                    u32x4 a[4], bb[4];
#pragma unroll
                    for (int j = 0; j < 4; ++j) { a[j] = *(const u32x4*)(p0 + 8 * j); bb[j] = *(const u32x4*)(p1 + 8 * j); }
                    float ss = 0.f; f32x4 y[4][2];
#pragma unroll
                    for (int j = 0; j < 4; ++j) {
                        y[j][0] = (f32x4){bf_lo(a[j].x) - lam * bf_lo(bb[j].x), bf_hi(a[j].x) - lam * bf_hi(bb[j].x), bf_lo(a[j].y) - lam * bf_lo(bb[j].y), bf_hi(a[j].y) - lam * bf_hi(bb[j].y)};
                        y[j][1] = (f32x4){bf_lo(a[j].z) - lam * bf_lo(bb[j].z), bf_hi(a[j].z) - lam * bf_hi(bb[j].z), bf_lo(a[j].w) - lam * bf_lo(bb[j].w), bf_hi(a[j].w) - lam * bf_hi(bb[j].w)};
#pragma unroll
                        for (int q = 0; q < 4; ++q) ss += y[j][0][q] * y[j][0][q] + y[j][1][q] * y[j][1][q]; }
                    ss += __shfl_xor(ss, 1); ss += __shfl_xor(ss, 2);
                    const float rstd = 0.8f / sqrtf(ss * (1.0f / 128.0f) + RMS_EPS);
                    const float* sg = ka->in[I_SUBLN] + dq; bf16_t* yo = YCAT + t * 1024 + h * 128 + dq;
#pragma unroll
                    for (int j = 0; j < 4; ++j) { const f32x4 s0 = *(const f32x4*)(sg + 8 * j), s1 = *(const f32x4*)(sg + 8 * j + 4); pg8::store8(yo + 8 * j, y[j][0] * rstd * s0, y[j][1] * rstd * s1); }
                    }
                }
            }
        }
        {
            for (int i = 0; i < 2; ++i) { const int idx = vcu * 2 + i; if (idx >= 512) break; const int b = idx >> 7, h = (idx >> 5) & 3, qb = idx & 31;
                attn_body::attn_unit<8, false>(qb * 256, 4, (const abf*)MQb + (size_t)b * SEQ * 256 + h * 64, 256, (const abf*)MKV + (size_t)b * MEMLEN * 512 + h * 64, 512,
                                               (const abf*)MKV + (size_t)b * MEMLEN * 512 + 256 + h * 64, 512, (abf*)YCAT + (size_t)b * SEQ * 1024 + 768 + h * 64, 1024, (char*)lds_raw); }
        }
        {
            LAS bf16_t* ul = (LAS bf16_t*)lds;
            LAS bf16_t* pb = (LAS bf16_t*)(lds + 24576);
            const int col = tid & 255, half = tid >> 8, w = 2 << (col >> 6);
            const int mg = wave & 3, mdh = wave >> 2, r32 = lane & 31, hh = lane >> 5;
            bf16x8 bw[4];
#pragma unroll
            for (int sx = 0; sx < 4; ++sx) { const float* wp = ka->in[I_WPOOL] + (size_t)(mg * 64 + 16 * sx + 8 * hh) * 64 + mdh * 32 + r32;
                u32x4 pk; pk.x = pk2(wp[0], wp[64]); pk.y = pk2(wp[128], wp[192]); pk.z = pk2(wp[256], wp[320]); pk.w = pk2(wp[384], wp[448]); bw[sx] = __builtin_bit_cast(bf16x8, pk); }
            const int ocol = mg * 64 + mdh * 32 + r32; const float psc = ka->in[I_PSCALE][ocol];
            for (int tile = vcu; tile < T / 32; tile += G) {
                const int t0 = tile * 32, p0 = t0 & (SEQ - 1);
                __syncthreads();
                for (int pc = tid; pc < 47 * 32; pc += 512) { const int r = pc >> 5, ch = pc & 31; const int pos = p0 - 15 + r;
                    u32x4 v = {0u, 0u, 0u, 0u}; if (pos >= 0) v = *(const u32x4*)(Ub + (size_t)(t0 - 15 + r) * 256 + ch * 8);
                    *(LAS u32x4*)(ul + r * 256 + ch * 8) = v; }
                __syncthreads();
                {
                    float sum = 0.f; const int rbase = 15 + 16 * half;
                    for (int i = 1; i < w; ++i) sum += __uint_as_float((unsigned)ul[(rbase - i) * 256 + col] << 16);
#pragma unroll
                    for (int tk = 0; tk < 16; ++tk) { const float ucur = __uint_as_float((unsigned)ul[(rbase + tk) * 256 + col] << 16); sum += ucur;
                        const int pos = p0 + 16 * half + tk; const float cnt = (float)((pos + 1 < w) ? pos + 1 : w);
                        pb[(16 * half + tk) * 264 + col] = (bf16_t)f2bf(sum / cnt - ucur);
                        sum -= __uint_as_float((unsigned)ul[(rbase + tk - (w - 1)) * 256 + col] << 16); }
                }
                __syncthreads();
                f32x16 acc = f32x16{};
#pragma unroll
                for (int sx = 0; sx < 4; ++sx) { const bf16x8 af = *(const LAS bf16x8*)(pb + r32 * 264 + mg * 64 + 16 * sx + 8 * hh);
                    acc = __builtin_amdgcn_mfma_f32_32x32x16_bf16(af, bw[sx], acc, 0, 0, 0); }
#pragma unroll
                for (int r = 0; r < 16; ++r) { const int tok = t0 + (r & 3) + 8 * (r >> 2) + 4 * hh; YCAT[(size_t)tok * 1024 + 512 + ocol] = (bf16_t)f2bf(acc[r] * psc); }
            }
            __syncthreads();
        }
    }
    SEAM(2);
    if (IN(4)) for (int rep_ = 0; rep_ < 1 + ((REPEAT_MASK >> 4) & 1); ++rep_) { KA; if (rep_) __syncthreads();
        pg8::StaticOrder S0; S0.init(T, 1024, G, bx); const pg8::TableOrder S = pg8::build_unit_table(S0, (LAS int*)(lds + MISC_OFF + 2048));
        pg8::DenseProb P{YCAT, WBRD_T, 1024, 1024, 1024}; pg8::EpiMergeR E{GATES, MERGB};
        pg8::gemm_phase<pg8::EpiMergeR, pg8::DenseProb, pg8::TableOrder, ALIGN_EPI_SEL>(lds, P, S, E);
    }
    SEAM(4);
    if (IN(5)) for (int rep_ = 0; rep_ < 1 + ((REPEAT_MASK >> 5) & 1); ++rep_) { KA; if (rep_) __syncthreads();
        pg8::DenseProb P{MERGB, WOUT_T, 1024, 1024, 1024}; pg8::StaticOrder S0; S0.init(T, 1024, G, bx); const pg8::TableOrder S = pg8::build_unit_table(S0, (LAS int*)(lds + MISC_OFF + 2048));
        pg8::EpiWout E{ka->in[I_X], OUT, (unsigned char*)XG, ka->in[I_NORM2]};
        pg8::gemm_phase<pg8::EpiWout, pg8::DenseProb, pg8::TableOrder, ALIGN_EPI_SEL>(lds, P, S, E);
    }
    SEAM(5);
    if (IN(6)) { KA;
        LAS int* lcnt = (LAS int*)(lds + MISC_OFF); LAS int* lbase = lcnt + 32;
        const int ngroups = T / 16, rounds = (ngroups + NGW - 1) / NGW;
        for (int rd = 0; rd < rounds; ++rd) {
            const int grp = rd * NGW + gw; const bool valid = grp < ngroups;
            if (tid < 32) lcnt[tid] = 0;
            __syncthreads();
            int e_sel = 0, rank = 0; float w_sel = 0.f, rstd = 0.f; const int q = lane >> 4, tok = grp * 16 + (lane & 15);
            if (valid) {
                f32x4 d0 = {0.f, 0.f, 0.f, 0.f}, d1 = {0.f, 0.f, 0.f, 0.f}; float ss = 0.f;
                const float* xrow = OUT + (size_t)tok * 1024 + 4 * q; const f32x4* wr2 = (const f32x4*)WR2 + lane;
#pragma unroll 4
                for (int s = 0; s < 64; ++s) { const f32x4 xv = *(const f32x4*)(xrow + 16 * s); const f32x4 wa = wr2[(s * 2) * 64], wb = wr2[(s * 2 + 1) * 64];
                    ss += (xv[0] * xv[0] + xv[1] * xv[1]) + (xv[2] * xv[2] + xv[3] * xv[3]);
#pragma unroll
                    for (int j = 0; j < 4; ++j) { d0 = __builtin_amdgcn_mfma_f32_16x16x4f32(wa[j], xv[j], d0, 0, 0, 0); d1 = __builtin_amdgcn_mfma_f32_16x16x4f32(wb[j], xv[j], d1, 0, 0, 0); } }
                ss += __shfl_xor(ss, 16); ss += __shfl_xor(ss, 32);
                rstd = 1.0f / sqrtf(ss * (1.0f / 1024.f) + RMS_EPS);
                unsigned key[8];
#pragma unroll
                for (int r = 0; r < 8; ++r) { const int e = (r >> 2) * 16 + 4 * q + (r & 3); const float lg = ((r < 4) ? d0[r & 3] : d1[r & 3]) * rstd + ka->in[I_BROUTER][e];
                    unsigned u = __float_as_uint(lg); u ^= (u >> 31) ? 0xffffffffu : 0x80000000u; key[r] = (u & ~31u) | (unsigned)(31 - e); }
                unsigned win[4];
#pragma unroll
                for (int r = 0; r < 4; ++r) { unsigned m = key[0];
#pragma unroll
                    for (int j = 1; j < 8; ++j) m = m > key[j] ? m : key[j];
                    unsigned o = (unsigned)__shfl_xor((int)m, 16); m = m > o ? m : o; o = (unsigned)__shfl_xor((int)m, 32); m = m > o ? m : o; win[r] = m;
#pragma unroll
                    for (int j = 0; j < 8; ++j) key[j] = (key[j] == m) ? 0u : key[j]; }
                float val[4];
#pragma unroll
                for (int r = 0; r < 4; ++r) { unsigned u = win[r] & ~31u; u ^= (u >> 31) ? 0x80000000u : 0xffffffffu; val[r] = __uint_as_float(u); }
                const float p1 = expf(val[1] - val[0]), p2 = expf(val[2] - val[0]), p3 = expf(val[3] - val[0]); const float inv = 1.0f / (1.0f + p1 + p2 + p3);
                const unsigned wk = (q == 0) ? win[0] : (q == 1) ? win[1] : (q == 2) ? win[2] : win[3];
                w_sel = ((q == 0) ? 1.0f : (q == 1) ? p1 : (q == 2) ? p2 : p3) * inv; e_sel = 31 - (int)(wk & 31u);
                rank = __hip_atomic_fetch_add((int*)(lcnt + e_sel), 1, __ATOMIC_RELAXED, __HIP_MEMORY_SCOPE_WORKGROUP);
            }
            __syncthreads();
            if (tid < 32) lbase[tid] = (int)__hip_atomic_fetch_add(CNT + 64 * tid, (unsigned)lcnt[tid], __ATOMIC_RELAXED, __HIP_MEMORY_SCOPE_AGENT);
            __syncthreads();
            if (valid) { const int pos = lbase[e_sel] + rank; LIST[(size_t)e_sel * CAP + pos] = (u32x2){(unsigned)(tok * 4 + q), __float_as_uint(rstd)}; ROUTEW[tok * 4 + q] = w_sel; }
            __syncthreads();
        }
    }
    SEAM(6);
    if (IN(7) || IN(8)) { KA;
        LAS int* tp = (LAS int*)(lds + MISC_OFF + 256); LAS int* cn = tp + 40;
        if (tid == 0) { int acc = 0; for (int e = 0; e < NEXP; ++e) { const int c = (int)__hip_atomic_load(CNT + 64 * e, __ATOMIC_RELAXED, __HIP_MEMORY_SCOPE_AGENT); cn[e] = c; tp[e] = acc; acc += (c + 255) >> 8; } tp[NEXP] = acc; }
        __syncthreads();
        if (IN(7)) for (int rep_ = 0; rep_ < 1 + ((REPEAT_MASK >> 7) & 1); ++rep_) {
            pg8::GuProb P{(const unsigned char*)XG, (const unsigned char*)WGU_T, LIST, 1024, 1024, 1024}; pg8::GroupedOrder S0{tp, cn, 8, G, bx}; const pg8::TableOrder S = pg8::build_unit_table(S0, (LAS int*)(lds + MISC_OFF + 2048));
            pg8::EpiSwiglu E{(unsigned char*)ACT, LIST, ka->in[I_BGU]};
            pg8::gemm_phase<pg8::EpiSwiglu, pg8::GuProb, pg8::TableOrder, ALIGN_EPI_SEL>(lds, P, S, E);
        }
        SEAM(7);
        if (IN(8)) for (int rep_ = 0; rep_ < 1 + ((REPEAT_MASK >> 8) & 1); ++rep_) {
            pg8::DownProb P{(const unsigned char*)ACT, (const unsigned char*)WD_T, 1024, 1024, 1024}; pg8::GroupedOrder S0{tp, cn, 4, G, bx}; const pg8::TableOrder S = pg8::build_unit_table(S0, (LAS int*)(lds + MISC_OFF + 2048));
            pg8::EpiDown E{Y4, LIST, ka->in[I_BD]};
            pg8::gemm_phase<pg8::EpiDown, pg8::DownProb, pg8::TableOrder, ALIGN_EPI_SEL>(lds, P, S, E);
        }
    }
    SEAM(8);
    if (IN(9)) { KA;
        for (int i = bx * 512 + tid; i < T * 128; i += G * 512) { const int tok = i >> 7, c8 = (i & 127) * 8;
            const f32x4 w = *(const f32x4*)(ROUTEW + tok * 4); float* op = OUT + (size_t)tok * 1024 + c8;
            f32x4 o0 = *(const f32x4*)op, o1 = *(const f32x4*)(op + 4);
#pragma unroll
            for (int k = 0; k < 4; ++k) { const u32x4 y = *(const u32x4*)(Y4 + ((size_t)tok * 4 + k) * 1024 + c8); const float wk = w[k];
                o0[0] += wk * bf_lo(y.x); o0[1] += wk * bf_hi(y.x); o0[2] += wk * bf_lo(y.y); o0[3] += wk * bf_hi(y.y);
                o1[0] += wk * bf_lo(y.z); o1[1] += wk * bf_hi(y.z); o1[2] += wk * bf_lo(y.w); o1[3] += wk * bf_hi(y.w); }
            *(f32x4*)op = o0; *(f32x4*)(op + 4) = o1; }
    }
#ifdef TAP
    if (lo <= 10 && 10 < hi) { KA; GSYNC();
        for (int i = bx * 512 + tid; i < T * 1024; i += G * 512) { const int t = i >> 10, c = i & 1023; float v = 0.f;
#define BFV(buf, pitch, col) __uint_as_float((unsigned)(buf)[(size_t)t * (pitch) + (col)] << 16)
            if (TAP == 1) v = BFV(Qb, 512, c & 511) + 2.f * BFV(Kb, 512, c & 511) + 4.f * BFV(Vb, 512, c & 511) + 8.f * BFV(Ub, 256, c & 255) + 16.f * BFV(MQb, 256, c & 255)
                            + 32.f * BFV(GATES, 3072, c) + 64.f * BFV(GATES, 3072, 1024 + c) + 128.f * BFV(GATES, 3072, 2048 + c);
            if (TAP == 2) v = BFV(OC, 1024, c) + 2.f * BFV(YCAT, 1024, c);
            if (TAP == 3) v = BFV(MERGB, 1024, c);
            if (TAP == 4) v = BFV(XN, 1024, c);
            if (TAP == 6) { const bf16_t* z = WSP(bf16_t, WS_B) + (size_t)t * 5120 + c; v = __uint_as_float((unsigned)z[0] << 16) + 2.f * __uint_as_float((unsigned)z[1024] << 16) + 4.f * __uint_as_float((unsigned)z[2048] << 16) + 8.f * __uint_as_float((unsigned)z[3072] << 16) + 16.f * __uint_as_float((unsigned)z[4096] << 16); }
            if (TAP == 5) { const bf16_t* wt = WIN_T; const int tt = t % 5120; v = __uint_as_float((unsigned)wt[(size_t)tt * 1024 + c] << 16) + ROPE[(t & 8191) * 32 + (c & 31)].x + 2.f * ROPE[(t & 8191) * 32 + (c & 31)].y; }
            OUT[i] = v; }
    }
#endif
#undef IN
#undef SEAM
}

extern "C" void kernel_launch(void* const* d_in, const int* in_sizes, int n_in, void* d_out, int out_size, void* d_ws, size_t ws_size, hipStream_t stream) {
    static int grid = 0;
    if (grid == 0) {
        if (n_in != 29 || in_sizes[0] != T * DMODEL || out_size != T * DMODEL || ws_size < WS_END) {
            fprintf(stderr, "kernel_launch: unexpected shapes: n_in %d in0 %d out %d ws %zu (need %zu)\n", n_in, n_in > 0 ? in_sizes[0] : -1, out_size, ws_size, (size_t)WS_END); grid = -1; return; }
        int dev = 0, cus = 0, per_cu = 0;
        (void)hipGetDevice(&dev); (void)hipDeviceGetAttribute(&cus, hipDeviceAttributeMultiprocessorCount, dev);
        (void)hipFuncSetAttribute((const void*)fwd_kernel, hipFuncAttributeMaxDynamicSharedMemorySize, LDS_BYTES);
        (void)hipOccupancyMaxActiveBlocksPerMultiprocessor(&per_cu, (const void*)fwd_kernel, NWAVES * 64, LDS_BYTES);
        (void)hipGetLastError();
        grid = cus;
        fprintf(stderr, "kernel_launch: cus %d occupancy %d/CU grid %d\n", cus, per_cu, grid);
        if (per_cu < 1) fprintf(stderr, "kernel_launch: occupancy query says the kernel does not fit\n");
    }
    if (grid < 0) return;
    (void)hipMemsetAsync((char*)d_ws + WS_CTL, 0, CTL_ZERO_BYTES, stream);
    Args a{};
    for (int i = 0; i < 29; ++i) a.in[i] = (const float*)d_in[i];
    a.out = (float*)d_out; a.ws = (unsigned char*)d_ws; a.ph_lo = 0; a.ph_hi = PH_HI;
    void* args[] = {&a};
    hipError_t e = hipLaunchCooperativeKernel((const void*)fwd_kernel, dim3(grid), dim3(NWAVES * 64), args, LDS_BYTES, stream);
    if (e != hipSuccess) fprintf(stderr, "cooperative launch failed: %s (grid %d)\n", hipGetErrorString(e), grid);
}
```

```cpp
#include <hip/hip_runtime.h>
#include <hip/hip_cooperative_groups.h>
#include <hip/hip_bf16.h>
#include <cstdio>
#include <cstdint>
#include <cmath>
namespace cg = cooperative_groups;

#define LAS __attribute__((address_space(3)))
#define GAS __attribute__((address_space(1)))
typedef unsigned short bf16_t;
typedef short bf16x8 __attribute__((ext_vector_type(8)));
typedef float f32x4 __attribute__((ext_vector_type(4)));
typedef float f32x2 __attribute__((ext_vector_type(2)));
typedef float f32x16 __attribute__((ext_vector_type(16)));
typedef unsigned u32x4 __attribute__((ext_vector_type(4)));
typedef unsigned u32x2 __attribute__((ext_vector_type(2)));

#define PH_HI 10
#define ALIGN_EPI_SEL true
#define F8MODE 2
#define USE_SETPRIO 1
#define ATTN_PRIO_A 1
#define ATTN_PRIO_B 1
#ifndef PHMASK
#define PHMASK 0x3ff
#endif
#define REPEAT_MASK 0x000
constexpr int BATCH = 4, SEQ = 8192, DMODEL = 1024, T = BATCH * SEQ, INW = 5120, NEXP = 32, MEMLEN = 256;
constexpr float RMS_EPS = 1e-6f;
constexpr float C2 = 0.125f * 1.4426950408889634f;
constexpr int CAP = T;

constexpr size_t MiB = 1u << 20;
constexpr size_t WS_CTL = 0, CTL_ZERO_BYTES = 32768;
constexpr int CW_BAR = 4096;
constexpr size_t WS_ROUTEW = 1 * MiB;
constexpr size_t WS_LAM = 1 * MiB + 768 * 1024;
constexpr size_t WS_ROPE = 2 * MiB;
constexpr size_t WS_WR2 = 4 * MiB;
constexpr size_t WS_MEMN = 5 * MiB;
constexpr size_t WS_MKV = 7 * MiB;
constexpr size_t WS_WIN_T = 8 * MiB;
constexpr size_t WS_WBRD_T = 18 * MiB;
constexpr size_t WS_WBRP_T = 19 * MiB;
constexpr size_t WS_WBRM_T = 19 * MiB + 512 * 1024;
constexpr size_t WS_WOUT_T = 20 * MiB;
constexpr size_t WS_WMKV_T = 22 * MiB;
constexpr size_t WS_WGU_T = 24 * MiB;
constexpr size_t WS_WD_T = 152 * MiB;
constexpr size_t WS_A = 216 * MiB;
constexpr size_t WS_XN = WS_A;
constexpr size_t WS_Q = WS_A + 64 * MiB, WS_K = WS_A + 96 * MiB, WS_V = WS_A + 128 * MiB;
constexpr size_t WS_U = WS_A + 160 * MiB, WS_MQ = WS_A + 176 * MiB;
constexpr size_t WS_OC = WS_A + 192 * MiB;
constexpr size_t WS_B = 488 * MiB;
constexpr size_t WS_GATES = WS_B;
constexpr size_t WS_YCAT = WS_B + 192 * MiB;
constexpr size_t WS_MERGF = 760 * MiB;
constexpr size_t WS_MERGB = 888 * MiB;
constexpr size_t WS_XG = 952 * MiB;
constexpr size_t WS_LIST = 1016 * MiB;
constexpr size_t WS_END = 1024 * MiB;

typedef __bf16 bf16x2_v __attribute__((ext_vector_type(2)));
__device__ __forceinline__ unsigned cvt_pk_bf16(float lo, float hi) { f32x2 v = {lo, hi}; bf16x2_v b = __builtin_convertvector(v, bf16x2_v); return __builtin_bit_cast(unsigned, b); }
__device__ __forceinline__ unsigned pk4_fp8(float a, float b, float c, float d) {
    a = fminf(fmaxf(a, -448.f), 448.f); b = fminf(fmaxf(b, -448.f), 448.f); c = fminf(fmaxf(c, -448.f), 448.f); d = fminf(fmaxf(d, -448.f), 448.f);
    int r = __builtin_amdgcn_cvt_pk_fp8_f32(a, b, 0, false); r = __builtin_amdgcn_cvt_pk_fp8_f32(c, d, r, true); return (unsigned)r; }
constexpr float W8_SCALE = 64.0f;
constexpr float A8_SCALE = 8.0f;
__device__ __forceinline__ float bf_lo(unsigned w) { return __uint_as_float(w << 16); }
__device__ __forceinline__ float bf_hi(unsigned w) { return __uint_as_float(w & 0xffff0000u); }
__device__ __forceinline__ float wave_sum(float v) {
#pragma unroll
    for (int o = 1; o < 64; o <<= 1) v += __shfl_xor(v, o);
    return v;
}
#define LDS_WAIT() asm volatile("s_waitcnt lgkmcnt(0)" ::: "memory")

namespace pg8 {
constexpr int BM = 256, BK = 64, HALF = 128, HTB = HALF * BK * 2, STAGE_BYTES = 8 * HTB, NXCD = 8, WGM = 8;
__host__ __device__ __forceinline__ int lds_byte(int r, int c) { const int st = (r >> 4) * 2 + (c >> 5), rr = r & 15, cc = c & 31, ob = rr * 64 + cc * 2; return st * 1024 + (ob ^ (((ob >> 9) & 1) << 5)); }
__host__ __device__ __forceinline__ void stage_rc(int b, int& R, int& C) { const int st = b / 1024, sb = b % 1024, swz = sb ^ (((sb >> 9) & 1) << 5); R = (st >> 1) * 16 + swz / 64; C = (st & 1) * 32 + (swz % 64) / 2; }
__host__ __device__ __forceinline__ int perm32(int rho) { const int n = rho >> 4, i = rho & 15; return 8 * (i >> 2) + 4 * n + (i & 3); }

typedef int i32x4_t __attribute__((ext_vector_type(4)));
typedef int i32x8_t __attribute__((ext_vector_type(8)));
typedef long i64x2_t __attribute__((ext_vector_type(2)));
struct Unit { int pm, pn, e, mt, cnt; };

template <int BMAP> __device__ __forceinline__ int brow(int R) { return BMAP == 0 ? ((R >> 5) * 64 + perm32(R & 31)) : ((R & ~31) + perm32(R & 31)); }

struct StaticOrder {
    int nM, nN, nwg, G, c;
    __device__ void init(int M, int N, int G_, int c_) { nM = M / BM; nN = N / BM; nwg = nM * nN; G = G_; c = c_; }
    __device__ bool next(int i, Unit& u) const {
        const long L = (long)i * G + c; if (L >= nwg) return false;
        int wgid = (int)L; { const int q = nwg / NXCD, r = nwg % NXCD, xcd = wgid % NXCD, off = wgid / NXCD; wgid = (xcd < r ? xcd * (q + 1) : r * (q + 1) + (xcd - r) * q) + off; }
        const int nig = WGM * nN, gid = wgid / nig, fm = gid * WGM, gsz = (nM - fm) < WGM ? (nM - fm) : WGM;
        u.pm = fm + ((wgid % nig) % gsz); u.pn = (wgid % nig) / gsz; u.e = 0; u.mt = 0; u.cnt = 0; return true;
    }
    __device__ bool next_lane(int i, Unit& u) const { return next(i, u); }
};
struct GroupedOrder {
    const LAS int* tp; const LAS int* cn; int NTN, G, c;
    __device__ bool next_lane(int i, Unit& u) const {
        const int nwg = tp[NEXP] * NTN; const long L = (long)i * G + c; if (L >= nwg) return false;
        int wgid = (int)L; { const int q = nwg / NXCD, r = nwg % NXCD, xcd = wgid % NXCD, off = wgid / NXCD; wgid = (xcd < r ? xcd * (q + 1) : r * (q + 1) + (xcd - r) * q) + off; }
        int e = 0; while (e < NEXP - 1 && wgid >= tp[e + 1] * NTN) ++e;
        const int idx = wgid - tp[e] * NTN, tiles = tp[e + 1] - tp[e];
        const int nig = 4 * NTN, gid = idx / nig, fm = gid * 4, gsz = (tiles - fm) < 4 ? (tiles - fm) : 4;
        u.mt = fm + ((idx % nig) % gsz); u.pn = (idx % nig) / gsz; u.e = e; u.pm = tp[e] + u.mt; u.cnt = cn[e]; return true;
    }
};
struct TableOrder {
    const LAS int* tab; int n;
    __device__ __forceinline__ bool next(int i, Unit& u) const {
        if (i >= n) return false;
        const LAS int* t = tab + i * 8;
        u.pm = __builtin_amdgcn_readfirstlane(t[0]); u.pn = __builtin_amdgcn_readfirstlane(t[1]); u.e = __builtin_amdgcn_readfirstlane(t[2]);
        u.mt = __builtin_amdgcn_readfirstlane(t[3]); u.cnt = __builtin_amdgcn_readfirstlane(t[4]); return true;
    }
};
template <class Sched> __device__ __forceinline__ TableOrder build_unit_table(const Sched& S, LAS int* tab) {
    __syncthreads();
    if (threadIdx.x < 32) { Unit u; const bool ok = S.next_lane((int)threadIdx.x, u);
        if (ok) { LAS int* t = tab + threadIdx.x * 8; t[0] = u.pm; t[1] = u.pn; t[2] = u.e; t[3] = u.mt; t[4] = u.cnt; }
        const unsigned long long m = __ballot(ok); if (threadIdx.x == 0) tab[256] = __popcll(m); }
    __syncthreads();
    TableOrder T; T.tab = tab; T.n = __builtin_amdgcn_readfirstlane(tab[256]); return T;
}
struct DenseProb {
    static constexpr bool GATHER = false; static constexpr int BMAP = 0; static constexpr bool F8 = false;
    const bf16_t* A; const bf16_t* Bt; int lda, ldb, K;
    __device__ __forceinline__ const char* a_base(const Unit& u) const { return (const char*)(A + (size_t)u.pm * BM * lda); }
    __device__ __forceinline__ const char* b_base(const Unit& u) const { return (const char*)(Bt + (size_t)u.pn * BM * ldb); }
    __device__ __forceinline__ size_t bhstep() const { return (size_t)32 * ldb * 2; }
    __device__ __forceinline__ unsigned a_off(const Unit&, int, int) const { return 0u; }
    __device__ __forceinline__ unsigned a_raw(const Unit&, int) const { return 0u; }
};
struct GuProb {
    static constexpr bool GATHER = true; static constexpr int BMAP = 1; static constexpr bool F8 = true;
    const unsigned char* XG; const unsigned char* Wt; const u32x2* list; int lda, ldb, K;
    __device__ __forceinline__ const char* a_base(const Unit&) const { return (const char*)XG; }
    __device__ __forceinline__ const char* b_base(const Unit& u) const { return (const char*)(Wt + ((size_t)u.e * 2048 + 128 * u.pn) * 1024); }
    __device__ __forceinline__ size_t bhstep() const { return (size_t)1024 * 1024; }
    __device__ __forceinline__ unsigned a_raw(const Unit& u, int r) const { const int rr = u.mt * BM + r, rc = rr < u.cnt ? rr : u.cnt - 1; return list[(size_t)u.e * CAP + rc].x; }
    __device__ __forceinline__ unsigned a_off(const Unit& u, int r, int C) const {
        const int rr = u.mt * BM + r, rc = rr < u.cnt ? rr : u.cnt - 1;
        const unsigned tok = list[(size_t)u.e * CAP + rc].x >> 2;
        return tok * 1024u + (unsigned)C * 2u;
    }
};
struct DownProb {
    static constexpr bool GATHER = false; static constexpr int BMAP = 0; static constexpr bool F8 = true;
    const unsigned char* A; const unsigned char* Wt; int lda, ldb, K;
    __device__ __forceinline__ const char* a_base(const Unit& u) const { return (const char*)(A + (size_t)u.pm * BM * lda); }
    __device__ __forceinline__ const char* b_base(const Unit& u) const { return (const char*)(Wt + ((size_t)u.e * 1024 + 256 * u.pn) * 1024); }
    __device__ __forceinline__ size_t bhstep() const { return (size_t)32 * ldb; }
    __device__ __forceinline__ unsigned a_off(const Unit&, int, int) const { return 0u; }
    __device__ __forceinline__ unsigned a_raw(const Unit&, int) const { return 0u; }
};

template <class Prob> __device__ __forceinline__ void calc_aoff(const Prob& P, const Unit& u, const int (&Rr)[2], const int (&Cc)[2], unsigned (&o)[2][2]) {
#pragma unroll
    for (int h = 0; h < 2; ++h)
#pragma unroll
        for (int i = 0; i < 2; ++i) {
            if constexpr (Prob::GATHER) o[h][i] = P.a_off(u, h * HALF + Rr[i], Cc[i]);
            else o[h][i] = Prob::F8 ? (unsigned)((h * HALF + Rr[i]) * P.lda + Cc[i] * 2) : (unsigned)((h * HALF + Rr[i]) * P.lda + Cc[i]) * 2u;
        }
}

struct NoPost { __device__ __forceinline__ void operator()(int) const {} };
template <class Epi, class Prob, class Sched, bool ALIGN_EPI, class Post = NoPost>
__device__ __forceinline__ void gemm_phase(LAS unsigned char* lds, const Prob& P, const Sched& S, const Epi& E, const Post& PU = Post()) {
    const int tid = threadIdx.x, wid = __builtin_amdgcn_readfirstlane(tid >> 6), lane = tid & 63, wr = wid >> 2, wc = wid & 3, fr = lane & 15, fq = lane >> 4;
    const int K = P.K, nt = Prob::F8 ? K / 128 : K / BK;
    int Rr[2], Cc[2]; unsigned voffB[2];
#pragma unroll
    for (int i = 0; i < 2; ++i) { stage_rc(tid * 16 + i * 8192, Rr[i], Cc[i]); voffB[i] = Prob::F8 ? (unsigned)(brow<Prob::BMAP>(Rr[i]) * P.ldb + Cc[i] * 2) : (unsigned)(brow<Prob::BMAP>(Rr[i]) * P.ldb + Cc[i]) * 2u; }
    const size_t kstep = (size_t)(BK * 2);
    const size_t bhstep = P.bhstep();
    const unsigned ldsw = (unsigned)wid * 1024u;
    const int aoff = lds_byte(wr * 64 + fr, fq * 8), boff = lds_byte(wc * 32 + fr, fq * 8);
#define PG8_SA(b, h) (((b) * 2 + (h)) * HTB)
#define PG8_SB(b, h) ((4 + (b) * 2 + (h)) * HTB)
#define PG8_STG(bufoff, gptr, v0, v1) do { \
        __builtin_amdgcn_global_load_lds((const unsigned*)((const char*)(gptr) + (v0)), (LAS unsigned*)(lds + (bufoff) + ldsw), 16, 0, 0); \
        __builtin_amdgcn_global_load_lds((const unsigned*)((const char*)(gptr) + (v1)), (LAS unsigned*)(lds + (bufoff) + ldsw + 8192), 16, 0, 0); } while (0)
#define PG8_STGB(bufoff, gptr) PG8_STG(bufoff, gptr, voffB[0], voffB[1])
#define PG8_LDA(dst, b, h) do { _Pragma("unroll") for (int m = 0; m < 4; ++m) _Pragma("unroll") for (int k = 0; k < 2; ++k) dst[m][k] = *(const LAS bf16x8*)(lds + PG8_SA(b, h) + aoff + m * 2048 + k * 1024); } while (0)
#define PG8_LDB(dst, b, h) do { _Pragma("unroll") for (int n = 0; n < 2; ++n) _Pragma("unroll") for (int k = 0; k < 2; ++k) dst[n][k] = *(const LAS bf16x8*)(lds + PG8_SB(b, h) + boff + n * 2048 + k * 1024); } while (0)
#define PG8_MMAB(ai, bj, At, Bt) do { _Pragma("unroll") for (int m = 0; m < 4; ++m) _Pragma("unroll") for (int n = 0; n < 2; ++n) _Pragma("unroll") for (int k = 0; k < 2; ++k) \
        acc[ai][bj][m][n] = __builtin_amdgcn_mfma_f32_16x16x32_bf16(Bt[n][k], At[m][k], acc[ai][bj][m][n], 0, 0, 0); } while (0)
#define PG8_MMAQ(ai, bj, At, Bt) do { _Pragma("unroll") for (int m = 0; m < 4; ++m) _Pragma("unroll") for (int n = 0; n < 2; ++n) _Pragma("unroll") for (int k = 0; k < 2; ++k) { \
        const i64x2_t bq = __builtin_bit_cast(i64x2_t, Bt[n][k]), aq = __builtin_bit_cast(i64x2_t, At[m][k]); \
        acc[ai][bj][m][n] = __builtin_amdgcn_mfma_f32_16x16x32_fp8_fp8(bq[0], aq[0], acc[ai][bj][m][n], 0, 0, 0); \
        acc[ai][bj][m][n] = __builtin_amdgcn_mfma_f32_16x16x32_fp8_fp8(bq[1], aq[1], acc[ai][bj][m][n], 0, 0, 0); } } while (0)
#define PG8_MMA8(ai, bj, A8, B8) do { _Pragma("unroll") for (int m = 0; m < 4; ++m) _Pragma("unroll") for (int n = 0; n < 2; ++n) \
        asm volatile("v_mfma_f32_16x16x128_f8f6f4 %0, %1, %2, %0" : "+v"(acc[ai][bj][m][n]) : "v"(B8[n]), "v"(A8[m])); } while (0)
#define PG8_LDA8(dst, b, h) do { _Pragma("unroll") for (int m = 0; m < 4; ++m) { dst[m].lo = *(const LAS i32x4_t*)(lds + PG8_SA(b, h) + aoff + m * 2048); dst[m].hi = *(const LAS i32x4_t*)(lds + PG8_SA(b, h) + aoff + m * 2048 + 1024); } } while (0)
#define PG8_LDB8(dst, b, h) do { _Pragma("unroll") for (int n = 0; n < 2; ++n) { dst[n].lo = *(const LAS i32x4_t*)(lds + PG8_SB(b, h) + boff + n * 2048); dst[n].hi = *(const LAS i32x4_t*)(lds + PG8_SB(b, h) + boff + n * 2048 + 1024); } } while (0)
#define PG8_XLDA(b, h)  do { if constexpr (Prob::F8 && F8MODE == 2) PG8_LDA8(At8, b, h); else PG8_LDA(At, b, h); } while (0)
#define PG8_XLDB0(b, h) do { if constexpr (Prob::F8 && F8MODE == 2) PG8_LDB8(B08, b, h); else PG8_LDB(B0, b, h); } while (0)
#define PG8_XLDB1(b, h) do { if constexpr (Prob::F8 && F8MODE == 2) PG8_LDB8(B18, b, h); else PG8_LDB(B1, b, h); } while (0)
#define PG8_XMMA0(ai, bj) do { if (USE_SETPRIO) __builtin_amdgcn_s_setprio(USE_SETPRIO); if constexpr (Prob::F8 && F8MODE == 2) PG8_MMA8(ai, bj, At8, B08); else if constexpr (Prob::F8) PG8_MMAQ(ai, bj, At, B0); else PG8_MMAB(ai, bj, At, B0); if (USE_SETPRIO) __builtin_amdgcn_s_setprio(0); } while (0)
#define PG8_XMMA1(ai, bj) do { if (USE_SETPRIO) __builtin_amdgcn_s_setprio(USE_SETPRIO); if constexpr (Prob::F8 && F8MODE == 2) PG8_MMA8(ai, bj, At8, B18); else if constexpr (Prob::F8) PG8_MMAQ(ai, bj, At, B1); else PG8_MMAB(ai, bj, At, B1); if (USE_SETPRIO) __builtin_amdgcn_s_setprio(0); } while (0)
#define PG8_WAIT_V(n) asm volatile("s_waitcnt vmcnt(" #n ")" ::: "memory")
#define PG8_WAIT_L(n) asm volatile("s_waitcnt lgkmcnt(" #n ")" ::: "memory")
#define PG8_BAR __builtin_amdgcn_s_barrier()
#define PG8_SCHED __builtin_amdgcn_sched_barrier(0)
    Unit cur, nxt; int ui = 0;
    if (!S.next(0, cur)) return;
    unsigned vo[2][2], nvo[2][2];
    calc_aoff(P, cur, Rr, Cc, vo);
    bool has_next = S.next(1, nxt);
    if constexpr (Prob::GATHER) { if (has_next) calc_aoff(P, nxt, Rr, Cc, nvo); else {
#pragma unroll
        for (int h = 0; h < 2; ++h)
#pragma unroll
            for (int i = 0; i < 2; ++i) nvo[h][i] = vo[h][i]; } }
    f32x4 acc[2][2][4][2];
#pragma unroll
    for (int a = 0; a < 2; ++a)
#pragma unroll
        for (int b = 0; b < 2; ++b)
#pragma unroll
            for (int m = 0; m < 4; ++m)
#pragma unroll
                for (int n = 0; n < 2; ++n) acc[a][b][m][n] = (f32x4){0.f, 0.f, 0.f, 0.f};
    bf16x8 At[4][2], B0[2][2], B1[2][2]; i32x8_t At8[4], B08[2], B18[2];
    const char* cA = P.a_base(cur); const char* cB = P.b_base(cur);
    PG8_STGB(PG8_SB(0, 0), cB); PG8_STGB(PG8_SB(0, 1), cB + bhstep); PG8_STG(PG8_SA(0, 0), cA, vo[0][0], vo[0][1]); PG8_STG(PG8_SA(0, 1), cA, vo[1][0], vo[1][1]);
    if (wr == 1) PG8_BAR;
    PG8_WAIT_V(2); PG8_BAR;
    PG8_STGB(PG8_SB(1, 0), cB + kstep); PG8_STG(PG8_SA(1, 0), cA + kstep, vo[0][0], vo[0][1]); PG8_STGB(PG8_SB(1, 1), cB + bhstep + kstep);
    PG8_WAIT_V(6); PG8_BAR;
    for (;;) {
        const char* nA = has_next ? P.a_base(nxt) : cA; const char* nB = has_next ? P.b_base(nxt) : cB;
        for (int t = 0; t < nt; t += 2) {
            const bool last = (t == nt - 2);
            if constexpr (Epi::HAS_MID) { if (t == Epi::MID_T0 || t == Epi::MID_T1) { E.mid(acc, cur, wr, wc, fr, fq, t == Epi::MID_T0 ? 0 : 1); PG8_SCHED; } }
            const char* a1 = cA + (size_t)(t + 1) * kstep;
            const char* a2 = last ? nA : cA + (size_t)(t + 2) * kstep; const char* b2 = last ? nB : cB + (size_t)(t + 2) * kstep;
            const char* a3 = a2 + kstep; const char* b3 = b2 + kstep;
            unsigned x00 = vo[0][0], x01 = vo[0][1], x10 = vo[1][0], x11 = vo[1][1];
            if constexpr (Prob::GATHER) { if (last) { x00 = nvo[0][0]; x01 = nvo[0][1]; x10 = nvo[1][0]; x11 = nvo[1][1]; } }
            PG8_XLDB0(0, 0); PG8_XLDB1(0, 1); PG8_SCHED; PG8_XLDA(0, 0); PG8_STG(PG8_SA(1, 1), a1, vo[1][0], vo[1][1]);
            PG8_WAIT_V(8); PG8_WAIT_L(0); PG8_BAR; PG8_XMMA0(0, 0); PG8_XMMA1(0, 1); PG8_BAR; PG8_SCHED;
            PG8_XLDA(0, 1); PG8_STGB(PG8_SB(0, 0), b2); PG8_STGB(PG8_SB(0, 1), b2 + bhstep); PG8_STG(PG8_SA(0, 0), a2, x00, x01);
            PG8_WAIT_V(8); PG8_WAIT_L(0); PG8_BAR; PG8_XMMA0(1, 0); PG8_XMMA1(1, 1); PG8_BAR; PG8_SCHED;
            PG8_XLDB0(1, 0); PG8_XLDB1(1, 1); PG8_SCHED; PG8_XLDA(1, 0); PG8_STG(PG8_SA(0, 1), a2, x10, x11);
            PG8_WAIT_V(8); PG8_WAIT_L(0); PG8_BAR; PG8_XMMA0(0, 0); PG8_XMMA1(0, 1); PG8_BAR; PG8_SCHED;
            PG8_XLDA(1, 1); PG8_STGB(PG8_SB(1, 0), b3); PG8_STGB(PG8_SB(1, 1), b3 + bhstep); PG8_STG(PG8_SA(1, 0), a3, x00, x01);
            PG8_WAIT_V(8); PG8_WAIT_L(0); PG8_BAR; PG8_XMMA0(1, 0); PG8_XMMA1(1, 1); PG8_BAR; PG8_SCHED;
        }
        if constexpr (ALIGN_EPI) { if (wr == 0) PG8_BAR; }
        if constexpr (Prob::F8 && F8MODE == 2) asm volatile("s_nop 15\n\ts_nop 15" ::: "memory");
        Unit nn; const bool has_nn = has_next && S.next(ui + 2, nn);
        if constexpr (Prob::GATHER) {
#pragma unroll
            for (int h = 0; h < 2; ++h)
#pragma unroll
                for (int i = 0; i < 2; ++i) vo[h][i] = nvo[h][i];
            if (has_nn) {
#pragma unroll
                for (int h = 0; h < 2; ++h)
#pragma unroll
                    for (int i = 0; i < 2; ++i) nvo[h][i] = P.a_raw(nn, h * HALF + Rr[i]); } }
        E(acc, cur, wr, wc, fr, fq);
        PU(ui);
        if (!has_next) break;
#pragma unroll
        for (int a = 0; a < 2; ++a)
#pragma unroll
            for (int b = 0; b < 2; ++b)
#pragma unroll
                for (int m = 0; m < 4; ++m)
#pragma unroll
                    for (int n = 0; n < 2; ++n) acc[a][b][m][n] = (f32x4){0.f, 0.f, 0.f, 0.f};
        cur = nxt; cA = nA; cB = nB; ++ui;
        has_next = has_nn; nxt = nn;
        if constexpr (Prob::GATHER) { if (has_next) {
#pragma unroll
            for (int h = 0; h < 2; ++h)
#pragma unroll
                for (int i = 0; i < 2; ++i) nvo[h][i] = (nvo[h][i] >> 2) * (Prob::F8 ? 1024u : 2048u) + (unsigned)Cc[i] * 2u;
            asm volatile("" : "+v"(nvo[0][0]), "+v"(nvo[0][1]), "+v"(nvo[1][0]), "+v"(nvo[1][1])); } }
        if constexpr (ALIGN_EPI) { if (wr == 1) PG8_BAR; }
    }
    PG8_WAIT_V(0);
    if constexpr (!ALIGN_EPI) { if (wr == 0) PG8_BAR; }
    PG8_BAR;
#undef PG8_SA
#undef PG8_SB
#undef PG8_STG
#undef PG8_STGB
#undef PG8_LDA
#undef PG8_LDB
#undef PG8_MMAB
#undef PG8_MMAQ
#undef PG8_MMA8
#undef PG8_LDA8
#undef PG8_LDB8
#undef PG8_XLDA
#undef PG8_XLDB0
#undef PG8_XLDB1
#undef PG8_XMMA0
#undef PG8_XMMA1
#undef PG8_WAIT_V
#undef PG8_WAIT_L
#undef PG8_BAR
#undef PG8_SCHED
}

typedef const f32x4 (&AccRef)[2][2][4][2];

__device__ __forceinline__ void store8(bf16_t* p, const f32x4& a, const f32x4& b) {
    u32x4 w; w.x = cvt_pk_bf16(a[0], a[1]); w.y = cvt_pk_bf16(a[2], a[3]); w.z = cvt_pk_bf16(b[0], b[1]); w.w = cvt_pk_bf16(b[2], b[3]); *(u32x4*)p = w;
}
__device__ __forceinline__ float sigmoidf_(float v) { return __builtin_amdgcn_rcpf(1.0f + __builtin_amdgcn_exp2f(-1.4426950408889634f * v)); }

struct EpiInProj {
    static constexpr bool HAS_MID = false;
    bf16_t *Q, *Kb, *V, *U, *MQ, *GT; const float *qn, *kn, *mqn, *bg; const f32x2* rope;
    __device__ __forceinline__ void operator()(AccRef acc, const Unit& u, int wr, int wc, int fr, int fq) const {
        const int pn = u.pn; const int row0 = u.pm * BM + wr * 64 + fr;
        bf16_t* const Q_ = Q; bf16_t* const K_ = Kb; bf16_t* const V_ = V; bf16_t* const U_ = U; bf16_t* const MQ_ = MQ; const float* const qn_ = qn; const float* const kn_ = kn; const float* const mqn_ = mqn;
        if (pn < 4 || pn == 7) {
            const bool rope_on = pn < 4; const float* gn = pn < 2 ? qn_ : (pn < 4 ? kn_ : mqn_);
            const float sc = (pn < 2 || pn == 7) ? C2 : 1.0f;
            bf16_t* O; int pitch, colb;
            if (pn < 2) { O = Q_; pitch = 512; colb = (pn * 4 + wc) * 64; } else if (pn < 4) { O = K_; pitch = 512; colb = ((pn - 2) * 4 + wc) * 64; } else { O = MQ_; pitch = 256; colb = wc * 64; }
            const f32x4 g00 = *(const f32x4*)(gn + 8 * fq), g01 = *(const f32x4*)(gn + 8 * fq + 4), g10 = *(const f32x4*)(gn + 32 + 8 * fq), g11 = *(const f32x4*)(gn + 32 + 8 * fq + 4);
#pragma unroll
            for (int ai = 0; ai < 2; ++ai)
#pragma unroll
                for (int m = 0; m < 4; ++m) {
                    const f32x4 a0 = acc[ai][0][m][0], a1 = acc[ai][0][m][1], b0 = acc[ai][1][m][0], b1 = acc[ai][1][m][1];
                    float ss = 0.f;
#pragma unroll
                    for (int j = 0; j < 4; ++j) ss += a0[j] * a0[j] + a1[j] * a1[j] + b0[j] * b0[j] + b1[j] * b1[j];
                    ss += __shfl_xor(ss, 16); ss += __shfl_xor(ss, 32);
                    const float rstd = 1.0f / sqrtf(ss * (1.0f / 64.0f) + RMS_EPS);
                    const int row = row0 + ai * HALF + m * 16;
                    f32x4 t10 = a0 * rstd * g00, t11 = a1 * rstd * g01, t20 = b0 * rstd * g10, t21 = b1 * rstd * g11;
                    f32x4 o10, o11, o20, o21;
                    if (rope_on) {
                        const f32x4* rp = (const f32x4*)(rope + (size_t)(row & (SEQ - 1)) * 32 + 8 * fq);
                        const f32x4 r0 = rp[0], r1 = rp[1], r2 = rp[2], r3 = rp[3];
                        const f32x4 cs0 = {r0[0], r0[2], r1[0], r1[2]}, sn0 = {r0[1], r0[3], r1[1], r1[3]}, cs1 = {r2[0], r2[2], r3[0], r3[2]}, sn1 = {r2[1], r2[3], r3[1], r3[3]};
                        o10 = (t10 * cs0 - t20 * sn0) * sc; o11 = (t11 * cs1 - t21 * sn1) * sc; o20 = (t20 * cs0 + t10 * sn0) * sc; o21 = (t21 * cs1 + t11 * sn1) * sc;
                    } else { o10 = t10 * sc; o11 = t11 * sc; o20 = t20 * sc; o21 = t21 * sc; }
                    bf16_t* rowp = O + (size_t)row * pitch + colb + 8 * fq;
                    store8(rowp, o10, o11); store8(rowp + 32, o20, o21);
                }
        } else if (pn < 7) {
            bf16_t* O; int pitch, colb;
            if (pn < 6) { O = V_; pitch = 512; colb = (pn - 4) * 256 + wc * 64; } else { O = U_; pitch = 256; colb = wc * 64; }
#pragma unroll
            for (int ai = 0; ai < 2; ++ai)
#pragma unroll
                for (int m = 0; m < 4; ++m) { bf16_t* rowp = O + (size_t)(row0 + ai * HALF + m * 16) * pitch + colb + 8 * fq;
                    store8(rowp, acc[ai][0][m][0], acc[ai][0][m][1]); store8(rowp + 32, acc[ai][1][m][0], acc[ai][1][m][1]); }
        } else {
            const int gc = (pn - 8) * 256 + wc * 64 + 8 * fq;
            f32x4 bv[2][2];
#pragma unroll
            for (int bj = 0; bj < 2; ++bj)
#pragma unroll
                for (int n = 0; n < 2; ++n) bv[bj][n] = *(const f32x4*)(bg + gc + 32 * bj + 4 * n);
#pragma unroll
            for (int ai = 0; ai < 2; ++ai)
#pragma unroll
                for (int m = 0; m < 4; ++m) {
                    bf16_t* blk = GT + ((size_t)(((pn - 8) >> 2) * 128 + u.pm) * 4 + ((pn - 8) & 3)) * 65536 + (size_t)((wr * 4 + wc) * 16 * 64 + (fq * 16 + fr)) * 8;
#pragma unroll
                    for (int bj = 0; bj < 2; ++bj) { f32x4 v0 = acc[ai][bj][m][0] + bv[bj][0], v1 = acc[ai][bj][m][1] + bv[bj][1];
#pragma unroll
                        for (int j = 0; j < 4; ++j) { v0[j] = sigmoidf_(v0[j]); v1[j] = sigmoidf_(v1[j]); }
                        store8(blk + (ai * 8 + m * 2 + bj) * 512, v0, v1); } }
        }
    }
};
struct EpiMemKV {
    static constexpr bool HAS_MID = false;
    bf16_t* MKV; const float* mkn;
    __device__ __forceinline__ void operator()(AccRef acc, const Unit& u, int wr, int wc, int fr, int fq) const {
        const int row0 = u.pm * BM + wr * 64 + fr;
        f32x4 g00 = {1.f, 1.f, 1.f, 1.f}, g01 = g00, g10 = g00, g11 = g00;
        if (u.pn == 0) { g00 = *(const f32x4*)(mkn + 8 * fq); g01 = *(const f32x4*)(mkn + 8 * fq + 4); g10 = *(const f32x4*)(mkn + 32 + 8 * fq); g11 = *(const f32x4*)(mkn + 32 + 8 * fq + 4); }
#pragma unroll
        for (int ai = 0; ai < 2; ++ai)
#pragma unroll
            for (int m = 0; m < 4; ++m) {
                const f32x4 a0 = acc[ai][0][m][0], a1 = acc[ai][0][m][1], b0 = acc[ai][1][m][0], b1 = acc[ai][1][m][1];
                float rstd = 1.0f;
                if (u.pn == 0) { float ss = 0.f;
#pragma unroll
                    for (int j = 0; j < 4; ++j) ss += a0[j] * a0[j] + a1[j] * a1[j] + b0[j] * b0[j] + b1[j] * b1[j];
                    ss += __shfl_xor(ss, 16); ss += __shfl_xor(ss, 32); rstd = 1.0f / sqrtf(ss * (1.0f / 64.0f) + RMS_EPS); }
                bf16_t* rowp = MKV + (size_t)(row0 + ai * HALF + m * 16) * 512 + u.pn * 256 + wc * 64 + 8 * fq;
                store8(rowp, a0 * rstd * g00, a1 * rstd * g01); store8(rowp + 32, b0 * rstd * g10, b1 * rstd * g11);
            }
    }
};
template <int STAGE> struct EpiMerge {
    static constexpr bool HAS_MID = false;
    const bf16_t* GT; float* MF; bf16_t* MB;
    __device__ __forceinline__ void operator()(AccRef acc, const Unit& u, int wr, int wc, int fr, int fq) const {
        const int row0 = u.pm * BM + wr * 64 + fr, col0 = u.pn * BM + wc * 64 + 8 * fq;
#pragma unroll
        for (int ai = 0; ai < 2; ++ai)
#pragma unroll
            for (int m = 0; m < 4; ++m) { const size_t row = (size_t)(row0 + ai * HALF + m * 16);
#pragma unroll
                for (int bj = 0; bj < 2; ++bj) { const int col = col0 + 32 * bj;
                    const u32x4 g = *(const u32x4*)(GT + row * 3072 + STAGE * 1024 + col);
                    const f32x4 ga = {bf_lo(g.x), bf_hi(g.x), bf_lo(g.y), bf_hi(g.y)}, gb = {bf_lo(g.z), bf_hi(g.z), bf_lo(g.w), bf_hi(g.w)};
                    f32x4 v0 = acc[ai][bj][m][0] * ga, v1 = acc[ai][bj][m][1] * gb;
                    float* mp = MF + row * 1024 + col;
                    if (STAGE > 0) { v0 += *(const f32x4*)mp; v1 += *(const f32x4*)(mp + 4); }
                    if (STAGE < 2) { *(f32x4*)mp = v0; *(f32x4*)(mp + 4) = v1; } else store8(MB + row * 1024 + col, v0, v1); }
                if (m & 1) asm volatile("" ::: "memory"); }
    }
};
struct EpiWout {
    static constexpr bool HAS_MID = false;
    const float* X; float* X2; unsigned char* XG; const float* n2;
    __device__ __forceinline__ void operator()(AccRef acc, const Unit& u, int wr, int wc, int fr, int fq) const {
        const int row0 = u.pm * BM + wr * 64 + fr, col0 = u.pn * BM + wc * 64 + 8 * fq;
        f32x4 nv[2][2];
#pragma unroll
        for (int bj = 0; bj < 2; ++bj)
#pragma unroll
            for (int n = 0; n < 2; ++n) nv[bj][n] = *(const f32x4*)(n2 + col0 + 32 * bj + 4 * n);
#pragma unroll
        for (int ai = 0; ai < 2; ++ai)
#pragma unroll
            for (int m = 0; m < 4; ++m) { const size_t off = (size_t)(row0 + ai * HALF + m * 16) * 1024 + col0;
#pragma unroll
                for (int bj = 0; bj < 2; ++bj) { const f32x4 x0 = *(const f32x4*)(X + off + 32 * bj) + acc[ai][bj][m][0], x1 = *(const f32x4*)(X + off + 32 * bj + 4) + acc[ai][bj][m][1];
                    *(f32x4*)(X2 + off + 32 * bj) = x0; *(f32x4*)(X2 + off + 32 * bj + 4) = x1;
                    { const f32x4 y0 = x0 * nv[bj][0], y1 = x1 * nv[bj][1]; u32x2 w8; w8.x = pk4_fp8(y0[0], y0[1], y0[2], y0[3]); w8.y = pk4_fp8(y1[0], y1[1], y1[2], y1[3]); *(u32x2*)(XG + off + 32 * bj) = w8; } }
                if (m & 1) asm volatile("" ::: "memory"); }
    }
};
struct EpiSwiglu {
    static constexpr bool HAS_MID = false;
    unsigned char* ACT; const u32x2* list; const float* bgu;
    __device__ __forceinline__ void operator()(AccRef acc, const Unit& u, int wr, int wc, int fr, int fq) const {
        int z = 0; asm volatile("" : "+v"(z));
        const int col = 128 * u.pn + 32 * wc + 8 * fq + z; const float* bp = bgu + (size_t)u.e * 2048 + col;
        const f32x4 bg0 = *(const f32x4*)bp, bg1 = *(const f32x4*)(bp + 4), bu0 = *(const f32x4*)(bp + 1024), bu1 = *(const f32x4*)(bp + 1028);
#pragma unroll
        for (int ai = 0; ai < 2; ++ai)
#pragma unroll
            for (int m = 0; m < 4; ++m) { const int r = ai * HALF + wr * 64 + m * 16 + fr, rr = u.mt * BM + r, rc = rr < u.cnt ? rr : u.cnt - 1;
                const float rstd = __uint_as_float(list[(size_t)u.e * CAP + rc].y) * (1.0f / W8_SCALE);
                f32x4 o[2];
#pragma unroll
                for (int n = 0; n < 2; ++n) { const f32x4 g = acc[ai][0][m][n] * rstd + (n ? bg1 : bg0), up = acc[ai][1][m][n] * rstd + (n ? bu1 : bu0);
#pragma unroll
                    for (int j = 0; j < 4; ++j) { const float gg = fminf(g[j], 7.0f), uu = fminf(fmaxf(up[j], -7.0f), 7.0f);
                        o[n][j] = gg * __builtin_amdgcn_rcpf(1.0f + __builtin_amdgcn_exp2f(-1.702f * 1.4426950408889634f * gg)) * (uu + 1.0f); } }
                { const f32x4 q0 = o[0] * A8_SCALE, q1 = o[1] * A8_SCALE; u32x2 w8; w8.x = pk4_fp8(q0[0], q0[1], q0[2], q0[3]); w8.y = pk4_fp8(q1[0], q1[1], q1[2], q1[3]); *(u32x2*)(ACT + (size_t)(u.pm * BM + r) * 1024 + col) = w8; } }
    }
};
struct EpiDown {
    static constexpr bool HAS_MID = false;
    bf16_t* Y4; const u32x2* list; const float* bd;
    __device__ __forceinline__ void operator()(AccRef acc, const Unit& u, int wr, int wc, int fr, int fq) const {
        int z = 0; asm volatile("" : "+v"(z));
        const int col0 = u.pn * BM + wc * 64 + 8 * fq + z; const float* bp = bd + (size_t)u.e * 1024 + col0;
        f32x4 bv[2][2];
#pragma unroll
        for (int bj = 0; bj < 2; ++bj)
#pragma unroll
            for (int n = 0; n < 2; ++n) bv[bj][n] = *(const f32x4*)(bp + 32 * bj + 4 * n);
        unsigned tkv[8];
#pragma unroll
        for (int ai = 0; ai < 2; ++ai)
#pragma unroll
            for (int m = 0; m < 4; ++m) { const int rr = u.mt * BM + ai * HALF + wr * 64 + m * 16 + fr, rc = rr < u.cnt ? rr : u.cnt - 1;
                tkv[ai * 4 + m] = list[(size_t)u.e * CAP + rc].x; }
#pragma unroll
        for (int ai = 0; ai < 2; ++ai)
#pragma unroll
            for (int m = 0; m < 4; ++m) { const int rr = u.mt * BM + ai * HALF + wr * 64 + m * 16 + fr;
                if (rr < u.cnt) { bf16_t* rowp = Y4 + (size_t)tkv[ai * 4 + m] * 1024 + col0;
#pragma unroll
                    for (int bj = 0; bj < 2; ++bj) store8(rowp + 32 * bj, acc[ai][bj][m][0] * (1.0f / (W8_SCALE * A8_SCALE)) + bv[bj][0], acc[ai][bj][m][1] * (1.0f / (W8_SCALE * A8_SCALE)) + bv[bj][1]); } }
    }
};
struct EpiMergeR {
    static constexpr bool HAS_MID = true; static constexpr int MID_T0 = 8, MID_T1 = 12;
    const bf16_t* GT; bf16_t* MB;
    __device__ __forceinline__ void mid(f32x4 (&acc)[2][2][4][2], const Unit& u, int wr, int wc, int fr, int fq, int seam) const {
        int z = 0; asm volatile("" : "+v"(z));
        const bf16_t* gp0 = GT + ((size_t)(seam * 128 + u.pm) * 4 + u.pn) * 65536 + (size_t)((wr * 4 + wc) * 16 * 64 + (fq * 16 + fr) + z) * 8;
#pragma unroll
        for (int ai = 0; ai < 2; ++ai)
#pragma unroll
            for (int m = 0; m < 4; ++m) {
#pragma unroll
                for (int bj = 0; bj < 2; ++bj) { const bf16_t* gp = gp0 + (ai * 8 + m * 2 + bj) * 512;
                    const u32x4 gn = *(const u32x4*)gp, gd = *(const u32x4*)(gp + (size_t)128 * 4 * 65536);
                    const unsigned nn[4] = {gn.x, gn.y, gn.z, gn.w}, dd[4] = {gd.x, gd.y, gd.z, gd.w};
#pragma unroll
                    for (int j = 0; j < 4; ++j) { const float r0 = bf_lo(nn[j]) * __builtin_amdgcn_rcpf(fmaxf(bf_lo(dd[j]), 8.67e-19f)), r1 = bf_hi(nn[j]) * __builtin_amdgcn_rcpf(fmaxf(bf_hi(dd[j]), 8.67e-19f));
                        acc[ai][bj][m][j >> 1][(j & 1) * 2] *= r0; acc[ai][bj][m][j >> 1][(j & 1) * 2 + 1] *= r1; } }
                if (m & 1) asm volatile("" ::: "memory"); }
    }
    __device__ __forceinline__ void operator()(AccRef acc, const Unit& u, int wr, int wc, int fr, int fq) const {
        int z = 0; asm volatile("" : "+v"(z));
        const size_t off0 = (size_t)(u.pm * BM + wr * 64 + fr + z) * 1024 + u.pn * BM + wc * 64 + 8 * fq;
        const bf16_t* gp0 = GT + ((size_t)(2 * 128 + u.pm) * 4 + u.pn) * 65536 + (size_t)((wr * 4 + wc) * 16 * 64 + (fq * 16 + fr) + z) * 8;
#pragma unroll
        for (int ai = 0; ai < 2; ++ai)
#pragma unroll
            for (int m = 0; m < 4; ++m) { const size_t ro = off0 + (size_t)(ai * HALF + m * 16) * 1024;
#pragma unroll
                for (int bj = 0; bj < 2; ++bj) {
                    const u32x4 g = *(const u32x4*)(gp0 + (ai * 8 + m * 2 + bj) * 512);
                    const f32x4 ga = {bf_lo(g.x), bf_hi(g.x), bf_lo(g.y), bf_hi(g.y)}, gb = {bf_lo(g.z), bf_hi(g.z), bf_lo(g.w), bf_hi(g.w)};
                    store8(MB + ro + 32 * bj, acc[ai][bj][m][0] * ga, acc[ai][bj][m][1] * gb); } }
    }
};
struct EpiPlain {
    static constexpr bool HAS_MID = false;
    bf16_t* Z; int ldz;
    __device__ __forceinline__ void operator()(AccRef acc, const Unit& u, int wr, int wc, int fr, int fq) const {
        const int row0 = u.pm * BM + wr * 64 + fr, col0 = u.pn * BM + wc * 64 + 8 * fq;
#pragma unroll
        for (int ai = 0; ai < 2; ++ai)
#pragma unroll
            for (int m = 0; m < 4; ++m) { bf16_t* rowp = Z + (size_t)(row0 + ai * HALF + m * 16) * ldz + col0;
                store8(rowp, acc[ai][0][m][0], acc[ai][0][m][1]); store8(rowp + 32, acc[ai][1][m][0], acc[ai][1][m][1]); }
    }
};
}

namespace attn_body {
using bf16 = __hip_bfloat16;
using s16x4 = __attribute__((ext_vector_type(4))) short;
constexpr int NW = 8, QBLK = 32, QB = QBLK * NW, KVBLK = 64, D = 64;
__device__ __forceinline__ int crow(int r, int hi) { return (r & 3) + 8 * (r >> 2) + 4 * hi; }
#define SBAR() __builtin_amdgcn_sched_barrier(0)
constexpr int NSLOT = 3, SLOTB = 8192;
constexpr int LDS_K = 0, LDS_V = NSLOT * SLOTB, LDS_WS = 2 * NSLOT * SLOTB, LDS_OST = LDS_WS + NW * 64 * 4, LDS_BYTES = LDS_OST + NW * 4096;
__device__ __forceinline__ void glds16(const void* gsrc, unsigned lds_dst) { unsigned keep;
    asm volatile("s_mov_b32 %0, m0\n\ts_mov_b32 m0, %2\n\ts_nop 0\n\tglobal_load_lds_dwordx4 %1, off\n\ts_mov_b32 m0, %0" : "=&s"(keep) : "v"(gsrc), "s"(lds_dst) : "memory"); }
__device__ __forceinline__ float max3f(float a, float b, float c) { float r; asm("v_max3_f32 %0, %1, %2, %3" : "=v"(r) : "v"(a), "v"(b), "v"(c)); return r; }
__device__ __forceinline__ float max2f(float a, float b) { float r; asm("v_max_f32_e32 %0, %1, %2" : "=v"(r) : "v"(a), "v"(b)); return r; }
__device__ __forceinline__ float fadd_s(float a, float b) { float r; asm("v_add_f32_e32 %0, %1, %2" : "=v"(r) : "v"(a), "v"(b)); return r; }
__device__ __forceinline__ float fsub_s(float a, float b) { float r; asm("v_sub_f32_e32 %0, %1, %2" : "=v"(r) : "v"(a), "v"(b)); return r; }
typedef float f32x2_t __attribute__((ext_vector_type(2))); typedef __bf16 bf16x2_t __attribute__((ext_vector_type(2)));
__device__ __forceinline__ unsigned cvtpk_s(float lo, float hi) { f32x2_t v = {lo, hi}; bf16x2_t b = __builtin_convertvector(v, bf16x2_t); return __builtin_bit_cast(unsigned, b); }
#define WAIT_BAR(N) asm volatile("s_waitcnt vmcnt(" #N ") lgkmcnt(0)\n\ts_barrier" ::: "memory")

__device__ __forceinline__ void qkt(f32x16& p0, f32x16& p1, const char* Kslot, const bf16x8* qr, const f32x16& negm, int r32, int hi) {
    const char* kb = Kslot + hi * 1024 + r32 * 16;
#pragma unroll
    for (int d0 = 0; d0 < 4; ++d0) {
        const bf16x8 b0 = *reinterpret_cast<const bf16x8*>(kb + d0 * 2048);
        const bf16x8 b1 = *reinterpret_cast<const bf16x8*>(kb + d0 * 2048 + 512);
        if (d0 == 0) { p0 = __builtin_amdgcn_mfma_f32_32x32x16_bf16(b0, qr[0], negm, 0, 0, 0); p1 = __builtin_amdgcn_mfma_f32_32x32x16_bf16(b1, qr[0], negm, 0, 0, 0); }
        else { p0 = __builtin_amdgcn_mfma_f32_32x32x16_bf16(b0, qr[d0], p0, 0, 0, 0); p1 = __builtin_amdgcn_mfma_f32_32x32x16_bf16(b1, qr[d0], p1, 0, 0, 0); } }
}
typedef __attribute__((address_space(3))) const char* lds_cptr;
typedef short v4i16_t __attribute__((ext_vector_type(4)));
__device__ __forceinline__ void kload8(bf16x8* kf, lds_cptr kp) {
    kf[0] = *(const __attribute__((address_space(3))) bf16x8*)(kp);        kf[1] = *(const __attribute__((address_space(3))) bf16x8*)(kp + 512);
    kf[2] = *(const __attribute__((address_space(3))) bf16x8*)(kp + 2048); kf[3] = *(const __attribute__((address_space(3))) bf16x8*)(kp + 2560);
    kf[4] = *(const __attribute__((address_space(3))) bf16x8*)(kp + 4096); kf[5] = *(const __attribute__((address_space(3))) bf16x8*)(kp + 4608);
    kf[6] = *(const __attribute__((address_space(3))) bf16x8*)(kp + 6144); kf[7] = *(const __attribute__((address_space(3))) bf16x8*)(kp + 6656);
}
__device__ __forceinline__ void kload2(bf16x8* kf, lds_cptr kp, int j) { kf[2 * j] = *(const __attribute__((address_space(3))) bf16x8*)(kp + j * 2048); kf[2 * j + 1] = *(const __attribute__((address_space(3))) bf16x8*)(kp + j * 2048 + 512); }
__device__ __forceinline__ s16x4 vtr(lds_cptr p) { return __builtin_bit_cast(s16x4, __builtin_amdgcn_ds_read_tr16_b64_v4i16((__attribute__((address_space(3))) v4i16_t*)p)); }
__device__ __forceinline__ float rowmax(const f32x16& p0, const f32x16& p1) {
    float a = max3f(p0[0], p0[1], p1[0]), b = max3f(p0[2], p0[3], p1[1]); a = max3f(a, p1[2], p1[3]);
#pragma unroll
    for (int r = 4; r < 16; r += 4) { a = max3f(a, p0[r], p0[r + 1]); b = max3f(b, p0[r + 2], p0[r + 3]); a = max3f(a, p1[r], p1[r + 1]); b = max3f(b, p1[r + 2], p1[r + 3]); }
    const float m = max2f(a, b);
    auto rr = __builtin_amdgcn_permlane32_swap(__float_as_uint(m), __float_as_uint(m), false, false);
    return max2f(__uint_as_float(rr[0]), __uint_as_float(rr[1]));
}
__device__ __forceinline__ void pv(f32x16* o, int vb, bf16x8 pa0, bf16x8 pa1, bf16x8 pa2, bf16x8 pa3) {
#pragma unroll
    for (int d0 = 0; d0 < 2; ++d0) { s16x4 lo[4], hi[4];
#pragma unroll
        for (int ks = 0; ks < 4; ++ks) {
            asm volatile("ds_read_b64_tr_b16 %0,%1 offset:%c2" : "=&v"(lo[ks]) : "v"(vb), "i"(d0 * 4096 + ks * 1024) : "memory");
            asm volatile("ds_read_b64_tr_b16 %0,%1 offset:%c2" : "=&v"(hi[ks]) : "v"(vb), "i"(d0 * 4096 + ks * 1024 + 512) : "memory"); }
        asm volatile("s_waitcnt lgkmcnt(0)" ::: "memory"); SBAR();
#define PK(k) (bf16x8){lo[k][0], lo[k][1], lo[k][2], lo[k][3], hi[k][0], hi[k][1], hi[k][2], hi[k][3]}
        o[d0] = __builtin_amdgcn_mfma_f32_32x32x16_bf16(pa0, PK(0), o[d0], 0, 0, 0);
        o[d0] = __builtin_amdgcn_mfma_f32_32x32x16_bf16(pa1, PK(1), o[d0], 0, 0, 0);
        o[d0] = __builtin_amdgcn_mfma_f32_32x32x16_bf16(pa2, PK(2), o[d0], 0, 0, 0);
        o[d0] = __builtin_amdgcn_mfma_f32_32x32x16_bf16(pa3, PK(3), o[d0], 0, 0, 0);
#undef PK
    }
}
__device__ __forceinline__ void cmask(f32x16& p0, f32x16& p1, int jb, int wid) {
    if (jb > (wid >> 1)) {
#pragma unroll
        for (int r = 0; r < 16; ++r) { p0[r] = -INFINITY; p1[r] = -INFINITY; } }
}
template <int THRL, bool MASK> __device__ __forceinline__ void attn_unit(int q0, int NT, const bf16* Qh, int qp, const bf16* __restrict__ Kh, int kp, const bf16* __restrict__ Vh, int vp, bf16* Oh, int op, char* shm) {
    const int tid = threadIdx.x, lane = tid & 63, r32 = lane & 31, hi = lane >> 5; const int wid = __builtin_amdgcn_readfirstlane(tid >> 6);
    const bf16* Qw = Qh + (long)(q0 + wid * QBLK) * qp;
    const unsigned lds0 = (unsigned)(uintptr_t)shm;
    float* wsf = (float*)(shm + LDS_WS) + wid * 64;
    const bf16* ksrc = Kh + (long)lane * kp + wid * 8;
    const bf16* vsrc = Vh + (long)(16 * (wid & 3) + (lane >> 2)) * vp + (wid >> 2) * 32 + (lane & 3) * 8;
    const unsigned kdst = lds0 + LDS_K + wid * 1024, vdst = lds0 + LDS_V + wid * 1024;
#define DMA_K(t, slot) glds16(ksrc + (long)(t) * KVBLK * kp, (unsigned)__builtin_amdgcn_readfirstlane(kdst + (slot)))
#define DMA_V(t, slot) glds16(vsrc + (long)(t) * KVBLK * vp, (unsigned)__builtin_amdgcn_readfirstlane(vdst + (slot)))
    const int vb0 = (int)(lds0 + LDS_V) + ((lane >> 4) & 1) * 32 + (lane & 3) * 8 + (4 * hi + ((lane & 15) >> 2)) * 64;
    const char* Kbase = shm + LDS_K; bf16x8 kf[8];
    const lds_cptr shm3 = (lds_cptr)shm; const lds_cptr kp0 = shm3 + LDS_K + hi * 1024 + r32 * 16; const lds_cptr vp0 = shm3 + LDS_V + ((lane >> 4) & 1) * 32 + (lane & 3) * 8 + (4 * hi + ((lane & 15) >> 2)) * 64;
    DMA_K(0, 0); DMA_V(0, 0); DMA_K(1, SLOTB);
    bf16x8 qr[4];
#pragma unroll
    for (int d0 = 0; d0 < 4; ++d0) qr[d0] = *reinterpret_cast<const bf16x8*>(&Qw[(long)r32 * qp + d0 * 16 + hi * 8]);
    float mhat = 0.f, l_reg = 0.f; f32x16 o[2]; o[0] = f32x16{}; o[1] = f32x16{}; f32x16 negm = f32x16{}; asm volatile("" : "+v"(negm));
#define CMASK(P0, P1, t) do { if (MASK) { int jb_ = (t) - (NT - 4); if (jb_ >= 0) cmask(P0, P1, jb_, wid); } } while (0)
    bool resc = false;
#define START(P0, P1) do { const float rm = rowmax(P0, P1); resc = false; \
    { const float dl = rm; mhat = fadd_s(mhat, dl); \
      _Pragma("unroll") for (int r = 0; r < 16; ++r) { P0[r] = fsub_s(P0[r], dl); P1[r] = fsub_s(P1[r], dl); } \
      _Pragma("unroll") for (int r = 0; r < 16; ++r) negm[r] = -mhat; asm volatile("" : "+v"(negm)); } \
    _Pragma("unroll") for (int r = 0; r < 16; ++r) P0[r] = __builtin_amdgcn_exp2f(P0[r]); } while (0)
#define RESC() do { if (resc) { asm volatile("s_waitcnt lgkmcnt(0)" ::: "memory"); \
      _Pragma("unroll") for (int d_ = 0; d_ < 2; ++d_) _Pragma("unroll") for (int r = 0; r < 16; ++r) o[d_][r] *= wsf[crow(r, hi)]; } } while (0)
    f32x16 pA0, pA1, pB0, pB1;
    int sl_prev = 0, sl_cur = 0, sl_next = SLOTB;
#define ROT() do { sl_prev = sl_cur; sl_cur = sl_next; sl_next = (sl_next == (NSLOT - 1) * SLOTB) ? 0 : sl_next + SLOTB; } while (0)
    DMA_K(2, 2 * SLOTB);
    WAIT_BAR(3);
    qkt(pA0, pA1, Kbase, qr, negm, r32, hi); asm volatile("s_nop 15\n\ts_nop 7" : "+v"(pA0), "+v"(pA1)); CMASK(pA0, pA1, 0);
    START(pA0, pA1);
    _Pragma("unroll") for (int r = 0; r < 16; ++r) pA1[r] = __builtin_amdgcn_exp2f(pA1[r]);
    WAIT_BAR(0);
    DMA_K(3, 0); DMA_V(1, SLOTB);
    ROT();
    kload8(kf, kp0 + sl_cur);
    WAIT_BAR(2);
    s16x4 vlo[8], vhi[8]; u32x4 pw0, pw1, pw2, pw3;
#define PKW(P, B) cvtpk_s(P[B], P[B + 1])
#define PAF(k) __builtin_bit_cast(bf16x8, pw##k)
#define VFR(i) (bf16x8){vlo[i][0], vlo[i][1], vlo[i][2], vlo[i][3], vhi[i][0], vhi[i][1], vhi[i][2], vhi[i][3]}
#define PIN(x) asm volatile("" : "+v"(x))
#define MX3(a, b, c) __builtin_fmaxf(__builtin_fmaxf((a), (b)), (c))
#define GAPA(MF, A0, A1, A2, A3, W0, W1, PW) do { MF; sacc += A0; sacc += A1; sacc += A2; sacc += A3; PIN(sacc); W0; W1; PIN(PW); SBAR(); } while (0)
#define EX(v) __builtin_amdgcn_exp2f(v)
#define GAPB(MF, X, B) do { MF; X[B] = EX(X[B]); X[B + 1] = EX(X[B + 1]); X[B + 2] = EX(X[B + 2]); X[B + 3] = EX(X[B + 3]); PIN(X); SBAR(); } while (0)
#define VRD(i) do { vlo[i] = vtr(vp_ + (((i) >> 2) * 4096 + ((i) & 3) * 1024)); vhi[i] = vtr(vp_ + (((i) >> 2) * 4096 + ((i) & 3) * 1024 + 512)); } while (0)
#define KRD(G, j) do { if (G) { kload2(kf, kp0 + sl_next, j); SBAR(); } } while (0)
#define STEP(C0, C1, P0, P1, t, GK, GV, GL) do { SBAR(); \
    const lds_cptr vp_ = vp0 + sl_prev; \
    VRD(0); SBAR(); float sacc = (P0[0] + P0[1]); \
    GAPA(C0 = __builtin_amdgcn_mfma_f32_32x32x16_bf16(kf[0], qr[0], negm, 0, 0, 0), P0[2], P0[3], P0[4], P0[5],     pw0[0] = PKW(P0, 0), pw0[1] = PKW(P0, 2), pw0); \
    VRD(4); SBAR(); GAPA(C1 = __builtin_amdgcn_mfma_f32_32x32x16_bf16(kf[1], qr[0], negm, 0, 0, 0), P0[6], P0[7], P0[8], P0[9],     pw0[2] = PKW(P0, 4), pw0[3] = PKW(P0, 6), pw0); \
    VRD(1); SBAR(); GAPA(C0 = __builtin_amdgcn_mfma_f32_32x32x16_bf16(kf[2], qr[1], C0, 0, 0, 0),   P0[10], P0[11], P0[12], P0[13], pw1[0] = PKW(P0, 8), pw1[1] = PKW(P0, 10), pw1); \
    VRD(5); SBAR(); GAPA(C1 = __builtin_amdgcn_mfma_f32_32x32x16_bf16(kf[3], qr[1], C1, 0, 0, 0),   P0[14], P0[15], P1[0], P1[1],   pw1[2] = PKW(P0, 12), pw1[3] = PKW(P0, 14), pw1); \
    VRD(2); SBAR(); GAPA(C0 = __builtin_amdgcn_mfma_f32_32x32x16_bf16(kf[4], qr[2], C0, 0, 0, 0),   P1[2], P1[3], P1[4], P1[5],     pw2[0] = PKW(P1, 0), pw2[1] = PKW(P1, 2), pw2); \
    VRD(6); SBAR(); GAPA(C1 = __builtin_amdgcn_mfma_f32_32x32x16_bf16(kf[5], qr[2], C1, 0, 0, 0),   P1[6], P1[7], P1[8], P1[9],     pw2[2] = PKW(P1, 4), pw2[3] = PKW(P1, 6), pw2); \
    VRD(3); SBAR(); GAPA(C0 = __builtin_amdgcn_mfma_f32_32x32x16_bf16(kf[6], qr[3], C0, 0, 0, 0),   P1[10], P1[11], P1[12], P1[13], pw3[0] = PKW(P1, 8), pw3[1] = PKW(P1, 10), pw3); \
    VRD(7); SBAR(); GAPA(C1 = __builtin_amdgcn_mfma_f32_32x32x16_bf16(kf[7], qr[3], C1, 0, 0, 0),   P1[14], P1[15], 0.f, 0.f,       pw3[2] = PKW(P1, 12), pw3[3] = PKW(P1, 14), pw3); \
    l_reg += sacc; \
    if (GK) { DMA_K((t) + 3, sl_cur); } if (GV) { DMA_V((t) + 1, sl_next); } \
    CMASK(C0, C1, t); \
    { float a = MX3(C0[0], C0[1], C1[0]), b = MX3(C0[2], C0[3], C1[1]); a = MX3(a, C1[2], C1[3]); \
      _Pragma("unroll") for (int r = 4; r < 16; r += 4) { a = MX3(a, C0[r], C0[r + 1]); b = MX3(b, C0[r + 2], C0[r + 3]); a = MX3(a, C1[r], C1[r + 1]); b = MX3(b, C1[r + 2], C1[r + 3]); } \
      float rm = __builtin_fmaxf(a, b); { auto rr = __builtin_amdgcn_permlane32_swap(__float_as_uint(rm), __float_as_uint(rm), false, false); rm = __builtin_fmaxf(__uint_as_float(rr[0]), __uint_as_float(rr[1])); } \
      resc = false; \
      if (__builtin_expect(__any(rm > (float)THRL), 0)) { const float dl = __builtin_fmaxf(rm, 0.f); mhat += dl; \
        _Pragma("unroll") for (int r = 0; r < 16; ++r) { C0[r] -= dl; C1[r] -= dl; } \
        _Pragma("unroll") for (int r = 0; r < 16; ++r) negm[r] = -mhat; asm volatile("" : "+v"(negm)); \
        const float f = __builtin_amdgcn_exp2f(-dl); l_reg *= f; if (hi == 0) wsf[r32] = f; resc = true; } } \
    SBAR(); \
    GAPB(o[0] = __builtin_amdgcn_mfma_f32_32x32x16_bf16(PAF(0), VFR(0), o[0], 0, 0, 0), C0, 0); \
    GAPB(o[1] = __builtin_amdgcn_mfma_f32_32x32x16_bf16(PAF(0), VFR(4), o[1], 0, 0, 0), C0, 4); \
    KRD(GL, 0); GAPB(o[0] = __builtin_amdgcn_mfma_f32_32x32x16_bf16(PAF(1), VFR(1), o[0], 0, 0, 0), C0, 8); \
    KRD(GL, 1); GAPB(o[1] = __builtin_amdgcn_mfma_f32_32x32x16_bf16(PAF(1), VFR(5), o[1], 0, 0, 0), C0, 12); \
    KRD(GL, 2); GAPB(o[0] = __builtin_amdgcn_mfma_f32_32x32x16_bf16(PAF(2), VFR(2), o[0], 0, 0, 0), C1, 0); \
    KRD(GL, 3); GAPB(o[1] = __builtin_amdgcn_mfma_f32_32x32x16_bf16(PAF(2), VFR(6), o[1], 0, 0, 0), C1, 4); \
    GAPB(o[0] = __builtin_amdgcn_mfma_f32_32x32x16_bf16(PAF(3), VFR(3), o[0], 0, 0, 0), C1, 8); \
    GAPB(o[1] = __builtin_amdgcn_mfma_f32_32x32x16_bf16(PAF(3), VFR(7), o[1], 0, 0, 0), C1, 12); \
    } while (0)
    int t = 1;
#undef CMASK
#define CMASK(P0, P1, t) do {} while (0)
    for (; t + 5 < NT; t += 2) {
        STEP(pB0, pB1, pA0, pA1, t, true, true, true);     WAIT_BAR(2); RESC(); ROT();
        STEP(pA0, pA1, pB0, pB1, t + 1, true, true, true); WAIT_BAR(2); RESC(); ROT();
    }
#undef CMASK
#define CMASK(P0, P1, t) do { if (MASK) { int jb_ = (t) - (NT - 4); if (jb_ >= 0) cmask(P0, P1, jb_, wid); } } while (0)
#define ENDW(tt) do { if ((tt) + 3 < NT) { WAIT_BAR(2); } else if ((tt) + 2 < NT) { WAIT_BAR(1); } else { WAIT_BAR(0); } } while (0)
    for (; t + 1 < NT; t += 2) {
        STEP(pB0, pB1, pA0, pA1, t, (t + 3 < NT), (t + 1 < NT), (t + 1 < NT));       ENDW(t);     RESC(); ROT();
        STEP(pA0, pA1, pB0, pB1, t + 1, (t + 4 < NT), (t + 2 < NT), (t + 2 < NT));   ENDW(t + 1); RESC(); ROT();
    }
    STEP(pB0, pB1, pA0, pA1, NT - 1, false, false, false); RESC();
    { float sacc = pB0[0] + pB0[1]; _Pragma("unroll") for (int r = 2; r < 16; ++r) sacc += pB0[r]; _Pragma("unroll") for (int r = 0; r < 16; ++r) sacc += pB1[r]; l_reg += sacc;
      pw0 = (u32x4){PKW(pB0, 0), PKW(pB0, 2), PKW(pB0, 4), PKW(pB0, 6)}; pw1 = (u32x4){PKW(pB0, 8), PKW(pB0, 10), PKW(pB0, 12), PKW(pB0, 14)}; pw2 = (u32x4){PKW(pB1, 0), PKW(pB1, 2), PKW(pB1, 4), PKW(pB1, 6)}; pw3 = (u32x4){PKW(pB1, 8), PKW(pB1, 10), PKW(pB1, 12), PKW(pB1, 14)};
      SBAR(); pv(o, vb0 + sl_cur, PAF(0), PAF(1), PAF(2), PAF(3)); }
#undef PKW
#undef PAF
#undef VFR
#undef PIN
#undef MX3
#undef GAPA
#undef GAPB
#undef EX
#undef VRD
#undef KRD
#undef STEP
#undef ENDW
    { auto rr = __builtin_amdgcn_permlane32_swap(__float_as_uint(l_reg), __float_as_uint(l_reg), false, false); l_reg = __uint_as_float(rr[0]) + __uint_as_float(rr[1]); }
    if (hi == 0) wsf[32 + r32] = l_reg; asm volatile("s_waitcnt lgkmcnt(0)" ::: "memory");
    float rli[16];
#pragma unroll
    for (int r = 0; r < 16; ++r) rli[r] = __builtin_amdgcn_rcpf(wsf[32 + crow(r, hi)]);
    bf16* Ow = Oh + (long)(q0 + wid * QBLK) * op;
    { bf16* stg = (bf16*)(shm + LDS_OST) + wid * 2048;
#pragma unroll
      for (int r = 0; r < 16; ++r) { const int orow = crow(r, hi);
#pragma unroll
        for (int d0 = 0; d0 < 2; ++d0) stg[orow * 64 + d0 * 32 + r32] = __float2bfloat16(o[d0][r] * rli[r]); }
      asm volatile("s_waitcnt lgkmcnt(0)" ::: "memory");
#pragma unroll
      for (int i = 0; i < 4; ++i) { const int row = i * 8 + (lane >> 3), ch = lane & 7; const u32x4 v = *(const u32x4*)(stg + row * 64 + ch * 8); *(u32x4*)(Ow + (long)row * op + ch * 8) = v; } }
    asm volatile("s_waitcnt lgkmcnt(0)\n\ts_barrier" ::: "memory");
#undef DMA_K
#undef DMA_V
#undef CMASK
#undef START
#undef RESC
#undef ROT
}

constexpr int L2_K = 0, L2_V = 3 * 8192, L2_WS = L2_V + 4 * 16384, L2_OST = L2_WS + NW * 64 * 4, L2_BYTES = L2_OST + NW * 4096;
template <bool MASK> __device__ __forceinline__ void attn_unit2(int q0, int NT, const bf16* Qh, int qp, const bf16* __restrict__ Kh, int kp, const bf16* __restrict__ Vh, int vp, bf16* Oh, int op, char* shm) {
    const int tid = threadIdx.x, lane = tid & 63, r32 = lane & 31, hi = lane >> 5; const int wid = __builtin_amdgcn_readfirstlane(tid >> 6);
    const bf16* Qw = Qh + (long)(q0 + wid * QBLK) * qp;
    const unsigned lds0 = (unsigned)(uintptr_t)shm;
    float* wsf = (float*)(shm + L2_WS) + wid * 64;
    const bf16* ksrc = Kh + (long)lane * kp + wid * 8;
    const bf16* vsrc = Vh + (long)(16 * (wid & 3) + (lane >> 2)) * vp + (wid >> 2) * 32 + (lane & 3) * 8;
    const unsigned kdst = lds0 + L2_K + wid * 1024, vdst = lds0 + L2_V + wid * 1024;
#define DMA_K(t, slot) glds16(ksrc + (long)(t) * KVBLK * kp, (unsigned)__builtin_amdgcn_readfirstlane(kdst + (slot)))
#define DMA_V(t, vslot) do { glds16(vsrc + (long)(t) * KVBLK * vp, (unsigned)__builtin_amdgcn_readfirstlane(vdst + (vslot))); \
                            glds16(vsrc + (long)(t) * KVBLK * vp + 64, (unsigned)__builtin_amdgcn_readfirstlane(vdst + (vslot) + 8192)); } while (0)
    const int vb0 = (int)(lds0 + L2_V) + ((lane >> 4) & 1) * 32 + (lane & 3) * 8 + (4 * hi + ((lane & 15) >> 2)) * 64;
    const char* Kbase = shm + L2_K; bf16x8 kf[8];
    const lds_cptr shm3 = (lds_cptr)shm; const lds_cptr kp0 = shm3 + L2_K + hi * 1024 + r32 * 16; const lds_cptr vp0 = shm3 + L2_V + ((lane >> 4) & 1) * 32 + (lane & 3) * 8 + (4 * hi + ((lane & 15) >> 2)) * 64;
    DMA_K(0, 0); DMA_V(0, 0); DMA_K(1, SLOTB);
    bf16x8 qr[4];
#pragma unroll
    for (int d0 = 0; d0 < 4; ++d0) qr[d0] = *reinterpret_cast<const bf16x8*>(&Qw[(long)r32 * qp + d0 * 16 + hi * 8]);
    float l_reg = 0.f; f32x16 o[4]; o[0] = f32x16{}; o[1] = f32x16{}; o[2] = f32x16{}; o[3] = f32x16{};
    const f32x16 zero16 = f32x16{};
#define CMASK(P0, P1, t) do { if (MASK) { int jb_ = (t) - (NT - 4); if (jb_ >= 0) cmask(P0, P1, jb_, wid); } } while (0)
    f32x16 pA0, pA1, pB0, pB1;
    int sl_prev = 0, sl_cur = 0, sl_next = SLOTB;
    int vs_rd = 0, vs_wr = 3 * 16384;
#define ROT() do { sl_prev = sl_cur; sl_cur = sl_next; sl_next = (sl_next == (NSLOT - 1) * SLOTB) ? 0 : sl_next + SLOTB; vs_rd = (vs_rd + 16384) & 65535; vs_wr = (vs_wr + 16384) & 65535; } while (0)
    DMA_K(2, 2 * SLOTB); DMA_V(1, 16384);
    WAIT_BAR(6);
    qkt(pA0, pA1, Kbase, qr, zero16, r32, hi); CMASK(pA0, pA1, 0);
    _Pragma("unroll") for (int r = 0; r < 16; ++r) { pA0[r] = __builtin_amdgcn_exp2f(pA0[r]); pA1[r] = __builtin_amdgcn_exp2f(pA1[r]); }
    WAIT_BAR(2);
    DMA_K(3, 0); DMA_V(2, 2 * 16384);
    sl_prev = sl_cur; sl_cur = sl_next; sl_next = 2 * SLOTB;
    kload8(kf, kp0 + sl_cur);
    WAIT_BAR(5);
    s16x4 f0lo, f0hi, f1lo, f1hi, f2lo, f2hi, f3lo, f3hi; u32x4 pw0, pw1, pw2, pw3;
#define PKW(P, B) cvtpk_s(P[B], P[B + 1])
#define PAF(k) __builtin_bit_cast(bf16x8, pw##k)
#define PIN(x) asm volatile("" : "+v"(x))
#define EX(v) __builtin_amdgcn_exp2f(v)
#define VOFF(id) ((((id) >> 2) * 4096) + (((id) & 3) * 1024))
#define VRD2(F, id) do { F##lo = vtr(vp_ + VOFF(id)); F##hi = vtr(vp_ + VOFF(id) + 512); } while (0)
#define VFR2(F) (bf16x8){F##lo[0], F##lo[1], F##lo[2], F##lo[3], F##hi[0], F##hi[1], F##hi[2], F##hi[3]}
#define GAPA(MF, A0, A1, A2, A3, W0, W1, PW) do { MF; sacc += A0; sacc += A1; sacc += A2; sacc += A3; PIN(sacc); W0; W1; PIN(PW); SBAR(); } while (0)
#define GAPB(MF, RD, X, B) do { MF; RD; X[B] = EX(X[B]); X[B + 1] = EX(X[B + 1]); PIN(X); SBAR(); } while (0)
#define KRD(G, j) do { if (G) { kload2(kf, kp0 + sl_next, j); SBAR(); } } while (0)
#define MF32(a, b, c) __builtin_amdgcn_mfma_f32_32x32x16_bf16(a, b, c, 0, 0, 0)
#define STEP(C0, C1, P0, P1, t, GK, GV, GL) do { SBAR(); __builtin_amdgcn_s_setprio(ATTN_PRIO_A); \
    const lds_cptr vp_ = vp0 + vs_rd; \
    float sacc = (P0[0] + P0[1]); \
    GAPA(C0 = MF32(kf[0], qr[0], zero16), P0[2], P0[3], P0[4], P0[5],     pw0[0] = PKW(P0, 0), pw0[1] = PKW(P0, 2), pw0); \
    GAPA(C1 = MF32(kf[1], qr[0], zero16), P0[6], P0[7], P0[8], P0[9],     pw0[2] = PKW(P0, 4), pw0[3] = PKW(P0, 6), pw0); \
    GAPA(C0 = MF32(kf[2], qr[1], C0),     P0[10], P0[11], P0[12], P0[13], pw1[0] = PKW(P0, 8), pw1[1] = PKW(P0, 10), pw1); \
    GAPA(C1 = MF32(kf[3], qr[1], C1),     P0[14], P0[15], P1[0], P1[1],   pw1[2] = PKW(P0, 12), pw1[3] = PKW(P0, 14), pw1); \
    VRD2(f0, 0); SBAR();  GAPA(C0 = MF32(kf[4], qr[2], C0), P1[2], P1[3], P1[4], P1[5],     pw2[0] = PKW(P1, 0), pw2[1] = PKW(P1, 2), pw2); \
    VRD2(f1, 4); SBAR();  GAPA(C1 = MF32(kf[5], qr[2], C1), P1[6], P1[7], P1[8], P1[9],     pw2[2] = PKW(P1, 4), pw2[3] = PKW(P1, 6), pw2); \
    VRD2(f2, 8); SBAR();  GAPA(C0 = MF32(kf[6], qr[3], C0), P1[10], P1[11], P1[12], P1[13], pw3[0] = PKW(P1, 8), pw3[1] = PKW(P1, 10), pw3); \
    VRD2(f3, 12); SBAR(); GAPA(C1 = MF32(kf[7], qr[3], C1), P1[14], P1[15], 0.f, 0.f,       pw3[2] = PKW(P1, 12), pw3[3] = PKW(P1, 14), pw3); \
    l_reg += sacc; __builtin_amdgcn_s_setprio(0); \
    if (GK) { DMA_K((t) + 3, sl_cur); } if (GV) { DMA_V((t) + 2, vs_wr); } \
    CMASK(C0, C1, t); \
    SBAR(); __builtin_amdgcn_s_setprio(ATTN_PRIO_B); \
    GAPB(o[0] = MF32(PAF(0), VFR2(f0), o[0]), VRD2(f0, 1),  C0, 0); \
    GAPB(o[1] = MF32(PAF(0), VFR2(f1), o[1]), VRD2(f1, 5),  C0, 2); \
    GAPB(o[2] = MF32(PAF(0), VFR2(f2), o[2]), VRD2(f2, 9),  C0, 4); \
    GAPB(o[3] = MF32(PAF(0), VFR2(f3), o[3]), VRD2(f3, 13), C0, 6); \
    KRD(GL, 0); GAPB(o[0] = MF32(PAF(1), VFR2(f0), o[0]), VRD2(f0, 2),  C0, 8); \
    GAPB(o[1] = MF32(PAF(1), VFR2(f1), o[1]), VRD2(f1, 6),  C0, 10); \
    KRD(GL, 1); GAPB(o[2] = MF32(PAF(1), VFR2(f2), o[2]), VRD2(f2, 10), C0, 12); \
    GAPB(o[3] = MF32(PAF(1), VFR2(f3), o[3]), VRD2(f3, 14), C0, 14); \
    KRD(GL, 2); GAPB(o[0] = MF32(PAF(2), VFR2(f0), o[0]), VRD2(f0, 3),  C1, 0); \
    GAPB(o[1] = MF32(PAF(2), VFR2(f1), o[1]), VRD2(f1, 7),  C1, 2); \
    KRD(GL, 3); GAPB(o[2] = MF32(PAF(2), VFR2(f2), o[2]), VRD2(f2, 11), C1, 4); \
    GAPB(o[3] = MF32(PAF(2), VFR2(f3), o[3]), VRD2(f3, 15), C1, 6); \
    GAPB(o[0] = MF32(PAF(3), VFR2(f0), o[0]), (void)0, C1, 8); \
    GAPB(o[1] = MF32(PAF(3), VFR2(f1), o[1]), (void)0, C1, 10); \
    GAPB(o[2] = MF32(PAF(3), VFR2(f2), o[2]), (void)0, C1, 12); \
    GAPB(o[3] = MF32(PAF(3), VFR2(f3), o[3]), (void)0, C1, 14); __builtin_amdgcn_s_setprio(0); \
    } while (0)
    int t = 1;
#undef CMASK
#define CMASK(P0, P1, t) do {} while (0)
    for (; t + 5 < NT; t += 2) {
        STEP(pB0, pB1, pA0, pA1, t, true, true, true);     WAIT_BAR(5); ROT();
        STEP(pA0, pA1, pB0, pB1, t + 1, true, true, true); WAIT_BAR(5); ROT();
    }
#undef CMASK
#define CMASK(P0, P1, t) do { if (MASK) { int jb_ = (t) - (NT - 4); if (jb_ >= 0) cmask(P0, P1, jb_, wid); } } while (0)
#define ENDW(tt) do { if ((tt) + 3 < NT) { WAIT_BAR(5); } else if ((tt) + 2 < NT) { WAIT_BAR(4); } else { WAIT_BAR(0); } } while (0)
    for (; t + 1 < NT; t += 2) {
        STEP(pB0, pB1, pA0, pA1, t, (t + 3 < NT), (t + 2 < NT), (t + 1 < NT));       ENDW(t);     ROT();
        STEP(pA0, pA1, pB0, pB1, t + 1, (t + 4 < NT), (t + 3 < NT), (t + 2 < NT));   ENDW(t + 1); ROT();
    }
    STEP(pB0, pB1, pA0, pA1, NT - 1, false, false, false);
    { float sacc = pB0[0] + pB0[1]; _Pragma("unroll") for (int r = 2; r < 16; ++r) sacc += pB0[r]; _Pragma("unroll") for (int r = 0; r < 16; ++r) sacc += pB1[r]; l_reg += sacc;
      pw0 = (u32x4){PKW(pB0, 0), PKW(pB0, 2), PKW(pB0, 4), PKW(pB0, 6)}; pw1 = (u32x4){PKW(pB0, 8), PKW(pB0, 10), PKW(pB0, 12), PKW(pB0, 14)}; pw2 = (u32x4){PKW(pB1, 0), PKW(pB1, 2), PKW(pB1, 4), PKW(pB1, 6)}; pw3 = (u32x4){PKW(pB1, 8), PKW(pB1, 10), PKW(pB1, 12), PKW(pB1, 14)};
      SBAR();
      const lds_cptr vp_ = vp0 + ((vs_rd + 16384) & 65535);
#pragma unroll
      for (int db = 0; db < 4; ++db) { VRD2(f0, db * 4 + 0); VRD2(f1, db * 4 + 1); VRD2(f2, db * 4 + 2); VRD2(f3, db * 4 + 3);
          o[db] = MF32(PAF(0), VFR2(f0), o[db]); o[db] = MF32(PAF(1), VFR2(f1), o[db]); o[db] = MF32(PAF(2), VFR2(f2), o[db]); o[db] = MF32(PAF(3), VFR2(f3), o[db]); } }
#undef PKW
#undef PAF
#undef PIN
#undef EX
#undef VOFF
#undef VRD2
#undef VFR2
#undef GAPA
#undef GAPB
#undef KRD
#undef MF32
#undef STEP
#undef ENDW
    { auto rr = __builtin_amdgcn_permlane32_swap(__float_as_uint(l_reg), __float_as_uint(l_reg), false, false); l_reg = __uint_as_float(rr[0]) + __uint_as_float(rr[1]); }
    if (hi == 0) wsf[32 + r32] = l_reg; asm volatile("s_waitcnt lgkmcnt(0)" ::: "memory");
    float rli[16];
#pragma unroll
    for (int r = 0; r < 16; ++r) rli[r] = __builtin_amdgcn_rcpf(wsf[32 + crow(r, hi)]);
    bf16* Ow = Oh + (long)(q0 + wid * QBLK) * op;
    { bf16* stg = (bf16*)(shm + L2_OST) + wid * 2048;
#pragma unroll
      for (int dh = 0; dh < 2; ++dh) {
#pragma unroll
        for (int r = 0; r < 16; ++r) { const int orow = crow(r, hi);
#pragma unroll
          for (int d0 = 0; d0 < 2; ++d0) stg[orow * 64 + d0 * 32 + r32] = __float2bfloat16(o[dh * 2 + d0][r] * rli[r]); }
        asm volatile("s_waitcnt lgkmcnt(0)" ::: "memory");
#pragma unroll
        for (int i = 0; i < 4; ++i) { const int row = i * 8 + (lane >> 3), ch = lane & 7; const u32x4 v = *(const u32x4*)(stg + row * 64 + ch * 8); *(u32x4*)(Ow + (long)row * op + dh * 64 + ch * 8) = v; }
        asm volatile("s_waitcnt lgkmcnt(0)" ::: "memory"); } }
    asm volatile("s_waitcnt lgkmcnt(0)\n\ts_barrier" ::: "memory");
#undef DMA_K
#undef DMA_V
#undef CMASK
#undef ROT
}
#undef SBAR
#undef WAIT_BAR
}

#define XB_TMO      128
#define XB_XCNT(j)  (256  + 64 * (j))
#define XB_XSUB(j)  (1280 + 64 * (j))
#define XB_XGEN(j)  (2304 + 64 * (j))
#define XB_TOP      3328
#define XB_TOPGEN   3392
#define XCD_BAR_WORDS 3456
#define XB_SPIN_CAP (1u << 22)
__device__ __forceinline__ unsigned xb_ld(unsigned* p)              { return __hip_atomic_load(p, __ATOMIC_RELAXED, __HIP_MEMORY_SCOPE_AGENT); }
__device__ __forceinline__ unsigned xb_add(unsigned* p, unsigned v) { return __hip_atomic_fetch_add(p, v, __ATOMIC_RELAXED, __HIP_MEMORY_SCOPE_AGENT); }
__device__ __forceinline__ unsigned xb_xcc_id() { return (unsigned)__builtin_amdgcn_s_getreg((3 << 11) | 20) & 0xFu; }
#define XB_SPIN(cond, bar) do { unsigned _sp = 0; while (cond) { __builtin_amdgcn_s_sleep(1); \
    if ((++_sp & 255u) == 0u) { if (xb_ld(&(bar)[XB_TMO])) break; if (_sp > XB_SPIN_CAP) { atomicAdd(&(bar)[XB_TMO], 1u); break; } } } } while (0)
struct XcdBarrier { unsigned* bar; unsigned x; volatile LAS unsigned* st; };
__device__ __forceinline__ XcdBarrier xcd_barrier_post(unsigned* bar, volatile LAS unsigned* st) {
    XcdBarrier b; b.bar = bar; b.x = xb_xcc_id(); b.st = st;
    if (threadIdx.x == 0) (void)xb_add(&bar[XB_XCNT(b.x)], 1u);
    return b;
}
__device__ __forceinline__ void xcd_barrier_complete(unsigned* bar, unsigned x, unsigned& nloc, unsigned& nx) {
    const unsigned G = gridDim.x * gridDim.y * gridDim.z;
    unsigned sum, cnt, mine, sp = 0u;
    for (;;) {
        sum = 0u; cnt = 0u; mine = 0u;
#pragma unroll
        for (unsigned j = 0; j < 16; ++j) { const unsigned c = xb_ld(&bar[XB_XCNT(j)]); sum += c; cnt += (c > 0u) ? 1u : 0u; mine = (j == x) ? c : mine; }
        if (sum == G) break;
        __builtin_amdgcn_s_sleep(1);
        if ((++sp & 255u) == 0u) { if (xb_ld(&bar[XB_TMO])) break; if (sp > XB_SPIN_CAP) { atomicAdd(&bar[XB_TMO], 1u); break; } }
    }
    nloc = mine > 0u ? mine : 1u; nx = cnt > 0u ? cnt : 1u;
}
__device__ __forceinline__ void xcd_barrier(const XcdBarrier& b) {
    asm volatile("s_waitcnt vmcnt(0)" ::: "memory");
    __syncthreads();
    if (threadIdx.x == 0) {
        unsigned* bar = b.bar;
        __builtin_amdgcn_s_waitcnt(0);
        unsigned nloc = b.st[0], nx = b.st[1];
        if (nloc == 0u) { xcd_barrier_complete(bar, b.x, nloc, nx); b.st[0] = nloc; b.st[1] = nx; }
        const unsigned old = xb_add(&bar[XB_XSUB(b.x)], 1u);
        const unsigned gen = old / nloc;
        if (old + 1u == (gen + 1u) * nloc) {
            __builtin_amdgcn_fence(__ATOMIC_RELEASE, "agent");
            asm volatile("s_waitcnt vmcnt(0)" ::: "memory");
            const unsigned og = xb_add(&bar[XB_TOP], 1u);
            const unsigned tg = og / nx;
            if (og + 1u == (tg + 1u) * nx) xb_add(&bar[XB_TOPGEN], 1u);
            else XB_SPIN(xb_ld(&bar[XB_TOPGEN]) == tg, bar);
            __builtin_amdgcn_fence(__ATOMIC_ACQUIRE, "agent");
            xb_add(&bar[XB_XGEN(b.x)], 1u);
            asm volatile("s_waitcnt vmcnt(0)" ::: "memory");
        } else {
            XB_SPIN(xb_ld(&bar[XB_XGEN(b.x)]) == gen, bar);
            __builtin_amdgcn_fence(__ATOMIC_ACQUIRE, "agent");
            asm volatile("s_waitcnt vmcnt(0)" ::: "memory");
        }
    }
    __syncthreads();
}

constexpr int RING_BYTES = 131072;
constexpr int MISC_OFF = RING_BYTES;
constexpr int LDS_BYTES = 147456;
constexpr int NWAVES = 8;

struct Args {
    const float* in[29]; float* out; unsigned char* ws; int ph_lo, ph_hi;
};
enum { I_X = 0, I_MEM, I_NORM1, I_WIN, I_BGATE, I_QN, I_KN, I_LQ1, I_LK1, I_LQ2, I_LK2, I_SUBLN, I_WPOOL, I_PSCALE, I_MEMNORM, I_WMKV, I_MQN, I_MKN, I_WBRD, I_WBRP, I_WBRM, I_WOUT, I_NORM2,
       I_WROUTER, I_BROUTER, I_WGU, I_BGU, I_WD, I_BD };

__device__ __forceinline__ unsigned f2bf(float f) { unsigned u = __builtin_bit_cast(unsigned, f); return (u + 0x7fffu + ((u >> 16) & 1u)) >> 16; }
__device__ __forceinline__ unsigned pk2(float lo, float hi) { return f2bf(lo) | (f2bf(hi) << 16); }
__device__ __forceinline__ void p0_transpose_item(const float* W, int K, int N, bf16_t* WT, LAS float* scr, int item, int lane, int ldo = 0) {
    if (ldo == 0) ldo = K;
    const int nblk = N / 64, kb = item / nblk, nb = item % nblk, k0 = 64 * kb, n0 = 64 * nb;
    const int kr = lane >> 3, n4 = (lane & 7) * 4;
    f32x4 v[16];
#pragma unroll
    for (int i = 0; i < 16; ++i) v[i] = *(const f32x4*)(W + (size_t)(k0 + 8 * (i & 7) + kr) * N + n0 + 32 * (i >> 3) + n4);
#pragma unroll
    for (int h = 0; h < 2; ++h) {
#pragma unroll
        for (int i = 0; i < 8; ++i)
#pragma unroll
            for (int j = 0; j < 4; ++j) scr[(n4 + j) * 68 + 8 * i + kr] = v[h * 8 + i][j];
        LDS_WAIT(); asm volatile("" ::: "memory");
        const int c = lane & 7;
#pragma unroll
        for (int jj = 0; jj < 4; ++jj) { const int nrow = 8 * jj + (lane >> 3); const LAS f32x4* sp = (const LAS f32x4*)(scr + nrow * 68 + 8 * c);
            const f32x4 a = sp[0], b = sp[1];
            u32x4 o; o.x = pk2(a[0], a[1]); o.y = pk2(a[2], a[3]); o.z = pk2(b[0], b[1]); o.w = pk2(b[2], b[3]);
            *(u32x4*)(WT + (size_t)(n0 + 32 * h + nrow) * ldo + k0 + 8 * c) = o; }
        LDS_WAIT(); asm volatile("" ::: "memory");
    }
}
__device__ __forceinline__ void p0_transpose_item_f8(const float* W, int K, int N, unsigned char* WT, LAS float* scr, int item, int lane) {
    const int nblk = N / 64, kb = item / nblk, nb = item % nblk, k0 = 64 * kb, n0 = 64 * nb;
    const int kr = lane >> 3, n4 = (lane & 7) * 4;
    f32x4 v[16];
#pragma unroll
    for (int i = 0; i < 16; ++i) v[i] = *(const f32x4*)(W + (size_t)(k0 + 8 * (i & 7) + kr) * N + n0 + 32 * (i >> 3) + n4);
#pragma unroll
    for (int h = 0; h < 2; ++h) {
#pragma unroll
        for (int i = 0; i < 8; ++i)
#pragma unroll
            for (int j = 0; j < 4; ++j) scr[(n4 + j) * 68 + 8 * i + kr] = v[h * 8 + i][j];
        LDS_WAIT(); asm volatile("" ::: "memory");
        const int c = lane & 7;
#pragma unroll
        for (int jj = 0; jj < 4; ++jj) { const int nrow = 8 * jj + (lane >> 3); const LAS f32x4* sp = (const LAS f32x4*)(scr + nrow * 68 + 8 * c);
            const f32x4 a = sp[0] * W8_SCALE, b = sp[1] * W8_SCALE;
            u32x2 o; o.x = pk4_fp8(a[0], a[1], a[2], a[3]); o.y = pk4_fp8(b[0], b[1], b[2], b[3]);
            *(u32x2*)(WT + (size_t)(n0 + 32 * h + nrow) * K + k0 + 8 * c) = o; }
        LDS_WAIT(); asm volatile("" ::: "memory");
    }
}
__device__ __forceinline__ void rms_row_to_bf16(const float* xrow, const float* gain, bf16_t* orow, int lane) {
    const f32x4* xr = (const f32x4*)xrow + lane; const f32x4* gr = (const f32x4*)gain + lane;
    f32x4 v[4]; float s = 0.f;
#pragma unroll
    for (int j = 0; j < 4; ++j) { v[j] = xr[64 * j]; s += (v[j].x * v[j].x + v[j].y * v[j].y) + (v[j].z * v[j].z + v[j].w * v[j].w); }
    const float rstd = 1.f / sqrtf(wave_sum(s) * (1.f / 1024.f) + RMS_EPS);
    u32x2* o8 = (u32x2*)orow + lane;
#pragma unroll
    for (int j = 0; j < 4; ++j) { const f32x4 g = gr[64 * j]; u32x2 w; w.x = pk2(v[j].x * rstd * g.x, v[j].y * rstd * g.y); w.y = pk2(v[j].z * rstd * g.z, v[j].w * rstd * g.w); o8[64 * j] = w; }
}

__device__ __forceinline__ void cvt_item64_f8(const float* W, int K, int N, unsigned char* WT, int item, int lane) {
    const int nblk = N / 64, kb = item / nblk, nb = item % nblk, k0 = 64 * kb, n0 = 64 * nb;
    const char* base = (const char*)(W + (size_t)k0 * N + n0);
    unsigned off = (unsigned)lane * 4u; const unsigned rstep = (unsigned)N * 4u;
    float v[64];
#pragma unroll
    for (int j = 0; j < 64; ++j) { v[j] = __builtin_nontemporal_load((const float*)(base + off)); off += rstep; }
    unsigned char* dst = WT + (size_t)(n0 + lane) * K + k0;
#pragma unroll
    for (int c = 0; c < 4; ++c) { u32x4 o;
#pragma unroll
        for (int q = 0; q < 4; ++q) { int r = __builtin_amdgcn_cvt_pk_fp8_f32(v[16 * c + 4 * q] * W8_SCALE, v[16 * c + 4 * q + 1] * W8_SCALE, 0, false);
            r = __builtin_amdgcn_cvt_pk_fp8_f32(v[16 * c + 4 * q + 2] * W8_SCALE, v[16 * c + 4 * q + 3] * W8_SCALE, r, true); o[q] = (unsigned)r; }
        *(u32x4*)(dst + 16 * c) = o; }
}
struct CvtJob {
    const float* wgu; const float* wd; unsigned char* wgu_t; unsigned char* wd_t; int ngw, gw, lane;
    __device__ __forceinline__ void item(int j) const {
        const int it = gw + j * ngw; if (it >= 24576) return;
        const bool gu = it < 16384; const int r = gu ? it : it - 16384, e = gu ? (r >> 9) : (r >> 8), idx = gu ? (r & 511) : (r & 255), N = gu ? 2048 : 1024;
        const float* W = gu ? wgu + (size_t)e * 1024 * 2048 : wd + (size_t)e * 1024 * 1024; unsigned char* WT = gu ? wgu_t + (size_t)e * 2048 * 1024 : wd_t + (size_t)e * 1024 * 1024;
        cvt_item64_f8(W, 1024, N, WT, idx, lane);
    }
};
struct PostCvt { CvtJob J; int jbase, jend; __device__ __forceinline__ void operator()(int ui) const { const int j = jbase + ui; if (j < jend) J.item(j); } };
struct Args;
typedef __attribute__((address_space(4))) const Args* kargs_t;
__device__ __forceinline__ kargs_t kargs() { kargs_t p = (kargs_t)__builtin_amdgcn_kernarg_segment_ptr(); asm volatile("" : "+s"(p)); return p; }
__global__ void __launch_bounds__(NWAVES * 64, 2) fwd_kernel(Args args) {
    extern __shared__ __attribute__((aligned(16))) unsigned char lds_raw[];
    cg::grid_group grid = cg::this_grid();
    LAS unsigned char* lds = (LAS unsigned char*)lds_raw;
    const int tid = threadIdx.x, lane = tid & 63, wave = __builtin_amdgcn_readfirstlane(tid >> 6);
    const int G = gridDim.x, bx = blockIdx.x; const int vcu = (G % 8 == 0) ? (bx % 8) * (G / 8) + bx / 8 : bx;
    const int gw = vcu * NWAVES + wave, NGW = G * NWAVES;
    const int lo = args.ph_lo, hi = args.ph_hi;
    if (tid < 64) ((LAS unsigned*)(lds + MISC_OFF + 1024))[tid] = 0u;
    __syncthreads();
    const XcdBarrier xbar = xcd_barrier_post((unsigned*)(args.ws + WS_CTL) + CW_BAR, (volatile LAS unsigned*)(lds + MISC_OFF + 1024));
#ifndef PHMASK
#define PHMASK 0x3ff
#endif
#define IN(k) (((PHMASK >> (k)) & 1) && lo <= (k) && (k) < hi)
#define GSYNC() do { asm volatile("s_waitcnt vmcnt(0) lgkmcnt(0)" ::: "memory"); __syncthreads(); grid.sync(); asm volatile("s_waitcnt vmcnt(0)" ::: "memory"); __syncthreads(); } while (0)
#define SEAM(k) do { if (lo <= (k) && (k) + 1 < hi) { xcd_barrier(xbar); } } while (0)
#define WSP(TY, off) ((TY*)(ka->ws + (off)))
#define WIN_T WSP(bf16_t, WS_WIN_T)
#define WBRD_T WSP(bf16_t, WS_WBRD_T)
#define WBRP_T WSP(bf16_t, WS_WBRP_T)
#define WBRM_T WSP(bf16_t, WS_WBRM_T)
#define WOUT_T WSP(bf16_t, WS_WOUT_T)
#define WMKV_T WSP(bf16_t, WS_WMKV_T)
#define WGU_T WSP(bf16_t, WS_WGU_T)
#define WD_T WSP(bf16_t, WS_WD_T)
#define XN WSP(bf16_t, WS_XN)
#define Qb WSP(bf16_t, WS_Q)
#define Kb WSP(bf16_t, WS_K)
#define Vb WSP(bf16_t, WS_V)
#define Ub WSP(bf16_t, WS_U)
#define MQb WSP(bf16_t, WS_MQ)
#define OC WSP(bf16_t, WS_OC)
#define GATES WSP(bf16_t, WS_GATES)
#define YCAT WSP(bf16_t, WS_YCAT)
#define MERGF WSP(float, WS_MERGF)
#define MERGB WSP(bf16_t, WS_MERGB)
#define XG WSP(bf16_t, WS_XG)
#define ACT WSP(bf16_t, WS_A)
#define Y4 WSP(bf16_t, WS_B)
#define MEMN WSP(bf16_t, WS_MEMN)
#define MKV WSP(bf16_t, WS_MKV)
#define ROPE WSP(f32x2, WS_ROPE)
#define WR2 WSP(float, WS_WR2)
#define ROUTEW WSP(float, WS_ROUTEW)
#define LAMP WSP(float, WS_LAM)
#define LIST WSP(u32x2, WS_LIST)
#define CNT WSP(unsigned, WS_CTL)
#define OUT (ka->out)
#define KA const kargs_t ka = kargs()

    if (lo > 1000) GSYNC();
    if (IN(0)) for (int rep_ = 0; rep_ < 1 + ((REPEAT_MASK >> 0) & 1); ++rep_) { KA; if (rep_) __syncthreads();
        LAS float* scr = (LAS float*)(lds + wave * 16384);
        constexpr int I0 = 16 * 80, I1 = 8 * 16, I2 = 4 * 16, I3 = 4 * 16, I4 = 16 * 16, I5 = 16 * 8, I6 = 0, I7 = 0;
        constexpr int NITEMS = I0 + I1 + I2 + I3 + I4 + I5 + I6 + I7;
        for (int it = gw; it < NITEMS; it += NGW) {
            int r = it;
            if (r < I0) { p0_transpose_item(ka->in[I_WIN], 1024, 5120, WIN_T, scr, r, lane); continue; } r -= I0;
            if (r < I1) { p0_transpose_item(ka->in[I_WBRD], 512, 1024, WBRD_T, scr, r, lane, 1024); continue; } r -= I1;
            if (r < I2) { p0_transpose_item(ka->in[I_WBRP], 256, 1024, WBRD_T + 512, scr, r, lane, 1024); continue; } r -= I2;
            if (r < I3) { p0_transpose_item(ka->in[I_WBRM], 256, 1024, WBRD_T + 768, scr, r, lane, 1024); continue; } r -= I3;
            if (r < I4) { p0_transpose_item(ka->in[I_WOUT], 1024, 1024, WOUT_T, scr, r, lane); continue; } r -= I4;
            p0_transpose_item(ka->in[I_WMKV], 1024, 512, WMKV_T, scr, r, lane);
        }
        for (int m = gw; m < T; m += NGW) rms_row_to_bf16(ka->in[I_X] + (size_t)m * 1024, ka->in[I_NORM1], XN + (size_t)m * 1024, lane);
        for (int m = gw; m < BATCH * MEMLEN; m += NGW) rms_row_to_bf16(ka->in[I_MEM] + (size_t)m * 1024, ka->in[I_MEMNORM], MEMN + (size_t)m * 1024, lane);
        for (int i = bx * 512 + tid; i < SEQ * 32; i += G * 512) { const int pos = i >> 5, j = i & 31;
            const float inv = 1.0f / powf(10000.0f, (float)(2 * j) / 64.0f); const float ang = (float)pos * inv;
            const double a = (double)ang; const double k = rint(a * 0.15915494309189535); const float red = (float)(a - k * 6.283185307179586);
            ROPE[i] = (f32x2){cosf(red), sinf(red)}; }
        for (int i = bx * 512 + tid; i < 1024 * 32; i += G * 512) { const int ii = i & 3, e = (i >> 2) & 15, kq = (i >> 6) & 3, eb = (i >> 8) & 1, s = i >> 9; const int k = 16 * s + 4 * kq + ii;
            WR2[i] = ka->in[I_NORM2][k] * ka->in[I_WROUTER][k * 32 + eb * 16 + e]; }
        if (bx == 0 && wave == 0) { const float s1 = wave_sum(ka->in[I_LQ1][lane] * ka->in[I_LK1][lane]), s2 = wave_sum(ka->in[I_LQ2][lane] * ka->in[I_LK2][lane]);
            if (lane == 0) LAMP[0] = expf(s1) - expf(s2) + 0.2f; }
    }
    SEAM(0);
    if (IN(1)) for (int rep_ = 0; rep_ < 1 + ((REPEAT_MASK >> 1) & 1); ++rep_) { KA; if (rep_) __syncthreads();
#if defined(TAP) && TAP == 6
        { pg8::DenseProb P{XN, WIN_T, 1024, 1024, 1024}; pg8::StaticOrder S; S.init(T, INW, G, bx);
          pg8::EpiPlain E{WSP(bf16_t, WS_B), 5120};
          pg8::gemm_phase<pg8::EpiPlain, pg8::DenseProb, pg8::StaticOrder, true>(lds, P, S, E); }
#else
        const CvtJob J{ka->in[I_WGU], ka->in[I_WD], (unsigned char*)WGU_T, (unsigned char*)WD_T, NGW, gw, lane};
        const int kpre = bx & 7;
        for (int j = 0; j < kpre; ++j) J.item(j);
        { pg8::DenseProb P{XN, WIN_T, 1024, 1024, 1024}; pg8::StaticOrder S0; S0.init(T, INW, G, bx); const pg8::TableOrder S = pg8::build_unit_table(S0, (LAS int*)(lds + MISC_OFF + 2048));
          pg8::EpiInProj E{Qb, Kb, Vb, Ub, MQb, GATES, ka->in[I_QN], ka->in[I_KN], ka->in[I_MQN], ka->in[I_BGATE], ROPE};
          const PostCvt PU{J, kpre, 12};
          pg8::gemm_phase<pg8::EpiInProj, pg8::DenseProb, pg8::TableOrder, ALIGN_EPI_SEL, PostCvt>(lds, P, S, E, PU); }
        for (int j = kpre + 10; j < 12; ++j) J.item(j);
#endif
        { pg8::DenseProb P{MEMN, WMKV_T, 1024, 1024, 1024}; pg8::StaticOrder S; S.init(BATCH * MEMLEN, 512, G, bx);
          pg8::EpiMemKV E{MKV, ka->in[I_MKN]};
          pg8::gemm_phase<pg8::EpiMemKV, pg8::DenseProb, pg8::StaticOrder, true>(lds, P, S, E); }
    }
    SEAM(1);
    if (IN(2)) for (int rep_ = 0; rep_ < 1 + ((REPEAT_MASK >> 2) & 1); ++rep_) { KA; if (rep_) __syncthreads();
        using abf = attn_body::bf16;
        {
            const int bh = vcu >> 4, b = bh >> 2, h = bh & 3, s = vcu & 15; const size_t rb = (size_t)b * SEQ;
            const float lam = LAMP[0];
            for (int i2 = 0; i2 < 4 * (1 + ((REPEAT_MASK >> 10) & 1)); ++i2) { const int ii = i2 & 3, c = ii & 1; const int qb = (ii < 2) ? s : 31 - s;
                attn_body::attn_unit2<true>(qb * 256, 4 * qb + 4, (const abf*)Qb + rb * 512 + (c * 4 + h) * 64, 512, (const abf*)Kb + rb * 512 + (c * 4 + h) * 64, 512,
                                            (const abf*)Vb + rb * 512 + h * 128, 512, (abf*)OC + rb * 1024 + (c * 4 + h) * 128, 1024, (char*)lds_raw);
                if (c == 1) {
                    asm volatile("s_waitcnt vmcnt(0)" ::: "memory");
#pragma unroll 1
                    for (int ps = 0; ps < 2; ++ps) {
                    const int row = ps * 16 + (lane >> 2), dq = (lane & 3) * 32; const size_t t = rb + (size_t)qb * 256 + wave * 32 + row;
                    const bf16_t* p0 = OC + t * 1024 + h * 128 + dq; const bf16_t* p1 = p0 + 512;
                    u32x4 a[4], bb[4];
#pragma unroll
                    for (int j = 0; j < 4; ++j) { a[j] = *(const u32x4*)(p0 + 8 * j); bb[j] = *(const u32x4*)(p1 + 8 * j); }
                    float ss = 0.f; f32x4 y[4][2];
#pragma unroll
                    for (int j = 0; j < 4; ++j) {
                        y[j][0] = (f32x4){bf_lo(a[j].x) - lam * bf_lo(bb[j].x), bf_hi(a[j].x) - lam * bf_hi(bb[j].x), bf_lo(a[j].y) - lam * bf_lo(bb[j].y), bf_hi(a[j].y) - lam * bf_hi(bb[j].y)};
                        y[j][1] = (f32x4){bf_lo(a[j].z) - lam * bf_lo(bb[j].z), bf_hi(a[j].z) - lam * bf_hi(bb[j].z), bf_lo(a[j].w) - lam * bf_lo(bb[j].w), bf_hi(a[j].w) - lam * bf_hi(bb[j].w)};
#pragma unroll
                        for (int q = 0; q < 4; ++q) ss += y[j][0][q] * y[j][0][q] + y[j][1][q] * y[j][1][q]; }
                    ss += __shfl_xor(ss, 1); ss += __shfl_xor(ss, 2);
                    const float rstd = 0.8f / sqrtf(ss * (1.0f / 128.0f) + RMS_EPS);
                    const float* sg = ka->in[I_SUBLN] + dq; bf16_t* yo = YCAT + t * 1024 + h * 128 + dq;
#pragma unroll
                    for (int j = 0; j < 4; ++j) { const f32x4 s0 = *(const f32x4*)(sg + 8 * j), s1 = *(const f32x4*)(sg + 8 * j + 4); pg8::store8(yo + 8 * j, y[j][0] * rstd * s0, y[j][1] * rstd * s1); }
                    }
                }
            }
        }
        {
            for (int i = 0; i < 2; ++i) { const int idx = vcu * 2 + i; if (idx >= 512) break; const int b = idx >> 7, h = (idx >> 5) & 3, qb = idx & 31;
                attn_body::attn_unit<8, false>(qb * 256, 4, (const abf*)MQb + (size_t)b * SEQ * 256 + h * 64, 256, (const abf*)MKV + (size_t)b * MEMLEN * 512 + h * 64, 512,
                                               (const abf*)MKV + (size_t)b * MEMLEN * 512 + 256 + h * 64, 512, (abf*)YCAT + (size_t)b * SEQ * 1024 + 768 + h * 64, 1024, (char*)lds_raw); }
        }
        {
            LAS bf16_t* ul = (LAS bf16_t*)lds;
            LAS bf16_t* pb = (LAS bf16_t*)(lds + 24576);
            const int col = tid & 255, half = tid >> 8, w = 2 << (col >> 6);
            const int mg = wave & 3, mdh = wave >> 2, r32 = lane & 31, hh = lane >> 5;
            bf16x8 bw[4];
#pragma unroll
            for (int sx = 0; sx < 4; ++sx) { const float* wp = ka->in[I_WPOOL] + (size_t)(mg * 64 + 16 * sx + 8 * hh) * 64 + mdh * 32 + r32;
                u32x4 pk; pk.x = pk2(wp[0], wp[64]); pk.y = pk2(wp[128], wp[192]); pk.z = pk2(wp[256], wp[320]); pk.w = pk2(wp[384], wp[448]); bw[sx] = __builtin_bit_cast(bf16x8, pk); }
            const int ocol = mg * 64 + mdh * 32 + r32; const float psc = ka->in[I_PSCALE][ocol];
            for (int tile = vcu; tile < T / 32; tile += G) {
                const int t0 = tile * 32, p0 = t0 & (SEQ - 1);
                __syncthreads();
                for (int pc = tid; pc < 47 * 32; pc += 512) { const int r = pc >> 5, ch = pc & 31; const int pos = p0 - 15 + r;
                    u32x4 v = {0u, 0u, 0u, 0u}; if (pos >= 0) v = *(const u32x4*)(Ub + (size_t)(t0 - 15 + r) * 256 + ch * 8);
                    *(LAS u32x4*)(ul + r * 256 + ch * 8) = v; }
                __syncthreads();
                {
                    float sum = 0.f; const int rbase = 15 + 16 * half;
                    for (int i = 1; i < w; ++i) sum += __uint_as_float((unsigned)ul[(rbase - i) * 256 + col] << 16);
#pragma unroll
                    for (int tk = 0; tk < 16; ++tk) { const float ucur = __uint_as_float((unsigned)ul[(rbase + tk) * 256 + col] << 16); sum += ucur;
                        const int pos = p0 + 16 * half + tk; const float cnt = (float)((pos + 1 < w) ? pos + 1 : w);
                        pb[(16 * half + tk) * 264 + col] = (bf16_t)f2bf(sum / cnt - ucur);
                        sum -= __uint_as_float((unsigned)ul[(rbase + tk - (w - 1)) * 256 + col] << 16); }
                }
                __syncthreads();
                f32x16 acc = f32x16{};
#pragma unroll
                for (int sx = 0; sx < 4; ++sx) { const bf16x8 af = *(const LAS bf16x8*)(pb + r32 * 264 + mg * 64 + 16 * sx + 8 * hh);
                    acc = __builtin_amdgcn_mfma_f32_32x32x16_bf16(af, bw[sx], acc, 0, 0, 0); }
#pragma unroll
                for (int r = 0; r < 16; ++r) { const int tok = t0 + (r & 3) + 8 * (r >> 2) + 4 * hh; YCAT[(size_t)tok * 1024 + 512 + ocol] = (bf16_t)f2bf(acc[r] * psc); }
            }
            __syncthreads();
        }
    }
    SEAM(2);
    if (IN(4)) for (int rep_ = 0; rep_ < 1 + ((REPEAT_MASK >> 4) & 1); ++rep_) { KA; if (rep_) __syncthreads();
        pg8::StaticOrder S0; S0.init(T, 1024, G, bx); const pg8::TableOrder S = pg8::build_unit_table(S0, (LAS int*)(lds + MISC_OFF + 2048));
        pg8::DenseProb P{YCAT, WBRD_T, 1024, 1024, 1024}; pg8::EpiMergeR E{GATES, MERGB};
        pg8::gemm_phase<pg8::EpiMergeR, pg8::DenseProb, pg8::TableOrder, ALIGN_EPI_SEL>(lds, P, S, E);
    }
    SEAM(4);
    if (IN(5)) for (int rep_ = 0; rep_ < 1 + ((REPEAT_MASK >> 5) & 1); ++rep_) { KA; if (rep_) __syncthreads();
        pg8::DenseProb P{MERGB, WOUT_T, 1024, 1024, 1024}; pg8::StaticOrder S0; S0.init(T, 1024, G, bx); const pg8::TableOrder S = pg8::build_unit_table(S0, (LAS int*)(lds + MISC_OFF + 2048));
        pg8::EpiWout E{ka->in[I_X], OUT, (unsigned char*)XG, ka->in[I_NORM2]};
        pg8::gemm_phase<pg8::EpiWout, pg8::DenseProb, pg8::TableOrder, ALIGN_EPI_SEL>(lds, P, S, E);
    }
    SEAM(5);
    if (IN(6)) { KA;
        LAS int* lcnt = (LAS int*)(lds + MISC_OFF); LAS int* lbase = lcnt + 32;
        const int ngroups = T / 16, rounds = (ngroups + NGW - 1) / NGW;
        for (int rd = 0; rd < rounds; ++rd) {
            const int grp = rd * NGW + gw; const bool valid = grp < ngroups;
            if (tid < 32) lcnt[tid] = 0;
            __syncthreads();
            int e_sel = 0, rank = 0; float w_sel = 0.f, rstd = 0.f; const int q = lane >> 4, tok = grp * 16 + (lane & 15);
            if (valid) {
                f32x4 d0 = {0.f, 0.f, 0.f, 0.f}, d1 = {0.f, 0.f, 0.f, 0.f}; float ss = 0.f;
                const float* xrow = OUT + (size_t)tok * 1024 + 4 * q; const f32x4* wr2 = (const f32x4*)WR2 + lane;
#pragma unroll 4
                for (int s = 0; s < 64; ++s) { const f32x4 xv = *(const f32x4*)(xrow + 16 * s); const f32x4 wa = wr2[(s * 2) * 64], wb = wr2[(s * 2 + 1) * 64];
                    ss += (xv[0] * xv[0] + xv[1] * xv[1]) + (xv[2] * xv[2] + xv[3] * xv[3]);
#pragma unroll
                    for (int j = 0; j < 4; ++j) { d0 = __builtin_amdgcn_mfma_f32_16x16x4f32(wa[j], xv[j], d0, 0, 0, 0); d1 = __builtin_amdgcn_mfma_f32_16x16x4f32(wb[j], xv[j], d1, 0, 0, 0); } }
                ss += __shfl_xor(ss, 16); ss += __shfl_xor(ss, 32);
                rstd = 1.0f / sqrtf(ss * (1.0f / 1024.f) + RMS_EPS);
                unsigned key[8];
#pragma unroll
                for (int r = 0; r < 8; ++r) { const int e = (r >> 2) * 16 + 4 * q + (r & 3); const float lg = ((r < 4) ? d0[r & 3] : d1[r & 3]) * rstd + ka->in[I_BROUTER][e];
                    unsigned u = __float_as_uint(lg); u ^= (u >> 31) ? 0xffffffffu : 0x80000000u; key[r] = (u & ~31u) | (unsigned)(31 - e); }
                unsigned win[4];
#pragma unroll
                for (int r = 0; r < 4; ++r) { unsigned m = key[0];
#pragma unroll
                    for (int j = 1; j < 8; ++j) m = m > key[j] ? m : key[j];
                    unsigned o = (unsigned)__shfl_xor((int)m, 16); m = m > o ? m : o; o = (unsigned)__shfl_xor((int)m, 32); m = m > o ? m : o; win[r] = m;
#pragma unroll
                    for (int j = 0; j < 8; ++j) key[j] = (key[j] == m) ? 0u : key[j]; }
                float val[4];
#pragma unroll
                for (int r = 0; r < 4; ++r) { unsigned u = win[r] & ~31u; u ^= (u >> 31) ? 0x80000000u : 0xffffffffu; val[r] = __uint_as_float(u); }
                const float p1 = expf(val[1] - val[0]), p2 = expf(val[2] - val[0]), p3 = expf(val[3] - val[0]); const float inv = 1.0f / (1.0f + p1 + p2 + p3);
                const unsigned wk = (q == 0) ? win[0] : (q == 1) ? win[1] : (q == 2) ? win[2] : win[3];
                w_sel = ((q == 0) ? 1.0f : (q == 1) ? p1 : (q == 2) ? p2 : p3) * inv; e_sel = 31 - (int)(wk & 31u);
                rank = __hip_atomic_fetch_add((int*)(lcnt + e_sel), 1, __ATOMIC_RELAXED, __HIP_MEMORY_SCOPE_WORKGROUP);
            }
            __syncthreads();
            if (tid < 32) lbase[tid] = (int)__hip_atomic_fetch_add(CNT + 64 * tid, (unsigned)lcnt[tid], __ATOMIC_RELAXED, __HIP_MEMORY_SCOPE_AGENT);
            __syncthreads();
            if (valid) { const int pos = lbase[e_sel] + rank; LIST[(size_t)e_sel * CAP + pos] = (u32x2){(unsigned)(tok * 4 + q), __float_as_uint(rstd)}; ROUTEW[tok * 4 + q] = w_sel; }
            __syncthreads();
        }
    }
    SEAM(6);
    if (IN(7) || IN(8)) { KA;
        LAS int* tp = (LAS int*)(lds + MISC_OFF + 256); LAS int* cn = tp + 40;
        if (tid == 0) { int acc = 0; for (int e = 0; e < NEXP; ++e) { const int c = (int)__hip_atomic_load(CNT + 64 * e, __ATOMIC_RELAXED, __HIP_MEMORY_SCOPE_AGENT); cn[e] = c; tp[e] = acc; acc += (c + 255) >> 8; } tp[NEXP] = acc; }
        __syncthreads();
        if (IN(7)) for (int rep_ = 0; rep_ < 1 + ((REPEAT_MASK >> 7) & 1); ++rep_) {
            pg8::GuProb P{(const unsigned char*)XG, (const unsigned char*)WGU_T, LIST, 1024, 1024, 1024}; pg8::GroupedOrder S0{tp, cn, 8, G, bx}; const pg8::TableOrder S = pg8::build_unit_table(S0, (LAS int*)(lds + MISC_OFF + 2048));
            pg8::EpiSwiglu E{(unsigned char*)ACT, LIST, ka->in[I_BGU]};
            pg8::gemm_phase<pg8::EpiSwiglu, pg8::GuProb, pg8::TableOrder, ALIGN_EPI_SEL>(lds, P, S, E);
        }
        SEAM(7);
        if (IN(8)) for (int rep_ = 0; rep_ < 1 + ((REPEAT_MASK >> 8) & 1); ++rep_) {
            pg8::DownProb P{(const unsigned char*)ACT, (const unsigned char*)WD_T, 1024, 1024, 1024}; pg8::GroupedOrder S0{tp, cn, 4, G, bx}; const pg8::TableOrder S = pg8::build_unit_table(S0, (LAS int*)(lds + MISC_OFF + 2048));
            pg8::EpiDown E{Y4, LIST, ka->in[I_BD]};
            pg8::gemm_phase<pg8::EpiDown, pg8::DownProb, pg8::TableOrder, ALIGN_EPI_SEL>(lds, P, S, E);
        }
    }
    SEAM(8);
    if (IN(9)) { KA;
        for (int i = bx * 512 + tid; i < T * 128; i += G * 512) { const int tok = i >> 7, c8 = (i & 127) * 8;
            const f32x4 w = *(const f32x4*)(ROUTEW + tok * 4); float* op = OUT + (size_t)tok * 1024 + c8;
            f32x4 o0 = *(const f32x4*)op, o1 = *(const f32x4*)(op + 4);
#pragma unroll
            for (int k = 0; k < 4; ++k) { const u32x4 y = *(const u32x4*)(Y4 + ((size_t)tok * 4 + k) * 1024 + c8); const float wk = w[k];
                o0[0] += wk * bf_lo(y.x); o0[1] += wk * bf_hi(y.x); o0[2] += wk * bf_lo(y.y); o0[3] += wk * bf_hi(y.y);
                o1[0] += wk * bf_lo(y.z); o1[1] += wk * bf_hi(y.z); o1[2] += wk * bf_lo(y.w); o1[3] += wk * bf_hi(y.w); }
            *(f32x4*)op = o0; *(f32x4*)(op + 4) = o1; }
    }
#ifdef TAP
    if (lo <= 10 && 10 < hi) { KA; GSYNC();
        for (int i = bx * 512 + tid; i < T * 1024; i += G * 512) { const int t = i >> 10, c = i & 1023; float v = 0.f;
#define BFV(buf, pitch, col) __uint_as_float((unsigned)(buf)[(size_t)t * (pitch) + (col)] << 16)
            if (TAP == 1) v = BFV(Qb, 512, c & 511) + 2.f * BFV(Kb, 512, c & 511) + 4.f * BFV(Vb, 512, c & 511) + 8.f * BFV(Ub, 256, c & 255) + 16.f * BFV(MQb, 256, c & 255)
                            + 32.f * BFV(GATES, 3072, c) + 64.f * BFV(GATES, 3072, 1024 + c) + 128.f * BFV(GATES, 3072, 2048 + c);
            if (TAP == 2) v = BFV(OC, 1024, c) + 2.f * BFV(YCAT, 1024, c);
            if (TAP == 3) v = BFV(MERGB, 1024, c);
            if (TAP == 4) v = BFV(XN, 1024, c);
            if (TAP == 6) { const bf16_t* z = WSP(bf16_t, WS_B) + (size_t)t * 5120 + c; v = __uint_as_float((unsigned)z[0] << 16) + 2.f * __uint_as_float((unsigned)z[1024] << 16) + 4.f * __uint_as_float((unsigned)z[2048] << 16) + 8.f * __uint_as_float((unsigned)z[3072] << 16) + 16.f * __uint_as_float((unsigned)z[4096] << 16); }
            if (TAP == 5) { const bf16_t* wt = WIN_T; const int tt = t % 5120; v = __uint_as_float((unsigned)wt[(size_t)tt * 1024 + c] << 16) + ROPE[(t & 8191) * 32 + (c & 31)].x + 2.f * ROPE[(t & 8191) * 32 + (c & 31)].y; }
            OUT[i] = v; }
    }
#endif
#undef IN
#undef SEAM
}

extern "C" void kernel_launch(void* const* d_in, const int* in_sizes, int n_in, void* d_out, int out_size, void* d_ws, size_t ws_size, hipStream_t stream) {
    static int grid = 0;
    if (grid == 0) {
        if (n_in != 29 || in_sizes[0] != T * DMODEL || out_size != T * DMODEL || ws_size < WS_END) {
            fprintf(stderr, "kernel_launch: unexpected shapes: n_in %d in0 %d out %d ws %zu (need %zu)\n", n_in, n_in > 0 ? in_sizes[0] : -1, out_size, ws_size, (size_t)WS_END); grid = -1; return; }
        int dev = 0, cus = 0, per_cu = 0;
        (void)hipGetDevice(&dev); (void)hipDeviceGetAttribute(&cus, hipDeviceAttributeMultiprocessorCount, dev);
        (void)hipFuncSetAttribute((const void*)fwd_kernel, hipFuncAttributeMaxDynamicSharedMemorySize, LDS_BYTES);
        (void)hipOccupancyMaxActiveBlocksPerMultiprocessor(&per_cu, (const void*)fwd_kernel, NWAVES * 64, LDS_BYTES);
        (void)hipGetLastError();
        grid = cus;
        fprintf(stderr, "kernel_launch: cus %d occupancy %d/CU grid %d\n", cus, per_cu, grid);
        if (per_cu < 1) fprintf(stderr, "kernel_launch: occupancy query says the kernel does not fit\n");
    }
    if (grid < 0) return;
    (void)hipMemsetAsync((char*)d_ws + WS_CTL, 0, CTL_ZERO_BYTES, stream);
    Args a{};
    for (int i = 0; i < 29; ++i) a.in[i] = (const float*)d_in[i];
    a.out = (float*)d_out; a.ws = (unsigned char*)d_ws; a.ph_lo = 0; a.ph_hi = PH_HI;
    void* args[] = {&a};
    hipError_t e = hipLaunchCooperativeKernel((const void*)fwd_kernel, dim3(grid), dim3(NWAVES * 64), args, LDS_BYTES, stream);
    if (e != hipSuccess) fprintf(stderr, "cooperative launch failed: %s (grid %d)\n", hipGetErrorString(e), grid);
}
```

```cpp
#include <hip/hip_runtime.h>
#include <hip/hip_cooperative_groups.h>
#include <hip/hip_bf16.h>
#include <cstdio>
#include <cstdint>
#include <cmath>
namespace cg = cooperative_groups;

#define LAS __attribute__((address_space(3)))
#define GAS __attribute__((address_space(1)))
typedef unsigned short bf16_t;
typedef short bf16x8 __attribute__((ext_vector_type(8)));
typedef float f32x4 __attribute__((ext_vector_type(4)));
typedef float f32x2 __attribute__((ext_vector_type(2)));
typedef float f32x16 __attribute__((ext_vector_type(16)));
typedef unsigned u32x4 __attribute__((ext_vector_type(4)));
typedef unsigned u32x2 __attribute__((ext_vector_type(2)));

#define PH_HI 10
#define ALIGN_EPI_SEL true
#define F8MODE 2
#define USE_SETPRIO 1
#define ATTN_PRIO_A 1
#define ATTN_PRIO_B 1
#ifndef PHMASK
#define PHMASK 0x3ff
#endif
#define REPEAT_MASK 0x000
constexpr int BATCH = 4, SEQ = 8192, DMODEL = 1024, T = BATCH * SEQ, INW = 5120, NEXP = 32, MEMLEN = 256;
constexpr float RMS_EPS = 1e-6f;
constexpr float C2 = 0.125f * 1.4426950408889634f;
constexpr int CAP = T;

constexpr size_t MiB = 1u << 20;
constexpr size_t WS_CTL = 0, CTL_ZERO_BYTES = 32768;
constexpr int CW_BAR = 4096;
constexpr size_t WS_ROUTEW = 1 * MiB;
constexpr size_t WS_LAM = 1 * MiB + 768 * 1024;
constexpr size_t WS_ROPE = 2 * MiB;
constexpr size_t WS_WR2 = 4 * MiB;
constexpr size_t WS_MEMN = 5 * MiB;
constexpr size_t WS_MKV = 7 * MiB;
constexpr size_t WS_WIN_T = 8 * MiB;
constexpr size_t WS_WBRD_T = 18 * MiB;
constexpr size_t WS_WBRP_T = 19 * MiB;
constexpr size_t WS_WBRM_T = 19 * MiB + 512 * 1024;
constexpr size_t WS_WOUT_T = 20 * MiB;
constexpr size_t WS_WMKV_T = 22 * MiB;
constexpr size_t WS_WGU_T = 24 * MiB;
constexpr size_t WS_WD_T = 152 * MiB;
constexpr size_t WS_A = 216 * MiB;
constexpr size_t WS_XN = WS_A;
constexpr size_t WS_Q = WS_A + 64 * MiB, WS_K = WS_A + 96 * MiB, WS_V = WS_A + 128 * MiB;
constexpr size_t WS_U = WS_A + 160 * MiB, WS_MQ = WS_A + 176 * MiB;
constexpr size_t WS_OC = WS_A + 192 * MiB;
constexpr size_t WS_B = 488 * MiB;
constexpr size_t WS_GATES = WS_B;
constexpr size_t WS_YCAT = WS_B + 192 * MiB;
constexpr size_t WS_MERGF = 760 * MiB;
constexpr size_t WS_MERGB = 888 * MiB;
constexpr size_t WS_XG = 952 * MiB;
constexpr size_t WS_LIST = 1016 * MiB;
constexpr size_t WS_END = 1024 * MiB;

typedef __bf16 bf16x2_v __attribute__((ext_vector_type(2)));
__device__ __forceinline__ unsigned cvt_pk_bf16(float lo, float hi) { f32x2 v = {lo, hi}; bf16x2_v b = __builtin_convertvector(v, bf16x2_v); return __builtin_bit_cast(unsigned, b); }
__device__ __forceinline__ unsigned pk4_fp8(float a, float b, float c, float d) {
    a = fminf(fmaxf(a, -448.f), 448.f); b = fminf(fmaxf(b, -448.f), 448.f); c = fminf(fmaxf(c, -448.f), 448.f); d = fminf(fmaxf(d, -448.f), 448.f);
    int r = __builtin_amdgcn_cvt_pk_fp8_f32(a, b, 0, false); r = __builtin_amdgcn_cvt_pk_fp8_f32(c, d, r, true); return (unsigned)r; }
constexpr float W8_SCALE = 64.0f;
constexpr float Y8_SCALE = 32.0f;
constexpr float A8_SCALE = 8.0f;
__device__ __forceinline__ float bf_lo(unsigned w) { return __uint_as_float(w << 16); }
__device__ __forceinline__ float bf_hi(unsigned w) { return __uint_as_float(w & 0xffff0000u); }
__device__ __forceinline__ float wave_sum(float v) {
#pragma unroll
    for (int o = 1; o < 64; o <<= 1) v += __shfl_xor(v, o);
    return v;
}
#define LDS_WAIT() asm volatile("s_waitcnt lgkmcnt(0)" ::: "memory")

namespace pg8 {
constexpr int BM = 256, BK = 64, HALF = 128, HTB = HALF * BK * 2, STAGE_BYTES = 8 * HTB, NXCD = 8, WGM = 8;
__host__ __device__ __forceinline__ int lds_byte(int r, int c) { const int st = (r >> 4) * 2 + (c >> 5), rr = r & 15, cc = c & 31, ob = rr * 64 + cc * 2; return st * 1024 + (ob ^ (((ob >> 9) & 1) << 5)); }
__host__ __device__ __forceinline__ void stage_rc(int b, int& R, int& C) { const int st = b / 1024, sb = b % 1024, swz = sb ^ (((sb >> 9) & 1) << 5); R = (st >> 1) * 16 + swz / 64; C = (st & 1) * 32 + (swz % 64) / 2; }
__host__ __device__ __forceinline__ int perm32(int rho) { const int n = rho >> 4, i = rho & 15; return 8 * (i >> 2) + 4 * n + (i & 3); }

typedef int i32x4_t __attribute__((ext_vector_type(4)));
typedef int i32x8_t __attribute__((ext_vector_type(8)));
typedef long i64x2_t __attribute__((ext_vector_type(2)));
struct Unit { int pm, pn, e, mt, cnt; };

template <int BMAP> __device__ __forceinline__ int brow(int R) { return BMAP == 0 ? ((R >> 5) * 64 + perm32(R & 31)) : ((R & ~31) + perm32(R & 31)); }

struct StaticOrder {
    int nM, nN, nwg, G, c;
    __device__ void init(int M, int N, int G_, int c_) { nM = M / BM; nN = N / BM; nwg = nM * nN; G = G_; c = c_; }
    __device__ bool next(int i, Unit& u) const {
        const long L = (long)i * G + c; if (L >= nwg) return false;
        int wgid = (int)L; { const int q = nwg / NXCD, r = nwg % NXCD, xcd = wgid % NXCD, off = wgid / NXCD; wgid = (xcd < r ? xcd * (q + 1) : r * (q + 1) + (xcd - r) * q) + off; }
        const int nig = WGM * nN, gid = wgid / nig, fm = gid * WGM, gsz = (nM - fm) < WGM ? (nM - fm) : WGM;
        u.pm = fm + ((wgid % nig) % gsz); u.pn = (wgid % nig) / gsz; u.e = 0; u.mt = 0; u.cnt = 0; return true;
    }
    __device__ bool next_lane(int i, Unit& u) const { return next(i, u); }
};
struct GroupedOrder {
    const LAS int* tp; const LAS int* cn; int NTN, G, c;
    __device__ bool next_lane(int i, Unit& u) const {
        const int nwg = tp[NEXP] * NTN; const long L = (long)i * G + c; if (L >= nwg) return false;
        int wgid = (int)L; { const int q = nwg / NXCD, r = nwg % NXCD, xcd = wgid % NXCD, off = wgid / NXCD; wgid = (xcd < r ? xcd * (q + 1) : r * (q + 1) + (xcd - r) * q) + off; }
        int e = 0; while (e < NEXP - 1 && wgid >= tp[e + 1] * NTN) ++e;
        const int idx = wgid - tp[e] * NTN, tiles = tp[e + 1] - tp[e];
        const int nig = 4 * NTN, gid = idx / nig, fm = gid * 4, gsz = (tiles - fm) < 4 ? (tiles - fm) : 4;
        u.mt = fm + ((idx % nig) % gsz); u.pn = (idx % nig) / gsz; u.e = e; u.pm = tp[e] + u.mt; u.cnt = cn[e]; return true;
    }
};
struct TableOrder {
    const LAS int* tab; int n;
    __device__ __forceinline__ bool next(int i, Unit& u) const {
        if (i >= n) return false;
        const LAS int* t = tab + i * 8;
        u.pm = __builtin_amdgcn_readfirstlane(t[0]); u.pn = __builtin_amdgcn_readfirstlane(t[1]); u.e = __builtin_amdgcn_readfirstlane(t[2]);
        u.mt = __builtin_amdgcn_readfirstlane(t[3]); u.cnt = __builtin_amdgcn_readfirstlane(t[4]); return true;
    }
};
template <class Sched> __device__ __forceinline__ TableOrder build_unit_table(const Sched& S, LAS int* tab) {
    __syncthreads();
    if (threadIdx.x < 32) { Unit u; const bool ok = S.next_lane((int)threadIdx.x, u);
        if (ok) { LAS int* t = tab + threadIdx.x * 8; t[0] = u.pm; t[1] = u.pn; t[2] = u.e; t[3] = u.mt; t[4] = u.cnt; }
        const unsigned long long m = __ballot(ok); if (threadIdx.x == 0) tab[256] = __popcll(m); }
    __syncthreads();
    TableOrder T; T.tab = tab; T.n = __builtin_amdgcn_readfirstlane(tab[256]); return T;
}
struct DenseProb {
    static constexpr bool GATHER = false; static constexpr int BMAP = 0; static constexpr bool F8 = false;
    const bf16_t* A; const bf16_t* Bt; int lda, ldb, K;
    __device__ __forceinline__ const char* a_base(const Unit& u) const { return (const char*)(A + (size_t)u.pm * BM * lda); }
    __device__ __forceinline__ const char* b_base(const Unit& u) const { return (const char*)(Bt + (size_t)u.pn * BM * ldb); }
    __device__ __forceinline__ size_t bhstep() const { return (size_t)32 * ldb * 2; }
    __device__ __forceinline__ unsigned a_off(const Unit&, int, int) const { return 0u; }
    __device__ __forceinline__ unsigned a_raw(const Unit&, int) const { return 0u; }
};
struct GuProb {
    static constexpr bool GATHER = true; static constexpr int BMAP = 1; static constexpr bool F8 = true;
    const unsigned char* XG; const unsigned char* Wt; const u32x2* list; int lda, ldb, K;
    __device__ __forceinline__ const char* a_base(const Unit&) const { return (const char*)XG; }
    __device__ __forceinline__ const char* b_base(const Unit& u) const { return (const char*)(Wt + ((size_t)u.e * 2048 + 128 * u.pn) * 1024); }
    __device__ __forceinline__ size_t bhstep() const { return (size_t)1024 * 1024; }
    __device__ __forceinline__ unsigned a_raw(const Unit& u, int r) const { const int rr = u.mt * BM + r, rc = rr < u.cnt ? rr : u.cnt - 1; return list[(size_t)u.e * CAP + rc].x; }
    __device__ __forceinline__ unsigned a_off(const Unit& u, int r, int C) const {
        const int rr = u.mt * BM + r, rc = rr < u.cnt ? rr : u.cnt - 1;
        const unsigned tok = list[(size_t)u.e * CAP + rc].x >> 2;
        return tok * 1024u + (unsigned)C * 2u;
    }
};
struct DownProb {
    static constexpr bool GATHER = false; static constexpr int BMAP = 0; static constexpr bool F8 = true;
    const unsigned char* A; const unsigned char* Wt; int lda, ldb, K;
    __device__ __forceinline__ const char* a_base(const Unit& u) const { return (const char*)(A + (size_t)u.pm * BM * lda); }
    __device__ __forceinline__ const char* b_base(const Unit& u) const { return (const char*)(Wt + ((size_t)u.e * 1024 + 256 * u.pn) * 1024); }
    __device__ __forceinline__ size_t bhstep() const { return (size_t)32 * ldb; }
    __device__ __forceinline__ unsigned a_off(const Unit&, int, int) const { return 0u; }
    __device__ __forceinline__ unsigned a_raw(const Unit&, int) const { return 0u; }
};

template <class Prob> __device__ __forceinline__ void calc_aoff(const Prob& P, const Unit& u, const int (&Rr)[2], const int (&Cc)[2], unsigned (&o)[2][2]) {
#pragma unroll
    for (int h = 0; h < 2; ++h)
#pragma unroll
        for (int i = 0; i < 2; ++i) {
            if constexpr (Prob::GATHER) o[h][i] = P.a_off(u, h * HALF + Rr[i], Cc[i]);
            else o[h][i] = Prob::F8 ? (unsigned)((h * HALF + Rr[i]) * P.lda + Cc[i] * 2) : (unsigned)((h * HALF + Rr[i]) * P.lda + Cc[i]) * 2u;
        }
}

struct NoPost { __device__ __forceinline__ void operator()(int) const {} };
template <class Epi, class Prob, class Sched, bool ALIGN_EPI, class Post = NoPost>
__device__ __forceinline__ void gemm_phase(LAS unsigned char* lds, const Prob& P, const Sched& S, const Epi& E, const Post& PU = Post()) {
    const int tid = threadIdx.x, wid = __builtin_amdgcn_readfirstlane(tid >> 6), lane = tid & 63, wr = wid >> 2, wc = wid & 3, fr = lane & 15, fq = lane >> 4;
    const int K = P.K, nt = Prob::F8 ? K / 128 : K / BK;
    int Rr[2], Cc[2]; unsigned voffB[2];
#pragma unroll
    for (int i = 0; i < 2; ++i) { stage_rc(tid * 16 + i * 8192, Rr[i], Cc[i]); voffB[i] = Prob::F8 ? (unsigned)(brow<Prob::BMAP>(Rr[i]) * P.ldb + Cc[i] * 2) : (unsigned)(brow<Prob::BMAP>(Rr[i]) * P.ldb + Cc[i]) * 2u; }
    const size_t kstep = (size_t)(BK * 2);
    const size_t bhstep = P.bhstep();
    const unsigned ldsw = (unsigned)wid * 1024u;
    const int aoff = lds_byte(wr * 64 + fr, fq * 8), boff = lds_byte(wc * 32 + fr, fq * 8);
#define PG8_SA(b, h) (((b) * 2 + (h)) * HTB)
#define PG8_SB(b, h) ((4 + (b) * 2 + (h)) * HTB)
#define PG8_STG(bufoff, gptr, v0, v1) do { \
        __builtin_amdgcn_global_load_lds((const unsigned*)((const char*)(gptr) + (v0)), (LAS unsigned*)(lds + (bufoff) + ldsw), 16, 0, 0); \
        __builtin_amdgcn_global_load_lds((const unsigned*)((const char*)(gptr) + (v1)), (LAS unsigned*)(lds + (bufoff) + ldsw + 8192), 16, 0, 0); } while (0)
#define PG8_STGB(bufoff, gptr) PG8_STG(bufoff, gptr, voffB[0], voffB[1])
#define PG8_LDA(dst, b, h) do { _Pragma("unroll") for (int m = 0; m < 4; ++m) _Pragma("unroll") for (int k = 0; k < 2; ++k) dst[m][k] = *(const LAS bf16x8*)(lds + PG8_SA(b, h) + aoff + m * 2048 + k * 1024); } while (0)
#define PG8_LDB(dst, b, h) do { _Pragma("unroll") for (int n = 0; n < 2; ++n) _Pragma("unroll") for (int k = 0; k < 2; ++k) dst[n][k] = *(const LAS bf16x8*)(lds + PG8_SB(b, h) + boff + n * 2048 + k * 1024); } while (0)
#define PG8_MMAB(ai, bj, At, Bt) do { _Pragma("unroll") for (int m = 0; m < 4; ++m) _Pragma("unroll") for (int n = 0; n < 2; ++n) _Pragma("unroll") for (int k = 0; k < 2; ++k) \
        acc[ai][bj][m][n] = __builtin_amdgcn_mfma_f32_16x16x32_bf16(Bt[n][k], At[m][k], acc[ai][bj][m][n], 0, 0, 0); } while (0)
#define PG8_MMAQ(ai, bj, At, Bt) do { _Pragma("unroll") for (int m = 0; m < 4; ++m) _Pragma("unroll") for (int n = 0; n < 2; ++n) _Pragma("unroll") for (int k = 0; k < 2; ++k) { \
        const i64x2_t bq = __builtin_bit_cast(i64x2_t, Bt[n][k]), aq = __builtin_bit_cast(i64x2_t, At[m][k]); \
        acc[ai][bj][m][n] = __builtin_amdgcn_mfma_f32_16x16x32_fp8_fp8(bq[0], aq[0], acc[ai][bj][m][n], 0, 0, 0); \
        acc[ai][bj][m][n] = __builtin_amdgcn_mfma_f32_16x16x32_fp8_fp8(bq[1], aq[1], acc[ai][bj][m][n], 0, 0, 0); } } while (0)
#define PG8_MMA8(ai, bj, A8, B8) do { _Pragma("unroll") for (int m = 0; m < 4; ++m) _Pragma("unroll") for (int n = 0; n < 2; ++n) \
        asm volatile("v_mfma_f32_16x16x128_f8f6f4 %0, %1, %2, %0" : "+v"(acc[ai][bj][m][n]) : "v"(B8[n]), "v"(A8[m])); } while (0)
#define PG8_LDA8(dst, b, h) do { _Pragma("unroll") for (int m = 0; m < 4; ++m) { dst[m].lo = *(const LAS i32x4_t*)(lds + PG8_SA(b, h) + aoff + m * 2048); dst[m].hi = *(const LAS i32x4_t*)(lds + PG8_SA(b, h) + aoff + m * 2048 + 1024); } } while (0)
#define PG8_LDB8(dst, b, h) do { _Pragma("unroll") for (int n = 0; n < 2; ++n) { dst[n].lo = *(const LAS i32x4_t*)(lds + PG8_SB(b, h) + boff + n * 2048); dst[n].hi = *(const LAS i32x4_t*)(lds + PG8_SB(b, h) + boff + n * 2048 + 1024); } } while (0)
#define PG8_XLDA(b, h)  do { if constexpr (Prob::F8 && F8MODE == 2) PG8_LDA8(At8, b, h); else PG8_LDA(At, b, h); } while (0)
#define PG8_XLDB0(b, h) do { if constexpr (Prob::F8 && F8MODE == 2) PG8_LDB8(B08, b, h); else PG8_LDB(B0, b, h); } while (0)
#define PG8_XLDB1(b, h) do { if constexpr (Prob::F8 && F8MODE == 2) PG8_LDB8(B18, b, h); else PG8_LDB(B1, b, h); } while (0)
#define PG8_XMMA0(ai, bj) do { if (USE_SETPRIO) __builtin_amdgcn_s_setprio(USE_SETPRIO); if constexpr (Prob::F8 && F8MODE == 2) PG8_MMA8(ai, bj, At8, B08); else if constexpr (Prob::F8) PG8_MMAQ(ai, bj, At, B0); else PG8_MMAB(ai, bj, At, B0); if (USE_SETPRIO) __builtin_amdgcn_s_setprio(0); } while (0)
#define PG8_XMMA1(ai, bj) do { if (USE_SETPRIO) __builtin_amdgcn_s_setprio(USE_SETPRIO); if constexpr (Prob::F8 && F8MODE == 2) PG8_MMA8(ai, bj, At8, B18); else if constexpr (Prob::F8) PG8_MMAQ(ai, bj, At, B1); else PG8_MMAB(ai, bj, At, B1); if (USE_SETPRIO) __builtin_amdgcn_s_setprio(0); } while (0)
#define PG8_WAIT_V(n) asm volatile("s_waitcnt vmcnt(" #n ")" ::: "memory")
#define PG8_WAIT_L(n) asm volatile("s_waitcnt lgkmcnt(" #n ")" ::: "memory")
#define PG8_BAR __builtin_amdgcn_s_barrier()
#define PG8_SCHED __builtin_amdgcn_sched_barrier(0)
    Unit cur, nxt; int ui = 0;
    if (!S.next(0, cur)) return;
    unsigned vo[2][2], nvo[2][2];
    calc_aoff(P, cur, Rr, Cc, vo);
    bool has_next = S.next(1, nxt);
    if constexpr (Prob::GATHER) { if (has_next) calc_aoff(P, nxt, Rr, Cc, nvo); else {
#pragma unroll
        for (int h = 0; h < 2; ++h)
#pragma unroll
            for (int i = 0; i < 2; ++i) nvo[h][i] = vo[h][i]; } }
    f32x4 acc[2][2][4][2];
#pragma unroll
    for (int a = 0; a < 2; ++a)
#pragma unroll
        for (int b = 0; b < 2; ++b)
#pragma unroll
            for (int m = 0; m < 4; ++m)
#pragma unroll
                for (int n = 0; n < 2; ++n) acc[a][b][m][n] = (f32x4){0.f, 0.f, 0.f, 0.f};
    bf16x8 At[4][2], B0[2][2], B1[2][2]; i32x8_t At8[4], B08[2], B18[2];
    const char* cA = P.a_base(cur); const char* cB = P.b_base(cur);
    PG8_STGB(PG8_SB(0, 0), cB); PG8_STGB(PG8_SB(0, 1), cB + bhstep); PG8_STG(PG8_SA(0, 0), cA, vo[0][0], vo[0][1]); PG8_STG(PG8_SA(0, 1), cA, vo[1][0], vo[1][1]);
    if (wr == 1) PG8_BAR;
    PG8_WAIT_V(2); PG8_BAR;
    PG8_STGB(PG8_SB(1, 0), cB + kstep); PG8_STG(PG8_SA(1, 0), cA + kstep, vo[0][0], vo[0][1]); PG8_STGB(PG8_SB(1, 1), cB + bhstep + kstep);
    PG8_WAIT_V(6); PG8_BAR;
    for (;;) {
        const char* nA = has_next ? P.a_base(nxt) : cA; const char* nB = has_next ? P.b_base(nxt) : cB;
        for (int t = 0; t < nt; t += 2) {
            const bool last = (t == nt - 2);
            if constexpr (Epi::HAS_MID) { if (t == Epi::MID_T0 || t == Epi::MID_T1) { E.mid(acc, cur, wr, wc, fr, fq, t == Epi::MID_T0 ? 0 : 1); PG8_SCHED; } }
            const char* a1 = cA + (size_t)(t + 1) * kstep;
            const char* a2 = last ? nA : cA + (size_t)(t + 2) * kstep; const char* b2 = last ? nB : cB + (size_t)(t + 2) * kstep;
            const char* a3 = a2 + kstep; const char* b3 = b2 + kstep;
            unsigned x00 = vo[0][0], x01 = vo[0][1], x10 = vo[1][0], x11 = vo[1][1];
            if constexpr (Prob::GATHER) { if (last) { x00 = nvo[0][0]; x01 = nvo[0][1]; x10 = nvo[1][0]; x11 = nvo[1][1]; } }
            PG8_XLDB0(0, 0); PG8_XLDB1(0, 1); PG8_SCHED; PG8_XLDA(0, 0); PG8_STG(PG8_SA(1, 1), a1, vo[1][0], vo[1][1]);
            PG8_WAIT_V(8); PG8_WAIT_L(0); PG8_BAR; PG8_XMMA0(0, 0); PG8_XMMA1(0, 1); PG8_BAR; PG8_SCHED;
            PG8_XLDA(0, 1); PG8_STGB(PG8_SB(0, 0), b2); PG8_STGB(PG8_SB(0, 1), b2 + bhstep); PG8_STG(PG8_SA(0, 0), a2, x00, x01);
            PG8_WAIT_V(8); PG8_WAIT_L(0); PG8_BAR; PG8_XMMA0(1, 0); PG8_XMMA1(1, 1); PG8_BAR; PG8_SCHED;
            PG8_XLDB0(1, 0); PG8_XLDB1(1, 1); PG8_SCHED; PG8_XLDA(1, 0); PG8_STG(PG8_SA(0, 1), a2, x10, x11);
            PG8_WAIT_V(8); PG8_WAIT_L(0); PG8_BAR; PG8_XMMA0(0, 0); PG8_XMMA1(0, 1); PG8_BAR; PG8_SCHED;
            PG8_XLDA(1, 1); PG8_STGB(PG8_SB(1, 0), b3); PG8_STGB(PG8_SB(1, 1), b3 + bhstep); PG8_STG(PG8_SA(1, 0), a3, x00, x01);
            PG8_WAIT_V(8); PG8_WAIT_L(0); PG8_BAR; PG8_XMMA0(1, 0); PG8_XMMA1(1, 1); PG8_BAR; PG8_SCHED;
        }
        if constexpr (ALIGN_EPI) { if (wr == 0) PG8_BAR; }
        if constexpr (Prob::F8 && F8MODE == 2) asm volatile("s_nop 15\n\ts_nop 15" ::: "memory");
        Unit nn; const bool has_nn = has_next && S.next(ui + 2, nn);
        if constexpr (Prob::GATHER) {
#pragma unroll
            for (int h = 0; h < 2; ++h)
#pragma unroll
                for (int i = 0; i < 2; ++i) vo[h][i] = nvo[h][i];
            if (has_nn) {
#pragma unroll
                for (int h = 0; h < 2; ++h)
#pragma unroll
                    for (int i = 0; i < 2; ++i) nvo[h][i] = P.a_raw(nn, h * HALF + Rr[i]); } }
        E(acc, cur, wr, wc, fr, fq);
        PU(ui);
        if (!has_next) break;
#pragma unroll
        for (int a = 0; a < 2; ++a)
#pragma unroll
            for (int b = 0; b < 2; ++b)
#pragma unroll
                for (int m = 0; m < 4; ++m)
#pragma unroll
                    for (int n = 0; n < 2; ++n) acc[a][b][m][n] = (f32x4){0.f, 0.f, 0.f, 0.f};
        cur = nxt; cA = nA; cB = nB; ++ui;
        has_next = has_nn; nxt = nn;
        if constexpr (Prob::GATHER) { if (has_next) {
#pragma unroll
            for (int h = 0; h < 2; ++h)
#pragma unroll
                for (int i = 0; i < 2; ++i) nvo[h][i] = (nvo[h][i] >> 2) * (Prob::F8 ? 1024u : 2048u) + (unsigned)Cc[i] * 2u;
            asm volatile("" : "+v"(nvo[0][0]), "+v"(nvo[0][1]), "+v"(nvo[1][0]), "+v"(nvo[1][1])); } }
        if constexpr (ALIGN_EPI) { if (wr == 1) PG8_BAR; }
    }
    PG8_WAIT_V(0);
    if constexpr (!ALIGN_EPI) { if (wr == 0) PG8_BAR; }
    PG8_BAR;
#undef PG8_SA
#undef PG8_SB
#undef PG8_STG
#undef PG8_STGB
#undef PG8_LDA
#undef PG8_LDB
#undef PG8_MMAB
#undef PG8_MMAQ
#undef PG8_MMA8
#undef PG8_LDA8
#undef PG8_LDB8
#undef PG8_XLDA
#undef PG8_XLDB0
#undef PG8_XLDB1
#undef PG8_XMMA0
#undef PG8_XMMA1
#undef PG8_WAIT_V
#undef PG8_WAIT_L
#undef PG8_BAR
#undef PG8_SCHED
}

typedef const f32x4 (&AccRef)[2][2][4][2];

__device__ __forceinline__ void store8(bf16_t* p, const f32x4& a, const f32x4& b) {
    u32x4 w; w.x = cvt_pk_bf16(a[0], a[1]); w.y = cvt_pk_bf16(a[2], a[3]); w.z = cvt_pk_bf16(b[0], b[1]); w.w = cvt_pk_bf16(b[2], b[3]); *(u32x4*)p = w;
}
__device__ __forceinline__ float sigmoidf_(float v) { return __builtin_amdgcn_rcpf(1.0f + __builtin_amdgcn_exp2f(-1.4426950408889634f * v)); }

struct EpiInProj {
    static constexpr bool HAS_MID = false;
    bf16_t *Q, *Kb, *V, *U, *MQ, *GT; const float *qn, *kn, *mqn, *bg; const f32x2* rope;
    __device__ __forceinline__ void operator()(AccRef acc, const Unit& u, int wr, int wc, int fr, int fq) const {
        const int pn = u.pn; const int row0 = u.pm * BM + wr * 64 + fr;
        bf16_t* const Q_ = Q; bf16_t* const K_ = Kb; bf16_t* const V_ = V; bf16_t* const U_ = U; bf16_t* const MQ_ = MQ; const float* const qn_ = qn; const float* const kn_ = kn; const float* const mqn_ = mqn;
        if (pn < 4 || pn == 7) {
            const bool rope_on = pn < 4; const float* gn = pn < 2 ? qn_ : (pn < 4 ? kn_ : mqn_);
            const float sc = (pn < 2 || pn == 7) ? C2 : 1.0f;
            bf16_t* O; int pitch, colb;
            if (pn < 2) { O = Q_; pitch = 512; colb = (pn * 4 + wc) * 64; } else if (pn < 4) { O = K_; pitch = 512; colb = ((pn - 2) * 4 + wc) * 64; } else { O = MQ_; pitch = 256; colb = wc * 64; }
            const f32x4 g00 = *(const f32x4*)(gn + 8 * fq), g01 = *(const f32x4*)(gn + 8 * fq + 4), g10 = *(const f32x4*)(gn + 32 + 8 * fq), g11 = *(const f32x4*)(gn + 32 + 8 * fq + 4);
#pragma unroll
            for (int ai = 0; ai < 2; ++ai)
#pragma unroll
                for (int m = 0; m < 4; ++m) {
                    const f32x4 a0 = acc[ai][0][m][0], a1 = acc[ai][0][m][1], b0 = acc[ai][1][m][0], b1 = acc[ai][1][m][1];
                    float ss = 0.f;
#pragma unroll
                    for (int j = 0; j < 4; ++j) ss += a0[j] * a0[j] + a1[j] * a1[j] + b0[j] * b0[j] + b1[j] * b1[j];
                    ss += __shfl_xor(ss, 16); ss += __shfl_xor(ss, 32);
                    const float rstd = 1.0f / sqrtf(ss * (1.0f / 64.0f) + RMS_EPS);
                    const int row = row0 + ai * HALF + m * 16;
                    f32x4 t10 = a0 * rstd * g00, t11 = a1 * rstd * g01, t20 = b0 * rstd * g10, t21 = b1 * rstd * g11;
                    f32x4 o10, o11, o20, o21;
                    if (rope_on) {
                        const f32x4* rp = (const f32x4*)(rope + (size_t)(row & (SEQ - 1)) * 32 + 8 * fq);
                        const f32x4 r0 = rp[0], r1 = rp[1], r2 = rp[2], r3 = rp[3];
                        const f32x4 cs0 = {r0[0], r0[2], r1[0], r1[2]}, sn0 = {r0[1], r0[3], r1[1], r1[3]}, cs1 = {r2[0], r2[2], r3[0], r3[2]}, sn1 = {r2[1], r2[3], r3[1], r3[3]};
                        o10 = (t10 * cs0 - t20 * sn0) * sc; o11 = (t11 * cs1 - t21 * sn1) * sc; o20 = (t20 * cs0 + t10 * sn0) * sc; o21 = (t21 * cs1 + t11 * sn1) * sc;
                    } else { o10 = t10 * sc; o11 = t11 * sc; o20 = t20 * sc; o21 = t21 * sc; }
                    bf16_t* rowp = O + (size_t)row * pitch + colb + 8 * fq;
                    store8(rowp, o10, o11); store8(rowp + 32, o20, o21);
                }
        } else if (pn < 7) {
            bf16_t* O; int pitch, colb;
            if (pn < 6) { O = V_; pitch = 512; colb = (pn - 4) * 256 + wc * 64; } else { O = U_; pitch = 256; colb = wc * 64; }
#pragma unroll
            for (int ai = 0; ai < 2; ++ai)
#pragma unroll
                for (int m = 0; m < 4; ++m) { bf16_t* rowp = O + (size_t)(row0 + ai * HALF + m * 16) * pitch + colb + 8 * fq;
                    store8(rowp, acc[ai][0][m][0], acc[ai][0][m][1]); store8(rowp + 32, acc[ai][1][m][0], acc[ai][1][m][1]); }
        } else {
            const int gc = (pn - 8) * 256 + wc * 64 + 8 * fq;
            f32x4 bv[2][2];
#pragma unroll
            for (int bj = 0; bj < 2; ++bj)
#pragma unroll
                for (int n = 0; n < 2; ++n) bv[bj][n] = *(const f32x4*)(bg + gc + 32 * bj + 4 * n);
#pragma unroll
            for (int ai = 0; ai < 2; ++ai)
#pragma unroll
                for (int m = 0; m < 4; ++m) {
                    bf16_t* blk = GT + ((size_t)(((pn - 8) >> 2) * 128 + u.pm) * 4 + ((pn - 8) & 3)) * 65536 + (size_t)((wr * 4 + wc) * 16 * 64 + (fq * 16 + fr)) * 8;
#pragma unroll
                    for (int bj = 0; bj < 2; ++bj) { f32x4 v0 = acc[ai][bj][m][0] + bv[bj][0], v1 = acc[ai][bj][m][1] + bv[bj][1];
#pragma unroll
                        for (int j = 0; j < 4; ++j) { v0[j] = sigmoidf_(v0[j]); v1[j] = sigmoidf_(v1[j]); }
                        store8(blk + (ai * 8 + m * 2 + bj) * 512, v0, v1); } }
        }
    }
};
struct EpiMemKV {
    static constexpr bool HAS_MID = false;
    bf16_t* MKV; const float* mkn;
    __device__ __forceinline__ void operator()(AccRef acc, const Unit& u, int wr, int wc, int fr, int fq) const {
        const int row0 = u.pm * BM + wr * 64 + fr;
        f32x4 g00 = {1.f, 1.f, 1.f, 1.f}, g01 = g00, g10 = g00, g11 = g00;
        if (u.pn == 0) { g00 = *(const f32x4*)(mkn + 8 * fq); g01 = *(const f32x4*)(mkn + 8 * fq + 4); g10 = *(const f32x4*)(mkn + 32 + 8 * fq); g11 = *(const f32x4*)(mkn + 32 + 8 * fq + 4); }
#pragma unroll
        for (int ai = 0; ai < 2; ++ai)
#pragma unroll
            for (int m = 0; m < 4; ++m) {
                const f32x4 a0 = acc[ai][0][m][0], a1 = acc[ai][0][m][1], b0 = acc[ai][1][m][0], b1 = acc[ai][1][m][1];
                float rstd = 1.0f;
                if (u.pn == 0) { float ss = 0.f;
#pragma unroll
                    for (int j = 0; j < 4; ++j) ss += a0[j] * a0[j] + a1[j] * a1[j] + b0[j] * b0[j] + b1[j] * b1[j];
                    ss += __shfl_xor(ss, 16); ss += __shfl_xor(ss, 32); rstd = 1.0f / sqrtf(ss * (1.0f / 64.0f) + RMS_EPS); }
                bf16_t* rowp = MKV + (size_t)(row0 + ai * HALF + m * 16) * 512 + u.pn * 256 + wc * 64 + 8 * fq;
                store8(rowp, a0 * rstd * g00, a1 * rstd * g01); store8(rowp + 32, b0 * rstd * g10, b1 * rstd * g11);
            }
    }
};
template <int STAGE> struct EpiMerge {
    static constexpr bool HAS_MID = false;
    const bf16_t* GT; float* MF; bf16_t* MB;
    __device__ __forceinline__ void operator()(AccRef acc, const Unit& u, int wr, int wc, int fr, int fq) const {
        const int row0 = u.pm * BM + wr * 64 + fr, col0 = u.pn * BM + wc * 64 + 8 * fq;
#pragma unroll
        for (int ai = 0; ai < 2; ++ai)
#pragma unroll
            for (int m = 0; m < 4; ++m) { const size_t row = (size_t)(row0 + ai * HALF + m * 16);
#pragma unroll
                for (int bj = 0; bj < 2; ++bj) { const int col = col0 + 32 * bj;
                    const u32x4 g = *(const u32x4*)(GT + row * 3072 + STAGE * 1024 + col);
                    const f32x4 ga = {bf_lo(g.x), bf_hi(g.x), bf_lo(g.y), bf_hi(g.y)}, gb = {bf_lo(g.z), bf_hi(g.z), bf_lo(g.w), bf_hi(g.w)};
                    f32x4 v0 = acc[ai][bj][m][0] * ga, v1 = acc[ai][bj][m][1] * gb;
                    float* mp = MF + row * 1024 + col;
                    if (STAGE > 0) { v0 += *(const f32x4*)mp; v1 += *(const f32x4*)(mp + 4); }
                    if (STAGE < 2) { *(f32x4*)mp = v0; *(f32x4*)(mp + 4) = v1; } else store8(MB + row * 1024 + col, v0, v1); }
                if (m & 1) asm volatile("" ::: "memory"); }
    }
};
struct EpiWout {
    static constexpr bool HAS_MID = false;
    const float* X; float* X2; unsigned char* XG; const float* n2;
    __device__ __forceinline__ void operator()(AccRef acc, const Unit& u, int wr, int wc, int fr, int fq) const {
        const int row0 = u.pm * BM + wr * 64 + fr, col0 = u.pn * BM + wc * 64 + 8 * fq;
        f32x4 nv[2][2];
#pragma unroll
        for (int bj = 0; bj < 2; ++bj)
#pragma unroll
            for (int n = 0; n < 2; ++n) nv[bj][n] = *(const f32x4*)(n2 + col0 + 32 * bj + 4 * n);
#pragma unroll
        for (int ai = 0; ai < 2; ++ai)
#pragma unroll
            for (int m = 0; m < 4; ++m) { const size_t off = (size_t)(row0 + ai * HALF + m * 16) * 1024 + col0;
#pragma unroll
                for (int bj = 0; bj < 2; ++bj) { const f32x4 x0 = *(const f32x4*)(X + off + 32 * bj) + acc[ai][bj][m][0], x1 = *(const f32x4*)(X + off + 32 * bj + 4) + acc[ai][bj][m][1];
                    *(f32x4*)(X2 + off + 32 * bj) = x0; *(f32x4*)(X2 + off + 32 * bj + 4) = x1;
                    { const f32x4 y0 = x0 * nv[bj][0], y1 = x1 * nv[bj][1]; u32x2 w8; w8.x = pk4_fp8(y0[0], y0[1], y0[2], y0[3]); w8.y = pk4_fp8(y1[0], y1[1], y1[2], y1[3]); *(u32x2*)(XG + off + 32 * bj) = w8; } }
                if (m & 1) asm volatile("" ::: "memory"); }
    }
};
struct EpiSwiglu {
    static constexpr bool HAS_MID = false;
    unsigned char* ACT; const u32x2* list; const float* bgu;
    __device__ __forceinline__ void operator()(AccRef acc, const Unit& u, int wr, int wc, int fr, int fq) const {
        int z = 0; asm volatile("" : "+v"(z));
        const int col = 128 * u.pn + 32 * wc + 8 * fq + z; const float* bp = bgu + (size_t)u.e * 2048 + col;
        const f32x4 bg0 = *(const f32x4*)bp, bg1 = *(const f32x4*)(bp + 4), bu0 = *(const f32x4*)(bp + 1024), bu1 = *(const f32x4*)(bp + 1028);
#pragma unroll
        for (int ai = 0; ai < 2; ++ai)
#pragma unroll
            for (int m = 0; m < 4; ++m) { const int r = ai * HALF + wr * 64 + m * 16 + fr, rr = u.mt * BM + r, rc = rr < u.cnt ? rr : u.cnt - 1;
                const float rstd = __uint_as_float(list[(size_t)u.e * CAP + rc].y) * (1.0f / W8_SCALE);
                f32x4 o[2];
#pragma unroll
                for (int n = 0; n < 2; ++n) { const f32x4 g = acc[ai][0][m][n] * rstd + (n ? bg1 : bg0), up = acc[ai][1][m][n] * rstd + (n ? bu1 : bu0);
#pragma unroll
                    for (int j = 0; j < 4; ++j) { const float gg = fminf(g[j], 7.0f), uu = fminf(fmaxf(up[j], -7.0f), 7.0f);
                        o[n][j] = gg * __builtin_amdgcn_rcpf(1.0f + __builtin_amdgcn_exp2f(-1.702f * 1.4426950408889634f * gg)) * (uu + 1.0f); } }
                { const f32x4 q0 = o[0] * A8_SCALE, q1 = o[1] * A8_SCALE; u32x2 w8; w8.x = pk4_fp8(q0[0], q0[1], q0[2], q0[3]); w8.y = pk4_fp8(q1[0], q1[1], q1[2], q1[3]); *(u32x2*)(ACT + (size_t)(u.pm * BM + r) * 1024 + col) = w8; } }
    }
};
struct EpiDown {
    static constexpr bool HAS_MID = false;
    unsigned char* Y4; const u32x2* list; const float* bd;
    __device__ __forceinline__ void operator()(AccRef acc, const Unit& u, int wr, int wc, int fr, int fq) const {
        int z = 0; asm volatile("" : "+v"(z));
        const int col0 = u.pn * BM + wc * 64 + 8 * fq + z; const float* bp = bd + (size_t)u.e * 1024 + col0;
        f32x4 bv[2][2];
#pragma unroll
        for (int bj = 0; bj < 2; ++bj)
#pragma unroll
            for (int n = 0; n < 2; ++n) bv[bj][n] = *(const f32x4*)(bp + 32 * bj + 4 * n);
        unsigned tkv[8];
#pragma unroll
        for (int ai = 0; ai < 2; ++ai)
#pragma unroll
            for (int m = 0; m < 4; ++m) { const int rr = u.mt * BM + ai * HALF + wr * 64 + m * 16 + fr, rc = rr < u.cnt ? rr : u.cnt - 1;
                tkv[ai * 4 + m] = list[(size_t)u.e * CAP + rc].x; }
#pragma unroll
        for (int ai = 0; ai < 2; ++ai)
#pragma unroll
            for (int m = 0; m < 4; ++m) { const int rr = u.mt * BM + ai * HALF + wr * 64 + m * 16 + fr;
                if (rr < u.cnt) { unsigned char* rowp = Y4 + (size_t)tkv[ai * 4 + m] * 1024 + col0;
#pragma unroll
                    for (int bj = 0; bj < 2; ++bj) { const f32x4 y0 = (acc[ai][bj][m][0] * (1.0f / (W8_SCALE * A8_SCALE)) + bv[bj][0]) * Y8_SCALE, y1 = (acc[ai][bj][m][1] * (1.0f / (W8_SCALE * A8_SCALE)) + bv[bj][1]) * Y8_SCALE;
                        u32x2 w8; w8.x = pk4_fp8(y0[0], y0[1], y0[2], y0[3]); w8.y = pk4_fp8(y1[0], y1[1], y1[2], y1[3]); *(u32x2*)(rowp + 32 * bj) = w8; } } }
    }
};
struct EpiMergeR {
    static constexpr bool HAS_MID = true; static constexpr int MID_T0 = 8, MID_T1 = 12;
    const bf16_t* GT; bf16_t* MB;
    __device__ __forceinline__ void mid(f32x4 (&acc)[2][2][4][2], const Unit& u, int wr, int wc, int fr, int fq, int seam) const {
        int z = 0; asm volatile("" : "+v"(z));
        const bf16_t* gp0 = GT + ((size_t)(seam * 128 + u.pm) * 4 + u.pn) * 65536 + (size_t)((wr * 4 + wc) * 16 * 64 + (fq * 16 + fr) + z) * 8;
#pragma unroll
        for (int ai = 0; ai < 2; ++ai)
#pragma unroll
            for (int m = 0; m < 4; ++m) {
#pragma unroll
                for (int bj = 0; bj < 2; ++bj) { const bf16_t* gp = gp0 + (ai * 8 + m * 2 + bj) * 512;
                    const u32x4 gn = *(const u32x4*)gp, gd = *(const u32x4*)(gp + (size_t)128 * 4 * 65536);
                    const unsigned nn[4] = {gn.x, gn.y, gn.z, gn.w}, dd[4] = {gd.x, gd.y, gd.z, gd.w};
#pragma unroll
                    for (int j = 0; j < 4; ++j) { const float r0 = bf_lo(nn[j]) * __builtin_amdgcn_rcpf(fmaxf(bf_lo(dd[j]), 8.67e-19f)), r1 = bf_hi(nn[j]) * __builtin_amdgcn_rcpf(fmaxf(bf_hi(dd[j]), 8.67e-19f));
                        acc[ai][bj][m][j >> 1][(j & 1) * 2] *= r0; acc[ai][bj][m][j >> 1][(j & 1) * 2 + 1] *= r1; } }
                if (m & 1) asm volatile("" ::: "memory"); }
    }
    __device__ __forceinline__ void operator()(AccRef acc, const Unit& u, int wr, int wc, int fr, int fq) const {
        int z = 0; asm volatile("" : "+v"(z));
        const size_t off0 = (size_t)(u.pm * BM + wr * 64 + fr + z) * 1024 + u.pn * BM + wc * 64 + 8 * fq;
        const bf16_t* gp0 = GT + ((size_t)(2 * 128 + u.pm) * 4 + u.pn) * 65536 + (size_t)((wr * 4 + wc) * 16 * 64 + (fq * 16 + fr) + z) * 8;
#pragma unroll
        for (int ai = 0; ai < 2; ++ai)
#pragma unroll
            for (int m = 0; m < 4; ++m) { const size_t ro = off0 + (size_t)(ai * HALF + m * 16) * 1024;
#pragma unroll
                for (int bj = 0; bj < 2; ++bj) {
                    const u32x4 g = *(const u32x4*)(gp0 + (ai * 8 + m * 2 + bj) * 512);
                    const f32x4 ga = {bf_lo(g.x), bf_hi(g.x), bf_lo(g.y), bf_hi(g.y)}, gb = {bf_lo(g.z), bf_hi(g.z), bf_lo(g.w), bf_hi(g.w)};
                    store8(MB + ro + 32 * bj, acc[ai][bj][m][0] * ga, acc[ai][bj][m][1] * gb); } }
    }
};
struct EpiPlain {
    static constexpr bool HAS_MID = false;
    bf16_t* Z; int ldz;
    __device__ __forceinline__ void operator()(AccRef acc, const Unit& u, int wr, int wc, int fr, int fq) const {
        const int row0 = u.pm * BM + wr * 64 + fr, col0 = u.pn * BM + wc * 64 + 8 * fq;
#pragma unroll
        for (int ai = 0; ai < 2; ++ai)
#pragma unroll
            for (int m = 0; m < 4; ++m) { bf16_t* rowp = Z + (size_t)(row0 + ai * HALF + m * 16) * ldz + col0;
                store8(rowp, acc[ai][0][m][0], acc[ai][0][m][1]); store8(rowp + 32, acc[ai][1][m][0], acc[ai][1][m][1]); }
    }
};
}

namespace attn_body {
using bf16 = __hip_bfloat16;
using s16x4 = __attribute__((ext_vector_type(4))) short;
constexpr int NW = 8, QBLK = 32, QB = QBLK * NW, KVBLK = 64, D = 64;
__device__ __forceinline__ int crow(int r, int hi) { return (r & 3) + 8 * (r >> 2) + 4 * hi; }
#define SBAR() __builtin_amdgcn_sched_barrier(0)
constexpr int NSLOT = 3, SLOTB = 8192;
constexpr int LDS_K = 0, LDS_V = NSLOT * SLOTB, LDS_WS = 2 * NSLOT * SLOTB, LDS_OST = LDS_WS + NW * 64 * 4, LDS_BYTES = LDS_OST + NW * 4096;
__device__ __forceinline__ void glds16(const void* gsrc, unsigned lds_dst) { unsigned keep;
    asm volatile("s_mov_b32 %0, m0\n\ts_mov_b32 m0, %2\n\ts_nop 0\n\tglobal_load_lds_dwordx4 %1, off\n\ts_mov_b32 m0, %0" : "=&s"(keep) : "v"(gsrc), "s"(lds_dst) : "memory"); }
__device__ __forceinline__ float max3f(float a, float b, float c) { float r; asm("v_max3_f32 %0, %1, %2, %3" : "=v"(r) : "v"(a), "v"(b), "v"(c)); return r; }
__device__ __forceinline__ float max2f(float a, float b) { float r; asm("v_max_f32_e32 %0, %1, %2" : "=v"(r) : "v"(a), "v"(b)); return r; }
__device__ __forceinline__ float fadd_s(float a, float b) { float r; asm("v_add_f32_e32 %0, %1, %2" : "=v"(r) : "v"(a), "v"(b)); return r; }
__device__ __forceinline__ float fsub_s(float a, float b) { float r; asm("v_sub_f32_e32 %0, %1, %2" : "=v"(r) : "v"(a), "v"(b)); return r; }
typedef float f32x2_t __attribute__((ext_vector_type(2))); typedef __bf16 bf16x2_t __attribute__((ext_vector_type(2)));
__device__ __forceinline__ unsigned cvtpk_s(float lo, float hi) { f32x2_t v = {lo, hi}; bf16x2_t b = __builtin_convertvector(v, bf16x2_t); return __builtin_bit_cast(unsigned, b); }
#define WAIT_BAR(N) asm volatile("s_waitcnt vmcnt(" #N ") lgkmcnt(0)\n\ts_barrier" ::: "memory")

__device__ __forceinline__ void qkt(f32x16& p0, f32x16& p1, const char* Kslot, const bf16x8* qr, const f32x16& negm, int r32, int hi) {
    const char* kb = Kslot + hi * 1024 + r32 * 16;
#pragma unroll
    for (int d0 = 0; d0 < 4; ++d0) {
        const bf16x8 b0 = *reinterpret_cast<const bf16x8*>(kb + d0 * 2048);
        const bf16x8 b1 = *reinterpret_cast<const bf16x8*>(kb + d0 * 2048 + 512);
        if (d0 == 0) { p0 = __builtin_amdgcn_mfma_f32_32x32x16_bf16(b0, qr[0], negm, 0, 0, 0); p1 = __builtin_amdgcn_mfma_f32_32x32x16_bf16(b1, qr[0], negm, 0, 0, 0); }
        else { p0 = __builtin_amdgcn_mfma_f32_32x32x16_bf16(b0, qr[d0], p0, 0, 0, 0); p1 = __builtin_amdgcn_mfma_f32_32x32x16_bf16(b1, qr[d0], p1, 0, 0, 0); } }
}
typedef __attribute__((address_space(3))) const char* lds_cptr;
typedef short v4i16_t __attribute__((ext_vector_type(4)));
__device__ __forceinline__ void kload8(bf16x8* kf, lds_cptr kp) {
    kf[0] = *(const __attribute__((address_space(3))) bf16x8*)(kp);        kf[1] = *(const __attribute__((address_space(3))) bf16x8*)(kp + 512);
    kf[2] = *(const __attribute__((address_space(3))) bf16x8*)(kp + 2048); kf[3] = *(const __attribute__((address_space(3))) bf16x8*)(kp + 2560);
    kf[4] = *(const __attribute__((address_space(3))) bf16x8*)(kp + 4096); kf[5] = *(const __attribute__((address_space(3))) bf16x8*)(kp + 4608);
    kf[6] = *(const __attribute__((address_space(3))) bf16x8*)(kp + 6144); kf[7] = *(const __attribute__((address_space(3))) bf16x8*)(kp + 6656);
}
__device__ __forceinline__ void kload2(bf16x8* kf, lds_cptr kp, int j) { kf[2 * j] = *(const __attribute__((address_space(3))) bf16x8*)(kp + j * 2048); kf[2 * j + 1] = *(const __attribute__((address_space(3))) bf16x8*)(kp + j * 2048 + 512); }
__device__ __forceinline__ s16x4 vtr(lds_cptr p) { return __builtin_bit_cast(s16x4, __builtin_amdgcn_ds_read_tr16_b64_v4i16((__attribute__((address_space(3))) v4i16_t*)p)); }
__device__ __forceinline__ float rowmax(const f32x16& p0, const f32x16& p1) {
    float a = max3f(p0[0], p0[1], p1[0]), b = max3f(p0[2], p0[3], p1[1]); a = max3f(a, p1[2], p1[3]);
#pragma unroll
    for (int r = 4; r < 16; r += 4) { a = max3f(a, p0[r], p0[r + 1]); b = max3f(b, p0[r + 2], p0[r + 3]); a = max3f(a, p1[r], p1[r + 1]); b = max3f(b, p1[r + 2], p1[r + 3]); }
    const float m = max2f(a, b);
    auto rr = __builtin_amdgcn_permlane32_swap(__float_as_uint(m), __float_as_uint(m), false, false);
    return max2f(__uint_as_float(rr[0]), __uint_as_float(rr[1]));
}
__device__ __forceinline__ void pv(f32x16* o, int vb, bf16x8 pa0, bf16x8 pa1, bf16x8 pa2, bf16x8 pa3) {
#pragma unroll
    for (int d0 = 0; d0 < 2; ++d0) { s16x4 lo[4], hi[4];
#pragma unroll
        for (int ks = 0; ks < 4; ++ks) {
            asm volatile("ds_read_b64_tr_b16 %0,%1 offset:%c2" : "=&v"(lo[ks]) : "v"(vb), "i"(d0 * 4096 + ks * 1024) : "memory");
            asm volatile("ds_read_b64_tr_b16 %0,%1 offset:%c2" : "=&v"(hi[ks]) : "v"(vb), "i"(d0 * 4096 + ks * 1024 + 512) : "memory"); }
        asm volatile("s_waitcnt lgkmcnt(0)" ::: "memory"); SBAR();
#define PK(k) (bf16x8){lo[k][0], lo[k][1], lo[k][2], lo[k][3], hi[k][0], hi[k][1], hi[k][2], hi[k][3]}
        o[d0] = __builtin_amdgcn_mfma_f32_32x32x16_bf16(pa0, PK(0), o[d0], 0, 0, 0);
        o[d0] = __builtin_amdgcn_mfma_f32_32x32x16_bf16(pa1, PK(1), o[d0], 0, 0, 0);
        o[d0] = __builtin_amdgcn_mfma_f32_32x32x16_bf16(pa2, PK(2), o[d0], 0, 0, 0);
        o[d0] = __builtin_amdgcn_mfma_f32_32x32x16_bf16(pa3, PK(3), o[d0], 0, 0, 0);
#undef PK
    }
}
__device__ __forceinline__ void cmask(f32x16& p0, f32x16& p1, int jb, int wid) {
    if (jb > (wid >> 1)) {
#pragma unroll
        for (int r = 0; r < 16; ++r) { p0[r] = -INFINITY; p1[r] = -INFINITY; } }
}
template <int THRL, bool MASK> __device__ __forceinline__ void attn_unit(int q0, int NT, const bf16* Qh, int qp, const bf16* __restrict__ Kh, int kp, const bf16* __restrict__ Vh, int vp, bf16* Oh, int op, char* shm) {
    const int tid = threadIdx.x, lane = tid & 63, r32 = lane & 31, hi = lane >> 5; const int wid = __builtin_amdgcn_readfirstlane(tid >> 6);
    const bf16* Qw = Qh + (long)(q0 + wid * QBLK) * qp;
    const unsigned lds0 = (unsigned)(uintptr_t)shm;
    float* wsf = (float*)(shm + LDS_WS) + wid * 64;
    const bf16* ksrc = Kh + (long)lane * kp + wid * 8;
    const bf16* vsrc = Vh + (long)(16 * (wid & 3) + (lane >> 2)) * vp + (wid >> 2) * 32 + (lane & 3) * 8;
    const unsigned kdst = lds0 + LDS_K + wid * 1024, vdst = lds0 + LDS_V + wid * 1024;
#define DMA_K(t, slot) glds16(ksrc + (long)(t) * KVBLK * kp, (unsigned)__builtin_amdgcn_readfirstlane(kdst + (slot)))
#define DMA_V(t, slot) glds16(vsrc + (long)(t) * KVBLK * vp, (unsigned)__builtin_amdgcn_readfirstlane(vdst + (slot)))
    const int vb0 = (int)(lds0 + LDS_V) + ((lane >> 4) & 1) * 32 + (lane & 3) * 8 + (4 * hi + ((lane & 15) >> 2)) * 64;
    const char* Kbase = shm + LDS_K; bf16x8 kf[8];
    const lds_cptr shm3 = (lds_cptr)shm; const lds_cptr kp0 = shm3 + LDS_K + hi * 1024 + r32 * 16; const lds_cptr vp0 = shm3 + LDS_V + ((lane >> 4) & 1) * 32 + (lane & 3) * 8 + (4 * hi + ((lane & 15) >> 2)) * 64;
    DMA_K(0, 0); DMA_V(0, 0); DMA_K(1, SLOTB);
    bf16x8 qr[4];
#pragma unroll
    for (int d0 = 0; d0 < 4; ++d0) qr[d0] = *reinterpret_cast<const bf16x8*>(&Qw[(long)r32 * qp + d0 * 16 + hi * 8]);
    float mhat = 0.f, l_reg = 0.f; f32x16 o[2]; o[0] = f32x16{}; o[1] = f32x16{}; f32x16 negm = f32x16{}; asm volatile("" : "+v"(negm));
#define CMASK(P0, P1, t) do { if (MASK) { int jb_ = (t) - (NT - 4); if (jb_ >= 0) cmask(P0, P1, jb_, wid); } } while (0)
    bool resc = false;
#define START(P0, P1) do { const float rm = rowmax(P0, P1); resc = false; \
    { const float dl = rm; mhat = fadd_s(mhat, dl); \
      _Pragma("unroll") for (int r = 0; r < 16; ++r) { P0[r] = fsub_s(P0[r], dl); P1[r] = fsub_s(P1[r], dl); } \
      _Pragma("unroll") for (int r = 0; r < 16; ++r) negm[r] = -mhat; asm volatile("" : "+v"(negm)); } \
    _Pragma("unroll") for (int r = 0; r < 16; ++r) P0[r] = __builtin_amdgcn_exp2f(P0[r]); } while (0)
#define RESC() do { if (resc) { asm volatile("s_waitcnt lgkmcnt(0)" ::: "memory"); \
      _Pragma("unroll") for (int d_ = 0; d_ < 2; ++d_) _Pragma("unroll") for (int r = 0; r < 16; ++r) o[d_][r] *= wsf[crow(r, hi)]; } } while (0)
    f32x16 pA0, pA1, pB0, pB1;
    int sl_prev = 0, sl_cur = 0, sl_next = SLOTB;
#define ROT() do { sl_prev = sl_cur; sl_cur = sl_next; sl_next = (sl_next == (NSLOT - 1) * SLOTB) ? 0 : sl_next + SLOTB; } while (0)
    DMA_K(2, 2 * SLOTB);
    WAIT_BAR(3);
    qkt(pA0, pA1, Kbase, qr, negm, r32, hi); asm volatile("s_nop 15\n\ts_nop 7" : "+v"(pA0), "+v"(pA1)); CMASK(pA0, pA1, 0);
    START(pA0, pA1);
    _Pragma("unroll") for (int r = 0; r < 16; ++r) pA1[r] = __builtin_amdgcn_exp2f(pA1[r]);
    WAIT_BAR(0);
    DMA_K(3, 0); DMA_V(1, SLOTB);
    ROT();
    kload8(kf, kp0 + sl_cur);
    WAIT_BAR(2);
    s16x4 vlo[8], vhi[8]; u32x4 pw0, pw1, pw2, pw3;
#define PKW(P, B) cvtpk_s(P[B], P[B + 1])
#define PAF(k) __builtin_bit_cast(bf16x8, pw##k)
#define VFR(i) (bf16x8){vlo[i][0], vlo[i][1], vlo[i][2], vlo[i][3], vhi[i][0], vhi[i][1], vhi[i][2], vhi[i][3]}
#define PIN(x) asm volatile("" : "+v"(x))
#define MX3(a, b, c) __builtin_fmaxf(__builtin_fmaxf((a), (b)), (c))
#define GAPA(MF, A0, A1, A2, A3, W0, W1, PW) do { MF; sacc += A0; sacc += A1; sacc += A2; sacc += A3; PIN(sacc); W0; W1; PIN(PW); SBAR(); } while (0)
#define EX(v) __builtin_amdgcn_exp2f(v)
#define GAPB(MF, X, B) do { MF; X[B] = EX(X[B]); X[B + 1] = EX(X[B + 1]); X[B + 2] = EX(X[B + 2]); X[B + 3] = EX(X[B + 3]); PIN(X); SBAR(); } while (0)
#define VRD(i) do { vlo[i] = vtr(vp_ + (((i) >> 2) * 4096 + ((i) & 3) * 1024)); vhi[i] = vtr(vp_ + (((i) >> 2) * 4096 + ((i) & 3) * 1024 + 512)); } while (0)
#define KRD(G, j) do { if (G) { kload2(kf, kp0 + sl_next, j); SBAR(); } } while (0)
#define STEP(C0, C1, P0, P1, t, GK, GV, GL) do { SBAR(); \
    const lds_cptr vp_ = vp0 + sl_prev; \
    VRD(0); SBAR(); float sacc = (P0[0] + P0[1]); \
    GAPA(C0 = __builtin_amdgcn_mfma_f32_32x32x16_bf16(kf[0], qr[0], negm, 0, 0, 0), P0[2], P0[3], P0[4], P0[5],     pw0[0] = PKW(P0, 0), pw0[1] = PKW(P0, 2), pw0); \
    VRD(4); SBAR(); GAPA(C1 = __builtin_amdgcn_mfma_f32_32x32x16_bf16(kf[1], qr[0], negm, 0, 0, 0), P0[6], P0[7], P0[8], P0[9],     pw0[2] = PKW(P0, 4), pw0[3] = PKW(P0, 6), pw0); \
    VRD(1); SBAR(); GAPA(C0 = __builtin_amdgcn_mfma_f32_32x32x16_bf16(kf[2], qr[1], C0, 0, 0, 0),   P0[10], P0[11], P0[12], P0[13], pw1[0] = PKW(P0, 8), pw1[1] = PKW(P0, 10), pw1); \
    VRD(5); SBAR(); GAPA(C1 = __builtin_amdgcn_mfma_f32_32x32x16_bf16(kf[3], qr[1], C1, 0, 0, 0),   P0[14], P0[15], P1[0], P1[1],   pw1[2] = PKW(P0, 12), pw1[3] = PKW(P0, 14), pw1); \
    VRD(2); SBAR(); GAPA(C0 = __builtin_amdgcn_mfma_f32_32x32x16_bf16(kf[4], qr[2], C0, 0, 0, 0),   P1[2], P1[3], P1[4], P1[5],     pw2[0] = PKW(P1, 0), pw2[1] = PKW(P1, 2), pw2); \
    VRD(6); SBAR(); GAPA(C1 = __builtin_amdgcn_mfma_f32_32x32x16_bf16(kf[5], qr[2], C1, 0, 0, 0),   P1[6], P1[7], P1[8], P1[9],     pw2[2] = PKW(P1, 4), pw2[3] = PKW(P1, 6), pw2); \
    VRD(3); SBAR(); GAPA(C0 = __builtin_amdgcn_mfma_f32_32x32x16_bf16(kf[6], qr[3], C0, 0, 0, 0),   P1[10], P1[11], P1[12], P1[13], pw3[0] = PKW(P1, 8), pw3[1] = PKW(P1, 10), pw3); \
    VRD(7); SBAR(); GAPA(C1 = __builtin_amdgcn_mfma_f32_32x32x16_bf16(kf[7], qr[3], C1, 0, 0, 0),   P1[14], P1[15], 0.f, 0.f,       pw3[2] = PKW(P1, 12), pw3[3] = PKW(P1, 14), pw3); \
    l_reg += sacc; \
    if (GK) { DMA_K((t) + 3, sl_cur); } if (GV) { DMA_V((t) + 1, sl_next); } \
    CMASK(C0, C1, t); \
    { float a = MX3(C0[0], C0[1], C1[0]), b = MX3(C0[2], C0[3], C1[1]); a = MX3(a, C1[2], C1[3]); \
      _Pragma("unroll") for (int r = 4; r < 16; r += 4) { a = MX3(a, C0[r], C0[r + 1]); b = MX3(b, C0[r + 2], C0[r + 3]); a = MX3(a, C1[r], C1[r + 1]); b = MX3(b, C1[r + 2], C1[r + 3]); } \
      float rm = __builtin_fmaxf(a, b); { auto rr = __builtin_amdgcn_permlane32_swap(__float_as_uint(rm), __float_as_uint(rm), false, false); rm = __builtin_fmaxf(__uint_as_float(rr[0]), __uint_as_float(rr[1])); } \
      resc = false; \
      if (__builtin_expect(__any(rm > (float)THRL), 0)) { const float dl = __builtin_fmaxf(rm, 0.f); mhat += dl; \
        _Pragma("unroll") for (int r = 0; r < 16; ++r) { C0[r] -= dl; C1[r] -= dl; } \
        _Pragma("unroll") for (int r = 0; r < 16; ++r) negm[r] = -mhat; asm volatile("" : "+v"(negm)); \
        const float f = __builtin_amdgcn_exp2f(-dl); l_reg *= f; if (hi == 0) wsf[r32] = f; resc = true; } } \
    SBAR(); \
    GAPB(o[0] = __builtin_amdgcn_mfma_f32_32x32x16_bf16(PAF(0), VFR(0), o[0], 0, 0, 0), C0, 0); \
    GAPB(o[1] = __builtin_amdgcn_mfma_f32_32x32x16_bf16(PAF(0), VFR(4), o[1], 0, 0, 0), C0, 4); \
    KRD(GL, 0); GAPB(o[0] = __builtin_amdgcn_mfma_f32_32x32x16_bf16(PAF(1), VFR(1), o[0], 0, 0, 0), C0, 8); \
    KRD(GL, 1); GAPB(o[1] = __builtin_amdgcn_mfma_f32_32x32x16_bf16(PAF(1), VFR(5), o[1], 0, 0, 0), C0, 12); \
    KRD(GL, 2); GAPB(o[0] = __builtin_amdgcn_mfma_f32_32x32x16_bf16(PAF(2), VFR(2), o[0], 0, 0, 0), C1, 0); \
    KRD(GL, 3); GAPB(o[1] = __builtin_amdgcn_mfma_f32_32x32x16_bf16(PAF(2), VFR(6), o[1], 0, 0, 0), C1, 4); \
    GAPB(o[0] = __builtin_amdgcn_mfma_f32_32x32x16_bf16(PAF(3), VFR(3), o[0], 0, 0, 0), C1, 8); \
    GAPB(o[1] = __builtin_amdgcn_mfma_f32_32x32x16_bf16(PAF(3), VFR(7), o[1], 0, 0, 0), C1, 12); \
    } while (0)
    int t = 1;
#undef CMASK
#define CMASK(P0, P1, t) do {} while (0)
    for (; t + 5 < NT; t += 2) {
        STEP(pB0, pB1, pA0, pA1, t, true, true, true);     WAIT_BAR(2); RESC(); ROT();
        STEP(pA0, pA1, pB0, pB1, t + 1, true, true, true); WAIT_BAR(2); RESC(); ROT();
    }
#undef CMASK
#define CMASK(P0, P1, t) do { if (MASK) { int jb_ = (t) - (NT - 4); if (jb_ >= 0) cmask(P0, P1, jb_, wid); } } while (0)
#define ENDW(tt) do { if ((tt) + 3 < NT) { WAIT_BAR(2); } else if ((tt) + 2 < NT) { WAIT_BAR(1); } else { WAIT_BAR(0); } } while (0)
    for (; t + 1 < NT; t += 2) {
        STEP(pB0, pB1, pA0, pA1, t, (t + 3 < NT), (t + 1 < NT), (t + 1 < NT));       ENDW(t);     RESC(); ROT();
        STEP(pA0, pA1, pB0, pB1, t + 1, (t + 4 < NT), (t + 2 < NT), (t + 2 < NT));   ENDW(t + 1); RESC(); ROT();
    }
    STEP(pB0, pB1, pA0, pA1, NT - 1, false, false, false); RESC();
    { float sacc = pB0[0] + pB0[1]; _Pragma("unroll") for (int r = 2; r < 16; ++r) sacc += pB0[r]; _Pragma("unroll") for (int r = 0; r < 16; ++r) sacc += pB1[r]; l_reg += sacc;
      pw0 = (u32x4){PKW(pB0, 0), PKW(pB0, 2), PKW(pB0, 4), PKW(pB0, 6)}; pw1 = (u32x4){PKW(pB0, 8), PKW(pB0, 10), PKW(pB0, 12), PKW(pB0, 14)}; pw2 = (u32x4){PKW(pB1, 0), PKW(pB1, 2), PKW(pB1, 4), PKW(pB1, 6)}; pw3 = (u32x4){PKW(pB1, 8), PKW(pB1, 10), PKW(pB1, 12), PKW(pB1, 14)};
      SBAR(); pv(o, vb0 + sl_cur, PAF(0), PAF(1), PAF(2), PAF(3)); }
#undef PKW
#undef PAF
#undef VFR
#undef PIN
#undef MX3
#undef GAPA
#undef GAPB
#undef EX
#undef VRD
#undef KRD
#undef STEP
#undef ENDW
    { auto rr = __builtin_amdgcn_permlane32_swap(__float_as_uint(l_reg), __float_as_uint(l_reg), false, false); l_reg = __uint_as_float(rr[0]) + __uint_as_float(rr[1]); }
    if (hi == 0) wsf[32 + r32] = l_reg; asm volatile("s_waitcnt lgkmcnt(0)" ::: "memory");
    float rli[16];
#pragma unroll
    for (int r = 0; r < 16; ++r) rli[r] = __builtin_amdgcn_rcpf(wsf[32 + crow(r, hi)]);
    bf16* Ow = Oh + (long)(q0 + wid * QBLK) * op;
    { bf16* stg = (bf16*)(shm + LDS_OST) + wid * 2048;
#pragma unroll
      for (int r = 0; r < 16; ++r) { const int orow = crow(r, hi);
#pragma unroll
        for (int d0 = 0; d0 < 2; ++d0) stg[orow * 64 + d0 * 32 + r32] = __float2bfloat16(o[d0][r] * rli[r]); }
      asm volatile("s_waitcnt lgkmcnt(0)" ::: "memory");
#pragma unroll
      for (int i = 0; i < 4; ++i) { const int row = i * 8 + (lane >> 3), ch = lane & 7; const u32x4 v = *(const u32x4*)(stg + row * 64 + ch * 8); *(u32x4*)(Ow + (long)row * op + ch * 8) = v; } }
    asm volatile("s_waitcnt lgkmcnt(0)\n\ts_barrier" ::: "memory");
#undef DMA_K
#undef DMA_V
#undef CMASK
#undef START
#undef RESC
#undef ROT
}

constexpr int L2_K = 0, L2_V = 3 * 8192, L2_WS = L2_V + 4 * 16384, L2_OST = L2_WS + NW * 64 * 4, L2_BYTES = L2_OST + NW * 4096;
template <bool MASK> __device__ __forceinline__ void attn_unit2(int q0, int NT, const bf16* Qh, int qp, const bf16* __restrict__ Kh, int kp, const bf16* __restrict__ Vh, int vp, bf16* Oh, int op, char* shm) {
    const int tid = threadIdx.x, lane = tid & 63, r32 = lane & 31, hi = lane >> 5; const int wid = __builtin_amdgcn_readfirstlane(tid >> 6);
    const bf16* Qw = Qh + (long)(q0 + wid * QBLK) * qp;
    const unsigned lds0 = (unsigned)(uintptr_t)shm;
    float* wsf = (float*)(shm + L2_WS) + wid * 64;
    const bf16* ksrc = Kh + (long)lane * kp + wid * 8;
    const bf16* vsrc = Vh + (long)(16 * (wid & 3) + (lane >> 2)) * vp + (wid >> 2) * 32 + (lane & 3) * 8;
    const unsigned kdst = lds0 + L2_K + wid * 1024, vdst = lds0 + L2_V + wid * 1024;
#define DMA_K(t, slot) glds16(ksrc + (long)(t) * KVBLK * kp, (unsigned)__builtin_amdgcn_readfirstlane(kdst + (slot)))
#define DMA_V(t, vslot) do { glds16(vsrc + (long)(t) * KVBLK * vp, (unsigned)__builtin_amdgcn_readfirstlane(vdst + (vslot))); \
                            glds16(vsrc + (long)(t) * KVBLK * vp + 64, (unsigned)__builtin_amdgcn_readfirstlane(vdst + (vslot) + 8192)); } while (0)
    const int vb0 = (int)(lds0 + L2_V) + ((lane >> 4) & 1) * 32 + (lane & 3) * 8 + (4 * hi + ((lane & 15) >> 2)) * 64;
    const char* Kbase = shm + L2_K; bf16x8 kf[8];
    const lds_cptr shm3 = (lds_cptr)shm; const lds_cptr kp0 = shm3 + L2_K + hi * 1024 + r32 * 16; const lds_cptr vp0 = shm3 + L2_V + ((lane >> 4) & 1) * 32 + (lane & 3) * 8 + (4 * hi + ((lane & 15) >> 2)) * 64;
    DMA_K(0, 0); DMA_V(0, 0); DMA_K(1, SLOTB);
    bf16x8 qr[4];
#pragma unroll
    for (int d0 = 0; d0 < 4; ++d0) qr[d0] = *reinterpret_cast<const bf16x8*>(&Qw[(long)r32 * qp + d0 * 16 + hi * 8]);
    float l_reg = 0.f; f32x16 o[4]; o[0] = f32x16{}; o[1] = f32x16{}; o[2] = f32x16{}; o[3] = f32x16{};
    const f32x16 zero16 = f32x16{};
#define CMASK(P0, P1, t) do { if (MASK) { int jb_ = (t) - (NT - 4); if (jb_ >= 0) cmask(P0, P1, jb_, wid); } } while (0)
    f32x16 pA0, pA1, pB0, pB1;
    int sl_prev = 0, sl_cur = 0, sl_next = SLOTB;
    int vs_rd = 0, vs_wr = 3 * 16384;
#define ROT() do { sl_prev = sl_cur; sl_cur = sl_next; sl_next = (sl_next == (NSLOT - 1) * SLOTB) ? 0 : sl_next + SLOTB; vs_rd = (vs_rd + 16384) & 65535; vs_wr = (vs_wr + 16384) & 65535; } while (0)
    DMA_K(2, 2 * SLOTB); DMA_V(1, 16384);
    WAIT_BAR(6);
    qkt(pA0, pA1, Kbase, qr, zero16, r32, hi); CMASK(pA0, pA1, 0);
    _Pragma("unroll") for (int r = 0; r < 16; ++r) { pA0[r] = __builtin_amdgcn_exp2f(pA0[r]); pA1[r] = __builtin_amdgcn_exp2f(pA1[r]); }
    WAIT_BAR(2);
    DMA_K(3, 0); DMA_V(2, 2 * 16384);
    sl_prev = sl_cur; sl_cur = sl_next; sl_next = 2 * SLOTB;
    kload8(kf, kp0 + sl_cur);
    WAIT_BAR(5);
    s16x4 f0lo, f0hi, f1lo, f1hi, f2lo, f2hi, f3lo, f3hi; u32x4 pw0, pw1, pw2, pw3;
#define PKW(P, B) cvtpk_s(P[B], P[B + 1])
#define PAF(k) __builtin_bit_cast(bf16x8, pw##k)
#define PIN(x) asm volatile("" : "+v"(x))
#define EX(v) __builtin_amdgcn_exp2f(v)
#define VOFF(id) ((((id) >> 2) * 4096) + (((id) & 3) * 1024))
#define VRD2(F, id) do { F##lo = vtr(vp_ + VOFF(id)); F##hi = vtr(vp_ + VOFF(id) + 512); } while (0)
#define VFR2(F) (bf16x8){F##lo[0], F##lo[1], F##lo[2], F##lo[3], F##hi[0], F##hi[1], F##hi[2], F##hi[3]}
#define GAPA(MF, A0, A1, A2, A3, W0, W1, PW) do { MF; sacc += A0; sacc += A1; sacc += A2; sacc += A3; PIN(sacc); W0; W1; PIN(PW); SBAR(); } while (0)
#define GAPB(MF, RD, X, B) do { MF; RD; X[B] = EX(X[B]); X[B + 1] = EX(X[B + 1]); PIN(X); SBAR(); } while (0)
#define KRD(G, j) do { if (G) { kload2(kf, kp0 + sl_next, j); SBAR(); } } while (0)
#define MF32(a, b, c) __builtin_amdgcn_mfma_f32_32x32x16_bf16(a, b, c, 0, 0, 0)
#define STEP(C0, C1, P0, P1, t, GK, GV, GL) do { SBAR(); __builtin_amdgcn_s_setprio(ATTN_PRIO_A); \
    const lds_cptr vp_ = vp0 + vs_rd; \
    float sacc = (P0[0] + P0[1]); \
    GAPA(C0 = MF32(kf[0], qr[0], zero16), P0[2], P0[3], P0[4], P0[5],     pw0[0] = PKW(P0, 0), pw0[1] = PKW(P0, 2), pw0); \
    GAPA(C1 = MF32(kf[1], qr[0], zero16), P0[6], P0[7], P0[8], P0[9],     pw0[2] = PKW(P0, 4), pw0[3] = PKW(P0, 6), pw0); \
    GAPA(C0 = MF32(kf[2], qr[1], C0),     P0[10], P0[11], P0[12], P0[13], pw1[0] = PKW(P0, 8), pw1[1] = PKW(P0, 10), pw1); \
    GAPA(C1 = MF32(kf[3], qr[1], C1),     P0[14], P0[15], P1[0], P1[1],   pw1[2] = PKW(P0, 12), pw1[3] = PKW(P0, 14), pw1); \
    VRD2(f0, 0); SBAR();  GAPA(C0 = MF32(kf[4], qr[2], C0), P1[2], P1[3], P1[4], P1[5],     pw2[0] = PKW(P1, 0), pw2[1] = PKW(P1, 2), pw2); \
    VRD2(f1, 4); SBAR();  GAPA(C1 = MF32(kf[5], qr[2], C1), P1[6], P1[7], P1[8], P1[9],     pw2[2] = PKW(P1, 4), pw2[3] = PKW(P1, 6), pw2); \
    VRD2(f2, 8); SBAR();  GAPA(C0 = MF32(kf[6], qr[3], C0), P1[10], P1[11], P1[12], P1[13], pw3[0] = PKW(P1, 8), pw3[1] = PKW(P1, 10), pw3); \
    VRD2(f3, 12); SBAR(); GAPA(C1 = MF32(kf[7], qr[3], C1), P1[14], P1[15], 0.f, 0.f,       pw3[2] = PKW(P1, 12), pw3[3] = PKW(P1, 14), pw3); \
    l_reg += sacc; __builtin_amdgcn_s_setprio(0); \
    if (GK) { DMA_K((t) + 3, sl_cur); } if (GV) { DMA_V((t) + 2, vs_wr); } \
    CMASK(C0, C1, t); \
    SBAR(); __builtin_amdgcn_s_setprio(ATTN_PRIO_B); \
    GAPB(o[0] = MF32(PAF(0), VFR2(f0), o[0]), VRD2(f0, 1),  C0, 0); \
    GAPB(o[1] = MF32(PAF(0), VFR2(f1), o[1]), VRD2(f1, 5),  C0, 2); \
    GAPB(o[2] = MF32(PAF(0), VFR2(f2), o[2]), VRD2(f2, 9),  C0, 4); \
    GAPB(o[3] = MF32(PAF(0), VFR2(f3), o[3]), VRD2(f3, 13), C0, 6); \
    KRD(GL, 0); GAPB(o[0] = MF32(PAF(1), VFR2(f0), o[0]), VRD2(f0, 2),  C0, 8); \
    GAPB(o[1] = MF32(PAF(1), VFR2(f1), o[1]), VRD2(f1, 6),  C0, 10); \
    KRD(GL, 1); GAPB(o[2] = MF32(PAF(1), VFR2(f2), o[2]), VRD2(f2, 10), C0, 12); \
    GAPB(o[3] = MF32(PAF(1), VFR2(f3), o[3]), VRD2(f3, 14), C0, 14); \
    KRD(GL, 2); GAPB(o[0] = MF32(PAF(2), VFR2(f0), o[0]), VRD2(f0, 3),  C1, 0); \
    GAPB(o[1] = MF32(PAF(2), VFR2(f1), o[1]), VRD2(f1, 7),  C1, 2); \
    KRD(GL, 3); GAPB(o[2] = MF32(PAF(2), VFR2(f2), o[2]), VRD2(f2, 11), C1, 4); \
    GAPB(o[3] = MF32(PAF(2), VFR2(f3), o[3]), VRD2(f3, 15), C1, 6); \
    GAPB(o[0] = MF32(PAF(3), VFR2(f0), o[0]), (void)0, C1, 8); \
    GAPB(o[1] = MF32(PAF(3), VFR2(f1), o[1]), (void)0, C1, 10); \
    GAPB(o[2] = MF32(PAF(3), VFR2(f2), o[2]), (void)0, C1, 12); \
    GAPB(o[3] = MF32(PAF(3), VFR2(f3), o[3]), (void)0, C1, 14); __builtin_amdgcn_s_setprio(0); \
    } while (0)
    int t = 1;
#undef CMASK
#define CMASK(P0, P1, t) do {} while (0)
    for (; t + 5 < NT; t += 2) {
        STEP(pB0, pB1, pA0, pA1, t, true, true, true);     WAIT_BAR(5); ROT();
        STEP(pA0, pA1, pB0, pB1, t + 1, true, true, true); WAIT_BAR(5); ROT();
    }
#undef CMASK
#define CMASK(P0, P1, t) do { if (MASK) { int jb_ = (t) - (NT - 4); if (jb_ >= 0) cmask(P0, P1, jb_, wid); } } while (0)
#define ENDW(tt) do { if ((tt) + 3 < NT) { WAIT_BAR(5); } else if ((tt) + 2 < NT) { WAIT_BAR(4); } else { WAIT_BAR(0); } } while (0)
    for (; t + 1 < NT; t += 2) {
        STEP(pB0, pB1, pA0, pA1, t, (t + 3 < NT), (t + 2 < NT), (t + 1 < NT));       ENDW(t);     ROT();
        STEP(pA0, pA1, pB0, pB1, t + 1, (t + 4 < NT), (t + 3 < NT), (t + 2 < NT));   ENDW(t + 1); ROT();
    }
    STEP(pB0, pB1, pA0, pA1, NT - 1, false, false, false);
    { float sacc = pB0[0] + pB0[1]; _Pragma("unroll") for (int r = 2; r < 16; ++r) sacc += pB0[r]; _Pragma("unroll") for (int r = 0; r < 16; ++r) sacc += pB1[r]; l_reg += sacc;
      pw0 = (u32x4){PKW(pB0, 0), PKW(pB0, 2), PKW(pB0, 4), PKW(pB0, 6)}; pw1 = (u32x4){PKW(pB0, 8), PKW(pB0, 10), PKW(pB0, 12), PKW(pB0, 14)}; pw2 = (u32x4){PKW(pB1, 0), PKW(pB1, 2), PKW(pB1, 4), PKW(pB1, 6)}; pw3 = (u32x4){PKW(pB1, 8), PKW(pB1, 10), PKW(pB1, 12), PKW(pB1, 14)};
      SBAR();
      const lds_cptr vp_ = vp0 + ((vs_rd + 16384) & 65535);
#pragma unroll
      for (int db = 0; db < 4; ++db) { VRD2(f0, db * 4 + 0); VRD2(f1, db * 4 + 1); VRD2(f2, db * 4 + 2); VRD2(f3, db * 4 + 3);
          o[db] = MF32(PAF(0), VFR2(f0), o[db]); o[db] = MF32(PAF(1), VFR2(f1), o[db]); o[db] = MF32(PAF(2), VFR2(f2), o[db]); o[db] = MF32(PAF(3), VFR2(f3), o[db]); } }
#undef PKW
#undef PAF
#undef PIN
#undef EX
#undef VOFF
#undef VRD2
#undef VFR2
#undef GAPA
#undef GAPB
#undef KRD
#undef MF32
#undef STEP
#undef ENDW
    { auto rr = __builtin_amdgcn_permlane32_swap(__float_as_uint(l_reg), __float_as_uint(l_reg), false, false); l_reg = __uint_as_float(rr[0]) + __uint_as_float(rr[1]); }
    if (hi == 0) wsf[32 + r32] = l_reg; asm volatile("s_waitcnt lgkmcnt(0)" ::: "memory");
    float rli[16];
#pragma unroll
    for (int r = 0; r < 16; ++r) rli[r] = __builtin_amdgcn_rcpf(wsf[32 + crow(r, hi)]);
    bf16* Ow = Oh + (long)(q0 + wid * QBLK) * op;
    { bf16* stg = (bf16*)(shm + L2_OST) + wid * 2048;
#pragma unroll
      for (int dh = 0; dh < 2; ++dh) {
#pragma unroll
        for (int r = 0; r < 16; ++r) { const int orow = crow(r, hi);
#pragma unroll
          for (int d0 = 0; d0 < 2; ++d0) stg[orow * 64 + d0 * 32 + r32] = __float2bfloat16(o[dh * 2 + d0][r] * rli[r]); }
        asm volatile("s_waitcnt lgkmcnt(0)" ::: "memory");
#pragma unroll
        for (int i = 0; i < 4; ++i) { const int row = i * 8 + (lane >> 3), ch = lane & 7; const u32x4 v = *(const u32x4*)(stg + row * 64 + ch * 8); *(u32x4*)(Ow + (long)row * op + dh * 64 + ch * 8) = v; }
        asm volatile("s_waitcnt lgkmcnt(0)" ::: "memory"); } }
    asm volatile("s_waitcnt lgkmcnt(0)\n\ts_barrier" ::: "memory");
#undef DMA_K
#undef DMA_V
#undef CMASK
#undef ROT
}
#undef SBAR
#undef WAIT_BAR
}

#define XB_TMO      128
#define XB_XCNT(j)  (256  + 64 * (j))
#define XB_XSUB(j)  (1280 + 64 * (j))
#define XB_XGEN(j)  (2304 + 64 * (j))
#define XB_TOP      3328
#define XB_TOPGEN   3392
#define XCD_BAR_WORDS 3456
#define XB_SPIN_CAP (1u << 22)
__device__ __forceinline__ unsigned xb_ld(unsigned* p)              { return __hip_atomic_load(p, __ATOMIC_RELAXED, __HIP_MEMORY_SCOPE_AGENT); }
__device__ __forceinline__ unsigned xb_add(unsigned* p, unsigned v) { return __hip_atomic_fetch_add(p, v, __ATOMIC_RELAXED, __HIP_MEMORY_SCOPE_AGENT); }
__device__ __forceinline__ unsigned xb_xcc_id() { return (unsigned)__builtin_amdgcn_s_getreg((3 << 11) | 20) & 0xFu; }
#define XB_SPIN(cond, bar) do { unsigned _sp = 0; while (cond) { __builtin_amdgcn_s_sleep(1); \
    if ((++_sp & 255u) == 0u) { if (xb_ld(&(bar)[XB_TMO])) break; if (_sp > XB_SPIN_CAP) { atomicAdd(&(bar)[XB_TMO], 1u); break; } } } } while (0)
struct XcdBarrier { unsigned* bar; unsigned x; volatile LAS unsigned* st; };
__device__ __forceinline__ XcdBarrier xcd_barrier_post(unsigned* bar, volatile LAS unsigned* st) {
    XcdBarrier b; b.bar = bar; b.x = xb_xcc_id(); b.st = st;
    if (threadIdx.x == 0) (void)xb_add(&bar[XB_XCNT(b.x)], 1u);
    return b;
}
__device__ __forceinline__ void xcd_barrier_complete(unsigned* bar, unsigned x, unsigned& nloc, unsigned& nx) {
    const unsigned G = gridDim.x * gridDim.y * gridDim.z;
    unsigned sum, cnt, mine, sp = 0u;
    for (;;) {
        sum = 0u; cnt = 0u; mine = 0u;
#pragma unroll
        for (unsigned j = 0; j < 16; ++j) { const unsigned c = xb_ld(&bar[XB_XCNT(j)]); sum += c; cnt += (c > 0u) ? 1u : 0u; mine = (j == x) ? c : mine; }
        if (sum == G) break;
        __builtin_amdgcn_s_sleep(1);
        if ((++sp & 255u) == 0u) { if (xb_ld(&bar[XB_TMO])) break; if (sp > XB_SPIN_CAP) { atomicAdd(&bar[XB_TMO], 1u); break; } }
    }
    nloc = mine > 0u ? mine : 1u; nx = cnt > 0u ? cnt : 1u;
}
__device__ __forceinline__ void xcd_barrier(const XcdBarrier& b) {
    asm volatile("s_waitcnt vmcnt(0)" ::: "memory");
    __syncthreads();
    if (threadIdx.x == 0) {
        unsigned* bar = b.bar;
        __builtin_amdgcn_s_waitcnt(0);
        unsigned nloc = b.st[0], nx = b.st[1];
        if (nloc == 0u) { xcd_barrier_complete(bar, b.x, nloc, nx); b.st[0] = nloc; b.st[1] = nx; }
        const unsigned old = xb_add(&bar[XB_XSUB(b.x)], 1u);
        const unsigned gen = old / nloc;
        if (old + 1u == (gen + 1u) * nloc) {
            __builtin_amdgcn_fence(__ATOMIC_RELEASE, "agent");
            asm volatile("s_waitcnt vmcnt(0)" ::: "memory");
            const unsigned og = xb_add(&bar[XB_TOP], 1u);
            const unsigned tg = og / nx;
            if (og + 1u == (tg + 1u) * nx) xb_add(&bar[XB_TOPGEN], 1u);
            else XB_SPIN(xb_ld(&bar[XB_TOPGEN]) == tg, bar);
            __builtin_amdgcn_fence(__ATOMIC_ACQUIRE, "agent");
            xb_add(&bar[XB_XGEN(b.x)], 1u);
            asm volatile("s_waitcnt vmcnt(0)" ::: "memory");
        } else {
            XB_SPIN(xb_ld(&bar[XB_XGEN(b.x)]) == gen, bar);
            __builtin_amdgcn_fence(__ATOMIC_ACQUIRE, "agent");
            asm volatile("s_waitcnt vmcnt(0)" ::: "memory");
        }
    }
    __syncthreads();
}

constexpr int RING_BYTES = 131072;
constexpr int MISC_OFF = RING_BYTES;
constexpr int LDS_BYTES = 147456;
constexpr int NWAVES = 8;

struct Args {
    const float* in[29]; float* out; unsigned char* ws; int ph_lo, ph_hi;
};
enum { I_X = 0, I_MEM, I_NORM1, I_WIN, I_BGATE, I_QN, I_KN, I_LQ1, I_LK1, I_LQ2, I_LK2, I_SUBLN, I_WPOOL, I_PSCALE, I_MEMNORM, I_WMKV, I_MQN, I_MKN, I_WBRD, I_WBRP, I_WBRM, I_WOUT, I_NORM2,
       I_WROUTER, I_BROUTER, I_WGU, I_BGU, I_WD, I_BD };

__device__ __forceinline__ unsigned f2bf(float f) { unsigned u = __builtin_bit_cast(unsigned, f); return (u + 0x7fffu + ((u >> 16) & 1u)) >> 16; }
__device__ __forceinline__ unsigned pk2(float lo, float hi) { return f2bf(lo) | (f2bf(hi) << 16); }
__device__ __forceinline__ void p0_transpose_item(const float* W, int K, int N, bf16_t* WT, LAS float* scr, int item, int lane, int ldo = 0) {
    if (ldo == 0) ldo = K;
    const int nblk = N / 64, kb = item / nblk, nb = item % nblk, k0 = 64 * kb, n0 = 64 * nb;
    const int kr = lane >> 3, n4 = (lane & 7) * 4;
    f32x4 v[16];
#pragma unroll
    for (int i = 0; i < 16; ++i) v[i] = *(const f32x4*)(W + (size_t)(k0 + 8 * (i & 7) + kr) * N + n0 + 32 * (i >> 3) + n4);
#pragma unroll
    for (int h = 0; h < 2; ++h) {
#pragma unroll
        for (int i = 0; i < 8; ++i)
#pragma unroll
            for (int j = 0; j < 4; ++j) scr[(n4 + j) * 68 + 8 * i + kr] = v[h * 8 + i][j];
        LDS_WAIT(); asm volatile("" ::: "memory");
        const int c = lane & 7;
#pragma unroll
        for (int jj = 0; jj < 4; ++jj) { const int nrow = 8 * jj + (lane >> 3); const LAS f32x4* sp = (const LAS f32x4*)(scr + nrow * 68 + 8 * c);
            const f32x4 a = sp[0], b = sp[1];
            u32x4 o; o.x = pk2(a[0], a[1]); o.y = pk2(a[2], a[3]); o.z = pk2(b[0], b[1]); o.w = pk2(b[2], b[3]);
            *(u32x4*)(WT + (size_t)(n0 + 32 * h + nrow) * ldo + k0 + 8 * c) = o; }
        LDS_WAIT(); asm volatile("" ::: "memory");
    }
}
__device__ __forceinline__ void p0_transpose_item_f8(const float* W, int K, int N, unsigned char* WT, LAS float* scr, int item, int lane) {
    const int nblk = N / 64, kb = item / nblk, nb = item % nblk, k0 = 64 * kb, n0 = 64 * nb;
    const int kr = lane >> 3, n4 = (lane & 7) * 4;
    f32x4 v[16];
#pragma unroll
    for (int i = 0; i < 16; ++i) v[i] = *(const f32x4*)(W + (size_t)(k0 + 8 * (i & 7) + kr) * N + n0 + 32 * (i >> 3) + n4);
#pragma unroll
    for (int h = 0; h < 2; ++h) {
#pragma unroll
        for (int i = 0; i < 8; ++i)
#pragma unroll
            for (int j = 0; j < 4; ++j) scr[(n4 + j) * 68 + 8 * i + kr] = v[h * 8 + i][j];
        LDS_WAIT(); asm volatile("" ::: "memory");
        const int c = lane & 7;
#pragma unroll
        for (int jj = 0; jj < 4; ++jj) { const int nrow = 8 * jj + (lane >> 3); const LAS f32x4* sp = (const LAS f32x4*)(scr + nrow * 68 + 8 * c);
            const f32x4 a = sp[0] * W8_SCALE, b = sp[1] * W8_SCALE;
            u32x2 o; o.x = pk4_fp8(a[0], a[1], a[2], a[3]); o.y = pk4_fp8(b[0], b[1], b[2], b[3]);
            *(u32x2*)(WT + (size_t)(n0 + 32 * h + nrow) * K + k0 + 8 * c) = o; }
        LDS_WAIT(); asm volatile("" ::: "memory");
    }
}
__device__ __forceinline__ void rms_row_to_bf16(const float* xrow, const float* gain, bf16_t* orow, int lane) {
    const f32x4* xr = (const f32x4*)xrow + lane; const f32x4* gr = (const f32x4*)gain + lane;
    f32x4 v[4]; float s = 0.f;
#pragma unroll
    for (int j = 0; j < 4; ++j) { v[j] = xr[64 * j]; s += (v[j].x * v[j].x + v[j].y * v[j].y) + (v[j].z * v[j].z + v[j].w * v[j].w); }
    const float rstd = 1.f / sqrtf(wave_sum(s) * (1.f / 1024.f) + RMS_EPS);
    u32x2* o8 = (u32x2*)orow + lane;
#pragma unroll
    for (int j = 0; j < 4; ++j) { const f32x4 g = gr[64 * j]; u32x2 w; w.x = pk2(v[j].x * rstd * g.x, v[j].y * rstd * g.y); w.y = pk2(v[j].z * rstd * g.z, v[j].w * rstd * g.w); o8[64 * j] = w; }
}

__device__ __forceinline__ void cvt_item64_f8(const float* W, int K, int N, unsigned char* WT, int item, int lane) {
    const int nblk = N / 64, kb = item / nblk, nb = item % nblk, k0 = 64 * kb, n0 = 64 * nb;
    const char* base = (const char*)(W + (size_t)k0 * N + n0);
    unsigned off = (unsigned)lane * 4u; const unsigned rstep = (unsigned)N * 4u;
    float v[64];
#pragma unroll
    for (int j = 0; j < 64; ++j) { v[j] = __builtin_nontemporal_load((const float*)(base + off)); off += rstep; }
    unsigned char* dst = WT + (size_t)(n0 + lane) * K + k0;
#pragma unroll
    for (int c = 0; c < 4; ++c) { u32x4 o;
#pragma unroll
        for (int q = 0; q < 4; ++q) { int r = __builtin_amdgcn_cvt_pk_fp8_f32(v[16 * c + 4 * q] * W8_SCALE, v[16 * c + 4 * q + 1] * W8_SCALE, 0, false);
            r = __builtin_amdgcn_cvt_pk_fp8_f32(v[16 * c + 4 * q + 2] * W8_SCALE, v[16 * c + 4 * q + 3] * W8_SCALE, r, true); o[q] = (unsigned)r; }
        *(u32x4*)(dst + 16 * c) = o; }
}
struct CvtJob {
    const float* wgu; const float* wd; unsigned char* wgu_t; unsigned char* wd_t; int ngw, gw, lane;
    __device__ __forceinline__ void item(int j) const {
        const int it = gw + j * ngw; if (it >= 24576) return;
        const bool gu = it < 16384; const int r = gu ? it : it - 16384, e = gu ? (r >> 9) : (r >> 8), idx = gu ? (r & 511) : (r & 255), N = gu ? 2048 : 1024;
        const float* W = gu ? wgu + (size_t)e * 1024 * 2048 : wd + (size_t)e * 1024 * 1024; unsigned char* WT = gu ? wgu_t + (size_t)e * 2048 * 1024 : wd_t + (size_t)e * 1024 * 1024;
        cvt_item64_f8(W, 1024, N, WT, idx, lane);
    }
};
struct PostCvt { CvtJob J; int jbase, jend; __device__ __forceinline__ void operator()(int ui) const { const int j = jbase + ui; if (j < jend) J.item(j); } };
struct Args;
typedef __attribute__((address_space(4))) const Args* kargs_t;
__device__ __forceinline__ kargs_t kargs() { kargs_t p = (kargs_t)__builtin_amdgcn_kernarg_segment_ptr(); asm volatile("" : "+s"(p)); return p; }
__global__ void __launch_bounds__(NWAVES * 64, 2) fwd_kernel(Args args) {
    extern __shared__ __attribute__((aligned(16))) unsigned char lds_raw[];
    cg::grid_group grid = cg::this_grid();
    LAS unsigned char* lds = (LAS unsigned char*)lds_raw;
    const int tid = threadIdx.x, lane = tid & 63, wave = __builtin_amdgcn_readfirstlane(tid >> 6);
    const int G = gridDim.x, bx = blockIdx.x; const int vcu = (G % 8 == 0) ? (bx % 8) * (G / 8) + bx / 8 : bx;
    const int gw = vcu * NWAVES + wave, NGW = G * NWAVES;
    const int lo = args.ph_lo, hi = args.ph_hi;
    if (tid < 64) ((LAS unsigned*)(lds + MISC_OFF + 1024))[tid] = 0u;
    __syncthreads();
    const XcdBarrier xbar = xcd_barrier_post((unsigned*)(args.ws + WS_CTL) + CW_BAR, (volatile LAS unsigned*)(lds + MISC_OFF + 1024));
#ifndef PHMASK
#define PHMASK 0x3ff
#endif
#define IN(k) (((PHMASK >> (k)) & 1) && lo <= (k) && (k) < hi)
#define GSYNC() do { asm volatile("s_waitcnt vmcnt(0) lgkmcnt(0)" ::: "memory"); __syncthreads(); grid.sync(); asm volatile("s_waitcnt vmcnt(0)" ::: "memory"); __syncthreads(); } while (0)
#define SEAM(k) do { if (lo <= (k) && (k) + 1 < hi) { xcd_barrier(xbar); } } while (0)
#define WSP(TY, off) ((TY*)(ka->ws + (off)))
#define WIN_T WSP(bf16_t, WS_WIN_T)
#define WBRD_T WSP(bf16_t, WS_WBRD_T)
#define WBRP_T WSP(bf16_t, WS_WBRP_T)
#define WBRM_T WSP(bf16_t, WS_WBRM_T)
#define WOUT_T WSP(bf16_t, WS_WOUT_T)
#define WMKV_T WSP(bf16_t, WS_WMKV_T)
#define WGU_T WSP(bf16_t, WS_WGU_T)
#define WD_T WSP(bf16_t, WS_WD_T)
#define XN WSP(bf16_t, WS_XN)
#define Qb WSP(bf16_t, WS_Q)
#define Kb WSP(bf16_t, WS_K)
#define Vb WSP(bf16_t, WS_V)
#define Ub WSP(bf16_t, WS_U)
#define MQb WSP(bf16_t, WS_MQ)
#define OC WSP(bf16_t, WS_OC)
#define GATES WSP(bf16_t, WS_GATES)
#define YCAT WSP(bf16_t, WS_YCAT)
#define MERGF WSP(float, WS_MERGF)
#define MERGB WSP(bf16_t, WS_MERGB)
#define XG WSP(bf16_t, WS_XG)
#define ACT WSP(bf16_t, WS_A)
#define Y4 WSP(bf16_t, WS_B)
#define MEMN WSP(bf16_t, WS_MEMN)
#define MKV WSP(bf16_t, WS_MKV)
#define ROPE WSP(f32x2, WS_ROPE)
#define WR2 WSP(float, WS_WR2)
#define ROUTEW WSP(float, WS_ROUTEW)
#define LAMP WSP(float, WS_LAM)
#define LIST WSP(u32x2, WS_LIST)
#define CNT WSP(unsigned, WS_CTL)
#define OUT (ka->out)
#define KA const kargs_t ka = kargs()

    if (lo > 1000) GSYNC();
    if (IN(0)) for (int rep_ = 0; rep_ < 1 + ((REPEAT_MASK >> 0) & 1); ++rep_) { KA; if (rep_) __syncthreads();
        LAS float* scr = (LAS float*)(lds + wave * 16384);
        constexpr int I0 = 16 * 80, I1 = 8 * 16, I2 = 4 * 16, I3 = 4 * 16, I4 = 16 * 16, I5 = 16 * 8, I6 = 0, I7 = 0;
        constexpr int NITEMS = I0 + I1 + I2 + I3 + I4 + I5 + I6 + I7;
        for (int it = gw; it < NITEMS; it += NGW) {
            int r = it;
            if (r < I0) { p0_transpose_item(ka->in[I_WIN], 1024, 5120, WIN_T, scr, r, lane); continue; } r -= I0;
            if (r < I1) { p0_transpose_item(ka->in[I_WBRD], 512, 1024, WBRD_T, scr, r, lane, 1024); continue; } r -= I1;
            if (r < I2) { p0_transpose_item(ka->in[I_WBRP], 256, 1024, WBRD_T + 512, scr, r, lane, 1024); continue; } r -= I2;
            if (r < I3) { p0_transpose_item(ka->in[I_WBRM], 256, 1024, WBRD_T + 768, scr, r, lane, 1024); continue; } r -= I3;
            if (r < I4) { p0_transpose_item(ka->in[I_WOUT], 1024, 1024, WOUT_T, scr, r, lane); continue; } r -= I4;
            p0_transpose_item(ka->in[I_WMKV], 1024, 512, WMKV_T, scr, r, lane);
        }
        for (int m = gw; m < T; m += NGW) rms_row_to_bf16(ka->in[I_X] + (size_t)m * 1024, ka->in[I_NORM1], XN + (size_t)m * 1024, lane);
        for (int m = gw; m < BATCH * MEMLEN; m += NGW) rms_row_to_bf16(ka->in[I_MEM] + (size_t)m * 1024, ka->in[I_MEMNORM], MEMN + (size_t)m * 1024, lane);
        for (int i = bx * 512 + tid; i < SEQ * 32; i += G * 512) { const int pos = i >> 5, j = i & 31;
            const float inv = 1.0f / powf(10000.0f, (float)(2 * j) / 64.0f); const float ang = (float)pos * inv;
            const double a = (double)ang; const double k = rint(a * 0.15915494309189535); const float red = (float)(a - k * 6.283185307179586);
            ROPE[i] = (f32x2){cosf(red), sinf(red)}; }
        for (int i = bx * 512 + tid; i < 1024 * 32; i += G * 512) { const int ii = i & 3, e = (i >> 2) & 15, kq = (i >> 6) & 3, eb = (i >> 8) & 1, s = i >> 9; const int k = 16 * s + 4 * kq + ii;
            WR2[i] = ka->in[I_NORM2][k] * ka->in[I_WROUTER][k * 32 + eb * 16 + e]; }
        if (bx == 0 && wave == 0) { const float s1 = wave_sum(ka->in[I_LQ1][lane] * ka->in[I_LK1][lane]), s2 = wave_sum(ka->in[I_LQ2][lane] * ka->in[I_LK2][lane]);
            if (lane == 0) LAMP[0] = expf(s1) - expf(s2) + 0.2f; }
    }
    SEAM(0);
    if (IN(1)) for (int rep_ = 0; rep_ < 1 + ((REPEAT_MASK >> 1) & 1); ++rep_) { KA; if (rep_) __syncthreads();
#if defined(TAP) && TAP == 6
        { pg8::DenseProb P{XN, WIN_T, 1024, 1024, 1024}; pg8::StaticOrder S; S.init(T, INW, G, bx);
          pg8::EpiPlain E{WSP(bf16_t, WS_B), 5120};
          pg8::gemm_phase<pg8::EpiPlain, pg8::DenseProb, pg8::StaticOrder, true>(lds, P, S, E); }
#else
        const CvtJob J{ka->in[I_WGU], ka->in[I_WD], (unsigned char*)WGU_T, (unsigned char*)WD_T, NGW, gw, lane};
        const int kpre = bx & 7;
        for (int j = 0; j < kpre; ++j) J.item(j);
        { pg8::DenseProb P{XN, WIN_T, 1024, 1024, 1024}; pg8::StaticOrder S0; S0.init(T, INW, G, bx); const pg8::TableOrder S = pg8::build_unit_table(S0, (LAS int*)(lds + MISC_OFF + 2048));
          pg8::EpiInProj E{Qb, Kb, Vb, Ub, MQb, GATES, ka->in[I_QN], ka->in[I_KN], ka->in[I_MQN], ka->in[I_BGATE], ROPE};
          const PostCvt PU{J, kpre, 12};
          pg8::gemm_phase<pg8::EpiInProj, pg8::DenseProb, pg8::TableOrder, ALIGN_EPI_SEL, PostCvt>(lds, P, S, E, PU); }
        for (int j = kpre + 10; j < 12; ++j) J.item(j);
#endif
        { pg8::DenseProb P{MEMN, WMKV_T, 1024, 1024, 1024}; pg8::StaticOrder S; S.init(BATCH * MEMLEN, 512, G, bx);
          pg8::EpiMemKV E{MKV, ka->in[I_MKN]};
          pg8::gemm_phase<pg8::EpiMemKV, pg8::DenseProb, pg8::StaticOrder, true>(lds, P, S, E); }
    }
    SEAM(1);
    if (IN(2)) for (int rep_ = 0; rep_ < 1 + ((REPEAT_MASK >> 2) & 1); ++rep_) { KA; if (rep_) __syncthreads();
        using abf = attn_body::bf16;
        {
            const int bh = vcu >> 4, b = bh >> 2, h = bh & 3, s = vcu & 15; const size_t rb = (size_t)b * SEQ;
            const float lam = LAMP[0];
            for (int i2 = 0; i2 < 4 * (1 + ((REPEAT_MASK >> 10) & 1)); ++i2) { const int ii = i2 & 3, c = ii & 1; const int qb = (ii < 2) ? s : 31 - s;
                attn_body::attn_unit2<true>(qb * 256, 4 * qb + 4, (const abf*)Qb + rb * 512 + (c * 4 + h) * 64, 512, (const abf*)Kb + rb * 512 + (c * 4 + h) * 64, 512,
                                            (const abf*)Vb + rb * 512 + h * 128, 512, (abf*)OC + rb * 1024 + (c * 4 + h) * 128, 1024, (char*)lds_raw);
                if (c == 1) {
                    asm volatile("s_waitcnt vmcnt(0)" ::: "memory");
#pragma unroll 1
                    for (int ps = 0; ps < 2; ++ps) {
                    const int row = ps * 16 + (lane >> 2), dq = (lane & 3) * 32; const size_t t = rb + (size_t)qb * 256 + wave * 32 + row;
                    const bf16_t* p0 = OC + t * 1024 + h * 128 + dq; const bf16_t* p1 = p0 + 512;
                    u32x4 a[4], bb[4];
#pragma unroll
                    for (int j = 0; j < 4; ++j) { a[j] = *(const u32x4*)(p0 + 8 * j); bb[j] = *(const u32x4*)(p1 + 8 * j); }
                    float ss = 0.f; f32x4 y[4][2];
#pragma unroll
                    for (int j = 0; j < 4; ++j) {
                        y[j][0] = (f32x4){bf_lo(a[j].x) - lam * bf_lo(bb[j].x), bf_hi(a[j].x) - lam * bf_hi(bb[j].x), bf_lo(a[j].y) - lam * bf_lo(bb[j].y), bf_hi(a[j].y) - lam * bf_hi(bb[j].y)};
                        y[j][1] = (f32x4){bf_lo(a[j].z) - lam * bf_lo(bb[j].z), bf_hi(a[j].z) - lam * bf_hi(bb[j].z), bf_lo(a[j].w) - lam * bf_lo(bb[j].w), bf_hi(a[j].w) - lam * bf_hi(bb[j].w)};
#pragma unroll
                        for (int q = 0; q < 4; ++q) ss += y[j][0][q] * y[j][0][q] + y[j][1][q] * y[j][1][q]; }
                    ss += __shfl_xor(ss, 1); ss += __shfl_xor(ss, 2);
                    const float rstd = 0.8f / sqrtf(ss * (1.0f / 128.0f) + RMS_EPS);
                    const float* sg = ka->in[I_SUBLN] + dq; bf16_t* yo = YCAT + t * 1024 + h * 128 + dq;
#pragma unroll
                    for (int j = 0; j < 4; ++j) { const f32x4 s0 = *(const f32x4*)(sg + 8 * j), s1 = *(const f32x4*)(sg + 8 * j + 4); pg8::store8(yo + 8 * j, y[j][0] * rstd * s0, y[j][1] * rstd * s1); }
                    }
                }
            }
        }
        {
            for (int i = 0; i < 2; ++i) { const int idx = vcu * 2 + i; if (idx >= 512) break; const int b = idx >> 7, h = (idx >> 5) & 3, qb = idx & 31;
                attn_body::attn_unit<8, false>(qb * 256, 4, (const abf*)MQb + (size_t)b * SEQ * 256 + h * 64, 256, (const abf*)MKV + (size_t)b * MEMLEN * 512 + h * 64, 512,
                                               (const abf*)MKV + (size_t)b * MEMLEN * 512 + 256 + h * 64, 512, (abf*)YCAT + (size_t)b * SEQ * 1024 + 768 + h * 64, 1024, (char*)lds_raw); }
        }
        {
            LAS bf16_t* ul = (LAS bf16_t*)lds;
            LAS bf16_t* pb = (LAS bf16_t*)(lds + 24576);
            const int col = tid & 255, half = tid >> 8, w = 2 << (col >> 6);
            const int mg = wave & 3, mdh = wave >> 2, r32 = lane & 31, hh = lane >> 5;
            bf16x8 bw[4];
#pragma unroll
            for (int sx = 0; sx < 4; ++sx) { const float* wp = ka->in[I_WPOOL] + (size_t)(mg * 64 + 16 * sx + 8 * hh) * 64 + mdh * 32 + r32;
                u32x4 pk; pk.x = pk2(wp[0], wp[64]); pk.y = pk2(wp[128], wp[192]); pk.z = pk2(wp[256], wp[320]); pk.w = pk2(wp[384], wp[448]); bw[sx] = __builtin_bit_cast(bf16x8, pk); }
            const int ocol = mg * 64 + mdh * 32 + r32; const float psc = ka->in[I_PSCALE][ocol];
            for (int tile = vcu; tile < T / 32; tile += G) {
                const int t0 = tile * 32, p0 = t0 & (SEQ - 1);
                __syncthreads();
                for (int pc = tid; pc < 47 * 32; pc += 512) { const int r = pc >> 5, ch = pc & 31; const int pos = p0 - 15 + r;
                    u32x4 v = {0u, 0u, 0u, 0u}; if (pos >= 0) v = *(const u32x4*)(Ub + (size_t)(t0 - 15 + r) * 256 + ch * 8);
                    *(LAS u32x4*)(ul + r * 256 + ch * 8) = v; }
                __syncthreads();
                {
                    float sum = 0.f; const int rbase = 15 + 16 * half;
                    for (int i = 1; i < w; ++i) sum += __uint_as_float((unsigned)ul[(rbase - i) * 256 + col] << 16);
#pragma unroll
                    for (int tk = 0; tk < 16; ++tk) { const float ucur = __uint_as_float((unsigned)ul[(rbase + tk) * 256 + col] << 16); sum += ucur;
                        const int pos = p0 + 16 * half + tk; const float cnt = (float)((pos + 1 < w) ? pos + 1 : w);
                        pb[(16 * half + tk) * 264 + col] = (bf16_t)f2bf(sum / cnt - ucur);
                        sum -= __uint_as_float((unsigned)ul[(rbase + tk - (w - 1)) * 256 + col] << 16); }
                }
                __syncthreads();
                f32x16 acc = f32x16{};
#pragma unroll
                for (int sx = 0; sx < 4; ++sx) { const bf16x8 af = *(const LAS bf16x8*)(pb + r32 * 264 + mg * 64 + 16 * sx + 8 * hh);
                    acc = __builtin_amdgcn_mfma_f32_32x32x16_bf16(af, bw[sx], acc, 0, 0, 0); }
#pragma unroll
                for (int r = 0; r < 16; ++r) { const int tok = t0 + (r & 3) + 8 * (r >> 2) + 4 * hh; YCAT[(size_t)tok * 1024 + 512 + ocol] = (bf16_t)f2bf(acc[r] * psc); }
            }
            __syncthreads();
        }
    }
    SEAM(2);
    if (IN(4)) for (int rep_ = 0; rep_ < 1 + ((REPEAT_MASK >> 4) & 1); ++rep_) { KA; if (rep_) __syncthreads();
        pg8::StaticOrder S0; S0.init(T, 1024, G, bx); const pg8::TableOrder S = pg8::build_unit_table(S0, (LAS int*)(lds + MISC_OFF + 2048));
        pg8::DenseProb P{YCAT, WBRD_T, 1024, 1024, 1024}; pg8::EpiMergeR E{GATES, MERGB};
        pg8::gemm_phase<pg8::EpiMergeR, pg8::DenseProb, pg8::TableOrder, ALIGN_EPI_SEL>(lds, P, S, E);
    }
    SEAM(4);
    if (IN(5)) for (int rep_ = 0; rep_ < 1 + ((REPEAT_MASK >> 5) & 1); ++rep_) { KA; if (rep_) __syncthreads();
        pg8::DenseProb P{MERGB, WOUT_T, 1024, 1024, 1024}; pg8::StaticOrder S0; S0.init(T, 1024, G, bx); const pg8::TableOrder S = pg8::build_unit_table(S0, (LAS int*)(lds + MISC_OFF + 2048));
        pg8::EpiWout E{ka->in[I_X], OUT, (unsigned char*)XG, ka->in[I_NORM2]};
        pg8::gemm_phase<pg8::EpiWout, pg8::DenseProb, pg8::TableOrder, ALIGN_EPI_SEL>(lds, P, S, E);
    }
    SEAM(5);
    if (IN(6)) { KA;
        LAS int* lcnt = (LAS int*)(lds + MISC_OFF); LAS int* lbase = lcnt + 32;
        const int ngroups = T / 16, rounds = (ngroups + NGW - 1) / NGW;
        for (int rd = 0; rd < rounds; ++rd) {
            const int grp = rd * NGW + gw; const bool valid = grp < ngroups;
            if (tid < 32) lcnt[tid] = 0;
            __syncthreads();
            int e_sel = 0, rank = 0; float w_sel = 0.f, rstd = 0.f; const int q = lane >> 4, tok = grp * 16 + (lane & 15);
            if (valid) {
                f32x4 d0 = {0.f, 0.f, 0.f, 0.f}, d1 = {0.f, 0.f, 0.f, 0.f}; float ss = 0.f;
                const float* xrow = OUT + (size_t)tok * 1024 + 4 * q; const f32x4* wr2 = (const f32x4*)WR2 + lane;
#pragma unroll 4
                for (int s = 0; s < 64; ++s) { const f32x4 xv = *(const f32x4*)(xrow + 16 * s); const f32x4 wa = wr2[(s * 2) * 64], wb = wr2[(s * 2 + 1) * 64];
                    ss += (xv[0] * xv[0] + xv[1] * xv[1]) + (xv[2] * xv[2] + xv[3] * xv[3]);
#pragma unroll
                    for (int j = 0; j < 4; ++j) { d0 = __builtin_amdgcn_mfma_f32_16x16x4f32(wa[j], xv[j], d0, 0, 0, 0); d1 = __builtin_amdgcn_mfma_f32_16x16x4f32(wb[j], xv[j], d1, 0, 0, 0); } }
                ss += __shfl_xor(ss, 16); ss += __shfl_xor(ss, 32);
                rstd = 1.0f / sqrtf(ss * (1.0f / 1024.f) + RMS_EPS);
                unsigned key[8];
#pragma unroll
                for (int r = 0; r < 8; ++r) { const int e = (r >> 2) * 16 + 4 * q + (r & 3); const float lg = ((r < 4) ? d0[r & 3] : d1[r & 3]) * rstd + ka->in[I_BROUTER][e];
                    unsigned u = __float_as_uint(lg); u ^= (u >> 31) ? 0xffffffffu : 0x80000000u; key[r] = (u & ~31u) | (unsigned)(31 - e); }
                unsigned win[4];
#pragma unroll
                for (int r = 0; r < 4; ++r) { unsigned m = key[0];
#pragma unroll
                    for (int j = 1; j < 8; ++j) m = m > key[j] ? m : key[j];
                    unsigned o = (unsigned)__shfl_xor((int)m, 16); m = m > o ? m : o; o = (unsigned)__shfl_xor((int)m, 32); m = m > o ? m : o; win[r] = m;
#pragma unroll
                    for (int j = 0; j < 8; ++j) key[j] = (key[j] == m) ? 0u : key[j]; }
                float val[4];
#pragma unroll
                for (int r = 0; r < 4; ++r) { unsigned u = win[r] & ~31u; u ^= (u >> 31) ? 0x80000000u : 0xffffffffu; val[r] = __uint_as_float(u); }
                const float p1 = expf(val[1] - val[0]), p2 = expf(val[2] - val[0]), p3 = expf(val[3] - val[0]); const float inv = 1.0f / (1.0f + p1 + p2 + p3);
                const unsigned wk = (q == 0) ? win[0] : (q == 1) ? win[1] : (q == 2) ? win[2] : win[3];
                w_sel = ((q == 0) ? 1.0f : (q == 1) ? p1 : (q == 2) ? p2 : p3) * inv; e_sel = 31 - (int)(wk & 31u);
                rank = __hip_atomic_fetch_add((int*)(lcnt + e_sel), 1, __ATOMIC_RELAXED, __HIP_MEMORY_SCOPE_WORKGROUP);
            }
            __syncthreads();
            if (tid < 32) lbase[tid] = (int)__hip_atomic_fetch_add(CNT + 64 * tid, (unsigned)lcnt[tid], __ATOMIC_RELAXED, __HIP_MEMORY_SCOPE_AGENT);
            __syncthreads();
            if (valid) { const int pos = lbase[e_sel] + rank; LIST[(size_t)e_sel * CAP + pos] = (u32x2){(unsigned)(tok * 4 + q), __float_as_uint(rstd)}; ROUTEW[tok * 4 + q] = w_sel; }
            __syncthreads();
        }
    }
    SEAM(6);
    if (IN(7) || IN(8)) { KA;
        LAS int* tp = (LAS int*)(lds + MISC_OFF + 256); LAS int* cn = tp + 40;
        if (tid == 0) { int acc = 0; for (int e = 0; e < NEXP; ++e) { const int c = (int)__hip_atomic_load(CNT + 64 * e, __ATOMIC_RELAXED, __HIP_MEMORY_SCOPE_AGENT); cn[e] = c; tp[e] = acc; acc += (c + 255) >> 8; } tp[NEXP] = acc; }
        __syncthreads();
        if (IN(7)) for (int rep_ = 0; rep_ < 1 + ((REPEAT_MASK >> 7) & 1); ++rep_) {
            pg8::GuProb P{(const unsigned char*)XG, (const unsigned char*)WGU_T, LIST, 1024, 1024, 1024}; pg8::GroupedOrder S0{tp, cn, 8, G, bx}; const pg8::TableOrder S = pg8::build_unit_table(S0, (LAS int*)(lds + MISC_OFF + 2048));
            pg8::EpiSwiglu E{(unsigned char*)ACT, LIST, ka->in[I_BGU]};
            pg8::gemm_phase<pg8::EpiSwiglu, pg8::GuProb, pg8::TableOrder, ALIGN_EPI_SEL>(lds, P, S, E);
        }
        SEAM(7);
        if (IN(8)) for (int rep_ = 0; rep_ < 1 + ((REPEAT_MASK >> 8) & 1); ++rep_) {
            pg8::DownProb P{(const unsigned char*)ACT, (const unsigned char*)WD_T, 1024, 1024, 1024}; pg8::GroupedOrder S0{tp, cn, 4, G, bx}; const pg8::TableOrder S = pg8::build_unit_table(S0, (LAS int*)(lds + MISC_OFF + 2048));
            pg8::EpiDown E{(unsigned char*)Y4, LIST, ka->in[I_BD]};
            pg8::gemm_phase<pg8::EpiDown, pg8::DownProb, pg8::TableOrder, ALIGN_EPI_SEL>(lds, P, S, E);
        }
    }
    SEAM(8);
    if (IN(9)) { KA;
        for (int i = bx * 512 + tid; i < T * 128; i += G * 512) { const int tok = i >> 7, c8 = (i & 127) * 8;
            const f32x4 w = *(const f32x4*)(ROUTEW + tok * 4); float* op = OUT + (size_t)tok * 1024 + c8;
            f32x4 o0 = *(const f32x4*)op, o1 = *(const f32x4*)(op + 4);
#pragma unroll
            for (int k = 0; k < 4; ++k) { const u32x2 y = *(const u32x2*)((const unsigned char*)Y4 + ((size_t)tok * 4 + k) * 1024 + c8); const float wk = w[k] * (1.0f / Y8_SCALE);
                const f32x2 p0 = __builtin_amdgcn_cvt_pk_f32_fp8((int)y.x, false), p1 = __builtin_amdgcn_cvt_pk_f32_fp8((int)y.x, true), p2 = __builtin_amdgcn_cvt_pk_f32_fp8((int)y.y, false), p3 = __builtin_amdgcn_cvt_pk_f32_fp8((int)y.y, true);
                o0[0] += wk * p0[0]; o0[1] += wk * p0[1]; o0[2] += wk * p1[0]; o0[3] += wk * p1[1];
                o1[0] += wk * p2[0]; o1[1] += wk * p2[1]; o1[2] += wk * p3[0]; o1[3] += wk * p3[1]; }
            *(f32x4*)op = o0; *(f32x4*)(op + 4) = o1; }
    }
#ifdef TAP
    if (lo <= 10 && 10 < hi) { KA; GSYNC();
        for (int i = bx * 512 + tid; i < T * 1024; i += G * 512) { const int t = i >> 10, c = i & 1023; float v = 0.f;
#define BFV(buf, pitch, col) __uint_as_float((unsigned)(buf)[(size_t)t * (pitch) + (col)] << 16)
            if (TAP == 1) v = BFV(Qb, 512, c & 511) + 2.f * BFV(Kb, 512, c & 511) + 4.f * BFV(Vb, 512, c & 511) + 8.f * BFV(Ub, 256, c & 255) + 16.f * BFV(MQb, 256, c & 255)
                            + 32.f * BFV(GATES, 3072, c) + 64.f * BFV(GATES, 3072, 1024 + c) + 128.f * BFV(GATES, 3072, 2048 + c);
            if (TAP == 2) v = BFV(OC, 1024, c) + 2.f * BFV(YCAT, 1024, c);
            if (TAP == 3) v = BFV(MERGB, 1024, c);
            if (TAP == 4) v = BFV(XN, 1024, c);
            if (TAP == 6) { const bf16_t* z = WSP(bf16_t, WS_B) + (size_t)t * 5120 + c; v = __uint_as_float((unsigned)z[0] << 16) + 2.f * __uint_as_float((unsigned)z[1024] << 16) + 4.f * __uint_as_float((unsigned)z[2048] << 16) + 8.f * __uint_as_float((unsigned)z[3072] << 16) + 16.f * __uint_as_float((unsigned)z[4096] << 16); }
            if (TAP == 5) { const bf16_t* wt = WIN_T; const int tt = t % 5120; v = __uint_as_float((unsigned)wt[(size_t)tt * 1024 + c] << 16) + ROPE[(t & 8191) * 32 + (c & 31)].x + 2.f * ROPE[(t & 8191) * 32 + (c & 31)].y; }
            OUT[i] = v; }
    }
#endif
#undef IN
#undef SEAM
}

extern "C" void kernel_launch(void* const* d_in, const int* in_sizes, int n_in, void* d_out, int out_size, void* d_ws, size_t ws_size, hipStream_t stream) {
    static int grid = 0;
    if (grid == 0) {
        if (n_in != 29 || in_sizes[0] != T * DMODEL || out_size != T * DMODEL || ws_size < WS_END) {
            fprintf(stderr, "kernel_launch: unexpected shapes: n_in %d in0 %d out %d ws %zu (need %zu)\n", n_in, n_in > 0 ? in_sizes[0] : -1, out_size, ws_size, (size_t)WS_END); grid = -1; return; }
        int dev = 0, cus = 0, per_cu = 0;
        (void)hipGetDevice(&dev); (void)hipDeviceGetAttribute(&cus, hipDeviceAttributeMultiprocessorCount, dev);
        (void)hipFuncSetAttribute((const void*)fwd_kernel, hipFuncAttributeMaxDynamicSharedMemorySize, LDS_BYTES);
        (void)hipOccupancyMaxActiveBlocksPerMultiprocessor(&per_cu, (const void*)fwd_kernel, NWAVES * 64, LDS_BYTES);
        (void)hipGetLastError();
        grid = cus;
        fprintf(stderr, "kernel_launch: cus %d occupancy %d/CU grid %d\n", cus, per_cu, grid);
        if (per_cu < 1) fprintf(stderr, "kernel_launch: occupancy query says the kernel does not fit\n");
    }
    if (grid < 0) return;
    (void)hipMemsetAsync((char*)d_ws + WS_CTL, 0, CTL_ZERO_BYTES, stream);
    Args a{};
    for (int i = 0; i < 29; ++i) a.in[i] = (const float*)d_in[i];
    a.out = (float*)d_out; a.ws = (unsigned char*)d_ws; a.ph_lo = 0; a.ph_hi = PH_HI;
    void* args[] = {&a};
    hipError_t e = hipLaunchCooperativeKernel((const void*)fwd_kernel, dim3(grid), dim3(NWAVES * 64), args, LDS_BYTES, stream);
    if (e != hipSuccess) fprintf(stderr, "cooperative launch failed: %s (grid %d)\n", hipGetErrorString(e), grid);
}
```

```cpp
#include <hip/hip_runtime.h>
#include <hip/hip_cooperative_groups.h>
#include <hip/hip_bf16.h>
#include <cstdio>
#include <cstdint>
#include <cmath>
namespace cg = cooperative_groups;

#define LAS __attribute__((address_space(3)))
#define GAS __attribute__((address_space(1)))
typedef unsigned short bf16_t;
typedef short bf16x8 __attribute__((ext_vector_type(8)));
typedef float f32x4 __attribute__((ext_vector_type(4)));
typedef float f32x2 __attribute__((ext_vector_type(2)));
typedef float f32x16 __attribute__((ext_vector_type(16)));
typedef unsigned u32x4 __attribute__((ext_vector_type(4)));
typedef unsigned u32x2 __attribute__((ext_vector_type(2)));

#define PH_HI 10
#define ALIGN_EPI_SEL true
#define F8MODE 2
#define USE_SETPRIO 1
#define ATTN_PRIO_A 1
#define ATTN_PRIO_B 1
#ifndef PHMASK
#define PHMASK 0x3ff
#endif
#define REPEAT_MASK 0x000
constexpr int BATCH = 4, SEQ = 8192, DMODEL = 1024, T = BATCH * SEQ, INW = 5120, NEXP = 32, MEMLEN = 256;
constexpr float RMS_EPS = 1e-6f;
constexpr float C2 = 0.125f * 1.4426950408889634f;
constexpr int CAP = T;

constexpr size_t MiB = 1u << 20;
constexpr size_t WS_CTL = 0, CTL_ZERO_BYTES = 32768;
constexpr int CW_BAR = 4096;
constexpr size_t WS_ROUTEW = 1 * MiB;
constexpr size_t WS_LAM = 1 * MiB + 768 * 1024;
constexpr size_t WS_ROPE = 2 * MiB;
constexpr size_t WS_WR2 = 4 * MiB;
constexpr size_t WS_MEMN = 5 * MiB;
constexpr size_t WS_MKV = 7 * MiB;
constexpr size_t WS_WIN_T = 8 * MiB;
constexpr size_t WS_WBRD_T = 18 * MiB;
constexpr size_t WS_WBRP_T = 19 * MiB;
constexpr size_t WS_WBRM_T = 19 * MiB + 512 * 1024;
constexpr size_t WS_WOUT_T = 20 * MiB;
constexpr size_t WS_WMKV_T = 22 * MiB;
constexpr size_t WS_WGU_T = 24 * MiB;
constexpr size_t WS_WD_T = 152 * MiB;
constexpr size_t WS_A = 216 * MiB;
constexpr size_t WS_XN = WS_A;
constexpr size_t WS_Q = WS_A + 64 * MiB, WS_K = WS_A + 96 * MiB, WS_V = WS_A + 128 * MiB;
constexpr size_t WS_U = WS_A + 160 * MiB, WS_MQ = WS_A + 176 * MiB;
constexpr size_t WS_OC = WS_A + 192 * MiB;
constexpr size_t WS_B = 488 * MiB;
constexpr size_t WS_GATES = WS_B;
constexpr size_t WS_YCAT = WS_B + 192 * MiB;
constexpr size_t WS_MERGF = 760 * MiB;
constexpr size_t WS_MERGB = 888 * MiB;
constexpr size_t WS_XG = 952 * MiB;
constexpr size_t WS_LIST = 1016 * MiB;
constexpr size_t WS_END = 1024 * MiB;

typedef __bf16 bf16x2_v __attribute__((ext_vector_type(2)));
__device__ __forceinline__ unsigned cvt_pk_bf16(float lo, float hi) { f32x2 v = {lo, hi}; bf16x2_v b = __builtin_convertvector(v, bf16x2_v); return __builtin_bit_cast(unsigned, b); }
__device__ __forceinline__ unsigned pk4_fp8(float a, float b, float c, float d) {
    a = fminf(fmaxf(a, -448.f), 448.f); b = fminf(fmaxf(b, -448.f), 448.f); c = fminf(fmaxf(c, -448.f), 448.f); d = fminf(fmaxf(d, -448.f), 448.f);
    int r = __builtin_amdgcn_cvt_pk_fp8_f32(a, b, 0, false); r = __builtin_amdgcn_cvt_pk_fp8_f32(c, d, r, true); return (unsigned)r; }
constexpr float W8_SCALE = 64.0f;
constexpr float Y8_SCALE = 32.0f;
constexpr float A8_SCALE = 8.0f;
__device__ __forceinline__ float bf_lo(unsigned w) { return __uint_as_float(w << 16); }
__device__ __forceinline__ float bf_hi(unsigned w) { return __uint_as_float(w & 0xffff0000u); }
__device__ __forceinline__ float wave_sum(float v) {
#pragma unroll
    for (int o = 1; o < 64; o <<= 1) v += __shfl_xor(v, o);
    return v;
}
#define LDS_WAIT() asm volatile("s_waitcnt lgkmcnt(0)" ::: "memory")

namespace pg8 {
constexpr int BM = 256, BK = 64, HALF = 128, HTB = HALF * BK * 2, STAGE_BYTES = 8 * HTB, NXCD = 8, WGM = 8;
__host__ __device__ __forceinline__ int lds_byte(int r, int c) { const int st = (r >> 4) * 2 + (c >> 5), rr = r & 15, cc = c & 31, ob = rr * 64 + cc * 2; return st * 1024 + (ob ^ (((ob >> 9) & 1) << 5)); }
__host__ __device__ __forceinline__ void stage_rc(int b, int& R, int& C) { const int st = b / 1024, sb = b % 1024, swz = sb ^ (((sb >> 9) & 1) << 5); R = (st >> 1) * 16 + swz / 64; C = (st & 1) * 32 + (swz % 64) / 2; }
__host__ __device__ __forceinline__ int perm32(int rho) { const int n = rho >> 4, i = rho & 15; return 8 * (i >> 2) + 4 * n + (i & 3); }

typedef int i32x4_t __attribute__((ext_vector_type(4)));
typedef int i32x8_t __attribute__((ext_vector_type(8)));
typedef long i64x2_t __attribute__((ext_vector_type(2)));
struct Unit { int pm, pn, e, mt, cnt; };

template <int BMAP> __device__ __forceinline__ int brow(int R) { return BMAP == 0 ? ((R >> 5) * 64 + perm32(R & 31)) : ((R & ~31) + perm32(R & 31)); }

struct StaticOrder {
    int nM, nN, nwg, G, c;
    __device__ void init(int M, int N, int G_, int c_) { nM = M / BM; nN = N / BM; nwg = nM * nN; G = G_; c = c_; }
    __device__ bool next(int i, Unit& u) const {
        const long L = (long)i * G + c; if (L >= nwg) return false;
        int wgid = (int)L; { const int q = nwg / NXCD, r = nwg % NXCD, xcd = wgid % NXCD, off = wgid / NXCD; wgid = (xcd < r ? xcd * (q + 1) : r * (q + 1) + (xcd - r) * q) + off; }
        const int nig = WGM * nN, gid = wgid / nig, fm = gid * WGM, gsz = (nM - fm) < WGM ? (nM - fm) : WGM;
        u.pm = fm + ((wgid % nig) % gsz); u.pn = (wgid % nig) / gsz; u.e = 0; u.mt = 0; u.cnt = 0; return true;
    }
    __device__ bool next_lane(int i, Unit& u) const { return next(i, u); }
};
struct GroupedOrder {
    const LAS int* tp; const LAS int* cn; int NTN, G, c;
    __device__ bool next_lane(int i, Unit& u) const {
        const int nwg = tp[NEXP] * NTN; const long L = (long)i * G + c; if (L >= nwg) return false;
        int wgid = (int)L; { const int q = nwg / NXCD, r = nwg % NXCD, xcd = wgid % NXCD, off = wgid / NXCD; wgid = (xcd < r ? xcd * (q + 1) : r * (q + 1) + (xcd - r) * q) + off; }
        int e = 0; while (e < NEXP - 1 && wgid >= tp[e + 1] * NTN) ++e;
        const int idx = wgid - tp[e] * NTN, tiles = tp[e + 1] - tp[e];
        const int nig = 4 * NTN, gid = idx / nig, fm = gid * 4, gsz = (tiles - fm) < 4 ? (tiles - fm) : 4;
        u.mt = fm + ((idx % nig) % gsz); u.pn = (idx % nig) / gsz; u.e = e; u.pm = tp[e] + u.mt; u.cnt = cn[e]; return true;
    }
};
struct TableOrder {
    const LAS int* tab; int n;
    __device__ __forceinline__ bool next(int i, Unit& u) const {
        if (i >= n) return false;
        const LAS int* t = tab + i * 8;
        u.pm = __builtin_amdgcn_readfirstlane(t[0]); u.pn = __builtin_amdgcn_readfirstlane(t[1]); u.e = __builtin_amdgcn_readfirstlane(t[2]);
        u.mt = __builtin_amdgcn_readfirstlane(t[3]); u.cnt = __builtin_amdgcn_readfirstlane(t[4]); return true;
    }
};
template <class Sched> __device__ __forceinline__ TableOrder build_unit_table(const Sched& S, LAS int* tab) {
    __syncthreads();
    if (threadIdx.x < 32) { Unit u; const bool ok = S.next_lane((int)threadIdx.x, u);
        if (ok) { LAS int* t = tab + threadIdx.x * 8; t[0] = u.pm; t[1] = u.pn; t[2] = u.e; t[3] = u.mt; t[4] = u.cnt; }
        const unsigned long long m = __ballot(ok); if (threadIdx.x == 0) tab[256] = __popcll(m); }
    __syncthreads();
    TableOrder T; T.tab = tab; T.n = __builtin_amdgcn_readfirstlane(tab[256]); return T;
}
struct DenseProb {
    static constexpr bool GATHER = false; static constexpr int BMAP = 0; static constexpr bool F8 = false;
    const bf16_t* A; const bf16_t* Bt; int lda, ldb, K;
    __device__ __forceinline__ const char* a_base(const Unit& u) const { return (const char*)(A + (size_t)u.pm * BM * lda); }
    __device__ __forceinline__ const char* b_base(const Unit& u) const { return (const char*)(Bt + (size_t)u.pn * BM * ldb); }
    __device__ __forceinline__ size_t bhstep() const { return (size_t)32 * ldb * 2; }
    __device__ __forceinline__ unsigned a_off(const Unit&, int, int) const { return 0u; }
    __device__ __forceinline__ unsigned a_raw(const Unit&, int) const { return 0u; }
};
struct GuProb {
    static constexpr bool GATHER = true; static constexpr int BMAP = 1; static constexpr bool F8 = true;
    const unsigned char* XG; const unsigned char* Wt; const u32x2* list; int lda, ldb, K;
    __device__ __forceinline__ const char* a_base(const Unit&) const { return (const char*)XG; }
    __device__ __forceinline__ const char* b_base(const Unit& u) const { return (const char*)(Wt + ((size_t)u.e * 2048 + 128 * u.pn) * 1024); }
    __device__ __forceinline__ size_t bhstep() const { return (size_t)1024 * 1024; }
    __device__ __forceinline__ unsigned a_raw(const Unit& u, int r) const { const int rr = u.mt * BM + r, rc = rr < u.cnt ? rr : u.cnt - 1; return list[(size_t)u.e * CAP + rc].x; }
    __device__ __forceinline__ unsigned a_off(const Unit& u, int r, int C) const {
        const int rr = u.mt * BM + r, rc = rr < u.cnt ? rr : u.cnt - 1;
        const unsigned tok = list[(size_t)u.e * CAP + rc].x >> 2;
        return tok * 1024u + (unsigned)C * 2u;
    }
};
struct DownProb {
    static constexpr bool GATHER = false; static constexpr int BMAP = 0; static constexpr bool F8 = true;
    const unsigned char* A; const unsigned char* Wt; int lda, ldb, K;
    __device__ __forceinline__ const char* a_base(const Unit& u) const { return (const char*)(A + (size_t)u.pm * BM * lda); }
    __device__ __forceinline__ const char* b_base(const Unit& u) const { return (const char*)(Wt + ((size_t)u.e * 1024 + 256 * u.pn) * 1024); }
    __device__ __forceinline__ size_t bhstep() const { return (size_t)32 * ldb; }
    __device__ __forceinline__ unsigned a_off(const Unit&, int, int) const { return 0u; }
    __device__ __forceinline__ unsigned a_raw(const Unit&, int) const { return 0u; }
};

template <class Prob> __device__ __forceinline__ void calc_aoff(const Prob& P, const Unit& u, const int (&Rr)[2], const int (&Cc)[2], unsigned (&o)[2][2]) {
#pragma unroll
    for (int h = 0; h < 2; ++h)
#pragma unroll
        for (int i = 0; i < 2; ++i) {
            if constexpr (Prob::GATHER) o[h][i] = P.a_off(u, h * HALF + Rr[i], Cc[i]);
            else o[h][i] = Prob::F8 ? (unsigned)((h * HALF + Rr[i]) * P.lda + Cc[i] * 2) : (unsigned)((h * HALF + Rr[i]) * P.lda + Cc[i]) * 2u;
        }
}

struct NoPost { __device__ __forceinline__ void operator()(int) const {} };
template <class Epi, class Prob, class Sched, bool ALIGN_EPI, class Post = NoPost>
__device__ __forceinline__ void gemm_phase(LAS unsigned char* lds, const Prob& P, const Sched& S, const Epi& E, const Post& PU = Post()) {
    const int tid = threadIdx.x, wid = __builtin_amdgcn_readfirstlane(tid >> 6), lane = tid & 63, wr = wid >> 2, wc = wid & 3, fr = lane & 15, fq = lane >> 4;
    const int K = P.K, nt = Prob::F8 ? K / 128 : K / BK;
    int Rr[2], Cc[2]; unsigned voffB[2];
#pragma unroll
    for (int i = 0; i < 2; ++i) { stage_rc(tid * 16 + i * 8192, Rr[i], Cc[i]); voffB[i] = Prob::F8 ? (unsigned)(brow<Prob::BMAP>(Rr[i]) * P.ldb + Cc[i] * 2) : (unsigned)(brow<Prob::BMAP>(Rr[i]) * P.ldb + Cc[i]) * 2u; }
    const size_t kstep = (size_t)(BK * 2);
    const size_t bhstep = P.bhstep();
    const unsigned ldsw = (unsigned)wid * 1024u;
    const int aoff = lds_byte(wr * 64 + fr, fq * 8), boff = lds_byte(wc * 32 + fr, fq * 8);
#define PG8_SA(b, h) (((b) * 2 + (h)) * HTB)
#define PG8_SB(b, h) ((4 + (b) * 2 + (h)) * HTB)
#define PG8_STG(bufoff, gptr, v0, v1) do { \
        __builtin_amdgcn_global_load_lds((const unsigned*)((const char*)(gptr) + (v0)), (LAS unsigned*)(lds + (bufoff) + ldsw), 16, 0, 0); \
        __builtin_amdgcn_global_load_lds((const unsigned*)((const char*)(gptr) + (v1)), (LAS unsigned*)(lds + (bufoff) + ldsw + 8192), 16, 0, 0); } while (0)
#define PG8_STGB(bufoff, gptr) PG8_STG(bufoff, gptr, voffB[0], voffB[1])
#define PG8_LDA(dst, b, h) do { _Pragma("unroll") for (int m = 0; m < 4; ++m) _Pragma("unroll") for (int k = 0; k < 2; ++k) dst[m][k] = *(const LAS bf16x8*)(lds + PG8_SA(b, h) + aoff + m * 2048 + k * 1024); } while (0)
#define PG8_LDB(dst, b, h) do { _Pragma("unroll") for (int n = 0; n < 2; ++n) _Pragma("unroll") for (int k = 0; k < 2; ++k) dst[n][k] = *(const LAS bf16x8*)(lds + PG8_SB(b, h) + boff + n * 2048 + k * 1024); } while (0)
#define PG8_MMAB(ai, bj, At, Bt) do { _Pragma("unroll") for (int m = 0; m < 4; ++m) _Pragma("unroll") for (int n = 0; n < 2; ++n) _Pragma("unroll") for (int k = 0; k < 2; ++k) \
        acc[ai][bj][m][n] = __builtin_amdgcn_mfma_f32_16x16x32_bf16(Bt[n][k], At[m][k], acc[ai][bj][m][n], 0, 0, 0); } while (0)
#define PG8_MMAQ(ai, bj, At, Bt) do { _Pragma("unroll") for (int m = 0; m < 4; ++m) _Pragma("unroll") for (int n = 0; n < 2; ++n) _Pragma("unroll") for (int k = 0; k < 2; ++k) { \
        const i64x2_t bq = __builtin_bit_cast(i64x2_t, Bt[n][k]), aq = __builtin_bit_cast(i64x2_t, At[m][k]); \
        acc[ai][bj][m][n] = __builtin_amdgcn_mfma_f32_16x16x32_fp8_fp8(bq[0], aq[0], acc[ai][bj][m][n], 0, 0, 0); \
        acc[ai][bj][m][n] = __builtin_amdgcn_mfma_f32_16x16x32_fp8_fp8(bq[1], aq[1], acc[ai][bj][m][n], 0, 0, 0); } } while (0)
#define PG8_MMA8(ai, bj, A8, B8) do { _Pragma("unroll") for (int m = 0; m < 4; ++m) _Pragma("unroll") for (int n = 0; n < 2; ++n) \
        asm volatile("v_mfma_f32_16x16x128_f8f6f4 %0, %1, %2, %0" : "+v"(acc[ai][bj][m][n]) : "v"(B8[n]), "v"(A8[m])); } while (0)
#define PG8_LDA8(dst, b, h) do { _Pragma("unroll") for (int m = 0; m < 4; ++m) { dst[m].lo = *(const LAS i32x4_t*)(lds + PG8_SA(b, h) + aoff + m * 2048); dst[m].hi = *(const LAS i32x4_t*)(lds + PG8_SA(b, h) + aoff + m * 2048 + 1024); } } while (0)
#define PG8_LDB8(dst, b, h) do { _Pragma("unroll") for (int n = 0; n < 2; ++n) { dst[n].lo = *(const LAS i32x4_t*)(lds + PG8_SB(b, h) + boff + n * 2048); dst[n].hi = *(const LAS i32x4_t*)(lds + PG8_SB(b, h) + boff + n * 2048 + 1024); } } while (0)
#define PG8_XLDA(b, h)  do { if constexpr (Prob::F8 && F8MODE == 2) PG8_LDA8(At8, b, h); else PG8_LDA(At, b, h); } while (0)
#define PG8_XLDB0(b, h) do { if constexpr (Prob::F8 && F8MODE == 2) PG8_LDB8(B08, b, h); else PG8_LDB(B0, b, h); } while (0)
#define PG8_XLDB1(b, h) do { if constexpr (Prob::F8 && F8MODE == 2) PG8_LDB8(B18, b, h); else PG8_LDB(B1, b, h); } while (0)
#define PG8_XMMA0(ai, bj) do { if (USE_SETPRIO) __builtin_amdgcn_s_setprio(USE_SETPRIO); if constexpr (Prob::F8 && F8MODE == 2) PG8_MMA8(ai, bj, At8, B08); else if constexpr (Prob::F8) PG8_MMAQ(ai, bj, At, B0); else PG8_MMAB(ai, bj, At, B0); if (USE_SETPRIO) __builtin_amdgcn_s_setprio(0); } while (0)
#define PG8_XMMA1(ai, bj) do { if (USE_SETPRIO) __builtin_amdgcn_s_setprio(USE_SETPRIO); if constexpr (Prob::F8 && F8MODE == 2) PG8_MMA8(ai, bj, At8, B18); else if constexpr (Prob::F8) PG8_MMAQ(ai, bj, At, B1); else PG8_MMAB(ai, bj, At, B1); if (USE_SETPRIO) __builtin_amdgcn_s_setprio(0); } while (0)
#define PG8_WAIT_V(n) asm volatile("s_waitcnt vmcnt(" #n ")" ::: "memory")
#define PG8_WAIT_L(n) asm volatile("s_waitcnt lgkmcnt(" #n ")" ::: "memory")
#define PG8_BAR __builtin_amdgcn_s_barrier()
#define PG8_SCHED __builtin_amdgcn_sched_barrier(0)
    Unit cur, nxt; int ui = 0;
    if (!S.next(0, cur)) return;
    unsigned vo[2][2], nvo[2][2];
    calc_aoff(P, cur, Rr, Cc, vo);
    bool has_next = S.next(1, nxt);
    if constexpr (Prob::GATHER) { if (has_next) calc_aoff(P, nxt, Rr, Cc, nvo); else {
#pragma unroll
        for (int h = 0; h < 2; ++h)
#pragma unroll
            for (int i = 0; i < 2; ++i) nvo[h][i] = vo[h][i]; } }
    f32x4 acc[2][2][4][2];
#pragma unroll
    for (int a = 0; a < 2; ++a)
#pragma unroll
        for (int b = 0; b < 2; ++b)
#pragma unroll
            for (int m = 0; m < 4; ++m)
#pragma unroll
                for (int n = 0; n < 2; ++n) acc[a][b][m][n] = (f32x4){0.f, 0.f, 0.f, 0.f};
    bf16x8 At[4][2], B0[2][2], B1[2][2]; i32x8_t At8[4], B08[2], B18[2];
    const char* cA = P.a_base(cur); const char* cB = P.b_base(cur);
    PG8_STGB(PG8_SB(0, 0), cB); PG8_STGB(PG8_SB(0, 1), cB + bhstep); PG8_STG(PG8_SA(0, 0), cA, vo[0][0], vo[0][1]); PG8_STG(PG8_SA(0, 1), cA, vo[1][0], vo[1][1]);
    if (wr == 1) PG8_BAR;
    PG8_WAIT_V(2); PG8_BAR;
    PG8_STGB(PG8_SB(1, 0), cB + kstep); PG8_STG(PG8_SA(1, 0), cA + kstep, vo[0][0], vo[0][1]); PG8_STGB(PG8_SB(1, 1), cB + bhstep + kstep);
    PG8_WAIT_V(6); PG8_BAR;
    for (;;) {
        const char* nA = has_next ? P.a_base(nxt) : cA; const char* nB = has_next ? P.b_base(nxt) : cB;
        for (int t = 0; t < nt; t += 2) {
            const bool last = (t == nt - 2);
            if constexpr (Epi::HAS_MID) { if (t == Epi::MID_T0 || t == Epi::MID_T1) { E.mid(acc, cur, wr, wc, fr, fq, t == Epi::MID_T0 ? 0 : 1); PG8_SCHED; } }
            const char* a1 = cA + (size_t)(t + 1) * kstep;
            const char* a2 = last ? nA : cA + (size_t)(t + 2) * kstep; const char* b2 = last ? nB : cB + (size_t)(t + 2) * kstep;
            const char* a3 = a2 + kstep; const char* b3 = b2 + kstep;
            unsigned x00 = vo[0][0], x01 = vo[0][1], x10 = vo[1][0], x11 = vo[1][1];
            if constexpr (Prob::GATHER) { if (last) { x00 = nvo[0][0]; x01 = nvo[0][1]; x10 = nvo[1][0]; x11 = nvo[1][1]; } }
            PG8_XLDB0(0, 0); PG8_XLDB1(0, 1); PG8_SCHED; PG8_XLDA(0, 0); PG8_STG(PG8_SA(1, 1), a1, vo[1][0], vo[1][1]);
            PG8_WAIT_V(8); PG8_WAIT_L(0); PG8_BAR; PG8_XMMA0(0, 0); PG8_XMMA1(0, 1); PG8_BAR; PG8_SCHED;
            PG8_XLDA(0, 1); PG8_STGB(PG8_SB(0, 0), b2); PG8_STGB(PG8_SB(0, 1), b2 + bhstep); PG8_STG(PG8_SA(0, 0), a2, x00, x01);
            PG8_WAIT_V(8); PG8_WAIT_L(0); PG8_BAR; PG8_XMMA0(1, 0); PG8_XMMA1(1, 1); PG8_BAR; PG8_SCHED;
            PG8_XLDB0(1, 0); PG8_XLDB1(1, 1); PG8_SCHED; PG8_XLDA(1, 0); PG8_STG(PG8_SA(0, 1), a2, x10, x11);
            PG8_WAIT_V(8); PG8_WAIT_L(0); PG8_BAR; PG8_XMMA0(0, 0); PG8_XMMA1(0, 1); PG8_BAR; PG8_SCHED;
            PG8_XLDA(1, 1); PG8_STGB(PG8_SB(1, 0), b3); PG8_STGB(PG8_SB(1, 1), b3 + bhstep); PG8_STG(PG8_SA(1, 0), a3, x00, x01);
            PG8_WAIT_V(8); PG8_WAIT_L(0); PG8_BAR; PG8_XMMA0(1, 0); PG8_XMMA1(1, 1); PG8_BAR; PG8_SCHED;
        }
        if constexpr (ALIGN_EPI) { if (wr == 0) PG8_BAR; }
        if constexpr (Prob::F8 && F8MODE == 2) asm volatile("s_nop 15\n\ts_nop 15" ::: "memory");
        Unit nn; const bool has_nn = has_next && S.next(ui + 2, nn);
        if constexpr (Prob::GATHER) {
#pragma unroll
            for (int h = 0; h < 2; ++h)
#pragma unroll
                for (int i = 0; i < 2; ++i) vo[h][i] = nvo[h][i];
            if (has_nn) {
#pragma unroll
                for (int h = 0; h < 2; ++h)
#pragma unroll
                    for (int i = 0; i < 2; ++i) nvo[h][i] = P.a_raw(nn, h * HALF + Rr[i]); } }
        E(acc, cur, wr, wc, fr, fq);
        PU(ui);
        if (!has_next) break;
#pragma unroll
        for (int a = 0; a < 2; ++a)
#pragma unroll
            for (int b = 0; b < 2; ++b)
#pragma unroll
                for (int m = 0; m < 4; ++m)
#pragma unroll
                    for (int n = 0; n < 2; ++n) acc[a][b][m][n] = (f32x4){0.f, 0.f, 0.f, 0.f};
        cur = nxt; cA = nA; cB = nB; ++ui;
        has_next = has_nn; nxt = nn;
        if constexpr (Prob::GATHER) { if (has_next) {
#pragma unroll
            for (int h = 0; h < 2; ++h)
#pragma unroll
                for (int i = 0; i < 2; ++i) nvo[h][i] = (nvo[h][i] >> 2) * (Prob::F8 ? 1024u : 2048u) + (unsigned)Cc[i] * 2u;
            asm volatile("" : "+v"(nvo[0][0]), "+v"(nvo[0][1]), "+v"(nvo[1][0]), "+v"(nvo[1][1])); } }
        if constexpr (ALIGN_EPI) { if (wr == 1) PG8_BAR; }
    }
    PG8_WAIT_V(0);
    if constexpr (!ALIGN_EPI) { if (wr == 0) PG8_BAR; }
    PG8_BAR;
#undef PG8_SA
#undef PG8_SB
#undef PG8_STG
#undef PG8_STGB
#undef PG8_LDA
#undef PG8_LDB
#undef PG8_MMAB
#undef PG8_MMAQ
#undef PG8_MMA8
#undef PG8_LDA8
#undef PG8_LDB8
#undef PG8_XLDA
#undef PG8_XLDB0
#undef PG8_XLDB1
#undef PG8_XMMA0
#undef PG8_XMMA1
#undef PG8_WAIT_V
#undef PG8_WAIT_L
#undef PG8_BAR
#undef PG8_SCHED
}

typedef const f32x4 (&AccRef)[2][2][4][2];

__device__ __forceinline__ void store8(bf16_t* p, const f32x4& a, const f32x4& b) {
    u32x4 w; w.x = cvt_pk_bf16(a[0], a[1]); w.y = cvt_pk_bf16(a[2], a[3]); w.z = cvt_pk_bf16(b[0], b[1]); w.w = cvt_pk_bf16(b[2], b[3]); *(u32x4*)p = w;
}
__device__ __forceinline__ float sigmoidf_(float v) { return __builtin_amdgcn_rcpf(1.0f + __builtin_amdgcn_exp2f(-1.4426950408889634f * v)); }

struct EpiInProj {
    static constexpr bool HAS_MID = false;
    bf16_t *Q, *Kb, *V, *U, *MQ, *GT; const float *qn, *kn, *mqn, *bg; const f32x2* rope;
    __device__ __forceinline__ void operator()(AccRef acc, const Unit& u, int wr, int wc, int fr, int fq) const {
        const int pn = u.pn; const int row0 = u.pm * BM + wr * 64 + fr;
        bf16_t* const Q_ = Q; bf16_t* const K_ = Kb; bf16_t* const V_ = V; bf16_t* const U_ = U; bf16_t* const MQ_ = MQ; const float* const qn_ = qn; const float* const kn_ = kn; const float* const mqn_ = mqn;
        if (pn < 4 || pn == 7) {
            const bool rope_on = pn < 4; const float* gn = pn < 2 ? qn_ : (pn < 4 ? kn_ : mqn_);
            const float sc = (pn < 2 || pn == 7) ? C2 : 1.0f;
            bf16_t* O; int pitch, colb;
            if (pn < 2) { O = Q_; pitch = 512; colb = (pn * 4 + wc) * 64; } else if (pn < 4) { O = K_; pitch = 512; colb = ((pn - 2) * 4 + wc) * 64; } else { O = MQ_; pitch = 256; colb = wc * 64; }
            const f32x4 g00 = *(const f32x4*)(gn + 8 * fq), g01 = *(const f32x4*)(gn + 8 * fq + 4), g10 = *(const f32x4*)(gn + 32 + 8 * fq), g11 = *(const f32x4*)(gn + 32 + 8 * fq + 4);
#pragma unroll
            for (int ai = 0; ai < 2; ++ai)
#pragma unroll
                for (int m = 0; m < 4; ++m) {
                    const f32x4 a0 = acc[ai][0][m][0], a1 = acc[ai][0][m][1], b0 = acc[ai][1][m][0], b1 = acc[ai][1][m][1];
                    float ss = 0.f;
#pragma unroll
                    for (int j = 0; j < 4; ++j) ss += a0[j] * a0[j] + a1[j] * a1[j] + b0[j] * b0[j] + b1[j] * b1[j];
                    ss += __shfl_xor(ss, 16); ss += __shfl_xor(ss, 32);
                    const float rstd = 1.0f / sqrtf(ss * (1.0f / 64.0f) + RMS_EPS);
                    const int row = row0 + ai * HALF + m * 16;
                    f32x4 t10 = a0 * rstd * g00, t11 = a1 * rstd * g01, t20 = b0 * rstd * g10, t21 = b1 * rstd * g11;
                    f32x4 o10, o11, o20, o21;
                    if (rope_on) {
                        const f32x4* rp = (const f32x4*)(rope + (size_t)(row & (SEQ - 1)) * 32 + 8 * fq);
                        const f32x4 r0 = rp[0], r1 = rp[1], r2 = rp[2], r3 = rp[3];
                        const f32x4 cs0 = {r0[0], r0[2], r1[0], r1[2]}, sn0 = {r0[1], r0[3], r1[1], r1[3]}, cs1 = {r2[0], r2[2], r3[0], r3[2]}, sn1 = {r2[1], r2[3], r3[1], r3[3]};
                        o10 = (t10 * cs0 - t20 * sn0) * sc; o11 = (t11 * cs1 - t21 * sn1) * sc; o20 = (t20 * cs0 + t10 * sn0) * sc; o21 = (t21 * cs1 + t11 * sn1) * sc;
                    } else { o10 = t10 * sc; o11 = t11 * sc; o20 = t20 * sc; o21 = t21 * sc; }
                    bf16_t* rowp = O + (size_t)row * pitch + colb + 8 * fq;
                    store8(rowp, o10, o11); store8(rowp + 32, o20, o21);
                }
        } else if (pn < 7) {
            bf16_t* O; int pitch, colb;
            if (pn < 6) { O = V_; pitch = 512; colb = (pn - 4) * 256 + wc * 64; } else { O = U_; pitch = 256; colb = wc * 64; }
#pragma unroll
            for (int ai = 0; ai < 2; ++ai)
#pragma unroll
                for (int m = 0; m < 4; ++m) { bf16_t* rowp = O + (size_t)(row0 + ai * HALF + m * 16) * pitch + colb + 8 * fq;
                    store8(rowp, acc[ai][0][m][0], acc[ai][0][m][1]); store8(rowp + 32, acc[ai][1][m][0], acc[ai][1][m][1]); }
        } else {
            const int gc = (pn - 8) * 256 + wc * 64 + 8 * fq;
            f32x4 bv[2][2];
#pragma unroll
            for (int bj = 0; bj < 2; ++bj)
#pragma unroll
                for (int n = 0; n < 2; ++n) bv[bj][n] = *(const f32x4*)(bg + gc + 32 * bj + 4 * n);
#pragma unroll
            for (int ai = 0; ai < 2; ++ai)
#pragma unroll
                for (int m = 0; m < 4; ++m) {
                    bf16_t* blk = GT + ((size_t)(((pn - 8) >> 2) * 128 + u.pm) * 4 + ((pn - 8) & 3)) * 65536 + (size_t)((wr * 4 + wc) * 16 * 64 + (fq * 16 + fr)) * 8;
#pragma unroll
                    for (int bj = 0; bj < 2; ++bj) { f32x4 v0 = acc[ai][bj][m][0] + bv[bj][0], v1 = acc[ai][bj][m][1] + bv[bj][1];
#pragma unroll
                        for (int j = 0; j < 4; ++j) { v0[j] = sigmoidf_(v0[j]); v1[j] = sigmoidf_(v1[j]); }
                        store8(blk + (ai * 8 + m * 2 + bj) * 512, v0, v1); } }
        }
    }
};
struct EpiMemKV {
    static constexpr bool HAS_MID = false;
    bf16_t* MKV; const float* mkn;
    __device__ __forceinline__ void operator()(AccRef acc, const Unit& u, int wr, int wc, int fr, int fq) const {
        const int row0 = u.pm * BM + wr * 64 + fr;
        f32x4 g00 = {1.f, 1.f, 1.f, 1.f}, g01 = g00, g10 = g00, g11 = g00;
        if (u.pn == 0) { g00 = *(const f32x4*)(mkn + 8 * fq); g01 = *(const f32x4*)(mkn + 8 * fq + 4); g10 = *(const f32x4*)(mkn + 32 + 8 * fq); g11 = *(const f32x4*)(mkn + 32 + 8 * fq + 4); }
#pragma unroll
        for (int ai = 0; ai < 2; ++ai)
#pragma unroll
            for (int m = 0; m < 4; ++m) {
                const f32x4 a0 = acc[ai][0][m][0], a1 = acc[ai][0][m][1], b0 = acc[ai][1][m][0], b1 = acc[ai][1][m][1];
                float rstd = 1.0f;
                if (u.pn == 0) { float ss = 0.f;
#pragma unroll
                    for (int j = 0; j < 4; ++j) ss += a0[j] * a0[j] + a1[j] * a1[j] + b0[j] * b0[j] + b1[j] * b1[j];
                    ss += __shfl_xor(ss, 16); ss += __shfl_xor(ss, 32); rstd = 1.0f / sqrtf(ss * (1.0f / 64.0f) + RMS_EPS); }
                bf16_t* rowp = MKV + (size_t)(row0 + ai * HALF + m * 16) * 512 + u.pn * 256 + wc * 64 + 8 * fq;
                store8(rowp, a0 * rstd * g00, a1 * rstd * g01); store8(rowp + 32, b0 * rstd * g10, b1 * rstd * g11);
            }
    }
};
template <int STAGE> struct EpiMerge {
    static constexpr bool HAS_MID = false;
    const bf16_t* GT; float* MF; bf16_t* MB;
    __device__ __forceinline__ void operator()(AccRef acc, const Unit& u, int wr, int wc, int fr, int fq) const {
        const int row0 = u.pm * BM + wr * 64 + fr, col0 = u.pn * BM + wc * 64 + 8 * fq;
#pragma unroll
        for (int ai = 0; ai < 2; ++ai)
#pragma unroll
            for (int m = 0; m < 4; ++m) { const size_t row = (size_t)(row0 + ai * HALF + m * 16);
#pragma unroll
                for (int bj = 0; bj < 2; ++bj) { const int col = col0 + 32 * bj;
                    const u32x4 g = *(const u32x4*)(GT + row * 3072 + STAGE * 1024 + col);
                    const f32x4 ga = {bf_lo(g.x), bf_hi(g.x), bf_lo(g.y), bf_hi(g.y)}, gb = {bf_lo(g.z), bf_hi(g.z), bf_lo(g.w), bf_hi(g.w)};
                    f32x4 v0 = acc[ai][bj][m][0] * ga, v1 = acc[ai][bj][m][1] * gb;
                    float* mp = MF + row * 1024 + col;
                    if (STAGE > 0) { v0 += *(const f32x4*)mp; v1 += *(const f32x4*)(mp + 4); }
                    if (STAGE < 2) { *(f32x4*)mp = v0; *(f32x4*)(mp + 4) = v1; } else store8(MB + row * 1024 + col, v0, v1); }
                if (m & 1) asm volatile("" ::: "memory"); }
    }
};
struct EpiWout {
    static constexpr bool HAS_MID = false;
    const float* X; float* X2; unsigned char* XG; const float* n2;
    __device__ __forceinline__ void operator()(AccRef acc, const Unit& u, int wr, int wc, int fr, int fq) const {
        const int row0 = u.pm * BM + wr * 64 + fr, col0 = u.pn * BM + wc * 64 + 8 * fq;
        f32x4 nv[2][2];
#pragma unroll
        for (int bj = 0; bj < 2; ++bj)
#pragma unroll
            for (int n = 0; n < 2; ++n) nv[bj][n] = *(const f32x4*)(n2 + col0 + 32 * bj + 4 * n);
#pragma unroll
        for (int ai = 0; ai < 2; ++ai)
#pragma unroll
            for (int m = 0; m < 4; ++m) { const size_t off = (size_t)(row0 + ai * HALF + m * 16) * 1024 + col0;
#pragma unroll
                for (int bj = 0; bj < 2; ++bj) { const f32x4 x0 = *(const f32x4*)(X + off + 32 * bj) + acc[ai][bj][m][0], x1 = *(const f32x4*)(X + off + 32 * bj + 4) + acc[ai][bj][m][1];
                    *(f32x4*)(X2 + off + 32 * bj) = x0; *(f32x4*)(X2 + off + 32 * bj + 4) = x1;
                    { const f32x4 y0 = x0 * nv[bj][0], y1 = x1 * nv[bj][1]; u32x2 w8; w8.x = pk4_fp8(y0[0], y0[1], y0[2], y0[3]); w8.y = pk4_fp8(y1[0], y1[1], y1[2], y1[3]); *(u32x2*)(XG + off + 32 * bj) = w8; } }
                if (m & 1) asm volatile("" ::: "memory"); }
    }
};
struct EpiSwiglu {
    static constexpr bool HAS_MID = false;
    unsigned char* ACT; const u32x2* list; const float* bgu;
    __device__ __forceinline__ static unsigned swi4(const f32x4& ag, const f32x4& au, float rstd, const f32x4& bg, const f32x4& bu) {
        unsigned w = 0;
#pragma unroll
        for (int h = 0; h < 2; ++h) {
            const f32x2 a2 = {ag[2 * h], ag[2 * h + 1]}, u2 = {au[2 * h], au[2 * h + 1]}, bg2 = {bg[2 * h], bg[2 * h + 1]}, bu2 = {bu[2 * h], bu[2 * h + 1]};
            const f32x2 G = a2 * rstd + bg2, U = u2 * rstd + bu2;
            const f32x2 gg = {fminf(G[0], 7.0f), fminf(G[1], 7.0f)};
            const f32x2 t = gg * (-1.702f * 1.4426950408889634f);
            const f32x2 d = (f32x2){__builtin_amdgcn_exp2f(t[0]), __builtin_amdgcn_exp2f(t[1])} + 1.0f;
            const f32x2 r = {__builtin_amdgcn_rcpf(d[0]), __builtin_amdgcn_rcpf(d[1])};
            const f32x2 uu = {__builtin_amdgcn_fmed3f(U[0], -7.0f, 7.0f), __builtin_amdgcn_fmed3f(U[1], -7.0f, 7.0f)};
            const f32x2 o = (gg * r) * (uu * A8_SCALE + A8_SCALE);
            w = h ? (unsigned)__builtin_amdgcn_cvt_pk_fp8_f32(o[0], o[1], (int)w, true) : (unsigned)__builtin_amdgcn_cvt_pk_fp8_f32(o[0], o[1], (int)w, false);
        }
        return w;
    }
    __device__ __forceinline__ void operator()(AccRef acc, const Unit& u, int wr, int wc, int fr, int fq) const {
        int z = 0; asm volatile("" : "+v"(z));
        const int col = 128 * u.pn + 32 * wc + 8 * fq + z; const float* bp = bgu + (size_t)u.e * 2048 + col;
        const f32x4 bg0 = *(const f32x4*)bp, bg1 = *(const f32x4*)(bp + 4), bu0 = *(const f32x4*)(bp + 1024), bu1 = *(const f32x4*)(bp + 1028);
#pragma unroll
        for (int ai = 0; ai < 2; ++ai)
#pragma unroll
            for (int m = 0; m < 4; ++m) { const int r = ai * HALF + wr * 64 + m * 16 + fr, rr = u.mt * BM + r, rc = rr < u.cnt ? rr : u.cnt - 1;
                const float rstd = __uint_as_float(list[(size_t)u.e * CAP + rc].y) * (1.0f / W8_SCALE);
                u32x2 w8; w8.x = swi4(acc[ai][0][m][0], acc[ai][1][m][0], rstd, bg0, bu0); w8.y = swi4(acc[ai][0][m][1], acc[ai][1][m][1], rstd, bg1, bu1);
                *(u32x2*)(ACT + (size_t)(u.pm * BM + r) * 1024 + col) = w8; }
    }
};
struct EpiDown {
    static constexpr bool HAS_MID = false;
    unsigned char* Y4; const u32x2* list; const float* bd;
    __device__ __forceinline__ static unsigned dn4(const f32x4& a, const f32x4& b32) {
        const f32x4 y = a * (Y8_SCALE / (W8_SCALE * A8_SCALE)) + b32;
        return pk4_fp8(y[0], y[1], y[2], y[3]);
    }
    __device__ __forceinline__ void operator()(AccRef acc, const Unit& u, int wr, int wc, int fr, int fq) const {
        int z = 0; asm volatile("" : "+v"(z));
        const int col0 = u.pn * BM + wc * 64 + 8 * fq + z; const float* bp = bd + (size_t)u.e * 1024 + col0;
        f32x4 bv[2][2];
#pragma unroll
        for (int bj = 0; bj < 2; ++bj)
#pragma unroll
            for (int n = 0; n < 2; ++n) bv[bj][n] = *(const f32x4*)(bp + 32 * bj + 4 * n) * Y8_SCALE;
        unsigned tkv[8];
#pragma unroll
        for (int ai = 0; ai < 2; ++ai)
#pragma unroll
            for (int m = 0; m < 4; ++m) { const int rr = u.mt * BM + ai * HALF + wr * 64 + m * 16 + fr, rc = rr < u.cnt ? rr : u.cnt - 1;
                tkv[ai * 4 + m] = list[(size_t)u.e * CAP + rc].x; }
#pragma unroll
        for (int ai = 0; ai < 2; ++ai)
#pragma unroll
            for (int m = 0; m < 4; ++m) { const int rr = u.mt * BM + ai * HALF + wr * 64 + m * 16 + fr;
                if (rr < u.cnt) { unsigned char* rowp = Y4 + (size_t)tkv[ai * 4 + m] * 1024 + col0;
#pragma unroll
                    for (int bj = 0; bj < 2; ++bj) { u32x2 w8; w8.x = dn4(acc[ai][bj][m][0], bv[bj][0]); w8.y = dn4(acc[ai][bj][m][1], bv[bj][1]); *(u32x2*)(rowp + 32 * bj) = w8; } } }
    }
};
struct EpiMergeR {
    static constexpr bool HAS_MID = true; static constexpr int MID_T0 = 8, MID_T1 = 12;
    const bf16_t* GT; bf16_t* MB;
    __device__ __forceinline__ void mid(f32x4 (&acc)[2][2][4][2], const Unit& u, int wr, int wc, int fr, int fq, int seam) const {
        int z = 0; asm volatile("" : "+v"(z));
        const bf16_t* gp0 = GT + ((size_t)(seam * 128 + u.pm) * 4 + u.pn) * 65536 + (size_t)((wr * 4 + wc) * 16 * 64 + (fq * 16 + fr) + z) * 8;
#pragma unroll
        for (int ai = 0; ai < 2; ++ai)
#pragma unroll
            for (int m = 0; m < 4; ++m) {
#pragma unroll
                for (int bj = 0; bj < 2; ++bj) { const bf16_t* gp = gp0 + (ai * 8 + m * 2 + bj) * 512;
                    const u32x4 gn = *(const u32x4*)gp, gd = *(const u32x4*)(gp + (size_t)128 * 4 * 65536);
                    const unsigned nn[4] = {gn.x, gn.y, gn.z, gn.w}, dd[4] = {gd.x, gd.y, gd.z, gd.w};
#pragma unroll
                    for (int j = 0; j < 4; ++j) { const float r0 = bf_lo(nn[j]) * __builtin_amdgcn_rcpf(fmaxf(bf_lo(dd[j]), 8.67e-19f)), r1 = bf_hi(nn[j]) * __builtin_amdgcn_rcpf(fmaxf(bf_hi(dd[j]), 8.67e-19f));
                        acc[ai][bj][m][j >> 1][(j & 1) * 2] *= r0; acc[ai][bj][m][j >> 1][(j & 1) * 2 + 1] *= r1; } }
                if (m & 1) asm volatile("" ::: "memory"); }
    }
    __device__ __forceinline__ void operator()(AccRef acc, const Unit& u, int wr, int wc, int fr, int fq) const {
        int z = 0; asm volatile("" : "+v"(z));
        const size_t off0 = (size_t)(u.pm * BM + wr * 64 + fr + z) * 1024 + u.pn * BM + wc * 64 + 8 * fq;
        const bf16_t* gp0 = GT + ((size_t)(2 * 128 + u.pm) * 4 + u.pn) * 65536 + (size_t)((wr * 4 + wc) * 16 * 64 + (fq * 16 + fr) + z) * 8;
#pragma unroll
        for (int ai = 0; ai < 2; ++ai)
#pragma unroll
            for (int m = 0; m < 4; ++m) { const size_t ro = off0 + (size_t)(ai * HALF + m * 16) * 1024;
#pragma unroll
                for (int bj = 0; bj < 2; ++bj) {
                    const u32x4 g = *(const u32x4*)(gp0 + (ai * 8 + m * 2 + bj) * 512);
                    const f32x4 ga = {bf_lo(g.x), bf_hi(g.x), bf_lo(g.y), bf_hi(g.y)}, gb = {bf_lo(g.z), bf_hi(g.z), bf_lo(g.w), bf_hi(g.w)};
                    store8(MB + ro + 32 * bj, acc[ai][bj][m][0] * ga, acc[ai][bj][m][1] * gb); } }
    }
};
struct EpiPlain {
    static constexpr bool HAS_MID = false;
    bf16_t* Z; int ldz;
    __device__ __forceinline__ void operator()(AccRef acc, const Unit& u, int wr, int wc, int fr, int fq) const {
        const int row0 = u.pm * BM + wr * 64 + fr, col0 = u.pn * BM + wc * 64 + 8 * fq;
#pragma unroll
        for (int ai = 0; ai < 2; ++ai)
#pragma unroll
            for (int m = 0; m < 4; ++m) { bf16_t* rowp = Z + (size_t)(row0 + ai * HALF + m * 16) * ldz + col0;
                store8(rowp, acc[ai][0][m][0], acc[ai][0][m][1]); store8(rowp + 32, acc[ai][1][m][0], acc[ai][1][m][1]); }
    }
};
}

namespace attn_body {
using bf16 = __hip_bfloat16;
using s16x4 = __attribute__((ext_vector_type(4))) short;
constexpr int NW = 8, QBLK = 32, QB = QBLK * NW, KVBLK = 64, D = 64;
__device__ __forceinline__ int crow(int r, int hi) { return (r & 3) + 8 * (r >> 2) + 4 * hi; }
#define SBAR() __builtin_amdgcn_sched_barrier(0)
constexpr int NSLOT = 3, SLOTB = 8192;
constexpr int LDS_K = 0, LDS_V = NSLOT * SLOTB, LDS_WS = 2 * NSLOT * SLOTB, LDS_OST = LDS_WS + NW * 64 * 4, LDS_BYTES = LDS_OST + NW * 4096;
__device__ __forceinline__ void glds16(const void* gsrc, unsigned lds_dst) { unsigned keep;
    asm volatile("s_mov_b32 %0, m0\n\ts_mov_b32 m0, %2\n\ts_nop 0\n\tglobal_load_lds_dwordx4 %1, off\n\ts_mov_b32 m0, %0" : "=&s"(keep) : "v"(gsrc), "s"(lds_dst) : "memory"); }
__device__ __forceinline__ float max3f(float a, float b, float c) { float r; asm("v_max3_f32 %0, %1, %2, %3" : "=v"(r) : "v"(a), "v"(b), "v"(c)); return r; }
__device__ __forceinline__ float max2f(float a, float b) { float r; asm("v_max_f32_e32 %0, %1, %2" : "=v"(r) : "v"(a), "v"(b)); return r; }
__device__ __forceinline__ float fadd_s(float a, float b) { float r; asm("v_add_f32_e32 %0, %1, %2" : "=v"(r) : "v"(a), "v"(b)); return r; }
__device__ __forceinline__ float fsub_s(float a, float b) { float r; asm("v_sub_f32_e32 %0, %1, %2" : "=v"(r) : "v"(a), "v"(b)); return r; }
typedef float f32x2_t __attribute__((ext_vector_type(2))); typedef __bf16 bf16x2_t __attribute__((ext_vector_type(2)));
__device__ __forceinline__ unsigned cvtpk_s(float lo, float hi) { f32x2_t v = {lo, hi}; bf16x2_t b = __builtin_convertvector(v, bf16x2_t); return __builtin_bit_cast(unsigned, b); }
#define WAIT_BAR(N) asm volatile("s_waitcnt vmcnt(" #N ") lgkmcnt(0)\n\ts_barrier" ::: "memory")

__device__ __forceinline__ void qkt(f32x16& p0, f32x16& p1, const char* Kslot, const bf16x8* qr, const f32x16& negm, int r32, int hi) {
    const char* kb = Kslot + hi * 1024 + r32 * 16;
#pragma unroll
    for (int d0 = 0; d0 < 4; ++d0) {
        const bf16x8 b0 = *reinterpret_cast<const bf16x8*>(kb + d0 * 2048);
        const bf16x8 b1 = *reinterpret_cast<const bf16x8*>(kb + d0 * 2048 + 512);
        if (d0 == 0) { p0 = __builtin_amdgcn_mfma_f32_32x32x16_bf16(b0, qr[0], negm, 0, 0, 0); p1 = __builtin_amdgcn_mfma_f32_32x32x16_bf16(b1, qr[0], negm, 0, 0, 0); }
        else { p0 = __builtin_amdgcn_mfma_f32_32x32x16_bf16(b0, qr[d0], p0, 0, 0, 0); p1 = __builtin_amdgcn_mfma_f32_32x32x16_bf16(b1, qr[d0], p1, 0, 0, 0); } }
}
typedef __attribute__((address_space(3))) const char* lds_cptr;
typedef short v4i16_t __attribute__((ext_vector_type(4)));
__device__ __forceinline__ void kload8(bf16x8* kf, lds_cptr kp) {
    kf[0] = *(const __attribute__((address_space(3))) bf16x8*)(kp);        kf[1] = *(const __attribute__((address_space(3))) bf16x8*)(kp + 512);
    kf[2] = *(const __attribute__((address_space(3))) bf16x8*)(kp + 2048); kf[3] = *(const __attribute__((address_space(3))) bf16x8*)(kp + 2560);
    kf[4] = *(const __attribute__((address_space(3))) bf16x8*)(kp + 4096); kf[5] = *(const __attribute__((address_space(3))) bf16x8*)(kp + 4608);
    kf[6] = *(const __attribute__((address_space(3))) bf16x8*)(kp + 6144); kf[7] = *(const __attribute__((address_space(3))) bf16x8*)(kp + 6656);
}
__device__ __forceinline__ void kload2(bf16x8* kf, lds_cptr kp, int j) { kf[2 * j] = *(const __attribute__((address_space(3))) bf16x8*)(kp + j * 2048); kf[2 * j + 1] = *(const __attribute__((address_space(3))) bf16x8*)(kp + j * 2048 + 512); }
__device__ __forceinline__ s16x4 vtr(lds_cptr p) { return __builtin_bit_cast(s16x4, __builtin_amdgcn_ds_read_tr16_b64_v4i16((__attribute__((address_space(3))) v4i16_t*)p)); }
__device__ __forceinline__ float rowmax(const f32x16& p0, const f32x16& p1) {
    float a = max3f(p0[0], p0[1], p1[0]), b = max3f(p0[2], p0[3], p1[1]); a = max3f(a, p1[2], p1[3]);
#pragma unroll
    for (int r = 4; r < 16; r += 4) { a = max3f(a, p0[r], p0[r + 1]); b = max3f(b, p0[r + 2], p0[r + 3]); a = max3f(a, p1[r], p1[r + 1]); b = max3f(b, p1[r + 2], p1[r + 3]); }
    const float m = max2f(a, b);
    auto rr = __builtin_amdgcn_permlane32_swap(__float_as_uint(m), __float_as_uint(m), false, false);
    return max2f(__uint_as_float(rr[0]), __uint_as_float(rr[1]));
}
__device__ __forceinline__ void pv(f32x16* o, int vb, bf16x8 pa0, bf16x8 pa1, bf16x8 pa2, bf16x8 pa3) {
#pragma unroll
    for (int d0 = 0; d0 < 2; ++d0) { s16x4 lo[4], hi[4];
#pragma unroll
        for (int ks = 0; ks < 4; ++ks) {
            asm volatile("ds_read_b64_tr_b16 %0,%1 offset:%c2" : "=&v"(lo[ks]) : "v"(vb), "i"(d0 * 4096 + ks * 1024) : "memory");
            asm volatile("ds_read_b64_tr_b16 %0,%1 offset:%c2" : "=&v"(hi[ks]) : "v"(vb), "i"(d0 * 4096 + ks * 1024 + 512) : "memory"); }
        asm volatile("s_waitcnt lgkmcnt(0)" ::: "memory"); SBAR();
#define PK(k) (bf16x8){lo[k][0], lo[k][1], lo[k][2], lo[k][3], hi[k][0], hi[k][1], hi[k][2], hi[k][3]}
        o[d0] = __builtin_amdgcn_mfma_f32_32x32x16_bf16(pa0, PK(0), o[d0], 0, 0, 0);
        o[d0] = __builtin_amdgcn_mfma_f32_32x32x16_bf16(pa1, PK(1), o[d0], 0, 0, 0);
        o[d0] = __builtin_amdgcn_mfma_f32_32x32x16_bf16(pa2, PK(2), o[d0], 0, 0, 0);
        o[d0] = __builtin_amdgcn_mfma_f32_32x32x16_bf16(pa3, PK(3), o[d0], 0, 0, 0);
#undef PK
    }
}
__device__ __forceinline__ void cmask(f32x16& p0, f32x16& p1, int jb, int wid) {
    if (jb > (wid >> 1)) {
#pragma unroll
        for (int r = 0; r < 16; ++r) { p0[r] = -INFINITY; p1[r] = -INFINITY; } }
}
template <int THRL, bool MASK> __device__ __forceinline__ void attn_unit(int q0, int NT, const bf16* Qh, int qp, const bf16* __restrict__ Kh, int kp, const bf16* __restrict__ Vh, int vp, bf16* Oh, int op, char* shm) {
    const int tid = threadIdx.x, lane = tid & 63, r32 = lane & 31, hi = lane >> 5; const int wid = __builtin_amdgcn_readfirstlane(tid >> 6);
    const bf16* Qw = Qh + (long)(q0 + wid * QBLK) * qp;
    const unsigned lds0 = (unsigned)(uintptr_t)shm;
    float* wsf = (float*)(shm + LDS_WS) + wid * 64;
    const bf16* ksrc = Kh + (long)lane * kp + wid * 8;
    const bf16* vsrc = Vh + (long)(16 * (wid & 3) + (lane >> 2)) * vp + (wid >> 2) * 32 + (lane & 3) * 8;
    const unsigned kdst = lds0 + LDS_K + wid * 1024, vdst = lds0 + LDS_V + wid * 1024;
#define DMA_K(t, slot) glds16(ksrc + (long)(t) * KVBLK * kp, (unsigned)__builtin_amdgcn_readfirstlane(kdst + (slot)))
#define DMA_V(t, slot) glds16(vsrc + (long)(t) * KVBLK * vp, (unsigned)__builtin_amdgcn_readfirstlane(vdst + (slot)))
    const int vb0 = (int)(lds0 + LDS_V) + ((lane >> 4) & 1) * 32 + (lane & 3) * 8 + (4 * hi + ((lane & 15) >> 2)) * 64;
    const char* Kbase = shm + LDS_K; bf16x8 kf[8];
    const lds_cptr shm3 = (lds_cptr)shm; const lds_cptr kp0 = shm3 + LDS_K + hi * 1024 + r32 * 16; const lds_cptr vp0 = shm3 + LDS_V + ((lane >> 4) & 1) * 32 + (lane & 3) * 8 + (4 * hi + ((lane & 15) >> 2)) * 64;
    DMA_K(0, 0); DMA_V(0, 0); DMA_K(1, SLOTB);
    bf16x8 qr[4];
#pragma unroll
    for (int d0 = 0; d0 < 4; ++d0) qr[d0] = *reinterpret_cast<const bf16x8*>(&Qw[(long)r32 * qp + d0 * 16 + hi * 8]);
    float mhat = 0.f, l_reg = 0.f; f32x16 o[2]; o[0] = f32x16{}; o[1] = f32x16{}; f32x16 negm = f32x16{}; asm volatile("" : "+v"(negm));
#define CMASK(P0, P1, t) do { if (MASK) { int jb_ = (t) - (NT - 4); if (jb_ >= 0) cmask(P0, P1, jb_, wid); } } while (0)
    bool resc = false;
#define START(P0, P1) do { const float rm = rowmax(P0, P1); resc = false; \
    { const float dl = rm; mhat = fadd_s(mhat, dl); \
      _Pragma("unroll") for (int r = 0; r < 16; ++r) { P0[r] = fsub_s(P0[r], dl); P1[r] = fsub_s(P1[r], dl); } \
      _Pragma("unroll") for (int r = 0; r < 16; ++r) negm[r] = -mhat; asm volatile("" : "+v"(negm)); } \
    _Pragma("unroll") for (int r = 0; r < 16; ++r) P0[r] = __builtin_amdgcn_exp2f(P0[r]); } while (0)
#define RESC() do { if (resc) { asm volatile("s_waitcnt lgkmcnt(0)" ::: "memory"); \
      _Pragma("unroll") for (int d_ = 0; d_ < 2; ++d_) _Pragma("unroll") for (int r = 0; r < 16; ++r) o[d_][r] *= wsf[crow(r, hi)]; } } while (0)
    f32x16 pA0, pA1, pB0, pB1;
    int sl_prev = 0, sl_cur = 0, sl_next = SLOTB;
#define ROT() do { sl_prev = sl_cur; sl_cur = sl_next; sl_next = (sl_next == (NSLOT - 1) * SLOTB) ? 0 : sl_next + SLOTB; } while (0)
    DMA_K(2, 2 * SLOTB);
    WAIT_BAR(3);
    qkt(pA0, pA1, Kbase, qr, negm, r32, hi); asm volatile("s_nop 15\n\ts_nop 7" : "+v"(pA0), "+v"(pA1)); CMASK(pA0, pA1, 0);
    START(pA0, pA1);
    _Pragma("unroll") for (int r = 0; r < 16; ++r) pA1[r] = __builtin_amdgcn_exp2f(pA1[r]);
    WAIT_BAR(0);
    DMA_K(3, 0); DMA_V(1, SLOTB);
    ROT();
    kload8(kf, kp0 + sl_cur);
    WAIT_BAR(2);
    s16x4 vlo[8], vhi[8]; u32x4 pw0, pw1, pw2, pw3;
#define PKW(P, B) cvtpk_s(P[B], P[B + 1])
#define PAF(k) __builtin_bit_cast(bf16x8, pw##k)
#define VFR(i) (bf16x8){vlo[i][0], vlo[i][1], vlo[i][2], vlo[i][3], vhi[i][0], vhi[i][1], vhi[i][2], vhi[i][3]}
#define PIN(x) asm volatile("" : "+v"(x))
#define MX3(a, b, c) __builtin_fmaxf(__builtin_fmaxf((a), (b)), (c))
#define GAPA(MF, A0, A1, A2, A3, W0, W1, PW) do { MF; sacc += A0; sacc += A1; sacc += A2; sacc += A3; PIN(sacc); W0; W1; PIN(PW); SBAR(); } while (0)
#define EX(v) __builtin_amdgcn_exp2f(v)
#define GAPB(MF, X, B) do { MF; X[B] = EX(X[B]); X[B + 1] = EX(X[B + 1]); X[B + 2] = EX(X[B + 2]); X[B + 3] = EX(X[B + 3]); PIN(X); SBAR(); } while (0)
#define VRD(i) do { vlo[i] = vtr(vp_ + (((i) >> 2) * 4096 + ((i) & 3) * 1024)); vhi[i] = vtr(vp_ + (((i) >> 2) * 4096 + ((i) & 3) * 1024 + 512)); } while (0)
#define KRD(G, j) do { if (G) { kload2(kf, kp0 + sl_next, j); SBAR(); } } while (0)
#define STEP(C0, C1, P0, P1, t, GK, GV, GL) do { SBAR(); \
    const lds_cptr vp_ = vp0 + sl_prev; \
    VRD(0); SBAR(); float sacc = (P0[0] + P0[1]); \
    GAPA(C0 = __builtin_amdgcn_mfma_f32_32x32x16_bf16(kf[0], qr[0], negm, 0, 0, 0), P0[2], P0[3], P0[4], P0[5],     pw0[0] = PKW(P0, 0), pw0[1] = PKW(P0, 2), pw0); \
    VRD(4); SBAR(); GAPA(C1 = __builtin_amdgcn_mfma_f32_32x32x16_bf16(kf[1], qr[0], negm, 0, 0, 0), P0[6], P0[7], P0[8], P0[9],     pw0[2] = PKW(P0, 4), pw0[3] = PKW(P0, 6), pw0); \
    VRD(1); SBAR(); GAPA(C0 = __builtin_amdgcn_mfma_f32_32x32x16_bf16(kf[2], qr[1], C0, 0, 0, 0),   P0[10], P0[11], P0[12], P0[13], pw1[0] = PKW(P0, 8), pw1[1] = PKW(P0, 10), pw1); \
    VRD(5); SBAR(); GAPA(C1 = __builtin_amdgcn_mfma_f32_32x32x16_bf16(kf[3], qr[1], C1, 0, 0, 0),   P0[14], P0[15], P1[0], P1[1],   pw1[2] = PKW(P0, 12), pw1[3] = PKW(P0, 14), pw1); \
    VRD(2); SBAR(); GAPA(C0 = __builtin_amdgcn_mfma_f32_32x32x16_bf16(kf[4], qr[2], C0, 0, 0, 0),   P1[2], P1[3], P1[4], P1[5],     pw2[0] = PKW(P1, 0), pw2[1] = PKW(P1, 2), pw2); \
    VRD(6); SBAR(); GAPA(C1 = __builtin_amdgcn_mfma_f32_32x32x16_bf16(kf[5], qr[2], C1, 0, 0, 0),   P1[6], P1[7], P1[8], P1[9],     pw2[2] = PKW(P1, 4), pw2[3] = PKW(P1, 6), pw2); \
    VRD(3); SBAR(); GAPA(C0 = __builtin_amdgcn_mfma_f32_32x32x16_bf16(kf[6], qr[3], C0, 0, 0, 0),   P1[10], P1[11], P1[12], P1[13], pw3[0] = PKW(P1, 8), pw3[1] = PKW(P1, 10), pw3); \
    VRD(7); SBAR(); GAPA(C1 = __builtin_amdgcn_mfma_f32_32x32x16_bf16(kf[7], qr[3], C1, 0, 0, 0),   P1[14], P1[15], 0.f, 0.f,       pw3[2] = PKW(P1, 12), pw3[3] = PKW(P1, 14), pw3); \
    l_reg += sacc; \
    if (GK) { DMA_K((t) + 3, sl_cur); } if (GV) { DMA_V((t) + 1, sl_next); } \
    CMASK(C0, C1, t); \
    { float a = MX3(C0[0], C0[1], C1[0]), b = MX3(C0[2], C0[3], C1[1]); a = MX3(a, C1[2], C1[3]); \
      _Pragma("unroll") for (int r = 4; r < 16; r += 4) { a = MX3(a, C0[r], C0[r + 1]); b = MX3(b, C0[r + 2], C0[r + 3]); a = MX3(a, C1[r], C1[r + 1]); b = MX3(b, C1[r + 2], C1[r + 3]); } \
      float rm = __builtin_fmaxf(a, b); { auto rr = __builtin_amdgcn_permlane32_swap(__float_as_uint(rm), __float_as_uint(rm), false, false); rm = __builtin_fmaxf(__uint_as_float(rr[0]), __uint_as_float(rr[1])); } \
      resc = false; \
      if (__builtin_expect(__any(rm > (float)THRL), 0)) { const float dl = __builtin_fmaxf(rm, 0.f); mhat += dl; \
        _Pragma("unroll") for (int r = 0; r < 16; ++r) { C0[r] -= dl; C1[r] -= dl; } \
        _Pragma("unroll") for (int r = 0; r < 16; ++r) negm[r] = -mhat; asm volatile("" : "+v"(negm)); \
        const float f = __builtin_amdgcn_exp2f(-dl); l_reg *= f; if (hi == 0) wsf[r32] = f; resc = true; } } \
    SBAR(); \
    GAPB(o[0] = __builtin_amdgcn_mfma_f32_32x32x16_bf16(PAF(0), VFR(0), o[0], 0, 0, 0), C0, 0); \
    GAPB(o[1] = __builtin_amdgcn_mfma_f32_32x32x16_bf16(PAF(0), VFR(4), o[1], 0, 0, 0), C0, 4); \
    KRD(GL, 0); GAPB(o[0] = __builtin_amdgcn_mfma_f32_32x32x16_bf16(PAF(1), VFR(1), o[0], 0, 0, 0), C0, 8); \
    KRD(GL, 1); GAPB(o[1] = __builtin_amdgcn_mfma_f32_32x32x16_bf16(PAF(1), VFR(5), o[1], 0, 0, 0), C0, 12); \
    KRD(GL, 2); GAPB(o[0] = __builtin_amdgcn_mfma_f32_32x32x16_bf16(PAF(2), VFR(2), o[0], 0, 0, 0), C1, 0); \
    KRD(GL, 3); GAPB(o[1] = __builtin_amdgcn_mfma_f32_32x32x16_bf16(PAF(2), VFR(6), o[1], 0, 0, 0), C1, 4); \
    GAPB(o[0] = __builtin_amdgcn_mfma_f32_32x32x16_bf16(PAF(3), VFR(3), o[0], 0, 0, 0), C1, 8); \
    GAPB(o[1] = __builtin_amdgcn_mfma_f32_32x32x16_bf16(PAF(3), VFR(7), o[1], 0, 0, 0), C1, 12); \
    } while (0)
    int t = 1;
#undef CMASK
#define CMASK(P0, P1, t) do {} while (0)
    for (; t + 5 < NT; t += 2) {
        STEP(pB0, pB1, pA0, pA1, t, true, true, true);     WAIT_BAR(2); RESC(); ROT();
        STEP(pA0, pA1, pB0, pB1, t + 1, true, true, true); WAIT_BAR(2); RESC(); ROT();
    }
#undef CMASK
#define CMASK(P0, P1, t) do { if (MASK) { int jb_ = (t) - (NT - 4); if (jb_ >= 0) cmask(P0, P1, jb_, wid); } } while (0)
#define ENDW(tt) do { if ((tt) + 3 < NT) { WAIT_BAR(2); } else if ((tt) + 2 < NT) { WAIT_BAR(1); } else { WAIT_BAR(0); } } while (0)
    for (; t + 1 < NT; t += 2) {
        STEP(pB0, pB1, pA0, pA1, t, (t + 3 < NT), (t + 1 < NT), (t + 1 < NT));       ENDW(t);     RESC(); ROT();
        STEP(pA0, pA1, pB0, pB1, t + 1, (t + 4 < NT), (t + 2 < NT), (t + 2 < NT));   ENDW(t + 1); RESC(); ROT();
    }
    STEP(pB0, pB1, pA0, pA1, NT - 1, false, false, false); RESC();
    { float sacc = pB0[0] + pB0[1]; _Pragma("unroll") for (int r = 2; r < 16; ++r) sacc += pB0[r]; _Pragma("unroll") for (int r = 0; r < 16; ++r) sacc += pB1[r]; l_reg += sacc;
      pw0 = (u32x4){PKW(pB0, 0), PKW(pB0, 2), PKW(pB0, 4), PKW(pB0, 6)}; pw1 = (u32x4){PKW(pB0, 8), PKW(pB0, 10), PKW(pB0, 12), PKW(pB0, 14)}; pw2 = (u32x4){PKW(pB1, 0), PKW(pB1, 2), PKW(pB1, 4), PKW(pB1, 6)}; pw3 = (u32x4){PKW(pB1, 8), PKW(pB1, 10), PKW(pB1, 12), PKW(pB1, 14)};
      SBAR(); pv(o, vb0 + sl_cur, PAF(0), PAF(1), PAF(2), PAF(3)); }
#undef PKW
#undef PAF
#undef VFR
#undef PIN
#undef MX3
#undef GAPA
#undef GAPB
#undef EX
#undef VRD
#undef KRD
#undef STEP
#undef ENDW
    { auto rr = __builtin_amdgcn_permlane32_swap(__float_as_uint(l_reg), __float_as_uint(l_reg), false, false); l_reg = __uint_as_float(rr[0]) + __uint_as_float(rr[1]); }
    if (hi == 0) wsf[32 + r32] = l_reg; asm volatile("s_waitcnt lgkmcnt(0)" ::: "memory");
    float rli[16];
#pragma unroll
    for (int r = 0; r < 16; ++r) rli[r] = __builtin_amdgcn_rcpf(wsf[32 + crow(r, hi)]);
    bf16* Ow = Oh + (long)(q0 + wid * QBLK) * op;
    { bf16* stg = (bf16*)(shm + LDS_OST) + wid * 2048;
#pragma unroll
      for (int r = 0; r < 16; ++r) { const int orow = crow(r, hi);
#pragma unroll
        for (int d0 = 0; d0 < 2; ++d0) stg[orow * 64 + d0 * 32 + r32] = __float2bfloat16(o[d0][r] * rli[r]); }
      asm volatile("s_waitcnt lgkmcnt(0)" ::: "memory");
#pragma unroll
      for (int i = 0; i < 4; ++i) { const int row = i * 8 + (lane >> 3), ch = lane & 7; const u32x4 v = *(const u32x4*)(stg + row * 64 + ch * 8); *(u32x4*)(Ow + (long)row * op + ch * 8) = v; } }
    asm volatile("s_waitcnt lgkmcnt(0)\n\ts_barrier" ::: "memory");
#undef DMA_K
#undef DMA_V
#undef CMASK
#undef START
#undef RESC
#undef ROT
}

constexpr int L2_K = 0, L2_V = 3 * 8192, L2_WS = L2_V + 4 * 16384, L2_OST = L2_WS + NW * 64 * 4, L2_BYTES = L2_OST + NW * 4096;
template <bool MASK> __device__ __forceinline__ void attn_unit2(int q0, int NT, const bf16* Qh, int qp, const bf16* __restrict__ Kh, int kp, const bf16* __restrict__ Vh, int vp, bf16* Oh, int op, char* shm) {
    const int tid = threadIdx.x, lane = tid & 63, r32 = lane & 31, hi = lane >> 5; const int wid = __builtin_amdgcn_readfirstlane(tid >> 6);
    const bf16* Qw = Qh + (long)(q0 + wid * QBLK) * qp;
    const unsigned lds0 = (unsigned)(uintptr_t)shm;
    float* wsf = (float*)(shm + L2_WS) + wid * 64;
    const bf16* ksrc = Kh + (long)lane * kp + wid * 8;
    const bf16* vsrc = Vh + (long)(16 * (wid & 3) + (lane >> 2)) * vp + (wid >> 2) * 32 + (lane & 3) * 8;
    const unsigned kdst = lds0 + L2_K + wid * 1024, vdst = lds0 + L2_V + wid * 1024;
#define DMA_K(t, slot) glds16(ksrc + (long)(t) * KVBLK * kp, (unsigned)__builtin_amdgcn_readfirstlane(kdst + (slot)))
#define DMA_V(t, vslot) do { glds16(vsrc + (long)(t) * KVBLK * vp, (unsigned)__builtin_amdgcn_readfirstlane(vdst + (vslot))); \
                            glds16(vsrc + (long)(t) * KVBLK * vp + 64, (unsigned)__builtin_amdgcn_readfirstlane(vdst + (vslot) + 8192)); } while (0)
    const int vb0 = (int)(lds0 + L2_V) + ((lane >> 4) & 1) * 32 + (lane & 3) * 8 + (4 * hi + ((lane & 15) >> 2)) * 64;
    const char* Kbase = shm + L2_K; bf16x8 kf[8];
    const lds_cptr shm3 = (lds_cptr)shm; const lds_cptr kp0 = shm3 + L2_K + hi * 1024 + r32 * 16; const lds_cptr vp0 = shm3 + L2_V + ((lane >> 4) & 1) * 32 + (lane & 3) * 8 + (4 * hi + ((lane & 15) >> 2)) * 64;
    DMA_K(0, 0); DMA_V(0, 0); DMA_K(1, SLOTB);
    bf16x8 qr[4];
#pragma unroll
    for (int d0 = 0; d0 < 4; ++d0) qr[d0] = *reinterpret_cast<const bf16x8*>(&Qw[(long)r32 * qp + d0 * 16 + hi * 8]);
    float l_reg = 0.f; f32x16 o[4]; o[0] = f32x16{}; o[1] = f32x16{}; o[2] = f32x16{}; o[3] = f32x16{};
    const f32x16 zero16 = f32x16{};
#define CMASK(P0, P1, t) do { if (MASK) { int jb_ = (t) - (NT - 4); if (jb_ >= 0) cmask(P0, P1, jb_, wid); } } while (0)
    f32x16 pA0, pA1, pB0, pB1;
    int sl_prev = 0, sl_cur = 0, sl_next = SLOTB;
    int vs_rd = 0, vs_wr = 3 * 16384;
#define ROT() do { sl_prev = sl_cur; sl_cur = sl_next; sl_next = (sl_next == (NSLOT - 1) * SLOTB) ? 0 : sl_next + SLOTB; vs_rd = (vs_rd + 16384) & 65535; vs_wr = (vs_wr + 16384) & 65535; } while (0)
    DMA_K(2, 2 * SLOTB); DMA_V(1, 16384);
    WAIT_BAR(6);
    qkt(pA0, pA1, Kbase, qr, zero16, r32, hi); CMASK(pA0, pA1, 0);
    _Pragma("unroll") for (int r = 0; r < 16; ++r) { pA0[r] = __builtin_amdgcn_exp2f(pA0[r]); pA1[r] = __builtin_amdgcn_exp2f(pA1[r]); }
    WAIT_BAR(2);
    DMA_K(3, 0); DMA_V(2, 2 * 16384);
    sl_prev = sl_cur; sl_cur = sl_next; sl_next = 2 * SLOTB;
    kload8(kf, kp0 + sl_cur);
    WAIT_BAR(5);
    s16x4 f0lo, f0hi, f1lo, f1hi, f2lo, f2hi, f3lo, f3hi; u32x4 pw0, pw1, pw2, pw3;
#define PKW(P, B) cvtpk_s(P[B], P[B + 1])
#define PAF(k) __builtin_bit_cast(bf16x8, pw##k)
#define PIN(x) asm volatile("" : "+v"(x))
#define EX(v) __builtin_amdgcn_exp2f(v)
#define VOFF(id) ((((id) >> 2) * 4096) + (((id) & 3) * 1024))
#define VRD2(F, id) do { F##lo = vtr(vp_ + VOFF(id)); F##hi = vtr(vp_ + VOFF(id) + 512); } while (0)
#define VFR2(F) (bf16x8){F##lo[0], F##lo[1], F##lo[2], F##lo[3], F##hi[0], F##hi[1], F##hi[2], F##hi[3]}
#define GAPA(MF, A0, A1, A2, A3, W0, W1, PW) do { MF; sacc += A0; sacc += A1; sacc += A2; sacc += A3; PIN(sacc); W0; W1; PIN(PW); SBAR(); } while (0)
#define GAPB(MF, RD, X, B) do { MF; RD; X[B] = EX(X[B]); X[B + 1] = EX(X[B + 1]); PIN(X); SBAR(); } while (0)
#define KRD(G, j) do { if (G) { kload2(kf, kp0 + sl_next, j); SBAR(); } } while (0)
#define MF32(a, b, c) __builtin_amdgcn_mfma_f32_32x32x16_bf16(a, b, c, 0, 0, 0)
#define STEP(C0, C1, P0, P1, t, GK, GV, GL) do { SBAR(); __builtin_amdgcn_s_setprio(ATTN_PRIO_A); \
    const lds_cptr vp_ = vp0 + vs_rd; \
    float sacc = (P0[0] + P0[1]); \
    GAPA(C0 = MF32(kf[0], qr[0], zero16), P0[2], P0[3], P0[4], P0[5],     pw0[0] = PKW(P0, 0), pw0[1] = PKW(P0, 2), pw0); \
    GAPA(C1 = MF32(kf[1], qr[0], zero16), P0[6], P0[7], P0[8], P0[9],     pw0[2] = PKW(P0, 4), pw0[3] = PKW(P0, 6), pw0); \
    GAPA(C0 = MF32(kf[2], qr[1], C0),     P0[10], P0[11], P0[12], P0[13], pw1[0] = PKW(P0, 8), pw1[1] = PKW(P0, 10), pw1); \
    GAPA(C1 = MF32(kf[3], qr[1], C1),     P0[14], P0[15], P1[0], P1[1],   pw1[2] = PKW(P0, 12), pw1[3] = PKW(P0, 14), pw1); \
    VRD2(f0, 0); SBAR();  GAPA(C0 = MF32(kf[4], qr[2], C0), P1[2], P1[3], P1[4], P1[5],     pw2[0] = PKW(P1, 0), pw2[1] = PKW(P1, 2), pw2); \
    VRD2(f1, 4); SBAR();  GAPA(C1 = MF32(kf[5], qr[2], C1), P1[6], P1[7], P1[8], P1[9],     pw2[2] = PKW(P1, 4), pw2[3] = PKW(P1, 6), pw2); \
    VRD2(f2, 8); SBAR();  GAPA(C0 = MF32(kf[6], qr[3], C0), P1[10], P1[11], P1[12], P1[13], pw3[0] = PKW(P1, 8), pw3[1] = PKW(P1, 10), pw3); \
    VRD2(f3, 12); SBAR(); GAPA(C1 = MF32(kf[7], qr[3], C1), P1[14], P1[15], 0.f, 0.f,       pw3[2] = PKW(P1, 12), pw3[3] = PKW(P1, 14), pw3); \
    l_reg += sacc; __builtin_amdgcn_s_setprio(0); \
    if (GK) { DMA_K((t) + 3, sl_cur); } if (GV) { DMA_V((t) + 2, vs_wr); } \
    CMASK(C0, C1, t); \
    SBAR(); __builtin_amdgcn_s_setprio(ATTN_PRIO_B); \
    GAPB(o[0] = MF32(PAF(0), VFR2(f0), o[0]), VRD2(f0, 1),  C0, 0); \
    GAPB(o[1] = MF32(PAF(0), VFR2(f1), o[1]), VRD2(f1, 5),  C0, 2); \
    GAPB(o[2] = MF32(PAF(0), VFR2(f2), o[2]), VRD2(f2, 9),  C0, 4); \
    GAPB(o[3] = MF32(PAF(0), VFR2(f3), o[3]), VRD2(f3, 13), C0, 6); \
    KRD(GL, 0); GAPB(o[0] = MF32(PAF(1), VFR2(f0), o[0]), VRD2(f0, 2),  C0, 8); \
    GAPB(o[1] = MF32(PAF(1), VFR2(f1), o[1]), VRD2(f1, 6),  C0, 10); \
    KRD(GL, 1); GAPB(o[2] = MF32(PAF(1), VFR2(f2), o[2]), VRD2(f2, 10), C0, 12); \
    GAPB(o[3] = MF32(PAF(1), VFR2(f3), o[3]), VRD2(f3, 14), C0, 14); \
    KRD(GL, 2); GAPB(o[0] = MF32(PAF(2), VFR2(f0), o[0]), VRD2(f0, 3),  C1, 0); \
    GAPB(o[1] = MF32(PAF(2), VFR2(f1), o[1]), VRD2(f1, 7),  C1, 2); \
    KRD(GL, 3); GAPB(o[2] = MF32(PAF(2), VFR2(f2), o[2]), VRD2(f2, 11), C1, 4); \
    GAPB(o[3] = MF32(PAF(2), VFR2(f3), o[3]), VRD2(f3, 15), C1, 6); \
    GAPB(o[0] = MF32(PAF(3), VFR2(f0), o[0]), (void)0, C1, 8); \
    GAPB(o[1] = MF32(PAF(3), VFR2(f1), o[1]), (void)0, C1, 10); \
    GAPB(o[2] = MF32(PAF(3), VFR2(f2), o[2]), (void)0, C1, 12); \
    GAPB(o[3] = MF32(PAF(3), VFR2(f3), o[3]), (void)0, C1, 14); __builtin_amdgcn_s_setprio(0); \
    } while (0)
    int t = 1;
#undef CMASK
#define CMASK(P0, P1, t) do {} while (0)
    for (; t + 5 < NT; t += 2) {
        STEP(pB0, pB1, pA0, pA1, t, true, true, true);     WAIT_BAR(5); ROT();
        STEP(pA0, pA1, pB0, pB1, t + 1, true, true, true); WAIT_BAR(5); ROT();
    }
#undef CMASK
#define CMASK(P0, P1, t) do { if (MASK) { int jb_ = (t) - (NT - 4); if (jb_ >= 0) cmask(P0, P1, jb_, wid); } } while (0)
#define ENDW(tt) do { if ((tt) + 3 < NT) { WAIT_BAR(5); } else if ((tt) + 2 < NT) { WAIT_BAR(4); } else { WAIT_BAR(0); } } while (0)
    for (; t + 1 < NT; t += 2) {
        STEP(pB0, pB1, pA0, pA1, t, (t + 3 < NT), (t + 2 < NT), (t + 1 < NT));       ENDW(t);     ROT();
        STEP(pA0, pA1, pB0, pB1, t + 1, (t + 4 < NT), (t + 3 < NT), (t + 2 < NT));   ENDW(t + 1); ROT();
    }
    STEP(pB0, pB1, pA0, pA1, NT - 1, false, false, false);
    { float sacc = pB0[0] + pB0[1]; _Pragma("unroll") for (int r = 2; r < 16; ++r) sacc += pB0[r]; _Pragma("unroll") for (int r = 0; r < 16; ++r) sacc += pB1[r]; l_reg += sacc;
      pw0 = (u32x4){PKW(pB0, 0), PKW(pB0, 2), PKW(pB0, 4), PKW(pB0, 6)}; pw1 = (u32x4){PKW(pB0, 8), PKW(pB0, 10), PKW(pB0, 12), PKW(pB0, 14)}; pw2 = (u32x4){PKW(pB1, 0), PKW(pB1, 2), PKW(pB1, 4), PKW(pB1, 6)}; pw3 = (u32x4){PKW(pB1, 8), PKW(pB1, 10), PKW(pB1, 12), PKW(pB1, 14)};
      SBAR();
      const lds_cptr vp_ = vp0 + ((vs_rd + 16384) & 65535);
#pragma unroll
      for (int db = 0; db < 4; ++db) { VRD2(f0, db * 4 + 0); VRD2(f1, db * 4 + 1); VRD2(f2, db * 4 + 2); VRD2(f3, db * 4 + 3);
          o[db] = MF32(PAF(0), VFR2(f0), o[db]); o[db] = MF32(PAF(1), VFR2(f1), o[db]); o[db] = MF32(PAF(2), VFR2(f2), o[db]); o[db] = MF32(PAF(3), VFR2(f3), o[db]); } }
#undef PKW
#undef PAF
#undef PIN
#undef EX
#undef VOFF
#undef VRD2
#undef VFR2
#undef GAPA
#undef GAPB
#undef KRD
#undef MF32
#undef STEP
#undef ENDW
    { auto rr = __builtin_amdgcn_permlane32_swap(__float_as_uint(l_reg), __float_as_uint(l_reg), false, false); l_reg = __uint_as_float(rr[0]) + __uint_as_float(rr[1]); }
    if (hi == 0) wsf[32 + r32] = l_reg; asm volatile("s_waitcnt lgkmcnt(0)" ::: "memory");
    float rli[16];
#pragma unroll
    for (int r = 0; r < 16; ++r) rli[r] = __builtin_amdgcn_rcpf(wsf[32 + crow(r, hi)]);
    bf16* Ow = Oh + (long)(q0 + wid * QBLK) * op;
    { bf16* stg = (bf16*)(shm + L2_OST) + wid * 2048;
#pragma unroll
      for (int dh = 0; dh < 2; ++dh) {
#pragma unroll
        for (int r = 0; r < 16; ++r) { const int orow = crow(r, hi);
#pragma unroll
          for (int d0 = 0; d0 < 2; ++d0) stg[orow * 64 + d0 * 32 + r32] = __float2bfloat16(o[dh * 2 + d0][r] * rli[r]); }
        asm volatile("s_waitcnt lgkmcnt(0)" ::: "memory");
#pragma unroll
        for (int i = 0; i < 4; ++i) { const int row = i * 8 + (lane >> 3), ch = lane & 7; const u32x4 v = *(const u32x4*)(stg + row * 64 + ch * 8); *(u32x4*)(Ow + (long)row * op + dh * 64 + ch * 8) = v; }
        asm volatile("s_waitcnt lgkmcnt(0)" ::: "memory"); } }
    asm volatile("s_waitcnt lgkmcnt(0)\n\ts_barrier" ::: "memory");
#undef DMA_K
#undef DMA_V
#undef CMASK
#undef ROT
}
#undef SBAR
#undef WAIT_BAR
}

#define XB_TMO      128
#define XB_XCNT(j)  (256  + 64 * (j))
#define XB_XSUB(j)  (1280 + 64 * (j))
#define XB_XGEN(j)  (2304 + 64 * (j))
#define XB_TOP      3328
#define XB_TOPGEN   3392
#define XCD_BAR_WORDS 3456
#define XB_SPIN_CAP (1u << 22)
__device__ __forceinline__ unsigned xb_ld(unsigned* p)              { return __hip_atomic_load(p, __ATOMIC_RELAXED, __HIP_MEMORY_SCOPE_AGENT); }
__device__ __forceinline__ unsigned xb_add(unsigned* p, unsigned v) { return __hip_atomic_fetch_add(p, v, __ATOMIC_RELAXED, __HIP_MEMORY_SCOPE_AGENT); }
__device__ __forceinline__ unsigned xb_xcc_id() { return (unsigned)__builtin_amdgcn_s_getreg((3 << 11) | 20) & 0xFu; }
#define XB_SPIN(cond, bar) do { unsigned _sp = 0; while (cond) { __builtin_amdgcn_s_sleep(1); \
    if ((++_sp & 255u) == 0u) { if (xb_ld(&(bar)[XB_TMO])) break; if (_sp > XB_SPIN_CAP) { atomicAdd(&(bar)[XB_TMO], 1u); break; } } } } while (0)
struct XcdBarrier { unsigned* bar; unsigned x; volatile LAS unsigned* st; };
__device__ __forceinline__ XcdBarrier xcd_barrier_post(unsigned* bar, volatile LAS unsigned* st) {
    XcdBarrier b; b.bar = bar; b.x = xb_xcc_id(); b.st = st;
    if (threadIdx.x == 0) (void)xb_add(&bar[XB_XCNT(b.x)], 1u);
    return b;
}
__device__ __forceinline__ void xcd_barrier_complete(unsigned* bar, unsigned x, unsigned& nloc, unsigned& nx) {
    const unsigned G = gridDim.x * gridDim.y * gridDim.z;
    unsigned sum, cnt, mine, sp = 0u;
    for (;;) {
        sum = 0u; cnt = 0u; mine = 0u;
#pragma unroll
        for (unsigned j = 0; j < 16; ++j) { const unsigned c = xb_ld(&bar[XB_XCNT(j)]); sum += c; cnt += (c > 0u) ? 1u : 0u; mine = (j == x) ? c : mine; }
        if (sum == G) break;
        __builtin_amdgcn_s_sleep(1);
        if ((++sp & 255u) == 0u) { if (xb_ld(&bar[XB_TMO])) break; if (sp > XB_SPIN_CAP) { atomicAdd(&bar[XB_TMO], 1u); break; } }
    }
    nloc = mine > 0u ? mine : 1u; nx = cnt > 0u ? cnt : 1u;
}
__device__ __forceinline__ void xcd_barrier(const XcdBarrier& b) {
    asm volatile("s_waitcnt vmcnt(0)" ::: "memory");
    __syncthreads();
    if (threadIdx.x == 0) {
        unsigned* bar = b.bar;
        __builtin_amdgcn_s_waitcnt(0);
        unsigned nloc = b.st[0], nx = b.st[1];
        if (nloc == 0u) { xcd_barrier_complete(bar, b.x, nloc, nx); b.st[0] = nloc; b.st[1] = nx; }
        const unsigned old = xb_add(&bar[XB_XSUB(b.x)], 1u);
        const unsigned gen = old / nloc;
        if (old + 1u == (gen + 1u) * nloc) {
            __builtin_amdgcn_fence(__ATOMIC_RELEASE, "agent");
            asm volatile("s_waitcnt vmcnt(0)" ::: "memory");
            const unsigned og = xb_add(&bar[XB_TOP], 1u);
            const unsigned tg = og / nx;
            if (og + 1u == (tg + 1u) * nx) xb_add(&bar[XB_TOPGEN], 1u);
            else XB_SPIN(xb_ld(&bar[XB_TOPGEN]) == tg, bar);
            __builtin_amdgcn_fence(__ATOMIC_ACQUIRE, "agent");
            xb_add(&bar[XB_XGEN(b.x)], 1u);
            asm volatile("s_waitcnt vmcnt(0)" ::: "memory");
        } else {
            XB_SPIN(xb_ld(&bar[XB_XGEN(b.x)]) == gen, bar);
            __builtin_amdgcn_fence(__ATOMIC_ACQUIRE, "agent");
            asm volatile("s_waitcnt vmcnt(0)" ::: "memory");
        }
    }
    __syncthreads();
}

constexpr int RING_BYTES = 131072;
constexpr int MISC_OFF = RING_BYTES;
constexpr int LDS_BYTES = 147456;
constexpr int NWAVES = 8;

struct Args {
    const float* in[29]; float* out; unsigned char* ws; int ph_lo, ph_hi;
};
enum { I_X = 0, I_MEM, I_NORM1, I_WIN, I_BGATE, I_QN, I_KN, I_LQ1, I_LK1, I_LQ2, I_LK2, I_SUBLN, I_WPOOL, I_PSCALE, I_MEMNORM, I_WMKV, I_MQN, I_MKN, I_WBRD, I_WBRP, I_WBRM, I_WOUT, I_NORM2,
       I_WROUTER, I_BROUTER, I_WGU, I_BGU, I_WD, I_BD };

__device__ __forceinline__ unsigned f2bf(float f) { unsigned u = __builtin_bit_cast(unsigned, f); return (u + 0x7fffu + ((u >> 16) & 1u)) >> 16; }
__device__ __forceinline__ unsigned pk2(float lo, float hi) { return f2bf(lo) | (f2bf(hi) << 16); }
__device__ __forceinline__ void p0_transpose_item(const float* W, int K, int N, bf16_t* WT, LAS float* scr, int item, int lane, int ldo = 0) {
    if (ldo == 0) ldo = K;
    const int nblk = N / 64, kb = item / nblk, nb = item % nblk, k0 = 64 * kb, n0 = 64 * nb;
    const int kr = lane >> 3, n4 = (lane & 7) * 4;
    f32x4 v[16];
#pragma unroll
    for (int i = 0; i < 16; ++i) v[i] = *(const f32x4*)(W + (size_t)(k0 + 8 * (i & 7) + kr) * N + n0 + 32 * (i >> 3) + n4);
#pragma unroll
    for (int h = 0; h < 2; ++h) {
#pragma unroll
        for (int i = 0; i < 8; ++i)
#pragma unroll
            for (int j = 0; j < 4; ++j) scr[(n4 + j) * 68 + 8 * i + kr] = v[h * 8 + i][j];
        LDS_WAIT(); asm volatile("" ::: "memory");
        const int c = lane & 7;
#pragma unroll
        for (int jj = 0; jj < 4; ++jj) { const int nrow = 8 * jj + (lane >> 3); const LAS f32x4* sp = (const LAS f32x4*)(scr + nrow * 68 + 8 * c);
            const f32x4 a = sp[0], b = sp[1];
            u32x4 o; o.x = pk2(a[0], a[1]); o.y = pk2(a[2], a[3]); o.z = pk2(b[0], b[1]); o.w = pk2(b[2], b[3]);
            *(u32x4*)(WT + (size_t)(n0 + 32 * h + nrow) * ldo + k0 + 8 * c) = o; }
        LDS_WAIT(); asm volatile("" ::: "memory");
    }
}
__device__ __forceinline__ void p0_transpose_item_f8(const float* W, int K, int N, unsigned char* WT, LAS float* scr, int item, int lane) {
    const int nblk = N / 64, kb = item / nblk, nb = item % nblk, k0 = 64 * kb, n0 = 64 * nb;
    const int kr = lane >> 3, n4 = (lane & 7) * 4;
    f32x4 v[16];
#pragma unroll
    for (int i = 0; i < 16; ++i) v[i] = *(const f32x4*)(W + (size_t)(k0 + 8 * (i & 7) + kr) * N + n0 + 32 * (i >> 3) + n4);
#pragma unroll
    for (int h = 0; h < 2; ++h) {
#pragma unroll
        for (int i = 0; i < 8; ++i)
#pragma unroll
            for (int j = 0; j < 4; ++j) scr[(n4 + j) * 68 + 8 * i + kr] = v[h * 8 + i][j];
        LDS_WAIT(); asm volatile("" ::: "memory");
        const int c = lane & 7;
#pragma unroll
        for (int jj = 0; jj < 4; ++jj) { const int nrow = 8 * jj + (lane >> 3); const LAS f32x4* sp = (const LAS f32x4*)(scr + nrow * 68 + 8 * c);
            const f32x4 a = sp[0] * W8_SCALE, b = sp[1] * W8_SCALE;
            u32x2 o; o.x = pk4_fp8(a[0], a[1], a[2], a[3]); o.y = pk4_fp8(b[0], b[1], b[2], b[3]);
            *(u32x2*)(WT + (size_t)(n0 + 32 * h + nrow) * K + k0 + 8 * c) = o; }
        LDS_WAIT(); asm volatile("" ::: "memory");
    }
}
__device__ __forceinline__ void rms_row_to_bf16(const float* xrow, const float* gain, bf16_t* orow, int lane) {
    const f32x4* xr = (const f32x4*)xrow + lane; const f32x4* gr = (const f32x4*)gain + lane;
    f32x4 v[4]; float s = 0.f;
#pragma unroll
    for (int j = 0; j < 4; ++j) { v[j] = xr[64 * j]; s += (v[j].x * v[j].x + v[j].y * v[j].y) + (v[j].z * v[j].z + v[j].w * v[j].w); }
    const float rstd = 1.f / sqrtf(wave_sum(s) * (1.f / 1024.f) + RMS_EPS);
    u32x2* o8 = (u32x2*)orow + lane;
#pragma unroll
    for (int j = 0; j < 4; ++j) { const f32x4 g = gr[64 * j]; u32x2 w; w.x = pk2(v[j].x * rstd * g.x, v[j].y * rstd * g.y); w.y = pk2(v[j].z * rstd * g.z, v[j].w * rstd * g.w); o8[64 * j] = w; }
}

__device__ __forceinline__ void cvt_item64_f8(const float* W, int K, int N, unsigned char* WT, int item, int lane) {
    const int nblk = N / 64, kb = item / nblk, nb = item % nblk, k0 = 64 * kb, n0 = 64 * nb;
    const char* base = (const char*)(W + (size_t)k0 * N + n0);
    unsigned off = (unsigned)lane * 4u; const unsigned rstep = (unsigned)N * 4u;
    float v[64];
#pragma unroll
    for (int j = 0; j < 64; ++j) { v[j] = __builtin_nontemporal_load((const float*)(base + off)); off += rstep; }
    unsigned char* dst = WT + (size_t)(n0 + lane) * K + k0;
#pragma unroll
    for (int c = 0; c < 4; ++c) { u32x4 o;
#pragma unroll
        for (int q = 0; q < 4; ++q) { int r = __builtin_amdgcn_cvt_pk_fp8_f32(v[16 * c + 4 * q] * W8_SCALE, v[16 * c + 4 * q + 1] * W8_SCALE, 0, false);
            r = __builtin_amdgcn_cvt_pk_fp8_f32(v[16 * c + 4 * q + 2] * W8_SCALE, v[16 * c + 4 * q + 3] * W8_SCALE, r, true); o[q] = (unsigned)r; }
        *(u32x4*)(dst + 16 * c) = o; }
}
struct CvtJob {
    const float* wgu; const float* wd; unsigned char* wgu_t; unsigned char* wd_t; int ngw, gw, lane;
    __device__ __forceinline__ void item(int j) const {
        const int it = gw + j * ngw; if (it >= 24576) return;
        const bool gu = it < 16384; const int r = gu ? it : it - 16384, e = gu ? (r >> 9) : (r >> 8), idx = gu ? (r & 511) : (r & 255), N = gu ? 2048 : 1024;
        const float* W = gu ? wgu + (size_t)e * 1024 * 2048 : wd + (size_t)e * 1024 * 1024; unsigned char* WT = gu ? wgu_t + (size_t)e * 2048 * 1024 : wd_t + (size_t)e * 1024 * 1024;
        cvt_item64_f8(W, 1024, N, WT, idx, lane);
    }
};
struct PostCvt { CvtJob J; int jbase, jend; __device__ __forceinline__ void operator()(int ui) const { const int j = jbase + ui; if (j < jend) J.item(j); } };
struct Args;
typedef __attribute__((address_space(4))) const Args* kargs_t;
__device__ __forceinline__ kargs_t kargs() { kargs_t p = (kargs_t)__builtin_amdgcn_kernarg_segment_ptr(); asm volatile("" : "+s"(p)); return p; }
__global__ void __launch_bounds__(NWAVES * 64, 2) fwd_kernel(Args args) {
    extern __shared__ __attribute__((aligned(16))) unsigned char lds_raw[];
    cg::grid_group grid = cg::this_grid();
    LAS unsigned char* lds = (LAS unsigned char*)lds_raw;
    const int tid = threadIdx.x, lane = tid & 63, wave = __builtin_amdgcn_readfirstlane(tid >> 6);
    const int G = gridDim.x, bx = blockIdx.x; const int vcu = (G % 8 == 0) ? (bx % 8) * (G / 8) + bx / 8 : bx;
    const int gw = vcu * NWAVES + wave, NGW = G * NWAVES;
    const int lo = args.ph_lo, hi = args.ph_hi;
    if (tid < 64) ((LAS unsigned*)(lds + MISC_OFF + 1024))[tid] = 0u;
    __syncthreads();
    const XcdBarrier xbar = xcd_barrier_post((unsigned*)(args.ws + WS_CTL) + CW_BAR, (volatile LAS unsigned*)(lds + MISC_OFF + 1024));
#ifndef PHMASK
#define PHMASK 0x3ff
#endif
#define IN(k) (((PHMASK >> (k)) & 1) && lo <= (k) && (k) < hi)
#define GSYNC() do { asm volatile("s_waitcnt vmcnt(0) lgkmcnt(0)" ::: "memory"); __syncthreads(); grid.sync(); asm volatile("s_waitcnt vmcnt(0)" ::: "memory"); __syncthreads(); } while (0)
#define SEAM(k) do { if (lo <= (k) && (k) + 1 < hi) { xcd_barrier(xbar); } } while (0)
#define WSP(TY, off) ((TY*)(ka->ws + (off)))
#define WIN_T WSP(bf16_t, WS_WIN_T)
#define WBRD_T WSP(bf16_t, WS_WBRD_T)
#define WBRP_T WSP(bf16_t, WS_WBRP_T)
#define WBRM_T WSP(bf16_t, WS_WBRM_T)
#define WOUT_T WSP(bf16_t, WS_WOUT_T)
#define WMKV_T WSP(bf16_t, WS_WMKV_T)
#define WGU_T WSP(bf16_t, WS_WGU_T)
#define WD_T WSP(bf16_t, WS_WD_T)
#define XN WSP(bf16_t, WS_XN)
#define Qb WSP(bf16_t, WS_Q)
#define Kb WSP(bf16_t, WS_K)
#define Vb WSP(bf16_t, WS_V)
#define Ub WSP(bf16_t, WS_U)
#define MQb WSP(bf16_t, WS_MQ)
#define OC WSP(bf16_t, WS_OC)
#define GATES WSP(bf16_t, WS_GATES)
#define YCAT WSP(bf16_t, WS_YCAT)
#define MERGF WSP(float, WS_MERGF)
#define MERGB WSP(bf16_t, WS_MERGB)
#define XG WSP(bf16_t, WS_XG)
#define ACT WSP(bf16_t, WS_A)
#define Y4 WSP(bf16_t, WS_B)
#define MEMN WSP(bf16_t, WS_MEMN)
#define MKV WSP(bf16_t, WS_MKV)
#define ROPE WSP(f32x2, WS_ROPE)
#define WR2 WSP(float, WS_WR2)
#define ROUTEW WSP(float, WS_ROUTEW)
#define LAMP WSP(float, WS_LAM)
#define LIST WSP(u32x2, WS_LIST)
#define CNT WSP(unsigned, WS_CTL)
#define OUT (ka->out)
#define KA const kargs_t ka = kargs()

    if (lo > 1000) GSYNC();
    if (IN(0)) for (int rep_ = 0; rep_ < 1 + ((REPEAT_MASK >> 0) & 1); ++rep_) { KA; if (rep_) __syncthreads();
        LAS float* scr = (LAS float*)(lds + wave * 16384);
        constexpr int I0 = 16 * 80, I1 = 8 * 16, I2 = 4 * 16, I3 = 4 * 16, I4 = 16 * 16, I5 = 16 * 8, I6 = 0, I7 = 0;
        constexpr int NITEMS = I0 + I1 + I2 + I3 + I4 + I5 + I6 + I7;
        for (int it = gw; it < NITEMS; it += NGW) {
            int r = it;
            if (r < I0) { p0_transpose_item(ka->in[I_WIN], 1024, 5120, WIN_T, scr, r, lane); continue; } r -= I0;
            if (r < I1) { p0_transpose_item(ka->in[I_WBRD], 512, 1024, WBRD_T, scr, r, lane, 1024); continue; } r -= I1;
            if (r < I2) { p0_transpose_item(ka->in[I_WBRP], 256, 1024, WBRD_T + 512, scr, r, lane, 1024); continue; } r -= I2;
            if (r < I3) { p0_transpose_item(ka->in[I_WBRM], 256, 1024, WBRD_T + 768, scr, r, lane, 1024); continue; } r -= I3;
            if (r < I4) { p0_transpose_item(ka->in[I_WOUT], 1024, 1024, WOUT_T, scr, r, lane); continue; } r -= I4;
            p0_transpose_item(ka->in[I_WMKV], 1024, 512, WMKV_T, scr, r, lane);
        }
        for (int m = gw; m < T; m += NGW) rms_row_to_bf16(ka->in[I_X] + (size_t)m * 1024, ka->in[I_NORM1], XN + (size_t)m * 1024, lane);
        for (int m = gw; m < BATCH * MEMLEN; m += NGW) rms_row_to_bf16(ka->in[I_MEM] + (size_t)m * 1024, ka->in[I_MEMNORM], MEMN + (size_t)m * 1024, lane);
        for (int i = bx * 512 + tid; i < SEQ * 32; i += G * 512) { const int pos = i >> 5, j = i & 31;
            const float inv = 1.0f / powf(10000.0f, (float)(2 * j) / 64.0f); const float ang = (float)pos * inv;
            const double a = (double)ang; const double k = rint(a * 0.15915494309189535); const float red = (float)(a - k * 6.283185307179586);
            ROPE[i] = (f32x2){cosf(red), sinf(red)}; }
        for (int i = bx * 512 + tid; i < 1024 * 32; i += G * 512) { const int ii = i & 3, e = (i >> 2) & 15, kq = (i >> 6) & 3, eb = (i >> 8) & 1, s = i >> 9; const int k = 16 * s + 4 * kq + ii;
            WR2[i] = ka->in[I_NORM2][k] * ka->in[I_WROUTER][k * 32 + eb * 16 + e]; }
        if (bx == 0 && wave == 0) { const float s1 = wave_sum(ka->in[I_LQ1][lane] * ka->in[I_LK1][lane]), s2 = wave_sum(ka->in[I_LQ2][lane] * ka->in[I_LK2][lane]);
            if (lane == 0) LAMP[0] = expf(s1) - expf(s2) + 0.2f; }
    }
    SEAM(0);
    if (IN(1)) for (int rep_ = 0; rep_ < 1 + ((REPEAT_MASK >> 1) & 1); ++rep_) { KA; if (rep_) __syncthreads();
#if defined(TAP) && TAP == 6
        { pg8::DenseProb P{XN, WIN_T, 1024, 1024, 1024}; pg8::StaticOrder S; S.init(T, INW, G, bx);
          pg8::EpiPlain E{WSP(bf16_t, WS_B), 5120};
          pg8::gemm_phase<pg8::EpiPlain, pg8::DenseProb, pg8::StaticOrder, true>(lds, P, S, E); }
#else
        const CvtJob J{ka->in[I_WGU], ka->in[I_WD], (unsigned char*)WGU_T, (unsigned char*)WD_T, NGW, gw, lane};
        const int kpre = bx & 7;
        for (int j = 0; j < kpre; ++j) J.item(j);
        { pg8::DenseProb P{XN, WIN_T, 1024, 1024, 1024}; pg8::StaticOrder S0; S0.init(T, INW, G, bx); const pg8::TableOrder S = pg8::build_unit_table(S0, (LAS int*)(lds + MISC_OFF + 2048));
          pg8::EpiInProj E{Qb, Kb, Vb, Ub, MQb, GATES, ka->in[I_QN], ka->in[I_KN], ka->in[I_MQN], ka->in[I_BGATE], ROPE};
          const PostCvt PU{J, kpre, 12};
          pg8::gemm_phase<pg8::EpiInProj, pg8::DenseProb, pg8::TableOrder, ALIGN_EPI_SEL, PostCvt>(lds, P, S, E, PU); }
        for (int j = kpre + 10; j < 12; ++j) J.item(j);
#endif
        { pg8::DenseProb P{MEMN, WMKV_T, 1024, 1024, 1024}; pg8::StaticOrder S; S.init(BATCH * MEMLEN, 512, G, bx);
          pg8::EpiMemKV E{MKV, ka->in[I_MKN]};
          pg8::gemm_phase<pg8::EpiMemKV, pg8::DenseProb, pg8::StaticOrder, true>(lds, P, S, E); }
    }
    SEAM(1);
    if (IN(2)) for (int rep_ = 0; rep_ < 1 + ((REPEAT_MASK >> 2) & 1); ++rep_) { KA; if (rep_) __syncthreads();
        using abf = attn_body::bf16;
        {
            const int bh = vcu >> 4, b = bh >> 2, h = bh & 3, s = vcu & 15; const size_t rb = (size_t)b * SEQ;
            const float lam = LAMP[0];
            for (int i2 = 0; i2 < 4 * (1 + ((REPEAT_MASK >> 10) & 1)); ++i2) { const int ii = i2 & 3, c = ii & 1; const int qb = (ii < 2) ? s : 31 - s;
                attn_body::attn_unit2<true>(qb * 256, 4 * qb + 4, (const abf*)Qb + rb * 512 + (c * 4 + h) * 64, 512, (const abf*)Kb + rb * 512 + (c * 4 + h) * 64, 512,
                                            (const abf*)Vb + rb * 512 + h * 128, 512, (abf*)OC + rb * 1024 + (c * 4 + h) * 128, 1024, (char*)lds_raw);
                if (c == 1) {
                    asm volatile("s_waitcnt vmcnt(0)" ::: "memory");
#pragma unroll 1
                    for (int ps = 0; ps < 2; ++ps) {
                    const int row = ps * 16 + (lane >> 2), dq = (lane & 3) * 32; const size_t t = rb + (size_t)qb * 256 + wave * 32 + row;
                    const bf16_t* p0 = OC + t * 1024 + h * 128 + dq; const bf16_t* p1 = p0 + 512;
                    u32x4 a[4], bb[4];
#pragma unroll
                    for (int j = 0; j < 4; ++j) { a[j] = *(const u32x4*)(p0 + 8 * j); bb[j] = *(const u32x4*)(p1 + 8 * j); }
                    float ss = 0.f; f32x4 y[4][2];
#pragma unroll
                    for (int j = 0; j < 4; ++j) {
                        y[j][0] = (f32x4){bf_lo(a[j].x) - lam * bf_lo(bb[j].x), bf_hi(a[j].x) - lam * bf_hi(bb[j].x), bf_lo(a[j].y) - lam * bf_lo(bb[j].y), bf_hi(a[j].y) - lam * bf_hi(bb[j].y)};
                        y[j][1] = (f32x4){bf_lo(a[j].z) - lam * bf_lo(bb[j].z), bf_hi(a[j].z) - lam * bf_hi(bb[j].z), bf_lo(a[j].w) - lam * bf_lo(bb[j].w), bf_hi(a[j].w) - lam * bf_hi(bb[j].w)};
#pragma unroll
                        for (int q = 0; q < 4; ++q) ss += y[j][0][q] * y[j][0][q] + y[j][1][q] * y[j][1][q]; }
                    ss += __shfl_xor(ss, 1); ss += __shfl_xor(ss, 2);
                    const float rstd = 0.8f / sqrtf(ss * (1.0f / 128.0f) + RMS_EPS);
                    const float* sg = ka->in[I_SUBLN] + dq; bf16_t* yo = YCAT + t * 1024 + h * 128 + dq;
#pragma unroll
                    for (int j = 0; j < 4; ++j) { const f32x4 s0 = *(const f32x4*)(sg + 8 * j), s1 = *(const f32x4*)(sg + 8 * j + 4); pg8::store8(yo + 8 * j, y[j][0] * rstd * s0, y[j][1] * rstd * s1); }
                    }
                }
            }
        }
        {
            for (int i = 0; i < 2; ++i) { const int idx = vcu * 2 + i; if (idx >= 512) break; const int b = idx >> 7, h = (idx >> 5) & 3, qb = idx & 31;
                attn_body::attn_unit<8, false>(qb * 256, 4, (const abf*)MQb + (size_t)b * SEQ * 256 + h * 64, 256, (const abf*)MKV + (size_t)b * MEMLEN * 512 + h * 64, 512,
                                               (const abf*)MKV + (size_t)b * MEMLEN * 512 + 256 + h * 64, 512, (abf*)YCAT + (size_t)b * SEQ * 1024 + 768 + h * 64, 1024, (char*)lds_raw); }
        }
        {
            LAS bf16_t* ul = (LAS bf16_t*)lds;
            LAS bf16_t* pb = (LAS bf16_t*)(lds + 24576);
            const int col = tid & 255, half = tid >> 8, w = 2 << (col >> 6);
            const int mg = wave & 3, mdh = wave >> 2, r32 = lane & 31, hh = lane >> 5;
            bf16x8 bw[4];
#pragma unroll
            for (int sx = 0; sx < 4; ++sx) { const float* wp = ka->in[I_WPOOL] + (size_t)(mg * 64 + 16 * sx + 8 * hh) * 64 + mdh * 32 + r32;
                u32x4 pk; pk.x = pk2(wp[0], wp[64]); pk.y = pk2(wp[128], wp[192]); pk.z = pk2(wp[256], wp[320]); pk.w = pk2(wp[384], wp[448]); bw[sx] = __builtin_bit_cast(bf16x8, pk); }
            const int ocol = mg * 64 + mdh * 32 + r32; const float psc = ka->in[I_PSCALE][ocol];
            for (int tile = vcu; tile < T / 32; tile += G) {
                const int t0 = tile * 32, p0 = t0 & (SEQ - 1);
                __syncthreads();
                for (int pc = tid; pc < 47 * 32; pc += 512) { const int r = pc >> 5, ch = pc & 31; const int pos = p0 - 15 + r;
                    u32x4 v = {0u, 0u, 0u, 0u}; if (pos >= 0) v = *(const u32x4*)(Ub + (size_t)(t0 - 15 + r) * 256 + ch * 8);
                    *(LAS u32x4*)(ul + r * 256 + ch * 8) = v; }
                __syncthreads();
                {
                    float sum = 0.f; const int rbase = 15 + 16 * half;
                    for (int i = 1; i < w; ++i) sum += __uint_as_float((unsigned)ul[(rbase - i) * 256 + col] << 16);
#pragma unroll
                    for (int tk = 0; tk < 16; ++tk) { const float ucur = __uint_as_float((unsigned)ul[(rbase + tk) * 256 + col] << 16); sum += ucur;
                        const int pos = p0 + 16 * half + tk; const float cnt = (float)((pos + 1 < w) ? pos + 1 : w);
                        pb[(16 * half + tk) * 264 + col] = (bf16_t)f2bf(sum / cnt - ucur);
                        sum -= __uint_as_float((unsigned)ul[(rbase + tk - (w - 1)) * 256 + col] << 16); }
                }
                __syncthreads();
                f32x16 acc = f32x16{};
#pragma unroll
                for (int sx = 0; sx < 4; ++sx) { const bf16x8 af = *(const LAS bf16x8*)(pb + r32 * 264 + mg * 64 + 16 * sx + 8 * hh);
                    acc = __builtin_amdgcn_mfma_f32_32x32x16_bf16(af, bw[sx], acc, 0, 0, 0); }
#pragma unroll
                for (int r = 0; r < 16; ++r) { const int tok = t0 + (r & 3) + 8 * (r >> 2) + 4 * hh; YCAT[(size_t)tok * 1024 + 512 + ocol] = (bf16_t)f2bf(acc[r] * psc); }
            }
            __syncthreads();
        }
    }
    SEAM(2);
    if (IN(4)) for (int rep_ = 0; rep_ < 1 + ((REPEAT_MASK >> 4) & 1); ++rep_) { KA; if (rep_) __syncthreads();
        pg8::StaticOrder S0; S0.init(T, 1024, G, bx); const pg8::TableOrder S = pg8::build_unit_table(S0, (LAS int*)(lds + MISC_OFF + 2048));
        pg8::DenseProb P{YCAT, WBRD_T, 1024, 1024, 1024}; pg8::EpiMergeR E{GATES, MERGB};
        pg8::gemm_phase<pg8::EpiMergeR, pg8::DenseProb, pg8::TableOrder, ALIGN_EPI_SEL>(lds, P, S, E);
    }
    SEAM(4);
    if (IN(5)) for (int rep_ = 0; rep_ < 1 + ((REPEAT_MASK >> 5) & 1); ++rep_) { KA; if (rep_) __syncthreads();
        pg8::DenseProb P{MERGB, WOUT_T, 1024, 1024, 1024}; pg8::StaticOrder S0; S0.init(T, 1024, G, bx); const pg8::TableOrder S = pg8::build_unit_table(S0, (LAS int*)(lds + MISC_OFF + 2048));
        pg8::EpiWout E{ka->in[I_X], OUT, (unsigned char*)XG, ka->in[I_NORM2]};
        pg8::gemm_phase<pg8::EpiWout, pg8::DenseProb, pg8::TableOrder, ALIGN_EPI_SEL>(lds, P, S, E);
    }
    SEAM(5);
    if (IN(6)) { KA;
        LAS int* lcnt = (LAS int*)(lds + MISC_OFF); LAS int* lbase = lcnt + 32;
        const int ngroups = T / 16, rounds = (ngroups + NGW - 1) / NGW;
        for (int rd = 0; rd < rounds; ++rd) {
            const int grp = rd * NGW + gw; const bool valid = grp < ngroups;
            if (tid < 32) lcnt[tid] = 0;
            __syncthreads();
            int e_sel = 0, rank = 0; float w_sel = 0.f, rstd = 0.f; const int q = lane >> 4, tok = grp * 16 + (lane & 15);
            if (valid) {
                f32x4 d0 = {0.f, 0.f, 0.f, 0.f}, d1 = {0.f, 0.f, 0.f, 0.f}; float ss = 0.f;
                const float* xrow = OUT + (size_t)tok * 1024 + 4 * q; const f32x4* wr2 = (const f32x4*)WR2 + lane;
#pragma unroll 4
                for (int s = 0; s < 64; ++s) { const f32x4 xv = *(const f32x4*)(xrow + 16 * s); const f32x4 wa = wr2[(s * 2) * 64], wb = wr2[(s * 2 + 1) * 64];
                    ss += (xv[0] * xv[0] + xv[1] * xv[1]) + (xv[2] * xv[2] + xv[3] * xv[3]);
#pragma unroll
                    for (int j = 0; j < 4; ++j) { d0 = __builtin_amdgcn_mfma_f32_16x16x4f32(wa[j], xv[j], d0, 0, 0, 0); d1 = __builtin_amdgcn_mfma_f32_16x16x4f32(wb[j], xv[j], d1, 0, 0, 0); } }
                ss += __shfl_xor(ss, 16); ss += __shfl_xor(ss, 32);
                rstd = 1.0f / sqrtf(ss * (1.0f / 1024.f) + RMS_EPS);
                unsigned key[8];
#pragma unroll
                for (int r = 0; r < 8; ++r) { const int e = (r >> 2) * 16 + 4 * q + (r & 3); const float lg = ((r < 4) ? d0[r & 3] : d1[r & 3]) * rstd + ka->in[I_BROUTER][e];
                    unsigned u = __float_as_uint(lg); u ^= (u >> 31) ? 0xffffffffu : 0x80000000u; key[r] = (u & ~31u) | (unsigned)(31 - e); }
                unsigned win[4];
#pragma unroll
                for (int r = 0; r < 4; ++r) { unsigned m = key[0];
#pragma unroll
                    for (int j = 1; j < 8; ++j) m = m > key[j] ? m : key[j];
                    unsigned o = (unsigned)__shfl_xor((int)m, 16); m = m > o ? m : o; o = (unsigned)__shfl_xor((int)m, 32); m = m > o ? m : o; win[r] = m;
#pragma unroll
                    for (int j = 0; j < 8; ++j) key[j] = (key[j] == m) ? 0u : key[j]; }
                float val[4];
#pragma unroll
                for (int r = 0; r < 4; ++r) { unsigned u = win[r] & ~31u; u ^= (u >> 31) ? 0x80000000u : 0xffffffffu; val[r] = __uint_as_float(u); }
                const float p1 = expf(val[1] - val[0]), p2 = expf(val[2] - val[0]), p3 = expf(val[3] - val[0]); const float inv = 1.0f / (1.0f + p1 + p2 + p3);
                const unsigned wk = (q == 0) ? win[0] : (q == 1) ? win[1] : (q == 2) ? win[2] : win[3];
                w_sel = ((q == 0) ? 1.0f : (q == 1) ? p1 : (q == 2) ? p2 : p3) * inv; e_sel = 31 - (int)(wk & 31u);
                rank = __hip_atomic_fetch_add((int*)(lcnt + e_sel), 1, __ATOMIC_RELAXED, __HIP_MEMORY_SCOPE_WORKGROUP);
            }
            __syncthreads();
            if (tid < 32) lbase[tid] = (int)__hip_atomic_fetch_add(CNT + 64 * tid, (unsigned)lcnt[tid], __ATOMIC_RELAXED, __HIP_MEMORY_SCOPE_AGENT);
            __syncthreads();
            if (valid) { const int pos = lbase[e_sel] + rank; LIST[(size_t)e_sel * CAP + pos] = (u32x2){(unsigned)(tok * 4 + q), __float_as_uint(rstd)}; ROUTEW[tok * 4 + q] = w_sel; }
            __syncthreads();
        }
    }
    SEAM(6);
    if (IN(7) || IN(8)) { KA;
        LAS int* tp = (LAS int*)(lds + MISC_OFF + 256); LAS int* cn = tp + 40;
        if (tid == 0) { int acc = 0; for (int e = 0; e < NEXP; ++e) { const int c = (int)__hip_atomic_load(CNT + 64 * e, __ATOMIC_RELAXED, __HIP_MEMORY_SCOPE_AGENT); cn[e] = c; tp[e] = acc; acc += (c + 255) >> 8; } tp[NEXP] = acc; }
        __syncthreads();
        if (IN(7)) for (int rep_ = 0; rep_ < 1 + ((REPEAT_MASK >> 7) & 1); ++rep_) {
            pg8::GuProb P{(const unsigned char*)XG, (const unsigned char*)WGU_T, LIST, 1024, 1024, 1024}; pg8::GroupedOrder S0{tp, cn, 8, G, bx}; const pg8::TableOrder S = pg8::build_unit_table(S0, (LAS int*)(lds + MISC_OFF + 2048));
            pg8::EpiSwiglu E{(unsigned char*)ACT, LIST, ka->in[I_BGU]};
            pg8::gemm_phase<pg8::EpiSwiglu, pg8::GuProb, pg8::TableOrder, ALIGN_EPI_SEL>(lds, P, S, E);
        }
        SEAM(7);
        if (IN(8)) for (int rep_ = 0; rep_ < 1 + ((REPEAT_MASK >> 8) & 1); ++rep_) {
            pg8::DownProb P{(const unsigned char*)ACT, (const unsigned char*)WD_T, 1024, 1024, 1024}; pg8::GroupedOrder S0{tp, cn, 4, G, bx}; const pg8::TableOrder S = pg8::build_unit_table(S0, (LAS int*)(lds + MISC_OFF + 2048));
            pg8::EpiDown E{(unsigned char*)Y4, LIST, ka->in[I_BD]};
            pg8::gemm_phase<pg8::EpiDown, pg8::DownProb, pg8::TableOrder, ALIGN_EPI_SEL>(lds, P, S, E);
        }
    }
    SEAM(8);
    if (IN(9)) { KA;
        for (int i = bx * 512 + tid; i < T * 128; i += G * 512) { const int tok = i >> 7, c8 = (i & 127) * 8;
            const f32x4 w = *(const f32x4*)(ROUTEW + tok * 4); float* op = OUT + (size_t)tok * 1024 + c8;
            f32x4 o0 = *(const f32x4*)op, o1 = *(const f32x4*)(op + 4);
#pragma unroll
            for (int k = 0; k < 4; ++k) { const u32x2 y = *(const u32x2*)((const unsigned char*)Y4 + ((size_t)tok * 4 + k) * 1024 + c8); const float wk = w[k] * (1.0f / Y8_SCALE);
                const f32x2 p0 = __builtin_amdgcn_cvt_pk_f32_fp8((int)y.x, false), p1 = __builtin_amdgcn_cvt_pk_f32_fp8((int)y.x, true), p2 = __builtin_amdgcn_cvt_pk_f32_fp8((int)y.y, false), p3 = __builtin_amdgcn_cvt_pk_f32_fp8((int)y.y, true);
                o0[0] += wk * p0[0]; o0[1] += wk * p0[1]; o0[2] += wk * p1[0]; o0[3] += wk * p1[1];
                o1[0] += wk * p2[0]; o1[1] += wk * p2[1]; o1[2] += wk * p3[0]; o1[3] += wk * p3[1]; }
            *(f32x4*)op = o0; *(f32x4*)(op + 4) = o1; }
    }
#ifdef TAP
    if (lo <= 10 && 10 < hi) { KA; GSYNC();
        for (int i = bx * 512 + tid; i < T * 1024; i += G * 512) { const int t = i >> 10, c = i & 1023; float v = 0.f;
#define BFV(buf, pitch, col) __uint_as_float((unsigned)(buf)[(size_t)t * (pitch) + (col)] << 16)
            if (TAP == 1) v = BFV(Qb, 512, c & 511) + 2.f * BFV(Kb, 512, c & 511) + 4.f * BFV(Vb, 512, c & 511) + 8.f * BFV(Ub, 256, c & 255) + 16.f * BFV(MQb, 256, c & 255)
                            + 32.f * BFV(GATES, 3072, c) + 64.f * BFV(GATES, 3072, 1024 + c) + 128.f * BFV(GATES, 3072, 2048 + c);
            if (TAP == 2) v = BFV(OC, 1024, c) + 2.f * BFV(YCAT, 1024, c);
            if (TAP == 3) v = BFV(MERGB, 1024, c);
            if (TAP == 4) v = BFV(XN, 1024, c);
            if (TAP == 6) { const bf16_t* z = WSP(bf16_t, WS_B) + (size_t)t * 5120 + c; v = __uint_as_float((unsigned)z[0] << 16) + 2.f * __uint_as_float((unsigned)z[1024] << 16) + 4.f * __uint_as_float((unsigned)z[2048] << 16) + 8.f * __uint_as_float((unsigned)z[3072] << 16) + 16.f * __uint_as_float((unsigned)z[4096] << 16); }
            if (TAP == 5) { const bf16_t* wt = WIN_T; const int tt = t % 5120; v = __uint_as_float((unsigned)wt[(size_t)tt * 1024 + c] << 16) + ROPE[(t & 8191) * 32 + (c & 31)].x + 2.f * ROPE[(t & 8191) * 32 + (c & 31)].y; }
            OUT[i] = v; }
    }
#endif
#undef IN
#undef SEAM
}

extern "C" void kernel_launch(void* const* d_in, const int* in_sizes, int n_in, void* d_out, int out_size, void* d_ws, size_t ws_size, hipStream_t stream) {
    static int grid = 0;
    if (grid == 0) {
        if (n_in != 29 || in_sizes[0] != T * DMODEL || out_size != T * DMODEL || ws_size < WS_END) {
            fprintf(stderr, "kernel_launch: unexpected shapes: n_in %d in0 %d out %d ws %zu (need %zu)\n", n_in, n_in > 0 ? in_sizes[0] : -1, out_size, ws_size, (size_t)WS_END); grid = -1; return; }
        int dev = 0, cus = 0, per_cu = 0;
        (void)hipGetDevice(&dev); (void)hipDeviceGetAttribute(&cus, hipDeviceAttributeMultiprocessorCount, dev);
        (void)hipFuncSetAttribute((const void*)fwd_kernel, hipFuncAttributeMaxDynamicSharedMemorySize, LDS_BYTES);
        (void)hipOccupancyMaxActiveBlocksPerMultiprocessor(&per_cu, (const void*)fwd_kernel, NWAVES * 64, LDS_BYTES);
        (void)hipGetLastError();
        grid = cus;
        fprintf(stderr, "kernel_launch: cus %d occupancy %d/CU grid %d\n", cus, per_cu, grid);
        if (per_cu < 1) fprintf(stderr, "kernel_launch: occupancy query says the kernel does not fit\n");
    }
    if (grid < 0) return;
    (void)hipMemsetAsync((char*)d_ws + WS_CTL, 0, CTL_ZERO_BYTES, stream);
    Args a{};
    for (int i = 0; i < 29; ++i) a.in[i] = (const float*)d_in[i];
    a.out = (float*)d_out; a.ws = (unsigned char*)d_ws; a.ph_lo = 0; a.ph_hi = PH_HI;
    void* args[] = {&a};
    hipError_t e = hipLaunchCooperativeKernel((const void*)fwd_kernel, dim3(grid), dim3(NWAVES * 64), args, LDS_BYTES, stream);
    if (e != hipSuccess) fprintf(stderr, "cooperative launch failed: %s (grid %d)\n", hipGetErrorString(e), grid);
}
```

```cpp
#include <hip/hip_runtime.h>
#include <hip/hip_cooperative_groups.h>
#include <hip/hip_bf16.h>
#include <cstdio>
#include <cstdint>
#include <cmath>
namespace cg = cooperative_groups;

#define LAS __attribute__((address_space(3)))
#define GAS __attribute__((address_space(1)))
typedef unsigned short bf16_t;
typedef short bf16x8 __attribute__((ext_vector_type(8)));
typedef float f32x4 __attribute__((ext_vector_type(4)));
typedef float f32x2 __attribute__((ext_vector_type(2)));
typedef float f32x16 __attribute__((ext_vector_type(16)));
typedef unsigned u32x4 __attribute__((ext_vector_type(4)));
typedef unsigned u32x2 __attribute__((ext_vector_type(2)));

#define PH_HI 10
#define ALIGN_EPI_SEL true
#define F8MODE 2
#define USE_SETPRIO 1
#define ATTN_PRIO_A 1
#define ATTN_PRIO_B 1
#ifndef PHMASK
#define PHMASK 0x3ff
#endif
#define REPEAT_MASK 0x000
constexpr int BATCH = 4, SEQ = 8192, DMODEL = 1024, T = BATCH * SEQ, INW = 5120, NEXP = 32, MEMLEN = 256;
constexpr float RMS_EPS = 1e-6f;
constexpr float C2 = 0.125f * 1.4426950408889634f;
constexpr int CAP = T;

constexpr size_t MiB = 1u << 20;
constexpr size_t WS_CTL = 0, CTL_ZERO_BYTES = 32768;
constexpr int CW_BAR = 4096;
constexpr size_t WS_ROUTEW = 1 * MiB;
constexpr size_t WS_LAM = 1 * MiB + 768 * 1024;
constexpr size_t WS_ROPE = 2 * MiB;
constexpr size_t WS_WR2 = 4 * MiB;
constexpr size_t WS_MEMN = 5 * MiB;
constexpr size_t WS_MKV = 7 * MiB;
constexpr size_t WS_WIN_T = 8 * MiB;
constexpr size_t WS_WBRD_T = 18 * MiB;
constexpr size_t WS_WBRP_T = 19 * MiB;
constexpr size_t WS_WBRM_T = 19 * MiB + 512 * 1024;
constexpr size_t WS_WOUT_T = 20 * MiB;
constexpr size_t WS_WMKV_T = 22 * MiB;
constexpr size_t WS_WGU_T = 24 * MiB;
constexpr size_t WS_WD_T = 152 * MiB;
constexpr size_t WS_A = 216 * MiB;
constexpr size_t WS_XN = WS_A;
constexpr size_t WS_Q = WS_A + 64 * MiB, WS_K = WS_A + 96 * MiB, WS_V = WS_A + 128 * MiB;
constexpr size_t WS_U = WS_A + 160 * MiB, WS_MQ = WS_A + 176 * MiB;
constexpr size_t WS_OC = WS_A + 192 * MiB;
constexpr size_t WS_B = 488 * MiB;
constexpr size_t WS_GATES = WS_B;
constexpr size_t WS_YCAT = WS_B + 192 * MiB;
constexpr size_t WS_MERGF = 760 * MiB;
constexpr size_t WS_MERGB = 888 * MiB;
constexpr size_t WS_XG = 952 * MiB;
constexpr size_t WS_LIST = 1016 * MiB;
constexpr size_t WS_END = 1024 * MiB;

typedef __bf16 bf16x2_v __attribute__((ext_vector_type(2)));
__device__ __forceinline__ unsigned cvt_pk_bf16(float lo, float hi) { f32x2 v = {lo, hi}; bf16x2_v b = __builtin_convertvector(v, bf16x2_v); return __builtin_bit_cast(unsigned, b); }
__device__ __forceinline__ unsigned pk4_fp8(float a, float b, float c, float d) {
    a = fminf(fmaxf(a, -448.f), 448.f); b = fminf(fmaxf(b, -448.f), 448.f); c = fminf(fmaxf(c, -448.f), 448.f); d = fminf(fmaxf(d, -448.f), 448.f);
    int r = __builtin_amdgcn_cvt_pk_fp8_f32(a, b, 0, false); r = __builtin_amdgcn_cvt_pk_fp8_f32(c, d, r, true); return (unsigned)r; }
constexpr float W8_SCALE = 64.0f;
constexpr float Y8_SCALE = 32.0f;
constexpr float A8_SCALE = 8.0f;
__device__ __forceinline__ float bf_lo(unsigned w) { return __uint_as_float(w << 16); }
__device__ __forceinline__ float bf_hi(unsigned w) { return __uint_as_float(w & 0xffff0000u); }
__device__ __forceinline__ float wave_sum(float v) {
#pragma unroll
    for (int o = 1; o < 64; o <<= 1) v += __shfl_xor(v, o);
    return v;
}
#define LDS_WAIT() asm volatile("s_waitcnt lgkmcnt(0)" ::: "memory")

namespace pg8 {
constexpr int BM = 256, BK = 64, HALF = 128, HTB = HALF * BK * 2, STAGE_BYTES = 8 * HTB, NXCD = 8, WGM = 8;
__host__ __device__ __forceinline__ int lds_byte(int r, int c) { const int st = (r >> 4) * 2 + (c >> 5), rr = r & 15, cc = c & 31, ob = rr * 64 + cc * 2; return st * 1024 + (ob ^ (((ob >> 9) & 1) << 5)); }
__host__ __device__ __forceinline__ void stage_rc(int b, int& R, int& C) { const int st = b / 1024, sb = b % 1024, swz = sb ^ (((sb >> 9) & 1) << 5); R = (st >> 1) * 16 + swz / 64; C = (st & 1) * 32 + (swz % 64) / 2; }
__host__ __device__ __forceinline__ int perm32(int rho) { const int n = rho >> 4, i = rho & 15; return 8 * (i >> 2) + 4 * n + (i & 3); }

typedef int i32x4_t __attribute__((ext_vector_type(4)));
typedef int i32x8_t __attribute__((ext_vector_type(8)));
typedef long i64x2_t __attribute__((ext_vector_type(2)));
struct Unit { int pm, pn, e, mt, cnt; };

template <int BMAP> __device__ __forceinline__ int brow(int R) { return BMAP == 0 ? ((R >> 5) * 64 + perm32(R & 31)) : BMAP == 1 ? ((R & ~31) + perm32(R & 31)) : ((R >> 5) * 64 + 16 * ((R & 15) >> 2) + 4 * ((R >> 4) & 1) + (R & 3)); }

struct StaticOrder {
    int nM, nN, nwg, G, c;
    __device__ void init(int M, int N, int G_, int c_) { nM = M / BM; nN = N / BM; nwg = nM * nN; G = G_; c = c_; }
    __device__ bool next(int i, Unit& u) const {
        const long L = (long)i * G + c; if (L >= nwg) return false;
        int wgid = (int)L; { const int q = nwg / NXCD, r = nwg % NXCD, xcd = wgid % NXCD, off = wgid / NXCD; wgid = (xcd < r ? xcd * (q + 1) : r * (q + 1) + (xcd - r) * q) + off; }
        const int nig = WGM * nN, gid = wgid / nig, fm = gid * WGM, gsz = (nM - fm) < WGM ? (nM - fm) : WGM;
        u.pm = fm + ((wgid % nig) % gsz); u.pn = (wgid % nig) / gsz; u.e = 0; u.mt = 0; u.cnt = 0; return true;
    }
    __device__ bool next_lane(int i, Unit& u) const { return next(i, u); }
};
struct GroupedOrder {
    const LAS int* tp; const LAS int* cn; int NTN, G, c;
    __device__ bool next_lane(int i, Unit& u) const {
        const int nwg = tp[NEXP] * NTN; const long L = (long)i * G + c; if (L >= nwg) return false;
        int wgid = (int)L; { const int q = nwg / NXCD, r = nwg % NXCD, xcd = wgid % NXCD, off = wgid / NXCD; wgid = (xcd < r ? xcd * (q + 1) : r * (q + 1) + (xcd - r) * q) + off; }
        int e = 0; while (e < NEXP - 1 && wgid >= tp[e + 1] * NTN) ++e;
        const int idx = wgid - tp[e] * NTN, tiles = tp[e + 1] - tp[e];
        const int nig = 4 * NTN, gid = idx / nig, fm = gid * 4, gsz = (tiles - fm) < 4 ? (tiles - fm) : 4;
        u.mt = fm + ((idx % nig) % gsz); u.pn = (idx % nig) / gsz; u.e = e; u.pm = tp[e] + u.mt; u.cnt = cn[e]; return true;
    }
};
struct TableOrder {
    const LAS int* tab; int n;
    __device__ __forceinline__ bool next(int i, Unit& u) const {
        if (i >= n) return false;
        const LAS int* t = tab + i * 8;
        u.pm = __builtin_amdgcn_readfirstlane(t[0]); u.pn = __builtin_amdgcn_readfirstlane(t[1]); u.e = __builtin_amdgcn_readfirstlane(t[2]);
        u.mt = __builtin_amdgcn_readfirstlane(t[3]); u.cnt = __builtin_amdgcn_readfirstlane(t[4]); return true;
    }
};
template <class Sched> __device__ __forceinline__ TableOrder build_unit_table(const Sched& S, LAS int* tab) {
    __syncthreads();
    if (threadIdx.x < 32) { Unit u; const bool ok = S.next_lane((int)threadIdx.x, u);
        if (ok) { LAS int* t = tab + threadIdx.x * 8; t[0] = u.pm; t[1] = u.pn; t[2] = u.e; t[3] = u.mt; t[4] = u.cnt; }
        const unsigned long long m = __ballot(ok); if (threadIdx.x == 0) tab[256] = __popcll(m); }
    __syncthreads();
    TableOrder T; T.tab = tab; T.n = __builtin_amdgcn_readfirstlane(tab[256]); return T;
}
struct DenseProb {
    static constexpr bool GATHER = false; static constexpr int BMAP = 0; static constexpr bool F8 = false;
    const bf16_t* A; const bf16_t* Bt; int lda, ldb, K;
    __device__ __forceinline__ const char* a_base(const Unit& u) const { return (const char*)(A + (size_t)u.pm * BM * lda); }
    __device__ __forceinline__ const char* b_base(const Unit& u) const { return (const char*)(Bt + (size_t)u.pn * BM * ldb); }
    __device__ __forceinline__ size_t bhstep() const { return (size_t)32 * ldb * 2; }
    __device__ __forceinline__ unsigned a_off(const Unit&, int, int) const { return 0u; }
    __device__ __forceinline__ unsigned a_raw(const Unit&, int) const { return 0u; }
};
struct GuProb {
    static constexpr bool GATHER = true; static constexpr int BMAP = 1; static constexpr bool F8 = true;
    const unsigned char* XG; const unsigned char* Wt; const u32x2* list; int lda, ldb, K;
    __device__ __forceinline__ const char* a_base(const Unit&) const { return (const char*)XG; }
    __device__ __forceinline__ const char* b_base(const Unit& u) const { return (const char*)(Wt + ((size_t)u.e * 2048 + 128 * u.pn) * 1024); }
    __device__ __forceinline__ size_t bhstep() const { return (size_t)1024 * 1024; }
    __device__ __forceinline__ unsigned a_raw(const Unit& u, int r) const { const int rr = u.mt * BM + r, rc = rr < u.cnt ? rr : u.cnt - 1; return list[(size_t)u.e * CAP + rc].x; }
    __device__ __forceinline__ unsigned a_off(const Unit& u, int r, int C) const {
        const int rr = u.mt * BM + r, rc = rr < u.cnt ? rr : u.cnt - 1;
        const unsigned tok = list[(size_t)u.e * CAP + rc].x >> 2;
        return tok * 1024u + (unsigned)C * 2u;
    }
};
struct DownProb {
    static constexpr bool GATHER = false; static constexpr int BMAP = 2; static constexpr bool F8 = true;
    const unsigned char* A; const unsigned char* Wt; int lda, ldb, K;
    __device__ __forceinline__ const char* a_base(const Unit& u) const { return (const char*)(A + (size_t)u.pm * BM * lda); }
    __device__ __forceinline__ const char* b_base(const Unit& u) const { return (const char*)(Wt + ((size_t)u.e * 1024 + 256 * u.pn) * 1024); }
    __device__ __forceinline__ size_t bhstep() const { return (size_t)8 * ldb; }
    __device__ __forceinline__ unsigned a_off(const Unit&, int, int) const { return 0u; }
    __device__ __forceinline__ unsigned a_raw(const Unit&, int) const { return 0u; }
};

template <class Prob> __device__ __forceinline__ void calc_aoff(const Prob& P, const Unit& u, const int (&Rr)[2], const int (&Cc)[2], unsigned (&o)[2][2]) {
#pragma unroll
    for (int h = 0; h < 2; ++h)
#pragma unroll
        for (int i = 0; i < 2; ++i) {
            if constexpr (Prob::GATHER) o[h][i] = P.a_off(u, h * HALF + Rr[i], Cc[i]);
            else o[h][i] = Prob::F8 ? (unsigned)((h * HALF + Rr[i]) * P.lda + Cc[i] * 2) : (unsigned)((h * HALF + Rr[i]) * P.lda + Cc[i]) * 2u;
        }
}

struct NoPost { __device__ __forceinline__ void operator()(int) const {} };
template <class Epi, class Prob, class Sched, bool ALIGN_EPI, class Post = NoPost>
__device__ __forceinline__ void gemm_phase(LAS unsigned char* lds, const Prob& P, const Sched& S, const Epi& E, const Post& PU = Post()) {
    const int tid = threadIdx.x, wid = __builtin_amdgcn_readfirstlane(tid >> 6), lane = tid & 63, wr = wid >> 2, wc = wid & 3, fr = lane & 15, fq = lane >> 4;
    const int K = P.K, nt = Prob::F8 ? K / 128 : K / BK;
    int Rr[2], Cc[2]; unsigned voffB[2];
#pragma unroll
    for (int i = 0; i < 2; ++i) { stage_rc(tid * 16 + i * 8192, Rr[i], Cc[i]); voffB[i] = Prob::F8 ? (unsigned)(brow<Prob::BMAP>(Rr[i]) * P.ldb + Cc[i] * 2) : (unsigned)(brow<Prob::BMAP>(Rr[i]) * P.ldb + Cc[i]) * 2u; }
    const size_t kstep = (size_t)(BK * 2);
    const size_t bhstep = P.bhstep();
    const unsigned ldsw = (unsigned)wid * 1024u;
    const int aoff = lds_byte(wr * 64 + fr, fq * 8), boff = lds_byte(wc * 32 + fr, fq * 8);
#define PG8_SA(b, h) (((b) * 2 + (h)) * HTB)
#define PG8_SB(b, h) ((4 + (b) * 2 + (h)) * HTB)
#define PG8_STG(bufoff, gptr, v0, v1) do { \
        __builtin_amdgcn_global_load_lds((const unsigned*)((const char*)(gptr) + (v0)), (LAS unsigned*)(lds + (bufoff) + ldsw), 16, 0, 0); \
        __builtin_amdgcn_global_load_lds((const unsigned*)((const char*)(gptr) + (v1)), (LAS unsigned*)(lds + (bufoff) + ldsw + 8192), 16, 0, 0); } while (0)
#define PG8_STGB(bufoff, gptr) PG8_STG(bufoff, gptr, voffB[0], voffB[1])
#define PG8_LDA(dst, b, h) do { _Pragma("unroll") for (int m = 0; m < 4; ++m) _Pragma("unroll") for (int k = 0; k < 2; ++k) dst[m][k] = *(const LAS bf16x8*)(lds + PG8_SA(b, h) + aoff + m * 2048 + k * 1024); } while (0)
#define PG8_LDB(dst, b, h) do { _Pragma("unroll") for (int n = 0; n < 2; ++n) _Pragma("unroll") for (int k = 0; k < 2; ++k) dst[n][k] = *(const LAS bf16x8*)(lds + PG8_SB(b, h) + boff + n * 2048 + k * 1024); } while (0)
#define PG8_MMAB(ai, bj, At, Bt) do { _Pragma("unroll") for (int m = 0; m < 4; ++m) _Pragma("unroll") for (int n = 0; n < 2; ++n) _Pragma("unroll") for (int k = 0; k < 2; ++k) \
        acc[ai][bj][m][n] = __builtin_amdgcn_mfma_f32_16x16x32_bf16(Bt[n][k], At[m][k], acc[ai][bj][m][n], 0, 0, 0); } while (0)
#define PG8_MMAQ(ai, bj, At, Bt) do { _Pragma("unroll") for (int m = 0; m < 4; ++m) _Pragma("unroll") for (int n = 0; n < 2; ++n) _Pragma("unroll") for (int k = 0; k < 2; ++k) { \
        const i64x2_t bq = __builtin_bit_cast(i64x2_t, Bt[n][k]), aq = __builtin_bit_cast(i64x2_t, At[m][k]); \
        acc[ai][bj][m][n] = __builtin_amdgcn_mfma_f32_16x16x32_fp8_fp8(bq[0], aq[0], acc[ai][bj][m][n], 0, 0, 0); \
        acc[ai][bj][m][n] = __builtin_amdgcn_mfma_f32_16x16x32_fp8_fp8(bq[1], aq[1], acc[ai][bj][m][n], 0, 0, 0); } } while (0)
#define PG8_MMA8(ai, bj, A8, B8) do { _Pragma("unroll") for (int m = 0; m < 4; ++m) _Pragma("unroll") for (int n = 0; n < 2; ++n) \
        asm volatile("v_mfma_f32_16x16x128_f8f6f4 %0, %1, %2, %0" : "+v"(acc[ai][bj][m][n]) : "v"(B8[n]), "v"(A8[m])); } while (0)
#define PG8_LDA8(dst, b, h) do { _Pragma("unroll") for (int m = 0; m < 4; ++m) { dst[m].lo = *(const LAS i32x4_t*)(lds + PG8_SA(b, h) + aoff + m * 2048); dst[m].hi = *(const LAS i32x4_t*)(lds + PG8_SA(b, h) + aoff + m * 2048 + 1024); } } while (0)
#define PG8_LDB8(dst, b, h) do { _Pragma("unroll") for (int n = 0; n < 2; ++n) { dst[n].lo = *(const LAS i32x4_t*)(lds + PG8_SB(b, h) + boff + n * 2048); dst[n].hi = *(const LAS i32x4_t*)(lds + PG8_SB(b, h) + boff + n * 2048 + 1024); } } while (0)
#define PG8_XLDA(b, h)  do { if constexpr (Prob::F8 && F8MODE == 2) PG8_LDA8(At8, b, h); else PG8_LDA(At, b, h); } while (0)
#define PG8_XLDB0(b, h) do { if constexpr (Prob::F8 && F8MODE == 2) PG8_LDB8(B08, b, h); else PG8_LDB(B0, b, h); } while (0)
#define PG8_XLDB1(b, h) do { if constexpr (Prob::F8 && F8MODE == 2) PG8_LDB8(B18, b, h); else PG8_LDB(B1, b, h); } while (0)
#define PG8_XMMA0(ai, bj) do { if (USE_SETPRIO) __builtin_amdgcn_s_setprio(USE_SETPRIO); if constexpr (Prob::F8 && F8MODE == 2) PG8_MMA8(ai, bj, At8, B08); else if constexpr (Prob::F8) PG8_MMAQ(ai, bj, At, B0); else PG8_MMAB(ai, bj, At, B0); if (USE_SETPRIO) __builtin_amdgcn_s_setprio(0); } while (0)
#define PG8_XMMA1(ai, bj) do { if (USE_SETPRIO) __builtin_amdgcn_s_setprio(USE_SETPRIO); if constexpr (Prob::F8 && F8MODE == 2) PG8_MMA8(ai, bj, At8, B18); else if constexpr (Prob::F8) PG8_MMAQ(ai, bj, At, B1); else PG8_MMAB(ai, bj, At, B1); if (USE_SETPRIO) __builtin_amdgcn_s_setprio(0); } while (0)
#define PG8_WAIT_V(n) asm volatile("s_waitcnt vmcnt(" #n ")" ::: "memory")
#define PG8_WAIT_L(n) asm volatile("s_waitcnt lgkmcnt(" #n ")" ::: "memory")
#define PG8_BAR __builtin_amdgcn_s_barrier()
#define PG8_SCHED __builtin_amdgcn_sched_barrier(0)
    Unit cur, nxt; int ui = 0;
    if (!S.next(0, cur)) return;
    unsigned vo[2][2], nvo[2][2];
    calc_aoff(P, cur, Rr, Cc, vo);
    bool has_next = S.next(1, nxt);
    if constexpr (Prob::GATHER) { if (has_next) calc_aoff(P, nxt, Rr, Cc, nvo); else {
#pragma unroll
        for (int h = 0; h < 2; ++h)
#pragma unroll
            for (int i = 0; i < 2; ++i) nvo[h][i] = vo[h][i]; } }
    f32x4 acc[2][2][4][2];
#pragma unroll
    for (int a = 0; a < 2; ++a)
#pragma unroll
        for (int b = 0; b < 2; ++b)
#pragma unroll
            for (int m = 0; m < 4; ++m)
#pragma unroll
                for (int n = 0; n < 2; ++n) acc[a][b][m][n] = (f32x4){0.f, 0.f, 0.f, 0.f};
    bf16x8 At[4][2], B0[2][2], B1[2][2]; i32x8_t At8[4], B08[2], B18[2];
    const char* cA = P.a_base(cur); const char* cB = P.b_base(cur);
    PG8_STGB(PG8_SB(0, 0), cB); PG8_STGB(PG8_SB(0, 1), cB + bhstep); PG8_STG(PG8_SA(0, 0), cA, vo[0][0], vo[0][1]); PG8_STG(PG8_SA(0, 1), cA, vo[1][0], vo[1][1]);
    if (wr == 1) PG8_BAR;
    PG8_WAIT_V(2); PG8_BAR;
    PG8_STGB(PG8_SB(1, 0), cB + kstep); PG8_STG(PG8_SA(1, 0), cA + kstep, vo[0][0], vo[0][1]); PG8_STGB(PG8_SB(1, 1), cB + bhstep + kstep);
    PG8_WAIT_V(6); PG8_BAR;
    for (;;) {
        const char* nA = has_next ? P.a_base(nxt) : cA; const char* nB = has_next ? P.b_base(nxt) : cB;
        for (int t = 0; t < nt; t += 2) {
            const bool last = (t == nt - 2);
            if constexpr (Epi::HAS_MID) { if (t == Epi::MID_T0 || t == Epi::MID_T1) { E.mid(acc, cur, wr, wc, fr, fq, t == Epi::MID_T0 ? 0 : 1); PG8_SCHED; } }
            const char* a1 = cA + (size_t)(t + 1) * kstep;
            const char* a2 = last ? nA : cA + (size_t)(t + 2) * kstep; const char* b2 = last ? nB : cB + (size_t)(t + 2) * kstep;
            const char* a3 = a2 + kstep; const char* b3 = b2 + kstep;
            unsigned x00 = vo[0][0], x01 = vo[0][1], x10 = vo[1][0], x11 = vo[1][1];
            if constexpr (Prob::GATHER) { if (last) { x00 = nvo[0][0]; x01 = nvo[0][1]; x10 = nvo[1][0]; x11 = nvo[1][1]; } }
            PG8_XLDB0(0, 0); PG8_XLDB1(0, 1); PG8_SCHED; PG8_XLDA(0, 0); PG8_STG(PG8_SA(1, 1), a1, vo[1][0], vo[1][1]);
            PG8_WAIT_V(8); PG8_WAIT_L(0); PG8_BAR; PG8_XMMA0(0, 0); PG8_XMMA1(0, 1); PG8_BAR; PG8_SCHED;
            PG8_XLDA(0, 1); PG8_STGB(PG8_SB(0, 0), b2); PG8_STGB(PG8_SB(0, 1), b2 + bhstep); PG8_STG(PG8_SA(0, 0), a2, x00, x01);
            PG8_WAIT_V(8); PG8_WAIT_L(0); PG8_BAR; PG8_XMMA0(1, 0); PG8_XMMA1(1, 1); PG8_BAR; PG8_SCHED;
            PG8_XLDB0(1, 0); PG8_XLDB1(1, 1); PG8_SCHED; PG8_XLDA(1, 0); PG8_STG(PG8_SA(0, 1), a2, x10, x11);
            PG8_WAIT_V(8); PG8_WAIT_L(0); PG8_BAR; PG8_XMMA0(0, 0); PG8_XMMA1(0, 1); PG8_BAR; PG8_SCHED;
            PG8_XLDA(1, 1); PG8_STGB(PG8_SB(1, 0), b3); PG8_STGB(PG8_SB(1, 1), b3 + bhstep); PG8_STG(PG8_SA(1, 0), a3, x00, x01);
            PG8_WAIT_V(8); PG8_WAIT_L(0); PG8_BAR; PG8_XMMA0(1, 0); PG8_XMMA1(1, 1); PG8_BAR; PG8_SCHED;
        }
        if constexpr (ALIGN_EPI) { if (wr == 0) PG8_BAR; }
        if constexpr (Prob::F8 && F8MODE == 2) asm volatile("s_nop 15\n\ts_nop 15" ::: "memory");
        Unit nn; const bool has_nn = has_next && S.next(ui + 2, nn);
        if constexpr (Prob::GATHER) {
#pragma unroll
            for (int h = 0; h < 2; ++h)
#pragma unroll
                for (int i = 0; i < 2; ++i) vo[h][i] = nvo[h][i];
            if (has_nn) {
#pragma unroll
                for (int h = 0; h < 2; ++h)
#pragma unroll
                    for (int i = 0; i < 2; ++i) nvo[h][i] = P.a_raw(nn, h * HALF + Rr[i]); } }
        E(acc, cur, wr, wc, fr, fq);
        PU(ui);
        if (!has_next) break;
#pragma unroll
        for (int a = 0; a < 2; ++a)
#pragma unroll
            for (int b = 0; b < 2; ++b)
#pragma unroll
                for (int m = 0; m < 4; ++m)
#pragma unroll
                    for (int n = 0; n < 2; ++n) acc[a][b][m][n] = (f32x4){0.f, 0.f, 0.f, 0.f};
        cur = nxt; cA = nA; cB = nB; ++ui;
        has_next = has_nn; nxt = nn;
        if constexpr (Prob::GATHER) { if (has_next) {
#pragma unroll
            for (int h = 0; h < 2; ++h)
#pragma unroll
                for (int i = 0; i < 2; ++i) nvo[h][i] = (nvo[h][i] >> 2) * (Prob::F8 ? 1024u : 2048u) + (unsigned)Cc[i] * 2u;
            asm volatile("" : "+v"(nvo[0][0]), "+v"(nvo[0][1]), "+v"(nvo[1][0]), "+v"(nvo[1][1])); } }
        if constexpr (ALIGN_EPI) { if (wr == 1) PG8_BAR; }
    }
    PG8_WAIT_V(0);
    if constexpr (!ALIGN_EPI) { if (wr == 0) PG8_BAR; }
    PG8_BAR;
#undef PG8_SA
#undef PG8_SB
#undef PG8_STG
#undef PG8_STGB
#undef PG8_LDA
#undef PG8_LDB
#undef PG8_MMAB
#undef PG8_MMAQ
#undef PG8_MMA8
#undef PG8_LDA8
#undef PG8_LDB8
#undef PG8_XLDA
#undef PG8_XLDB0
#undef PG8_XLDB1
#undef PG8_XMMA0
#undef PG8_XMMA1
#undef PG8_WAIT_V
#undef PG8_WAIT_L
#undef PG8_BAR
#undef PG8_SCHED
}

typedef const f32x4 (&AccRef)[2][2][4][2];

__device__ __forceinline__ void store8(bf16_t* p, const f32x4& a, const f32x4& b) {
    u32x4 w; w.x = cvt_pk_bf16(a[0], a[1]); w.y = cvt_pk_bf16(a[2], a[3]); w.z = cvt_pk_bf16(b[0], b[1]); w.w = cvt_pk_bf16(b[2], b[3]); *(u32x4*)p = w;
}
__device__ __forceinline__ float sigmoidf_(float v) { return __builtin_amdgcn_rcpf(1.0f + __builtin_amdgcn_exp2f(-1.4426950408889634f * v)); }

struct EpiInProj {
    static constexpr bool HAS_MID = false;
    bf16_t *Q, *Kb, *V, *U, *MQ, *GT; const float *qn, *kn, *mqn, *bg; const f32x2* rope;
    __device__ __forceinline__ void operator()(AccRef acc, const Unit& u, int wr, int wc, int fr, int fq) const {
        const int pn = u.pn; const int row0 = u.pm * BM + wr * 64 + fr;
        bf16_t* const Q_ = Q; bf16_t* const K_ = Kb; bf16_t* const V_ = V; bf16_t* const U_ = U; bf16_t* const MQ_ = MQ; const float* const qn_ = qn; const float* const kn_ = kn; const float* const mqn_ = mqn;
        if (pn < 4 || pn == 7) {
            const bool rope_on = pn < 4; const float* gn = pn < 2 ? qn_ : (pn < 4 ? kn_ : mqn_);
            const float sc = (pn < 2 || pn == 7) ? C2 : 1.0f;
            bf16_t* O; int pitch, colb;
            if (pn < 2) { O = Q_; pitch = 512; colb = (pn * 4 + wc) * 64; } else if (pn < 4) { O = K_; pitch = 512; colb = ((pn - 2) * 4 + wc) * 64; } else { O = MQ_; pitch = 256; colb = wc * 64; }
            const f32x4 g00 = *(const f32x4*)(gn + 8 * fq), g01 = *(const f32x4*)(gn + 8 * fq + 4), g10 = *(const f32x4*)(gn + 32 + 8 * fq), g11 = *(const f32x4*)(gn + 32 + 8 * fq + 4);
#pragma unroll
            for (int ai = 0; ai < 2; ++ai)
#pragma unroll
                for (int m = 0; m < 4; ++m) {
                    const f32x4 a0 = acc[ai][0][m][0], a1 = acc[ai][0][m][1], b0 = acc[ai][1][m][0], b1 = acc[ai][1][m][1];
                    float ss = 0.f;
#pragma unroll
                    for (int j = 0; j < 4; ++j) ss += a0[j] * a0[j] + a1[j] * a1[j] + b0[j] * b0[j] + b1[j] * b1[j];
                    ss += __shfl_xor(ss, 16); ss += __shfl_xor(ss, 32);
                    const float rstd = 1.0f / sqrtf(ss * (1.0f / 64.0f) + RMS_EPS);
                    const int row = row0 + ai * HALF + m * 16;
                    f32x4 t10 = a0 * rstd * g00, t11 = a1 * rstd * g01, t20 = b0 * rstd * g10, t21 = b1 * rstd * g11;
                    f32x4 o10, o11, o20, o21;
                    if (rope_on) {
                        const f32x4* rp = (const f32x4*)(rope + (size_t)(row & (SEQ - 1)) * 32 + 8 * fq);
                        const f32x4 r0 = rp[0], r1 = rp[1], r2 = rp[2], r3 = rp[3];
                        const f32x4 cs0 = {r0[0], r0[2], r1[0], r1[2]}, sn0 = {r0[1], r0[3], r1[1], r1[3]}, cs1 = {r2[0], r2[2], r3[0], r3[2]}, sn1 = {r2[1], r2[3], r3[1], r3[3]};
                        o10 = (t10 * cs0 - t20 * sn0) * sc; o11 = (t11 * cs1 - t21 * sn1) * sc; o20 = (t20 * cs0 + t10 * sn0) * sc; o21 = (t21 * cs1 + t11 * sn1) * sc;
                    } else { o10 = t10 * sc; o11 = t11 * sc; o20 = t20 * sc; o21 = t21 * sc; }
                    bf16_t* rowp = O + (size_t)row * pitch + colb + 8 * fq;
                    store8(rowp, o10, o11); store8(rowp + 32, o20, o21);
                }
        } else if (pn < 7) {
            bf16_t* O; int pitch, colb;
            if (pn < 6) { O = V_; pitch = 512; colb = (pn - 4) * 256 + wc * 64; } else { O = U_; pitch = 256; colb = wc * 64; }
#pragma unroll
            for (int ai = 0; ai < 2; ++ai)
#pragma unroll
                for (int m = 0; m < 4; ++m) { bf16_t* rowp = O + (size_t)(row0 + ai * HALF + m * 16) * pitch + colb + 8 * fq;
                    store8(rowp, acc[ai][0][m][0], acc[ai][0][m][1]); store8(rowp + 32, acc[ai][1][m][0], acc[ai][1][m][1]); }
        } else {
            const int gc = (pn - 8) * 256 + wc * 64 + 8 * fq;
            f32x4 bv[2][2];
#pragma unroll
            for (int bj = 0; bj < 2; ++bj)
#pragma unroll
                for (int n = 0; n < 2; ++n) bv[bj][n] = *(const f32x4*)(bg + gc + 32 * bj + 4 * n);
#pragma unroll
            for (int ai = 0; ai < 2; ++ai)
#pragma unroll
                for (int m = 0; m < 4; ++m) {
                    bf16_t* blk = GT + ((size_t)(((pn - 8) >> 2) * 128 + u.pm) * 4 + ((pn - 8) & 3)) * 65536 + (size_t)((wr * 4 + wc) * 16 * 64 + (fq * 16 + fr)) * 8;
#pragma unroll
                    for (int bj = 0; bj < 2; ++bj) { f32x4 v0 = acc[ai][bj][m][0] + bv[bj][0], v1 = acc[ai][bj][m][1] + bv[bj][1];
#pragma unroll
                        for (int j = 0; j < 4; ++j) { v0[j] = sigmoidf_(v0[j]); v1[j] = sigmoidf_(v1[j]); }
                        store8(blk + (ai * 8 + m * 2 + bj) * 512, v0, v1); } }
        }
    }
};
struct EpiMemKV {
    static constexpr bool HAS_MID = false;
    bf16_t* MKV; const float* mkn;
    __device__ __forceinline__ void operator()(AccRef acc, const Unit& u, int wr, int wc, int fr, int fq) const {
        const int row0 = u.pm * BM + wr * 64 + fr;
        f32x4 g00 = {1.f, 1.f, 1.f, 1.f}, g01 = g00, g10 = g00, g11 = g00;
        if (u.pn == 0) { g00 = *(const f32x4*)(mkn + 8 * fq); g01 = *(const f32x4*)(mkn + 8 * fq + 4); g10 = *(const f32x4*)(mkn + 32 + 8 * fq); g11 = *(const f32x4*)(mkn + 32 + 8 * fq + 4); }
#pragma unroll
        for (int ai = 0; ai < 2; ++ai)
#pragma unroll
            for (int m = 0; m < 4; ++m) {
                const f32x4 a0 = acc[ai][0][m][0], a1 = acc[ai][0][m][1], b0 = acc[ai][1][m][0], b1 = acc[ai][1][m][1];
                float rstd = 1.0f;
                if (u.pn == 0) { float ss = 0.f;
#pragma unroll
                    for (int j = 0; j < 4; ++j) ss += a0[j] * a0[j] + a1[j] * a1[j] + b0[j] * b0[j] + b1[j] * b1[j];
                    ss += __shfl_xor(ss, 16); ss += __shfl_xor(ss, 32); rstd = 1.0f / sqrtf(ss * (1.0f / 64.0f) + RMS_EPS); }
                bf16_t* rowp = MKV + (size_t)(row0 + ai * HALF + m * 16) * 512 + u.pn * 256 + wc * 64 + 8 * fq;
                store8(rowp, a0 * rstd * g00, a1 * rstd * g01); store8(rowp + 32, b0 * rstd * g10, b1 * rstd * g11);
            }
    }
};
template <int STAGE> struct EpiMerge {
    static constexpr bool HAS_MID = false;
    const bf16_t* GT; float* MF; bf16_t* MB;
    __device__ __forceinline__ void operator()(AccRef acc, const Unit& u, int wr, int wc, int fr, int fq) const {
        const int row0 = u.pm * BM + wr * 64 + fr, col0 = u.pn * BM + wc * 64 + 8 * fq;
#pragma unroll
        for (int ai = 0; ai < 2; ++ai)
#pragma unroll
            for (int m = 0; m < 4; ++m) { const size_t row = (size_t)(row0 + ai * HALF + m * 16);
#pragma unroll
                for (int bj = 0; bj < 2; ++bj) { const int col = col0 + 32 * bj;
                    const u32x4 g = *(const u32x4*)(GT + row * 3072 + STAGE * 1024 + col);
                    const f32x4 ga = {bf_lo(g.x), bf_hi(g.x), bf_lo(g.y), bf_hi(g.y)}, gb = {bf_lo(g.z), bf_hi(g.z), bf_lo(g.w), bf_hi(g.w)};
                    f32x4 v0 = acc[ai][bj][m][0] * ga, v1 = acc[ai][bj][m][1] * gb;
                    float* mp = MF + row * 1024 + col;
                    if (STAGE > 0) { v0 += *(const f32x4*)mp; v1 += *(const f32x4*)(mp + 4); }
                    if (STAGE < 2) { *(f32x4*)mp = v0; *(f32x4*)(mp + 4) = v1; } else store8(MB + row * 1024 + col, v0, v1); }
                if (m & 1) asm volatile("" ::: "memory"); }
    }
};
struct EpiWout {
    static constexpr bool HAS_MID = false;
    const float* X; float* X2; unsigned char* XG; const float* n2;
    __device__ __forceinline__ void operator()(AccRef acc, const Unit& u, int wr, int wc, int fr, int fq) const {
        const int row0 = u.pm * BM + wr * 64 + fr, col0 = u.pn * BM + wc * 64 + 8 * fq;
        f32x4 nv[2][2];
#pragma unroll
        for (int bj = 0; bj < 2; ++bj)
#pragma unroll
            for (int n = 0; n < 2; ++n) nv[bj][n] = *(const f32x4*)(n2 + col0 + 32 * bj + 4 * n);
#pragma unroll
        for (int ai = 0; ai < 2; ++ai)
#pragma unroll
            for (int m = 0; m < 4; ++m) { const size_t off = (size_t)(row0 + ai * HALF + m * 16) * 1024 + col0;
#pragma unroll
                for (int bj = 0; bj < 2; ++bj) { const f32x4 x0 = *(const f32x4*)(X + off + 32 * bj) + acc[ai][bj][m][0], x1 = *(const f32x4*)(X + off + 32 * bj + 4) + acc[ai][bj][m][1];
                    *(f32x4*)(X2 + off + 32 * bj) = x0; *(f32x4*)(X2 + off + 32 * bj + 4) = x1;
                    { const f32x4 y0 = x0 * nv[bj][0], y1 = x1 * nv[bj][1]; u32x2 w8; w8.x = pk4_fp8(y0[0], y0[1], y0[2], y0[3]); w8.y = pk4_fp8(y1[0], y1[1], y1[2], y1[3]); *(u32x2*)(XG + off + 32 * bj) = w8; } }
                if (m & 1) asm volatile("" ::: "memory"); }
    }
};
struct EpiSwiglu {
    static constexpr bool HAS_MID = false;
    unsigned char* ACT; const u32x2* list; const float* bgu;
    __device__ __forceinline__ static unsigned swi4(const f32x4& ag, const f32x4& au, float rstd, const f32x4& bg, const f32x4& bu) {
        unsigned w = 0;
#pragma unroll
        for (int h = 0; h < 2; ++h) {
            const f32x2 a2 = {ag[2 * h], ag[2 * h + 1]}, u2 = {au[2 * h], au[2 * h + 1]}, bg2 = {bg[2 * h], bg[2 * h + 1]}, bu2 = {bu[2 * h], bu[2 * h + 1]};
            const f32x2 G = a2 * rstd + bg2, U = u2 * rstd + bu2;
            const f32x2 gg = {fminf(G[0], 7.0f), fminf(G[1], 7.0f)};
            const f32x2 t = gg * (-1.702f * 1.4426950408889634f);
            const f32x2 d = (f32x2){__builtin_amdgcn_exp2f(t[0]), __builtin_amdgcn_exp2f(t[1])} + 1.0f;
            const f32x2 r = {__builtin_amdgcn_rcpf(d[0]), __builtin_amdgcn_rcpf(d[1])};
            const f32x2 uu = {__builtin_amdgcn_fmed3f(U[0], -7.0f, 7.0f), __builtin_amdgcn_fmed3f(U[1], -7.0f, 7.0f)};
            const f32x2 o = (gg * r) * (uu * A8_SCALE + A8_SCALE);
            w = h ? (unsigned)__builtin_amdgcn_cvt_pk_fp8_f32(o[0], o[1], (int)w, true) : (unsigned)__builtin_amdgcn_cvt_pk_fp8_f32(o[0], o[1], (int)w, false);
        }
        return w;
    }
    __device__ __forceinline__ void operator()(AccRef acc, const Unit& u, int wr, int wc, int fr, int fq) const {
        int z = 0; asm volatile("" : "+v"(z));
        const int col = 128 * u.pn + 32 * wc + 8 * fq + z; const float* bp = bgu + (size_t)u.e * 2048 + col;
        const f32x4 bg0 = *(const f32x4*)bp, bg1 = *(const f32x4*)(bp + 4), bu0 = *(const f32x4*)(bp + 1024), bu1 = *(const f32x4*)(bp + 1028);
#pragma unroll
        for (int ai = 0; ai < 2; ++ai)
#pragma unroll
            for (int m = 0; m < 4; ++m) { const int r = ai * HALF + wr * 64 + m * 16 + fr, rr = u.mt * BM + r, rc = rr < u.cnt ? rr : u.cnt - 1;
                const float rstd = __uint_as_float(list[(size_t)u.e * CAP + rc].y) * (1.0f / W8_SCALE);
                u32x2 w8; w8.x = swi4(acc[ai][0][m][0], acc[ai][1][m][0], rstd, bg0, bu0); w8.y = swi4(acc[ai][0][m][1], acc[ai][1][m][1], rstd, bg1, bu1);
                *(u32x2*)(ACT + (size_t)(u.pm * BM + r) * 1024 + col) = w8; }
    }
};
struct EpiDown {
    static constexpr bool HAS_MID = false;
    unsigned char* Y4; const u32x2* list; const float* bd;
    __device__ __forceinline__ static unsigned dn4(const f32x4& a, const f32x4& b32) {
        const f32x4 y = a * (Y8_SCALE / (W8_SCALE * A8_SCALE)) + b32;
        return pk4_fp8(y[0], y[1], y[2], y[3]);
    }
    __device__ __forceinline__ void operator()(AccRef acc, const Unit& u, int wr, int wc, int fr, int fq) const {
        int z = 0; asm volatile("" : "+v"(z));
        const int col0 = u.pn * BM + wc * 64 + 16 * fq + z; const float* bp = bd + (size_t)u.e * 1024 + col0;
        f32x4 bv[2][2];
#pragma unroll
        for (int bj = 0; bj < 2; ++bj)
#pragma unroll
            for (int n = 0; n < 2; ++n) bv[bj][n] = *(const f32x4*)(bp + 8 * bj + 4 * n) * Y8_SCALE;
        unsigned tkv[8];
#pragma unroll
        for (int ai = 0; ai < 2; ++ai)
#pragma unroll
            for (int m = 0; m < 4; ++m) { const int rr = u.mt * BM + ai * HALF + wr * 64 + m * 16 + fr, rc = rr < u.cnt ? rr : u.cnt - 1;
                tkv[ai * 4 + m] = list[(size_t)u.e * CAP + rc].x; }
#pragma unroll
        for (int ai = 0; ai < 2; ++ai)
#pragma unroll
            for (int m = 0; m < 4; ++m) { const int rr = u.mt * BM + ai * HALF + wr * 64 + m * 16 + fr;
                if (rr < u.cnt) { u32x4 w8; w8.x = dn4(acc[ai][0][m][0], bv[0][0]); w8.y = dn4(acc[ai][0][m][1], bv[0][1]); w8.z = dn4(acc[ai][1][m][0], bv[1][0]); w8.w = dn4(acc[ai][1][m][1], bv[1][1]);
                    *(u32x4*)(Y4 + (size_t)tkv[ai * 4 + m] * 1024 + col0) = w8; } }
    }
};
struct EpiMergeR {
    static constexpr bool HAS_MID = true; static constexpr int MID_T0 = 8, MID_T1 = 12;
    const bf16_t* GT; bf16_t* MB;
    __device__ __forceinline__ void mid(f32x4 (&acc)[2][2][4][2], const Unit& u, int wr, int wc, int fr, int fq, int seam) const {
        int z = 0; asm volatile("" : "+v"(z));
        const bf16_t* gp0 = GT + ((size_t)(seam * 128 + u.pm) * 4 + u.pn) * 65536 + (size_t)((wr * 4 + wc) * 16 * 64 + (fq * 16 + fr) + z) * 8;
#pragma unroll
        for (int ai = 0; ai < 2; ++ai)
#pragma unroll
            for (int m = 0; m < 4; ++m) {
#pragma unroll
                for (int bj = 0; bj < 2; ++bj) { const bf16_t* gp = gp0 + (ai * 8 + m * 2 + bj) * 512;
                    const u32x4 gn = *(const u32x4*)gp, gd = *(const u32x4*)(gp + (size_t)128 * 4 * 65536);
                    const unsigned nn[4] = {gn.x, gn.y, gn.z, gn.w}, dd[4] = {gd.x, gd.y, gd.z, gd.w};
#pragma unroll
                    for (int j = 0; j < 4; ++j) { const float r0 = bf_lo(nn[j]) * __builtin_amdgcn_rcpf(fmaxf(bf_lo(dd[j]), 8.67e-19f)), r1 = bf_hi(nn[j]) * __builtin_amdgcn_rcpf(fmaxf(bf_hi(dd[j]), 8.67e-19f));
                        acc[ai][bj][m][j >> 1][(j & 1) * 2] *= r0; acc[ai][bj][m][j >> 1][(j & 1) * 2 + 1] *= r1; } }
                if (m & 1) asm volatile("" ::: "memory"); }
    }
    __device__ __forceinline__ void operator()(AccRef acc, const Unit& u, int wr, int wc, int fr, int fq) const {
        int z = 0; asm volatile("" : "+v"(z));
        const size_t off0 = (size_t)(u.pm * BM + wr * 64 + fr + z) * 1024 + u.pn * BM + wc * 64 + 8 * fq;
        const bf16_t* gp0 = GT + ((size_t)(2 * 128 + u.pm) * 4 + u.pn) * 65536 + (size_t)((wr * 4 + wc) * 16 * 64 + (fq * 16 + fr) + z) * 8;
#pragma unroll
        for (int ai = 0; ai < 2; ++ai)
#pragma unroll
            for (int m = 0; m < 4; ++m) { const size_t ro = off0 + (size_t)(ai * HALF + m * 16) * 1024;
#pragma unroll
                for (int bj = 0; bj < 2; ++bj) {
                    const u32x4 g = *(const u32x4*)(gp0 + (ai * 8 + m * 2 + bj) * 512);
                    const f32x4 ga = {bf_lo(g.x), bf_hi(g.x), bf_lo(g.y), bf_hi(g.y)}, gb = {bf_lo(g.z), bf_hi(g.z), bf_lo(g.w), bf_hi(g.w)};
                    store8(MB + ro + 32 * bj, acc[ai][bj][m][0] * ga, acc[ai][bj][m][1] * gb); } }
    }
};
struct EpiPlain {
    static constexpr bool HAS_MID = false;
    bf16_t* Z; int ldz;
    __device__ __forceinline__ void operator()(AccRef acc, const Unit& u, int wr, int wc, int fr, int fq) const {
        const int row0 = u.pm * BM + wr * 64 + fr, col0 = u.pn * BM + wc * 64 + 8 * fq;
#pragma unroll
        for (int ai = 0; ai < 2; ++ai)
#pragma unroll
            for (int m = 0; m < 4; ++m) { bf16_t* rowp = Z + (size_t)(row0 + ai * HALF + m * 16) * ldz + col0;
                store8(rowp, acc[ai][0][m][0], acc[ai][0][m][1]); store8(rowp + 32, acc[ai][1][m][0], acc[ai][1][m][1]); }
    }
};
}

namespace attn_body {
using bf16 = __hip_bfloat16;
using s16x4 = __attribute__((ext_vector_type(4))) short;
constexpr int NW = 8, QBLK = 32, QB = QBLK * NW, KVBLK = 64, D = 64;
__device__ __forceinline__ int crow(int r, int hi) { return (r & 3) + 8 * (r >> 2) + 4 * hi; }
#define SBAR() __builtin_amdgcn_sched_barrier(0)
constexpr int NSLOT = 3, SLOTB = 8192;
constexpr int LDS_K = 0, LDS_V = NSLOT * SLOTB, LDS_WS = 2 * NSLOT * SLOTB, LDS_OST = LDS_WS + NW * 64 * 4, LDS_BYTES = LDS_OST + NW * 4096;
__device__ __forceinline__ void glds16(const void* gsrc, unsigned lds_dst) { unsigned keep;
    asm volatile("s_mov_b32 %0, m0\n\ts_mov_b32 m0, %2\n\ts_nop 0\n\tglobal_load_lds_dwordx4 %1, off\n\ts_mov_b32 m0, %0" : "=&s"(keep) : "v"(gsrc), "s"(lds_dst) : "memory"); }
__device__ __forceinline__ float max3f(float a, float b, float c) { float r; asm("v_max3_f32 %0, %1, %2, %3" : "=v"(r) : "v"(a), "v"(b), "v"(c)); return r; }
__device__ __forceinline__ float max2f(float a, float b) { float r; asm("v_max_f32_e32 %0, %1, %2" : "=v"(r) : "v"(a), "v"(b)); return r; }
__device__ __forceinline__ float fadd_s(float a, float b) { float r; asm("v_add_f32_e32 %0, %1, %2" : "=v"(r) : "v"(a), "v"(b)); return r; }
__device__ __forceinline__ float fsub_s(float a, float b) { float r; asm("v_sub_f32_e32 %0, %1, %2" : "=v"(r) : "v"(a), "v"(b)); return r; }
typedef float f32x2_t __attribute__((ext_vector_type(2))); typedef __bf16 bf16x2_t __attribute__((ext_vector_type(2)));
__device__ __forceinline__ unsigned cvtpk_s(float lo, float hi) { f32x2_t v = {lo, hi}; bf16x2_t b = __builtin_convertvector(v, bf16x2_t); return __builtin_bit_cast(unsigned, b); }
#define WAIT_BAR(N) asm volatile("s_waitcnt vmcnt(" #N ") lgkmcnt(0)\n\ts_barrier" ::: "memory")

__device__ __forceinline__ void qkt(f32x16& p0, f32x16& p1, const char* Kslot, const bf16x8* qr, const f32x16& negm, int r32, int hi) {
    const char* kb = Kslot + hi * 1024 + r32 * 16;
#pragma unroll
    for (int d0 = 0; d0 < 4; ++d0) {
        const bf16x8 b0 = *reinterpret_cast<const bf16x8*>(kb + d0 * 2048);
        const bf16x8 b1 = *reinterpret_cast<const bf16x8*>(kb + d0 * 2048 + 512);
        if (d0 == 0) { p0 = __builtin_amdgcn_mfma_f32_32x32x16_bf16(b0, qr[0], negm, 0, 0, 0); p1 = __builtin_amdgcn_mfma_f32_32x32x16_bf16(b1, qr[0], negm, 0, 0, 0); }
        else { p0 = __builtin_amdgcn_mfma_f32_32x32x16_bf16(b0, qr[d0], p0, 0, 0, 0); p1 = __builtin_amdgcn_mfma_f32_32x32x16_bf16(b1, qr[d0], p1, 0, 0, 0); } }
}
typedef __attribute__((address_space(3))) const char* lds_cptr;
typedef short v4i16_t __attribute__((ext_vector_type(4)));
__device__ __forceinline__ void kload8(bf16x8* kf, lds_cptr kp) {
    kf[0] = *(const __attribute__((address_space(3))) bf16x8*)(kp);        kf[1] = *(const __attribute__((address_space(3))) bf16x8*)(kp + 512);
    kf[2] = *(const __attribute__((address_space(3))) bf16x8*)(kp + 2048); kf[3] = *(const __attribute__((address_space(3))) bf16x8*)(kp + 2560);
    kf[4] = *(const __attribute__((address_space(3))) bf16x8*)(kp + 4096); kf[5] = *(const __attribute__((address_space(3))) bf16x8*)(kp + 4608);
    kf[6] = *(const __attribute__((address_space(3))) bf16x8*)(kp + 6144); kf[7] = *(const __attribute__((address_space(3))) bf16x8*)(kp + 6656);
}
__device__ __forceinline__ void kload2(bf16x8* kf, lds_cptr kp, int j) { kf[2 * j] = *(const __attribute__((address_space(3))) bf16x8*)(kp + j * 2048); kf[2 * j + 1] = *(const __attribute__((address_space(3))) bf16x8*)(kp + j * 2048 + 512); }
__device__ __forceinline__ s16x4 vtr(lds_cptr p) { return __builtin_bit_cast(s16x4, __builtin_amdgcn_ds_read_tr16_b64_v4i16((__attribute__((address_space(3))) v4i16_t*)p)); }
__device__ __forceinline__ float rowmax(const f32x16& p0, const f32x16& p1) {
    float a = max3f(p0[0], p0[1], p1[0]), b = max3f(p0[2], p0[3], p1[1]); a = max3f(a, p1[2], p1[3]);
#pragma unroll
    for (int r = 4; r < 16; r += 4) { a = max3f(a, p0[r], p0[r + 1]); b = max3f(b, p0[r + 2], p0[r + 3]); a = max3f(a, p1[r], p1[r + 1]); b = max3f(b, p1[r + 2], p1[r + 3]); }
    const float m = max2f(a, b);
    auto rr = __builtin_amdgcn_permlane32_swap(__float_as_uint(m), __float_as_uint(m), false, false);
    return max2f(__uint_as_float(rr[0]), __uint_as_float(rr[1]));
}
__device__ __forceinline__ void pv(f32x16* o, int vb, bf16x8 pa0, bf16x8 pa1, bf16x8 pa2, bf16x8 pa3) {
#pragma unroll
    for (int d0 = 0; d0 < 2; ++d0) { s16x4 lo[4], hi[4];
#pragma unroll
        for (int ks = 0; ks < 4; ++ks) {
            asm volatile("ds_read_b64_tr_b16 %0,%1 offset:%c2" : "=&v"(lo[ks]) : "v"(vb), "i"(d0 * 4096 + ks * 1024) : "memory");
            asm volatile("ds_read_b64_tr_b16 %0,%1 offset:%c2" : "=&v"(hi[ks]) : "v"(vb), "i"(d0 * 4096 + ks * 1024 + 512) : "memory"); }
        asm volatile("s_waitcnt lgkmcnt(0)" ::: "memory"); SBAR();
#define PK(k) (bf16x8){lo[k][0], lo[k][1], lo[k][2], lo[k][3], hi[k][0], hi[k][1], hi[k][2], hi[k][3]}
        o[d0] = __builtin_amdgcn_mfma_f32_32x32x16_bf16(pa0, PK(0), o[d0], 0, 0, 0);
        o[d0] = __builtin_amdgcn_mfma_f32_32x32x16_bf16(pa1, PK(1), o[d0], 0, 0, 0);
        o[d0] = __builtin_amdgcn_mfma_f32_32x32x16_bf16(pa2, PK(2), o[d0], 0, 0, 0);
        o[d0] = __builtin_amdgcn_mfma_f32_32x32x16_bf16(pa3, PK(3), o[d0], 0, 0, 0);
#undef PK
    }
}
__device__ __forceinline__ void cmask(f32x16& p0, f32x16& p1, int jb, int wid) {
    if (jb > (wid >> 1)) {
#pragma unroll
        for (int r = 0; r < 16; ++r) { p0[r] = -INFINITY; p1[r] = -INFINITY; } }
}
template <int THRL, bool MASK> __device__ __forceinline__ void attn_unit(int q0, int NT, const bf16* Qh, int qp, const bf16* __restrict__ Kh, int kp, const bf16* __restrict__ Vh, int vp, bf16* Oh, int op, char* shm) {
    const int tid = threadIdx.x, lane = tid & 63, r32 = lane & 31, hi = lane >> 5; const int wid = __builtin_amdgcn_readfirstlane(tid >> 6);
    const bf16* Qw = Qh + (long)(q0 + wid * QBLK) * qp;
    const unsigned lds0 = (unsigned)(uintptr_t)shm;
    float* wsf = (float*)(shm + LDS_WS) + wid * 64;
    const bf16* ksrc = Kh + (long)lane * kp + wid * 8;
    const bf16* vsrc = Vh + (long)(16 * (wid & 3) + (lane >> 2)) * vp + (wid >> 2) * 32 + (lane & 3) * 8;
    const unsigned kdst = lds0 + LDS_K + wid * 1024, vdst = lds0 + LDS_V + wid * 1024;
#define DMA_K(t, slot) glds16(ksrc + (long)(t) * KVBLK * kp, (unsigned)__builtin_amdgcn_readfirstlane(kdst + (slot)))
#define DMA_V(t, slot) glds16(vsrc + (long)(t) * KVBLK * vp, (unsigned)__builtin_amdgcn_readfirstlane(vdst + (slot)))
    const int vb0 = (int)(lds0 + LDS_V) + ((lane >> 4) & 1) * 32 + (lane & 3) * 8 + (4 * hi + ((lane & 15) >> 2)) * 64;
    const char* Kbase = shm + LDS_K; bf16x8 kf[8];
    const lds_cptr shm3 = (lds_cptr)shm; const lds_cptr kp0 = shm3 + LDS_K + hi * 1024 + r32 * 16; const lds_cptr vp0 = shm3 + LDS_V + ((lane >> 4) & 1) * 32 + (lane & 3) * 8 + (4 * hi + ((lane & 15) >> 2)) * 64;
    DMA_K(0, 0); DMA_V(0, 0); DMA_K(1, SLOTB);
    bf16x8 qr[4];
#pragma unroll
    for (int d0 = 0; d0 < 4; ++d0) qr[d0] = *reinterpret_cast<const bf16x8*>(&Qw[(long)r32 * qp + d0 * 16 + hi * 8]);
    float mhat = 0.f, l_reg = 0.f; f32x16 o[2]; o[0] = f32x16{}; o[1] = f32x16{}; f32x16 negm = f32x16{}; asm volatile("" : "+v"(negm));
#define CMASK(P0, P1, t) do { if (MASK) { int jb_ = (t) - (NT - 4); if (jb_ >= 0) cmask(P0, P1, jb_, wid); } } while (0)
    bool resc = false;
#define START(P0, P1) do { const float rm = rowmax(P0, P1); resc = false; \
    { const float dl = rm; mhat = fadd_s(mhat, dl); \
      _Pragma("unroll") for (int r = 0; r < 16; ++r) { P0[r] = fsub_s(P0[r], dl); P1[r] = fsub_s(P1[r], dl); } \
      _Pragma("unroll") for (int r = 0; r < 16; ++r) negm[r] = -mhat; asm volatile("" : "+v"(negm)); } \
    _Pragma("unroll") for (int r = 0; r < 16; ++r) P0[r] = __builtin_amdgcn_exp2f(P0[r]); } while (0)
#define RESC() do { if (resc) { asm volatile("s_waitcnt lgkmcnt(0)" ::: "memory"); \
      _Pragma("unroll") for (int d_ = 0; d_ < 2; ++d_) _Pragma("unroll") for (int r = 0; r < 16; ++r) o[d_][r] *= wsf[crow(r, hi)]; } } while (0)
    f32x16 pA0, pA1, pB0, pB1;
    int sl_prev = 0, sl_cur = 0, sl_next = SLOTB;
#define ROT() do { sl_prev = sl_cur; sl_cur = sl_next; sl_next = (sl_next == (NSLOT - 1) * SLOTB) ? 0 : sl_next + SLOTB; } while (0)
    DMA_K(2, 2 * SLOTB);
    WAIT_BAR(3);
    qkt(pA0, pA1, Kbase, qr, negm, r32, hi); asm volatile("s_nop 15\n\ts_nop 7" : "+v"(pA0), "+v"(pA1)); CMASK(pA0, pA1, 0);
    START(pA0, pA1);
    _Pragma("unroll") for (int r = 0; r < 16; ++r) pA1[r] = __builtin_amdgcn_exp2f(pA1[r]);
    WAIT_BAR(0);
    DMA_K(3, 0); DMA_V(1, SLOTB);
    ROT();
    kload8(kf, kp0 + sl_cur);
    WAIT_BAR(2);
    s16x4 vlo[8], vhi[8]; u32x4 pw0, pw1, pw2, pw3;
#define PKW(P, B) cvtpk_s(P[B], P[B + 1])
#define PAF(k) __builtin_bit_cast(bf16x8, pw##k)
#define VFR(i) (bf16x8){vlo[i][0], vlo[i][1], vlo[i][2], vlo[i][3], vhi[i][0], vhi[i][1], vhi[i][2], vhi[i][3]}
#define PIN(x) asm volatile("" : "+v"(x))
#define MX3(a, b, c) __builtin_fmaxf(__builtin_fmaxf((a), (b)), (c))
#define GAPA(MF, A0, A1, A2, A3, W0, W1, PW) do { MF; sacc += A0; sacc += A1; sacc += A2; sacc += A3; PIN(sacc); W0; W1; PIN(PW); SBAR(); } while (0)
#define EX(v) __builtin_amdgcn_exp2f(v)
#define GAPB(MF, X, B) do { MF; X[B] = EX(X[B]); X[B + 1] = EX(X[B + 1]); X[B + 2] = EX(X[B + 2]); X[B + 3] = EX(X[B + 3]); PIN(X); SBAR(); } while (0)
#define VRD(i) do { vlo[i] = vtr(vp_ + (((i) >> 2) * 4096 + ((i) & 3) * 1024)); vhi[i] = vtr(vp_ + (((i) >> 2) * 4096 + ((i) & 3) * 1024 + 512)); } while (0)
#define KRD(G, j) do { if (G) { kload2(kf, kp0 + sl_next, j); SBAR(); } } while (0)
#define STEP(C0, C1, P0, P1, t, GK, GV, GL) do { SBAR(); \
    const lds_cptr vp_ = vp0 + sl_prev; \
    VRD(0); SBAR(); float sacc = (P0[0] + P0[1]); \
    GAPA(C0 = __builtin_amdgcn_mfma_f32_32x32x16_bf16(kf[0], qr[0], negm, 0, 0, 0), P0[2], P0[3], P0[4], P0[5],     pw0[0] = PKW(P0, 0), pw0[1] = PKW(P0, 2), pw0); \
    VRD(4); SBAR(); GAPA(C1 = __builtin_amdgcn_mfma_f32_32x32x16_bf16(kf[1], qr[0], negm, 0, 0, 0), P0[6], P0[7], P0[8], P0[9],     pw0[2] = PKW(P0, 4), pw0[3] = PKW(P0, 6), pw0); \
    VRD(1); SBAR(); GAPA(C0 = __builtin_amdgcn_mfma_f32_32x32x16_bf16(kf[2], qr[1], C0, 0, 0, 0),   P0[10], P0[11], P0[12], P0[13], pw1[0] = PKW(P0, 8), pw1[1] = PKW(P0, 10), pw1); \
    VRD(5); SBAR(); GAPA(C1 = __builtin_amdgcn_mfma_f32_32x32x16_bf16(kf[3], qr[1], C1, 0, 0, 0),   P0[14], P0[15], P1[0], P1[1],   pw1[2] = PKW(P0, 12), pw1[3] = PKW(P0, 14), pw1); \
    VRD(2); SBAR(); GAPA(C0 = __builtin_amdgcn_mfma_f32_32x32x16_bf16(kf[4], qr[2], C0, 0, 0, 0),   P1[2], P1[3], P1[4], P1[5],     pw2[0] = PKW(P1, 0), pw2[1] = PKW(P1, 2), pw2); \
    VRD(6); SBAR(); GAPA(C1 = __builtin_amdgcn_mfma_f32_32x32x16_bf16(kf[5], qr[2], C1, 0, 0, 0),   P1[6], P1[7], P1[8], P1[9],     pw2[2] = PKW(P1, 4), pw2[3] = PKW(P1, 6), pw2); \
    VRD(3); SBAR(); GAPA(C0 = __builtin_amdgcn_mfma_f32_32x32x16_bf16(kf[6], qr[3], C0, 0, 0, 0),   P1[10], P1[11], P1[12], P1[13], pw3[0] = PKW(P1, 8), pw3[1] = PKW(P1, 10), pw3); \
    VRD(7); SBAR(); GAPA(C1 = __builtin_amdgcn_mfma_f32_32x32x16_bf16(kf[7], qr[3], C1, 0, 0, 0),   P1[14], P1[15], 0.f, 0.f,       pw3[2] = PKW(P1, 12), pw3[3] = PKW(P1, 14), pw3); \
    l_reg += sacc; \
    if (GK) { DMA_K((t) + 3, sl_cur); } if (GV) { DMA_V((t) + 1, sl_next); } \
    CMASK(C0, C1, t); \
    { float a = MX3(C0[0], C0[1], C1[0]), b = MX3(C0[2], C0[3], C1[1]); a = MX3(a, C1[2], C1[3]); \
      _Pragma("unroll") for (int r = 4; r < 16; r += 4) { a = MX3(a, C0[r], C0[r + 1]); b = MX3(b, C0[r + 2], C0[r + 3]); a = MX3(a, C1[r], C1[r + 1]); b = MX3(b, C1[r + 2], C1[r + 3]); } \
      float rm = __builtin_fmaxf(a, b); { auto rr = __builtin_amdgcn_permlane32_swap(__float_as_uint(rm), __float_as_uint(rm), false, false); rm = __builtin_fmaxf(__uint_as_float(rr[0]), __uint_as_float(rr[1])); } \
      resc = false; \
      if (__builtin_expect(__any(rm > (float)THRL), 0)) { const float dl = __builtin_fmaxf(rm, 0.f); mhat += dl; \
        _Pragma("unroll") for (int r = 0; r < 16; ++r) { C0[r] -= dl; C1[r] -= dl; } \
        _Pragma("unroll") for (int r = 0; r < 16; ++r) negm[r] = -mhat; asm volatile("" : "+v"(negm)); \
        const float f = __builtin_amdgcn_exp2f(-dl); l_reg *= f; if (hi == 0) wsf[r32] = f; resc = true; } } \
    SBAR(); \
    GAPB(o[0] = __builtin_amdgcn_mfma_f32_32x32x16_bf16(PAF(0), VFR(0), o[0], 0, 0, 0), C0, 0); \
    GAPB(o[1] = __builtin_amdgcn_mfma_f32_32x32x16_bf16(PAF(0), VFR(4), o[1], 0, 0, 0), C0, 4); \
    KRD(GL, 0); GAPB(o[0] = __builtin_amdgcn_mfma_f32_32x32x16_bf16(PAF(1), VFR(1), o[0], 0, 0, 0), C0, 8); \
    KRD(GL, 1); GAPB(o[1] = __builtin_amdgcn_mfma_f32_32x32x16_bf16(PAF(1), VFR(5), o[1], 0, 0, 0), C0, 12); \
    KRD(GL, 2); GAPB(o[0] = __builtin_amdgcn_mfma_f32_32x32x16_bf16(PAF(2), VFR(2), o[0], 0, 0, 0), C1, 0); \
    KRD(GL, 3); GAPB(o[1] = __builtin_amdgcn_mfma_f32_32x32x16_bf16(PAF(2), VFR(6), o[1], 0, 0, 0), C1, 4); \
    GAPB(o[0] = __builtin_amdgcn_mfma_f32_32x32x16_bf16(PAF(3), VFR(3), o[0], 0, 0, 0), C1, 8); \
    GAPB(o[1] = __builtin_amdgcn_mfma_f32_32x32x16_bf16(PAF(3), VFR(7), o[1], 0, 0, 0), C1, 12); \
    } while (0)
    int t = 1;
#undef CMASK
#define CMASK(P0, P1, t) do {} while (0)
    for (; t + 5 < NT; t += 2) {
        STEP(pB0, pB1, pA0, pA1, t, true, true, true);     WAIT_BAR(2); RESC(); ROT();
        STEP(pA0, pA1, pB0, pB1, t + 1, true, true, true); WAIT_BAR(2); RESC(); ROT();
    }
#undef CMASK
#define CMASK(P0, P1, t) do { if (MASK) { int jb_ = (t) - (NT - 4); if (jb_ >= 0) cmask(P0, P1, jb_, wid); } } while (0)
#define ENDW(tt) do { if ((tt) + 3 < NT) { WAIT_BAR(2); } else if ((tt) + 2 < NT) { WAIT_BAR(1); } else { WAIT_BAR(0); } } while (0)
    for (; t + 1 < NT; t += 2) {
        STEP(pB0, pB1, pA0, pA1, t, (t + 3 < NT), (t + 1 < NT), (t + 1 < NT));       ENDW(t);     RESC(); ROT();
        STEP(pA0, pA1, pB0, pB1, t + 1, (t + 4 < NT), (t + 2 < NT), (t + 2 < NT));   ENDW(t + 1); RESC(); ROT();
    }
    STEP(pB0, pB1, pA0, pA1, NT - 1, false, false, false); RESC();
    { float sacc = pB0[0] + pB0[1]; _Pragma("unroll") for (int r = 2; r < 16; ++r) sacc += pB0[r]; _Pragma("unroll") for (int r = 0; r < 16; ++r) sacc += pB1[r]; l_reg += sacc;
      pw0 = (u32x4){PKW(pB0, 0), PKW(pB0, 2), PKW(pB0, 4), PKW(pB0, 6)}; pw1 = (u32x4){PKW(pB0, 8), PKW(pB0, 10), PKW(pB0, 12), PKW(pB0, 14)}; pw2 = (u32x4){PKW(pB1, 0), PKW(pB1, 2), PKW(pB1, 4), PKW(pB1, 6)}; pw3 = (u32x4){PKW(pB1, 8), PKW(pB1, 10), PKW(pB1, 12), PKW(pB1, 14)};
      SBAR(); pv(o, vb0 + sl_cur, PAF(0), PAF(1), PAF(2), PAF(3)); }
#undef PKW
#undef PAF
#undef VFR
#undef PIN
#undef MX3
#undef GAPA
#undef GAPB
#undef EX
#undef VRD
#undef KRD
#undef STEP
#undef ENDW
    { auto rr = __builtin_amdgcn_permlane32_swap(__float_as_uint(l_reg), __float_as_uint(l_reg), false, false); l_reg = __uint_as_float(rr[0]) + __uint_as_float(rr[1]); }
    if (hi == 0) wsf[32 + r32] = l_reg; asm volatile("s_waitcnt lgkmcnt(0)" ::: "memory");
    float rli[16];
#pragma unroll
    for (int r = 0; r < 16; ++r) rli[r] = __builtin_amdgcn_rcpf(wsf[32 + crow(r, hi)]);
    bf16* Ow = Oh + (long)(q0 + wid * QBLK) * op;
    { bf16* stg = (bf16*)(shm + LDS_OST) + wid * 2048;
#pragma unroll
      for (int r = 0; r < 16; ++r) { const int orow = crow(r, hi);
#pragma unroll
        for (int d0 = 0; d0 < 2; ++d0) stg[orow * 64 + d0 * 32 + r32] = __float2bfloat16(o[d0][r] * rli[r]); }
      asm volatile("s_waitcnt lgkmcnt(0)" ::: "memory");
#pragma unroll
      for (int i = 0; i < 4; ++i) { const int row = i * 8 + (lane >> 3), ch = lane & 7; const u32x4 v = *(const u32x4*)(stg + row * 64 + ch * 8); *(u32x4*)(Ow + (long)row * op + ch * 8) = v; } }
    asm volatile("s_waitcnt lgkmcnt(0)\n\ts_barrier" ::: "memory");
#undef DMA_K
#undef DMA_V
#undef CMASK
#undef START
#undef RESC
#undef ROT
}

constexpr int L2_K = 0, L2_V = 3 * 8192, L2_WS = L2_V + 4 * 16384, L2_OST = L2_WS + NW * 64 * 4, L2_BYTES = L2_OST + NW * 4096;
template <bool MASK> __device__ __forceinline__ void attn_unit2(int q0, int NT, const bf16* Qh, int qp, const bf16* __restrict__ Kh, int kp, const bf16* __restrict__ Vh, int vp, bf16* Oh, int op, char* shm) {
    const int tid = threadIdx.x, lane = tid & 63, r32 = lane & 31, hi = lane >> 5; const int wid = __builtin_amdgcn_readfirstlane(tid >> 6);
    const bf16* Qw = Qh + (long)(q0 + wid * QBLK) * qp;
    const unsigned lds0 = (unsigned)(uintptr_t)shm;
    float* wsf = (float*)(shm + L2_WS) + wid * 64;
    const bf16* ksrc = Kh + (long)lane * kp + wid * 8;
    const bf16* vsrc = Vh + (long)(16 * (wid & 3) + (lane >> 2)) * vp + (wid >> 2) * 32 + (lane & 3) * 8;
    const unsigned kdst = lds0 + L2_K + wid * 1024, vdst = lds0 + L2_V + wid * 1024;
#define DMA_K(t, slot) glds16(ksrc + (long)(t) * KVBLK * kp, (unsigned)__builtin_amdgcn_readfirstlane(kdst + (slot)))
#define DMA_V(t, vslot) do { glds16(vsrc + (long)(t) * KVBLK * vp, (unsigned)__builtin_amdgcn_readfirstlane(vdst + (vslot))); \
                            glds16(vsrc + (long)(t) * KVBLK * vp + 64, (unsigned)__builtin_amdgcn_readfirstlane(vdst + (vslot) + 8192)); } while (0)
    const int vb0 = (int)(lds0 + L2_V) + ((lane >> 4) & 1) * 32 + (lane & 3) * 8 + (4 * hi + ((lane & 15) >> 2)) * 64;
    const char* Kbase = shm + L2_K; bf16x8 kf[8];
    const lds_cptr shm3 = (lds_cptr)shm; const lds_cptr kp0 = shm3 + L2_K + hi * 1024 + r32 * 16; const lds_cptr vp0 = shm3 + L2_V + ((lane >> 4) & 1) * 32 + (lane & 3) * 8 + (4 * hi + ((lane & 15) >> 2)) * 64;
    DMA_K(0, 0); DMA_V(0, 0); DMA_K(1, SLOTB);
    bf16x8 qr[4];
#pragma unroll
    for (int d0 = 0; d0 < 4; ++d0) qr[d0] = *reinterpret_cast<const bf16x8*>(&Qw[(long)r32 * qp + d0 * 16 + hi * 8]);
    float l_reg = 0.f; f32x16 o[4]; o[0] = f32x16{}; o[1] = f32x16{}; o[2] = f32x16{}; o[3] = f32x16{};
    const f32x16 zero16 = f32x16{};
#define CMASK(P0, P1, t) do { if (MASK) { int jb_ = (t) - (NT - 4); if (jb_ >= 0) cmask(P0, P1, jb_, wid); } } while (0)
    f32x16 pA0, pA1, pB0, pB1;
    int sl_prev = 0, sl_cur = 0, sl_next = SLOTB;
    int vs_rd = 0, vs_wr = 3 * 16384;
#define ROT() do { sl_prev = sl_cur; sl_cur = sl_next; sl_next = (sl_next == (NSLOT - 1) * SLOTB) ? 0 : sl_next + SLOTB; vs_rd = (vs_rd + 16384) & 65535; vs_wr = (vs_wr + 16384) & 65535; } while (0)
    DMA_K(2, 2 * SLOTB); DMA_V(1, 16384);
    WAIT_BAR(6);
    qkt(pA0, pA1, Kbase, qr, zero16, r32, hi); CMASK(pA0, pA1, 0);
    _Pragma("unroll") for (int r = 0; r < 16; ++r) { pA0[r] = __builtin_amdgcn_exp2f(pA0[r]); pA1[r] = __builtin_amdgcn_exp2f(pA1[r]); }
    WAIT_BAR(2);
    DMA_K(3, 0); DMA_V(2, 2 * 16384);
    sl_prev = sl_cur; sl_cur = sl_next; sl_next = 2 * SLOTB;
    kload8(kf, kp0 + sl_cur);
    WAIT_BAR(5);
    s16x4 f0lo, f0hi, f1lo, f1hi, f2lo, f2hi, f3lo, f3hi; u32x4 pw0, pw1, pw2, pw3;
#define PKW(P, B) cvtpk_s(P[B], P[B + 1])
#define PAF(k) __builtin_bit_cast(bf16x8, pw##k)
#define PIN(x) asm volatile("" : "+v"(x))
#define EX(v) __builtin_amdgcn_exp2f(v)
#define VOFF(id) ((((id) >> 2) * 4096) + (((id) & 3) * 1024))
#define VRD2(F, id) do { F##lo = vtr(vp_ + VOFF(id)); F##hi = vtr(vp_ + VOFF(id) + 512); } while (0)
#define VFR2(F) (bf16x8){F##lo[0], F##lo[1], F##lo[2], F##lo[3], F##hi[0], F##hi[1], F##hi[2], F##hi[3]}
#define GAPA(MF, A0, A1, A2, A3, W0, W1, PW) do { MF; sacc += A0; sacc += A1; sacc += A2; sacc += A3; PIN(sacc); W0; W1; PIN(PW); SBAR(); } while (0)
#define GAPB(MF, RD, X, B) do { MF; RD; X[B] = EX(X[B]); X[B + 1] = EX(X[B + 1]); PIN(X); SBAR(); } while (0)
#define KRD(G, j) do { if (G) { kload2(kf, kp0 + sl_next, j); SBAR(); } } while (0)
#define MF32(a, b, c) __builtin_amdgcn_mfma_f32_32x32x16_bf16(a, b, c, 0, 0, 0)
#define STEP(C0, C1, P0, P1, t, GK, GV, GL) do { SBAR(); __builtin_amdgcn_s_setprio(ATTN_PRIO_A); \
    const lds_cptr vp_ = vp0 + vs_rd; \
    float sacc = (P0[0] + P0[1]); \
    GAPA(C0 = MF32(kf[0], qr[0], zero16), P0[2], P0[3], P0[4], P0[5],     pw0[0] = PKW(P0, 0), pw0[1] = PKW(P0, 2), pw0); \
    GAPA(C1 = MF32(kf[1], qr[0], zero16), P0[6], P0[7], P0[8], P0[9],     pw0[2] = PKW(P0, 4), pw0[3] = PKW(P0, 6), pw0); \
    GAPA(C0 = MF32(kf[2], qr[1], C0),     P0[10], P0[11], P0[12], P0[13], pw1[0] = PKW(P0, 8), pw1[1] = PKW(P0, 10), pw1); \
    GAPA(C1 = MF32(kf[3], qr[1], C1),     P0[14], P0[15], P1[0], P1[1],   pw1[2] = PKW(P0, 12), pw1[3] = PKW(P0, 14), pw1); \
    VRD2(f0, 0); SBAR();  GAPA(C0 = MF32(kf[4], qr[2], C0), P1[2], P1[3], P1[4], P1[5],     pw2[0] = PKW(P1, 0), pw2[1] = PKW(P1, 2), pw2); \
    VRD2(f1, 4); SBAR();  GAPA(C1 = MF32(kf[5], qr[2], C1), P1[6], P1[7], P1[8], P1[9],     pw2[2] = PKW(P1, 4), pw2[3] = PKW(P1, 6), pw2); \
    VRD2(f2, 8); SBAR();  GAPA(C0 = MF32(kf[6], qr[3], C0), P1[10], P1[11], P1[12], P1[13], pw3[0] = PKW(P1, 8), pw3[1] = PKW(P1, 10), pw3); \
    VRD2(f3, 12); SBAR(); GAPA(C1 = MF32(kf[7], qr[3], C1), P1[14], P1[15], 0.f, 0.f,       pw3[2] = PKW(P1, 12), pw3[3] = PKW(P1, 14), pw3); \
    l_reg += sacc; __builtin_amdgcn_s_setprio(0); \
    if (GK) { DMA_K((t) + 3, sl_cur); } if (GV) { DMA_V((t) + 2, vs_wr); } \
    CMASK(C0, C1, t); \
    SBAR(); __builtin_amdgcn_s_setprio(ATTN_PRIO_B); \
    GAPB(o[0] = MF32(PAF(0), VFR2(f0), o[0]), VRD2(f0, 1),  C0, 0); \
    GAPB(o[1] = MF32(PAF(0), VFR2(f1), o[1]), VRD2(f1, 5),  C0, 2); \
    GAPB(o[2] = MF32(PAF(0), VFR2(f2), o[2]), VRD2(f2, 9),  C0, 4); \
    GAPB(o[3] = MF32(PAF(0), VFR2(f3), o[3]), VRD2(f3, 13), C0, 6); \
    KRD(GL, 0); GAPB(o[0] = MF32(PAF(1), VFR2(f0), o[0]), VRD2(f0, 2),  C0, 8); \
    GAPB(o[1] = MF32(PAF(1), VFR2(f1), o[1]), VRD2(f1, 6),  C0, 10); \
    KRD(GL, 1); GAPB(o[2] = MF32(PAF(1), VFR2(f2), o[2]), VRD2(f2, 10), C0, 12); \
    GAPB(o[3] = MF32(PAF(1), VFR2(f3), o[3]), VRD2(f3, 14), C0, 14); \
    KRD(GL, 2); GAPB(o[0] = MF32(PAF(2), VFR2(f0), o[0]), VRD2(f0, 3),  C1, 0); \
    GAPB(o[1] = MF32(PAF(2), VFR2(f1), o[1]), VRD2(f1, 7),  C1, 2); \
    KRD(GL, 3); GAPB(o[2] = MF32(PAF(2), VFR2(f2), o[2]), VRD2(f2, 11), C1, 4); \
    GAPB(o[3] = MF32(PAF(2), VFR2(f3), o[3]), VRD2(f3, 15), C1, 6); \
    GAPB(o[0] = MF32(PAF(3), VFR2(f0), o[0]), (void)0, C1, 8); \
    GAPB(o[1] = MF32(PAF(3), VFR2(f1), o[1]), (void)0, C1, 10); \
    GAPB(o[2] = MF32(PAF(3), VFR2(f2), o[2]), (void)0, C1, 12); \
    GAPB(o[3] = MF32(PAF(3), VFR2(f3), o[3]), (void)0, C1, 14); __builtin_amdgcn_s_setprio(0); \
    } while (0)
    int t = 1;
#undef CMASK
#define CMASK(P0, P1, t) do {} while (0)
    for (; t + 5 < NT; t += 2) {
        STEP(pB0, pB1, pA0, pA1, t, true, true, true);     WAIT_BAR(5); ROT();
        STEP(pA0, pA1, pB0, pB1, t + 1, true, true, true); WAIT_BAR(5); ROT();
    }
#undef CMASK
#define CMASK(P0, P1, t) do { if (MASK) { int jb_ = (t) - (NT - 4); if (jb_ >= 0) cmask(P0, P1, jb_, wid); } } while (0)
#define ENDW(tt) do { if ((tt) + 3 < NT) { WAIT_BAR(5); } else if ((tt) + 2 < NT) { WAIT_BAR(4); } else { WAIT_BAR(0); } } while (0)
    for (; t + 1 < NT; t += 2) {
        STEP(pB0, pB1, pA0, pA1, t, (t + 3 < NT), (t + 2 < NT), (t + 1 < NT));       ENDW(t);     ROT();
        STEP(pA0, pA1, pB0, pB1, t + 1, (t + 4 < NT), (t + 3 < NT), (t + 2 < NT));   ENDW(t + 1); ROT();
    }
    STEP(pB0, pB1, pA0, pA1, NT - 1, false, false, false);
    { float sacc = pB0[0] + pB0[1]; _Pragma("unroll") for (int r = 2; r < 16; ++r) sacc += pB0[r]; _Pragma("unroll") for (int r = 0; r < 16; ++r) sacc += pB1[r]; l_reg += sacc;
      pw0 = (u32x4){PKW(pB0, 0), PKW(pB0, 2), PKW(pB0, 4), PKW(pB0, 6)}; pw1 = (u32x4){PKW(pB0, 8), PKW(pB0, 10), PKW(pB0, 12), PKW(pB0, 14)}; pw2 = (u32x4){PKW(pB1, 0), PKW(pB1, 2), PKW(pB1, 4), PKW(pB1, 6)}; pw3 = (u32x4){PKW(pB1, 8), PKW(pB1, 10), PKW(pB1, 12), PKW(pB1, 14)};
      SBAR();
      const lds_cptr vp_ = vp0 + ((vs_rd + 16384) & 65535);
#pragma unroll
      for (int db = 0; db < 4; ++db) { VRD2(f0, db * 4 + 0); VRD2(f1, db * 4 + 1); VRD2(f2, db * 4 + 2); VRD2(f3, db * 4 + 3);
          o[db] = MF32(PAF(0), VFR2(f0), o[db]); o[db] = MF32(PAF(1), VFR2(f1), o[db]); o[db] = MF32(PAF(2), VFR2(f2), o[db]); o[db] = MF32(PAF(3), VFR2(f3), o[db]); } }
#undef PKW
#undef PAF
#undef PIN
#undef EX
#undef VOFF
#undef VRD2
#undef VFR2
#undef GAPA
#undef GAPB
#undef KRD
#undef MF32
#undef STEP
#undef ENDW
    { auto rr = __builtin_amdgcn_permlane32_swap(__float_as_uint(l_reg), __float_as_uint(l_reg), false, false); l_reg = __uint_as_float(rr[0]) + __uint_as_float(rr[1]); }
    if (hi == 0) wsf[32 + r32] = l_reg; asm volatile("s_waitcnt lgkmcnt(0)" ::: "memory");
    float rli[16];
#pragma unroll
    for (int r = 0; r < 16; ++r) rli[r] = __builtin_amdgcn_rcpf(wsf[32 + crow(r, hi)]);
    bf16* Ow = Oh + (long)(q0 + wid * QBLK) * op;
    { bf16* stg = (bf16*)(shm + L2_OST) + wid * 2048;
#pragma unroll
      for (int dh = 0; dh < 2; ++dh) {
#pragma unroll
        for (int r = 0; r < 16; ++r) { const int orow = crow(r, hi);
#pragma unroll
          for (int d0 = 0; d0 < 2; ++d0) stg[orow * 64 + d0 * 32 + r32] = __float2bfloat16(o[dh * 2 + d0][r] * rli[r]); }
        asm volatile("s_waitcnt lgkmcnt(0)" ::: "memory");
#pragma unroll
        for (int i = 0; i < 4; ++i) { const int row = i * 8 + (lane >> 3), ch = lane & 7; const u32x4 v = *(const u32x4*)(stg + row * 64 + ch * 8); *(u32x4*)(Ow + (long)row * op + dh * 64 + ch * 8) = v; }
        asm volatile("s_waitcnt lgkmcnt(0)" ::: "memory"); } }
    asm volatile("s_waitcnt lgkmcnt(0)\n\ts_barrier" ::: "memory");
#undef DMA_K
#undef DMA_V
#undef CMASK
#undef ROT
}
#undef SBAR
#undef WAIT_BAR
}

#define XB_TMO      128
#define XB_XCNT(j)  (256  + 64 * (j))
#define XB_XSUB(j)  (1280 + 64 * (j))
#define XB_XGEN(j)  (2304 + 64 * (j))
#define XB_TOP      3328
#define XB_TOPGEN   3392
#define XCD_BAR_WORDS 3456
#define XB_SPIN_CAP (1u << 22)
__device__ __forceinline__ unsigned xb_ld(unsigned* p)              { return __hip_atomic_load(p, __ATOMIC_RELAXED, __HIP_MEMORY_SCOPE_AGENT); }
__device__ __forceinline__ unsigned xb_add(unsigned* p, unsigned v) { return __hip_atomic_fetch_add(p, v, __ATOMIC_RELAXED, __HIP_MEMORY_SCOPE_AGENT); }
__device__ __forceinline__ unsigned xb_xcc_id() { return (unsigned)__builtin_amdgcn_s_getreg((3 << 11) | 20) & 0xFu; }
#define XB_SPIN(cond, bar) do { unsigned _sp = 0; while (cond) { __builtin_amdgcn_s_sleep(1); \
    if ((++_sp & 255u) == 0u) { if (xb_ld(&(bar)[XB_TMO])) break; if (_sp > XB_SPIN_CAP) { atomicAdd(&(bar)[XB_TMO], 1u); break; } } } } while (0)
struct XcdBarrier { unsigned* bar; unsigned x; volatile LAS unsigned* st; };
__device__ __forceinline__ XcdBarrier xcd_barrier_post(unsigned* bar, volatile LAS unsigned* st) {
    XcdBarrier b; b.bar = bar; b.x = xb_xcc_id(); b.st = st;
    if (threadIdx.x == 0) (void)xb_add(&bar[XB_XCNT(b.x)], 1u);
    return b;
}
__device__ __forceinline__ void xcd_barrier_complete(unsigned* bar, unsigned x, unsigned& nloc, unsigned& nx) {
    const unsigned G = gridDim.x * gridDim.y * gridDim.z;
    unsigned sum, cnt, mine, sp = 0u;
    for (;;) {
        sum = 0u; cnt = 0u; mine = 0u;
#pragma unroll
        for (unsigned j = 0; j < 16; ++j) { const unsigned c = xb_ld(&bar[XB_XCNT(j)]); sum += c; cnt += (c > 0u) ? 1u : 0u; mine = (j == x) ? c : mine; }
        if (sum == G) break;
        __builtin_amdgcn_s_sleep(1);
        if ((++sp & 255u) == 0u) { if (xb_ld(&bar[XB_TMO])) break; if (sp > XB_SPIN_CAP) { atomicAdd(&bar[XB_TMO], 1u); break; } }
    }
    nloc = mine > 0u ? mine : 1u; nx = cnt > 0u ? cnt : 1u;
}
__device__ __forceinline__ void xcd_barrier(const XcdBarrier& b) {
    asm volatile("s_waitcnt vmcnt(0)" ::: "memory");
    __syncthreads();
    if (threadIdx.x == 0) {
        unsigned* bar = b.bar;
        __builtin_amdgcn_s_waitcnt(0);
        unsigned nloc = b.st[0], nx = b.st[1];
        if (nloc == 0u) { xcd_barrier_complete(bar, b.x, nloc, nx); b.st[0] = nloc; b.st[1] = nx; }
        const unsigned old = xb_add(&bar[XB_XSUB(b.x)], 1u);
        const unsigned gen = old / nloc;
        if (old + 1u == (gen + 1u) * nloc) {
            __builtin_amdgcn_fence(__ATOMIC_RELEASE, "agent");
            asm volatile("s_waitcnt vmcnt(0)" ::: "memory");
            const unsigned og = xb_add(&bar[XB_TOP], 1u);
            const unsigned tg = og / nx;
            if (og + 1u == (tg + 1u) * nx) xb_add(&bar[XB_TOPGEN], 1u);
            else XB_SPIN(xb_ld(&bar[XB_TOPGEN]) == tg, bar);
            __builtin_amdgcn_fence(__ATOMIC_ACQUIRE, "agent");
            xb_add(&bar[XB_XGEN(b.x)], 1u);
            asm volatile("s_waitcnt vmcnt(0)" ::: "memory");
        } else {
            XB_SPIN(xb_ld(&bar[XB_XGEN(b.x)]) == gen, bar);
            __builtin_amdgcn_fence(__ATOMIC_ACQUIRE, "agent");
            asm volatile("s_waitcnt vmcnt(0)" ::: "memory");
        }
    }
    __syncthreads();
}

constexpr int RING_BYTES = 131072;
constexpr int MISC_OFF = RING_BYTES;
constexpr int LDS_BYTES = 147456;
constexpr int NWAVES = 8;

struct Args {
    const float* in[29]; float* out; unsigned char* ws; int ph_lo, ph_hi;
};
enum { I_X = 0, I_MEM, I_NORM1, I_WIN, I_BGATE, I_QN, I_KN, I_LQ1, I_LK1, I_LQ2, I_LK2, I_SUBLN, I_WPOOL, I_PSCALE, I_MEMNORM, I_WMKV, I_MQN, I_MKN, I_WBRD, I_WBRP, I_WBRM, I_WOUT, I_NORM2,
       I_WROUTER, I_BROUTER, I_WGU, I_BGU, I_WD, I_BD };

__device__ __forceinline__ unsigned f2bf(float f) { unsigned u = __builtin_bit_cast(unsigned, f); return (u + 0x7fffu + ((u >> 16) & 1u)) >> 16; }
__device__ __forceinline__ unsigned pk2(float lo, float hi) { return f2bf(lo) | (f2bf(hi) << 16); }
__device__ __forceinline__ void p0_transpose_item(const float* W, int K, int N, bf16_t* WT, LAS float* scr, int item, int lane, int ldo = 0) {
    if (ldo == 0) ldo = K;
    const int nblk = N / 64, kb = item / nblk, nb = item % nblk, k0 = 64 * kb, n0 = 64 * nb;
    const int kr = lane >> 3, n4 = (lane & 7) * 4;
    f32x4 v[16];
#pragma unroll
    for (int i = 0; i < 16; ++i) v[i] = *(const f32x4*)(W + (size_t)(k0 + 8 * (i & 7) + kr) * N + n0 + 32 * (i >> 3) + n4);
#pragma unroll
    for (int h = 0; h < 2; ++h) {
#pragma unroll
        for (int i = 0; i < 8; ++i)
#pragma unroll
            for (int j = 0; j < 4; ++j) scr[(n4 + j) * 68 + 8 * i + kr] = v[h * 8 + i][j];
        LDS_WAIT(); asm volatile("" ::: "memory");
        const int c = lane & 7;
#pragma unroll
        for (int jj = 0; jj < 4; ++jj) { const int nrow = 8 * jj + (lane >> 3); const LAS f32x4* sp = (const LAS f32x4*)(scr + nrow * 68 + 8 * c);
            const f32x4 a = sp[0], b = sp[1];
            u32x4 o; o.x = pk2(a[0], a[1]); o.y = pk2(a[2], a[3]); o.z = pk2(b[0], b[1]); o.w = pk2(b[2], b[3]);
            *(u32x4*)(WT + (size_t)(n0 + 32 * h + nrow) * ldo + k0 + 8 * c) = o; }
        LDS_WAIT(); asm volatile("" ::: "memory");
    }
}
__device__ __forceinline__ void p0_transpose_item_f8(const float* W, int K, int N, unsigned char* WT, LAS float* scr, int item, int lane) {
    const int nblk = N / 64, kb = item / nblk, nb = item % nblk, k0 = 64 * kb, n0 = 64 * nb;
    const int kr = lane >> 3, n4 = (lane & 7) * 4;
    f32x4 v[16];
#pragma unroll
    for (int i = 0; i < 16; ++i) v[i] = *(const f32x4*)(W + (size_t)(k0 + 8 * (i & 7) + kr) * N + n0 + 32 * (i >> 3) + n4);
#pragma unroll
    for (int h = 0; h < 2; ++h) {
#pragma unroll
        for (int i = 0; i < 8; ++i)
#pragma unroll
            for (int j = 0; j < 4; ++j) scr[(n4 + j) * 68 + 8 * i + kr] = v[h * 8 + i][j];
        LDS_WAIT(); asm volatile("" ::: "memory");
        const int c = lane & 7;
#pragma unroll
        for (int jj = 0; jj < 4; ++jj) { const int nrow = 8 * jj + (lane >> 3); const LAS f32x4* sp = (const LAS f32x4*)(scr + nrow * 68 + 8 * c);
            const f32x4 a = sp[0] * W8_SCALE, b = sp[1] * W8_SCALE;
            u32x2 o; o.x = pk4_fp8(a[0], a[1], a[2], a[3]); o.y = pk4_fp8(b[0], b[1], b[2], b[3]);
            *(u32x2*)(WT + (size_t)(n0 + 32 * h + nrow) * K + k0 + 8 * c) = o; }
        LDS_WAIT(); asm volatile("" ::: "memory");
    }
}
__device__ __forceinline__ void rms_row_to_bf16(const float* xrow, const float* gain, bf16_t* orow, int lane) {
    const f32x4* xr = (const f32x4*)xrow + lane; const f32x4* gr = (const f32x4*)gain + lane;
    f32x4 v[4]; float s = 0.f;
#pragma unroll
    for (int j = 0; j < 4; ++j) { v[j] = xr[64 * j]; s += (v[j].x * v[j].x + v[j].y * v[j].y) + (v[j].z * v[j].z + v[j].w * v[j].w); }
    const float rstd = 1.f / sqrtf(wave_sum(s) * (1.f / 1024.f) + RMS_EPS);
    u32x2* o8 = (u32x2*)orow + lane;
#pragma unroll
    for (int j = 0; j < 4; ++j) { const f32x4 g = gr[64 * j]; u32x2 w; w.x = pk2(v[j].x * rstd * g.x, v[j].y * rstd * g.y); w.y = pk2(v[j].z * rstd * g.z, v[j].w * rstd * g.w); o8[64 * j] = w; }
}

__device__ __forceinline__ void cvt_item64_f8(const float* W, int K, int N, unsigned char* WT, int item, int lane) {
    const int nblk = N / 64, kb = item / nblk, nb = item % nblk, k0 = 64 * kb, n0 = 64 * nb;
    const char* base = (const char*)(W + (size_t)k0 * N + n0);
    unsigned off = (unsigned)lane * 4u; const unsigned rstep = (unsigned)N * 4u;
    float v[64];
#pragma unroll
    for (int j = 0; j < 64; ++j) { v[j] = __builtin_nontemporal_load((const float*)(base + off)); off += rstep; }
    unsigned char* dst = WT + (size_t)(n0 + lane) * K + k0;
#pragma unroll
    for (int c = 0; c < 4; ++c) { u32x4 o;
#pragma unroll
        for (int q = 0; q < 4; ++q) { int r = __builtin_amdgcn_cvt_pk_fp8_f32(v[16 * c + 4 * q] * W8_SCALE, v[16 * c + 4 * q + 1] * W8_SCALE, 0, false);
            r = __builtin_amdgcn_cvt_pk_fp8_f32(v[16 * c + 4 * q + 2] * W8_SCALE, v[16 * c + 4 * q + 3] * W8_SCALE, r, true); o[q] = (unsigned)r; }
        *(u32x4*)(dst + 16 * c) = o; }
}
struct CvtJob {
    const float* wgu; const float* wd; unsigned char* wgu_t; unsigned char* wd_t; int ngw, gw, lane;
    __device__ __forceinline__ void item(int j) const {
        const int it = gw + j * ngw; if (it >= 24576) return;
        const bool gu = it < 16384; const int r = gu ? it : it - 16384, e = gu ? (r >> 9) : (r >> 8), idx = gu ? (r & 511) : (r & 255), N = gu ? 2048 : 1024;
        const float* W = gu ? wgu + (size_t)e * 1024 * 2048 : wd + (size_t)e * 1024 * 1024; unsigned char* WT = gu ? wgu_t + (size_t)e * 2048 * 1024 : wd_t + (size_t)e * 1024 * 1024;
        cvt_item64_f8(W, 1024, N, WT, idx, lane);
    }
};
struct PostCvt { CvtJob J; int jbase, jend; __device__ __forceinline__ void operator()(int ui) const { const int j = jbase + ui; if (j < jend) J.item(j); } };
struct Args;
typedef __attribute__((address_space(4))) const Args* kargs_t;
__device__ __forceinline__ kargs_t kargs() { kargs_t p = (kargs_t)__builtin_amdgcn_kernarg_segment_ptr(); asm volatile("" : "+s"(p)); return p; }
__global__ void __launch_bounds__(NWAVES * 64, 2) fwd_kernel(Args args) {
    extern __shared__ __attribute__((aligned(16))) unsigned char lds_raw[];
    cg::grid_group grid = cg::this_grid();
    LAS unsigned char* lds = (LAS unsigned char*)lds_raw;
    const int tid = threadIdx.x, lane = tid & 63, wave = __builtin_amdgcn_readfirstlane(tid >> 6);
    const int G = gridDim.x, bx = blockIdx.x; const int vcu = (G % 8 == 0) ? (bx % 8) * (G / 8) + bx / 8 : bx;
    const int gw = vcu * NWAVES + wave, NGW = G * NWAVES;
    const int lo = args.ph_lo, hi = args.ph_hi;
    if (tid < 64) ((LAS unsigned*)(lds + MISC_OFF + 1024))[tid] = 0u;
    __syncthreads();
    const XcdBarrier xbar = xcd_barrier_post((unsigned*)(args.ws + WS_CTL) + CW_BAR, (volatile LAS unsigned*)(lds + MISC_OFF + 1024));
#ifndef PHMASK
#define PHMASK 0x3ff
#endif
#define IN(k) (((PHMASK >> (k)) & 1) && lo <= (k) && (k) < hi)
#define GSYNC() do { asm volatile("s_waitcnt vmcnt(0) lgkmcnt(0)" ::: "memory"); __syncthreads(); grid.sync(); asm volatile("s_waitcnt vmcnt(0)" ::: "memory"); __syncthreads(); } while (0)
#define SEAM(k) do { if (lo <= (k) && (k) + 1 < hi) { xcd_barrier(xbar); } } while (0)
#define WSP(TY, off) ((TY*)(ka->ws + (off)))
#define WIN_T WSP(bf16_t, WS_WIN_T)
#define WBRD_T WSP(bf16_t, WS_WBRD_T)
#define WBRP_T WSP(bf16_t, WS_WBRP_T)
#define WBRM_T WSP(bf16_t, WS_WBRM_T)
#define WOUT_T WSP(bf16_t, WS_WOUT_T)
#define WMKV_T WSP(bf16_t, WS_WMKV_T)
#define WGU_T WSP(bf16_t, WS_WGU_T)
#define WD_T WSP(bf16_t, WS_WD_T)
#define XN WSP(bf16_t, WS_XN)
#define Qb WSP(bf16_t, WS_Q)
#define Kb WSP(bf16_t, WS_K)
#define Vb WSP(bf16_t, WS_V)
#define Ub WSP(bf16_t, WS_U)
#define MQb WSP(bf16_t, WS_MQ)
#define OC WSP(bf16_t, WS_OC)
#define GATES WSP(bf16_t, WS_GATES)
#define YCAT WSP(bf16_t, WS_YCAT)
#define MERGF WSP(float, WS_MERGF)
#define MERGB WSP(bf16_t, WS_MERGB)
#define XG WSP(bf16_t, WS_XG)
#define ACT WSP(bf16_t, WS_A)
#define Y4 WSP(bf16_t, WS_B)
#define MEMN WSP(bf16_t, WS_MEMN)
#define MKV WSP(bf16_t, WS_MKV)
#define ROPE WSP(f32x2, WS_ROPE)
#define WR2 WSP(float, WS_WR2)
#define ROUTEW WSP(float, WS_ROUTEW)
#define LAMP WSP(float, WS_LAM)
#define LIST WSP(u32x2, WS_LIST)
#define CNT WSP(unsigned, WS_CTL)
#define OUT (ka->out)
#define KA const kargs_t ka = kargs()

    if (lo > 1000) GSYNC();
    if (IN(0)) for (int rep_ = 0; rep_ < 1 + ((REPEAT_MASK >> 0) & 1); ++rep_) { KA; if (rep_) __syncthreads();
        LAS float* scr = (LAS float*)(lds + wave * 16384);
        constexpr int I0 = 16 * 80, I1 = 8 * 16, I2 = 4 * 16, I3 = 4 * 16, I4 = 16 * 16, I5 = 16 * 8, I6 = 0, I7 = 0;
        constexpr int NITEMS = I0 + I1 + I2 + I3 + I4 + I5 + I6 + I7;
        for (int it = gw; it < NITEMS; it += NGW) {
            int r = it;
            if (r < I0) { p0_transpose_item(ka->in[I_WIN], 1024, 5120, WIN_T, scr, r, lane); continue; } r -= I0;
            if (r < I1) { p0_transpose_item(ka->in[I_WBRD], 512, 1024, WBRD_T, scr, r, lane, 1024); continue; } r -= I1;
            if (r < I2) { p0_transpose_item(ka->in[I_WBRP], 256, 1024, WBRD_T + 512, scr, r, lane, 1024); continue; } r -= I2;
            if (r < I3) { p0_transpose_item(ka->in[I_WBRM], 256, 1024, WBRD_T + 768, scr, r, lane, 1024); continue; } r -= I3;
            if (r < I4) { p0_transpose_item(ka->in[I_WOUT], 1024, 1024, WOUT_T, scr, r, lane); continue; } r -= I4;
            p0_transpose_item(ka->in[I_WMKV], 1024, 512, WMKV_T, scr, r, lane);
        }
        for (int m = gw; m < T; m += NGW) rms_row_to_bf16(ka->in[I_X] + (size_t)m * 1024, ka->in[I_NORM1], XN + (size_t)m * 1024, lane);
        for (int m = gw; m < BATCH * MEMLEN; m += NGW) rms_row_to_bf16(ka->in[I_MEM] + (size_t)m * 1024, ka->in[I_MEMNORM], MEMN + (size_t)m * 1024, lane);
        for (int i = bx * 512 + tid; i < SEQ * 32; i += G * 512) { const int pos = i >> 5, j = i & 31;
            const float inv = 1.0f / powf(10000.0f, (float)(2 * j) / 64.0f); const float ang = (float)pos * inv;
            const double a = (double)ang; const double k = rint(a * 0.15915494309189535); const float red = (float)(a - k * 6.283185307179586);
            ROPE[i] = (f32x2){cosf(red), sinf(red)}; }
        for (int i = bx * 512 + tid; i < 1024 * 32; i += G * 512) { const int ii = i & 3, e = (i >> 2) & 15, kq = (i >> 6) & 3, eb = (i >> 8) & 1, s = i >> 9; const int k = 16 * s + 4 * kq + ii;
            WR2[i] = ka->in[I_NORM2][k] * ka->in[I_WROUTER][k * 32 + eb * 16 + e]; }
        if (bx == 0 && wave == 0) { const float s1 = wave_sum(ka->in[I_LQ1][lane] * ka->in[I_LK1][lane]), s2 = wave_sum(ka->in[I_LQ2][lane] * ka->in[I_LK2][lane]);
            if (lane == 0) LAMP[0] = expf(s1) - expf(s2) + 0.2f; }
    }
    SEAM(0);
    if (IN(1)) for (int rep_ = 0; rep_ < 1 + ((REPEAT_MASK >> 1) & 1); ++rep_) { KA; if (rep_) __syncthreads();
#if defined(TAP) && TAP == 6
        { pg8::DenseProb P{XN, WIN_T, 1024, 1024, 1024}; pg8::StaticOrder S; S.init(T, INW, G, bx);
          pg8::EpiPlain E{WSP(bf16_t, WS_B), 5120};
          pg8::gemm_phase<pg8::EpiPlain, pg8::DenseProb, pg8::StaticOrder, true>(lds, P, S, E); }
#else
        const CvtJob J{ka->in[I_WGU], ka->in[I_WD], (unsigned char*)WGU_T, (unsigned char*)WD_T, NGW, gw, lane};
        const int kpre = bx & 7;
        for (int j = 0; j < kpre; ++j) J.item(j);
        { pg8::DenseProb P{XN, WIN_T, 1024, 1024, 1024}; pg8::StaticOrder S0; S0.init(T, INW, G, bx); const pg8::TableOrder S = pg8::build_unit_table(S0, (LAS int*)(lds + MISC_OFF + 2048));
          pg8::EpiInProj E{Qb, Kb, Vb, Ub, MQb, GATES, ka->in[I_QN], ka->in[I_KN], ka->in[I_MQN], ka->in[I_BGATE], ROPE};
          const PostCvt PU{J, kpre, 12};
          pg8::gemm_phase<pg8::EpiInProj, pg8::DenseProb, pg8::TableOrder, ALIGN_EPI_SEL, PostCvt>(lds, P, S, E, PU); }
        for (int j = kpre + 10; j < 12; ++j) J.item(j);
#endif
        { pg8::DenseProb P{MEMN, WMKV_T, 1024, 1024, 1024}; pg8::StaticOrder S; S.init(BATCH * MEMLEN, 512, G, bx);
          pg8::EpiMemKV E{MKV, ka->in[I_MKN]};
          pg8::gemm_phase<pg8::EpiMemKV, pg8::DenseProb, pg8::StaticOrder, true>(lds, P, S, E); }
    }
    SEAM(1);
    if (IN(2)) for (int rep_ = 0; rep_ < 1 + ((REPEAT_MASK >> 2) & 1); ++rep_) { KA; if (rep_) __syncthreads();
        using abf = attn_body::bf16;
        {
            const int bh = vcu >> 4, b = bh >> 2, h = bh & 3, s = vcu & 15; const size_t rb = (size_t)b * SEQ;
            const float lam = LAMP[0];
            for (int i2 = 0; i2 < 4 * (1 + ((REPEAT_MASK >> 10) & 1)); ++i2) { const int ii = i2 & 3, c = ii & 1; const int qb = (ii < 2) ? s : 31 - s;
                attn_body::attn_unit2<true>(qb * 256, 4 * qb + 4, (const abf*)Qb + rb * 512 + (c * 4 + h) * 64, 512, (const abf*)Kb + rb * 512 + (c * 4 + h) * 64, 512,
                                            (const abf*)Vb + rb * 512 + h * 128, 512, (abf*)OC + rb * 1024 + (c * 4 + h) * 128, 1024, (char*)lds_raw);
                if (c == 1) {
                    asm volatile("s_waitcnt vmcnt(0)" ::: "memory");
#pragma unroll 1
                    for (int ps = 0; ps < 2; ++ps) {
                    const int row = ps * 16 + (lane >> 2), dq = (lane & 3) * 32; const size_t t = rb + (size_t)qb * 256 + wave * 32 + row;
                    const bf16_t* p0 = OC + t * 1024 + h * 128 + dq; const bf16_t* p1 = p0 + 512;
                    u32x4 a[4], bb[4];
#pragma unroll
                    for (int j = 0; j < 4; ++j) { a[j] = *(const u32x4*)(p0 + 8 * j); bb[j] = *(const u32x4*)(p1 + 8 * j); }
                    float ss = 0.f; f32x4 y[4][2];
#pragma unroll
                    for (int j = 0; j < 4; ++j) {
                        y[j][0] = (f32x4){bf_lo(a[j].x) - lam * bf_lo(bb[j].x), bf_hi(a[j].x) - lam * bf_hi(bb[j].x), bf_lo(a[j].y) - lam * bf_lo(bb[j].y), bf_hi(a[j].y) - lam * bf_hi(bb[j].y)};
                        y[j][1] = (f32x4){bf_lo(a[j].z) - lam * bf_lo(bb[j].z), bf_hi(a[j].z) - lam * bf_hi(bb[j].z), bf_lo(a[j].w) - lam * bf_lo(bb[j].w), bf_hi(a[j].w) - lam * bf_hi(bb[j].w)};
#pragma unroll
                        for (int q = 0; q < 4; ++q) ss += y[j][0][q] * y[j][0][q] + y[j][1][q] * y[j][1][q]; }
                    ss += __shfl_xor(ss, 1); ss += __shfl_xor(ss, 2);
                    const float rstd = 0.8f / sqrtf(ss * (1.0f / 128.0f) + RMS_EPS);
                    const float* sg = ka->in[I_SUBLN] + dq; bf16_t* yo = YCAT + t * 1024 + h * 128 + dq;
#pragma unroll
                    for (int j = 0; j < 4; ++j) { const f32x4 s0 = *(const f32x4*)(sg + 8 * j), s1 = *(const f32x4*)(sg + 8 * j + 4); pg8::store8(yo + 8 * j, y[j][0] * rstd * s0, y[j][1] * rstd * s1); }
                    }
                }
            }
        }
        {
            for (int i = 0; i < 2; ++i) { const int idx = vcu * 2 + i; if (idx >= 512) break; const int b = idx >> 7, h = (idx >> 5) & 3, qb = idx & 31;
                attn_body::attn_unit<8, false>(qb * 256, 4, (const abf*)MQb + (size_t)b * SEQ * 256 + h * 64, 256, (const abf*)MKV + (size_t)b * MEMLEN * 512 + h * 64, 512,
                                               (const abf*)MKV + (size_t)b * MEMLEN * 512 + 256 + h * 64, 512, (abf*)YCAT + (size_t)b * SEQ * 1024 + 768 + h * 64, 1024, (char*)lds_raw); }
        }
        {
            LAS bf16_t* ul = (LAS bf16_t*)lds;
            LAS bf16_t* pb = (LAS bf16_t*)(lds + 24576);
            const int col = tid & 255, half = tid >> 8, w = 2 << (col >> 6);
            const int mg = wave & 3, mdh = wave >> 2, r32 = lane & 31, hh = lane >> 5;
            bf16x8 bw[4];
#pragma unroll
            for (int sx = 0; sx < 4; ++sx) { const float* wp = ka->in[I_WPOOL] + (size_t)(mg * 64 + 16 * sx + 8 * hh) * 64 + mdh * 32 + r32;
                u32x4 pk; pk.x = pk2(wp[0], wp[64]); pk.y = pk2(wp[128], wp[192]); pk.z = pk2(wp[256], wp[320]); pk.w = pk2(wp[384], wp[448]); bw[sx] = __builtin_bit_cast(bf16x8, pk); }
            const int ocol = mg * 64 + mdh * 32 + r32; const float psc = ka->in[I_PSCALE][ocol];
            for (int tile = vcu; tile < T / 32; tile += G) {
                const int t0 = tile * 32, p0 = t0 & (SEQ - 1);
                __syncthreads();
                for (int pc = tid; pc < 47 * 32; pc += 512) { const int r = pc >> 5, ch = pc & 31; const int pos = p0 - 15 + r;
                    u32x4 v = {0u, 0u, 0u, 0u}; if (pos >= 0) v = *(const u32x4*)(Ub + (size_t)(t0 - 15 + r) * 256 + ch * 8);
                    *(LAS u32x4*)(ul + r * 256 + ch * 8) = v; }
                __syncthreads();
                {
                    float sum = 0.f; const int rbase = 15 + 16 * half;
                    for (int i = 1; i < w; ++i) sum += __uint_as_float((unsigned)ul[(rbase - i) * 256 + col] << 16);
#pragma unroll
                    for (int tk = 0; tk < 16; ++tk) { const float ucur = __uint_as_float((unsigned)ul[(rbase + tk) * 256 + col] << 16); sum += ucur;
                        const int pos = p0 + 16 * half + tk; const float cnt = (float)((pos + 1 < w) ? pos + 1 : w);
                        pb[(16 * half + tk) * 264 + col] = (bf16_t)f2bf(sum / cnt - ucur);
                        sum -= __uint_as_float((unsigned)ul[(rbase + tk - (w - 1)) * 256 + col] << 16); }
                }
                __syncthreads();
                f32x16 acc = f32x16{};
#pragma unroll
                for (int sx = 0; sx < 4; ++sx) { const bf16x8 af = *(const LAS bf16x8*)(pb + r32 * 264 + mg * 64 + 16 * sx + 8 * hh);
                    acc = __builtin_amdgcn_mfma_f32_32x32x16_bf16(af, bw[sx], acc, 0, 0, 0); }
#pragma unroll
                for (int r = 0; r < 16; ++r) { const int tok = t0 + (r & 3) + 8 * (r >> 2) + 4 * hh; YCAT[(size_t)tok * 1024 + 512 + ocol] = (bf16_t)f2bf(acc[r] * psc); }
            }
            __syncthreads();
        }
    }
    SEAM(2);
    if (IN(4)) for (int rep_ = 0; rep_ < 1 + ((REPEAT_MASK >> 4) & 1); ++rep_) { KA; if (rep_) __syncthreads();
        pg8::StaticOrder S0; S0.init(T, 1024, G, bx); const pg8::TableOrder S = pg8::build_unit_table(S0, (LAS int*)(lds + MISC_OFF + 2048));
        pg8::DenseProb P{YCAT, WBRD_T, 1024, 1024, 1024}; pg8::EpiMergeR E{GATES, MERGB};
        pg8::gemm_phase<pg8::EpiMergeR, pg8::DenseProb, pg8::TableOrder, ALIGN_EPI_SEL>(lds, P, S, E);
    }
    SEAM(4);
    if (IN(5)) for (int rep_ = 0; rep_ < 1 + ((REPEAT_MASK >> 5) & 1); ++rep_) { KA; if (rep_) __syncthreads();
        pg8::DenseProb P{MERGB, WOUT_T, 1024, 1024, 1024}; pg8::StaticOrder S0; S0.init(T, 1024, G, bx); const pg8::TableOrder S = pg8::build_unit_table(S0, (LAS int*)(lds + MISC_OFF + 2048));
        pg8::EpiWout E{ka->in[I_X], OUT, (unsigned char*)XG, ka->in[I_NORM2]};
        pg8::gemm_phase<pg8::EpiWout, pg8::DenseProb, pg8::TableOrder, ALIGN_EPI_SEL>(lds, P, S, E);
    }
    SEAM(5);
    if (IN(6)) { KA;
        LAS int* lcnt = (LAS int*)(lds + MISC_OFF); LAS int* lbase = lcnt + 32;
        const int ngroups = T / 16, rounds = (ngroups + NGW - 1) / NGW;
        for (int rd = 0; rd < rounds; ++rd) {
            const int grp = rd * NGW + gw; const bool valid = grp < ngroups;
            if (tid < 32) lcnt[tid] = 0;
            __syncthreads();
            int e_sel = 0, rank = 0; float w_sel = 0.f, rstd = 0.f; const int q = lane >> 4, tok = grp * 16 + (lane & 15);
            if (valid) {
                f32x4 d0 = {0.f, 0.f, 0.f, 0.f}, d1 = {0.f, 0.f, 0.f, 0.f}; float ss = 0.f;
                const float* xrow = OUT + (size_t)tok * 1024 + 4 * q; const f32x4* wr2 = (const f32x4*)WR2 + lane;
#pragma unroll 4
                for (int s = 0; s < 64; ++s) { const f32x4 xv = *(const f32x4*)(xrow + 16 * s); const f32x4 wa = wr2[(s * 2) * 64], wb = wr2[(s * 2 + 1) * 64];
                    ss += (xv[0] * xv[0] + xv[1] * xv[1]) + (xv[2] * xv[2] + xv[3] * xv[3]);
#pragma unroll
                    for (int j = 0; j < 4; ++j) { d0 = __builtin_amdgcn_mfma_f32_16x16x4f32(wa[j], xv[j], d0, 0, 0, 0); d1 = __builtin_amdgcn_mfma_f32_16x16x4f32(wb[j], xv[j], d1, 0, 0, 0); } }
                ss += __shfl_xor(ss, 16); ss += __shfl_xor(ss, 32);
                rstd = 1.0f / sqrtf(ss * (1.0f / 1024.f) + RMS_EPS);
                unsigned key[8];
#pragma unroll
                for (int r = 0; r < 8; ++r) { const int e = (r >> 2) * 16 + 4 * q + (r & 3); const float lg = ((r < 4) ? d0[r & 3] : d1[r & 3]) * rstd + ka->in[I_BROUTER][e];
                    unsigned u = __float_as_uint(lg); u ^= (u >> 31) ? 0xffffffffu : 0x80000000u; key[r] = (u & ~31u) | (unsigned)(31 - e); }
                unsigned win[4];
#pragma unroll
                for (int r = 0; r < 4; ++r) { unsigned m = key[0];
#pragma unroll
                    for (int j = 1; j < 8; ++j) m = m > key[j] ? m : key[j];
                    unsigned o = (unsigned)__shfl_xor((int)m, 16); m = m > o ? m : o; o = (unsigned)__shfl_xor((int)m, 32); m = m > o ? m : o; win[r] = m;
#pragma unroll
                    for (int j = 0; j < 8; ++j) key[j] = (key[j] == m) ? 0u : key[j]; }
                float val[4];
#pragma unroll
                for (int r = 0; r < 4; ++r) { unsigned u = win[r] & ~31u; u ^= (u >> 31) ? 0x80000000u : 0xffffffffu; val[r] = __uint_as_float(u); }
                const float p1 = expf(val[1] - val[0]), p2 = expf(val[2] - val[0]), p3 = expf(val[3] - val[0]); const float inv = 1.0f / (1.0f + p1 + p2 + p3);
                const unsigned wk = (q == 0) ? win[0] : (q == 1) ? win[1] : (q == 2) ? win[2] : win[3];
                w_sel = ((q == 0) ? 1.0f : (q == 1) ? p1 : (q == 2) ? p2 : p3) * inv; e_sel = 31 - (int)(wk & 31u);
                rank = __hip_atomic_fetch_add((int*)(lcnt + e_sel), 1, __ATOMIC_RELAXED, __HIP_MEMORY_SCOPE_WORKGROUP);
            }
            __syncthreads();
            if (tid < 32) lbase[tid] = (int)__hip_atomic_fetch_add(CNT + 64 * tid, (unsigned)lcnt[tid], __ATOMIC_RELAXED, __HIP_MEMORY_SCOPE_AGENT);
            __syncthreads();
            if (valid) { const int pos = lbase[e_sel] + rank; LIST[(size_t)e_sel * CAP + pos] = (u32x2){(unsigned)(tok * 4 + q), __float_as_uint(rstd)}; ROUTEW[tok * 4 + q] = w_sel; }
            __syncthreads();
        }
    }
    SEAM(6);
    if (IN(7) || IN(8)) { KA;
        LAS int* tp = (LAS int*)(lds + MISC_OFF + 256); LAS int* cn = tp + 40;
        if (tid == 0) { int acc = 0; for (int e = 0; e < NEXP; ++e) { const int c = (int)__hip_atomic_load(CNT + 64 * e, __ATOMIC_RELAXED, __HIP_MEMORY_SCOPE_AGENT); cn[e] = c; tp[e] = acc; acc += (c + 255) >> 8; } tp[NEXP] = acc; }
        __syncthreads();
        if (IN(7)) for (int rep_ = 0; rep_ < 1 + ((REPEAT_MASK >> 7) & 1); ++rep_) {
            pg8::GuProb P{(const unsigned char*)XG, (const unsigned char*)WGU_T, LIST, 1024, 1024, 1024}; pg8::GroupedOrder S0{tp, cn, 8, G, bx}; const pg8::TableOrder S = pg8::build_unit_table(S0, (LAS int*)(lds + MISC_OFF + 2048));
            pg8::EpiSwiglu E{(unsigned char*)ACT, LIST, ka->in[I_BGU]};
            pg8::gemm_phase<pg8::EpiSwiglu, pg8::GuProb, pg8::TableOrder, ALIGN_EPI_SEL>(lds, P, S, E);
        }
        SEAM(7);
        if (IN(8)) for (int rep_ = 0; rep_ < 1 + ((REPEAT_MASK >> 8) & 1); ++rep_) {
            pg8::DownProb P{(const unsigned char*)ACT, (const unsigned char*)WD_T, 1024, 1024, 1024}; pg8::GroupedOrder S0{tp, cn, 4, G, bx}; const pg8::TableOrder S = pg8::build_unit_table(S0, (LAS int*)(lds + MISC_OFF + 2048));
            pg8::EpiDown E{(unsigned char*)Y4, LIST, ka->in[I_BD]};
            pg8::gemm_phase<pg8::EpiDown, pg8::DownProb, pg8::TableOrder, ALIGN_EPI_SEL>(lds, P, S, E);
        }
    }
    SEAM(8);
    if (IN(9)) { KA;
        for (int i = bx * 512 + tid; i < T * 128; i += G * 512) { const int tok = i >> 7, c8 = (i & 127) * 8;
            const f32x4 w = *(const f32x4*)(ROUTEW + tok * 4); float* op = OUT + (size_t)tok * 1024 + c8;
            f32x4 o0 = *(const f32x4*)op, o1 = *(const f32x4*)(op + 4);
#pragma unroll
            for (int k = 0; k < 4; ++k) { const u32x2 y = *(const u32x2*)((const unsigned char*)Y4 + ((size_t)tok * 4 + k) * 1024 + c8); const float wk = w[k] * (1.0f / Y8_SCALE);
                const f32x2 p0 = __builtin_amdgcn_cvt_pk_f32_fp8((int)y.x, false), p1 = __builtin_amdgcn_cvt_pk_f32_fp8((int)y.x, true), p2 = __builtin_amdgcn_cvt_pk_f32_fp8((int)y.y, false), p3 = __builtin_amdgcn_cvt_pk_f32_fp8((int)y.y, true);
                o0[0] += wk * p0[0]; o0[1] += wk * p0[1]; o0[2] += wk * p1[0]; o0[3] += wk * p1[1];
                o1[0] += wk * p2[0]; o1[1] += wk * p2[1]; o1[2] += wk * p3[0]; o1[3] += wk * p3[1]; }
            *(f32x4*)op = o0; *(f32x4*)(op + 4) = o1; }
    }
#ifdef TAP
    if (lo <= 10 && 10 < hi) { KA; GSYNC();
        for (int i = bx * 512 + tid; i < T * 1024; i += G * 512) { const int t = i >> 10, c = i & 1023; float v = 0.f;
#define BFV(buf, pitch, col) __uint_as_float((unsigned)(buf)[(size_t)t * (pitch) + (col)] << 16)
            if (TAP == 1) v = BFV(Qb, 512, c & 511) + 2.f * BFV(Kb, 512, c & 511) + 4.f * BFV(Vb, 512, c & 511) + 8.f * BFV(Ub, 256, c & 255) + 16.f * BFV(MQb, 256, c & 255)
                            + 32.f * BFV(GATES, 3072, c) + 64.f * BFV(GATES, 3072, 1024 + c) + 128.f * BFV(GATES, 3072, 2048 + c);
            if (TAP == 2) v = BFV(OC, 1024, c) + 2.f * BFV(YCAT, 1024, c);
            if (TAP == 3) v = BFV(MERGB, 1024, c);
            if (TAP == 4) v = BFV(XN, 1024, c);
            if (TAP == 6) { const bf16_t* z = WSP(bf16_t, WS_B) + (size_t)t * 5120 + c; v = __uint_as_float((unsigned)z[0] << 16) + 2.f * __uint_as_float((unsigned)z[1024] << 16) + 4.f * __uint_as_float((unsigned)z[2048] << 16) + 8.f * __uint_as_float((unsigned)z[3072] << 16) + 16.f * __uint_as_float((unsigned)z[4096] << 16); }
            if (TAP == 5) { const bf16_t* wt = WIN_T; const int tt = t % 5120; v = __uint_as_float((unsigned)wt[(size_t)tt * 1024 + c] << 16) + ROPE[(t & 8191) * 32 + (c & 31)].x + 2.f * ROPE[(t & 8191) * 32 + (c & 31)].y; }
            OUT[i] = v; }
    }
#endif
#undef IN
#undef SEAM
}

extern "C" void kernel_launch(void* const* d_in, const int* in_sizes, int n_in, void* d_out, int out_size, void* d_ws, size_t ws_size, hipStream_t stream) {
    static int grid = 0;
    if (grid == 0) {
        if (n_in != 29 || in_sizes[0] != T * DMODEL || out_size != T * DMODEL || ws_size < WS_END) {
            fprintf(stderr, "kernel_launch: unexpected shapes: n_in %d in0 %d out %d ws %zu (need %zu)\n", n_in, n_in > 0 ? in_sizes[0] : -1, out_size, ws_size, (size_t)WS_END); grid = -1; return; }
        int dev = 0, cus = 0, per_cu = 0;
        (void)hipGetDevice(&dev); (void)hipDeviceGetAttribute(&cus, hipDeviceAttributeMultiprocessorCount, dev);
        (void)hipFuncSetAttribute((const void*)fwd_kernel, hipFuncAttributeMaxDynamicSharedMemorySize, LDS_BYTES);
        (void)hipOccupancyMaxActiveBlocksPerMultiprocessor(&per_cu, (const void*)fwd_kernel, NWAVES * 64, LDS_BYTES);
        (void)hipGetLastError();
        grid = cus;
        fprintf(stderr, "kernel_launch: cus %d occupancy %d/CU grid %d\n", cus, per_cu, grid);
        if (per_cu < 1) fprintf(stderr, "kernel_launch: occupancy query says the kernel does not fit\n");
    }
    if (grid < 0) return;
    (void)hipMemsetAsync((char*)d_ws + WS_CTL, 0, CTL_ZERO_BYTES, stream);
    Args a{};
    for (int i = 0; i < 29; ++i) a.in[i] = (const float*)d_in[i];
    a.out = (float*)d_out; a.ws = (unsigned char*)d_ws; a.ph_lo = 0; a.ph_hi = PH_HI;
    void* args[] = {&a};
    hipError_t e = hipLaunchCooperativeKernel((const void*)fwd_kernel, dim3(grid), dim3(NWAVES * 64), args, LDS_BYTES, stream);
    if (e != hipSuccess) fprintf(stderr, "cooperative launch failed: %s (grid %d)\n", hipGetErrorString(e), grid);
}
```

```cpp
#include <hip/hip_runtime.h>
#include <hip/hip_cooperative_groups.h>
#include <hip/hip_bf16.h>
#include <cstdio>
#include <cstdint>
#include <cmath>
namespace cg = cooperative_groups;

#define LAS __attribute__((address_space(3)))
#define GAS __attribute__((address_space(1)))
typedef unsigned short bf16_t;
typedef short bf16x8 __attribute__((ext_vector_type(8)));
typedef float f32x4 __attribute__((ext_vector_type(4)));
typedef float f32x2 __attribute__((ext_vector_type(2)));
typedef float f32x16 __attribute__((ext_vector_type(16)));
typedef unsigned u32x4 __attribute__((ext_vector_type(4)));
typedef unsigned u32x2 __attribute__((ext_vector_type(2)));

#define PH_HI 10
#define ALIGN_EPI_SEL true
#define F8MODE 2
#define USE_SETPRIO 1
#define ATTN_PRIO_A 1
#define ATTN_PRIO_B 1
#ifndef PHMASK
#define PHMASK 0x3ff
#endif
#define REPEAT_MASK 0x000
constexpr int BATCH = 4, SEQ = 8192, DMODEL = 1024, T = BATCH * SEQ, INW = 5120, NEXP = 32, MEMLEN = 256;
constexpr float RMS_EPS = 1e-6f;
constexpr float C2 = 0.125f * 1.4426950408889634f;
constexpr int CAP = T;

constexpr size_t MiB = 1u << 20;
constexpr size_t WS_CTL = 0, CTL_ZERO_BYTES = 32768;
constexpr int CW_BAR = 4096;
constexpr size_t WS_ROUTEW = 1 * MiB;
constexpr size_t WS_LAM = 1 * MiB + 768 * 1024;
constexpr size_t WS_ROPE = 2 * MiB;
constexpr size_t WS_WR2 = 4 * MiB;
constexpr size_t WS_MEMN = 5 * MiB;
constexpr size_t WS_MKV = 7 * MiB;
constexpr size_t WS_WIN_T = 8 * MiB;
constexpr size_t WS_WBRD_T = 18 * MiB;
constexpr size_t WS_WBRP_T = 19 * MiB;
constexpr size_t WS_WBRM_T = 19 * MiB + 512 * 1024;
constexpr size_t WS_WOUT_T = 20 * MiB;
constexpr size_t WS_WMKV_T = 22 * MiB;
constexpr size_t WS_WGU_T = 24 * MiB;
constexpr size_t WS_WD_T = 152 * MiB;
constexpr size_t WS_A = 216 * MiB;
constexpr size_t WS_XN = WS_A;
constexpr size_t WS_Q = WS_A + 64 * MiB, WS_K = WS_A + 96 * MiB, WS_V = WS_A + 128 * MiB;
constexpr size_t WS_U = WS_A + 160 * MiB, WS_MQ = WS_A + 176 * MiB;
constexpr size_t WS_OC = WS_A + 192 * MiB;
constexpr size_t WS_B = 488 * MiB;
constexpr size_t WS_GATES = WS_B;
constexpr size_t WS_YCAT = WS_B + 192 * MiB;
constexpr size_t WS_MERGF = 760 * MiB;
constexpr size_t WS_MERGB = 888 * MiB;
constexpr size_t WS_XG = 952 * MiB;
constexpr size_t WS_LIST = 1016 * MiB;
constexpr size_t WS_END = 1024 * MiB;

typedef __bf16 bf16x2_v __attribute__((ext_vector_type(2)));
__device__ __forceinline__ unsigned cvt_pk_bf16(float lo, float hi) { f32x2 v = {lo, hi}; bf16x2_v b = __builtin_convertvector(v, bf16x2_v); return __builtin_bit_cast(unsigned, b); }
__device__ __forceinline__ unsigned pk4_fp8(float a, float b, float c, float d) {
    a = fminf(fmaxf(a, -448.f), 448.f); b = fminf(fmaxf(b, -448.f), 448.f); c = fminf(fmaxf(c, -448.f), 448.f); d = fminf(fmaxf(d, -448.f), 448.f);
    int r = __builtin_amdgcn_cvt_pk_fp8_f32(a, b, 0, false); r = __builtin_amdgcn_cvt_pk_fp8_f32(c, d, r, true); return (unsigned)r; }
constexpr float W8_SCALE = 64.0f;
constexpr float Y8_SCALE = 32.0f;
constexpr float A8_SCALE = 8.0f;
__device__ __forceinline__ float bf_lo(unsigned w) { return __uint_as_float(w << 16); }
__device__ __forceinline__ float bf_hi(unsigned w) { return __uint_as_float(w & 0xffff0000u); }
__device__ __forceinline__ float wave_sum(float v) {
#pragma unroll
    for (int o = 1; o < 64; o <<= 1) v += __shfl_xor(v, o);
    return v;
}
#define LDS_WAIT() asm volatile("s_waitcnt lgkmcnt(0)" ::: "memory")

namespace pg8 {
constexpr int BM = 256, BK = 64, HALF = 128, HTB = HALF * BK * 2, STAGE_BYTES = 8 * HTB, NXCD = 8, WGM = 8;
__host__ __device__ __forceinline__ int lds_byte(int r, int c) { const int st = (r >> 4) * 2 + (c >> 5), rr = r & 15, cc = c & 31, ob = rr * 64 + cc * 2; return st * 1024 + (ob ^ (((ob >> 9) & 1) << 5)); }
__host__ __device__ __forceinline__ void stage_rc(int b, int& R, int& C) { const int st = b / 1024, sb = b % 1024, swz = sb ^ (((sb >> 9) & 1) << 5); R = (st >> 1) * 16 + swz / 64; C = (st & 1) * 32 + (swz % 64) / 2; }
__host__ __device__ __forceinline__ int perm32(int rho) { const int n = rho >> 4, i = rho & 15; return 8 * (i >> 2) + 4 * n + (i & 3); }

typedef int i32x4_t __attribute__((ext_vector_type(4)));
typedef int i32x8_t __attribute__((ext_vector_type(8)));
typedef long i64x2_t __attribute__((ext_vector_type(2)));
struct Unit { int pm, pn, e, mt, cnt; };

template <int BMAP> __device__ __forceinline__ int brow(int R) { return BMAP == 0 ? ((R >> 5) * 64 + perm32(R & 31)) : BMAP == 1 ? ((R & ~31) + perm32(R & 31)) : ((R >> 5) * 64 + 16 * ((R & 15) >> 2) + 4 * ((R >> 4) & 1) + (R & 3)); }

struct StaticOrder {
    int nM, nN, nwg, G, c;
    __device__ void init(int M, int N, int G_, int c_) { nM = M / BM; nN = N / BM; nwg = nM * nN; G = G_; c = c_; }
    __device__ bool next(int i, Unit& u) const {
        const long L = (long)i * G + c; if (L >= nwg) return false;
        int wgid = (int)L; { const int q = nwg / NXCD, r = nwg % NXCD, xcd = wgid % NXCD, off = wgid / NXCD; wgid = (xcd < r ? xcd * (q + 1) : r * (q + 1) + (xcd - r) * q) + off; }
        const int nig = WGM * nN, gid = wgid / nig, fm = gid * WGM, gsz = (nM - fm) < WGM ? (nM - fm) : WGM;
        u.pm = fm + ((wgid % nig) % gsz); u.pn = (wgid % nig) / gsz; u.e = 0; u.mt = 0; u.cnt = 0; return true;
    }
    __device__ bool next_lane(int i, Unit& u) const { return next(i, u); }
};
struct GroupedOrder {
    const LAS int* tp; const LAS int* cn; int NTN, G, c;
    __device__ bool next_lane(int i, Unit& u) const {
        const int nwg = tp[NEXP] * NTN; const long L = (long)i * G + c; if (L >= nwg) return false;
        int wgid = (int)L; { const int q = nwg / NXCD, r = nwg % NXCD, xcd = wgid % NXCD, off = wgid / NXCD; wgid = (xcd < r ? xcd * (q + 1) : r * (q + 1) + (xcd - r) * q) + off; }
        int e = 0; while (e < NEXP - 1 && wgid >= tp[e + 1] * NTN) ++e;
        const int idx = wgid - tp[e] * NTN, tiles = tp[e + 1] - tp[e];
        const int nig = 4 * NTN, gid = idx / nig, fm = gid * 4, gsz = (tiles - fm) < 4 ? (tiles - fm) : 4;
        u.mt = fm + ((idx % nig) % gsz); u.pn = (idx % nig) / gsz; u.e = e; u.pm = tp[e] + u.mt; u.cnt = cn[e]; return true;
    }
};
struct TableOrder {
    const LAS int* tab; int n;
    __device__ __forceinline__ bool next(int i, Unit& u) const {
        if (i >= n) return false;
        const LAS int* t = tab + i * 8;
        u.pm = __builtin_amdgcn_readfirstlane(t[0]); u.pn = __builtin_amdgcn_readfirstlane(t[1]); u.e = __builtin_amdgcn_readfirstlane(t[2]);
        u.mt = __builtin_amdgcn_readfirstlane(t[3]); u.cnt = __builtin_amdgcn_readfirstlane(t[4]); return true;
    }
};
template <class Sched> __device__ __forceinline__ TableOrder build_unit_table(const Sched& S, LAS int* tab) {
    __syncthreads();
    if (threadIdx.x < 32) { Unit u; const bool ok = S.next_lane((int)threadIdx.x, u);
        if (ok) { LAS int* t = tab + threadIdx.x * 8; t[0] = u.pm; t[1] = u.pn; t[2] = u.e; t[3] = u.mt; t[4] = u.cnt; }
        const unsigned long long m = __ballot(ok); if (threadIdx.x == 0) tab[256] = __popcll(m); }
    __syncthreads();
    TableOrder T; T.tab = tab; T.n = __builtin_amdgcn_readfirstlane(tab[256]); return T;
}
struct DenseProb {
    static constexpr bool GATHER = false; static constexpr int BMAP = 0; static constexpr bool F8 = false;
    const bf16_t* A; const bf16_t* Bt; int lda, ldb, K;
    __device__ __forceinline__ const char* a_base(const Unit& u) const { return (const char*)(A + (size_t)u.pm * BM * lda); }
    __device__ __forceinline__ const char* b_base(const Unit& u) const { return (const char*)(Bt + (size_t)u.pn * BM * ldb); }
    __device__ __forceinline__ size_t bhstep() const { return (size_t)32 * ldb * 2; }
    __device__ __forceinline__ unsigned a_off(const Unit&, int, int) const { return 0u; }
    __device__ __forceinline__ unsigned a_raw(const Unit&, int) const { return 0u; }
};
struct GuProb {
    static constexpr bool GATHER = true; static constexpr int BMAP = 1; static constexpr bool F8 = true;
    const unsigned char* XG; const unsigned char* Wt; const u32x2* list; int lda, ldb, K;
    __device__ __forceinline__ const char* a_base(const Unit&) const { return (const char*)XG; }
    __device__ __forceinline__ const char* b_base(const Unit& u) const { return (const char*)(Wt + ((size_t)u.e * 2048 + 128 * u.pn) * 1024); }
    __device__ __forceinline__ size_t bhstep() const { return (size_t)1024 * 1024; }
    __device__ __forceinline__ unsigned a_raw(const Unit& u, int r) const { const int rr = u.mt * BM + r, rc = rr < u.cnt ? rr : u.cnt - 1; return list[(size_t)u.e * CAP + rc].x; }
    __device__ __forceinline__ unsigned a_off(const Unit& u, int r, int C) const {
        const int rr = u.mt * BM + r, rc = rr < u.cnt ? rr : u.cnt - 1;
        const unsigned tok = list[(size_t)u.e * CAP + rc].x >> 2;
        return tok * 1024u + (unsigned)C * 2u;
    }
};
struct DownProb {
    static constexpr bool GATHER = false; static constexpr int BMAP = 2; static constexpr bool F8 = true;
    const unsigned char* A; const unsigned char* Wt; int lda, ldb, K;
    __device__ __forceinline__ const char* a_base(const Unit& u) const { return (const char*)(A + (size_t)u.pm * BM * lda); }
    __device__ __forceinline__ const char* b_base(const Unit& u) const { return (const char*)(Wt + ((size_t)u.e * 1024 + 256 * u.pn) * 1024); }
    __device__ __forceinline__ size_t bhstep() const { return (size_t)8 * ldb; }
    __device__ __forceinline__ unsigned a_off(const Unit&, int, int) const { return 0u; }
    __device__ __forceinline__ unsigned a_raw(const Unit&, int) const { return 0u; }
};

template <class Prob> __device__ __forceinline__ void calc_aoff(const Prob& P, const Unit& u, const int (&Rr)[2], const int (&Cc)[2], unsigned (&o)[2][2]) {
#pragma unroll
    for (int h = 0; h < 2; ++h)
#pragma unroll
        for (int i = 0; i < 2; ++i) {
            if constexpr (Prob::GATHER) o[h][i] = P.a_off(u, h * HALF + Rr[i], Cc[i]);
            else o[h][i] = Prob::F8 ? (unsigned)((h * HALF + Rr[i]) * P.lda + Cc[i] * 2) : (unsigned)((h * HALF + Rr[i]) * P.lda + Cc[i]) * 2u;
        }
}

struct NoPost { __device__ __forceinline__ void operator()(int) const {} };
template <class Epi, class Prob, class Sched, bool ALIGN_EPI, class Post = NoPost>
__device__ __forceinline__ void gemm_phase(LAS unsigned char* lds, const Prob& P, const Sched& S, const Epi& E, const Post& PU = Post()) {
    const int tid = threadIdx.x, wid = __builtin_amdgcn_readfirstlane(tid >> 6), lane = tid & 63, wr = wid >> 2, wc = wid & 3, fr = lane & 15, fq = lane >> 4;
    const int K = P.K, nt = Prob::F8 ? K / 128 : K / BK;
    int Rr[2], Cc[2]; unsigned voffB[2];
#pragma unroll
    for (int i = 0; i < 2; ++i) { stage_rc(tid * 16 + i * 8192, Rr[i], Cc[i]); voffB[i] = Prob::F8 ? (unsigned)(brow<Prob::BMAP>(Rr[i]) * P.ldb + Cc[i] * 2) : (unsigned)(brow<Prob::BMAP>(Rr[i]) * P.ldb + Cc[i]) * 2u; }
    const size_t kstep = (size_t)(BK * 2);
    const size_t bhstep = P.bhstep();
    const unsigned ldsw = (unsigned)wid * 1024u;
    const int aoff = lds_byte(wr * 64 + fr, fq * 8), boff = lds_byte(wc * 32 + fr, fq * 8);
#define PG8_SA(b, h) (((b) * 2 + (h)) * HTB)
#define PG8_SB(b, h) ((4 + (b) * 2 + (h)) * HTB)
#define PG8_STG(bufoff, gptr, v0, v1) do { \
        __builtin_amdgcn_global_load_lds((const unsigned*)((const char*)(gptr) + (v0)), (LAS unsigned*)(lds + (bufoff) + ldsw), 16, 0, 0); \
        __builtin_amdgcn_global_load_lds((const unsigned*)((const char*)(gptr) + (v1)), (LAS unsigned*)(lds + (bufoff) + ldsw + 8192), 16, 0, 0); } while (0)
#define PG8_STGB(bufoff, gptr) PG8_STG(bufoff, gptr, voffB[0], voffB[1])
#define PG8_LDA(dst, b, h) do { _Pragma("unroll") for (int m = 0; m < 4; ++m) _Pragma("unroll") for (int k = 0; k < 2; ++k) dst[m][k] = *(const LAS bf16x8*)(lds + PG8_SA(b, h) + aoff + m * 2048 + k * 1024); } while (0)
#define PG8_LDB(dst, b, h) do { _Pragma("unroll") for (int n = 0; n < 2; ++n) _Pragma("unroll") for (int k = 0; k < 2; ++k) dst[n][k] = *(const LAS bf16x8*)(lds + PG8_SB(b, h) + boff + n * 2048 + k * 1024); } while (0)
#define PG8_MMAB(ai, bj, At, Bt) do { _Pragma("unroll") for (int m = 0; m < 4; ++m) _Pragma("unroll") for (int n = 0; n < 2; ++n) _Pragma("unroll") for (int k = 0; k < 2; ++k) \
        acc[ai][bj][m][n] = __builtin_amdgcn_mfma_f32_16x16x32_bf16(Bt[n][k], At[m][k], acc[ai][bj][m][n], 0, 0, 0); } while (0)
#define PG8_MMAQ(ai, bj, At, Bt) do { _Pragma("unroll") for (int m = 0; m < 4; ++m) _Pragma("unroll") for (int n = 0; n < 2; ++n) _Pragma("unroll") for (int k = 0; k < 2; ++k) { \
        const i64x2_t bq = __builtin_bit_cast(i64x2_t, Bt[n][k]), aq = __builtin_bit_cast(i64x2_t, At[m][k]); \
        acc[ai][bj][m][n] = __builtin_amdgcn_mfma_f32_16x16x32_fp8_fp8(bq[0], aq[0], acc[ai][bj][m][n], 0, 0, 0); \
        acc[ai][bj][m][n] = __builtin_amdgcn_mfma_f32_16x16x32_fp8_fp8(bq[1], aq[1], acc[ai][bj][m][n], 0, 0, 0); } } while (0)
#define PG8_MMA8(ai, bj, A8, B8) do { _Pragma("unroll") for (int m = 0; m < 4; ++m) _Pragma("unroll") for (int n = 0; n < 2; ++n) \
        asm volatile("v_mfma_f32_16x16x128_f8f6f4 %0, %1, %2, %0" : "+v"(acc[ai][bj][m][n]) : "v"(B8[n]), "v"(A8[m])); } while (0)
#define PG8_LDA8(dst, b, h) do { _Pragma("unroll") for (int m = 0; m < 4; ++m) { dst[m].lo = *(const LAS i32x4_t*)(lds + PG8_SA(b, h) + aoff + m * 2048); dst[m].hi = *(const LAS i32x4_t*)(lds + PG8_SA(b, h) + aoff + m * 2048 + 1024); } } while (0)
#define PG8_LDB8(dst, b, h) do { _Pragma("unroll") for (int n = 0; n < 2; ++n) { dst[n].lo = *(const LAS i32x4_t*)(lds + PG8_SB(b, h) + boff + n * 2048); dst[n].hi = *(const LAS i32x4_t*)(lds + PG8_SB(b, h) + boff + n * 2048 + 1024); } } while (0)
#define PG8_XLDA(b, h)  do { if constexpr (Prob::F8 && F8MODE == 2) PG8_LDA8(At8, b, h); else PG8_LDA(At, b, h); } while (0)
#define PG8_XLDB0(b, h) do { if constexpr (Prob::F8 && F8MODE == 2) PG8_LDB8(B08, b, h); else PG8_LDB(B0, b, h); } while (0)
#define PG8_XLDB1(b, h) do { if constexpr (Prob::F8 && F8MODE == 2) PG8_LDB8(B18, b, h); else PG8_LDB(B1, b, h); } while (0)
#define PG8_XMMA0(ai, bj) do { if (USE_SETPRIO) __builtin_amdgcn_s_setprio(USE_SETPRIO); if constexpr (Prob::F8 && F8MODE == 2) PG8_MMA8(ai, bj, At8, B08); else if constexpr (Prob::F8) PG8_MMAQ(ai, bj, At, B0); else PG8_MMAB(ai, bj, At, B0); if (USE_SETPRIO) __builtin_amdgcn_s_setprio(0); } while (0)
#define PG8_XMMA1(ai, bj) do { if (USE_SETPRIO) __builtin_amdgcn_s_setprio(USE_SETPRIO); if constexpr (Prob::F8 && F8MODE == 2) PG8_MMA8(ai, bj, At8, B18); else if constexpr (Prob::F8) PG8_MMAQ(ai, bj, At, B1); else PG8_MMAB(ai, bj, At, B1); if (USE_SETPRIO) __builtin_amdgcn_s_setprio(0); } while (0)
#define PG8_WAIT_V(n) asm volatile("s_waitcnt vmcnt(" #n ")" ::: "memory")
#define PG8_WAIT_L(n) asm volatile("s_waitcnt lgkmcnt(" #n ")" ::: "memory")
#define PG8_BAR __builtin_amdgcn_s_barrier()
#define PG8_SCHED __builtin_amdgcn_sched_barrier(0)
    Unit cur, nxt; int ui = 0;
    if (!S.next(0, cur)) return;
    unsigned vo[2][2], nvo[2][2];
    calc_aoff(P, cur, Rr, Cc, vo);
    bool has_next = S.next(1, nxt);
    if constexpr (Prob::GATHER) { if (has_next) calc_aoff(P, nxt, Rr, Cc, nvo); else {
#pragma unroll
        for (int h = 0; h < 2; ++h)
#pragma unroll
            for (int i = 0; i < 2; ++i) nvo[h][i] = vo[h][i]; } }
    f32x4 acc[2][2][4][2];
#pragma unroll
    for (int a = 0; a < 2; ++a)
#pragma unroll
        for (int b = 0; b < 2; ++b)
#pragma unroll
            for (int m = 0; m < 4; ++m)
#pragma unroll
                for (int n = 0; n < 2; ++n) acc[a][b][m][n] = (f32x4){0.f, 0.f, 0.f, 0.f};
    bf16x8 At[4][2], B0[2][2], B1[2][2]; i32x8_t At8[4], B08[2], B18[2];
    const char* cA = P.a_base(cur); const char* cB = P.b_base(cur);
    if constexpr (Epi::HAS_PRE) E.pre(cur, 0, wid, lane);
    PG8_STGB(PG8_SB(0, 0), cB); PG8_STGB(PG8_SB(0, 1), cB + bhstep); PG8_STG(PG8_SA(0, 0), cA, vo[0][0], vo[0][1]); PG8_STG(PG8_SA(0, 1), cA, vo[1][0], vo[1][1]);
    if (wr == 1) PG8_BAR;
    PG8_WAIT_V(2); PG8_BAR;
    PG8_STGB(PG8_SB(1, 0), cB + kstep); PG8_STG(PG8_SA(1, 0), cA + kstep, vo[0][0], vo[0][1]); PG8_STGB(PG8_SB(1, 1), cB + bhstep + kstep);
    PG8_WAIT_V(6); PG8_BAR;
    for (;;) {
        const char* nA = has_next ? P.a_base(nxt) : cA; const char* nB = has_next ? P.b_base(nxt) : cB;
        for (int t = 0; t < nt; t += 2) {
            const bool last = (t == nt - 2);
            if constexpr (Epi::HAS_MID) { if (t == Epi::MID_T0 || t == Epi::MID_T1) { E.mid(acc, cur, wr, wc, fr, fq, t == Epi::MID_T0 ? 0 : 1); PG8_SCHED; } }
            const char* a1 = cA + (size_t)(t + 1) * kstep;
            const char* a2 = last ? nA : cA + (size_t)(t + 2) * kstep; const char* b2 = last ? nB : cB + (size_t)(t + 2) * kstep;
            const char* a3 = a2 + kstep; const char* b3 = b2 + kstep;
            unsigned x00 = vo[0][0], x01 = vo[0][1], x10 = vo[1][0], x11 = vo[1][1];
            if constexpr (Prob::GATHER) { if (last) { x00 = nvo[0][0]; x01 = nvo[0][1]; x10 = nvo[1][0]; x11 = nvo[1][1]; } }
            PG8_XLDB0(0, 0); PG8_XLDB1(0, 1); PG8_SCHED; PG8_XLDA(0, 0); PG8_STG(PG8_SA(1, 1), a1, vo[1][0], vo[1][1]);
            PG8_WAIT_V(8); PG8_WAIT_L(0); PG8_BAR; PG8_XMMA0(0, 0); PG8_XMMA1(0, 1); PG8_BAR; PG8_SCHED;
            PG8_XLDA(0, 1); PG8_STGB(PG8_SB(0, 0), b2); PG8_STGB(PG8_SB(0, 1), b2 + bhstep); PG8_STG(PG8_SA(0, 0), a2, x00, x01);
            PG8_WAIT_V(8); PG8_WAIT_L(0); PG8_BAR; PG8_XMMA0(1, 0); PG8_XMMA1(1, 1); PG8_BAR; PG8_SCHED;
            PG8_XLDB0(1, 0); PG8_XLDB1(1, 1); PG8_SCHED; PG8_XLDA(1, 0); PG8_STG(PG8_SA(0, 1), a2, x10, x11);
            PG8_WAIT_V(8); PG8_WAIT_L(0); PG8_BAR; PG8_XMMA0(0, 0); PG8_XMMA1(0, 1); PG8_BAR; PG8_SCHED;
            PG8_XLDA(1, 1); PG8_STGB(PG8_SB(1, 0), b3); PG8_STGB(PG8_SB(1, 1), b3 + bhstep); PG8_STG(PG8_SA(1, 0), a3, x00, x01);
            PG8_WAIT_V(8); PG8_WAIT_L(0); PG8_BAR; PG8_XMMA0(1, 0); PG8_XMMA1(1, 1); PG8_BAR; PG8_SCHED;
        }
        if constexpr (ALIGN_EPI) { if (wr == 0) PG8_BAR; }
        if constexpr (Prob::F8 && F8MODE == 2) asm volatile("s_nop 15\n\ts_nop 15" ::: "memory");
        Unit nn; const bool has_nn = has_next && S.next(ui + 2, nn);
        if constexpr (Prob::GATHER) {
#pragma unroll
            for (int h = 0; h < 2; ++h)
#pragma unroll
                for (int i = 0; i < 2; ++i) vo[h][i] = nvo[h][i];
            if (has_nn) {
#pragma unroll
                for (int h = 0; h < 2; ++h)
#pragma unroll
                    for (int i = 0; i < 2; ++i) nvo[h][i] = P.a_raw(nn, h * HALF + Rr[i]); } }
        if constexpr (Epi::HAS_PRE) E(acc, cur, wr, wc, fr, fq, ui & 1); else E(acc, cur, wr, wc, fr, fq);
        PU(ui);
        if (!has_next) break;
#pragma unroll
        for (int a = 0; a < 2; ++a)
#pragma unroll
            for (int b = 0; b < 2; ++b)
#pragma unroll
                for (int m = 0; m < 4; ++m)
#pragma unroll
                    for (int n = 0; n < 2; ++n) acc[a][b][m][n] = (f32x4){0.f, 0.f, 0.f, 0.f};
        cur = nxt; cA = nA; cB = nB; ++ui;
        if constexpr (Epi::HAS_PRE) E.pre(cur, ui, wid, lane);
        has_next = has_nn; nxt = nn;
        if constexpr (Prob::GATHER) { if (has_next) {
#pragma unroll
            for (int h = 0; h < 2; ++h)
#pragma unroll
                for (int i = 0; i < 2; ++i) nvo[h][i] = (nvo[h][i] >> 2) * (Prob::F8 ? 1024u : 2048u) + (unsigned)Cc[i] * 2u;
            asm volatile("" : "+v"(nvo[0][0]), "+v"(nvo[0][1]), "+v"(nvo[1][0]), "+v"(nvo[1][1])); } }
        if constexpr (ALIGN_EPI) { if (wr == 1) PG8_BAR; }
    }
    PG8_WAIT_V(0);
    if constexpr (!ALIGN_EPI) { if (wr == 0) PG8_BAR; }
    PG8_BAR;
#undef PG8_SA
#undef PG8_SB
#undef PG8_STG
#undef PG8_STGB
#undef PG8_LDA
#undef PG8_LDB
#undef PG8_MMAB
#undef PG8_MMAQ
#undef PG8_MMA8
#undef PG8_LDA8
#undef PG8_LDB8
#undef PG8_XLDA
#undef PG8_XLDB0
#undef PG8_XLDB1
#undef PG8_XMMA0
#undef PG8_XMMA1
#undef PG8_WAIT_V
#undef PG8_WAIT_L
#undef PG8_BAR
#undef PG8_SCHED
}

typedef const f32x4 (&AccRef)[2][2][4][2];
__device__ __forceinline__ void dma4(const void* g, LAS unsigned char* dst) { __builtin_amdgcn_global_load_lds((const unsigned*)g, (LAS unsigned*)dst, 4, 0, 0); }

__device__ __forceinline__ void store8(bf16_t* p, const f32x4& a, const f32x4& b) {
    u32x4 w; w.x = cvt_pk_bf16(a[0], a[1]); w.y = cvt_pk_bf16(a[2], a[3]); w.z = cvt_pk_bf16(b[0], b[1]); w.w = cvt_pk_bf16(b[2], b[3]); *(u32x4*)p = w;
}
__device__ __forceinline__ float sigmoidf_(float v) { return __builtin_amdgcn_rcpf(1.0f + __builtin_amdgcn_exp2f(-1.4426950408889634f * v)); }

struct EpiInProj {
    static constexpr bool HAS_MID = false; static constexpr bool HAS_PRE = false;
    bf16_t *Q, *Kb, *V, *U, *MQ, *GT; const float *qn, *kn, *mqn, *bg; const f32x2* rope;
    __device__ __forceinline__ void operator()(AccRef acc, const Unit& u, int wr, int wc, int fr, int fq) const {
        const int pn = u.pn; const int row0 = u.pm * BM + wr * 64 + fr;
        bf16_t* const Q_ = Q; bf16_t* const K_ = Kb; bf16_t* const V_ = V; bf16_t* const U_ = U; bf16_t* const MQ_ = MQ; const float* const qn_ = qn; const float* const kn_ = kn; const float* const mqn_ = mqn;
        if (pn < 4 || pn == 7) {
            const bool rope_on = pn < 4; const float* gn = pn < 2 ? qn_ : (pn < 4 ? kn_ : mqn_);
            const float sc = (pn < 2 || pn == 7) ? C2 : 1.0f;
            bf16_t* O; int pitch, colb;
            if (pn < 2) { O = Q_; pitch = 512; colb = (pn * 4 + wc) * 64; } else if (pn < 4) { O = K_; pitch = 512; colb = ((pn - 2) * 4 + wc) * 64; } else { O = MQ_; pitch = 256; colb = wc * 64; }
            const f32x4 g00 = *(const f32x4*)(gn + 8 * fq), g01 = *(const f32x4*)(gn + 8 * fq + 4), g10 = *(const f32x4*)(gn + 32 + 8 * fq), g11 = *(const f32x4*)(gn + 32 + 8 * fq + 4);
#pragma unroll
            for (int ai = 0; ai < 2; ++ai)
#pragma unroll
                for (int m = 0; m < 4; ++m) {
                    const f32x4 a0 = acc[ai][0][m][0], a1 = acc[ai][0][m][1], b0 = acc[ai][1][m][0], b1 = acc[ai][1][m][1];
                    float ss = 0.f;
#pragma unroll
                    for (int j = 0; j < 4; ++j) ss += a0[j] * a0[j] + a1[j] * a1[j] + b0[j] * b0[j] + b1[j] * b1[j];
                    ss += __shfl_xor(ss, 16); ss += __shfl_xor(ss, 32);
                    const float rstd = 1.0f / sqrtf(ss * (1.0f / 64.0f) + RMS_EPS);
                    const int row = row0 + ai * HALF + m * 16;
                    f32x4 t10 = a0 * rstd * g00, t11 = a1 * rstd * g01, t20 = b0 * rstd * g10, t21 = b1 * rstd * g11;
                    f32x4 o10, o11, o20, o21;
                    if (rope_on) {
                        const f32x4* rp = (const f32x4*)(rope + (size_t)(row & (SEQ - 1)) * 32 + 8 * fq);
                        const f32x4 r0 = rp[0], r1 = rp[1], r2 = rp[2], r3 = rp[3];
                        const f32x4 cs0 = {r0[0], r0[2], r1[0], r1[2]}, sn0 = {r0[1], r0[3], r1[1], r1[3]}, cs1 = {r2[0], r2[2], r3[0], r3[2]}, sn1 = {r2[1], r2[3], r3[1], r3[3]};
                        o10 = (t10 * cs0 - t20 * sn0) * sc; o11 = (t11 * cs1 - t21 * sn1) * sc; o20 = (t20 * cs0 + t10 * sn0) * sc; o21 = (t21 * cs1 + t11 * sn1) * sc;
                    } else { o10 = t10 * sc; o11 = t11 * sc; o20 = t20 * sc; o21 = t21 * sc; }
                    bf16_t* rowp = O + (size_t)row * pitch + colb + 8 * fq;
                    store8(rowp, o10, o11); store8(rowp + 32, o20, o21);
                }
        } else if (pn < 7) {
            bf16_t* O; int pitch, colb;
            if (pn < 6) { O = V_; pitch = 512; colb = (pn - 4) * 256 + wc * 64; } else { O = U_; pitch = 256; colb = wc * 64; }
#pragma unroll
            for (int ai = 0; ai < 2; ++ai)
#pragma unroll
                for (int m = 0; m < 4; ++m) { bf16_t* rowp = O + (size_t)(row0 + ai * HALF + m * 16) * pitch + colb + 8 * fq;
                    store8(rowp, acc[ai][0][m][0], acc[ai][0][m][1]); store8(rowp + 32, acc[ai][1][m][0], acc[ai][1][m][1]); }
        } else {
            const int gc = (pn - 8) * 256 + wc * 64 + 8 * fq;
            f32x4 bv[2][2];
#pragma unroll
            for (int bj = 0; bj < 2; ++bj)
#pragma unroll
                for (int n = 0; n < 2; ++n) bv[bj][n] = *(const f32x4*)(bg + gc + 32 * bj + 4 * n);
#pragma unroll
            for (int ai = 0; ai < 2; ++ai)
#pragma unroll
                for (int m = 0; m < 4; ++m) {
                    bf16_t* blk = GT + ((size_t)(((pn - 8) >> 2) * 128 + u.pm) * 4 + ((pn - 8) & 3)) * 65536 + (size_t)((wr * 4 + wc) * 16 * 64 + (fq * 16 + fr)) * 8;
#pragma unroll
                    for (int bj = 0; bj < 2; ++bj) { f32x4 v0 = acc[ai][bj][m][0] + bv[bj][0], v1 = acc[ai][bj][m][1] + bv[bj][1];
#pragma unroll
                        for (int j = 0; j < 4; ++j) { v0[j] = sigmoidf_(v0[j]); v1[j] = sigmoidf_(v1[j]); }
                        store8(blk + (ai * 8 + m * 2 + bj) * 512, v0, v1); } }
        }
    }
};
struct EpiMemKV {
    static constexpr bool HAS_MID = false; static constexpr bool HAS_PRE = false;
    bf16_t* MKV; const float* mkn;
    __device__ __forceinline__ void operator()(AccRef acc, const Unit& u, int wr, int wc, int fr, int fq) const {
        const int row0 = u.pm * BM + wr * 64 + fr;
        f32x4 g00 = {1.f, 1.f, 1.f, 1.f}, g01 = g00, g10 = g00, g11 = g00;
        if (u.pn == 0) { g00 = *(const f32x4*)(mkn + 8 * fq); g01 = *(const f32x4*)(mkn + 8 * fq + 4); g10 = *(const f32x4*)(mkn + 32 + 8 * fq); g11 = *(const f32x4*)(mkn + 32 + 8 * fq + 4); }
#pragma unroll
        for (int ai = 0; ai < 2; ++ai)
#pragma unroll
            for (int m = 0; m < 4; ++m) {
                const f32x4 a0 = acc[ai][0][m][0], a1 = acc[ai][0][m][1], b0 = acc[ai][1][m][0], b1 = acc[ai][1][m][1];
                float rstd = 1.0f;
                if (u.pn == 0) { float ss = 0.f;
#pragma unroll
                    for (int j = 0; j < 4; ++j) ss += a0[j] * a0[j] + a1[j] * a1[j] + b0[j] * b0[j] + b1[j] * b1[j];
                    ss += __shfl_xor(ss, 16); ss += __shfl_xor(ss, 32); rstd = 1.0f / sqrtf(ss * (1.0f / 64.0f) + RMS_EPS); }
                bf16_t* rowp = MKV + (size_t)(row0 + ai * HALF + m * 16) * 512 + u.pn * 256 + wc * 64 + 8 * fq;
                store8(rowp, a0 * rstd * g00, a1 * rstd * g01); store8(rowp + 32, b0 * rstd * g10, b1 * rstd * g11);
            }
    }
};
template <int STAGE> struct EpiMerge {
    static constexpr bool HAS_MID = false; static constexpr bool HAS_PRE = false;
    const bf16_t* GT; float* MF; bf16_t* MB;
    __device__ __forceinline__ void operator()(AccRef acc, const Unit& u, int wr, int wc, int fr, int fq) const {
        const int row0 = u.pm * BM + wr * 64 + fr, col0 = u.pn * BM + wc * 64 + 8 * fq;
#pragma unroll
        for (int ai = 0; ai < 2; ++ai)
#pragma unroll
            for (int m = 0; m < 4; ++m) { const size_t row = (size_t)(row0 + ai * HALF + m * 16);
#pragma unroll
                for (int bj = 0; bj < 2; ++bj) { const int col = col0 + 32 * bj;
                    const u32x4 g = *(const u32x4*)(GT + row * 3072 + STAGE * 1024 + col);
                    const f32x4 ga = {bf_lo(g.x), bf_hi(g.x), bf_lo(g.y), bf_hi(g.y)}, gb = {bf_lo(g.z), bf_hi(g.z), bf_lo(g.w), bf_hi(g.w)};
                    f32x4 v0 = acc[ai][bj][m][0] * ga, v1 = acc[ai][bj][m][1] * gb;
                    float* mp = MF + row * 1024 + col;
                    if (STAGE > 0) { v0 += *(const f32x4*)mp; v1 += *(const f32x4*)(mp + 4); }
                    if (STAGE < 2) { *(f32x4*)mp = v0; *(f32x4*)(mp + 4) = v1; } else store8(MB + row * 1024 + col, v0, v1); }
                if (m & 1) asm volatile("" ::: "memory"); }
    }
};
struct EpiWout {
    static constexpr bool HAS_MID = false; static constexpr bool HAS_PRE = false;
    const float* X; float* X2; unsigned char* XG; const float* n2;
    __device__ __forceinline__ void operator()(AccRef acc, const Unit& u, int wr, int wc, int fr, int fq) const {
        const int row0 = u.pm * BM + wr * 64 + fr, col0 = u.pn * BM + wc * 64 + 8 * fq;
        f32x4 nv[2][2];
#pragma unroll
        for (int bj = 0; bj < 2; ++bj)
#pragma unroll
            for (int n = 0; n < 2; ++n) nv[bj][n] = *(const f32x4*)(n2 + col0 + 32 * bj + 4 * n);
#pragma unroll
        for (int ai = 0; ai < 2; ++ai)
#pragma unroll
            for (int m = 0; m < 4; ++m) { const size_t off = (size_t)(row0 + ai * HALF + m * 16) * 1024 + col0;
#pragma unroll
                for (int bj = 0; bj < 2; ++bj) { const f32x4 x0 = *(const f32x4*)(X + off + 32 * bj) + acc[ai][bj][m][0], x1 = *(const f32x4*)(X + off + 32 * bj + 4) + acc[ai][bj][m][1];
                    *(f32x4*)(X2 + off + 32 * bj) = x0; *(f32x4*)(X2 + off + 32 * bj + 4) = x1;
                    { const f32x4 y0 = x0 * nv[bj][0], y1 = x1 * nv[bj][1]; u32x2 w8; w8.x = pk4_fp8(y0[0], y0[1], y0[2], y0[3]); w8.y = pk4_fp8(y1[0], y1[1], y1[2], y1[3]); *(u32x2*)(XG + off + 32 * bj) = w8; } }
                if (m & 1) asm volatile("" ::: "memory"); }
    }
};
struct EpiSwiglu {
    static constexpr bool HAS_MID = false; static constexpr bool HAS_PRE = true;
    unsigned char* ACT; const u32x2* list; const float* bgu; LAS unsigned char* xb;
    __device__ __forceinline__ void pre(const Unit& u, int ui, int wid, int lane) const {
        LAS unsigned char* b = xb + (ui & 1) * 2048;
        if (wid < 4) { const int rr = u.mt * BM + 64 * wid + lane, rc = rr < u.cnt ? rr : u.cnt - 1; dma4((const unsigned*)(list + (size_t)u.e * CAP + rc) + 1, b + wid * 256); }
        else { const int j = 64 * (wid - 4) + lane; dma4(bgu + (size_t)u.e * 2048 + 128 * u.pn + (j < 128 ? j : 1024 + (j - 128)), b + 1024 + (wid - 4) * 256); }
    }
    __device__ __forceinline__ static unsigned swi4(const f32x4& ag, const f32x4& au, float rstd, const f32x4& bg, const f32x4& bu) {
        unsigned w = 0;
#pragma unroll
        for (int h = 0; h < 2; ++h) {
            const f32x2 a2 = {ag[2 * h], ag[2 * h + 1]}, u2 = {au[2 * h], au[2 * h + 1]}, bg2 = {bg[2 * h], bg[2 * h + 1]}, bu2 = {bu[2 * h], bu[2 * h + 1]};
            const f32x2 G = a2 * rstd + bg2, U = u2 * rstd + bu2;
            const f32x2 gg = {fminf(G[0], 7.0f), fminf(G[1], 7.0f)};
            const f32x2 t = gg * (-1.702f * 1.4426950408889634f);
            const f32x2 d = (f32x2){__builtin_amdgcn_exp2f(t[0]), __builtin_amdgcn_exp2f(t[1])} + 1.0f;
            const f32x2 r = {__builtin_amdgcn_rcpf(d[0]), __builtin_amdgcn_rcpf(d[1])};
            const f32x2 uu = {__builtin_amdgcn_fmed3f(U[0], -7.0f, 7.0f), __builtin_amdgcn_fmed3f(U[1], -7.0f, 7.0f)};
            const f32x2 o = (gg * r) * (uu * A8_SCALE + A8_SCALE);
            w = h ? (unsigned)__builtin_amdgcn_cvt_pk_fp8_f32(o[0], o[1], (int)w, true) : (unsigned)__builtin_amdgcn_cvt_pk_fp8_f32(o[0], o[1], (int)w, false);
        }
        return w;
    }
    __device__ __forceinline__ void operator()(AccRef acc, const Unit& u, int wr, int wc, int fr, int fq, int par) const {
        int z = 0; asm volatile("" : "+v"(z));
        const int col = 128 * u.pn + 32 * wc + 8 * fq + z; const LAS unsigned char* b = xb + par * 2048; const LAS unsigned char* bb = b + 1024 + (32 * wc + 8 * fq + z) * 4;
        const f32x4 bg0 = *(const LAS f32x4*)bb, bg1 = *(const LAS f32x4*)(bb + 16), bu0 = *(const LAS f32x4*)(bb + 512), bu1 = *(const LAS f32x4*)(bb + 528);
#pragma unroll
        for (int ai = 0; ai < 2; ++ai)
#pragma unroll
            for (int m = 0; m < 4; ++m) { const int r = ai * HALF + wr * 64 + m * 16 + fr;
                const float rstd = *(const LAS float*)(b + (r + z) * 4) * (1.0f / W8_SCALE);
                u32x2 w8; w8.x = swi4(acc[ai][0][m][0], acc[ai][1][m][0], rstd, bg0, bu0); w8.y = swi4(acc[ai][0][m][1], acc[ai][1][m][1], rstd, bg1, bu1);
                *(u32x2*)(ACT + (size_t)(u.pm * BM + r) * 1024 + col) = w8; }
    }
};
struct EpiDown {
    static constexpr bool HAS_MID = false; static constexpr bool HAS_PRE = true;
    unsigned char* Y4; const u32x2* list; const float* bd; LAS unsigned char* xb;
    __device__ __forceinline__ void pre(const Unit& u, int ui, int wid, int lane) const {
        LAS unsigned char* b = xb + (ui & 1) * 2048;
        if (wid < 4) { const int rr = u.mt * BM + 64 * wid + lane, rc = rr < u.cnt ? rr : u.cnt - 1; dma4((const unsigned*)(list + (size_t)u.e * CAP + rc), b + wid * 256); }
        else { const int j = 64 * (wid - 4) + lane; dma4(bd + (size_t)u.e * 1024 + u.pn * BM + j, b + 1024 + (wid - 4) * 256); }
    }
    __device__ __forceinline__ static unsigned dn4(const f32x4& a, const f32x4& b32) {
        const f32x4 y = a * (Y8_SCALE / (W8_SCALE * A8_SCALE)) + b32;
        return pk4_fp8(y[0], y[1], y[2], y[3]);
    }
    __device__ __forceinline__ void operator()(AccRef acc, const Unit& u, int wr, int wc, int fr, int fq, int par) const {
        int z = 0; asm volatile("" : "+v"(z));
        const int colw = wc * 64 + 16 * fq + z, col0 = u.pn * BM + colw;
        const LAS unsigned char* b = xb + par * 2048;
        f32x4 bv[2][2];
#pragma unroll
        for (int bj = 0; bj < 2; ++bj)
#pragma unroll
            for (int n = 0; n < 2; ++n) bv[bj][n] = *(const LAS f32x4*)(b + 1024 + (colw + 8 * bj + 4 * n) * 4) * Y8_SCALE;
#pragma unroll
        for (int ai = 0; ai < 2; ++ai)
#pragma unroll
            for (int m = 0; m < 4; ++m) { const int r = ai * HALF + wr * 64 + m * 16 + fr, rr = u.mt * BM + r;
                if (rr < u.cnt) { const unsigned tk = *(const LAS unsigned*)(b + (r + z) * 4);
                    u32x4 w8; w8.x = dn4(acc[ai][0][m][0], bv[0][0]); w8.y = dn4(acc[ai][0][m][1], bv[0][1]); w8.z = dn4(acc[ai][1][m][0], bv[1][0]); w8.w = dn4(acc[ai][1][m][1], bv[1][1]);
                    *(u32x4*)(Y4 + (size_t)tk * 1024 + col0) = w8; } }
    }
};
struct EpiMergeR {
    static constexpr bool HAS_MID = true; static constexpr bool HAS_PRE = false; static constexpr int MID_T0 = 8, MID_T1 = 12;
    const bf16_t* GT; bf16_t* MB;
    __device__ __forceinline__ void mid(f32x4 (&acc)[2][2][4][2], const Unit& u, int wr, int wc, int fr, int fq, int seam) const {
        int z = 0; asm volatile("" : "+v"(z));
        const bf16_t* gp0 = GT + ((size_t)(seam * 128 + u.pm) * 4 + u.pn) * 65536 + (size_t)((wr * 4 + wc) * 16 * 64 + (fq * 16 + fr) + z) * 8;
#pragma unroll
        for (int ai = 0; ai < 2; ++ai)
#pragma unroll
            for (int m = 0; m < 4; ++m) {
#pragma unroll
                for (int bj = 0; bj < 2; ++bj) { const bf16_t* gp = gp0 + (ai * 8 + m * 2 + bj) * 512;
                    const u32x4 gn = *(const u32x4*)gp, gd = *(const u32x4*)(gp + (size_t)128 * 4 * 65536);
                    const unsigned nn[4] = {gn.x, gn.y, gn.z, gn.w}, dd[4] = {gd.x, gd.y, gd.z, gd.w};
#pragma unroll
                    for (int j = 0; j < 4; ++j) { const float r0 = bf_lo(nn[j]) * __builtin_amdgcn_rcpf(fmaxf(bf_lo(dd[j]), 8.67e-19f)), r1 = bf_hi(nn[j]) * __builtin_amdgcn_rcpf(fmaxf(bf_hi(dd[j]), 8.67e-19f));
                        acc[ai][bj][m][j >> 1][(j & 1) * 2] *= r0; acc[ai][bj][m][j >> 1][(j & 1) * 2 + 1] *= r1; } }
                if (m & 1) asm volatile("" ::: "memory"); }
    }
    __device__ __forceinline__ void operator()(AccRef acc, const Unit& u, int wr, int wc, int fr, int fq) const {
        int z = 0; asm volatile("" : "+v"(z));
        const size_t off0 = (size_t)(u.pm * BM + wr * 64 + fr + z) * 1024 + u.pn * BM + wc * 64 + 8 * fq;
        const bf16_t* gp0 = GT + ((size_t)(2 * 128 + u.pm) * 4 + u.pn) * 65536 + (size_t)((wr * 4 + wc) * 16 * 64 + (fq * 16 + fr) + z) * 8;
#pragma unroll
        for (int ai = 0; ai < 2; ++ai)
#pragma unroll
            for (int m = 0; m < 4; ++m) { const size_t ro = off0 + (size_t)(ai * HALF + m * 16) * 1024;
#pragma unroll
                for (int bj = 0; bj < 2; ++bj) {
                    const u32x4 g = *(const u32x4*)(gp0 + (ai * 8 + m * 2 + bj) * 512);
                    const f32x4 ga = {bf_lo(g.x), bf_hi(g.x), bf_lo(g.y), bf_hi(g.y)}, gb = {bf_lo(g.z), bf_hi(g.z), bf_lo(g.w), bf_hi(g.w)};
                    store8(MB + ro + 32 * bj, acc[ai][bj][m][0] * ga, acc[ai][bj][m][1] * gb); } }
    }
};
struct EpiPlain {
    static constexpr bool HAS_MID = false; static constexpr bool HAS_PRE = false;
    bf16_t* Z; int ldz;
    __device__ __forceinline__ void operator()(AccRef acc, const Unit& u, int wr, int wc, int fr, int fq) const {
        const int row0 = u.pm * BM + wr * 64 + fr, col0 = u.pn * BM + wc * 64 + 8 * fq;
#pragma unroll
        for (int ai = 0; ai < 2; ++ai)
#pragma unroll
            for (int m = 0; m < 4; ++m) { bf16_t* rowp = Z + (size_t)(row0 + ai * HALF + m * 16) * ldz + col0;
                store8(rowp, acc[ai][0][m][0], acc[ai][0][m][1]); store8(rowp + 32, acc[ai][1][m][0], acc[ai][1][m][1]); }
    }
};
}

namespace attn_body {
using bf16 = __hip_bfloat16;
using s16x4 = __attribute__((ext_vector_type(4))) short;
constexpr int NW = 8, QBLK = 32, QB = QBLK * NW, KVBLK = 64, D = 64;
__device__ __forceinline__ int crow(int r, int hi) { return (r & 3) + 8 * (r >> 2) + 4 * hi; }
#define SBAR() __builtin_amdgcn_sched_barrier(0)
constexpr int NSLOT = 3, SLOTB = 8192;
constexpr int LDS_K = 0, LDS_V = NSLOT * SLOTB, LDS_WS = 2 * NSLOT * SLOTB, LDS_OST = LDS_WS + NW * 64 * 4, LDS_BYTES = LDS_OST + NW * 4096;
__device__ __forceinline__ void glds16(const void* gsrc, unsigned lds_dst) { unsigned keep;
    asm volatile("s_mov_b32 %0, m0\n\ts_mov_b32 m0, %2\n\ts_nop 0\n\tglobal_load_lds_dwordx4 %1, off\n\ts_mov_b32 m0, %0" : "=&s"(keep) : "v"(gsrc), "s"(lds_dst) : "memory"); }
__device__ __forceinline__ float max3f(float a, float b, float c) { float r; asm("v_max3_f32 %0, %1, %2, %3" : "=v"(r) : "v"(a), "v"(b), "v"(c)); return r; }
__device__ __forceinline__ float max2f(float a, float b) { float r; asm("v_max_f32_e32 %0, %1, %2" : "=v"(r) : "v"(a), "v"(b)); return r; }
__device__ __forceinline__ float fadd_s(float a, float b) { float r; asm("v_add_f32_e32 %0, %1, %2" : "=v"(r) : "v"(a), "v"(b)); return r; }
__device__ __forceinline__ float fsub_s(float a, float b) { float r; asm("v_sub_f32_e32 %0, %1, %2" : "=v"(r) : "v"(a), "v"(b)); return r; }
typedef float f32x2_t __attribute__((ext_vector_type(2))); typedef __bf16 bf16x2_t __attribute__((ext_vector_type(2)));
__device__ __forceinline__ unsigned cvtpk_s(float lo, float hi) { f32x2_t v = {lo, hi}; bf16x2_t b = __builtin_convertvector(v, bf16x2_t); return __builtin_bit_cast(unsigned, b); }
#define WAIT_BAR(N) asm volatile("s_waitcnt vmcnt(" #N ") lgkmcnt(0)\n\ts_barrier" ::: "memory")

__device__ __forceinline__ void qkt(f32x16& p0, f32x16& p1, const char* Kslot, const bf16x8* qr, const f32x16& negm, int r32, int hi) {
    const char* kb = Kslot + hi * 1024 + r32 * 16;
#pragma unroll
    for (int d0 = 0; d0 < 4; ++d0) {
        const bf16x8 b0 = *reinterpret_cast<const bf16x8*>(kb + d0 * 2048);
        const bf16x8 b1 = *reinterpret_cast<const bf16x8*>(kb + d0 * 2048 + 512);
        if (d0 == 0) { p0 = __builtin_amdgcn_mfma_f32_32x32x16_bf16(b0, qr[0], negm, 0, 0, 0); p1 = __builtin_amdgcn_mfma_f32_32x32x16_bf16(b1, qr[0], negm, 0, 0, 0); }
        else { p0 = __builtin_amdgcn_mfma_f32_32x32x16_bf16(b0, qr[d0], p0, 0, 0, 0); p1 = __builtin_amdgcn_mfma_f32_32x32x16_bf16(b1, qr[d0], p1, 0, 0, 0); } }
}
typedef __attribute__((address_space(3))) const char* lds_cptr;
typedef short v4i16_t __attribute__((ext_vector_type(4)));
__device__ __forceinline__ void kload8(bf16x8* kf, lds_cptr kp) {
    kf[0] = *(const __attribute__((address_space(3))) bf16x8*)(kp);        kf[1] = *(const __attribute__((address_space(3))) bf16x8*)(kp + 512);
    kf[2] = *(const __attribute__((address_space(3))) bf16x8*)(kp + 2048); kf[3] = *(const __attribute__((address_space(3))) bf16x8*)(kp + 2560);
    kf[4] = *(const __attribute__((address_space(3))) bf16x8*)(kp + 4096); kf[5] = *(const __attribute__((address_space(3))) bf16x8*)(kp + 4608);
    kf[6] = *(const __attribute__((address_space(3))) bf16x8*)(kp + 6144); kf[7] = *(const __attribute__((address_space(3))) bf16x8*)(kp + 6656);
}
__device__ __forceinline__ void kload2(bf16x8* kf, lds_cptr kp, int j) { kf[2 * j] = *(const __attribute__((address_space(3))) bf16x8*)(kp + j * 2048); kf[2 * j + 1] = *(const __attribute__((address_space(3))) bf16x8*)(kp + j * 2048 + 512); }
__device__ __forceinline__ s16x4 vtr(lds_cptr p) { return __builtin_bit_cast(s16x4, __builtin_amdgcn_ds_read_tr16_b64_v4i16((__attribute__((address_space(3))) v4i16_t*)p)); }
__device__ __forceinline__ float rowmax(const f32x16& p0, const f32x16& p1) {
    float a = max3f(p0[0], p0[1], p1[0]), b = max3f(p0[2], p0[3], p1[1]); a = max3f(a, p1[2], p1[3]);
#pragma unroll
    for (int r = 4; r < 16; r += 4) { a = max3f(a, p0[r], p0[r + 1]); b = max3f(b, p0[r + 2], p0[r + 3]); a = max3f(a, p1[r], p1[r + 1]); b = max3f(b, p1[r + 2], p1[r + 3]); }
    const float m = max2f(a, b);
    auto rr = __builtin_amdgcn_permlane32_swap(__float_as_uint(m), __float_as_uint(m), false, false);
    return max2f(__uint_as_float(rr[0]), __uint_as_float(rr[1]));
}
__device__ __forceinline__ void pv(f32x16* o, int vb, bf16x8 pa0, bf16x8 pa1, bf16x8 pa2, bf16x8 pa3) {
#pragma unroll
    for (int d0 = 0; d0 < 2; ++d0) { s16x4 lo[4], hi[4];
#pragma unroll
        for (int ks = 0; ks < 4; ++ks) {
            asm volatile("ds_read_b64_tr_b16 %0,%1 offset:%c2" : "=&v"(lo[ks]) : "v"(vb), "i"(d0 * 4096 + ks * 1024) : "memory");
            asm volatile("ds_read_b64_tr_b16 %0,%1 offset:%c2" : "=&v"(hi[ks]) : "v"(vb), "i"(d0 * 4096 + ks * 1024 + 512) : "memory"); }
        asm volatile("s_waitcnt lgkmcnt(0)" ::: "memory"); SBAR();
#define PK(k) (bf16x8){lo[k][0], lo[k][1], lo[k][2], lo[k][3], hi[k][0], hi[k][1], hi[k][2], hi[k][3]}
        o[d0] = __builtin_amdgcn_mfma_f32_32x32x16_bf16(pa0, PK(0), o[d0], 0, 0, 0);
        o[d0] = __builtin_amdgcn_mfma_f32_32x32x16_bf16(pa1, PK(1), o[d0], 0, 0, 0);
        o[d0] = __builtin_amdgcn_mfma_f32_32x32x16_bf16(pa2, PK(2), o[d0], 0, 0, 0);
        o[d0] = __builtin_amdgcn_mfma_f32_32x32x16_bf16(pa3, PK(3), o[d0], 0, 0, 0);
#undef PK
    }
}
__device__ __forceinline__ void cmask(f32x16& p0, f32x16& p1, int jb, int wid) {
    if (jb > (wid >> 1)) {
#pragma unroll
        for (int r = 0; r < 16; ++r) { p0[r] = -INFINITY; p1[r] = -INFINITY; } }
}
template <int THRL, bool MASK> __device__ __forceinline__ void attn_unit(int q0, int NT, const bf16* Qh, int qp, const bf16* __restrict__ Kh, int kp, const bf16* __restrict__ Vh, int vp, bf16* Oh, int op, char* shm) {
    const int tid = threadIdx.x, lane = tid & 63, r32 = lane & 31, hi = lane >> 5; const int wid = __builtin_amdgcn_readfirstlane(tid >> 6);
    const bf16* Qw = Qh + (long)(q0 + wid * QBLK) * qp;
    const unsigned lds0 = (unsigned)(uintptr_t)shm;
    float* wsf = (float*)(shm + LDS_WS) + wid * 64;
    const bf16* ksrc = Kh + (long)lane * kp + wid * 8;
    const bf16* vsrc = Vh + (long)(16 * (wid & 3) + (lane >> 2)) * vp + (wid >> 2) * 32 + (lane & 3) * 8;
    const unsigned kdst = lds0 + LDS_K + wid * 1024, vdst = lds0 + LDS_V + wid * 1024;
#define DMA_K(t, slot) glds16(ksrc + (long)(t) * KVBLK * kp, (unsigned)__builtin_amdgcn_readfirstlane(kdst + (slot)))
#define DMA_V(t, slot) glds16(vsrc + (long)(t) * KVBLK * vp, (unsigned)__builtin_amdgcn_readfirstlane(vdst + (slot)))
    const int vb0 = (int)(lds0 + LDS_V) + ((lane >> 4) & 1) * 32 + (lane & 3) * 8 + (4 * hi + ((lane & 15) >> 2)) * 64;
    const char* Kbase = shm + LDS_K; bf16x8 kf[8];
    const lds_cptr shm3 = (lds_cptr)shm; const lds_cptr kp0 = shm3 + LDS_K + hi * 1024 + r32 * 16; const lds_cptr vp0 = shm3 + LDS_V + ((lane >> 4) & 1) * 32 + (lane & 3) * 8 + (4 * hi + ((lane & 15) >> 2)) * 64;
    DMA_K(0, 0); DMA_V(0, 0); DMA_K(1, SLOTB);
    bf16x8 qr[4];
#pragma unroll
    for (int d0 = 0; d0 < 4; ++d0) qr[d0] = *reinterpret_cast<const bf16x8*>(&Qw[(long)r32 * qp + d0 * 16 + hi * 8]);
    float mhat = 0.f, l_reg = 0.f; f32x16 o[2]; o[0] = f32x16{}; o[1] = f32x16{}; f32x16 negm = f32x16{}; asm volatile("" : "+v"(negm));
#define CMASK(P0, P1, t) do { if (MASK) { int jb_ = (t) - (NT - 4); if (jb_ >= 0) cmask(P0, P1, jb_, wid); } } while (0)
    bool resc = false;
#define START(P0, P1) do { const float rm = rowmax(P0, P1); resc = false; \
    { const float dl = rm; mhat = fadd_s(mhat, dl); \
      _Pragma("unroll") for (int r = 0; r < 16; ++r) { P0[r] = fsub_s(P0[r], dl); P1[r] = fsub_s(P1[r], dl); } \
      _Pragma("unroll") for (int r = 0; r < 16; ++r) negm[r] = -mhat; asm volatile("" : "+v"(negm)); } \
    _Pragma("unroll") for (int r = 0; r < 16; ++r) P0[r] = __builtin_amdgcn_exp2f(P0[r]); } while (0)
#define RESC() do { if (resc) { asm volatile("s_waitcnt lgkmcnt(0)" ::: "memory"); \
      _Pragma("unroll") for (int d_ = 0; d_ < 2; ++d_) _Pragma("unroll") for (int r = 0; r < 16; ++r) o[d_][r] *= wsf[crow(r, hi)]; } } while (0)
    f32x16 pA0, pA1, pB0, pB1;
    int sl_prev = 0, sl_cur = 0, sl_next = SLOTB;
#define ROT() do { sl_prev = sl_cur; sl_cur = sl_next; sl_next = (sl_next == (NSLOT - 1) * SLOTB) ? 0 : sl_next + SLOTB; } while (0)
    DMA_K(2, 2 * SLOTB);
    WAIT_BAR(3);
    qkt(pA0, pA1, Kbase, qr, negm, r32, hi); asm volatile("s_nop 15\n\ts_nop 7" : "+v"(pA0), "+v"(pA1)); CMASK(pA0, pA1, 0);
    START(pA0, pA1);
    _Pragma("unroll") for (int r = 0; r < 16; ++r) pA1[r] = __builtin_amdgcn_exp2f(pA1[r]);
    WAIT_BAR(0);
    DMA_K(3, 0); DMA_V(1, SLOTB);
    ROT();
    kload8(kf, kp0 + sl_cur);
    WAIT_BAR(2);
    s16x4 vlo[8], vhi[8]; u32x4 pw0, pw1, pw2, pw3;
#define PKW(P, B) cvtpk_s(P[B], P[B + 1])
#define PAF(k) __builtin_bit_cast(bf16x8, pw##k)
#define VFR(i) (bf16x8){vlo[i][0], vlo[i][1], vlo[i][2], vlo[i][3], vhi[i][0], vhi[i][1], vhi[i][2], vhi[i][3]}
#define PIN(x) asm volatile("" : "+v"(x))
#define MX3(a, b, c) __builtin_fmaxf(__builtin_fmaxf((a), (b)), (c))
#define GAPA(MF, A0, A1, A2, A3, W0, W1, PW) do { MF; sacc += A0; sacc += A1; sacc += A2; sacc += A3; PIN(sacc); W0; W1; PIN(PW); SBAR(); } while (0)
#define EX(v) __builtin_amdgcn_exp2f(v)
#define GAPB(MF, X, B) do { MF; X[B] = EX(X[B]); X[B + 1] = EX(X[B + 1]); X[B + 2] = EX(X[B + 2]); X[B + 3] = EX(X[B + 3]); PIN(X); SBAR(); } while (0)
#define VRD(i) do { vlo[i] = vtr(vp_ + (((i) >> 2) * 4096 + ((i) & 3) * 1024)); vhi[i] = vtr(vp_ + (((i) >> 2) * 4096 + ((i) & 3) * 1024 + 512)); } while (0)
#define KRD(G, j) do { if (G) { kload2(kf, kp0 + sl_next, j); SBAR(); } } while (0)
#define STEP(C0, C1, P0, P1, t, GK, GV, GL) do { SBAR(); \
    const lds_cptr vp_ = vp0 + sl_prev; \
    VRD(0); SBAR(); float sacc = (P0[0] + P0[1]); \
    GAPA(C0 = __builtin_amdgcn_mfma_f32_32x32x16_bf16(kf[0], qr[0], negm, 0, 0, 0), P0[2], P0[3], P0[4], P0[5],     pw0[0] = PKW(P0, 0), pw0[1] = PKW(P0, 2), pw0); \
    VRD(4); SBAR(); GAPA(C1 = __builtin_amdgcn_mfma_f32_32x32x16_bf16(kf[1], qr[0], negm, 0, 0, 0), P0[6], P0[7], P0[8], P0[9],     pw0[2] = PKW(P0, 4), pw0[3] = PKW(P0, 6), pw0); \
    VRD(1); SBAR(); GAPA(C0 = __builtin_amdgcn_mfma_f32_32x32x16_bf16(kf[2], qr[1], C0, 0, 0, 0),   P0[10], P0[11], P0[12], P0[13], pw1[0] = PKW(P0, 8), pw1[1] = PKW(P0, 10), pw1); \
    VRD(5); SBAR(); GAPA(C1 = __builtin_amdgcn_mfma_f32_32x32x16_bf16(kf[3], qr[1], C1, 0, 0, 0),   P0[14], P0[15], P1[0], P1[1],   pw1[2] = PKW(P0, 12), pw1[3] = PKW(P0, 14), pw1); \
    VRD(2); SBAR(); GAPA(C0 = __builtin_amdgcn_mfma_f32_32x32x16_bf16(kf[4], qr[2], C0, 0, 0, 0),   P1[2], P1[3], P1[4], P1[5],     pw2[0] = PKW(P1, 0), pw2[1] = PKW(P1, 2), pw2); \
    VRD(6); SBAR(); GAPA(C1 = __builtin_amdgcn_mfma_f32_32x32x16_bf16(kf[5], qr[2], C1, 0, 0, 0),   P1[6], P1[7], P1[8], P1[9],     pw2[2] = PKW(P1, 4), pw2[3] = PKW(P1, 6), pw2); \
    VRD(3); SBAR(); GAPA(C0 = __builtin_amdgcn_mfma_f32_32x32x16_bf16(kf[6], qr[3], C0, 0, 0, 0),   P1[10], P1[11], P1[12], P1[13], pw3[0] = PKW(P1, 8), pw3[1] = PKW(P1, 10), pw3); \
    VRD(7); SBAR(); GAPA(C1 = __builtin_amdgcn_mfma_f32_32x32x16_bf16(kf[7], qr[3], C1, 0, 0, 0),   P1[14], P1[15], 0.f, 0.f,       pw3[2] = PKW(P1, 12), pw3[3] = PKW(P1, 14), pw3); \
    l_reg += sacc; \
    if (GK) { DMA_K((t) + 3, sl_cur); } if (GV) { DMA_V((t) + 1, sl_next); } \
    CMASK(C0, C1, t); \
    { float a = MX3(C0[0], C0[1], C1[0]), b = MX3(C0[2], C0[3], C1[1]); a = MX3(a, C1[2], C1[3]); \
      _Pragma("unroll") for (int r = 4; r < 16; r += 4) { a = MX3(a, C0[r], C0[r + 1]); b = MX3(b, C0[r + 2], C0[r + 3]); a = MX3(a, C1[r], C1[r + 1]); b = MX3(b, C1[r + 2], C1[r + 3]); } \
      float rm = __builtin_fmaxf(a, b); { auto rr = __builtin_amdgcn_permlane32_swap(__float_as_uint(rm), __float_as_uint(rm), false, false); rm = __builtin_fmaxf(__uint_as_float(rr[0]), __uint_as_float(rr[1])); } \
      resc = false; \
      if (__builtin_expect(__any(rm > (float)THRL), 0)) { const float dl = __builtin_fmaxf(rm, 0.f); mhat += dl; \
        _Pragma("unroll") for (int r = 0; r < 16; ++r) { C0[r] -= dl; C1[r] -= dl; } \
        _Pragma("unroll") for (int r = 0; r < 16; ++r) negm[r] = -mhat; asm volatile("" : "+v"(negm)); \
        const float f = __builtin_amdgcn_exp2f(-dl); l_reg *= f; if (hi == 0) wsf[r32] = f; resc = true; } } \
    SBAR(); \
    GAPB(o[0] = __builtin_amdgcn_mfma_f32_32x32x16_bf16(PAF(0), VFR(0), o[0], 0, 0, 0), C0, 0); \
    GAPB(o[1] = __builtin_amdgcn_mfma_f32_32x32x16_bf16(PAF(0), VFR(4), o[1], 0, 0, 0), C0, 4); \
    KRD(GL, 0); GAPB(o[0] = __builtin_amdgcn_mfma_f32_32x32x16_bf16(PAF(1), VFR(1), o[0], 0, 0, 0), C0, 8); \
    KRD(GL, 1); GAPB(o[1] = __builtin_amdgcn_mfma_f32_32x32x16_bf16(PAF(1), VFR(5), o[1], 0, 0, 0), C0, 12); \
    KRD(GL, 2); GAPB(o[0] = __builtin_amdgcn_mfma_f32_32x32x16_bf16(PAF(2), VFR(2), o[0], 0, 0, 0), C1, 0); \
    KRD(GL, 3); GAPB(o[1] = __builtin_amdgcn_mfma_f32_32x32x16_bf16(PAF(2), VFR(6), o[1], 0, 0, 0), C1, 4); \
    GAPB(o[0] = __builtin_amdgcn_mfma_f32_32x32x16_bf16(PAF(3), VFR(3), o[0], 0, 0, 0), C1, 8); \
    GAPB(o[1] = __builtin_amdgcn_mfma_f32_32x32x16_bf16(PAF(3), VFR(7), o[1], 0, 0, 0), C1, 12); \
    } while (0)
    int t = 1;
#undef CMASK
#define CMASK(P0, P1, t) do {} while (0)
    for (; t + 5 < NT; t += 2) {
        STEP(pB0, pB1, pA0, pA1, t, true, true, true);     WAIT_BAR(2); RESC(); ROT();
        STEP(pA0, pA1, pB0, pB1, t + 1, true, true, true); WAIT_BAR(2); RESC(); ROT();
    }
#undef CMASK
#define CMASK(P0, P1, t) do { if (MASK) { int jb_ = (t) - (NT - 4); if (jb_ >= 0) cmask(P0, P1, jb_, wid); } } while (0)
#define ENDW(tt) do { if ((tt) + 3 < NT) { WAIT_BAR(2); } else if ((tt) + 2 < NT) { WAIT_BAR(1); } else { WAIT_BAR(0); } } while (0)
    for (; t + 1 < NT; t += 2) {
        STEP(pB0, pB1, pA0, pA1, t, (t + 3 < NT), (t + 1 < NT), (t + 1 < NT));       ENDW(t);     RESC(); ROT();
        STEP(pA0, pA1, pB0, pB1, t + 1, (t + 4 < NT), (t + 2 < NT), (t + 2 < NT));   ENDW(t + 1); RESC(); ROT();
    }
    STEP(pB0, pB1, pA0, pA1, NT - 1, false, false, false); RESC();
    { float sacc = pB0[0] + pB0[1]; _Pragma("unroll") for (int r = 2; r < 16; ++r) sacc += pB0[r]; _Pragma("unroll") for (int r = 0; r < 16; ++r) sacc += pB1[r]; l_reg += sacc;
      pw0 = (u32x4){PKW(pB0, 0), PKW(pB0, 2), PKW(pB0, 4), PKW(pB0, 6)}; pw1 = (u32x4){PKW(pB0, 8), PKW(pB0, 10), PKW(pB0, 12), PKW(pB0, 14)}; pw2 = (u32x4){PKW(pB1, 0), PKW(pB1, 2), PKW(pB1, 4), PKW(pB1, 6)}; pw3 = (u32x4){PKW(pB1, 8), PKW(pB1, 10), PKW(pB1, 12), PKW(pB1, 14)};
      SBAR(); pv(o, vb0 + sl_cur, PAF(0), PAF(1), PAF(2), PAF(3)); }
#undef PKW
#undef PAF
#undef VFR
#undef PIN
#undef MX3
#undef GAPA
#undef GAPB
#undef EX
#undef VRD
#undef KRD
#undef STEP
#undef ENDW
    { auto rr = __builtin_amdgcn_permlane32_swap(__float_as_uint(l_reg), __float_as_uint(l_reg), false, false); l_reg = __uint_as_float(rr[0]) + __uint_as_float(rr[1]); }
    if (hi == 0) wsf[32 + r32] = l_reg; asm volatile("s_waitcnt lgkmcnt(0)" ::: "memory");
    float rli[16];
#pragma unroll
    for (int r = 0; r < 16; ++r) rli[r] = __builtin_amdgcn_rcpf(wsf[32 + crow(r, hi)]);
    bf16* Ow = Oh + (long)(q0 + wid * QBLK) * op;
    { bf16* stg = (bf16*)(shm + LDS_OST) + wid * 2048;
#pragma unroll
      for (int r = 0; r < 16; ++r) { const int orow = crow(r, hi);
#pragma unroll
        for (int d0 = 0; d0 < 2; ++d0) stg[orow * 64 + d0 * 32 + r32] = __float2bfloat16(o[d0][r] * rli[r]); }
      asm volatile("s_waitcnt lgkmcnt(0)" ::: "memory");
#pragma unroll
      for (int i = 0; i < 4; ++i) { const int row = i * 8 + (lane >> 3), ch = lane & 7; const u32x4 v = *(const u32x4*)(stg + row * 64 + ch * 8); *(u32x4*)(Ow + (long)row * op + ch * 8) = v; } }
    asm volatile("s_waitcnt lgkmcnt(0)\n\ts_barrier" ::: "memory");
#undef DMA_K
#undef DMA_V
#undef CMASK
#undef START
#undef RESC
#undef ROT
}

constexpr int L2_K = 0, L2_V = 3 * 8192, L2_WS = L2_V + 4 * 16384, L2_OST = L2_WS + NW * 64 * 4, L2_BYTES = L2_OST + NW * 4096;
template <bool MASK> __device__ __forceinline__ void attn_unit2(int q0, int NT, const bf16* Qh, int qp, const bf16* __restrict__ Kh, int kp, const bf16* __restrict__ Vh, int vp, bf16* Oh, int op, char* shm) {
    const int tid = threadIdx.x, lane = tid & 63, r32 = lane & 31, hi = lane >> 5; const int wid = __builtin_amdgcn_readfirstlane(tid >> 6);
    const bf16* Qw = Qh + (long)(q0 + wid * QBLK) * qp;
    const unsigned lds0 = (unsigned)(uintptr_t)shm;
    float* wsf = (float*)(shm + L2_WS) + wid * 64;
    const bf16* ksrc = Kh + (long)lane * kp + wid * 8;
    const bf16* vsrc = Vh + (long)(16 * (wid & 3) + (lane >> 2)) * vp + (wid >> 2) * 32 + (lane & 3) * 8;
    const unsigned kdst = lds0 + L2_K + wid * 1024, vdst = lds0 + L2_V + wid * 1024;
#define DMA_K(t, slot) glds16(ksrc + (long)(t) * KVBLK * kp, (unsigned)__builtin_amdgcn_readfirstlane(kdst + (slot)))
#define DMA_V(t, vslot) do { glds16(vsrc + (long)(t) * KVBLK * vp, (unsigned)__builtin_amdgcn_readfirstlane(vdst + (vslot))); \
                            glds16(vsrc + (long)(t) * KVBLK * vp + 64, (unsigned)__builtin_amdgcn_readfirstlane(vdst + (vslot) + 8192)); } while (0)
    const int vb0 = (int)(lds0 + L2_V) + ((lane >> 4) & 1) * 32 + (lane & 3) * 8 + (4 * hi + ((lane & 15) >> 2)) * 64;
    const char* Kbase = shm + L2_K; bf16x8 kf[8];
    const lds_cptr shm3 = (lds_cptr)shm; const lds_cptr kp0 = shm3 + L2_K + hi * 1024 + r32 * 16; const lds_cptr vp0 = shm3 + L2_V + ((lane >> 4) & 1) * 32 + (lane & 3) * 8 + (4 * hi + ((lane & 15) >> 2)) * 64;
    DMA_K(0, 0); DMA_V(0, 0); DMA_K(1, SLOTB);
    bf16x8 qr[4];
#pragma unroll
    for (int d0 = 0; d0 < 4; ++d0) qr[d0] = *reinterpret_cast<const bf16x8*>(&Qw[(long)r32 * qp + d0 * 16 + hi * 8]);
    float l_reg = 0.f; f32x16 o[4]; o[0] = f32x16{}; o[1] = f32x16{}; o[2] = f32x16{}; o[3] = f32x16{};
    const f32x16 zero16 = f32x16{};
#define CMASK(P0, P1, t) do { if (MASK) { int jb_ = (t) - (NT - 4); if (jb_ >= 0) cmask(P0, P1, jb_, wid); } } while (0)
    f32x16 pA0, pA1, pB0, pB1;
    int sl_prev = 0, sl_cur = 0, sl_next = SLOTB;
    int vs_rd = 0, vs_wr = 3 * 16384;
#define ROT() do { sl_prev = sl_cur; sl_cur = sl_next; sl_next = (sl_next == (NSLOT - 1) * SLOTB) ? 0 : sl_next + SLOTB; vs_rd = (vs_rd + 16384) & 65535; vs_wr = (vs_wr + 16384) & 65535; } while (0)
    DMA_K(2, 2 * SLOTB); DMA_V(1, 16384);
    WAIT_BAR(6);
    qkt(pA0, pA1, Kbase, qr, zero16, r32, hi); CMASK(pA0, pA1, 0);
    _Pragma("unroll") for (int r = 0; r < 16; ++r) { pA0[r] = __builtin_amdgcn_exp2f(pA0[r]); pA1[r] = __builtin_amdgcn_exp2f(pA1[r]); }
    WAIT_BAR(2);
    DMA_K(3, 0); DMA_V(2, 2 * 16384);
    sl_prev = sl_cur; sl_cur = sl_next; sl_next = 2 * SLOTB;
    kload8(kf, kp0 + sl_cur);
    WAIT_BAR(5);
    s16x4 f0lo, f0hi, f1lo, f1hi, f2lo, f2hi, f3lo, f3hi; u32x4 pw0, pw1, pw2, pw3;
#define PKW(P, B) cvtpk_s(P[B], P[B + 1])
#define PAF(k) __builtin_bit_cast(bf16x8, pw##k)
#define PIN(x) asm volatile("" : "+v"(x))
#define EX(v) __builtin_amdgcn_exp2f(v)
#define VOFF(id) ((((id) >> 2) * 4096) + (((id) & 3) * 1024))
#define VRD2(F, id) do { F##lo = vtr(vp_ + VOFF(id)); F##hi = vtr(vp_ + VOFF(id) + 512); } while (0)
#define VFR2(F) (bf16x8){F##lo[0], F##lo[1], F##lo[2], F##lo[3], F##hi[0], F##hi[1], F##hi[2], F##hi[3]}
#define GAPA(MF, A0, A1, A2, A3, W0, W1, PW) do { MF; sacc += A0; sacc += A1; sacc += A2; sacc += A3; PIN(sacc); W0; W1; PIN(PW); SBAR(); } while (0)
#define GAPB(MF, RD, X, B) do { MF; RD; X[B] = EX(X[B]); X[B + 1] = EX(X[B + 1]); PIN(X); SBAR(); } while (0)
#define KRD(G, j) do { if (G) { kload2(kf, kp0 + sl_next, j); SBAR(); } } while (0)
#define MF32(a, b, c) __builtin_amdgcn_mfma_f32_32x32x16_bf16(a, b, c, 0, 0, 0)
#define STEP(C0, C1, P0, P1, t, GK, GV, GL) do { SBAR(); __builtin_amdgcn_s_setprio(ATTN_PRIO_A); \
    const lds_cptr vp_ = vp0 + vs_rd; \
    float sacc = (P0[0] + P0[1]); \
    GAPA(C0 = MF32(kf[0], qr[0], zero16), P0[2], P0[3], P0[4], P0[5],     pw0[0] = PKW(P0, 0), pw0[1] = PKW(P0, 2), pw0); \
    GAPA(C1 = MF32(kf[1], qr[0], zero16), P0[6], P0[7], P0[8], P0[9],     pw0[2] = PKW(P0, 4), pw0[3] = PKW(P0, 6), pw0); \
    GAPA(C0 = MF32(kf[2], qr[1], C0),     P0[10], P0[11], P0[12], P0[13], pw1[0] = PKW(P0, 8), pw1[1] = PKW(P0, 10), pw1); \
    GAPA(C1 = MF32(kf[3], qr[1], C1),     P0[14], P0[15], P1[0], P1[1],   pw1[2] = PKW(P0, 12), pw1[3] = PKW(P0, 14), pw1); \
    VRD2(f0, 0); SBAR();  GAPA(C0 = MF32(kf[4], qr[2], C0), P1[2], P1[3], P1[4], P1[5],     pw2[0] = PKW(P1, 0), pw2[1] = PKW(P1, 2), pw2); \
    VRD2(f1, 4); SBAR();  GAPA(C1 = MF32(kf[5], qr[2], C1), P1[6], P1[7], P1[8], P1[9],     pw2[2] = PKW(P1, 4), pw2[3] = PKW(P1, 6), pw2); \
    VRD2(f2, 8); SBAR();  GAPA(C0 = MF32(kf[6], qr[3], C0), P1[10], P1[11], P1[12], P1[13], pw3[0] = PKW(P1, 8), pw3[1] = PKW(P1, 10), pw3); \
    VRD2(f3, 12); SBAR(); GAPA(C1 = MF32(kf[7], qr[3], C1), P1[14], P1[15], 0.f, 0.f,       pw3[2] = PKW(P1, 12), pw3[3] = PKW(P1, 14), pw3); \
    l_reg += sacc; __builtin_amdgcn_s_setprio(0); \
    if (GK) { DMA_K((t) + 3, sl_cur); } if (GV) { DMA_V((t) + 2, vs_wr); } \
    CMASK(C0, C1, t); \
    SBAR(); __builtin_amdgcn_s_setprio(ATTN_PRIO_B); \
    GAPB(o[0] = MF32(PAF(0), VFR2(f0), o[0]), VRD2(f0, 1),  C0, 0); \
    GAPB(o[1] = MF32(PAF(0), VFR2(f1), o[1]), VRD2(f1, 5),  C0, 2); \
    GAPB(o[2] = MF32(PAF(0), VFR2(f2), o[2]), VRD2(f2, 9),  C0, 4); \
    GAPB(o[3] = MF32(PAF(0), VFR2(f3), o[3]), VRD2(f3, 13), C0, 6); \
    KRD(GL, 0); GAPB(o[0] = MF32(PAF(1), VFR2(f0), o[0]), VRD2(f0, 2),  C0, 8); \
    GAPB(o[1] = MF32(PAF(1), VFR2(f1), o[1]), VRD2(f1, 6),  C0, 10); \
    KRD(GL, 1); GAPB(o[2] = MF32(PAF(1), VFR2(f2), o[2]), VRD2(f2, 10), C0, 12); \
    GAPB(o[3] = MF32(PAF(1), VFR2(f3), o[3]), VRD2(f3, 14), C0, 14); \
    KRD(GL, 2); GAPB(o[0] = MF32(PAF(2), VFR2(f0), o[0]), VRD2(f0, 3),  C1, 0); \
    GAPB(o[1] = MF32(PAF(2), VFR2(f1), o[1]), VRD2(f1, 7),  C1, 2); \
    KRD(GL, 3); GAPB(o[2] = MF32(PAF(2), VFR2(f2), o[2]), VRD2(f2, 11), C1, 4); \
    GAPB(o[3] = MF32(PAF(2), VFR2(f3), o[3]), VRD2(f3, 15), C1, 6); \
    GAPB(o[0] = MF32(PAF(3), VFR2(f0), o[0]), (void)0, C1, 8); \
    GAPB(o[1] = MF32(PAF(3), VFR2(f1), o[1]), (void)0, C1, 10); \
    GAPB(o[2] = MF32(PAF(3), VFR2(f2), o[2]), (void)0, C1, 12); \
    GAPB(o[3] = MF32(PAF(3), VFR2(f3), o[3]), (void)0, C1, 14); __builtin_amdgcn_s_setprio(0); \
    } while (0)
    int t = 1;
#undef CMASK
#define CMASK(P0, P1, t) do {} while (0)
    for (; t + 5 < NT; t += 2) {
        STEP(pB0, pB1, pA0, pA1, t, true, true, true);     WAIT_BAR(5); ROT();
        STEP(pA0, pA1, pB0, pB1, t + 1, true, true, true); WAIT_BAR(5); ROT();
    }
#undef CMASK
#define CMASK(P0, P1, t) do { if (MASK) { int jb_ = (t) - (NT - 4); if (jb_ >= 0) cmask(P0, P1, jb_, wid); } } while (0)
#define ENDW(tt) do { if ((tt) + 3 < NT) { WAIT_BAR(5); } else if ((tt) + 2 < NT) { WAIT_BAR(4); } else { WAIT_BAR(0); } } while (0)
    for (; t + 1 < NT; t += 2) {
        STEP(pB0, pB1, pA0, pA1, t, (t + 3 < NT), (t + 2 < NT), (t + 1 < NT));       ENDW(t);     ROT();
        STEP(pA0, pA1, pB0, pB1, t + 1, (t + 4 < NT), (t + 3 < NT), (t + 2 < NT));   ENDW(t + 1); ROT();
    }
    STEP(pB0, pB1, pA0, pA1, NT - 1, false, false, false);
    { float sacc = pB0[0] + pB0[1]; _Pragma("unroll") for (int r = 2; r < 16; ++r) sacc += pB0[r]; _Pragma("unroll") for (int r = 0; r < 16; ++r) sacc += pB1[r]; l_reg += sacc;
      pw0 = (u32x4){PKW(pB0, 0), PKW(pB0, 2), PKW(pB0, 4), PKW(pB0, 6)}; pw1 = (u32x4){PKW(pB0, 8), PKW(pB0, 10), PKW(pB0, 12), PKW(pB0, 14)}; pw2 = (u32x4){PKW(pB1, 0), PKW(pB1, 2), PKW(pB1, 4), PKW(pB1, 6)}; pw3 = (u32x4){PKW(pB1, 8), PKW(pB1, 10), PKW(pB1, 12), PKW(pB1, 14)};
      SBAR();
      const lds_cptr vp_ = vp0 + ((vs_rd + 16384) & 65535);
#pragma unroll
      for (int db = 0; db < 4; ++db) { VRD2(f0, db * 4 + 0); VRD2(f1, db * 4 + 1); VRD2(f2, db * 4 + 2); VRD2(f3, db * 4 + 3);
          o[db] = MF32(PAF(0), VFR2(f0), o[db]); o[db] = MF32(PAF(1), VFR2(f1), o[db]); o[db] = MF32(PAF(2), VFR2(f2), o[db]); o[db] = MF32(PAF(3), VFR2(f3), o[db]); } }
#undef PKW
#undef PAF
#undef PIN
#undef EX
#undef VOFF
#undef VRD2
#undef VFR2
#undef GAPA
#undef GAPB
#undef KRD
#undef MF32
#undef STEP
#undef ENDW
    { auto rr = __builtin_amdgcn_permlane32_swap(__float_as_uint(l_reg), __float_as_uint(l_reg), false, false); l_reg = __uint_as_float(rr[0]) + __uint_as_float(rr[1]); }
    if (hi == 0) wsf[32 + r32] = l_reg; asm volatile("s_waitcnt lgkmcnt(0)" ::: "memory");
    float rli[16];
#pragma unroll
    for (int r = 0; r < 16; ++r) rli[r] = __builtin_amdgcn_rcpf(wsf[32 + crow(r, hi)]);
    bf16* Ow = Oh + (long)(q0 + wid * QBLK) * op;
    { bf16* stg = (bf16*)(shm + L2_OST) + wid * 2048;
#pragma unroll
      for (int dh = 0; dh < 2; ++dh) {
#pragma unroll
        for (int r = 0; r < 16; ++r) { const int orow = crow(r, hi);
#pragma unroll
          for (int d0 = 0; d0 < 2; ++d0) stg[orow * 64 + d0 * 32 + r32] = __float2bfloat16(o[dh * 2 + d0][r] * rli[r]); }
        asm volatile("s_waitcnt lgkmcnt(0)" ::: "memory");
#pragma unroll
        for (int i = 0; i < 4; ++i) { const int row = i * 8 + (lane >> 3), ch = lane & 7; const u32x4 v = *(const u32x4*)(stg + row * 64 + ch * 8); *(u32x4*)(Ow + (long)row * op + dh * 64 + ch * 8) = v; }
        asm volatile("s_waitcnt lgkmcnt(0)" ::: "memory"); } }
    asm volatile("s_waitcnt lgkmcnt(0)\n\ts_barrier" ::: "memory");
#undef DMA_K
#undef DMA_V
#undef CMASK
#undef ROT
}
#undef SBAR
#undef WAIT_BAR
}

#define XB_TMO      128
#define XB_XCNT(j)  (256  + 64 * (j))
#define XB_XSUB(j)  (1280 + 64 * (j))
#define XB_XGEN(j)  (2304 + 64 * (j))
#define XB_TOP      3328
#define XB_TOPGEN   3392
#define XCD_BAR_WORDS 3456
#define XB_SPIN_CAP (1u << 22)
__device__ __forceinline__ unsigned xb_ld(unsigned* p)              { return __hip_atomic_load(p, __ATOMIC_RELAXED, __HIP_MEMORY_SCOPE_AGENT); }
__device__ __forceinline__ unsigned xb_add(unsigned* p, unsigned v) { return __hip_atomic_fetch_add(p, v, __ATOMIC_RELAXED, __HIP_MEMORY_SCOPE_AGENT); }
__device__ __forceinline__ unsigned xb_xcc_id() { return (unsigned)__builtin_amdgcn_s_getreg((3 << 11) | 20) & 0xFu; }
#define XB_SPIN(cond, bar) do { unsigned _sp = 0; while (cond) { __builtin_amdgcn_s_sleep(1); \
    if ((++_sp & 255u) == 0u) { if (xb_ld(&(bar)[XB_TMO])) break; if (_sp > XB_SPIN_CAP) { atomicAdd(&(bar)[XB_TMO], 1u); break; } } } } while (0)
struct XcdBarrier { unsigned* bar; unsigned x; volatile LAS unsigned* st; };
__device__ __forceinline__ XcdBarrier xcd_barrier_post(unsigned* bar, volatile LAS unsigned* st) {
    XcdBarrier b; b.bar = bar; b.x = xb_xcc_id(); b.st = st;
    if (threadIdx.x == 0) (void)xb_add(&bar[XB_XCNT(b.x)], 1u);
    return b;
}
__device__ __forceinline__ void xcd_barrier_complete(unsigned* bar, unsigned x, unsigned& nloc, unsigned& nx) {
    const unsigned G = gridDim.x * gridDim.y * gridDim.z;
    unsigned sum, cnt, mine, sp = 0u;
    for (;;) {
        sum = 0u; cnt = 0u; mine = 0u;
#pragma unroll
        for (unsigned j = 0; j < 16; ++j) { const unsigned c = xb_ld(&bar[XB_XCNT(j)]); sum += c; cnt += (c > 0u) ? 1u : 0u; mine = (j == x) ? c : mine; }
        if (sum == G) break;
        __builtin_amdgcn_s_sleep(1);
        if ((++sp & 255u) == 0u) { if (xb_ld(&bar[XB_TMO])) break; if (sp > XB_SPIN_CAP) { atomicAdd(&bar[XB_TMO], 1u); break; } }
    }
    nloc = mine > 0u ? mine : 1u; nx = cnt > 0u ? cnt : 1u;
}
__device__ __forceinline__ void xcd_barrier(const XcdBarrier& b) {
    asm volatile("s_waitcnt vmcnt(0)" ::: "memory");
    __syncthreads();
    if (threadIdx.x == 0) {
        unsigned* bar = b.bar;
        __builtin_amdgcn_s_waitcnt(0);
        unsigned nloc = b.st[0], nx = b.st[1];
        if (nloc == 0u) { xcd_barrier_complete(bar, b.x, nloc, nx); b.st[0] = nloc; b.st[1] = nx; }
        const unsigned old = xb_add(&bar[XB_XSUB(b.x)], 1u);
        const unsigned gen = old / nloc;
        if (old + 1u == (gen + 1u) * nloc) {
            __builtin_amdgcn_fence(__ATOMIC_RELEASE, "agent");
            asm volatile("s_waitcnt vmcnt(0)" ::: "memory");
            const unsigned og = xb_add(&bar[XB_TOP], 1u);
            const unsigned tg = og / nx;
            if (og + 1u == (tg + 1u) * nx) xb_add(&bar[XB_TOPGEN], 1u);
            else XB_SPIN(xb_ld(&bar[XB_TOPGEN]) == tg, bar);
            __builtin_amdgcn_fence(__ATOMIC_ACQUIRE, "agent");
            xb_add(&bar[XB_XGEN(b.x)], 1u);
            asm volatile("s_waitcnt vmcnt(0)" ::: "memory");
        } else {
            XB_SPIN(xb_ld(&bar[XB_XGEN(b.x)]) == gen, bar);
            __builtin_amdgcn_fence(__ATOMIC_ACQUIRE, "agent");
            asm volatile("s_waitcnt vmcnt(0)" ::: "memory");
        }
    }
    __syncthreads();
}

constexpr int RING_BYTES = 131072;
constexpr int MISC_OFF = RING_BYTES;
constexpr int LDS_BYTES = 147456;
constexpr int NWAVES = 8;

struct Args {
    const float* in[29]; float* out; unsigned char* ws; int ph_lo, ph_hi;
};
enum { I_X = 0, I_MEM, I_NORM1, I_WIN, I_BGATE, I_QN, I_KN, I_LQ1, I_LK1, I_LQ2, I_LK2, I_SUBLN, I_WPOOL, I_PSCALE, I_MEMNORM, I_WMKV, I_MQN, I_MKN, I_WBRD, I_WBRP, I_WBRM, I_WOUT, I_NORM2,
       I_WROUTER, I_BROUTER, I_WGU, I_BGU, I_WD, I_BD };

__device__ __forceinline__ unsigned f2bf(float f) { unsigned u = __builtin_bit_cast(unsigned, f); return (u + 0x7fffu + ((u >> 16) & 1u)) >> 16; }
__device__ __forceinline__ unsigned pk2(float lo, float hi) { return f2bf(lo) | (f2bf(hi) << 16); }
__device__ __forceinline__ void p0_transpose_item(const float* W, int K, int N, bf16_t* WT, LAS float* scr, int item, int lane, int ldo = 0) {
    if (ldo == 0) ldo = K;
    const int nblk = N / 64, kb = item / nblk, nb = item % nblk, k0 = 64 * kb, n0 = 64 * nb;
    const int kr = lane >> 3, n4 = (lane & 7) * 4;
    f32x4 v[16];
#pragma unroll
    for (int i = 0; i < 16; ++i) v[i] = *(const f32x4*)(W + (size_t)(k0 + 8 * (i & 7) + kr) * N + n0 + 32 * (i >> 3) + n4);
#pragma unroll
    for (int h = 0; h < 2; ++h) {
#pragma unroll
        for (int i = 0; i < 8; ++i)
#pragma unroll
            for (int j = 0; j < 4; ++j) scr[(n4 + j) * 68 + 8 * i + kr] = v[h * 8 + i][j];
        LDS_WAIT(); asm volatile("" ::: "memory");
        const int c = lane & 7;
#pragma unroll
        for (int jj = 0; jj < 4; ++jj) { const int nrow = 8 * jj + (lane >> 3); const LAS f32x4* sp = (const LAS f32x4*)(scr + nrow * 68 + 8 * c);
            const f32x4 a = sp[0], b = sp[1];
            u32x4 o; o.x = pk2(a[0], a[1]); o.y = pk2(a[2], a[3]); o.z = pk2(b[0], b[1]); o.w = pk2(b[2], b[3]);
            *(u32x4*)(WT + (size_t)(n0 + 32 * h + nrow) * ldo + k0 + 8 * c) = o; }
        LDS_WAIT(); asm volatile("" ::: "memory");
    }
}
__device__ __forceinline__ void p0_transpose_item_f8(const float* W, int K, int N, unsigned char* WT, LAS float* scr, int item, int lane) {
    const int nblk = N / 64, kb = item / nblk, nb = item % nblk, k0 = 64 * kb, n0 = 64 * nb;
    const int kr = lane >> 3, n4 = (lane & 7) * 4;
    f32x4 v[16];
#pragma unroll
    for (int i = 0; i < 16; ++i) v[i] = *(const f32x4*)(W + (size_t)(k0 + 8 * (i & 7) + kr) * N + n0 + 32 * (i >> 3) + n4);
#pragma unroll
    for (int h = 0; h < 2; ++h) {
#pragma unroll
        for (int i = 0; i < 8; ++i)
#pragma unroll
            for (int j = 0; j < 4; ++j) scr[(n4 + j) * 68 + 8 * i + kr] = v[h * 8 + i][j];
        LDS_WAIT(); asm volatile("" ::: "memory");
        const int c = lane & 7;
#pragma unroll
        for (int jj = 0; jj < 4; ++jj) { const int nrow = 8 * jj + (lane >> 3); const LAS f32x4* sp = (const LAS f32x4*)(scr + nrow * 68 + 8 * c);
            const f32x4 a = sp[0] * W8_SCALE, b = sp[1] * W8_SCALE;
            u32x2 o; o.x = pk4_fp8(a[0], a[1], a[2], a[3]); o.y = pk4_fp8(b[0], b[1], b[2], b[3]);
            *(u32x2*)(WT + (size_t)(n0 + 32 * h + nrow) * K + k0 + 8 * c) = o; }
        LDS_WAIT(); asm volatile("" ::: "memory");
    }
}
__device__ __forceinline__ void rms_row_to_bf16(const float* xrow, const float* gain, bf16_t* orow, int lane) {
    const f32x4* xr = (const f32x4*)xrow + lane; const f32x4* gr = (const f32x4*)gain + lane;
    f32x4 v[4]; float s = 0.f;
#pragma unroll
    for (int j = 0; j < 4; ++j) { v[j] = xr[64 * j]; s += (v[j].x * v[j].x + v[j].y * v[j].y) + (v[j].z * v[j].z + v[j].w * v[j].w); }
    const float rstd = 1.f / sqrtf(wave_sum(s) * (1.f / 1024.f) + RMS_EPS);
    u32x2* o8 = (u32x2*)orow + lane;
#pragma unroll
    for (int j = 0; j < 4; ++j) { const f32x4 g = gr[64 * j]; u32x2 w; w.x = pk2(v[j].x * rstd * g.x, v[j].y * rstd * g.y); w.y = pk2(v[j].z * rstd * g.z, v[j].w * rstd * g.w); o8[64 * j] = w; }
}

__device__ __forceinline__ void cvt_item64_f8(const float* W, int K, int N, unsigned char* WT, int item, int lane) {
    const int nblk = N / 64, kb = item / nblk, nb = item % nblk, k0 = 64 * kb, n0 = 64 * nb;
    const char* base = (const char*)(W + (size_t)k0 * N + n0);
    unsigned off = (unsigned)lane * 4u; const unsigned rstep = (unsigned)N * 4u;
    float v[64];
#pragma unroll
    for (int j = 0; j < 64; ++j) { v[j] = __builtin_nontemporal_load((const float*)(base + off)); off += rstep; }
    unsigned char* dst = WT + (size_t)(n0 + lane) * K + k0;
#pragma unroll
    for (int c = 0; c < 4; ++c) { u32x4 o;
#pragma unroll
        for (int q = 0; q < 4; ++q) { int r = __builtin_amdgcn_cvt_pk_fp8_f32(v[16 * c + 4 * q] * W8_SCALE, v[16 * c + 4 * q + 1] * W8_SCALE, 0, false);
            r = __builtin_amdgcn_cvt_pk_fp8_f32(v[16 * c + 4 * q + 2] * W8_SCALE, v[16 * c + 4 * q + 3] * W8_SCALE, r, true); o[q] = (unsigned)r; }
        *(u32x4*)(dst + 16 * c) = o; }
}
struct CvtJob {
    const float* wgu; const float* wd; unsigned char* wgu_t; unsigned char* wd_t; int ngw, gw, lane;
    __device__ __forceinline__ void item(int j) const {
        const int it = gw + j * ngw; if (it >= 24576) return;
        const bool gu = it < 16384; const int r = gu ? it : it - 16384, e = gu ? (r >> 9) : (r >> 8), idx = gu ? (r & 511) : (r & 255), N = gu ? 2048 : 1024;
        const float* W = gu ? wgu + (size_t)e * 1024 * 2048 : wd + (size_t)e * 1024 * 1024; unsigned char* WT = gu ? wgu_t + (size_t)e * 2048 * 1024 : wd_t + (size_t)e * 1024 * 1024;
        cvt_item64_f8(W, 1024, N, WT, idx, lane);
    }
};
struct PostCvt { CvtJob J; int jbase, jend; __device__ __forceinline__ void operator()(int ui) const { const int j = jbase + ui; if (j < jend) J.item(j); } };
struct Args;
typedef __attribute__((address_space(4))) const Args* kargs_t;
__device__ __forceinline__ kargs_t kargs() { kargs_t p = (kargs_t)__builtin_amdgcn_kernarg_segment_ptr(); asm volatile("" : "+s"(p)); return p; }
__global__ void __launch_bounds__(NWAVES * 64, 2) fwd_kernel(Args args) {
    extern __shared__ __attribute__((aligned(16))) unsigned char lds_raw[];
    cg::grid_group grid = cg::this_grid();
    LAS unsigned char* lds = (LAS unsigned char*)lds_raw;
    const int tid = threadIdx.x, lane = tid & 63, wave = __builtin_amdgcn_readfirstlane(tid >> 6);
    const int G = gridDim.x, bx = blockIdx.x; const int vcu = (G % 8 == 0) ? (bx % 8) * (G / 8) + bx / 8 : bx;
    const int gw = vcu * NWAVES + wave, NGW = G * NWAVES;
    const int lo = args.ph_lo, hi = args.ph_hi;
    if (tid < 64) ((LAS unsigned*)(lds + MISC_OFF + 1024))[tid] = 0u;
    __syncthreads();
    const XcdBarrier xbar = xcd_barrier_post((unsigned*)(args.ws + WS_CTL) + CW_BAR, (volatile LAS unsigned*)(lds + MISC_OFF + 1024));
#ifndef PHMASK
#define PHMASK 0x3ff
#endif
#define IN(k) (((PHMASK >> (k)) & 1) && lo <= (k) && (k) < hi)
#define GSYNC() do { asm volatile("s_waitcnt vmcnt(0) lgkmcnt(0)" ::: "memory"); __syncthreads(); grid.sync(); asm volatile("s_waitcnt vmcnt(0)" ::: "memory"); __syncthreads(); } while (0)
#define SEAM(k) do { if (lo <= (k) && (k) + 1 < hi) { xcd_barrier(xbar); } } while (0)
#define WSP(TY, off) ((TY*)(ka->ws + (off)))
#define WIN_T WSP(bf16_t, WS_WIN_T)
#define WBRD_T WSP(bf16_t, WS_WBRD_T)
#define WBRP_T WSP(bf16_t, WS_WBRP_T)
#define WBRM_T WSP(bf16_t, WS_WBRM_T)
#define WOUT_T WSP(bf16_t, WS_WOUT_T)
#define WMKV_T WSP(bf16_t, WS_WMKV_T)
#define WGU_T WSP(bf16_t, WS_WGU_T)
#define WD_T WSP(bf16_t, WS_WD_T)
#define XN WSP(bf16_t, WS_XN)
#define Qb WSP(bf16_t, WS_Q)
#define Kb WSP(bf16_t, WS_K)
#define Vb WSP(bf16_t, WS_V)
#define Ub WSP(bf16_t, WS_U)
#define MQb WSP(bf16_t, WS_MQ)
#define OC WSP(bf16_t, WS_OC)
#define GATES WSP(bf16_t, WS_GATES)
#define YCAT WSP(bf16_t, WS_YCAT)
#define MERGF WSP(float, WS_MERGF)
#define MERGB WSP(bf16_t, WS_MERGB)
#define XG WSP(bf16_t, WS_XG)
#define ACT WSP(bf16_t, WS_A)
#define Y4 WSP(bf16_t, WS_B)
#define MEMN WSP(bf16_t, WS_MEMN)
#define MKV WSP(bf16_t, WS_MKV)
#define ROPE WSP(f32x2, WS_ROPE)
#define WR2 WSP(float, WS_WR2)
#define ROUTEW WSP(float, WS_ROUTEW)
#define LAMP WSP(float, WS_LAM)
#define LIST WSP(u32x2, WS_LIST)
#define CNT WSP(unsigned, WS_CTL)
#define OUT (ka->out)
#define KA const kargs_t ka = kargs()

    if (lo > 1000) GSYNC();
    if (IN(0)) for (int rep_ = 0; rep_ < 1 + ((REPEAT_MASK >> 0) & 1); ++rep_) { KA; if (rep_) __syncthreads();
        LAS float* scr = (LAS float*)(lds + wave * 16384);
        constexpr int I0 = 16 * 80, I1 = 8 * 16, I2 = 4 * 16, I3 = 4 * 16, I4 = 16 * 16, I5 = 16 * 8, I6 = 0, I7 = 0;
        constexpr int NITEMS = I0 + I1 + I2 + I3 + I4 + I5 + I6 + I7;
        for (int it = gw; it < NITEMS; it += NGW) {
            int r = it;
            if (r < I0) { p0_transpose_item(ka->in[I_WIN], 1024, 5120, WIN_T, scr, r, lane); continue; } r -= I0;
            if (r < I1) { p0_transpose_item(ka->in[I_WBRD], 512, 1024, WBRD_T, scr, r, lane, 1024); continue; } r -= I1;
            if (r < I2) { p0_transpose_item(ka->in[I_WBRP], 256, 1024, WBRD_T + 512, scr, r, lane, 1024); continue; } r -= I2;
            if (r < I3) { p0_transpose_item(ka->in[I_WBRM], 256, 1024, WBRD_T + 768, scr, r, lane, 1024); continue; } r -= I3;
            if (r < I4) { p0_transpose_item(ka->in[I_WOUT], 1024, 1024, WOUT_T, scr, r, lane); continue; } r -= I4;
            p0_transpose_item(ka->in[I_WMKV], 1024, 512, WMKV_T, scr, r, lane);
        }
        for (int m = gw; m < T; m += NGW) rms_row_to_bf16(ka->in[I_X] + (size_t)m * 1024, ka->in[I_NORM1], XN + (size_t)m * 1024, lane);
        for (int m = gw; m < BATCH * MEMLEN; m += NGW) rms_row_to_bf16(ka->in[I_MEM] + (size_t)m * 1024, ka->in[I_MEMNORM], MEMN + (size_t)m * 1024, lane);
        for (int i = bx * 512 + tid; i < SEQ * 32; i += G * 512) { const int pos = i >> 5, j = i & 31;
            const float inv = 1.0f / powf(10000.0f, (float)(2 * j) / 64.0f); const float ang = (float)pos * inv;
            const double a = (double)ang; const double k = rint(a * 0.15915494309189535); const float red = (float)(a - k * 6.283185307179586);
            ROPE[i] = (f32x2){cosf(red), sinf(red)}; }
        for (int i = bx * 512 + tid; i < 1024 * 32; i += G * 512) { const int ii = i & 3, e = (i >> 2) & 15, kq = (i >> 6) & 3, eb = (i >> 8) & 1, s = i >> 9; const int k = 16 * s + 4 * kq + ii;
            WR2[i] = ka->in[I_NORM2][k] * ka->in[I_WROUTER][k * 32 + eb * 16 + e]; }
        if (bx == 0 && wave == 0) { const float s1 = wave_sum(ka->in[I_LQ1][lane] * ka->in[I_LK1][lane]), s2 = wave_sum(ka->in[I_LQ2][lane] * ka->in[I_LK2][lane]);
            if (lane == 0) LAMP[0] = expf(s1) - expf(s2) + 0.2f; }
    }
    SEAM(0);
    if (IN(1)) for (int rep_ = 0; rep_ < 1 + ((REPEAT_MASK >> 1) & 1); ++rep_) { KA; if (rep_) __syncthreads();
#if defined(TAP) && TAP == 6
        { pg8::DenseProb P{XN, WIN_T, 1024, 1024, 1024}; pg8::StaticOrder S; S.init(T, INW, G, bx);
          pg8::EpiPlain E{WSP(bf16_t, WS_B), 5120};
          pg8::gemm_phase<pg8::EpiPlain, pg8::DenseProb, pg8::StaticOrder, true>(lds, P, S, E); }
#else
        const CvtJob J{ka->in[I_WGU], ka->in[I_WD], (unsigned char*)WGU_T, (unsigned char*)WD_T, NGW, gw, lane};
        const int kpre = bx & 7;
        for (int j = 0; j < kpre; ++j) J.item(j);
        { pg8::DenseProb P{XN, WIN_T, 1024, 1024, 1024}; pg8::StaticOrder S0; S0.init(T, INW, G, bx); const pg8::TableOrder S = pg8::build_unit_table(S0, (LAS int*)(lds + MISC_OFF + 2048));
          pg8::EpiInProj E{Qb, Kb, Vb, Ub, MQb, GATES, ka->in[I_QN], ka->in[I_KN], ka->in[I_MQN], ka->in[I_BGATE], ROPE};
          const PostCvt PU{J, kpre, 12};
          pg8::gemm_phase<pg8::EpiInProj, pg8::DenseProb, pg8::TableOrder, ALIGN_EPI_SEL, PostCvt>(lds, P, S, E, PU); }
        for (int j = kpre + 10; j < 12; ++j) J.item(j);
#endif
        { pg8::DenseProb P{MEMN, WMKV_T, 1024, 1024, 1024}; pg8::StaticOrder S; S.init(BATCH * MEMLEN, 512, G, bx);
          pg8::EpiMemKV E{MKV, ka->in[I_MKN]};
          pg8::gemm_phase<pg8::EpiMemKV, pg8::DenseProb, pg8::StaticOrder, true>(lds, P, S, E); }
    }
    SEAM(1);
    if (IN(2)) for (int rep_ = 0; rep_ < 1 + ((REPEAT_MASK >> 2) & 1); ++rep_) { KA; if (rep_) __syncthreads();
        using abf = attn_body::bf16;
        {
            const int bh = vcu >> 4, b = bh >> 2, h = bh & 3, s = vcu & 15; const size_t rb = (size_t)b * SEQ;
            const float lam = LAMP[0];
            for (int i2 = 0; i2 < 4 * (1 + ((REPEAT_MASK >> 10) & 1)); ++i2) { const int ii = i2 & 3, c = ii & 1; const int qb = (ii < 2) ? s : 31 - s;
                attn_body::attn_unit2<true>(qb * 256, 4 * qb + 4, (const abf*)Qb + rb * 512 + (c * 4 + h) * 64, 512, (const abf*)Kb + rb * 512 + (c * 4 + h) * 64, 512,
                                            (const abf*)Vb + rb * 512 + h * 128, 512, (abf*)OC + rb * 1024 + (c * 4 + h) * 128, 1024, (char*)lds_raw);
                if (c == 1) {
                    asm volatile("s_waitcnt vmcnt(0)" ::: "memory");
#pragma unroll 1
                    for (int ps = 0; ps < 2; ++ps) {
                    const int row = ps * 16 + (lane >> 2), dq = (lane & 3) * 32; const size_t t = rb + (size_t)qb * 256 + wave * 32 + row;
                    const bf16_t* p0 = OC + t * 1024 + h * 128 + dq; const bf16_t* p1 = p0 + 512;
                    u32x4 a[4], bb[4];
#pragma unroll
                    for (int j = 0; j < 4; ++j) { a[j] = *(const u32x4*)(p0 + 8 * j); bb[j] = *(const u32x4*)(p1 + 8 * j); }
                    float ss = 0.f; f32x4 y[4][2];
#pragma unroll
                    for (int j = 0; j < 4; ++j) {
                        y[j][0] = (f32x4){bf_lo(a[j].x) - lam * bf_lo(bb[j].x), bf_hi(a[j].x) - lam * bf_hi(bb[j].x), bf_lo(a[j].y) - lam * bf_lo(bb[j].y), bf_hi(a[j].y) - lam * bf_hi(bb[j].y)};
                        y[j][1] = (f32x4){bf_lo(a[j].z) - lam * bf_lo(bb[j].z), bf_hi(a[j].z) - lam * bf_hi(bb[j].z), bf_lo(a[j].w) - lam * bf_lo(bb[j].w), bf_hi(a[j].w) - lam * bf_hi(bb[j].w)};
#pragma unroll
                        for (int q = 0; q < 4; ++q) ss += y[j][0][q] * y[j][0][q] + y[j][1][q] * y[j][1][q]; }
                    ss += __shfl_xor(ss, 1); ss += __shfl_xor(ss, 2);
                    const float rstd = 0.8f / sqrtf(ss * (1.0f / 128.0f) + RMS_EPS);
                    const float* sg = ka->in[I_SUBLN] + dq; bf16_t* yo = YCAT + t * 1024 + h * 128 + dq;
#pragma unroll
                    for (int j = 0; j < 4; ++j) { const f32x4 s0 = *(const f32x4*)(sg + 8 * j), s1 = *(const f32x4*)(sg + 8 * j + 4); pg8::store8(yo + 8 * j, y[j][0] * rstd * s0, y[j][1] * rstd * s1); }
                    }
                }
            }
        }
        {
            for (int i = 0; i < 2; ++i) { const int idx = vcu * 2 + i; if (idx >= 512) break; const int b = idx >> 7, h = (idx >> 5) & 3, qb = idx & 31;
                attn_body::attn_unit<8, false>(qb * 256, 4, (const abf*)MQb + (size_t)b * SEQ * 256 + h * 64, 256, (const abf*)MKV + (size_t)b * MEMLEN * 512 + h * 64, 512,
                                               (const abf*)MKV + (size_t)b * MEMLEN * 512 + 256 + h * 64, 512, (abf*)YCAT + (size_t)b * SEQ * 1024 + 768 + h * 64, 1024, (char*)lds_raw); }
        }
        {
            LAS bf16_t* ul = (LAS bf16_t*)lds;
            LAS bf16_t* pb = (LAS bf16_t*)(lds + 24576);
            const int col = tid & 255, half = tid >> 8, w = 2 << (col >> 6);
            const int mg = wave & 3, mdh = wave >> 2, r32 = lane & 31, hh = lane >> 5;
            bf16x8 bw[4];
#pragma unroll
            for (int sx = 0; sx < 4; ++sx) { const float* wp = ka->in[I_WPOOL] + (size_t)(mg * 64 + 16 * sx + 8 * hh) * 64 + mdh * 32 + r32;
                u32x4 pk; pk.x = pk2(wp[0], wp[64]); pk.y = pk2(wp[128], wp[192]); pk.z = pk2(wp[256], wp[320]); pk.w = pk2(wp[384], wp[448]); bw[sx] = __builtin_bit_cast(bf16x8, pk); }
            const int ocol = mg * 64 + mdh * 32 + r32; const float psc = ka->in[I_PSCALE][ocol];
            for (int tile = vcu; tile < T / 32; tile += G) {
                const int t0 = tile * 32, p0 = t0 & (SEQ - 1);
                __syncthreads();
                for (int pc = tid; pc < 47 * 32; pc += 512) { const int r = pc >> 5, ch = pc & 31; const int pos = p0 - 15 + r;
                    u32x4 v = {0u, 0u, 0u, 0u}; if (pos >= 0) v = *(const u32x4*)(Ub + (size_t)(t0 - 15 + r) * 256 + ch * 8);
                    *(LAS u32x4*)(ul + r * 256 + ch * 8) = v; }
                __syncthreads();
                {
                    float sum = 0.f; const int rbase = 15 + 16 * half;
                    for (int i = 1; i < w; ++i) sum += __uint_as_float((unsigned)ul[(rbase - i) * 256 + col] << 16);
#pragma unroll
                    for (int tk = 0; tk < 16; ++tk) { const float ucur = __uint_as_float((unsigned)ul[(rbase + tk) * 256 + col] << 16); sum += ucur;
                        const int pos = p0 + 16 * half + tk; const float cnt = (float)((pos + 1 < w) ? pos + 1 : w);
                        pb[(16 * half + tk) * 264 + col] = (bf16_t)f2bf(sum / cnt - ucur);
                        sum -= __uint_as_float((unsigned)ul[(rbase + tk - (w - 1)) * 256 + col] << 16); }
                }
                __syncthreads();
                f32x16 acc = f32x16{};
#pragma unroll
                for (int sx = 0; sx < 4; ++sx) { const bf16x8 af = *(const LAS bf16x8*)(pb + r32 * 264 + mg * 64 + 16 * sx + 8 * hh);
                    acc = __builtin_amdgcn_mfma_f32_32x32x16_bf16(af, bw[sx], acc, 0, 0, 0); }
#pragma unroll
                for (int r = 0; r < 16; ++r) { const int tok = t0 + (r & 3) + 8 * (r >> 2) + 4 * hh; YCAT[(size_t)tok * 1024 + 512 + ocol] = (bf16_t)f2bf(acc[r] * psc); }
            }
            __syncthreads();
        }
    }
    SEAM(2);
    if (IN(4)) for (int rep_ = 0; rep_ < 1 + ((REPEAT_MASK >> 4) & 1); ++rep_) { KA; if (rep_) __syncthreads();
        pg8::StaticOrder S0; S0.init(T, 1024, G, bx); const pg8::TableOrder S = pg8::build_unit_table(S0, (LAS int*)(lds + MISC_OFF + 2048));
        pg8::DenseProb P{YCAT, WBRD_T, 1024, 1024, 1024}; pg8::EpiMergeR E{GATES, MERGB};
        pg8::gemm_phase<pg8::EpiMergeR, pg8::DenseProb, pg8::TableOrder, ALIGN_EPI_SEL>(lds, P, S, E);
    }
    SEAM(4);
    if (IN(5)) for (int rep_ = 0; rep_ < 1 + ((REPEAT_MASK >> 5) & 1); ++rep_) { KA; if (rep_) __syncthreads();
        pg8::DenseProb P{MERGB, WOUT_T, 1024, 1024, 1024}; pg8::StaticOrder S0; S0.init(T, 1024, G, bx); const pg8::TableOrder S = pg8::build_unit_table(S0, (LAS int*)(lds + MISC_OFF + 2048));
        pg8::EpiWout E{ka->in[I_X], OUT, (unsigned char*)XG, ka->in[I_NORM2]};
        pg8::gemm_phase<pg8::EpiWout, pg8::DenseProb, pg8::TableOrder, ALIGN_EPI_SEL>(lds, P, S, E);
    }
    SEAM(5);
    if (IN(6)) { KA;
        LAS int* lcnt = (LAS int*)(lds + MISC_OFF); LAS int* lbase = lcnt + 32;
        const int ngroups = T / 16, rounds = (ngroups + NGW - 1) / NGW;
        for (int rd = 0; rd < rounds; ++rd) {
            const int grp = rd * NGW + gw; const bool valid = grp < ngroups;
            if (tid < 32) lcnt[tid] = 0;
            __syncthreads();
            int e_sel = 0, rank = 0; float w_sel = 0.f, rstd = 0.f; const int q = lane >> 4, tok = grp * 16 + (lane & 15);
            if (valid) {
                f32x4 d0 = {0.f, 0.f, 0.f, 0.f}, d1 = {0.f, 0.f, 0.f, 0.f}; float ss = 0.f;
                const float* xrow = OUT + (size_t)tok * 1024 + 4 * q; const f32x4* wr2 = (const f32x4*)WR2 + lane;
#pragma unroll 4
                for (int s = 0; s < 64; ++s) { const f32x4 xv = *(const f32x4*)(xrow + 16 * s); const f32x4 wa = wr2[(s * 2) * 64], wb = wr2[(s * 2 + 1) * 64];
                    ss += (xv[0] * xv[0] + xv[1] * xv[1]) + (xv[2] * xv[2] + xv[3] * xv[3]);
#pragma unroll
                    for (int j = 0; j < 4; ++j) { d0 = __builtin_amdgcn_mfma_f32_16x16x4f32(wa[j], xv[j], d0, 0, 0, 0); d1 = __builtin_amdgcn_mfma_f32_16x16x4f32(wb[j], xv[j], d1, 0, 0, 0); } }
                ss += __shfl_xor(ss, 16); ss += __shfl_xor(ss, 32);
                rstd = 1.0f / sqrtf(ss * (1.0f / 1024.f) + RMS_EPS);
                unsigned key[8];
#pragma unroll
                for (int r = 0; r < 8; ++r) { const int e = (r >> 2) * 16 + 4 * q + (r & 3); const float lg = ((r < 4) ? d0[r & 3] : d1[r & 3]) * rstd + ka->in[I_BROUTER][e];
                    unsigned u = __float_as_uint(lg); u ^= (u >> 31) ? 0xffffffffu : 0x80000000u; key[r] = (u & ~31u) | (unsigned)(31 - e); }
                unsigned win[4];
#pragma unroll
                for (int r = 0; r < 4; ++r) { unsigned m = key[0];
#pragma unroll
                    for (int j = 1; j < 8; ++j) m = m > key[j] ? m : key[j];
                    unsigned o = (unsigned)__shfl_xor((int)m, 16); m = m > o ? m : o; o = (unsigned)__shfl_xor((int)m, 32); m = m > o ? m : o; win[r] = m;
#pragma unroll
                    for (int j = 0; j < 8; ++j) key[j] = (key[j] == m) ? 0u : key[j]; }
                float val[4];
#pragma unroll
                for (int r = 0; r < 4; ++r) { unsigned u = win[r] & ~31u; u ^= (u >> 31) ? 0x80000000u : 0xffffffffu; val[r] = __uint_as_float(u); }
                const float p1 = expf(val[1] - val[0]), p2 = expf(val[2] - val[0]), p3 = expf(val[3] - val[0]); const float inv = 1.0f / (1.0f + p1 + p2 + p3);
                const unsigned wk = (q == 0) ? win[0] : (q == 1) ? win[1] : (q == 2) ? win[2] : win[3];
                w_sel = ((q == 0) ? 1.0f : (q == 1) ? p1 : (q == 2) ? p2 : p3) * inv; e_sel = 31 - (int)(wk & 31u);
                rank = __hip_atomic_fetch_add((int*)(lcnt + e_sel), 1, __ATOMIC_RELAXED, __HIP_MEMORY_SCOPE_WORKGROUP);
            }
            __syncthreads();
            if (tid < 32) lbase[tid] = (int)__hip_atomic_fetch_add(CNT + 64 * tid, (unsigned)lcnt[tid], __ATOMIC_RELAXED, __HIP_MEMORY_SCOPE_AGENT);
            __syncthreads();
            if (valid) { const int pos = lbase[e_sel] + rank; LIST[(size_t)e_sel * CAP + pos] = (u32x2){(unsigned)(tok * 4 + q), __float_as_uint(rstd)}; ROUTEW[tok * 4 + q] = w_sel; }
            __syncthreads();
        }
    }
    SEAM(6);
    if (IN(7) || IN(8)) { KA;
        LAS int* tp = (LAS int*)(lds + MISC_OFF + 256); LAS int* cn = tp + 40;
        if (tid < 64) {
            const int e = tid & 31; const int c = (int)__hip_atomic_load(CNT + 64 * e, __ATOMIC_RELAXED, __HIP_MEMORY_SCOPE_AGENT); const int tiles = (c + 255) >> 8; int x = tiles;
#pragma unroll
            for (int o = 1; o < 32; o <<= 1) { const int y = __shfl_up(x, o, 32); if (e >= o) x += y; }
            if (tid < 32) { cn[e] = c; tp[e] = x - tiles; if (e == 31) tp[NEXP] = x; } }
        __syncthreads();
        if (IN(7)) for (int rep_ = 0; rep_ < 1 + ((REPEAT_MASK >> 7) & 1); ++rep_) {
            pg8::GuProb P{(const unsigned char*)XG, (const unsigned char*)WGU_T, LIST, 1024, 1024, 1024}; pg8::GroupedOrder S0{tp, cn, 8, G, bx}; const pg8::TableOrder S = pg8::build_unit_table(S0, (LAS int*)(lds + MISC_OFF + 2048));
            pg8::EpiSwiglu E{(unsigned char*)ACT, LIST, ka->in[I_BGU], lds + MISC_OFF + 4096};
            pg8::gemm_phase<pg8::EpiSwiglu, pg8::GuProb, pg8::TableOrder, ALIGN_EPI_SEL>(lds, P, S, E);
        }
        SEAM(7);
        if (IN(8)) for (int rep_ = 0; rep_ < 1 + ((REPEAT_MASK >> 8) & 1); ++rep_) {
            pg8::DownProb P{(const unsigned char*)ACT, (const unsigned char*)WD_T, 1024, 1024, 1024}; pg8::GroupedOrder S0{tp, cn, 4, G, bx}; const pg8::TableOrder S = pg8::build_unit_table(S0, (LAS int*)(lds + MISC_OFF + 2048));
            pg8::EpiDown E{(unsigned char*)Y4, LIST, ka->in[I_BD], lds + MISC_OFF + 4096};
            pg8::gemm_phase<pg8::EpiDown, pg8::DownProb, pg8::TableOrder, ALIGN_EPI_SEL>(lds, P, S, E);
        }
    }
    SEAM(8);
    if (IN(9)) { KA;
        for (int i = bx * 512 + tid; i < T * 128; i += G * 512) { const int tok = i >> 7, c8 = (i & 127) * 8;
            const f32x4 w = *(const f32x4*)(ROUTEW + tok * 4); float* op = OUT + (size_t)tok * 1024 + c8;
            f32x4 o0 = *(const f32x4*)op, o1 = *(const f32x4*)(op + 4);
#pragma unroll
            for (int k = 0; k < 4; ++k) { const u32x2 y = *(const u32x2*)((const unsigned char*)Y4 + ((size_t)tok * 4 + k) * 1024 + c8); const float wk = w[k] * (1.0f / Y8_SCALE);
                const f32x2 p0 = __builtin_amdgcn_cvt_pk_f32_fp8((int)y.x, false), p1 = __builtin_amdgcn_cvt_pk_f32_fp8((int)y.x, true), p2 = __builtin_amdgcn_cvt_pk_f32_fp8((int)y.y, false), p3 = __builtin_amdgcn_cvt_pk_f32_fp8((int)y.y, true);
                o0[0] += wk * p0[0]; o0[1] += wk * p0[1]; o0[2] += wk * p1[0]; o0[3] += wk * p1[1];
                o1[0] += wk * p2[0]; o1[1] += wk * p2[1]; o1[2] += wk * p3[0]; o1[3] += wk * p3[1]; }
            *(f32x4*)op = o0; *(f32x4*)(op + 4) = o1; }
    }
#ifdef TAP
    if (lo <= 10 && 10 < hi) { KA; GSYNC();
        for (int i = bx * 512 + tid; i < T * 1024; i += G * 512) { const int t = i >> 10, c = i & 1023; float v = 0.f;
#define BFV(buf, pitch, col) __uint_as_float((unsigned)(buf)[(size_t)t * (pitch) + (col)] << 16)
            if (TAP == 1) v = BFV(Qb, 512, c & 511) + 2.f * BFV(Kb, 512, c & 511) + 4.f * BFV(Vb, 512, c & 511) + 8.f * BFV(Ub, 256, c & 255) + 16.f * BFV(MQb, 256, c & 255)
                            + 32.f * BFV(GATES, 3072, c) + 64.f * BFV(GATES, 3072, 1024 + c) + 128.f * BFV(GATES, 3072, 2048 + c);
            if (TAP == 2) v = BFV(OC, 1024, c) + 2.f * BFV(YCAT, 1024, c);
            if (TAP == 3) v = BFV(MERGB, 1024, c);
            if (TAP == 4) v = BFV(XN, 1024, c);
            if (TAP == 6) { const bf16_t* z = WSP(bf16_t, WS_B) + (size_t)t * 5120 + c; v = __uint_as_float((unsigned)z[0] << 16) + 2.f * __uint_as_float((unsigned)z[1024] << 16) + 4.f * __uint_as_float((unsigned)z[2048] << 16) + 8.f * __uint_as_float((unsigned)z[3072] << 16) + 16.f * __uint_as_float((unsigned)z[4096] << 16); }
            if (TAP == 5) { const bf16_t* wt = WIN_T; const int tt = t % 5120; v = __uint_as_float((unsigned)wt[(size_t)tt * 1024 + c] << 16) + ROPE[(t & 8191) * 32 + (c & 31)].x + 2.f * ROPE[(t & 8191) * 32 + (c & 31)].y; }
            OUT[i] = v; }
    }
#endif
#undef IN
#undef SEAM
}

extern "C" void kernel_launch(void* const* d_in, const int* in_sizes, int n_in, void* d_out, int out_size, void* d_ws, size_t ws_size, hipStream_t stream) {
    static int grid = 0;
    if (grid == 0) {
        if (n_in != 29 || in_sizes[0] != T * DMODEL || out_size != T * DMODEL || ws_size < WS_END) {
            fprintf(stderr, "kernel_launch: unexpected shapes: n_in %d in0 %d out %d ws %zu (need %zu)\n", n_in, n_in > 0 ? in_sizes[0] : -1, out_size, ws_size, (size_t)WS_END); grid = -1; return; }
        int dev = 0, cus = 0, per_cu = 0;
        (void)hipGetDevice(&dev); (void)hipDeviceGetAttribute(&cus, hipDeviceAttributeMultiprocessorCount, dev);
        (void)hipFuncSetAttribute((const void*)fwd_kernel, hipFuncAttributeMaxDynamicSharedMemorySize, LDS_BYTES);
        (void)hipOccupancyMaxActiveBlocksPerMultiprocessor(&per_cu, (const void*)fwd_kernel, NWAVES * 64, LDS_BYTES);
        (void)hipGetLastError();
        grid = cus;
        fprintf(stderr, "kernel_launch: cus %d occupancy %d/CU grid %d\n", cus, per_cu, grid);
        if (per_cu < 1) fprintf(stderr, "kernel_launch: occupancy query says the kernel does not fit\n");
    }
    if (grid < 0) return;
    (void)hipMemsetAsync((char*)d_ws + WS_CTL, 0, CTL_ZERO_BYTES, stream);
    Args a{};
    for (int i = 0; i < 29; ++i) a.in[i] = (const float*)d_in[i];
    a.out = (float*)d_out; a.ws = (unsigned char*)d_ws; a.ph_lo = 0; a.ph_hi = PH_HI;
    void* args[] = {&a};
    hipError_t e = hipLaunchCooperativeKernel((const void*)fwd_kernel, dim3(grid), dim3(NWAVES * 64), args, LDS_BYTES, stream);
    if (e != hipSuccess) fprintf(stderr, "cooperative launch failed: %s (grid %d)\n", hipGetErrorString(e), grid);
}
```

```cpp
#include <hip/hip_runtime.h>
#include <hip/hip_cooperative_groups.h>
#include <hip/hip_bf16.h>
#include <cstdio>
#include <cstdint>
#include <cmath>
namespace cg = cooperative_groups;

#define LAS __attribute__((address_space(3)))
#define GAS __attribute__((address_space(1)))
typedef unsigned short bf16_t;
typedef short bf16x8 __attribute__((ext_vector_type(8)));
typedef float f32x4 __attribute__((ext_vector_type(4)));
typedef float f32x2 __attribute__((ext_vector_type(2)));
typedef float f32x16 __attribute__((ext_vector_type(16)));
typedef unsigned u32x4 __attribute__((ext_vector_type(4)));
typedef unsigned u32x2 __attribute__((ext_vector_type(2)));

#define PH_HI 10
#define ALIGN_EPI_SEL true
#define F8MODE 2
#define USE_SETPRIO 1
#define ATTN_PRIO_A 1
#define ATTN_PRIO_B 1
#ifndef PHMASK
#define PHMASK 0x3ff
#endif
#define REPEAT_MASK 0x000
constexpr int BATCH = 4, SEQ = 8192, DMODEL = 1024, T = BATCH * SEQ, INW = 5120, NEXP = 32, MEMLEN = 256;
constexpr float RMS_EPS = 1e-6f;
constexpr float C2 = 0.125f * 1.4426950408889634f;
constexpr int CAP = T;

constexpr size_t MiB = 1u << 20;
constexpr size_t WS_CTL = 0, CTL_ZERO_BYTES = 32768;
constexpr int CW_BAR = 4096;
constexpr size_t WS_ROUTEW = 1 * MiB;
constexpr size_t WS_LAM = 1 * MiB + 768 * 1024;
constexpr size_t WS_ROPE = 2 * MiB;
constexpr size_t WS_WR2 = 4 * MiB;
constexpr size_t WS_MEMN = 5 * MiB;
constexpr size_t WS_MKV = 7 * MiB;
constexpr size_t WS_WIN_T = 8 * MiB;
constexpr size_t WS_WBRD_T = 18 * MiB;
constexpr size_t WS_WBRP_T = 19 * MiB;
constexpr size_t WS_WBRM_T = 19 * MiB + 512 * 1024;
constexpr size_t WS_WOUT_T = 20 * MiB;
constexpr size_t WS_WMKV_T = 22 * MiB;
constexpr size_t WS_WGU_T = 24 * MiB;
constexpr size_t WS_WD_T = 152 * MiB;
constexpr size_t WS_A = 216 * MiB;
constexpr size_t WS_XN = WS_A;
constexpr size_t WS_Q = WS_A + 64 * MiB, WS_K = WS_A + 96 * MiB, WS_V = WS_A + 128 * MiB;
constexpr size_t WS_U = WS_A + 160 * MiB, WS_MQ = WS_A + 176 * MiB;
constexpr size_t WS_OC = WS_A + 192 * MiB;
constexpr size_t WS_B = 488 * MiB;
constexpr size_t WS_GATES = WS_B;
constexpr size_t WS_YCAT = WS_B + 192 * MiB;
constexpr size_t WS_MERGF = 760 * MiB;
constexpr size_t WS_MERGB = 888 * MiB;
constexpr size_t WS_XG = 952 * MiB;
constexpr size_t WS_LIST = 1016 * MiB;
constexpr size_t WS_END = 1024 * MiB;

typedef __bf16 bf16x2_v __attribute__((ext_vector_type(2)));
__device__ __forceinline__ unsigned cvt_pk_bf16(float lo, float hi) { f32x2 v = {lo, hi}; bf16x2_v b = __builtin_convertvector(v, bf16x2_v); return __builtin_bit_cast(unsigned, b); }
__device__ __forceinline__ unsigned pk4_fp8(float a, float b, float c, float d) {
    a = fminf(fmaxf(a, -448.f), 448.f); b = fminf(fmaxf(b, -448.f), 448.f); c = fminf(fmaxf(c, -448.f), 448.f); d = fminf(fmaxf(d, -448.f), 448.f);
    int r = __builtin_amdgcn_cvt_pk_fp8_f32(a, b, 0, false); r = __builtin_amdgcn_cvt_pk_fp8_f32(c, d, r, true); return (unsigned)r; }
constexpr float W8_SCALE = 64.0f;
constexpr float Y8_SCALE = 32.0f;
constexpr float A8_SCALE = 8.0f;
__device__ __forceinline__ float bf_lo(unsigned w) { return __uint_as_float(w << 16); }
__device__ __forceinline__ float bf_hi(unsigned w) { return __uint_as_float(w & 0xffff0000u); }
__device__ __forceinline__ float wave_sum(float v) {
#pragma unroll
    for (int o = 1; o < 64; o <<= 1) v += __shfl_xor(v, o);
    return v;
}
#define LDS_WAIT() asm volatile("s_waitcnt lgkmcnt(0)" ::: "memory")

namespace pg8 {
constexpr int BM = 256, BK = 64, HALF = 128, HTB = HALF * BK * 2, STAGE_BYTES = 8 * HTB, NXCD = 8, WGM = 8;
__host__ __device__ __forceinline__ int lds_byte(int r, int c) { const int st = (r >> 4) * 2 + (c >> 5), rr = r & 15, cc = c & 31, ob = rr * 64 + cc * 2; return st * 1024 + (ob ^ (((ob >> 9) & 1) << 5)); }
__host__ __device__ __forceinline__ void stage_rc(int b, int& R, int& C) { const int st = b / 1024, sb = b % 1024, swz = sb ^ (((sb >> 9) & 1) << 5); R = (st >> 1) * 16 + swz / 64; C = (st & 1) * 32 + (swz % 64) / 2; }
__host__ __device__ __forceinline__ int perm32(int rho) { const int n = rho >> 4, i = rho & 15; return 8 * (i >> 2) + 4 * n + (i & 3); }

typedef int i32x4_t __attribute__((ext_vector_type(4)));
typedef int i32x8_t __attribute__((ext_vector_type(8)));
typedef long i64x2_t __attribute__((ext_vector_type(2)));
struct Unit { int pm, pn, e, mt, cnt; };

template <int BMAP> __device__ __forceinline__ int brow(int R) { return BMAP == 0 ? ((R >> 5) * 64 + perm32(R & 31)) : BMAP == 1 ? ((R & ~31) + perm32(R & 31)) : ((R >> 5) * 64 + 16 * ((R & 15) >> 2) + 4 * ((R >> 4) & 1) + (R & 3)); }

struct StaticOrder {
    int nM, nN, nwg, G, c;
    __device__ void init(int M, int N, int G_, int c_) { nM = M / BM; nN = N / BM; nwg = nM * nN; G = G_; c = c_; }
    __device__ bool next(int i, Unit& u) const {
        const long L = (long)i * G + c; if (L >= nwg) return false;
        int wgid = (int)L; { const int q = nwg / NXCD, r = nwg % NXCD, xcd = wgid % NXCD, off = wgid / NXCD; wgid = (xcd < r ? xcd * (q + 1) : r * (q + 1) + (xcd - r) * q) + off; }
        const int nig = WGM * nN, gid = wgid / nig, fm = gid * WGM, gsz = (nM - fm) < WGM ? (nM - fm) : WGM;
        u.pm = fm + ((wgid % nig) % gsz); u.pn = (wgid % nig) / gsz; u.e = 0; u.mt = 0; u.cnt = 0; return true;
    }
    __device__ bool next_lane(int i, Unit& u) const { return next(i, u); }
};
struct GroupedOrder {
    const LAS int* tp; const LAS int* cn; int NTN, G, c;
    __device__ bool next_lane(int i, Unit& u) const {
        const int nwg = tp[NEXP] * NTN; const long L = (long)i * G + c; if (L >= nwg) return false;
        int wgid = (int)L; { const int q = nwg / NXCD, r = nwg % NXCD, xcd = wgid % NXCD, off = wgid / NXCD; wgid = (xcd < r ? xcd * (q + 1) : r * (q + 1) + (xcd - r) * q) + off; }
        int e = 0; while (e < NEXP - 1 && wgid >= tp[e + 1] * NTN) ++e;
        const int idx = wgid - tp[e] * NTN, tiles = tp[e + 1] - tp[e];
        const int nig = 4 * NTN, gid = idx / nig, fm = gid * 4, gsz = (tiles - fm) < 4 ? (tiles - fm) : 4;
        u.mt = fm + ((idx % nig) % gsz); u.pn = (idx % nig) / gsz; u.e = e; u.pm = tp[e] + u.mt; u.cnt = cn[e]; return true;
    }
};
struct TableOrder {
    const LAS int* tab; int n;
    __device__ __forceinline__ bool next(int i, Unit& u) const {
        if (i >= n) return false;
        const LAS int* t = tab + i * 8;
        u.pm = __builtin_amdgcn_readfirstlane(t[0]); u.pn = __builtin_amdgcn_readfirstlane(t[1]); u.e = __builtin_amdgcn_readfirstlane(t[2]);
        u.mt = __builtin_amdgcn_readfirstlane(t[3]); u.cnt = __builtin_amdgcn_readfirstlane(t[4]); return true;
    }
};
template <class Sched> __device__ __forceinline__ TableOrder build_unit_table(const Sched& S, LAS int* tab) {
    __syncthreads();
    if (threadIdx.x < 32) { Unit u; const bool ok = S.next_lane((int)threadIdx.x, u);
        if (ok) { LAS int* t = tab + threadIdx.x * 8; t[0] = u.pm; t[1] = u.pn; t[2] = u.e; t[3] = u.mt; t[4] = u.cnt; }
        const unsigned long long m = __ballot(ok); if (threadIdx.x == 0) tab[256] = __popcll(m); }
    __syncthreads();
    TableOrder T; T.tab = tab; T.n = __builtin_amdgcn_readfirstlane(tab[256]); return T;
}
struct DenseProb {
    static constexpr bool GATHER = false; static constexpr int BMAP = 0; static constexpr bool F8 = false;
    const bf16_t* A; const bf16_t* Bt; int lda, ldb, K;
    __device__ __forceinline__ const char* a_base(const Unit& u) const { return (const char*)(A + (size_t)u.pm * BM * lda); }
    __device__ __forceinline__ const char* b_base(const Unit& u) const { return (const char*)(Bt + (size_t)u.pn * BM * ldb); }
    __device__ __forceinline__ size_t bhstep() const { return (size_t)32 * ldb * 2; }
    __device__ __forceinline__ unsigned a_off(const Unit&, int, int) const { return 0u; }
    __device__ __forceinline__ unsigned a_raw(const Unit&, int) const { return 0u; }
};
struct GuProb {
    static constexpr bool GATHER = true; static constexpr int BMAP = 1; static constexpr bool F8 = true;
    const unsigned char* XG; const unsigned char* Wt; const u32x2* list; int lda, ldb, K;
    __device__ __forceinline__ const char* a_base(const Unit&) const { return (const char*)XG; }
    __device__ __forceinline__ const char* b_base(const Unit& u) const { return (const char*)(Wt + ((size_t)u.e * 2048 + 128 * u.pn) * 1024); }
    __device__ __forceinline__ size_t bhstep() const { return (size_t)1024 * 1024; }
    __device__ __forceinline__ unsigned a_raw(const Unit& u, int r) const { const int rr = u.mt * BM + r, rc = rr < u.cnt ? rr : u.cnt - 1; return list[(size_t)u.e * CAP + rc].x; }
    __device__ __forceinline__ unsigned a_off(const Unit& u, int r, int C) const {
        const int rr = u.mt * BM + r, rc = rr < u.cnt ? rr : u.cnt - 1;
        const unsigned tok = list[(size_t)u.e * CAP + rc].x >> 2;
        return tok * 1024u + (unsigned)C * 2u;
    }
};
struct DownProb {
    static constexpr bool GATHER = false; static constexpr int BMAP = 2; static constexpr bool F8 = true;
    const unsigned char* A; const unsigned char* Wt; int lda, ldb, K;
    __device__ __forceinline__ const char* a_base(const Unit& u) const { return (const char*)(A + (size_t)u.pm * BM * lda); }
    __device__ __forceinline__ const char* b_base(const Unit& u) const { return (const char*)(Wt + ((size_t)u.e * 1024 + 256 * u.pn) * 1024); }
    __device__ __forceinline__ size_t bhstep() const { return (size_t)8 * ldb; }
    __device__ __forceinline__ unsigned a_off(const Unit&, int, int) const { return 0u; }
    __device__ __forceinline__ unsigned a_raw(const Unit&, int) const { return 0u; }
};

template <class Prob> __device__ __forceinline__ void calc_aoff(const Prob& P, const Unit& u, const int (&Rr)[2], const int (&Cc)[2], unsigned (&o)[2][2]) {
#pragma unroll
    for (int h = 0; h < 2; ++h)
#pragma unroll
        for (int i = 0; i < 2; ++i) {
            if constexpr (Prob::GATHER) o[h][i] = P.a_off(u, h * HALF + Rr[i], Cc[i]);
            else o[h][i] = Prob::F8 ? (unsigned)((h * HALF + Rr[i]) * P.lda + Cc[i] * 2) : (unsigned)((h * HALF + Rr[i]) * P.lda + Cc[i]) * 2u;
        }
}

struct NoPost { __device__ __forceinline__ void operator()(int) const {} };
template <class Epi, class Prob, class Sched, bool ALIGN_EPI, class Post = NoPost>
__device__ __forceinline__ void gemm_phase(LAS unsigned char* lds, const Prob& P, const Sched& S, const Epi& E, const Post& PU = Post()) {
    const int tid = threadIdx.x, wid = __builtin_amdgcn_readfirstlane(tid >> 6), lane = tid & 63, wr = wid >> 2, wc = wid & 3, fr = lane & 15, fq = lane >> 4;
    const int K = P.K, nt = Prob::F8 ? K / 128 : K / BK;
    int Rr[2], Cc[2]; unsigned voffB[2];
#pragma unroll
    for (int i = 0; i < 2; ++i) { stage_rc(tid * 16 + i * 8192, Rr[i], Cc[i]); voffB[i] = Prob::F8 ? (unsigned)(brow<Prob::BMAP>(Rr[i]) * P.ldb + Cc[i] * 2) : (unsigned)(brow<Prob::BMAP>(Rr[i]) * P.ldb + Cc[i]) * 2u; }
    const size_t kstep = (size_t)(BK * 2);
    const size_t bhstep = P.bhstep();
    const unsigned ldsw = (unsigned)wid * 1024u;
    const int aoff = lds_byte(wr * 64 + fr, fq * 8), boff = lds_byte(wc * 32 + fr, fq * 8);
#define PG8_SA(b, h) (((b) * 2 + (h)) * HTB)
#define PG8_SB(b, h) ((4 + (b) * 2 + (h)) * HTB)
#define PG8_STG(bufoff, gptr, v0, v1) do { \
        __builtin_amdgcn_global_load_lds((const unsigned*)((const char*)(gptr) + (v0)), (LAS unsigned*)(lds + (bufoff) + ldsw), 16, 0, 0); \
        __builtin_amdgcn_global_load_lds((const unsigned*)((const char*)(gptr) + (v1)), (LAS unsigned*)(lds + (bufoff) + ldsw + 8192), 16, 0, 0); } while (0)
#define PG8_STGB(bufoff, gptr) PG8_STG(bufoff, gptr, voffB[0], voffB[1])
#define PG8_LDA(dst, b, h) do { _Pragma("unroll") for (int m = 0; m < 4; ++m) _Pragma("unroll") for (int k = 0; k < 2; ++k) dst[m][k] = *(const LAS bf16x8*)(lds + PG8_SA(b, h) + aoff + m * 2048 + k * 1024); } while (0)
#define PG8_LDB(dst, b, h) do { _Pragma("unroll") for (int n = 0; n < 2; ++n) _Pragma("unroll") for (int k = 0; k < 2; ++k) dst[n][k] = *(const LAS bf16x8*)(lds + PG8_SB(b, h) + boff + n * 2048 + k * 1024); } while (0)
#define PG8_MMAB(ai, bj, At, Bt) do { _Pragma("unroll") for (int m = 0; m < 4; ++m) _Pragma("unroll") for (int n = 0; n < 2; ++n) _Pragma("unroll") for (int k = 0; k < 2; ++k) \
        acc[ai][bj][m][n] = __builtin_amdgcn_mfma_f32_16x16x32_bf16(Bt[n][k], At[m][k], acc[ai][bj][m][n], 0, 0, 0); } while (0)
#define PG8_MMAQ(ai, bj, At, Bt) do { _Pragma("unroll") for (int m = 0; m < 4; ++m) _Pragma("unroll") for (int n = 0; n < 2; ++n) _Pragma("unroll") for (int k = 0; k < 2; ++k) { \
        const i64x2_t bq = __builtin_bit_cast(i64x2_t, Bt[n][k]), aq = __builtin_bit_cast(i64x2_t, At[m][k]); \
        acc[ai][bj][m][n] = __builtin_amdgcn_mfma_f32_16x16x32_fp8_fp8(bq[0], aq[0], acc[ai][bj][m][n], 0, 0, 0); \
        acc[ai][bj][m][n] = __builtin_amdgcn_mfma_f32_16x16x32_fp8_fp8(bq[1], aq[1], acc[ai][bj][m][n], 0, 0, 0); } } while (0)
#define PG8_MMA8(ai, bj, A8, B8) do { _Pragma("unroll") for (int m = 0; m < 4; ++m) _Pragma("unroll") for (int n = 0; n < 2; ++n) \
        asm volatile("v_mfma_f32_16x16x128_f8f6f4 %0, %1, %2, %0" : "+v"(acc[ai][bj][m][n]) : "v"(B8[n]), "v"(A8[m])); } while (0)
#define PG8_LDA8(dst, b, h) do { _Pragma("unroll") for (int m = 0; m < 4; ++m) { dst[m].lo = *(const LAS i32x4_t*)(lds + PG8_SA(b, h) + aoff + m * 2048); dst[m].hi = *(const LAS i32x4_t*)(lds + PG8_SA(b, h) + aoff + m * 2048 + 1024); } } while (0)
#define PG8_LDB8(dst, b, h) do { _Pragma("unroll") for (int n = 0; n < 2; ++n) { dst[n].lo = *(const LAS i32x4_t*)(lds + PG8_SB(b, h) + boff + n * 2048); dst[n].hi = *(const LAS i32x4_t*)(lds + PG8_SB(b, h) + boff + n * 2048 + 1024); } } while (0)
#define PG8_XLDA(b, h)  do { if constexpr (Prob::F8 && F8MODE == 2) PG8_LDA8(At8, b, h); else PG8_LDA(At, b, h); } while (0)
#define PG8_XLDB0(b, h) do { if constexpr (Prob::F8 && F8MODE == 2) PG8_LDB8(B08, b, h); else PG8_LDB(B0, b, h); } while (0)
#define PG8_XLDB1(b, h) do { if constexpr (Prob::F8 && F8MODE == 2) PG8_LDB8(B18, b, h); else PG8_LDB(B1, b, h); } while (0)
#define PG8_XMMA0(ai, bj) do { if (USE_SETPRIO) __builtin_amdgcn_s_setprio(USE_SETPRIO); if constexpr (Prob::F8 && F8MODE == 2) PG8_MMA8(ai, bj, At8, B08); else if constexpr (Prob::F8) PG8_MMAQ(ai, bj, At, B0); else PG8_MMAB(ai, bj, At, B0); if (USE_SETPRIO) __builtin_amdgcn_s_setprio(0); } while (0)
#define PG8_XMMA1(ai, bj) do { if (USE_SETPRIO) __builtin_amdgcn_s_setprio(USE_SETPRIO); if constexpr (Prob::F8 && F8MODE == 2) PG8_MMA8(ai, bj, At8, B18); else if constexpr (Prob::F8) PG8_MMAQ(ai, bj, At, B1); else PG8_MMAB(ai, bj, At, B1); if (USE_SETPRIO) __builtin_amdgcn_s_setprio(0); } while (0)
#define PG8_WAIT_V(n) asm volatile("s_waitcnt vmcnt(" #n ")" ::: "memory")
#define PG8_WAIT_L(n) asm volatile("s_waitcnt lgkmcnt(" #n ")" ::: "memory")
#define PG8_BAR __builtin_amdgcn_s_barrier()
#define PG8_SCHED __builtin_amdgcn_sched_barrier(0)
    Unit cur, nxt; int ui = 0;
    if (!S.next(0, cur)) return;
    unsigned vo[2][2], nvo[2][2];
    calc_aoff(P, cur, Rr, Cc, vo);
    bool has_next = S.next(1, nxt);
    if constexpr (Prob::GATHER) { if (has_next) calc_aoff(P, nxt, Rr, Cc, nvo); else {
#pragma unroll
        for (int h = 0; h < 2; ++h)
#pragma unroll
            for (int i = 0; i < 2; ++i) nvo[h][i] = vo[h][i]; } }
    f32x4 acc[2][2][4][2];
#pragma unroll
    for (int a = 0; a < 2; ++a)
#pragma unroll
        for (int b = 0; b < 2; ++b)
#pragma unroll
            for (int m = 0; m < 4; ++m)
#pragma unroll
                for (int n = 0; n < 2; ++n) acc[a][b][m][n] = (f32x4){0.f, 0.f, 0.f, 0.f};
    bf16x8 At[4][2], B0[2][2], B1[2][2]; i32x8_t At8[4], B08[2], B18[2];
    const char* cA = P.a_base(cur); const char* cB = P.b_base(cur);
    if constexpr (Epi::HAS_PRE) E.pre(cur, 0, wid, lane);
    PG8_STGB(PG8_SB(0, 0), cB); PG8_STGB(PG8_SB(0, 1), cB + bhstep); PG8_STG(PG8_SA(0, 0), cA, vo[0][0], vo[0][1]); PG8_STG(PG8_SA(0, 1), cA, vo[1][0], vo[1][1]);
    if (wr == 1) PG8_BAR;
    PG8_WAIT_V(2); PG8_BAR;
    PG8_STGB(PG8_SB(1, 0), cB + kstep); PG8_STG(PG8_SA(1, 0), cA + kstep, vo[0][0], vo[0][1]); PG8_STGB(PG8_SB(1, 1), cB + bhstep + kstep);
    PG8_WAIT_V(6); PG8_BAR;
    for (;;) {
        const char* nA = has_next ? P.a_base(nxt) : cA; const char* nB = has_next ? P.b_base(nxt) : cB;
        for (int t = 0; t < nt; t += 2) {
            const bool last = (t == nt - 2);
            if constexpr (Epi::HAS_MID) { if (t == Epi::MID_T0 || t == Epi::MID_T1) { E.mid(acc, cur, wr, wc, fr, fq, t == Epi::MID_T0 ? 0 : 1); PG8_SCHED; } }
            const char* a1 = cA + (size_t)(t + 1) * kstep;
            const char* a2 = last ? nA : cA + (size_t)(t + 2) * kstep; const char* b2 = last ? nB : cB + (size_t)(t + 2) * kstep;
            const char* a3 = a2 + kstep; const char* b3 = b2 + kstep;
            unsigned x00 = vo[0][0], x01 = vo[0][1], x10 = vo[1][0], x11 = vo[1][1];
            if constexpr (Prob::GATHER) { if (last) { x00 = nvo[0][0]; x01 = nvo[0][1]; x10 = nvo[1][0]; x11 = nvo[1][1]; } }
            PG8_XLDB0(0, 0); PG8_XLDB1(0, 1); PG8_SCHED; PG8_XLDA(0, 0); PG8_STG(PG8_SA(1, 1), a1, vo[1][0], vo[1][1]);
            PG8_WAIT_V(8); PG8_WAIT_L(0); PG8_BAR; PG8_XMMA0(0, 0); PG8_XMMA1(0, 1); PG8_BAR; PG8_SCHED;
            PG8_XLDA(0, 1); PG8_STGB(PG8_SB(0, 0), b2); PG8_STGB(PG8_SB(0, 1), b2 + bhstep); PG8_STG(PG8_SA(0, 0), a2, x00, x01);
            PG8_WAIT_V(8); PG8_WAIT_L(0); PG8_BAR; PG8_XMMA0(1, 0); PG8_XMMA1(1, 1); PG8_BAR; PG8_SCHED;
            PG8_XLDB0(1, 0); PG8_XLDB1(1, 1); PG8_SCHED; PG8_XLDA(1, 0); PG8_STG(PG8_SA(0, 1), a2, x10, x11);
            PG8_WAIT_V(8); PG8_WAIT_L(0); PG8_BAR; PG8_XMMA0(0, 0); PG8_XMMA1(0, 1); PG8_BAR; PG8_SCHED;
            PG8_XLDA(1, 1); PG8_STGB(PG8_SB(1, 0), b3); PG8_STGB(PG8_SB(1, 1), b3 + bhstep); PG8_STG(PG8_SA(1, 0), a3, x00, x01);
            PG8_WAIT_V(8); PG8_WAIT_L(0); PG8_BAR; PG8_XMMA0(1, 0); PG8_XMMA1(1, 1); PG8_BAR; PG8_SCHED;
        }
        if constexpr (ALIGN_EPI) { if (wr == 0) PG8_BAR; }
        if constexpr (Prob::F8 && F8MODE == 2) asm volatile("s_nop 15\n\ts_nop 15" ::: "memory");
        Unit nn; const bool has_nn = has_next && S.next(ui + 2, nn);
        if constexpr (Prob::GATHER) {
#pragma unroll
            for (int h = 0; h < 2; ++h)
#pragma unroll
                for (int i = 0; i < 2; ++i) vo[h][i] = nvo[h][i];
            if (has_nn) {
#pragma unroll
                for (int h = 0; h < 2; ++h)
#pragma unroll
                    for (int i = 0; i < 2; ++i) nvo[h][i] = P.a_raw(nn, h * HALF + Rr[i]); } }
        if constexpr (Epi::HAS_PRE) E(acc, cur, wr, wc, fr, fq, ui & 1); else E(acc, cur, wr, wc, fr, fq);
        PU(ui);
        if (!has_next) break;
#pragma unroll
        for (int a = 0; a < 2; ++a)
#pragma unroll
            for (int b = 0; b < 2; ++b)
#pragma unroll
                for (int m = 0; m < 4; ++m)
#pragma unroll
                    for (int n = 0; n < 2; ++n) acc[a][b][m][n] = (f32x4){0.f, 0.f, 0.f, 0.f};
        cur = nxt; cA = nA; cB = nB; ++ui;
        if constexpr (Epi::HAS_PRE) E.pre(cur, ui, wid, lane);
        has_next = has_nn; nxt = nn;
        if constexpr (Prob::GATHER) { if (has_next) {
#pragma unroll
            for (int h = 0; h < 2; ++h)
#pragma unroll
                for (int i = 0; i < 2; ++i) nvo[h][i] = (nvo[h][i] >> 2) * (Prob::F8 ? 1024u : 2048u) + (unsigned)Cc[i] * 2u;
            asm volatile("" : "+v"(nvo[0][0]), "+v"(nvo[0][1]), "+v"(nvo[1][0]), "+v"(nvo[1][1])); } }
        if constexpr (ALIGN_EPI) { if (wr == 1) PG8_BAR; }
    }
    PG8_WAIT_V(0);
    if constexpr (!ALIGN_EPI) { if (wr == 0) PG8_BAR; }
    PG8_BAR;
#undef PG8_SA
#undef PG8_SB
#undef PG8_STG
#undef PG8_STGB
#undef PG8_LDA
#undef PG8_LDB
#undef PG8_MMAB
#undef PG8_MMAQ
#undef PG8_MMA8
#undef PG8_LDA8
#undef PG8_LDB8
#undef PG8_XLDA
#undef PG8_XLDB0
#undef PG8_XLDB1
#undef PG8_XMMA0
#undef PG8_XMMA1
#undef PG8_WAIT_V
#undef PG8_WAIT_L
#undef PG8_BAR
#undef PG8_SCHED
}

typedef const f32x4 (&AccRef)[2][2][4][2];
__device__ __forceinline__ void dma4(const void* g, LAS unsigned char* dst) { __builtin_amdgcn_global_load_lds((const unsigned*)g, (LAS unsigned*)dst, 4, 0, 0); }

__device__ __forceinline__ void store8(bf16_t* p, const f32x4& a, const f32x4& b) {
    u32x4 w; w.x = cvt_pk_bf16(a[0], a[1]); w.y = cvt_pk_bf16(a[2], a[3]); w.z = cvt_pk_bf16(b[0], b[1]); w.w = cvt_pk_bf16(b[2], b[3]); *(u32x4*)p = w;
}
__device__ __forceinline__ float sigmoidf_(float v) { return __builtin_amdgcn_rcpf(1.0f + __builtin_amdgcn_exp2f(-1.4426950408889634f * v)); }

struct EpiInProj {
    static constexpr bool HAS_MID = false; static constexpr bool HAS_PRE = false;
    bf16_t *Q, *Kb, *V, *U, *MQ, *GT; const float *qn, *kn, *mqn, *bg; const f32x2* rope;
    __device__ __forceinline__ void operator()(AccRef acc, const Unit& u, int wr, int wc, int fr, int fq) const {
        const int pn = u.pn; const int row0 = u.pm * BM + wr * 64 + fr;
        bf16_t* const Q_ = Q; bf16_t* const K_ = Kb; bf16_t* const V_ = V; bf16_t* const U_ = U; bf16_t* const MQ_ = MQ; const float* const qn_ = qn; const float* const kn_ = kn; const float* const mqn_ = mqn;
        if (pn < 4 || pn == 7) {
            const bool rope_on = pn < 4; const float* gn = pn < 2 ? qn_ : (pn < 4 ? kn_ : mqn_);
            const float sc = (pn < 2 || pn == 7) ? C2 : 1.0f;
            bf16_t* O; int pitch, colb;
            if (pn < 2) { O = Q_; pitch = 512; colb = (pn * 4 + wc) * 64; } else if (pn < 4) { O = K_; pitch = 512; colb = ((pn - 2) * 4 + wc) * 64; } else { O = MQ_; pitch = 256; colb = wc * 64; }
            const f32x4 g00 = *(const f32x4*)(gn + 8 * fq), g01 = *(const f32x4*)(gn + 8 * fq + 4), g10 = *(const f32x4*)(gn + 32 + 8 * fq), g11 = *(const f32x4*)(gn + 32 + 8 * fq + 4);
#pragma unroll
            for (int ai = 0; ai < 2; ++ai)
#pragma unroll
                for (int m = 0; m < 4; ++m) {
                    const f32x4 a0 = acc[ai][0][m][0], a1 = acc[ai][0][m][1], b0 = acc[ai][1][m][0], b1 = acc[ai][1][m][1];
                    float ss = 0.f;
#pragma unroll
                    for (int j = 0; j < 4; ++j) ss += a0[j] * a0[j] + a1[j] * a1[j] + b0[j] * b0[j] + b1[j] * b1[j];
                    ss += __shfl_xor(ss, 16); ss += __shfl_xor(ss, 32);
                    const float rstd = 1.0f / sqrtf(ss * (1.0f / 64.0f) + RMS_EPS);
                    const int row = row0 + ai * HALF + m * 16;
                    f32x4 t10 = a0 * rstd * g00, t11 = a1 * rstd * g01, t20 = b0 * rstd * g10, t21 = b1 * rstd * g11;
                    f32x4 o10, o11, o20, o21;
                    if (rope_on) {
                        const f32x4* rp = (const f32x4*)(rope + (size_t)(row & (SEQ - 1)) * 32 + 8 * fq);
                        const f32x4 r0 = rp[0], r1 = rp[1], r2 = rp[2], r3 = rp[3];
                        const f32x4 cs0 = {r0[0], r0[2], r1[0], r1[2]}, sn0 = {r0[1], r0[3], r1[1], r1[3]}, cs1 = {r2[0], r2[2], r3[0], r3[2]}, sn1 = {r2[1], r2[3], r3[1], r3[3]};
                        o10 = (t10 * cs0 - t20 * sn0) * sc; o11 = (t11 * cs1 - t21 * sn1) * sc; o20 = (t20 * cs0 + t10 * sn0) * sc; o21 = (t21 * cs1 + t11 * sn1) * sc;
                    } else { o10 = t10 * sc; o11 = t11 * sc; o20 = t20 * sc; o21 = t21 * sc; }
                    bf16_t* rowp = O + (size_t)row * pitch + colb + 8 * fq;
                    store8(rowp, o10, o11); store8(rowp + 32, o20, o21);
                }
        } else if (pn < 7) {
            bf16_t* O; int pitch, colb;
            if (pn < 6) { O = V_; pitch = 512; colb = (pn - 4) * 256 + wc * 64; } else { O = U_; pitch = 256; colb = wc * 64; }
#pragma unroll
            for (int ai = 0; ai < 2; ++ai)
#pragma unroll
                for (int m = 0; m < 4; ++m) { bf16_t* rowp = O + (size_t)(row0 + ai * HALF + m * 16) * pitch + colb + 8 * fq;
                    store8(rowp, acc[ai][0][m][0], acc[ai][0][m][1]); store8(rowp + 32, acc[ai][1][m][0], acc[ai][1][m][1]); }
        } else {
            const int gc = (pn - 8) * 256 + wc * 64 + 8 * fq;
            f32x4 bv[2][2];
#pragma unroll
            for (int bj = 0; bj < 2; ++bj)
#pragma unroll
                for (int n = 0; n < 2; ++n) bv[bj][n] = *(const f32x4*)(bg + gc + 32 * bj + 4 * n);
#pragma unroll
            for (int ai = 0; ai < 2; ++ai)
#pragma unroll
                for (int m = 0; m < 4; ++m) {
                    bf16_t* blk = GT + ((size_t)(((pn - 8) >> 2) * 128 + u.pm) * 4 + ((pn - 8) & 3)) * 65536 + (size_t)((wr * 4 + wc) * 16 * 64 + (fq * 16 + fr)) * 8;
#pragma unroll
                    for (int bj = 0; bj < 2; ++bj) { f32x4 v0 = acc[ai][bj][m][0] + bv[bj][0], v1 = acc[ai][bj][m][1] + bv[bj][1];
#pragma unroll
                        for (int j = 0; j < 4; ++j) { v0[j] = sigmoidf_(v0[j]); v1[j] = sigmoidf_(v1[j]); }
                        store8(blk + (ai * 8 + m * 2 + bj) * 512, v0, v1); } }
        }
    }
};
struct EpiMemKV {
    static constexpr bool HAS_MID = false; static constexpr bool HAS_PRE = false;
    bf16_t* MKV; const float* mkn;
    __device__ __forceinline__ void operator()(AccRef acc, const Unit& u, int wr, int wc, int fr, int fq) const {
        const int row0 = u.pm * BM + wr * 64 + fr;
        f32x4 g00 = {1.f, 1.f, 1.f, 1.f}, g01 = g00, g10 = g00, g11 = g00;
        if (u.pn == 0) { g00 = *(const f32x4*)(mkn + 8 * fq); g01 = *(const f32x4*)(mkn + 8 * fq + 4); g10 = *(const f32x4*)(mkn + 32 + 8 * fq); g11 = *(const f32x4*)(mkn + 32 + 8 * fq + 4); }
#pragma unroll
        for (int ai = 0; ai < 2; ++ai)
#pragma unroll
            for (int m = 0; m < 4; ++m) {
                const f32x4 a0 = acc[ai][0][m][0], a1 = acc[ai][0][m][1], b0 = acc[ai][1][m][0], b1 = acc[ai][1][m][1];
                float rstd = 1.0f;
                if (u.pn == 0) { float ss = 0.f;
#pragma unroll
                    for (int j = 0; j < 4; ++j) ss += a0[j] * a0[j] + a1[j] * a1[j] + b0[j] * b0[j] + b1[j] * b1[j];
                    ss += __shfl_xor(ss, 16); ss += __shfl_xor(ss, 32); rstd = 1.0f / sqrtf(ss * (1.0f / 64.0f) + RMS_EPS); }
                bf16_t* rowp = MKV + (size_t)(row0 + ai * HALF + m * 16) * 512 + u.pn * 256 + wc * 64 + 8 * fq;
                store8(rowp, a0 * rstd * g00, a1 * rstd * g01); store8(rowp + 32, b0 * rstd * g10, b1 * rstd * g11);
            }
    }
};
template <int STAGE> struct EpiMerge {
    static constexpr bool HAS_MID = false; static constexpr bool HAS_PRE = false;
    const bf16_t* GT; float* MF; bf16_t* MB;
    __device__ __forceinline__ void operator()(AccRef acc, const Unit& u, int wr, int wc, int fr, int fq) const {
        const int row0 = u.pm * BM + wr * 64 + fr, col0 = u.pn * BM + wc * 64 + 8 * fq;
#pragma unroll
        for (int ai = 0; ai < 2; ++ai)
#pragma unroll
            for (int m = 0; m < 4; ++m) { const size_t row = (size_t)(row0 + ai * HALF + m * 16);
#pragma unroll
                for (int bj = 0; bj < 2; ++bj) { const int col = col0 + 32 * bj;
                    const u32x4 g = *(const u32x4*)(GT + row * 3072 + STAGE * 1024 + col);
                    const f32x4 ga = {bf_lo(g.x), bf_hi(g.x), bf_lo(g.y), bf_hi(g.y)}, gb = {bf_lo(g.z), bf_hi(g.z), bf_lo(g.w), bf_hi(g.w)};
                    f32x4 v0 = acc[ai][bj][m][0] * ga, v1 = acc[ai][bj][m][1] * gb;
                    float* mp = MF + row * 1024 + col;
                    if (STAGE > 0) { v0 += *(const f32x4*)mp; v1 += *(const f32x4*)(mp + 4); }
                    if (STAGE < 2) { *(f32x4*)mp = v0; *(f32x4*)(mp + 4) = v1; } else store8(MB + row * 1024 + col, v0, v1); }
                if (m & 1) asm volatile("" ::: "memory"); }
    }
};
struct EpiWout {
    static constexpr bool HAS_MID = false; static constexpr bool HAS_PRE = false;
    const float* X; float* X2; unsigned char* XG; const float* n2;
    __device__ __forceinline__ void operator()(AccRef acc, const Unit& u, int wr, int wc, int fr, int fq) const {
        const int row0 = u.pm * BM + wr * 64 + fr, col0 = u.pn * BM + wc * 64 + 8 * fq;
        f32x4 nv[2][2];
#pragma unroll
        for (int bj = 0; bj < 2; ++bj)
#pragma unroll
            for (int n = 0; n < 2; ++n) nv[bj][n] = *(const f32x4*)(n2 + col0 + 32 * bj + 4 * n);
#pragma unroll
        for (int ai = 0; ai < 2; ++ai)
#pragma unroll
            for (int m = 0; m < 4; ++m) { const size_t off = (size_t)(row0 + ai * HALF + m * 16) * 1024 + col0;
#pragma unroll
                for (int bj = 0; bj < 2; ++bj) { const f32x4 x0 = *(const f32x4*)(X + off + 32 * bj) + acc[ai][bj][m][0], x1 = *(const f32x4*)(X + off + 32 * bj + 4) + acc[ai][bj][m][1];
                    *(f32x4*)(X2 + off + 32 * bj) = x0; *(f32x4*)(X2 + off + 32 * bj + 4) = x1;
                    { const f32x4 y0 = x0 * nv[bj][0], y1 = x1 * nv[bj][1]; u32x2 w8; w8.x = pk4_fp8(y0[0], y0[1], y0[2], y0[3]); w8.y = pk4_fp8(y1[0], y1[1], y1[2], y1[3]); *(u32x2*)(XG + off + 32 * bj) = w8; } }
                if (m & 1) asm volatile("" ::: "memory"); }
    }
};
struct EpiSwiglu {
    static constexpr bool HAS_MID = false; static constexpr bool HAS_PRE = true;
    unsigned char* ACT; const u32x2* list; const float* bgu; LAS unsigned char* xb;
    __device__ __forceinline__ void pre(const Unit& u, int ui, int wid, int lane) const {
        LAS unsigned char* b = xb + (ui & 1) * 2048;
        if (wid < 4) { const int rr = u.mt * BM + 64 * wid + lane, rc = rr < u.cnt ? rr : u.cnt - 1; dma4((const unsigned*)(list + (size_t)u.e * CAP + rc) + 1, b + wid * 256); }
        else { const int j = 64 * (wid - 4) + lane; dma4(bgu + (size_t)u.e * 2048 + 128 * u.pn + (j < 128 ? j : 1024 + (j - 128)), b + 1024 + (wid - 4) * 256); }
    }
    __device__ __forceinline__ static unsigned swi4(const f32x4& ag, const f32x4& au, float rstd, const f32x4& bg, const f32x4& bu) {
        unsigned w = 0;
#pragma unroll
        for (int h = 0; h < 2; ++h) {
            const f32x2 a2 = {ag[2 * h], ag[2 * h + 1]}, u2 = {au[2 * h], au[2 * h + 1]}, bg2 = {bg[2 * h], bg[2 * h + 1]}, bu2 = {bu[2 * h], bu[2 * h + 1]};
            const f32x2 G = a2 * rstd + bg2, U = u2 * rstd + bu2;
            const f32x2 gg = {fminf(G[0], 7.0f), fminf(G[1], 7.0f)};
            const f32x2 t = gg * (-1.702f * 1.4426950408889634f);
            const f32x2 d = (f32x2){__builtin_amdgcn_exp2f(t[0]), __builtin_amdgcn_exp2f(t[1])} + 1.0f;
            const f32x2 r = {__builtin_amdgcn_rcpf(d[0]), __builtin_amdgcn_rcpf(d[1])};
            const f32x2 uu = {__builtin_amdgcn_fmed3f(U[0], -7.0f, 7.0f), __builtin_amdgcn_fmed3f(U[1], -7.0f, 7.0f)};
            const f32x2 o = (gg * r) * (uu * A8_SCALE + A8_SCALE);
            w = h ? (unsigned)__builtin_amdgcn_cvt_pk_fp8_f32(o[0], o[1], (int)w, true) : (unsigned)__builtin_amdgcn_cvt_pk_fp8_f32(o[0], o[1], (int)w, false);
        }
        return w;
    }
    __device__ __forceinline__ void operator()(AccRef acc, const Unit& u, int wr, int wc, int fr, int fq, int par) const {
        int z = 0; asm volatile("" : "+v"(z));
        const int col = 128 * u.pn + 32 * wc + 8 * fq + z; const LAS unsigned char* b = xb + par * 2048; const LAS unsigned char* bb = b + 1024 + (32 * wc + 8 * fq + z) * 4;
        const f32x4 bg0 = *(const LAS f32x4*)bb, bg1 = *(const LAS f32x4*)(bb + 16), bu0 = *(const LAS f32x4*)(bb + 512), bu1 = *(const LAS f32x4*)(bb + 528);
#pragma unroll
        for (int ai = 0; ai < 2; ++ai)
#pragma unroll
            for (int m = 0; m < 4; ++m) { const int r = ai * HALF + wr * 64 + m * 16 + fr;
                const float rstd = *(const LAS float*)(b + (r + z) * 4) * (1.0f / W8_SCALE);
                u32x2 w8; w8.x = swi4(acc[ai][0][m][0], acc[ai][1][m][0], rstd, bg0, bu0); w8.y = swi4(acc[ai][0][m][1], acc[ai][1][m][1], rstd, bg1, bu1);
                *(u32x2*)(ACT + (size_t)(u.pm * BM + r) * 1024 + col) = w8; }
    }
};
struct EpiDown {
    static constexpr bool HAS_MID = false; static constexpr bool HAS_PRE = true;
    unsigned char* Y4; const u32x2* list; const float* bd; LAS unsigned char* xb;
    __device__ __forceinline__ void pre(const Unit& u, int ui, int wid, int lane) const {
        LAS unsigned char* b = xb + (ui & 1) * 2048;
        if (wid < 4) { const int rr = u.mt * BM + 64 * wid + lane, rc = rr < u.cnt ? rr : u.cnt - 1; dma4((const unsigned*)(list + (size_t)u.e * CAP + rc), b + wid * 256); }
        else { const int j = 64 * (wid - 4) + lane; dma4(bd + (size_t)u.e * 1024 + u.pn * BM + j, b + 1024 + (wid - 4) * 256); }
    }
    __device__ __forceinline__ static unsigned dn4(const f32x4& a, const f32x4& b32) {
        const f32x4 y = a * (Y8_SCALE / (W8_SCALE * A8_SCALE)) + b32;
        return pk4_fp8(y[0], y[1], y[2], y[3]);
    }
    __device__ __forceinline__ void operator()(AccRef acc, const Unit& u, int wr, int wc, int fr, int fq, int par) const {
        int z = 0; asm volatile("" : "+v"(z));
        const int colw = wc * 64 + 16 * fq + z, col0 = u.pn * BM + colw;
        const LAS unsigned char* b = xb + par * 2048;
        f32x4 bv[2][2];
#pragma unroll
        for (int bj = 0; bj < 2; ++bj)
#pragma unroll
            for (int n = 0; n < 2; ++n) bv[bj][n] = *(const LAS f32x4*)(b + 1024 + (colw + 8 * bj + 4 * n) * 4) * Y8_SCALE;
#pragma unroll
        for (int ai = 0; ai < 2; ++ai)
#pragma unroll
            for (int m = 0; m < 4; ++m) { const int r = ai * HALF + wr * 64 + m * 16 + fr, rr = u.mt * BM + r;
                if (rr < u.cnt) { const unsigned tk = *(const LAS unsigned*)(b + (r + z) * 4);
                    u32x4 w8; w8.x = dn4(acc[ai][0][m][0], bv[0][0]); w8.y = dn4(acc[ai][0][m][1], bv[0][1]); w8.z = dn4(acc[ai][1][m][0], bv[1][0]); w8.w = dn4(acc[ai][1][m][1], bv[1][1]);
                    *(u32x4*)(Y4 + (size_t)tk * 1024 + col0) = w8; } }
    }
};
struct EpiMergeR {
    static constexpr bool HAS_MID = true; static constexpr bool HAS_PRE = false; static constexpr int MID_T0 = 8, MID_T1 = 12;
    const bf16_t* GT; bf16_t* MB;
    __device__ __forceinline__ void mid(f32x4 (&acc)[2][2][4][2], const Unit& u, int wr, int wc, int fr, int fq, int seam) const {
        int z = 0; asm volatile("" : "+v"(z));
        const bf16_t* gp0 = GT + ((size_t)(seam * 128 + u.pm) * 4 + u.pn) * 65536 + (size_t)((wr * 4 + wc) * 16 * 64 + (fq * 16 + fr) + z) * 8;
#pragma unroll
        for (int ai = 0; ai < 2; ++ai)
#pragma unroll
            for (int m = 0; m < 4; ++m) {
#pragma unroll
                for (int bj = 0; bj < 2; ++bj) { const bf16_t* gp = gp0 + (ai * 8 + m * 2 + bj) * 512;
                    const u32x4 gn = *(const u32x4*)gp, gd = *(const u32x4*)(gp + (size_t)128 * 4 * 65536);
                    const unsigned nn[4] = {gn.x, gn.y, gn.z, gn.w}, dd[4] = {gd.x, gd.y, gd.z, gd.w};
#pragma unroll
                    for (int j = 0; j < 4; ++j) { const float r0 = bf_lo(nn[j]) * __builtin_amdgcn_rcpf(fmaxf(bf_lo(dd[j]), 8.67e-19f)), r1 = bf_hi(nn[j]) * __builtin_amdgcn_rcpf(fmaxf(bf_hi(dd[j]), 8.67e-19f));
                        acc[ai][bj][m][j >> 1][(j & 1) * 2] *= r0; acc[ai][bj][m][j >> 1][(j & 1) * 2 + 1] *= r1; } }
                if (m & 1) asm volatile("" ::: "memory"); }
    }
    __device__ __forceinline__ void operator()(AccRef acc, const Unit& u, int wr, int wc, int fr, int fq) const {
        int z = 0; asm volatile("" : "+v"(z));
        const size_t off0 = (size_t)(u.pm * BM + wr * 64 + fr + z) * 1024 + u.pn * BM + wc * 64 + 8 * fq;
        const bf16_t* gp0 = GT + ((size_t)(2 * 128 + u.pm) * 4 + u.pn) * 65536 + (size_t)((wr * 4 + wc) * 16 * 64 + (fq * 16 + fr) + z) * 8;
#pragma unroll
        for (int ai = 0; ai < 2; ++ai)
#pragma unroll
            for (int m = 0; m < 4; ++m) { const size_t ro = off0 + (size_t)(ai * HALF + m * 16) * 1024;
#pragma unroll
                for (int bj = 0; bj < 2; ++bj) {
                    const u32x4 g = *(const u32x4*)(gp0 + (ai * 8 + m * 2 + bj) * 512);
                    const f32x4 ga = {bf_lo(g.x), bf_hi(g.x), bf_lo(g.y), bf_hi(g.y)}, gb = {bf_lo(g.z), bf_hi(g.z), bf_lo(g.w), bf_hi(g.w)};
                    store8(MB + ro + 32 * bj, acc[ai][bj][m][0] * ga, acc[ai][bj][m][1] * gb); } }
    }
};
struct EpiPlain {
    static constexpr bool HAS_MID = false; static constexpr bool HAS_PRE = false;
    bf16_t* Z; int ldz;
    __device__ __forceinline__ void operator()(AccRef acc, const Unit& u, int wr, int wc, int fr, int fq) const {
        const int row0 = u.pm * BM + wr * 64 + fr, col0 = u.pn * BM + wc * 64 + 8 * fq;
#pragma unroll
        for (int ai = 0; ai < 2; ++ai)
#pragma unroll
            for (int m = 0; m < 4; ++m) { bf16_t* rowp = Z + (size_t)(row0 + ai * HALF + m * 16) * ldz + col0;
                store8(rowp, acc[ai][0][m][0], acc[ai][0][m][1]); store8(rowp + 32, acc[ai][1][m][0], acc[ai][1][m][1]); }
    }
};
}

namespace attn_body {
using bf16 = __hip_bfloat16;
using s16x4 = __attribute__((ext_vector_type(4))) short;
constexpr int NW = 8, QBLK = 32, QB = QBLK * NW, KVBLK = 64, D = 64;
__device__ __forceinline__ int crow(int r, int hi) { return (r & 3) + 8 * (r >> 2) + 4 * hi; }
#define SBAR() __builtin_amdgcn_sched_barrier(0)
constexpr int NSLOT = 3, SLOTB = 8192;
constexpr int LDS_K = 0, LDS_V = NSLOT * SLOTB, LDS_WS = 2 * NSLOT * SLOTB, LDS_OST = LDS_WS + NW * 64 * 4, LDS_BYTES = LDS_OST + NW * 4096;
__device__ __forceinline__ void glds16(const void* gsrc, unsigned lds_dst) { unsigned keep;
    asm volatile("s_mov_b32 %0, m0\n\ts_mov_b32 m0, %2\n\ts_nop 0\n\tglobal_load_lds_dwordx4 %1, off\n\ts_mov_b32 m0, %0" : "=&s"(keep) : "v"(gsrc), "s"(lds_dst) : "memory"); }
__device__ __forceinline__ float max3f(float a, float b, float c) { float r; asm("v_max3_f32 %0, %1, %2, %3" : "=v"(r) : "v"(a), "v"(b), "v"(c)); return r; }
__device__ __forceinline__ float max2f(float a, float b) { float r; asm("v_max_f32_e32 %0, %1, %2" : "=v"(r) : "v"(a), "v"(b)); return r; }
__device__ __forceinline__ float fadd_s(float a, float b) { float r; asm("v_add_f32_e32 %0, %1, %2" : "=v"(r) : "v"(a), "v"(b)); return r; }
__device__ __forceinline__ float fsub_s(float a, float b) { float r; asm("v_sub_f32_e32 %0, %1, %2" : "=v"(r) : "v"(a), "v"(b)); return r; }
typedef float f32x2_t __attribute__((ext_vector_type(2))); typedef __bf16 bf16x2_t __attribute__((ext_vector_type(2)));
__device__ __forceinline__ unsigned cvtpk_s(float lo, float hi) { f32x2_t v = {lo, hi}; bf16x2_t b = __builtin_convertvector(v, bf16x2_t); return __builtin_bit_cast(unsigned, b); }
#define WAIT_BAR(N) asm volatile("s_waitcnt vmcnt(" #N ") lgkmcnt(0)\n\ts_barrier" ::: "memory")

__device__ __forceinline__ void qkt(f32x16& p0, f32x16& p1, const char* Kslot, const bf16x8* qr, const f32x16& negm, int r32, int hi) {
    const char* kb = Kslot + hi * 1024 + r32 * 16;
#pragma unroll
    for (int d0 = 0; d0 < 4; ++d0) {
        const bf16x8 b0 = *reinterpret_cast<const bf16x8*>(kb + d0 * 2048);
        const bf16x8 b1 = *reinterpret_cast<const bf16x8*>(kb + d0 * 2048 + 512);
        if (d0 == 0) { p0 = __builtin_amdgcn_mfma_f32_32x32x16_bf16(b0, qr[0], negm, 0, 0, 0); p1 = __builtin_amdgcn_mfma_f32_32x32x16_bf16(b1, qr[0], negm, 0, 0, 0); }
        else { p0 = __builtin_amdgcn_mfma_f32_32x32x16_bf16(b0, qr[d0], p0, 0, 0, 0); p1 = __builtin_amdgcn_mfma_f32_32x32x16_bf16(b1, qr[d0], p1, 0, 0, 0); } }
}
typedef __attribute__((address_space(3))) const char* lds_cptr;
typedef short v4i16_t __attribute__((ext_vector_type(4)));
__device__ __forceinline__ void kload8(bf16x8* kf, lds_cptr kp) {
    kf[0] = *(const __attribute__((address_space(3))) bf16x8*)(kp);        kf[1] = *(const __attribute__((address_space(3))) bf16x8*)(kp + 512);
    kf[2] = *(const __attribute__((address_space(3))) bf16x8*)(kp + 2048); kf[3] = *(const __attribute__((address_space(3))) bf16x8*)(kp + 2560);
    kf[4] = *(const __attribute__((address_space(3))) bf16x8*)(kp + 4096); kf[5] = *(const __attribute__((address_space(3))) bf16x8*)(kp + 4608);
    kf[6] = *(const __attribute__((address_space(3))) bf16x8*)(kp + 6144); kf[7] = *(const __attribute__((address_space(3))) bf16x8*)(kp + 6656);
}
__device__ __forceinline__ void kload2(bf16x8* kf, lds_cptr kp, int j) { kf[2 * j] = *(const __attribute__((address_space(3))) bf16x8*)(kp + j * 2048); kf[2 * j + 1] = *(const __attribute__((address_space(3))) bf16x8*)(kp + j * 2048 + 512); }
__device__ __forceinline__ s16x4 vtr(lds_cptr p) { return __builtin_bit_cast(s16x4, __builtin_amdgcn_ds_read_tr16_b64_v4i16((__attribute__((address_space(3))) v4i16_t*)p)); }
__device__ __forceinline__ float rowmax(const f32x16& p0, const f32x16& p1) {
    float a = max3f(p0[0], p0[1], p1[0]), b = max3f(p0[2], p0[3], p1[1]); a = max3f(a, p1[2], p1[3]);
#pragma unroll
    for (int r = 4; r < 16; r += 4) { a = max3f(a, p0[r], p0[r + 1]); b = max3f(b, p0[r + 2], p0[r + 3]); a = max3f(a, p1[r], p1[r + 1]); b = max3f(b, p1[r + 2], p1[r + 3]); }
    const float m = max2f(a, b);
    auto rr = __builtin_amdgcn_permlane32_swap(__float_as_uint(m), __float_as_uint(m), false, false);
    return max2f(__uint_as_float(rr[0]), __uint_as_float(rr[1]));
}
__device__ __forceinline__ void pv(f32x16* o, int vb, bf16x8 pa0, bf16x8 pa1, bf16x8 pa2, bf16x8 pa3) {
#pragma unroll
    for (int d0 = 0; d0 < 2; ++d0) { s16x4 lo[4], hi[4];
#pragma unroll
        for (int ks = 0; ks < 4; ++ks) {
            asm volatile("ds_read_b64_tr_b16 %0,%1 offset:%c2" : "=&v"(lo[ks]) : "v"(vb), "i"(d0 * 4096 + ks * 1024) : "memory");
            asm volatile("ds_read_b64_tr_b16 %0,%1 offset:%c2" : "=&v"(hi[ks]) : "v"(vb), "i"(d0 * 4096 + ks * 1024 + 512) : "memory"); }
        asm volatile("s_waitcnt lgkmcnt(0)" ::: "memory"); SBAR();
#define PK(k) (bf16x8){lo[k][0], lo[k][1], lo[k][2], lo[k][3], hi[k][0], hi[k][1], hi[k][2], hi[k][3]}
        o[d0] = __builtin_amdgcn_mfma_f32_32x32x16_bf16(pa0, PK(0), o[d0], 0, 0, 0);
        o[d0] = __builtin_amdgcn_mfma_f32_32x32x16_bf16(pa1, PK(1), o[d0], 0, 0, 0);
        o[d0] = __builtin_amdgcn_mfma_f32_32x32x16_bf16(pa2, PK(2), o[d0], 0, 0, 0);
        o[d0] = __builtin_amdgcn_mfma_f32_32x32x16_bf16(pa3, PK(3), o[d0], 0, 0, 0);
#undef PK
    }
}
__device__ __forceinline__ void cmask(f32x16& p0, f32x16& p1, int jb, int wid) {
    if (jb > (wid >> 1)) {
#pragma unroll
        for (int r = 0; r < 16; ++r) { p0[r] = -INFINITY; p1[r] = -INFINITY; } }
}
template <int THRL, bool MASK> __device__ __forceinline__ void attn_unit(int q0, int NT, const bf16* Qh, int qp, const bf16* __restrict__ Kh, int kp, const bf16* __restrict__ Vh, int vp, bf16* Oh, int op, char* shm) {
    const int tid = threadIdx.x, lane = tid & 63, r32 = lane & 31, hi = lane >> 5; const int wid = __builtin_amdgcn_readfirstlane(tid >> 6);
    const bf16* Qw = Qh + (long)(q0 + wid * QBLK) * qp;
    const unsigned lds0 = (unsigned)(uintptr_t)shm;
    float* wsf = (float*)(shm + LDS_WS) + wid * 64;
    const bf16* ksrc = Kh + (long)lane * kp + wid * 8;
    const bf16* vsrc = Vh + (long)(16 * (wid & 3) + (lane >> 2)) * vp + (wid >> 2) * 32 + (lane & 3) * 8;
    const unsigned kdst = lds0 + LDS_K + wid * 1024, vdst = lds0 + LDS_V + wid * 1024;
#define DMA_K(t, slot) glds16(ksrc + (long)(t) * KVBLK * kp, (unsigned)__builtin_amdgcn_readfirstlane(kdst + (slot)))
#define DMA_V(t, slot) glds16(vsrc + (long)(t) * KVBLK * vp, (unsigned)__builtin_amdgcn_readfirstlane(vdst + (slot)))
    const int vb0 = (int)(lds0 + LDS_V) + ((lane >> 4) & 1) * 32 + (lane & 3) * 8 + (4 * hi + ((lane & 15) >> 2)) * 64;
    const char* Kbase = shm + LDS_K; bf16x8 kf[8];
    const lds_cptr shm3 = (lds_cptr)shm; const lds_cptr kp0 = shm3 + LDS_K + hi * 1024 + r32 * 16; const lds_cptr vp0 = shm3 + LDS_V + ((lane >> 4) & 1) * 32 + (lane & 3) * 8 + (4 * hi + ((lane & 15) >> 2)) * 64;
    DMA_K(0, 0); DMA_V(0, 0); DMA_K(1, SLOTB);
    bf16x8 qr[4];
#pragma unroll
    for (int d0 = 0; d0 < 4; ++d0) qr[d0] = *reinterpret_cast<const bf16x8*>(&Qw[(long)r32 * qp + d0 * 16 + hi * 8]);
    float mhat = 0.f, l_reg = 0.f; f32x16 o[2]; o[0] = f32x16{}; o[1] = f32x16{}; f32x16 negm = f32x16{}; asm volatile("" : "+v"(negm));
#define CMASK(P0, P1, t) do { if (MASK) { int jb_ = (t) - (NT - 4); if (jb_ >= 0) cmask(P0, P1, jb_, wid); } } while (0)
    bool resc = false;
#define START(P0, P1) do { const float rm = rowmax(P0, P1); resc = false; \
    { const float dl = rm; mhat = fadd_s(mhat, dl); \
      _Pragma("unroll") for (int r = 0; r < 16; ++r) { P0[r] = fsub_s(P0[r], dl); P1[r] = fsub_s(P1[r], dl); } \
      _Pragma("unroll") for (int r = 0; r < 16; ++r) negm[r] = -mhat; asm volatile("" : "+v"(negm)); } \
    _Pragma("unroll") for (int r = 0; r < 16; ++r) P0[r] = __builtin_amdgcn_exp2f(P0[r]); } while (0)
#define RESC() do { if (resc) { asm volatile("s_waitcnt lgkmcnt(0)" ::: "memory"); \
      _Pragma("unroll") for (int d_ = 0; d_ < 2; ++d_) _Pragma("unroll") for (int r = 0; r < 16; ++r) o[d_][r] *= wsf[crow(r, hi)]; } } while (0)
    f32x16 pA0, pA1, pB0, pB1;
    int sl_prev = 0, sl_cur = 0, sl_next = SLOTB;
#define ROT() do { sl_prev = sl_cur; sl_cur = sl_next; sl_next = (sl_next == (NSLOT - 1) * SLOTB) ? 0 : sl_next + SLOTB; } while (0)
    DMA_K(2, 2 * SLOTB);
    WAIT_BAR(3);
    qkt(pA0, pA1, Kbase, qr, negm, r32, hi); asm volatile("s_nop 15\n\ts_nop 7" : "+v"(pA0), "+v"(pA1)); CMASK(pA0, pA1, 0);
    START(pA0, pA1);
    _Pragma("unroll") for (int r = 0; r < 16; ++r) pA1[r] = __builtin_amdgcn_exp2f(pA1[r]);
    WAIT_BAR(0);
    DMA_K(3, 0); DMA_V(1, SLOTB);
    ROT();
    kload8(kf, kp0 + sl_cur);
    WAIT_BAR(2);
    s16x4 vlo[8], vhi[8]; u32x4 pw0, pw1, pw2, pw3;
#define PKW(P, B) cvtpk_s(P[B], P[B + 1])
#define PAF(k) __builtin_bit_cast(bf16x8, pw##k)
#define VFR(i) (bf16x8){vlo[i][0], vlo[i][1], vlo[i][2], vlo[i][3], vhi[i][0], vhi[i][1], vhi[i][2], vhi[i][3]}
#define PIN(x) asm volatile("" : "+v"(x))
#define MX3(a, b, c) __builtin_fmaxf(__builtin_fmaxf((a), (b)), (c))
#define GAPA(MF, A0, A1, A2, A3, W0, W1, PW) do { MF; sacc += A0; sacc += A1; sacc += A2; sacc += A3; PIN(sacc); W0; W1; PIN(PW); SBAR(); } while (0)
#define EX(v) __builtin_amdgcn_exp2f(v)
#define GAPB(MF, X, B) do { MF; X[B] = EX(X[B]); X[B + 1] = EX(X[B + 1]); X[B + 2] = EX(X[B + 2]); X[B + 3] = EX(X[B + 3]); PIN(X); SBAR(); } while (0)
#define VRD(i) do { vlo[i] = vtr(vp_ + (((i) >> 2) * 4096 + ((i) & 3) * 1024)); vhi[i] = vtr(vp_ + (((i) >> 2) * 4096 + ((i) & 3) * 1024 + 512)); } while (0)
#define KRD(G, j) do { if (G) { kload2(kf, kp0 + sl_next, j); SBAR(); } } while (0)
#define STEP(C0, C1, P0, P1, t, GK, GV, GL) do { SBAR(); \
    const lds_cptr vp_ = vp0 + sl_prev; \
    VRD(0); SBAR(); float sacc = (P0[0] + P0[1]); \
    GAPA(C0 = __builtin_amdgcn_mfma_f32_32x32x16_bf16(kf[0], qr[0], negm, 0, 0, 0), P0[2], P0[3], P0[4], P0[5],     pw0[0] = PKW(P0, 0), pw0[1] = PKW(P0, 2), pw0); \
    VRD(4); SBAR(); GAPA(C1 = __builtin_amdgcn_mfma_f32_32x32x16_bf16(kf[1], qr[0], negm, 0, 0, 0), P0[6], P0[7], P0[8], P0[9],     pw0[2] = PKW(P0, 4), pw0[3] = PKW(P0, 6), pw0); \
    VRD(1); SBAR(); GAPA(C0 = __builtin_amdgcn_mfma_f32_32x32x16_bf16(kf[2], qr[1], C0, 0, 0, 0),   P0[10], P0[11], P0[12], P0[13], pw1[0] = PKW(P0, 8), pw1[1] = PKW(P0, 10), pw1); \
    VRD(5); SBAR(); GAPA(C1 = __builtin_amdgcn_mfma_f32_32x32x16_bf16(kf[3], qr[1], C1, 0, 0, 0),   P0[14], P0[15], P1[0], P1[1],   pw1[2] = PKW(P0, 12), pw1[3] = PKW(P0, 14), pw1); \
    VRD(2); SBAR(); GAPA(C0 = __builtin_amdgcn_mfma_f32_32x32x16_bf16(kf[4], qr[2], C0, 0, 0, 0),   P1[2], P1[3], P1[4], P1[5],     pw2[0] = PKW(P1, 0), pw2[1] = PKW(P1, 2), pw2); \
    VRD(6); SBAR(); GAPA(C1 = __builtin_amdgcn_mfma_f32_32x32x16_bf16(kf[5], qr[2], C1, 0, 0, 0),   P1[6], P1[7], P1[8], P1[9],     pw2[2] = PKW(P1, 4), pw2[3] = PKW(P1, 6), pw2); \
    VRD(3); SBAR(); GAPA(C0 = __builtin_amdgcn_mfma_f32_32x32x16_bf16(kf[6], qr[3], C0, 0, 0, 0),   P1[10], P1[11], P1[12], P1[13], pw3[0] = PKW(P1, 8), pw3[1] = PKW(P1, 10), pw3); \
    VRD(7); SBAR(); GAPA(C1 = __builtin_amdgcn_mfma_f32_32x32x16_bf16(kf[7], qr[3], C1, 0, 0, 0),   P1[14], P1[15], 0.f, 0.f,       pw3[2] = PKW(P1, 12), pw3[3] = PKW(P1, 14), pw3); \
    l_reg += sacc; \
    if (GK) { DMA_K((t) + 3, sl_cur); } if (GV) { DMA_V((t) + 1, sl_next); } \
    CMASK(C0, C1, t); \
    { float a = MX3(C0[0], C0[1], C1[0]), b = MX3(C0[2], C0[3], C1[1]); a = MX3(a, C1[2], C1[3]); \
      _Pragma("unroll") for (int r = 4; r < 16; r += 4) { a = MX3(a, C0[r], C0[r + 1]); b = MX3(b, C0[r + 2], C0[r + 3]); a = MX3(a, C1[r], C1[r + 1]); b = MX3(b, C1[r + 2], C1[r + 3]); } \
      float rm = __builtin_fmaxf(a, b); { auto rr = __builtin_amdgcn_permlane32_swap(__float_as_uint(rm), __float_as_uint(rm), false, false); rm = __builtin_fmaxf(__uint_as_float(rr[0]), __uint_as_float(rr[1])); } \
      resc = false; \
      if (__builtin_expect(__any(rm > (float)THRL), 0)) { const float dl = __builtin_fmaxf(rm, 0.f); mhat += dl; \
        _Pragma("unroll") for (int r = 0; r < 16; ++r) { C0[r] -= dl; C1[r] -= dl; } \
        _Pragma("unroll") for (int r = 0; r < 16; ++r) negm[r] = -mhat; asm volatile("" : "+v"(negm)); \
        const float f = __builtin_amdgcn_exp2f(-dl); l_reg *= f; if (hi == 0) wsf[r32] = f; resc = true; } } \
    SBAR(); \
    GAPB(o[0] = __builtin_amdgcn_mfma_f32_32x32x16_bf16(PAF(0), VFR(0), o[0], 0, 0, 0), C0, 0); \
    GAPB(o[1] = __builtin_amdgcn_mfma_f32_32x32x16_bf16(PAF(0), VFR(4), o[1], 0, 0, 0), C0, 4); \
    KRD(GL, 0); GAPB(o[0] = __builtin_amdgcn_mfma_f32_32x32x16_bf16(PAF(1), VFR(1), o[0], 0, 0, 0), C0, 8); \
    KRD(GL, 1); GAPB(o[1] = __builtin_amdgcn_mfma_f32_32x32x16_bf16(PAF(1), VFR(5), o[1], 0, 0, 0), C0, 12); \
    KRD(GL, 2); GAPB(o[0] = __builtin_amdgcn_mfma_f32_32x32x16_bf16(PAF(2), VFR(2), o[0], 0, 0, 0), C1, 0); \
    KRD(GL, 3); GAPB(o[1] = __builtin_amdgcn_mfma_f32_32x32x16_bf16(PAF(2), VFR(6), o[1], 0, 0, 0), C1, 4); \
    GAPB(o[0] = __builtin_amdgcn_mfma_f32_32x32x16_bf16(PAF(3), VFR(3), o[0], 0, 0, 0), C1, 8); \
    GAPB(o[1] = __builtin_amdgcn_mfma_f32_32x32x16_bf16(PAF(3), VFR(7), o[1], 0, 0, 0), C1, 12); \
    } while (0)
    int t = 1;
#undef CMASK
#define CMASK(P0, P1, t) do {} while (0)
    for (; t + 5 < NT; t += 2) {
        STEP(pB0, pB1, pA0, pA1, t, true, true, true);     WAIT_BAR(2); RESC(); ROT();
        STEP(pA0, pA1, pB0, pB1, t + 1, true, true, true); WAIT_BAR(2); RESC(); ROT();
    }
#undef CMASK
#define CMASK(P0, P1, t) do { if (MASK) { int jb_ = (t) - (NT - 4); if (jb_ >= 0) cmask(P0, P1, jb_, wid); } } while (0)
#define ENDW(tt) do { if ((tt) + 3 < NT) { WAIT_BAR(2); } else if ((tt) + 2 < NT) { WAIT_BAR(1); } else { WAIT_BAR(0); } } while (0)
    for (; t + 1 < NT; t += 2) {
        STEP(pB0, pB1, pA0, pA1, t, (t + 3 < NT), (t + 1 < NT), (t + 1 < NT));       ENDW(t);     RESC(); ROT();
        STEP(pA0, pA1, pB0, pB1, t + 1, (t + 4 < NT), (t + 2 < NT), (t + 2 < NT));   ENDW(t + 1); RESC(); ROT();
    }
    STEP(pB0, pB1, pA0, pA1, NT - 1, false, false, false); RESC();
    { float sacc = pB0[0] + pB0[1]; _Pragma("unroll") for (int r = 2; r < 16; ++r) sacc += pB0[r]; _Pragma("unroll") for (int r = 0; r < 16; ++r) sacc += pB1[r]; l_reg += sacc;
      pw0 = (u32x4){PKW(pB0, 0), PKW(pB0, 2), PKW(pB0, 4), PKW(pB0, 6)}; pw1 = (u32x4){PKW(pB0, 8), PKW(pB0, 10), PKW(pB0, 12), PKW(pB0, 14)}; pw2 = (u32x4){PKW(pB1, 0), PKW(pB1, 2), PKW(pB1, 4), PKW(pB1, 6)}; pw3 = (u32x4){PKW(pB1, 8), PKW(pB1, 10), PKW(pB1, 12), PKW(pB1, 14)};
      SBAR(); pv(o, vb0 + sl_cur, PAF(0), PAF(1), PAF(2), PAF(3)); }
#undef PKW
#undef PAF
#undef VFR
#undef PIN
#undef MX3
#undef GAPA
#undef GAPB
#undef EX
#undef VRD
#undef KRD
#undef STEP
#undef ENDW
    { auto rr = __builtin_amdgcn_permlane32_swap(__float_as_uint(l_reg), __float_as_uint(l_reg), false, false); l_reg = __uint_as_float(rr[0]) + __uint_as_float(rr[1]); }
    if (hi == 0) wsf[32 + r32] = l_reg; asm volatile("s_waitcnt lgkmcnt(0)" ::: "memory");
    float rli[16];
#pragma unroll
    for (int r = 0; r < 16; ++r) rli[r] = __builtin_amdgcn_rcpf(wsf[32 + crow(r, hi)]);
    bf16* Ow = Oh + (long)(q0 + wid * QBLK) * op;
    { bf16* stg = (bf16*)(shm + LDS_OST) + wid * 2048;
#pragma unroll
      for (int r = 0; r < 16; ++r) { const int orow = crow(r, hi);
#pragma unroll
        for (int d0 = 0; d0 < 2; ++d0) stg[orow * 64 + d0 * 32 + r32] = __float2bfloat16(o[d0][r] * rli[r]); }
      asm volatile("s_waitcnt lgkmcnt(0)" ::: "memory");
#pragma unroll
      for (int i = 0; i < 4; ++i) { const int row = i * 8 + (lane >> 3), ch = lane & 7; const u32x4 v = *(const u32x4*)(stg + row * 64 + ch * 8); *(u32x4*)(Ow + (long)row * op + ch * 8) = v; } }
    asm volatile("s_waitcnt lgkmcnt(0)\n\ts_barrier" ::: "memory");
#undef DMA_K
#undef DMA_V
#undef CMASK
#undef START
#undef RESC
#undef ROT
}

constexpr int L2_K = 0, L2_V = 3 * 8192, L2_WS = L2_V + 4 * 16384, L2_OST = L2_WS + NW * 64 * 4, L2_BYTES = L2_OST + NW * 4096;
template <bool MASK> __device__ __forceinline__ void attn_unit2(int q0, int NT, const bf16* Qh, int qp, const bf16* __restrict__ Kh, int kp, const bf16* __restrict__ Vh, int vp, bf16* Oh, int op, char* shm) {
    const int tid = threadIdx.x, lane = tid & 63, r32 = lane & 31, hi = lane >> 5; const int wid = __builtin_amdgcn_readfirstlane(tid >> 6);
    const bf16* Qw = Qh + (long)(q0 + wid * QBLK) * qp;
    const unsigned lds0 = (unsigned)(uintptr_t)shm;
    float* wsf = (float*)(shm + L2_WS) + wid * 64;
    const bf16* ksrc = Kh + (long)lane * kp + wid * 8;
    const bf16* vsrc = Vh + (long)(16 * (wid & 3) + (lane >> 2)) * vp + (wid >> 2) * 32 + (lane & 3) * 8;
    const unsigned kdst = lds0 + L2_K + wid * 1024, vdst = lds0 + L2_V + wid * 1024;
#define DMA_K(t, slot) glds16(ksrc + (long)(t) * KVBLK * kp, (unsigned)__builtin_amdgcn_readfirstlane(kdst + (slot)))
#define DMA_V(t, vslot) do { glds16(vsrc + (long)(t) * KVBLK * vp, (unsigned)__builtin_amdgcn_readfirstlane(vdst + (vslot))); \
                            glds16(vsrc + (long)(t) * KVBLK * vp + 64, (unsigned)__builtin_amdgcn_readfirstlane(vdst + (vslot) + 8192)); } while (0)
    const int vb0 = (int)(lds0 + L2_V) + ((lane >> 4) & 1) * 32 + (lane & 3) * 8 + (4 * hi + ((lane & 15) >> 2)) * 64;
    const char* Kbase = shm + L2_K; bf16x8 kf[8];
    const lds_cptr shm3 = (lds_cptr)shm; const lds_cptr kp0 = shm3 + L2_K + hi * 1024 + r32 * 16; const lds_cptr vp0 = shm3 + L2_V + ((lane >> 4) & 1) * 32 + (lane & 3) * 8 + (4 * hi + ((lane & 15) >> 2)) * 64;
    DMA_K(0, 0); DMA_V(0, 0); DMA_K(1, SLOTB);
    bf16x8 qr[4];
#pragma unroll
    for (int d0 = 0; d0 < 4; ++d0) qr[d0] = *reinterpret_cast<const bf16x8*>(&Qw[(long)r32 * qp + d0 * 16 + hi * 8]);
    float l_reg = 0.f; f32x16 o[4]; o[0] = f32x16{}; o[1] = f32x16{}; o[2] = f32x16{}; o[3] = f32x16{};
    const f32x16 zero16 = f32x16{};
#define CMASK(P0, P1, t) do { if (MASK) { int jb_ = (t) - (NT - 4); if (jb_ >= 0) cmask(P0, P1, jb_, wid); } } while (0)
    f32x16 pA0, pA1, pB0, pB1;
    int sl_prev = 0, sl_cur = 0, sl_next = SLOTB;
    int vs_rd = 0, vs_wr = 3 * 16384;
#define ROT() do { sl_prev = sl_cur; sl_cur = sl_next; sl_next = (sl_next == (NSLOT - 1) * SLOTB) ? 0 : sl_next + SLOTB; vs_rd = (vs_rd + 16384) & 65535; vs_wr = (vs_wr + 16384) & 65535; } while (0)
    DMA_K(2, 2 * SLOTB); DMA_V(1, 16384);
    WAIT_BAR(6);
    qkt(pA0, pA1, Kbase, qr, zero16, r32, hi); CMASK(pA0, pA1, 0);
    _Pragma("unroll") for (int r = 0; r < 16; ++r) { pA0[r] = __builtin_amdgcn_exp2f(pA0[r]); pA1[r] = __builtin_amdgcn_exp2f(pA1[r]); }
    WAIT_BAR(2);
    DMA_K(3, 0); DMA_V(2, 2 * 16384);
    sl_prev = sl_cur; sl_cur = sl_next; sl_next = 2 * SLOTB;
    kload8(kf, kp0 + sl_cur);
    WAIT_BAR(5);
    s16x4 f0lo, f0hi, f1lo, f1hi, f2lo, f2hi, f3lo, f3hi; u32x4 pw0, pw1, pw2, pw3;
#define PKW(P, B) cvtpk_s(P[B], P[B + 1])
#define PAF(k) __builtin_bit_cast(bf16x8, pw##k)
#define PIN(x) asm volatile("" : "+v"(x))
#define EX(v) __builtin_amdgcn_exp2f(v)
#define VOFF(id) ((((id) >> 2) * 4096) + (((id) & 3) * 1024))
#define VRD2(F, id) do { F##lo = vtr(vp_ + VOFF(id)); F##hi = vtr(vp_ + VOFF(id) + 512); } while (0)
#define VFR2(F) (bf16x8){F##lo[0], F##lo[1], F##lo[2], F##lo[3], F##hi[0], F##hi[1], F##hi[2], F##hi[3]}
#define GAPA(MF, A0, A1, A2, A3, W0, W1, PW) do { MF; sacc += A0; sacc += A1; sacc += A2; sacc += A3; PIN(sacc); W0; W1; PIN(PW); SBAR(); } while (0)
#define GAPB(MF, RD, X, B) do { MF; RD; X[B] = EX(X[B]); X[B + 1] = EX(X[B + 1]); PIN(X); SBAR(); } while (0)
#define KRD(G, j) do { if (G) { kload2(kf, kp0 + sl_next, j); SBAR(); } } while (0)
#define MF32(a, b, c) __builtin_amdgcn_mfma_f32_32x32x16_bf16(a, b, c, 0, 0, 0)
#define STEP(C0, C1, P0, P1, t, GK, GV, GL) do { SBAR(); __builtin_amdgcn_s_setprio(ATTN_PRIO_A); \
    const lds_cptr vp_ = vp0 + vs_rd; \
    float sacc = (P0[0] + P0[1]); \
    GAPA(C0 = MF32(kf[0], qr[0], zero16), P0[2], P0[3], P0[4], P0[5],     pw0[0] = PKW(P0, 0), pw0[1] = PKW(P0, 2), pw0); \
    GAPA(C1 = MF32(kf[1], qr[0], zero16), P0[6], P0[7], P0[8], P0[9],     pw0[2] = PKW(P0, 4), pw0[3] = PKW(P0, 6), pw0); \
    GAPA(C0 = MF32(kf[2], qr[1], C0),     P0[10], P0[11], P0[12], P0[13], pw1[0] = PKW(P0, 8), pw1[1] = PKW(P0, 10), pw1); \
    GAPA(C1 = MF32(kf[3], qr[1], C1),     P0[14], P0[15], P1[0], P1[1],   pw1[2] = PKW(P0, 12), pw1[3] = PKW(P0, 14), pw1); \
    VRD2(f0, 0); SBAR();  GAPA(C0 = MF32(kf[4], qr[2], C0), P1[2], P1[3], P1[4], P1[5],     pw2[0] = PKW(P1, 0), pw2[1] = PKW(P1, 2), pw2); \
    VRD2(f1, 4); SBAR();  GAPA(C1 = MF32(kf[5], qr[2], C1), P1[6], P1[7], P1[8], P1[9],     pw2[2] = PKW(P1, 4), pw2[3] = PKW(P1, 6), pw2); \
    VRD2(f2, 8); SBAR();  GAPA(C0 = MF32(kf[6], qr[3], C0), P1[10], P1[11], P1[12], P1[13], pw3[0] = PKW(P1, 8), pw3[1] = PKW(P1, 10), pw3); \
    VRD2(f3, 12); SBAR(); GAPA(C1 = MF32(kf[7], qr[3], C1), P1[14], P1[15], 0.f, 0.f,       pw3[2] = PKW(P1, 12), pw3[3] = PKW(P1, 14), pw3); \
    l_reg += sacc; __builtin_amdgcn_s_setprio(0); \
    if (GK) { DMA_K((t) + 3, sl_cur); } if (GV) { DMA_V((t) + 2, vs_wr); } \
    CMASK(C0, C1, t); \
    SBAR(); __builtin_amdgcn_s_setprio(ATTN_PRIO_B); \
    GAPB(o[0] = MF32(PAF(0), VFR2(f0), o[0]), VRD2(f0, 1),  C0, 0); \
    GAPB(o[1] = MF32(PAF(0), VFR2(f1), o[1]), VRD2(f1, 5),  C0, 2); \
    GAPB(o[2] = MF32(PAF(0), VFR2(f2), o[2]), VRD2(f2, 9),  C0, 4); \
    GAPB(o[3] = MF32(PAF(0), VFR2(f3), o[3]), VRD2(f3, 13), C0, 6); \
    KRD(GL, 0); GAPB(o[0] = MF32(PAF(1), VFR2(f0), o[0]), VRD2(f0, 2),  C0, 8); \
    GAPB(o[1] = MF32(PAF(1), VFR2(f1), o[1]), VRD2(f1, 6),  C0, 10); \
    KRD(GL, 1); GAPB(o[2] = MF32(PAF(1), VFR2(f2), o[2]), VRD2(f2, 10), C0, 12); \
    GAPB(o[3] = MF32(PAF(1), VFR2(f3), o[3]), VRD2(f3, 14), C0, 14); \
    KRD(GL, 2); GAPB(o[0] = MF32(PAF(2), VFR2(f0), o[0]), VRD2(f0, 3),  C1, 0); \
    GAPB(o[1] = MF32(PAF(2), VFR2(f1), o[1]), VRD2(f1, 7),  C1, 2); \
    KRD(GL, 3); GAPB(o[2] = MF32(PAF(2), VFR2(f2), o[2]), VRD2(f2, 11), C1, 4); \
    GAPB(o[3] = MF32(PAF(2), VFR2(f3), o[3]), VRD2(f3, 15), C1, 6); \
    GAPB(o[0] = MF32(PAF(3), VFR2(f0), o[0]), (void)0, C1, 8); \
    GAPB(o[1] = MF32(PAF(3), VFR2(f1), o[1]), (void)0, C1, 10); \
    GAPB(o[2] = MF32(PAF(3), VFR2(f2), o[2]), (void)0, C1, 12); \
    GAPB(o[3] = MF32(PAF(3), VFR2(f3), o[3]), (void)0, C1, 14); __builtin_amdgcn_s_setprio(0); \
    } while (0)
    int t = 1;
#undef CMASK
#define CMASK(P0, P1, t) do {} while (0)
    for (; t + 5 < NT; t += 2) {
        STEP(pB0, pB1, pA0, pA1, t, true, true, true);     WAIT_BAR(5); ROT();
        STEP(pA0, pA1, pB0, pB1, t + 1, true, true, true); WAIT_BAR(5); ROT();
    }
#undef CMASK
#define CMASK(P0, P1, t) do { if (MASK) { int jb_ = (t) - (NT - 4); if (jb_ >= 0) cmask(P0, P1, jb_, wid); } } while (0)
#define ENDW(tt) do { if ((tt) + 3 < NT) { WAIT_BAR(5); } else if ((tt) + 2 < NT) { WAIT_BAR(4); } else { WAIT_BAR(0); } } while (0)
    for (; t + 1 < NT; t += 2) {
        STEP(pB0, pB1, pA0, pA1, t, (t + 3 < NT), (t + 2 < NT), (t + 1 < NT));       ENDW(t);     ROT();
        STEP(pA0, pA1, pB0, pB1, t + 1, (t + 4 < NT), (t + 3 < NT), (t + 2 < NT));   ENDW(t + 1); ROT();
    }
    STEP(pB0, pB1, pA0, pA1, NT - 1, false, false, false);
    { float sacc = pB0[0] + pB0[1]; _Pragma("unroll") for (int r = 2; r < 16; ++r) sacc += pB0[r]; _Pragma("unroll") for (int r = 0; r < 16; ++r) sacc += pB1[r]; l_reg += sacc;
      pw0 = (u32x4){PKW(pB0, 0), PKW(pB0, 2), PKW(pB0, 4), PKW(pB0, 6)}; pw1 = (u32x4){PKW(pB0, 8), PKW(pB0, 10), PKW(pB0, 12), PKW(pB0, 14)}; pw2 = (u32x4){PKW(pB1, 0), PKW(pB1, 2), PKW(pB1, 4), PKW(pB1, 6)}; pw3 = (u32x4){PKW(pB1, 8), PKW(pB1, 10), PKW(pB1, 12), PKW(pB1, 14)};
      SBAR();
      const lds_cptr vp_ = vp0 + ((vs_rd + 16384) & 65535);
#pragma unroll
      for (int db = 0; db < 4; ++db) { VRD2(f0, db * 4 + 0); VRD2(f1, db * 4 + 1); VRD2(f2, db * 4 + 2); VRD2(f3, db * 4 + 3);
          o[db] = MF32(PAF(0), VFR2(f0), o[db]); o[db] = MF32(PAF(1), VFR2(f1), o[db]); o[db] = MF32(PAF(2), VFR2(f2), o[db]); o[db] = MF32(PAF(3), VFR2(f3), o[db]); } }
#undef PKW
#undef PAF
#undef PIN
#undef EX
#undef VOFF
#undef VRD2
#undef VFR2
#undef GAPA
#undef GAPB
#undef KRD
#undef MF32
#undef STEP
#undef ENDW
    { auto rr = __builtin_amdgcn_permlane32_swap(__float_as_uint(l_reg), __float_as_uint(l_reg), false, false); l_reg = __uint_as_float(rr[0]) + __uint_as_float(rr[1]); }
    if (hi == 0) wsf[32 + r32] = l_reg; asm volatile("s_waitcnt lgkmcnt(0)" ::: "memory");
    float rli[16];
#pragma unroll
    for (int r = 0; r < 16; ++r) rli[r] = __builtin_amdgcn_rcpf(wsf[32 + crow(r, hi)]);
    bf16* Ow = Oh + (long)(q0 + wid * QBLK) * op;
    { bf16* stg = (bf16*)(shm + L2_OST) + wid * 2048;
#pragma unroll
      for (int dh = 0; dh < 2; ++dh) {
#pragma unroll
        for (int r = 0; r < 16; ++r) { const int orow = crow(r, hi);
#pragma unroll
          for (int d0 = 0; d0 < 2; ++d0) stg[orow * 64 + d0 * 32 + r32] = __float2bfloat16(o[dh * 2 + d0][r] * rli[r]); }
        asm volatile("s_waitcnt lgkmcnt(0)" ::: "memory");
#pragma unroll
        for (int i = 0; i < 4; ++i) { const int row = i * 8 + (lane >> 3), ch = lane & 7; const u32x4 v = *(const u32x4*)(stg + row * 64 + ch * 8); *(u32x4*)(Ow + (long)row * op + dh * 64 + ch * 8) = v; }
        asm volatile("s_waitcnt lgkmcnt(0)" ::: "memory"); } }
    asm volatile("s_waitcnt lgkmcnt(0)\n\ts_barrier" ::: "memory");
#undef DMA_K
#undef DMA_V
#undef CMASK
#undef ROT
}
#undef SBAR
#undef WAIT_BAR
}

#define XB_TMO      128
#define XB_XCNT(j)  (256  + 64 * (j))
#define XB_XSUB(j)  (1280 + 64 * (j))
#define XB_XGEN(j)  (2304 + 64 * (j))
#define XB_TOP      3328
#define XB_TOPGEN   3392
#define XCD_BAR_WORDS 3456
#define XB_SPIN_CAP (1u << 22)
__device__ __forceinline__ unsigned xb_ld(unsigned* p)              { return __hip_atomic_load(p, __ATOMIC_RELAXED, __HIP_MEMORY_SCOPE_AGENT); }
__device__ __forceinline__ unsigned xb_add(unsigned* p, unsigned v) { return __hip_atomic_fetch_add(p, v, __ATOMIC_RELAXED, __HIP_MEMORY_SCOPE_AGENT); }
__device__ __forceinline__ unsigned xb_xcc_id() { return (unsigned)__builtin_amdgcn_s_getreg((3 << 11) | 20) & 0xFu; }
#define XB_SPIN(cond, bar) do { unsigned _sp = 0; while (cond) { __builtin_amdgcn_s_sleep(1); \
    if ((++_sp & 255u) == 0u) { if (xb_ld(&(bar)[XB_TMO])) break; if (_sp > XB_SPIN_CAP) { atomicAdd(&(bar)[XB_TMO], 1u); break; } } } } while (0)
struct XcdBarrier { unsigned* bar; unsigned x; volatile LAS unsigned* st; };
__device__ __forceinline__ XcdBarrier xcd_barrier_post(unsigned* bar, volatile LAS unsigned* st) {
    XcdBarrier b; b.bar = bar; b.x = xb_xcc_id(); b.st = st;
    if (threadIdx.x == 0) (void)xb_add(&bar[XB_XCNT(b.x)], 1u);
    return b;
}
__device__ __forceinline__ void xcd_barrier_complete(unsigned* bar, unsigned x, unsigned& nloc, unsigned& nx) {
    const unsigned G = gridDim.x * gridDim.y * gridDim.z;
    unsigned sum, cnt, mine, sp = 0u;
    for (;;) {
        sum = 0u; cnt = 0u; mine = 0u;
#pragma unroll
        for (unsigned j = 0; j < 16; ++j) { const unsigned c = xb_ld(&bar[XB_XCNT(j)]); sum += c; cnt += (c > 0u) ? 1u : 0u; mine = (j == x) ? c : mine; }
        if (sum == G) break;
        __builtin_amdgcn_s_sleep(1);
        if ((++sp & 255u) == 0u) { if (xb_ld(&bar[XB_TMO])) break; if (sp > XB_SPIN_CAP) { atomicAdd(&bar[XB_TMO], 1u); break; } }
    }
    nloc = mine > 0u ? mine : 1u; nx = cnt > 0u ? cnt : 1u;
}
__device__ __forceinline__ void xcd_barrier(const XcdBarrier& b) {
    asm volatile("s_waitcnt vmcnt(0)" ::: "memory");
    __syncthreads();
    if (threadIdx.x == 0) {
        unsigned* bar = b.bar;
        __builtin_amdgcn_s_waitcnt(0);
        unsigned nloc = b.st[0], nx = b.st[1];
        if (nloc == 0u) { xcd_barrier_complete(bar, b.x, nloc, nx); b.st[0] = nloc; b.st[1] = nx; }
        const unsigned old = xb_add(&bar[XB_XSUB(b.x)], 1u);
        const unsigned gen = old / nloc;
        if (old + 1u == (gen + 1u) * nloc) {
            __builtin_amdgcn_fence(__ATOMIC_RELEASE, "agent");
            asm volatile("s_waitcnt vmcnt(0)" ::: "memory");
            const unsigned og = xb_add(&bar[XB_TOP], 1u);
            const unsigned tg = og / nx;
            if (og + 1u == (tg + 1u) * nx) xb_add(&bar[XB_TOPGEN], 1u);
            else XB_SPIN(xb_ld(&bar[XB_TOPGEN]) == tg, bar);
            __builtin_amdgcn_fence(__ATOMIC_ACQUIRE, "agent");
            xb_add(&bar[XB_XGEN(b.x)], 1u);
            asm volatile("s_waitcnt vmcnt(0)" ::: "memory");
        } else {
            XB_SPIN(xb_ld(&bar[XB_XGEN(b.x)]) == gen, bar);
            __builtin_amdgcn_fence(__ATOMIC_ACQUIRE, "agent");
            asm volatile("s_waitcnt vmcnt(0)" ::: "memory");
        }
    }
    __syncthreads();
}

constexpr int RING_BYTES = 131072;
constexpr int MISC_OFF = RING_BYTES;
constexpr int LDS_BYTES = 147456;
constexpr int NWAVES = 8;

struct Args {
    const float* in[29]; float* out; unsigned char* ws; int ph_lo, ph_hi;
};
enum { I_X = 0, I_MEM, I_NORM1, I_WIN, I_BGATE, I_QN, I_KN, I_LQ1, I_LK1, I_LQ2, I_LK2, I_SUBLN, I_WPOOL, I_PSCALE, I_MEMNORM, I_WMKV, I_MQN, I_MKN, I_WBRD, I_WBRP, I_WBRM, I_WOUT, I_NORM2,
       I_WROUTER, I_BROUTER, I_WGU, I_BGU, I_WD, I_BD };

__device__ __forceinline__ unsigned f2bf(float f) { unsigned u = __builtin_bit_cast(unsigned, f); return (u + 0x7fffu + ((u >> 16) & 1u)) >> 16; }
__device__ __forceinline__ unsigned pk2(float lo, float hi) { return f2bf(lo) | (f2bf(hi) << 16); }
__device__ __forceinline__ void p0_transpose_item(const float* W, int K, int N, bf16_t* WT, LAS float* scr, int item, int lane, int ldo = 0) {
    if (ldo == 0) ldo = K;
    const int nblk = N / 64, kb = item / nblk, nb = item % nblk, k0 = 64 * kb, n0 = 64 * nb;
    const int kr = lane >> 3, n4 = (lane & 7) * 4;
    f32x4 v[16];
#pragma unroll
    for (int i = 0; i < 16; ++i) v[i] = *(const f32x4*)(W + (size_t)(k0 + 8 * (i & 7) + kr) * N + n0 + 32 * (i >> 3) + n4);
#pragma unroll
    for (int h = 0; h < 2; ++h) {
#pragma unroll
        for (int i = 0; i < 8; ++i)
#pragma unroll
            for (int j = 0; j < 4; ++j) scr[(n4 + j) * 68 + 8 * i + kr] = v[h * 8 + i][j];
        LDS_WAIT(); asm volatile("" ::: "memory");
        const int c = lane & 7;
#pragma unroll
        for (int jj = 0; jj < 4; ++jj) { const int nrow = 8 * jj + (lane >> 3); const LAS f32x4* sp = (const LAS f32x4*)(scr + nrow * 68 + 8 * c);
            const f32x4 a = sp[0], b = sp[1];
            u32x4 o; o.x = pk2(a[0], a[1]); o.y = pk2(a[2], a[3]); o.z = pk2(b[0], b[1]); o.w = pk2(b[2], b[3]);
            *(u32x4*)(WT + (size_t)(n0 + 32 * h + nrow) * ldo + k0 + 8 * c) = o; }
        LDS_WAIT(); asm volatile("" ::: "memory");
    }
}
__device__ __forceinline__ void p0_transpose_item_f8(const float* W, int K, int N, unsigned char* WT, LAS float* scr, int item, int lane) {
    const int nblk = N / 64, kb = item / nblk, nb = item % nblk, k0 = 64 * kb, n0 = 64 * nb;
    const int kr = lane >> 3, n4 = (lane & 7) * 4;
    f32x4 v[16];
#pragma unroll
    for (int i = 0; i < 16; ++i) v[i] = *(const f32x4*)(W + (size_t)(k0 + 8 * (i & 7) + kr) * N + n0 + 32 * (i >> 3) + n4);
#pragma unroll
    for (int h = 0; h < 2; ++h) {
#pragma unroll
        for (int i = 0; i < 8; ++i)
#pragma unroll
            for (int j = 0; j < 4; ++j) scr[(n4 + j) * 68 + 8 * i + kr] = v[h * 8 + i][j];
        LDS_WAIT(); asm volatile("" ::: "memory");
        const int c = lane & 7;
#pragma unroll
        for (int jj = 0; jj < 4; ++jj) { const int nrow = 8 * jj + (lane >> 3); const LAS f32x4* sp = (const LAS f32x4*)(scr + nrow * 68 + 8 * c);
            const f32x4 a = sp[0] * W8_SCALE, b = sp[1] * W8_SCALE;
            u32x2 o; o.x = pk4_fp8(a[0], a[1], a[2], a[3]); o.y = pk4_fp8(b[0], b[1], b[2], b[3]);
            *(u32x2*)(WT + (size_t)(n0 + 32 * h + nrow) * K + k0 + 8 * c) = o; }
        LDS_WAIT(); asm volatile("" ::: "memory");
    }
}
__device__ __forceinline__ void rms_row_to_bf16(const float* xrow, const float* gain, bf16_t* orow, int lane) {
    const f32x4* xr = (const f32x4*)xrow + lane; const f32x4* gr = (const f32x4*)gain + lane;
    f32x4 v[4]; float s = 0.f;
#pragma unroll
    for (int j = 0; j < 4; ++j) { v[j] = xr[64 * j]; s += (v[j].x * v[j].x + v[j].y * v[j].y) + (v[j].z * v[j].z + v[j].w * v[j].w); }
    const float rstd = 1.f / sqrtf(wave_sum(s) * (1.f / 1024.f) + RMS_EPS);
    u32x2* o8 = (u32x2*)orow + lane;
#pragma unroll
    for (int j = 0; j < 4; ++j) { const f32x4 g = gr[64 * j]; u32x2 w; w.x = pk2(v[j].x * rstd * g.x, v[j].y * rstd * g.y); w.y = pk2(v[j].z * rstd * g.z, v[j].w * rstd * g.w); o8[64 * j] = w; }
}

__device__ __forceinline__ void cvt_item64_f8(const float* W, int K, int N, unsigned char* WT, int item, int lane) {
    const int nblk = N / 64, kb = item / nblk, nb = item % nblk, k0 = 64 * kb, n0 = 64 * nb;
    const char* base = (const char*)(W + (size_t)k0 * N + n0);
    unsigned off = (unsigned)lane * 4u; const unsigned rstep = (unsigned)N * 4u;
    float v[64];
#pragma unroll
    for (int j = 0; j < 64; ++j) { v[j] = __builtin_nontemporal_load((const float*)(base + off)); off += rstep; }
    unsigned char* dst = WT + (size_t)(n0 + lane) * K + k0;
#pragma unroll
    for (int c = 0; c < 4; ++c) { u32x4 o;
#pragma unroll
        for (int q = 0; q < 4; ++q) { int r = __builtin_amdgcn_cvt_pk_fp8_f32(v[16 * c + 4 * q] * W8_SCALE, v[16 * c + 4 * q + 1] * W8_SCALE, 0, false);
            r = __builtin_amdgcn_cvt_pk_fp8_f32(v[16 * c + 4 * q + 2] * W8_SCALE, v[16 * c + 4 * q + 3] * W8_SCALE, r, true); o[q] = (unsigned)r; }
        *(u32x4*)(dst + 16 * c) = o; }
}
struct CvtJob {
    const float* wgu; const float* wd; unsigned char* wgu_t; unsigned char* wd_t; int ngw, gw, lane;
    __device__ __forceinline__ void item(int j) const {
        const int it = gw + j * ngw; if (it >= 24576) return;
        const bool gu = it < 16384; const int r = gu ? it : it - 16384, e = gu ? (r >> 9) : (r >> 8), idx = gu ? (r & 511) : (r & 255), N = gu ? 2048 : 1024;
        const float* W = gu ? wgu + (size_t)e * 1024 * 2048 : wd + (size_t)e * 1024 * 1024; unsigned char* WT = gu ? wgu_t + (size_t)e * 2048 * 1024 : wd_t + (size_t)e * 1024 * 1024;
        cvt_item64_f8(W, 1024, N, WT, idx, lane);
    }
};
struct PostCvt { CvtJob J; int jbase, jend; __device__ __forceinline__ void operator()(int ui) const { const int j = jbase + ui; if (j < jend) J.item(j); } };
struct Args;
typedef __attribute__((address_space(4))) const Args* kargs_t;
__device__ __forceinline__ kargs_t kargs() { kargs_t p = (kargs_t)__builtin_amdgcn_kernarg_segment_ptr(); asm volatile("" : "+s"(p)); return p; }
__global__ void __launch_bounds__(NWAVES * 64, 2) fwd_kernel(Args args) {
    extern __shared__ __attribute__((aligned(16))) unsigned char lds_raw[];
    cg::grid_group grid = cg::this_grid();
    LAS unsigned char* lds = (LAS unsigned char*)lds_raw;
    const int tid = threadIdx.x, lane = tid & 63, wave = __builtin_amdgcn_readfirstlane(tid >> 6);
    const int G = gridDim.x, bx = blockIdx.x; const int vcu = (G % 8 == 0) ? (bx % 8) * (G / 8) + bx / 8 : bx;
    const int gw = vcu * NWAVES + wave, NGW = G * NWAVES;
    const int lo = args.ph_lo, hi = args.ph_hi;
    if (tid < 64) ((LAS unsigned*)(lds + MISC_OFF + 1024))[tid] = 0u;
    __syncthreads();
    const XcdBarrier xbar = xcd_barrier_post((unsigned*)(args.ws + WS_CTL) + CW_BAR, (volatile LAS unsigned*)(lds + MISC_OFF + 1024));
#ifndef PHMASK
#define PHMASK 0x3ff
#endif
#define IN(k) (((PHMASK >> (k)) & 1) && lo <= (k) && (k) < hi)
#define GSYNC() do { asm volatile("s_waitcnt vmcnt(0) lgkmcnt(0)" ::: "memory"); __syncthreads(); grid.sync(); asm volatile("s_waitcnt vmcnt(0)" ::: "memory"); __syncthreads(); } while (0)
#define SEAM(k) do { if (lo <= (k) && (k) + 1 < hi) { xcd_barrier(xbar); } } while (0)
#define WSP(TY, off) ((TY*)(ka->ws + (off)))
#define WIN_T WSP(bf16_t, WS_WIN_T)
#define WBRD_T WSP(bf16_t, WS_WBRD_T)
#define WBRP_T WSP(bf16_t, WS_WBRP_T)
#define WBRM_T WSP(bf16_t, WS_WBRM_T)
#define WOUT_T WSP(bf16_t, WS_WOUT_T)
#define WMKV_T WSP(bf16_t, WS_WMKV_T)
#define WGU_T WSP(bf16_t, WS_WGU_T)
#define WD_T WSP(bf16_t, WS_WD_T)
#define XN WSP(bf16_t, WS_XN)
#define Qb WSP(bf16_t, WS_Q)
#define Kb WSP(bf16_t, WS_K)
#define Vb WSP(bf16_t, WS_V)
#define Ub WSP(bf16_t, WS_U)
#define MQb WSP(bf16_t, WS_MQ)
#define OC WSP(bf16_t, WS_OC)
#define GATES WSP(bf16_t, WS_GATES)
#define YCAT WSP(bf16_t, WS_YCAT)
#define MERGF WSP(float, WS_MERGF)
#define MERGB WSP(bf16_t, WS_MERGB)
#define XG WSP(bf16_t, WS_XG)
#define ACT WSP(bf16_t, WS_A)
#define Y4 WSP(bf16_t, WS_B)
#define MEMN WSP(bf16_t, WS_MEMN)
#define MKV WSP(bf16_t, WS_MKV)
#define ROPE WSP(f32x2, WS_ROPE)
#define WR2 WSP(float, WS_WR2)
#define ROUTEW WSP(float, WS_ROUTEW)
#define LAMP WSP(float, WS_LAM)
#define LIST WSP(u32x2, WS_LIST)
#define CNT WSP(unsigned, WS_CTL)
#define OUT (ka->out)
#define KA const kargs_t ka = kargs()

    if (lo > 1000) GSYNC();
    if (IN(0)) for (int rep_ = 0; rep_ < 1 + ((REPEAT_MASK >> 0) & 1); ++rep_) { KA; if (rep_) __syncthreads();
        LAS float* scr = (LAS float*)(lds + wave * 16384);
        constexpr int I0 = 16 * 80, I1 = 8 * 16, I2 = 4 * 16, I3 = 4 * 16, I4 = 16 * 16, I5 = 16 * 8, I6 = 0, I7 = 0;
        constexpr int NITEMS = I0 + I1 + I2 + I3 + I4 + I5 + I6 + I7;
        for (int it = gw; it < NITEMS; it += NGW) {
            int r = it;
            if (r < I0) { p0_transpose_item(ka->in[I_WIN], 1024, 5120, WIN_T, scr, r, lane); continue; } r -= I0;
            if (r < I1) { p0_transpose_item(ka->in[I_WBRD], 512, 1024, WBRD_T, scr, r, lane, 1024); continue; } r -= I1;
            if (r < I2) { p0_transpose_item(ka->in[I_WBRP], 256, 1024, WBRD_T + 512, scr, r, lane, 1024); continue; } r -= I2;
            if (r < I3) { p0_transpose_item(ka->in[I_WBRM], 256, 1024, WBRD_T + 768, scr, r, lane, 1024); continue; } r -= I3;
            if (r < I4) { p0_transpose_item(ka->in[I_WOUT], 1024, 1024, WOUT_T, scr, r, lane); continue; } r -= I4;
            p0_transpose_item(ka->in[I_WMKV], 1024, 512, WMKV_T, scr, r, lane);
        }
        for (int m = gw; m < T; m += NGW) rms_row_to_bf16(ka->in[I_X] + (size_t)m * 1024, ka->in[I_NORM1], XN + (size_t)m * 1024, lane);
        for (int m = gw; m < BATCH * MEMLEN; m += NGW) rms_row_to_bf16(ka->in[I_MEM] + (size_t)m * 1024, ka->in[I_MEMNORM], MEMN + (size_t)m * 1024, lane);
        for (int i = bx * 512 + tid; i < SEQ * 32; i += G * 512) { const int pos = i >> 5, j = i & 31;
            const float inv = 1.0f / powf(10000.0f, (float)(2 * j) / 64.0f); const float ang = (float)pos * inv;
            const double a = (double)ang; const double k = rint(a * 0.15915494309189535); const float red = (float)(a - k * 6.283185307179586);
            ROPE[i] = (f32x2){cosf(red), sinf(red)}; }
        for (int i = bx * 512 + tid; i < 1024 * 32; i += G * 512) { const int ii = i & 3, e = (i >> 2) & 15, kq = (i >> 6) & 3, eb = (i >> 8) & 1, s = i >> 9; const int k = 16 * s + 4 * kq + ii;
            WR2[i] = ka->in[I_NORM2][k] * ka->in[I_WROUTER][k * 32 + eb * 16 + e]; }
        if (bx == 0 && wave == 0) { const float s1 = wave_sum(ka->in[I_LQ1][lane] * ka->in[I_LK1][lane]), s2 = wave_sum(ka->in[I_LQ2][lane] * ka->in[I_LK2][lane]);
            if (lane == 0) LAMP[0] = expf(s1) - expf(s2) + 0.2f; }
    }
    SEAM(0);
    if (IN(1)) for (int rep_ = 0; rep_ < 1 + ((REPEAT_MASK >> 1) & 1); ++rep_) { KA; if (rep_) __syncthreads();
#if defined(TAP) && TAP == 6
        { pg8::DenseProb P{XN, WIN_T, 1024, 1024, 1024}; pg8::StaticOrder S; S.init(T, INW, G, bx);
          pg8::EpiPlain E{WSP(bf16_t, WS_B), 5120};
          pg8::gemm_phase<pg8::EpiPlain, pg8::DenseProb, pg8::StaticOrder, true>(lds, P, S, E); }
#else
        const CvtJob J{ka->in[I_WGU], ka->in[I_WD], (unsigned char*)WGU_T, (unsigned char*)WD_T, NGW, gw, lane};
        const int kpre = bx & 7;
        for (int j = 0; j < kpre; ++j) J.item(j);
        { pg8::DenseProb P{XN, WIN_T, 1024, 1024, 1024}; pg8::StaticOrder S0; S0.init(T, INW, G, bx); const pg8::TableOrder S = pg8::build_unit_table(S0, (LAS int*)(lds + MISC_OFF + 2048));
          pg8::EpiInProj E{Qb, Kb, Vb, Ub, MQb, GATES, ka->in[I_QN], ka->in[I_KN], ka->in[I_MQN], ka->in[I_BGATE], ROPE};
          const PostCvt PU{J, kpre, 12};
          pg8::gemm_phase<pg8::EpiInProj, pg8::DenseProb, pg8::TableOrder, ALIGN_EPI_SEL, PostCvt>(lds, P, S, E, PU); }
        for (int j = kpre + 10; j < 12; ++j) J.item(j);
#endif
        for (int tile = bx; tile < 256; tile += G) {
            const int rt = tile >> 3, ct = tile & 7, r32 = lane & 31, hh = lane >> 5;
            const bf16_t* ap = MEMN + (size_t)(32 * rt + r32) * 1024 + 128 * wave + 8 * hh; const bf16_t* bp = WMKV_T + (size_t)(64 * ct + r32) * 1024 + 128 * wave + 8 * hh;
            bf16x8 af[8], b0[8], b1[8];
#pragma unroll
            for (int ks = 0; ks < 8; ++ks) { af[ks] = *(const bf16x8*)(ap + 16 * ks); b0[ks] = *(const bf16x8*)(bp + 16 * ks); b1[ks] = *(const bf16x8*)(bp + 32 * 1024 + 16 * ks); }
            f32x16 c0 = f32x16{}, c1 = f32x16{};
#pragma unroll
            for (int ks = 0; ks < 8; ++ks) { c0 = __builtin_amdgcn_mfma_f32_32x32x16_bf16(af[ks], b0[ks], c0, 0, 0, 0); c1 = __builtin_amdgcn_mfma_f32_32x32x16_bf16(af[ks], b1[ks], c1, 0, 0, 0); }
            LAS float* part = (LAS float*)lds;
            __syncthreads();
#pragma unroll
            for (int r = 0; r < 16; ++r) { const int row = (r & 3) + 8 * (r >> 2) + 4 * hh; part[(wave * 32 + row) * 64 + r32] = c0[r]; part[(wave * 32 + row) * 64 + 32 + r32] = c1[r]; }
            __syncthreads();
            const int row = tid >> 4, c4 = (tid & 15) * 4; f32x4 a = {0.f, 0.f, 0.f, 0.f};
#pragma unroll
            for (int w = 0; w < 8; ++w) a += *(const LAS f32x4*)(part + (w * 32 + row) * 64 + c4);
            if (ct < 4) {
                float ss = (a[0] * a[0] + a[1] * a[1]) + (a[2] * a[2] + a[3] * a[3]);
                ss += __shfl_xor(ss, 1); ss += __shfl_xor(ss, 2); ss += __shfl_xor(ss, 4); ss += __shfl_xor(ss, 8);
                const float rstd = 1.0f / sqrtf(ss * (1.0f / 64.0f) + RMS_EPS); const f32x4 g = *(const f32x4*)(ka->in[I_MKN] + c4); a = a * rstd * g; }
            u32x2 o; o.x = cvt_pk_bf16(a[0], a[1]); o.y = cvt_pk_bf16(a[2], a[3]);
            *(u32x2*)(MKV + (size_t)(32 * rt + row) * 512 + 64 * ct + c4) = o;
        }
        __syncthreads();
    }
    SEAM(1);
    if (IN(2)) for (int rep_ = 0; rep_ < 1 + ((REPEAT_MASK >> 2) & 1); ++rep_) { KA; if (rep_) __syncthreads();
        using abf = attn_body::bf16;
        {
            const int bh = vcu >> 4, b = bh >> 2, h = bh & 3, s = vcu & 15; const size_t rb = (size_t)b * SEQ;
            const float lam = LAMP[0];
            for (int i2 = 0; i2 < 4 * (1 + ((REPEAT_MASK >> 10) & 1)); ++i2) { const int ii = i2 & 3, c = ii & 1; const int qb = (ii < 2) ? s : 31 - s;
                attn_body::attn_unit2<true>(qb * 256, 4 * qb + 4, (const abf*)Qb + rb * 512 + (c * 4 + h) * 64, 512, (const abf*)Kb + rb * 512 + (c * 4 + h) * 64, 512,
                                            (const abf*)Vb + rb * 512 + h * 128, 512, (abf*)OC + rb * 1024 + (c * 4 + h) * 128, 1024, (char*)lds_raw);
                if (c == 1) {
                    asm volatile("s_waitcnt vmcnt(0)" ::: "memory");
#pragma unroll 1
                    for (int ps = 0; ps < 2; ++ps) {
                    const int row = ps * 16 + (lane >> 2), dq = (lane & 3) * 32; const size_t t = rb + (size_t)qb * 256 + wave * 32 + row;
                    const bf16_t* p0 = OC + t * 1024 + h * 128 + dq; const bf16_t* p1 = p0 + 512;
                    u32x4 a[4], bb[4];
#pragma unroll
                    for (int j = 0; j < 4; ++j) { a[j] = *(const u32x4*)(p0 + 8 * j); bb[j] = *(const u32x4*)(p1 + 8 * j); }
                    float ss = 0.f; f32x4 y[4][2];
#pragma unroll
                    for (int j = 0; j < 4; ++j) {
                        y[j][0] = (f32x4){bf_lo(a[j].x) - lam * bf_lo(bb[j].x), bf_hi(a[j].x) - lam * bf_hi(bb[j].x), bf_lo(a[j].y) - lam * bf_lo(bb[j].y), bf_hi(a[j].y) - lam * bf_hi(bb[j].y)};
                        y[j][1] = (f32x4){bf_lo(a[j].z) - lam * bf_lo(bb[j].z), bf_hi(a[j].z) - lam * bf_hi(bb[j].z), bf_lo(a[j].w) - lam * bf_lo(bb[j].w), bf_hi(a[j].w) - lam * bf_hi(bb[j].w)};
#pragma unroll
                        for (int q = 0; q < 4; ++q) ss += y[j][0][q] * y[j][0][q] + y[j][1][q] * y[j][1][q]; }
                    ss += __shfl_xor(ss, 1); ss += __shfl_xor(ss, 2);
                    const float rstd = 0.8f / sqrtf(ss * (1.0f / 128.0f) + RMS_EPS);
                    const float* sg = ka->in[I_SUBLN] + dq; bf16_t* yo = YCAT + t * 1024 + h * 128 + dq;
#pragma unroll
                    for (int j = 0; j < 4; ++j) { const f32x4 s0 = *(const f32x4*)(sg + 8 * j), s1 = *(const f32x4*)(sg + 8 * j + 4); pg8::store8(yo + 8 * j, y[j][0] * rstd * s0, y[j][1] * rstd * s1); }
                    }
                }
            }
        }
        {
            for (int i = 0; i < 2; ++i) { const int idx = vcu * 2 + i; if (idx >= 512) break; const int b = idx >> 7, h = (idx >> 5) & 3, qb = idx & 31;
                attn_body::attn_unit<8, false>(qb * 256, 4, (const abf*)MQb + (size_t)b * SEQ * 256 + h * 64, 256, (const abf*)MKV + (size_t)b * MEMLEN * 512 + h * 64, 512,
                                               (const abf*)MKV + (size_t)b * MEMLEN * 512 + 256 + h * 64, 512, (abf*)YCAT + (size_t)b * SEQ * 1024 + 768 + h * 64, 1024, (char*)lds_raw); }
        }
        {
            LAS bf16_t* ul = (LAS bf16_t*)lds;
            LAS bf16_t* pb = (LAS bf16_t*)(lds + 24576);
            const int col = tid & 255, half = tid >> 8, w = 2 << (col >> 6);
            const int mg = wave & 3, mdh = wave >> 2, r32 = lane & 31, hh = lane >> 5;
            bf16x8 bw[4];
#pragma unroll
            for (int sx = 0; sx < 4; ++sx) { const float* wp = ka->in[I_WPOOL] + (size_t)(mg * 64 + 16 * sx + 8 * hh) * 64 + mdh * 32 + r32;
                u32x4 pk; pk.x = pk2(wp[0], wp[64]); pk.y = pk2(wp[128], wp[192]); pk.z = pk2(wp[256], wp[320]); pk.w = pk2(wp[384], wp[448]); bw[sx] = __builtin_bit_cast(bf16x8, pk); }
            const int ocol = mg * 64 + mdh * 32 + r32; const float psc = ka->in[I_PSCALE][ocol];
            for (int tile = vcu; tile < T / 32; tile += G) {
                const int t0 = tile * 32, p0 = t0 & (SEQ - 1);
                __syncthreads();
                for (int pc = tid; pc < 47 * 32; pc += 512) { const int r = pc >> 5, ch = pc & 31; const int pos = p0 - 15 + r;
                    u32x4 v = {0u, 0u, 0u, 0u}; if (pos >= 0) v = *(const u32x4*)(Ub + (size_t)(t0 - 15 + r) * 256 + ch * 8);
                    *(LAS u32x4*)(ul + r * 256 + ch * 8) = v; }
                __syncthreads();
                {
                    float sum = 0.f; const int rbase = 15 + 16 * half;
                    for (int i = 1; i < w; ++i) sum += __uint_as_float((unsigned)ul[(rbase - i) * 256 + col] << 16);
#pragma unroll
                    for (int tk = 0; tk < 16; ++tk) { const float ucur = __uint_as_float((unsigned)ul[(rbase + tk) * 256 + col] << 16); sum += ucur;
                        const int pos = p0 + 16 * half + tk; const float cnt = (float)((pos + 1 < w) ? pos + 1 : w);
                        pb[(16 * half + tk) * 264 + col] = (bf16_t)f2bf(sum / cnt - ucur);
                        sum -= __uint_as_float((unsigned)ul[(rbase + tk - (w - 1)) * 256 + col] << 16); }
                }
                __syncthreads();
                f32x16 acc = f32x16{};
#pragma unroll
                for (int sx = 0; sx < 4; ++sx) { const bf16x8 af = *(const LAS bf16x8*)(pb + r32 * 264 + mg * 64 + 16 * sx + 8 * hh);
                    acc = __builtin_amdgcn_mfma_f32_32x32x16_bf16(af, bw[sx], acc, 0, 0, 0); }
#pragma unroll
                for (int r = 0; r < 16; ++r) { const int tok = t0 + (r & 3) + 8 * (r >> 2) + 4 * hh; YCAT[(size_t)tok * 1024 + 512 + ocol] = (bf16_t)f2bf(acc[r] * psc); }
            }
            __syncthreads();
        }
    }
    SEAM(2);
    if (IN(4)) for (int rep_ = 0; rep_ < 1 + ((REPEAT_MASK >> 4) & 1); ++rep_) { KA; if (rep_) __syncthreads();
        pg8::StaticOrder S0; S0.init(T, 1024, G, bx); const pg8::TableOrder S = pg8::build_unit_table(S0, (LAS int*)(lds + MISC_OFF + 2048));
        pg8::DenseProb P{YCAT, WBRD_T, 1024, 1024, 1024}; pg8::EpiMergeR E{GATES, MERGB};
        pg8::gemm_phase<pg8::EpiMergeR, pg8::DenseProb, pg8::TableOrder, ALIGN_EPI_SEL>(lds, P, S, E);
    }
    SEAM(4);
    if (IN(5)) for (int rep_ = 0; rep_ < 1 + ((REPEAT_MASK >> 5) & 1); ++rep_) { KA; if (rep_) __syncthreads();
        pg8::DenseProb P{MERGB, WOUT_T, 1024, 1024, 1024}; pg8::StaticOrder S0; S0.init(T, 1024, G, bx); const pg8::TableOrder S = pg8::build_unit_table(S0, (LAS int*)(lds + MISC_OFF + 2048));
        pg8::EpiWout E{ka->in[I_X], OUT, (unsigned char*)XG, ka->in[I_NORM2]};
        pg8::gemm_phase<pg8::EpiWout, pg8::DenseProb, pg8::TableOrder, ALIGN_EPI_SEL>(lds, P, S, E);
    }
    SEAM(5);
    if (IN(6)) { KA;
        LAS int* lcnt = (LAS int*)(lds + MISC_OFF); LAS int* lbase = lcnt + 32;
        const int ngroups = T / 16, rounds = (ngroups + NGW - 1) / NGW;
        for (int rd = 0; rd < rounds; ++rd) {
            const int grp = rd * NGW + gw; const bool valid = grp < ngroups;
            if (tid < 32) lcnt[tid] = 0;
            __syncthreads();
            int e_sel = 0, rank = 0; float w_sel = 0.f, rstd = 0.f; const int q = lane >> 4, tok = grp * 16 + (lane & 15);
            if (valid) {
                f32x4 d0 = {0.f, 0.f, 0.f, 0.f}, d1 = {0.f, 0.f, 0.f, 0.f}; float ss = 0.f;
                const float* xrow = OUT + (size_t)tok * 1024 + 4 * q; const f32x4* wr2 = (const f32x4*)WR2 + lane;
#pragma unroll 4
                for (int s = 0; s < 64; ++s) { const f32x4 xv = *(const f32x4*)(xrow + 16 * s); const f32x4 wa = wr2[(s * 2) * 64], wb = wr2[(s * 2 + 1) * 64];
                    ss += (xv[0] * xv[0] + xv[1] * xv[1]) + (xv[2] * xv[2] + xv[3] * xv[3]);
#pragma unroll
                    for (int j = 0; j < 4; ++j) { d0 = __builtin_amdgcn_mfma_f32_16x16x4f32(wa[j], xv[j], d0, 0, 0, 0); d1 = __builtin_amdgcn_mfma_f32_16x16x4f32(wb[j], xv[j], d1, 0, 0, 0); } }
                ss += __shfl_xor(ss, 16); ss += __shfl_xor(ss, 32);
                rstd = 1.0f / sqrtf(ss * (1.0f / 1024.f) + RMS_EPS);
                unsigned key[8];
#pragma unroll
                for (int r = 0; r < 8; ++r) { const int e = (r >> 2) * 16 + 4 * q + (r & 3); const float lg = ((r < 4) ? d0[r & 3] : d1[r & 3]) * rstd + ka->in[I_BROUTER][e];
                    unsigned u = __float_as_uint(lg); u ^= (u >> 31) ? 0xffffffffu : 0x80000000u; key[r] = (u & ~31u) | (unsigned)(31 - e); }
                unsigned win[4];
#pragma unroll
                for (int r = 0; r < 4; ++r) { unsigned m = key[0];
#pragma unroll
                    for (int j = 1; j < 8; ++j) m = m > key[j] ? m : key[j];
                    unsigned o = (unsigned)__shfl_xor((int)m, 16); m = m > o ? m : o; o = (unsigned)__shfl_xor((int)m, 32); m = m > o ? m : o; win[r] = m;
#pragma unroll
                    for (int j = 0; j < 8; ++j) key[j] = (key[j] == m) ? 0u : key[j]; }
                float val[4];
#pragma unroll
                for (int r = 0; r < 4; ++r) { unsigned u = win[r] & ~31u; u ^= (u >> 31) ? 0x80000000u : 0xffffffffu; val[r] = __uint_as_float(u); }
                const float p1 = expf(val[1] - val[0]), p2 = expf(val[2] - val[0]), p3 = expf(val[3] - val[0]); const float inv = 1.0f / (1.0f + p1 + p2 + p3);
                const unsigned wk = (q == 0) ? win[0] : (q == 1) ? win[1] : (q == 2) ? win[2] : win[3];
                w_sel = ((q == 0) ? 1.0f : (q == 1) ? p1 : (q == 2) ? p2 : p3) * inv; e_sel = 31 - (int)(wk & 31u);
                rank = __hip_atomic_fetch_add((int*)(lcnt + e_sel), 1, __ATOMIC_RELAXED, __HIP_MEMORY_SCOPE_WORKGROUP);
            }
            __syncthreads();
            if (tid < 32) lbase[tid] = (int)__hip_atomic_fetch_add(CNT + 64 * tid, (unsigned)lcnt[tid], __ATOMIC_RELAXED, __HIP_MEMORY_SCOPE_AGENT);
            __syncthreads();
            if (valid) { const int pos = lbase[e_sel] + rank; LIST[(size_t)e_sel * CAP + pos] = (u32x2){(unsigned)(tok * 4 + q), __float_as_uint(rstd)}; ROUTEW[tok * 4 + q] = w_sel; }
            __syncthreads();
        }
    }
    SEAM(6);
    if (IN(7) || IN(8)) { KA;
        LAS int* tp = (LAS int*)(lds + MISC_OFF + 256); LAS int* cn = tp + 40;
        if (tid < 64) {
            const int e = tid & 31; const int c = (int)__hip_atomic_load(CNT + 64 * e, __ATOMIC_RELAXED, __HIP_MEMORY_SCOPE_AGENT); const int tiles = (c + 255) >> 8; int x = tiles;
#pragma unroll
            for (int o = 1; o < 32; o <<= 1) { const int y = __shfl_up(x, o, 32); if (e >= o) x += y; }
            if (tid < 32) { cn[e] = c; tp[e] = x - tiles; if (e == 31) tp[NEXP] = x; } }
        __syncthreads();
        if (IN(7)) for (int rep_ = 0; rep_ < 1 + ((REPEAT_MASK >> 7) & 1); ++rep_) {
            pg8::GuProb P{(const unsigned char*)XG, (const unsigned char*)WGU_T, LIST, 1024, 1024, 1024}; pg8::GroupedOrder S0{tp, cn, 8, G, bx}; const pg8::TableOrder S = pg8::build_unit_table(S0, (LAS int*)(lds + MISC_OFF + 2048));
            pg8::EpiSwiglu E{(unsigned char*)ACT, LIST, ka->in[I_BGU], lds + MISC_OFF + 4096};
            pg8::gemm_phase<pg8::EpiSwiglu, pg8::GuProb, pg8::TableOrder, ALIGN_EPI_SEL>(lds, P, S, E);
        }
        SEAM(7);
        if (IN(8)) for (int rep_ = 0; rep_ < 1 + ((REPEAT_MASK >> 8) & 1); ++rep_) {
            pg8::DownProb P{(const unsigned char*)ACT, (const unsigned char*)WD_T, 1024, 1024, 1024}; pg8::GroupedOrder S0{tp, cn, 4, G, bx}; const pg8::TableOrder S = pg8::build_unit_table(S0, (LAS int*)(lds + MISC_OFF + 2048));
            pg8::EpiDown E{(unsigned char*)Y4, LIST, ka->in[I_BD], lds + MISC_OFF + 4096};
            pg8::gemm_phase<pg8::EpiDown, pg8::DownProb, pg8::TableOrder, ALIGN_EPI_SEL>(lds, P, S, E);
        }
    }
    SEAM(8);
    if (IN(9)) { KA;
        for (int i = bx * 512 + tid; i < T * 128; i += G * 512) { const int tok = i >> 7, c8 = (i & 127) * 8;
            const f32x4 w = *(const f32x4*)(ROUTEW + tok * 4); float* op = OUT + (size_t)tok * 1024 + c8;
            f32x4 o0 = *(const f32x4*)op, o1 = *(const f32x4*)(op + 4);
#pragma unroll
            for (int k = 0; k < 4; ++k) { const u32x2 y = *(const u32x2*)((const unsigned char*)Y4 + ((size_t)tok * 4 + k) * 1024 + c8); const float wk = w[k] * (1.0f / Y8_SCALE);
                const f32x2 p0 = __builtin_amdgcn_cvt_pk_f32_fp8((int)y.x, false), p1 = __builtin_amdgcn_cvt_pk_f32_fp8((int)y.x, true), p2 = __builtin_amdgcn_cvt_pk_f32_fp8((int)y.y, false), p3 = __builtin_amdgcn_cvt_pk_f32_fp8((int)y.y, true);
                o0[0] += wk * p0[0]; o0[1] += wk * p0[1]; o0[2] += wk * p1[0]; o0[3] += wk * p1[1];
                o1[0] += wk * p2[0]; o1[1] += wk * p2[1]; o1[2] += wk * p3[0]; o1[3] += wk * p3[1]; }
            *(f32x4*)op = o0; *(f32x4*)(op + 4) = o1; }
    }
#ifdef TAP
    if (lo <= 10 && 10 < hi) { KA; GSYNC();
        for (int i = bx * 512 + tid; i < T * 1024; i += G * 512) { const int t = i >> 10, c = i & 1023; float v = 0.f;
#define BFV(buf, pitch, col) __uint_as_float((unsigned)(buf)[(size_t)t * (pitch) + (col)] << 16)
            if (TAP == 1) v = BFV(Qb, 512, c & 511) + 2.f * BFV(Kb, 512, c & 511) + 4.f * BFV(Vb, 512, c & 511) + 8.f * BFV(Ub, 256, c & 255) + 16.f * BFV(MQb, 256, c & 255)
                            + 32.f * BFV(GATES, 3072, c) + 64.f * BFV(GATES, 3072, 1024 + c) + 128.f * BFV(GATES, 3072, 2048 + c);
            if (TAP == 2) v = BFV(OC, 1024, c) + 2.f * BFV(YCAT, 1024, c);
            if (TAP == 3) v = BFV(MERGB, 1024, c);
            if (TAP == 4) v = BFV(XN, 1024, c);
            if (TAP == 6) { const bf16_t* z = WSP(bf16_t, WS_B) + (size_t)t * 5120 + c; v = __uint_as_float((unsigned)z[0] << 16) + 2.f * __uint_as_float((unsigned)z[1024] << 16) + 4.f * __uint_as_float((unsigned)z[2048] << 16) + 8.f * __uint_as_float((unsigned)z[3072] << 16) + 16.f * __uint_as_float((unsigned)z[4096] << 16); }
            if (TAP == 5) { const bf16_t* wt = WIN_T; const int tt = t % 5120; v = __uint_as_float((unsigned)wt[(size_t)tt * 1024 + c] << 16) + ROPE[(t & 8191) * 32 + (c & 31)].x + 2.f * ROPE[(t & 8191) * 32 + (c & 31)].y; }
            OUT[i] = v; }
    }
#endif
#undef IN
#undef SEAM
}

extern "C" void kernel_launch(void* const* d_in, const int* in_sizes, int n_in, void* d_out, int out_size, void* d_ws, size_t ws_size, hipStream_t stream) {
    static int grid = 0;
    if (grid == 0) {
        if (n_in != 29 || in_sizes[0] != T * DMODEL || out_size != T * DMODEL || ws_size < WS_END) {
            fprintf(stderr, "kernel_launch: unexpected shapes: n_in %d in0 %d out %d ws %zu (need %zu)\n", n_in, n_in > 0 ? in_sizes[0] : -1, out_size, ws_size, (size_t)WS_END); grid = -1; return; }
        int dev = 0, cus = 0, per_cu = 0;
        (void)hipGetDevice(&dev); (void)hipDeviceGetAttribute(&cus, hipDeviceAttributeMultiprocessorCount, dev);
        (void)hipFuncSetAttribute((const void*)fwd_kernel, hipFuncAttributeMaxDynamicSharedMemorySize, LDS_BYTES);
        (void)hipOccupancyMaxActiveBlocksPerMultiprocessor(&per_cu, (const void*)fwd_kernel, NWAVES * 64, LDS_BYTES);
        (void)hipGetLastError();
        grid = cus;
        fprintf(stderr, "kernel_launch: cus %d occupancy %d/CU grid %d\n", cus, per_cu, grid);
        if (per_cu < 1) fprintf(stderr, "kernel_launch: occupancy query says the kernel does not fit\n");
    }
    if (grid < 0) return;
    (void)hipMemsetAsync((char*)d_ws + WS_CTL, 0, CTL_ZERO_BYTES, stream);
    Args a{};
    for (int i = 0; i < 29; ++i) a.in[i] = (const float*)d_in[i];
    a.out = (float*)d_out; a.ws = (unsigned char*)d_ws; a.ph_lo = 0; a.ph_hi = PH_HI;
    void* args[] = {&a};
    hipError_t e = hipLaunchCooperativeKernel((const void*)fwd_kernel, dim3(grid), dim3(NWAVES * 64), args, LDS_BYTES, stream);
    if (e != hipSuccess) fprintf(stderr, "cooperative launch failed: %s (grid %d)\n", hipGetErrorString(e), grid);
}
```

```cpp
#include <hip/hip_runtime.h>
#include <hip/hip_cooperative_groups.h>
#include <hip/hip_bf16.h>
#include <cstdio>
#include <cstdint>
#include <cmath>
namespace cg = cooperative_groups;

#define LAS __attribute__((address_space(3)))
#define GAS __attribute__((address_space(1)))
typedef unsigned short bf16_t;
typedef short bf16x8 __attribute__((ext_vector_type(8)));
typedef float f32x4 __attribute__((ext_vector_type(4)));
typedef float f32x2 __attribute__((ext_vector_type(2)));
typedef float f32x16 __attribute__((ext_vector_type(16)));
typedef unsigned u32x4 __attribute__((ext_vector_type(4)));
typedef unsigned u32x2 __attribute__((ext_vector_type(2)));

#define PH_HI 10
#define ALIGN_EPI_SEL true
#define F8MODE 2
#define USE_SETPRIO 1
#define ATTN_PRIO_A 1
#define ATTN_PRIO_B 1
#ifndef PHMASK
#define PHMASK 0x3ff
#endif
#define REPEAT_MASK 0x000
constexpr int BATCH = 4, SEQ = 8192, DMODEL = 1024, T = BATCH * SEQ, INW = 5120, NEXP = 32, MEMLEN = 256;
constexpr float RMS_EPS = 1e-6f;
constexpr float C2 = 0.125f * 1.4426950408889634f;
constexpr int CAP = T;

constexpr size_t MiB = 1u << 20;
constexpr size_t WS_CTL = 0, CTL_ZERO_BYTES = 32768;
constexpr int CW_BAR = 4096;
constexpr size_t WS_ROUTEW = 1 * MiB;
constexpr size_t WS_LAM = 1 * MiB + 768 * 1024;
constexpr size_t WS_ROPE = 2 * MiB;
constexpr size_t WS_WR2 = 4 * MiB;
constexpr size_t WS_MEMN = 5 * MiB;
constexpr size_t WS_MKV = 7 * MiB;
constexpr size_t WS_WIN_T = 8 * MiB;
constexpr size_t WS_WBRD_T = 18 * MiB;
constexpr size_t WS_WBRP_T = 19 * MiB;
constexpr size_t WS_WBRM_T = 19 * MiB + 512 * 1024;
constexpr size_t WS_WOUT_T = 20 * MiB;
constexpr size_t WS_WMKV_T = 22 * MiB;
constexpr size_t WS_WGU_T = 24 * MiB;
constexpr size_t WS_WD_T = 152 * MiB;
constexpr size_t WS_A = 216 * MiB;
constexpr size_t WS_XN = WS_A;
constexpr size_t WS_Q = WS_A + 64 * MiB, WS_K = WS_A + 96 * MiB, WS_V = WS_A + 128 * MiB;
constexpr size_t WS_U = WS_A + 160 * MiB, WS_MQ = WS_A + 176 * MiB;
constexpr size_t WS_OC = WS_A + 192 * MiB;
constexpr size_t WS_B = 488 * MiB;
constexpr size_t WS_GATES = WS_B;
constexpr size_t WS_YCAT = WS_B + 192 * MiB;
constexpr size_t WS_MERGF = 760 * MiB;
constexpr size_t WS_MERGB = 888 * MiB;
constexpr size_t WS_XG = 952 * MiB;
constexpr size_t WS_LIST = 1016 * MiB;
constexpr size_t WS_END = 1024 * MiB;

typedef __bf16 bf16x2_v __attribute__((ext_vector_type(2)));
__device__ __forceinline__ unsigned cvt_pk_bf16(float lo, float hi) { f32x2 v = {lo, hi}; bf16x2_v b = __builtin_convertvector(v, bf16x2_v); return __builtin_bit_cast(unsigned, b); }
__device__ __forceinline__ unsigned pk4_fp8(float a, float b, float c, float d) {
    a = fminf(fmaxf(a, -448.f), 448.f); b = fminf(fmaxf(b, -448.f), 448.f); c = fminf(fmaxf(c, -448.f), 448.f); d = fminf(fmaxf(d, -448.f), 448.f);
    int r = __builtin_amdgcn_cvt_pk_fp8_f32(a, b, 0, false); r = __builtin_amdgcn_cvt_pk_fp8_f32(c, d, r, true); return (unsigned)r; }
constexpr float W8_SCALE = 64.0f;
constexpr float Y8_SCALE = 32.0f;
constexpr float A8_SCALE = 8.0f;
__device__ __forceinline__ float bf_lo(unsigned w) { return __uint_as_float(w << 16); }
__device__ __forceinline__ float bf_hi(unsigned w) { return __uint_as_float(w & 0xffff0000u); }
__device__ __forceinline__ float wave_sum(float v) {
#pragma unroll
    for (int o = 1; o < 64; o <<= 1) v += __shfl_xor(v, o);
    return v;
}
#define LDS_WAIT() asm volatile("s_waitcnt lgkmcnt(0)" ::: "memory")

namespace pg8 {
constexpr int BM = 256, BK = 64, HALF = 128, HTB = HALF * BK * 2, STAGE_BYTES = 8 * HTB, NXCD = 8, WGM = 8;
__host__ __device__ __forceinline__ int lds_byte(int r, int c) { const int st = (r >> 4) * 2 + (c >> 5), rr = r & 15, cc = c & 31, ob = rr * 64 + cc * 2; return st * 1024 + (ob ^ (((ob >> 9) & 1) << 5)); }
__host__ __device__ __forceinline__ void stage_rc(int b, int& R, int& C) { const int st = b / 1024, sb = b % 1024, swz = sb ^ (((sb >> 9) & 1) << 5); R = (st >> 1) * 16 + swz / 64; C = (st & 1) * 32 + (swz % 64) / 2; }
__host__ __device__ __forceinline__ int perm32(int rho) { const int n = rho >> 4, i = rho & 15; return 8 * (i >> 2) + 4 * n + (i & 3); }

typedef int i32x4_t __attribute__((ext_vector_type(4)));
typedef int i32x8_t __attribute__((ext_vector_type(8)));
typedef long i64x2_t __attribute__((ext_vector_type(2)));
struct Unit { int pm, pn, e, mt, cnt; };

template <int BMAP> __device__ __forceinline__ int brow(int R) { return BMAP == 0 ? ((R >> 5) * 64 + perm32(R & 31)) : BMAP == 1 ? ((R & ~31) + perm32(R & 31)) : ((R >> 5) * 64 + 16 * ((R & 15) >> 2) + 4 * ((R >> 4) & 1) + (R & 3)); }

struct StaticOrder {
    int nM, nN, nwg, G, c;
    __device__ void init(int M, int N, int G_, int c_) { nM = M / BM; nN = N / BM; nwg = nM * nN; G = G_; c = c_; }
    __device__ bool next(int i, Unit& u) const {
        const long L = (long)i * G + c; if (L >= nwg) return false;
        int wgid = (int)L; { const int q = nwg / NXCD, r = nwg % NXCD, xcd = wgid % NXCD, off = wgid / NXCD; wgid = (xcd < r ? xcd * (q + 1) : r * (q + 1) + (xcd - r) * q) + off; }
        const int nig = WGM * nN, gid = wgid / nig, fm = gid * WGM, gsz = (nM - fm) < WGM ? (nM - fm) : WGM;
        u.pm = fm + ((wgid % nig) % gsz); u.pn = (wgid % nig) / gsz; u.e = 0; u.mt = 0; u.cnt = 0; return true;
    }
    __device__ bool next_lane(int i, Unit& u) const { return next(i, u); }
};
struct GroupedOrder {
    const LAS int* tp; const LAS int* cn; int NTN, G, c;
    __device__ bool next_lane(int i, Unit& u) const {
        const int nwg = tp[NEXP] * NTN; const long L = (long)i * G + c; if (L >= nwg) return false;
        int wgid = (int)L; { const int q = nwg / NXCD, r = nwg % NXCD, xcd = wgid % NXCD, off = wgid / NXCD; wgid = (xcd < r ? xcd * (q + 1) : r * (q + 1) + (xcd - r) * q) + off; }
        int e = 0; while (e < NEXP - 1 && wgid >= tp[e + 1] * NTN) ++e;
        const int idx = wgid - tp[e] * NTN, tiles = tp[e + 1] - tp[e];
        const int nig = 4 * NTN, gid = idx / nig, fm = gid * 4, gsz = (tiles - fm) < 4 ? (tiles - fm) : 4;
        u.mt = fm + ((idx % nig) % gsz); u.pn = (idx % nig) / gsz; u.e = e; u.pm = tp[e] + u.mt; u.cnt = cn[e]; return true;
    }
};
struct TableOrder {
    const LAS int* tab; int n;
    __device__ __forceinline__ bool next(int i, Unit& u) const {
        if (i >= n) return false;
        const LAS int* t = tab + i * 8;
        u.pm = __builtin_amdgcn_readfirstlane(t[0]); u.pn = __builtin_amdgcn_readfirstlane(t[1]); u.e = __builtin_amdgcn_readfirstlane(t[2]);
        u.mt = __builtin_amdgcn_readfirstlane(t[3]); u.cnt = __builtin_amdgcn_readfirstlane(t[4]); return true;
    }
};
template <class Sched> __device__ __forceinline__ TableOrder build_unit_table(const Sched& S, LAS int* tab) {
    __syncthreads();
    if (threadIdx.x < 32) { Unit u; const bool ok = S.next_lane((int)threadIdx.x, u);
        if (ok) { LAS int* t = tab + threadIdx.x * 8; t[0] = u.pm; t[1] = u.pn; t[2] = u.e; t[3] = u.mt; t[4] = u.cnt; }
        const unsigned long long m = __ballot(ok); if (threadIdx.x == 0) tab[256] = __popcll(m); }
    __syncthreads();
    TableOrder T; T.tab = tab; T.n = __builtin_amdgcn_readfirstlane(tab[256]); return T;
}
struct DenseProb {
    static constexpr bool GATHER = false; static constexpr int BMAP = 0; static constexpr bool F8 = false;
    const bf16_t* A; const bf16_t* Bt; int lda, ldb, K;
    __device__ __forceinline__ const char* a_base(const Unit& u) const { return (const char*)(A + (size_t)u.pm * BM * lda); }
    __device__ __forceinline__ const char* b_base(const Unit& u) const { return (const char*)(Bt + (size_t)u.pn * BM * ldb); }
    __device__ __forceinline__ size_t bhstep() const { return (size_t)32 * ldb * 2; }
    __device__ __forceinline__ unsigned a_off(const Unit&, int, int) const { return 0u; }
    __device__ __forceinline__ unsigned a_raw(const Unit&, int) const { return 0u; }
};
struct GuProb {
    static constexpr bool GATHER = true; static constexpr int BMAP = 1; static constexpr bool F8 = true;
    const unsigned char* XG; const unsigned char* Wt; const u32x2* list; int lda, ldb, K;
    __device__ __forceinline__ const char* a_base(const Unit&) const { return (const char*)XG; }
    __device__ __forceinline__ const char* b_base(const Unit& u) const { return (const char*)(Wt + ((size_t)u.e * 2048 + 128 * u.pn) * 1024); }
    __device__ __forceinline__ size_t bhstep() const { return (size_t)1024 * 1024; }
    __device__ __forceinline__ unsigned a_raw(const Unit& u, int r) const { const int rr = u.mt * BM + r, rc = rr < u.cnt ? rr : u.cnt - 1; return list[(size_t)u.e * CAP + rc].x; }
    __device__ __forceinline__ unsigned a_off(const Unit& u, int r, int C) const {
        const int rr = u.mt * BM + r, rc = rr < u.cnt ? rr : u.cnt - 1;
        const unsigned tok = list[(size_t)u.e * CAP + rc].x >> 2;
        return tok * 1024u + (unsigned)C * 2u;
    }
};
struct DownProb {
    static constexpr bool GATHER = false; static constexpr int BMAP = 2; static constexpr bool F8 = true;
    const unsigned char* A; const unsigned char* Wt; int lda, ldb, K;
    __device__ __forceinline__ const char* a_base(const Unit& u) const { return (const char*)(A + (size_t)u.pm * BM * lda); }
    __device__ __forceinline__ const char* b_base(const Unit& u) const { return (const char*)(Wt + ((size_t)u.e * 1024 + 256 * u.pn) * 1024); }
    __device__ __forceinline__ size_t bhstep() const { return (size_t)8 * ldb; }
    __device__ __forceinline__ unsigned a_off(const Unit&, int, int) const { return 0u; }
    __device__ __forceinline__ unsigned a_raw(const Unit&, int) const { return 0u; }
};

template <class Prob> __device__ __forceinline__ void calc_aoff(const Prob& P, const Unit& u, const int (&Rr)[2], const int (&Cc)[2], unsigned (&o)[2][2]) {
#pragma unroll
    for (int h = 0; h < 2; ++h)
#pragma unroll
        for (int i = 0; i < 2; ++i) {
            if constexpr (Prob::GATHER) o[h][i] = P.a_off(u, h * HALF + Rr[i], Cc[i]);
            else o[h][i] = Prob::F8 ? (unsigned)((h * HALF + Rr[i]) * P.lda + Cc[i] * 2) : (unsigned)((h * HALF + Rr[i]) * P.lda + Cc[i]) * 2u;
        }
}

struct NoPost { __device__ __forceinline__ void operator()(int) const {} };
template <class Epi, class Prob, class Sched, bool ALIGN_EPI, class Post = NoPost>
__device__ __forceinline__ void gemm_phase(LAS unsigned char* lds, const Prob& P, const Sched& S, const Epi& E, const Post& PU = Post()) {
    const int tid = threadIdx.x, wid = __builtin_amdgcn_readfirstlane(tid >> 6), lane = tid & 63, wr = wid >> 2, wc = wid & 3, fr = lane & 15, fq = lane >> 4;
    const int K = P.K, nt = Prob::F8 ? K / 128 : K / BK;
    int Rr[2], Cc[2]; unsigned voffB[2];
#pragma unroll
    for (int i = 0; i < 2; ++i) { stage_rc(tid * 16 + i * 8192, Rr[i], Cc[i]); voffB[i] = Prob::F8 ? (unsigned)(brow<Prob::BMAP>(Rr[i]) * P.ldb + Cc[i] * 2) : (unsigned)(brow<Prob::BMAP>(Rr[i]) * P.ldb + Cc[i]) * 2u; }
    const size_t kstep = (size_t)(BK * 2);
    const size_t bhstep = P.bhstep();
    const unsigned ldsw = (unsigned)wid * 1024u;
    const int aoff = lds_byte(wr * 64 + fr, fq * 8), boff = lds_byte(wc * 32 + fr, fq * 8);
#define PG8_SA(b, h) (((b) * 2 + (h)) * HTB)
#define PG8_SB(b, h) ((4 + (b) * 2 + (h)) * HTB)
#define PG8_STG(bufoff, gptr, v0, v1) do { \
        __builtin_amdgcn_global_load_lds((const unsigned*)((const char*)(gptr) + (v0)), (LAS unsigned*)(lds + (bufoff) + ldsw), 16, 0, 0); \
        __builtin_amdgcn_global_load_lds((const unsigned*)((const char*)(gptr) + (v1)), (LAS unsigned*)(lds + (bufoff) + ldsw + 8192), 16, 0, 0); } while (0)
#define PG8_STGB(bufoff, gptr) PG8_STG(bufoff, gptr, voffB[0], voffB[1])
#define PG8_LDA(dst, b, h) do { _Pragma("unroll") for (int m = 0; m < 4; ++m) _Pragma("unroll") for (int k = 0; k < 2; ++k) dst[m][k] = *(const LAS bf16x8*)(lds + PG8_SA(b, h) + aoff + m * 2048 + k * 1024); } while (0)
#define PG8_LDB(dst, b, h) do { _Pragma("unroll") for (int n = 0; n < 2; ++n) _Pragma("unroll") for (int k = 0; k < 2; ++k) dst[n][k] = *(const LAS bf16x8*)(lds + PG8_SB(b, h) + boff + n * 2048 + k * 1024); } while (0)
#define PG8_MMAB(ai, bj, At, Bt) do { _Pragma("unroll") for (int m = 0; m < 4; ++m) _Pragma("unroll") for (int n = 0; n < 2; ++n) _Pragma("unroll") for (int k = 0; k < 2; ++k) \
        acc[ai][bj][m][n] = __builtin_amdgcn_mfma_f32_16x16x32_bf16(Bt[n][k], At[m][k], acc[ai][bj][m][n], 0, 0, 0); } while (0)
#define PG8_MMAQ(ai, bj, At, Bt) do { _Pragma("unroll") for (int m = 0; m < 4; ++m) _Pragma("unroll") for (int n = 0; n < 2; ++n) _Pragma("unroll") for (int k = 0; k < 2; ++k) { \
        const i64x2_t bq = __builtin_bit_cast(i64x2_t, Bt[n][k]), aq = __builtin_bit_cast(i64x2_t, At[m][k]); \
        acc[ai][bj][m][n] = __builtin_amdgcn_mfma_f32_16x16x32_fp8_fp8(bq[0], aq[0], acc[ai][bj][m][n], 0, 0, 0); \
        acc[ai][bj][m][n] = __builtin_amdgcn_mfma_f32_16x16x32_fp8_fp8(bq[1], aq[1], acc[ai][bj][m][n], 0, 0, 0); } } while (0)
#define PG8_MMA8(ai, bj, A8, B8) do { _Pragma("unroll") for (int m = 0; m < 4; ++m) _Pragma("unroll") for (int n = 0; n < 2; ++n) \
        asm volatile("v_mfma_f32_16x16x128_f8f6f4 %0, %1, %2, %0" : "+v"(acc[ai][bj][m][n]) : "v"(B8[n]), "v"(A8[m])); } while (0)
#define PG8_LDA8(dst, b, h) do { _Pragma("unroll") for (int m = 0; m < 4; ++m) { dst[m].lo = *(const LAS i32x4_t*)(lds + PG8_SA(b, h) + aoff + m * 2048); dst[m].hi = *(const LAS i32x4_t*)(lds + PG8_SA(b, h) + aoff + m * 2048 + 1024); } } while (0)
#define PG8_LDB8(dst, b, h) do { _Pragma("unroll") for (int n = 0; n < 2; ++n) { dst[n].lo = *(const LAS i32x4_t*)(lds + PG8_SB(b, h) + boff + n * 2048); dst[n].hi = *(const LAS i32x4_t*)(lds + PG8_SB(b, h) + boff + n * 2048 + 1024); } } while (0)
#define PG8_XLDA(b, h)  do { if constexpr (Prob::F8 && F8MODE == 2) PG8_LDA8(At8, b, h); else PG8_LDA(At, b, h); } while (0)
#define PG8_XLDB0(b, h) do { if constexpr (Prob::F8 && F8MODE == 2) PG8_LDB8(B08, b, h); else PG8_LDB(B0, b, h); } while (0)
#define PG8_XLDB1(b, h) do { if constexpr (Prob::F8 && F8MODE == 2) PG8_LDB8(B18, b, h); else PG8_LDB(B1, b, h); } while (0)
#define PG8_XMMA0(ai, bj) do { if (USE_SETPRIO) __builtin_amdgcn_s_setprio(USE_SETPRIO); if constexpr (Prob::F8 && F8MODE == 2) PG8_MMA8(ai, bj, At8, B08); else if constexpr (Prob::F8) PG8_MMAQ(ai, bj, At, B0); else PG8_MMAB(ai, bj, At, B0); if (USE_SETPRIO) __builtin_amdgcn_s_setprio(0); } while (0)
#define PG8_XMMA1(ai, bj) do { if (USE_SETPRIO) __builtin_amdgcn_s_setprio(USE_SETPRIO); if constexpr (Prob::F8 && F8MODE == 2) PG8_MMA8(ai, bj, At8, B18); else if constexpr (Prob::F8) PG8_MMAQ(ai, bj, At, B1); else PG8_MMAB(ai, bj, At, B1); if (USE_SETPRIO) __builtin_amdgcn_s_setprio(0); } while (0)
#define PG8_WAIT_V(n) asm volatile("s_waitcnt vmcnt(" #n ")" ::: "memory")
#define PG8_WAIT_L(n) asm volatile("s_waitcnt lgkmcnt(" #n ")" ::: "memory")
#define PG8_BAR __builtin_amdgcn_s_barrier()
#define PG8_SCHED __builtin_amdgcn_sched_barrier(0)
    Unit cur, nxt; int ui = 0;
    if (!S.next(0, cur)) return;
    unsigned vo[2][2], nvo[2][2];
    calc_aoff(P, cur, Rr, Cc, vo);
    bool has_next = S.next(1, nxt);
    if constexpr (Prob::GATHER) { if (has_next) calc_aoff(P, nxt, Rr, Cc, nvo); else {
#pragma unroll
        for (int h = 0; h < 2; ++h)
#pragma unroll
            for (int i = 0; i < 2; ++i) nvo[h][i] = vo[h][i]; } }
    f32x4 acc[2][2][4][2];
#pragma unroll
    for (int a = 0; a < 2; ++a)
#pragma unroll
        for (int b = 0; b < 2; ++b)
#pragma unroll
            for (int m = 0; m < 4; ++m)
#pragma unroll
                for (int n = 0; n < 2; ++n) acc[a][b][m][n] = (f32x4){0.f, 0.f, 0.f, 0.f};
    bf16x8 At[4][2], B0[2][2], B1[2][2]; i32x8_t At8[4], B08[2], B18[2];
    const char* cA = P.a_base(cur); const char* cB = P.b_base(cur);
    if constexpr (Epi::HAS_PRE) E.pre(cur, 0, wid, lane);
    PG8_STGB(PG8_SB(0, 0), cB); PG8_STGB(PG8_SB(0, 1), cB + bhstep); PG8_STG(PG8_SA(0, 0), cA, vo[0][0], vo[0][1]); PG8_STG(PG8_SA(0, 1), cA, vo[1][0], vo[1][1]);
    if (wr == 1) PG8_BAR;
    PG8_WAIT_V(2); PG8_BAR;
    PG8_STGB(PG8_SB(1, 0), cB + kstep); PG8_STG(PG8_SA(1, 0), cA + kstep, vo[0][0], vo[0][1]); PG8_STGB(PG8_SB(1, 1), cB + bhstep + kstep);
    PG8_WAIT_V(6); PG8_BAR;
    for (;;) {
        const char* nA = has_next ? P.a_base(nxt) : cA; const char* nB = has_next ? P.b_base(nxt) : cB;
        for (int t = 0; t < nt; t += 2) {
            const bool last = (t == nt - 2);
            if constexpr (Epi::HAS_MID) { if (t == Epi::MID_T0 || t == Epi::MID_T1) { E.mid(acc, cur, wr, wc, fr, fq, t == Epi::MID_T0 ? 0 : 1); PG8_SCHED; } }
            const char* a1 = cA + (size_t)(t + 1) * kstep;
            const char* a2 = last ? nA : cA + (size_t)(t + 2) * kstep; const char* b2 = last ? nB : cB + (size_t)(t + 2) * kstep;
            const char* a3 = a2 + kstep; const char* b3 = b2 + kstep;
            unsigned x00 = vo[0][0], x01 = vo[0][1], x10 = vo[1][0], x11 = vo[1][1];
            if constexpr (Prob::GATHER) { if (last) { x00 = nvo[0][0]; x01 = nvo[0][1]; x10 = nvo[1][0]; x11 = nvo[1][1]; } }
            PG8_XLDB0(0, 0); PG8_XLDB1(0, 1); PG8_SCHED; PG8_XLDA(0, 0); PG8_STG(PG8_SA(1, 1), a1, vo[1][0], vo[1][1]);
            PG8_WAIT_V(8); PG8_WAIT_L(0); PG8_BAR; PG8_XMMA0(0, 0); PG8_XMMA1(0, 1); PG8_BAR; PG8_SCHED;
            PG8_XLDA(0, 1); PG8_STGB(PG8_SB(0, 0), b2); PG8_STGB(PG8_SB(0, 1), b2 + bhstep); PG8_STG(PG8_SA(0, 0), a2, x00, x01);
            PG8_WAIT_V(8); PG8_WAIT_L(0); PG8_BAR; PG8_XMMA0(1, 0); PG8_XMMA1(1, 1); PG8_BAR; PG8_SCHED;
            PG8_XLDB0(1, 0); PG8_XLDB1(1, 1); PG8_SCHED; PG8_XLDA(1, 0); PG8_STG(PG8_SA(0, 1), a2, x10, x11);
            PG8_WAIT_V(8); PG8_WAIT_L(0); PG8_BAR; PG8_XMMA0(0, 0); PG8_XMMA1(0, 1); PG8_BAR; PG8_SCHED;
            PG8_XLDA(1, 1); PG8_STGB(PG8_SB(1, 0), b3); PG8_STGB(PG8_SB(1, 1), b3 + bhstep); PG8_STG(PG8_SA(1, 0), a3, x00, x01);
            PG8_WAIT_V(8); PG8_WAIT_L(0); PG8_BAR; PG8_XMMA0(1, 0); PG8_XMMA1(1, 1); PG8_BAR; PG8_SCHED;
        }
        if constexpr (ALIGN_EPI) { if (wr == 0) PG8_BAR; }
        if constexpr (Prob::F8 && F8MODE == 2) asm volatile("s_nop 15\n\ts_nop 15" ::: "memory");
        Unit nn; const bool has_nn = has_next && S.next(ui + 2, nn);
        if constexpr (Prob::GATHER) {
#pragma unroll
            for (int h = 0; h < 2; ++h)
#pragma unroll
                for (int i = 0; i < 2; ++i) vo[h][i] = nvo[h][i];
            if (has_nn) {
#pragma unroll
                for (int h = 0; h < 2; ++h)
#pragma unroll
                    for (int i = 0; i < 2; ++i) nvo[h][i] = P.a_raw(nn, h * HALF + Rr[i]); } }
        if constexpr (Epi::HAS_PRE) E(acc, cur, wr, wc, fr, fq, ui & 1); else E(acc, cur, wr, wc, fr, fq);
        PU(ui);
        if (!has_next) break;
#pragma unroll
        for (int a = 0; a < 2; ++a)
#pragma unroll
            for (int b = 0; b < 2; ++b)
#pragma unroll
                for (int m = 0; m < 4; ++m)
#pragma unroll
                    for (int n = 0; n < 2; ++n) acc[a][b][m][n] = (f32x4){0.f, 0.f, 0.f, 0.f};
        cur = nxt; cA = nA; cB = nB; ++ui;
        if constexpr (Epi::HAS_PRE) E.pre(cur, ui, wid, lane);
        has_next = has_nn; nxt = nn;
        if constexpr (Prob::GATHER) { if (has_next) {
#pragma unroll
            for (int h = 0; h < 2; ++h)
#pragma unroll
                for (int i = 0; i < 2; ++i) nvo[h][i] = (nvo[h][i] >> 2) * (Prob::F8 ? 1024u : 2048u) + (unsigned)Cc[i] * 2u;
            asm volatile("" : "+v"(nvo[0][0]), "+v"(nvo[0][1]), "+v"(nvo[1][0]), "+v"(nvo[1][1])); } }
        if constexpr (ALIGN_EPI) { if (wr == 1) PG8_BAR; }
    }
    PG8_WAIT_V(0);
    if constexpr (!ALIGN_EPI) { if (wr == 0) PG8_BAR; }
    PG8_BAR;
#undef PG8_SA
#undef PG8_SB
#undef PG8_STG
#undef PG8_STGB
#undef PG8_LDA
#undef PG8_LDB
#undef PG8_MMAB
#undef PG8_MMAQ
#undef PG8_MMA8
#undef PG8_LDA8
#undef PG8_LDB8
#undef PG8_XLDA
#undef PG8_XLDB0
#undef PG8_XLDB1
#undef PG8_XMMA0
#undef PG8_XMMA1
#undef PG8_WAIT_V
#undef PG8_WAIT_L
#undef PG8_BAR
#undef PG8_SCHED
}

typedef const f32x4 (&AccRef)[2][2][4][2];
__device__ __forceinline__ void dma4(const void* g, LAS unsigned char* dst) { __builtin_amdgcn_global_load_lds((const unsigned*)g, (LAS unsigned*)dst, 4, 0, 0); }

__device__ __forceinline__ void store8(bf16_t* p, const f32x4& a, const f32x4& b) {
    u32x4 w; w.x = cvt_pk_bf16(a[0], a[1]); w.y = cvt_pk_bf16(a[2], a[3]); w.z = cvt_pk_bf16(b[0], b[1]); w.w = cvt_pk_bf16(b[2], b[3]); *(u32x4*)p = w;
}
__device__ __forceinline__ float sigmoidf_(float v) { return __builtin_amdgcn_rcpf(1.0f + __builtin_amdgcn_exp2f(-1.4426950408889634f * v)); }

struct EpiInProj {
    static constexpr bool HAS_MID = false; static constexpr bool HAS_PRE = false;
    bf16_t *Q, *Kb, *V, *U, *MQ, *GT; const float *qn, *kn, *mqn, *bg; const f32x2* rope;
    __device__ __forceinline__ void operator()(AccRef acc, const Unit& u, int wr, int wc, int fr, int fq) const {
        const int pn = u.pn; const int row0 = u.pm * BM + wr * 64 + fr;
        bf16_t* const Q_ = Q; bf16_t* const K_ = Kb; bf16_t* const V_ = V; bf16_t* const U_ = U; bf16_t* const MQ_ = MQ; const float* const qn_ = qn; const float* const kn_ = kn; const float* const mqn_ = mqn;
        if (pn < 4 || pn == 7) {
            const bool rope_on = pn < 4; const float* gn = pn < 2 ? qn_ : (pn < 4 ? kn_ : mqn_);
            const float sc = (pn < 2 || pn == 7) ? C2 : 1.0f;
            bf16_t* O; int pitch, colb;
            if (pn < 2) { O = Q_; pitch = 512; colb = (pn * 4 + wc) * 64; } else if (pn < 4) { O = K_; pitch = 512; colb = ((pn - 2) * 4 + wc) * 64; } else { O = MQ_; pitch = 256; colb = wc * 64; }
            const f32x4 g00 = *(const f32x4*)(gn + 8 * fq), g01 = *(const f32x4*)(gn + 8 * fq + 4), g10 = *(const f32x4*)(gn + 32 + 8 * fq), g11 = *(const f32x4*)(gn + 32 + 8 * fq + 4);
#pragma unroll
            for (int ai = 0; ai < 2; ++ai)
#pragma unroll
                for (int m = 0; m < 4; ++m) {
                    const f32x4 a0 = acc[ai][0][m][0], a1 = acc[ai][0][m][1], b0 = acc[ai][1][m][0], b1 = acc[ai][1][m][1];
                    float ss = 0.f;
#pragma unroll
                    for (int j = 0; j < 4; ++j) ss += a0[j] * a0[j] + a1[j] * a1[j] + b0[j] * b0[j] + b1[j] * b1[j];
                    ss += __shfl_xor(ss, 16); ss += __shfl_xor(ss, 32);
                    const float rstd = 1.0f / sqrtf(ss * (1.0f / 64.0f) + RMS_EPS);
                    const int row = row0 + ai * HALF + m * 16;
                    f32x4 t10 = a0 * rstd * g00, t11 = a1 * rstd * g01, t20 = b0 * rstd * g10, t21 = b1 * rstd * g11;
                    f32x4 o10, o11, o20, o21;
                    if (rope_on) {
                        const f32x4* rp = (const f32x4*)(rope + (size_t)(row & (SEQ - 1)) * 32 + 8 * fq);
                        const f32x4 r0 = rp[0], r1 = rp[1], r2 = rp[2], r3 = rp[3];
                        const f32x4 cs0 = {r0[0], r0[2], r1[0], r1[2]}, sn0 = {r0[1], r0[3], r1[1], r1[3]}, cs1 = {r2[0], r2[2], r3[0], r3[2]}, sn1 = {r2[1], r2[3], r3[1], r3[3]};
                        o10 = (t10 * cs0 - t20 * sn0) * sc; o11 = (t11 * cs1 - t21 * sn1) * sc; o20 = (t20 * cs0 + t10 * sn0) * sc; o21 = (t21 * cs1 + t11 * sn1) * sc;
                    } else { o10 = t10 * sc; o11 = t11 * sc; o20 = t20 * sc; o21 = t21 * sc; }
                    bf16_t* rowp = O + (size_t)row * pitch + colb + 8 * fq;
                    store8(rowp, o10, o11); store8(rowp + 32, o20, o21);
                }
        } else if (pn < 7) {
            bf16_t* O; int pitch, colb;
            if (pn < 6) { O = V_; pitch = 512; colb = (pn - 4) * 256 + wc * 64; } else { O = U_; pitch = 256; colb = wc * 64; }
#pragma unroll
            for (int ai = 0; ai < 2; ++ai)
#pragma unroll
                for (int m = 0; m < 4; ++m) { bf16_t* rowp = O + (size_t)(row0 + ai * HALF + m * 16) * pitch + colb + 8 * fq;
                    store8(rowp, acc[ai][0][m][0], acc[ai][0][m][1]); store8(rowp + 32, acc[ai][1][m][0], acc[ai][1][m][1]); }
        } else {
            const int gc = (pn - 8) * 256 + wc * 64 + 8 * fq;
            f32x4 bv[2][2];
#pragma unroll
            for (int bj = 0; bj < 2; ++bj)
#pragma unroll
                for (int n = 0; n < 2; ++n) bv[bj][n] = *(const f32x4*)(bg + gc + 32 * bj + 4 * n) * (-1.4426950408889634f);
#pragma unroll
            for (int ai = 0; ai < 2; ++ai)
#pragma unroll
                for (int m = 0; m < 4; ++m) {
                    unsigned char* blk = (unsigned char*)GT + ((size_t)(((pn - 8) >> 2) * 128 + u.pm) * 4 + ((pn - 8) & 3)) * 65536 + (size_t)((wr * 4 + wc) * 16 * 64 + (fq * 16 + fr)) * 8;
#pragma unroll
                    for (int bj = 0; bj < 2; ++bj) { f32x4 v0 = acc[ai][bj][m][0] * (-1.4426950408889634f) + bv[bj][0], v1 = acc[ai][bj][m][1] * (-1.4426950408889634f) + bv[bj][1];
                        u32x2 w = {0u, 0u};
#pragma unroll
                        for (int j = 0; j < 4; ++j) { const float g0 = __builtin_amdgcn_rcpf(1.0f + __builtin_amdgcn_exp2f(v0[j])), g1 = __builtin_amdgcn_rcpf(1.0f + __builtin_amdgcn_exp2f(v1[j]));
                            w.x = __builtin_amdgcn_cvt_pk_u8_f32(fmaxf(g0 * 255.0f + 0.25f, 1.0f), j, w.x); w.y = __builtin_amdgcn_cvt_pk_u8_f32(fmaxf(g1 * 255.0f + 0.25f, 1.0f), j, w.y); }
                        *(u32x2*)(blk + (ai * 8 + m * 2 + bj) * 512) = w; } }
        }
    }
};
struct EpiMemKV {
    static constexpr bool HAS_MID = false; static constexpr bool HAS_PRE = false;
    bf16_t* MKV; const float* mkn;
    __device__ __forceinline__ void operator()(AccRef acc, const Unit& u, int wr, int wc, int fr, int fq) const {
        const int row0 = u.pm * BM + wr * 64 + fr;
        f32x4 g00 = {1.f, 1.f, 1.f, 1.f}, g01 = g00, g10 = g00, g11 = g00;
        if (u.pn == 0) { g00 = *(const f32x4*)(mkn + 8 * fq); g01 = *(const f32x4*)(mkn + 8 * fq + 4); g10 = *(const f32x4*)(mkn + 32 + 8 * fq); g11 = *(const f32x4*)(mkn + 32 + 8 * fq + 4); }
#pragma unroll
        for (int ai = 0; ai < 2; ++ai)
#pragma unroll
            for (int m = 0; m < 4; ++m) {
                const f32x4 a0 = acc[ai][0][m][0], a1 = acc[ai][0][m][1], b0 = acc[ai][1][m][0], b1 = acc[ai][1][m][1];
                float rstd = 1.0f;
                if (u.pn == 0) { float ss = 0.f;
#pragma unroll
                    for (int j = 0; j < 4; ++j) ss += a0[j] * a0[j] + a1[j] * a1[j] + b0[j] * b0[j] + b1[j] * b1[j];
                    ss += __shfl_xor(ss, 16); ss += __shfl_xor(ss, 32); rstd = 1.0f / sqrtf(ss * (1.0f / 64.0f) + RMS_EPS); }
                bf16_t* rowp = MKV + (size_t)(row0 + ai * HALF + m * 16) * 512 + u.pn * 256 + wc * 64 + 8 * fq;
                store8(rowp, a0 * rstd * g00, a1 * rstd * g01); store8(rowp + 32, b0 * rstd * g10, b1 * rstd * g11);
            }
    }
};
template <int STAGE> struct EpiMerge {
    static constexpr bool HAS_MID = false; static constexpr bool HAS_PRE = false;
    const bf16_t* GT; float* MF; bf16_t* MB;
    __device__ __forceinline__ void operator()(AccRef acc, const Unit& u, int wr, int wc, int fr, int fq) const {
        const int row0 = u.pm * BM + wr * 64 + fr, col0 = u.pn * BM + wc * 64 + 8 * fq;
#pragma unroll
        for (int ai = 0; ai < 2; ++ai)
#pragma unroll
            for (int m = 0; m < 4; ++m) { const size_t row = (size_t)(row0 + ai * HALF + m * 16);
#pragma unroll
                for (int bj = 0; bj < 2; ++bj) { const int col = col0 + 32 * bj;
                    const u32x4 g = *(const u32x4*)(GT + row * 3072 + STAGE * 1024 + col);
                    const f32x4 ga = {bf_lo(g.x), bf_hi(g.x), bf_lo(g.y), bf_hi(g.y)}, gb = {bf_lo(g.z), bf_hi(g.z), bf_lo(g.w), bf_hi(g.w)};
                    f32x4 v0 = acc[ai][bj][m][0] * ga, v1 = acc[ai][bj][m][1] * gb;
                    float* mp = MF + row * 1024 + col;
                    if (STAGE > 0) { v0 += *(const f32x4*)mp; v1 += *(const f32x4*)(mp + 4); }
                    if (STAGE < 2) { *(f32x4*)mp = v0; *(f32x4*)(mp + 4) = v1; } else store8(MB + row * 1024 + col, v0, v1); }
                if (m & 1) asm volatile("" ::: "memory"); }
    }
};
struct EpiWout {
    static constexpr bool HAS_MID = false; static constexpr bool HAS_PRE = false;
    const float* X; float* X2; unsigned char* XG; const float* n2;
    __device__ __forceinline__ void operator()(AccRef acc, const Unit& u, int wr, int wc, int fr, int fq) const {
        const int row0 = u.pm * BM + wr * 64 + fr, col0 = u.pn * BM + wc * 64 + 8 * fq;
        f32x4 nv[2][2];
#pragma unroll
        for (int bj = 0; bj < 2; ++bj)
#pragma unroll
            for (int n = 0; n < 2; ++n) nv[bj][n] = *(const f32x4*)(n2 + col0 + 32 * bj + 4 * n);
#pragma unroll
        for (int ai = 0; ai < 2; ++ai)
#pragma unroll
            for (int m = 0; m < 4; ++m) { const size_t off = (size_t)(row0 + ai * HALF + m * 16) * 1024 + col0;
#pragma unroll
                for (int bj = 0; bj < 2; ++bj) { const f32x4 x0 = *(const f32x4*)(X + off + 32 * bj) + acc[ai][bj][m][0], x1 = *(const f32x4*)(X + off + 32 * bj + 4) + acc[ai][bj][m][1];
                    *(f32x4*)(X2 + off + 32 * bj) = x0; *(f32x4*)(X2 + off + 32 * bj + 4) = x1;
                    { const f32x4 y0 = x0 * nv[bj][0], y1 = x1 * nv[bj][1]; u32x2 w8; w8.x = pk4_fp8(y0[0], y0[1], y0[2], y0[3]); w8.y = pk4_fp8(y1[0], y1[1], y1[2], y1[3]); *(u32x2*)(XG + off + 32 * bj) = w8; } }
                if (m & 1) asm volatile("" ::: "memory"); }
    }
};
struct EpiSwiglu {
    static constexpr bool HAS_MID = false; static constexpr bool HAS_PRE = true;
    unsigned char* ACT; const u32x2* list; const float* bgu; LAS unsigned char* xb;
    __device__ __forceinline__ void pre(const Unit& u, int ui, int wid, int lane) const {
        LAS unsigned char* b = xb + (ui & 1) * 2048;
        if (wid < 4) { const int rr = u.mt * BM + 64 * wid + lane, rc = rr < u.cnt ? rr : u.cnt - 1; dma4((const unsigned*)(list + (size_t)u.e * CAP + rc) + 1, b + wid * 256); }
        else { const int j = 64 * (wid - 4) + lane; dma4(bgu + (size_t)u.e * 2048 + 128 * u.pn + (j < 128 ? j : 1024 + (j - 128)), b + 1024 + (wid - 4) * 256); }
    }
    __device__ __forceinline__ static unsigned swi4(const f32x4& ag, const f32x4& au, float rstd, const f32x4& bg, const f32x4& bu) {
        unsigned w = 0;
#pragma unroll
        for (int h = 0; h < 2; ++h) {
            const f32x2 a2 = {ag[2 * h], ag[2 * h + 1]}, u2 = {au[2 * h], au[2 * h + 1]}, bg2 = {bg[2 * h], bg[2 * h + 1]}, bu2 = {bu[2 * h], bu[2 * h + 1]};
            const f32x2 G = a2 * rstd + bg2, U = u2 * rstd + bu2;
            const f32x2 gg = {fminf(G[0], 7.0f), fminf(G[1], 7.0f)};
            const f32x2 t = gg * (-1.702f * 1.4426950408889634f);
            const f32x2 d = (f32x2){__builtin_amdgcn_exp2f(t[0]), __builtin_amdgcn_exp2f(t[1])} + 1.0f;
            const f32x2 r = {__builtin_amdgcn_rcpf(d[0]), __builtin_amdgcn_rcpf(d[1])};
            const f32x2 uu = {__builtin_amdgcn_fmed3f(U[0], -7.0f, 7.0f), __builtin_amdgcn_fmed3f(U[1], -7.0f, 7.0f)};
            const f32x2 o = (gg * r) * (uu * A8_SCALE + A8_SCALE);
            w = h ? (unsigned)__builtin_amdgcn_cvt_pk_fp8_f32(o[0], o[1], (int)w, true) : (unsigned)__builtin_amdgcn_cvt_pk_fp8_f32(o[0], o[1], (int)w, false);
        }
        return w;
    }
    __device__ __forceinline__ void operator()(AccRef acc, const Unit& u, int wr, int wc, int fr, int fq, int par) const {
        int z = 0; asm volatile("" : "+v"(z));
        const int col = 128 * u.pn + 32 * wc + 8 * fq + z; const LAS unsigned char* b = xb + par * 2048; const LAS unsigned char* bb = b + 1024 + (32 * wc + 8 * fq + z) * 4;
        const f32x4 bg0 = *(const LAS f32x4*)bb, bg1 = *(const LAS f32x4*)(bb + 16), bu0 = *(const LAS f32x4*)(bb + 512), bu1 = *(const LAS f32x4*)(bb + 528);
#pragma unroll
        for (int ai = 0; ai < 2; ++ai)
#pragma unroll
            for (int m = 0; m < 4; ++m) { const int r = ai * HALF + wr * 64 + m * 16 + fr;
                const float rstd = *(const LAS float*)(b + (r + z) * 4) * (1.0f / W8_SCALE);
                u32x2 w8; w8.x = swi4(acc[ai][0][m][0], acc[ai][1][m][0], rstd, bg0, bu0); w8.y = swi4(acc[ai][0][m][1], acc[ai][1][m][1], rstd, bg1, bu1);
                *(u32x2*)(ACT + (size_t)(u.pm * BM + r) * 1024 + col) = w8; }
    }
};
struct EpiDown {
    static constexpr bool HAS_MID = false; static constexpr bool HAS_PRE = true;
    unsigned char* Y4; const u32x2* list; const float* bd; LAS unsigned char* xb;
    __device__ __forceinline__ void pre(const Unit& u, int ui, int wid, int lane) const {
        LAS unsigned char* b = xb + (ui & 1) * 2048;
        if (wid < 4) { const int rr = u.mt * BM + 64 * wid + lane, rc = rr < u.cnt ? rr : u.cnt - 1; dma4((const unsigned*)(list + (size_t)u.e * CAP + rc), b + wid * 256); }
        else { const int j = 64 * (wid - 4) + lane; dma4(bd + (size_t)u.e * 1024 + u.pn * BM + j, b + 1024 + (wid - 4) * 256); }
    }
    __device__ __forceinline__ static unsigned dn4(const f32x4& a, const f32x4& b32) {
        const f32x4 y = a * (Y8_SCALE / (W8_SCALE * A8_SCALE)) + b32;
        return pk4_fp8(y[0], y[1], y[2], y[3]);
    }
    __device__ __forceinline__ void operator()(AccRef acc, const Unit& u, int wr, int wc, int fr, int fq, int par) const {
        int z = 0; asm volatile("" : "+v"(z));
        const int colw = wc * 64 + 16 * fq + z, col0 = u.pn * BM + colw;
        const LAS unsigned char* b = xb + par * 2048;
        f32x4 bv[2][2];
#pragma unroll
        for (int bj = 0; bj < 2; ++bj)
#pragma unroll
            for (int n = 0; n < 2; ++n) bv[bj][n] = *(const LAS f32x4*)(b + 1024 + (colw + 8 * bj + 4 * n) * 4) * Y8_SCALE;
#pragma unroll
        for (int ai = 0; ai < 2; ++ai)
#pragma unroll
            for (int m = 0; m < 4; ++m) { const int r = ai * HALF + wr * 64 + m * 16 + fr, rr = u.mt * BM + r;
                if (rr < u.cnt) { const unsigned tk = *(const LAS unsigned*)(b + (r + z) * 4);
                    u32x4 w8; w8.x = dn4(acc[ai][0][m][0], bv[0][0]); w8.y = dn4(acc[ai][0][m][1], bv[0][1]); w8.z = dn4(acc[ai][1][m][0], bv[1][0]); w8.w = dn4(acc[ai][1][m][1], bv[1][1]);
                    *(u32x4*)(Y4 + (size_t)tk * 1024 + col0) = w8; } }
    }
};
struct EpiMergeR {
    static constexpr bool HAS_MID = true; static constexpr bool HAS_PRE = false; static constexpr int MID_T0 = 8, MID_T1 = 12;
    const bf16_t* GT; bf16_t* MB;
    __device__ __forceinline__ void mid(f32x4 (&acc)[2][2][4][2], const Unit& u, int wr, int wc, int fr, int fq, int seam) const {
        int z = 0; asm volatile("" : "+v"(z));
        const unsigned char* gp0 = (const unsigned char*)GT + ((size_t)(seam * 128 + u.pm) * 4 + u.pn) * 65536 + (size_t)((wr * 4 + wc) * 16 * 64 + (fq * 16 + fr) + z) * 8;
#pragma unroll
        for (int ai = 0; ai < 2; ++ai)
#pragma unroll
            for (int m = 0; m < 4; ++m) {
#pragma unroll
                for (int bj = 0; bj < 2; ++bj) { const unsigned char* gp = gp0 + (ai * 8 + m * 2 + bj) * 512;
                    const u32x2 gn = *(const u32x2*)gp, gd = *(const u32x2*)(gp + (size_t)128 * 4 * 65536);
#pragma unroll
                    for (int n = 0; n < 2; ++n) { const unsigned wn = n ? gn.y : gn.x, wd = n ? gd.y : gd.x;
#pragma unroll
                        for (int j = 0; j < 4; ++j) acc[ai][bj][m][n][j] *= (float)((wn >> (8 * j)) & 0xffu) * __builtin_amdgcn_rcpf((float)((wd >> (8 * j)) & 0xffu)); } }
                if (m & 1) asm volatile("" ::: "memory"); }
    }
    __device__ __forceinline__ void operator()(AccRef acc, const Unit& u, int wr, int wc, int fr, int fq) const {
        int z = 0; asm volatile("" : "+v"(z));
        const size_t off0 = (size_t)(u.pm * BM + wr * 64 + fr + z) * 1024 + u.pn * BM + wc * 64 + 8 * fq;
        const unsigned char* gp0 = (const unsigned char*)GT + ((size_t)(2 * 128 + u.pm) * 4 + u.pn) * 65536 + (size_t)((wr * 4 + wc) * 16 * 64 + (fq * 16 + fr) + z) * 8;
#pragma unroll
        for (int ai = 0; ai < 2; ++ai)
#pragma unroll
            for (int m = 0; m < 4; ++m) { const size_t ro = off0 + (size_t)(ai * HALF + m * 16) * 1024;
#pragma unroll
                for (int bj = 0; bj < 2; ++bj) {
                    const u32x2 g = *(const u32x2*)(gp0 + (ai * 8 + m * 2 + bj) * 512);
                    f32x4 ga, gb;
#pragma unroll
                    for (int j = 0; j < 4; ++j) { ga[j] = (float)((g.x >> (8 * j)) & 0xffu) * (1.0f / 255.0f); gb[j] = (float)((g.y >> (8 * j)) & 0xffu) * (1.0f / 255.0f); }
                    store8(MB + ro + 32 * bj, acc[ai][bj][m][0] * ga, acc[ai][bj][m][1] * gb); } }
    }
};
struct EpiPlain {
    static constexpr bool HAS_MID = false; static constexpr bool HAS_PRE = false;
    bf16_t* Z; int ldz;
    __device__ __forceinline__ void operator()(AccRef acc, const Unit& u, int wr, int wc, int fr, int fq) const {
        const int row0 = u.pm * BM + wr * 64 + fr, col0 = u.pn * BM + wc * 64 + 8 * fq;
#pragma unroll
        for (int ai = 0; ai < 2; ++ai)
#pragma unroll
            for (int m = 0; m < 4; ++m) { bf16_t* rowp = Z + (size_t)(row0 + ai * HALF + m * 16) * ldz + col0;
                store8(rowp, acc[ai][0][m][0], acc[ai][0][m][1]); store8(rowp + 32, acc[ai][1][m][0], acc[ai][1][m][1]); }
    }
};
}

namespace attn_body {
using bf16 = __hip_bfloat16;
using s16x4 = __attribute__((ext_vector_type(4))) short;
constexpr int NW = 8, QBLK = 32, QB = QBLK * NW, KVBLK = 64, D = 64;
__device__ __forceinline__ int crow(int r, int hi) { return (r & 3) + 8 * (r >> 2) + 4 * hi; }
#define SBAR() __builtin_amdgcn_sched_barrier(0)
constexpr int NSLOT = 3, SLOTB = 8192;
constexpr int LDS_K = 0, LDS_V = NSLOT * SLOTB, LDS_WS = 2 * NSLOT * SLOTB, LDS_OST = LDS_WS + NW * 64 * 4, LDS_BYTES = LDS_OST + NW * 4096;
__device__ __forceinline__ void glds16(const void* gsrc, unsigned lds_dst) { unsigned keep;
    asm volatile("s_mov_b32 %0, m0\n\ts_mov_b32 m0, %2\n\ts_nop 0\n\tglobal_load_lds_dwordx4 %1, off\n\ts_mov_b32 m0, %0" : "=&s"(keep) : "v"(gsrc), "s"(lds_dst) : "memory"); }
__device__ __forceinline__ float max3f(float a, float b, float c) { float r; asm("v_max3_f32 %0, %1, %2, %3" : "=v"(r) : "v"(a), "v"(b), "v"(c)); return r; }
__device__ __forceinline__ float max2f(float a, float b) { float r; asm("v_max_f32_e32 %0, %1, %2" : "=v"(r) : "v"(a), "v"(b)); return r; }
__device__ __forceinline__ float fadd_s(float a, float b) { float r; asm("v_add_f32_e32 %0, %1, %2" : "=v"(r) : "v"(a), "v"(b)); return r; }
__device__ __forceinline__ float fsub_s(float a, float b) { float r; asm("v_sub_f32_e32 %0, %1, %2" : "=v"(r) : "v"(a), "v"(b)); return r; }
typedef float f32x2_t __attribute__((ext_vector_type(2))); typedef __bf16 bf16x2_t __attribute__((ext_vector_type(2)));
__device__ __forceinline__ unsigned cvtpk_s(float lo, float hi) { f32x2_t v = {lo, hi}; bf16x2_t b = __builtin_convertvector(v, bf16x2_t); return __builtin_bit_cast(unsigned, b); }
#define WAIT_BAR(N) asm volatile("s_waitcnt vmcnt(" #N ") lgkmcnt(0)\n\ts_barrier" ::: "memory")

__device__ __forceinline__ void qkt(f32x16& p0, f32x16& p1, const char* Kslot, const bf16x8* qr, const f32x16& negm, int r32, int hi) {
    const char* kb = Kslot + hi * 1024 + r32 * 16;
#pragma unroll
    for (int d0 = 0; d0 < 4; ++d0) {
        const bf16x8 b0 = *reinterpret_cast<const bf16x8*>(kb + d0 * 2048);
        const bf16x8 b1 = *reinterpret_cast<const bf16x8*>(kb + d0 * 2048 + 512);
        if (d0 == 0) { p0 = __builtin_amdgcn_mfma_f32_32x32x16_bf16(b0, qr[0], negm, 0, 0, 0); p1 = __builtin_amdgcn_mfma_f32_32x32x16_bf16(b1, qr[0], negm, 0, 0, 0); }
        else { p0 = __builtin_amdgcn_mfma_f32_32x32x16_bf16(b0, qr[d0], p0, 0, 0, 0); p1 = __builtin_amdgcn_mfma_f32_32x32x16_bf16(b1, qr[d0], p1, 0, 0, 0); } }
}
typedef __attribute__((address_space(3))) const char* lds_cptr;
typedef short v4i16_t __attribute__((ext_vector_type(4)));
__device__ __forceinline__ void kload8(bf16x8* kf, lds_cptr kp) {
    kf[0] = *(const __attribute__((address_space(3))) bf16x8*)(kp);        kf[1] = *(const __attribute__((address_space(3))) bf16x8*)(kp + 512);
    kf[2] = *(const __attribute__((address_space(3))) bf16x8*)(kp + 2048); kf[3] = *(const __attribute__((address_space(3))) bf16x8*)(kp + 2560);
    kf[4] = *(const __attribute__((address_space(3))) bf16x8*)(kp + 4096); kf[5] = *(const __attribute__((address_space(3))) bf16x8*)(kp + 4608);
    kf[6] = *(const __attribute__((address_space(3))) bf16x8*)(kp + 6144); kf[7] = *(const __attribute__((address_space(3))) bf16x8*)(kp + 6656);
}
__device__ __forceinline__ void kload2(bf16x8* kf, lds_cptr kp, int j) { kf[2 * j] = *(const __attribute__((address_space(3))) bf16x8*)(kp + j * 2048); kf[2 * j + 1] = *(const __attribute__((address_space(3))) bf16x8*)(kp + j * 2048 + 512); }
__device__ __forceinline__ s16x4 vtr(lds_cptr p) { return __builtin_bit_cast(s16x4, __builtin_amdgcn_ds_read_tr16_b64_v4i16((__attribute__((address_space(3))) v4i16_t*)p)); }
__device__ __forceinline__ float rowmax(const f32x16& p0, const f32x16& p1) {
    float a = max3f(p0[0], p0[1], p1[0]), b = max3f(p0[2], p0[3], p1[1]); a = max3f(a, p1[2], p1[3]);
#pragma unroll
    for (int r = 4; r < 16; r += 4) { a = max3f(a, p0[r], p0[r + 1]); b = max3f(b, p0[r + 2], p0[r + 3]); a = max3f(a, p1[r], p1[r + 1]); b = max3f(b, p1[r + 2], p1[r + 3]); }
    const float m = max2f(a, b);
    auto rr = __builtin_amdgcn_permlane32_swap(__float_as_uint(m), __float_as_uint(m), false, false);
    return max2f(__uint_as_float(rr[0]), __uint_as_float(rr[1]));
}
__device__ __forceinline__ void pv(f32x16* o, int vb, bf16x8 pa0, bf16x8 pa1, bf16x8 pa2, bf16x8 pa3) {
#pragma unroll
    for (int d0 = 0; d0 < 2; ++d0) { s16x4 lo[4], hi[4];
#pragma unroll
        for (int ks = 0; ks < 4; ++ks) {
            asm volatile("ds_read_b64_tr_b16 %0,%1 offset:%c2" : "=&v"(lo[ks]) : "v"(vb), "i"(d0 * 4096 + ks * 1024) : "memory");
            asm volatile("ds_read_b64_tr_b16 %0,%1 offset:%c2" : "=&v"(hi[ks]) : "v"(vb), "i"(d0 * 4096 + ks * 1024 + 512) : "memory"); }
        asm volatile("s_waitcnt lgkmcnt(0)" ::: "memory"); SBAR();
#define PK(k) (bf16x8){lo[k][0], lo[k][1], lo[k][2], lo[k][3], hi[k][0], hi[k][1], hi[k][2], hi[k][3]}
        o[d0] = __builtin_amdgcn_mfma_f32_32x32x16_bf16(pa0, PK(0), o[d0], 0, 0, 0);
        o[d0] = __builtin_amdgcn_mfma_f32_32x32x16_bf16(pa1, PK(1), o[d0], 0, 0, 0);
        o[d0] = __builtin_amdgcn_mfma_f32_32x32x16_bf16(pa2, PK(2), o[d0], 0, 0, 0);
        o[d0] = __builtin_amdgcn_mfma_f32_32x32x16_bf16(pa3, PK(3), o[d0], 0, 0, 0);
#undef PK
    }
}
__device__ __forceinline__ void cmask(f32x16& p0, f32x16& p1, int jb, int wid) {
    if (jb > (wid >> 1)) {
#pragma unroll
        for (int r = 0; r < 16; ++r) { p0[r] = -INFINITY; p1[r] = -INFINITY; } }
}
template <int THRL, bool MASK> __device__ __forceinline__ void attn_unit(int q0, int NT, const bf16* Qh, int qp, const bf16* __restrict__ Kh, int kp, const bf16* __restrict__ Vh, int vp, bf16* Oh, int op, char* shm) {
    const int tid = threadIdx.x, lane = tid & 63, r32 = lane & 31, hi = lane >> 5; const int wid = __builtin_amdgcn_readfirstlane(tid >> 6);
    const bf16* Qw = Qh + (long)(q0 + wid * QBLK) * qp;
    const unsigned lds0 = (unsigned)(uintptr_t)shm;
    float* wsf = (float*)(shm + LDS_WS) + wid * 64;
    const bf16* ksrc = Kh + (long)lane * kp + wid * 8;
    const bf16* vsrc = Vh + (long)(16 * (wid & 3) + (lane >> 2)) * vp + (wid >> 2) * 32 + (lane & 3) * 8;
    const unsigned kdst = lds0 + LDS_K + wid * 1024, vdst = lds0 + LDS_V + wid * 1024;
#define DMA_K(t, slot) glds16(ksrc + (long)(t) * KVBLK * kp, (unsigned)__builtin_amdgcn_readfirstlane(kdst + (slot)))
#define DMA_V(t, slot) glds16(vsrc + (long)(t) * KVBLK * vp, (unsigned)__builtin_amdgcn_readfirstlane(vdst + (slot)))
    const int vb0 = (int)(lds0 + LDS_V) + ((lane >> 4) & 1) * 32 + (lane & 3) * 8 + (4 * hi + ((lane & 15) >> 2)) * 64;
    const char* Kbase = shm + LDS_K; bf16x8 kf[8];
    const lds_cptr shm3 = (lds_cptr)shm; const lds_cptr kp0 = shm3 + LDS_K + hi * 1024 + r32 * 16; const lds_cptr vp0 = shm3 + LDS_V + ((lane >> 4) & 1) * 32 + (lane & 3) * 8 + (4 * hi + ((lane & 15) >> 2)) * 64;
    DMA_K(0, 0); DMA_V(0, 0); DMA_K(1, SLOTB);
    bf16x8 qr[4];
#pragma unroll
    for (int d0 = 0; d0 < 4; ++d0) qr[d0] = *reinterpret_cast<const bf16x8*>(&Qw[(long)r32 * qp + d0 * 16 + hi * 8]);
    float mhat = 0.f, l_reg = 0.f; f32x16 o[2]; o[0] = f32x16{}; o[1] = f32x16{}; f32x16 negm = f32x16{}; asm volatile("" : "+v"(negm));
#define CMASK(P0, P1, t) do { if (MASK) { int jb_ = (t) - (NT - 4); if (jb_ >= 0) cmask(P0, P1, jb_, wid); } } while (0)
    bool resc = false;
#define START(P0, P1) do { const float rm = rowmax(P0, P1); resc = false; \
    { const float dl = rm; mhat = fadd_s(mhat, dl); \
      _Pragma("unroll") for (int r = 0; r < 16; ++r) { P0[r] = fsub_s(P0[r], dl); P1[r] = fsub_s(P1[r], dl); } \
      _Pragma("unroll") for (int r = 0; r < 16; ++r) negm[r] = -mhat; asm volatile("" : "+v"(negm)); } \
    _Pragma("unroll") for (int r = 0; r < 16; ++r) P0[r] = __builtin_amdgcn_exp2f(P0[r]); } while (0)
#define RESC() do { if (resc) { asm volatile("s_waitcnt lgkmcnt(0)" ::: "memory"); \
      _Pragma("unroll") for (int d_ = 0; d_ < 2; ++d_) _Pragma("unroll") for (int r = 0; r < 16; ++r) o[d_][r] *= wsf[crow(r, hi)]; } } while (0)
    f32x16 pA0, pA1, pB0, pB1;
    int sl_prev = 0, sl_cur = 0, sl_next = SLOTB;
#define ROT() do { sl_prev = sl_cur; sl_cur = sl_next; sl_next = (sl_next == (NSLOT - 1) * SLOTB) ? 0 : sl_next + SLOTB; } while (0)
    DMA_K(2, 2 * SLOTB);
    WAIT_BAR(3);
    qkt(pA0, pA1, Kbase, qr, negm, r32, hi); asm volatile("s_nop 15\n\ts_nop 7" : "+v"(pA0), "+v"(pA1)); CMASK(pA0, pA1, 0);
    START(pA0, pA1);
    _Pragma("unroll") for (int r = 0; r < 16; ++r) pA1[r] = __builtin_amdgcn_exp2f(pA1[r]);
    WAIT_BAR(0);
    DMA_K(3, 0); DMA_V(1, SLOTB);
    ROT();
    kload8(kf, kp0 + sl_cur);
    WAIT_BAR(2);
    s16x4 vlo[8], vhi[8]; u32x4 pw0, pw1, pw2, pw3;
#define PKW(P, B) cvtpk_s(P[B], P[B + 1])
#define PAF(k) __builtin_bit_cast(bf16x8, pw##k)
#define VFR(i) (bf16x8){vlo[i][0], vlo[i][1], vlo[i][2], vlo[i][3], vhi[i][0], vhi[i][1], vhi[i][2], vhi[i][3]}
#define PIN(x) asm volatile("" : "+v"(x))
#define MX3(a, b, c) __builtin_fmaxf(__builtin_fmaxf((a), (b)), (c))
#define GAPA(MF, A0, A1, A2, A3, W0, W1, PW) do { MF; sacc += A0; sacc += A1; sacc += A2; sacc += A3; PIN(sacc); W0; W1; PIN(PW); SBAR(); } while (0)
#define EX(v) __builtin_amdgcn_exp2f(v)
#define GAPB(MF, X, B) do { MF; X[B] = EX(X[B]); X[B + 1] = EX(X[B + 1]); X[B + 2] = EX(X[B + 2]); X[B + 3] = EX(X[B + 3]); PIN(X); SBAR(); } while (0)
#define VRD(i) do { vlo[i] = vtr(vp_ + (((i) >> 2) * 4096 + ((i) & 3) * 1024)); vhi[i] = vtr(vp_ + (((i) >> 2) * 4096 + ((i) & 3) * 1024 + 512)); } while (0)
#define KRD(G, j) do { if (G) { kload2(kf, kp0 + sl_next, j); SBAR(); } } while (0)
#define STEP(C0, C1, P0, P1, t, GK, GV, GL) do { SBAR(); \
    const lds_cptr vp_ = vp0 + sl_prev; \
    VRD(0); SBAR(); float sacc = (P0[0] + P0[1]); \
    GAPA(C0 = __builtin_amdgcn_mfma_f32_32x32x16_bf16(kf[0], qr[0], negm, 0, 0, 0), P0[2], P0[3], P0[4], P0[5],     pw0[0] = PKW(P0, 0), pw0[1] = PKW(P0, 2), pw0); \
    VRD(4); SBAR(); GAPA(C1 = __builtin_amdgcn_mfma_f32_32x32x16_bf16(kf[1], qr[0], negm, 0, 0, 0), P0[6], P0[7], P0[8], P0[9],     pw0[2] = PKW(P0, 4), pw0[3] = PKW(P0, 6), pw0); \
    VRD(1); SBAR(); GAPA(C0 = __builtin_amdgcn_mfma_f32_32x32x16_bf16(kf[2], qr[1], C0, 0, 0, 0),   P0[10], P0[11], P0[12], P0[13], pw1[0] = PKW(P0, 8), pw1[1] = PKW(P0, 10), pw1); \
    VRD(5); SBAR(); GAPA(C1 = __builtin_amdgcn_mfma_f32_32x32x16_bf16(kf[3], qr[1], C1, 0, 0, 0),   P0[14], P0[15], P1[0], P1[1],   pw1[2] = PKW(P0, 12), pw1[3] = PKW(P0, 14), pw1); \
    VRD(2); SBAR(); GAPA(C0 = __builtin_amdgcn_mfma_f32_32x32x16_bf16(kf[4], qr[2], C0, 0, 0, 0),   P1[2], P1[3], P1[4], P1[5],     pw2[0] = PKW(P1, 0), pw2[1] = PKW(P1, 2), pw2); \
    VRD(6); SBAR(); GAPA(C1 = __builtin_amdgcn_mfma_f32_32x32x16_bf16(kf[5], qr[2], C1, 0, 0, 0),   P1[6], P1[7], P1[8], P1[9],     pw2[2] = PKW(P1, 4), pw2[3] = PKW(P1, 6), pw2); \
    VRD(3); SBAR(); GAPA(C0 = __builtin_amdgcn_mfma_f32_32x32x16_bf16(kf[6], qr[3], C0, 0, 0, 0),   P1[10], P1[11], P1[12], P1[13], pw3[0] = PKW(P1, 8), pw3[1] = PKW(P1, 10), pw3); \
    VRD(7); SBAR(); GAPA(C1 = __builtin_amdgcn_mfma_f32_32x32x16_bf16(kf[7], qr[3], C1, 0, 0, 0),   P1[14], P1[15], 0.f, 0.f,       pw3[2] = PKW(P1, 12), pw3[3] = PKW(P1, 14), pw3); \
    l_reg += sacc; \
    if (GK) { DMA_K((t) + 3, sl_cur); } if (GV) { DMA_V((t) + 1, sl_next); } \
    CMASK(C0, C1, t); \
    { float a = MX3(C0[0], C0[1], C1[0]), b = MX3(C0[2], C0[3], C1[1]); a = MX3(a, C1[2], C1[3]); \
      _Pragma("unroll") for (int r = 4; r < 16; r += 4) { a = MX3(a, C0[r], C0[r + 1]); b = MX3(b, C0[r + 2], C0[r + 3]); a = MX3(a, C1[r], C1[r + 1]); b = MX3(b, C1[r + 2], C1[r + 3]); } \
      float rm = __builtin_fmaxf(a, b); { auto rr = __builtin_amdgcn_permlane32_swap(__float_as_uint(rm), __float_as_uint(rm), false, false); rm = __builtin_fmaxf(__uint_as_float(rr[0]), __uint_as_float(rr[1])); } \
      resc = false; \
      if (__builtin_expect(__any(rm > (float)THRL), 0)) { const float dl = __builtin_fmaxf(rm, 0.f); mhat += dl; \
        _Pragma("unroll") for (int r = 0; r < 16; ++r) { C0[r] -= dl; C1[r] -= dl; } \
        _Pragma("unroll") for (int r = 0; r < 16; ++r) negm[r] = -mhat; asm volatile("" : "+v"(negm)); \
        const float f = __builtin_amdgcn_exp2f(-dl); l_reg *= f; if (hi == 0) wsf[r32] = f; resc = true; } } \
    SBAR(); \
    GAPB(o[0] = __builtin_amdgcn_mfma_f32_32x32x16_bf16(PAF(0), VFR(0), o[0], 0, 0, 0), C0, 0); \
    GAPB(o[1] = __builtin_amdgcn_mfma_f32_32x32x16_bf16(PAF(0), VFR(4), o[1], 0, 0, 0), C0, 4); \
    KRD(GL, 0); GAPB(o[0] = __builtin_amdgcn_mfma_f32_32x32x16_bf16(PAF(1), VFR(1), o[0], 0, 0, 0), C0, 8); \
    KRD(GL, 1); GAPB(o[1] = __builtin_amdgcn_mfma_f32_32x32x16_bf16(PAF(1), VFR(5), o[1], 0, 0, 0), C0, 12); \
    KRD(GL, 2); GAPB(o[0] = __builtin_amdgcn_mfma_f32_32x32x16_bf16(PAF(2), VFR(2), o[0], 0, 0, 0), C1, 0); \
    KRD(GL, 3); GAPB(o[1] = __builtin_amdgcn_mfma_f32_32x32x16_bf16(PAF(2), VFR(6), o[1], 0, 0, 0), C1, 4); \
    GAPB(o[0] = __builtin_amdgcn_mfma_f32_32x32x16_bf16(PAF(3), VFR(3), o[0], 0, 0, 0), C1, 8); \
    GAPB(o[1] = __builtin_amdgcn_mfma_f32_32x32x16_bf16(PAF(3), VFR(7), o[1], 0, 0, 0), C1, 12); \
    } while (0)
    int t = 1;
#undef CMASK
#define CMASK(P0, P1, t) do {} while (0)
    for (; t + 5 < NT; t += 2) {
        STEP(pB0, pB1, pA0, pA1, t, true, true, true);     WAIT_BAR(2); RESC(); ROT();
        STEP(pA0, pA1, pB0, pB1, t + 1, true, true, true); WAIT_BAR(2); RESC(); ROT();
    }
#undef CMASK
#define CMASK(P0, P1, t) do { if (MASK) { int jb_ = (t) - (NT - 4); if (jb_ >= 0) cmask(P0, P1, jb_, wid); } } while (0)
#define ENDW(tt) do { if ((tt) + 3 < NT) { WAIT_BAR(2); } else if ((tt) + 2 < NT) { WAIT_BAR(1); } else { WAIT_BAR(0); } } while (0)
    for (; t + 1 < NT; t += 2) {
        STEP(pB0, pB1, pA0, pA1, t, (t + 3 < NT), (t + 1 < NT), (t + 1 < NT));       ENDW(t);     RESC(); ROT();
        STEP(pA0, pA1, pB0, pB1, t + 1, (t + 4 < NT), (t + 2 < NT), (t + 2 < NT));   ENDW(t + 1); RESC(); ROT();
    }
    STEP(pB0, pB1, pA0, pA1, NT - 1, false, false, false); RESC();
    { float sacc = pB0[0] + pB0[1]; _Pragma("unroll") for (int r = 2; r < 16; ++r) sacc += pB0[r]; _Pragma("unroll") for (int r = 0; r < 16; ++r) sacc += pB1[r]; l_reg += sacc;
      pw0 = (u32x4){PKW(pB0, 0), PKW(pB0, 2), PKW(pB0, 4), PKW(pB0, 6)}; pw1 = (u32x4){PKW(pB0, 8), PKW(pB0, 10), PKW(pB0, 12), PKW(pB0, 14)}; pw2 = (u32x4){PKW(pB1, 0), PKW(pB1, 2), PKW(pB1, 4), PKW(pB1, 6)}; pw3 = (u32x4){PKW(pB1, 8), PKW(pB1, 10), PKW(pB1, 12), PKW(pB1, 14)};
      SBAR(); pv(o, vb0 + sl_cur, PAF(0), PAF(1), PAF(2), PAF(3)); }
#undef PKW
#undef PAF
#undef VFR
#undef PIN
#undef MX3
#undef GAPA
#undef GAPB
#undef EX
#undef VRD
#undef KRD
#undef STEP
#undef ENDW
    { auto rr = __builtin_amdgcn_permlane32_swap(__float_as_uint(l_reg), __float_as_uint(l_reg), false, false); l_reg = __uint_as_float(rr[0]) + __uint_as_float(rr[1]); }
    if (hi == 0) wsf[32 + r32] = l_reg; asm volatile("s_waitcnt lgkmcnt(0)" ::: "memory");
    float rli[16];
#pragma unroll
    for (int r = 0; r < 16; ++r) rli[r] = __builtin_amdgcn_rcpf(wsf[32 + crow(r, hi)]);
    bf16* Ow = Oh + (long)(q0 + wid * QBLK) * op;
    { bf16* stg = (bf16*)(shm + LDS_OST) + wid * 2048;
#pragma unroll
      for (int r = 0; r < 16; ++r) { const int orow = crow(r, hi);
#pragma unroll
        for (int d0 = 0; d0 < 2; ++d0) stg[orow * 64 + d0 * 32 + r32] = __float2bfloat16(o[d0][r] * rli[r]); }
      asm volatile("s_waitcnt lgkmcnt(0)" ::: "memory");
#pragma unroll
      for (int i = 0; i < 4; ++i) { const int row = i * 8 + (lane >> 3), ch = lane & 7; const u32x4 v = *(const u32x4*)(stg + row * 64 + ch * 8); *(u32x4*)(Ow + (long)row * op + ch * 8) = v; } }
    asm volatile("s_waitcnt lgkmcnt(0)\n\ts_barrier" ::: "memory");
#undef DMA_K
#undef DMA_V
#undef CMASK
#undef START
#undef RESC
#undef ROT
}

constexpr int L2_K = 0, L2_V = 3 * 8192, L2_WS = L2_V + 4 * 16384, L2_OST = L2_WS + NW * 64 * 4, L2_BYTES = L2_OST + NW * 4096;
template <bool MASK> __device__ __forceinline__ void attn_unit2(int q0, int NT, const bf16* Qh, int qp, const bf16* __restrict__ Kh, int kp, const bf16* __restrict__ Vh, int vp, bf16* Oh, int op, char* shm) {
    const int tid = threadIdx.x, lane = tid & 63, r32 = lane & 31, hi = lane >> 5; const int wid = __builtin_amdgcn_readfirstlane(tid >> 6);
    const bf16* Qw = Qh + (long)(q0 + wid * QBLK) * qp;
    const unsigned lds0 = (unsigned)(uintptr_t)shm;
    float* wsf = (float*)(shm + L2_WS) + wid * 64;
    const bf16* ksrc = Kh + (long)lane * kp + wid * 8;
    const bf16* vsrc = Vh + (long)(16 * (wid & 3) + (lane >> 2)) * vp + (wid >> 2) * 32 + (lane & 3) * 8;
    const unsigned kdst = lds0 + L2_K + wid * 1024, vdst = lds0 + L2_V + wid * 1024;
#define DMA_K(t, slot) glds16(ksrc + (long)(t) * KVBLK * kp, (unsigned)__builtin_amdgcn_readfirstlane(kdst + (slot)))
#define DMA_V(t, vslot) do { glds16(vsrc + (long)(t) * KVBLK * vp, (unsigned)__builtin_amdgcn_readfirstlane(vdst + (vslot))); \
                            glds16(vsrc + (long)(t) * KVBLK * vp + 64, (unsigned)__builtin_amdgcn_readfirstlane(vdst + (vslot) + 8192)); } while (0)
    const int vb0 = (int)(lds0 + L2_V) + ((lane >> 4) & 1) * 32 + (lane & 3) * 8 + (4 * hi + ((lane & 15) >> 2)) * 64;
    const char* Kbase = shm + L2_K; bf16x8 kf[8];
    const lds_cptr shm3 = (lds_cptr)shm; const lds_cptr kp0 = shm3 + L2_K + hi * 1024 + r32 * 16; const lds_cptr vp0 = shm3 + L2_V + ((lane >> 4) & 1) * 32 + (lane & 3) * 8 + (4 * hi + ((lane & 15) >> 2)) * 64;
    DMA_K(0, 0); DMA_V(0, 0); DMA_K(1, SLOTB);
    bf16x8 qr[4];
#pragma unroll
    for (int d0 = 0; d0 < 4; ++d0) qr[d0] = *reinterpret_cast<const bf16x8*>(&Qw[(long)r32 * qp + d0 * 16 + hi * 8]);
    float l_reg = 0.f; f32x16 o[4]; o[0] = f32x16{}; o[1] = f32x16{}; o[2] = f32x16{}; o[3] = f32x16{};
    const f32x16 zero16 = f32x16{};
#define CMASK(P0, P1, t) do { if (MASK) { int jb_ = (t) - (NT - 4); if (jb_ >= 0) cmask(P0, P1, jb_, wid); } } while (0)
    f32x16 pA0, pA1, pB0, pB1;
    int sl_prev = 0, sl_cur = 0, sl_next = SLOTB;
    int vs_rd = 0, vs_wr = 3 * 16384;
#define ROT() do { sl_prev = sl_cur; sl_cur = sl_next; sl_next = (sl_next == (NSLOT - 1) * SLOTB) ? 0 : sl_next + SLOTB; vs_rd = (vs_rd + 16384) & 65535; vs_wr = (vs_wr + 16384) & 65535; } while (0)
    DMA_K(2, 2 * SLOTB); DMA_V(1, 16384);
    WAIT_BAR(6);
    qkt(pA0, pA1, Kbase, qr, zero16, r32, hi); CMASK(pA0, pA1, 0);
    _Pragma("unroll") for (int r = 0; r < 16; ++r) { pA0[r] = __builtin_amdgcn_exp2f(pA0[r]); pA1[r] = __builtin_amdgcn_exp2f(pA1[r]); }
    WAIT_BAR(2);
    DMA_K(3, 0); DMA_V(2, 2 * 16384);
    sl_prev = sl_cur; sl_cur = sl_next; sl_next = 2 * SLOTB;
    kload8(kf, kp0 + sl_cur);
    WAIT_BAR(5);
    s16x4 f0lo, f0hi, f1lo, f1hi, f2lo, f2hi, f3lo, f3hi; u32x4 pw0, pw1, pw2, pw3;
#define PKW(P, B) cvtpk_s(P[B], P[B + 1])
#define PAF(k) __builtin_bit_cast(bf16x8, pw##k)
#define PIN(x) asm volatile("" : "+v"(x))
#define EX(v) __builtin_amdgcn_exp2f(v)
#define VOFF(id) ((((id) >> 2) * 4096) + (((id) & 3) * 1024))
#define VRD2(F, id) do { F##lo = vtr(vp_ + VOFF(id)); F##hi = vtr(vp_ + VOFF(id) + 512); } while (0)
#define VFR2(F) (bf16x8){F##lo[0], F##lo[1], F##lo[2], F##lo[3], F##hi[0], F##hi[1], F##hi[2], F##hi[3]}
#define GAPA(MF, A0, A1, A2, A3, W0, W1, PW) do { MF; sacc += A0; sacc += A1; sacc += A2; sacc += A3; PIN(sacc); W0; W1; PIN(PW); SBAR(); } while (0)
#define GAPB(MF, RD, X, B) do { MF; RD; X[B] = EX(X[B]); X[B + 1] = EX(X[B + 1]); PIN(X); SBAR(); } while (0)
#define KRD(G, j) do { if (G) { kload2(kf, kp0 + sl_next, j); SBAR(); } } while (0)
#define MF32(a, b, c) __builtin_amdgcn_mfma_f32_32x32x16_bf16(a, b, c, 0, 0, 0)
#define STEP(C0, C1, P0, P1, t, GK, GV, GL) do { SBAR(); __builtin_amdgcn_s_setprio(ATTN_PRIO_A); \
    const lds_cptr vp_ = vp0 + vs_rd; \
    float sacc = (P0[0] + P0[1]); \
    GAPA(C0 = MF32(kf[0], qr[0], zero16), P0[2], P0[3], P0[4], P0[5],     pw0[0] = PKW(P0, 0), pw0[1] = PKW(P0, 2), pw0); \
    GAPA(C1 = MF32(kf[1], qr[0], zero16), P0[6], P0[7], P0[8], P0[9],     pw0[2] = PKW(P0, 4), pw0[3] = PKW(P0, 6), pw0); \
    GAPA(C0 = MF32(kf[2], qr[1], C0),     P0[10], P0[11], P0[12], P0[13], pw1[0] = PKW(P0, 8), pw1[1] = PKW(P0, 10), pw1); \
    GAPA(C1 = MF32(kf[3], qr[1], C1),     P0[14], P0[15], P1[0], P1[1],   pw1[2] = PKW(P0, 12), pw1[3] = PKW(P0, 14), pw1); \
    VRD2(f0, 0); SBAR();  GAPA(C0 = MF32(kf[4], qr[2], C0), P1[2], P1[3], P1[4], P1[5],     pw2[0] = PKW(P1, 0), pw2[1] = PKW(P1, 2), pw2); \
    VRD2(f1, 4); SBAR();  GAPA(C1 = MF32(kf[5], qr[2], C1), P1[6], P1[7], P1[8], P1[9],     pw2[2] = PKW(P1, 4), pw2[3] = PKW(P1, 6), pw2); \
    VRD2(f2, 8); SBAR();  GAPA(C0 = MF32(kf[6], qr[3], C0), P1[10], P1[11], P1[12], P1[13], pw3[0] = PKW(P1, 8), pw3[1] = PKW(P1, 10), pw3); \
    VRD2(f3, 12); SBAR(); GAPA(C1 = MF32(kf[7], qr[3], C1), P1[14], P1[15], 0.f, 0.f,       pw3[2] = PKW(P1, 12), pw3[3] = PKW(P1, 14), pw3); \
    l_reg += sacc; __builtin_amdgcn_s_setprio(0); \
    if (GK) { DMA_K((t) + 3, sl_cur); } if (GV) { DMA_V((t) + 2, vs_wr); } \
    CMASK(C0, C1, t); \
    SBAR(); __builtin_amdgcn_s_setprio(ATTN_PRIO_B); \
    GAPB(o[0] = MF32(PAF(0), VFR2(f0), o[0]), VRD2(f0, 1),  C0, 0); \
    GAPB(o[1] = MF32(PAF(0), VFR2(f1), o[1]), VRD2(f1, 5),  C0, 2); \
    GAPB(o[2] = MF32(PAF(0), VFR2(f2), o[2]), VRD2(f2, 9),  C0, 4); \
    GAPB(o[3] = MF32(PAF(0), VFR2(f3), o[3]), VRD2(f3, 13), C0, 6); \
    KRD(GL, 0); GAPB(o[0] = MF32(PAF(1), VFR2(f0), o[0]), VRD2(f0, 2),  C0, 8); \
    GAPB(o[1] = MF32(PAF(1), VFR2(f1), o[1]), VRD2(f1, 6),  C0, 10); \
    KRD(GL, 1); GAPB(o[2] = MF32(PAF(1), VFR2(f2), o[2]), VRD2(f2, 10), C0, 12); \
    GAPB(o[3] = MF32(PAF(1), VFR2(f3), o[3]), VRD2(f3, 14), C0, 14); \
    KRD(GL, 2); GAPB(o[0] = MF32(PAF(2), VFR2(f0), o[0]), VRD2(f0, 3),  C1, 0); \
    GAPB(o[1] = MF32(PAF(2), VFR2(f1), o[1]), VRD2(f1, 7),  C1, 2); \
    KRD(GL, 3); GAPB(o[2] = MF32(PAF(2), VFR2(f2), o[2]), VRD2(f2, 11), C1, 4); \
    GAPB(o[3] = MF32(PAF(2), VFR2(f3), o[3]), VRD2(f3, 15), C1, 6); \
    GAPB(o[0] = MF32(PAF(3), VFR2(f0), o[0]), (void)0, C1, 8); \
    GAPB(o[1] = MF32(PAF(3), VFR2(f1), o[1]), (void)0, C1, 10); \
    GAPB(o[2] = MF32(PAF(3), VFR2(f2), o[2]), (void)0, C1, 12); \
    GAPB(o[3] = MF32(PAF(3), VFR2(f3), o[3]), (void)0, C1, 14); __builtin_amdgcn_s_setprio(0); \
    } while (0)
    int t = 1;
#undef CMASK
#define CMASK(P0, P1, t) do {} while (0)
    for (; t + 5 < NT; t += 2) {
        STEP(pB0, pB1, pA0, pA1, t, true, true, true);     WAIT_BAR(5); ROT();
        STEP(pA0, pA1, pB0, pB1, t + 1, true, true, true); WAIT_BAR(5); ROT();
    }
#undef CMASK
#define CMASK(P0, P1, t) do { if (MASK) { int jb_ = (t) - (NT - 4); if (jb_ >= 0) cmask(P0, P1, jb_, wid); } } while (0)
#define ENDW(tt) do { if ((tt) + 3 < NT) { WAIT_BAR(5); } else if ((tt) + 2 < NT) { WAIT_BAR(4); } else { WAIT_BAR(0); } } while (0)
    for (; t + 1 < NT; t += 2) {
        STEP(pB0, pB1, pA0, pA1, t, (t + 3 < NT), (t + 2 < NT), (t + 1 < NT));       ENDW(t);     ROT();
        STEP(pA0, pA1, pB0, pB1, t + 1, (t + 4 < NT), (t + 3 < NT), (t + 2 < NT));   ENDW(t + 1); ROT();
    }
    STEP(pB0, pB1, pA0, pA1, NT - 1, false, false, false);
    { float sacc = pB0[0] + pB0[1]; _Pragma("unroll") for (int r = 2; r < 16; ++r) sacc += pB0[r]; _Pragma("unroll") for (int r = 0; r < 16; ++r) sacc += pB1[r]; l_reg += sacc;
      pw0 = (u32x4){PKW(pB0, 0), PKW(pB0, 2), PKW(pB0, 4), PKW(pB0, 6)}; pw1 = (u32x4){PKW(pB0, 8), PKW(pB0, 10), PKW(pB0, 12), PKW(pB0, 14)}; pw2 = (u32x4){PKW(pB1, 0), PKW(pB1, 2), PKW(pB1, 4), PKW(pB1, 6)}; pw3 = (u32x4){PKW(pB1, 8), PKW(pB1, 10), PKW(pB1, 12), PKW(pB1, 14)};
      SBAR();
      const lds_cptr vp_ = vp0 + ((vs_rd + 16384) & 65535);
#pragma unroll
      for (int db = 0; db < 4; ++db) { VRD2(f0, db * 4 + 0); VRD2(f1, db * 4 + 1); VRD2(f2, db * 4 + 2); VRD2(f3, db * 4 + 3);
          o[db] = MF32(PAF(0), VFR2(f0), o[db]); o[db] = MF32(PAF(1), VFR2(f1), o[db]); o[db] = MF32(PAF(2), VFR2(f2), o[db]); o[db] = MF32(PAF(3), VFR2(f3), o[db]); } }
#undef PKW
#undef PAF
#undef PIN
#undef EX
#undef VOFF
#undef VRD2
#undef VFR2
#undef GAPA
#undef GAPB
#undef KRD
#undef MF32
#undef STEP
#undef ENDW
    { auto rr = __builtin_amdgcn_permlane32_swap(__float_as_uint(l_reg), __float_as_uint(l_reg), false, false); l_reg = __uint_as_float(rr[0]) + __uint_as_float(rr[1]); }
    if (hi == 0) wsf[32 + r32] = l_reg; asm volatile("s_waitcnt lgkmcnt(0)" ::: "memory");
    float rli[16];
#pragma unroll
    for (int r = 0; r < 16; ++r) rli[r] = __builtin_amdgcn_rcpf(wsf[32 + crow(r, hi)]);
    bf16* Ow = Oh + (long)(q0 + wid * QBLK) * op;
    { bf16* stg = (bf16*)(shm + L2_OST) + wid * 2048;
#pragma unroll
      for (int dh = 0; dh < 2; ++dh) {
#pragma unroll
        for (int r = 0; r < 16; ++r) { const int orow = crow(r, hi);
#pragma unroll
          for (int d0 = 0; d0 < 2; ++d0) stg[orow * 64 + d0 * 32 + r32] = __float2bfloat16(o[dh * 2 + d0][r] * rli[r]); }
        asm volatile("s_waitcnt lgkmcnt(0)" ::: "memory");
#pragma unroll
        for (int i = 0; i < 4; ++i) { const int row = i * 8 + (lane >> 3), ch = lane & 7; const u32x4 v = *(const u32x4*)(stg + row * 64 + ch * 8); *(u32x4*)(Ow + (long)row * op + dh * 64 + ch * 8) = v; }
        asm volatile("s_waitcnt lgkmcnt(0)" ::: "memory"); } }
    asm volatile("s_waitcnt lgkmcnt(0)\n\ts_barrier" ::: "memory");
#undef DMA_K
#undef DMA_V
#undef CMASK
#undef ROT
}
#undef SBAR
#undef WAIT_BAR
}

#define XB_TMO      128
#define XB_XCNT(j)  (256  + 64 * (j))
#define XB_XSUB(j)  (1280 + 64 * (j))
#define XB_XGEN(j)  (2304 + 64 * (j))
#define XB_TOP      3328
#define XB_TOPGEN   3392
#define XCD_BAR_WORDS 3456
#define XB_SPIN_CAP (1u << 22)
__device__ __forceinline__ unsigned xb_ld(unsigned* p)              { return __hip_atomic_load(p, __ATOMIC_RELAXED, __HIP_MEMORY_SCOPE_AGENT); }
__device__ __forceinline__ unsigned xb_add(unsigned* p, unsigned v) { return __hip_atomic_fetch_add(p, v, __ATOMIC_RELAXED, __HIP_MEMORY_SCOPE_AGENT); }
__device__ __forceinline__ unsigned xb_xcc_id() { return (unsigned)__builtin_amdgcn_s_getreg((3 << 11) | 20) & 0xFu; }
#define XB_SPIN(cond, bar) do { unsigned _sp = 0; while (cond) { __builtin_amdgcn_s_sleep(1); \
    if ((++_sp & 255u) == 0u) { if (xb_ld(&(bar)[XB_TMO])) break; if (_sp > XB_SPIN_CAP) { atomicAdd(&(bar)[XB_TMO], 1u); break; } } } } while (0)
struct XcdBarrier { unsigned* bar; unsigned x; volatile LAS unsigned* st; };
__device__ __forceinline__ XcdBarrier xcd_barrier_post(unsigned* bar, volatile LAS unsigned* st) {
    XcdBarrier b; b.bar = bar; b.x = xb_xcc_id(); b.st = st;
    if (threadIdx.x == 0) (void)xb_add(&bar[XB_XCNT(b.x)], 1u);
    return b;
}
__device__ __forceinline__ void xcd_barrier_complete(unsigned* bar, unsigned x, unsigned& nloc, unsigned& nx) {
    const unsigned G = gridDim.x * gridDim.y * gridDim.z;
    unsigned sum, cnt, mine, sp = 0u;
    for (;;) {
        sum = 0u; cnt = 0u; mine = 0u;
#pragma unroll
        for (unsigned j = 0; j < 16; ++j) { const unsigned c = xb_ld(&bar[XB_XCNT(j)]); sum += c; cnt += (c > 0u) ? 1u : 0u; mine = (j == x) ? c : mine; }
        if (sum == G) break;
        __builtin_amdgcn_s_sleep(1);
        if ((++sp & 255u) == 0u) { if (xb_ld(&bar[XB_TMO])) break; if (sp > XB_SPIN_CAP) { atomicAdd(&bar[XB_TMO], 1u); break; } }
    }
    nloc = mine > 0u ? mine : 1u; nx = cnt > 0u ? cnt : 1u;
}
__device__ __forceinline__ void xcd_barrier(const XcdBarrier& b) {
    asm volatile("s_waitcnt vmcnt(0)" ::: "memory");
    __syncthreads();
    if (threadIdx.x == 0) {
        unsigned* bar = b.bar;
        __builtin_amdgcn_s_waitcnt(0);
        unsigned nloc = b.st[0], nx = b.st[1];
        if (nloc == 0u) { xcd_barrier_complete(bar, b.x, nloc, nx); b.st[0] = nloc; b.st[1] = nx; }
        const unsigned old = xb_add(&bar[XB_XSUB(b.x)], 1u);
        const unsigned gen = old / nloc;
        if (old + 1u == (gen + 1u) * nloc) {
            __builtin_amdgcn_fence(__ATOMIC_RELEASE, "agent");
            asm volatile("s_waitcnt vmcnt(0)" ::: "memory");
            const unsigned og = xb_add(&bar[XB_TOP], 1u);
            const unsigned tg = og / nx;
            if (og + 1u == (tg + 1u) * nx) xb_add(&bar[XB_TOPGEN], 1u);
            else XB_SPIN(xb_ld(&bar[XB_TOPGEN]) == tg, bar);
            __builtin_amdgcn_fence(__ATOMIC_ACQUIRE, "agent");
            xb_add(&bar[XB_XGEN(b.x)], 1u);
            asm volatile("s_waitcnt vmcnt(0)" ::: "memory");
        } else {
            XB_SPIN(xb_ld(&bar[XB_XGEN(b.x)]) == gen, bar);
            __builtin_amdgcn_fence(__ATOMIC_ACQUIRE, "agent");
            asm volatile("s_waitcnt vmcnt(0)" ::: "memory");
        }
    }
    __syncthreads();
}

constexpr int RING_BYTES = 131072;
constexpr int MISC_OFF = RING_BYTES;
constexpr int LDS_BYTES = 147456;
constexpr int NWAVES = 8;

struct Args {
    const float* in[29]; float* out; unsigned char* ws; int ph_lo, ph_hi;
};
enum { I_X = 0, I_MEM, I_NORM1, I_WIN, I_BGATE, I_QN, I_KN, I_LQ1, I_LK1, I_LQ2, I_LK2, I_SUBLN, I_WPOOL, I_PSCALE, I_MEMNORM, I_WMKV, I_MQN, I_MKN, I_WBRD, I_WBRP, I_WBRM, I_WOUT, I_NORM2,
       I_WROUTER, I_BROUTER, I_WGU, I_BGU, I_WD, I_BD };

__device__ __forceinline__ unsigned f2bf(float f) { unsigned u = __builtin_bit_cast(unsigned, f); return (u + 0x7fffu + ((u >> 16) & 1u)) >> 16; }
__device__ __forceinline__ unsigned pk2(float lo, float hi) { return f2bf(lo) | (f2bf(hi) << 16); }
__device__ __forceinline__ void p0_transpose_item(const float* W, int K, int N, bf16_t* WT, LAS float* scr, int item, int lane, int ldo = 0) {
    if (ldo == 0) ldo = K;
    const int nblk = N / 64, kb = item / nblk, nb = item % nblk, k0 = 64 * kb, n0 = 64 * nb;
    const int kr = lane >> 3, n4 = (lane & 7) * 4;
    f32x4 v[16];
#pragma unroll
    for (int i = 0; i < 16; ++i) v[i] = *(const f32x4*)(W + (size_t)(k0 + 8 * (i & 7) + kr) * N + n0 + 32 * (i >> 3) + n4);
#pragma unroll
    for (int h = 0; h < 2; ++h) {
#pragma unroll
        for (int i = 0; i < 8; ++i)
#pragma unroll
            for (int j = 0; j < 4; ++j) scr[(n4 + j) * 68 + 8 * i + kr] = v[h * 8 + i][j];
        LDS_WAIT(); asm volatile("" ::: "memory");
        const int c = lane & 7;
#pragma unroll
        for (int jj = 0; jj < 4; ++jj) { const int nrow = 8 * jj + (lane >> 3); const LAS f32x4* sp = (const LAS f32x4*)(scr + nrow * 68 + 8 * c);
            const f32x4 a = sp[0], b = sp[1];
            u32x4 o; o.x = pk2(a[0], a[1]); o.y = pk2(a[2], a[3]); o.z = pk2(b[0], b[1]); o.w = pk2(b[2], b[3]);
            *(u32x4*)(WT + (size_t)(n0 + 32 * h + nrow) * ldo + k0 + 8 * c) = o; }
        LDS_WAIT(); asm volatile("" ::: "memory");
    }
}
__device__ __forceinline__ void p0_transpose_item_f8(const float* W, int K, int N, unsigned char* WT, LAS float* scr, int item, int lane) {
    const int nblk = N / 64, kb = item / nblk, nb = item % nblk, k0 = 64 * kb, n0 = 64 * nb;
    const int kr = lane >> 3, n4 = (lane & 7) * 4;
    f32x4 v[16];
#pragma unroll
    for (int i = 0; i < 16; ++i) v[i] = *(const f32x4*)(W + (size_t)(k0 + 8 * (i & 7) + kr) * N + n0 + 32 * (i >> 3) + n4);
#pragma unroll
    for (int h = 0; h < 2; ++h) {
#pragma unroll
        for (int i = 0; i < 8; ++i)
#pragma unroll
            for (int j = 0; j < 4; ++j) scr[(n4 + j) * 68 + 8 * i + kr] = v[h * 8 + i][j];
        LDS_WAIT(); asm volatile("" ::: "memory");
        const int c = lane & 7;
#pragma unroll
        for (int jj = 0; jj < 4; ++jj) { const int nrow = 8 * jj + (lane >> 3); const LAS f32x4* sp = (const LAS f32x4*)(scr + nrow * 68 + 8 * c);
            const f32x4 a = sp[0] * W8_SCALE, b = sp[1] * W8_SCALE;
            u32x2 o; o.x = pk4_fp8(a[0], a[1], a[2], a[3]); o.y = pk4_fp8(b[0], b[1], b[2], b[3]);
            *(u32x2*)(WT + (size_t)(n0 + 32 * h + nrow) * K + k0 + 8 * c) = o; }
        LDS_WAIT(); asm volatile("" ::: "memory");
    }
}
__device__ __forceinline__ void rms_row_to_bf16(const float* xrow, const float* gain, bf16_t* orow, int lane) {
    const f32x4* xr = (const f32x4*)xrow + lane; const f32x4* gr = (const f32x4*)gain + lane;
    f32x4 v[4]; float s = 0.f;
#pragma unroll
    for (int j = 0; j < 4; ++j) { v[j] = xr[64 * j]; s += (v[j].x * v[j].x + v[j].y * v[j].y) + (v[j].z * v[j].z + v[j].w * v[j].w); }
    const float rstd = 1.f / sqrtf(wave_sum(s) * (1.f / 1024.f) + RMS_EPS);
    u32x2* o8 = (u32x2*)orow + lane;
#pragma unroll
    for (int j = 0; j < 4; ++j) { const f32x4 g = gr[64 * j]; u32x2 w; w.x = pk2(v[j].x * rstd * g.x, v[j].y * rstd * g.y); w.y = pk2(v[j].z * rstd * g.z, v[j].w * rstd * g.w); o8[64 * j] = w; }
}

__device__ __forceinline__ void cvt_item64_f8(const float* W, int K, int N, unsigned char* WT, int item, int lane) {
    const int nblk = N / 64, kb = item / nblk, nb = item % nblk, k0 = 64 * kb, n0 = 64 * nb;
    const char* base = (const char*)(W + (size_t)k0 * N + n0);
    unsigned off = (unsigned)lane * 4u; const unsigned rstep = (unsigned)N * 4u;
    float v[64];
#pragma unroll
    for (int j = 0; j < 64; ++j) { v[j] = __builtin_nontemporal_load((const float*)(base + off)); off += rstep; }
    unsigned char* dst = WT + (size_t)(n0 + lane) * K + k0;
#pragma unroll
    for (int c = 0; c < 4; ++c) { u32x4 o;
#pragma unroll
        for (int q = 0; q < 4; ++q) { int r = __builtin_amdgcn_cvt_pk_fp8_f32(v[16 * c + 4 * q] * W8_SCALE, v[16 * c + 4 * q + 1] * W8_SCALE, 0, false);
            r = __builtin_amdgcn_cvt_pk_fp8_f32(v[16 * c + 4 * q + 2] * W8_SCALE, v[16 * c + 4 * q + 3] * W8_SCALE, r, true); o[q] = (unsigned)r; }
        *(u32x4*)(dst + 16 * c) = o; }
}
struct CvtJob {
    const float* wgu; const float* wd; unsigned char* wgu_t; unsigned char* wd_t; int ngw, gw, lane;
    __device__ __forceinline__ void item(int j) const {
        const int it = gw + j * ngw; if (it >= 24576) return;
        const bool gu = it < 16384; const int r = gu ? it : it - 16384, e = gu ? (r >> 9) : (r >> 8), idx = gu ? (r & 511) : (r & 255), N = gu ? 2048 : 1024;
        const float* W = gu ? wgu + (size_t)e * 1024 * 2048 : wd + (size_t)e * 1024 * 1024; unsigned char* WT = gu ? wgu_t + (size_t)e * 2048 * 1024 : wd_t + (size_t)e * 1024 * 1024;
        cvt_item64_f8(W, 1024, N, WT, idx, lane);
    }
};
struct PostCvt { CvtJob J; int jbase, jend; __device__ __forceinline__ void operator()(int ui) const { const int j = jbase + ui; if (j < jend) J.item(j); } };
struct Args;
typedef __attribute__((address_space(4))) const Args* kargs_t;
__device__ __forceinline__ kargs_t kargs() { kargs_t p = (kargs_t)__builtin_amdgcn_kernarg_segment_ptr(); asm volatile("" : "+s"(p)); return p; }
__global__ void __launch_bounds__(NWAVES * 64, 2) fwd_kernel(Args args) {
    extern __shared__ __attribute__((aligned(16))) unsigned char lds_raw[];
    cg::grid_group grid = cg::this_grid();
    LAS unsigned char* lds = (LAS unsigned char*)lds_raw;
    const int tid = threadIdx.x, lane = tid & 63, wave = __builtin_amdgcn_readfirstlane(tid >> 6);
    const int G = gridDim.x, bx = blockIdx.x; const int vcu = (G % 8 == 0) ? (bx % 8) * (G / 8) + bx / 8 : bx;
    const int gw = vcu * NWAVES + wave, NGW = G * NWAVES;
    const int lo = args.ph_lo, hi = args.ph_hi;
    if (tid < 64) ((LAS unsigned*)(lds + MISC_OFF + 1024))[tid] = 0u;
    __syncthreads();
    const XcdBarrier xbar = xcd_barrier_post((unsigned*)(args.ws + WS_CTL) + CW_BAR, (volatile LAS unsigned*)(lds + MISC_OFF + 1024));
#ifndef PHMASK
#define PHMASK 0x3ff
#endif
#define IN(k) (((PHMASK >> (k)) & 1) && lo <= (k) && (k) < hi)
#define GSYNC() do { asm volatile("s_waitcnt vmcnt(0) lgkmcnt(0)" ::: "memory"); __syncthreads(); grid.sync(); asm volatile("s_waitcnt vmcnt(0)" ::: "memory"); __syncthreads(); } while (0)
#define SEAM(k) do { if (lo <= (k) && (k) + 1 < hi) { xcd_barrier(xbar); } } while (0)
#define WSP(TY, off) ((TY*)(ka->ws + (off)))
#define WIN_T WSP(bf16_t, WS_WIN_T)
#define WBRD_T WSP(bf16_t, WS_WBRD_T)
#define WBRP_T WSP(bf16_t, WS_WBRP_T)
#define WBRM_T WSP(bf16_t, WS_WBRM_T)
#define WOUT_T WSP(bf16_t, WS_WOUT_T)
#define WMKV_T WSP(bf16_t, WS_WMKV_T)
#define WGU_T WSP(bf16_t, WS_WGU_T)
#define WD_T WSP(bf16_t, WS_WD_T)
#define XN WSP(bf16_t, WS_XN)
#define Qb WSP(bf16_t, WS_Q)
#define Kb WSP(bf16_t, WS_K)
#define Vb WSP(bf16_t, WS_V)
#define Ub WSP(bf16_t, WS_U)
#define MQb WSP(bf16_t, WS_MQ)
#define OC WSP(bf16_t, WS_OC)
#define GATES WSP(bf16_t, WS_GATES)
#define YCAT WSP(bf16_t, WS_YCAT)
#define MERGF WSP(float, WS_MERGF)
#define MERGB WSP(bf16_t, WS_MERGB)
#define XG WSP(bf16_t, WS_XG)
#define ACT WSP(bf16_t, WS_A)
#define Y4 WSP(bf16_t, WS_B)
#define MEMN WSP(bf16_t, WS_MEMN)
#define MKV WSP(bf16_t, WS_MKV)
#define ROPE WSP(f32x2, WS_ROPE)
#define WR2 WSP(float, WS_WR2)
#define ROUTEW WSP(float, WS_ROUTEW)
#define LAMP WSP(float, WS_LAM)
#define LIST WSP(u32x2, WS_LIST)
#define CNT WSP(unsigned, WS_CTL)
#define OUT (ka->out)
#define KA const kargs_t ka = kargs()

    if (lo > 1000) GSYNC();
    if (IN(0)) for (int rep_ = 0; rep_ < 1 + ((REPEAT_MASK >> 0) & 1); ++rep_) { KA; if (rep_) __syncthreads();
        LAS float* scr = (LAS float*)(lds + wave * 16384);
        constexpr int I0 = 16 * 80, I1 = 8 * 16, I2 = 4 * 16, I3 = 4 * 16, I4 = 16 * 16, I5 = 16 * 8, I6 = 0, I7 = 0;
        constexpr int NITEMS = I0 + I1 + I2 + I3 + I4 + I5 + I6 + I7;
        for (int it = gw; it < NITEMS; it += NGW) {
            int r = it;
            if (r < I0) { p0_transpose_item(ka->in[I_WIN], 1024, 5120, WIN_T, scr, r, lane); continue; } r -= I0;
            if (r < I1) { p0_transpose_item(ka->in[I_WBRD], 512, 1024, WBRD_T, scr, r, lane, 1024); continue; } r -= I1;
            if (r < I2) { p0_transpose_item(ka->in[I_WBRP], 256, 1024, WBRD_T + 512, scr, r, lane, 1024); continue; } r -= I2;
            if (r < I3) { p0_transpose_item(ka->in[I_WBRM], 256, 1024, WBRD_T + 768, scr, r, lane, 1024); continue; } r -= I3;
            if (r < I4) { p0_transpose_item(ka->in[I_WOUT], 1024, 1024, WOUT_T, scr, r, lane); continue; } r -= I4;
            p0_transpose_item(ka->in[I_WMKV], 1024, 512, WMKV_T, scr, r, lane);
        }
        for (int m = gw; m < T; m += NGW) rms_row_to_bf16(ka->in[I_X] + (size_t)m * 1024, ka->in[I_NORM1], XN + (size_t)m * 1024, lane);
        for (int m = gw; m < BATCH * MEMLEN; m += NGW) rms_row_to_bf16(ka->in[I_MEM] + (size_t)m * 1024, ka->in[I_MEMNORM], MEMN + (size_t)m * 1024, lane);
        for (int i = bx * 512 + tid; i < SEQ * 32; i += G * 512) { const int pos = i >> 5, j = i & 31;
            const float inv = 1.0f / powf(10000.0f, (float)(2 * j) / 64.0f); const float ang = (float)pos * inv;
            const double a = (double)ang; const double k = rint(a * 0.15915494309189535); const float red = (float)(a - k * 6.283185307179586);
            ROPE[i] = (f32x2){cosf(red), sinf(red)}; }
        for (int i = bx * 512 + tid; i < 1024 * 32; i += G * 512) { const int ii = i & 3, e = (i >> 2) & 15, kq = (i >> 6) & 3, eb = (i >> 8) & 1, s = i >> 9; const int k = 16 * s + 4 * kq + ii;
            WR2[i] = ka->in[I_NORM2][k] * ka->in[I_WROUTER][k * 32 + eb * 16 + e]; }
        if (bx == 0 && wave == 0) { const float s1 = wave_sum(ka->in[I_LQ1][lane] * ka->in[I_LK1][lane]), s2 = wave_sum(ka->in[I_LQ2][lane] * ka->in[I_LK2][lane]);
            if (lane == 0) LAMP[0] = expf(s1) - expf(s2) + 0.2f; }
    }
    SEAM(0);
    if (IN(1)) for (int rep_ = 0; rep_ < 1 + ((REPEAT_MASK >> 1) & 1); ++rep_) { KA; if (rep_) __syncthreads();
#if defined(TAP) && TAP == 6
        { pg8::DenseProb P{XN, WIN_T, 1024, 1024, 1024}; pg8::StaticOrder S; S.init(T, INW, G, bx);
          pg8::EpiPlain E{WSP(bf16_t, WS_B), 5120};
          pg8::gemm_phase<pg8::EpiPlain, pg8::DenseProb, pg8::StaticOrder, true>(lds, P, S, E); }
#else
        const CvtJob J{ka->in[I_WGU], ka->in[I_WD], (unsigned char*)WGU_T, (unsigned char*)WD_T, NGW, gw, lane};
        const int kpre = bx & 7;
        for (int j = 0; j < kpre; ++j) J.item(j);
        { pg8::DenseProb P{XN, WIN_T, 1024, 1024, 1024}; pg8::StaticOrder S0; S0.init(T, INW, G, bx); const pg8::TableOrder S = pg8::build_unit_table(S0, (LAS int*)(lds + MISC_OFF + 2048));
          pg8::EpiInProj E{Qb, Kb, Vb, Ub, MQb, GATES, ka->in[I_QN], ka->in[I_KN], ka->in[I_MQN], ka->in[I_BGATE], ROPE};
          const PostCvt PU{J, kpre, 12};
          pg8::gemm_phase<pg8::EpiInProj, pg8::DenseProb, pg8::TableOrder, ALIGN_EPI_SEL, PostCvt>(lds, P, S, E, PU); }
        for (int j = kpre + 10; j < 12; ++j) J.item(j);
#endif
        for (int tile = bx; tile < 256; tile += G) {
            const int rt = tile >> 3, ct = tile & 7, r32 = lane & 31, hh = lane >> 5;
            const bf16_t* ap = MEMN + (size_t)(32 * rt + r32) * 1024 + 128 * wave + 8 * hh; const bf16_t* bp = WMKV_T + (size_t)(64 * ct + r32) * 1024 + 128 * wave + 8 * hh;
            bf16x8 af[8], b0[8], b1[8];
#pragma unroll
            for (int ks = 0; ks < 8; ++ks) { af[ks] = *(const bf16x8*)(ap + 16 * ks); b0[ks] = *(const bf16x8*)(bp + 16 * ks); b1[ks] = *(const bf16x8*)(bp + 32 * 1024 + 16 * ks); }
            f32x16 c0 = f32x16{}, c1 = f32x16{};
#pragma unroll
            for (int ks = 0; ks < 8; ++ks) { c0 = __builtin_amdgcn_mfma_f32_32x32x16_bf16(af[ks], b0[ks], c0, 0, 0, 0); c1 = __builtin_amdgcn_mfma_f32_32x32x16_bf16(af[ks], b1[ks], c1, 0, 0, 0); }
            LAS float* part = (LAS float*)lds;
            __syncthreads();
#pragma unroll
            for (int r = 0; r < 16; ++r) { const int row = (r & 3) + 8 * (r >> 2) + 4 * hh; part[(wave * 32 + row) * 64 + r32] = c0[r]; part[(wave * 32 + row) * 64 + 32 + r32] = c1[r]; }
            __syncthreads();
            const int row = tid >> 4, c4 = (tid & 15) * 4; f32x4 a = {0.f, 0.f, 0.f, 0.f};
#pragma unroll
            for (int w = 0; w < 8; ++w) a += *(const LAS f32x4*)(part + (w * 32 + row) * 64 + c4);
            if (ct < 4) {
                float ss = (a[0] * a[0] + a[1] * a[1]) + (a[2] * a[2] + a[3] * a[3]);
                ss += __shfl_xor(ss, 1); ss += __shfl_xor(ss, 2); ss += __shfl_xor(ss, 4); ss += __shfl_xor(ss, 8);
                const float rstd = 1.0f / sqrtf(ss * (1.0f / 64.0f) + RMS_EPS); const f32x4 g = *(const f32x4*)(ka->in[I_MKN] + c4); a = a * rstd * g; }
            u32x2 o; o.x = cvt_pk_bf16(a[0], a[1]); o.y = cvt_pk_bf16(a[2], a[3]);
            *(u32x2*)(MKV + (size_t)(32 * rt + row) * 512 + 64 * ct + c4) = o;
        }
        __syncthreads();
    }
    SEAM(1);
    if (IN(2)) for (int rep_ = 0; rep_ < 1 + ((REPEAT_MASK >> 2) & 1); ++rep_) { KA; if (rep_) __syncthreads();
        using abf = attn_body::bf16;
        {
            const int bh = vcu >> 4, b = bh >> 2, h = bh & 3, s = vcu & 15; const size_t rb = (size_t)b * SEQ;
            const float lam = LAMP[0];
            for (int i2 = 0; i2 < 4 * (1 + ((REPEAT_MASK >> 10) & 1)); ++i2) { const int ii = i2 & 3, c = ii & 1; const int qb = (ii < 2) ? s : 31 - s;
                attn_body::attn_unit2<true>(qb * 256, 4 * qb + 4, (const abf*)Qb + rb * 512 + (c * 4 + h) * 64, 512, (const abf*)Kb + rb * 512 + (c * 4 + h) * 64, 512,
                                            (const abf*)Vb + rb * 512 + h * 128, 512, (abf*)OC + rb * 1024 + (c * 4 + h) * 128, 1024, (char*)lds_raw);
                if (c == 1) {
                    asm volatile("s_waitcnt vmcnt(0)" ::: "memory");
#pragma unroll
                    for (int ps = 0; ps < 2; ++ps) {
                    const int row = ps * 16 + (lane >> 2), dq = (lane & 3) * 32; const size_t t = rb + (size_t)qb * 256 + wave * 32 + row;
                    const bf16_t* p0 = OC + t * 1024 + h * 128 + dq; const bf16_t* p1 = p0 + 512;
                    u32x4 a[4], bb[4];
#pragma unroll
                    for (int j = 0; j < 4; ++j) { a[j] = *(const u32x4*)(p0 + 8 * j); bb[j] = *(const u32x4*)(p1 + 8 * j); }
                    float ss = 0.f; f32x4 y[4][2];
#pragma unroll
                    for (int j = 0; j < 4; ++j) {
                        y[j][0] = (f32x4){bf_lo(a[j].x) - lam * bf_lo(bb[j].x), bf_hi(a[j].x) - lam * bf_hi(bb[j].x), bf_lo(a[j].y) - lam * bf_lo(bb[j].y), bf_hi(a[j].y) - lam * bf_hi(bb[j].y)};
                        y[j][1] = (f32x4){bf_lo(a[j].z) - lam * bf_lo(bb[j].z), bf_hi(a[j].z) - lam * bf_hi(bb[j].z), bf_lo(a[j].w) - lam * bf_lo(bb[j].w), bf_hi(a[j].w) - lam * bf_hi(bb[j].w)};
#pragma unroll
                        for (int q = 0; q < 4; ++q) ss += y[j][0][q] * y[j][0][q] + y[j][1][q] * y[j][1][q]; }
                    ss += __shfl_xor(ss, 1); ss += __shfl_xor(ss, 2);
                    const float rstd = 0.8f / sqrtf(ss * (1.0f / 128.0f) + RMS_EPS);
                    const float* sg = ka->in[I_SUBLN] + dq; bf16_t* yo = YCAT + t * 1024 + h * 128 + dq;
#pragma unroll
                    for (int j = 0; j < 4; ++j) { const f32x4 s0 = *(const f32x4*)(sg + 8 * j), s1 = *(const f32x4*)(sg + 8 * j + 4); pg8::store8(yo + 8 * j, y[j][0] * rstd * s0, y[j][1] * rstd * s1); }
                    }
                }
            }
        }
        {
            for (int i = 0; i < 2; ++i) { const int idx = vcu * 2 + i; if (idx >= 512) break; const int b = idx >> 7, h = (idx >> 5) & 3, qb = idx & 31;
                attn_body::attn_unit<8, false>(qb * 256, 4, (const abf*)MQb + (size_t)b * SEQ * 256 + h * 64, 256, (const abf*)MKV + (size_t)b * MEMLEN * 512 + h * 64, 512,
                                               (const abf*)MKV + (size_t)b * MEMLEN * 512 + 256 + h * 64, 512, (abf*)YCAT + (size_t)b * SEQ * 1024 + 768 + h * 64, 1024, (char*)lds_raw); }
        }
        {
            LAS bf16_t* ul = (LAS bf16_t*)lds;
            LAS bf16_t* pb = (LAS bf16_t*)(lds + 24576);
            const int col = tid & 255, half = tid >> 8, w = 2 << (col >> 6);
            const int mg = wave & 3, mdh = wave >> 2, r32 = lane & 31, hh = lane >> 5;
            bf16x8 bw[4];
#pragma unroll
            for (int sx = 0; sx < 4; ++sx) { const float* wp = ka->in[I_WPOOL] + (size_t)(mg * 64 + 16 * sx + 8 * hh) * 64 + mdh * 32 + r32;
                u32x4 pk; pk.x = pk2(wp[0], wp[64]); pk.y = pk2(wp[128], wp[192]); pk.z = pk2(wp[256], wp[320]); pk.w = pk2(wp[384], wp[448]); bw[sx] = __builtin_bit_cast(bf16x8, pk); }
            const int ocol = mg * 64 + mdh * 32 + r32; const float psc = ka->in[I_PSCALE][ocol];
            u32x4 pre[3];
#define POOL_LOAD(tl) do { const int t0_ = (tl) * 32, p0_ = t0_ & (SEQ - 1); _Pragma("unroll") for (int k_ = 0; k_ < 3; ++k_) { const int pc = tid + 512 * k_, r = pc >> 5, ch = pc & 31; \
                pre[k_] = (u32x4){0u, 0u, 0u, 0u}; if (pc < 47 * 32 && p0_ - 15 + r >= 0) pre[k_] = *(const u32x4*)(Ub + (size_t)(t0_ - 15 + r) * 256 + ch * 8); } } while (0)
            if (vcu < T / 32) POOL_LOAD(vcu);
            for (int tile = vcu; tile < T / 32; tile += G) {
                const int t0 = tile * 32, p0 = t0 & (SEQ - 1);
                __syncthreads();
#pragma unroll
                for (int k = 0; k < 3; ++k) { const int pc = tid + 512 * k, r = pc >> 5, ch = pc & 31; if (pc < 47 * 32) *(LAS u32x4*)(ul + r * 256 + ch * 8) = pre[k]; }
                if (tile + G < T / 32) POOL_LOAD(tile + G);
                __syncthreads();
                {
                    float sum = 0.f; const int rbase = 15 + 16 * half;
                    for (int i = 1; i < w; ++i) sum += __uint_as_float((unsigned)ul[(rbase - i) * 256 + col] << 16);
#pragma unroll
                    for (int tk = 0; tk < 16; ++tk) { const float ucur = __uint_as_float((unsigned)ul[(rbase + tk) * 256 + col] << 16); sum += ucur;
                        const int pos = p0 + 16 * half + tk; const float cnt = (float)((pos + 1 < w) ? pos + 1 : w);
                        pb[(16 * half + tk) * 264 + col] = (bf16_t)f2bf(sum / cnt - ucur);
                        sum -= __uint_as_float((unsigned)ul[(rbase + tk - (w - 1)) * 256 + col] << 16); }
                }
                __syncthreads();
                f32x16 acc = f32x16{};
#pragma unroll
                for (int sx = 0; sx < 4; ++sx) { const bf16x8 af = *(const LAS bf16x8*)(pb + r32 * 264 + mg * 64 + 16 * sx + 8 * hh);
                    acc = __builtin_amdgcn_mfma_f32_32x32x16_bf16(af, bw[sx], acc, 0, 0, 0); }
#pragma unroll
                for (int r = 0; r < 16; ++r) { const int tok = t0 + (r & 3) + 8 * (r >> 2) + 4 * hh; YCAT[(size_t)tok * 1024 + 512 + ocol] = (bf16_t)f2bf(acc[r] * psc); }
            }
            __syncthreads();
        }
    }
    SEAM(2);
    if (IN(4)) for (int rep_ = 0; rep_ < 1 + ((REPEAT_MASK >> 4) & 1); ++rep_) { KA; if (rep_) __syncthreads();
        pg8::StaticOrder S0; S0.init(T, 1024, G, bx); const pg8::TableOrder S = pg8::build_unit_table(S0, (LAS int*)(lds + MISC_OFF + 2048));
        pg8::DenseProb P{YCAT, WBRD_T, 1024, 1024, 1024}; pg8::EpiMergeR E{GATES, MERGB};
        pg8::gemm_phase<pg8::EpiMergeR, pg8::DenseProb, pg8::TableOrder, ALIGN_EPI_SEL>(lds, P, S, E);
    }
    SEAM(4);
    if (IN(5)) for (int rep_ = 0; rep_ < 1 + ((REPEAT_MASK >> 5) & 1); ++rep_) { KA; if (rep_) __syncthreads();
        pg8::DenseProb P{MERGB, WOUT_T, 1024, 1024, 1024}; pg8::StaticOrder S0; S0.init(T, 1024, G, bx); const pg8::TableOrder S = pg8::build_unit_table(S0, (LAS int*)(lds + MISC_OFF + 2048));
        pg8::EpiWout E{ka->in[I_X], OUT, (unsigned char*)XG, ka->in[I_NORM2]};
        pg8::gemm_phase<pg8::EpiWout, pg8::DenseProb, pg8::TableOrder, ALIGN_EPI_SEL>(lds, P, S, E);
    }
    SEAM(5);
    if (IN(6)) { KA;
        LAS int* lcnt = (LAS int*)(lds + MISC_OFF); LAS int* lbase = lcnt + 32;
        const int ngroups = T / 16, rounds = (ngroups + NGW - 1) / NGW;
        for (int rd = 0; rd < rounds; ++rd) {
            const int grp = rd * NGW + gw; const bool valid = grp < ngroups;
            if (tid < 32) lcnt[tid] = 0;
            __syncthreads();
            int e_sel = 0, rank = 0; float w_sel = 0.f, rstd = 0.f; const int q = lane >> 4, tok = grp * 16 + (lane & 15);
            if (valid) {
                f32x4 d0 = {0.f, 0.f, 0.f, 0.f}, d1 = {0.f, 0.f, 0.f, 0.f}; float ss = 0.f;
                const float* xrow = OUT + (size_t)tok * 1024 + 4 * q; const f32x4* wr2 = (const f32x4*)WR2 + lane;
#pragma unroll 8
                for (int s = 0; s < 64; ++s) { const f32x4 xv = *(const f32x4*)(xrow + 16 * s); const f32x4 wa = wr2[(s * 2) * 64], wb = wr2[(s * 2 + 1) * 64];
                    ss += (xv[0] * xv[0] + xv[1] * xv[1]) + (xv[2] * xv[2] + xv[3] * xv[3]);
#pragma unroll
                    for (int j = 0; j < 4; ++j) { d0 = __builtin_amdgcn_mfma_f32_16x16x4f32(wa[j], xv[j], d0, 0, 0, 0); d1 = __builtin_amdgcn_mfma_f32_16x16x4f32(wb[j], xv[j], d1, 0, 0, 0); } }
                ss += __shfl_xor(ss, 16); ss += __shfl_xor(ss, 32);
                rstd = 1.0f / sqrtf(ss * (1.0f / 1024.f) + RMS_EPS);
                unsigned key[8];
#pragma unroll
                for (int r = 0; r < 8; ++r) { const int e = (r >> 2) * 16 + 4 * q + (r & 3); const float lg = ((r < 4) ? d0[r & 3] : d1[r & 3]) * rstd + ka->in[I_BROUTER][e];
                    unsigned u = __float_as_uint(lg); u ^= (u >> 31) ? 0xffffffffu : 0x80000000u; key[r] = (u & ~31u) | (unsigned)(31 - e); }
                unsigned win[4];
#pragma unroll
                for (int r = 0; r < 4; ++r) { unsigned m = key[0];
#pragma unroll
                    for (int j = 1; j < 8; ++j) m = m > key[j] ? m : key[j];
                    unsigned o = (unsigned)__shfl_xor((int)m, 16); m = m > o ? m : o; o = (unsigned)__shfl_xor((int)m, 32); m = m > o ? m : o; win[r] = m;
#pragma unroll
                    for (int j = 0; j < 8; ++j) key[j] = (key[j] == m) ? 0u : key[j]; }
                float val[4];
#pragma unroll
                for (int r = 0; r < 4; ++r) { unsigned u = win[r] & ~31u; u ^= (u >> 31) ? 0x80000000u : 0xffffffffu; val[r] = __uint_as_float(u); }
                const float p1 = expf(val[1] - val[0]), p2 = expf(val[2] - val[0]), p3 = expf(val[3] - val[0]); const float inv = 1.0f / (1.0f + p1 + p2 + p3);
                const unsigned wk = (q == 0) ? win[0] : (q == 1) ? win[1] : (q == 2) ? win[2] : win[3];
                w_sel = ((q == 0) ? 1.0f : (q == 1) ? p1 : (q == 2) ? p2 : p3) * inv; e_sel = 31 - (int)(wk & 31u);
                rank = __hip_atomic_fetch_add((int*)(lcnt + e_sel), 1, __ATOMIC_RELAXED, __HIP_MEMORY_SCOPE_WORKGROUP);
            }
            __syncthreads();
            if (tid < 32) lbase[tid] = (int)__hip_atomic_fetch_add(CNT + 64 * tid, (unsigned)lcnt[tid], __ATOMIC_RELAXED, __HIP_MEMORY_SCOPE_AGENT);
            __syncthreads();
            if (valid) { const int pos = lbase[e_sel] + rank; LIST[(size_t)e_sel * CAP + pos] = (u32x2){(unsigned)(tok * 4 + q), __float_as_uint(rstd)}; ROUTEW[tok * 4 + q] = w_sel; }
            __syncthreads();
        }
    }
    SEAM(6);
    if (IN(7) || IN(8)) { KA;
        LAS int* tp = (LAS int*)(lds + MISC_OFF + 256); LAS int* cn = tp + 40;
        if (tid < 64) {
            const int e = tid & 31; const int c = (int)__hip_atomic_load(CNT + 64 * e, __ATOMIC_RELAXED, __HIP_MEMORY_SCOPE_AGENT); const int tiles = (c + 255) >> 8; int x = tiles;
#pragma unroll
            for (int o = 1; o < 32; o <<= 1) { const int y = __shfl_up(x, o, 32); if (e >= o) x += y; }
            if (tid < 32) { cn[e] = c; tp[e] = x - tiles; if (e == 31) tp[NEXP] = x; } }
        __syncthreads();
        if (IN(7)) for (int rep_ = 0; rep_ < 1 + ((REPEAT_MASK >> 7) & 1); ++rep_) {
            pg8::GuProb P{(const unsigned char*)XG, (const unsigned char*)WGU_T, LIST, 1024, 1024, 1024}; pg8::GroupedOrder S0{tp, cn, 8, G, bx}; const pg8::TableOrder S = pg8::build_unit_table(S0, (LAS int*)(lds + MISC_OFF + 2048));
            pg8::EpiSwiglu E{(unsigned char*)ACT, LIST, ka->in[I_BGU], lds + MISC_OFF + 4096};
            pg8::gemm_phase<pg8::EpiSwiglu, pg8::GuProb, pg8::TableOrder, ALIGN_EPI_SEL>(lds, P, S, E);
        }
        SEAM(7);
        if (IN(8)) for (int rep_ = 0; rep_ < 1 + ((REPEAT_MASK >> 8) & 1); ++rep_) {
            pg8::DownProb P{(const unsigned char*)ACT, (const unsigned char*)WD_T, 1024, 1024, 1024}; pg8::GroupedOrder S0{tp, cn, 4, G, bx}; const pg8::TableOrder S = pg8::build_unit_table(S0, (LAS int*)(lds + MISC_OFF + 2048));
            pg8::EpiDown E{(unsigned char*)Y4, LIST, ka->in[I_BD], lds + MISC_OFF + 4096};
            pg8::gemm_phase<pg8::EpiDown, pg8::DownProb, pg8::TableOrder, ALIGN_EPI_SEL>(lds, P, S, E);
        }
    }
    SEAM(8);
    if (IN(9)) { KA;
        for (int i = bx * 512 + tid; i < T * 128; i += G * 512) { const int tok = i >> 7, c8 = (i & 127) * 8;
            const f32x4 w = *(const f32x4*)(ROUTEW + tok * 4); float* op = OUT + (size_t)tok * 1024 + c8;
            f32x4 o0 = *(const f32x4*)op, o1 = *(const f32x4*)(op + 4);
#pragma unroll
            for (int k = 0; k < 4; ++k) { const u32x2 y = *(const u32x2*)((const unsigned char*)Y4 + ((size_t)tok * 4 + k) * 1024 + c8); const float wk = w[k] * (1.0f / Y8_SCALE);
                const f32x2 p0 = __builtin_amdgcn_cvt_pk_f32_fp8((int)y.x, false), p1 = __builtin_amdgcn_cvt_pk_f32_fp8((int)y.x, true), p2 = __builtin_amdgcn_cvt_pk_f32_fp8((int)y.y, false), p3 = __builtin_amdgcn_cvt_pk_f32_fp8((int)y.y, true);
                o0[0] += wk * p0[0]; o0[1] += wk * p0[1]; o0[2] += wk * p1[0]; o0[3] += wk * p1[1];
                o1[0] += wk * p2[0]; o1[1] += wk * p2[1]; o1[2] += wk * p3[0]; o1[3] += wk * p3[1]; }
            *(f32x4*)op = o0; *(f32x4*)(op + 4) = o1; }
    }
#ifdef TAP
    if (lo <= 10 && 10 < hi) { KA; GSYNC();
        for (int i = bx * 512 + tid; i < T * 1024; i += G * 512) { const int t = i >> 10, c = i & 1023; float v = 0.f;
#define BFV(buf, pitch, col) __uint_as_float((unsigned)(buf)[(size_t)t * (pitch) + (col)] << 16)
            if (TAP == 1) v = BFV(Qb, 512, c & 511) + 2.f * BFV(Kb, 512, c & 511) + 4.f * BFV(Vb, 512, c & 511) + 8.f * BFV(Ub, 256, c & 255) + 16.f * BFV(MQb, 256, c & 255)
                            + 32.f * BFV(GATES, 3072, c) + 64.f * BFV(GATES, 3072, 1024 + c) + 128.f * BFV(GATES, 3072, 2048 + c);
            if (TAP == 2) v = BFV(OC, 1024, c) + 2.f * BFV(YCAT, 1024, c);
            if (TAP == 3) v = BFV(MERGB, 1024, c);
            if (TAP == 4) v = BFV(XN, 1024, c);
            if (TAP == 6) { const bf16_t* z = WSP(bf16_t, WS_B) + (size_t)t * 5120 + c; v = __uint_as_float((unsigned)z[0] << 16) + 2.f * __uint_as_float((unsigned)z[1024] << 16) + 4.f * __uint_as_float((unsigned)z[2048] << 16) + 8.f * __uint_as_float((unsigned)z[3072] << 16) + 16.f * __uint_as_float((unsigned)z[4096] << 16); }
            if (TAP == 5) { const bf16_t* wt = WIN_T; const int tt = t % 5120; v = __uint_as_float((unsigned)wt[(size_t)tt * 1024 + c] << 16) + ROPE[(t & 8191) * 32 + (c & 31)].x + 2.f * ROPE[(t & 8191) * 32 + (c & 31)].y; }
            OUT[i] = v; }
    }
#endif
#undef IN
#undef SEAM
}

extern "C" void kernel_launch(void* const* d_in, const int* in_sizes, int n_in, void* d_out, int out_size, void* d_ws, size_t ws_size, hipStream_t stream) {
    static int grid = 0;
    if (grid == 0) {
        if (n_in != 29 || in_sizes[0] != T * DMODEL || out_size != T * DMODEL || ws_size < WS_END) {
            fprintf(stderr, "kernel_launch: unexpected shapes: n_in %d in0 %d out %d ws %zu (need %zu)\n", n_in, n_in > 0 ? in_sizes[0] : -1, out_size, ws_size, (size_t)WS_END); grid = -1; return; }
        int dev = 0, cus = 0, per_cu = 0;
        (void)hipGetDevice(&dev); (void)hipDeviceGetAttribute(&cus, hipDeviceAttributeMultiprocessorCount, dev);
        (void)hipFuncSetAttribute((const void*)fwd_kernel, hipFuncAttributeMaxDynamicSharedMemorySize, LDS_BYTES);
        (void)hipOccupancyMaxActiveBlocksPerMultiprocessor(&per_cu, (const void*)fwd_kernel, NWAVES * 64, LDS_BYTES);
        (void)hipGetLastError();
        grid = cus;
        fprintf(stderr, "kernel_launch: cus %d occupancy %d/CU grid %d\n", cus, per_cu, grid);
        if (per_cu < 1) fprintf(stderr, "kernel_launch: occupancy query says the kernel does not fit\n");
    }
    if (grid < 0) return;
    (void)hipMemsetAsync((char*)d_ws + WS_CTL, 0, CTL_ZERO_BYTES, stream);
    Args a{};
    for (int i = 0; i < 29; ++i) a.in[i] = (const float*)d_in[i];
    a.out = (float*)d_out; a.ws = (unsigned char*)d_ws; a.ph_lo = 0; a.ph_hi = PH_HI;
    void* args[] = {&a};
    hipError_t e = hipLaunchCooperativeKernel((const void*)fwd_kernel, dim3(grid), dim3(NWAVES * 64), args, LDS_BYTES, stream);
    if (e != hipSuccess) fprintf(stderr, "cooperative launch failed: %s (grid %d)\n", hipGetErrorString(e), grid);
}
```

```cpp
#include <hip/hip_runtime.h>
#include <hip/hip_cooperative_groups.h>
#include <hip/hip_bf16.h>
#include <cstdio>
#include <cstdint>
#include <cmath>
namespace cg = cooperative_groups;

#define LAS __attribute__((address_space(3)))
#define GAS __attribute__((address_space(1)))
typedef unsigned short bf16_t;
typedef short bf16x8 __attribute__((ext_vector_type(8)));
typedef float f32x4 __attribute__((ext_vector_type(4)));
typedef float f32x2 __attribute__((ext_vector_type(2)));
typedef float f32x16 __attribute__((ext_vector_type(16)));
typedef unsigned u32x4 __attribute__((ext_vector_type(4)));
typedef unsigned u32x2 __attribute__((ext_vector_type(2)));

#define PH_HI 10
#define ALIGN_EPI_SEL true
#define F8MODE 2
#define USE_SETPRIO 1
#define ATTN_PRIO_A 1
#define ATTN_PRIO_B 1
#ifndef PHMASK
#define PHMASK 0x3ff
#endif
#define REPEAT_MASK 0x000
constexpr int BATCH = 4, SEQ = 8192, DMODEL = 1024, T = BATCH * SEQ, INW = 5120, NEXP = 32, MEMLEN = 256;
constexpr float RMS_EPS = 1e-6f;
constexpr float C2 = 0.125f * 1.4426950408889634f;
constexpr int CAP = T;

constexpr size_t MiB = 1u << 20;
constexpr size_t WS_CTL = 0, CTL_ZERO_BYTES = 32768;
constexpr int CW_BAR = 4096;
constexpr size_t WS_ROUTEW = 1 * MiB;
constexpr size_t WS_LAM = 1 * MiB + 768 * 1024;
constexpr size_t WS_ROPE = 2 * MiB;
constexpr size_t WS_WR2 = 4 * MiB;
constexpr size_t WS_MEMN = 5 * MiB;
constexpr size_t WS_MKV = 7 * MiB;
constexpr size_t WS_WIN_T = 8 * MiB;
constexpr size_t WS_WBRD_T = 18 * MiB;
constexpr size_t WS_WBRP_T = 19 * MiB;
constexpr size_t WS_WBRM_T = 19 * MiB + 512 * 1024;
constexpr size_t WS_WOUT_T = 20 * MiB;
constexpr size_t WS_WMKV_T = 22 * MiB;
constexpr size_t WS_WGU_T = 24 * MiB;
constexpr size_t WS_WD_T = 152 * MiB;
constexpr size_t WS_A = 216 * MiB;
constexpr size_t WS_XN = WS_A;
constexpr size_t WS_Q = WS_A + 64 * MiB, WS_K = WS_A + 96 * MiB, WS_V = WS_A + 128 * MiB;
constexpr size_t WS_U = WS_A + 160 * MiB, WS_MQ = WS_A + 176 * MiB;
constexpr size_t WS_OC = WS_A + 192 * MiB;
constexpr size_t WS_B = 488 * MiB;
constexpr size_t WS_GATES = WS_B;
constexpr size_t WS_YCAT = WS_B + 192 * MiB;
constexpr size_t WS_MERGF = 760 * MiB;
constexpr size_t WS_MERGB = 888 * MiB;
constexpr size_t WS_XG = 952 * MiB;
constexpr size_t WS_LIST = 1016 * MiB;
constexpr size_t WS_END = 1024 * MiB;

typedef __bf16 bf16x2_v __attribute__((ext_vector_type(2)));
__device__ __forceinline__ unsigned cvt_pk_bf16(float lo, float hi) { f32x2 v = {lo, hi}; bf16x2_v b = __builtin_convertvector(v, bf16x2_v); return __builtin_bit_cast(unsigned, b); }
__device__ __forceinline__ unsigned pk4_fp8(float a, float b, float c, float d) {
    a = fminf(fmaxf(a, -448.f), 448.f); b = fminf(fmaxf(b, -448.f), 448.f); c = fminf(fmaxf(c, -448.f), 448.f); d = fminf(fmaxf(d, -448.f), 448.f);
    int r = __builtin_amdgcn_cvt_pk_fp8_f32(a, b, 0, false); r = __builtin_amdgcn_cvt_pk_fp8_f32(c, d, r, true); return (unsigned)r; }
__device__ __forceinline__ unsigned pk4_i8(float a, float b, float c, float d) {
    const int q0 = (int)fminf(fmaxf(rintf(a), -127.f), 127.f), q1 = (int)fminf(fmaxf(rintf(b), -127.f), 127.f), q2 = (int)fminf(fmaxf(rintf(c), -127.f), 127.f), q3 = (int)fminf(fmaxf(rintf(d), -127.f), 127.f);
    return ((unsigned)q0 & 0xffu) | (((unsigned)q1 & 0xffu) << 8) | (((unsigned)q2 & 0xffu) << 16) | ((unsigned)q3 << 24); }
constexpr float WQ_IN = 127.0f * 32.0f / 4.0f;
constexpr float W8_SCALE = 64.0f;
constexpr float Y8_SCALE = 32.0f;
constexpr float A8_SCALE = 8.0f;
__device__ __forceinline__ float bf_lo(unsigned w) { return __uint_as_float(w << 16); }
__device__ __forceinline__ float bf_hi(unsigned w) { return __uint_as_float(w & 0xffff0000u); }
__device__ __forceinline__ float wave_sum(float v) {
#pragma unroll
    for (int o = 1; o < 64; o <<= 1) v += __shfl_xor(v, o);
    return v;
}
#define LDS_WAIT() asm volatile("s_waitcnt lgkmcnt(0)" ::: "memory")

namespace pg8 {
constexpr int BM = 256, BK = 64, HALF = 128, HTB = HALF * BK * 2, STAGE_BYTES = 8 * HTB, NXCD = 8, WGM = 8;
__host__ __device__ __forceinline__ int lds_byte(int r, int c) { const int st = (r >> 4) * 2 + (c >> 5), rr = r & 15, cc = c & 31, ob = rr * 64 + cc * 2; return st * 1024 + (ob ^ (((ob >> 9) & 1) << 5)); }
__host__ __device__ __forceinline__ void stage_rc(int b, int& R, int& C) { const int st = b / 1024, sb = b % 1024, swz = sb ^ (((sb >> 9) & 1) << 5); R = (st >> 1) * 16 + swz / 64; C = (st & 1) * 32 + (swz % 64) / 2; }
__host__ __device__ __forceinline__ int perm32(int rho) { const int n = rho >> 4, i = rho & 15; return 8 * (i >> 2) + 4 * n + (i & 3); }

typedef int i32x4_t __attribute__((ext_vector_type(4)));
typedef int i32x8_t __attribute__((ext_vector_type(8)));
typedef long i64x2_t __attribute__((ext_vector_type(2)));
struct Unit { int pm, pn, e, mt, cnt; };

template <int BMAP> __device__ __forceinline__ int brow(int R) { return BMAP == 0 ? ((R >> 5) * 64 + perm32(R & 31)) : BMAP == 1 ? ((R & ~31) + perm32(R & 31)) : ((R >> 5) * 64 + 16 * ((R & 15) >> 2) + 4 * ((R >> 4) & 1) + (R & 3)); }

struct StaticOrder {
    int nM, nN, nwg, G, c;
    __device__ void init(int M, int N, int G_, int c_) { nM = M / BM; nN = N / BM; nwg = nM * nN; G = G_; c = c_; }
    __device__ bool next(int i, Unit& u) const {
        const long L = (long)i * G + c; if (L >= nwg) return false;
        int wgid = (int)L; { const int q = nwg / NXCD, r = nwg % NXCD, xcd = wgid % NXCD, off = wgid / NXCD; wgid = (xcd < r ? xcd * (q + 1) : r * (q + 1) + (xcd - r) * q) + off; }
        const int nig = WGM * nN, gid = wgid / nig, fm = gid * WGM, gsz = (nM - fm) < WGM ? (nM - fm) : WGM;
        u.pm = fm + ((wgid % nig) % gsz); u.pn = (wgid % nig) / gsz; u.e = 0; u.mt = 0; u.cnt = 0; return true;
    }
    __device__ bool next_lane(int i, Unit& u) const { return next(i, u); }
};
struct GroupedOrder {
    const LAS int* tp; const LAS int* cn; int NTN, G, c;
    __device__ bool next_lane(int i, Unit& u) const {
        const int nwg = tp[NEXP] * NTN; const long L = (long)i * G + c; if (L >= nwg) return false;
        int wgid = (int)L; { const int q = nwg / NXCD, r = nwg % NXCD, xcd = wgid % NXCD, off = wgid / NXCD; wgid = (xcd < r ? xcd * (q + 1) : r * (q + 1) + (xcd - r) * q) + off; }
        int e = 0; while (e < NEXP - 1 && wgid >= tp[e + 1] * NTN) ++e;
        const int idx = wgid - tp[e] * NTN, tiles = tp[e + 1] - tp[e];
        const int nig = 4 * NTN, gid = idx / nig, fm = gid * 4, gsz = (tiles - fm) < 4 ? (tiles - fm) : 4;
        u.mt = fm + ((idx % nig) % gsz); u.pn = (idx % nig) / gsz; u.e = e; u.pm = tp[e] + u.mt; u.cnt = cn[e]; return true;
    }
};
struct TableOrder {
    const LAS int* tab; int n;
    __device__ __forceinline__ bool next(int i, Unit& u) const {
        if (i >= n) return false;
        const LAS int* t = tab + i * 8;
        u.pm = __builtin_amdgcn_readfirstlane(t[0]); u.pn = __builtin_amdgcn_readfirstlane(t[1]); u.e = __builtin_amdgcn_readfirstlane(t[2]);
        u.mt = __builtin_amdgcn_readfirstlane(t[3]); u.cnt = __builtin_amdgcn_readfirstlane(t[4]); return true;
    }
};
template <class Sched> __device__ __forceinline__ TableOrder build_unit_table(const Sched& S, LAS int* tab) {
    __syncthreads();
    if (threadIdx.x < 32) { Unit u; const bool ok = S.next_lane((int)threadIdx.x, u);
        if (ok) { LAS int* t = tab + threadIdx.x * 8; t[0] = u.pm; t[1] = u.pn; t[2] = u.e; t[3] = u.mt; t[4] = u.cnt; }
        const unsigned long long m = __ballot(ok); if (threadIdx.x == 0) tab[256] = __popcll(m); }
    __syncthreads();
    TableOrder T; T.tab = tab; T.n = __builtin_amdgcn_readfirstlane(tab[256]); return T;
}
struct DenseProb {
    static constexpr bool GATHER = false; static constexpr int BMAP = 0; static constexpr bool F8 = false; static constexpr bool I8 = false;
    const bf16_t* A; const bf16_t* Bt; int lda, ldb, K;
    __device__ __forceinline__ const char* a_base(const Unit& u) const { return (const char*)(A + (size_t)u.pm * BM * lda); }
    __device__ __forceinline__ const char* b_base(const Unit& u) const { return (const char*)(Bt + (size_t)u.pn * BM * ldb); }
    __device__ __forceinline__ size_t bhstep() const { return (size_t)32 * ldb * 2; }
    __device__ __forceinline__ unsigned a_off(const Unit&, int, int) const { return 0u; }
    __device__ __forceinline__ unsigned a_raw(const Unit&, int) const { return 0u; }
};
struct DenseProbI8 {
    static constexpr bool GATHER = false; static constexpr int BMAP = 0; static constexpr bool F8 = true; static constexpr bool I8 = true;
    const unsigned char* A; const unsigned char* Bt; int lda, ldb, K;
    __device__ __forceinline__ const char* a_base(const Unit& u) const { return (const char*)(A + (size_t)u.pm * BM * lda); }
    __device__ __forceinline__ const char* b_base(const Unit& u) const { return (const char*)(Bt + (size_t)u.pn * BM * ldb); }
    __device__ __forceinline__ size_t bhstep() const { return (size_t)32 * ldb; }
    __device__ __forceinline__ unsigned a_off(const Unit&, int, int) const { return 0u; }
    __device__ __forceinline__ unsigned a_raw(const Unit&, int) const { return 0u; }
};
struct GuProb {
    static constexpr bool GATHER = true; static constexpr int BMAP = 1; static constexpr bool F8 = true; static constexpr bool I8 = false;
    const unsigned char* XG; const unsigned char* Wt; const u32x2* list; int lda, ldb, K;
    __device__ __forceinline__ const char* a_base(const Unit&) const { return (const char*)XG; }
    __device__ __forceinline__ const char* b_base(const Unit& u) const { return (const char*)(Wt + ((size_t)u.e * 2048 + 128 * u.pn) * 1024); }
    __device__ __forceinline__ size_t bhstep() const { return (size_t)1024 * 1024; }
    __device__ __forceinline__ unsigned a_raw(const Unit& u, int r) const { const int rr = u.mt * BM + r, rc = rr < u.cnt ? rr : u.cnt - 1; return list[(size_t)u.e * CAP + rc].x; }
    __device__ __forceinline__ unsigned a_off(const Unit& u, int r, int C) const {
        const int rr = u.mt * BM + r, rc = rr < u.cnt ? rr : u.cnt - 1;
        const unsigned tok = list[(size_t)u.e * CAP + rc].x >> 2;
        return tok * 1024u + (unsigned)C * 2u;
    }
};
struct DownProb {
    static constexpr bool GATHER = false; static constexpr int BMAP = 2; static constexpr bool F8 = true; static constexpr bool I8 = false;
    const unsigned char* A; const unsigned char* Wt; int lda, ldb, K;
    __device__ __forceinline__ const char* a_base(const Unit& u) const { return (const char*)(A + (size_t)u.pm * BM * lda); }
    __device__ __forceinline__ const char* b_base(const Unit& u) const { return (const char*)(Wt + ((size_t)u.e * 1024 + 256 * u.pn) * 1024); }
    __device__ __forceinline__ size_t bhstep() const { return (size_t)8 * ldb; }
    __device__ __forceinline__ unsigned a_off(const Unit&, int, int) const { return 0u; }
    __device__ __forceinline__ unsigned a_raw(const Unit&, int) const { return 0u; }
};

template <class Prob> __device__ __forceinline__ void calc_aoff(const Prob& P, const Unit& u, const int (&Rr)[2], const int (&Cc)[2], unsigned (&o)[2][2]) {
#pragma unroll
    for (int h = 0; h < 2; ++h)
#pragma unroll
        for (int i = 0; i < 2; ++i) {
            if constexpr (Prob::GATHER) o[h][i] = P.a_off(u, h * HALF + Rr[i], Cc[i]);
            else o[h][i] = Prob::F8 ? (unsigned)((h * HALF + Rr[i]) * P.lda + Cc[i] * 2) : (unsigned)((h * HALF + Rr[i]) * P.lda + Cc[i]) * 2u;
        }
}

struct NoPost { __device__ __forceinline__ void operator()(int) const {} };
template <class Epi, class Prob, class Sched, bool ALIGN_EPI, class Post = NoPost>
__device__ __forceinline__ void gemm_phase(LAS unsigned char* lds, const Prob& P, const Sched& S, const Epi& E, const Post& PU = Post()) {
    const int tid = threadIdx.x, wid = __builtin_amdgcn_readfirstlane(tid >> 6), lane = tid & 63, wr = wid >> 2, wc = wid & 3, fr = lane & 15, fq = lane >> 4;
    const int K = P.K, nt = Prob::F8 ? K / 128 : K / BK;
    int Rr[2], Cc[2]; unsigned voffB[2];
#pragma unroll
    for (int i = 0; i < 2; ++i) { stage_rc(tid * 16 + i * 8192, Rr[i], Cc[i]); voffB[i] = Prob::F8 ? (unsigned)(brow<Prob::BMAP>(Rr[i]) * P.ldb + Cc[i] * 2) : (unsigned)(brow<Prob::BMAP>(Rr[i]) * P.ldb + Cc[i]) * 2u; }
    const size_t kstep = (size_t)(BK * 2);
    const size_t bhstep = P.bhstep();
    const unsigned ldsw = (unsigned)wid * 1024u;
    const int aoff = lds_byte(wr * 64 + fr, fq * 8), boff = lds_byte(wc * 32 + fr, fq * 8);
#define PG8_SA(b, h) (((b) * 2 + (h)) * HTB)
#define PG8_SB(b, h) ((4 + (b) * 2 + (h)) * HTB)
#define PG8_STG(bufoff, gptr, v0, v1) do { \
        __builtin_amdgcn_global_load_lds((const unsigned*)((const char*)(gptr) + (v0)), (LAS unsigned*)(lds + (bufoff) + ldsw), 16, 0, 0); \
        __builtin_amdgcn_global_load_lds((const unsigned*)((const char*)(gptr) + (v1)), (LAS unsigned*)(lds + (bufoff) + ldsw + 8192), 16, 0, 0); } while (0)
#define PG8_STGB(bufoff, gptr) PG8_STG(bufoff, gptr, voffB[0], voffB[1])
#define PG8_LDA(dst, b, h) do { _Pragma("unroll") for (int m = 0; m < 4; ++m) _Pragma("unroll") for (int k = 0; k < 2; ++k) dst[m][k] = *(const LAS bf16x8*)(lds + PG8_SA(b, h) + aoff + m * 2048 + k * 1024); } while (0)
#define PG8_LDB(dst, b, h) do { _Pragma("unroll") for (int n = 0; n < 2; ++n) _Pragma("unroll") for (int k = 0; k < 2; ++k) dst[n][k] = *(const LAS bf16x8*)(lds + PG8_SB(b, h) + boff + n * 2048 + k * 1024); } while (0)
#define PG8_MMAB(ai, bj, At, Bt) do { _Pragma("unroll") for (int m = 0; m < 4; ++m) _Pragma("unroll") for (int n = 0; n < 2; ++n) _Pragma("unroll") for (int k = 0; k < 2; ++k) \
        acc[ai][bj][m][n] = __builtin_amdgcn_mfma_f32_16x16x32_bf16(Bt[n][k], At[m][k], acc[ai][bj][m][n], 0, 0, 0); } while (0)
#define PG8_MMAQ(ai, bj, At, Bt) do { _Pragma("unroll") for (int m = 0; m < 4; ++m) _Pragma("unroll") for (int n = 0; n < 2; ++n) _Pragma("unroll") for (int k = 0; k < 2; ++k) { \
        const i64x2_t bq = __builtin_bit_cast(i64x2_t, Bt[n][k]), aq = __builtin_bit_cast(i64x2_t, At[m][k]); \
        acc[ai][bj][m][n] = __builtin_amdgcn_mfma_f32_16x16x32_fp8_fp8(bq[0], aq[0], acc[ai][bj][m][n], 0, 0, 0); \
        acc[ai][bj][m][n] = __builtin_amdgcn_mfma_f32_16x16x32_fp8_fp8(bq[1], aq[1], acc[ai][bj][m][n], 0, 0, 0); } } while (0)
#define PG8_MMA8(ai, bj, A8, B8) do { _Pragma("unroll") for (int m = 0; m < 4; ++m) _Pragma("unroll") for (int n = 0; n < 2; ++n) \
        asm volatile("v_mfma_f32_16x16x128_f8f6f4 %0, %1, %2, %0" : "+v"(acc[ai][bj][m][n]) : "v"(B8[n]), "v"(A8[m])); } while (0)
#define PG8_MMAI(ai, bj, At, Bt) do { _Pragma("unroll") for (int k = 0; k < 2; ++k) _Pragma("unroll") for (int m = 0; m < 4; ++m) _Pragma("unroll") for (int n = 0; n < 2; ++n) \
        asm volatile("v_mfma_i32_16x16x64_i8 %0, %1, %2, %0" : "+v"(acc[ai][bj][m][n]) : "v"(Bt[n][k]), "v"(At[m][k])); } while (0)
#define PG8_LDA8(dst, b, h) do { _Pragma("unroll") for (int m = 0; m < 4; ++m) { dst[m].lo = *(const LAS i32x4_t*)(lds + PG8_SA(b, h) + aoff + m * 2048); dst[m].hi = *(const LAS i32x4_t*)(lds + PG8_SA(b, h) + aoff + m * 2048 + 1024); } } while (0)
#define PG8_LDB8(dst, b, h) do { _Pragma("unroll") for (int n = 0; n < 2; ++n) { dst[n].lo = *(const LAS i32x4_t*)(lds + PG8_SB(b, h) + boff + n * 2048); dst[n].hi = *(const LAS i32x4_t*)(lds + PG8_SB(b, h) + boff + n * 2048 + 1024); } } while (0)
#define PG8_XLDA(b, h)  do { if constexpr (Prob::F8 && !Prob::I8 && F8MODE == 2) PG8_LDA8(At8, b, h); else PG8_LDA(At, b, h); } while (0)
#define PG8_XLDB0(b, h) do { if constexpr (Prob::F8 && !Prob::I8 && F8MODE == 2) PG8_LDB8(B08, b, h); else PG8_LDB(B0, b, h); } while (0)
#define PG8_XLDB1(b, h) do { if constexpr (Prob::F8 && !Prob::I8 && F8MODE == 2) PG8_LDB8(B18, b, h); else PG8_LDB(B1, b, h); } while (0)
#define PG8_XMMA0(ai, bj) do { if (USE_SETPRIO) __builtin_amdgcn_s_setprio(USE_SETPRIO); if constexpr (Prob::I8) PG8_MMAI(ai, bj, At, B0); else if constexpr (Prob::F8 && F8MODE == 2) PG8_MMA8(ai, bj, At8, B08); else if constexpr (Prob::F8) PG8_MMAQ(ai, bj, At, B0); else PG8_MMAB(ai, bj, At, B0); if (USE_SETPRIO) __builtin_amdgcn_s_setprio(0); } while (0)
#define PG8_XMMA1(ai, bj) do { if (USE_SETPRIO) __builtin_amdgcn_s_setprio(USE_SETPRIO); if constexpr (Prob::I8) PG8_MMAI(ai, bj, At, B1); else if constexpr (Prob::F8 && F8MODE == 2) PG8_MMA8(ai, bj, At8, B18); else if constexpr (Prob::F8) PG8_MMAQ(ai, bj, At, B1); else PG8_MMAB(ai, bj, At, B1); if (USE_SETPRIO) __builtin_amdgcn_s_setprio(0); } while (0)
#define PG8_WAIT_V(n) asm volatile("s_waitcnt vmcnt(" #n ")" ::: "memory")
#define PG8_WAIT_L(n) asm volatile("s_waitcnt lgkmcnt(" #n ")" ::: "memory")
#define PG8_BAR __builtin_amdgcn_s_barrier()
#define PG8_SCHED __builtin_amdgcn_sched_barrier(0)
    Unit cur, nxt; int ui = 0;
    if (!S.next(0, cur)) return;
    unsigned vo[2][2], nvo[2][2];
    calc_aoff(P, cur, Rr, Cc, vo);
    bool has_next = S.next(1, nxt);
    if constexpr (Prob::GATHER) { if (has_next) calc_aoff(P, nxt, Rr, Cc, nvo); else {
#pragma unroll
        for (int h = 0; h < 2; ++h)
#pragma unroll
            for (int i = 0; i < 2; ++i) nvo[h][i] = vo[h][i]; } }
    f32x4 acc[2][2][4][2];
#pragma unroll
    for (int a = 0; a < 2; ++a)
#pragma unroll
        for (int b = 0; b < 2; ++b)
#pragma unroll
            for (int m = 0; m < 4; ++m)
#pragma unroll
                for (int n = 0; n < 2; ++n) acc[a][b][m][n] = (f32x4){0.f, 0.f, 0.f, 0.f};
    bf16x8 At[4][2], B0[2][2], B1[2][2]; i32x8_t At8[4], B08[2], B18[2];
    const char* cA = P.a_base(cur); const char* cB = P.b_base(cur);
    if constexpr (Epi::HAS_PRE) E.pre(cur, 0, wid, lane);
    PG8_STGB(PG8_SB(0, 0), cB); PG8_STGB(PG8_SB(0, 1), cB + bhstep); PG8_STG(PG8_SA(0, 0), cA, vo[0][0], vo[0][1]); PG8_STG(PG8_SA(0, 1), cA, vo[1][0], vo[1][1]);
    if (wr == 1) PG8_BAR;
    PG8_WAIT_V(2); PG8_BAR;
    PG8_STGB(PG8_SB(1, 0), cB + kstep); PG8_STG(PG8_SA(1, 0), cA + kstep, vo[0][0], vo[0][1]); PG8_STGB(PG8_SB(1, 1), cB + bhstep + kstep);
    PG8_WAIT_V(6); PG8_BAR;
    for (;;) {
        const char* nA = has_next ? P.a_base(nxt) : cA; const char* nB = has_next ? P.b_base(nxt) : cB;
        for (int t = 0; t < nt; t += 2) {
            const bool last = (t == nt - 2);
            if constexpr (Epi::HAS_MID) { if (t == Epi::MID_T0 || t == Epi::MID_T1) { E.mid(acc, cur, wr, wc, fr, fq, t == Epi::MID_T0 ? 0 : 1); PG8_SCHED; } }
            const char* a1 = cA + (size_t)(t + 1) * kstep;
            const char* a2 = last ? nA : cA + (size_t)(t + 2) * kstep; const char* b2 = last ? nB : cB + (size_t)(t + 2) * kstep;
            const char* a3 = a2 + kstep; const char* b3 = b2 + kstep;
            unsigned x00 = vo[0][0], x01 = vo[0][1], x10 = vo[1][0], x11 = vo[1][1];
            if constexpr (Prob::GATHER) { if (last) { x00 = nvo[0][0]; x01 = nvo[0][1]; x10 = nvo[1][0]; x11 = nvo[1][1]; } }
            PG8_XLDB0(0, 0); PG8_XLDB1(0, 1); PG8_SCHED; PG8_XLDA(0, 0); PG8_STG(PG8_SA(1, 1), a1, vo[1][0], vo[1][1]);
            PG8_WAIT_V(8); PG8_WAIT_L(0); PG8_BAR; PG8_XMMA0(0, 0); PG8_XMMA1(0, 1); PG8_BAR; PG8_SCHED;
            PG8_XLDA(0, 1); PG8_STGB(PG8_SB(0, 0), b2); PG8_STGB(PG8_SB(0, 1), b2 + bhstep); PG8_STG(PG8_SA(0, 0), a2, x00, x01);
            PG8_WAIT_V(8); PG8_WAIT_L(0); PG8_BAR; PG8_XMMA0(1, 0); PG8_XMMA1(1, 1); PG8_BAR; PG8_SCHED;
            PG8_XLDB0(1, 0); PG8_XLDB1(1, 1); PG8_SCHED; PG8_XLDA(1, 0); PG8_STG(PG8_SA(0, 1), a2, x10, x11);
            PG8_WAIT_V(8); PG8_WAIT_L(0); PG8_BAR; PG8_XMMA0(0, 0); PG8_XMMA1(0, 1); PG8_BAR; PG8_SCHED;
            PG8_XLDA(1, 1); PG8_STGB(PG8_SB(1, 0), b3); PG8_STGB(PG8_SB(1, 1), b3 + bhstep); PG8_STG(PG8_SA(1, 0), a3, x00, x01);
            PG8_WAIT_V(8); PG8_WAIT_L(0); PG8_BAR; PG8_XMMA0(1, 0); PG8_XMMA1(1, 1); PG8_BAR; PG8_SCHED;
        }
        if constexpr (ALIGN_EPI) { if (wr == 0) PG8_BAR; }
        if constexpr ((Prob::F8 && F8MODE == 2) || Prob::I8) asm volatile("s_nop 15\n\ts_nop 15" ::: "memory");
        Unit nn; const bool has_nn = has_next && S.next(ui + 2, nn);
        if constexpr (Prob::GATHER) {
#pragma unroll
            for (int h = 0; h < 2; ++h)
#pragma unroll
                for (int i = 0; i < 2; ++i) vo[h][i] = nvo[h][i];
            if (has_nn) {
#pragma unroll
                for (int h = 0; h < 2; ++h)
#pragma unroll
                    for (int i = 0; i < 2; ++i) nvo[h][i] = P.a_raw(nn, h * HALF + Rr[i]); } }
        if constexpr (Epi::HAS_PRE) E(acc, cur, wr, wc, fr, fq, ui & 1); else E(acc, cur, wr, wc, fr, fq);
        PU(ui);
        if (!has_next) break;
#pragma unroll
        for (int a = 0; a < 2; ++a)
#pragma unroll
            for (int b = 0; b < 2; ++b)
#pragma unroll
                for (int m = 0; m < 4; ++m)
#pragma unroll
                    for (int n = 0; n < 2; ++n) acc[a][b][m][n] = (f32x4){0.f, 0.f, 0.f, 0.f};
        cur = nxt; cA = nA; cB = nB; ++ui;
        if constexpr (Epi::HAS_PRE) E.pre(cur, ui, wid, lane);
        has_next = has_nn; nxt = nn;
        if constexpr (Prob::GATHER) { if (has_next) {
#pragma unroll
            for (int h = 0; h < 2; ++h)
#pragma unroll
                for (int i = 0; i < 2; ++i) nvo[h][i] = (nvo[h][i] >> 2) * (Prob::F8 ? 1024u : 2048u) + (unsigned)Cc[i] * 2u;
            asm volatile("" : "+v"(nvo[0][0]), "+v"(nvo[0][1]), "+v"(nvo[1][0]), "+v"(nvo[1][1])); } }
        if constexpr (ALIGN_EPI) { if (wr == 1) PG8_BAR; }
    }
    PG8_WAIT_V(0);
    if constexpr (!ALIGN_EPI) { if (wr == 0) PG8_BAR; }
    PG8_BAR;
#undef PG8_SA
#undef PG8_SB
#undef PG8_STG
#undef PG8_STGB
#undef PG8_LDA
#undef PG8_LDB
#undef PG8_MMAB
#undef PG8_MMAQ
#undef PG8_MMA8
#undef PG8_MMAI
#undef PG8_LDA8
#undef PG8_LDB8
#undef PG8_XLDA
#undef PG8_XLDB0
#undef PG8_XLDB1
#undef PG8_XMMA0
#undef PG8_XMMA1
#undef PG8_WAIT_V
#undef PG8_WAIT_L
#undef PG8_BAR
#undef PG8_SCHED
}

typedef const f32x4 (&AccRef)[2][2][4][2];
__device__ __forceinline__ void dma4(const void* g, LAS unsigned char* dst) { __builtin_amdgcn_global_load_lds((const unsigned*)g, (LAS unsigned*)dst, 4, 0, 0); }

__device__ __forceinline__ void store8(bf16_t* p, const f32x4& a, const f32x4& b) {
    u32x4 w; w.x = cvt_pk_bf16(a[0], a[1]); w.y = cvt_pk_bf16(a[2], a[3]); w.z = cvt_pk_bf16(b[0], b[1]); w.w = cvt_pk_bf16(b[2], b[3]); *(u32x4*)p = w;
}
__device__ __forceinline__ float sigmoidf_(float v) { return __builtin_amdgcn_rcpf(1.0f + __builtin_amdgcn_exp2f(-1.4426950408889634f * v)); }

struct EpiInProj {
    static constexpr bool HAS_MID = false; static constexpr bool HAS_PRE = false;
    bf16_t *Q, *Kb, *V, *U, *MQ, *GT; const float *qn, *kn, *mqn, *bg; const f32x2* rope; const float* rs;
    __device__ __forceinline__ void operator()(AccRef acc, const Unit& u, int wr, int wc, int fr, int fq) const {
        const int pn = u.pn; const int row0 = u.pm * BM + wr * 64 + fr;
        float sc8[8];
#pragma unroll
        for (int q = 0; q < 8; ++q) sc8[q] = rs[row0 + (q >> 2) * HALF + (q & 3) * 16] * (1.0f / WQ_IN);
#define I2F(v) __builtin_convertvector(__builtin_bit_cast(i32x4_t, v), f32x4)
        bf16_t* const Q_ = Q; bf16_t* const K_ = Kb; bf16_t* const V_ = V; bf16_t* const U_ = U; bf16_t* const MQ_ = MQ; const float* const qn_ = qn; const float* const kn_ = kn; const float* const mqn_ = mqn;
        if (pn < 4 || pn == 7) {
            const bool rope_on = pn < 4; const float* gn = pn < 2 ? qn_ : (pn < 4 ? kn_ : mqn_);
            const float sc = (pn < 2 || pn == 7) ? C2 : 1.0f;
            bf16_t* O; int pitch, colb;
            if (pn < 2) { O = Q_; pitch = 512; colb = (pn * 4 + wc) * 64; } else if (pn < 4) { O = K_; pitch = 512; colb = ((pn - 2) * 4 + wc) * 64; } else { O = MQ_; pitch = 256; colb = wc * 64; }
            const f32x4 g00 = *(const f32x4*)(gn + 8 * fq), g01 = *(const f32x4*)(gn + 8 * fq + 4), g10 = *(const f32x4*)(gn + 32 + 8 * fq), g11 = *(const f32x4*)(gn + 32 + 8 * fq + 4);
#pragma unroll
            for (int ai = 0; ai < 2; ++ai)
#pragma unroll
                for (int m = 0; m < 4; ++m) {
                    const float rsc = sc8[ai * 4 + m]; const f32x4 a0 = I2F(acc[ai][0][m][0]) * rsc, a1 = I2F(acc[ai][0][m][1]) * rsc, b0 = I2F(acc[ai][1][m][0]) * rsc, b1 = I2F(acc[ai][1][m][1]) * rsc;
                    float ss = 0.f;
#pragma unroll
                    for (int j = 0; j < 4; ++j) ss += a0[j] * a0[j] + a1[j] * a1[j] + b0[j] * b0[j] + b1[j] * b1[j];
                    ss += __shfl_xor(ss, 16); ss += __shfl_xor(ss, 32);
                    const float rstd = 1.0f / sqrtf(ss * (1.0f / 64.0f) + RMS_EPS);
                    const int row = row0 + ai * HALF + m * 16;
                    f32x4 t10 = a0 * rstd * g00, t11 = a1 * rstd * g01, t20 = b0 * rstd * g10, t21 = b1 * rstd * g11;
                    f32x4 o10, o11, o20, o21;
                    if (rope_on) {
                        const f32x4* rp = (const f32x4*)(rope + (size_t)(row & (SEQ - 1)) * 32 + 8 * fq);
                        const f32x4 r0 = rp[0], r1 = rp[1], r2 = rp[2], r3 = rp[3];
                        const f32x4 cs0 = {r0[0], r0[2], r1[0], r1[2]}, sn0 = {r0[1], r0[3], r1[1], r1[3]}, cs1 = {r2[0], r2[2], r3[0], r3[2]}, sn1 = {r2[1], r2[3], r3[1], r3[3]};
                        o10 = (t10 * cs0 - t20 * sn0) * sc; o11 = (t11 * cs1 - t21 * sn1) * sc; o20 = (t20 * cs0 + t10 * sn0) * sc; o21 = (t21 * cs1 + t11 * sn1) * sc;
                    } else { o10 = t10 * sc; o11 = t11 * sc; o20 = t20 * sc; o21 = t21 * sc; }
                    bf16_t* rowp = O + (size_t)row * pitch + colb + 8 * fq;
                    store8(rowp, o10, o11); store8(rowp + 32, o20, o21);
                }
        } else if (pn < 7) {
            bf16_t* O; int pitch, colb;
            if (pn < 6) { O = V_; pitch = 512; colb = (pn - 4) * 256 + wc * 64; } else { O = U_; pitch = 256; colb = wc * 64; }
#pragma unroll
            for (int ai = 0; ai < 2; ++ai)
#pragma unroll
                for (int m = 0; m < 4; ++m) { bf16_t* rowp = O + (size_t)(row0 + ai * HALF + m * 16) * pitch + colb + 8 * fq;
                    const float sc = sc8[ai * 4 + m]; store8(rowp, I2F(acc[ai][0][m][0]) * sc, I2F(acc[ai][0][m][1]) * sc); store8(rowp + 32, I2F(acc[ai][1][m][0]) * sc, I2F(acc[ai][1][m][1]) * sc); }
        } else {
            const int gc = (pn - 8) * 256 + wc * 64 + 8 * fq;
            f32x4 bv[2][2];
#pragma unroll
            for (int bj = 0; bj < 2; ++bj)
#pragma unroll
                for (int n = 0; n < 2; ++n) bv[bj][n] = *(const f32x4*)(bg + gc + 32 * bj + 4 * n) * (-1.4426950408889634f);
#pragma unroll
            for (int ai = 0; ai < 2; ++ai)
#pragma unroll
                for (int m = 0; m < 4; ++m) {
                    unsigned char* blk = (unsigned char*)GT + ((size_t)(((pn - 8) >> 2) * 128 + u.pm) * 4 + ((pn - 8) & 3)) * 65536 + (size_t)((wr * 4 + wc) * 16 * 64 + (fq * 16 + fr)) * 8;
#pragma unroll
                    for (int bj = 0; bj < 2; ++bj) { const float scl = sc8[ai * 4 + m] * (-1.4426950408889634f); f32x4 v0 = I2F(acc[ai][bj][m][0]) * scl + bv[bj][0], v1 = I2F(acc[ai][bj][m][1]) * scl + bv[bj][1];
                        u32x2 w = {0u, 0u};
#pragma unroll
                        for (int j = 0; j < 4; ++j) { const float g0 = __builtin_amdgcn_rcpf(1.0f + __builtin_amdgcn_exp2f(v0[j])), g1 = __builtin_amdgcn_rcpf(1.0f + __builtin_amdgcn_exp2f(v1[j]));
                            w.x = __builtin_amdgcn_cvt_pk_u8_f32(fmaxf(g0 * 255.0f + 0.25f, 1.0f), j, w.x); w.y = __builtin_amdgcn_cvt_pk_u8_f32(fmaxf(g1 * 255.0f + 0.25f, 1.0f), j, w.y); }
                        *(u32x2*)(blk + (ai * 8 + m * 2 + bj) * 512) = w; } }
        }
    }
};
#undef I2F
struct EpiMemKV {
    static constexpr bool HAS_MID = false; static constexpr bool HAS_PRE = false;
    bf16_t* MKV; const float* mkn;
    __device__ __forceinline__ void operator()(AccRef acc, const Unit& u, int wr, int wc, int fr, int fq) const {
        const int row0 = u.pm * BM + wr * 64 + fr;
        f32x4 g00 = {1.f, 1.f, 1.f, 1.f}, g01 = g00, g10 = g00, g11 = g00;
        if (u.pn == 0) { g00 = *(const f32x4*)(mkn + 8 * fq); g01 = *(const f32x4*)(mkn + 8 * fq + 4); g10 = *(const f32x4*)(mkn + 32 + 8 * fq); g11 = *(const f32x4*)(mkn + 32 + 8 * fq + 4); }
#pragma unroll
        for (int ai = 0; ai < 2; ++ai)
#pragma unroll
            for (int m = 0; m < 4; ++m) {
                const f32x4 a0 = acc[ai][0][m][0], a1 = acc[ai][0][m][1], b0 = acc[ai][1][m][0], b1 = acc[ai][1][m][1];
                float rstd = 1.0f;
                if (u.pn == 0) { float ss = 0.f;
#pragma unroll
                    for (int j = 0; j < 4; ++j) ss += a0[j] * a0[j] + a1[j] * a1[j] + b0[j] * b0[j] + b1[j] * b1[j];
                    ss += __shfl_xor(ss, 16); ss += __shfl_xor(ss, 32); rstd = 1.0f / sqrtf(ss * (1.0f / 64.0f) + RMS_EPS); }
                bf16_t* rowp = MKV + (size_t)(row0 + ai * HALF + m * 16) * 512 + u.pn * 256 + wc * 64 + 8 * fq;
                store8(rowp, a0 * rstd * g00, a1 * rstd * g01); store8(rowp + 32, b0 * rstd * g10, b1 * rstd * g11);
            }
    }
};
template <int STAGE> struct EpiMerge {
    static constexpr bool HAS_MID = false; static constexpr bool HAS_PRE = false;
    const bf16_t* GT; float* MF; bf16_t* MB;
    __device__ __forceinline__ void operator()(AccRef acc, const Unit& u, int wr, int wc, int fr, int fq) const {
        const int row0 = u.pm * BM + wr * 64 + fr, col0 = u.pn * BM + wc * 64 + 8 * fq;
#pragma unroll
        for (int ai = 0; ai < 2; ++ai)
#pragma unroll
            for (int m = 0; m < 4; ++m) { const size_t row = (size_t)(row0 + ai * HALF + m * 16);
#pragma unroll
                for (int bj = 0; bj < 2; ++bj) { const int col = col0 + 32 * bj;
                    const u32x4 g = *(const u32x4*)(GT + row * 3072 + STAGE * 1024 + col);
                    const f32x4 ga = {bf_lo(g.x), bf_hi(g.x), bf_lo(g.y), bf_hi(g.y)}, gb = {bf_lo(g.z), bf_hi(g.z), bf_lo(g.w), bf_hi(g.w)};
                    f32x4 v0 = acc[ai][bj][m][0] * ga, v1 = acc[ai][bj][m][1] * gb;
                    float* mp = MF + row * 1024 + col;
                    if (STAGE > 0) { v0 += *(const f32x4*)mp; v1 += *(const f32x4*)(mp + 4); }
                    if (STAGE < 2) { *(f32x4*)mp = v0; *(f32x4*)(mp + 4) = v1; } else store8(MB + row * 1024 + col, v0, v1); }
                if (m & 1) asm volatile("" ::: "memory"); }
    }
};
struct EpiWout {
    static constexpr bool HAS_MID = false; static constexpr bool HAS_PRE = false;
    const float* X; float* X2; unsigned char* XG; const float* n2;
    __device__ __forceinline__ void operator()(AccRef acc, const Unit& u, int wr, int wc, int fr, int fq) const {
        const int row0 = u.pm * BM + wr * 64 + fr, col0 = u.pn * BM + wc * 64 + 8 * fq;
        f32x4 nv[2][2];
#pragma unroll
        for (int bj = 0; bj < 2; ++bj)
#pragma unroll
            for (int n = 0; n < 2; ++n) nv[bj][n] = *(const f32x4*)(n2 + col0 + 32 * bj + 4 * n);
#pragma unroll
        for (int ai = 0; ai < 2; ++ai)
#pragma unroll
            for (int m = 0; m < 4; ++m) { const size_t off = (size_t)(row0 + ai * HALF + m * 16) * 1024 + col0;
#pragma unroll
                for (int bj = 0; bj < 2; ++bj) { const f32x4 x0 = *(const f32x4*)(X + off + 32 * bj) + acc[ai][bj][m][0], x1 = *(const f32x4*)(X + off + 32 * bj + 4) + acc[ai][bj][m][1];
                    *(f32x4*)(X2 + off + 32 * bj) = x0; *(f32x4*)(X2 + off + 32 * bj + 4) = x1;
                    { const f32x4 y0 = x0 * nv[bj][0], y1 = x1 * nv[bj][1]; u32x2 w8; w8.x = pk4_fp8(y0[0], y0[1], y0[2], y0[3]); w8.y = pk4_fp8(y1[0], y1[1], y1[2], y1[3]); *(u32x2*)(XG + off + 32 * bj) = w8; } }
                if (m & 1) asm volatile("" ::: "memory"); }
    }
};
struct EpiSwiglu {
    static constexpr bool HAS_MID = false; static constexpr bool HAS_PRE = true;
    unsigned char* ACT; const u32x2* list; const float* bgu; LAS unsigned char* xb;
    __device__ __forceinline__ void pre(const Unit& u, int ui, int wid, int lane) const {
        LAS unsigned char* b = xb + (ui & 1) * 2048;
        if (wid < 4) { const int rr = u.mt * BM + 64 * wid + lane, rc = rr < u.cnt ? rr : u.cnt - 1; dma4((const unsigned*)(list + (size_t)u.e * CAP + rc) + 1, b + wid * 256); }
        else { const int j = 64 * (wid - 4) + lane; dma4(bgu + (size_t)u.e * 2048 + 128 * u.pn + (j < 128 ? j : 1024 + (j - 128)), b + 1024 + (wid - 4) * 256); }
    }
    __device__ __forceinline__ static unsigned swi4(const f32x4& ag, const f32x4& au, float rstd, const f32x4& bg, const f32x4& bu) {
        unsigned w = 0;
#pragma unroll
        for (int h = 0; h < 2; ++h) {
            const f32x2 a2 = {ag[2 * h], ag[2 * h + 1]}, u2 = {au[2 * h], au[2 * h + 1]}, bg2 = {bg[2 * h], bg[2 * h + 1]}, bu2 = {bu[2 * h], bu[2 * h + 1]};
            const f32x2 G = a2 * rstd + bg2, U = u2 * rstd + bu2;
            const f32x2 gg = {fminf(G[0], 7.0f), fminf(G[1], 7.0f)};
            const f32x2 t = gg * (-1.702f * 1.4426950408889634f);
            const f32x2 d = (f32x2){__builtin_amdgcn_exp2f(t[0]), __builtin_amdgcn_exp2f(t[1])} + 1.0f;
            const f32x2 r = {__builtin_amdgcn_rcpf(d[0]), __builtin_amdgcn_rcpf(d[1])};
            const f32x2 uu = {__builtin_amdgcn_fmed3f(U[0], -7.0f, 7.0f), __builtin_amdgcn_fmed3f(U[1], -7.0f, 7.0f)};
            const f32x2 o = (gg * r) * (uu * A8_SCALE + A8_SCALE);
            w = h ? (unsigned)__builtin_amdgcn_cvt_pk_fp8_f32(o[0], o[1], (int)w, true) : (unsigned)__builtin_amdgcn_cvt_pk_fp8_f32(o[0], o[1], (int)w, false);
        }
        return w;
    }
    __device__ __forceinline__ void operator()(AccRef acc, const Unit& u, int wr, int wc, int fr, int fq, int par) const {
        int z = 0; asm volatile("" : "+v"(z));
        const int col = 128 * u.pn + 32 * wc + 8 * fq + z; const LAS unsigned char* b = xb + par * 2048; const LAS unsigned char* bb = b + 1024 + (32 * wc + 8 * fq + z) * 4;
        const f32x4 bg0 = *(const LAS f32x4*)bb, bg1 = *(const LAS f32x4*)(bb + 16), bu0 = *(const LAS f32x4*)(bb + 512), bu1 = *(const LAS f32x4*)(bb + 528);
#pragma unroll
        for (int ai = 0; ai < 2; ++ai)
#pragma unroll
            for (int m = 0; m < 4; ++m) { const int r = ai * HALF + wr * 64 + m * 16 + fr;
                const float rstd = *(const LAS float*)(b + (r + z) * 4) * (1.0f / W8_SCALE);
                u32x2 w8; w8.x = swi4(acc[ai][0][m][0], acc[ai][1][m][0], rstd, bg0, bu0); w8.y = swi4(acc[ai][0][m][1], acc[ai][1][m][1], rstd, bg1, bu1);
                *(u32x2*)(ACT + (size_t)(u.pm * BM + r) * 1024 + col) = w8; }
    }
};
struct EpiDown {
    static constexpr bool HAS_MID = false; static constexpr bool HAS_PRE = true;
    unsigned char* Y4; const u32x2* list; const float* bd; LAS unsigned char* xb;
    __device__ __forceinline__ void pre(const Unit& u, int ui, int wid, int lane) const {
        LAS unsigned char* b = xb + (ui & 1) * 2048;
        if (wid < 4) { const int rr = u.mt * BM + 64 * wid + lane, rc = rr < u.cnt ? rr : u.cnt - 1; dma4((const unsigned*)(list + (size_t)u.e * CAP + rc), b + wid * 256); }
        else { const int j = 64 * (wid - 4) + lane; dma4(bd + (size_t)u.e * 1024 + u.pn * BM + j, b + 1024 + (wid - 4) * 256); }
    }
    __device__ __forceinline__ static unsigned dn4(const f32x4& a, const f32x4& b32) {
        const f32x4 y = a * (Y8_SCALE / (W8_SCALE * A8_SCALE)) + b32;
        return pk4_fp8(y[0], y[1], y[2], y[3]);
    }
    __device__ __forceinline__ void operator()(AccRef acc, const Unit& u, int wr, int wc, int fr, int fq, int par) const {
        int z = 0; asm volatile("" : "+v"(z));
        const int colw = wc * 64 + 16 * fq + z, col0 = u.pn * BM + colw;
        const LAS unsigned char* b = xb + par * 2048;
        f32x4 bv[2][2];
#pragma unroll
        for (int bj = 0; bj < 2; ++bj)
#pragma unroll
            for (int n = 0; n < 2; ++n) bv[bj][n] = *(const LAS f32x4*)(b + 1024 + (colw + 8 * bj + 4 * n) * 4) * Y8_SCALE;
#pragma unroll
        for (int ai = 0; ai < 2; ++ai)
#pragma unroll
            for (int m = 0; m < 4; ++m) { const int r = ai * HALF + wr * 64 + m * 16 + fr, rr = u.mt * BM + r;
                if (rr < u.cnt) { const unsigned tk = *(const LAS unsigned*)(b + (r + z) * 4);
                    u32x4 w8; w8.x = dn4(acc[ai][0][m][0], bv[0][0]); w8.y = dn4(acc[ai][0][m][1], bv[0][1]); w8.z = dn4(acc[ai][1][m][0], bv[1][0]); w8.w = dn4(acc[ai][1][m][1], bv[1][1]);
                    *(u32x4*)(Y4 + (size_t)tk * 1024 + col0) = w8; } }
    }
};
struct EpiMergeR {
    static constexpr bool HAS_MID = true; static constexpr bool HAS_PRE = false; static constexpr int MID_T0 = 8, MID_T1 = 12;
    const bf16_t* GT; bf16_t* MB;
    __device__ __forceinline__ void mid(f32x4 (&acc)[2][2][4][2], const Unit& u, int wr, int wc, int fr, int fq, int seam) const {
        int z = 0; asm volatile("" : "+v"(z));
        const unsigned char* gp0 = (const unsigned char*)GT + ((size_t)(seam * 128 + u.pm) * 4 + u.pn) * 65536 + (size_t)((wr * 4 + wc) * 16 * 64 + (fq * 16 + fr) + z) * 8;
#pragma unroll
        for (int ai = 0; ai < 2; ++ai)
#pragma unroll
            for (int m = 0; m < 4; ++m) {
#pragma unroll
                for (int bj = 0; bj < 2; ++bj) { const unsigned char* gp = gp0 + (ai * 8 + m * 2 + bj) * 512;
                    const u32x2 gn = *(const u32x2*)gp, gd = *(const u32x2*)(gp + (size_t)128 * 4 * 65536);
#pragma unroll
                    for (int n = 0; n < 2; ++n) { const unsigned wn = n ? gn.y : gn.x, wd = n ? gd.y : gd.x;
#pragma unroll
                        for (int j = 0; j < 4; ++j) acc[ai][bj][m][n][j] *= (float)((wn >> (8 * j)) & 0xffu) * __builtin_amdgcn_rcpf((float)((wd >> (8 * j)) & 0xffu)); } }
                if (m & 1) asm volatile("" ::: "memory"); }
    }
    __device__ __forceinline__ void operator()(AccRef acc, const Unit& u, int wr, int wc, int fr, int fq) const {
        int z = 0; asm volatile("" : "+v"(z));
        const size_t off0 = (size_t)(u.pm * BM + wr * 64 + fr + z) * 1024 + u.pn * BM + wc * 64 + 8 * fq;
        const unsigned char* gp0 = (const unsigned char*)GT + ((size_t)(2 * 128 + u.pm) * 4 + u.pn) * 65536 + (size_t)((wr * 4 + wc) * 16 * 64 + (fq * 16 + fr) + z) * 8;
#pragma unroll
        for (int ai = 0; ai < 2; ++ai)
#pragma unroll
            for (int m = 0; m < 4; ++m) { const size_t ro = off0 + (size_t)(ai * HALF + m * 16) * 1024;
#pragma unroll
                for (int bj = 0; bj < 2; ++bj) {
                    const u32x2 g = *(const u32x2*)(gp0 + (ai * 8 + m * 2 + bj) * 512);
                    f32x4 ga, gb;
#pragma unroll
                    for (int j = 0; j < 4; ++j) { ga[j] = (float)((g.x >> (8 * j)) & 0xffu) * (1.0f / 255.0f); gb[j] = (float)((g.y >> (8 * j)) & 0xffu) * (1.0f / 255.0f); }
                    store8(MB + ro + 32 * bj, acc[ai][bj][m][0] * ga, acc[ai][bj][m][1] * gb); } }
    }
};
struct EpiPlain {
    static constexpr bool HAS_MID = false; static constexpr bool HAS_PRE = false;
    bf16_t* Z; int ldz;
    __device__ __forceinline__ void operator()(AccRef acc, const Unit& u, int wr, int wc, int fr, int fq) const {
        const int row0 = u.pm * BM + wr * 64 + fr, col0 = u.pn * BM + wc * 64 + 8 * fq;
#pragma unroll
        for (int ai = 0; ai < 2; ++ai)
#pragma unroll
            for (int m = 0; m < 4; ++m) { bf16_t* rowp = Z + (size_t)(row0 + ai * HALF + m * 16) * ldz + col0;
                store8(rowp, acc[ai][0][m][0], acc[ai][0][m][1]); store8(rowp + 32, acc[ai][1][m][0], acc[ai][1][m][1]); }
    }
};
}

namespace attn_body {
using bf16 = __hip_bfloat16;
using s16x4 = __attribute__((ext_vector_type(4))) short;
constexpr int NW = 8, QBLK = 32, QB = QBLK * NW, KVBLK = 64, D = 64;
__device__ __forceinline__ int crow(int r, int hi) { return (r & 3) + 8 * (r >> 2) + 4 * hi; }
#define SBAR() __builtin_amdgcn_sched_barrier(0)
constexpr int NSLOT = 3, SLOTB = 8192;
constexpr int LDS_K = 0, LDS_V = NSLOT * SLOTB, LDS_WS = 2 * NSLOT * SLOTB, LDS_OST = LDS_WS + NW * 64 * 4, LDS_BYTES = LDS_OST + NW * 4096;
__device__ __forceinline__ void glds16(const void* gsrc, unsigned lds_dst) { unsigned keep;
    asm volatile("s_mov_b32 %0, m0\n\ts_mov_b32 m0, %2\n\ts_nop 0\n\tglobal_load_lds_dwordx4 %1, off\n\ts_mov_b32 m0, %0" : "=&s"(keep) : "v"(gsrc), "s"(lds_dst) : "memory"); }
__device__ __forceinline__ float max3f(float a, float b, float c) { float r; asm("v_max3_f32 %0, %1, %2, %3" : "=v"(r) : "v"(a), "v"(b), "v"(c)); return r; }
__device__ __forceinline__ float max2f(float a, float b) { float r; asm("v_max_f32_e32 %0, %1, %2" : "=v"(r) : "v"(a), "v"(b)); return r; }
__device__ __forceinline__ float fadd_s(float a, float b) { float r; asm("v_add_f32_e32 %0, %1, %2" : "=v"(r) : "v"(a), "v"(b)); return r; }
__device__ __forceinline__ float fsub_s(float a, float b) { float r; asm("v_sub_f32_e32 %0, %1, %2" : "=v"(r) : "v"(a), "v"(b)); return r; }
typedef float f32x2_t __attribute__((ext_vector_type(2))); typedef __bf16 bf16x2_t __attribute__((ext_vector_type(2)));
__device__ __forceinline__ unsigned cvtpk_s(float lo, float hi) { f32x2_t v = {lo, hi}; bf16x2_t b = __builtin_convertvector(v, bf16x2_t); return __builtin_bit_cast(unsigned, b); }
#define WAIT_BAR(N) asm volatile("s_waitcnt vmcnt(" #N ") lgkmcnt(0)\n\ts_barrier" ::: "memory")

__device__ __forceinline__ void qkt(f32x16& p0, f32x16& p1, const char* Kslot, const bf16x8* qr, const f32x16& negm, int r32, int hi) {
    const char* kb = Kslot + hi * 1024 + r32 * 16;
#pragma unroll
    for (int d0 = 0; d0 < 4; ++d0) {
        const bf16x8 b0 = *reinterpret_cast<const bf16x8*>(kb + d0 * 2048);
        const bf16x8 b1 = *reinterpret_cast<const bf16x8*>(kb + d0 * 2048 + 512);
        if (d0 == 0) { p0 = __builtin_amdgcn_mfma_f32_32x32x16_bf16(b0, qr[0], negm, 0, 0, 0); p1 = __builtin_amdgcn_mfma_f32_32x32x16_bf16(b1, qr[0], negm, 0, 0, 0); }
        else { p0 = __builtin_amdgcn_mfma_f32_32x32x16_bf16(b0, qr[d0], p0, 0, 0, 0); p1 = __builtin_amdgcn_mfma_f32_32x32x16_bf16(b1, qr[d0], p1, 0, 0, 0); } }
}
typedef __attribute__((address_space(3))) const char* lds_cptr;
typedef short v4i16_t __attribute__((ext_vector_type(4)));
__device__ __forceinline__ void kload8(bf16x8* kf, lds_cptr kp) {
    kf[0] = *(const __attribute__((address_space(3))) bf16x8*)(kp);        kf[1] = *(const __attribute__((address_space(3))) bf16x8*)(kp + 512);
    kf[2] = *(const __attribute__((address_space(3))) bf16x8*)(kp + 2048); kf[3] = *(const __attribute__((address_space(3))) bf16x8*)(kp + 2560);
    kf[4] = *(const __attribute__((address_space(3))) bf16x8*)(kp + 4096); kf[5] = *(const __attribute__((address_space(3))) bf16x8*)(kp + 4608);
    kf[6] = *(const __attribute__((address_space(3))) bf16x8*)(kp + 6144); kf[7] = *(const __attribute__((address_space(3))) bf16x8*)(kp + 6656);
}
__device__ __forceinline__ void kload2(bf16x8* kf, lds_cptr kp, int j) { kf[2 * j] = *(const __attribute__((address_space(3))) bf16x8*)(kp + j * 2048); kf[2 * j + 1] = *(const __attribute__((address_space(3))) bf16x8*)(kp + j * 2048 + 512); }
__device__ __forceinline__ s16x4 vtr(lds_cptr p) { return __builtin_bit_cast(s16x4, __builtin_amdgcn_ds_read_tr16_b64_v4i16((__attribute__((address_space(3))) v4i16_t*)p)); }
__device__ __forceinline__ float rowmax(const f32x16& p0, const f32x16& p1) {
    float a = max3f(p0[0], p0[1], p1[0]), b = max3f(p0[2], p0[3], p1[1]); a = max3f(a, p1[2], p1[3]);
#pragma unroll
    for (int r = 4; r < 16; r += 4) { a = max3f(a, p0[r], p0[r + 1]); b = max3f(b, p0[r + 2], p0[r + 3]); a = max3f(a, p1[r], p1[r + 1]); b = max3f(b, p1[r + 2], p1[r + 3]); }
    const float m = max2f(a, b);
    auto rr = __builtin_amdgcn_permlane32_swap(__float_as_uint(m), __float_as_uint(m), false, false);
    return max2f(__uint_as_float(rr[0]), __uint_as_float(rr[1]));
}
__device__ __forceinline__ void pv(f32x16* o, int vb, bf16x8 pa0, bf16x8 pa1, bf16x8 pa2, bf16x8 pa3) {
#pragma unroll
    for (int d0 = 0; d0 < 2; ++d0) { s16x4 lo[4], hi[4];
#pragma unroll
        for (int ks = 0; ks < 4; ++ks) {
            asm volatile("ds_read_b64_tr_b16 %0,%1 offset:%c2" : "=&v"(lo[ks]) : "v"(vb), "i"(d0 * 4096 + ks * 1024) : "memory");
            asm volatile("ds_read_b64_tr_b16 %0,%1 offset:%c2" : "=&v"(hi[ks]) : "v"(vb), "i"(d0 * 4096 + ks * 1024 + 512) : "memory"); }
        asm volatile("s_waitcnt lgkmcnt(0)" ::: "memory"); SBAR();
#define PK(k) (bf16x8){lo[k][0], lo[k][1], lo[k][2], lo[k][3], hi[k][0], hi[k][1], hi[k][2], hi[k][3]}
        o[d0] = __builtin_amdgcn_mfma_f32_32x32x16_bf16(pa0, PK(0), o[d0], 0, 0, 0);
        o[d0] = __builtin_amdgcn_mfma_f32_32x32x16_bf16(pa1, PK(1), o[d0], 0, 0, 0);
        o[d0] = __builtin_amdgcn_mfma_f32_32x32x16_bf16(pa2, PK(2), o[d0], 0, 0, 0);
        o[d0] = __builtin_amdgcn_mfma_f32_32x32x16_bf16(pa3, PK(3), o[d0], 0, 0, 0);
#undef PK
    }
}
__device__ __forceinline__ void cmask(f32x16& p0, f32x16& p1, int jb, int wid) {
    if (jb > (wid >> 1)) {
#pragma unroll
        for (int r = 0; r < 16; ++r) { p0[r] = -INFINITY; p1[r] = -INFINITY; } }
}
template <int THRL, bool MASK> __device__ __forceinline__ void attn_unit(int q0, int NT, const bf16* Qh, int qp, const bf16* __restrict__ Kh, int kp, const bf16* __restrict__ Vh, int vp, bf16* Oh, int op, char* shm) {
    const int tid = threadIdx.x, lane = tid & 63, r32 = lane & 31, hi = lane >> 5; const int wid = __builtin_amdgcn_readfirstlane(tid >> 6);
    const bf16* Qw = Qh + (long)(q0 + wid * QBLK) * qp;
    const unsigned lds0 = (unsigned)(uintptr_t)shm;
    float* wsf = (float*)(shm + LDS_WS) + wid * 64;
    const bf16* ksrc = Kh + (long)lane * kp + wid * 8;
    const bf16* vsrc = Vh + (long)(16 * (wid & 3) + (lane >> 2)) * vp + (wid >> 2) * 32 + (lane & 3) * 8;
    const unsigned kdst = lds0 + LDS_K + wid * 1024, vdst = lds0 + LDS_V + wid * 1024;
#define DMA_K(t, slot) glds16(ksrc + (long)(t) * KVBLK * kp, (unsigned)__builtin_amdgcn_readfirstlane(kdst + (slot)))
#define DMA_V(t, slot) glds16(vsrc + (long)(t) * KVBLK * vp, (unsigned)__builtin_amdgcn_readfirstlane(vdst + (slot)))
    const int vb0 = (int)(lds0 + LDS_V) + ((lane >> 4) & 1) * 32 + (lane & 3) * 8 + (4 * hi + ((lane & 15) >> 2)) * 64;
    const char* Kbase = shm + LDS_K; bf16x8 kf[8];
    const lds_cptr shm3 = (lds_cptr)shm; const lds_cptr kp0 = shm3 + LDS_K + hi * 1024 + r32 * 16; const lds_cptr vp0 = shm3 + LDS_V + ((lane >> 4) & 1) * 32 + (lane & 3) * 8 + (4 * hi + ((lane & 15) >> 2)) * 64;
    DMA_K(0, 0); DMA_V(0, 0); DMA_K(1, SLOTB);
    bf16x8 qr[4];
#pragma unroll
    for (int d0 = 0; d0 < 4; ++d0) qr[d0] = *reinterpret_cast<const bf16x8*>(&Qw[(long)r32 * qp + d0 * 16 + hi * 8]);
    float mhat = 0.f, l_reg = 0.f; f32x16 o[2]; o[0] = f32x16{}; o[1] = f32x16{}; f32x16 negm = f32x16{}; asm volatile("" : "+v"(negm));
#define CMASK(P0, P1, t) do { if (MASK) { int jb_ = (t) - (NT - 4); if (jb_ >= 0) cmask(P0, P1, jb_, wid); } } while (0)
    bool resc = false;
#define START(P0, P1) do { const float rm = rowmax(P0, P1); resc = false; \
    { const float dl = rm; mhat = fadd_s(mhat, dl); \
      _Pragma("unroll") for (int r = 0; r < 16; ++r) { P0[r] = fsub_s(P0[r], dl); P1[r] = fsub_s(P1[r], dl); } \
      _Pragma("unroll") for (int r = 0; r < 16; ++r) negm[r] = -mhat; asm volatile("" : "+v"(negm)); } \
    _Pragma("unroll") for (int r = 0; r < 16; ++r) P0[r] = __builtin_amdgcn_exp2f(P0[r]); } while (0)
#define RESC() do { if (resc) { asm volatile("s_waitcnt lgkmcnt(0)" ::: "memory"); \
      _Pragma("unroll") for (int d_ = 0; d_ < 2; ++d_) _Pragma("unroll") for (int r = 0; r < 16; ++r) o[d_][r] *= wsf[crow(r, hi)]; } } while (0)
    f32x16 pA0, pA1, pB0, pB1;
    int sl_prev = 0, sl_cur = 0, sl_next = SLOTB;
#define ROT() do { sl_prev = sl_cur; sl_cur = sl_next; sl_next = (sl_next == (NSLOT - 1) * SLOTB) ? 0 : sl_next + SLOTB; } while (0)
    DMA_K(2, 2 * SLOTB);
    WAIT_BAR(3);
    qkt(pA0, pA1, Kbase, qr, negm, r32, hi); asm volatile("s_nop 15\n\ts_nop 7" : "+v"(pA0), "+v"(pA1)); CMASK(pA0, pA1, 0);
    START(pA0, pA1);
    _Pragma("unroll") for (int r = 0; r < 16; ++r) pA1[r] = __builtin_amdgcn_exp2f(pA1[r]);
    WAIT_BAR(0);
    DMA_K(3, 0); DMA_V(1, SLOTB);
    ROT();
    kload8(kf, kp0 + sl_cur);
    WAIT_BAR(2);
    s16x4 vlo[8], vhi[8]; u32x4 pw0, pw1, pw2, pw3;
#define PKW(P, B) cvtpk_s(P[B], P[B + 1])
#define PAF(k) __builtin_bit_cast(bf16x8, pw##k)
#define VFR(i) (bf16x8){vlo[i][0], vlo[i][1], vlo[i][2], vlo[i][3], vhi[i][0], vhi[i][1], vhi[i][2], vhi[i][3]}
#define PIN(x) asm volatile("" : "+v"(x))
#define MX3(a, b, c) __builtin_fmaxf(__builtin_fmaxf((a), (b)), (c))
#define GAPA(MF, A0, A1, A2, A3, W0, W1, PW) do { MF; sacc += A0; sacc += A1; sacc += A2; sacc += A3; PIN(sacc); W0; W1; PIN(PW); SBAR(); } while (0)
#define EX(v) __builtin_amdgcn_exp2f(v)
#define GAPB(MF, X, B) do { MF; X[B] = EX(X[B]); X[B + 1] = EX(X[B + 1]); X[B + 2] = EX(X[B + 2]); X[B + 3] = EX(X[B + 3]); PIN(X); SBAR(); } while (0)
#define VRD(i) do { vlo[i] = vtr(vp_ + (((i) >> 2) * 4096 + ((i) & 3) * 1024)); vhi[i] = vtr(vp_ + (((i) >> 2) * 4096 + ((i) & 3) * 1024 + 512)); } while (0)
#define KRD(G, j) do { if (G) { kload2(kf, kp0 + sl_next, j); SBAR(); } } while (0)
#define STEP(C0, C1, P0, P1, t, GK, GV, GL) do { SBAR(); \
    const lds_cptr vp_ = vp0 + sl_prev; \
    VRD(0); SBAR(); float sacc = (P0[0] + P0[1]); \
    GAPA(C0 = __builtin_amdgcn_mfma_f32_32x32x16_bf16(kf[0], qr[0], negm, 0, 0, 0), P0[2], P0[3], P0[4], P0[5],     pw0[0] = PKW(P0, 0), pw0[1] = PKW(P0, 2), pw0); \
    VRD(4); SBAR(); GAPA(C1 = __builtin_amdgcn_mfma_f32_32x32x16_bf16(kf[1], qr[0], negm, 0, 0, 0), P0[6], P0[7], P0[8], P0[9],     pw0[2] = PKW(P0, 4), pw0[3] = PKW(P0, 6), pw0); \
    VRD(1); SBAR(); GAPA(C0 = __builtin_amdgcn_mfma_f32_32x32x16_bf16(kf[2], qr[1], C0, 0, 0, 0),   P0[10], P0[11], P0[12], P0[13], pw1[0] = PKW(P0, 8), pw1[1] = PKW(P0, 10), pw1); \
    VRD(5); SBAR(); GAPA(C1 = __builtin_amdgcn_mfma_f32_32x32x16_bf16(kf[3], qr[1], C1, 0, 0, 0),   P0[14], P0[15], P1[0], P1[1],   pw1[2] = PKW(P0, 12), pw1[3] = PKW(P0, 14), pw1); \
    VRD(2); SBAR(); GAPA(C0 = __builtin_amdgcn_mfma_f32_32x32x16_bf16(kf[4], qr[2], C0, 0, 0, 0),   P1[2], P1[3], P1[4], P1[5],     pw2[0] = PKW(P1, 0), pw2[1] = PKW(P1, 2), pw2); \
    VRD(6); SBAR(); GAPA(C1 = __builtin_amdgcn_mfma_f32_32x32x16_bf16(kf[5], qr[2], C1, 0, 0, 0),   P1[6], P1[7], P1[8], P1[9],     pw2[2] = PKW(P1, 4), pw2[3] = PKW(P1, 6), pw2); \
    VRD(3); SBAR(); GAPA(C0 = __builtin_amdgcn_mfma_f32_32x32x16_bf16(kf[6], qr[3], C0, 0, 0, 0),   P1[10], P1[11], P1[12], P1[13], pw3[0] = PKW(P1, 8), pw3[1] = PKW(P1, 10), pw3); \
    VRD(7); SBAR(); GAPA(C1 = __builtin_amdgcn_mfma_f32_32x32x16_bf16(kf[7], qr[3], C1, 0, 0, 0),   P1[14], P1[15], 0.f, 0.f,       pw3[2] = PKW(P1, 12), pw3[3] = PKW(P1, 14), pw3); \
    l_reg += sacc; \
    if (GK) { DMA_K((t) + 3, sl_cur); } if (GV) { DMA_V((t) + 1, sl_next); } \
    CMASK(C0, C1, t); \
    { float a = MX3(C0[0], C0[1], C1[0]), b = MX3(C0[2], C0[3], C1[1]); a = MX3(a, C1[2], C1[3]); \
      _Pragma("unroll") for (int r = 4; r < 16; r += 4) { a = MX3(a, C0[r], C0[r + 1]); b = MX3(b, C0[r + 2], C0[r + 3]); a = MX3(a, C1[r], C1[r + 1]); b = MX3(b, C1[r + 2], C1[r + 3]); } \
      float rm = __builtin_fmaxf(a, b); { auto rr = __builtin_amdgcn_permlane32_swap(__float_as_uint(rm), __float_as_uint(rm), false, false); rm = __builtin_fmaxf(__uint_as_float(rr[0]), __uint_as_float(rr[1])); } \
      resc = false; \
      if (__builtin_expect(__any(rm > (float)THRL), 0)) { const float dl = __builtin_fmaxf(rm, 0.f); mhat += dl; \
        _Pragma("unroll") for (int r = 0; r < 16; ++r) { C0[r] -= dl; C1[r] -= dl; } \
        _Pragma("unroll") for (int r = 0; r < 16; ++r) negm[r] = -mhat; asm volatile("" : "+v"(negm)); \
        const float f = __builtin_amdgcn_exp2f(-dl); l_reg *= f; if (hi == 0) wsf[r32] = f; resc = true; } } \
    SBAR(); \
    GAPB(o[0] = __builtin_amdgcn_mfma_f32_32x32x16_bf16(PAF(0), VFR(0), o[0], 0, 0, 0), C0, 0); \
    GAPB(o[1] = __builtin_amdgcn_mfma_f32_32x32x16_bf16(PAF(0), VFR(4), o[1], 0, 0, 0), C0, 4); \
    KRD(GL, 0); GAPB(o[0] = __builtin_amdgcn_mfma_f32_32x32x16_bf16(PAF(1), VFR(1), o[0], 0, 0, 0), C0, 8); \
    KRD(GL, 1); GAPB(o[1] = __builtin_amdgcn_mfma_f32_32x32x16_bf16(PAF(1), VFR(5), o[1], 0, 0, 0), C0, 12); \
    KRD(GL, 2); GAPB(o[0] = __builtin_amdgcn_mfma_f32_32x32x16_bf16(PAF(2), VFR(2), o[0], 0, 0, 0), C1, 0); \
    KRD(GL, 3); GAPB(o[1] = __builtin_amdgcn_mfma_f32_32x32x16_bf16(PAF(2), VFR(6), o[1], 0, 0, 0), C1, 4); \
    GAPB(o[0] = __builtin_amdgcn_mfma_f32_32x32x16_bf16(PAF(3), VFR(3), o[0], 0, 0, 0), C1, 8); \
    GAPB(o[1] = __builtin_amdgcn_mfma_f32_32x32x16_bf16(PAF(3), VFR(7), o[1], 0, 0, 0), C1, 12); \
    } while (0)
    int t = 1;
#undef CMASK
#define CMASK(P0, P1, t) do {} while (0)
    for (; t + 5 < NT; t += 2) {
        STEP(pB0, pB1, pA0, pA1, t, true, true, true);     WAIT_BAR(2); RESC(); ROT();
        STEP(pA0, pA1, pB0, pB1, t + 1, true, true, true); WAIT_BAR(2); RESC(); ROT();
    }
#undef CMASK
#define CMASK(P0, P1, t) do { if (MASK) { int jb_ = (t) - (NT - 4); if (jb_ >= 0) cmask(P0, P1, jb_, wid); } } while (0)
#define ENDW(tt) do { if ((tt) + 3 < NT) { WAIT_BAR(2); } else if ((tt) + 2 < NT) { WAIT_BAR(1); } else { WAIT_BAR(0); } } while (0)
    for (; t + 1 < NT; t += 2) {
        STEP(pB0, pB1, pA0, pA1, t, (t + 3 < NT), (t + 1 < NT), (t + 1 < NT));       ENDW(t);     RESC(); ROT();
        STEP(pA0, pA1, pB0, pB1, t + 1, (t + 4 < NT), (t + 2 < NT), (t + 2 < NT));   ENDW(t + 1); RESC(); ROT();
    }
    STEP(pB0, pB1, pA0, pA1, NT - 1, false, false, false); RESC();
    { float sacc = pB0[0] + pB0[1]; _Pragma("unroll") for (int r = 2; r < 16; ++r) sacc += pB0[r]; _Pragma("unroll") for (int r = 0; r < 16; ++r) sacc += pB1[r]; l_reg += sacc;
      pw0 = (u32x4){PKW(pB0, 0), PKW(pB0, 2), PKW(pB0, 4), PKW(pB0, 6)}; pw1 = (u32x4){PKW(pB0, 8), PKW(pB0, 10), PKW(pB0, 12), PKW(pB0, 14)}; pw2 = (u32x4){PKW(pB1, 0), PKW(pB1, 2), PKW(pB1, 4), PKW(pB1, 6)}; pw3 = (u32x4){PKW(pB1, 8), PKW(pB1, 10), PKW(pB1, 12), PKW(pB1, 14)};
      SBAR(); pv(o, vb0 + sl_cur, PAF(0), PAF(1), PAF(2), PAF(3)); }
#undef PKW
#undef PAF
#undef VFR
#undef PIN
#undef MX3
#undef GAPA
#undef GAPB
#undef EX
#undef VRD
#undef KRD
#undef STEP
#undef ENDW
    { auto rr = __builtin_amdgcn_permlane32_swap(__float_as_uint(l_reg), __float_as_uint(l_reg), false, false); l_reg = __uint_as_float(rr[0]) + __uint_as_float(rr[1]); }
    if (hi == 0) wsf[32 + r32] = l_reg; asm volatile("s_waitcnt lgkmcnt(0)" ::: "memory");
    float rli[16];
#pragma unroll
    for (int r = 0; r < 16; ++r) rli[r] = __builtin_amdgcn_rcpf(wsf[32 + crow(r, hi)]);
    bf16* Ow = Oh + (long)(q0 + wid * QBLK) * op;
    { bf16* stg = (bf16*)(shm + LDS_OST) + wid * 2048;
#pragma unroll
      for (int r = 0; r < 16; ++r) { const int orow = crow(r, hi);
#pragma unroll
        for (int d0 = 0; d0 < 2; ++d0) stg[orow * 64 + d0 * 32 + r32] = __float2bfloat16(o[d0][r] * rli[r]); }
      asm volatile("s_waitcnt lgkmcnt(0)" ::: "memory");
#pragma unroll
      for (int i = 0; i < 4; ++i) { const int row = i * 8 + (lane >> 3), ch = lane & 7; const u32x4 v = *(const u32x4*)(stg + row * 64 + ch * 8); *(u32x4*)(Ow + (long)row * op + ch * 8) = v; } }
    asm volatile("s_waitcnt lgkmcnt(0)\n\ts_barrier" ::: "memory");
#undef DMA_K
#undef DMA_V
#undef CMASK
#undef START
#undef RESC
#undef ROT
}

constexpr int L2_K = 0, L2_V = 3 * 8192, L2_WS = L2_V + 4 * 16384, L2_OST = L2_WS + NW * 64 * 4, L2_BYTES = L2_OST + NW * 4096;
template <bool MASK> __device__ __forceinline__ void attn_unit2(int q0, int NT, const bf16* Qh, int qp, const bf16* __restrict__ Kh, int kp, const bf16* __restrict__ Vh, int vp, bf16* Oh, int op, char* shm) {
    const int tid = threadIdx.x, lane = tid & 63, r32 = lane & 31, hi = lane >> 5; const int wid = __builtin_amdgcn_readfirstlane(tid >> 6);
    const bf16* Qw = Qh + (long)(q0 + wid * QBLK) * qp;
    const unsigned lds0 = (unsigned)(uintptr_t)shm;
    float* wsf = (float*)(shm + L2_WS) + wid * 64;
    const bf16* ksrc = Kh + (long)lane * kp + wid * 8;
    const bf16* vsrc = Vh + (long)(16 * (wid & 3) + (lane >> 2)) * vp + (wid >> 2) * 32 + (lane & 3) * 8;
    const unsigned kdst = lds0 + L2_K + wid * 1024, vdst = lds0 + L2_V + wid * 1024;
#define DMA_K(t, slot) glds16(ksrc + (long)(t) * KVBLK * kp, (unsigned)__builtin_amdgcn_readfirstlane(kdst + (slot)))
#define DMA_V(t, vslot) do { glds16(vsrc + (long)(t) * KVBLK * vp, (unsigned)__builtin_amdgcn_readfirstlane(vdst + (vslot))); \
                            glds16(vsrc + (long)(t) * KVBLK * vp + 64, (unsigned)__builtin_amdgcn_readfirstlane(vdst + (vslot) + 8192)); } while (0)
    const int vb0 = (int)(lds0 + L2_V) + ((lane >> 4) & 1) * 32 + (lane & 3) * 8 + (4 * hi + ((lane & 15) >> 2)) * 64;
    const char* Kbase = shm + L2_K; bf16x8 kf[8];
    const lds_cptr shm3 = (lds_cptr)shm; const lds_cptr kp0 = shm3 + L2_K + hi * 1024 + r32 * 16; const lds_cptr vp0 = shm3 + L2_V + ((lane >> 4) & 1) * 32 + (lane & 3) * 8 + (4 * hi + ((lane & 15) >> 2)) * 64;
    DMA_K(0, 0); DMA_V(0, 0); DMA_K(1, SLOTB);
    bf16x8 qr[4];
#pragma unroll
    for (int d0 = 0; d0 < 4; ++d0) qr[d0] = *reinterpret_cast<const bf16x8*>(&Qw[(long)r32 * qp + d0 * 16 + hi * 8]);
    float l_reg = 0.f; f32x16 o[4]; o[0] = f32x16{}; o[1] = f32x16{}; o[2] = f32x16{}; o[3] = f32x16{};
    const f32x16 zero16 = f32x16{};
#define CMASK(P0, P1, t) do { if (MASK) { int jb_ = (t) - (NT - 4); if (jb_ >= 0) cmask(P0, P1, jb_, wid); } } while (0)
    f32x16 pA0, pA1, pB0, pB1;
    int sl_prev = 0, sl_cur = 0, sl_next = SLOTB;
    int vs_rd = 0, vs_wr = 3 * 16384;
#define ROT() do { sl_prev = sl_cur; sl_cur = sl_next; sl_next = (sl_next == (NSLOT - 1) * SLOTB) ? 0 : sl_next + SLOTB; vs_rd = (vs_rd + 16384) & 65535; vs_wr = (vs_wr + 16384) & 65535; } while (0)
    DMA_K(2, 2 * SLOTB); DMA_V(1, 16384);
    WAIT_BAR(6);
    qkt(pA0, pA1, Kbase, qr, zero16, r32, hi); CMASK(pA0, pA1, 0);
    _Pragma("unroll") for (int r = 0; r < 16; ++r) { pA0[r] = __builtin_amdgcn_exp2f(pA0[r]); pA1[r] = __builtin_amdgcn_exp2f(pA1[r]); }
    WAIT_BAR(2);
    DMA_K(3, 0); DMA_V(2, 2 * 16384);
    sl_prev = sl_cur; sl_cur = sl_next; sl_next = 2 * SLOTB;
    kload8(kf, kp0 + sl_cur);
    WAIT_BAR(5);
    s16x4 f0lo, f0hi, f1lo, f1hi, f2lo, f2hi, f3lo, f3hi; u32x4 pw0, pw1, pw2, pw3;
#define PKW(P, B) cvtpk_s(P[B], P[B + 1])
#define PAF(k) __builtin_bit_cast(bf16x8, pw##k)
#define PIN(x) asm volatile("" : "+v"(x))
#define EX(v) __builtin_amdgcn_exp2f(v)
#define VOFF(id) ((((id) >> 2) * 4096) + (((id) & 3) * 1024))
#define VRD2(F, id) do { F##lo = vtr(vp_ + VOFF(id)); F##hi = vtr(vp_ + VOFF(id) + 512); } while (0)
#define VFR2(F) (bf16x8){F##lo[0], F##lo[1], F##lo[2], F##lo[3], F##hi[0], F##hi[1], F##hi[2], F##hi[3]}
#define GAPA(MF, A0, A1, A2, A3, W0, W1, PW) do { MF; sacc += A0; sacc += A1; sacc += A2; sacc += A3; PIN(sacc); W0; W1; PIN(PW); SBAR(); } while (0)
#define GAPB(MF, RD, X, B) do { MF; RD; X[B] = EX(X[B]); X[B + 1] = EX(X[B + 1]); PIN(X); SBAR(); } while (0)
#define KRD(G, j) do { if (G) { kload2(kf, kp0 + sl_next, j); SBAR(); } } while (0)
#define MF32(a, b, c) __builtin_amdgcn_mfma_f32_32x32x16_bf16(a, b, c, 0, 0, 0)
#define STEP(C0, C1, P0, P1, t, GK, GV, GL) do { SBAR(); __builtin_amdgcn_s_setprio(ATTN_PRIO_A); \
    const lds_cptr vp_ = vp0 + vs_rd; \
    float sacc = (P0[0] + P0[1]); \
    GAPA(C0 = MF32(kf[0], qr[0], zero16), P0[2], P0[3], P0[4], P0[5],     pw0[0] = PKW(P0, 0), pw0[1] = PKW(P0, 2), pw0); \
    GAPA(C1 = MF32(kf[1], qr[0], zero16), P0[6], P0[7], P0[8], P0[9],     pw0[2] = PKW(P0, 4), pw0[3] = PKW(P0, 6), pw0); \
    GAPA(C0 = MF32(kf[2], qr[1], C0),     P0[10], P0[11], P0[12], P0[13], pw1[0] = PKW(P0, 8), pw1[1] = PKW(P0, 10), pw1); \
    GAPA(C1 = MF32(kf[3], qr[1], C1),     P0[14], P0[15], P1[0], P1[1],   pw1[2] = PKW(P0, 12), pw1[3] = PKW(P0, 14), pw1); \
    VRD2(f0, 0); SBAR();  GAPA(C0 = MF32(kf[4], qr[2], C0), P1[2], P1[3], P1[4], P1[5],     pw2[0] = PKW(P1, 0), pw2[1] = PKW(P1, 2), pw2); \
    VRD2(f1, 4); SBAR();  GAPA(C1 = MF32(kf[5], qr[2], C1), P1[6], P1[7], P1[8], P1[9],     pw2[2] = PKW(P1, 4), pw2[3] = PKW(P1, 6), pw2); \
    VRD2(f2, 8); SBAR();  GAPA(C0 = MF32(kf[6], qr[3], C0), P1[10], P1[11], P1[12], P1[13], pw3[0] = PKW(P1, 8), pw3[1] = PKW(P1, 10), pw3); \
    VRD2(f3, 12); SBAR(); GAPA(C1 = MF32(kf[7], qr[3], C1), P1[14], P1[15], 0.f, 0.f,       pw3[2] = PKW(P1, 12), pw3[3] = PKW(P1, 14), pw3); \
    l_reg += sacc; __builtin_amdgcn_s_setprio(0); \
    if (GK) { DMA_K((t) + 3, sl_cur); } if (GV) { DMA_V((t) + 2, vs_wr); } \
    CMASK(C0, C1, t); \
    SBAR(); __builtin_amdgcn_s_setprio(ATTN_PRIO_B); \
    GAPB(o[0] = MF32(PAF(0), VFR2(f0), o[0]), VRD2(f0, 1),  C0, 0); \
    GAPB(o[1] = MF32(PAF(0), VFR2(f1), o[1]), VRD2(f1, 5),  C0, 2); \
    GAPB(o[2] = MF32(PAF(0), VFR2(f2), o[2]), VRD2(f2, 9),  C0, 4); \
    GAPB(o[3] = MF32(PAF(0), VFR2(f3), o[3]), VRD2(f3, 13), C0, 6); \
    KRD(GL, 0); GAPB(o[0] = MF32(PAF(1), VFR2(f0), o[0]), VRD2(f0, 2),  C0, 8); \
    GAPB(o[1] = MF32(PAF(1), VFR2(f1), o[1]), VRD2(f1, 6),  C0, 10); \
    KRD(GL, 1); GAPB(o[2] = MF32(PAF(1), VFR2(f2), o[2]), VRD2(f2, 10), C0, 12); \
    GAPB(o[3] = MF32(PAF(1), VFR2(f3), o[3]), VRD2(f3, 14), C0, 14); \
    KRD(GL, 2); GAPB(o[0] = MF32(PAF(2), VFR2(f0), o[0]), VRD2(f0, 3),  C1, 0); \
    GAPB(o[1] = MF32(PAF(2), VFR2(f1), o[1]), VRD2(f1, 7),  C1, 2); \
    KRD(GL, 3); GAPB(o[2] = MF32(PAF(2), VFR2(f2), o[2]), VRD2(f2, 11), C1, 4); \
    GAPB(o[3] = MF32(PAF(2), VFR2(f3), o[3]), VRD2(f3, 15), C1, 6); \
    GAPB(o[0] = MF32(PAF(3), VFR2(f0), o[0]), (void)0, C1, 8); \
    GAPB(o[1] = MF32(PAF(3), VFR2(f1), o[1]), (void)0, C1, 10); \
    GAPB(o[2] = MF32(PAF(3), VFR2(f2), o[2]), (void)0, C1, 12); \
    GAPB(o[3] = MF32(PAF(3), VFR2(f3), o[3]), (void)0, C1, 14); __builtin_amdgcn_s_setprio(0); \
    } while (0)
    int t = 1;
#undef CMASK
#define CMASK(P0, P1, t) do {} while (0)
    for (; t + 5 < NT; t += 2) {
        STEP(pB0, pB1, pA0, pA1, t, true, true, true);     WAIT_BAR(5); ROT();
        STEP(pA0, pA1, pB0, pB1, t + 1, true, true, true); WAIT_BAR(5); ROT();
    }
#undef CMASK
#define CMASK(P0, P1, t) do { if (MASK) { int jb_ = (t) - (NT - 4); if (jb_ >= 0) cmask(P0, P1, jb_, wid); } } while (0)
#define ENDW(tt) do { if ((tt) + 3 < NT) { WAIT_BAR(5); } else if ((tt) + 2 < NT) { WAIT_BAR(4); } else { WAIT_BAR(0); } } while (0)
    for (; t + 1 < NT; t += 2) {
        STEP(pB0, pB1, pA0, pA1, t, (t + 3 < NT), (t + 2 < NT), (t + 1 < NT));       ENDW(t);     ROT();
        STEP(pA0, pA1, pB0, pB1, t + 1, (t + 4 < NT), (t + 3 < NT), (t + 2 < NT));   ENDW(t + 1); ROT();
    }
    STEP(pB0, pB1, pA0, pA1, NT - 1, false, false, false);
    { float sacc = pB0[0] + pB0[1]; _Pragma("unroll") for (int r = 2; r < 16; ++r) sacc += pB0[r]; _Pragma("unroll") for (int r = 0; r < 16; ++r) sacc += pB1[r]; l_reg += sacc;
      pw0 = (u32x4){PKW(pB0, 0), PKW(pB0, 2), PKW(pB0, 4), PKW(pB0, 6)}; pw1 = (u32x4){PKW(pB0, 8), PKW(pB0, 10), PKW(pB0, 12), PKW(pB0, 14)}; pw2 = (u32x4){PKW(pB1, 0), PKW(pB1, 2), PKW(pB1, 4), PKW(pB1, 6)}; pw3 = (u32x4){PKW(pB1, 8), PKW(pB1, 10), PKW(pB1, 12), PKW(pB1, 14)};
      SBAR();
      const lds_cptr vp_ = vp0 + ((vs_rd + 16384) & 65535);
#pragma unroll
      for (int db = 0; db < 4; ++db) { VRD2(f0, db * 4 + 0); VRD2(f1, db * 4 + 1); VRD2(f2, db * 4 + 2); VRD2(f3, db * 4 + 3);
          o[db] = MF32(PAF(0), VFR2(f0), o[db]); o[db] = MF32(PAF(1), VFR2(f1), o[db]); o[db] = MF32(PAF(2), VFR2(f2), o[db]); o[db] = MF32(PAF(3), VFR2(f3), o[db]); } }
#undef PKW
#undef PAF
#undef PIN
#undef EX
#undef VOFF
#undef VRD2
#undef VFR2
#undef GAPA
#undef GAPB
#undef KRD
#undef MF32
#undef STEP
#undef ENDW
    { auto rr = __builtin_amdgcn_permlane32_swap(__float_as_uint(l_reg), __float_as_uint(l_reg), false, false); l_reg = __uint_as_float(rr[0]) + __uint_as_float(rr[1]); }
    if (hi == 0) wsf[32 + r32] = l_reg; asm volatile("s_waitcnt lgkmcnt(0)" ::: "memory");
    float rli[16];
#pragma unroll
    for (int r = 0; r < 16; ++r) rli[r] = __builtin_amdgcn_rcpf(wsf[32 + crow(r, hi)]);
    bf16* Ow = Oh + (long)(q0 + wid * QBLK) * op;
    { bf16* stg = (bf16*)(shm + L2_OST) + wid * 2048;
#pragma unroll
      for (int dh = 0; dh < 2; ++dh) {
#pragma unroll
        for (int r = 0; r < 16; ++r) { const int orow = crow(r, hi);
#pragma unroll
          for (int d0 = 0; d0 < 2; ++d0) stg[orow * 64 + d0 * 32 + r32] = __float2bfloat16(o[dh * 2 + d0][r] * rli[r]); }
        asm volatile("s_waitcnt lgkmcnt(0)" ::: "memory");
#pragma unroll
        for (int i = 0; i < 4; ++i) { const int row = i * 8 + (lane >> 3), ch = lane & 7; const u32x4 v = *(const u32x4*)(stg + row * 64 + ch * 8); *(u32x4*)(Ow + (long)row * op + dh * 64 + ch * 8) = v; }
        asm volatile("s_waitcnt lgkmcnt(0)" ::: "memory"); } }
    asm volatile("s_waitcnt lgkmcnt(0)\n\ts_barrier" ::: "memory");
#undef DMA_K
#undef DMA_V
#undef CMASK
#undef ROT
}
#undef SBAR
#undef WAIT_BAR
}

#define XB_TMO      128
#define XB_XCNT(j)  (256  + 64 * (j))
#define XB_XSUB(j)  (1280 + 64 * (j))
#define XB_XGEN(j)  (2304 + 64 * (j))
#define XB_TOP      3328
#define XB_TOPGEN   3392
#define XCD_BAR_WORDS 3456
#define XB_SPIN_CAP (1u << 22)
__device__ __forceinline__ unsigned xb_ld(unsigned* p)              { return __hip_atomic_load(p, __ATOMIC_RELAXED, __HIP_MEMORY_SCOPE_AGENT); }
__device__ __forceinline__ unsigned xb_add(unsigned* p, unsigned v) { return __hip_atomic_fetch_add(p, v, __ATOMIC_RELAXED, __HIP_MEMORY_SCOPE_AGENT); }
__device__ __forceinline__ unsigned xb_xcc_id() { return (unsigned)__builtin_amdgcn_s_getreg((3 << 11) | 20) & 0xFu; }
#define XB_SPIN(cond, bar) do { unsigned _sp = 0; while (cond) { __builtin_amdgcn_s_sleep(1); \
    if ((++_sp & 255u) == 0u) { if (xb_ld(&(bar)[XB_TMO])) break; if (_sp > XB_SPIN_CAP) { atomicAdd(&(bar)[XB_TMO], 1u); break; } } } } while (0)
struct XcdBarrier { unsigned* bar; unsigned x; volatile LAS unsigned* st; };
__device__ __forceinline__ XcdBarrier xcd_barrier_post(unsigned* bar, volatile LAS unsigned* st) {
    XcdBarrier b; b.bar = bar; b.x = xb_xcc_id(); b.st = st;
    if (threadIdx.x == 0) (void)xb_add(&bar[XB_XCNT(b.x)], 1u);
    return b;
}
__device__ __forceinline__ void xcd_barrier_complete(unsigned* bar, unsigned x, unsigned& nloc, unsigned& nx) {
    const unsigned G = gridDim.x * gridDim.y * gridDim.z;
    unsigned sum, cnt, mine, sp = 0u;
    for (;;) {
        sum = 0u; cnt = 0u; mine = 0u;
#pragma unroll
        for (unsigned j = 0; j < 16; ++j) { const unsigned c = xb_ld(&bar[XB_XCNT(j)]); sum += c; cnt += (c > 0u) ? 1u : 0u; mine = (j == x) ? c : mine; }
        if (sum == G) break;
        __builtin_amdgcn_s_sleep(1);
        if ((++sp & 255u) == 0u) { if (xb_ld(&bar[XB_TMO])) break; if (sp > XB_SPIN_CAP) { atomicAdd(&bar[XB_TMO], 1u); break; } }
    }
    nloc = mine > 0u ? mine : 1u; nx = cnt > 0u ? cnt : 1u;
}
__device__ __forceinline__ void xcd_barrier(const XcdBarrier& b) {
    asm volatile("s_waitcnt vmcnt(0)" ::: "memory");
    __syncthreads();
    if (threadIdx.x == 0) {
        unsigned* bar = b.bar;
        __builtin_amdgcn_s_waitcnt(0);
        unsigned nloc = b.st[0], nx = b.st[1];
        if (nloc == 0u) { xcd_barrier_complete(bar, b.x, nloc, nx); b.st[0] = nloc; b.st[1] = nx; }
        const unsigned old = xb_add(&bar[XB_XSUB(b.x)], 1u);
        const unsigned gen = old / nloc;
        if (old + 1u == (gen + 1u) * nloc) {
            __builtin_amdgcn_fence(__ATOMIC_RELEASE, "agent");
            asm volatile("s_waitcnt vmcnt(0)" ::: "memory");
            const unsigned og = xb_add(&bar[XB_TOP], 1u);
            const unsigned tg = og / nx;
            if (og + 1u == (tg + 1u) * nx) xb_add(&bar[XB_TOPGEN], 1u);
            else XB_SPIN(xb_ld(&bar[XB_TOPGEN]) == tg, bar);
            __builtin_amdgcn_fence(__ATOMIC_ACQUIRE, "agent");
            xb_add(&bar[XB_XGEN(b.x)], 1u);
            asm volatile("s_waitcnt vmcnt(0)" ::: "memory");
        } else {
            XB_SPIN(xb_ld(&bar[XB_XGEN(b.x)]) == gen, bar);
            __builtin_amdgcn_fence(__ATOMIC_ACQUIRE, "agent");
            asm volatile("s_waitcnt vmcnt(0)" ::: "memory");
        }
    }
    __syncthreads();
}

constexpr int RING_BYTES = 131072;
constexpr int MISC_OFF = RING_BYTES;
constexpr int LDS_BYTES = 147456;
constexpr int NWAVES = 8;

struct Args {
    const float* in[29]; float* out; unsigned char* ws; int ph_lo, ph_hi;
};
enum { I_X = 0, I_MEM, I_NORM1, I_WIN, I_BGATE, I_QN, I_KN, I_LQ1, I_LK1, I_LQ2, I_LK2, I_SUBLN, I_WPOOL, I_PSCALE, I_MEMNORM, I_WMKV, I_MQN, I_MKN, I_WBRD, I_WBRP, I_WBRM, I_WOUT, I_NORM2,
       I_WROUTER, I_BROUTER, I_WGU, I_BGU, I_WD, I_BD };

__device__ __forceinline__ unsigned f2bf(float f) { unsigned u = __builtin_bit_cast(unsigned, f); return (u + 0x7fffu + ((u >> 16) & 1u)) >> 16; }
__device__ __forceinline__ unsigned pk2(float lo, float hi) { return f2bf(lo) | (f2bf(hi) << 16); }
__device__ __forceinline__ void p0_transpose_item(const float* W, int K, int N, bf16_t* WT, LAS float* scr, int item, int lane, int ldo = 0, float qs = 0.f) {
    if (ldo == 0) ldo = K;
    const int nblk = N / 64, kb = item / nblk, nb = item % nblk, k0 = 64 * kb, n0 = 64 * nb;
    const int kr = lane >> 3, n4 = (lane & 7) * 4;
    f32x4 v[16];
#pragma unroll
    for (int i = 0; i < 16; ++i) v[i] = *(const f32x4*)(W + (size_t)(k0 + 8 * (i & 7) + kr) * N + n0 + 32 * (i >> 3) + n4);
#pragma unroll
    for (int h = 0; h < 2; ++h) {
#pragma unroll
        for (int i = 0; i < 8; ++i)
#pragma unroll
            for (int j = 0; j < 4; ++j) scr[(n4 + j) * 68 + 8 * i + kr] = v[h * 8 + i][j];
        LDS_WAIT(); asm volatile("" ::: "memory");
        const int c = lane & 7;
#pragma unroll
        for (int jj = 0; jj < 4; ++jj) { const int nrow = 8 * jj + (lane >> 3); const LAS f32x4* sp = (const LAS f32x4*)(scr + nrow * 68 + 8 * c);
            f32x4 a = sp[0], b = sp[1];
            if (qs != 0.f) { for (int q = 0; q < 4; ++q) { a[q] = fminf(fmaxf(rintf(a[q] * qs), -127.f), 127.f); b[q] = fminf(fmaxf(rintf(b[q] * qs), -127.f), 127.f); } }
            u32x4 o; o.x = pk2(a[0], a[1]); o.y = pk2(a[2], a[3]); o.z = pk2(b[0], b[1]); o.w = pk2(b[2], b[3]);
            *(u32x4*)(WT + (size_t)(n0 + 32 * h + nrow) * ldo + k0 + 8 * c) = o; }
        LDS_WAIT(); asm volatile("" ::: "memory");
    }
}
__device__ __forceinline__ void p0_transpose_item_f8(const float* W, int K, int N, unsigned char* WT, LAS float* scr, int item, int lane) {
    const int nblk = N / 64, kb = item / nblk, nb = item % nblk, k0 = 64 * kb, n0 = 64 * nb;
    const int kr = lane >> 3, n4 = (lane & 7) * 4;
    f32x4 v[16];
#pragma unroll
    for (int i = 0; i < 16; ++i) v[i] = *(const f32x4*)(W + (size_t)(k0 + 8 * (i & 7) + kr) * N + n0 + 32 * (i >> 3) + n4);
#pragma unroll
    for (int h = 0; h < 2; ++h) {
#pragma unroll
        for (int i = 0; i < 8; ++i)
#pragma unroll
            for (int j = 0; j < 4; ++j) scr[(n4 + j) * 68 + 8 * i + kr] = v[h * 8 + i][j];
        LDS_WAIT(); asm volatile("" ::: "memory");
        const int c = lane & 7;
#pragma unroll
        for (int jj = 0; jj < 4; ++jj) { const int nrow = 8 * jj + (lane >> 3); const LAS f32x4* sp = (const LAS f32x4*)(scr + nrow * 68 + 8 * c);
            const f32x4 a = sp[0] * W8_SCALE, b = sp[1] * W8_SCALE;
            u32x2 o; o.x = pk4_fp8(a[0], a[1], a[2], a[3]); o.y = pk4_fp8(b[0], b[1], b[2], b[3]);
            *(u32x2*)(WT + (size_t)(n0 + 32 * h + nrow) * K + k0 + 8 * c) = o; }
        LDS_WAIT(); asm volatile("" ::: "memory");
    }
}
__device__ __forceinline__ void p0_transpose_item_i8(const float* W, int K, int N, unsigned char* WT, LAS float* scr, int item, int lane, float qs) {
    const int nblk = N / 64, kb = item / nblk, nb = item % nblk, k0 = 64 * kb, n0 = 64 * nb;
    const int kr = lane >> 3, n4 = (lane & 7) * 4;
    f32x4 v[16];
#pragma unroll
    for (int i = 0; i < 16; ++i) v[i] = *(const f32x4*)(W + (size_t)(k0 + 8 * (i & 7) + kr) * N + n0 + 32 * (i >> 3) + n4);
#pragma unroll
    for (int h = 0; h < 2; ++h) {
#pragma unroll
        for (int i = 0; i < 8; ++i)
#pragma unroll
            for (int j = 0; j < 4; ++j) scr[(n4 + j) * 68 + 8 * i + kr] = v[h * 8 + i][j];
        LDS_WAIT(); asm volatile("" ::: "memory");
        const int c = lane & 7;
#pragma unroll
        for (int jj = 0; jj < 4; ++jj) { const int nrow = 8 * jj + (lane >> 3); const LAS f32x4* sp = (const LAS f32x4*)(scr + nrow * 68 + 8 * c);
            const f32x4 a = sp[0] * qs, b = sp[1] * qs;
            u32x2 o; o.x = pk4_i8(a[0], a[1], a[2], a[3]); o.y = pk4_i8(b[0], b[1], b[2], b[3]);
            *(u32x2*)(WT + (size_t)(n0 + 32 * h + nrow) * K + k0 + 8 * c) = o; }
        LDS_WAIT(); asm volatile("" ::: "memory");
    }
}
__device__ __forceinline__ void rms_row_to_q(const float* xrow, const float* gain, unsigned char* orow, float* rs, int lane) {
    const f32x4* xr = (const f32x4*)xrow + lane; const f32x4* gr = (const f32x4*)gain + lane;
    f32x4 v[4]; float s = 0.f;
#pragma unroll
    for (int j = 0; j < 4; ++j) { v[j] = xr[64 * j]; s += (v[j].x * v[j].x + v[j].y * v[j].y) + (v[j].z * v[j].z + v[j].w * v[j].w); }
    const float rstd = 1.f / sqrtf(wave_sum(s) * (1.f / 1024.f) + RMS_EPS);
    float am = 0.f;
#pragma unroll
    for (int j = 0; j < 4; ++j) { const f32x4 g = gr[64 * j]; v[j] = v[j] * rstd * g; am = fmaxf(am, fmaxf(fmaxf(fabsf(v[j].x), fabsf(v[j].y)), fmaxf(fabsf(v[j].z), fabsf(v[j].w)))); }
#pragma unroll
    for (int o = 1; o < 64; o <<= 1) am = fmaxf(am, __shfl_xor(am, o));
    am = fmaxf(am, 1e-20f); const float qi = 127.0f / am;
    unsigned* o4 = (unsigned*)orow + lane;
#pragma unroll
    for (int j = 0; j < 4; ++j) o4[64 * j] = pk4_i8(v[j].x * qi, v[j].y * qi, v[j].z * qi, v[j].w * qi);
    if (lane == 0) rs[0] = am * (1.0f / 127.0f);
}
__device__ __forceinline__ void rms_row_to_bf16(const float* xrow, const float* gain, bf16_t* orow, int lane) {
    const f32x4* xr = (const f32x4*)xrow + lane; const f32x4* gr = (const f32x4*)gain + lane;
    f32x4 v[4]; float s = 0.f;
#pragma unroll
    for (int j = 0; j < 4; ++j) { v[j] = xr[64 * j]; s += (v[j].x * v[j].x + v[j].y * v[j].y) + (v[j].z * v[j].z + v[j].w * v[j].w); }
    const float rstd = 1.f / sqrtf(wave_sum(s) * (1.f / 1024.f) + RMS_EPS);
    u32x2* o8 = (u32x2*)orow + lane;
#pragma unroll
    for (int j = 0; j < 4; ++j) { const f32x4 g = gr[64 * j]; u32x2 w; w.x = pk2(v[j].x * rstd * g.x, v[j].y * rstd * g.y); w.y = pk2(v[j].z * rstd * g.z, v[j].w * rstd * g.w); o8[64 * j] = w; }
}

__device__ __forceinline__ void cvt_item64_f8(const float* W, int K, int N, unsigned char* WT, int item, int lane) {
    const int nblk = N / 64, kb = item / nblk, nb = item % nblk, k0 = 64 * kb, n0 = 64 * nb;
    const char* base = (const char*)(W + (size_t)k0 * N + n0);
    unsigned off = (unsigned)lane * 4u; const unsigned rstep = (unsigned)N * 4u;
    float v[64];
#pragma unroll
    for (int j = 0; j < 64; ++j) { v[j] = __builtin_nontemporal_load((const float*)(base + off)); off += rstep; }
    unsigned char* dst = WT + (size_t)(n0 + lane) * K + k0;
#pragma unroll
    for (int c = 0; c < 4; ++c) { u32x4 o;
#pragma unroll
        for (int q = 0; q < 4; ++q) { int r = __builtin_amdgcn_cvt_pk_fp8_f32(v[16 * c + 4 * q] * W8_SCALE, v[16 * c + 4 * q + 1] * W8_SCALE, 0, false);
            r = __builtin_amdgcn_cvt_pk_fp8_f32(v[16 * c + 4 * q + 2] * W8_SCALE, v[16 * c + 4 * q + 3] * W8_SCALE, r, true); o[q] = (unsigned)r; }
        *(u32x4*)(dst + 16 * c) = o; }
}
struct CvtJob {
    const float* wgu; const float* wd; unsigned char* wgu_t; unsigned char* wd_t; int ngw, gw, lane;
    __device__ __forceinline__ void item(int j) const {
        const int it = gw + j * ngw; if (it >= 24576) return;
        const bool gu = it < 16384; const int r = gu ? it : it - 16384, e = gu ? (r >> 9) : (r >> 8), idx = gu ? (r & 511) : (r & 255), N = gu ? 2048 : 1024;
        const float* W = gu ? wgu + (size_t)e * 1024 * 2048 : wd + (size_t)e * 1024 * 1024; unsigned char* WT = gu ? wgu_t + (size_t)e * 2048 * 1024 : wd_t + (size_t)e * 1024 * 1024;
        cvt_item64_f8(W, 1024, N, WT, idx, lane);
    }
};
struct PostCvt { CvtJob J; int jbase, jend; __device__ __forceinline__ void operator()(int ui) const { const int j = jbase + ui; if (j < jend) J.item(j); } };
struct Args;
typedef __attribute__((address_space(4))) const Args* kargs_t;
__device__ __forceinline__ kargs_t kargs() { kargs_t p = (kargs_t)__builtin_amdgcn_kernarg_segment_ptr(); asm volatile("" : "+s"(p)); return p; }
__global__ void __launch_bounds__(NWAVES * 64, 2) fwd_kernel(Args args) {
    extern __shared__ __attribute__((aligned(16))) unsigned char lds_raw[];
    cg::grid_group grid = cg::this_grid();
    LAS unsigned char* lds = (LAS unsigned char*)lds_raw;
    const int tid = threadIdx.x, lane = tid & 63, wave = __builtin_amdgcn_readfirstlane(tid >> 6);
    const int G = gridDim.x, bx = blockIdx.x; const int vcu = (G % 8 == 0) ? (bx % 8) * (G / 8) + bx / 8 : bx;
    const int gw = vcu * NWAVES + wave, NGW = G * NWAVES;
    const int lo = args.ph_lo, hi = args.ph_hi;
    if (tid < 64) ((LAS unsigned*)(lds + MISC_OFF + 1024))[tid] = 0u;
    __syncthreads();
    const XcdBarrier xbar = xcd_barrier_post((unsigned*)(args.ws + WS_CTL) + CW_BAR, (volatile LAS unsigned*)(lds + MISC_OFF + 1024));
#ifndef PHMASK
#define PHMASK 0x3ff
#endif
#define IN(k) (((PHMASK >> (k)) & 1) && lo <= (k) && (k) < hi)
#define GSYNC() do { asm volatile("s_waitcnt vmcnt(0) lgkmcnt(0)" ::: "memory"); __syncthreads(); grid.sync(); asm volatile("s_waitcnt vmcnt(0)" ::: "memory"); __syncthreads(); } while (0)
#define SEAM(k) do { if (lo <= (k) && (k) + 1 < hi) { xcd_barrier(xbar); } } while (0)
#define WSP(TY, off) ((TY*)(ka->ws + (off)))
#define WIN_T WSP(bf16_t, WS_WIN_T)
#define WBRD_T WSP(bf16_t, WS_WBRD_T)
#define WBRP_T WSP(bf16_t, WS_WBRP_T)
#define WBRM_T WSP(bf16_t, WS_WBRM_T)
#define WOUT_T WSP(bf16_t, WS_WOUT_T)
#define WMKV_T WSP(bf16_t, WS_WMKV_T)
#define WGU_T WSP(bf16_t, WS_WGU_T)
#define WD_T WSP(bf16_t, WS_WD_T)
#define XN WSP(bf16_t, WS_XN)
#define Qb WSP(bf16_t, WS_Q)
#define Kb WSP(bf16_t, WS_K)
#define Vb WSP(bf16_t, WS_V)
#define Ub WSP(bf16_t, WS_U)
#define MQb WSP(bf16_t, WS_MQ)
#define OC WSP(bf16_t, WS_OC)
#define GATES WSP(bf16_t, WS_GATES)
#define YCAT WSP(bf16_t, WS_YCAT)
#define MERGF WSP(float, WS_MERGF)
#define MERGB WSP(bf16_t, WS_MERGB)
#define XG WSP(bf16_t, WS_XG)
#define ACT WSP(bf16_t, WS_A)
#define Y4 WSP(bf16_t, WS_B)
#define MEMN WSP(bf16_t, WS_MEMN)
#define MKV WSP(bf16_t, WS_MKV)
#define ROPE WSP(f32x2, WS_ROPE)
#define WR2 WSP(float, WS_WR2)
#define ROUTEW WSP(float, WS_ROUTEW)
#define LAMP WSP(float, WS_LAM)
#define LIST WSP(u32x2, WS_LIST)
#define CNT WSP(unsigned, WS_CTL)
#define OUT (ka->out)
#define KA const kargs_t ka = kargs()

    if (lo > 1000) GSYNC();
    if (IN(0)) for (int rep_ = 0; rep_ < 1 + ((REPEAT_MASK >> 0) & 1); ++rep_) { KA; if (rep_) __syncthreads();
        LAS float* scr = (LAS float*)(lds + wave * 16384);
        constexpr int I0 = 16 * 80, I1 = 8 * 16, I2 = 4 * 16, I3 = 4 * 16, I4 = 16 * 16, I5 = 16 * 8, I6 = 0, I7 = 0;
        constexpr int NITEMS = I0 + I1 + I2 + I3 + I4 + I5 + I6 + I7;
        for (int it = gw; it < NITEMS; it += NGW) {
            int r = it;
            if (r < I0) { p0_transpose_item_i8(ka->in[I_WIN], 1024, 5120, (unsigned char*)WIN_T, scr, r, lane, WQ_IN); continue; } r -= I0;
            if (r < I1) { p0_transpose_item(ka->in[I_WBRD], 512, 1024, WBRD_T, scr, r, lane, 1024); continue; } r -= I1;
            if (r < I2) { p0_transpose_item(ka->in[I_WBRP], 256, 1024, WBRD_T + 512, scr, r, lane, 1024); continue; } r -= I2;
            if (r < I3) { p0_transpose_item(ka->in[I_WBRM], 256, 1024, WBRD_T + 768, scr, r, lane, 1024); continue; } r -= I3;
            if (r < I4) { p0_transpose_item(ka->in[I_WOUT], 1024, 1024, WOUT_T, scr, r, lane); continue; } r -= I4;
            p0_transpose_item(ka->in[I_WMKV], 1024, 512, WMKV_T, scr, r, lane);
        }
        for (int m = gw; m < T; m += NGW) rms_row_to_q(ka->in[I_X] + (size_t)m * 1024, ka->in[I_NORM1], (unsigned char*)XN + (size_t)m * 1024, WSP(float, WS_MERGF) + m, lane);
        for (int m = gw; m < BATCH * MEMLEN; m += NGW) rms_row_to_bf16(ka->in[I_MEM] + (size_t)m * 1024, ka->in[I_MEMNORM], MEMN + (size_t)m * 1024, lane);
        for (int i = bx * 512 + tid; i < SEQ * 32; i += G * 512) { const int pos = i >> 5, j = i & 31;
            const float inv = 1.0f / powf(10000.0f, (float)(2 * j) / 64.0f); const float ang = (float)pos * inv;
            const double a = (double)ang; const double k = rint(a * 0.15915494309189535); const float red = (float)(a - k * 6.283185307179586);
            ROPE[i] = (f32x2){cosf(red), sinf(red)}; }
        for (int i = bx * 512 + tid; i < 1024 * 32; i += G * 512) { const int ii = i & 3, e = (i >> 2) & 15, kq = (i >> 6) & 3, eb = (i >> 8) & 1, s = i >> 9; const int k = 16 * s + 4 * kq + ii;
            WR2[i] = ka->in[I_NORM2][k] * ka->in[I_WROUTER][k * 32 + eb * 16 + e]; }
        if (bx == 0 && wave == 0) { const float s1 = wave_sum(ka->in[I_LQ1][lane] * ka->in[I_LK1][lane]), s2 = wave_sum(ka->in[I_LQ2][lane] * ka->in[I_LK2][lane]);
            if (lane == 0) LAMP[0] = expf(s1) - expf(s2) + 0.2f; }
    }
    SEAM(0);
    if (IN(1)) for (int rep_ = 0; rep_ < 1 + ((REPEAT_MASK >> 1) & 1); ++rep_) { KA; if (rep_) __syncthreads();
#if defined(TAP) && TAP == 6
        { pg8::DenseProb P{XN, WIN_T, 1024, 1024, 1024}; pg8::StaticOrder S; S.init(T, INW, G, bx);
          pg8::EpiPlain E{WSP(bf16_t, WS_B), 5120};
          pg8::gemm_phase<pg8::EpiPlain, pg8::DenseProb, pg8::StaticOrder, true>(lds, P, S, E); }
#else
        const CvtJob J{ka->in[I_WGU], ka->in[I_WD], (unsigned char*)WGU_T, (unsigned char*)WD_T, NGW, gw, lane};
        const int kpre = bx & 7;
        for (int j = 0; j < kpre; ++j) J.item(j);
        { pg8::DenseProbI8 P{(const unsigned char*)XN, (const unsigned char*)WIN_T, 1024, 1024, 1024}; pg8::StaticOrder S0; S0.init(T, INW, G, bx); const pg8::TableOrder S = pg8::build_unit_table(S0, (LAS int*)(lds + MISC_OFF + 2048));
          pg8::EpiInProj E{Qb, Kb, Vb, Ub, MQb, GATES, ka->in[I_QN], ka->in[I_KN], ka->in[I_MQN], ka->in[I_BGATE], ROPE, WSP(float, WS_MERGF)};
          const PostCvt PU{J, kpre, 12};
          pg8::gemm_phase<pg8::EpiInProj, pg8::DenseProbI8, pg8::TableOrder, ALIGN_EPI_SEL, PostCvt>(lds, P, S, E, PU); }
        for (int j = kpre + 10; j < 12; ++j) J.item(j);
#endif
        for (int tile = bx; tile < 256; tile += G) {
            const int rt = tile >> 3, ct = tile & 7, r32 = lane & 31, hh = lane >> 5;
            const bf16_t* ap = MEMN + (size_t)(32 * rt + r32) * 1024 + 128 * wave + 8 * hh; const bf16_t* bp = WMKV_T + (size_t)(64 * ct + r32) * 1024 + 128 * wave + 8 * hh;
            bf16x8 af[8], b0[8], b1[8];
#pragma unroll
            for (int ks = 0; ks < 8; ++ks) { af[ks] = *(const bf16x8*)(ap + 16 * ks); b0[ks] = *(const bf16x8*)(bp + 16 * ks); b1[ks] = *(const bf16x8*)(bp + 32 * 1024 + 16 * ks); }
            f32x16 c0 = f32x16{}, c1 = f32x16{};
#pragma unroll
            for (int ks = 0; ks < 8; ++ks) { c0 = __builtin_amdgcn_mfma_f32_32x32x16_bf16(af[ks], b0[ks], c0, 0, 0, 0); c1 = __builtin_amdgcn_mfma_f32_32x32x16_bf16(af[ks], b1[ks], c1, 0, 0, 0); }
            LAS float* part = (LAS float*)lds;
            __syncthreads();
#pragma unroll
            for (int r = 0; r < 16; ++r) { const int row = (r & 3) + 8 * (r >> 2) + 4 * hh; part[(wave * 32 + row) * 64 + r32] = c0[r]; part[(wave * 32 + row) * 64 + 32 + r32] = c1[r]; }
            __syncthreads();
            const int row = tid >> 4, c4 = (tid & 15) * 4; f32x4 a = {0.f, 0.f, 0.f, 0.f};
#pragma unroll
            for (int w = 0; w < 8; ++w) a += *(const LAS f32x4*)(part + (w * 32 + row) * 64 + c4);
            if (ct < 4) {
                float ss = (a[0] * a[0] + a[1] * a[1]) + (a[2] * a[2] + a[3] * a[3]);
                ss += __shfl_xor(ss, 1); ss += __shfl_xor(ss, 2); ss += __shfl_xor(ss, 4); ss += __shfl_xor(ss, 8);
                const float rstd = 1.0f / sqrtf(ss * (1.0f / 64.0f) + RMS_EPS); const f32x4 g = *(const f32x4*)(ka->in[I_MKN] + c4); a = a * rstd * g; }
            u32x2 o; o.x = cvt_pk_bf16(a[0], a[1]); o.y = cvt_pk_bf16(a[2], a[3]);
            *(u32x2*)(MKV + (size_t)(32 * rt + row) * 512 + 64 * ct + c4) = o;
        }
        __syncthreads();
    }
    SEAM(1);
    if (IN(2)) for (int rep_ = 0; rep_ < 1 + ((REPEAT_MASK >> 2) & 1); ++rep_) { KA; if (rep_) __syncthreads();
        using abf = attn_body::bf16;
        {
            const int bh = vcu >> 4, b = bh >> 2, h = bh & 3, s = vcu & 15; const size_t rb = (size_t)b * SEQ;
            const float lam = LAMP[0];
            for (int i2 = 0; i2 < 4 * (1 + ((REPEAT_MASK >> 10) & 1)); ++i2) { const int ii = i2 & 3, c = ii & 1; const int qb = (ii < 2) ? s : 31 - s;
                attn_body::attn_unit2<true>(qb * 256, 4 * qb + 4, (const abf*)Qb + rb * 512 + (c * 4 + h) * 64, 512, (const abf*)Kb + rb * 512 + (c * 4 + h) * 64, 512,
                                            (const abf*)Vb + rb * 512 + h * 128, 512, (abf*)OC + rb * 1024 + (c * 4 + h) * 128, 1024, (char*)lds_raw);
                if (c == 1) {
                    asm volatile("s_waitcnt vmcnt(0)" ::: "memory");
#pragma unroll
                    for (int ps = 0; ps < 2; ++ps) {
                    const int row = ps * 16 + (lane >> 2), dq = (lane & 3) * 32; const size_t t = rb + (size_t)qb * 256 + wave * 32 + row;
                    const bf16_t* p0 = OC + t * 1024 + h * 128 + dq; const bf16_t* p1 = p0 + 512;
                    u32x4 a[4], bb[4];
#pragma unroll
                    for (int j = 0; j < 4; ++j) { a[j] = *(const u32x4*)(p0 + 8 * j); bb[j] = *(const u32x4*)(p1 + 8 * j); }
                    float ss = 0.f; f32x4 y[4][2];
#pragma unroll
                    for (int j = 0; j < 4; ++j) {
                        y[j][0] = (f32x4){bf_lo(a[j].x) - lam * bf_lo(bb[j].x), bf_hi(a[j].x) - lam * bf_hi(bb[j].x), bf_lo(a[j].y) - lam * bf_lo(bb[j].y), bf_hi(a[j].y) - lam * bf_hi(bb[j].y)};
                        y[j][1] = (f32x4){bf_lo(a[j].z) - lam * bf_lo(bb[j].z), bf_hi(a[j].z) - lam * bf_hi(bb[j].z), bf_lo(a[j].w) - lam * bf_lo(bb[j].w), bf_hi(a[j].w) - lam * bf_hi(bb[j].w)};
#pragma unroll
                        for (int q = 0; q < 4; ++q) ss += y[j][0][q] * y[j][0][q] + y[j][1][q] * y[j][1][q]; }
                    ss += __shfl_xor(ss, 1); ss += __shfl_xor(ss, 2);
                    const float rstd = 0.8f / sqrtf(ss * (1.0f / 128.0f) + RMS_EPS);
                    const float* sg = ka->in[I_SUBLN] + dq; bf16_t* yo = YCAT + t * 1024 + h * 128 + dq;
#pragma unroll
                    for (int j = 0; j < 4; ++j) { const f32x4 s0 = *(const f32x4*)(sg + 8 * j), s1 = *(const f32x4*)(sg + 8 * j + 4); pg8::store8(yo + 8 * j, y[j][0] * rstd * s0, y[j][1] * rstd * s1); }
                    }
                }
            }
        }
        {
            for (int i = 0; i < 2; ++i) { const int idx = vcu * 2 + i; if (idx >= 512) break; const int b = idx >> 7, h = (idx >> 5) & 3, qb = idx & 31;
                attn_body::attn_unit<8, false>(qb * 256, 4, (const abf*)MQb + (size_t)b * SEQ * 256 + h * 64, 256, (const abf*)MKV + (size_t)b * MEMLEN * 512 + h * 64, 512,
                                               (const abf*)MKV + (size_t)b * MEMLEN * 512 + 256 + h * 64, 512, (abf*)YCAT + (size_t)b * SEQ * 1024 + 768 + h * 64, 1024, (char*)lds_raw); }
        }
        {
            LAS bf16_t* ul = (LAS bf16_t*)lds;
            LAS bf16_t* pb = (LAS bf16_t*)(lds + 24576);
            const int col = tid & 255, half = tid >> 8, w = 2 << (col >> 6);
            const int mg = wave & 3, mdh = wave >> 2, r32 = lane & 31, hh = lane >> 5;
            bf16x8 bw[4];
#pragma unroll
            for (int sx = 0; sx < 4; ++sx) { const float* wp = ka->in[I_WPOOL] + (size_t)(mg * 64 + 16 * sx + 8 * hh) * 64 + mdh * 32 + r32;
                u32x4 pk; pk.x = pk2(wp[0], wp[64]); pk.y = pk2(wp[128], wp[192]); pk.z = pk2(wp[256], wp[320]); pk.w = pk2(wp[384], wp[448]); bw[sx] = __builtin_bit_cast(bf16x8, pk); }
            const int ocol = mg * 64 + mdh * 32 + r32; const float psc = ka->in[I_PSCALE][ocol];
            u32x4 pre[3];
#define POOL_LOAD(tl) do { const int t0_ = (tl) * 32, p0_ = t0_ & (SEQ - 1); _Pragma("unroll") for (int k_ = 0; k_ < 3; ++k_) { const int pc = tid + 512 * k_, r = pc >> 5, ch = pc & 31; \
                pre[k_] = (u32x4){0u, 0u, 0u, 0u}; if (pc < 47 * 32 && p0_ - 15 + r >= 0) pre[k_] = *(const u32x4*)(Ub + (size_t)(t0_ - 15 + r) * 256 + ch * 8); } } while (0)
            if (vcu < T / 32) POOL_LOAD(vcu);
            for (int tile = vcu; tile < T / 32; tile += G) {
                const int t0 = tile * 32, p0 = t0 & (SEQ - 1);
                __syncthreads();
#pragma unroll
                for (int k = 0; k < 3; ++k) { const int pc = tid + 512 * k, r = pc >> 5, ch = pc & 31; if (pc < 47 * 32) *(LAS u32x4*)(ul + r * 256 + ch * 8) = pre[k]; }
                if (tile + G < T / 32) POOL_LOAD(tile + G);
                __syncthreads();
                {
                    float sum = 0.f; const int rbase = 15 + 16 * half;
                    for (int i = 1; i < w; ++i) sum += __uint_as_float((unsigned)ul[(rbase - i) * 256 + col] << 16);
#pragma unroll
                    for (int tk = 0; tk < 16; ++tk) { const float ucur = __uint_as_float((unsigned)ul[(rbase + tk) * 256 + col] << 16); sum += ucur;
                        const int pos = p0 + 16 * half + tk; const float cnt = (float)((pos + 1 < w) ? pos + 1 : w);
                        pb[(16 * half + tk) * 264 + col] = (bf16_t)f2bf(sum / cnt - ucur);
                        sum -= __uint_as_float((unsigned)ul[(rbase + tk - (w - 1)) * 256 + col] << 16); }
                }
                __syncthreads();
                f32x16 acc = f32x16{};
#pragma unroll
                for (int sx = 0; sx < 4; ++sx) { const bf16x8 af = *(const LAS bf16x8*)(pb + r32 * 264 + mg * 64 + 16 * sx + 8 * hh);
                    acc = __builtin_amdgcn_mfma_f32_32x32x16_bf16(af, bw[sx], acc, 0, 0, 0); }
#pragma unroll
                for (int r = 0; r < 16; ++r) { const int tok = t0 + (r & 3) + 8 * (r >> 2) + 4 * hh; YCAT[(size_t)tok * 1024 + 512 + ocol] = (bf16_t)f2bf(acc[r] * psc); }
            }
            __syncthreads();
        }
    }
    SEAM(2);
    if (IN(4)) for (int rep_ = 0; rep_ < 1 + ((REPEAT_MASK >> 4) & 1); ++rep_) { KA; if (rep_) __syncthreads();
        pg8::StaticOrder S0; S0.init(T, 1024, G, bx); const pg8::TableOrder S = pg8::build_unit_table(S0, (LAS int*)(lds + MISC_OFF + 2048));
        pg8::DenseProb P{YCAT, WBRD_T, 1024, 1024, 1024}; pg8::EpiMergeR E{GATES, MERGB};
        pg8::gemm_phase<pg8::EpiMergeR, pg8::DenseProb, pg8::TableOrder, ALIGN_EPI_SEL>(lds, P, S, E);
    }
    SEAM(4);
    if (IN(5)) for (int rep_ = 0; rep_ < 1 + ((REPEAT_MASK >> 5) & 1); ++rep_) { KA; if (rep_) __syncthreads();
        pg8::DenseProb P{MERGB, WOUT_T, 1024, 1024, 1024}; pg8::StaticOrder S0; S0.init(T, 1024, G, bx); const pg8::TableOrder S = pg8::build_unit_table(S0, (LAS int*)(lds + MISC_OFF + 2048));
        pg8::EpiWout E{ka->in[I_X], OUT, (unsigned char*)XG, ka->in[I_NORM2]};
        pg8::gemm_phase<pg8::EpiWout, pg8::DenseProb, pg8::TableOrder, ALIGN_EPI_SEL>(lds, P, S, E);
    }
    SEAM(5);
    if (IN(6)) { KA;
        LAS int* lcnt = (LAS int*)(lds + MISC_OFF); LAS int* lbase = lcnt + 32;
        const int ngroups = T / 16, rounds = (ngroups + NGW - 1) / NGW;
        for (int rd = 0; rd < rounds; ++rd) {
            const int grp = rd * NGW + gw; const bool valid = grp < ngroups;
            if (tid < 32) lcnt[tid] = 0;
            __syncthreads();
            int e_sel = 0, rank = 0; float w_sel = 0.f, rstd = 0.f; const int q = lane >> 4, tok = grp * 16 + (lane & 15);
            if (valid) {
                f32x4 d0 = {0.f, 0.f, 0.f, 0.f}, d1 = {0.f, 0.f, 0.f, 0.f}; float ss = 0.f;
                const float* xrow = OUT + (size_t)tok * 1024 + 4 * q; const f32x4* wr2 = (const f32x4*)WR2 + lane;
#pragma unroll 8
                for (int s = 0; s < 64; ++s) { const f32x4 xv = *(const f32x4*)(xrow + 16 * s); const f32x4 wa = wr2[(s * 2) * 64], wb = wr2[(s * 2 + 1) * 64];
                    ss += (xv[0] * xv[0] + xv[1] * xv[1]) + (xv[2] * xv[2] + xv[3] * xv[3]);
#pragma unroll
                    for (int j = 0; j < 4; ++j) { d0 = __builtin_amdgcn_mfma_f32_16x16x4f32(wa[j], xv[j], d0, 0, 0, 0); d1 = __builtin_amdgcn_mfma_f32_16x16x4f32(wb[j], xv[j], d1, 0, 0, 0); } }
                ss += __shfl_xor(ss, 16); ss += __shfl_xor(ss, 32);
                rstd = 1.0f / sqrtf(ss * (1.0f / 1024.f) + RMS_EPS);
                unsigned key[8];
#pragma unroll
                for (int r = 0; r < 8; ++r) { const int e = (r >> 2) * 16 + 4 * q + (r & 3); const float lg = ((r < 4) ? d0[r & 3] : d1[r & 3]) * rstd + ka->in[I_BROUTER][e];
                    unsigned u = __float_as_uint(lg); u ^= (u >> 31) ? 0xffffffffu : 0x80000000u; key[r] = (u & ~31u) | (unsigned)(31 - e); }
                unsigned win[4];
#pragma unroll
                for (int r = 0; r < 4; ++r) { unsigned m = key[0];
#pragma unroll
                    for (int j = 1; j < 8; ++j) m = m > key[j] ? m : key[j];
                    unsigned o = (unsigned)__shfl_xor((int)m, 16); m = m > o ? m : o; o = (unsigned)__shfl_xor((int)m, 32); m = m > o ? m : o; win[r] = m;
#pragma unroll
                    for (int j = 0; j < 8; ++j) key[j] = (key[j] == m) ? 0u : key[j]; }
                float val[4];
#pragma unroll
                for (int r = 0; r < 4; ++r) { unsigned u = win[r] & ~31u; u ^= (u >> 31) ? 0x80000000u : 0xffffffffu; val[r] = __uint_as_float(u); }
                const float p1 = expf(val[1] - val[0]), p2 = expf(val[2] - val[0]), p3 = expf(val[3] - val[0]); const float inv = 1.0f / (1.0f + p1 + p2 + p3);
                const unsigned wk = (q == 0) ? win[0] : (q == 1) ? win[1] : (q == 2) ? win[2] : win[3];
                w_sel = ((q == 0) ? 1.0f : (q == 1) ? p1 : (q == 2) ? p2 : p3) * inv; e_sel = 31 - (int)(wk & 31u);
                rank = __hip_atomic_fetch_add((int*)(lcnt + e_sel), 1, __ATOMIC_RELAXED, __HIP_MEMORY_SCOPE_WORKGROUP);
            }
            __syncthreads();
            if (tid < 32) lbase[tid] = (int)__hip_atomic_fetch_add(CNT + 64 * tid, (unsigned)lcnt[tid], __ATOMIC_RELAXED, __HIP_MEMORY_SCOPE_AGENT);
            __syncthreads();
            if (valid) { const int pos = lbase[e_sel] + rank; LIST[(size_t)e_sel * CAP + pos] = (u32x2){(unsigned)(tok * 4 + q), __float_as_uint(rstd)}; ROUTEW[tok * 4 + q] = w_sel; }
            __syncthreads();
        }
    }
    SEAM(6);
    if (IN(7) || IN(8)) { KA;
        LAS int* tp = (LAS int*)(lds + MISC_OFF + 256); LAS int* cn = tp + 40;
        if (tid < 64) {
            const int e = tid & 31; const int c = (int)__hip_atomic_load(CNT + 64 * e, __ATOMIC_RELAXED, __HIP_MEMORY_SCOPE_AGENT); const int tiles = (c + 255) >> 8; int x = tiles;
#pragma unroll
            for (int o = 1; o < 32; o <<= 1) { const int y = __shfl_up(x, o, 32); if (e >= o) x += y; }
            if (tid < 32) { cn[e] = c; tp[e] = x - tiles; if (e == 31) tp[NEXP] = x; } }
        __syncthreads();
        if (IN(7)) for (int rep_ = 0; rep_ < 1 + ((REPEAT_MASK >> 7) & 1); ++rep_) {
            pg8::GuProb P{(const unsigned char*)XG, (const unsigned char*)WGU_T, LIST, 1024, 1024, 1024}; pg8::GroupedOrder S0{tp, cn, 8, G, bx}; const pg8::TableOrder S = pg8::build_unit_table(S0, (LAS int*)(lds + MISC_OFF + 2048));
            pg8::EpiSwiglu E{(unsigned char*)ACT, LIST, ka->in[I_BGU], lds + MISC_OFF + 4096};
            pg8::gemm_phase<pg8::EpiSwiglu, pg8::GuProb, pg8::TableOrder, ALIGN_EPI_SEL>(lds, P, S, E);
        }
        SEAM(7);
        if (IN(8)) for (int rep_ = 0; rep_ < 1 + ((REPEAT_MASK >> 8) & 1); ++rep_) {
            pg8::DownProb P{(const unsigned char*)ACT, (const unsigned char*)WD_T, 1024, 1024, 1024}; pg8::GroupedOrder S0{tp, cn, 4, G, bx}; const pg8::TableOrder S = pg8::build_unit_table(S0, (LAS int*)(lds + MISC_OFF + 2048));
            pg8::EpiDown E{(unsigned char*)Y4, LIST, ka->in[I_BD], lds + MISC_OFF + 4096};
            pg8::gemm_phase<pg8::EpiDown, pg8::DownProb, pg8::TableOrder, ALIGN_EPI_SEL>(lds, P, S, E);
        }
    }
    SEAM(8);
    if (IN(9)) { KA;
        for (int i = bx * 512 + tid; i < T * 128; i += G * 512) { const int tok = i >> 7, c8 = (i & 127) * 8;
            const f32x4 w = *(const f32x4*)(ROUTEW + tok * 4); float* op = OUT + (size_t)tok * 1024 + c8;
            f32x4 o0 = *(const f32x4*)op, o1 = *(const f32x4*)(op + 4);
#pragma unroll
            for (int k = 0; k < 4; ++k) { const u32x2 y = *(const u32x2*)((const unsigned char*)Y4 + ((size_t)tok * 4 + k) * 1024 + c8); const float wk = w[k] * (1.0f / Y8_SCALE);
                const f32x2 p0 = __builtin_amdgcn_cvt_pk_f32_fp8((int)y.x, false), p1 = __builtin_amdgcn_cvt_pk_f32_fp8((int)y.x, true), p2 = __builtin_amdgcn_cvt_pk_f32_fp8((int)y.y, false), p3 = __builtin_amdgcn_cvt_pk_f32_fp8((int)y.y, true);
                o0[0] += wk * p0[0]; o0[1] += wk * p0[1]; o0[2] += wk * p1[0]; o0[3] += wk * p1[1];
                o1[0] += wk * p2[0]; o1[1] += wk * p2[1]; o1[2] += wk * p3[0]; o1[3] += wk * p3[1]; }
            *(f32x4*)op = o0; *(f32x4*)(op + 4) = o1; }
    }
#ifdef TAP
    if (lo <= 10 && 10 < hi) { KA; GSYNC();
        for (int i = bx * 512 + tid; i < T * 1024; i += G * 512) { const int t = i >> 10, c = i & 1023; float v = 0.f;
#define BFV(buf, pitch, col) __uint_as_float((unsigned)(buf)[(size_t)t * (pitch) + (col)] << 16)
            if (TAP == 1) v = BFV(Qb, 512, c & 511) + 2.f * BFV(Kb, 512, c & 511) + 4.f * BFV(Vb, 512, c & 511) + 8.f * BFV(Ub, 256, c & 255) + 16.f * BFV(MQb, 256, c & 255)
                            + 32.f * BFV(GATES, 3072, c) + 64.f * BFV(GATES, 3072, 1024 + c) + 128.f * BFV(GATES, 3072, 2048 + c);
            if (TAP == 2) v = BFV(OC, 1024, c) + 2.f * BFV(YCAT, 1024, c);
            if (TAP == 3) v = BFV(MERGB, 1024, c);
            if (TAP == 4) v = BFV(XN, 1024, c);
            if (TAP == 6) { const bf16_t* z = WSP(bf16_t, WS_B) + (size_t)t * 5120 + c; v = __uint_as_float((unsigned)z[0] << 16) + 2.f * __uint_as_float((unsigned)z[1024] << 16) + 4.f * __uint_as_float((unsigned)z[2048] << 16) + 8.f * __uint_as_float((unsigned)z[3072] << 16) + 16.f * __uint_as_float((unsigned)z[4096] << 16); }
            if (TAP == 5) { const bf16_t* wt = WIN_T; const int tt = t % 5120; v = __uint_as_float((unsigned)wt[(size_t)tt * 1024 + c] << 16) + ROPE[(t & 8191) * 32 + (c & 31)].x + 2.f * ROPE[(t & 8191) * 32 + (c & 31)].y; }
            OUT[i] = v; }
    }
#endif
#undef IN
#undef SEAM
}

extern "C" void kernel_launch(void* const* d_in, const int* in_sizes, int n_in, void* d_out, int out_size, void* d_ws, size_t ws_size, hipStream_t stream) {
    static int grid = 0;
    if (grid == 0) {
        if (n_in != 29 || in_sizes[0] != T * DMODEL || out_size != T * DMODEL || ws_size < WS_END) {
            fprintf(stderr, "kernel_launch: unexpected shapes: n_in %d in0 %d out %d ws %zu (need %zu)\n", n_in, n_in > 0 ? in_sizes[0] : -1, out_size, ws_size, (size_t)WS_END); grid = -1; return; }
        int dev = 0, cus = 0, per_cu = 0;
        (void)hipGetDevice(&dev); (void)hipDeviceGetAttribute(&cus, hipDeviceAttributeMultiprocessorCount, dev);
        (void)hipFuncSetAttribute((const void*)fwd_kernel, hipFuncAttributeMaxDynamicSharedMemorySize, LDS_BYTES);
        (void)hipOccupancyMaxActiveBlocksPerMultiprocessor(&per_cu, (const void*)fwd_kernel, NWAVES * 64, LDS_BYTES);
        (void)hipGetLastError();
        grid = cus;
        fprintf(stderr, "kernel_launch: cus %d occupancy %d/CU grid %d\n", cus, per_cu, grid);
        if (per_cu < 1) fprintf(stderr, "kernel_launch: occupancy query says the kernel does not fit\n");
    }
    if (grid < 0) return;
    (void)hipMemsetAsync((char*)d_ws + WS_CTL, 0, CTL_ZERO_BYTES, stream);
    Args a{};
    for (int i = 0; i < 29; ++i) a.in[i] = (const float*)d_in[i];
    a.out = (float*)d_out; a.ws = (unsigned char*)d_ws; a.ph_lo = 0; a.ph_hi = PH_HI;
    void* args[] = {&a};
    hipError_t e = hipLaunchCooperativeKernel((const void*)fwd_kernel, dim3(grid), dim3(NWAVES * 64), args, LDS_BYTES, stream);
    if (e != hipSuccess) fprintf(stderr, "cooperative launch failed: %s (grid %d)\n", hipGetErrorString(e), grid);
}
```

```cpp
#include <hip/hip_runtime.h>
#include <hip/hip_cooperative_groups.h>
#include <hip/hip_bf16.h>
#include <cstdio>
#include <cstdint>
#include <cmath>
namespace cg = cooperative_groups;

#define LAS __attribute__((address_space(3)))
#define GAS __attribute__((address_space(1)))
typedef unsigned short bf16_t;
typedef short bf16x8 __attribute__((ext_vector_type(8)));
typedef float f32x4 __attribute__((ext_vector_type(4)));
typedef float f32x2 __attribute__((ext_vector_type(2)));
typedef float f32x16 __attribute__((ext_vector_type(16)));
typedef unsigned u32x4 __attribute__((ext_vector_type(4)));
typedef unsigned u32x2 __attribute__((ext_vector_type(2)));

#define PH_HI 10
#define ALIGN_EPI_SEL true
#define F8MODE 2
#define USE_SETPRIO 1
#define ATTN_PRIO_A 1
#define ATTN_PRIO_B 1
#ifndef PHMASK
#define PHMASK 0x3ff
#endif
#define CVT_NB2 4
#define REPEAT_MASK 0x000
constexpr int BATCH = 4, SEQ = 8192, DMODEL = 1024, T = BATCH * SEQ, INW = 5120, NEXP = 32, MEMLEN = 256;
constexpr float RMS_EPS = 1e-6f;
constexpr float C2 = 0.125f * 1.4426950408889634f;
constexpr int CAP = T;

constexpr size_t MiB = 1u << 20;
constexpr size_t WS_CTL = 0, CTL_ZERO_BYTES = 32768;
constexpr int CW_BAR = 4096;
constexpr size_t WS_ROUTEW = 1 * MiB;
constexpr size_t WS_LAM = 1 * MiB + 768 * 1024;
constexpr size_t WS_ROPE = 2 * MiB;
constexpr size_t WS_WR2 = 4 * MiB;
constexpr size_t WS_MEMN = 5 * MiB;
constexpr size_t WS_MKV = 7 * MiB;
constexpr size_t WS_WIN_T = 8 * MiB;
constexpr size_t WS_WBRD_T = 18 * MiB;
constexpr size_t WS_WBRP_T = 19 * MiB;
constexpr size_t WS_WBRM_T = 19 * MiB + 512 * 1024;
constexpr size_t WS_WOUT_T = 20 * MiB;
constexpr size_t WS_WMKV_T = 22 * MiB;
constexpr size_t WS_WGU_T = 24 * MiB;
constexpr size_t WS_WD_T = 152 * MiB;
constexpr size_t WS_A = 216 * MiB;
constexpr size_t WS_XN = WS_A;
constexpr size_t WS_Q = WS_A + 64 * MiB, WS_K = WS_A + 96 * MiB, WS_V = WS_A + 128 * MiB;
constexpr size_t WS_U = WS_A + 160 * MiB, WS_MQ = WS_A + 176 * MiB;
constexpr size_t WS_OC = WS_A + 192 * MiB;
constexpr size_t WS_B = 488 * MiB;
constexpr size_t WS_GATES = WS_B;
constexpr size_t WS_YCAT = WS_B + 192 * MiB;
constexpr size_t WS_MERGF = 760 * MiB;
constexpr size_t WS_MERGB = 888 * MiB;
constexpr size_t WS_XG = 952 * MiB;
constexpr size_t WS_LIST = 1016 * MiB;
constexpr size_t WS_END = 1024 * MiB;

typedef __bf16 bf16x2_v __attribute__((ext_vector_type(2)));
__device__ __forceinline__ unsigned cvt_pk_bf16(float lo, float hi) { f32x2 v = {lo, hi}; bf16x2_v b = __builtin_convertvector(v, bf16x2_v); return __builtin_bit_cast(unsigned, b); }
__device__ __forceinline__ unsigned pk4_fp8(float a, float b, float c, float d) {
    a = fminf(fmaxf(a, -448.f), 448.f); b = fminf(fmaxf(b, -448.f), 448.f); c = fminf(fmaxf(c, -448.f), 448.f); d = fminf(fmaxf(d, -448.f), 448.f);
    int r = __builtin_amdgcn_cvt_pk_fp8_f32(a, b, 0, false); r = __builtin_amdgcn_cvt_pk_fp8_f32(c, d, r, true); return (unsigned)r; }
__device__ __forceinline__ unsigned pk4_i8(float a, float b, float c, float d) {
    const int q0 = (int)fminf(fmaxf(rintf(a), -127.f), 127.f), q1 = (int)fminf(fmaxf(rintf(b), -127.f), 127.f), q2 = (int)fminf(fmaxf(rintf(c), -127.f), 127.f), q3 = (int)fminf(fmaxf(rintf(d), -127.f), 127.f);
    return ((unsigned)q0 & 0xffu) | (((unsigned)q1 & 0xffu) << 8) | (((unsigned)q2 & 0xffu) << 16) | ((unsigned)q3 << 24); }
constexpr float WQ_IN = 127.0f * 32.0f / 4.0f;
constexpr float W8_SCALE = 64.0f;
constexpr float Y8_SCALE = 32.0f;
constexpr float A8_SCALE = 8.0f;
__device__ __forceinline__ float bf_lo(unsigned w) { return __uint_as_float(w << 16); }
__device__ __forceinline__ float bf_hi(unsigned w) { return __uint_as_float(w & 0xffff0000u); }
__device__ __forceinline__ float wave_sum(float v) {
#pragma unroll
    for (int o = 1; o < 64; o <<= 1) v += __shfl_xor(v, o);
    return v;
}
#define LDS_WAIT() asm volatile("s_waitcnt lgkmcnt(0)" ::: "memory")

namespace pg8 {
constexpr int BM = 256, BK = 64, HALF = 128, HTB = HALF * BK * 2, STAGE_BYTES = 8 * HTB, NXCD = 8, WGM = 8;
__host__ __device__ __forceinline__ int lds_byte(int r, int c) { const int st = (r >> 4) * 2 + (c >> 5), rr = r & 15, cc = c & 31, ob = rr * 64 + cc * 2; return st * 1024 + (ob ^ (((ob >> 9) & 1) << 5)); }
__host__ __device__ __forceinline__ void stage_rc(int b, int& R, int& C) { const int st = b / 1024, sb = b % 1024, swz = sb ^ (((sb >> 9) & 1) << 5); R = (st >> 1) * 16 + swz / 64; C = (st & 1) * 32 + (swz % 64) / 2; }
__host__ __device__ __forceinline__ int perm32(int rho) { const int n = rho >> 4, i = rho & 15; return 8 * (i >> 2) + 4 * n + (i & 3); }

typedef int i32x4_t __attribute__((ext_vector_type(4)));
typedef int i32x8_t __attribute__((ext_vector_type(8)));
typedef long i64x2_t __attribute__((ext_vector_type(2)));
struct Unit { int pm, pn, e, mt, cnt; };

template <int BMAP> __device__ __forceinline__ int brow(int R) { return BMAP == 0 ? ((R >> 5) * 64 + perm32(R & 31)) : BMAP == 1 ? ((R & ~31) + perm32(R & 31)) : ((R >> 5) * 64 + 16 * ((R & 15) >> 2) + 4 * ((R >> 4) & 1) + (R & 3)); }

struct StaticOrder {
    int nM, nN, nwg, G, c;
    __device__ void init(int M, int N, int G_, int c_) { nM = M / BM; nN = N / BM; nwg = nM * nN; G = G_; c = c_; }
    __device__ bool next(int i, Unit& u) const {
        const long L = (long)i * G + c; if (L >= nwg) return false;
        int wgid = (int)L; { const int q = nwg / NXCD, r = nwg % NXCD, xcd = wgid % NXCD, off = wgid / NXCD; wgid = (xcd < r ? xcd * (q + 1) : r * (q + 1) + (xcd - r) * q) + off; }
        const int nig = WGM * nN, gid = wgid / nig, fm = gid * WGM, gsz = (nM - fm) < WGM ? (nM - fm) : WGM;
        u.pm = fm + ((wgid % nig) % gsz); u.pn = (wgid % nig) / gsz; u.e = 0; u.mt = 0; u.cnt = 0; return true;
    }
    __device__ bool next_lane(int i, Unit& u) const { return next(i, u); }
};
struct GroupedOrder {
    const LAS int* tp; const LAS int* cn; int NTN, G, c;
    __device__ bool next_lane(int i, Unit& u) const {
        const int nwg = tp[NEXP] * NTN; const long L = (long)i * G + c; if (L >= nwg) return false;
        int wgid = (int)L; { const int q = nwg / NXCD, r = nwg % NXCD, xcd = wgid % NXCD, off = wgid / NXCD; wgid = (xcd < r ? xcd * (q + 1) : r * (q + 1) + (xcd - r) * q) + off; }
        int e = 0; while (e < NEXP - 1 && wgid >= tp[e + 1] * NTN) ++e;
        const int idx = wgid - tp[e] * NTN, tiles = tp[e + 1] - tp[e];
        const int nig = 4 * NTN, gid = idx / nig, fm = gid * 4, gsz = (tiles - fm) < 4 ? (tiles - fm) : 4;
        u.mt = fm + ((idx % nig) % gsz); u.pn = (idx % nig) / gsz; u.e = e; u.pm = tp[e] + u.mt; u.cnt = cn[e]; return true;
    }
};
struct TableOrder {
    const LAS int* tab; int n;
    __device__ __forceinline__ bool next(int i, Unit& u) const {
        if (i >= n) return false;
        const LAS int* t = tab + i * 8;
        u.pm = __builtin_amdgcn_readfirstlane(t[0]); u.pn = __builtin_amdgcn_readfirstlane(t[1]); u.e = __builtin_amdgcn_readfirstlane(t[2]);
        u.mt = __builtin_amdgcn_readfirstlane(t[3]); u.cnt = __builtin_amdgcn_readfirstlane(t[4]); return true;
    }
};
template <class Sched> __device__ __forceinline__ TableOrder build_unit_table(const Sched& S, LAS int* tab) {
    __syncthreads();
    if (threadIdx.x < 32) { Unit u; const bool ok = S.next_lane((int)threadIdx.x, u);
        if (ok) { LAS int* t = tab + threadIdx.x * 8; t[0] = u.pm; t[1] = u.pn; t[2] = u.e; t[3] = u.mt; t[4] = u.cnt; }
        const unsigned long long m = __ballot(ok); if (threadIdx.x == 0) tab[256] = __popcll(m); }
    __syncthreads();
    TableOrder T; T.tab = tab; T.n = __builtin_amdgcn_readfirstlane(tab[256]); return T;
}
struct DenseProb {
    static constexpr bool GATHER = false; static constexpr int BMAP = 0; static constexpr bool F8 = false; static constexpr bool I8 = false;
    const bf16_t* A; const bf16_t* Bt; int lda, ldb, K;
    __device__ __forceinline__ const char* a_base(const Unit& u) const { return (const char*)(A + (size_t)u.pm * BM * lda); }
    __device__ __forceinline__ const char* b_base(const Unit& u) const { return (const char*)(Bt + (size_t)u.pn * BM * ldb); }
    __device__ __forceinline__ size_t bhstep() const { return (size_t)32 * ldb * 2; }
    __device__ __forceinline__ unsigned a_off(const Unit&, int, int) const { return 0u; }
    __device__ __forceinline__ unsigned a_raw(const Unit&, int) const { return 0u; }
};
struct DenseProbI8 {
    static constexpr bool GATHER = false; static constexpr int BMAP = 0; static constexpr bool F8 = true; static constexpr bool I8 = true;
    const unsigned char* A; const unsigned char* Bt; int lda, ldb, K;
    __device__ __forceinline__ const char* a_base(const Unit& u) const { return (const char*)(A + (size_t)u.pm * BM * lda); }
    __device__ __forceinline__ const char* b_base(const Unit& u) const { return (const char*)(Bt + (size_t)u.pn * BM * ldb); }
    __device__ __forceinline__ size_t bhstep() const { return (size_t)32 * ldb; }
    __device__ __forceinline__ unsigned a_off(const Unit&, int, int) const { return 0u; }
    __device__ __forceinline__ unsigned a_raw(const Unit&, int) const { return 0u; }
};
struct GuProb {
    static constexpr bool GATHER = true; static constexpr int BMAP = 1; static constexpr bool F8 = true; static constexpr bool I8 = false;
    const unsigned char* XG; const unsigned char* Wt; const u32x2* list; int lda, ldb, K;
    __device__ __forceinline__ const char* a_base(const Unit&) const { return (const char*)XG; }
    __device__ __forceinline__ const char* b_base(const Unit& u) const { return (const char*)(Wt + ((size_t)u.e * 2048 + 128 * u.pn) * 1024); }
    __device__ __forceinline__ size_t bhstep() const { return (size_t)1024 * 1024; }
    __device__ __forceinline__ unsigned a_raw(const Unit& u, int r) const { const int rr = u.mt * BM + r, rc = rr < u.cnt ? rr : u.cnt - 1; return list[(size_t)u.e * CAP + rc].x; }
    __device__ __forceinline__ unsigned a_off(const Unit& u, int r, int C) const {
        const int rr = u.mt * BM + r, rc = rr < u.cnt ? rr : u.cnt - 1;
        const unsigned tok = list[(size_t)u.e * CAP + rc].x >> 2;
        return tok * 1024u + (unsigned)C * 2u;
    }
};
struct DownProb {
    static constexpr bool GATHER = false; static constexpr int BMAP = 2; static constexpr bool F8 = true; static constexpr bool I8 = false;
    const unsigned char* A; const unsigned char* Wt; int lda, ldb, K;
    __device__ __forceinline__ const char* a_base(const Unit& u) const { return (const char*)(A + (size_t)u.pm * BM * lda); }
    __device__ __forceinline__ const char* b_base(const Unit& u) const { return (const char*)(Wt + ((size_t)u.e * 1024 + 256 * u.pn) * 1024); }
    __device__ __forceinline__ size_t bhstep() const { return (size_t)8 * ldb; }
    __device__ __forceinline__ unsigned a_off(const Unit&, int, int) const { return 0u; }
    __device__ __forceinline__ unsigned a_raw(const Unit&, int) const { return 0u; }
};

template <class Prob> __device__ __forceinline__ void calc_aoff(const Prob& P, const Unit& u, const int (&Rr)[2], const int (&Cc)[2], unsigned (&o)[2][2]) {
#pragma unroll
    for (int h = 0; h < 2; ++h)
#pragma unroll
        for (int i = 0; i < 2; ++i) {
            if constexpr (Prob::GATHER) o[h][i] = P.a_off(u, h * HALF + Rr[i], Cc[i]);
            else o[h][i] = Prob::F8 ? (unsigned)((h * HALF + Rr[i]) * P.lda + Cc[i] * 2) : (unsigned)((h * HALF + Rr[i]) * P.lda + Cc[i]) * 2u;
        }
}

struct NoPost { __device__ __forceinline__ void operator()(int) const {} };
template <class Epi, class Prob, class Sched, bool ALIGN_EPI, class Post = NoPost>
__device__ __forceinline__ void gemm_phase(LAS unsigned char* lds, const Prob& P, const Sched& S, const Epi& E, const Post& PU = Post()) {
    const int tid = threadIdx.x, wid = __builtin_amdgcn_readfirstlane(tid >> 6), lane = tid & 63, wr = wid >> 2, wc = wid & 3, fr = lane & 15, fq = lane >> 4;
    const int K = P.K, nt = Prob::F8 ? K / 128 : K / BK;
    int Rr[2], Cc[2]; unsigned voffB[2];
#pragma unroll
    for (int i = 0; i < 2; ++i) { stage_rc(tid * 16 + i * 8192, Rr[i], Cc[i]); voffB[i] = Prob::F8 ? (unsigned)(brow<Prob::BMAP>(Rr[i]) * P.ldb + Cc[i] * 2) : (unsigned)(brow<Prob::BMAP>(Rr[i]) * P.ldb + Cc[i]) * 2u; }
    const size_t kstep = (size_t)(BK * 2);
    const size_t bhstep = P.bhstep();
    const unsigned ldsw = (unsigned)wid * 1024u;
    const int aoff = lds_byte(wr * 64 + fr, fq * 8), boff = lds_byte(wc * 32 + fr, fq * 8);
#define PG8_SA(b, h) (((b) * 2 + (h)) * HTB)
#define PG8_SB(b, h) ((4 + (b) * 2 + (h)) * HTB)
#define PG8_STG(bufoff, gptr, v0, v1) do { \
        __builtin_amdgcn_global_load_lds((const unsigned*)((const char*)(gptr) + (v0)), (LAS unsigned*)(lds + (bufoff) + ldsw), 16, 0, 0); \
        __builtin_amdgcn_global_load_lds((const unsigned*)((const char*)(gptr) + (v1)), (LAS unsigned*)(lds + (bufoff) + ldsw + 8192), 16, 0, 0); } while (0)
#define PG8_STGB(bufoff, gptr) PG8_STG(bufoff, gptr, voffB[0], voffB[1])
#define PG8_LDA(dst, b, h) do { _Pragma("unroll") for (int m = 0; m < 4; ++m) _Pragma("unroll") for (int k = 0; k < 2; ++k) dst[m][k] = *(const LAS bf16x8*)(lds + PG8_SA(b, h) + aoff + m * 2048 + k * 1024); } while (0)
#define PG8_LDB(dst, b, h) do { _Pragma("unroll") for (int n = 0; n < 2; ++n) _Pragma("unroll") for (int k = 0; k < 2; ++k) dst[n][k] = *(const LAS bf16x8*)(lds + PG8_SB(b, h) + boff + n * 2048 + k * 1024); } while (0)
#define PG8_MMAB(ai, bj, At, Bt) do { _Pragma("unroll") for (int m = 0; m < 4; ++m) _Pragma("unroll") for (int n = 0; n < 2; ++n) _Pragma("unroll") for (int k = 0; k < 2; ++k) \
        acc[ai][bj][m][n] = __builtin_amdgcn_mfma_f32_16x16x32_bf16(Bt[n][k], At[m][k], acc[ai][bj][m][n], 0, 0, 0); } while (0)
#define PG8_MMAQ(ai, bj, At, Bt) do { _Pragma("unroll") for (int m = 0; m < 4; ++m) _Pragma("unroll") for (int n = 0; n < 2; ++n) _Pragma("unroll") for (int k = 0; k < 2; ++k) { \
        const i64x2_t bq = __builtin_bit_cast(i64x2_t, Bt[n][k]), aq = __builtin_bit_cast(i64x2_t, At[m][k]); \
        acc[ai][bj][m][n] = __builtin_amdgcn_mfma_f32_16x16x32_fp8_fp8(bq[0], aq[0], acc[ai][bj][m][n], 0, 0, 0); \
        acc[ai][bj][m][n] = __builtin_amdgcn_mfma_f32_16x16x32_fp8_fp8(bq[1], aq[1], acc[ai][bj][m][n], 0, 0, 0); } } while (0)
#define PG8_MMA8(ai, bj, A8, B8) do { _Pragma("unroll") for (int m = 0; m < 4; ++m) _Pragma("unroll") for (int n = 0; n < 2; ++n) \
        asm volatile("v_mfma_f32_16x16x128_f8f6f4 %0, %1, %2, %0" : "+v"(acc[ai][bj][m][n]) : "v"(B8[n]), "v"(A8[m])); } while (0)
#define PG8_MMAI(ai, bj, At, Bt) do { _Pragma("unroll") for (int k = 0; k < 2; ++k) _Pragma("unroll") for (int m = 0; m < 4; ++m) _Pragma("unroll") for (int n = 0; n < 2; ++n) \
        asm volatile("v_mfma_i32_16x16x64_i8 %0, %1, %2, %0" : "+v"(acc[ai][bj][m][n]) : "v"(Bt[n][k]), "v"(At[m][k])); } while (0)
#define PG8_LDA8(dst, b, h) do { _Pragma("unroll") for (int m = 0; m < 4; ++m) { dst[m].lo = *(const LAS i32x4_t*)(lds + PG8_SA(b, h) + aoff + m * 2048); dst[m].hi = *(const LAS i32x4_t*)(lds + PG8_SA(b, h) + aoff + m * 2048 + 1024); } } while (0)
#define PG8_LDB8(dst, b, h) do { _Pragma("unroll") for (int n = 0; n < 2; ++n) { dst[n].lo = *(const LAS i32x4_t*)(lds + PG8_SB(b, h) + boff + n * 2048); dst[n].hi = *(const LAS i32x4_t*)(lds + PG8_SB(b, h) + boff + n * 2048 + 1024); } } while (0)
#define PG8_XLDA(b, h)  do { if constexpr (Prob::F8 && !Prob::I8 && F8MODE == 2) PG8_LDA8(At8, b, h); else PG8_LDA(At, b, h); } while (0)
#define PG8_XLDB0(b, h) do { if constexpr (Prob::F8 && !Prob::I8 && F8MODE == 2) PG8_LDB8(B08, b, h); else PG8_LDB(B0, b, h); } while (0)
#define PG8_XLDB1(b, h) do { if constexpr (Prob::F8 && !Prob::I8 && F8MODE == 2) PG8_LDB8(B18, b, h); else PG8_LDB(B1, b, h); } while (0)
#define PG8_XMMA0(ai, bj) do { if (USE_SETPRIO) __builtin_amdgcn_s_setprio(USE_SETPRIO); if constexpr (Prob::I8) PG8_MMAI(ai, bj, At, B0); else if constexpr (Prob::F8 && F8MODE == 2) PG8_MMA8(ai, bj, At8, B08); else if constexpr (Prob::F8) PG8_MMAQ(ai, bj, At, B0); else PG8_MMAB(ai, bj, At, B0); if (USE_SETPRIO) __builtin_amdgcn_s_setprio(0); } while (0)
#define PG8_XMMA1(ai, bj) do { if (USE_SETPRIO) __builtin_amdgcn_s_setprio(USE_SETPRIO); if constexpr (Prob::I8) PG8_MMAI(ai, bj, At, B1); else if constexpr (Prob::F8 && F8MODE == 2) PG8_MMA8(ai, bj, At8, B18); else if constexpr (Prob::F8) PG8_MMAQ(ai, bj, At, B1); else PG8_MMAB(ai, bj, At, B1); if (USE_SETPRIO) __builtin_amdgcn_s_setprio(0); } while (0)
#define PG8_WAIT_V(n) asm volatile("s_waitcnt vmcnt(" #n ")" ::: "memory")
#define PG8_WAIT_L(n) asm volatile("s_waitcnt lgkmcnt(" #n ")" ::: "memory")
#define PG8_BAR __builtin_amdgcn_s_barrier()
#define PG8_SCHED __builtin_amdgcn_sched_barrier(0)
    Unit cur, nxt; int ui = 0;
    if (!S.next(0, cur)) return;
    unsigned vo[2][2], nvo[2][2];
    calc_aoff(P, cur, Rr, Cc, vo);
    bool has_next = S.next(1, nxt);
    if constexpr (Prob::GATHER) { if (has_next) calc_aoff(P, nxt, Rr, Cc, nvo); else {
#pragma unroll
        for (int h = 0; h < 2; ++h)
#pragma unroll
            for (int i = 0; i < 2; ++i) nvo[h][i] = vo[h][i]; } }
    f32x4 acc[2][2][4][2];
#pragma unroll
    for (int a = 0; a < 2; ++a)
#pragma unroll
        for (int b = 0; b < 2; ++b)
#pragma unroll
            for (int m = 0; m < 4; ++m)
#pragma unroll
                for (int n = 0; n < 2; ++n) acc[a][b][m][n] = (f32x4){0.f, 0.f, 0.f, 0.f};
    bf16x8 At[4][2], B0[2][2], B1[2][2]; i32x8_t At8[4], B08[2], B18[2];
    const char* cA = P.a_base(cur); const char* cB = P.b_base(cur);
    if constexpr (Epi::HAS_PRE) E.pre(cur, 0, wid, lane);
    PG8_STGB(PG8_SB(0, 0), cB); PG8_STGB(PG8_SB(0, 1), cB + bhstep); PG8_STG(PG8_SA(0, 0), cA, vo[0][0], vo[0][1]); PG8_STG(PG8_SA(0, 1), cA, vo[1][0], vo[1][1]);
    if (wr == 1) PG8_BAR;
    PG8_WAIT_V(2); PG8_BAR;
    PG8_STGB(PG8_SB(1, 0), cB + kstep); PG8_STG(PG8_SA(1, 0), cA + kstep, vo[0][0], vo[0][1]); PG8_STGB(PG8_SB(1, 1), cB + bhstep + kstep);
    PG8_WAIT_V(6); PG8_BAR;
    for (;;) {
        const char* nA = has_next ? P.a_base(nxt) : cA; const char* nB = has_next ? P.b_base(nxt) : cB;
        for (int t = 0; t < nt; t += 2) {
            const bool last = (t == nt - 2);
            if constexpr (Epi::HAS_MID) { if (t == Epi::MID_T0 || t == Epi::MID_T1) { E.mid(acc, cur, wr, wc, fr, fq, t == Epi::MID_T0 ? 0 : 1); PG8_SCHED; } }
            const char* a1 = cA + (size_t)(t + 1) * kstep;
            const char* a2 = last ? nA : cA + (size_t)(t + 2) * kstep; const char* b2 = last ? nB : cB + (size_t)(t + 2) * kstep;
            const char* a3 = a2 + kstep; const char* b3 = b2 + kstep;
            unsigned x00 = vo[0][0], x01 = vo[0][1], x10 = vo[1][0], x11 = vo[1][1];
            if constexpr (Prob::GATHER) { if (last) { x00 = nvo[0][0]; x01 = nvo[0][1]; x10 = nvo[1][0]; x11 = nvo[1][1]; } }
            PG8_XLDB0(0, 0); PG8_XLDB1(0, 1); PG8_SCHED; PG8_XLDA(0, 0); PG8_STG(PG8_SA(1, 1), a1, vo[1][0], vo[1][1]);
            PG8_WAIT_V(8); PG8_WAIT_L(0); PG8_BAR; PG8_XMMA0(0, 0); PG8_XMMA1(0, 1); PG8_BAR; PG8_SCHED;
            PG8_XLDA(0, 1); PG8_STGB(PG8_SB(0, 0), b2); PG8_STGB(PG8_SB(0, 1), b2 + bhstep); PG8_STG(PG8_SA(0, 0), a2, x00, x01);
            PG8_WAIT_V(8); PG8_WAIT_L(0); PG8_BAR; PG8_XMMA0(1, 0); PG8_XMMA1(1, 1); PG8_BAR; PG8_SCHED;
            PG8_XLDB0(1, 0); PG8_XLDB1(1, 1); PG8_SCHED; PG8_XLDA(1, 0); PG8_STG(PG8_SA(0, 1), a2, x10, x11);
            PG8_WAIT_V(8); PG8_WAIT_L(0); PG8_BAR; PG8_XMMA0(0, 0); PG8_XMMA1(0, 1); PG8_BAR; PG8_SCHED;
            PG8_XLDA(1, 1); PG8_STGB(PG8_SB(1, 0), b3); PG8_STGB(PG8_SB(1, 1), b3 + bhstep); PG8_STG(PG8_SA(1, 0), a3, x00, x01);
            PG8_WAIT_V(8); PG8_WAIT_L(0); PG8_BAR; PG8_XMMA0(1, 0); PG8_XMMA1(1, 1); PG8_BAR; PG8_SCHED;
        }
        if constexpr (ALIGN_EPI) { if (wr == 0) PG8_BAR; }
        if constexpr ((Prob::F8 && F8MODE == 2) || Prob::I8) asm volatile("s_nop 15\n\ts_nop 15" ::: "memory");
        Unit nn; const bool has_nn = has_next && S.next(ui + 2, nn);
        if constexpr (Prob::GATHER) {
#pragma unroll
            for (int h = 0; h < 2; ++h)
#pragma unroll
                for (int i = 0; i < 2; ++i) vo[h][i] = nvo[h][i];
            if (has_nn) {
#pragma unroll
                for (int h = 0; h < 2; ++h)
#pragma unroll
                    for (int i = 0; i < 2; ++i) nvo[h][i] = P.a_raw(nn, h * HALF + Rr[i]); } }
        if constexpr (Epi::HAS_PRE) E(acc, cur, wr, wc, fr, fq, ui & 1); else E(acc, cur, wr, wc, fr, fq);
        PU(ui);
        if (!has_next) break;
#pragma unroll
        for (int a = 0; a < 2; ++a)
#pragma unroll
            for (int b = 0; b < 2; ++b)
#pragma unroll
                for (int m = 0; m < 4; ++m)
#pragma unroll
                    for (int n = 0; n < 2; ++n) acc[a][b][m][n] = (f32x4){0.f, 0.f, 0.f, 0.f};
        cur = nxt; cA = nA; cB = nB; ++ui;
        if constexpr (Epi::HAS_PRE) E.pre(cur, ui, wid, lane);
        has_next = has_nn; nxt = nn;
        if constexpr (Prob::GATHER) { if (has_next) {
#pragma unroll
            for (int h = 0; h < 2; ++h)
#pragma unroll
                for (int i = 0; i < 2; ++i) nvo[h][i] = (nvo[h][i] >> 2) * (Prob::F8 ? 1024u : 2048u) + (unsigned)Cc[i] * 2u;
            asm volatile("" : "+v"(nvo[0][0]), "+v"(nvo[0][1]), "+v"(nvo[1][0]), "+v"(nvo[1][1])); } }
        if constexpr (ALIGN_EPI) { if (wr == 1) PG8_BAR; }
    }
    PG8_WAIT_V(0);
    if constexpr (!ALIGN_EPI) { if (wr == 0) PG8_BAR; }
    PG8_BAR;
#undef PG8_SA
#undef PG8_SB
#undef PG8_STG
#undef PG8_STGB
#undef PG8_LDA
#undef PG8_LDB
#undef PG8_MMAB
#undef PG8_MMAQ
#undef PG8_MMA8
#undef PG8_MMAI
#undef PG8_LDA8
#undef PG8_LDB8
#undef PG8_XLDA
#undef PG8_XLDB0
#undef PG8_XLDB1
#undef PG8_XMMA0
#undef PG8_XMMA1
#undef PG8_WAIT_V
#undef PG8_WAIT_L
#undef PG8_BAR
#undef PG8_SCHED
}

typedef const f32x4 (&AccRef)[2][2][4][2];
__device__ __forceinline__ void dma4(const void* g, LAS unsigned char* dst) { __builtin_amdgcn_global_load_lds((const unsigned*)g, (LAS unsigned*)dst, 4, 0, 0); }

__device__ __forceinline__ void store8(bf16_t* p, const f32x4& a, const f32x4& b) {
    u32x4 w; w.x = cvt_pk_bf16(a[0], a[1]); w.y = cvt_pk_bf16(a[2], a[3]); w.z = cvt_pk_bf16(b[0], b[1]); w.w = cvt_pk_bf16(b[2], b[3]); *(u32x4*)p = w;
}
__device__ __forceinline__ float sigmoidf_(float v) { return __builtin_amdgcn_rcpf(1.0f + __builtin_amdgcn_exp2f(-1.4426950408889634f * v)); }

struct EpiInProj {
    static constexpr bool HAS_MID = false; static constexpr bool HAS_PRE = false;
    bf16_t *Q, *Kb, *V, *U, *MQ, *GT; const float *qn, *kn, *mqn, *bg; const f32x2* rope; const float* rs;
    __device__ __forceinline__ void operator()(AccRef acc, const Unit& u, int wr, int wc, int fr, int fq) const {
        const int pn = u.pn; const int row0 = u.pm * BM + wr * 64 + fr;
        float sc8[8];
#pragma unroll
        for (int q = 0; q < 8; ++q) sc8[q] = rs[row0 + (q >> 2) * HALF + (q & 3) * 16] * (1.0f / WQ_IN);
#define I2F(v) __builtin_convertvector(__builtin_bit_cast(i32x4_t, v), f32x4)
        bf16_t* const Q_ = Q; bf16_t* const K_ = Kb; bf16_t* const V_ = V; bf16_t* const U_ = U; bf16_t* const MQ_ = MQ; const float* const qn_ = qn; const float* const kn_ = kn; const float* const mqn_ = mqn;
        if (pn < 4 || pn == 7) {
            const bool rope_on = pn < 4; const float* gn = pn < 2 ? qn_ : (pn < 4 ? kn_ : mqn_);
            const float sc = (pn < 2 || pn == 7) ? C2 : 1.0f;
            bf16_t* O; int pitch, colb;
            if (pn < 2) { O = Q_; pitch = 512; colb = (pn * 4 + wc) * 64; } else if (pn < 4) { O = K_; pitch = 512; colb = ((pn - 2) * 4 + wc) * 64; } else { O = MQ_; pitch = 256; colb = wc * 64; }
            const f32x4 g00 = *(const f32x4*)(gn + 8 * fq), g01 = *(const f32x4*)(gn + 8 * fq + 4), g10 = *(const f32x4*)(gn + 32 + 8 * fq), g11 = *(const f32x4*)(gn + 32 + 8 * fq + 4);
#pragma unroll
            for (int ai = 0; ai < 2; ++ai)
#pragma unroll
                for (int m = 0; m < 4; ++m) {
                    const float rsc = sc8[ai * 4 + m]; const f32x4 a0 = I2F(acc[ai][0][m][0]) * rsc, a1 = I2F(acc[ai][0][m][1]) * rsc, b0 = I2F(acc[ai][1][m][0]) * rsc, b1 = I2F(acc[ai][1][m][1]) * rsc;
                    float ss = 0.f;
#pragma unroll
                    for (int j = 0; j < 4; ++j) ss += a0[j] * a0[j] + a1[j] * a1[j] + b0[j] * b0[j] + b1[j] * b1[j];
                    ss += __shfl_xor(ss, 16); ss += __shfl_xor(ss, 32);
                    const float rstd = 1.0f / sqrtf(ss * (1.0f / 64.0f) + RMS_EPS);
                    const int row = row0 + ai * HALF + m * 16;
                    f32x4 t10 = a0 * rstd * g00, t11 = a1 * rstd * g01, t20 = b0 * rstd * g10, t21 = b1 * rstd * g11;
                    f32x4 o10, o11, o20, o21;
                    if (rope_on) {
                        const f32x4* rp = (const f32x4*)(rope + (size_t)(row & (SEQ - 1)) * 32 + 8 * fq);
                        const f32x4 r0 = rp[0], r1 = rp[1], r2 = rp[2], r3 = rp[3];
                        const f32x4 cs0 = {r0[0], r0[2], r1[0], r1[2]}, sn0 = {r0[1], r0[3], r1[1], r1[3]}, cs1 = {r2[0], r2[2], r3[0], r3[2]}, sn1 = {r2[1], r2[3], r3[1], r3[3]};
                        o10 = (t10 * cs0 - t20 * sn0) * sc; o11 = (t11 * cs1 - t21 * sn1) * sc; o20 = (t20 * cs0 + t10 * sn0) * sc; o21 = (t21 * cs1 + t11 * sn1) * sc;
                    } else { o10 = t10 * sc; o11 = t11 * sc; o20 = t20 * sc; o21 = t21 * sc; }
                    bf16_t* rowp = O + (size_t)row * pitch + colb + 8 * fq;
                    store8(rowp, o10, o11); store8(rowp + 32, o20, o21);
                }
        } else if (pn < 7) {
            bf16_t* O; int pitch, colb;
            if (pn < 6) { O = V_; pitch = 512; colb = (pn - 4) * 256 + wc * 64; } else { O = U_; pitch = 256; colb = wc * 64; }
#pragma unroll
            for (int ai = 0; ai < 2; ++ai)
#pragma unroll
                for (int m = 0; m < 4; ++m) { bf16_t* rowp = O + (size_t)(row0 + ai * HALF + m * 16) * pitch + colb + 8 * fq;
                    const float sc = sc8[ai * 4 + m]; store8(rowp, I2F(acc[ai][0][m][0]) * sc, I2F(acc[ai][0][m][1]) * sc); store8(rowp + 32, I2F(acc[ai][1][m][0]) * sc, I2F(acc[ai][1][m][1]) * sc); }
        } else {
            const int gc = (pn - 8) * 256 + wc * 64 + 8 * fq;
            f32x4 bv[2][2];
#pragma unroll
            for (int bj = 0; bj < 2; ++bj)
#pragma unroll
                for (int n = 0; n < 2; ++n) bv[bj][n] = *(const f32x4*)(bg + gc + 32 * bj + 4 * n) * (-1.4426950408889634f);
#pragma unroll
            for (int ai = 0; ai < 2; ++ai)
#pragma unroll
                for (int m = 0; m < 4; ++m) {
                    unsigned char* blk = (unsigned char*)GT + ((size_t)(((pn - 8) >> 2) * 128 + u.pm) * 4 + ((pn - 8) & 3)) * 65536 + (size_t)((wr * 4 + wc) * 16 * 64 + (fq * 16 + fr)) * 8;
#pragma unroll
                    for (int bj = 0; bj < 2; ++bj) { const float scl = sc8[ai * 4 + m] * (-1.4426950408889634f); f32x4 v0 = I2F(acc[ai][bj][m][0]) * scl + bv[bj][0], v1 = I2F(acc[ai][bj][m][1]) * scl + bv[bj][1];
                        u32x2 w = {0u, 0u};
#pragma unroll
                        for (int j = 0; j < 4; ++j) { const float g0 = __builtin_amdgcn_rcpf(1.0f + __builtin_amdgcn_exp2f(v0[j])), g1 = __builtin_amdgcn_rcpf(1.0f + __builtin_amdgcn_exp2f(v1[j]));
                            w.x = __builtin_amdgcn_cvt_pk_u8_f32(fmaxf(g0 * 255.0f + 0.25f, 1.0f), j, w.x); w.y = __builtin_amdgcn_cvt_pk_u8_f32(fmaxf(g1 * 255.0f + 0.25f, 1.0f), j, w.y); }
                        *(u32x2*)(blk + (ai * 8 + m * 2 + bj) * 512) = w; } }
        }
    }
};
#undef I2F
struct EpiMemKV {
    static constexpr bool HAS_MID = false; static constexpr bool HAS_PRE = false;
    bf16_t* MKV; const float* mkn;
    __device__ __forceinline__ void operator()(AccRef acc, const Unit& u, int wr, int wc, int fr, int fq) const {
        const int row0 = u.pm * BM + wr * 64 + fr;
        f32x4 g00 = {1.f, 1.f, 1.f, 1.f}, g01 = g00, g10 = g00, g11 = g00;
        if (u.pn == 0) { g00 = *(const f32x4*)(mkn + 8 * fq); g01 = *(const f32x4*)(mkn + 8 * fq + 4); g10 = *(const f32x4*)(mkn + 32 + 8 * fq); g11 = *(const f32x4*)(mkn + 32 + 8 * fq + 4); }
#pragma unroll
        for (int ai = 0; ai < 2; ++ai)
#pragma unroll
            for (int m = 0; m < 4; ++m) {
                const f32x4 a0 = acc[ai][0][m][0], a1 = acc[ai][0][m][1], b0 = acc[ai][1][m][0], b1 = acc[ai][1][m][1];
                float rstd = 1.0f;
                if (u.pn == 0) { float ss = 0.f;
#pragma unroll
                    for (int j = 0; j < 4; ++j) ss += a0[j] * a0[j] + a1[j] * a1[j] + b0[j] * b0[j] + b1[j] * b1[j];
                    ss += __shfl_xor(ss, 16); ss += __shfl_xor(ss, 32); rstd = 1.0f / sqrtf(ss * (1.0f / 64.0f) + RMS_EPS); }
                bf16_t* rowp = MKV + (size_t)(row0 + ai * HALF + m * 16) * 512 + u.pn * 256 + wc * 64 + 8 * fq;
                store8(rowp, a0 * rstd * g00, a1 * rstd * g01); store8(rowp + 32, b0 * rstd * g10, b1 * rstd * g11);
            }
    }
};
template <int STAGE> struct EpiMerge {
    static constexpr bool HAS_MID = false; static constexpr bool HAS_PRE = false;
    const bf16_t* GT; float* MF; bf16_t* MB;
    __device__ __forceinline__ void operator()(AccRef acc, const Unit& u, int wr, int wc, int fr, int fq) const {
        const int row0 = u.pm * BM + wr * 64 + fr, col0 = u.pn * BM + wc * 64 + 8 * fq;
#pragma unroll
        for (int ai = 0; ai < 2; ++ai)
#pragma unroll
            for (int m = 0; m < 4; ++m) { const size_t row = (size_t)(row0 + ai * HALF + m * 16);
#pragma unroll
                for (int bj = 0; bj < 2; ++bj) { const int col = col0 + 32 * bj;
                    const u32x4 g = *(const u32x4*)(GT + row * 3072 + STAGE * 1024 + col);
                    const f32x4 ga = {bf_lo(g.x), bf_hi(g.x), bf_lo(g.y), bf_hi(g.y)}, gb = {bf_lo(g.z), bf_hi(g.z), bf_lo(g.w), bf_hi(g.w)};
                    f32x4 v0 = acc[ai][bj][m][0] * ga, v1 = acc[ai][bj][m][1] * gb;
                    float* mp = MF + row * 1024 + col;
                    if (STAGE > 0) { v0 += *(const f32x4*)mp; v1 += *(const f32x4*)(mp + 4); }
                    if (STAGE < 2) { *(f32x4*)mp = v0; *(f32x4*)(mp + 4) = v1; } else store8(MB + row * 1024 + col, v0, v1); }
                if (m & 1) asm volatile("" ::: "memory"); }
    }
};
struct EpiWout {
    static constexpr bool HAS_MID = false; static constexpr bool HAS_PRE = false;
    const float* X; float* X2; unsigned char* XG; const float* n2;
    __device__ __forceinline__ void operator()(AccRef acc, const Unit& u, int wr, int wc, int fr, int fq) const {
        const int row0 = u.pm * BM + wr * 64 + fr, col0 = u.pn * BM + wc * 64 + 8 * fq;
        f32x4 nv[2][2];
#pragma unroll
        for (int bj = 0; bj < 2; ++bj)
#pragma unroll
            for (int n = 0; n < 2; ++n) nv[bj][n] = *(const f32x4*)(n2 + col0 + 32 * bj + 4 * n);
#pragma unroll
        for (int ai = 0; ai < 2; ++ai)
#pragma unroll
            for (int m = 0; m < 4; ++m) { const size_t off = (size_t)(row0 + ai * HALF + m * 16) * 1024 + col0;
#pragma unroll
                for (int bj = 0; bj < 2; ++bj) { const f32x4 x0 = *(const f32x4*)(X + off + 32 * bj) + acc[ai][bj][m][0], x1 = *(const f32x4*)(X + off + 32 * bj + 4) + acc[ai][bj][m][1];
                    *(f32x4*)(X2 + off + 32 * bj) = x0; *(f32x4*)(X2 + off + 32 * bj + 4) = x1;
                    { const f32x4 y0 = x0 * nv[bj][0], y1 = x1 * nv[bj][1]; u32x2 w8; w8.x = pk4_fp8(y0[0], y0[1], y0[2], y0[3]); w8.y = pk4_fp8(y1[0], y1[1], y1[2], y1[3]); *(u32x2*)(XG + off + 32 * bj) = w8; } }
                if (m & 1) asm volatile("" ::: "memory"); }
    }
};
struct EpiSwiglu {
    static constexpr bool HAS_MID = false; static constexpr bool HAS_PRE = true;
    unsigned char* ACT; const u32x2* list; const float* bgu; LAS unsigned char* xb;
    __device__ __forceinline__ void pre(const Unit& u, int ui, int wid, int lane) const {
        LAS unsigned char* b = xb + (ui & 1) * 2048;
        if (wid < 4) { const int rr = u.mt * BM + 64 * wid + lane, rc = rr < u.cnt ? rr : u.cnt - 1; dma4((const unsigned*)(list + (size_t)u.e * CAP + rc) + 1, b + wid * 256); }
        else { const int j = 64 * (wid - 4) + lane; dma4(bgu + (size_t)u.e * 2048 + 128 * u.pn + (j < 128 ? j : 1024 + (j - 128)), b + 1024 + (wid - 4) * 256); }
    }
    __device__ __forceinline__ static unsigned swi4(const f32x4& ag, const f32x4& au, float rstd, const f32x4& bg, const f32x4& bu) {
        unsigned w = 0;
#pragma unroll
        for (int h = 0; h < 2; ++h) {
            const f32x2 a2 = {ag[2 * h], ag[2 * h + 1]}, u2 = {au[2 * h], au[2 * h + 1]}, bg2 = {bg[2 * h], bg[2 * h + 1]}, bu2 = {bu[2 * h], bu[2 * h + 1]};
            const f32x2 G = a2 * rstd + bg2, U = u2 * rstd + bu2;
            const f32x2 gg = {fminf(G[0], 7.0f), fminf(G[1], 7.0f)};
            const f32x2 t = gg * (-1.702f * 1.4426950408889634f);
            const f32x2 d = (f32x2){__builtin_amdgcn_exp2f(t[0]), __builtin_amdgcn_exp2f(t[1])} + 1.0f;
            const f32x2 r = {__builtin_amdgcn_rcpf(d[0]), __builtin_amdgcn_rcpf(d[1])};
            const f32x2 uu = {__builtin_amdgcn_fmed3f(U[0], -7.0f, 7.0f), __builtin_amdgcn_fmed3f(U[1], -7.0f, 7.0f)};
            const f32x2 o = (gg * r) * (uu * A8_SCALE + A8_SCALE);
            w = h ? (unsigned)__builtin_amdgcn_cvt_pk_fp8_f32(o[0], o[1], (int)w, true) : (unsigned)__builtin_amdgcn_cvt_pk_fp8_f32(o[0], o[1], (int)w, false);
        }
        return w;
    }
    __device__ __forceinline__ void operator()(AccRef acc, const Unit& u, int wr, int wc, int fr, int fq, int par) const {
        int z = 0; asm volatile("" : "+v"(z));
        const int col = 128 * u.pn + 32 * wc + 8 * fq + z; const LAS unsigned char* b = xb + par * 2048; const LAS unsigned char* bb = b + 1024 + (32 * wc + 8 * fq + z) * 4;
        const f32x4 bg0 = *(const LAS f32x4*)bb, bg1 = *(const LAS f32x4*)(bb + 16), bu0 = *(const LAS f32x4*)(bb + 512), bu1 = *(const LAS f32x4*)(bb + 528);
#pragma unroll
        for (int ai = 0; ai < 2; ++ai)
#pragma unroll
            for (int m = 0; m < 4; ++m) { const int r = ai * HALF + wr * 64 + m * 16 + fr;
                const float rstd = *(const LAS float*)(b + (r + z) * 4) * (1.0f / W8_SCALE);
                u32x2 w8; w8.x = swi4(acc[ai][0][m][0], acc[ai][1][m][0], rstd, bg0, bu0); w8.y = swi4(acc[ai][0][m][1], acc[ai][1][m][1], rstd, bg1, bu1);
                *(u32x2*)(ACT + (size_t)(u.pm * BM + r) * 1024 + col) = w8; }
    }
};
struct EpiDown {
    static constexpr bool HAS_MID = false; static constexpr bool HAS_PRE = true;
    unsigned char* Y4; const u32x2* list; const float* bd; LAS unsigned char* xb;
    __device__ __forceinline__ void pre(const Unit& u, int ui, int wid, int lane) const {
        LAS unsigned char* b = xb + (ui & 1) * 2048;
        if (wid < 4) { const int rr = u.mt * BM + 64 * wid + lane, rc = rr < u.cnt ? rr : u.cnt - 1; dma4((const unsigned*)(list + (size_t)u.e * CAP + rc), b + wid * 256); }
        else { const int j = 64 * (wid - 4) + lane; dma4(bd + (size_t)u.e * 1024 + u.pn * BM + j, b + 1024 + (wid - 4) * 256); }
    }
    __device__ __forceinline__ static unsigned dn4(const f32x4& a, const f32x4& b32) {
        const f32x4 y = a * (Y8_SCALE / (W8_SCALE * A8_SCALE)) + b32;
        return pk4_fp8(y[0], y[1], y[2], y[3]);
    }
    __device__ __forceinline__ void operator()(AccRef acc, const Unit& u, int wr, int wc, int fr, int fq, int par) const {
        int z = 0; asm volatile("" : "+v"(z));
        const int colw = wc * 64 + 16 * fq + z, col0 = u.pn * BM + colw;
        const LAS unsigned char* b = xb + par * 2048;
        f32x4 bv[2][2];
#pragma unroll
        for (int bj = 0; bj < 2; ++bj)
#pragma unroll
            for (int n = 0; n < 2; ++n) bv[bj][n] = *(const LAS f32x4*)(b + 1024 + (colw + 8 * bj + 4 * n) * 4) * Y8_SCALE;
#pragma unroll
        for (int ai = 0; ai < 2; ++ai)
#pragma unroll
            for (int m = 0; m < 4; ++m) { const int r = ai * HALF + wr * 64 + m * 16 + fr, rr = u.mt * BM + r;
                if (rr < u.cnt) { const unsigned tk = *(const LAS unsigned*)(b + (r + z) * 4);
                    u32x4 w8; w8.x = dn4(acc[ai][0][m][0], bv[0][0]); w8.y = dn4(acc[ai][0][m][1], bv[0][1]); w8.z = dn4(acc[ai][1][m][0], bv[1][0]); w8.w = dn4(acc[ai][1][m][1], bv[1][1]);
                    *(u32x4*)(Y4 + (size_t)tk * 1024 + col0) = w8; } }
    }
};
struct EpiMergeR {
    static constexpr bool HAS_MID = true; static constexpr bool HAS_PRE = false; static constexpr int MID_T0 = 8, MID_T1 = 12;
    const bf16_t* GT; bf16_t* MB;
    __device__ __forceinline__ void mid(f32x4 (&acc)[2][2][4][2], const Unit& u, int wr, int wc, int fr, int fq, int seam) const {
        int z = 0; asm volatile("" : "+v"(z));
        const unsigned char* gp0 = (const unsigned char*)GT + ((size_t)(seam * 128 + u.pm) * 4 + u.pn) * 65536 + (size_t)((wr * 4 + wc) * 16 * 64 + (fq * 16 + fr) + z) * 8;
#pragma unroll
        for (int ai = 0; ai < 2; ++ai)
#pragma unroll
            for (int m = 0; m < 4; ++m) {
#pragma unroll
                for (int bj = 0; bj < 2; ++bj) { const unsigned char* gp = gp0 + (ai * 8 + m * 2 + bj) * 512;
                    const u32x2 gn = *(const u32x2*)gp, gd = *(const u32x2*)(gp + (size_t)128 * 4 * 65536);
#pragma unroll
                    for (int n = 0; n < 2; ++n) { const unsigned wn = n ? gn.y : gn.x, wd = n ? gd.y : gd.x;
#pragma unroll
                        for (int j = 0; j < 4; ++j) acc[ai][bj][m][n][j] *= (float)((wn >> (8 * j)) & 0xffu) * __builtin_amdgcn_rcpf((float)((wd >> (8 * j)) & 0xffu)); } }
                if (m & 1) asm volatile("" ::: "memory"); }
    }
    __device__ __forceinline__ void operator()(AccRef acc, const Unit& u, int wr, int wc, int fr, int fq) const {
        int z = 0; asm volatile("" : "+v"(z));
        const size_t off0 = (size_t)(u.pm * BM + wr * 64 + fr + z) * 1024 + u.pn * BM + wc * 64 + 8 * fq;
        const unsigned char* gp0 = (const unsigned char*)GT + ((size_t)(2 * 128 + u.pm) * 4 + u.pn) * 65536 + (size_t)((wr * 4 + wc) * 16 * 64 + (fq * 16 + fr) + z) * 8;
#pragma unroll
        for (int ai = 0; ai < 2; ++ai)
#pragma unroll
            for (int m = 0; m < 4; ++m) { const size_t ro = off0 + (size_t)(ai * HALF + m * 16) * 1024;
#pragma unroll
                for (int bj = 0; bj < 2; ++bj) {
                    const u32x2 g = *(const u32x2*)(gp0 + (ai * 8 + m * 2 + bj) * 512);
                    f32x4 ga, gb;
#pragma unroll
                    for (int j = 0; j < 4; ++j) { ga[j] = (float)((g.x >> (8 * j)) & 0xffu) * (1.0f / 255.0f); gb[j] = (float)((g.y >> (8 * j)) & 0xffu) * (1.0f / 255.0f); }
                    store8(MB + ro + 32 * bj, acc[ai][bj][m][0] * ga, acc[ai][bj][m][1] * gb); } }
    }
};
struct EpiPlain {
    static constexpr bool HAS_MID = false; static constexpr bool HAS_PRE = false;
    bf16_t* Z; int ldz;
    __device__ __forceinline__ void operator()(AccRef acc, const Unit& u, int wr, int wc, int fr, int fq) const {
        const int row0 = u.pm * BM + wr * 64 + fr, col0 = u.pn * BM + wc * 64 + 8 * fq;
#pragma unroll
        for (int ai = 0; ai < 2; ++ai)
#pragma unroll
            for (int m = 0; m < 4; ++m) { bf16_t* rowp = Z + (size_t)(row0 + ai * HALF + m * 16) * ldz + col0;
                store8(rowp, acc[ai][0][m][0], acc[ai][0][m][1]); store8(rowp + 32, acc[ai][1][m][0], acc[ai][1][m][1]); }
    }
};
}

namespace attn_body {
using bf16 = __hip_bfloat16;
using s16x4 = __attribute__((ext_vector_type(4))) short;
constexpr int NW = 8, QBLK = 32, QB = QBLK * NW, KVBLK = 64, D = 64;
__device__ __forceinline__ int crow(int r, int hi) { return (r & 3) + 8 * (r >> 2) + 4 * hi; }
#define SBAR() __builtin_amdgcn_sched_barrier(0)
constexpr int NSLOT = 3, SLOTB = 8192;
constexpr int LDS_K = 0, LDS_V = NSLOT * SLOTB, LDS_WS = 2 * NSLOT * SLOTB, LDS_OST = LDS_WS + NW * 64 * 4, LDS_BYTES = LDS_OST + NW * 4096;
__device__ __forceinline__ void glds16(const void* gsrc, unsigned lds_dst) { unsigned keep;
    asm volatile("s_mov_b32 %0, m0\n\ts_mov_b32 m0, %2\n\ts_nop 0\n\tglobal_load_lds_dwordx4 %1, off\n\ts_mov_b32 m0, %0" : "=&s"(keep) : "v"(gsrc), "s"(lds_dst) : "memory"); }
__device__ __forceinline__ float max3f(float a, float b, float c) { float r; asm("v_max3_f32 %0, %1, %2, %3" : "=v"(r) : "v"(a), "v"(b), "v"(c)); return r; }
__device__ __forceinline__ float max2f(float a, float b) { float r; asm("v_max_f32_e32 %0, %1, %2" : "=v"(r) : "v"(a), "v"(b)); return r; }
__device__ __forceinline__ float fadd_s(float a, float b) { float r; asm("v_add_f32_e32 %0, %1, %2" : "=v"(r) : "v"(a), "v"(b)); return r; }
__device__ __forceinline__ float fsub_s(float a, float b) { float r; asm("v_sub_f32_e32 %0, %1, %2" : "=v"(r) : "v"(a), "v"(b)); return r; }
typedef float f32x2_t __attribute__((ext_vector_type(2))); typedef __bf16 bf16x2_t __attribute__((ext_vector_type(2)));
__device__ __forceinline__ unsigned cvtpk_s(float lo, float hi) { f32x2_t v = {lo, hi}; bf16x2_t b = __builtin_convertvector(v, bf16x2_t); return __builtin_bit_cast(unsigned, b); }
#define WAIT_BAR(N) asm volatile("s_waitcnt vmcnt(" #N ") lgkmcnt(0)\n\ts_barrier" ::: "memory")

__device__ __forceinline__ void qkt(f32x16& p0, f32x16& p1, const char* Kslot, const bf16x8* qr, const f32x16& negm, int r32, int hi) {
    const char* kb = Kslot + hi * 1024 + r32 * 16;
#pragma unroll
    for (int d0 = 0; d0 < 4; ++d0) {
        const bf16x8 b0 = *reinterpret_cast<const bf16x8*>(kb + d0 * 2048);
        const bf16x8 b1 = *reinterpret_cast<const bf16x8*>(kb + d0 * 2048 + 512);
        if (d0 == 0) { p0 = __builtin_amdgcn_mfma_f32_32x32x16_bf16(b0, qr[0], negm, 0, 0, 0); p1 = __builtin_amdgcn_mfma_f32_32x32x16_bf16(b1, qr[0], negm, 0, 0, 0); }
        else { p0 = __builtin_amdgcn_mfma_f32_32x32x16_bf16(b0, qr[d0], p0, 0, 0, 0); p1 = __builtin_amdgcn_mfma_f32_32x32x16_bf16(b1, qr[d0], p1, 0, 0, 0); } }
}
typedef __attribute__((address_space(3))) const char* lds_cptr;
typedef short v4i16_t __attribute__((ext_vector_type(4)));
__device__ __forceinline__ void kload8(bf16x8* kf, lds_cptr kp) {
    kf[0] = *(const __attribute__((address_space(3))) bf16x8*)(kp);        kf[1] = *(const __attribute__((address_space(3))) bf16x8*)(kp + 512);
    kf[2] = *(const __attribute__((address_space(3))) bf16x8*)(kp + 2048); kf[3] = *(const __attribute__((address_space(3))) bf16x8*)(kp + 2560);
    kf[4] = *(const __attribute__((address_space(3))) bf16x8*)(kp + 4096); kf[5] = *(const __attribute__((address_space(3))) bf16x8*)(kp + 4608);
    kf[6] = *(const __attribute__((address_space(3))) bf16x8*)(kp + 6144); kf[7] = *(const __attribute__((address_space(3))) bf16x8*)(kp + 6656);
}
__device__ __forceinline__ void kload2(bf16x8* kf, lds_cptr kp, int j) { kf[2 * j] = *(const __attribute__((address_space(3))) bf16x8*)(kp + j * 2048); kf[2 * j + 1] = *(const __attribute__((address_space(3))) bf16x8*)(kp + j * 2048 + 512); }
__device__ __forceinline__ s16x4 vtr(lds_cptr p) { return __builtin_bit_cast(s16x4, __builtin_amdgcn_ds_read_tr16_b64_v4i16((__attribute__((address_space(3))) v4i16_t*)p)); }
__device__ __forceinline__ float rowmax(const f32x16& p0, const f32x16& p1) {
    float a = max3f(p0[0], p0[1], p1[0]), b = max3f(p0[2], p0[3], p1[1]); a = max3f(a, p1[2], p1[3]);
#pragma unroll
    for (int r = 4; r < 16; r += 4) { a = max3f(a, p0[r], p0[r + 1]); b = max3f(b, p0[r + 2], p0[r + 3]); a = max3f(a, p1[r], p1[r + 1]); b = max3f(b, p1[r + 2], p1[r + 3]); }
    const float m = max2f(a, b);
    auto rr = __builtin_amdgcn_permlane32_swap(__float_as_uint(m), __float_as_uint(m), false, false);
    return max2f(__uint_as_float(rr[0]), __uint_as_float(rr[1]));
}
__device__ __forceinline__ void pv(f32x16* o, int vb, bf16x8 pa0, bf16x8 pa1, bf16x8 pa2, bf16x8 pa3) {
#pragma unroll
    for (int d0 = 0; d0 < 2; ++d0) { s16x4 lo[4], hi[4];
#pragma unroll
        for (int ks = 0; ks < 4; ++ks) {
            asm volatile("ds_read_b64_tr_b16 %0,%1 offset:%c2" : "=&v"(lo[ks]) : "v"(vb), "i"(d0 * 4096 + ks * 1024) : "memory");
            asm volatile("ds_read_b64_tr_b16 %0,%1 offset:%c2" : "=&v"(hi[ks]) : "v"(vb), "i"(d0 * 4096 + ks * 1024 + 512) : "memory"); }
        asm volatile("s_waitcnt lgkmcnt(0)" ::: "memory"); SBAR();
#define PK(k) (bf16x8){lo[k][0], lo[k][1], lo[k][2], lo[k][3], hi[k][0], hi[k][1], hi[k][2], hi[k][3]}
        o[d0] = __builtin_amdgcn_mfma_f32_32x32x16_bf16(pa0, PK(0), o[d0], 0, 0, 0);
        o[d0] = __builtin_amdgcn_mfma_f32_32x32x16_bf16(pa1, PK(1), o[d0], 0, 0, 0);
        o[d0] = __builtin_amdgcn_mfma_f32_32x32x16_bf16(pa2, PK(2), o[d0], 0, 0, 0);
        o[d0] = __builtin_amdgcn_mfma_f32_32x32x16_bf16(pa3, PK(3), o[d0], 0, 0, 0);
#undef PK
    }
}
__device__ __forceinline__ void cmask(f32x16& p0, f32x16& p1, int jb, int wid) {
    if (jb > (wid >> 1)) {
#pragma unroll
        for (int r = 0; r < 16; ++r) { p0[r] = -INFINITY; p1[r] = -INFINITY; } }
}
template <int THRL, bool MASK> __device__ __forceinline__ void attn_unit(int q0, int NT, const bf16* Qh, int qp, const bf16* __restrict__ Kh, int kp, const bf16* __restrict__ Vh, int vp, bf16* Oh, int op, char* shm) {
    const int tid = threadIdx.x, lane = tid & 63, r32 = lane & 31, hi = lane >> 5; const int wid = __builtin_amdgcn_readfirstlane(tid >> 6);
    const bf16* Qw = Qh + (long)(q0 + wid * QBLK) * qp;
    const unsigned lds0 = (unsigned)(uintptr_t)shm;
    float* wsf = (float*)(shm + LDS_WS) + wid * 64;
    const bf16* ksrc = Kh + (long)lane * kp + wid * 8;
    const bf16* vsrc = Vh + (long)(16 * (wid & 3) + (lane >> 2)) * vp + (wid >> 2) * 32 + (lane & 3) * 8;
    const unsigned kdst = lds0 + LDS_K + wid * 1024, vdst = lds0 + LDS_V + wid * 1024;
#define DMA_K(t, slot) glds16(ksrc + (long)(t) * KVBLK * kp, (unsigned)__builtin_amdgcn_readfirstlane(kdst + (slot)))
#define DMA_V(t, slot) glds16(vsrc + (long)(t) * KVBLK * vp, (unsigned)__builtin_amdgcn_readfirstlane(vdst + (slot)))
    const int vb0 = (int)(lds0 + LDS_V) + ((lane >> 4) & 1) * 32 + (lane & 3) * 8 + (4 * hi + ((lane & 15) >> 2)) * 64;
    const char* Kbase = shm + LDS_K; bf16x8 kf[8];
    const lds_cptr shm3 = (lds_cptr)shm; const lds_cptr kp0 = shm3 + LDS_K + hi * 1024 + r32 * 16; const lds_cptr vp0 = shm3 + LDS_V + ((lane >> 4) & 1) * 32 + (lane & 3) * 8 + (4 * hi + ((lane & 15) >> 2)) * 64;
    DMA_K(0, 0); DMA_V(0, 0); DMA_K(1, SLOTB);
    bf16x8 qr[4];
#pragma unroll
    for (int d0 = 0; d0 < 4; ++d0) qr[d0] = *reinterpret_cast<const bf16x8*>(&Qw[(long)r32 * qp + d0 * 16 + hi * 8]);
    float mhat = 0.f, l_reg = 0.f; f32x16 o[2]; o[0] = f32x16{}; o[1] = f32x16{}; f32x16 negm = f32x16{}; asm volatile("" : "+v"(negm));
#define CMASK(P0, P1, t) do { if (MASK) { int jb_ = (t) - (NT - 4); if (jb_ >= 0) cmask(P0, P1, jb_, wid); } } while (0)
    bool resc = false;
#define START(P0, P1) do { const float rm = rowmax(P0, P1); resc = false; \
    { const float dl = rm; mhat = fadd_s(mhat, dl); \
      _Pragma("unroll") for (int r = 0; r < 16; ++r) { P0[r] = fsub_s(P0[r], dl); P1[r] = fsub_s(P1[r], dl); } \
      _Pragma("unroll") for (int r = 0; r < 16; ++r) negm[r] = -mhat; asm volatile("" : "+v"(negm)); } \
    _Pragma("unroll") for (int r = 0; r < 16; ++r) P0[r] = __builtin_amdgcn_exp2f(P0[r]); } while (0)
#define RESC() do { if (resc) { asm volatile("s_waitcnt lgkmcnt(0)" ::: "memory"); \
      _Pragma("unroll") for (int d_ = 0; d_ < 2; ++d_) _Pragma("unroll") for (int r = 0; r < 16; ++r) o[d_][r] *= wsf[crow(r, hi)]; } } while (0)
    f32x16 pA0, pA1, pB0, pB1;
    int sl_prev = 0, sl_cur = 0, sl_next = SLOTB;
#define ROT() do { sl_prev = sl_cur; sl_cur = sl_next; sl_next = (sl_next == (NSLOT - 1) * SLOTB) ? 0 : sl_next + SLOTB; } while (0)
    DMA_K(2, 2 * SLOTB);
    WAIT_BAR(3);
    qkt(pA0, pA1, Kbase, qr, negm, r32, hi); asm volatile("s_nop 15\n\ts_nop 7" : "+v"(pA0), "+v"(pA1)); CMASK(pA0, pA1, 0);
    START(pA0, pA1);
    _Pragma("unroll") for (int r = 0; r < 16; ++r) pA1[r] = __builtin_amdgcn_exp2f(pA1[r]);
    WAIT_BAR(0);
    DMA_K(3, 0); DMA_V(1, SLOTB);
    ROT();
    kload8(kf, kp0 + sl_cur);
    WAIT_BAR(2);
    s16x4 vlo[8], vhi[8]; u32x4 pw0, pw1, pw2, pw3;
#define PKW(P, B) cvtpk_s(P[B], P[B + 1])
#define PAF(k) __builtin_bit_cast(bf16x8, pw##k)
#define VFR(i) (bf16x8){vlo[i][0], vlo[i][1], vlo[i][2], vlo[i][3], vhi[i][0], vhi[i][1], vhi[i][2], vhi[i][3]}
#define PIN(x) asm volatile("" : "+v"(x))
#define MX3(a, b, c) __builtin_fmaxf(__builtin_fmaxf((a), (b)), (c))
#define GAPA(MF, A0, A1, A2, A3, W0, W1, PW) do { MF; sacc += A0; sacc += A1; sacc += A2; sacc += A3; PIN(sacc); W0; W1; PIN(PW); SBAR(); } while (0)
#define EX(v) __builtin_amdgcn_exp2f(v)
#define GAPB(MF, X, B) do { MF; X[B] = EX(X[B]); X[B + 1] = EX(X[B + 1]); X[B + 2] = EX(X[B + 2]); X[B + 3] = EX(X[B + 3]); PIN(X); SBAR(); } while (0)
#define VRD(i) do { vlo[i] = vtr(vp_ + (((i) >> 2) * 4096 + ((i) & 3) * 1024)); vhi[i] = vtr(vp_ + (((i) >> 2) * 4096 + ((i) & 3) * 1024 + 512)); } while (0)
#define KRD(G, j) do { if (G) { kload2(kf, kp0 + sl_next, j); SBAR(); } } while (0)
#define STEP(C0, C1, P0, P1, t, GK, GV, GL) do { SBAR(); \
    const lds_cptr vp_ = vp0 + sl_prev; \
    VRD(0); SBAR(); float sacc = (P0[0] + P0[1]); \
    GAPA(C0 = __builtin_amdgcn_mfma_f32_32x32x16_bf16(kf[0], qr[0], negm, 0, 0, 0), P0[2], P0[3], P0[4], P0[5],     pw0[0] = PKW(P0, 0), pw0[1] = PKW(P0, 2), pw0); \
    VRD(4); SBAR(); GAPA(C1 = __builtin_amdgcn_mfma_f32_32x32x16_bf16(kf[1], qr[0], negm, 0, 0, 0), P0[6], P0[7], P0[8], P0[9],     pw0[2] = PKW(P0, 4), pw0[3] = PKW(P0, 6), pw0); \
    VRD(1); SBAR(); GAPA(C0 = __builtin_amdgcn_mfma_f32_32x32x16_bf16(kf[2], qr[1], C0, 0, 0, 0),   P0[10], P0[11], P0[12], P0[13], pw1[0] = PKW(P0, 8), pw1[1] = PKW(P0, 10), pw1); \
    VRD(5); SBAR(); GAPA(C1 = __builtin_amdgcn_mfma_f32_32x32x16_bf16(kf[3], qr[1], C1, 0, 0, 0),   P0[14], P0[15], P1[0], P1[1],   pw1[2] = PKW(P0, 12), pw1[3] = PKW(P0, 14), pw1); \
    VRD(2); SBAR(); GAPA(C0 = __builtin_amdgcn_mfma_f32_32x32x16_bf16(kf[4], qr[2], C0, 0, 0, 0),   P1[2], P1[3], P1[4], P1[5],     pw2[0] = PKW(P1, 0), pw2[1] = PKW(P1, 2), pw2); \
    VRD(6); SBAR(); GAPA(C1 = __builtin_amdgcn_mfma_f32_32x32x16_bf16(kf[5], qr[2], C1, 0, 0, 0),   P1[6], P1[7], P1[8], P1[9],     pw2[2] = PKW(P1, 4), pw2[3] = PKW(P1, 6), pw2); \
    VRD(3); SBAR(); GAPA(C0 = __builtin_amdgcn_mfma_f32_32x32x16_bf16(kf[6], qr[3], C0, 0, 0, 0),   P1[10], P1[11], P1[12], P1[13], pw3[0] = PKW(P1, 8), pw3[1] = PKW(P1, 10), pw3); \
    VRD(7); SBAR(); GAPA(C1 = __builtin_amdgcn_mfma_f32_32x32x16_bf16(kf[7], qr[3], C1, 0, 0, 0),   P1[14], P1[15], 0.f, 0.f,       pw3[2] = PKW(P1, 12), pw3[3] = PKW(P1, 14), pw3); \
    l_reg += sacc; \
    if (GK) { DMA_K((t) + 3, sl_cur); } if (GV) { DMA_V((t) + 1, sl_next); } \
    CMASK(C0, C1, t); \
    { float a = MX3(C0[0], C0[1], C1[0]), b = MX3(C0[2], C0[3], C1[1]); a = MX3(a, C1[2], C1[3]); \
      _Pragma("unroll") for (int r = 4; r < 16; r += 4) { a = MX3(a, C0[r], C0[r + 1]); b = MX3(b, C0[r + 2], C0[r + 3]); a = MX3(a, C1[r], C1[r + 1]); b = MX3(b, C1[r + 2], C1[r + 3]); } \
      float rm = __builtin_fmaxf(a, b); { auto rr = __builtin_amdgcn_permlane32_swap(__float_as_uint(rm), __float_as_uint(rm), false, false); rm = __builtin_fmaxf(__uint_as_float(rr[0]), __uint_as_float(rr[1])); } \
      resc = false; \
      if (__builtin_expect(__any(rm > (float)THRL), 0)) { const float dl = __builtin_fmaxf(rm, 0.f); mhat += dl; \
        _Pragma("unroll") for (int r = 0; r < 16; ++r) { C0[r] -= dl; C1[r] -= dl; } \
        _Pragma("unroll") for (int r = 0; r < 16; ++r) negm[r] = -mhat; asm volatile("" : "+v"(negm)); \
        const float f = __builtin_amdgcn_exp2f(-dl); l_reg *= f; if (hi == 0) wsf[r32] = f; resc = true; } } \
    SBAR(); \
    GAPB(o[0] = __builtin_amdgcn_mfma_f32_32x32x16_bf16(PAF(0), VFR(0), o[0], 0, 0, 0), C0, 0); \
    GAPB(o[1] = __builtin_amdgcn_mfma_f32_32x32x16_bf16(PAF(0), VFR(4), o[1], 0, 0, 0), C0, 4); \
    KRD(GL, 0); GAPB(o[0] = __builtin_amdgcn_mfma_f32_32x32x16_bf16(PAF(1), VFR(1), o[0], 0, 0, 0), C0, 8); \
    KRD(GL, 1); GAPB(o[1] = __builtin_amdgcn_mfma_f32_32x32x16_bf16(PAF(1), VFR(5), o[1], 0, 0, 0), C0, 12); \
    KRD(GL, 2); GAPB(o[0] = __builtin_amdgcn_mfma_f32_32x32x16_bf16(PAF(2), VFR(2), o[0], 0, 0, 0), C1, 0); \
    KRD(GL, 3); GAPB(o[1] = __builtin_amdgcn_mfma_f32_32x32x16_bf16(PAF(2), VFR(6), o[1], 0, 0, 0), C1, 4); \
    GAPB(o[0] = __builtin_amdgcn_mfma_f32_32x32x16_bf16(PAF(3), VFR(3), o[0], 0, 0, 0), C1, 8); \
    GAPB(o[1] = __builtin_amdgcn_mfma_f32_32x32x16_bf16(PAF(3), VFR(7), o[1], 0, 0, 0), C1, 12); \
    } while (0)
    int t = 1;
#undef CMASK
#define CMASK(P0, P1, t) do {} while (0)
    for (; t + 5 < NT; t += 2) {
        STEP(pB0, pB1, pA0, pA1, t, true, true, true);     WAIT_BAR(2); RESC(); ROT();
        STEP(pA0, pA1, pB0, pB1, t + 1, true, true, true); WAIT_BAR(2); RESC(); ROT();
    }
#undef CMASK
#define CMASK(P0, P1, t) do { if (MASK) { int jb_ = (t) - (NT - 4); if (jb_ >= 0) cmask(P0, P1, jb_, wid); } } while (0)
#define ENDW(tt) do { if ((tt) + 3 < NT) { WAIT_BAR(2); } else if ((tt) + 2 < NT) { WAIT_BAR(1); } else { WAIT_BAR(0); } } while (0)
    for (; t + 1 < NT; t += 2) {
        STEP(pB0, pB1, pA0, pA1, t, (t + 3 < NT), (t + 1 < NT), (t + 1 < NT));       ENDW(t);     RESC(); ROT();
        STEP(pA0, pA1, pB0, pB1, t + 1, (t + 4 < NT), (t + 2 < NT), (t + 2 < NT));   ENDW(t + 1); RESC(); ROT();
    }
    STEP(pB0, pB1, pA0, pA1, NT - 1, false, false, false); RESC();
    { float sacc = pB0[0] + pB0[1]; _Pragma("unroll") for (int r = 2; r < 16; ++r) sacc += pB0[r]; _Pragma("unroll") for (int r = 0; r < 16; ++r) sacc += pB1[r]; l_reg += sacc;
      pw0 = (u32x4){PKW(pB0, 0), PKW(pB0, 2), PKW(pB0, 4), PKW(pB0, 6)}; pw1 = (u32x4){PKW(pB0, 8), PKW(pB0, 10), PKW(pB0, 12), PKW(pB0, 14)}; pw2 = (u32x4){PKW(pB1, 0), PKW(pB1, 2), PKW(pB1, 4), PKW(pB1, 6)}; pw3 = (u32x4){PKW(pB1, 8), PKW(pB1, 10), PKW(pB1, 12), PKW(pB1, 14)};
      SBAR(); pv(o, vb0 + sl_cur, PAF(0), PAF(1), PAF(2), PAF(3)); }
#undef PKW
#undef PAF
#undef VFR
#undef PIN
#undef MX3
#undef GAPA
#undef GAPB
#undef EX
#undef VRD
#undef KRD
#undef STEP
#undef ENDW
    { auto rr = __builtin_amdgcn_permlane32_swap(__float_as_uint(l_reg), __float_as_uint(l_reg), false, false); l_reg = __uint_as_float(rr[0]) + __uint_as_float(rr[1]); }
    if (hi == 0) wsf[32 + r32] = l_reg; asm volatile("s_waitcnt lgkmcnt(0)" ::: "memory");
    float rli[16];
#pragma unroll
    for (int r = 0; r < 16; ++r) rli[r] = __builtin_amdgcn_rcpf(wsf[32 + crow(r, hi)]);
    bf16* Ow = Oh + (long)(q0 + wid * QBLK) * op;
    { bf16* stg = (bf16*)(shm + LDS_OST) + wid * 2048;
#pragma unroll
      for (int r = 0; r < 16; ++r) { const int orow = crow(r, hi);
#pragma unroll
        for (int d0 = 0; d0 < 2; ++d0) stg[orow * 64 + d0 * 32 + r32] = __float2bfloat16(o[d0][r] * rli[r]); }
      asm volatile("s_waitcnt lgkmcnt(0)" ::: "memory");
#pragma unroll
      for (int i = 0; i < 4; ++i) { const int row = i * 8 + (lane >> 3), ch = lane & 7; const u32x4 v = *(const u32x4*)(stg + row * 64 + ch * 8); *(u32x4*)(Ow + (long)row * op + ch * 8) = v; } }
    asm volatile("s_waitcnt lgkmcnt(0)\n\ts_barrier" ::: "memory");
#undef DMA_K
#undef DMA_V
#undef CMASK
#undef START
#undef RESC
#undef ROT
}

constexpr int L2_K = 0, L2_V = 3 * 8192, L2_WS = L2_V + 4 * 16384, L2_OST = L2_WS + NW * 64 * 4, L2_BYTES = L2_OST + NW * 4096;
template <bool MASK> __device__ __forceinline__ void attn_unit2(int q0, int NT, const bf16* Qh, int qp, const bf16* __restrict__ Kh, int kp, const bf16* __restrict__ Vh, int vp, bf16* Oh, int op, char* shm) {
    const int tid = threadIdx.x, lane = tid & 63, r32 = lane & 31, hi = lane >> 5; const int wid = __builtin_amdgcn_readfirstlane(tid >> 6);
    const bf16* Qw = Qh + (long)(q0 + wid * QBLK) * qp;
    const unsigned lds0 = (unsigned)(uintptr_t)shm;
    float* wsf = (float*)(shm + L2_WS) + wid * 64;
    const bf16* ksrc = Kh + (long)lane * kp + wid * 8;
    const bf16* vsrc = Vh + (long)(16 * (wid & 3) + (lane >> 2)) * vp + (wid >> 2) * 32 + (lane & 3) * 8;
    const unsigned kdst = lds0 + L2_K + wid * 1024, vdst = lds0 + L2_V + wid * 1024;
#define DMA_K(t, slot) glds16(ksrc + (long)(t) * KVBLK * kp, (unsigned)__builtin_amdgcn_readfirstlane(kdst + (slot)))
#define DMA_V(t, vslot) do { glds16(vsrc + (long)(t) * KVBLK * vp, (unsigned)__builtin_amdgcn_readfirstlane(vdst + (vslot))); \
                            glds16(vsrc + (long)(t) * KVBLK * vp + 64, (unsigned)__builtin_amdgcn_readfirstlane(vdst + (vslot) + 8192)); } while (0)
    const int vb0 = (int)(lds0 + L2_V) + ((lane >> 4) & 1) * 32 + (lane & 3) * 8 + (4 * hi + ((lane & 15) >> 2)) * 64;
    const char* Kbase = shm + L2_K; bf16x8 kf[8];
    const lds_cptr shm3 = (lds_cptr)shm; const lds_cptr kp0 = shm3 + L2_K + hi * 1024 + r32 * 16; const lds_cptr vp0 = shm3 + L2_V + ((lane >> 4) & 1) * 32 + (lane & 3) * 8 + (4 * hi + ((lane & 15) >> 2)) * 64;
    DMA_K(0, 0); DMA_V(0, 0); DMA_K(1, SLOTB);
    bf16x8 qr[4];
#pragma unroll
    for (int d0 = 0; d0 < 4; ++d0) qr[d0] = *reinterpret_cast<const bf16x8*>(&Qw[(long)r32 * qp + d0 * 16 + hi * 8]);
    float l_reg = 0.f; f32x16 o[4]; o[0] = f32x16{}; o[1] = f32x16{}; o[2] = f32x16{}; o[3] = f32x16{};
    const f32x16 zero16 = f32x16{};
#define CMASK(P0, P1, t) do { if (MASK) { int jb_ = (t) - (NT - 4); if (jb_ >= 0) cmask(P0, P1, jb_, wid); } } while (0)
    f32x16 pA0, pA1, pB0, pB1;
    int sl_prev = 0, sl_cur = 0, sl_next = SLOTB;
    int vs_rd = 0, vs_wr = 3 * 16384;
#define ROT() do { sl_prev = sl_cur; sl_cur = sl_next; sl_next = (sl_next == (NSLOT - 1) * SLOTB) ? 0 : sl_next + SLOTB; vs_rd = (vs_rd + 16384) & 65535; vs_wr = (vs_wr + 16384) & 65535; } while (0)
    DMA_K(2, 2 * SLOTB); DMA_V(1, 16384);
    WAIT_BAR(6);
    qkt(pA0, pA1, Kbase, qr, zero16, r32, hi); CMASK(pA0, pA1, 0);
    _Pragma("unroll") for (int r = 0; r < 16; ++r) { pA0[r] = __builtin_amdgcn_exp2f(pA0[r]); pA1[r] = __builtin_amdgcn_exp2f(pA1[r]); }
    WAIT_BAR(2);
    DMA_K(3, 0); DMA_V(2, 2 * 16384);
    sl_prev = sl_cur; sl_cur = sl_next; sl_next = 2 * SLOTB;
    kload8(kf, kp0 + sl_cur);
    WAIT_BAR(5);
    s16x4 f0lo, f0hi, f1lo, f1hi, f2lo, f2hi, f3lo, f3hi; u32x4 pw0, pw1, pw2, pw3;
#define PKW(P, B) cvtpk_s(P[B], P[B + 1])
#define PAF(k) __builtin_bit_cast(bf16x8, pw##k)
#define PIN(x) asm volatile("" : "+v"(x))
#define EX(v) __builtin_amdgcn_exp2f(v)
#define VOFF(id) ((((id) >> 2) * 4096) + (((id) & 3) * 1024))
#define VRD2(F, id) do { F##lo = vtr(vp_ + VOFF(id)); F##hi = vtr(vp_ + VOFF(id) + 512); } while (0)
#define VFR2(F) (bf16x8){F##lo[0], F##lo[1], F##lo[2], F##lo[3], F##hi[0], F##hi[1], F##hi[2], F##hi[3]}
#define GAPA(MF, A0, A1, A2, A3, W0, W1, PW) do { MF; sacc += A0; sacc += A1; sacc += A2; sacc += A3; PIN(sacc); W0; W1; PIN(PW); SBAR(); } while (0)
#define GAPB(MF, RD, X, B) do { MF; RD; X[B] = EX(X[B]); X[B + 1] = EX(X[B + 1]); PIN(X); SBAR(); } while (0)
#define KRD(G, j) do { if (G) { kload2(kf, kp0 + sl_next, j); SBAR(); } } while (0)
#define MF32(a, b, c) __builtin_amdgcn_mfma_f32_32x32x16_bf16(a, b, c, 0, 0, 0)
#define STEP(C0, C1, P0, P1, t, GK, GV, GL) do { SBAR(); __builtin_amdgcn_s_setprio(ATTN_PRIO_A); \
    const lds_cptr vp_ = vp0 + vs_rd; \
    float sacc = (P0[0] + P0[1]); \
    GAPA(C0 = MF32(kf[0], qr[0], zero16), P0[2], P0[3], P0[4], P0[5],     pw0[0] = PKW(P0, 0), pw0[1] = PKW(P0, 2), pw0); \
    GAPA(C1 = MF32(kf[1], qr[0], zero16), P0[6], P0[7], P0[8], P0[9],     pw0[2] = PKW(P0, 4), pw0[3] = PKW(P0, 6), pw0); \
    GAPA(C0 = MF32(kf[2], qr[1], C0),     P0[10], P0[11], P0[12], P0[13], pw1[0] = PKW(P0, 8), pw1[1] = PKW(P0, 10), pw1); \
    GAPA(C1 = MF32(kf[3], qr[1], C1),     P0[14], P0[15], P1[0], P1[1],   pw1[2] = PKW(P0, 12), pw1[3] = PKW(P0, 14), pw1); \
    VRD2(f0, 0); SBAR();  GAPA(C0 = MF32(kf[4], qr[2], C0), P1[2], P1[3], P1[4], P1[5],     pw2[0] = PKW(P1, 0), pw2[1] = PKW(P1, 2), pw2); \
    VRD2(f1, 4); SBAR();  GAPA(C1 = MF32(kf[5], qr[2], C1), P1[6], P1[7], P1[8], P1[9],     pw2[2] = PKW(P1, 4), pw2[3] = PKW(P1, 6), pw2); \
    VRD2(f2, 8); SBAR();  GAPA(C0 = MF32(kf[6], qr[3], C0), P1[10], P1[11], P1[12], P1[13], pw3[0] = PKW(P1, 8), pw3[1] = PKW(P1, 10), pw3); \
    VRD2(f3, 12); SBAR(); GAPA(C1 = MF32(kf[7], qr[3], C1), P1[14], P1[15], 0.f, 0.f,       pw3[2] = PKW(P1, 12), pw3[3] = PKW(P1, 14), pw3); \
    l_reg += sacc; __builtin_amdgcn_s_setprio(0); \
    if (GK) { DMA_K((t) + 3, sl_cur); } if (GV) { DMA_V((t) + 2, vs_wr); } \
    CMASK(C0, C1, t); \
    SBAR(); __builtin_amdgcn_s_setprio(ATTN_PRIO_B); \
    GAPB(o[0] = MF32(PAF(0), VFR2(f0), o[0]), VRD2(f0, 1),  C0, 0); \
    GAPB(o[1] = MF32(PAF(0), VFR2(f1), o[1]), VRD2(f1, 5),  C0, 2); \
    GAPB(o[2] = MF32(PAF(0), VFR2(f2), o[2]), VRD2(f2, 9),  C0, 4); \
    GAPB(o[3] = MF32(PAF(0), VFR2(f3), o[3]), VRD2(f3, 13), C0, 6); \
    KRD(GL, 0); GAPB(o[0] = MF32(PAF(1), VFR2(f0), o[0]), VRD2(f0, 2),  C0, 8); \
    GAPB(o[1] = MF32(PAF(1), VFR2(f1), o[1]), VRD2(f1, 6),  C0, 10); \
    KRD(GL, 1); GAPB(o[2] = MF32(PAF(1), VFR2(f2), o[2]), VRD2(f2, 10), C0, 12); \
    GAPB(o[3] = MF32(PAF(1), VFR2(f3), o[3]), VRD2(f3, 14), C0, 14); \
    KRD(GL, 2); GAPB(o[0] = MF32(PAF(2), VFR2(f0), o[0]), VRD2(f0, 3),  C1, 0); \
    GAPB(o[1] = MF32(PAF(2), VFR2(f1), o[1]), VRD2(f1, 7),  C1, 2); \
    KRD(GL, 3); GAPB(o[2] = MF32(PAF(2), VFR2(f2), o[2]), VRD2(f2, 11), C1, 4); \
    GAPB(o[3] = MF32(PAF(2), VFR2(f3), o[3]), VRD2(f3, 15), C1, 6); \
    GAPB(o[0] = MF32(PAF(3), VFR2(f0), o[0]), (void)0, C1, 8); \
    GAPB(o[1] = MF32(PAF(3), VFR2(f1), o[1]), (void)0, C1, 10); \
    GAPB(o[2] = MF32(PAF(3), VFR2(f2), o[2]), (void)0, C1, 12); \
    GAPB(o[3] = MF32(PAF(3), VFR2(f3), o[3]), (void)0, C1, 14); __builtin_amdgcn_s_setprio(0); \
    } while (0)
    int t = 1;
#undef CMASK
#define CMASK(P0, P1, t) do {} while (0)
    for (; t + 5 < NT; t += 2) {
        STEP(pB0, pB1, pA0, pA1, t, true, true, true);     WAIT_BAR(5); ROT();
        STEP(pA0, pA1, pB0, pB1, t + 1, true, true, true); WAIT_BAR(5); ROT();
    }
#undef CMASK
#define CMASK(P0, P1, t) do { if (MASK) { int jb_ = (t) - (NT - 4); if (jb_ >= 0) cmask(P0, P1, jb_, wid); } } while (0)
#define ENDW(tt) do { if ((tt) + 3 < NT) { WAIT_BAR(5); } else if ((tt) + 2 < NT) { WAIT_BAR(4); } else { WAIT_BAR(0); } } while (0)
    for (; t + 1 < NT; t += 2) {
        STEP(pB0, pB1, pA0, pA1, t, (t + 3 < NT), (t + 2 < NT), (t + 1 < NT));       ENDW(t);     ROT();
        STEP(pA0, pA1, pB0, pB1, t + 1, (t + 4 < NT), (t + 3 < NT), (t + 2 < NT));   ENDW(t + 1); ROT();
    }
    STEP(pB0, pB1, pA0, pA1, NT - 1, false, false, false);
    { float sacc = pB0[0] + pB0[1]; _Pragma("unroll") for (int r = 2; r < 16; ++r) sacc += pB0[r]; _Pragma("unroll") for (int r = 0; r < 16; ++r) sacc += pB1[r]; l_reg += sacc;
      pw0 = (u32x4){PKW(pB0, 0), PKW(pB0, 2), PKW(pB0, 4), PKW(pB0, 6)}; pw1 = (u32x4){PKW(pB0, 8), PKW(pB0, 10), PKW(pB0, 12), PKW(pB0, 14)}; pw2 = (u32x4){PKW(pB1, 0), PKW(pB1, 2), PKW(pB1, 4), PKW(pB1, 6)}; pw3 = (u32x4){PKW(pB1, 8), PKW(pB1, 10), PKW(pB1, 12), PKW(pB1, 14)};
      SBAR();
      const lds_cptr vp_ = vp0 + ((vs_rd + 16384) & 65535);
#pragma unroll
      for (int db = 0; db < 4; ++db) { VRD2(f0, db * 4 + 0); VRD2(f1, db * 4 + 1); VRD2(f2, db * 4 + 2); VRD2(f3, db * 4 + 3);
          o[db] = MF32(PAF(0), VFR2(f0), o[db]); o[db] = MF32(PAF(1), VFR2(f1), o[db]); o[db] = MF32(PAF(2), VFR2(f2), o[db]); o[db] = MF32(PAF(3), VFR2(f3), o[db]); } }
#undef PKW
#undef PAF
#undef PIN
#undef EX
#undef VOFF
#undef VRD2
#undef VFR2
#undef GAPA
#undef GAPB
#undef KRD
#undef MF32
#undef STEP
#undef ENDW
    { auto rr = __builtin_amdgcn_permlane32_swap(__float_as_uint(l_reg), __float_as_uint(l_reg), false, false); l_reg = __uint_as_float(rr[0]) + __uint_as_float(rr[1]); }
    if (hi == 0) wsf[32 + r32] = l_reg; asm volatile("s_waitcnt lgkmcnt(0)" ::: "memory");
    float rli[16];
#pragma unroll
    for (int r = 0; r < 16; ++r) rli[r] = __builtin_amdgcn_rcpf(wsf[32 + crow(r, hi)]);
    bf16* Ow = Oh + (long)(q0 + wid * QBLK) * op;
    { bf16* stg = (bf16*)(shm + L2_OST) + wid * 2048;
#pragma unroll
      for (int dh = 0; dh < 2; ++dh) {
#pragma unroll
        for (int r = 0; r < 16; ++r) { const int orow = crow(r, hi);
#pragma unroll
          for (int d0 = 0; d0 < 2; ++d0) stg[orow * 64 + d0 * 32 + r32] = __float2bfloat16(o[dh * 2 + d0][r] * rli[r]); }
        asm volatile("s_waitcnt lgkmcnt(0)" ::: "memory");
#pragma unroll
        for (int i = 0; i < 4; ++i) { const int row = i * 8 + (lane >> 3), ch = lane & 7; const u32x4 v = *(const u32x4*)(stg + row * 64 + ch * 8); *(u32x4*)(Ow + (long)row * op + dh * 64 + ch * 8) = v; }
        asm volatile("s_waitcnt lgkmcnt(0)" ::: "memory"); } }
    asm volatile("s_waitcnt lgkmcnt(0)\n\ts_barrier" ::: "memory");
#undef DMA_K
#undef DMA_V
#undef CMASK
#undef ROT
}
#undef SBAR
#undef WAIT_BAR
}

#define XB_TMO      128
#define XB_XCNT(j)  (256  + 64 * (j))
#define XB_XSUB(j)  (1280 + 64 * (j))
#define XB_XGEN(j)  (2304 + 64 * (j))
#define XB_TOP      3328
#define XB_TOPGEN   3392
#define XCD_BAR_WORDS 3456
#define XB_SPIN_CAP (1u << 22)
__device__ __forceinline__ unsigned xb_ld(unsigned* p)              { return __hip_atomic_load(p, __ATOMIC_RELAXED, __HIP_MEMORY_SCOPE_AGENT); }
__device__ __forceinline__ unsigned xb_add(unsigned* p, unsigned v) { return __hip_atomic_fetch_add(p, v, __ATOMIC_RELAXED, __HIP_MEMORY_SCOPE_AGENT); }
__device__ __forceinline__ unsigned xb_xcc_id() { return (unsigned)__builtin_amdgcn_s_getreg((3 << 11) | 20) & 0xFu; }
#define XB_SPIN(cond, bar) do { unsigned _sp = 0; while (cond) { __builtin_amdgcn_s_sleep(1); \
    if ((++_sp & 255u) == 0u) { if (xb_ld(&(bar)[XB_TMO])) break; if (_sp > XB_SPIN_CAP) { atomicAdd(&(bar)[XB_TMO], 1u); break; } } } } while (0)
struct XcdBarrier { unsigned* bar; unsigned x; volatile LAS unsigned* st; };
__device__ __forceinline__ XcdBarrier xcd_barrier_post(unsigned* bar, volatile LAS unsigned* st) {
    XcdBarrier b; b.bar = bar; b.x = xb_xcc_id(); b.st = st;
    if (threadIdx.x == 0) (void)xb_add(&bar[XB_XCNT(b.x)], 1u);
    return b;
}
__device__ __forceinline__ void xcd_barrier_complete(unsigned* bar, unsigned x, unsigned& nloc, unsigned& nx) {
    const unsigned G = gridDim.x * gridDim.y * gridDim.z;
    unsigned sum, cnt, mine, sp = 0u;
    for (;;) {
        sum = 0u; cnt = 0u; mine = 0u;
#pragma unroll
        for (unsigned j = 0; j < 16; ++j) { const unsigned c = xb_ld(&bar[XB_XCNT(j)]); sum += c; cnt += (c > 0u) ? 1u : 0u; mine = (j == x) ? c : mine; }
        if (sum == G) break;
        __builtin_amdgcn_s_sleep(1);
        if ((++sp & 255u) == 0u) { if (xb_ld(&bar[XB_TMO])) break; if (sp > XB_SPIN_CAP) { atomicAdd(&bar[XB_TMO], 1u); break; } }
    }
    nloc = mine > 0u ? mine : 1u; nx = cnt > 0u ? cnt : 1u;
}
__device__ __forceinline__ void xcd_barrier(const XcdBarrier& b) {
    asm volatile("s_waitcnt vmcnt(0)" ::: "memory");
    __syncthreads();
    if (threadIdx.x == 0) {
        unsigned* bar = b.bar;
        __builtin_amdgcn_s_waitcnt(0);
        unsigned nloc = b.st[0], nx = b.st[1];
        if (nloc == 0u) { xcd_barrier_complete(bar, b.x, nloc, nx); b.st[0] = nloc; b.st[1] = nx; }
        const unsigned old = xb_add(&bar[XB_XSUB(b.x)], 1u);
        const unsigned gen = old / nloc;
        if (old + 1u == (gen + 1u) * nloc) {
            __builtin_amdgcn_fence(__ATOMIC_RELEASE, "agent");
            asm volatile("s_waitcnt vmcnt(0)" ::: "memory");
            const unsigned og = xb_add(&bar[XB_TOP], 1u);
            const unsigned tg = og / nx;
            if (og + 1u == (tg + 1u) * nx) xb_add(&bar[XB_TOPGEN], 1u);
            else XB_SPIN(xb_ld(&bar[XB_TOPGEN]) == tg, bar);
            __builtin_amdgcn_fence(__ATOMIC_ACQUIRE, "agent");
            xb_add(&bar[XB_XGEN(b.x)], 1u);
            asm volatile("s_waitcnt vmcnt(0)" ::: "memory");
        } else {
            XB_SPIN(xb_ld(&bar[XB_XGEN(b.x)]) == gen, bar);
            __builtin_amdgcn_fence(__ATOMIC_ACQUIRE, "agent");
            asm volatile("s_waitcnt vmcnt(0)" ::: "memory");
        }
    }
    __syncthreads();
}

constexpr int RING_BYTES = 131072;
constexpr int MISC_OFF = RING_BYTES;
constexpr int LDS_BYTES = 147456;
constexpr int NWAVES = 8;

struct Args {
    const float* in[29]; float* out; unsigned char* ws; int ph_lo, ph_hi;
};
enum { I_X = 0, I_MEM, I_NORM1, I_WIN, I_BGATE, I_QN, I_KN, I_LQ1, I_LK1, I_LQ2, I_LK2, I_SUBLN, I_WPOOL, I_PSCALE, I_MEMNORM, I_WMKV, I_MQN, I_MKN, I_WBRD, I_WBRP, I_WBRM, I_WOUT, I_NORM2,
       I_WROUTER, I_BROUTER, I_WGU, I_BGU, I_WD, I_BD };

__device__ __forceinline__ unsigned f2bf(float f) { unsigned u = __builtin_bit_cast(unsigned, f); return (u + 0x7fffu + ((u >> 16) & 1u)) >> 16; }
__device__ __forceinline__ unsigned pk2(float lo, float hi) { return f2bf(lo) | (f2bf(hi) << 16); }
__device__ __forceinline__ void p0_transpose_item(const float* W, int K, int N, bf16_t* WT, LAS float* scr, int item, int lane, int ldo = 0, float qs = 0.f) {
    if (ldo == 0) ldo = K;
    const int nblk = N / 64, kb = item / nblk, nb = item % nblk, k0 = 64 * kb, n0 = 64 * nb;
    const int kr = lane >> 3, n4 = (lane & 7) * 4;
    f32x4 v[16];
#pragma unroll
    for (int i = 0; i < 16; ++i) v[i] = *(const f32x4*)(W + (size_t)(k0 + 8 * (i & 7) + kr) * N + n0 + 32 * (i >> 3) + n4);
#pragma unroll
    for (int h = 0; h < 2; ++h) {
#pragma unroll
        for (int i = 0; i < 8; ++i)
#pragma unroll
            for (int j = 0; j < 4; ++j) scr[(n4 + j) * 68 + 8 * i + kr] = v[h * 8 + i][j];
        LDS_WAIT(); asm volatile("" ::: "memory");
        const int c = lane & 7;
#pragma unroll
        for (int jj = 0; jj < 4; ++jj) { const int nrow = 8 * jj + (lane >> 3); const LAS f32x4* sp = (const LAS f32x4*)(scr + nrow * 68 + 8 * c);
            f32x4 a = sp[0], b = sp[1];
            if (qs != 0.f) { for (int q = 0; q < 4; ++q) { a[q] = fminf(fmaxf(rintf(a[q] * qs), -127.f), 127.f); b[q] = fminf(fmaxf(rintf(b[q] * qs), -127.f), 127.f); } }
            u32x4 o; o.x = pk2(a[0], a[1]); o.y = pk2(a[2], a[3]); o.z = pk2(b[0], b[1]); o.w = pk2(b[2], b[3]);
            *(u32x4*)(WT + (size_t)(n0 + 32 * h + nrow) * ldo + k0 + 8 * c) = o; }
        LDS_WAIT(); asm volatile("" ::: "memory");
    }
}
__device__ __forceinline__ void p0_transpose_item_f8(const float* W, int K, int N, unsigned char* WT, LAS float* scr, int item, int lane) {
    const int nblk = N / 64, kb = item / nblk, nb = item % nblk, k0 = 64 * kb, n0 = 64 * nb;
    const int kr = lane >> 3, n4 = (lane & 7) * 4;
    f32x4 v[16];
#pragma unroll
    for (int i = 0; i < 16; ++i) v[i] = *(const f32x4*)(W + (size_t)(k0 + 8 * (i & 7) + kr) * N + n0 + 32 * (i >> 3) + n4);
#pragma unroll
    for (int h = 0; h < 2; ++h) {
#pragma unroll
        for (int i = 0; i < 8; ++i)
#pragma unroll
            for (int j = 0; j < 4; ++j) scr[(n4 + j) * 68 + 8 * i + kr] = v[h * 8 + i][j];
        LDS_WAIT(); asm volatile("" ::: "memory");
        const int c = lane & 7;
#pragma unroll
        for (int jj = 0; jj < 4; ++jj) { const int nrow = 8 * jj + (lane >> 3); const LAS f32x4* sp = (const LAS f32x4*)(scr + nrow * 68 + 8 * c);
            const f32x4 a = sp[0] * W8_SCALE, b = sp[1] * W8_SCALE;
            u32x2 o; o.x = pk4_fp8(a[0], a[1], a[2], a[3]); o.y = pk4_fp8(b[0], b[1], b[2], b[3]);
            *(u32x2*)(WT + (size_t)(n0 + 32 * h + nrow) * K + k0 + 8 * c) = o; }
        LDS_WAIT(); asm volatile("" ::: "memory");
    }
}
__device__ __forceinline__ void p0_transpose_item_i8(const float* W, int K, int N, unsigned char* WT, LAS float* scr, int item, int lane, float qs) {
    const int nblk = N / 64, kb = item / nblk, nb = item % nblk, k0 = 64 * kb, n0 = 64 * nb;
    const int kr = lane >> 3, n4 = (lane & 7) * 4;
    f32x4 v[16];
#pragma unroll
    for (int i = 0; i < 16; ++i) v[i] = *(const f32x4*)(W + (size_t)(k0 + 8 * (i & 7) + kr) * N + n0 + 32 * (i >> 3) + n4);
#pragma unroll
    for (int h = 0; h < 2; ++h) {
#pragma unroll
        for (int i = 0; i < 8; ++i)
#pragma unroll
            for (int j = 0; j < 4; ++j) scr[(n4 + j) * 68 + 8 * i + kr] = v[h * 8 + i][j];
        LDS_WAIT(); asm volatile("" ::: "memory");
        const int c = lane & 7;
#pragma unroll
        for (int jj = 0; jj < 4; ++jj) { const int nrow = 8 * jj + (lane >> 3); const LAS f32x4* sp = (const LAS f32x4*)(scr + nrow * 68 + 8 * c);
            const f32x4 a = sp[0] * qs, b = sp[1] * qs;
            u32x2 o; o.x = pk4_i8(a[0], a[1], a[2], a[3]); o.y = pk4_i8(b[0], b[1], b[2], b[3]);
            *(u32x2*)(WT + (size_t)(n0 + 32 * h + nrow) * K + k0 + 8 * c) = o; }
        LDS_WAIT(); asm volatile("" ::: "memory");
    }
}
__device__ __forceinline__ void rms_row_to_q(const float* xrow, const float* gain, unsigned char* orow, float* rs, int lane) {
    const f32x4* xr = (const f32x4*)xrow + lane; const f32x4* gr = (const f32x4*)gain + lane;
    f32x4 v[4]; float s = 0.f;
#pragma unroll
    for (int j = 0; j < 4; ++j) { v[j] = xr[64 * j]; s += (v[j].x * v[j].x + v[j].y * v[j].y) + (v[j].z * v[j].z + v[j].w * v[j].w); }
    const float rstd = 1.f / sqrtf(wave_sum(s) * (1.f / 1024.f) + RMS_EPS);
    float am = 0.f;
#pragma unroll
    for (int j = 0; j < 4; ++j) { const f32x4 g = gr[64 * j]; v[j] = v[j] * rstd * g; am = fmaxf(am, fmaxf(fmaxf(fabsf(v[j].x), fabsf(v[j].y)), fmaxf(fabsf(v[j].z), fabsf(v[j].w)))); }
#pragma unroll
    for (int o = 1; o < 64; o <<= 1) am = fmaxf(am, __shfl_xor(am, o));
    am = fmaxf(am, 1e-20f); const float qi = 127.0f / am;
    unsigned* o4 = (unsigned*)orow + lane;
#pragma unroll
    for (int j = 0; j < 4; ++j) o4[64 * j] = pk4_i8(v[j].x * qi, v[j].y * qi, v[j].z * qi, v[j].w * qi);
    if (lane == 0) rs[0] = am * (1.0f / 127.0f);
}
__device__ __forceinline__ void rms_row_to_bf16(const float* xrow, const float* gain, bf16_t* orow, int lane) {
    const f32x4* xr = (const f32x4*)xrow + lane; const f32x4* gr = (const f32x4*)gain + lane;
    f32x4 v[4]; float s = 0.f;
#pragma unroll
    for (int j = 0; j < 4; ++j) { v[j] = xr[64 * j]; s += (v[j].x * v[j].x + v[j].y * v[j].y) + (v[j].z * v[j].z + v[j].w * v[j].w); }
    const float rstd = 1.f / sqrtf(wave_sum(s) * (1.f / 1024.f) + RMS_EPS);
    u32x2* o8 = (u32x2*)orow + lane;
#pragma unroll
    for (int j = 0; j < 4; ++j) { const f32x4 g = gr[64 * j]; u32x2 w; w.x = pk2(v[j].x * rstd * g.x, v[j].y * rstd * g.y); w.y = pk2(v[j].z * rstd * g.z, v[j].w * rstd * g.w); o8[64 * j] = w; }
}

__device__ __forceinline__ void cvt_item64_f8(const float* W, int K, int N, unsigned char* WT, int item, int lane) {
    const int nblk = N / 64, kb = item / nblk, nb = item % nblk, k0 = 64 * kb, n0 = 64 * nb;
    const char* base = (const char*)(W + (size_t)k0 * N + n0);
    unsigned off = (unsigned)lane * 4u; const unsigned rstep = (unsigned)N * 4u;
    float v[64];
#pragma unroll
    for (int j = 0; j < 64; ++j) { v[j] = __builtin_nontemporal_load((const float*)(base + off)); off += rstep; }
    unsigned char* dst = WT + (size_t)(n0 + lane) * K + k0;
#pragma unroll
    for (int c = 0; c < 4; ++c) { u32x4 o;
#pragma unroll
        for (int q = 0; q < 4; ++q) { int r = __builtin_amdgcn_cvt_pk_fp8_f32(v[16 * c + 4 * q] * W8_SCALE, v[16 * c + 4 * q + 1] * W8_SCALE, 0, false);
            r = __builtin_amdgcn_cvt_pk_fp8_f32(v[16 * c + 4 * q + 2] * W8_SCALE, v[16 * c + 4 * q + 3] * W8_SCALE, r, true); o[q] = (unsigned)r; }
        *(u32x4*)(dst + 16 * c) = o; }
}
struct CvtJob {
    const float* wgu; const float* wd; unsigned char* wgu_t; unsigned char* wd_t; int ngw, gw, lane;
    __device__ __forceinline__ void item(int j) const {
        const int it = gw + j * ngw; if (it >= 24576) return;
        const bool gu = it < 16384; const int r = gu ? it : it - 16384, e = gu ? (r >> 9) : (r >> 8), idx = gu ? (r & 511) : (r & 255), N = gu ? 2048 : 1024;
        const float* W = gu ? wgu + (size_t)e * 1024 * 2048 : wd + (size_t)e * 1024 * 1024; unsigned char* WT = gu ? wgu_t + (size_t)e * 2048 * 1024 : wd_t + (size_t)e * 1024 * 1024;
        cvt_item64_f8(W, 1024, N, WT, idx, lane);
    }
    __device__ __forceinline__ void item3(int j) const {
        const char* base[3]; unsigned char* dst[3]; unsigned rstep[3]; bool ok[3]; float v[3][64];
#pragma unroll
        for (int b = 0; b < 3; ++b) { const int it0 = gw + (j + b) * ngw; ok[b] = it0 < 24576; const int it = ok[b] ? it0 : gw;
            const bool gu = it < 16384; const int r = gu ? it : it - 16384, e = gu ? (r >> 9) : (r >> 8), idx = gu ? (r & 511) : (r & 255), N = gu ? 2048 : 1024;
            const float* W = gu ? wgu + (size_t)e * 1024 * 2048 : wd + (size_t)e * 1024 * 1024; unsigned char* WT = gu ? wgu_t + (size_t)e * 2048 * 1024 : wd_t + (size_t)e * 1024 * 1024;
            const int nblk = N / 64, kb = idx / nblk, nb = idx % nblk, k0 = 64 * kb, n0 = 64 * nb;
            base[b] = (const char*)(W + (size_t)k0 * N + n0); dst[b] = WT + (size_t)(n0 + lane) * 1024 + k0; rstep[b] = (unsigned)N * 4u; }
#pragma unroll
        for (int b = 0; b < 3; ++b) { unsigned off = (unsigned)lane * 4u;
#pragma unroll
            for (int q = 0; q < 64; ++q) { v[b][q] = __builtin_nontemporal_load((const float*)(base[b] + off)); off += rstep[b]; } }
#pragma unroll
        for (int b = 0; b < 3; ++b) if (ok[b]) {
#pragma unroll
            for (int c = 0; c < 4; ++c) { u32x4 o;
#pragma unroll
                for (int q = 0; q < 4; ++q) { int r = __builtin_amdgcn_cvt_pk_fp8_f32(v[b][16 * c + 4 * q] * W8_SCALE, v[b][16 * c + 4 * q + 1] * W8_SCALE, 0, false);
                    r = __builtin_amdgcn_cvt_pk_fp8_f32(v[b][16 * c + 4 * q + 2] * W8_SCALE, v[b][16 * c + 4 * q + 3] * W8_SCALE, r, true); o[q] = (unsigned)r; }
                *(u32x4*)(dst[b] + 16 * c) = o; } }
    }
};
struct PostCvt { CvtJob J; int jbase, jend; __device__ __forceinline__ void operator()(int ui) const { const int j = jbase + ui; if (j < jend) J.item(j); } };
struct Args;
typedef __attribute__((address_space(4))) const Args* kargs_t;
__device__ __forceinline__ kargs_t kargs() { kargs_t p = (kargs_t)__builtin_amdgcn_kernarg_segment_ptr(); asm volatile("" : "+s"(p)); return p; }
__global__ void __launch_bounds__(NWAVES * 64, 2) fwd_kernel(Args args) {
    extern __shared__ __attribute__((aligned(16))) unsigned char lds_raw[];
    cg::grid_group grid = cg::this_grid();
    LAS unsigned char* lds = (LAS unsigned char*)lds_raw;
    const int tid = threadIdx.x, lane = tid & 63, wave = __builtin_amdgcn_readfirstlane(tid >> 6);
    const int G = gridDim.x, bx = blockIdx.x; const int vcu = (G % 8 == 0) ? (bx % 8) * (G / 8) + bx / 8 : bx;
    const int gw = vcu * NWAVES + wave, NGW = G * NWAVES;
    const int lo = args.ph_lo, hi = args.ph_hi;
    if (tid < 64) ((LAS unsigned*)(lds + MISC_OFF + 1024))[tid] = 0u;
    __syncthreads();
    const XcdBarrier xbar = xcd_barrier_post((unsigned*)(args.ws + WS_CTL) + CW_BAR, (volatile LAS unsigned*)(lds + MISC_OFF + 1024));
#ifndef PHMASK
#define PHMASK 0x3ff
#endif
#define IN(k) (((PHMASK >> (k)) & 1) && lo <= (k) && (k) < hi)
#define GSYNC() do { asm volatile("s_waitcnt vmcnt(0) lgkmcnt(0)" ::: "memory"); __syncthreads(); grid.sync(); asm volatile("s_waitcnt vmcnt(0)" ::: "memory"); __syncthreads(); } while (0)
#define SEAM(k) do { if (lo <= (k) && (k) + 1 < hi) { xcd_barrier(xbar); } } while (0)
#define WSP(TY, off) ((TY*)(ka->ws + (off)))
#define WIN_T WSP(bf16_t, WS_WIN_T)
#define WBRD_T WSP(bf16_t, WS_WBRD_T)
#define WBRP_T WSP(bf16_t, WS_WBRP_T)
#define WBRM_T WSP(bf16_t, WS_WBRM_T)
#define WOUT_T WSP(bf16_t, WS_WOUT_T)
#define WMKV_T WSP(bf16_t, WS_WMKV_T)
#define WGU_T WSP(bf16_t, WS_WGU_T)
#define WD_T WSP(bf16_t, WS_WD_T)
#define XN WSP(bf16_t, WS_XN)
#define Qb WSP(bf16_t, WS_Q)
#define Kb WSP(bf16_t, WS_K)
#define Vb WSP(bf16_t, WS_V)
#define Ub WSP(bf16_t, WS_U)
#define MQb WSP(bf16_t, WS_MQ)
#define OC WSP(bf16_t, WS_OC)
#define GATES WSP(bf16_t, WS_GATES)
#define YCAT WSP(bf16_t, WS_YCAT)
#define MERGF WSP(float, WS_MERGF)
#define MERGB WSP(bf16_t, WS_MERGB)
#define XG WSP(bf16_t, WS_XG)
#define ACT WSP(bf16_t, WS_A)
#define Y4 WSP(bf16_t, WS_B)
#define MEMN WSP(bf16_t, WS_MEMN)
#define MKV WSP(bf16_t, WS_MKV)
#define ROPE WSP(f32x2, WS_ROPE)
#define WR2 WSP(float, WS_WR2)
#define ROUTEW WSP(float, WS_ROUTEW)
#define LAMP WSP(float, WS_LAM)
#define LIST WSP(u32x2, WS_LIST)
#define CNT WSP(unsigned, WS_CTL)
#define OUT (ka->out)
#define KA const kargs_t ka = kargs()

    if (lo > 1000) GSYNC();
    if (IN(0)) for (int rep_ = 0; rep_ < 1 + ((REPEAT_MASK >> 0) & 1); ++rep_) { KA; if (rep_) __syncthreads();
        LAS float* scr = (LAS float*)(lds + wave * 16384);
        constexpr int I0 = 16 * 80, I1 = 8 * 16, I2 = 4 * 16, I3 = 4 * 16, I4 = 16 * 16, I5 = 16 * 8, I6 = 0, I7 = 0;
        constexpr int NITEMS = I0 + I1 + I2 + I3 + I4 + I5 + I6 + I7;
        for (int it = gw; it < NITEMS; it += NGW) {
            int r = it;
            if (r < I0) { p0_transpose_item_i8(ka->in[I_WIN], 1024, 5120, (unsigned char*)WIN_T, scr, r, lane, WQ_IN); continue; } r -= I0;
            if (r < I1) { p0_transpose_item(ka->in[I_WBRD], 512, 1024, WBRD_T, scr, r, lane, 1024); continue; } r -= I1;
            if (r < I2) { p0_transpose_item(ka->in[I_WBRP], 256, 1024, WBRD_T + 512, scr, r, lane, 1024); continue; } r -= I2;
            if (r < I3) { p0_transpose_item(ka->in[I_WBRM], 256, 1024, WBRD_T + 768, scr, r, lane, 1024); continue; } r -= I3;
            if (r < I4) { p0_transpose_item(ka->in[I_WOUT], 1024, 1024, WOUT_T, scr, r, lane); continue; } r -= I4;
            p0_transpose_item(ka->in[I_WMKV], 1024, 512, WMKV_T, scr, r, lane);
        }
        for (int m = gw; m < T; m += NGW) rms_row_to_q(ka->in[I_X] + (size_t)m * 1024, ka->in[I_NORM1], (unsigned char*)XN + (size_t)m * 1024, WSP(float, WS_MERGF) + m, lane);
        for (int m = gw; m < BATCH * MEMLEN; m += NGW) rms_row_to_bf16(ka->in[I_MEM] + (size_t)m * 1024, ka->in[I_MEMNORM], MEMN + (size_t)m * 1024, lane);
        for (int i = bx * 512 + tid; i < SEQ * 32; i += G * 512) { const int pos = i >> 5, j = i & 31;
            const float inv = 1.0f / powf(10000.0f, (float)(2 * j) / 64.0f); const float ang = (float)pos * inv;
            const double a = (double)ang; const double k = rint(a * 0.15915494309189535); const float red = (float)(a - k * 6.283185307179586);
            ROPE[i] = (f32x2){cosf(red), sinf(red)}; }
        for (int i = bx * 512 + tid; i < 1024 * 32; i += G * 512) { const int ii = i & 3, e = (i >> 2) & 15, kq = (i >> 6) & 3, eb = (i >> 8) & 1, s = i >> 9; const int k = 16 * s + 4 * kq + ii;
            WR2[i] = ka->in[I_NORM2][k] * ka->in[I_WROUTER][k * 32 + eb * 16 + e]; }
        if (bx == 0 && wave == 0) { const float s1 = wave_sum(ka->in[I_LQ1][lane] * ka->in[I_LK1][lane]), s2 = wave_sum(ka->in[I_LQ2][lane] * ka->in[I_LK2][lane]);
            if (lane == 0) LAMP[0] = expf(s1) - expf(s2) + 0.2f; }
    }
    SEAM(0);
    if (IN(1)) for (int rep_ = 0; rep_ < 1 + ((REPEAT_MASK >> 1) & 1); ++rep_) { KA; if (rep_) __syncthreads();
#if defined(TAP) && TAP == 6
        { pg8::DenseProb P{XN, WIN_T, 1024, 1024, 1024}; pg8::StaticOrder S; S.init(T, INW, G, bx);
          pg8::EpiPlain E{WSP(bf16_t, WS_B), 5120};
          pg8::gemm_phase<pg8::EpiPlain, pg8::DenseProb, pg8::StaticOrder, true>(lds, P, S, E); }
#else
        const CvtJob J{ka->in[I_WGU], ka->in[I_WD], (unsigned char*)WGU_T, (unsigned char*)WD_T, NGW, gw, lane};
        const int kpre = (bx & 7) < 12 - 3 * CVT_NB2 ? (bx & 7) : 12 - 3 * CVT_NB2;
        for (int j = 0; j < kpre; ++j) J.item(3 * CVT_NB2 + j);
        { pg8::DenseProbI8 P{(const unsigned char*)XN, (const unsigned char*)WIN_T, 1024, 1024, 1024}; pg8::StaticOrder S0; S0.init(T, INW, G, bx); const pg8::TableOrder S = pg8::build_unit_table(S0, (LAS int*)(lds + MISC_OFF + 2048));
          pg8::EpiInProj E{Qb, Kb, Vb, Ub, MQb, GATES, ka->in[I_QN], ka->in[I_KN], ka->in[I_MQN], ka->in[I_BGATE], ROPE, WSP(float, WS_MERGF)};
          const PostCvt PU{J, 3 * CVT_NB2 + kpre, 12};
          pg8::gemm_phase<pg8::EpiInProj, pg8::DenseProbI8, pg8::TableOrder, ALIGN_EPI_SEL, PostCvt>(lds, P, S, E, PU); }
        for (int j = 3 * CVT_NB2 + kpre + 10; j < 12; ++j) J.item(j);
#endif
        for (int tile = bx; tile < 256; tile += G) {
            const int rt = tile >> 3, ct = tile & 7, r32 = lane & 31, hh = lane >> 5;
            const bf16_t* ap = MEMN + (size_t)(32 * rt + r32) * 1024 + 128 * wave + 8 * hh; const bf16_t* bp = WMKV_T + (size_t)(64 * ct + r32) * 1024 + 128 * wave + 8 * hh;
            bf16x8 af[8], b0[8], b1[8];
#pragma unroll
            for (int ks = 0; ks < 8; ++ks) { af[ks] = *(const bf16x8*)(ap + 16 * ks); b0[ks] = *(const bf16x8*)(bp + 16 * ks); b1[ks] = *(const bf16x8*)(bp + 32 * 1024 + 16 * ks); }
            f32x16 c0 = f32x16{}, c1 = f32x16{};
#pragma unroll
            for (int ks = 0; ks < 8; ++ks) { c0 = __builtin_amdgcn_mfma_f32_32x32x16_bf16(af[ks], b0[ks], c0, 0, 0, 0); c1 = __builtin_amdgcn_mfma_f32_32x32x16_bf16(af[ks], b1[ks], c1, 0, 0, 0); }
            LAS float* part = (LAS float*)lds;
            __syncthreads();
#pragma unroll
            for (int r = 0; r < 16; ++r) { const int row = (r & 3) + 8 * (r >> 2) + 4 * hh; part[(wave * 32 + row) * 64 + r32] = c0[r]; part[(wave * 32 + row) * 64 + 32 + r32] = c1[r]; }
            __syncthreads();
            const int row = tid >> 4, c4 = (tid & 15) * 4; f32x4 a = {0.f, 0.f, 0.f, 0.f};
#pragma unroll
            for (int w = 0; w < 8; ++w) a += *(const LAS f32x4*)(part + (w * 32 + row) * 64 + c4);
            if (ct < 4) {
                float ss = (a[0] * a[0] + a[1] * a[1]) + (a[2] * a[2] + a[3] * a[3]);
                ss += __shfl_xor(ss, 1); ss += __shfl_xor(ss, 2); ss += __shfl_xor(ss, 4); ss += __shfl_xor(ss, 8);
                const float rstd = 1.0f / sqrtf(ss * (1.0f / 64.0f) + RMS_EPS); const f32x4 g = *(const f32x4*)(ka->in[I_MKN] + c4); a = a * rstd * g; }
            u32x2 o; o.x = cvt_pk_bf16(a[0], a[1]); o.y = cvt_pk_bf16(a[2], a[3]);
            *(u32x2*)(MKV + (size_t)(32 * rt + row) * 512 + 64 * ct + c4) = o;
        }
        __syncthreads();
    }
    SEAM(1);
    if (IN(2)) for (int rep_ = 0; rep_ < 1 + ((REPEAT_MASK >> 2) & 1); ++rep_) { KA; if (rep_) __syncthreads();
        using abf = attn_body::bf16;
        {
            const int bh = vcu >> 4, b = bh >> 2, h = bh & 3, s = vcu & 15; const size_t rb = (size_t)b * SEQ;
            const float lam = LAMP[0];
            const CvtJob J2{ka->in[I_WGU], ka->in[I_WD], (unsigned char*)WGU_T, (unsigned char*)WD_T, NGW, gw, lane};
            for (int i2 = 0; i2 < 4 * (1 + ((REPEAT_MASK >> 10) & 1)); ++i2) { const int ii = i2 & 3, c = ii & 1; const int qb = (ii < 2) ? s : 31 - s;
                attn_body::attn_unit2<true>(qb * 256, 4 * qb + 4, (const abf*)Qb + rb * 512 + (c * 4 + h) * 64, 512, (const abf*)Kb + rb * 512 + (c * 4 + h) * 64, 512,
                                            (const abf*)Vb + rb * 512 + h * 128, 512, (abf*)OC + rb * 1024 + (c * 4 + h) * 128, 1024, (char*)lds_raw);
                if (c == 1) {
                    asm volatile("s_waitcnt vmcnt(0)" ::: "memory");
#pragma unroll
                    for (int ps = 0; ps < 2; ++ps) {
                    const int row = ps * 16 + (lane >> 2), dq = (lane & 3) * 32; const size_t t = rb + (size_t)qb * 256 + wave * 32 + row;
                    const bf16_t* p0 = OC + t * 1024 + h * 128 + dq; const bf16_t* p1 = p0 + 512;
                    u32x4 a[4], bb[4];
#pragma unroll
                    for (int j = 0; j < 4; ++j) { a[j] = *(const u32x4*)(p0 + 8 * j); bb[j] = *(const u32x4*)(p1 + 8 * j); }
                    float ss = 0.f; f32x4 y[4][2];
#pragma unroll
                    for (int j = 0; j < 4; ++j) {
                        y[j][0] = (f32x4){bf_lo(a[j].x) - lam * bf_lo(bb[j].x), bf_hi(a[j].x) - lam * bf_hi(bb[j].x), bf_lo(a[j].y) - lam * bf_lo(bb[j].y), bf_hi(a[j].y) - lam * bf_hi(bb[j].y)};
                        y[j][1] = (f32x4){bf_lo(a[j].z) - lam * bf_lo(bb[j].z), bf_hi(a[j].z) - lam * bf_hi(bb[j].z), bf_lo(a[j].w) - lam * bf_lo(bb[j].w), bf_hi(a[j].w) - lam * bf_hi(bb[j].w)};
#pragma unroll
                        for (int q = 0; q < 4; ++q) ss += y[j][0][q] * y[j][0][q] + y[j][1][q] * y[j][1][q]; }
                    ss += __shfl_xor(ss, 1); ss += __shfl_xor(ss, 2);
                    const float rstd = 0.8f / sqrtf(ss * (1.0f / 128.0f) + RMS_EPS);
                    const float* sg = ka->in[I_SUBLN] + dq; bf16_t* yo = YCAT + t * 1024 + h * 128 + dq;
#pragma unroll
                    for (int j = 0; j < 4; ++j) { const f32x4 s0 = *(const f32x4*)(sg + 8 * j), s1 = *(const f32x4*)(sg + 8 * j + 4); pg8::store8(yo + 8 * j, y[j][0] * rstd * s0, y[j][1] * rstd * s1); }
                    }
                }
                if (ii < CVT_NB2) J2.item3(3 * ii);
            }
        }
        {
            for (int i = 0; i < 2; ++i) { const int idx = vcu * 2 + i; if (idx >= 512) break; const int b = idx >> 7, h = (idx >> 5) & 3, qb = idx & 31;
                attn_body::attn_unit<8, false>(qb * 256, 4, (const abf*)MQb + (size_t)b * SEQ * 256 + h * 64, 256, (const abf*)MKV + (size_t)b * MEMLEN * 512 + h * 64, 512,
                                               (const abf*)MKV + (size_t)b * MEMLEN * 512 + 256 + h * 64, 512, (abf*)YCAT + (size_t)b * SEQ * 1024 + 768 + h * 64, 1024, (char*)lds_raw); }
        }
        {
            LAS bf16_t* ul = (LAS bf16_t*)lds;
            LAS bf16_t* pb = (LAS bf16_t*)(lds + 24576);
            const int col = tid & 255, half = tid >> 8, w = 2 << (col >> 6);
            const int mg = wave & 3, mdh = wave >> 2, r32 = lane & 31, hh = lane >> 5;
            bf16x8 bw[4];
#pragma unroll
            for (int sx = 0; sx < 4; ++sx) { const float* wp = ka->in[I_WPOOL] + (size_t)(mg * 64 + 16 * sx + 8 * hh) * 64 + mdh * 32 + r32;
                u32x4 pk; pk.x = pk2(wp[0], wp[64]); pk.y = pk2(wp[128], wp[192]); pk.z = pk2(wp[256], wp[320]); pk.w = pk2(wp[384], wp[448]); bw[sx] = __builtin_bit_cast(bf16x8, pk); }
            const int ocol = mg * 64 + mdh * 32 + r32; const float psc = ka->in[I_PSCALE][ocol];
            u32x4 pre[3];
#define POOL_LOAD(tl) do { const int t0_ = (tl) * 32, p0_ = t0_ & (SEQ - 1); _Pragma("unroll") for (int k_ = 0; k_ < 3; ++k_) { const int pc = tid + 512 * k_, r = pc >> 5, ch = pc & 31; \
                pre[k_] = (u32x4){0u, 0u, 0u, 0u}; if (pc < 47 * 32 && p0_ - 15 + r >= 0) pre[k_] = *(const u32x4*)(Ub + (size_t)(t0_ - 15 + r) * 256 + ch * 8); } } while (0)
            if (vcu < T / 32) POOL_LOAD(vcu);
            for (int tile = vcu; tile < T / 32; tile += G) {
                const int t0 = tile * 32, p0 = t0 & (SEQ - 1);
                __syncthreads();
#pragma unroll
                for (int k = 0; k < 3; ++k) { const int pc = tid + 512 * k, r = pc >> 5, ch = pc & 31; if (pc < 47 * 32) *(LAS u32x4*)(ul + r * 256 + ch * 8) = pre[k]; }
                if (tile + G < T / 32) POOL_LOAD(tile + G);
                __syncthreads();
                {
                    float sum = 0.f; const int rbase = 15 + 16 * half;
                    for (int i = 1; i < w; ++i) sum += __uint_as_float((unsigned)ul[(rbase - i) * 256 + col] << 16);
#pragma unroll
                    for (int tk = 0; tk < 16; ++tk) { const float ucur = __uint_as_float((unsigned)ul[(rbase + tk) * 256 + col] << 16); sum += ucur;
                        const int pos = p0 + 16 * half + tk; const float cnt = (float)((pos + 1 < w) ? pos + 1 : w);
                        pb[(16 * half + tk) * 264 + col] = (bf16_t)f2bf(sum / cnt - ucur);
                        sum -= __uint_as_float((unsigned)ul[(rbase + tk - (w - 1)) * 256 + col] << 16); }
                }
                __syncthreads();
                f32x16 acc = f32x16{};
#pragma unroll
                for (int sx = 0; sx < 4; ++sx) { const bf16x8 af = *(const LAS bf16x8*)(pb + r32 * 264 + mg * 64 + 16 * sx + 8 * hh);
                    acc = __builtin_amdgcn_mfma_f32_32x32x16_bf16(af, bw[sx], acc, 0, 0, 0); }
#pragma unroll
                for (int r = 0; r < 16; ++r) { const int tok = t0 + (r & 3) + 8 * (r >> 2) + 4 * hh; YCAT[(size_t)tok * 1024 + 512 + ocol] = (bf16_t)f2bf(acc[r] * psc); }
            }
            __syncthreads();
        }
    }
    SEAM(2);
    if (IN(4)) for (int rep_ = 0; rep_ < 1 + ((REPEAT_MASK >> 4) & 1); ++rep_) { KA; if (rep_) __syncthreads();
        pg8::StaticOrder S0; S0.init(T, 1024, G, bx); const pg8::TableOrder S = pg8::build_unit_table(S0, (LAS int*)(lds + MISC_OFF + 2048));
        pg8::DenseProb P{YCAT, WBRD_T, 1024, 1024, 1024}; pg8::EpiMergeR E{GATES, MERGB};
        pg8::gemm_phase<pg8::EpiMergeR, pg8::DenseProb, pg8::TableOrder, ALIGN_EPI_SEL>(lds, P, S, E);
    }
    SEAM(4);
    if (IN(5)) for (int rep_ = 0; rep_ < 1 + ((REPEAT_MASK >> 5) & 1); ++rep_) { KA; if (rep_) __syncthreads();
        pg8::DenseProb P{MERGB, WOUT_T, 1024, 1024, 1024}; pg8::StaticOrder S0; S0.init(T, 1024, G, bx); const pg8::TableOrder S = pg8::build_unit_table(S0, (LAS int*)(lds + MISC_OFF + 2048));
        pg8::EpiWout E{ka->in[I_X], OUT, (unsigned char*)XG, ka->in[I_NORM2]};
        pg8::gemm_phase<pg8::EpiWout, pg8::DenseProb, pg8::TableOrder, ALIGN_EPI_SEL>(lds, P, S, E);
    }
    SEAM(5);
    if (IN(6)) { KA;
        LAS int* lcnt = (LAS int*)(lds + MISC_OFF); LAS int* lbase = lcnt + 32;
        const int ngroups = T / 16, rounds = (ngroups + NGW - 1) / NGW;
        for (int rd = 0; rd < rounds; ++rd) {
            const int grp = rd * NGW + gw; const bool valid = grp < ngroups;
            if (tid < 32) lcnt[tid] = 0;
            __syncthreads();
            int e_sel = 0, rank = 0; float w_sel = 0.f, rstd = 0.f; const int q = lane >> 4, tok = grp * 16 + (lane & 15);
            if (valid) {
                f32x4 d0 = {0.f, 0.f, 0.f, 0.f}, d1 = {0.f, 0.f, 0.f, 0.f}; float ss = 0.f;
                const float* xrow = OUT + (size_t)tok * 1024 + 4 * q; const f32x4* wr2 = (const f32x4*)WR2 + lane;
#pragma unroll 8
                for (int s = 0; s < 64; ++s) { const f32x4 xv = *(const f32x4*)(xrow + 16 * s); const f32x4 wa = wr2[(s * 2) * 64], wb = wr2[(s * 2 + 1) * 64];
                    ss += (xv[0] * xv[0] + xv[1] * xv[1]) + (xv[2] * xv[2] + xv[3] * xv[3]);
#pragma unroll
                    for (int j = 0; j < 4; ++j) { d0 = __builtin_amdgcn_mfma_f32_16x16x4f32(wa[j], xv[j], d0, 0, 0, 0); d1 = __builtin_amdgcn_mfma_f32_16x16x4f32(wb[j], xv[j], d1, 0, 0, 0); } }
                ss += __shfl_xor(ss, 16); ss += __shfl_xor(ss, 32);
                rstd = 1.0f / sqrtf(ss * (1.0f / 1024.f) + RMS_EPS);
                unsigned key[8];
#pragma unroll
                for (int r = 0; r < 8; ++r) { const int e = (r >> 2) * 16 + 4 * q + (r & 3); const float lg = ((r < 4) ? d0[r & 3] : d1[r & 3]) * rstd + ka->in[I_BROUTER][e];
                    unsigned u = __float_as_uint(lg); u ^= (u >> 31) ? 0xffffffffu : 0x80000000u; key[r] = (u & ~31u) | (unsigned)(31 - e); }
                unsigned win[4];
#pragma unroll
                for (int r = 0; r < 4; ++r) { unsigned m = key[0];
#pragma unroll
                    for (int j = 1; j < 8; ++j) m = m > key[j] ? m : key[j];
                    unsigned o = (unsigned)__shfl_xor((int)m, 16); m = m > o ? m : o; o = (unsigned)__shfl_xor((int)m, 32); m = m > o ? m : o; win[r] = m;
#pragma unroll
                    for (int j = 0; j < 8; ++j) key[j] = (key[j] == m) ? 0u : key[j]; }
                float val[4];
#pragma unroll
                for (int r = 0; r < 4; ++r) { unsigned u = win[r] & ~31u; u ^= (u >> 31) ? 0x80000000u : 0xffffffffu; val[r] = __uint_as_float(u); }
                const float p1 = expf(val[1] - val[0]), p2 = expf(val[2] - val[0]), p3 = expf(val[3] - val[0]); const float inv = 1.0f / (1.0f + p1 + p2 + p3);
                const unsigned wk = (q == 0) ? win[0] : (q == 1) ? win[1] : (q == 2) ? win[2] : win[3];
                w_sel = ((q == 0) ? 1.0f : (q == 1) ? p1 : (q == 2) ? p2 : p3) * inv; e_sel = 31 - (int)(wk & 31u);
                rank = __hip_atomic_fetch_add((int*)(lcnt + e_sel), 1, __ATOMIC_RELAXED, __HIP_MEMORY_SCOPE_WORKGROUP);
            }
            __syncthreads();
            if (tid < 32) lbase[tid] = (int)__hip_atomic_fetch_add(CNT + 64 * tid, (unsigned)lcnt[tid], __ATOMIC_RELAXED, __HIP_MEMORY_SCOPE_AGENT);
            __syncthreads();
            if (valid) { const int pos = lbase[e_sel] + rank; LIST[(size_t)e_sel * CAP + pos] = (u32x2){(unsigned)(tok * 4 + q), __float_as_uint(rstd)}; ROUTEW[tok * 4 + q] = w_sel; }
            __syncthreads();
        }
    }
    SEAM(6);
    if (IN(7) || IN(8)) { KA;
        LAS int* tp = (LAS int*)(lds + MISC_OFF + 256); LAS int* cn = tp + 40;
        if (tid < 64) {
            const int e = tid & 31; const int c = (int)__hip_atomic_load(CNT + 64 * e, __ATOMIC_RELAXED, __HIP_MEMORY_SCOPE_AGENT); const int tiles = (c + 255) >> 8; int x = tiles;
#pragma unroll
            for (int o = 1; o < 32; o <<= 1) { const int y = __shfl_up(x, o, 32); if (e >= o) x += y; }
            if (tid < 32) { cn[e] = c; tp[e] = x - tiles; if (e == 31) tp[NEXP] = x; } }
        __syncthreads();
        if (IN(7)) for (int rep_ = 0; rep_ < 1 + ((REPEAT_MASK >> 7) & 1); ++rep_) {
            pg8::GuProb P{(const unsigned char*)XG, (const unsigned char*)WGU_T, LIST, 1024, 1024, 1024}; pg8::GroupedOrder S0{tp, cn, 8, G, bx}; const pg8::TableOrder S = pg8::build_unit_table(S0, (LAS int*)(lds + MISC_OFF + 2048));
            pg8::EpiSwiglu E{(unsigned char*)ACT, LIST, ka->in[I_BGU], lds + MISC_OFF + 4096};
            pg8::gemm_phase<pg8::EpiSwiglu, pg8::GuProb, pg8::TableOrder, ALIGN_EPI_SEL>(lds, P, S, E);
        }
        SEAM(7);
        if (IN(8)) for (int rep_ = 0; rep_ < 1 + ((REPEAT_MASK >> 8) & 1); ++rep_) {
            pg8::DownProb P{(const unsigned char*)ACT, (const unsigned char*)WD_T, 1024, 1024, 1024}; pg8::GroupedOrder S0{tp, cn, 4, G, bx}; const pg8::TableOrder S = pg8::build_unit_table(S0, (LAS int*)(lds + MISC_OFF + 2048));
            pg8::EpiDown E{(unsigned char*)Y4, LIST, ka->in[I_BD], lds + MISC_OFF + 4096};
            pg8::gemm_phase<pg8::EpiDown, pg8::DownProb, pg8::TableOrder, ALIGN_EPI_SEL>(lds, P, S, E);
        }
    }
    SEAM(8);
    if (IN(9)) { KA;
        for (int i = bx * 512 + tid; i < T * 128; i += G * 512) { const int tok = i >> 7, c8 = (i & 127) * 8;
            const f32x4 w = *(const f32x4*)(ROUTEW + tok * 4); float* op = OUT + (size_t)tok * 1024 + c8;
            f32x4 o0 = *(const f32x4*)op, o1 = *(const f32x4*)(op + 4);
#pragma unroll
            for (int k = 0; k < 4; ++k) { const u32x2 y = *(const u32x2*)((const unsigned char*)Y4 + ((size_t)tok * 4 + k) * 1024 + c8); const float wk = w[k] * (1.0f / Y8_SCALE);
                const f32x2 p0 = __builtin_amdgcn_cvt_pk_f32_fp8((int)y.x, false), p1 = __builtin_amdgcn_cvt_pk_f32_fp8((int)y.x, true), p2 = __builtin_amdgcn_cvt_pk_f32_fp8((int)y.y, false), p3 = __builtin_amdgcn_cvt_pk_f32_fp8((int)y.y, true);
                o0[0] += wk * p0[0]; o0[1] += wk * p0[1]; o0[2] += wk * p1[0]; o0[3] += wk * p1[1];
                o1[0] += wk * p2[0]; o1[1] += wk * p2[1]; o1[2] += wk * p3[0]; o1[3] += wk * p3[1]; }
            *(f32x4*)op = o0; *(f32x4*)(op + 4) = o1; }
    }
#ifdef TAP
    if (lo <= 10 && 10 < hi) { KA; GSYNC();
        for (int i = bx * 512 + tid; i < T * 1024; i += G * 512) { const int t = i >> 10, c = i & 1023; float v = 0.f;
#define BFV(buf, pitch, col) __uint_as_float((unsigned)(buf)[(size_t)t * (pitch) + (col)] << 16)
            if (TAP == 1) v = BFV(Qb, 512, c & 511) + 2.f * BFV(Kb, 512, c & 511) + 4.f * BFV(Vb, 512, c & 511) + 8.f * BFV(Ub, 256, c & 255) + 16.f * BFV(MQb, 256, c & 255)
                            + 32.f * BFV(GATES, 3072, c) + 64.f * BFV(GATES, 3072, 1024 + c) + 128.f * BFV(GATES, 3072, 2048 + c);
            if (TAP == 2) v = BFV(OC, 1024, c) + 2.f * BFV(YCAT, 1024, c);
            if (TAP == 3) v = BFV(MERGB, 1024, c);
            if (TAP == 4) v = BFV(XN, 1024, c);
            if (TAP == 6) { const bf16_t* z = WSP(bf16_t, WS_B) + (size_t)t * 5120 + c; v = __uint_as_float((unsigned)z[0] << 16) + 2.f * __uint_as_float((unsigned)z[1024] << 16) + 4.f * __uint_as_float((unsigned)z[2048] << 16) + 8.f * __uint_as_float((unsigned)z[3072] << 16) + 16.f * __uint_as_float((unsigned)z[4096] << 16); }
            if (TAP == 5) { const bf16_t* wt = WIN_T; const int tt = t % 5120; v = __uint_as_float((unsigned)wt[(size_t)tt * 1024 + c] << 16) + ROPE[(t & 8191) * 32 + (c & 31)].x + 2.f * ROPE[(t & 8191) * 32 + (c & 31)].y; }
            OUT[i] = v; }
    }
#endif
#undef IN
#undef SEAM
}

extern "C" void kernel_launch(void* const* d_in, const int* in_sizes, int n_in, void* d_out, int out_size, void* d_ws, size_t ws_size, hipStream_t stream) {
    static int grid = 0;
    if (grid == 0) {
        if (n_in != 29 || in_sizes[0] != T * DMODEL || out_size != T * DMODEL || ws_size < WS_END) {
            fprintf(stderr, "kernel_launch: unexpected shapes: n_in %d in0 %d out %d ws %zu (need %zu)\n", n_in, n_in > 0 ? in_sizes[0] : -1, out_size, ws_size, (size_t)WS_END); grid = -1; return; }
        int dev = 0, cus = 0, per_cu = 0;
        (void)hipGetDevice(&dev); (void)hipDeviceGetAttribute(&cus, hipDeviceAttributeMultiprocessorCount, dev);
        (void)hipFuncSetAttribute((const void*)fwd_kernel, hipFuncAttributeMaxDynamicSharedMemorySize, LDS_BYTES);
        (void)hipOccupancyMaxActiveBlocksPerMultiprocessor(&per_cu, (const void*)fwd_kernel, NWAVES * 64, LDS_BYTES);
        (void)hipGetLastError();
        grid = cus;
        fprintf(stderr, "kernel_launch: cus %d occupancy %d/CU grid %d\n", cus, per_cu, grid);
        if (per_cu < 1) fprintf(stderr, "kernel_launch: occupancy query says the kernel does not fit\n");
    }
    if (grid < 0) return;
    (void)hipMemsetAsync((char*)d_ws + WS_CTL, 0, CTL_ZERO_BYTES, stream);
    Args a{};
    for (int i = 0; i < 29; ++i) a.in[i] = (const float*)d_in[i];
    a.out = (float*)d_out; a.ws = (unsigned char*)d_ws; a.ph_lo = 0; a.ph_hi = PH_HI;
    void* args[] = {&a};
    hipError_t e = hipLaunchCooperativeKernel((const void*)fwd_kernel, dim3(grid), dim3(NWAVES * 64), args, LDS_BYTES, stream);
    if (e != hipSuccess) fprintf(stderr, "cooperative launch failed: %s (grid %d)\n", hipGetErrorString(e), grid);
}
```

```cpp
#include <hip/hip_runtime.h>
#include <hip/hip_cooperative_groups.h>
#include <hip/hip_bf16.h>
#include <cstdio>
#include <cstdint>
#include <cmath>
namespace cg = cooperative_groups;

#define LAS __attribute__((address_space(3)))
#define GAS __attribute__((address_space(1)))
typedef unsigned short bf16_t;
typedef short bf16x8 __attribute__((ext_vector_type(8)));
typedef float f32x4 __attribute__((ext_vector_type(4)));
typedef float f32x2 __attribute__((ext_vector_type(2)));
typedef float f32x16 __attribute__((ext_vector_type(16)));
typedef unsigned u32x4 __attribute__((ext_vector_type(4)));
typedef unsigned u32x2 __attribute__((ext_vector_type(2)));

#define PH_HI 10
#define ALIGN_EPI_SEL true
#define F8MODE 2
#define USE_SETPRIO 1
#define ATTN_PRIO_A 1
#define ATTN_PRIO_B 1
#ifndef PHMASK
#define PHMASK 0x3ff
#endif
#define CVT_NB2 4
#define REPEAT_MASK 0x000
constexpr int BATCH = 4, SEQ = 8192, DMODEL = 1024, T = BATCH * SEQ, INW = 5120, NEXP = 32, MEMLEN = 256;
constexpr float RMS_EPS = 1e-6f;
constexpr float C2 = 0.125f * 1.4426950408889634f;
constexpr int CAP = T;

constexpr size_t MiB = 1u << 20;
constexpr size_t WS_CTL = 0, CTL_ZERO_BYTES = 32768;
constexpr int CW_BAR = 4096;
constexpr size_t WS_ROUTEW = 1 * MiB;
constexpr size_t WS_LAM = 1 * MiB + 768 * 1024;
constexpr size_t WS_ROPE = 2 * MiB;
constexpr size_t WS_WR2 = 4 * MiB;
constexpr size_t WS_MEMN = 5 * MiB;
constexpr size_t WS_MKV = 7 * MiB;
constexpr size_t WS_WIN_T = 8 * MiB;
constexpr size_t WS_WBRD_T = 18 * MiB;
constexpr size_t WS_WBRP_T = 19 * MiB;
constexpr size_t WS_WBRM_T = 19 * MiB + 512 * 1024;
constexpr size_t WS_WOUT_T = 20 * MiB;
constexpr size_t WS_WMKV_T = 22 * MiB;
constexpr size_t WS_WGU_T = 24 * MiB;
constexpr size_t WS_WD_T = 152 * MiB;
constexpr size_t WS_A = 216 * MiB;
constexpr size_t WS_XN = WS_A;
constexpr size_t WS_Q = WS_A + 64 * MiB, WS_K = WS_A + 96 * MiB, WS_V = WS_A + 128 * MiB;
constexpr size_t WS_U = WS_A + 160 * MiB, WS_MQ = WS_A + 176 * MiB;
constexpr size_t WS_OC = WS_A + 192 * MiB;
constexpr size_t WS_B = 488 * MiB;
constexpr size_t WS_GATES = WS_B;
constexpr size_t WS_YCAT = WS_B + 192 * MiB;
constexpr size_t WS_MERGF = 760 * MiB;
constexpr size_t WS_MERGB = 888 * MiB;
constexpr size_t WS_XG = 952 * MiB;
constexpr size_t WS_LIST = 1016 * MiB;
constexpr size_t WS_END = 1024 * MiB;

typedef __bf16 bf16x2_v __attribute__((ext_vector_type(2)));
__device__ __forceinline__ unsigned cvt_pk_bf16(float lo, float hi) { f32x2 v = {lo, hi}; bf16x2_v b = __builtin_convertvector(v, bf16x2_v); return __builtin_bit_cast(unsigned, b); }
__device__ __forceinline__ unsigned pk4_fp8(float a, float b, float c, float d) {
    a = fminf(fmaxf(a, -448.f), 448.f); b = fminf(fmaxf(b, -448.f), 448.f); c = fminf(fmaxf(c, -448.f), 448.f); d = fminf(fmaxf(d, -448.f), 448.f);
    int r = __builtin_amdgcn_cvt_pk_fp8_f32(a, b, 0, false); r = __builtin_amdgcn_cvt_pk_fp8_f32(c, d, r, true); return (unsigned)r; }
__device__ __forceinline__ unsigned pk4_i8(float a, float b, float c, float d) {
    const int q0 = (int)fminf(fmaxf(rintf(a), -127.f), 127.f), q1 = (int)fminf(fmaxf(rintf(b), -127.f), 127.f), q2 = (int)fminf(fmaxf(rintf(c), -127.f), 127.f), q3 = (int)fminf(fmaxf(rintf(d), -127.f), 127.f);
    return ((unsigned)q0 & 0xffu) | (((unsigned)q1 & 0xffu) << 8) | (((unsigned)q2 & 0xffu) << 16) | ((unsigned)q3 << 24); }
constexpr float WQ_IN = 127.0f * 32.0f / 4.0f;
constexpr float W8_SCALE = 64.0f;
constexpr float Y8_SCALE = 32.0f;
constexpr float A8_SCALE = 8.0f;
__device__ __forceinline__ float bf_lo(unsigned w) { return __uint_as_float(w << 16); }
__device__ __forceinline__ float bf_hi(unsigned w) { return __uint_as_float(w & 0xffff0000u); }
__device__ __forceinline__ float wave_sum(float v) {
#pragma unroll
    for (int o = 1; o < 64; o <<= 1) v += __shfl_xor(v, o);
    return v;
}
#define LDS_WAIT() asm volatile("s_waitcnt lgkmcnt(0)" ::: "memory")

namespace pg8 {
constexpr int BM = 256, BK = 64, HALF = 128, HTB = HALF * BK * 2, STAGE_BYTES = 8 * HTB, NXCD = 8, WGM = 8;
__host__ __device__ __forceinline__ int lds_byte(int r, int c) { const int st = (r >> 4) * 2 + (c >> 5), rr = r & 15, cc = c & 31, ob = rr * 64 + cc * 2; return st * 1024 + (ob ^ (((ob >> 9) & 1) << 5)); }
__host__ __device__ __forceinline__ void stage_rc(int b, int& R, int& C) { const int st = b / 1024, sb = b % 1024, swz = sb ^ (((sb >> 9) & 1) << 5); R = (st >> 1) * 16 + swz / 64; C = (st & 1) * 32 + (swz % 64) / 2; }
__host__ __device__ __forceinline__ int perm32(int rho) { const int n = rho >> 4, i = rho & 15; return 8 * (i >> 2) + 4 * n + (i & 3); }

typedef int i32x4_t __attribute__((ext_vector_type(4)));
typedef int i32x8_t __attribute__((ext_vector_type(8)));
typedef long i64x2_t __attribute__((ext_vector_type(2)));
struct Unit { int pm, pn, e, mt, cnt; };

template <int BMAP> __device__ __forceinline__ int brow(int R) { return BMAP == 0 ? ((R >> 5) * 64 + perm32(R & 31)) : BMAP == 1 ? ((R & ~31) + perm32(R & 31)) : ((R >> 5) * 64 + 16 * ((R & 15) >> 2) + 4 * ((R >> 4) & 1) + (R & 3)); }

struct StaticOrder {
    int nM, nN, nwg, G, c;
    __device__ void init(int M, int N, int G_, int c_) { nM = M / BM; nN = N / BM; nwg = nM * nN; G = G_; c = c_; }
    __device__ bool next(int i, Unit& u) const {
        const long L = (long)i * G + c; if (L >= nwg) return false;
        int wgid = (int)L; { const int q = nwg / NXCD, r = nwg % NXCD, xcd = wgid % NXCD, off = wgid / NXCD; wgid = (xcd < r ? xcd * (q + 1) : r * (q + 1) + (xcd - r) * q) + off; }
        const int nig = WGM * nN, gid = wgid / nig, fm = gid * WGM, gsz = (nM - fm) < WGM ? (nM - fm) : WGM;
        u.pm = fm + ((wgid % nig) % gsz); u.pn = (wgid % nig) / gsz; u.e = 0; u.mt = 0; u.cnt = 0; return true;
    }
    __device__ bool next_lane(int i, Unit& u) const { return next(i, u); }
};
struct GroupedOrder {
    const LAS int* tp; const LAS int* cn; int NTN, G, c;
    __device__ bool next_lane(int i, Unit& u) const {
        const int nwg = tp[NEXP] * NTN; const long L = (long)i * G + c; if (L >= nwg) return false;
        int wgid = (int)L; { const int q = nwg / NXCD, r = nwg % NXCD, xcd = wgid % NXCD, off = wgid / NXCD; wgid = (xcd < r ? xcd * (q + 1) : r * (q + 1) + (xcd - r) * q) + off; }
        int e = 0; while (e < NEXP - 1 && wgid >= tp[e + 1] * NTN) ++e;
        const int idx = wgid - tp[e] * NTN, tiles = tp[e + 1] - tp[e];
        const int nig = 4 * NTN, gid = idx / nig, fm = gid * 4, gsz = (tiles - fm) < 4 ? (tiles - fm) : 4;
        u.mt = fm + ((idx % nig) % gsz); u.pn = (idx % nig) / gsz; u.e = e; u.pm = tp[e] + u.mt; u.cnt = cn[e]; return true;
    }
};
struct TableOrder {
    const LAS int* tab; int n;
    __device__ __forceinline__ bool next(int i, Unit& u) const {
        if (i >= n) return false;
        const LAS int* t = tab + i * 8;
        u.pm = __builtin_amdgcn_readfirstlane(t[0]); u.pn = __builtin_amdgcn_readfirstlane(t[1]); u.e = __builtin_amdgcn_readfirstlane(t[2]);
        u.mt = __builtin_amdgcn_readfirstlane(t[3]); u.cnt = __builtin_amdgcn_readfirstlane(t[4]); return true;
    }
};
template <class Sched> __device__ __forceinline__ TableOrder build_unit_table(const Sched& S, LAS int* tab) {
    __syncthreads();
    if (threadIdx.x < 32) { Unit u; const bool ok = S.next_lane((int)threadIdx.x, u);
        if (ok) { LAS int* t = tab + threadIdx.x * 8; t[0] = u.pm; t[1] = u.pn; t[2] = u.e; t[3] = u.mt; t[4] = u.cnt; }
        const unsigned long long m = __ballot(ok); if (threadIdx.x == 0) tab[256] = __popcll(m); }
    __syncthreads();
    TableOrder T; T.tab = tab; T.n = __builtin_amdgcn_readfirstlane(tab[256]); return T;
}
struct DenseProb {
    static constexpr bool GATHER = false; static constexpr int BMAP = 0; static constexpr bool F8 = false; static constexpr bool I8 = false;
    const bf16_t* A; const bf16_t* Bt; int lda, ldb, K;
    __device__ __forceinline__ const char* a_base(const Unit& u) const { return (const char*)(A + (size_t)u.pm * BM * lda); }
    __device__ __forceinline__ const char* b_base(const Unit& u) const { return (const char*)(Bt + (size_t)u.pn * BM * ldb); }
    __device__ __forceinline__ size_t bhstep() const { return (size_t)32 * ldb * 2; }
    __device__ __forceinline__ unsigned a_off(const Unit&, int, int) const { return 0u; }
    __device__ __forceinline__ unsigned a_raw(const Unit&, int) const { return 0u; }
};
struct DenseProbI8 {
    static constexpr bool GATHER = false; static constexpr int BMAP = 0; static constexpr bool F8 = true; static constexpr bool I8 = true;
    const unsigned char* A; const unsigned char* Bt; int lda, ldb, K;
    __device__ __forceinline__ const char* a_base(const Unit& u) const { return (const char*)(A + (size_t)u.pm * BM * lda); }
    __device__ __forceinline__ const char* b_base(const Unit& u) const { return (const char*)(Bt + (size_t)u.pn * BM * ldb); }
    __device__ __forceinline__ size_t bhstep() const { return (size_t)32 * ldb; }
    __device__ __forceinline__ unsigned a_off(const Unit&, int, int) const { return 0u; }
    __device__ __forceinline__ unsigned a_raw(const Unit&, int) const { return 0u; }
};
struct GuProb {
    static constexpr bool GATHER = true; static constexpr int BMAP = 1; static constexpr bool F8 = true; static constexpr bool I8 = false;
    const unsigned char* XG; const unsigned char* Wt; const u32x2* list; int lda, ldb, K;
    __device__ __forceinline__ const char* a_base(const Unit&) const { return (const char*)XG; }
    __device__ __forceinline__ const char* b_base(const Unit& u) const { return (const char*)(Wt + ((size_t)u.e * 2048 + 128 * u.pn) * 1024); }
    __device__ __forceinline__ size_t bhstep() const { return (size_t)1024 * 1024; }
    __device__ __forceinline__ unsigned a_raw(const Unit& u, int r) const { const int rr = u.mt * BM + r, rc = rr < u.cnt ? rr : u.cnt - 1; return list[(size_t)u.e * CAP + rc].x; }
    __device__ __forceinline__ unsigned a_off(const Unit& u, int r, int C) const {
        const int rr = u.mt * BM + r, rc = rr < u.cnt ? rr : u.cnt - 1;
        const unsigned tok = list[(size_t)u.e * CAP + rc].x >> 2;
        return tok * 1024u + (unsigned)C * 2u;
    }
};
struct DownProb {
    static constexpr bool GATHER = false; static constexpr int BMAP = 2; static constexpr bool F8 = true; static constexpr bool I8 = false;
    const unsigned char* A; const unsigned char* Wt; int lda, ldb, K;
    __device__ __forceinline__ const char* a_base(const Unit& u) const { return (const char*)(A + (size_t)u.pm * BM * lda); }
    __device__ __forceinline__ const char* b_base(const Unit& u) const { return (const char*)(Wt + ((size_t)u.e * 1024 + 256 * u.pn) * 1024); }
    __device__ __forceinline__ size_t bhstep() const { return (size_t)8 * ldb; }
    __device__ __forceinline__ unsigned a_off(const Unit&, int, int) const { return 0u; }
    __device__ __forceinline__ unsigned a_raw(const Unit&, int) const { return 0u; }
};

template <class Prob> __device__ __forceinline__ void calc_aoff(const Prob& P, const Unit& u, const int (&Rr)[2], const int (&Cc)[2], unsigned (&o)[2][2]) {
#pragma unroll
    for (int h = 0; h < 2; ++h)
#pragma unroll
        for (int i = 0; i < 2; ++i) {
            if constexpr (Prob::GATHER) o[h][i] = P.a_off(u, h * HALF + Rr[i], Cc[i]);
            else o[h][i] = Prob::F8 ? (unsigned)((h * HALF + Rr[i]) * P.lda + Cc[i] * 2) : (unsigned)((h * HALF + Rr[i]) * P.lda + Cc[i]) * 2u;
        }
}

struct NoPost { __device__ __forceinline__ void operator()(int) const {} };
template <class Epi, class Prob, class Sched, bool ALIGN_EPI, class Post = NoPost>
__device__ __forceinline__ void gemm_phase(LAS unsigned char* lds, const Prob& P, const Sched& S, const Epi& E, const Post& PU = Post()) {
    const int tid = threadIdx.x, wid = __builtin_amdgcn_readfirstlane(tid >> 6), lane = tid & 63, wr = wid >> 2, wc = wid & 3, fr = lane & 15, fq = lane >> 4;
    const int K = P.K, nt = Prob::F8 ? K / 128 : K / BK;
    int Rr[2], Cc[2]; unsigned voffB[2];
#pragma unroll
    for (int i = 0; i < 2; ++i) { stage_rc(tid * 16 + i * 8192, Rr[i], Cc[i]); voffB[i] = Prob::F8 ? (unsigned)(brow<Prob::BMAP>(Rr[i]) * P.ldb + Cc[i] * 2) : (unsigned)(brow<Prob::BMAP>(Rr[i]) * P.ldb + Cc[i]) * 2u; }
    const size_t kstep = (size_t)(BK * 2);
    const size_t bhstep = P.bhstep();
    const unsigned ldsw = (unsigned)wid * 1024u;
    const int aoff = lds_byte(wr * 64 + fr, fq * 8), boff = lds_byte(wc * 32 + fr, fq * 8);
#define PG8_SA(b, h) (((b) * 2 + (h)) * HTB)
#define PG8_SB(b, h) ((4 + (b) * 2 + (h)) * HTB)
#define PG8_STG(bufoff, gptr, v0, v1) do { \
        __builtin_amdgcn_global_load_lds((const unsigned*)((const char*)(gptr) + (v0)), (LAS unsigned*)(lds + (bufoff) + ldsw), 16, 0, 0); \
        __builtin_amdgcn_global_load_lds((const unsigned*)((const char*)(gptr) + (v1)), (LAS unsigned*)(lds + (bufoff) + ldsw + 8192), 16, 0, 0); } while (0)
#define PG8_STGB(bufoff, gptr) PG8_STG(bufoff, gptr, voffB[0], voffB[1])
#define PG8_LDA(dst, b, h) do { _Pragma("unroll") for (int m = 0; m < 4; ++m) _Pragma("unroll") for (int k = 0; k < 2; ++k) dst[m][k] = *(const LAS bf16x8*)(lds + PG8_SA(b, h) + aoff + m * 2048 + k * 1024); } while (0)
#define PG8_LDB(dst, b, h) do { _Pragma("unroll") for (int n = 0; n < 2; ++n) _Pragma("unroll") for (int k = 0; k < 2; ++k) dst[n][k] = *(const LAS bf16x8*)(lds + PG8_SB(b, h) + boff + n * 2048 + k * 1024); } while (0)
#define PG8_MMAB(ai, bj, At, Bt) do { _Pragma("unroll") for (int m = 0; m < 4; ++m) _Pragma("unroll") for (int n = 0; n < 2; ++n) _Pragma("unroll") for (int k = 0; k < 2; ++k) \
        acc[ai][bj][m][n] = __builtin_amdgcn_mfma_f32_16x16x32_bf16(Bt[n][k], At[m][k], acc[ai][bj][m][n], 0, 0, 0); } while (0)
#define PG8_MMAQ(ai, bj, At, Bt) do { _Pragma("unroll") for (int m = 0; m < 4; ++m) _Pragma("unroll") for (int n = 0; n < 2; ++n) _Pragma("unroll") for (int k = 0; k < 2; ++k) { \
        const i64x2_t bq = __builtin_bit_cast(i64x2_t, Bt[n][k]), aq = __builtin_bit_cast(i64x2_t, At[m][k]); \
        acc[ai][bj][m][n] = __builtin_amdgcn_mfma_f32_16x16x32_fp8_fp8(bq[0], aq[0], acc[ai][bj][m][n], 0, 0, 0); \
        acc[ai][bj][m][n] = __builtin_amdgcn_mfma_f32_16x16x32_fp8_fp8(bq[1], aq[1], acc[ai][bj][m][n], 0, 0, 0); } } while (0)
#define PG8_MMA8(ai, bj, A8, B8) do { _Pragma("unroll") for (int m = 0; m < 4; ++m) _Pragma("unroll") for (int n = 0; n < 2; ++n) \
        asm volatile("v_mfma_f32_16x16x128_f8f6f4 %0, %1, %2, %0" : "+v"(acc[ai][bj][m][n]) : "v"(B8[n]), "v"(A8[m])); } while (0)
#define PG8_MMAI(ai, bj, At, Bt) do { _Pragma("unroll") for (int k = 0; k < 2; ++k) _Pragma("unroll") for (int m = 0; m < 4; ++m) _Pragma("unroll") for (int n = 0; n < 2; ++n) \
        asm volatile("v_mfma_i32_16x16x64_i8 %0, %1, %2, %0" : "+v"(acc[ai][bj][m][n]) : "v"(Bt[n][k]), "v"(At[m][k])); } while (0)
#define PG8_LDA8(dst, b, h) do { _Pragma("unroll") for (int m = 0; m < 4; ++m) { dst[m].lo = *(const LAS i32x4_t*)(lds + PG8_SA(b, h) + aoff + m * 2048); dst[m].hi = *(const LAS i32x4_t*)(lds + PG8_SA(b, h) + aoff + m * 2048 + 1024); } } while (0)
#define PG8_LDB8(dst, b, h) do { _Pragma("unroll") for (int n = 0; n < 2; ++n) { dst[n].lo = *(const LAS i32x4_t*)(lds + PG8_SB(b, h) + boff + n * 2048); dst[n].hi = *(const LAS i32x4_t*)(lds + PG8_SB(b, h) + boff + n * 2048 + 1024); } } while (0)
#define PG8_XLDA(b, h)  do { if constexpr (Prob::F8 && !Prob::I8 && F8MODE == 2) PG8_LDA8(At8, b, h); else PG8_LDA(At, b, h); } while (0)
#define PG8_XLDB0(b, h) do { if constexpr (Prob::F8 && !Prob::I8 && F8MODE == 2) PG8_LDB8(B08, b, h); else PG8_LDB(B0, b, h); } while (0)
#define PG8_XLDB1(b, h) do { if constexpr (Prob::F8 && !Prob::I8 && F8MODE == 2) PG8_LDB8(B18, b, h); else PG8_LDB(B1, b, h); } while (0)
#define PG8_XMMA0(ai, bj) do { if (USE_SETPRIO) __builtin_amdgcn_s_setprio(USE_SETPRIO); if constexpr (Prob::I8) PG8_MMAI(ai, bj, At, B0); else if constexpr (Prob::F8 && F8MODE == 2) PG8_MMA8(ai, bj, At8, B08); else if constexpr (Prob::F8) PG8_MMAQ(ai, bj, At, B0); else PG8_MMAB(ai, bj, At, B0); if (USE_SETPRIO) __builtin_amdgcn_s_setprio(0); } while (0)
#define PG8_XMMA1(ai, bj) do { if (USE_SETPRIO) __builtin_amdgcn_s_setprio(USE_SETPRIO); if constexpr (Prob::I8) PG8_MMAI(ai, bj, At, B1); else if constexpr (Prob::F8 && F8MODE == 2) PG8_MMA8(ai, bj, At8, B18); else if constexpr (Prob::F8) PG8_MMAQ(ai, bj, At, B1); else PG8_MMAB(ai, bj, At, B1); if (USE_SETPRIO) __builtin_amdgcn_s_setprio(0); } while (0)
#define PG8_WAIT_V(n) asm volatile("s_waitcnt vmcnt(" #n ")" ::: "memory")
#define PG8_WAIT_L(n) asm volatile("s_waitcnt lgkmcnt(" #n ")" ::: "memory")
#define PG8_BAR __builtin_amdgcn_s_barrier()
#define PG8_SCHED __builtin_amdgcn_sched_barrier(0)
    Unit cur, nxt; int ui = 0;
    if (!S.next(0, cur)) return;
    unsigned vo[2][2], nvo[2][2];
    calc_aoff(P, cur, Rr, Cc, vo);
    bool has_next = S.next(1, nxt);
    if constexpr (Prob::GATHER) { if (has_next) calc_aoff(P, nxt, Rr, Cc, nvo); else {
#pragma unroll
        for (int h = 0; h < 2; ++h)
#pragma unroll
            for (int i = 0; i < 2; ++i) nvo[h][i] = vo[h][i]; } }
    f32x4 acc[2][2][4][2];
#pragma unroll
    for (int a = 0; a < 2; ++a)
#pragma unroll
        for (int b = 0; b < 2; ++b)
#pragma unroll
            for (int m = 0; m < 4; ++m)
#pragma unroll
                for (int n = 0; n < 2; ++n) acc[a][b][m][n] = (f32x4){0.f, 0.f, 0.f, 0.f};
    bf16x8 At[4][2], B0[2][2], B1[2][2]; i32x8_t At8[4], B08[2], B18[2];
    const char* cA = P.a_base(cur); const char* cB = P.b_base(cur);
    if constexpr (Epi::HAS_PRE) E.pre(cur, 0, wid, lane);
    PG8_STGB(PG8_SB(0, 0), cB); PG8_STGB(PG8_SB(0, 1), cB + bhstep); PG8_STG(PG8_SA(0, 0), cA, vo[0][0], vo[0][1]); PG8_STG(PG8_SA(0, 1), cA, vo[1][0], vo[1][1]);
    if (wr == 1) PG8_BAR;
    PG8_WAIT_V(2); PG8_BAR;
    PG8_STGB(PG8_SB(1, 0), cB + kstep); PG8_STG(PG8_SA(1, 0), cA + kstep, vo[0][0], vo[0][1]); PG8_STGB(PG8_SB(1, 1), cB + bhstep + kstep);
    PG8_WAIT_V(6); PG8_BAR;
    for (;;) {
        const char* nA = has_next ? P.a_base(nxt) : cA; const char* nB = has_next ? P.b_base(nxt) : cB;
        for (int t = 0; t < nt; t += 2) {
            const bool last = (t == nt - 2);
            if constexpr (Epi::HAS_MID) { if (t == Epi::MID_T0 || t == Epi::MID_T1) { E.mid(acc, cur, wr, wc, fr, fq, t == Epi::MID_T0 ? 0 : 1); PG8_SCHED; } }
            const char* a1 = cA + (size_t)(t + 1) * kstep;
            const char* a2 = last ? nA : cA + (size_t)(t + 2) * kstep; const char* b2 = last ? nB : cB + (size_t)(t + 2) * kstep;
            const char* a3 = a2 + kstep; const char* b3 = b2 + kstep;
            unsigned x00 = vo[0][0], x01 = vo[0][1], x10 = vo[1][0], x11 = vo[1][1];
            if constexpr (Prob::GATHER) { if (last) { x00 = nvo[0][0]; x01 = nvo[0][1]; x10 = nvo[1][0]; x11 = nvo[1][1]; } }
            PG8_XLDB0(0, 0); PG8_XLDB1(0, 1); PG8_SCHED; PG8_XLDA(0, 0); PG8_STG(PG8_SA(1, 1), a1, vo[1][0], vo[1][1]);
            PG8_WAIT_V(8); PG8_WAIT_L(0); PG8_BAR; PG8_XMMA0(0, 0); PG8_XMMA1(0, 1); PG8_BAR; PG8_SCHED;
            PG8_XLDA(0, 1); PG8_STGB(PG8_SB(0, 0), b2); PG8_STGB(PG8_SB(0, 1), b2 + bhstep); PG8_STG(PG8_SA(0, 0), a2, x00, x01);
            PG8_WAIT_V(8); PG8_WAIT_L(0); PG8_BAR; PG8_XMMA0(1, 0); PG8_XMMA1(1, 1); PG8_BAR; PG8_SCHED;
            PG8_XLDB0(1, 0); PG8_XLDB1(1, 1); PG8_SCHED; PG8_XLDA(1, 0); PG8_STG(PG8_SA(0, 1), a2, x10, x11);
            PG8_WAIT_V(8); PG8_WAIT_L(0); PG8_BAR; PG8_XMMA0(0, 0); PG8_XMMA1(0, 1); PG8_BAR; PG8_SCHED;
            PG8_XLDA(1, 1); PG8_STGB(PG8_SB(1, 0), b3); PG8_STGB(PG8_SB(1, 1), b3 + bhstep); PG8_STG(PG8_SA(1, 0), a3, x00, x01);
            PG8_WAIT_V(8); PG8_WAIT_L(0); PG8_BAR; PG8_XMMA0(1, 0); PG8_XMMA1(1, 1); PG8_BAR; PG8_SCHED;
        }
        if constexpr (ALIGN_EPI) { if (wr == 0) PG8_BAR; }
        if constexpr ((Prob::F8 && F8MODE == 2) || Prob::I8) asm volatile("s_nop 15\n\ts_nop 15" ::: "memory");
        Unit nn; const bool has_nn = has_next && S.next(ui + 2, nn);
        if constexpr (Prob::GATHER) {
#pragma unroll
            for (int h = 0; h < 2; ++h)
#pragma unroll
                for (int i = 0; i < 2; ++i) vo[h][i] = nvo[h][i];
            if (has_nn) {
#pragma unroll
                for (int h = 0; h < 2; ++h)
#pragma unroll
                    for (int i = 0; i < 2; ++i) nvo[h][i] = P.a_raw(nn, h * HALF + Rr[i]); } }
        if constexpr (Epi::HAS_PRE) E(acc, cur, wr, wc, fr, fq, ui & 1); else E(acc, cur, wr, wc, fr, fq);
        PU(ui);
        if (!has_next) break;
#pragma unroll
        for (int a = 0; a < 2; ++a)
#pragma unroll
            for (int b = 0; b < 2; ++b)
#pragma unroll
                for (int m = 0; m < 4; ++m)
#pragma unroll
                    for (int n = 0; n < 2; ++n) acc[a][b][m][n] = (f32x4){0.f, 0.f, 0.f, 0.f};
        cur = nxt; cA = nA; cB = nB; ++ui;
        if constexpr (Epi::HAS_PRE) E.pre(cur, ui, wid, lane);
        has_next = has_nn; nxt = nn;
        if constexpr (Prob::GATHER) { if (has_next) {
#pragma unroll
            for (int h = 0; h < 2; ++h)
#pragma unroll
                for (int i = 0; i < 2; ++i) nvo[h][i] = (nvo[h][i] >> 2) * (Prob::F8 ? 1024u : 2048u) + (unsigned)Cc[i] * 2u;
            asm volatile("" : "+v"(nvo[0][0]), "+v"(nvo[0][1]), "+v"(nvo[1][0]), "+v"(nvo[1][1])); } }
        if constexpr (ALIGN_EPI) { if (wr == 1) PG8_BAR; }
    }
    PG8_WAIT_V(0);
    if constexpr (!ALIGN_EPI) { if (wr == 0) PG8_BAR; }
    PG8_BAR;
#undef PG8_SA
#undef PG8_SB
#undef PG8_STG
#undef PG8_STGB
#undef PG8_LDA
#undef PG8_LDB
#undef PG8_MMAB
#undef PG8_MMAQ
#undef PG8_MMA8
#undef PG8_MMAI
#undef PG8_LDA8
#undef PG8_LDB8
#undef PG8_XLDA
#undef PG8_XLDB0
#undef PG8_XLDB1
#undef PG8_XMMA0
#undef PG8_XMMA1
#undef PG8_WAIT_V
#undef PG8_WAIT_L
#undef PG8_BAR
#undef PG8_SCHED
}

typedef const f32x4 (&AccRef)[2][2][4][2];
__device__ __forceinline__ void dma4(const void* g, LAS unsigned char* dst) { __builtin_amdgcn_global_load_lds((const unsigned*)g, (LAS unsigned*)dst, 4, 0, 0); }

__device__ __forceinline__ void store8(bf16_t* p, const f32x4& a, const f32x4& b) {
    u32x4 w; w.x = cvt_pk_bf16(a[0], a[1]); w.y = cvt_pk_bf16(a[2], a[3]); w.z = cvt_pk_bf16(b[0], b[1]); w.w = cvt_pk_bf16(b[2], b[3]); *(u32x4*)p = w;
}
__device__ __forceinline__ float sigmoidf_(float v) { return __builtin_amdgcn_rcpf(1.0f + __builtin_amdgcn_exp2f(-1.4426950408889634f * v)); }

struct EpiInProj {
    static constexpr bool HAS_MID = false; static constexpr bool HAS_PRE = false;
    bf16_t *Q, *Kb, *V, *U, *MQ, *GT; const float *qn, *kn, *mqn, *bg; const f32x2* rope; const float* rs;
    __device__ __forceinline__ void operator()(AccRef acc, const Unit& u, int wr, int wc, int fr, int fq) const {
        const int pn = u.pn; const int row0 = u.pm * BM + wr * 64 + fr;
        float sc8[8];
#pragma unroll
        for (int q = 0; q < 8; ++q) sc8[q] = rs[row0 + (q >> 2) * HALF + (q & 3) * 16] * (1.0f / WQ_IN);
#define I2F(v) __builtin_convertvector(__builtin_bit_cast(i32x4_t, v), f32x4)
        bf16_t* const Q_ = Q; bf16_t* const K_ = Kb; bf16_t* const V_ = V; bf16_t* const U_ = U; bf16_t* const MQ_ = MQ; const float* const qn_ = qn; const float* const kn_ = kn; const float* const mqn_ = mqn;
        if (pn < 4 || pn == 7) {
            const bool rope_on = pn < 4; const float* gn = pn < 2 ? qn_ : (pn < 4 ? kn_ : mqn_);
            const float sc = (pn < 2 || pn == 7) ? C2 : 1.0f;
            bf16_t* O; int pitch, colb;
            if (pn < 2) { O = Q_; pitch = 512; colb = (pn * 4 + wc) * 64; } else if (pn < 4) { O = K_; pitch = 512; colb = ((pn - 2) * 4 + wc) * 64; } else { O = MQ_; pitch = 256; colb = wc * 64; }
            const f32x4 g00 = *(const f32x4*)(gn + 8 * fq), g01 = *(const f32x4*)(gn + 8 * fq + 4), g10 = *(const f32x4*)(gn + 32 + 8 * fq), g11 = *(const f32x4*)(gn + 32 + 8 * fq + 4);
#pragma unroll
            for (int ai = 0; ai < 2; ++ai)
#pragma unroll
                for (int m = 0; m < 4; ++m) {
                    const float rsc = sc8[ai * 4 + m]; const f32x4 a0 = I2F(acc[ai][0][m][0]) * rsc, a1 = I2F(acc[ai][0][m][1]) * rsc, b0 = I2F(acc[ai][1][m][0]) * rsc, b1 = I2F(acc[ai][1][m][1]) * rsc;
                    float ss = 0.f;
#pragma unroll
                    for (int j = 0; j < 4; ++j) ss += a0[j] * a0[j] + a1[j] * a1[j] + b0[j] * b0[j] + b1[j] * b1[j];
                    ss += __shfl_xor(ss, 16); ss += __shfl_xor(ss, 32);
                    const float rstd = 1.0f / sqrtf(ss * (1.0f / 64.0f) + RMS_EPS);
                    const int row = row0 + ai * HALF + m * 16;
                    f32x4 t10 = a0 * rstd * g00, t11 = a1 * rstd * g01, t20 = b0 * rstd * g10, t21 = b1 * rstd * g11;
                    f32x4 o10, o11, o20, o21;
                    if (rope_on) {
                        const f32x4* rp = (const f32x4*)(rope + (size_t)(row & (SEQ - 1)) * 32 + 8 * fq);
                        const f32x4 r0 = rp[0], r1 = rp[1], r2 = rp[2], r3 = rp[3];
                        const f32x4 cs0 = {r0[0], r0[2], r1[0], r1[2]}, sn0 = {r0[1], r0[3], r1[1], r1[3]}, cs1 = {r2[0], r2[2], r3[0], r3[2]}, sn1 = {r2[1], r2[3], r3[1], r3[3]};
                        o10 = (t10 * cs0 - t20 * sn0) * sc; o11 = (t11 * cs1 - t21 * sn1) * sc; o20 = (t20 * cs0 + t10 * sn0) * sc; o21 = (t21 * cs1 + t11 * sn1) * sc;
                    } else { o10 = t10 * sc; o11 = t11 * sc; o20 = t20 * sc; o21 = t21 * sc; }
                    bf16_t* rowp = O + (size_t)row * pitch + colb + 8 * fq;
                    store8(rowp, o10, o11); store8(rowp + 32, o20, o21);
                }
        } else if (pn < 7) {
            bf16_t* O; int pitch, colb;
            if (pn < 6) { O = V_; pitch = 512; colb = (pn - 4) * 256 + wc * 64; } else { O = U_; pitch = 256; colb = wc * 64; }
#pragma unroll
            for (int ai = 0; ai < 2; ++ai)
#pragma unroll
                for (int m = 0; m < 4; ++m) { bf16_t* rowp = O + (size_t)(row0 + ai * HALF + m * 16) * pitch + colb + 8 * fq;
                    const float sc = sc8[ai * 4 + m]; store8(rowp, I2F(acc[ai][0][m][0]) * sc, I2F(acc[ai][0][m][1]) * sc); store8(rowp + 32, I2F(acc[ai][1][m][0]) * sc, I2F(acc[ai][1][m][1]) * sc); }
        } else {
            const int gc = (pn - 8) * 256 + wc * 64 + 8 * fq;
            f32x4 bv[2][2];
#pragma unroll
            for (int bj = 0; bj < 2; ++bj)
#pragma unroll
                for (int n = 0; n < 2; ++n) bv[bj][n] = *(const f32x4*)(bg + gc + 32 * bj + 4 * n) * (-1.4426950408889634f);
#pragma unroll
            for (int ai = 0; ai < 2; ++ai)
#pragma unroll
                for (int m = 0; m < 4; ++m) {
                    unsigned char* blk = (unsigned char*)GT + ((size_t)(((pn - 8) >> 2) * 128 + u.pm) * 4 + ((pn - 8) & 3)) * 65536 + (size_t)((wr * 4 + wc) * 8 * 64 + (fq * 16 + fr)) * 16;
                    u32x4 w4 = {0u, 0u, 0u, 0u};
#pragma unroll
                    for (int bj = 0; bj < 2; ++bj) { const float scl = sc8[ai * 4 + m] * (-1.4426950408889634f); f32x4 v0 = I2F(acc[ai][bj][m][0]) * scl + bv[bj][0], v1 = I2F(acc[ai][bj][m][1]) * scl + bv[bj][1];
                        unsigned wx = 0u, wy = 0u;
#pragma unroll
                        for (int j = 0; j < 4; ++j) { const float g0 = __builtin_amdgcn_rcpf(1.0f + __builtin_amdgcn_exp2f(v0[j])), g1 = __builtin_amdgcn_rcpf(1.0f + __builtin_amdgcn_exp2f(v1[j]));
                            wx = __builtin_amdgcn_cvt_pk_u8_f32(fmaxf(g0 * 255.0f + 0.25f, 1.0f), j, wx); wy = __builtin_amdgcn_cvt_pk_u8_f32(fmaxf(g1 * 255.0f + 0.25f, 1.0f), j, wy); }
                        if (bj == 0) { w4.x = wx; w4.y = wy; } else { w4.z = wx; w4.w = wy; } }
                    *(u32x4*)(blk + (ai * 4 + m) * 1024) = w4; }
        }
    }
};
#undef I2F
struct EpiMemKV {
    static constexpr bool HAS_MID = false; static constexpr bool HAS_PRE = false;
    bf16_t* MKV; const float* mkn;
    __device__ __forceinline__ void operator()(AccRef acc, const Unit& u, int wr, int wc, int fr, int fq) const {
        const int row0 = u.pm * BM + wr * 64 + fr;
        f32x4 g00 = {1.f, 1.f, 1.f, 1.f}, g01 = g00, g10 = g00, g11 = g00;
        if (u.pn == 0) { g00 = *(const f32x4*)(mkn + 8 * fq); g01 = *(const f32x4*)(mkn + 8 * fq + 4); g10 = *(const f32x4*)(mkn + 32 + 8 * fq); g11 = *(const f32x4*)(mkn + 32 + 8 * fq + 4); }
#pragma unroll
        for (int ai = 0; ai < 2; ++ai)
#pragma unroll
            for (int m = 0; m < 4; ++m) {
                const f32x4 a0 = acc[ai][0][m][0], a1 = acc[ai][0][m][1], b0 = acc[ai][1][m][0], b1 = acc[ai][1][m][1];
                float rstd = 1.0f;
                if (u.pn == 0) { float ss = 0.f;
#pragma unroll
                    for (int j = 0; j < 4; ++j) ss += a0[j] * a0[j] + a1[j] * a1[j] + b0[j] * b0[j] + b1[j] * b1[j];
                    ss += __shfl_xor(ss, 16); ss += __shfl_xor(ss, 32); rstd = 1.0f / sqrtf(ss * (1.0f / 64.0f) + RMS_EPS); }
                bf16_t* rowp = MKV + (size_t)(row0 + ai * HALF + m * 16) * 512 + u.pn * 256 + wc * 64 + 8 * fq;
                store8(rowp, a0 * rstd * g00, a1 * rstd * g01); store8(rowp + 32, b0 * rstd * g10, b1 * rstd * g11);
            }
    }
};
template <int STAGE> struct EpiMerge {
    static constexpr bool HAS_MID = false; static constexpr bool HAS_PRE = false;
    const bf16_t* GT; float* MF; bf16_t* MB;
    __device__ __forceinline__ void operator()(AccRef acc, const Unit& u, int wr, int wc, int fr, int fq) const {
        const int row0 = u.pm * BM + wr * 64 + fr, col0 = u.pn * BM + wc * 64 + 8 * fq;
#pragma unroll
        for (int ai = 0; ai < 2; ++ai)
#pragma unroll
            for (int m = 0; m < 4; ++m) { const size_t row = (size_t)(row0 + ai * HALF + m * 16);
#pragma unroll
                for (int bj = 0; bj < 2; ++bj) { const int col = col0 + 32 * bj;
                    const u32x4 g = *(const u32x4*)(GT + row * 3072 + STAGE * 1024 + col);
                    const f32x4 ga = {bf_lo(g.x), bf_hi(g.x), bf_lo(g.y), bf_hi(g.y)}, gb = {bf_lo(g.z), bf_hi(g.z), bf_lo(g.w), bf_hi(g.w)};
                    f32x4 v0 = acc[ai][bj][m][0] * ga, v1 = acc[ai][bj][m][1] * gb;
                    float* mp = MF + row * 1024 + col;
                    if (STAGE > 0) { v0 += *(const f32x4*)mp; v1 += *(const f32x4*)(mp + 4); }
                    if (STAGE < 2) { *(f32x4*)mp = v0; *(f32x4*)(mp + 4) = v1; } else store8(MB + row * 1024 + col, v0, v1); }
                if (m & 1) asm volatile("" ::: "memory"); }
    }
};
__device__ __forceinline__ u32x4 pair16(const u32x2& a, const u32x2& b) {
    const auto rx = __builtin_amdgcn_permlane16_swap(a.x, b.x, false, false), ry = __builtin_amdgcn_permlane16_swap(a.y, b.y, false, false);
    return (u32x4){rx[0], ry[0], rx[1], ry[1]};
}
struct EpiWout {
    static constexpr bool HAS_MID = false; static constexpr bool HAS_PRE = false;
    const float* X; float* X2; unsigned char* XG; const float* n2;
    __device__ __forceinline__ void operator()(AccRef acc, const Unit& u, int wr, int wc, int fr, int fq) const {
        const int row0 = u.pm * BM + wr * 64 + fr, col0 = u.pn * BM + wc * 64 + 8 * fq;
        f32x4 nv[2][2];
#pragma unroll
        for (int bj = 0; bj < 2; ++bj)
#pragma unroll
            for (int n = 0; n < 2; ++n) nv[bj][n] = *(const f32x4*)(n2 + col0 + 32 * bj + 4 * n);
        const size_t xgoff = (size_t)(row0 + 16 * (fq & 1)) * 1024 + u.pn * BM + wc * 64 + 8 * (fq & 2);
#pragma unroll
        for (int ai = 0; ai < 2; ++ai)
#pragma unroll
            for (int mp = 0; mp < 2; ++mp) { u32x2 w8[2][2];
#pragma unroll
                for (int mm = 0; mm < 2; ++mm) { const int m = 2 * mp + mm; const size_t off = (size_t)(row0 + ai * HALF + m * 16) * 1024 + col0;
#pragma unroll
                    for (int bj = 0; bj < 2; ++bj) { const f32x4 x0 = *(const f32x4*)(X + off + 32 * bj) + acc[ai][bj][m][0], x1 = *(const f32x4*)(X + off + 32 * bj + 4) + acc[ai][bj][m][1];
                        *(f32x4*)(X2 + off + 32 * bj) = x0; *(f32x4*)(X2 + off + 32 * bj + 4) = x1;
                        const f32x4 y0 = x0 * nv[bj][0], y1 = x1 * nv[bj][1]; w8[mm][bj].x = pk4_fp8(y0[0], y0[1], y0[2], y0[3]); w8[mm][bj].y = pk4_fp8(y1[0], y1[1], y1[2], y1[3]); } }
#pragma unroll
                for (int bj = 0; bj < 2; ++bj) *(u32x4*)(XG + xgoff + (size_t)(ai * HALF + mp * 32) * 1024 + 32 * bj) = pair16(w8[0][bj], w8[1][bj]);
                asm volatile("" ::: "memory"); }
    }
};
struct EpiSwiglu {
    static constexpr bool HAS_MID = false; static constexpr bool HAS_PRE = true;
    unsigned char* ACT; const u32x2* list; const float* bgu; LAS unsigned char* xb;
    __device__ __forceinline__ void pre(const Unit& u, int ui, int wid, int lane) const {
        LAS unsigned char* b = xb + (ui & 1) * 2048;
        if (wid < 4) { const int rr = u.mt * BM + 64 * wid + lane, rc = rr < u.cnt ? rr : u.cnt - 1; dma4((const unsigned*)(list + (size_t)u.e * CAP + rc) + 1, b + wid * 256); }
        else { const int j = 64 * (wid - 4) + lane; dma4(bgu + (size_t)u.e * 2048 + 128 * u.pn + (j < 128 ? j : 1024 + (j - 128)), b + 1024 + (wid - 4) * 256); }
    }
    __device__ __forceinline__ static unsigned swi4(const f32x4& ag, const f32x4& au, float rstd, const f32x4& bg, const f32x4& bu) {
        unsigned w = 0;
#pragma unroll
        for (int h = 0; h < 2; ++h) {
            const f32x2 a2 = {ag[2 * h], ag[2 * h + 1]}, u2 = {au[2 * h], au[2 * h + 1]}, bg2 = {bg[2 * h], bg[2 * h + 1]}, bu2 = {bu[2 * h], bu[2 * h + 1]};
            const f32x2 G = a2 * rstd + bg2, U = u2 * rstd + bu2;
            const f32x2 gg = {fminf(G[0], 7.0f), fminf(G[1], 7.0f)};
            const f32x2 t = gg * (-1.702f * 1.4426950408889634f);
            const f32x2 d = (f32x2){__builtin_amdgcn_exp2f(t[0]), __builtin_amdgcn_exp2f(t[1])} + 1.0f;
            const f32x2 r = {__builtin_amdgcn_rcpf(d[0]), __builtin_amdgcn_rcpf(d[1])};
            const f32x2 uu = {__builtin_amdgcn_fmed3f(U[0], -7.0f, 7.0f), __builtin_amdgcn_fmed3f(U[1], -7.0f, 7.0f)};
            const f32x2 o = (gg * r) * (uu * A8_SCALE + A8_SCALE);
            w = h ? (unsigned)__builtin_amdgcn_cvt_pk_fp8_f32(o[0], o[1], (int)w, true) : (unsigned)__builtin_amdgcn_cvt_pk_fp8_f32(o[0], o[1], (int)w, false);
        }
        return w;
    }
    __device__ __forceinline__ void operator()(AccRef acc, const Unit& u, int wr, int wc, int fr, int fq, int par) const {
        int z = 0; asm volatile("" : "+v"(z));
        const int col = 128 * u.pn + 32 * wc + 8 * fq + z; const LAS unsigned char* b = xb + par * 2048; const LAS unsigned char* bb = b + 1024 + (32 * wc + 8 * fq + z) * 4;
        const f32x4 bg0 = *(const LAS f32x4*)bb, bg1 = *(const LAS f32x4*)(bb + 16), bu0 = *(const LAS f32x4*)(bb + 512), bu1 = *(const LAS f32x4*)(bb + 528);
        unsigned char* const ap = ACT + (size_t)(u.pm * BM + wr * 64 + fr + 16 * (fq & 1)) * 1024 + 128 * u.pn + 32 * wc + 8 * (fq & 2) + z;
#pragma unroll
        for (int ai = 0; ai < 2; ++ai)
#pragma unroll
            for (int mp = 0; mp < 2; ++mp) { u32x2 w8[2];
#pragma unroll
                for (int mm = 0; mm < 2; ++mm) { const int m = 2 * mp + mm, r = ai * HALF + wr * 64 + m * 16 + fr;
                    const float rstd = *(const LAS float*)(b + (r + z) * 4) * (1.0f / W8_SCALE);
                    w8[mm].x = swi4(acc[ai][0][m][0], acc[ai][1][m][0], rstd, bg0, bu0); w8[mm].y = swi4(acc[ai][0][m][1], acc[ai][1][m][1], rstd, bg1, bu1); }
                *(u32x4*)(ap + (size_t)(ai * HALF + mp * 32) * 1024) = pair16(w8[0], w8[1]); }
    }
};
struct EpiDown {
    static constexpr bool HAS_MID = false; static constexpr bool HAS_PRE = true;
    unsigned char* Y4; const u32x2* list; const float* bd; LAS unsigned char* xb;
    __device__ __forceinline__ void pre(const Unit& u, int ui, int wid, int lane) const {
        LAS unsigned char* b = xb + (ui & 1) * 2048;
        if (wid < 4) { const int rr = u.mt * BM + 64 * wid + lane, rc = rr < u.cnt ? rr : u.cnt - 1; dma4((const unsigned*)(list + (size_t)u.e * CAP + rc), b + wid * 256); }
        else { const int j = 64 * (wid - 4) + lane; dma4(bd + (size_t)u.e * 1024 + u.pn * BM + j, b + 1024 + (wid - 4) * 256); }
    }
    __device__ __forceinline__ static unsigned dn4(const f32x4& a, const f32x4& b32) {
        const f32x4 y = a * (Y8_SCALE / (W8_SCALE * A8_SCALE)) + b32;
        return pk4_fp8(y[0], y[1], y[2], y[3]);
    }
    __device__ __forceinline__ void operator()(AccRef acc, const Unit& u, int wr, int wc, int fr, int fq, int par) const {
        int z = 0; asm volatile("" : "+v"(z));
        const int colw = wc * 64 + 16 * fq + z, col0 = u.pn * BM + colw;
        const LAS unsigned char* b = xb + par * 2048;
        f32x4 bv[2][2];
#pragma unroll
        for (int bj = 0; bj < 2; ++bj)
#pragma unroll
            for (int n = 0; n < 2; ++n) bv[bj][n] = *(const LAS f32x4*)(b + 1024 + (colw + 8 * bj + 4 * n) * 4) * Y8_SCALE;
#pragma unroll
        for (int ai = 0; ai < 2; ++ai)
#pragma unroll
            for (int m = 0; m < 4; ++m) { const int r = ai * HALF + wr * 64 + m * 16 + fr, rr = u.mt * BM + r;
                if (rr < u.cnt) { const unsigned tk = *(const LAS unsigned*)(b + (r + z) * 4);
                    u32x4 w8; w8.x = dn4(acc[ai][0][m][0], bv[0][0]); w8.y = dn4(acc[ai][0][m][1], bv[0][1]); w8.z = dn4(acc[ai][1][m][0], bv[1][0]); w8.w = dn4(acc[ai][1][m][1], bv[1][1]);
                    *(u32x4*)(Y4 + (size_t)tk * 1024 + col0) = w8; } }
    }
};
struct EpiMergeR {
    static constexpr bool HAS_MID = true; static constexpr bool HAS_PRE = false; static constexpr int MID_T0 = 8, MID_T1 = 12;
    const bf16_t* GT; bf16_t* MB;
    __device__ __forceinline__ void mid(f32x4 (&acc)[2][2][4][2], const Unit& u, int wr, int wc, int fr, int fq, int seam) const {
        int z = 0; asm volatile("" : "+v"(z));
        const unsigned char* gp0 = (const unsigned char*)GT + ((size_t)(seam * 128 + u.pm) * 4 + u.pn) * 65536 + (size_t)((wr * 4 + wc) * 8 * 64 + (fq * 16 + fr) + z) * 16;
#pragma unroll
        for (int ai = 0; ai < 2; ++ai)
#pragma unroll
            for (int m = 0; m < 4; ++m) { const unsigned char* gp = gp0 + (ai * 4 + m) * 1024;
                const u32x4 gn = *(const u32x4*)gp, gd = *(const u32x4*)(gp + (size_t)128 * 4 * 65536);
#pragma unroll
                for (int bj = 0; bj < 2; ++bj)
#pragma unroll
                    for (int n = 0; n < 2; ++n) { const unsigned wn = gn[bj * 2 + n], wd = gd[bj * 2 + n];
#pragma unroll
                        for (int j = 0; j < 4; ++j) acc[ai][bj][m][n][j] *= (float)((wn >> (8 * j)) & 0xffu) * __builtin_amdgcn_rcpf((float)((wd >> (8 * j)) & 0xffu)); }
                if (m & 1) asm volatile("" ::: "memory"); }
    }
    __device__ __forceinline__ void operator()(AccRef acc, const Unit& u, int wr, int wc, int fr, int fq) const {
        int z = 0; asm volatile("" : "+v"(z));
        const size_t off0 = (size_t)(u.pm * BM + wr * 64 + fr + z) * 1024 + u.pn * BM + wc * 64 + 8 * fq;
        const unsigned char* gp0 = (const unsigned char*)GT + ((size_t)(2 * 128 + u.pm) * 4 + u.pn) * 65536 + (size_t)((wr * 4 + wc) * 8 * 64 + (fq * 16 + fr) + z) * 16;
#pragma unroll
        for (int ai = 0; ai < 2; ++ai)
#pragma unroll
            for (int m = 0; m < 4; ++m) { const size_t ro = off0 + (size_t)(ai * HALF + m * 16) * 1024;
                const u32x4 g4 = *(const u32x4*)(gp0 + (ai * 4 + m) * 1024);
#pragma unroll
                for (int bj = 0; bj < 2; ++bj) { const unsigned gx = g4[bj * 2], gy = g4[bj * 2 + 1];
                    f32x4 ga, gb;
#pragma unroll
                    for (int j = 0; j < 4; ++j) { ga[j] = (float)((gx >> (8 * j)) & 0xffu) * (1.0f / 255.0f); gb[j] = (float)((gy >> (8 * j)) & 0xffu) * (1.0f / 255.0f); }
                    store8(MB + ro + 32 * bj, acc[ai][bj][m][0] * ga, acc[ai][bj][m][1] * gb); } }
    }
};
struct EpiPlain {
    static constexpr bool HAS_MID = false; static constexpr bool HAS_PRE = false;
    bf16_t* Z; int ldz;
    __device__ __forceinline__ void operator()(AccRef acc, const Unit& u, int wr, int wc, int fr, int fq) const {
        const int row0 = u.pm * BM + wr * 64 + fr, col0 = u.pn * BM + wc * 64 + 8 * fq;
#pragma unroll
        for (int ai = 0; ai < 2; ++ai)
#pragma unroll
            for (int m = 0; m < 4; ++m) { bf16_t* rowp = Z + (size_t)(row0 + ai * HALF + m * 16) * ldz + col0;
                store8(rowp, acc[ai][0][m][0], acc[ai][0][m][1]); store8(rowp + 32, acc[ai][1][m][0], acc[ai][1][m][1]); }
    }
};
}

namespace attn_body {
using bf16 = __hip_bfloat16;
using s16x4 = __attribute__((ext_vector_type(4))) short;
constexpr int NW = 8, QBLK = 32, QB = QBLK * NW, KVBLK = 64, D = 64;
__device__ __forceinline__ int crow(int r, int hi) { return (r & 3) + 8 * (r >> 2) + 4 * hi; }
#define SBAR() __builtin_amdgcn_sched_barrier(0)
constexpr int NSLOT = 3, SLOTB = 8192;
constexpr int LDS_K = 0, LDS_V = NSLOT * SLOTB, LDS_WS = 2 * NSLOT * SLOTB, LDS_OST = LDS_WS + NW * 64 * 4, LDS_BYTES = LDS_OST + NW * 4096;
__device__ __forceinline__ void glds16(const void* gsrc, unsigned lds_dst) { unsigned keep;
    asm volatile("s_mov_b32 %0, m0\n\ts_mov_b32 m0, %2\n\ts_nop 0\n\tglobal_load_lds_dwordx4 %1, off\n\ts_mov_b32 m0, %0" : "=&s"(keep) : "v"(gsrc), "s"(lds_dst) : "memory"); }
__device__ __forceinline__ float max3f(float a, float b, float c) { float r; asm("v_max3_f32 %0, %1, %2, %3" : "=v"(r) : "v"(a), "v"(b), "v"(c)); return r; }
__device__ __forceinline__ float max2f(float a, float b) { float r; asm("v_max_f32_e32 %0, %1, %2" : "=v"(r) : "v"(a), "v"(b)); return r; }
__device__ __forceinline__ float fadd_s(float a, float b) { float r; asm("v_add_f32_e32 %0, %1, %2" : "=v"(r) : "v"(a), "v"(b)); return r; }
__device__ __forceinline__ float fsub_s(float a, float b) { float r; asm("v_sub_f32_e32 %0, %1, %2" : "=v"(r) : "v"(a), "v"(b)); return r; }
typedef float f32x2_t __attribute__((ext_vector_type(2))); typedef __bf16 bf16x2_t __attribute__((ext_vector_type(2)));
__device__ __forceinline__ unsigned cvtpk_s(float lo, float hi) { f32x2_t v = {lo, hi}; bf16x2_t b = __builtin_convertvector(v, bf16x2_t); return __builtin_bit_cast(unsigned, b); }
#define WAIT_BAR(N) asm volatile("s_waitcnt vmcnt(" #N ") lgkmcnt(0)\n\ts_barrier" ::: "memory")

__device__ __forceinline__ void qkt(f32x16& p0, f32x16& p1, const char* Kslot, const bf16x8* qr, const f32x16& negm, int r32, int hi) {
    const char* kb = Kslot + hi * 1024 + r32 * 16;
#pragma unroll
    for (int d0 = 0; d0 < 4; ++d0) {
        const bf16x8 b0 = *reinterpret_cast<const bf16x8*>(kb + d0 * 2048);
        const bf16x8 b1 = *reinterpret_cast<const bf16x8*>(kb + d0 * 2048 + 512);
        if (d0 == 0) { p0 = __builtin_amdgcn_mfma_f32_32x32x16_bf16(b0, qr[0], negm, 0, 0, 0); p1 = __builtin_amdgcn_mfma_f32_32x32x16_bf16(b1, qr[0], negm, 0, 0, 0); }
        else { p0 = __builtin_amdgcn_mfma_f32_32x32x16_bf16(b0, qr[d0], p0, 0, 0, 0); p1 = __builtin_amdgcn_mfma_f32_32x32x16_bf16(b1, qr[d0], p1, 0, 0, 0); } }
}
typedef __attribute__((address_space(3))) const char* lds_cptr;
typedef short v4i16_t __attribute__((ext_vector_type(4)));
__device__ __forceinline__ void kload8(bf16x8* kf, lds_cptr kp) {
    kf[0] = *(const __attribute__((address_space(3))) bf16x8*)(kp);        kf[1] = *(const __attribute__((address_space(3))) bf16x8*)(kp + 512);
    kf[2] = *(const __attribute__((address_space(3))) bf16x8*)(kp + 2048); kf[3] = *(const __attribute__((address_space(3))) bf16x8*)(kp + 2560);
    kf[4] = *(const __attribute__((address_space(3))) bf16x8*)(kp + 4096); kf[5] = *(const __attribute__((address_space(3))) bf16x8*)(kp + 4608);
    kf[6] = *(const __attribute__((address_space(3))) bf16x8*)(kp + 6144); kf[7] = *(const __attribute__((address_space(3))) bf16x8*)(kp + 6656);
}
__device__ __forceinline__ void kload2(bf16x8* kf, lds_cptr kp, int j) { kf[2 * j] = *(const __attribute__((address_space(3))) bf16x8*)(kp + j * 2048); kf[2 * j + 1] = *(const __attribute__((address_space(3))) bf16x8*)(kp + j * 2048 + 512); }
__device__ __forceinline__ s16x4 vtr(lds_cptr p) { return __builtin_bit_cast(s16x4, __builtin_amdgcn_ds_read_tr16_b64_v4i16((__attribute__((address_space(3))) v4i16_t*)p)); }
__device__ __forceinline__ float rowmax(const f32x16& p0, const f32x16& p1) {
    float a = max3f(p0[0], p0[1], p1[0]), b = max3f(p0[2], p0[3], p1[1]); a = max3f(a, p1[2], p1[3]);
#pragma unroll
    for (int r = 4; r < 16; r += 4) { a = max3f(a, p0[r], p0[r + 1]); b = max3f(b, p0[r + 2], p0[r + 3]); a = max3f(a, p1[r], p1[r + 1]); b = max3f(b, p1[r + 2], p1[r + 3]); }
    const float m = max2f(a, b);
    auto rr = __builtin_amdgcn_permlane32_swap(__float_as_uint(m), __float_as_uint(m), false, false);
    return max2f(__uint_as_float(rr[0]), __uint_as_float(rr[1]));
}
__device__ __forceinline__ void pv(f32x16* o, int vb, bf16x8 pa0, bf16x8 pa1, bf16x8 pa2, bf16x8 pa3) {
#pragma unroll
    for (int d0 = 0; d0 < 2; ++d0) { s16x4 lo[4], hi[4];
#pragma unroll
        for (int ks = 0; ks < 4; ++ks) {
            asm volatile("ds_read_b64_tr_b16 %0,%1 offset:%c2" : "=&v"(lo[ks]) : "v"(vb), "i"(d0 * 4096 + ks * 1024) : "memory");
            asm volatile("ds_read_b64_tr_b16 %0,%1 offset:%c2" : "=&v"(hi[ks]) : "v"(vb), "i"(d0 * 4096 + ks * 1024 + 512) : "memory"); }
        asm volatile("s_waitcnt lgkmcnt(0)" ::: "memory"); SBAR();
#define PK(k) (bf16x8){lo[k][0], lo[k][1], lo[k][2], lo[k][3], hi[k][0], hi[k][1], hi[k][2], hi[k][3]}
        o[d0] = __builtin_amdgcn_mfma_f32_32x32x16_bf16(pa0, PK(0), o[d0], 0, 0, 0);
        o[d0] = __builtin_amdgcn_mfma_f32_32x32x16_bf16(pa1, PK(1), o[d0], 0, 0, 0);
        o[d0] = __builtin_amdgcn_mfma_f32_32x32x16_bf16(pa2, PK(2), o[d0], 0, 0, 0);
        o[d0] = __builtin_amdgcn_mfma_f32_32x32x16_bf16(pa3, PK(3), o[d0], 0, 0, 0);
#undef PK
    }
}
__device__ __forceinline__ void cmask(f32x16& p0, f32x16& p1, int jb, int wid) {
    if (jb > (wid >> 1)) {
#pragma unroll
        for (int r = 0; r < 16; ++r) { p0[r] = -INFINITY; p1[r] = -INFINITY; } }
}
template <int THRL, bool MASK> __device__ __forceinline__ void attn_unit(int q0, int NT, const bf16* Qh, int qp, const bf16* __restrict__ Kh, int kp, const bf16* __restrict__ Vh, int vp, bf16* Oh, int op, char* shm) {
    const int tid = threadIdx.x, lane = tid & 63, r32 = lane & 31, hi = lane >> 5; const int wid = __builtin_amdgcn_readfirstlane(tid >> 6);
    const bf16* Qw = Qh + (long)(q0 + wid * QBLK) * qp;
    const unsigned lds0 = (unsigned)(uintptr_t)shm;
    float* wsf = (float*)(shm + LDS_WS) + wid * 64;
    const bf16* ksrc = Kh + (long)lane * kp + wid * 8;
    const bf16* vsrc = Vh + (long)(16 * (wid & 3) + (lane >> 2)) * vp + (wid >> 2) * 32 + (lane & 3) * 8;
    const unsigned kdst = lds0 + LDS_K + wid * 1024, vdst = lds0 + LDS_V + wid * 1024;
#define DMA_K(t, slot) glds16(ksrc + (long)(t) * KVBLK * kp, (unsigned)__builtin_amdgcn_readfirstlane(kdst + (slot)))
#define DMA_V(t, slot) glds16(vsrc + (long)(t) * KVBLK * vp, (unsigned)__builtin_amdgcn_readfirstlane(vdst + (slot)))
    const int vb0 = (int)(lds0 + LDS_V) + ((lane >> 4) & 1) * 32 + (lane & 3) * 8 + (4 * hi + ((lane & 15) >> 2)) * 64;
    const char* Kbase = shm + LDS_K; bf16x8 kf[8];
    const lds_cptr shm3 = (lds_cptr)shm; const lds_cptr kp0 = shm3 + LDS_K + hi * 1024 + r32 * 16; const lds_cptr vp0 = shm3 + LDS_V + ((lane >> 4) & 1) * 32 + (lane & 3) * 8 + (4 * hi + ((lane & 15) >> 2)) * 64;
    DMA_K(0, 0); DMA_V(0, 0); DMA_K(1, SLOTB);
    bf16x8 qr[4];
#pragma unroll
    for (int d0 = 0; d0 < 4; ++d0) qr[d0] = *reinterpret_cast<const bf16x8*>(&Qw[(long)r32 * qp + d0 * 16 + hi * 8]);
    float mhat = 0.f, l_reg = 0.f; f32x16 o[2]; o[0] = f32x16{}; o[1] = f32x16{}; f32x16 negm = f32x16{}; asm volatile("" : "+v"(negm));
#define CMASK(P0, P1, t) do { if (MASK) { int jb_ = (t) - (NT - 4); if (jb_ >= 0) cmask(P0, P1, jb_, wid); } } while (0)
    bool resc = false;
#define START(P0, P1) do { const float rm = rowmax(P0, P1); resc = false; \
    { const float dl = rm; mhat = fadd_s(mhat, dl); \
      _Pragma("unroll") for (int r = 0; r < 16; ++r) { P0[r] = fsub_s(P0[r], dl); P1[r] = fsub_s(P1[r], dl); } \
      _Pragma("unroll") for (int r = 0; r < 16; ++r) negm[r] = -mhat; asm volatile("" : "+v"(negm)); } \
    _Pragma("unroll") for (int r = 0; r < 16; ++r) P0[r] = __builtin_amdgcn_exp2f(P0[r]); } while (0)
#define RESC() do { if (resc) { asm volatile("s_waitcnt lgkmcnt(0)" ::: "memory"); \
      _Pragma("unroll") for (int d_ = 0; d_ < 2; ++d_) _Pragma("unroll") for (int r = 0; r < 16; ++r) o[d_][r] *= wsf[crow(r, hi)]; } } while (0)
    f32x16 pA0, pA1, pB0, pB1;
    int sl_prev = 0, sl_cur = 0, sl_next = SLOTB;
#define ROT() do { sl_prev = sl_cur; sl_cur = sl_next; sl_next = (sl_next == (NSLOT - 1) * SLOTB) ? 0 : sl_next + SLOTB; } while (0)
    DMA_K(2, 2 * SLOTB);
    WAIT_BAR(3);
    qkt(pA0, pA1, Kbase, qr, negm, r32, hi); asm volatile("s_nop 15\n\ts_nop 7" : "+v"(pA0), "+v"(pA1)); CMASK(pA0, pA1, 0);
    START(pA0, pA1);
    _Pragma("unroll") for (int r = 0; r < 16; ++r) pA1[r] = __builtin_amdgcn_exp2f(pA1[r]);
    WAIT_BAR(0);
    DMA_K(3, 0); DMA_V(1, SLOTB);
    ROT();
    kload8(kf, kp0 + sl_cur);
    WAIT_BAR(2);
    s16x4 vlo[8], vhi[8]; u32x4 pw0, pw1, pw2, pw3;
#define PKW(P, B) cvtpk_s(P[B], P[B + 1])
#define PAF(k) __builtin_bit_cast(bf16x8, pw##k)
#define VFR(i) (bf16x8){vlo[i][0], vlo[i][1], vlo[i][2], vlo[i][3], vhi[i][0], vhi[i][1], vhi[i][2], vhi[i][3]}
#define PIN(x) asm volatile("" : "+v"(x))
#define MX3(a, b, c) __builtin_fmaxf(__builtin_fmaxf((a), (b)), (c))
#define GAPA(MF, A0, A1, A2, A3, W0, W1, PW) do { MF; sacc += A0; sacc += A1; sacc += A2; sacc += A3; PIN(sacc); W0; W1; PIN(PW); SBAR(); } while (0)
#define EX(v) __builtin_amdgcn_exp2f(v)
#define GAPB(MF, X, B) do { MF; X[B] = EX(X[B]); X[B + 1] = EX(X[B + 1]); X[B + 2] = EX(X[B + 2]); X[B + 3] = EX(X[B + 3]); PIN(X); SBAR(); } while (0)
#define VRD(i) do { vlo[i] = vtr(vp_ + (((i) >> 2) * 4096 + ((i) & 3) * 1024)); vhi[i] = vtr(vp_ + (((i) >> 2) * 4096 + ((i) & 3) * 1024 + 512)); } while (0)
#define KRD(G, j) do { if (G) { kload2(kf, kp0 + sl_next, j); SBAR(); } } while (0)
#define STEP(C0, C1, P0, P1, t, GK, GV, GL) do { SBAR(); \
    const lds_cptr vp_ = vp0 + sl_prev; \
    VRD(0); SBAR(); float sacc = (P0[0] + P0[1]); \
    GAPA(C0 = __builtin_amdgcn_mfma_f32_32x32x16_bf16(kf[0], qr[0], negm, 0, 0, 0), P0[2], P0[3], P0[4], P0[5],     pw0[0] = PKW(P0, 0), pw0[1] = PKW(P0, 2), pw0); \
    VRD(4); SBAR(); GAPA(C1 = __builtin_amdgcn_mfma_f32_32x32x16_bf16(kf[1], qr[0], negm, 0, 0, 0), P0[6], P0[7], P0[8], P0[9],     pw0[2] = PKW(P0, 4), pw0[3] = PKW(P0, 6), pw0); \
    VRD(1); SBAR(); GAPA(C0 = __builtin_amdgcn_mfma_f32_32x32x16_bf16(kf[2], qr[1], C0, 0, 0, 0),   P0[10], P0[11], P0[12], P0[13], pw1[0] = PKW(P0, 8), pw1[1] = PKW(P0, 10), pw1); \
    VRD(5); SBAR(); GAPA(C1 = __builtin_amdgcn_mfma_f32_32x32x16_bf16(kf[3], qr[1], C1, 0, 0, 0),   P0[14], P0[15], P1[0], P1[1],   pw1[2] = PKW(P0, 12), pw1[3] = PKW(P0, 14), pw1); \
    VRD(2); SBAR(); GAPA(C0 = __builtin_amdgcn_mfma_f32_32x32x16_bf16(kf[4], qr[2], C0, 0, 0, 0),   P1[2], P1[3], P1[4], P1[5],     pw2[0] = PKW(P1, 0), pw2[1] = PKW(P1, 2), pw2); \
    VRD(6); SBAR(); GAPA(C1 = __builtin_amdgcn_mfma_f32_32x32x16_bf16(kf[5], qr[2], C1, 0, 0, 0),   P1[6], P1[7], P1[8], P1[9],     pw2[2] = PKW(P1, 4), pw2[3] = PKW(P1, 6), pw2); \
    VRD(3); SBAR(); GAPA(C0 = __builtin_amdgcn_mfma_f32_32x32x16_bf16(kf[6], qr[3], C0, 0, 0, 0),   P1[10], P1[11], P1[12], P1[13], pw3[0] = PKW(P1, 8), pw3[1] = PKW(P1, 10), pw3); \
    VRD(7); SBAR(); GAPA(C1 = __builtin_amdgcn_mfma_f32_32x32x16_bf16(kf[7], qr[3], C1, 0, 0, 0),   P1[14], P1[15], 0.f, 0.f,       pw3[2] = PKW(P1, 12), pw3[3] = PKW(P1, 14), pw3); \
    l_reg += sacc; \
    if (GK) { DMA_K((t) + 3, sl_cur); } if (GV) { DMA_V((t) + 1, sl_next); } \
    CMASK(C0, C1, t); \
    { float a = MX3(C0[0], C0[1], C1[0]), b = MX3(C0[2], C0[3], C1[1]); a = MX3(a, C1[2], C1[3]); \
      _Pragma("unroll") for (int r = 4; r < 16; r += 4) { a = MX3(a, C0[r], C0[r + 1]); b = MX3(b, C0[r + 2], C0[r + 3]); a = MX3(a, C1[r], C1[r + 1]); b = MX3(b, C1[r + 2], C1[r + 3]); } \
      float rm = __builtin_fmaxf(a, b); { auto rr = __builtin_amdgcn_permlane32_swap(__float_as_uint(rm), __float_as_uint(rm), false, false); rm = __builtin_fmaxf(__uint_as_float(rr[0]), __uint_as_float(rr[1])); } \
      resc = false; \
      if (__builtin_expect(__any(rm > (float)THRL), 0)) { const float dl = __builtin_fmaxf(rm, 0.f); mhat += dl; \
        _Pragma("unroll") for (int r = 0; r < 16; ++r) { C0[r] -= dl; C1[r] -= dl; } \
        _Pragma("unroll") for (int r = 0; r < 16; ++r) negm[r] = -mhat; asm volatile("" : "+v"(negm)); \
        const float f = __builtin_amdgcn_exp2f(-dl); l_reg *= f; if (hi == 0) wsf[r32] = f; resc = true; } } \
    SBAR(); \
    GAPB(o[0] = __builtin_amdgcn_mfma_f32_32x32x16_bf16(PAF(0), VFR(0), o[0], 0, 0, 0), C0, 0); \
    GAPB(o[1] = __builtin_amdgcn_mfma_f32_32x32x16_bf16(PAF(0), VFR(4), o[1], 0, 0, 0), C0, 4); \
    KRD(GL, 0); GAPB(o[0] = __builtin_amdgcn_mfma_f32_32x32x16_bf16(PAF(1), VFR(1), o[0], 0, 0, 0), C0, 8); \
    KRD(GL, 1); GAPB(o[1] = __builtin_amdgcn_mfma_f32_32x32x16_bf16(PAF(1), VFR(5), o[1], 0, 0, 0), C0, 12); \
    KRD(GL, 2); GAPB(o[0] = __builtin_amdgcn_mfma_f32_32x32x16_bf16(PAF(2), VFR(2), o[0], 0, 0, 0), C1, 0); \
    KRD(GL, 3); GAPB(o[1] = __builtin_amdgcn_mfma_f32_32x32x16_bf16(PAF(2), VFR(6), o[1], 0, 0, 0), C1, 4); \
    GAPB(o[0] = __builtin_amdgcn_mfma_f32_32x32x16_bf16(PAF(3), VFR(3), o[0], 0, 0, 0), C1, 8); \
    GAPB(o[1] = __builtin_amdgcn_mfma_f32_32x32x16_bf16(PAF(3), VFR(7), o[1], 0, 0, 0), C1, 12); \
    } while (0)
    int t = 1;
#undef CMASK
#define CMASK(P0, P1, t) do {} while (0)
    for (; t + 5 < NT; t += 2) {
        STEP(pB0, pB1, pA0, pA1, t, true, true, true);     WAIT_BAR(2); RESC(); ROT();
        STEP(pA0, pA1, pB0, pB1, t + 1, true, true, true); WAIT_BAR(2); RESC(); ROT();
    }
#undef CMASK
#define CMASK(P0, P1, t) do { if (MASK) { int jb_ = (t) - (NT - 4); if (jb_ >= 0) cmask(P0, P1, jb_, wid); } } while (0)
#define ENDW(tt) do { if ((tt) + 3 < NT) { WAIT_BAR(2); } else if ((tt) + 2 < NT) { WAIT_BAR(1); } else { WAIT_BAR(0); } } while (0)
    for (; t + 1 < NT; t += 2) {
        STEP(pB0, pB1, pA0, pA1, t, (t + 3 < NT), (t + 1 < NT), (t + 1 < NT));       ENDW(t);     RESC(); ROT();
        STEP(pA0, pA1, pB0, pB1, t + 1, (t + 4 < NT), (t + 2 < NT), (t + 2 < NT));   ENDW(t + 1); RESC(); ROT();
    }
    STEP(pB0, pB1, pA0, pA1, NT - 1, false, false, false); RESC();
    { float sacc = pB0[0] + pB0[1]; _Pragma("unroll") for (int r = 2; r < 16; ++r) sacc += pB0[r]; _Pragma("unroll") for (int r = 0; r < 16; ++r) sacc += pB1[r]; l_reg += sacc;
      pw0 = (u32x4){PKW(pB0, 0), PKW(pB0, 2), PKW(pB0, 4), PKW(pB0, 6)}; pw1 = (u32x4){PKW(pB0, 8), PKW(pB0, 10), PKW(pB0, 12), PKW(pB0, 14)}; pw2 = (u32x4){PKW(pB1, 0), PKW(pB1, 2), PKW(pB1, 4), PKW(pB1, 6)}; pw3 = (u32x4){PKW(pB1, 8), PKW(pB1, 10), PKW(pB1, 12), PKW(pB1, 14)};
      SBAR(); pv(o, vb0 + sl_cur, PAF(0), PAF(1), PAF(2), PAF(3)); }
#undef PKW
#undef PAF
#undef VFR
#undef PIN
#undef MX3
#undef GAPA
#undef GAPB
#undef EX
#undef VRD
#undef KRD
#undef STEP
#undef ENDW
    { auto rr = __builtin_amdgcn_permlane32_swap(__float_as_uint(l_reg), __float_as_uint(l_reg), false, false); l_reg = __uint_as_float(rr[0]) + __uint_as_float(rr[1]); }
    if (hi == 0) wsf[32 + r32] = l_reg; asm volatile("s_waitcnt lgkmcnt(0)" ::: "memory");
    float rli[16];
#pragma unroll
    for (int r = 0; r < 16; ++r) rli[r] = __builtin_amdgcn_rcpf(wsf[32 + crow(r, hi)]);
    bf16* Ow = Oh + (long)(q0 + wid * QBLK) * op;
    { bf16* stg = (bf16*)(shm + LDS_OST) + wid * 2048;
#pragma unroll
      for (int r = 0; r < 16; ++r) { const int orow = crow(r, hi);
#pragma unroll
        for (int d0 = 0; d0 < 2; ++d0) stg[orow * 64 + d0 * 32 + r32] = __float2bfloat16(o[d0][r] * rli[r]); }
      asm volatile("s_waitcnt lgkmcnt(0)" ::: "memory");
#pragma unroll
      for (int i = 0; i < 4; ++i) { const int row = i * 8 + (lane >> 3), ch = lane & 7; const u32x4 v = *(const u32x4*)(stg + row * 64 + ch * 8); *(u32x4*)(Ow + (long)row * op + ch * 8) = v; } }
    asm volatile("s_waitcnt lgkmcnt(0)\n\ts_barrier" ::: "memory");
#undef DMA_K
#undef DMA_V
#undef CMASK
#undef START
#undef RESC
#undef ROT
}

constexpr int L2_K = 0, L2_V = 3 * 8192, L2_WS = L2_V + 4 * 16384, L2_OST = L2_WS + NW * 64 * 4, L2_BYTES = L2_OST + NW * 4096;
template <bool MASK> __device__ __forceinline__ void attn_unit2(int q0, int NT, const bf16* Qh, int qp, const bf16* __restrict__ Kh, int kp, const bf16* __restrict__ Vh, int vp, bf16* Oh, int op, char* shm) {
    const int tid = threadIdx.x, lane = tid & 63, r32 = lane & 31, hi = lane >> 5; const int wid = __builtin_amdgcn_readfirstlane(tid >> 6);
    const bf16* Qw = Qh + (long)(q0 + wid * QBLK) * qp;
    const unsigned lds0 = (unsigned)(uintptr_t)shm;
    float* wsf = (float*)(shm + L2_WS) + wid * 64;
    const bf16* ksrc = Kh + (long)lane * kp + wid * 8;
    const bf16* vsrc = Vh + (long)(16 * (wid & 3) + (lane >> 2)) * vp + (wid >> 2) * 32 + (lane & 3) * 8;
    const unsigned kdst = lds0 + L2_K + wid * 1024, vdst = lds0 + L2_V + wid * 1024;
#define DMA_K(t, slot) glds16(ksrc + (long)(t) * KVBLK * kp, (unsigned)__builtin_amdgcn_readfirstlane(kdst + (slot)))
#define DMA_V(t, vslot) do { glds16(vsrc + (long)(t) * KVBLK * vp, (unsigned)__builtin_amdgcn_readfirstlane(vdst + (vslot))); \
                            glds16(vsrc + (long)(t) * KVBLK * vp + 64, (unsigned)__builtin_amdgcn_readfirstlane(vdst + (vslot) + 8192)); } while (0)
    const int vb0 = (int)(lds0 + L2_V) + ((lane >> 4) & 1) * 32 + (lane & 3) * 8 + (4 * hi + ((lane & 15) >> 2)) * 64;
    const char* Kbase = shm + L2_K; bf16x8 kf[8];
    const lds_cptr shm3 = (lds_cptr)shm; const lds_cptr kp0 = shm3 + L2_K + hi * 1024 + r32 * 16; const lds_cptr vp0 = shm3 + L2_V + ((lane >> 4) & 1) * 32 + (lane & 3) * 8 + (4 * hi + ((lane & 15) >> 2)) * 64;
    DMA_K(0, 0); DMA_V(0, 0); DMA_K(1, SLOTB);
    bf16x8 qr[4];
#pragma unroll
    for (int d0 = 0; d0 < 4; ++d0) qr[d0] = *reinterpret_cast<const bf16x8*>(&Qw[(long)r32 * qp + d0 * 16 + hi * 8]);
    float l_reg = 0.f; f32x16 o[4]; o[0] = f32x16{}; o[1] = f32x16{}; o[2] = f32x16{}; o[3] = f32x16{};
    const f32x16 zero16 = f32x16{};
#define CMASK(P0, P1, t) do { if (MASK) { int jb_ = (t) - (NT - 4); if (jb_ >= 0) cmask(P0, P1, jb_, wid); } } while (0)
    f32x16 pA0, pA1, pB0, pB1;
    int sl_prev = 0, sl_cur = 0, sl_next = SLOTB;
    int vs_rd = 0, vs_wr = 3 * 16384;
#define ROT() do { sl_prev = sl_cur; sl_cur = sl_next; sl_next = (sl_next == (NSLOT - 1) * SLOTB) ? 0 : sl_next + SLOTB; vs_rd = (vs_rd + 16384) & 65535; vs_wr = (vs_wr + 16384) & 65535; } while (0)
    DMA_K(2, 2 * SLOTB); DMA_V(1, 16384);
    WAIT_BAR(6);
    qkt(pA0, pA1, Kbase, qr, zero16, r32, hi); CMASK(pA0, pA1, 0);
    _Pragma("unroll") for (int r = 0; r < 16; ++r) { pA0[r] = __builtin_amdgcn_exp2f(pA0[r]); pA1[r] = __builtin_amdgcn_exp2f(pA1[r]); }
    WAIT_BAR(2);
    DMA_K(3, 0); DMA_V(2, 2 * 16384);
    sl_prev = sl_cur; sl_cur = sl_next; sl_next = 2 * SLOTB;
    kload8(kf, kp0 + sl_cur);
    WAIT_BAR(5);
    s16x4 f0lo, f0hi, f1lo, f1hi, f2lo, f2hi, f3lo, f3hi; u32x4 pw0, pw1, pw2, pw3;
#define PKW(P, B) cvtpk_s(P[B], P[B + 1])
#define PAF(k) __builtin_bit_cast(bf16x8, pw##k)
#define PIN(x) asm volatile("" : "+v"(x))
#define EX(v) __builtin_amdgcn_exp2f(v)
#define VOFF(id) ((((id) >> 2) * 4096) + (((id) & 3) * 1024))
#define VRD2(F, id) do { F##lo = vtr(vp_ + VOFF(id)); F##hi = vtr(vp_ + VOFF(id) + 512); } while (0)
#define VFR2(F) (bf16x8){F##lo[0], F##lo[1], F##lo[2], F##lo[3], F##hi[0], F##hi[1], F##hi[2], F##hi[3]}
#define GAPA(MF, A0, A1, A2, A3, W0, W1, PW) do { MF; sacc += A0; sacc += A1; sacc += A2; sacc += A3; PIN(sacc); W0; W1; PIN(PW); SBAR(); } while (0)
#define GAPB(MF, RD, X, B) do { MF; RD; X[B] = EX(X[B]); X[B + 1] = EX(X[B + 1]); PIN(X); SBAR(); } while (0)
#define KRD(G, j) do { if (G) { kload2(kf, kp0 + sl_next, j); SBAR(); } } while (0)
#define MF32(a, b, c) __builtin_amdgcn_mfma_f32_32x32x16_bf16(a, b, c, 0, 0, 0)
#define STEP(C0, C1, P0, P1, t, GK, GV, GL) do { SBAR(); __builtin_amdgcn_s_setprio(ATTN_PRIO_A); \
    const lds_cptr vp_ = vp0 + vs_rd; \
    float sacc = (P0[0] + P0[1]); \
    GAPA(C0 = MF32(kf[0], qr[0], zero16), P0[2], P0[3], P0[4], P0[5],     pw0[0] = PKW(P0, 0), pw0[1] = PKW(P0, 2), pw0); \
    GAPA(C1 = MF32(kf[1], qr[0], zero16), P0[6], P0[7], P0[8], P0[9],     pw0[2] = PKW(P0, 4), pw0[3] = PKW(P0, 6), pw0); \
    GAPA(C0 = MF32(kf[2], qr[1], C0),     P0[10], P0[11], P0[12], P0[13], pw1[0] = PKW(P0, 8), pw1[1] = PKW(P0, 10), pw1); \
    GAPA(C1 = MF32(kf[3], qr[1], C1),     P0[14], P0[15], P1[0], P1[1],   pw1[2] = PKW(P0, 12), pw1[3] = PKW(P0, 14), pw1); \
    VRD2(f0, 0); SBAR();  GAPA(C0 = MF32(kf[4], qr[2], C0), P1[2], P1[3], P1[4], P1[5],     pw2[0] = PKW(P1, 0), pw2[1] = PKW(P1, 2), pw2); \
    VRD2(f1, 4); SBAR();  GAPA(C1 = MF32(kf[5], qr[2], C1), P1[6], P1[7], P1[8], P1[9],     pw2[2] = PKW(P1, 4), pw2[3] = PKW(P1, 6), pw2); \
    VRD2(f2, 8); SBAR();  GAPA(C0 = MF32(kf[6], qr[3], C0), P1[10], P1[11], P1[12], P1[13], pw3[0] = PKW(P1, 8), pw3[1] = PKW(P1, 10), pw3); \
    VRD2(f3, 12); SBAR(); GAPA(C1 = MF32(kf[7], qr[3], C1), P1[14], P1[15], 0.f, 0.f,       pw3[2] = PKW(P1, 12), pw3[3] = PKW(P1, 14), pw3); \
    l_reg += sacc; __builtin_amdgcn_s_setprio(0); \
    if (GK) { DMA_K((t) + 3, sl_cur); } if (GV) { DMA_V((t) + 2, vs_wr); } \
    CMASK(C0, C1, t); \
    SBAR(); __builtin_amdgcn_s_setprio(ATTN_PRIO_B); \
    GAPB(o[0] = MF32(PAF(0), VFR2(f0), o[0]), VRD2(f0, 1),  C0, 0); \
    GAPB(o[1] = MF32(PAF(0), VFR2(f1), o[1]), VRD2(f1, 5),  C0, 2); \
    GAPB(o[2] = MF32(PAF(0), VFR2(f2), o[2]), VRD2(f2, 9),  C0, 4); \
    GAPB(o[3] = MF32(PAF(0), VFR2(f3), o[3]), VRD2(f3, 13), C0, 6); \
    KRD(GL, 0); GAPB(o[0] = MF32(PAF(1), VFR2(f0), o[0]), VRD2(f0, 2),  C0, 8); \
    GAPB(o[1] = MF32(PAF(1), VFR2(f1), o[1]), VRD2(f1, 6),  C0, 10); \
    KRD(GL, 1); GAPB(o[2] = MF32(PAF(1), VFR2(f2), o[2]), VRD2(f2, 10), C0, 12); \
    GAPB(o[3] = MF32(PAF(1), VFR2(f3), o[3]), VRD2(f3, 14), C0, 14); \
    KRD(GL, 2); GAPB(o[0] = MF32(PAF(2), VFR2(f0), o[0]), VRD2(f0, 3),  C1, 0); \
    GAPB(o[1] = MF32(PAF(2), VFR2(f1), o[1]), VRD2(f1, 7),  C1, 2); \
    KRD(GL, 3); GAPB(o[2] = MF32(PAF(2), VFR2(f2), o[2]), VRD2(f2, 11), C1, 4); \
    GAPB(o[3] = MF32(PAF(2), VFR2(f3), o[3]), VRD2(f3, 15), C1, 6); \
    GAPB(o[0] = MF32(PAF(3), VFR2(f0), o[0]), (void)0, C1, 8); \
    GAPB(o[1] = MF32(PAF(3), VFR2(f1), o[1]), (void)0, C1, 10); \
    GAPB(o[2] = MF32(PAF(3), VFR2(f2), o[2]), (void)0, C1, 12); \
    GAPB(o[3] = MF32(PAF(3), VFR2(f3), o[3]), (void)0, C1, 14); __builtin_amdgcn_s_setprio(0); \
    } while (0)
    int t = 1;
#undef CMASK
#define CMASK(P0, P1, t) do {} while (0)
    for (; t + 5 < NT; t += 2) {
        STEP(pB0, pB1, pA0, pA1, t, true, true, true);     WAIT_BAR(5); ROT();
        STEP(pA0, pA1, pB0, pB1, t + 1, true, true, true); WAIT_BAR(5); ROT();
    }
#undef CMASK
#define CMASK(P0, P1, t) do { if (MASK) { int jb_ = (t) - (NT - 4); if (jb_ >= 0) cmask(P0, P1, jb_, wid); } } while (0)
#define ENDW(tt) do { if ((tt) + 3 < NT) { WAIT_BAR(5); } else if ((tt) + 2 < NT) { WAIT_BAR(4); } else { WAIT_BAR(0); } } while (0)
    for (; t + 1 < NT; t += 2) {
        STEP(pB0, pB1, pA0, pA1, t, (t + 3 < NT), (t + 2 < NT), (t + 1 < NT));       ENDW(t);     ROT();
        STEP(pA0, pA1, pB0, pB1, t + 1, (t + 4 < NT), (t + 3 < NT), (t + 2 < NT));   ENDW(t + 1); ROT();
    }
    STEP(pB0, pB1, pA0, pA1, NT - 1, false, false, false);
    { float sacc = pB0[0] + pB0[1]; _Pragma("unroll") for (int r = 2; r < 16; ++r) sacc += pB0[r]; _Pragma("unroll") for (int r = 0; r < 16; ++r) sacc += pB1[r]; l_reg += sacc;
      pw0 = (u32x4){PKW(pB0, 0), PKW(pB0, 2), PKW(pB0, 4), PKW(pB0, 6)}; pw1 = (u32x4){PKW(pB0, 8), PKW(pB0, 10), PKW(pB0, 12), PKW(pB0, 14)}; pw2 = (u32x4){PKW(pB1, 0), PKW(pB1, 2), PKW(pB1, 4), PKW(pB1, 6)}; pw3 = (u32x4){PKW(pB1, 8), PKW(pB1, 10), PKW(pB1, 12), PKW(pB1, 14)};
      SBAR();
      const lds_cptr vp_ = vp0 + ((vs_rd + 16384) & 65535);
#pragma unroll
      for (int db = 0; db < 4; ++db) { VRD2(f0, db * 4 + 0); VRD2(f1, db * 4 + 1); VRD2(f2, db * 4 + 2); VRD2(f3, db * 4 + 3);
          o[db] = MF32(PAF(0), VFR2(f0), o[db]); o[db] = MF32(PAF(1), VFR2(f1), o[db]); o[db] = MF32(PAF(2), VFR2(f2), o[db]); o[db] = MF32(PAF(3), VFR2(f3), o[db]); } }
#undef PKW
#undef PAF
#undef PIN
#undef EX
#undef VOFF
#undef VRD2
#undef VFR2
#undef GAPA
#undef GAPB
#undef KRD
#undef MF32
#undef STEP
#undef ENDW
    { auto rr = __builtin_amdgcn_permlane32_swap(__float_as_uint(l_reg), __float_as_uint(l_reg), false, false); l_reg = __uint_as_float(rr[0]) + __uint_as_float(rr[1]); }
    if (hi == 0) wsf[32 + r32] = l_reg; asm volatile("s_waitcnt lgkmcnt(0)" ::: "memory");
    float rli[16];
#pragma unroll
    for (int r = 0; r < 16; ++r) rli[r] = __builtin_amdgcn_rcpf(wsf[32 + crow(r, hi)]);
    bf16* Ow = Oh + (long)(q0 + wid * QBLK) * op;
    { bf16* stg = (bf16*)(shm + L2_OST) + wid * 2048;
#pragma unroll
      for (int dh = 0; dh < 2; ++dh) {
#pragma unroll
        for (int r = 0; r < 16; ++r) { const int orow = crow(r, hi);
#pragma unroll
          for (int d0 = 0; d0 < 2; ++d0) stg[orow * 64 + d0 * 32 + r32] = __float2bfloat16(o[dh * 2 + d0][r] * rli[r]); }
        asm volatile("s_waitcnt lgkmcnt(0)" ::: "memory");
#pragma unroll
        for (int i = 0; i < 4; ++i) { const int row = i * 8 + (lane >> 3), ch = lane & 7; const u32x4 v = *(const u32x4*)(stg + row * 64 + ch * 8); *(u32x4*)(Ow + (long)row * op + dh * 64 + ch * 8) = v; }
        asm volatile("s_waitcnt lgkmcnt(0)" ::: "memory"); } }
    asm volatile("s_waitcnt lgkmcnt(0)\n\ts_barrier" ::: "memory");
#undef DMA_K
#undef DMA_V
#undef CMASK
#undef ROT
}
#undef SBAR
#undef WAIT_BAR
}

#define XB_TMO      128
#define XB_XCNT(j)  (256  + 64 * (j))
#define XB_XSUB(j)  (1280 + 64 * (j))
#define XB_XGEN(j)  (2304 + 64 * (j))
#define XB_TOP      3328
#define XB_TOPGEN   3392
#define XCD_BAR_WORDS 3456
#define XB_SPIN_CAP (1u << 22)
__device__ __forceinline__ unsigned xb_ld(unsigned* p)              { return __hip_atomic_load(p, __ATOMIC_RELAXED, __HIP_MEMORY_SCOPE_AGENT); }
__device__ __forceinline__ unsigned xb_add(unsigned* p, unsigned v) { return __hip_atomic_fetch_add(p, v, __ATOMIC_RELAXED, __HIP_MEMORY_SCOPE_AGENT); }
__device__ __forceinline__ unsigned xb_xcc_id() { return (unsigned)__builtin_amdgcn_s_getreg((3 << 11) | 20) & 0xFu; }
#define XB_SPIN(cond, bar) do { unsigned _sp = 0; while (cond) { __builtin_amdgcn_s_sleep(1); \
    if ((++_sp & 255u) == 0u) { if (xb_ld(&(bar)[XB_TMO])) break; if (_sp > XB_SPIN_CAP) { atomicAdd(&(bar)[XB_TMO], 1u); break; } } } } while (0)
struct XcdBarrier { unsigned* bar; unsigned x; volatile LAS unsigned* st; };
__device__ __forceinline__ XcdBarrier xcd_barrier_post(unsigned* bar, volatile LAS unsigned* st) {
    XcdBarrier b; b.bar = bar; b.x = xb_xcc_id(); b.st = st;
    if (threadIdx.x == 0) (void)xb_add(&bar[XB_XCNT(b.x)], 1u);
    return b;
}
__device__ __forceinline__ void xcd_barrier_complete(unsigned* bar, unsigned x, unsigned& nloc, unsigned& nx) {
    const unsigned G = gridDim.x * gridDim.y * gridDim.z;
    unsigned sum, cnt, mine, sp = 0u;
    for (;;) {
        sum = 0u; cnt = 0u; mine = 0u;
#pragma unroll
        for (unsigned j = 0; j < 16; ++j) { const unsigned c = xb_ld(&bar[XB_XCNT(j)]); sum += c; cnt += (c > 0u) ? 1u : 0u; mine = (j == x) ? c : mine; }
        if (sum == G) break;
        __builtin_amdgcn_s_sleep(1);
        if ((++sp & 255u) == 0u) { if (xb_ld(&bar[XB_TMO])) break; if (sp > XB_SPIN_CAP) { atomicAdd(&bar[XB_TMO], 1u); break; } }
    }
    nloc = mine > 0u ? mine : 1u; nx = cnt > 0u ? cnt : 1u;
}
__device__ __forceinline__ void xcd_barrier(const XcdBarrier& b) {
    asm volatile("s_waitcnt vmcnt(0)" ::: "memory");
    __syncthreads();
    if (threadIdx.x == 0) {
        unsigned* bar = b.bar;
        __builtin_amdgcn_s_waitcnt(0);
        unsigned nloc = b.st[0], nx = b.st[1];
        if (nloc == 0u) { xcd_barrier_complete(bar, b.x, nloc, nx); b.st[0] = nloc; b.st[1] = nx; }
        const unsigned old = xb_add(&bar[XB_XSUB(b.x)], 1u);
        const unsigned gen = old / nloc;
        if (old + 1u == (gen + 1u) * nloc) {
            __builtin_amdgcn_fence(__ATOMIC_RELEASE, "agent");
            asm volatile("s_waitcnt vmcnt(0)" ::: "memory");
            const unsigned og = xb_add(&bar[XB_TOP], 1u);
            const unsigned tg = og / nx;
            if (og + 1u == (tg + 1u) * nx) xb_add(&bar[XB_TOPGEN], 1u);
            else XB_SPIN(xb_ld(&bar[XB_TOPGEN]) == tg, bar);
            __builtin_amdgcn_fence(__ATOMIC_ACQUIRE, "agent");
            xb_add(&bar[XB_XGEN(b.x)], 1u);
            asm volatile("s_waitcnt vmcnt(0)" ::: "memory");
        } else {
            XB_SPIN(xb_ld(&bar[XB_XGEN(b.x)]) == gen, bar);
            __builtin_amdgcn_fence(__ATOMIC_ACQUIRE, "agent");
            asm volatile("s_waitcnt vmcnt(0)" ::: "memory");
        }
    }
    __syncthreads();
}

constexpr int RING_BYTES = 131072;
constexpr int MISC_OFF = RING_BYTES;
constexpr int LDS_BYTES = 147456;
constexpr int NWAVES = 8;

struct Args {
    const float* in[29]; float* out; unsigned char* ws; int ph_lo, ph_hi;
};
enum { I_X = 0, I_MEM, I_NORM1, I_WIN, I_BGATE, I_QN, I_KN, I_LQ1, I_LK1, I_LQ2, I_LK2, I_SUBLN, I_WPOOL, I_PSCALE, I_MEMNORM, I_WMKV, I_MQN, I_MKN, I_WBRD, I_WBRP, I_WBRM, I_WOUT, I_NORM2,
       I_WROUTER, I_BROUTER, I_WGU, I_BGU, I_WD, I_BD };

__device__ __forceinline__ unsigned f2bf(float f) { unsigned u = __builtin_bit_cast(unsigned, f); return (u + 0x7fffu + ((u >> 16) & 1u)) >> 16; }
__device__ __forceinline__ unsigned pk2(float lo, float hi) { return f2bf(lo) | (f2bf(hi) << 16); }
__device__ __forceinline__ void p0_transpose_item(const float* W, int K, int N, bf16_t* WT, LAS float* scr, int item, int lane, int ldo = 0, float qs = 0.f) {
    if (ldo == 0) ldo = K;
    const int nblk = N / 64, kb = item / nblk, nb = item % nblk, k0 = 64 * kb, n0 = 64 * nb;
    const int kr = lane >> 3, n4 = (lane & 7) * 4;
    f32x4 v[16];
#pragma unroll
    for (int i = 0; i < 16; ++i) v[i] = *(const f32x4*)(W + (size_t)(k0 + 8 * (i & 7) + kr) * N + n0 + 32 * (i >> 3) + n4);
#pragma unroll
    for (int h = 0; h < 2; ++h) {
#pragma unroll
        for (int i = 0; i < 8; ++i)
#pragma unroll
            for (int j = 0; j < 4; ++j) scr[(n4 + j) * 68 + 8 * i + kr] = v[h * 8 + i][j];
        LDS_WAIT(); asm volatile("" ::: "memory");
        const int c = lane & 7;
#pragma unroll
        for (int jj = 0; jj < 4; ++jj) { const int nrow = 8 * jj + (lane >> 3); const LAS f32x4* sp = (const LAS f32x4*)(scr + nrow * 68 + 8 * c);
            f32x4 a = sp[0], b = sp[1];
            if (qs != 0.f) { for (int q = 0; q < 4; ++q) { a[q] = fminf(fmaxf(rintf(a[q] * qs), -127.f), 127.f); b[q] = fminf(fmaxf(rintf(b[q] * qs), -127.f), 127.f); } }
            u32x4 o; o.x = pk2(a[0], a[1]); o.y = pk2(a[2], a[3]); o.z = pk2(b[0], b[1]); o.w = pk2(b[2], b[3]);
            *(u32x4*)(WT + (size_t)(n0 + 32 * h + nrow) * ldo + k0 + 8 * c) = o; }
        LDS_WAIT(); asm volatile("" ::: "memory");
    }
}
__device__ __forceinline__ void p0_transpose_item_f8(const float* W, int K, int N, unsigned char* WT, LAS float* scr, int item, int lane) {
    const int nblk = N / 64, kb = item / nblk, nb = item % nblk, k0 = 64 * kb, n0 = 64 * nb;
    const int kr = lane >> 3, n4 = (lane & 7) * 4;
    f32x4 v[16];
#pragma unroll
    for (int i = 0; i < 16; ++i) v[i] = *(const f32x4*)(W + (size_t)(k0 + 8 * (i & 7) + kr) * N + n0 + 32 * (i >> 3) + n4);
#pragma unroll
    for (int h = 0; h < 2; ++h) {
#pragma unroll
        for (int i = 0; i < 8; ++i)
#pragma unroll
            for (int j = 0; j < 4; ++j) scr[(n4 + j) * 68 + 8 * i + kr] = v[h * 8 + i][j];
        LDS_WAIT(); asm volatile("" ::: "memory");
        const int c = lane & 7;
#pragma unroll
        for (int jj = 0; jj < 4; ++jj) { const int nrow = 8 * jj + (lane >> 3); const LAS f32x4* sp = (const LAS f32x4*)(scr + nrow * 68 + 8 * c);
            const f32x4 a = sp[0] * W8_SCALE, b = sp[1] * W8_SCALE;
            u32x2 o; o.x = pk4_fp8(a[0], a[1], a[2], a[3]); o.y = pk4_fp8(b[0], b[1], b[2], b[3]);
            *(u32x2*)(WT + (size_t)(n0 + 32 * h + nrow) * K + k0 + 8 * c) = o; }
        LDS_WAIT(); asm volatile("" ::: "memory");
    }
}
__device__ __forceinline__ void p0_transpose_item_i8(const float* W, int K, int N, unsigned char* WT, LAS float* scr, int item, int lane, float qs) {
    const int nblk = N / 64, kb = item / nblk, nb = item % nblk, k0 = 64 * kb, n0 = 64 * nb;
    const int kr = lane >> 3, n4 = (lane & 7) * 4;
    f32x4 v[16];
#pragma unroll
    for (int i = 0; i < 16; ++i) v[i] = *(const f32x4*)(W + (size_t)(k0 + 8 * (i & 7) + kr) * N + n0 + 32 * (i >> 3) + n4);
#pragma unroll
    for (int h = 0; h < 2; ++h) {
#pragma unroll
        for (int i = 0; i < 8; ++i)
#pragma unroll
            for (int j = 0; j < 4; ++j) scr[(n4 + j) * 68 + 8 * i + kr] = v[h * 8 + i][j];
        LDS_WAIT(); asm volatile("" ::: "memory");
        const int c = lane & 7;
#pragma unroll
        for (int jj = 0; jj < 4; ++jj) { const int nrow = 8 * jj + (lane >> 3); const LAS f32x4* sp = (const LAS f32x4*)(scr + nrow * 68 + 8 * c);
            const f32x4 a = sp[0] * qs, b = sp[1] * qs;
            u32x2 o; o.x = pk4_i8(a[0], a[1], a[2], a[3]); o.y = pk4_i8(b[0], b[1], b[2], b[3]);
            *(u32x2*)(WT + (size_t)(n0 + 32 * h + nrow) * K + k0 + 8 * c) = o; }
        LDS_WAIT(); asm volatile("" ::: "memory");
    }
}
__device__ __forceinline__ void rms_row_to_q(const float* xrow, const float* gain, unsigned char* orow, float* rs, int lane) {
    const f32x4* xr = (const f32x4*)xrow + lane; const f32x4* gr = (const f32x4*)gain + lane;
    f32x4 v[4]; float s = 0.f;
#pragma unroll
    for (int j = 0; j < 4; ++j) { v[j] = xr[64 * j]; s += (v[j].x * v[j].x + v[j].y * v[j].y) + (v[j].z * v[j].z + v[j].w * v[j].w); }
    const float rstd = 1.f / sqrtf(wave_sum(s) * (1.f / 1024.f) + RMS_EPS);
    float am = 0.f;
#pragma unroll
    for (int j = 0; j < 4; ++j) { const f32x4 g = gr[64 * j]; v[j] = v[j] * rstd * g; am = fmaxf(am, fmaxf(fmaxf(fabsf(v[j].x), fabsf(v[j].y)), fmaxf(fabsf(v[j].z), fabsf(v[j].w)))); }
#pragma unroll
    for (int o = 1; o < 64; o <<= 1) am = fmaxf(am, __shfl_xor(am, o));
    am = fmaxf(am, 1e-20f); const float qi = 127.0f / am;
    unsigned* o4 = (unsigned*)orow + lane;
#pragma unroll
    for (int j = 0; j < 4; ++j) o4[64 * j] = pk4_i8(v[j].x * qi, v[j].y * qi, v[j].z * qi, v[j].w * qi);
    if (lane == 0) rs[0] = am * (1.0f / 127.0f);
}
__device__ __forceinline__ void rms_row_to_bf16(const float* xrow, const float* gain, bf16_t* orow, int lane) {
    const f32x4* xr = (const f32x4*)xrow + lane; const f32x4* gr = (const f32x4*)gain + lane;
    f32x4 v[4]; float s = 0.f;
#pragma unroll
    for (int j = 0; j < 4; ++j) { v[j] = xr[64 * j]; s += (v[j].x * v[j].x + v[j].y * v[j].y) + (v[j].z * v[j].z + v[j].w * v[j].w); }
    const float rstd = 1.f / sqrtf(wave_sum(s) * (1.f / 1024.f) + RMS_EPS);
    u32x2* o8 = (u32x2*)orow + lane;
#pragma unroll
    for (int j = 0; j < 4; ++j) { const f32x4 g = gr[64 * j]; u32x2 w; w.x = pk2(v[j].x * rstd * g.x, v[j].y * rstd * g.y); w.y = pk2(v[j].z * rstd * g.z, v[j].w * rstd * g.w); o8[64 * j] = w; }
}

__device__ __forceinline__ void cvt_item64_f8(const float* W, int K, int N, unsigned char* WT, int item, int lane) {
    const int nblk = N / 64, kb = item / nblk, nb = item % nblk, k0 = 64 * kb, n0 = 64 * nb;
    const char* base = (const char*)(W + (size_t)k0 * N + n0);
    unsigned off = (unsigned)lane * 4u; const unsigned rstep = (unsigned)N * 4u;
    float v[64];
#pragma unroll
    for (int j = 0; j < 64; ++j) { v[j] = __builtin_nontemporal_load((const float*)(base + off)); off += rstep; }
    unsigned char* dst = WT + (size_t)(n0 + lane) * K + k0;
#pragma unroll
    for (int c = 0; c < 4; ++c) { u32x4 o;
#pragma unroll
        for (int q = 0; q < 4; ++q) { int r = __builtin_amdgcn_cvt_pk_fp8_f32(v[16 * c + 4 * q] * W8_SCALE, v[16 * c + 4 * q + 1] * W8_SCALE, 0, false);
            r = __builtin_amdgcn_cvt_pk_fp8_f32(v[16 * c + 4 * q + 2] * W8_SCALE, v[16 * c + 4 * q + 3] * W8_SCALE, r, true); o[q] = (unsigned)r; }
        *(u32x4*)(dst + 16 * c) = o; }
}
struct CvtJob {
    const float* wgu; const float* wd; unsigned char* wgu_t; unsigned char* wd_t; int ngw, gw, lane;
    __device__ __forceinline__ void item(int j) const {
        const int it = gw + j * ngw; if (it >= 24576) return;
        const bool gu = it < 16384; const int r = gu ? it : it - 16384, e = gu ? (r >> 9) : (r >> 8), idx = gu ? (r & 511) : (r & 255), N = gu ? 2048 : 1024;
        const float* W = gu ? wgu + (size_t)e * 1024 * 2048 : wd + (size_t)e * 1024 * 1024; unsigned char* WT = gu ? wgu_t + (size_t)e * 2048 * 1024 : wd_t + (size_t)e * 1024 * 1024;
        cvt_item64_f8(W, 1024, N, WT, idx, lane);
    }
    __device__ __forceinline__ void item3(int j) const {
        const char* base[3]; unsigned char* dst[3]; unsigned rstep[3]; bool ok[3]; float v[3][64];
#pragma unroll
        for (int b = 0; b < 3; ++b) { const int it0 = gw + (j + b) * ngw; ok[b] = it0 < 24576; const int it = ok[b] ? it0 : gw;
            const bool gu = it < 16384; const int r = gu ? it : it - 16384, e = gu ? (r >> 9) : (r >> 8), idx = gu ? (r & 511) : (r & 255), N = gu ? 2048 : 1024;
            const float* W = gu ? wgu + (size_t)e * 1024 * 2048 : wd + (size_t)e * 1024 * 1024; unsigned char* WT = gu ? wgu_t + (size_t)e * 2048 * 1024 : wd_t + (size_t)e * 1024 * 1024;
            const int nblk = N / 64, kb = idx / nblk, nb = idx % nblk, k0 = 64 * kb, n0 = 64 * nb;
            base[b] = (const char*)(W + (size_t)k0 * N + n0); dst[b] = WT + (size_t)(n0 + lane) * 1024 + k0; rstep[b] = (unsigned)N * 4u; }
#pragma unroll
        for (int b = 0; b < 3; ++b) { unsigned off = (unsigned)lane * 4u;
#pragma unroll
            for (int q = 0; q < 64; ++q) { v[b][q] = __builtin_nontemporal_load((const float*)(base[b] + off)); off += rstep[b]; } }
#pragma unroll
        for (int b = 0; b < 3; ++b) if (ok[b]) {
#pragma unroll
            for (int c = 0; c < 4; ++c) { u32x4 o;
#pragma unroll
                for (int q = 0; q < 4; ++q) { int r = __builtin_amdgcn_cvt_pk_fp8_f32(v[b][16 * c + 4 * q] * W8_SCALE, v[b][16 * c + 4 * q + 1] * W8_SCALE, 0, false);
                    r = __builtin_amdgcn_cvt_pk_fp8_f32(v[b][16 * c + 4 * q + 2] * W8_SCALE, v[b][16 * c + 4 * q + 3] * W8_SCALE, r, true); o[q] = (unsigned)r; }
                *(u32x4*)(dst[b] + 16 * c) = o; } }
    }
};
struct PostCvt { CvtJob J; int jbase, jend; __device__ __forceinline__ void operator()(int ui) const { const int j = jbase + ui; if (j < jend) J.item(j); } };
struct Args;
typedef __attribute__((address_space(4))) const Args* kargs_t;
__device__ __forceinline__ kargs_t kargs() { kargs_t p = (kargs_t)__builtin_amdgcn_kernarg_segment_ptr(); asm volatile("" : "+s"(p)); return p; }
__global__ void __launch_bounds__(NWAVES * 64, 2) fwd_kernel(Args args) {
    extern __shared__ __attribute__((aligned(16))) unsigned char lds_raw[];
    cg::grid_group grid = cg::this_grid();
    LAS unsigned char* lds = (LAS unsigned char*)lds_raw;
    const int tid = threadIdx.x, lane = tid & 63, wave = __builtin_amdgcn_readfirstlane(tid >> 6);
    const int G = gridDim.x, bx = blockIdx.x; const int vcu = (G % 8 == 0) ? (bx % 8) * (G / 8) + bx / 8 : bx;
    const int gw = vcu * NWAVES + wave, NGW = G * NWAVES;
    const int lo = args.ph_lo, hi = args.ph_hi;
    if (tid < 64) ((LAS unsigned*)(lds + MISC_OFF + 1024))[tid] = 0u;
    __syncthreads();
    const XcdBarrier xbar = xcd_barrier_post((unsigned*)(args.ws + WS_CTL) + CW_BAR, (volatile LAS unsigned*)(lds + MISC_OFF + 1024));
#ifndef PHMASK
#define PHMASK 0x3ff
#endif
#define IN(k) (((PHMASK >> (k)) & 1) && lo <= (k) && (k) < hi)
#define GSYNC() do { asm volatile("s_waitcnt vmcnt(0) lgkmcnt(0)" ::: "memory"); __syncthreads(); grid.sync(); asm volatile("s_waitcnt vmcnt(0)" ::: "memory"); __syncthreads(); } while (0)
#define SEAM(k) do { if (lo <= (k) && (k) + 1 < hi) { xcd_barrier(xbar); } } while (0)
#define WSP(TY, off) ((TY*)(ka->ws + (off)))
#define WIN_T WSP(bf16_t, WS_WIN_T)
#define WBRD_T WSP(bf16_t, WS_WBRD_T)
#define WBRP_T WSP(bf16_t, WS_WBRP_T)
#define WBRM_T WSP(bf16_t, WS_WBRM_T)
#define WOUT_T WSP(bf16_t, WS_WOUT_T)
#define WMKV_T WSP(bf16_t, WS_WMKV_T)
#define WGU_T WSP(bf16_t, WS_WGU_T)
#define WD_T WSP(bf16_t, WS_WD_T)
#define XN WSP(bf16_t, WS_XN)
#define Qb WSP(bf16_t, WS_Q)
#define Kb WSP(bf16_t, WS_K)
#define Vb WSP(bf16_t, WS_V)
#define Ub WSP(bf16_t, WS_U)
#define MQb WSP(bf16_t, WS_MQ)
#define OC WSP(bf16_t, WS_OC)
#define GATES WSP(bf16_t, WS_GATES)
#define YCAT WSP(bf16_t, WS_YCAT)
#define MERGF WSP(float, WS_MERGF)
#define MERGB WSP(bf16_t, WS_MERGB)
#define XG WSP(bf16_t, WS_XG)
#define ACT WSP(bf16_t, WS_A)
#define Y4 WSP(bf16_t, WS_B)
#define MEMN WSP(bf16_t, WS_MEMN)
#define MKV WSP(bf16_t, WS_MKV)
#define ROPE WSP(f32x2, WS_ROPE)
#define WR2 WSP(float, WS_WR2)
#define ROUTEW WSP(float, WS_ROUTEW)
#define LAMP WSP(float, WS_LAM)
#define LIST WSP(u32x2, WS_LIST)
#define CNT WSP(unsigned, WS_CTL)
#define OUT (ka->out)
#define KA const kargs_t ka = kargs()

    if (lo > 1000) GSYNC();
    if (IN(0)) for (int rep_ = 0; rep_ < 1 + ((REPEAT_MASK >> 0) & 1); ++rep_) { KA; if (rep_) __syncthreads();
        LAS float* scr = (LAS float*)(lds + wave * 16384);
        constexpr int I0 = 16 * 80, I1 = 8 * 16, I2 = 4 * 16, I3 = 4 * 16, I4 = 16 * 16, I5 = 16 * 8, I6 = 0, I7 = 0;
        constexpr int NITEMS = I0 + I1 + I2 + I3 + I4 + I5 + I6 + I7;
        for (int it = gw; it < NITEMS; it += NGW) {
            int r = it;
            if (r < I0) { p0_transpose_item_i8(ka->in[I_WIN], 1024, 5120, (unsigned char*)WIN_T, scr, r, lane, WQ_IN); continue; } r -= I0;
            if (r < I1) { p0_transpose_item(ka->in[I_WBRD], 512, 1024, WBRD_T, scr, r, lane, 1024); continue; } r -= I1;
            if (r < I2) { p0_transpose_item(ka->in[I_WBRP], 256, 1024, WBRD_T + 512, scr, r, lane, 1024); continue; } r -= I2;
            if (r < I3) { p0_transpose_item(ka->in[I_WBRM], 256, 1024, WBRD_T + 768, scr, r, lane, 1024); continue; } r -= I3;
            if (r < I4) { p0_transpose_item(ka->in[I_WOUT], 1024, 1024, WOUT_T, scr, r, lane); continue; } r -= I4;
            p0_transpose_item(ka->in[I_WMKV], 1024, 512, WMKV_T, scr, r, lane);
        }
        for (int m = gw; m < T; m += NGW) rms_row_to_q(ka->in[I_X] + (size_t)m * 1024, ka->in[I_NORM1], (unsigned char*)XN + (size_t)m * 1024, WSP(float, WS_MERGF) + m, lane);
        for (int m = gw; m < BATCH * MEMLEN; m += NGW) rms_row_to_bf16(ka->in[I_MEM] + (size_t)m * 1024, ka->in[I_MEMNORM], MEMN + (size_t)m * 1024, lane);
        for (int i = bx * 512 + tid; i < SEQ * 32; i += G * 512) { const int pos = i >> 5, j = i & 31;
            const float inv = 1.0f / powf(10000.0f, (float)(2 * j) / 64.0f); const float ang = (float)pos * inv;
            const double a = (double)ang; const double k = rint(a * 0.15915494309189535); const float red = (float)(a - k * 6.283185307179586);
            ROPE[i] = (f32x2){cosf(red), sinf(red)}; }
        for (int i = bx * 512 + tid; i < 1024 * 32; i += G * 512) { const int ii = i & 3, e = (i >> 2) & 15, kq = (i >> 6) & 3, eb = (i >> 8) & 1, s = i >> 9; const int k = 16 * s + 4 * kq + ii;
            WR2[i] = ka->in[I_NORM2][k] * ka->in[I_WROUTER][k * 32 + eb * 16 + e]; }
        if (bx == 0 && wave == 0) { const float s1 = wave_sum(ka->in[I_LQ1][lane] * ka->in[I_LK1][lane]), s2 = wave_sum(ka->in[I_LQ2][lane] * ka->in[I_LK2][lane]);
            if (lane == 0) LAMP[0] = expf(s1) - expf(s2) + 0.2f; }
    }
    SEAM(0);
    if (IN(1)) for (int rep_ = 0; rep_ < 1 + ((REPEAT_MASK >> 1) & 1); ++rep_) { KA; if (rep_) __syncthreads();
#if defined(TAP) && TAP == 6
        { pg8::DenseProb P{XN, WIN_T, 1024, 1024, 1024}; pg8::StaticOrder S; S.init(T, INW, G, bx);
          pg8::EpiPlain E{WSP(bf16_t, WS_B), 5120};
          pg8::gemm_phase<pg8::EpiPlain, pg8::DenseProb, pg8::StaticOrder, true>(lds, P, S, E); }
#else
        const CvtJob J{ka->in[I_WGU], ka->in[I_WD], (unsigned char*)WGU_T, (unsigned char*)WD_T, NGW, gw, lane};
        const int kpre = (bx & 7) < 12 - 3 * CVT_NB2 ? (bx & 7) : 12 - 3 * CVT_NB2;
        for (int j = 0; j < kpre; ++j) J.item(3 * CVT_NB2 + j);
        { pg8::DenseProbI8 P{(const unsigned char*)XN, (const unsigned char*)WIN_T, 1024, 1024, 1024}; pg8::StaticOrder S0; S0.init(T, INW, G, bx); const pg8::TableOrder S = pg8::build_unit_table(S0, (LAS int*)(lds + MISC_OFF + 2048));
          pg8::EpiInProj E{Qb, Kb, Vb, Ub, MQb, GATES, ka->in[I_QN], ka->in[I_KN], ka->in[I_MQN], ka->in[I_BGATE], ROPE, WSP(float, WS_MERGF)};
          const PostCvt PU{J, 3 * CVT_NB2 + kpre, 12};
          pg8::gemm_phase<pg8::EpiInProj, pg8::DenseProbI8, pg8::TableOrder, ALIGN_EPI_SEL, PostCvt>(lds, P, S, E, PU); }
        for (int j = 3 * CVT_NB2 + kpre + 10; j < 12; ++j) J.item(j);
#endif
        for (int tile = bx; tile < 256; tile += G) {
            const int rt = tile >> 3, ct = tile & 7, r32 = lane & 31, hh = lane >> 5;
            const bf16_t* ap = MEMN + (size_t)(32 * rt + r32) * 1024 + 128 * wave + 8 * hh; const bf16_t* bp = WMKV_T + (size_t)(64 * ct + r32) * 1024 + 128 * wave + 8 * hh;
            bf16x8 af[8], b0[8], b1[8];
#pragma unroll
            for (int ks = 0; ks < 8; ++ks) { af[ks] = *(const bf16x8*)(ap + 16 * ks); b0[ks] = *(const bf16x8*)(bp + 16 * ks); b1[ks] = *(const bf16x8*)(bp + 32 * 1024 + 16 * ks); }
            f32x16 c0 = f32x16{}, c1 = f32x16{};
#pragma unroll
            for (int ks = 0; ks < 8; ++ks) { c0 = __builtin_amdgcn_mfma_f32_32x32x16_bf16(af[ks], b0[ks], c0, 0, 0, 0); c1 = __builtin_amdgcn_mfma_f32_32x32x16_bf16(af[ks], b1[ks], c1, 0, 0, 0); }
            LAS float* part = (LAS float*)lds;
            __syncthreads();
#pragma unroll
            for (int r = 0; r < 16; ++r) { const int row = (r & 3) + 8 * (r >> 2) + 4 * hh; part[(wave * 32 + row) * 64 + r32] = c0[r]; part[(wave * 32 + row) * 64 + 32 + r32] = c1[r]; }
            __syncthreads();
            const int row = tid >> 4, c4 = (tid & 15) * 4; f32x4 a = {0.f, 0.f, 0.f, 0.f};
#pragma unroll
            for (int w = 0; w < 8; ++w) a += *(const LAS f32x4*)(part + (w * 32 + row) * 64 + c4);
            if (ct < 4) {
                float ss = (a[0] * a[0] + a[1] * a[1]) + (a[2] * a[2] + a[3] * a[3]);
                ss += __shfl_xor(ss, 1); ss += __shfl_xor(ss, 2); ss += __shfl_xor(ss, 4); ss += __shfl_xor(ss, 8);
                const float rstd = 1.0f / sqrtf(ss * (1.0f / 64.0f) + RMS_EPS); const f32x4 g = *(const f32x4*)(ka->in[I_MKN] + c4); a = a * rstd * g; }
            u32x2 o; o.x = cvt_pk_bf16(a[0], a[1]); o.y = cvt_pk_bf16(a[2], a[3]);
            *(u32x2*)(MKV + (size_t)(32 * rt + row) * 512 + 64 * ct + c4) = o;
        }
        __syncthreads();
    }
    SEAM(1);
    if (IN(2)) for (int rep_ = 0; rep_ < 1 + ((REPEAT_MASK >> 2) & 1); ++rep_) { KA; if (rep_) __syncthreads();
        using abf = attn_body::bf16;
        {
            const int bh = vcu >> 4, b = bh >> 2, h = bh & 3, s = vcu & 15; const size_t rb = (size_t)b * SEQ;
            const float lam = LAMP[0];
            const CvtJob J2{ka->in[I_WGU], ka->in[I_WD], (unsigned char*)WGU_T, (unsigned char*)WD_T, NGW, gw, lane};
            for (int i2 = 0; i2 < 4 * (1 + ((REPEAT_MASK >> 10) & 1)); ++i2) { const int ii = i2 & 3, c = ii & 1; const int qb = (ii < 2) ? s : 31 - s;
                attn_body::attn_unit2<true>(qb * 256, 4 * qb + 4, (const abf*)Qb + rb * 512 + (c * 4 + h) * 64, 512, (const abf*)Kb + rb * 512 + (c * 4 + h) * 64, 512,
                                            (const abf*)Vb + rb * 512 + h * 128, 512, (abf*)OC + rb * 1024 + (c * 4 + h) * 128, 1024, (char*)lds_raw);
                if (c == 1) {
                    asm volatile("s_waitcnt vmcnt(0)" ::: "memory");
#pragma unroll
                    for (int ps = 0; ps < 2; ++ps) {
                    const int row = ps * 16 + (lane >> 2), dq = (lane & 3) * 32; const size_t t = rb + (size_t)qb * 256 + wave * 32 + row;
                    const bf16_t* p0 = OC + t * 1024 + h * 128 + dq; const bf16_t* p1 = p0 + 512;
                    u32x4 a[4], bb[4];
#pragma unroll
                    for (int j = 0; j < 4; ++j) { a[j] = *(const u32x4*)(p0 + 8 * j); bb[j] = *(const u32x4*)(p1 + 8 * j); }
                    float ss = 0.f; f32x4 y[4][2];
#pragma unroll
                    for (int j = 0; j < 4; ++j) {
                        y[j][0] = (f32x4){bf_lo(a[j].x) - lam * bf_lo(bb[j].x), bf_hi(a[j].x) - lam * bf_hi(bb[j].x), bf_lo(a[j].y) - lam * bf_lo(bb[j].y), bf_hi(a[j].y) - lam * bf_hi(bb[j].y)};
                        y[j][1] = (f32x4){bf_lo(a[j].z) - lam * bf_lo(bb[j].z), bf_hi(a[j].z) - lam * bf_hi(bb[j].z), bf_lo(a[j].w) - lam * bf_lo(bb[j].w), bf_hi(a[j].w) - lam * bf_hi(bb[j].w)};
#pragma unroll
                        for (int q = 0; q < 4; ++q) ss += y[j][0][q] * y[j][0][q] + y[j][1][q] * y[j][1][q]; }
                    ss += __shfl_xor(ss, 1); ss += __shfl_xor(ss, 2);
                    const float rstd = 0.8f / sqrtf(ss * (1.0f / 128.0f) + RMS_EPS);
                    const float* sg = ka->in[I_SUBLN] + dq; bf16_t* yo = YCAT + t * 1024 + h * 128 + dq;
#pragma unroll
                    for (int j = 0; j < 4; ++j) { const f32x4 s0 = *(const f32x4*)(sg + 8 * j), s1 = *(const f32x4*)(sg + 8 * j + 4); pg8::store8(yo + 8 * j, y[j][0] * rstd * s0, y[j][1] * rstd * s1); }
                    }
                }
                if (ii < CVT_NB2) J2.item3(3 * ii);
            }
        }
        {
            for (int i = 0; i < 2; ++i) { const int idx = vcu * 2 + i; if (idx >= 512) break; const int b = idx >> 7, h = (idx >> 5) & 3, qb = idx & 31;
                attn_body::attn_unit<8, false>(qb * 256, 4, (const abf*)MQb + (size_t)b * SEQ * 256 + h * 64, 256, (const abf*)MKV + (size_t)b * MEMLEN * 512 + h * 64, 512,
                                               (const abf*)MKV + (size_t)b * MEMLEN * 512 + 256 + h * 64, 512, (abf*)YCAT + (size_t)b * SEQ * 1024 + 768 + h * 64, 1024, (char*)lds_raw); }
        }
        {
            LAS bf16_t* ul = (LAS bf16_t*)lds;
            LAS bf16_t* pb = (LAS bf16_t*)(lds + 24576);
            const int col = tid & 255, half = tid >> 8, w = 2 << (col >> 6);
            const int mg = wave & 3, mdh = wave >> 2, r32 = lane & 31, hh = lane >> 5;
            bf16x8 bw[4];
#pragma unroll
            for (int sx = 0; sx < 4; ++sx) { const float* wp = ka->in[I_WPOOL] + (size_t)(mg * 64 + 16 * sx + 8 * hh) * 64 + mdh * 32 + r32;
                u32x4 pk; pk.x = pk2(wp[0], wp[64]); pk.y = pk2(wp[128], wp[192]); pk.z = pk2(wp[256], wp[320]); pk.w = pk2(wp[384], wp[448]); bw[sx] = __builtin_bit_cast(bf16x8, pk); }
            const int ocol = mg * 64 + mdh * 32 + r32; const float psc = ka->in[I_PSCALE][ocol];
            u32x4 pre[3];
#define POOL_LOAD(tl) do { const int t0_ = (tl) * 32, p0_ = t0_ & (SEQ - 1); _Pragma("unroll") for (int k_ = 0; k_ < 3; ++k_) { const int pc = tid + 512 * k_, r = pc >> 5, ch = pc & 31; \
                pre[k_] = (u32x4){0u, 0u, 0u, 0u}; if (pc < 47 * 32 && p0_ - 15 + r >= 0) pre[k_] = *(const u32x4*)(Ub + (size_t)(t0_ - 15 + r) * 256 + ch * 8); } } while (0)
            if (vcu < T / 32) POOL_LOAD(vcu);
            for (int tile = vcu; tile < T / 32; tile += G) {
                const int t0 = tile * 32, p0 = t0 & (SEQ - 1);
                __syncthreads();
#pragma unroll
                for (int k = 0; k < 3; ++k) { const int pc = tid + 512 * k, r = pc >> 5, ch = pc & 31; if (pc < 47 * 32) *(LAS u32x4*)(ul + r * 256 + ch * 8) = pre[k]; }
                if (tile + G < T / 32) POOL_LOAD(tile + G);
                __syncthreads();
                {
                    float sum = 0.f; const int rbase = 15 + 16 * half;
                    for (int i = 1; i < w; ++i) sum += __uint_as_float((unsigned)ul[(rbase - i) * 256 + col] << 16);
#pragma unroll
                    for (int tk = 0; tk < 16; ++tk) { const float ucur = __uint_as_float((unsigned)ul[(rbase + tk) * 256 + col] << 16); sum += ucur;
                        const int pos = p0 + 16 * half + tk; const float cnt = (float)((pos + 1 < w) ? pos + 1 : w);
                        pb[(16 * half + tk) * 264 + col] = (bf16_t)f2bf(sum / cnt - ucur);
                        sum -= __uint_as_float((unsigned)ul[(rbase + tk - (w - 1)) * 256 + col] << 16); }
                }
                __syncthreads();
                f32x16 acc = f32x16{};
#pragma unroll
                for (int sx = 0; sx < 4; ++sx) { const bf16x8 af = *(const LAS bf16x8*)(pb + r32 * 264 + mg * 64 + 16 * sx + 8 * hh);
                    acc = __builtin_amdgcn_mfma_f32_32x32x16_bf16(af, bw[sx], acc, 0, 0, 0); }
#pragma unroll
                for (int r = 0; r < 16; ++r) { const int tok = t0 + (r & 3) + 8 * (r >> 2) + 4 * hh; YCAT[(size_t)tok * 1024 + 512 + ocol] = (bf16_t)f2bf(acc[r] * psc); }
            }
            __syncthreads();
        }
    }
    SEAM(2);
    if (IN(4)) for (int rep_ = 0; rep_ < 1 + ((REPEAT_MASK >> 4) & 1); ++rep_) { KA; if (rep_) __syncthreads();
        pg8::StaticOrder S0; S0.init(T, 1024, G, bx); const pg8::TableOrder S = pg8::build_unit_table(S0, (LAS int*)(lds + MISC_OFF + 2048));
        pg8::DenseProb P{YCAT, WBRD_T, 1024, 1024, 1024}; pg8::EpiMergeR E{GATES, MERGB};
        pg8::gemm_phase<pg8::EpiMergeR, pg8::DenseProb, pg8::TableOrder, ALIGN_EPI_SEL>(lds, P, S, E);
    }
    SEAM(4);
    if (IN(5)) for (int rep_ = 0; rep_ < 1 + ((REPEAT_MASK >> 5) & 1); ++rep_) { KA; if (rep_) __syncthreads();
        pg8::DenseProb P{MERGB, WOUT_T, 1024, 1024, 1024}; pg8::StaticOrder S0; S0.init(T, 1024, G, bx); const pg8::TableOrder S = pg8::build_unit_table(S0, (LAS int*)(lds + MISC_OFF + 2048));
        pg8::EpiWout E{ka->in[I_X], OUT, (unsigned char*)XG, ka->in[I_NORM2]};
        pg8::gemm_phase<pg8::EpiWout, pg8::DenseProb, pg8::TableOrder, ALIGN_EPI_SEL>(lds, P, S, E);
    }
    SEAM(5);
    if (IN(6)) { KA;
        LAS int* lcnt = (LAS int*)(lds + MISC_OFF); LAS int* lbase = lcnt + 32;
        const int ngroups = T / 16, rounds = (ngroups + NGW - 1) / NGW;
        for (int rd = 0; rd < rounds; ++rd) {
            const int grp = rd * NGW + gw; const bool valid = grp < ngroups;
            if (tid < 32) lcnt[tid] = 0;
            __syncthreads();
            int e_sel = 0, rank = 0; float w_sel = 0.f, rstd = 0.f; const int q = lane >> 4, tok = grp * 16 + (lane & 15);
            if (valid) {
                f32x4 d0 = {0.f, 0.f, 0.f, 0.f}, d1 = {0.f, 0.f, 0.f, 0.f}; float ss = 0.f;
                const float* xrow = OUT + (size_t)tok * 1024 + 4 * q; const f32x4* wr2 = (const f32x4*)WR2 + lane;
#pragma unroll 8
                for (int s = 0; s < 64; ++s) { const f32x4 xv = *(const f32x4*)(xrow + 16 * s); const f32x4 wa = wr2[(s * 2) * 64], wb = wr2[(s * 2 + 1) * 64];
                    ss += (xv[0] * xv[0] + xv[1] * xv[1]) + (xv[2] * xv[2] + xv[3] * xv[3]);
#pragma unroll
                    for (int j = 0; j < 4; ++j) { d0 = __builtin_amdgcn_mfma_f32_16x16x4f32(wa[j], xv[j], d0, 0, 0, 0); d1 = __builtin_amdgcn_mfma_f32_16x16x4f32(wb[j], xv[j], d1, 0, 0, 0); } }
                ss += __shfl_xor(ss, 16); ss += __shfl_xor(ss, 32);
                rstd = 1.0f / sqrtf(ss * (1.0f / 1024.f) + RMS_EPS);
                unsigned key[8];
#pragma unroll
                for (int r = 0; r < 8; ++r) { const int e = (r >> 2) * 16 + 4 * q + (r & 3); const float lg = ((r < 4) ? d0[r & 3] : d1[r & 3]) * rstd + ka->in[I_BROUTER][e];
                    unsigned u = __float_as_uint(lg); u ^= (u >> 31) ? 0xffffffffu : 0x80000000u; key[r] = (u & ~31u) | (unsigned)(31 - e); }
                unsigned win[4];
#pragma unroll
                for (int r = 0; r < 4; ++r) { unsigned m = key[0];
#pragma unroll
                    for (int j = 1; j < 8; ++j) m = m > key[j] ? m : key[j];
                    unsigned o = (unsigned)__shfl_xor((int)m, 16); m = m > o ? m : o; o = (unsigned)__shfl_xor((int)m, 32); m = m > o ? m : o; win[r] = m;
#pragma unroll
                    for (int j = 0; j < 8; ++j) key[j] = (key[j] == m) ? 0u : key[j]; }
                float val[4];
#pragma unroll
                for (int r = 0; r < 4; ++r) { unsigned u = win[r] & ~31u; u ^= (u >> 31) ? 0x80000000u : 0xffffffffu; val[r] = __uint_as_float(u); }
                const float p1 = expf(val[1] - val[0]), p2 = expf(val[2] - val[0]), p3 = expf(val[3] - val[0]); const float inv = 1.0f / (1.0f + p1 + p2 + p3);
                const unsigned wk = (q == 0) ? win[0] : (q == 1) ? win[1] : (q == 2) ? win[2] : win[3];
                w_sel = ((q == 0) ? 1.0f : (q == 1) ? p1 : (q == 2) ? p2 : p3) * inv; e_sel = 31 - (int)(wk & 31u);
                rank = __hip_atomic_fetch_add((int*)(lcnt + e_sel), 1, __ATOMIC_RELAXED, __HIP_MEMORY_SCOPE_WORKGROUP);
            }
            __syncthreads();
            if (tid < 32) lbase[tid] = (int)__hip_atomic_fetch_add(CNT + 64 * tid, (unsigned)lcnt[tid], __ATOMIC_RELAXED, __HIP_MEMORY_SCOPE_AGENT);
            __syncthreads();
            if (valid) { const int pos = lbase[e_sel] + rank; LIST[(size_t)e_sel * CAP + pos] = (u32x2){(unsigned)(tok * 4 + q), __float_as_uint(rstd)}; ROUTEW[tok * 4 + q] = w_sel; }
            __syncthreads();
        }
    }
    SEAM(6);
    if (IN(7) || IN(8)) { KA;
        LAS int* tp = (LAS int*)(lds + MISC_OFF + 256); LAS int* cn = tp + 40;
        if (tid < 64) {
            const int e = tid & 31; const int c = (int)__hip_atomic_load(CNT + 64 * e, __ATOMIC_RELAXED, __HIP_MEMORY_SCOPE_AGENT); const int tiles = (c + 255) >> 8; int x = tiles;
#pragma unroll
            for (int o = 1; o < 32; o <<= 1) { const int y = __shfl_up(x, o, 32); if (e >= o) x += y; }
            if (tid < 32) { cn[e] = c; tp[e] = x - tiles; if (e == 31) tp[NEXP] = x; } }
        __syncthreads();
        if (IN(7)) for (int rep_ = 0; rep_ < 1 + ((REPEAT_MASK >> 7) & 1); ++rep_) {
            pg8::GuProb P{(const unsigned char*)XG, (const unsigned char*)WGU_T, LIST, 1024, 1024, 1024}; pg8::GroupedOrder S0{tp, cn, 8, G, bx}; const pg8::TableOrder S = pg8::build_unit_table(S0, (LAS int*)(lds + MISC_OFF + 2048));
            pg8::EpiSwiglu E{(unsigned char*)ACT, LIST, ka->in[I_BGU], lds + MISC_OFF + 4096};
            pg8::gemm_phase<pg8::EpiSwiglu, pg8::GuProb, pg8::TableOrder, ALIGN_EPI_SEL>(lds, P, S, E);
        }
        SEAM(7);
        if (IN(8)) for (int rep_ = 0; rep_ < 1 + ((REPEAT_MASK >> 8) & 1); ++rep_) {
            pg8::DownProb P{(const unsigned char*)ACT, (const unsigned char*)WD_T, 1024, 1024, 1024}; pg8::GroupedOrder S0{tp, cn, 4, G, bx}; const pg8::TableOrder S = pg8::build_unit_table(S0, (LAS int*)(lds + MISC_OFF + 2048));
            pg8::EpiDown E{(unsigned char*)Y4, LIST, ka->in[I_BD], lds + MISC_OFF + 4096};
            pg8::gemm_phase<pg8::EpiDown, pg8::DownProb, pg8::TableOrder, ALIGN_EPI_SEL>(lds, P, S, E);
        }
    }
    SEAM(8);
    if (IN(9)) { KA;
        for (int i = bx * 512 + tid; i < T * 128; i += G * 512) { const int tok = i >> 7, c8 = (i & 127) * 8;
            const f32x4 w = *(const f32x4*)(ROUTEW + tok * 4); float* op = OUT + (size_t)tok * 1024 + c8;
            f32x4 o0 = *(const f32x4*)op, o1 = *(const f32x4*)(op + 4);
#pragma unroll
            for (int k = 0; k < 4; ++k) { const u32x2 y = *(const u32x2*)((const unsigned char*)Y4 + ((size_t)tok * 4 + k) * 1024 + c8); const float wk = w[k] * (1.0f / Y8_SCALE);
                const f32x2 p0 = __builtin_amdgcn_cvt_pk_f32_fp8((int)y.x, false), p1 = __builtin_amdgcn_cvt_pk_f32_fp8((int)y.x, true), p2 = __builtin_amdgcn_cvt_pk_f32_fp8((int)y.y, false), p3 = __builtin_amdgcn_cvt_pk_f32_fp8((int)y.y, true);
                o0[0] += wk * p0[0]; o0[1] += wk * p0[1]; o0[2] += wk * p1[0]; o0[3] += wk * p1[1];
                o1[0] += wk * p2[0]; o1[1] += wk * p2[1]; o1[2] += wk * p3[0]; o1[3] += wk * p3[1]; }
            *(f32x4*)op = o0; *(f32x4*)(op + 4) = o1; }
    }
#ifdef TAP
    if (lo <= 10 && 10 < hi) { KA; GSYNC();
        for (int i = bx * 512 + tid; i < T * 1024; i += G * 512) { const int t = i >> 10, c = i & 1023; float v = 0.f;
#define BFV(buf, pitch, col) __uint_as_float((unsigned)(buf)[(size_t)t * (pitch) + (col)] << 16)
            if (TAP == 1) v = BFV(Qb, 512, c & 511) + 2.f * BFV(Kb, 512, c & 511) + 4.f * BFV(Vb, 512, c & 511) + 8.f * BFV(Ub, 256, c & 255) + 16.f * BFV(MQb, 256, c & 255)
                            + 32.f * BFV(GATES, 3072, c) + 64.f * BFV(GATES, 3072, 1024 + c) + 128.f * BFV(GATES, 3072, 2048 + c);
            if (TAP == 2) v = BFV(OC, 1024, c) + 2.f * BFV(YCAT, 1024, c);
            if (TAP == 3) v = BFV(MERGB, 1024, c);
            if (TAP == 4) v = BFV(XN, 1024, c);
            if (TAP == 6) { const bf16_t* z = WSP(bf16_t, WS_B) + (size_t)t * 5120 + c; v = __uint_as_float((unsigned)z[0] << 16) + 2.f * __uint_as_float((unsigned)z[1024] << 16) + 4.f * __uint_as_float((unsigned)z[2048] << 16) + 8.f * __uint_as_float((unsigned)z[3072] << 16) + 16.f * __uint_as_float((unsigned)z[4096] << 16); }
            if (TAP == 5) { const bf16_t* wt = WIN_T; const int tt = t % 5120; v = __uint_as_float((unsigned)wt[(size_t)tt * 1024 + c] << 16) + ROPE[(t & 8191) * 32 + (c & 31)].x + 2.f * ROPE[(t & 8191) * 32 + (c & 31)].y; }
            OUT[i] = v; }
    }
#endif
#undef IN
#undef SEAM
}

extern "C" void kernel_launch(void* const* d_in, const int* in_sizes, int n_in, void* d_out, int out_size, void* d_ws, size_t ws_size, hipStream_t stream) {
    static int grid = 0;
    if (grid == 0) {
        if (n_in != 29 || in_sizes[0] != T * DMODEL || out_size != T * DMODEL || ws_size < WS_END) {
            fprintf(stderr, "kernel_launch: unexpected shapes: n_in %d in0 %d out %d ws %zu (need %zu)\n", n_in, n_in > 0 ? in_sizes[0] : -1, out_size, ws_size, (size_t)WS_END); grid = -1; return; }
        int dev = 0, cus = 0, per_cu = 0;
        (void)hipGetDevice(&dev); (void)hipDeviceGetAttribute(&cus, hipDeviceAttributeMultiprocessorCount, dev);
        (void)hipFuncSetAttribute((const void*)fwd_kernel, hipFuncAttributeMaxDynamicSharedMemorySize, LDS_BYTES);
        (void)hipOccupancyMaxActiveBlocksPerMultiprocessor(&per_cu, (const void*)fwd_kernel, NWAVES * 64, LDS_BYTES);
        (void)hipGetLastError();
        grid = cus;
        fprintf(stderr, "kernel_launch: cus %d occupancy %d/CU grid %d\n", cus, per_cu, grid);
        if (per_cu < 1) fprintf(stderr, "kernel_launch: occupancy query says the kernel does not fit\n");
    }
    if (grid < 0) return;
    (void)hipMemsetAsync((char*)d_ws + WS_CTL, 0, CTL_ZERO_BYTES, stream);
    Args a{};
    for (int i = 0; i < 29; ++i) a.in[i] = (const float*)d_in[i];
    a.out = (float*)d_out; a.ws = (unsigned char*)d_ws; a.ph_lo = 0; a.ph_hi = PH_HI;
    void* args[] = {&a};
    hipError_t e = hipLaunchCooperativeKernel((const void*)fwd_kernel, dim3(grid), dim3(NWAVES * 64), args, LDS_BYTES, stream);
    if (e != hipSuccess) fprintf(stderr, "cooperative launch failed: %s (grid %d)\n", hipGetErrorString(e), grid);
}
```

```cpp
#include <hip/hip_runtime.h>
#include <hip/hip_cooperative_groups.h>
#include <hip/hip_bf16.h>
#include <cstdio>
#include <cstdint>
#include <cmath>
namespace cg = cooperative_groups;

#define LAS __attribute__((address_space(3)))
#define GAS __attribute__((address_space(1)))
typedef unsigned short bf16_t;
typedef short bf16x8 __attribute__((ext_vector_type(8)));
typedef float f32x4 __attribute__((ext_vector_type(4)));
typedef float f32x2 __attribute__((ext_vector_type(2)));
typedef float f32x16 __attribute__((ext_vector_type(16)));
typedef unsigned u32x4 __attribute__((ext_vector_type(4)));
typedef unsigned u32x2 __attribute__((ext_vector_type(2)));

#define PH_HI 10
#define ALIGN_EPI_SEL true
#define F8MODE 2
#define USE_SETPRIO 1
#define ATTN_PRIO_A 1
#define ATTN_PRIO_B 1
#ifndef PHMASK
#define PHMASK 0x3ff
#endif
#define CVT_NB2 4
#define REPEAT_MASK 0x000
constexpr int BATCH = 4, SEQ = 8192, DMODEL = 1024, T = BATCH * SEQ, INW = 5120, NEXP = 32, MEMLEN = 256;
constexpr float RMS_EPS = 1e-6f;
constexpr float C2 = 0.125f * 1.4426950408889634f;
constexpr int CAP = T;

constexpr size_t MiB = 1u << 20;
constexpr size_t WS_CTL = 0, CTL_ZERO_BYTES = 32768;
constexpr int CW_BAR = 4096;
constexpr size_t WS_ROUTEW = 1 * MiB;
constexpr size_t WS_LAM = 1 * MiB + 768 * 1024;
constexpr size_t WS_ROPE = 2 * MiB;
constexpr size_t WS_WR2 = 4 * MiB;
constexpr size_t WS_MEMN = 5 * MiB;
constexpr size_t WS_MKV = 7 * MiB;
constexpr size_t WS_WIN_T = 8 * MiB;
constexpr size_t WS_WBRD_T = 18 * MiB;
constexpr size_t WS_WBRP_T = 19 * MiB;
constexpr size_t WS_WBRM_T = 19 * MiB + 512 * 1024;
constexpr size_t WS_WOUT_T = 20 * MiB;
constexpr size_t WS_WMKV_T = 22 * MiB;
constexpr size_t WS_WGU_T = 24 * MiB;
constexpr size_t WS_WD_T = 152 * MiB;
constexpr size_t WS_A = 216 * MiB;
constexpr size_t WS_XN = WS_A;
constexpr size_t WS_Q = WS_A + 64 * MiB, WS_K = WS_A + 96 * MiB, WS_V = WS_A + 128 * MiB;
constexpr size_t WS_U = WS_A + 160 * MiB, WS_MQ = WS_A + 176 * MiB;
constexpr size_t WS_OC = WS_A + 192 * MiB;
constexpr size_t WS_B = 488 * MiB;
constexpr size_t WS_GATES = WS_B;
constexpr size_t WS_YCAT = WS_B + 192 * MiB;
constexpr size_t WS_MERGF = 760 * MiB;
constexpr size_t WS_MERGB = 888 * MiB;
constexpr size_t WS_XG = 952 * MiB;
constexpr size_t WS_LIST = 1016 * MiB;
constexpr size_t WS_END = 1024 * MiB;

typedef __bf16 bf16x2_v __attribute__((ext_vector_type(2)));
__device__ __forceinline__ unsigned cvt_pk_bf16(float lo, float hi) { f32x2 v = {lo, hi}; bf16x2_v b = __builtin_convertvector(v, bf16x2_v); return __builtin_bit_cast(unsigned, b); }
__device__ __forceinline__ unsigned pk4_fp8(float a, float b, float c, float d) {
    a = fminf(fmaxf(a, -448.f), 448.f); b = fminf(fmaxf(b, -448.f), 448.f); c = fminf(fmaxf(c, -448.f), 448.f); d = fminf(fmaxf(d, -448.f), 448.f);
    int r = __builtin_amdgcn_cvt_pk_fp8_f32(a, b, 0, false); r = __builtin_amdgcn_cvt_pk_fp8_f32(c, d, r, true); return (unsigned)r; }
__device__ __forceinline__ unsigned pk4_i8(float a, float b, float c, float d) {
    const int q0 = (int)fminf(fmaxf(rintf(a), -127.f), 127.f), q1 = (int)fminf(fmaxf(rintf(b), -127.f), 127.f), q2 = (int)fminf(fmaxf(rintf(c), -127.f), 127.f), q3 = (int)fminf(fmaxf(rintf(d), -127.f), 127.f);
    return ((unsigned)q0 & 0xffu) | (((unsigned)q1 & 0xffu) << 8) | (((unsigned)q2 & 0xffu) << 16) | ((unsigned)q3 << 24); }
constexpr float WQ_IN = 127.0f * 32.0f / 4.0f;
constexpr float W8_SCALE = 64.0f;
constexpr float Y8_SCALE = 32.0f;
constexpr float A8_SCALE = 8.0f;
__device__ __forceinline__ float bf_lo(unsigned w) { return __uint_as_float(w << 16); }
__device__ __forceinline__ float bf_hi(unsigned w) { return __uint_as_float(w & 0xffff0000u); }
__device__ __forceinline__ float wave_sum(float v) {
#pragma unroll
    for (int o = 1; o < 64; o <<= 1) v += __shfl_xor(v, o);
    return v;
}
#define LDS_WAIT() asm volatile("s_waitcnt lgkmcnt(0)" ::: "memory")

namespace pg8 {
constexpr int BM = 256, BK = 64, HALF = 128, HTB = HALF * BK * 2, STAGE_BYTES = 8 * HTB, NXCD = 8, WGM = 8;
__host__ __device__ __forceinline__ int lds_byte(int r, int c) { const int st = (r >> 4) * 2 + (c >> 5), rr = r & 15, cc = c & 31, ob = rr * 64 + cc * 2; return st * 1024 + (ob ^ (((ob >> 9) & 1) << 5)); }
__host__ __device__ __forceinline__ void stage_rc(int b, int& R, int& C) { const int st = b / 1024, sb = b % 1024, swz = sb ^ (((sb >> 9) & 1) << 5); R = (st >> 1) * 16 + swz / 64; C = (st & 1) * 32 + (swz % 64) / 2; }
__host__ __device__ __forceinline__ int perm32(int rho) { const int n = rho >> 4, i = rho & 15; return 8 * (i >> 2) + 4 * n + (i & 3); }

typedef int i32x4_t __attribute__((ext_vector_type(4)));
typedef int i32x8_t __attribute__((ext_vector_type(8)));
typedef long i64x2_t __attribute__((ext_vector_type(2)));
struct Unit { int pm, pn, e, mt, cnt; };

template <int BMAP> __device__ __forceinline__ int brow(int R) { return BMAP == 0 ? ((R >> 5) * 64 + perm32(R & 31)) : BMAP == 1 ? ((R & ~31) + perm32(R & 31)) : ((R >> 5) * 64 + 16 * ((R & 15) >> 2) + 4 * ((R >> 4) & 1) + (R & 3)); }

struct StaticOrder {
    int nM, nN, nwg, G, c;
    __device__ void init(int M, int N, int G_, int c_) { nM = M / BM; nN = N / BM; nwg = nM * nN; G = G_; c = c_; }
    __device__ bool next(int i, Unit& u) const {
        const long L = (long)i * G + c; if (L >= nwg) return false;
        int wgid = (int)L; { const int q = nwg / NXCD, r = nwg % NXCD, xcd = wgid % NXCD, off = wgid / NXCD; wgid = (xcd < r ? xcd * (q + 1) : r * (q + 1) + (xcd - r) * q) + off; }
        const int nig = WGM * nN, gid = wgid / nig, fm = gid * WGM, gsz = (nM - fm) < WGM ? (nM - fm) : WGM;
        u.pm = fm + ((wgid % nig) % gsz); u.pn = (wgid % nig) / gsz; u.e = 0; u.mt = 0; u.cnt = 0; return true;
    }
    __device__ bool next_lane(int i, Unit& u) const { return next(i, u); }
};
struct GroupedOrder {
    const LAS int* tp; const LAS int* cn; int NTN, G, c;
    __device__ bool next_lane(int i, Unit& u) const {
        const int nwg = tp[NEXP] * NTN; const long L = (long)i * G + c; if (L >= nwg) return false;
        int wgid = (int)L; { const int q = nwg / NXCD, r = nwg % NXCD, xcd = wgid % NXCD, off = wgid / NXCD; wgid = (xcd < r ? xcd * (q + 1) : r * (q + 1) + (xcd - r) * q) + off; }
        int e = 0; while (e < NEXP - 1 && wgid >= tp[e + 1] * NTN) ++e;
        const int idx = wgid - tp[e] * NTN, tiles = tp[e + 1] - tp[e];
        const int nig = 4 * NTN, gid = idx / nig, fm = gid * 4, gsz = (tiles - fm) < 4 ? (tiles - fm) : 4;
        u.mt = fm + ((idx % nig) % gsz); u.pn = (idx % nig) / gsz; u.e = e; u.pm = tp[e] + u.mt; u.cnt = cn[e]; return true;
    }
};
struct TableOrder {
    const LAS int* tab; int n;
    __device__ __forceinline__ bool next(int i, Unit& u) const {
        if (i >= n) return false;
        const LAS int* t = tab + i * 8;
        u.pm = __builtin_amdgcn_readfirstlane(t[0]); u.pn = __builtin_amdgcn_readfirstlane(t[1]); u.e = __builtin_amdgcn_readfirstlane(t[2]);
        u.mt = __builtin_amdgcn_readfirstlane(t[3]); u.cnt = __builtin_amdgcn_readfirstlane(t[4]); return true;
    }
};
template <class Sched> __device__ __forceinline__ TableOrder build_unit_table(const Sched& S, LAS int* tab) {
    __syncthreads();
    if (threadIdx.x < 32) { Unit u; const bool ok = S.next_lane((int)threadIdx.x, u);
        if (ok) { LAS int* t = tab + threadIdx.x * 8; t[0] = u.pm; t[1] = u.pn; t[2] = u.e; t[3] = u.mt; t[4] = u.cnt; }
        const unsigned long long m = __ballot(ok); if (threadIdx.x == 0) tab[256] = __popcll(m); }
    __syncthreads();
    TableOrder T; T.tab = tab; T.n = __builtin_amdgcn_readfirstlane(tab[256]); return T;
}
struct DenseProb {
    static constexpr bool GATHER = false; static constexpr int BMAP = 0; static constexpr bool F8 = false; static constexpr bool I8 = false;
    const bf16_t* A; const bf16_t* Bt; int lda, ldb, K;
    __device__ __forceinline__ const char* a_base(const Unit& u) const { return (const char*)(A + (size_t)u.pm * BM * lda); }
    __device__ __forceinline__ const char* b_base(const Unit& u) const { return (const char*)(Bt + (size_t)u.pn * BM * ldb); }
    __device__ __forceinline__ size_t bhstep() const { return (size_t)32 * ldb * 2; }
    __device__ __forceinline__ unsigned a_off(const Unit&, int, int) const { return 0u; }
    __device__ __forceinline__ unsigned a_raw(const Unit&, int) const { return 0u; }
};
struct DenseProbI8 {
    static constexpr bool GATHER = false; static constexpr int BMAP = 0; static constexpr bool F8 = true; static constexpr bool I8 = true;
    const unsigned char* A; const unsigned char* Bt; int lda, ldb, K;
    __device__ __forceinline__ const char* a_base(const Unit& u) const { return (const char*)(A + (size_t)u.pm * BM * lda); }
    __device__ __forceinline__ const char* b_base(const Unit& u) const { return (const char*)(Bt + (size_t)u.pn * BM * ldb); }
    __device__ __forceinline__ size_t bhstep() const { return (size_t)32 * ldb; }
    __device__ __forceinline__ unsigned a_off(const Unit&, int, int) const { return 0u; }
    __device__ __forceinline__ unsigned a_raw(const Unit&, int) const { return 0u; }
};
struct GuProb {
    static constexpr bool GATHER = true; static constexpr int BMAP = 1; static constexpr bool F8 = true; static constexpr bool I8 = false;
    const unsigned char* XG; const unsigned char* Wt; const u32x2* list; int lda, ldb, K;
    __device__ __forceinline__ const char* a_base(const Unit&) const { return (const char*)XG; }
    __device__ __forceinline__ const char* b_base(const Unit& u) const { return (const char*)(Wt + ((size_t)u.e * 2048 + 128 * u.pn) * 1024); }
    __device__ __forceinline__ size_t bhstep() const { return (size_t)1024 * 1024; }
    __device__ __forceinline__ unsigned a_raw(const Unit& u, int r) const { const int rr = u.mt * BM + r, rc = rr < u.cnt ? rr : u.cnt - 1; return list[(size_t)u.e * CAP + rc].x; }
    __device__ __forceinline__ unsigned a_off(const Unit& u, int r, int C) const {
        const int rr = u.mt * BM + r, rc = rr < u.cnt ? rr : u.cnt - 1;
        const unsigned tok = list[(size_t)u.e * CAP + rc].x >> 2;
        return tok * 1024u + (unsigned)C * 2u;
    }
};
struct DownProb {
    static constexpr bool GATHER = false; static constexpr int BMAP = 2; static constexpr bool F8 = true; static constexpr bool I8 = false;
    const unsigned char* A; const unsigned char* Wt; int lda, ldb, K;
    __device__ __forceinline__ const char* a_base(const Unit& u) const { return (const char*)(A + (size_t)u.pm * BM * lda); }
    __device__ __forceinline__ const char* b_base(const Unit& u) const { return (const char*)(Wt + ((size_t)u.e * 1024 + 256 * u.pn) * 1024); }
    __device__ __forceinline__ size_t bhstep() const { return (size_t)8 * ldb; }
    __device__ __forceinline__ unsigned a_off(const Unit&, int, int) const { return 0u; }
    __device__ __forceinline__ unsigned a_raw(const Unit&, int) const { return 0u; }
};

template <class Prob> __device__ __forceinline__ void calc_aoff(const Prob& P, const Unit& u, const int (&Rr)[2], const int (&Cc)[2], unsigned (&o)[2][2]) {
#pragma unroll
    for (int h = 0; h < 2; ++h)
#pragma unroll
        for (int i = 0; i < 2; ++i) {
            if constexpr (Prob::GATHER) o[h][i] = P.a_off(u, h * HALF + Rr[i], Cc[i]);
            else o[h][i] = Prob::F8 ? (unsigned)((h * HALF + Rr[i]) * P.lda + Cc[i] * 2) : (unsigned)((h * HALF + Rr[i]) * P.lda + Cc[i]) * 2u;
        }
}

struct NoPost { __device__ __forceinline__ void operator()(int) const {} };
template <class Epi, class Prob, class Sched, bool ALIGN_EPI, class Post = NoPost>
__device__ __forceinline__ void gemm_phase(LAS unsigned char* lds, const Prob& P, const Sched& S, const Epi& E, const Post& PU = Post()) {
    const int tid = threadIdx.x, wid = __builtin_amdgcn_readfirstlane(tid >> 6), lane = tid & 63, wr = wid >> 2, wc = wid & 3, fr = lane & 15, fq = lane >> 4;
    const int K = P.K, nt = Prob::F8 ? K / 128 : K / BK;
    int Rr[2], Cc[2]; unsigned voffB[2];
#pragma unroll
    for (int i = 0; i < 2; ++i) { stage_rc(tid * 16 + i * 8192, Rr[i], Cc[i]); voffB[i] = Prob::F8 ? (unsigned)(brow<Prob::BMAP>(Rr[i]) * P.ldb + Cc[i] * 2) : (unsigned)(brow<Prob::BMAP>(Rr[i]) * P.ldb + Cc[i]) * 2u; }
    const size_t kstep = (size_t)(BK * 2);
    const size_t bhstep = P.bhstep();
    const unsigned ldsw = (unsigned)wid * 1024u;
    const int aoff = lds_byte(wr * 64 + fr, fq * 8), boff = lds_byte(wc * 32 + fr, fq * 8);
#define PG8_SA(b, h) (((b) * 2 + (h)) * HTB)
#define PG8_SB(b, h) ((4 + (b) * 2 + (h)) * HTB)
#define PG8_STG(bufoff, gptr, v0, v1) do { \
        __builtin_amdgcn_global_load_lds((const unsigned*)((const char*)(gptr) + (v0)), (LAS unsigned*)(lds + (bufoff) + ldsw), 16, 0, 0); \
        __builtin_amdgcn_global_load_lds((const unsigned*)((const char*)(gptr) + (v1)), (LAS unsigned*)(lds + (bufoff) + ldsw + 8192), 16, 0, 0); } while (0)
#define PG8_STGB(bufoff, gptr) PG8_STG(bufoff, gptr, voffB[0], voffB[1])
#define PG8_LDA(dst, b, h) do { _Pragma("unroll") for (int m = 0; m < 4; ++m) _Pragma("unroll") for (int k = 0; k < 2; ++k) dst[m][k] = *(const LAS bf16x8*)(lds + PG8_SA(b, h) + aoff + m * 2048 + k * 1024); } while (0)
#define PG8_LDB(dst, b, h) do { _Pragma("unroll") for (int n = 0; n < 2; ++n) _Pragma("unroll") for (int k = 0; k < 2; ++k) dst[n][k] = *(const LAS bf16x8*)(lds + PG8_SB(b, h) + boff + n * 2048 + k * 1024); } while (0)
#define PG8_MMAB(ai, bj, At, Bt) do { _Pragma("unroll") for (int m = 0; m < 4; ++m) _Pragma("unroll") for (int n = 0; n < 2; ++n) _Pragma("unroll") for (int k = 0; k < 2; ++k) \
        acc[ai][bj][m][n] = __builtin_amdgcn_mfma_f32_16x16x32_bf16(Bt[n][k], At[m][k], acc[ai][bj][m][n], 0, 0, 0); } while (0)
#define PG8_MMAQ(ai, bj, At, Bt) do { _Pragma("unroll") for (int m = 0; m < 4; ++m) _Pragma("unroll") for (int n = 0; n < 2; ++n) _Pragma("unroll") for (int k = 0; k < 2; ++k) { \
        const i64x2_t bq = __builtin_bit_cast(i64x2_t, Bt[n][k]), aq = __builtin_bit_cast(i64x2_t, At[m][k]); \
        acc[ai][bj][m][n] = __builtin_amdgcn_mfma_f32_16x16x32_fp8_fp8(bq[0], aq[0], acc[ai][bj][m][n], 0, 0, 0); \
        acc[ai][bj][m][n] = __builtin_amdgcn_mfma_f32_16x16x32_fp8_fp8(bq[1], aq[1], acc[ai][bj][m][n], 0, 0, 0); } } while (0)
#define PG8_MMA8(ai, bj, A8, B8) do { _Pragma("unroll") for (int m = 0; m < 4; ++m) _Pragma("unroll") for (int n = 0; n < 2; ++n) \
        asm volatile("v_mfma_f32_16x16x128_f8f6f4 %0, %1, %2, %0" : "+v"(acc[ai][bj][m][n]) : "v"(B8[n]), "v"(A8[m])); } while (0)
#define PG8_MMAI(ai, bj, At, Bt) do { _Pragma("unroll") for (int k = 0; k < 2; ++k) _Pragma("unroll") for (int m = 0; m < 4; ++m) _Pragma("unroll") for (int n = 0; n < 2; ++n) \
        asm volatile("v_mfma_i32_16x16x64_i8 %0, %1, %2, %0" : "+v"(acc[ai][bj][m][n]) : "v"(Bt[n][k]), "v"(At[m][k])); } while (0)
#define PG8_LDA8(dst, b, h) do { _Pragma("unroll") for (int m = 0; m < 4; ++m) { dst[m].lo = *(const LAS i32x4_t*)(lds + PG8_SA(b, h) + aoff + m * 2048); dst[m].hi = *(const LAS i32x4_t*)(lds + PG8_SA(b, h) + aoff + m * 2048 + 1024); } } while (0)
#define PG8_LDB8(dst, b, h) do { _Pragma("unroll") for (int n = 0; n < 2; ++n) { dst[n].lo = *(const LAS i32x4_t*)(lds + PG8_SB(b, h) + boff + n * 2048); dst[n].hi = *(const LAS i32x4_t*)(lds + PG8_SB(b, h) + boff + n * 2048 + 1024); } } while (0)
#define PG8_XLDA(b, h)  do { if constexpr (Prob::F8 && !Prob::I8 && F8MODE == 2) PG8_LDA8(At8, b, h); else PG8_LDA(At, b, h); } while (0)
#define PG8_XLDB0(b, h) do { if constexpr (Prob::F8 && !Prob::I8 && F8MODE == 2) PG8_LDB8(B08, b, h); else PG8_LDB(B0, b, h); } while (0)
#define PG8_XLDB1(b, h) do { if constexpr (Prob::F8 && !Prob::I8 && F8MODE == 2) PG8_LDB8(B18, b, h); else PG8_LDB(B1, b, h); } while (0)
#define PG8_XMMA0(ai, bj) do { if (USE_SETPRIO) __builtin_amdgcn_s_setprio(USE_SETPRIO); if constexpr (Prob::I8) PG8_MMAI(ai, bj, At, B0); else if constexpr (Prob::F8 && F8MODE == 2) PG8_MMA8(ai, bj, At8, B08); else if constexpr (Prob::F8) PG8_MMAQ(ai, bj, At, B0); else PG8_MMAB(ai, bj, At, B0); if (USE_SETPRIO) __builtin_amdgcn_s_setprio(0); } while (0)
#define PG8_XMMA1(ai, bj) do { if (USE_SETPRIO) __builtin_amdgcn_s_setprio(USE_SETPRIO); if constexpr (Prob::I8) PG8_MMAI(ai, bj, At, B1); else if constexpr (Prob::F8 && F8MODE == 2) PG8_MMA8(ai, bj, At8, B18); else if constexpr (Prob::F8) PG8_MMAQ(ai, bj, At, B1); else PG8_MMAB(ai, bj, At, B1); if (USE_SETPRIO) __builtin_amdgcn_s_setprio(0); } while (0)
#define PG8_WAIT_V(n) asm volatile("s_waitcnt vmcnt(" #n ")" ::: "memory")
#define PG8_WAIT_L(n) asm volatile("s_waitcnt lgkmcnt(" #n ")" ::: "memory")
#define PG8_BAR __builtin_amdgcn_s_barrier()
#define PG8_SCHED __builtin_amdgcn_sched_barrier(0)
    Unit cur, nxt; int ui = 0;
    if (!S.next(0, cur)) return;
    unsigned vo[2][2], nvo[2][2];
    calc_aoff(P, cur, Rr, Cc, vo);
    bool has_next = S.next(1, nxt);
    if constexpr (Prob::GATHER) { if (has_next) calc_aoff(P, nxt, Rr, Cc, nvo); else {
#pragma unroll
        for (int h = 0; h < 2; ++h)
#pragma unroll
            for (int i = 0; i < 2; ++i) nvo[h][i] = vo[h][i]; } }
    f32x4 acc[2][2][4][2];
#pragma unroll
    for (int a = 0; a < 2; ++a)
#pragma unroll
        for (int b = 0; b < 2; ++b)
#pragma unroll
            for (int m = 0; m < 4; ++m)
#pragma unroll
                for (int n = 0; n < 2; ++n) acc[a][b][m][n] = (f32x4){0.f, 0.f, 0.f, 0.f};
    bf16x8 At[4][2], B0[2][2], B1[2][2]; i32x8_t At8[4], B08[2], B18[2];
    const char* cA = P.a_base(cur); const char* cB = P.b_base(cur);
    if constexpr (Epi::HAS_PRE) E.pre(cur, 0, wid, lane);
    PG8_STGB(PG8_SB(0, 0), cB); PG8_STGB(PG8_SB(0, 1), cB + bhstep); PG8_STG(PG8_SA(0, 0), cA, vo[0][0], vo[0][1]); PG8_STG(PG8_SA(0, 1), cA, vo[1][0], vo[1][1]);
    if (wr == 1) PG8_BAR;
    PG8_WAIT_V(2); PG8_BAR;
    PG8_STGB(PG8_SB(1, 0), cB + kstep); PG8_STG(PG8_SA(1, 0), cA + kstep, vo[0][0], vo[0][1]); PG8_STGB(PG8_SB(1, 1), cB + bhstep + kstep);
    PG8_WAIT_V(6); PG8_BAR;
    for (;;) {
        const char* nA = has_next ? P.a_base(nxt) : cA; const char* nB = has_next ? P.b_base(nxt) : cB;
        for (int t = 0; t < nt; t += 2) {
            const bool last = (t == nt - 2);
            if constexpr (Epi::HAS_MID) { if (t == Epi::MID_T0 || t == Epi::MID_T1) { E.mid(acc, cur, wr, wc, fr, fq, t == Epi::MID_T0 ? 0 : 1); PG8_SCHED; } }
            const char* a1 = cA + (size_t)(t + 1) * kstep;
            const char* a2 = last ? nA : cA + (size_t)(t + 2) * kstep; const char* b2 = last ? nB : cB + (size_t)(t + 2) * kstep;
            const char* a3 = a2 + kstep; const char* b3 = b2 + kstep;
            unsigned x00 = vo[0][0], x01 = vo[0][1], x10 = vo[1][0], x11 = vo[1][1];
            if constexpr (Prob::GATHER) { if (last) { x00 = nvo[0][0]; x01 = nvo[0][1]; x10 = nvo[1][0]; x11 = nvo[1][1]; } }
            PG8_XLDB0(0, 0); PG8_XLDB1(0, 1); PG8_SCHED; PG8_XLDA(0, 0); PG8_STG(PG8_SA(1, 1), a1, vo[1][0], vo[1][1]);
            PG8_WAIT_V(8); PG8_WAIT_L(0); PG8_BAR; PG8_XMMA0(0, 0); PG8_XMMA1(0, 1); PG8_BAR; PG8_SCHED;
            PG8_XLDA(0, 1); PG8_STGB(PG8_SB(0, 0), b2); PG8_STGB(PG8_SB(0, 1), b2 + bhstep); PG8_STG(PG8_SA(0, 0), a2, x00, x01);
            PG8_WAIT_V(8); PG8_WAIT_L(0); PG8_BAR; PG8_XMMA0(1, 0); PG8_XMMA1(1, 1); PG8_BAR; PG8_SCHED;
            PG8_XLDB0(1, 0); PG8_XLDB1(1, 1); PG8_SCHED; PG8_XLDA(1, 0); PG8_STG(PG8_SA(0, 1), a2, x10, x11);
            PG8_WAIT_V(8); PG8_WAIT_L(0); PG8_BAR; PG8_XMMA0(0, 0); PG8_XMMA1(0, 1); PG8_BAR; PG8_SCHED;
            PG8_XLDA(1, 1); PG8_STGB(PG8_SB(1, 0), b3); PG8_STGB(PG8_SB(1, 1), b3 + bhstep); PG8_STG(PG8_SA(1, 0), a3, x00, x01);
            PG8_WAIT_V(8); PG8_WAIT_L(0); PG8_BAR; PG8_XMMA0(1, 0); PG8_XMMA1(1, 1); PG8_BAR; PG8_SCHED;
        }
        if constexpr (ALIGN_EPI) { if (wr == 0) PG8_BAR; }
        if constexpr ((Prob::F8 && F8MODE == 2) || Prob::I8) asm volatile("s_nop 15\n\ts_nop 15" ::: "memory");
        Unit nn; const bool has_nn = has_next && S.next(ui + 2, nn);
        if constexpr (Prob::GATHER) {
#pragma unroll
            for (int h = 0; h < 2; ++h)
#pragma unroll
                for (int i = 0; i < 2; ++i) vo[h][i] = nvo[h][i];
            if (has_nn) {
#pragma unroll
                for (int h = 0; h < 2; ++h)
#pragma unroll
                    for (int i = 0; i < 2; ++i) nvo[h][i] = P.a_raw(nn, h * HALF + Rr[i]); } }
        if constexpr (Epi::HAS_PRE) E(acc, cur, wr, wc, fr, fq, ui & 1); else E(acc, cur, wr, wc, fr, fq);
        PU(ui);
        if (!has_next) break;
#pragma unroll
        for (int a = 0; a < 2; ++a)
#pragma unroll
            for (int b = 0; b < 2; ++b)
#pragma unroll
                for (int m = 0; m < 4; ++m)
#pragma unroll
                    for (int n = 0; n < 2; ++n) acc[a][b][m][n] = (f32x4){0.f, 0.f, 0.f, 0.f};
        cur = nxt; cA = nA; cB = nB; ++ui;
        if constexpr (Epi::HAS_PRE) E.pre(cur, ui, wid, lane);
        has_next = has_nn; nxt = nn;
        if constexpr (Prob::GATHER) { if (has_next) {
#pragma unroll
            for (int h = 0; h < 2; ++h)
#pragma unroll
                for (int i = 0; i < 2; ++i) nvo[h][i] = (nvo[h][i] >> 2) * (Prob::F8 ? 1024u : 2048u) + (unsigned)Cc[i] * 2u;
            asm volatile("" : "+v"(nvo[0][0]), "+v"(nvo[0][1]), "+v"(nvo[1][0]), "+v"(nvo[1][1])); } }
        if constexpr (ALIGN_EPI) { if (wr == 1) PG8_BAR; }
    }
    PG8_WAIT_V(0);
    if constexpr (!ALIGN_EPI) { if (wr == 0) PG8_BAR; }
    PG8_BAR;
#undef PG8_SA
#undef PG8_SB
#undef PG8_STG
#undef PG8_STGB
#undef PG8_LDA
#undef PG8_LDB
#undef PG8_MMAB
#undef PG8_MMAQ
#undef PG8_MMA8
#undef PG8_MMAI
#undef PG8_LDA8
#undef PG8_LDB8
#undef PG8_XLDA
#undef PG8_XLDB0
#undef PG8_XLDB1
#undef PG8_XMMA0
#undef PG8_XMMA1
#undef PG8_WAIT_V
#undef PG8_WAIT_L
#undef PG8_BAR
#undef PG8_SCHED
}

typedef const f32x4 (&AccRef)[2][2][4][2];
__device__ __forceinline__ void dma4(const void* g, LAS unsigned char* dst) { __builtin_amdgcn_global_load_lds((const unsigned*)g, (LAS unsigned*)dst, 4, 0, 0); }

__device__ __forceinline__ void store8(bf16_t* p, const f32x4& a, const f32x4& b) {
    u32x4 w; w.x = cvt_pk_bf16(a[0], a[1]); w.y = cvt_pk_bf16(a[2], a[3]); w.z = cvt_pk_bf16(b[0], b[1]); w.w = cvt_pk_bf16(b[2], b[3]); *(u32x4*)p = w;
}
__device__ __forceinline__ float sigmoidf_(float v) { return __builtin_amdgcn_rcpf(1.0f + __builtin_amdgcn_exp2f(-1.4426950408889634f * v)); }

struct EpiInProj {
    static constexpr bool HAS_MID = false; static constexpr bool HAS_PRE = false;
    bf16_t *Q, *Kb, *V, *U, *MQ, *GT; const float *qn, *kn, *mqn, *bg; const f32x2* rope; const float* rs;
    __device__ __forceinline__ void operator()(AccRef acc, const Unit& u, int wr, int wc, int fr, int fq) const {
        const int pn = u.pn; const int row0 = u.pm * BM + wr * 64 + fr;
        float sc8[8];
#pragma unroll
        for (int q = 0; q < 8; ++q) sc8[q] = rs[row0 + (q >> 2) * HALF + (q & 3) * 16] * (1.0f / WQ_IN);
#define I2F(v) __builtin_convertvector(__builtin_bit_cast(i32x4_t, v), f32x4)
        bf16_t* const Q_ = Q; bf16_t* const K_ = Kb; bf16_t* const V_ = V; bf16_t* const U_ = U; bf16_t* const MQ_ = MQ; const float* const qn_ = qn; const float* const kn_ = kn; const float* const mqn_ = mqn;
        if (pn < 4 || pn == 7) {
            const bool rope_on = pn < 4; const float* gn = pn < 2 ? qn_ : (pn < 4 ? kn_ : mqn_);
            const float sc = (pn < 2 || pn == 7) ? C2 : 1.0f;
            bf16_t* O; int pitch, colb;
            if (pn < 2) { O = Q_; pitch = 512; colb = (pn * 4 + wc) * 64; } else if (pn < 4) { O = K_; pitch = 512; colb = ((pn - 2) * 4 + wc) * 64; } else { O = MQ_; pitch = 256; colb = wc * 64; }
            const f32x4 g00 = *(const f32x4*)(gn + 8 * fq), g01 = *(const f32x4*)(gn + 8 * fq + 4), g10 = *(const f32x4*)(gn + 32 + 8 * fq), g11 = *(const f32x4*)(gn + 32 + 8 * fq + 4);
#pragma unroll
            for (int ai = 0; ai < 2; ++ai)
#pragma unroll
                for (int m = 0; m < 4; ++m) {
                    const float rsc = sc8[ai * 4 + m]; const f32x4 a0 = I2F(acc[ai][0][m][0]) * rsc, a1 = I2F(acc[ai][0][m][1]) * rsc, b0 = I2F(acc[ai][1][m][0]) * rsc, b1 = I2F(acc[ai][1][m][1]) * rsc;
                    float ss = 0.f;
#pragma unroll
                    for (int j = 0; j < 4; ++j) ss += a0[j] * a0[j] + a1[j] * a1[j] + b0[j] * b0[j] + b1[j] * b1[j];
                    ss += __shfl_xor(ss, 16); ss += __shfl_xor(ss, 32);
                    const float rstd = 1.0f / sqrtf(ss * (1.0f / 64.0f) + RMS_EPS);
                    const int row = row0 + ai * HALF + m * 16;
                    f32x4 t10 = a0 * rstd * g00, t11 = a1 * rstd * g01, t20 = b0 * rstd * g10, t21 = b1 * rstd * g11;
                    f32x4 o10, o11, o20, o21;
                    if (rope_on) {
                        const f32x4* rp = (const f32x4*)(rope + (size_t)(row & (SEQ - 1)) * 32 + 8 * fq);
                        const f32x4 r0 = rp[0], r1 = rp[1], r2 = rp[2], r3 = rp[3];
                        const f32x4 cs0 = {r0[0], r0[2], r1[0], r1[2]}, sn0 = {r0[1], r0[3], r1[1], r1[3]}, cs1 = {r2[0], r2[2], r3[0], r3[2]}, sn1 = {r2[1], r2[3], r3[1], r3[3]};
                        o10 = (t10 * cs0 - t20 * sn0) * sc; o11 = (t11 * cs1 - t21 * sn1) * sc; o20 = (t20 * cs0 + t10 * sn0) * sc; o21 = (t21 * cs1 + t11 * sn1) * sc;
                    } else { o10 = t10 * sc; o11 = t11 * sc; o20 = t20 * sc; o21 = t21 * sc; }
                    bf16_t* rowp = O + (size_t)row * pitch + colb + 8 * fq;
                    store8(rowp, o10, o11); store8(rowp + 32, o20, o21);
                }
        } else if (pn < 7) {
            bf16_t* O; int pitch, colb;
            if (pn < 6) { O = V_; pitch = 512; colb = (pn - 4) * 256 + wc * 64; } else { O = U_; pitch = 256; colb = wc * 64; }
#pragma unroll
            for (int ai = 0; ai < 2; ++ai)
#pragma unroll
                for (int m = 0; m < 4; ++m) { bf16_t* rowp = O + (size_t)(row0 + ai * HALF + m * 16) * pitch + colb + 8 * fq;
                    const float sc = sc8[ai * 4 + m]; store8(rowp, I2F(acc[ai][0][m][0]) * sc, I2F(acc[ai][0][m][1]) * sc); store8(rowp + 32, I2F(acc[ai][1][m][0]) * sc, I2F(acc[ai][1][m][1]) * sc); }
        } else {
            const int gc = (pn - 8) * 256 + wc * 64 + 8 * fq;
            f32x4 bv[2][2];
#pragma unroll
            for (int bj = 0; bj < 2; ++bj)
#pragma unroll
                for (int n = 0; n < 2; ++n) bv[bj][n] = *(const f32x4*)(bg + gc + 32 * bj + 4 * n) * (-1.4426950408889634f);
#pragma unroll
            for (int ai = 0; ai < 2; ++ai)
#pragma unroll
                for (int m = 0; m < 4; ++m) {
                    unsigned char* blk = (unsigned char*)GT + ((size_t)(((pn - 8) >> 2) * 128 + u.pm) * 4 + ((pn - 8) & 3)) * 65536 + (size_t)((wr * 4 + wc) * 8 * 64 + (fq * 16 + fr)) * 16;
                    u32x4 w4 = {0u, 0u, 0u, 0u};
#pragma unroll
                    for (int bj = 0; bj < 2; ++bj) { const float scl = sc8[ai * 4 + m] * (-1.4426950408889634f); f32x4 v0 = I2F(acc[ai][bj][m][0]) * scl + bv[bj][0], v1 = I2F(acc[ai][bj][m][1]) * scl + bv[bj][1];
                        unsigned wx = 0u, wy = 0u;
#pragma unroll
                        for (int j = 0; j < 4; ++j) { const float g0 = __builtin_amdgcn_rcpf(1.0f + __builtin_amdgcn_exp2f(v0[j])), g1 = __builtin_amdgcn_rcpf(1.0f + __builtin_amdgcn_exp2f(v1[j]));
                            wx = __builtin_amdgcn_cvt_pk_u8_f32(fmaxf(g0 * 255.0f + 0.25f, 1.0f), j, wx); wy = __builtin_amdgcn_cvt_pk_u8_f32(fmaxf(g1 * 255.0f + 0.25f, 1.0f), j, wy); }
                        if (bj == 0) { w4.x = wx; w4.y = wy; } else { w4.z = wx; w4.w = wy; } }
                    *(u32x4*)(blk + (ai * 4 + m) * 1024) = w4; }
        }
    }
};
#undef I2F
struct EpiMemKV {
    static constexpr bool HAS_MID = false; static constexpr bool HAS_PRE = false;
    bf16_t* MKV; const float* mkn;
    __device__ __forceinline__ void operator()(AccRef acc, const Unit& u, int wr, int wc, int fr, int fq) const {
        const int row0 = u.pm * BM + wr * 64 + fr;
        f32x4 g00 = {1.f, 1.f, 1.f, 1.f}, g01 = g00, g10 = g00, g11 = g00;
        if (u.pn == 0) { g00 = *(const f32x4*)(mkn + 8 * fq); g01 = *(const f32x4*)(mkn + 8 * fq + 4); g10 = *(const f32x4*)(mkn + 32 + 8 * fq); g11 = *(const f32x4*)(mkn + 32 + 8 * fq + 4); }
#pragma unroll
        for (int ai = 0; ai < 2; ++ai)
#pragma unroll
            for (int m = 0; m < 4; ++m) {
                const f32x4 a0 = acc[ai][0][m][0], a1 = acc[ai][0][m][1], b0 = acc[ai][1][m][0], b1 = acc[ai][1][m][1];
                float rstd = 1.0f;
                if (u.pn == 0) { float ss = 0.f;
#pragma unroll
                    for (int j = 0; j < 4; ++j) ss += a0[j] * a0[j] + a1[j] * a1[j] + b0[j] * b0[j] + b1[j] * b1[j];
                    ss += __shfl_xor(ss, 16); ss += __shfl_xor(ss, 32); rstd = 1.0f / sqrtf(ss * (1.0f / 64.0f) + RMS_EPS); }
                bf16_t* rowp = MKV + (size_t)(row0 + ai * HALF + m * 16) * 512 + u.pn * 256 + wc * 64 + 8 * fq;
                store8(rowp, a0 * rstd * g00, a1 * rstd * g01); store8(rowp + 32, b0 * rstd * g10, b1 * rstd * g11);
            }
    }
};
template <int STAGE> struct EpiMerge {
    static constexpr bool HAS_MID = false; static constexpr bool HAS_PRE = false;
    const bf16_t* GT; float* MF; bf16_t* MB;
    __device__ __forceinline__ void operator()(AccRef acc, const Unit& u, int wr, int wc, int fr, int fq) const {
        const int row0 = u.pm * BM + wr * 64 + fr, col0 = u.pn * BM + wc * 64 + 8 * fq;
#pragma unroll
        for (int ai = 0; ai < 2; ++ai)
#pragma unroll
            for (int m = 0; m < 4; ++m) { const size_t row = (size_t)(row0 + ai * HALF + m * 16);
#pragma unroll
                for (int bj = 0; bj < 2; ++bj) { const int col = col0 + 32 * bj;
                    const u32x4 g = *(const u32x4*)(GT + row * 3072 + STAGE * 1024 + col);
                    const f32x4 ga = {bf_lo(g.x), bf_hi(g.x), bf_lo(g.y), bf_hi(g.y)}, gb = {bf_lo(g.z), bf_hi(g.z), bf_lo(g.w), bf_hi(g.w)};
                    f32x4 v0 = acc[ai][bj][m][0] * ga, v1 = acc[ai][bj][m][1] * gb;
                    float* mp = MF + row * 1024 + col;
                    if (STAGE > 0) { v0 += *(const f32x4*)mp; v1 += *(const f32x4*)(mp + 4); }
                    if (STAGE < 2) { *(f32x4*)mp = v0; *(f32x4*)(mp + 4) = v1; } else store8(MB + row * 1024 + col, v0, v1); }
                if (m & 1) asm volatile("" ::: "memory"); }
    }
};
__device__ __forceinline__ u32x4 pair16(const u32x2& a, const u32x2& b) {
    const auto rx = __builtin_amdgcn_permlane16_swap(a.x, b.x, false, false), ry = __builtin_amdgcn_permlane16_swap(a.y, b.y, false, false);
    return (u32x4){rx[0], ry[0], rx[1], ry[1]};
}
struct EpiWout {
    static constexpr bool HAS_MID = false; static constexpr bool HAS_PRE = false;
    const float* X; float* X2; unsigned char* XG; const float* n2;
    __device__ __forceinline__ void operator()(AccRef acc, const Unit& u, int wr, int wc, int fr, int fq) const {
        const int row0 = u.pm * BM + wr * 64 + fr, col0 = u.pn * BM + wc * 64 + 8 * fq;
        f32x4 nv[2][2];
#pragma unroll
        for (int bj = 0; bj < 2; ++bj)
#pragma unroll
            for (int n = 0; n < 2; ++n) nv[bj][n] = *(const f32x4*)(n2 + col0 + 32 * bj + 4 * n);
        const size_t xgoff = (size_t)(row0 + 16 * (fq & 1)) * 1024 + u.pn * BM + wc * 64 + 8 * (fq & 2);
#pragma unroll
        for (int ai = 0; ai < 2; ++ai) {
            f32x4 xv[4][2][2];
#pragma unroll
            for (int m = 0; m < 4; ++m)
#pragma unroll
                for (int bj = 0; bj < 2; ++bj) { const float* xp = X + (size_t)(row0 + ai * HALF + m * 16) * 1024 + col0 + 32 * bj; xv[m][bj][0] = *(const f32x4*)xp; xv[m][bj][1] = *(const f32x4*)(xp + 4); }
            asm volatile("" ::: "memory");
#pragma unroll
            for (int mp = 0; mp < 2; ++mp) { u32x2 w8[2][2];
#pragma unroll
                for (int mm = 0; mm < 2; ++mm) { const int m = 2 * mp + mm; const size_t off = (size_t)(row0 + ai * HALF + m * 16) * 1024 + col0;
#pragma unroll
                    for (int bj = 0; bj < 2; ++bj) { const f32x4 x0 = xv[m][bj][0] + acc[ai][bj][m][0], x1 = xv[m][bj][1] + acc[ai][bj][m][1];
                        *(f32x4*)(X2 + off + 32 * bj) = x0; *(f32x4*)(X2 + off + 32 * bj + 4) = x1;
                        const f32x4 y0 = x0 * nv[bj][0], y1 = x1 * nv[bj][1]; w8[mm][bj].x = pk4_fp8(y0[0], y0[1], y0[2], y0[3]); w8[mm][bj].y = pk4_fp8(y1[0], y1[1], y1[2], y1[3]); } }
#pragma unroll
                for (int bj = 0; bj < 2; ++bj) *(u32x4*)(XG + xgoff + (size_t)(ai * HALF + mp * 32) * 1024 + 32 * bj) = pair16(w8[0][bj], w8[1][bj]); }
            asm volatile("" ::: "memory"); }
    }
};
struct EpiSwiglu {
    static constexpr bool HAS_MID = false; static constexpr bool HAS_PRE = true;
    unsigned char* ACT; const u32x2* list; const float* bgu; LAS unsigned char* xb;
    __device__ __forceinline__ void pre(const Unit& u, int ui, int wid, int lane) const {
        LAS unsigned char* b = xb + (ui & 1) * 2048;
        if (wid < 4) { const int rr = u.mt * BM + 64 * wid + lane, rc = rr < u.cnt ? rr : u.cnt - 1; dma4((const unsigned*)(list + (size_t)u.e * CAP + rc) + 1, b + wid * 256); }
        else { const int j = 64 * (wid - 4) + lane; dma4(bgu + (size_t)u.e * 2048 + 128 * u.pn + (j < 128 ? j : 1024 + (j - 128)), b + 1024 + (wid - 4) * 256); }
    }
    __device__ __forceinline__ static unsigned swi4(const f32x4& ag, const f32x4& au, float rstd, const f32x4& bg, const f32x4& bu) {
        unsigned w = 0;
#pragma unroll
        for (int h = 0; h < 2; ++h) {
            const f32x2 a2 = {ag[2 * h], ag[2 * h + 1]}, u2 = {au[2 * h], au[2 * h + 1]}, bg2 = {bg[2 * h], bg[2 * h + 1]}, bu2 = {bu[2 * h], bu[2 * h + 1]};
            const f32x2 G = a2 * rstd + bg2, U = u2 * rstd + bu2;
            const f32x2 gg = {fminf(G[0], 7.0f), fminf(G[1], 7.0f)};
            const f32x2 t = gg * (-1.702f * 1.4426950408889634f);
            const f32x2 d = (f32x2){__builtin_amdgcn_exp2f(t[0]), __builtin_amdgcn_exp2f(t[1])} + 1.0f;
            const f32x2 r = {__builtin_amdgcn_rcpf(d[0]), __builtin_amdgcn_rcpf(d[1])};
            const f32x2 uu = {__builtin_amdgcn_fmed3f(U[0], -7.0f, 7.0f), __builtin_amdgcn_fmed3f(U[1], -7.0f, 7.0f)};
            const f32x2 o = (gg * r) * (uu * A8_SCALE + A8_SCALE);
            w = h ? (unsigned)__builtin_amdgcn_cvt_pk_fp8_f32(o[0], o[1], (int)w, true) : (unsigned)__builtin_amdgcn_cvt_pk_fp8_f32(o[0], o[1], (int)w, false);
        }
        return w;
    }
    __device__ __forceinline__ void operator()(AccRef acc, const Unit& u, int wr, int wc, int fr, int fq, int par) const {
        int z = 0; asm volatile("" : "+v"(z));
        const int col = 128 * u.pn + 32 * wc + 8 * fq + z; const LAS unsigned char* b = xb + par * 2048; const LAS unsigned char* bb = b + 1024 + (32 * wc + 8 * fq + z) * 4;
        const f32x4 bg0 = *(const LAS f32x4*)bb, bg1 = *(const LAS f32x4*)(bb + 16), bu0 = *(const LAS f32x4*)(bb + 512), bu1 = *(const LAS f32x4*)(bb + 528);
        unsigned char* const ap = ACT + (size_t)(u.pm * BM + wr * 64 + fr + 16 * (fq & 1)) * 1024 + 128 * u.pn + 32 * wc + 8 * (fq & 2) + z;
#pragma unroll
        for (int ai = 0; ai < 2; ++ai)
#pragma unroll
            for (int mp = 0; mp < 2; ++mp) { u32x2 w8[2];
#pragma unroll
                for (int mm = 0; mm < 2; ++mm) { const int m = 2 * mp + mm, r = ai * HALF + wr * 64 + m * 16 + fr;
                    const float rstd = *(const LAS float*)(b + (r + z) * 4) * (1.0f / W8_SCALE);
                    w8[mm].x = swi4(acc[ai][0][m][0], acc[ai][1][m][0], rstd, bg0, bu0); w8[mm].y = swi4(acc[ai][0][m][1], acc[ai][1][m][1], rstd, bg1, bu1); }
                *(u32x4*)(ap + (size_t)(ai * HALF + mp * 32) * 1024) = pair16(w8[0], w8[1]); }
    }
};
struct EpiDown {
    static constexpr bool HAS_MID = false; static constexpr bool HAS_PRE = true;
    unsigned char* Y4; const u32x2* list; const float* bd; LAS unsigned char* xb;
    __device__ __forceinline__ void pre(const Unit& u, int ui, int wid, int lane) const {
        LAS unsigned char* b = xb + (ui & 1) * 2048;
        if (wid < 4) { const int rr = u.mt * BM + 64 * wid + lane, rc = rr < u.cnt ? rr : u.cnt - 1; dma4((const unsigned*)(list + (size_t)u.e * CAP + rc), b + wid * 256); }
        else { const int j = 64 * (wid - 4) + lane; dma4(bd + (size_t)u.e * 1024 + u.pn * BM + j, b + 1024 + (wid - 4) * 256); }
    }
    __device__ __forceinline__ static unsigned dn4(const f32x4& a, const f32x4& b32) {
        const f32x4 y = a * (Y8_SCALE / (W8_SCALE * A8_SCALE)) + b32;
        return pk4_fp8(y[0], y[1], y[2], y[3]);
    }
    __device__ __forceinline__ void operator()(AccRef acc, const Unit& u, int wr, int wc, int fr, int fq, int par) const {
        int z = 0; asm volatile("" : "+v"(z));
        const int colw = wc * 64 + 16 * fq + z, col0 = u.pn * BM + colw;
        const LAS unsigned char* b = xb + par * 2048;
        f32x4 bv[2][2];
#pragma unroll
        for (int bj = 0; bj < 2; ++bj)
#pragma unroll
            for (int n = 0; n < 2; ++n) bv[bj][n] = *(const LAS f32x4*)(b + 1024 + (colw + 8 * bj + 4 * n) * 4) * Y8_SCALE;
#pragma unroll
        for (int ai = 0; ai < 2; ++ai)
#pragma unroll
            for (int m = 0; m < 4; ++m) { const int r = ai * HALF + wr * 64 + m * 16 + fr, rr = u.mt * BM + r;
                if (rr < u.cnt) { const unsigned tk = *(const LAS unsigned*)(b + (r + z) * 4);
                    u32x4 w8; w8.x = dn4(acc[ai][0][m][0], bv[0][0]); w8.y = dn4(acc[ai][0][m][1], bv[0][1]); w8.z = dn4(acc[ai][1][m][0], bv[1][0]); w8.w = dn4(acc[ai][1][m][1], bv[1][1]);
                    *(u32x4*)(Y4 + (size_t)tk * 1024 + col0) = w8; } }
    }
};
struct EpiMergeR {
    static constexpr bool HAS_MID = true; static constexpr bool HAS_PRE = false; static constexpr int MID_T0 = 8, MID_T1 = 12;
    const bf16_t* GT; bf16_t* MB;
    __device__ __forceinline__ void mid(f32x4 (&acc)[2][2][4][2], const Unit& u, int wr, int wc, int fr, int fq, int seam) const {
        int z = 0; asm volatile("" : "+v"(z));
        const unsigned char* gp0 = (const unsigned char*)GT + ((size_t)(seam * 128 + u.pm) * 4 + u.pn) * 65536 + (size_t)((wr * 4 + wc) * 8 * 64 + (fq * 16 + fr) + z) * 16;
        u32x4 gnv[8], gdv[8];
#pragma unroll
        for (int k = 0; k < 8; ++k) { gnv[k] = *(const u32x4*)(gp0 + k * 1024); gdv[k] = *(const u32x4*)(gp0 + k * 1024 + (size_t)128 * 4 * 65536); }
        asm volatile("" ::: "memory");
#pragma unroll
        for (int ai = 0; ai < 2; ++ai)
#pragma unroll
            for (int m = 0; m < 4; ++m) { const u32x4 gn = gnv[ai * 4 + m], gd = gdv[ai * 4 + m];
#pragma unroll
                for (int bj = 0; bj < 2; ++bj)
#pragma unroll
                    for (int n = 0; n < 2; ++n) { const unsigned wn = gn[bj * 2 + n], wd = gd[bj * 2 + n];
#pragma unroll
                        for (int j = 0; j < 4; ++j) acc[ai][bj][m][n][j] *= (float)((wn >> (8 * j)) & 0xffu) * __builtin_amdgcn_rcpf((float)((wd >> (8 * j)) & 0xffu)); } }
    }
    __device__ __forceinline__ void operator()(AccRef acc, const Unit& u, int wr, int wc, int fr, int fq) const {
        int z = 0; asm volatile("" : "+v"(z));
        const size_t off0 = (size_t)(u.pm * BM + wr * 64 + fr + z) * 1024 + u.pn * BM + wc * 64 + 8 * fq;
        const unsigned char* gp0 = (const unsigned char*)GT + ((size_t)(2 * 128 + u.pm) * 4 + u.pn) * 65536 + (size_t)((wr * 4 + wc) * 8 * 64 + (fq * 16 + fr) + z) * 16;
        u32x4 g4v[8];
#pragma unroll
        for (int k = 0; k < 8; ++k) g4v[k] = *(const u32x4*)(gp0 + k * 1024);
        asm volatile("" ::: "memory");
#pragma unroll
        for (int ai = 0; ai < 2; ++ai)
#pragma unroll
            for (int m = 0; m < 4; ++m) { const size_t ro = off0 + (size_t)(ai * HALF + m * 16) * 1024;
                const u32x4 g4 = g4v[ai * 4 + m];
#pragma unroll
                for (int bj = 0; bj < 2; ++bj) { const unsigned gx = g4[bj * 2], gy = g4[bj * 2 + 1];
                    f32x4 ga, gb;
#pragma unroll
                    for (int j = 0; j < 4; ++j) { ga[j] = (float)((gx >> (8 * j)) & 0xffu) * (1.0f / 255.0f); gb[j] = (float)((gy >> (8 * j)) & 0xffu) * (1.0f / 255.0f); }
                    store8(MB + ro + 32 * bj, acc[ai][bj][m][0] * ga, acc[ai][bj][m][1] * gb); } }
    }
};
struct EpiPlain {
    static constexpr bool HAS_MID = false; static constexpr bool HAS_PRE = false;
    bf16_t* Z; int ldz;
    __device__ __forceinline__ void operator()(AccRef acc, const Unit& u, int wr, int wc, int fr, int fq) const {
        const int row0 = u.pm * BM + wr * 64 + fr, col0 = u.pn * BM + wc * 64 + 8 * fq;
#pragma unroll
        for (int ai = 0; ai < 2; ++ai)
#pragma unroll
            for (int m = 0; m < 4; ++m) { bf16_t* rowp = Z + (size_t)(row0 + ai * HALF + m * 16) * ldz + col0;
                store8(rowp, acc[ai][0][m][0], acc[ai][0][m][1]); store8(rowp + 32, acc[ai][1][m][0], acc[ai][1][m][1]); }
    }
};
}

namespace attn_body {
using bf16 = __hip_bfloat16;
using s16x4 = __attribute__((ext_vector_type(4))) short;
constexpr int NW = 8, QBLK = 32, QB = QBLK * NW, KVBLK = 64, D = 64;
__device__ __forceinline__ int crow(int r, int hi) { return (r & 3) + 8 * (r >> 2) + 4 * hi; }
#define SBAR() __builtin_amdgcn_sched_barrier(0)
constexpr int NSLOT = 3, SLOTB = 8192;
constexpr int LDS_K = 0, LDS_V = NSLOT * SLOTB, LDS_WS = 2 * NSLOT * SLOTB, LDS_OST = LDS_WS + NW * 64 * 4, LDS_BYTES = LDS_OST + NW * 4096;
__device__ __forceinline__ void glds16(const void* gsrc, unsigned lds_dst) { unsigned keep;
    asm volatile("s_mov_b32 %0, m0\n\ts_mov_b32 m0, %2\n\ts_nop 0\n\tglobal_load_lds_dwordx4 %1, off\n\ts_mov_b32 m0, %0" : "=&s"(keep) : "v"(gsrc), "s"(lds_dst) : "memory"); }
__device__ __forceinline__ float max3f(float a, float b, float c) { float r; asm("v_max3_f32 %0, %1, %2, %3" : "=v"(r) : "v"(a), "v"(b), "v"(c)); return r; }
__device__ __forceinline__ float max2f(float a, float b) { float r; asm("v_max_f32_e32 %0, %1, %2" : "=v"(r) : "v"(a), "v"(b)); return r; }
__device__ __forceinline__ float fadd_s(float a, float b) { float r; asm("v_add_f32_e32 %0, %1, %2" : "=v"(r) : "v"(a), "v"(b)); return r; }
__device__ __forceinline__ float fsub_s(float a, float b) { float r; asm("v_sub_f32_e32 %0, %1, %2" : "=v"(r) : "v"(a), "v"(b)); return r; }
typedef float f32x2_t __attribute__((ext_vector_type(2))); typedef __bf16 bf16x2_t __attribute__((ext_vector_type(2)));
__device__ __forceinline__ unsigned cvtpk_s(float lo, float hi) { f32x2_t v = {lo, hi}; bf16x2_t b = __builtin_convertvector(v, bf16x2_t); return __builtin_bit_cast(unsigned, b); }
#define WAIT_BAR(N) asm volatile("s_waitcnt vmcnt(" #N ") lgkmcnt(0)\n\ts_barrier" ::: "memory")

__device__ __forceinline__ void qkt(f32x16& p0, f32x16& p1, const char* Kslot, const bf16x8* qr, const f32x16& negm, int r32, int hi) {
    const char* kb = Kslot + hi * 1024 + r32 * 16;
#pragma unroll
    for (int d0 = 0; d0 < 4; ++d0) {
        const bf16x8 b0 = *reinterpret_cast<const bf16x8*>(kb + d0 * 2048);
        const bf16x8 b1 = *reinterpret_cast<const bf16x8*>(kb + d0 * 2048 + 512);
        if (d0 == 0) { p0 = __builtin_amdgcn_mfma_f32_32x32x16_bf16(b0, qr[0], negm, 0, 0, 0); p1 = __builtin_amdgcn_mfma_f32_32x32x16_bf16(b1, qr[0], negm, 0, 0, 0); }
        else { p0 = __builtin_amdgcn_mfma_f32_32x32x16_bf16(b0, qr[d0], p0, 0, 0, 0); p1 = __builtin_amdgcn_mfma_f32_32x32x16_bf16(b1, qr[d0], p1, 0, 0, 0); } }
}
typedef __attribute__((address_space(3))) const char* lds_cptr;
typedef short v4i16_t __attribute__((ext_vector_type(4)));
__device__ __forceinline__ void kload8(bf16x8* kf, lds_cptr kp) {
    kf[0] = *(const __attribute__((address_space(3))) bf16x8*)(kp);        kf[1] = *(const __attribute__((address_space(3))) bf16x8*)(kp + 512);
    kf[2] = *(const __attribute__((address_space(3))) bf16x8*)(kp + 2048); kf[3] = *(const __attribute__((address_space(3))) bf16x8*)(kp + 2560);
    kf[4] = *(const __attribute__((address_space(3))) bf16x8*)(kp + 4096); kf[5] = *(const __attribute__((address_space(3))) bf16x8*)(kp + 4608);
    kf[6] = *(const __attribute__((address_space(3))) bf16x8*)(kp + 6144); kf[7] = *(const __attribute__((address_space(3))) bf16x8*)(kp + 6656);
}
__device__ __forceinline__ void kload2(bf16x8* kf, lds_cptr kp, int j) { kf[2 * j] = *(const __attribute__((address_space(3))) bf16x8*)(kp + j * 2048); kf[2 * j + 1] = *(const __attribute__((address_space(3))) bf16x8*)(kp + j * 2048 + 512); }
__device__ __forceinline__ s16x4 vtr(lds_cptr p) { return __builtin_bit_cast(s16x4, __builtin_amdgcn_ds_read_tr16_b64_v4i16((__attribute__((address_space(3))) v4i16_t*)p)); }
__device__ __forceinline__ float rowmax(const f32x16& p0, const f32x16& p1) {
    float a = max3f(p0[0], p0[1], p1[0]), b = max3f(p0[2], p0[3], p1[1]); a = max3f(a, p1[2], p1[3]);
#pragma unroll
    for (int r = 4; r < 16; r += 4) { a = max3f(a, p0[r], p0[r + 1]); b = max3f(b, p0[r + 2], p0[r + 3]); a = max3f(a, p1[r], p1[r + 1]); b = max3f(b, p1[r + 2], p1[r + 3]); }
    const float m = max2f(a, b);
    auto rr = __builtin_amdgcn_permlane32_swap(__float_as_uint(m), __float_as_uint(m), false, false);
    return max2f(__uint_as_float(rr[0]), __uint_as_float(rr[1]));
}
__device__ __forceinline__ void pv(f32x16* o, int vb, bf16x8 pa0, bf16x8 pa1, bf16x8 pa2, bf16x8 pa3) {
#pragma unroll
    for (int d0 = 0; d0 < 2; ++d0) { s16x4 lo[4], hi[4];
#pragma unroll
        for (int ks = 0; ks < 4; ++ks) {
            asm volatile("ds_read_b64_tr_b16 %0,%1 offset:%c2" : "=&v"(lo[ks]) : "v"(vb), "i"(d0 * 4096 + ks * 1024) : "memory");
            asm volatile("ds_read_b64_tr_b16 %0,%1 offset:%c2" : "=&v"(hi[ks]) : "v"(vb), "i"(d0 * 4096 + ks * 1024 + 512) : "memory"); }
        asm volatile("s_waitcnt lgkmcnt(0)" ::: "memory"); SBAR();
#define PK(k) (bf16x8){lo[k][0], lo[k][1], lo[k][2], lo[k][3], hi[k][0], hi[k][1], hi[k][2], hi[k][3]}
        o[d0] = __builtin_amdgcn_mfma_f32_32x32x16_bf16(pa0, PK(0), o[d0], 0, 0, 0);
        o[d0] = __builtin_amdgcn_mfma_f32_32x32x16_bf16(pa1, PK(1), o[d0], 0, 0, 0);
        o[d0] = __builtin_amdgcn_mfma_f32_32x32x16_bf16(pa2, PK(2), o[d0], 0, 0, 0);
        o[d0] = __builtin_amdgcn_mfma_f32_32x32x16_bf16(pa3, PK(3), o[d0], 0, 0, 0);
#undef PK
    }
}
__device__ __forceinline__ void cmask(f32x16& p0, f32x16& p1, int jb, int wid) {
    if (jb > (wid >> 1)) {
#pragma unroll
        for (int r = 0; r < 16; ++r) { p0[r] = -INFINITY; p1[r] = -INFINITY; } }
}
template <int THRL, bool MASK> __device__ __forceinline__ void attn_unit(int q0, int NT, const bf16* Qh, int qp, const bf16* __restrict__ Kh, int kp, const bf16* __restrict__ Vh, int vp, bf16* Oh, int op, char* shm) {
    const int tid = threadIdx.x, lane = tid & 63, r32 = lane & 31, hi = lane >> 5; const int wid = __builtin_amdgcn_readfirstlane(tid >> 6);
    const bf16* Qw = Qh + (long)(q0 + wid * QBLK) * qp;
    const unsigned lds0 = (unsigned)(uintptr_t)shm;
    float* wsf = (float*)(shm + LDS_WS) + wid * 64;
    const bf16* ksrc = Kh + (long)lane * kp + wid * 8;
    const bf16* vsrc = Vh + (long)(16 * (wid & 3) + (lane >> 2)) * vp + (wid >> 2) * 32 + (lane & 3) * 8;
    const unsigned kdst = lds0 + LDS_K + wid * 1024, vdst = lds0 + LDS_V + wid * 1024;
#define DMA_K(t, slot) glds16(ksrc + (long)(t) * KVBLK * kp, (unsigned)__builtin_amdgcn_readfirstlane(kdst + (slot)))
#define DMA_V(t, slot) glds16(vsrc + (long)(t) * KVBLK * vp, (unsigned)__builtin_amdgcn_readfirstlane(vdst + (slot)))
    const int vb0 = (int)(lds0 + LDS_V) + ((lane >> 4) & 1) * 32 + (lane & 3) * 8 + (4 * hi + ((lane & 15) >> 2)) * 64;
    const char* Kbase = shm + LDS_K; bf16x8 kf[8];
    const lds_cptr shm3 = (lds_cptr)shm; const lds_cptr kp0 = shm3 + LDS_K + hi * 1024 + r32 * 16; const lds_cptr vp0 = shm3 + LDS_V + ((lane >> 4) & 1) * 32 + (lane & 3) * 8 + (4 * hi + ((lane & 15) >> 2)) * 64;
    DMA_K(0, 0); DMA_V(0, 0); DMA_K(1, SLOTB);
    bf16x8 qr[4];
#pragma unroll
    for (int d0 = 0; d0 < 4; ++d0) qr[d0] = *reinterpret_cast<const bf16x8*>(&Qw[(long)r32 * qp + d0 * 16 + hi * 8]);
    float mhat = 0.f, l_reg = 0.f; f32x16 o[2]; o[0] = f32x16{}; o[1] = f32x16{}; f32x16 negm = f32x16{}; asm volatile("" : "+v"(negm));
#define CMASK(P0, P1, t) do { if (MASK) { int jb_ = (t) - (NT - 4); if (jb_ >= 0) cmask(P0, P1, jb_, wid); } } while (0)
    bool resc = false;
#define START(P0, P1) do { const float rm = rowmax(P0, P1); resc = false; \
    { const float dl = rm; mhat = fadd_s(mhat, dl); \
      _Pragma("unroll") for (int r = 0; r < 16; ++r) { P0[r] = fsub_s(P0[r], dl); P1[r] = fsub_s(P1[r], dl); } \
      _Pragma("unroll") for (int r = 0; r < 16; ++r) negm[r] = -mhat; asm volatile("" : "+v"(negm)); } \
    _Pragma("unroll") for (int r = 0; r < 16; ++r) P0[r] = __builtin_amdgcn_exp2f(P0[r]); } while (0)
#define RESC() do { if (resc) { asm volatile("s_waitcnt lgkmcnt(0)" ::: "memory"); \
      _Pragma("unroll") for (int d_ = 0; d_ < 2; ++d_) _Pragma("unroll") for (int r = 0; r < 16; ++r) o[d_][r] *= wsf[crow(r, hi)]; } } while (0)
    f32x16 pA0, pA1, pB0, pB1;
    int sl_prev = 0, sl_cur = 0, sl_next = SLOTB;
#define ROT() do { sl_prev = sl_cur; sl_cur = sl_next; sl_next = (sl_next == (NSLOT - 1) * SLOTB) ? 0 : sl_next + SLOTB; } while (0)
    DMA_K(2, 2 * SLOTB);
    WAIT_BAR(3);
    qkt(pA0, pA1, Kbase, qr, negm, r32, hi); asm volatile("s_nop 15\n\ts_nop 7" : "+v"(pA0), "+v"(pA1)); CMASK(pA0, pA1, 0);
    START(pA0, pA1);
    _Pragma("unroll") for (int r = 0; r < 16; ++r) pA1[r] = __builtin_amdgcn_exp2f(pA1[r]);
    WAIT_BAR(0);
    DMA_K(3, 0); DMA_V(1, SLOTB);
    ROT();
    kload8(kf, kp0 + sl_cur);
    WAIT_BAR(2);
    s16x4 vlo[8], vhi[8]; u32x4 pw0, pw1, pw2, pw3;
#define PKW(P, B) cvtpk_s(P[B], P[B + 1])
#define PAF(k) __builtin_bit_cast(bf16x8, pw##k)
#define VFR(i) (bf16x8){vlo[i][0], vlo[i][1], vlo[i][2], vlo[i][3], vhi[i][0], vhi[i][1], vhi[i][2], vhi[i][3]}
#define PIN(x) asm volatile("" : "+v"(x))
#define MX3(a, b, c) __builtin_fmaxf(__builtin_fmaxf((a), (b)), (c))
#define GAPA(MF, A0, A1, A2, A3, W0, W1, PW) do { MF; sacc += A0; sacc += A1; sacc += A2; sacc += A3; PIN(sacc); W0; W1; PIN(PW); SBAR(); } while (0)
#define EX(v) __builtin_amdgcn_exp2f(v)
#define GAPB(MF, X, B) do { MF; X[B] = EX(X[B]); X[B + 1] = EX(X[B + 1]); X[B + 2] = EX(X[B + 2]); X[B + 3] = EX(X[B + 3]); PIN(X); SBAR(); } while (0)
#define VRD(i) do { vlo[i] = vtr(vp_ + (((i) >> 2) * 4096 + ((i) & 3) * 1024)); vhi[i] = vtr(vp_ + (((i) >> 2) * 4096 + ((i) & 3) * 1024 + 512)); } while (0)
#define KRD(G, j) do { if (G) { kload2(kf, kp0 + sl_next, j); SBAR(); } } while (0)
#define STEP(C0, C1, P0, P1, t, GK, GV, GL) do { SBAR(); \
    const lds_cptr vp_ = vp0 + sl_prev; \
    VRD(0); SBAR(); float sacc = (P0[0] + P0[1]); \
    GAPA(C0 = __builtin_amdgcn_mfma_f32_32x32x16_bf16(kf[0], qr[0], negm, 0, 0, 0), P0[2], P0[3], P0[4], P0[5],     pw0[0] = PKW(P0, 0), pw0[1] = PKW(P0, 2), pw0); \
    VRD(4); SBAR(); GAPA(C1 = __builtin_amdgcn_mfma_f32_32x32x16_bf16(kf[1], qr[0], negm, 0, 0, 0), P0[6], P0[7], P0[8], P0[9],     pw0[2] = PKW(P0, 4), pw0[3] = PKW(P0, 6), pw0); \
    VRD(1); SBAR(); GAPA(C0 = __builtin_amdgcn_mfma_f32_32x32x16_bf16(kf[2], qr[1], C0, 0, 0, 0),   P0[10], P0[11], P0[12], P0[13], pw1[0] = PKW(P0, 8), pw1[1] = PKW(P0, 10), pw1); \
    VRD(5); SBAR(); GAPA(C1 = __builtin_amdgcn_mfma_f32_32x32x16_bf16(kf[3], qr[1], C1, 0, 0, 0),   P0[14], P0[15], P1[0], P1[1],   pw1[2] = PKW(P0, 12), pw1[3] = PKW(P0, 14), pw1); \
    VRD(2); SBAR(); GAPA(C0 = __builtin_amdgcn_mfma_f32_32x32x16_bf16(kf[4], qr[2], C0, 0, 0, 0),   P1[2], P1[3], P1[4], P1[5],     pw2[0] = PKW(P1, 0), pw2[1] = PKW(P1, 2), pw2); \
    VRD(6); SBAR(); GAPA(C1 = __builtin_amdgcn_mfma_f32_32x32x16_bf16(kf[5], qr[2], C1, 0, 0, 0),   P1[6], P1[7], P1[8], P1[9],     pw2[2] = PKW(P1, 4), pw2[3] = PKW(P1, 6), pw2); \
    VRD(3); SBAR(); GAPA(C0 = __builtin_amdgcn_mfma_f32_32x32x16_bf16(kf[6], qr[3], C0, 0, 0, 0),   P1[10], P1[11], P1[12], P1[13], pw3[0] = PKW(P1, 8), pw3[1] = PKW(P1, 10), pw3); \
    VRD(7); SBAR(); GAPA(C1 = __builtin_amdgcn_mfma_f32_32x32x16_bf16(kf[7], qr[3], C1, 0, 0, 0),   P1[14], P1[15], 0.f, 0.f,       pw3[2] = PKW(P1, 12), pw3[3] = PKW(P1, 14), pw3); \
    l_reg += sacc; \
    if (GK) { DMA_K((t) + 3, sl_cur); } if (GV) { DMA_V((t) + 1, sl_next); } \
    CMASK(C0, C1, t); \
    { float a = MX3(C0[0], C0[1], C1[0]), b = MX3(C0[2], C0[3], C1[1]); a = MX3(a, C1[2], C1[3]); \
      _Pragma("unroll") for (int r = 4; r < 16; r += 4) { a = MX3(a, C0[r], C0[r + 1]); b = MX3(b, C0[r + 2], C0[r + 3]); a = MX3(a, C1[r], C1[r + 1]); b = MX3(b, C1[r + 2], C1[r + 3]); } \
      float rm = __builtin_fmaxf(a, b); { auto rr = __builtin_amdgcn_permlane32_swap(__float_as_uint(rm), __float_as_uint(rm), false, false); rm = __builtin_fmaxf(__uint_as_float(rr[0]), __uint_as_float(rr[1])); } \
      resc = false; \
      if (__builtin_expect(__any(rm > (float)THRL), 0)) { const float dl = __builtin_fmaxf(rm, 0.f); mhat += dl; \
        _Pragma("unroll") for (int r = 0; r < 16; ++r) { C0[r] -= dl; C1[r] -= dl; } \
        _Pragma("unroll") for (int r = 0; r < 16; ++r) negm[r] = -mhat; asm volatile("" : "+v"(negm)); \
        const float f = __builtin_amdgcn_exp2f(-dl); l_reg *= f; if (hi == 0) wsf[r32] = f; resc = true; } } \
    SBAR(); \
    GAPB(o[0] = __builtin_amdgcn_mfma_f32_32x32x16_bf16(PAF(0), VFR(0), o[0], 0, 0, 0), C0, 0); \
    GAPB(o[1] = __builtin_amdgcn_mfma_f32_32x32x16_bf16(PAF(0), VFR(4), o[1], 0, 0, 0), C0, 4); \
    KRD(GL, 0); GAPB(o[0] = __builtin_amdgcn_mfma_f32_32x32x16_bf16(PAF(1), VFR(1), o[0], 0, 0, 0), C0, 8); \
    KRD(GL, 1); GAPB(o[1] = __builtin_amdgcn_mfma_f32_32x32x16_bf16(PAF(1), VFR(5), o[1], 0, 0, 0), C0, 12); \
    KRD(GL, 2); GAPB(o[0] = __builtin_amdgcn_mfma_f32_32x32x16_bf16(PAF(2), VFR(2), o[0], 0, 0, 0), C1, 0); \
    KRD(GL, 3); GAPB(o[1] = __builtin_amdgcn_mfma_f32_32x32x16_bf16(PAF(2), VFR(6), o[1], 0, 0, 0), C1, 4); \
    GAPB(o[0] = __builtin_amdgcn_mfma_f32_32x32x16_bf16(PAF(3), VFR(3), o[0], 0, 0, 0), C1, 8); \
    GAPB(o[1] = __builtin_amdgcn_mfma_f32_32x32x16_bf16(PAF(3), VFR(7), o[1], 0, 0, 0), C1, 12); \
    } while (0)
    int t = 1;
#undef CMASK
#define CMASK(P0, P1, t) do {} while (0)
    for (; t + 5 < NT; t += 2) {
        STEP(pB0, pB1, pA0, pA1, t, true, true, true);     WAIT_BAR(2); RESC(); ROT();
        STEP(pA0, pA1, pB0, pB1, t + 1, true, true, true); WAIT_BAR(2); RESC(); ROT();
    }
#undef CMASK
#define CMASK(P0, P1, t) do { if (MASK) { int jb_ = (t) - (NT - 4); if (jb_ >= 0) cmask(P0, P1, jb_, wid); } } while (0)
#define ENDW(tt) do { if ((tt) + 3 < NT) { WAIT_BAR(2); } else if ((tt) + 2 < NT) { WAIT_BAR(1); } else { WAIT_BAR(0); } } while (0)
    for (; t + 1 < NT; t += 2) {
        STEP(pB0, pB1, pA0, pA1, t, (t + 3 < NT), (t + 1 < NT), (t + 1 < NT));       ENDW(t);     RESC(); ROT();
        STEP(pA0, pA1, pB0, pB1, t + 1, (t + 4 < NT), (t + 2 < NT), (t + 2 < NT));   ENDW(t + 1); RESC(); ROT();
    }
    STEP(pB0, pB1, pA0, pA1, NT - 1, false, false, false); RESC();
    { float sacc = pB0[0] + pB0[1]; _Pragma("unroll") for (int r = 2; r < 16; ++r) sacc += pB0[r]; _Pragma("unroll") for (int r = 0; r < 16; ++r) sacc += pB1[r]; l_reg += sacc;
      pw0 = (u32x4){PKW(pB0, 0), PKW(pB0, 2), PKW(pB0, 4), PKW(pB0, 6)}; pw1 = (u32x4){PKW(pB0, 8), PKW(pB0, 10), PKW(pB0, 12), PKW(pB0, 14)}; pw2 = (u32x4){PKW(pB1, 0), PKW(pB1, 2), PKW(pB1, 4), PKW(pB1, 6)}; pw3 = (u32x4){PKW(pB1, 8), PKW(pB1, 10), PKW(pB1, 12), PKW(pB1, 14)};
      SBAR(); pv(o, vb0 + sl_cur, PAF(0), PAF(1), PAF(2), PAF(3)); }
#undef PKW
#undef PAF
#undef VFR
#undef PIN
#undef MX3
#undef GAPA
#undef GAPB
#undef EX
#undef VRD
#undef KRD
#undef STEP
#undef ENDW
    { auto rr = __builtin_amdgcn_permlane32_swap(__float_as_uint(l_reg), __float_as_uint(l_reg), false, false); l_reg = __uint_as_float(rr[0]) + __uint_as_float(rr[1]); }
    if (hi == 0) wsf[32 + r32] = l_reg; asm volatile("s_waitcnt lgkmcnt(0)" ::: "memory");
    float rli[16];
#pragma unroll
    for (int r = 0; r < 16; ++r) rli[r] = __builtin_amdgcn_rcpf(wsf[32 + crow(r, hi)]);
    bf16* Ow = Oh + (long)(q0 + wid * QBLK) * op;
    { bf16* stg = (bf16*)(shm + LDS_OST) + wid * 2048;
#pragma unroll
      for (int r = 0; r < 16; ++r) { const int orow = crow(r, hi);
#pragma unroll
        for (int d0 = 0; d0 < 2; ++d0) stg[orow * 64 + d0 * 32 + r32] = __float2bfloat16(o[d0][r] * rli[r]); }
      asm volatile("s_waitcnt lgkmcnt(0)" ::: "memory");
#pragma unroll
      for (int i = 0; i < 4; ++i) { const int row = i * 8 + (lane >> 3), ch = lane & 7; const u32x4 v = *(const u32x4*)(stg + row * 64 + ch * 8); *(u32x4*)(Ow + (long)row * op + ch * 8) = v; } }
    asm volatile("s_waitcnt lgkmcnt(0)\n\ts_barrier" ::: "memory");
#undef DMA_K
#undef DMA_V
#undef CMASK
#undef START
#undef RESC
#undef ROT
}

constexpr int L2_K = 0, L2_V = 3 * 8192, L2_WS = L2_V + 4 * 16384, L2_OST = L2_WS + NW * 64 * 4, L2_BYTES = L2_OST + NW * 4096;
template <bool MASK> __device__ __forceinline__ void attn_unit2(int q0, int NT, const bf16* Qh, int qp, const bf16* __restrict__ Kh, int kp, const bf16* __restrict__ Vh, int vp, bf16* Oh, int op, char* shm) {
    const int tid = threadIdx.x, lane = tid & 63, r32 = lane & 31, hi = lane >> 5; const int wid = __builtin_amdgcn_readfirstlane(tid >> 6);
    const bf16* Qw = Qh + (long)(q0 + wid * QBLK) * qp;
    const unsigned lds0 = (unsigned)(uintptr_t)shm;
    float* wsf = (float*)(shm + L2_WS) + wid * 64;
    const bf16* ksrc = Kh + (long)lane * kp + wid * 8;
    const bf16* vsrc = Vh + (long)(16 * (wid & 3) + (lane >> 2)) * vp + (wid >> 2) * 32 + (lane & 3) * 8;
    const unsigned kdst = lds0 + L2_K + wid * 1024, vdst = lds0 + L2_V + wid * 1024;
#define DMA_K(t, slot) glds16(ksrc + (long)(t) * KVBLK * kp, (unsigned)__builtin_amdgcn_readfirstlane(kdst + (slot)))
#define DMA_V(t, vslot) do { glds16(vsrc + (long)(t) * KVBLK * vp, (unsigned)__builtin_amdgcn_readfirstlane(vdst + (vslot))); \
                            glds16(vsrc + (long)(t) * KVBLK * vp + 64, (unsigned)__builtin_amdgcn_readfirstlane(vdst + (vslot) + 8192)); } while (0)
    const int vb0 = (int)(lds0 + L2_V) + ((lane >> 4) & 1) * 32 + (lane & 3) * 8 + (4 * hi + ((lane & 15) >> 2)) * 64;
    const char* Kbase = shm + L2_K; bf16x8 kf[8];
    const lds_cptr shm3 = (lds_cptr)shm; const lds_cptr kp0 = shm3 + L2_K + hi * 1024 + r32 * 16; const lds_cptr vp0 = shm3 + L2_V + ((lane >> 4) & 1) * 32 + (lane & 3) * 8 + (4 * hi + ((lane & 15) >> 2)) * 64;
    DMA_K(0, 0); DMA_V(0, 0); DMA_K(1, SLOTB);
    bf16x8 qr[4];
#pragma unroll
    for (int d0 = 0; d0 < 4; ++d0) qr[d0] = *reinterpret_cast<const bf16x8*>(&Qw[(long)r32 * qp + d0 * 16 + hi * 8]);
    float l_reg = 0.f; f32x16 o[4]; o[0] = f32x16{}; o[1] = f32x16{}; o[2] = f32x16{}; o[3] = f32x16{};
    const f32x16 zero16 = f32x16{};
#define CMASK(P0, P1, t) do { if (MASK) { int jb_ = (t) - (NT - 4); if (jb_ >= 0) cmask(P0, P1, jb_, wid); } } while (0)
    f32x16 pA0, pA1, pB0, pB1;
    int sl_prev = 0, sl_cur = 0, sl_next = SLOTB;
    int vs_rd = 0, vs_wr = 3 * 16384;
#define ROT() do { sl_prev = sl_cur; sl_cur = sl_next; sl_next = (sl_next == (NSLOT - 1) * SLOTB) ? 0 : sl_next + SLOTB; vs_rd = (vs_rd + 16384) & 65535; vs_wr = (vs_wr + 16384) & 65535; } while (0)
    DMA_K(2, 2 * SLOTB); DMA_V(1, 16384);
    WAIT_BAR(6);
    qkt(pA0, pA1, Kbase, qr, zero16, r32, hi); CMASK(pA0, pA1, 0);
    _Pragma("unroll") for (int r = 0; r < 16; ++r) { pA0[r] = __builtin_amdgcn_exp2f(pA0[r]); pA1[r] = __builtin_amdgcn_exp2f(pA1[r]); }
    WAIT_BAR(2);
    DMA_K(3, 0); DMA_V(2, 2 * 16384);
    sl_prev = sl_cur; sl_cur = sl_next; sl_next = 2 * SLOTB;
    kload8(kf, kp0 + sl_cur);
    WAIT_BAR(5);
    s16x4 f0lo, f0hi, f1lo, f1hi, f2lo, f2hi, f3lo, f3hi; u32x4 pw0, pw1, pw2, pw3;
#define PKW(P, B) cvtpk_s(P[B], P[B + 1])
#define PAF(k) __builtin_bit_cast(bf16x8, pw##k)
#define PIN(x) asm volatile("" : "+v"(x))
#define EX(v) __builtin_amdgcn_exp2f(v)
#define VOFF(id) ((((id) >> 2) * 4096) + (((id) & 3) * 1024))
#define VRD2(F, id) do { F##lo = vtr(vp_ + VOFF(id)); F##hi = vtr(vp_ + VOFF(id) + 512); } while (0)
#define VFR2(F) (bf16x8){F##lo[0], F##lo[1], F##lo[2], F##lo[3], F##hi[0], F##hi[1], F##hi[2], F##hi[3]}
#define GAPA(MF, A0, A1, A2, A3, W0, W1, PW) do { MF; sacc += A0; sacc += A1; sacc += A2; sacc += A3; PIN(sacc); W0; W1; PIN(PW); SBAR(); } while (0)
#define GAPB(MF, RD, X, B) do { MF; RD; X[B] = EX(X[B]); X[B + 1] = EX(X[B + 1]); PIN(X); SBAR(); } while (0)
#define KRD(G, j) do { if (G) { kload2(kf, kp0 + sl_next, j); SBAR(); } } while (0)
#define MF32(a, b, c) __builtin_amdgcn_mfma_f32_32x32x16_bf16(a, b, c, 0, 0, 0)
#define STEP(C0, C1, P0, P1, t, GK, GV, GL) do { SBAR(); __builtin_amdgcn_s_setprio(ATTN_PRIO_A); \
    const lds_cptr vp_ = vp0 + vs_rd; \
    float sacc = (P0[0] + P0[1]); \
    GAPA(C0 = MF32(kf[0], qr[0], zero16), P0[2], P0[3], P0[4], P0[5],     pw0[0] = PKW(P0, 0), pw0[1] = PKW(P0, 2), pw0); \
    GAPA(C1 = MF32(kf[1], qr[0], zero16), P0[6], P0[7], P0[8], P0[9],     pw0[2] = PKW(P0, 4), pw0[3] = PKW(P0, 6), pw0); \
    GAPA(C0 = MF32(kf[2], qr[1], C0),     P0[10], P0[11], P0[12], P0[13], pw1[0] = PKW(P0, 8), pw1[1] = PKW(P0, 10), pw1); \
    GAPA(C1 = MF32(kf[3], qr[1], C1),     P0[14], P0[15], P1[0], P1[1],   pw1[2] = PKW(P0, 12), pw1[3] = PKW(P0, 14), pw1); \
    VRD2(f0, 0); SBAR();  GAPA(C0 = MF32(kf[4], qr[2], C0), P1[2], P1[3], P1[4], P1[5],     pw2[0] = PKW(P1, 0), pw2[1] = PKW(P1, 2), pw2); \
    VRD2(f1, 4); SBAR();  GAPA(C1 = MF32(kf[5], qr[2], C1), P1[6], P1[7], P1[8], P1[9],     pw2[2] = PKW(P1, 4), pw2[3] = PKW(P1, 6), pw2); \
    VRD2(f2, 8); SBAR();  GAPA(C0 = MF32(kf[6], qr[3], C0), P1[10], P1[11], P1[12], P1[13], pw3[0] = PKW(P1, 8), pw3[1] = PKW(P1, 10), pw3); \
    VRD2(f3, 12); SBAR(); GAPA(C1 = MF32(kf[7], qr[3], C1), P1[14], P1[15], 0.f, 0.f,       pw3[2] = PKW(P1, 12), pw3[3] = PKW(P1, 14), pw3); \
    l_reg += sacc; __builtin_amdgcn_s_setprio(0); \
    if (GK) { DMA_K((t) + 3, sl_cur); } if (GV) { DMA_V((t) + 2, vs_wr); } \
    CMASK(C0, C1, t); \
    SBAR(); __builtin_amdgcn_s_setprio(ATTN_PRIO_B); \
    GAPB(o[0] = MF32(PAF(0), VFR2(f0), o[0]), VRD2(f0, 1),  C0, 0); \
    GAPB(o[1] = MF32(PAF(0), VFR2(f1), o[1]), VRD2(f1, 5),  C0, 2); \
    GAPB(o[2] = MF32(PAF(0), VFR2(f2), o[2]), VRD2(f2, 9),  C0, 4); \
    GAPB(o[3] = MF32(PAF(0), VFR2(f3), o[3]), VRD2(f3, 13), C0, 6); \
    KRD(GL, 0); GAPB(o[0] = MF32(PAF(1), VFR2(f0), o[0]), VRD2(f0, 2),  C0, 8); \
    GAPB(o[1] = MF32(PAF(1), VFR2(f1), o[1]), VRD2(f1, 6),  C0, 10); \
    KRD(GL, 1); GAPB(o[2] = MF32(PAF(1), VFR2(f2), o[2]), VRD2(f2, 10), C0, 12); \
    GAPB(o[3] = MF32(PAF(1), VFR2(f3), o[3]), VRD2(f3, 14), C0, 14); \
    KRD(GL, 2); GAPB(o[0] = MF32(PAF(2), VFR2(f0), o[0]), VRD2(f0, 3),  C1, 0); \
    GAPB(o[1] = MF32(PAF(2), VFR2(f1), o[1]), VRD2(f1, 7),  C1, 2); \
    KRD(GL, 3); GAPB(o[2] = MF32(PAF(2), VFR2(f2), o[2]), VRD2(f2, 11), C1, 4); \
    GAPB(o[3] = MF32(PAF(2), VFR2(f3), o[3]), VRD2(f3, 15), C1, 6); \
    GAPB(o[0] = MF32(PAF(3), VFR2(f0), o[0]), (void)0, C1, 8); \
    GAPB(o[1] = MF32(PAF(3), VFR2(f1), o[1]), (void)0, C1, 10); \
    GAPB(o[2] = MF32(PAF(3), VFR2(f2), o[2]), (void)0, C1, 12); \
    GAPB(o[3] = MF32(PAF(3), VFR2(f3), o[3]), (void)0, C1, 14); __builtin_amdgcn_s_setprio(0); \
    } while (0)
    int t = 1;
#undef CMASK
#define CMASK(P0, P1, t) do {} while (0)
    for (; t + 5 < NT; t += 2) {
        STEP(pB0, pB1, pA0, pA1, t, true, true, true);     WAIT_BAR(5); ROT();
        STEP(pA0, pA1, pB0, pB1, t + 1, true, true, true); WAIT_BAR(5); ROT();
    }
#undef CMASK
#define CMASK(P0, P1, t) do { if (MASK) { int jb_ = (t) - (NT - 4); if (jb_ >= 0) cmask(P0, P1, jb_, wid); } } while (0)
#define ENDW(tt) do { if ((tt) + 3 < NT) { WAIT_BAR(5); } else if ((tt) + 2 < NT) { WAIT_BAR(4); } else { WAIT_BAR(0); } } while (0)
    for (; t + 1 < NT; t += 2) {
        STEP(pB0, pB1, pA0, pA1, t, (t + 3 < NT), (t + 2 < NT), (t + 1 < NT));       ENDW(t);     ROT();
        STEP(pA0, pA1, pB0, pB1, t + 1, (t + 4 < NT), (t + 3 < NT), (t + 2 < NT));   ENDW(t + 1); ROT();
    }
    STEP(pB0, pB1, pA0, pA1, NT - 1, false, false, false);
    { float sacc = pB0[0] + pB0[1]; _Pragma("unroll") for (int r = 2; r < 16; ++r) sacc += pB0[r]; _Pragma("unroll") for (int r = 0; r < 16; ++r) sacc += pB1[r]; l_reg += sacc;
      pw0 = (u32x4){PKW(pB0, 0), PKW(pB0, 2), PKW(pB0, 4), PKW(pB0, 6)}; pw1 = (u32x4){PKW(pB0, 8), PKW(pB0, 10), PKW(pB0, 12), PKW(pB0, 14)}; pw2 = (u32x4){PKW(pB1, 0), PKW(pB1, 2), PKW(pB1, 4), PKW(pB1, 6)}; pw3 = (u32x4){PKW(pB1, 8), PKW(pB1, 10), PKW(pB1, 12), PKW(pB1, 14)};
      SBAR();
      const lds_cptr vp_ = vp0 + ((vs_rd + 16384) & 65535);
#pragma unroll
      for (int db = 0; db < 4; ++db) { VRD2(f0, db * 4 + 0); VRD2(f1, db * 4 + 1); VRD2(f2, db * 4 + 2); VRD2(f3, db * 4 + 3);
          o[db] = MF32(PAF(0), VFR2(f0), o[db]); o[db] = MF32(PAF(1), VFR2(f1), o[db]); o[db] = MF32(PAF(2), VFR2(f2), o[db]); o[db] = MF32(PAF(3), VFR2(f3), o[db]); } }
#undef PKW
#undef PAF
#undef PIN
#undef EX
#undef VOFF
#undef VRD2
#undef VFR2
#undef GAPA
#undef GAPB
#undef KRD
#undef MF32
#undef STEP
#undef ENDW
    { auto rr = __builtin_amdgcn_permlane32_swap(__float_as_uint(l_reg), __float_as_uint(l_reg), false, false); l_reg = __uint_as_float(rr[0]) + __uint_as_float(rr[1]); }
    if (hi == 0) wsf[32 + r32] = l_reg; asm volatile("s_waitcnt lgkmcnt(0)" ::: "memory");
    float rli[16];
#pragma unroll
    for (int r = 0; r < 16; ++r) rli[r] = __builtin_amdgcn_rcpf(wsf[32 + crow(r, hi)]);
    bf16* Ow = Oh + (long)(q0 + wid * QBLK) * op;
    { bf16* stg = (bf16*)(shm + L2_OST) + wid * 2048;
#pragma unroll
      for (int dh = 0; dh < 2; ++dh) {
#pragma unroll
        for (int r = 0; r < 16; ++r) { const int orow = crow(r, hi);
#pragma unroll
          for (int d0 = 0; d0 < 2; ++d0) stg[orow * 64 + d0 * 32 + r32] = __float2bfloat16(o[dh * 2 + d0][r] * rli[r]); }
        asm volatile("s_waitcnt lgkmcnt(0)" ::: "memory");
#pragma unroll
        for (int i = 0; i < 4; ++i) { const int row = i * 8 + (lane >> 3), ch = lane & 7; const u32x4 v = *(const u32x4*)(stg + row * 64 + ch * 8); *(u32x4*)(Ow + (long)row * op + dh * 64 + ch * 8) = v; }
        asm volatile("s_waitcnt lgkmcnt(0)" ::: "memory"); } }
    asm volatile("s_waitcnt lgkmcnt(0)\n\ts_barrier" ::: "memory");
#undef DMA_K
#undef DMA_V
#undef CMASK
#undef ROT
}
#undef SBAR
#undef WAIT_BAR
}

#define XB_TMO      128
#define XB_XCNT(j)  (256  + 64 * (j))
#define XB_XSUB(j)  (1280 + 64 * (j))
#define XB_XGEN(j)  (2304 + 64 * (j))
#define XB_TOP      3328
#define XB_TOPGEN   3392
#define XCD_BAR_WORDS 3456
#define XB_SPIN_CAP (1u << 22)
__device__ __forceinline__ unsigned xb_ld(unsigned* p)              { return __hip_atomic_load(p, __ATOMIC_RELAXED, __HIP_MEMORY_SCOPE_AGENT); }
__device__ __forceinline__ unsigned xb_add(unsigned* p, unsigned v) { return __hip_atomic_fetch_add(p, v, __ATOMIC_RELAXED, __HIP_MEMORY_SCOPE_AGENT); }
__device__ __forceinline__ unsigned xb_xcc_id() { return (unsigned)__builtin_amdgcn_s_getreg((3 << 11) | 20) & 0xFu; }
#define XB_SPIN(cond, bar) do { unsigned _sp = 0; while (cond) { __builtin_amdgcn_s_sleep(1); \
    if ((++_sp & 255u) == 0u) { if (xb_ld(&(bar)[XB_TMO])) break; if (_sp > XB_SPIN_CAP) { atomicAdd(&(bar)[XB_TMO], 1u); break; } } } } while (0)
struct XcdBarrier { unsigned* bar; unsigned x; volatile LAS unsigned* st; };
__device__ __forceinline__ XcdBarrier xcd_barrier_post(unsigned* bar, volatile LAS unsigned* st) {
    XcdBarrier b; b.bar = bar; b.x = xb_xcc_id(); b.st = st;
    if (threadIdx.x == 0) (void)xb_add(&bar[XB_XCNT(b.x)], 1u);
    return b;
}
__device__ __forceinline__ void xcd_barrier_complete(unsigned* bar, unsigned x, unsigned& nloc, unsigned& nx) {
    const unsigned G = gridDim.x * gridDim.y * gridDim.z;
    unsigned sum, cnt, mine, sp = 0u;
    for (;;) {
        sum = 0u; cnt = 0u; mine = 0u;
#pragma unroll
        for (unsigned j = 0; j < 16; ++j) { const unsigned c = xb_ld(&bar[XB_XCNT(j)]); sum += c; cnt += (c > 0u) ? 1u : 0u; mine = (j == x) ? c : mine; }
        if (sum == G) break;
        __builtin_amdgcn_s_sleep(1);
        if ((++sp & 255u) == 0u) { if (xb_ld(&bar[XB_TMO])) break; if (sp > XB_SPIN_CAP) { atomicAdd(&bar[XB_TMO], 1u); break; } }
    }
    nloc = mine > 0u ? mine : 1u; nx = cnt > 0u ? cnt : 1u;
}
__device__ __forceinline__ void xcd_barrier(const XcdBarrier& b) {
    asm volatile("s_waitcnt vmcnt(0)" ::: "memory");
    __syncthreads();
    if (threadIdx.x == 0) {
        unsigned* bar = b.bar;
        __builtin_amdgcn_s_waitcnt(0);
        unsigned nloc = b.st[0], nx = b.st[1];
        if (nloc == 0u) { xcd_barrier_complete(bar, b.x, nloc, nx); b.st[0] = nloc; b.st[1] = nx; }
        const unsigned old = xb_add(&bar[XB_XSUB(b.x)], 1u);
        const unsigned gen = old / nloc;
        if (old + 1u == (gen + 1u) * nloc) {
            __builtin_amdgcn_fence(__ATOMIC_RELEASE, "agent");
            asm volatile("s_waitcnt vmcnt(0)" ::: "memory");
            const unsigned og = xb_add(&bar[XB_TOP], 1u);
            const unsigned tg = og / nx;
            if (og + 1u == (tg + 1u) * nx) xb_add(&bar[XB_TOPGEN], 1u);
            else XB_SPIN(xb_ld(&bar[XB_TOPGEN]) == tg, bar);
            __builtin_amdgcn_fence(__ATOMIC_ACQUIRE, "agent");
            xb_add(&bar[XB_XGEN(b.x)], 1u);
            asm volatile("s_waitcnt vmcnt(0)" ::: "memory");
        } else {
            XB_SPIN(xb_ld(&bar[XB_XGEN(b.x)]) == gen, bar);
            __builtin_amdgcn_fence(__ATOMIC_ACQUIRE, "agent");
            asm volatile("s_waitcnt vmcnt(0)" ::: "memory");
        }
    }
    __syncthreads();
}

constexpr int RING_BYTES = 131072;
constexpr int MISC_OFF = RING_BYTES;
constexpr int LDS_BYTES = 147456;
constexpr int NWAVES = 8;

struct Args {
    const float* in[29]; float* out; unsigned char* ws; int ph_lo, ph_hi;
};
enum { I_X = 0, I_MEM, I_NORM1, I_WIN, I_BGATE, I_QN, I_KN, I_LQ1, I_LK1, I_LQ2, I_LK2, I_SUBLN, I_WPOOL, I_PSCALE, I_MEMNORM, I_WMKV, I_MQN, I_MKN, I_WBRD, I_WBRP, I_WBRM, I_WOUT, I_NORM2,
       I_WROUTER, I_BROUTER, I_WGU, I_BGU, I_WD, I_BD };

__device__ __forceinline__ unsigned f2bf(float f) { unsigned u = __builtin_bit_cast(unsigned, f); return (u + 0x7fffu + ((u >> 16) & 1u)) >> 16; }
__device__ __forceinline__ unsigned pk2(float lo, float hi) { return f2bf(lo) | (f2bf(hi) << 16); }
__device__ __forceinline__ void p0_transpose_item(const float* W, int K, int N, bf16_t* WT, LAS float* scr, int item, int lane, int ldo = 0, float qs = 0.f) {
    if (ldo == 0) ldo = K;
    const int nblk = N / 64, kb = item / nblk, nb = item % nblk, k0 = 64 * kb, n0 = 64 * nb;
    const int kr = lane >> 3, n4 = (lane & 7) * 4;
    f32x4 v[16];
#pragma unroll
    for (int i = 0; i < 16; ++i) v[i] = *(const f32x4*)(W + (size_t)(k0 + 8 * (i & 7) + kr) * N + n0 + 32 * (i >> 3) + n4);
#pragma unroll
    for (int h = 0; h < 2; ++h) {
#pragma unroll
        for (int i = 0; i < 8; ++i)
#pragma unroll
            for (int j = 0; j < 4; ++j) scr[(n4 + j) * 68 + 8 * i + kr] = v[h * 8 + i][j];
        LDS_WAIT(); asm volatile("" ::: "memory");
        const int c = lane & 7;
#pragma unroll
        for (int jj = 0; jj < 4; ++jj) { const int nrow = 8 * jj + (lane >> 3); const LAS f32x4* sp = (const LAS f32x4*)(scr + nrow * 68 + 8 * c);
            f32x4 a = sp[0], b = sp[1];
            if (qs != 0.f) { for (int q = 0; q < 4; ++q) { a[q] = fminf(fmaxf(rintf(a[q] * qs), -127.f), 127.f); b[q] = fminf(fmaxf(rintf(b[q] * qs), -127.f), 127.f); } }
            u32x4 o; o.x = pk2(a[0], a[1]); o.y = pk2(a[2], a[3]); o.z = pk2(b[0], b[1]); o.w = pk2(b[2], b[3]);
            *(u32x4*)(WT + (size_t)(n0 + 32 * h + nrow) * ldo + k0 + 8 * c) = o; }
        LDS_WAIT(); asm volatile("" ::: "memory");
    }
}
__device__ __forceinline__ void p0_transpose_item_f8(const float* W, int K, int N, unsigned char* WT, LAS float* scr, int item, int lane) {
    const int nblk = N / 64, kb = item / nblk, nb = item % nblk, k0 = 64 * kb, n0 = 64 * nb;
    const int kr = lane >> 3, n4 = (lane & 7) * 4;
    f32x4 v[16];
#pragma unroll
    for (int i = 0; i < 16; ++i) v[i] = *(const f32x4*)(W + (size_t)(k0 + 8 * (i & 7) + kr) * N + n0 + 32 * (i >> 3) + n4);
#pragma unroll
    for (int h = 0; h < 2; ++h) {
#pragma unroll
        for (int i = 0; i < 8; ++i)
#pragma unroll
            for (int j = 0; j < 4; ++j) scr[(n4 + j) * 68 + 8 * i + kr] = v[h * 8 + i][j];
        LDS_WAIT(); asm volatile("" ::: "memory");
        const int c = lane & 7;
#pragma unroll
        for (int jj = 0; jj < 4; ++jj) { const int nrow = 8 * jj + (lane >> 3); const LAS f32x4* sp = (const LAS f32x4*)(scr + nrow * 68 + 8 * c);
            const f32x4 a = sp[0] * W8_SCALE, b = sp[1] * W8_SCALE;
            u32x2 o; o.x = pk4_fp8(a[0], a[1], a[2], a[3]); o.y = pk4_fp8(b[0], b[1], b[2], b[3]);
            *(u32x2*)(WT + (size_t)(n0 + 32 * h + nrow) * K + k0 + 8 * c) = o; }
        LDS_WAIT(); asm volatile("" ::: "memory");
    }
}
__device__ __forceinline__ void p0_transpose_item_i8(const float* W, int K, int N, unsigned char* WT, LAS float* scr, int item, int lane, float qs) {
    const int nblk = N / 64, kb = item / nblk, nb = item % nblk, k0 = 64 * kb, n0 = 64 * nb;
    const int kr = lane >> 3, n4 = (lane & 7) * 4;
    f32x4 v[16];
#pragma unroll
    for (int i = 0; i < 16; ++i) v[i] = *(const f32x4*)(W + (size_t)(k0 + 8 * (i & 7) + kr) * N + n0 + 32 * (i >> 3) + n4);
#pragma unroll
    for (int h = 0; h < 2; ++h) {
#pragma unroll
        for (int i = 0; i < 8; ++i)
#pragma unroll
            for (int j = 0; j < 4; ++j) scr[(n4 + j) * 68 + 8 * i + kr] = v[h * 8 + i][j];
        LDS_WAIT(); asm volatile("" ::: "memory");
        const int c = lane & 7;
#pragma unroll
        for (int jj = 0; jj < 4; ++jj) { const int nrow = 8 * jj + (lane >> 3); const LAS f32x4* sp = (const LAS f32x4*)(scr + nrow * 68 + 8 * c);
            const f32x4 a = sp[0] * qs, b = sp[1] * qs;
            u32x2 o; o.x = pk4_i8(a[0], a[1], a[2], a[3]); o.y = pk4_i8(b[0], b[1], b[2], b[3]);
            *(u32x2*)(WT + (size_t)(n0 + 32 * h + nrow) * K + k0 + 8 * c) = o; }
        LDS_WAIT(); asm volatile("" ::: "memory");
    }
}
__device__ __forceinline__ void rms_row_to_q(const float* xrow, const float* gain, unsigned char* orow, float* rs, int lane) {
    const f32x4* xr = (const f32x4*)xrow + lane; const f32x4* gr = (const f32x4*)gain + lane;
    f32x4 v[4]; float s = 0.f;
#pragma unroll
    for (int j = 0; j < 4; ++j) { v[j] = xr[64 * j]; s += (v[j].x * v[j].x + v[j].y * v[j].y) + (v[j].z * v[j].z + v[j].w * v[j].w); }
    const float rstd = 1.f / sqrtf(wave_sum(s) * (1.f / 1024.f) + RMS_EPS);
    float am = 0.f;
#pragma unroll
    for (int j = 0; j < 4; ++j) { const f32x4 g = gr[64 * j]; v[j] = v[j] * rstd * g; am = fmaxf(am, fmaxf(fmaxf(fabsf(v[j].x), fabsf(v[j].y)), fmaxf(fabsf(v[j].z), fabsf(v[j].w)))); }
#pragma unroll
    for (int o = 1; o < 64; o <<= 1) am = fmaxf(am, __shfl_xor(am, o));
    am = fmaxf(am, 1e-20f); const float qi = 127.0f / am;
    unsigned* o4 = (unsigned*)orow + lane;
#pragma unroll
    for (int j = 0; j < 4; ++j) o4[64 * j] = pk4_i8(v[j].x * qi, v[j].y * qi, v[j].z * qi, v[j].w * qi);
    if (lane == 0) rs[0] = am * (1.0f / 127.0f);
}
__device__ __forceinline__ void rms_row_to_bf16(const float* xrow, const float* gain, bf16_t* orow, int lane) {
    const f32x4* xr = (const f32x4*)xrow + lane; const f32x4* gr = (const f32x4*)gain + lane;
    f32x4 v[4]; float s = 0.f;
#pragma unroll
    for (int j = 0; j < 4; ++j) { v[j] = xr[64 * j]; s += (v[j].x * v[j].x + v[j].y * v[j].y) + (v[j].z * v[j].z + v[j].w * v[j].w); }
    const float rstd = 1.f / sqrtf(wave_sum(s) * (1.f / 1024.f) + RMS_EPS);
    u32x2* o8 = (u32x2*)orow + lane;
#pragma unroll
    for (int j = 0; j < 4; ++j) { const f32x4 g = gr[64 * j]; u32x2 w; w.x = pk2(v[j].x * rstd * g.x, v[j].y * rstd * g.y); w.y = pk2(v[j].z * rstd * g.z, v[j].w * rstd * g.w); o8[64 * j] = w; }
}

__device__ __forceinline__ void cvt_item64_f8(const float* W, int K, int N, unsigned char* WT, int item, int lane) {
    const int nblk = N / 64, kb = item / nblk, nb = item % nblk, k0 = 64 * kb, n0 = 64 * nb;
    const char* base = (const char*)(W + (size_t)k0 * N + n0);
    unsigned off = (unsigned)lane * 4u; const unsigned rstep = (unsigned)N * 4u;
    float v[64];
#pragma unroll
    for (int j = 0; j < 64; ++j) { v[j] = __builtin_nontemporal_load((const float*)(base + off)); off += rstep; }
    unsigned char* dst = WT + (size_t)(n0 + lane) * K + k0;
#pragma unroll
    for (int c = 0; c < 4; ++c) { u32x4 o;
#pragma unroll
        for (int q = 0; q < 4; ++q) { int r = __builtin_amdgcn_cvt_pk_fp8_f32(v[16 * c + 4 * q] * W8_SCALE, v[16 * c + 4 * q + 1] * W8_SCALE, 0, false);
            r = __builtin_amdgcn_cvt_pk_fp8_f32(v[16 * c + 4 * q + 2] * W8_SCALE, v[16 * c + 4 * q + 3] * W8_SCALE, r, true); o[q] = (unsigned)r; }
        *(u32x4*)(dst + 16 * c) = o; }
}
struct CvtJob {
    const float* wgu; const float* wd; unsigned char* wgu_t; unsigned char* wd_t; int ngw, gw, lane;
    __device__ __forceinline__ void item(int j) const {
        const int it = gw + j * ngw; if (it >= 24576) return;
        const bool gu = it < 16384; const int r = gu ? it : it - 16384, e = gu ? (r >> 9) : (r >> 8), idx = gu ? (r & 511) : (r & 255), N = gu ? 2048 : 1024;
        const float* W = gu ? wgu + (size_t)e * 1024 * 2048 : wd + (size_t)e * 1024 * 1024; unsigned char* WT = gu ? wgu_t + (size_t)e * 2048 * 1024 : wd_t + (size_t)e * 1024 * 1024;
        cvt_item64_f8(W, 1024, N, WT, idx, lane);
    }
    __device__ __forceinline__ void item3(int j) const {
        const char* base[3]; unsigned char* dst[3]; unsigned rstep[3]; bool ok[3]; float v[3][64];
#pragma unroll
        for (int b = 0; b < 3; ++b) { const int it0 = gw + (j + b) * ngw; ok[b] = it0 < 24576; const int it = ok[b] ? it0 : gw;
            const bool gu = it < 16384; const int r = gu ? it : it - 16384, e = gu ? (r >> 9) : (r >> 8), idx = gu ? (r & 511) : (r & 255), N = gu ? 2048 : 1024;
            const float* W = gu ? wgu + (size_t)e * 1024 * 2048 : wd + (size_t)e * 1024 * 1024; unsigned char* WT = gu ? wgu_t + (size_t)e * 2048 * 1024 : wd_t + (size_t)e * 1024 * 1024;
            const int nblk = N / 64, kb = idx / nblk, nb = idx % nblk, k0 = 64 * kb, n0 = 64 * nb;
            base[b] = (const char*)(W + (size_t)k0 * N + n0); dst[b] = WT + (size_t)(n0 + lane) * 1024 + k0; rstep[b] = (unsigned)N * 4u; }
#pragma unroll
        for (int b = 0; b < 3; ++b) { unsigned off = (unsigned)lane * 4u;
#pragma unroll
            for (int q = 0; q < 64; ++q) { v[b][q] = __builtin_nontemporal_load((const float*)(base[b] + off)); off += rstep[b]; } }
#pragma unroll
        for (int b = 0; b < 3; ++b) if (ok[b]) {
#pragma unroll
            for (int c = 0; c < 4; ++c) { u32x4 o;
#pragma unroll
                for (int q = 0; q < 4; ++q) { int r = __builtin_amdgcn_cvt_pk_fp8_f32(v[b][16 * c + 4 * q] * W8_SCALE, v[b][16 * c + 4 * q + 1] * W8_SCALE, 0, false);
                    r = __builtin_amdgcn_cvt_pk_fp8_f32(v[b][16 * c + 4 * q + 2] * W8_SCALE, v[b][16 * c + 4 * q + 3] * W8_SCALE, r, true); o[q] = (unsigned)r; }
                *(u32x4*)(dst[b] + 16 * c) = o; } }
    }
};
struct PostCvt { CvtJob J; int jbase, jend; __device__ __forceinline__ void operator()(int ui) const { const int j = jbase + ui; if (j < jend) J.item(j); } };
struct Args;
typedef __attribute__((address_space(4))) const Args* kargs_t;
__device__ __forceinline__ kargs_t kargs() { kargs_t p = (kargs_t)__builtin_amdgcn_kernarg_segment_ptr(); asm volatile("" : "+s"(p)); return p; }
__global__ void __launch_bounds__(NWAVES * 64, 2) fwd_kernel(Args args) {
    extern __shared__ __attribute__((aligned(16))) unsigned char lds_raw[];
    cg::grid_group grid = cg::this_grid();
    LAS unsigned char* lds = (LAS unsigned char*)lds_raw;
    const int tid = threadIdx.x, lane = tid & 63, wave = __builtin_amdgcn_readfirstlane(tid >> 6);
    const int G = gridDim.x, bx = blockIdx.x; const int vcu = (G % 8 == 0) ? (bx % 8) * (G / 8) + bx / 8 : bx;
    const int gw = vcu * NWAVES + wave, NGW = G * NWAVES;
    const int lo = args.ph_lo, hi = args.ph_hi;
    if (tid < 64) ((LAS unsigned*)(lds + MISC_OFF + 1024))[tid] = 0u;
    __syncthreads();
    const XcdBarrier xbar = xcd_barrier_post((unsigned*)(args.ws + WS_CTL) + CW_BAR, (volatile LAS unsigned*)(lds + MISC_OFF + 1024));
#ifndef PHMASK
#define PHMASK 0x3ff
#endif
#define IN(k) (((PHMASK >> (k)) & 1) && lo <= (k) && (k) < hi)
#define GSYNC() do { asm volatile("s_waitcnt vmcnt(0) lgkmcnt(0)" ::: "memory"); __syncthreads(); grid.sync(); asm volatile("s_waitcnt vmcnt(0)" ::: "memory"); __syncthreads(); } while (0)
#define SEAM(k) do { if (lo <= (k) && (k) + 1 < hi) { xcd_barrier(xbar); } } while (0)
#define WSP(TY, off) ((TY*)(ka->ws + (off)))
#define WIN_T WSP(bf16_t, WS_WIN_T)
#define WBRD_T WSP(bf16_t, WS_WBRD_T)
#define WBRP_T WSP(bf16_t, WS_WBRP_T)
#define WBRM_T WSP(bf16_t, WS_WBRM_T)
#define WOUT_T WSP(bf16_t, WS_WOUT_T)
#define WMKV_T WSP(bf16_t, WS_WMKV_T)
#define WGU_T WSP(bf16_t, WS_WGU_T)
#define WD_T WSP(bf16_t, WS_WD_T)
#define XN WSP(bf16_t, WS_XN)
#define Qb WSP(bf16_t, WS_Q)
#define Kb WSP(bf16_t, WS_K)
#define Vb WSP(bf16_t, WS_V)
#define Ub WSP(bf16_t, WS_U)
#define MQb WSP(bf16_t, WS_MQ)
#define OC WSP(bf16_t, WS_OC)
#define GATES WSP(bf16_t, WS_GATES)
#define YCAT WSP(bf16_t, WS_YCAT)
#define MERGF WSP(float, WS_MERGF)
#define MERGB WSP(bf16_t, WS_MERGB)
#define XG WSP(bf16_t, WS_XG)
#define ACT WSP(bf16_t, WS_A)
#define Y4 WSP(bf16_t, WS_B)
#define MEMN WSP(bf16_t, WS_MEMN)
#define MKV WSP(bf16_t, WS_MKV)
#define ROPE WSP(f32x2, WS_ROPE)
#define WR2 WSP(float, WS_WR2)
#define ROUTEW WSP(float, WS_ROUTEW)
#define LAMP WSP(float, WS_LAM)
#define LIST WSP(u32x2, WS_LIST)
#define CNT WSP(unsigned, WS_CTL)
#define OUT (ka->out)
#define KA const kargs_t ka = kargs()

    if (lo > 1000) GSYNC();
    if (IN(0)) for (int rep_ = 0; rep_ < 1 + ((REPEAT_MASK >> 0) & 1); ++rep_) { KA; if (rep_) __syncthreads();
        LAS float* scr = (LAS float*)(lds + wave * 16384);
        constexpr int I0 = 16 * 80, I1 = 8 * 16, I2 = 4 * 16, I3 = 4 * 16, I4 = 16 * 16, I5 = 16 * 8, I6 = 0, I7 = 0;
        constexpr int NITEMS = I0 + I1 + I2 + I3 + I4 + I5 + I6 + I7;
        for (int it = gw; it < NITEMS; it += NGW) {
            int r = it;
            if (r < I0) { p0_transpose_item_i8(ka->in[I_WIN], 1024, 5120, (unsigned char*)WIN_T, scr, r, lane, WQ_IN); continue; } r -= I0;
            if (r < I1) { p0_transpose_item(ka->in[I_WBRD], 512, 1024, WBRD_T, scr, r, lane, 1024); continue; } r -= I1;
            if (r < I2) { p0_transpose_item(ka->in[I_WBRP], 256, 1024, WBRD_T + 512, scr, r, lane, 1024); continue; } r -= I2;
            if (r < I3) { p0_transpose_item(ka->in[I_WBRM], 256, 1024, WBRD_T + 768, scr, r, lane, 1024); continue; } r -= I3;
            if (r < I4) { p0_transpose_item(ka->in[I_WOUT], 1024, 1024, WOUT_T, scr, r, lane); continue; } r -= I4;
            p0_transpose_item(ka->in[I_WMKV], 1024, 512, WMKV_T, scr, r, lane);
        }
        for (int m = gw; m < T; m += NGW) rms_row_to_q(ka->in[I_X] + (size_t)m * 1024, ka->in[I_NORM1], (unsigned char*)XN + (size_t)m * 1024, WSP(float, WS_MERGF) + m, lane);
        for (int m = gw; m < BATCH * MEMLEN; m += NGW) rms_row_to_bf16(ka->in[I_MEM] + (size_t)m * 1024, ka->in[I_MEMNORM], MEMN + (size_t)m * 1024, lane);
        for (int i = bx * 512 + tid; i < SEQ * 32; i += G * 512) { const int pos = i >> 5, j = i & 31;
            const float inv = 1.0f / powf(10000.0f, (float)(2 * j) / 64.0f); const float ang = (float)pos * inv;
            const double a = (double)ang; const double k = rint(a * 0.15915494309189535); const float red = (float)(a - k * 6.283185307179586);
            ROPE[i] = (f32x2){cosf(red), sinf(red)}; }
        for (int i = bx * 512 + tid; i < 1024 * 32; i += G * 512) { const int ii = i & 3, e = (i >> 2) & 15, kq = (i >> 6) & 3, eb = (i >> 8) & 1, s = i >> 9; const int k = 16 * s + 4 * kq + ii;
            WR2[i] = ka->in[I_NORM2][k] * ka->in[I_WROUTER][k * 32 + eb * 16 + e]; }
        if (bx == 0 && wave == 0) { const float s1 = wave_sum(ka->in[I_LQ1][lane] * ka->in[I_LK1][lane]), s2 = wave_sum(ka->in[I_LQ2][lane] * ka->in[I_LK2][lane]);
            if (lane == 0) LAMP[0] = expf(s1) - expf(s2) + 0.2f; }
    }
    SEAM(0);
    if (IN(1)) for (int rep_ = 0; rep_ < 1 + ((REPEAT_MASK >> 1) & 1); ++rep_) { KA; if (rep_) __syncthreads();
#if defined(TAP) && TAP == 6
        { pg8::DenseProb P{XN, WIN_T, 1024, 1024, 1024}; pg8::StaticOrder S; S.init(T, INW, G, bx);
          pg8::EpiPlain E{WSP(bf16_t, WS_B), 5120};
          pg8::gemm_phase<pg8::EpiPlain, pg8::DenseProb, pg8::StaticOrder, true>(lds, P, S, E); }
#else
        const CvtJob J{ka->in[I_WGU], ka->in[I_WD], (unsigned char*)WGU_T, (unsigned char*)WD_T, NGW, gw, lane};
        const int kpre = (bx & 7) < 12 - 3 * CVT_NB2 ? (bx & 7) : 12 - 3 * CVT_NB2;
        for (int j = 0; j < kpre; ++j) J.item(3 * CVT_NB2 + j);
        { pg8::DenseProbI8 P{(const unsigned char*)XN, (const unsigned char*)WIN_T, 1024, 1024, 1024}; pg8::StaticOrder S0; S0.init(T, INW, G, bx); const pg8::TableOrder S = pg8::build_unit_table(S0, (LAS int*)(lds + MISC_OFF + 2048));
          pg8::EpiInProj E{Qb, Kb, Vb, Ub, MQb, GATES, ka->in[I_QN], ka->in[I_KN], ka->in[I_MQN], ka->in[I_BGATE], ROPE, WSP(float, WS_MERGF)};
          const PostCvt PU{J, 3 * CVT_NB2 + kpre, 12};
          pg8::gemm_phase<pg8::EpiInProj, pg8::DenseProbI8, pg8::TableOrder, ALIGN_EPI_SEL, PostCvt>(lds, P, S, E, PU); }
        for (int j = 3 * CVT_NB2 + kpre + 10; j < 12; ++j) J.item(j);
#endif
        for (int tile = bx; tile < 256; tile += G) {
            const int rt = tile >> 3, ct = tile & 7, r32 = lane & 31, hh = lane >> 5;
            const bf16_t* ap = MEMN + (size_t)(32 * rt + r32) * 1024 + 128 * wave + 8 * hh; const bf16_t* bp = WMKV_T + (size_t)(64 * ct + r32) * 1024 + 128 * wave + 8 * hh;
            bf16x8 af[8], b0[8], b1[8];
#pragma unroll
            for (int ks = 0; ks < 8; ++ks) { af[ks] = *(const bf16x8*)(ap + 16 * ks); b0[ks] = *(const bf16x8*)(bp + 16 * ks); b1[ks] = *(const bf16x8*)(bp + 32 * 1024 + 16 * ks); }
            f32x16 c0 = f32x16{}, c1 = f32x16{};
#pragma unroll
            for (int ks = 0; ks < 8; ++ks) { c0 = __builtin_amdgcn_mfma_f32_32x32x16_bf16(af[ks], b0[ks], c0, 0, 0, 0); c1 = __builtin_amdgcn_mfma_f32_32x32x16_bf16(af[ks], b1[ks], c1, 0, 0, 0); }
            LAS float* part = (LAS float*)lds;
            __syncthreads();
#pragma unroll
            for (int r = 0; r < 16; ++r) { const int row = (r & 3) + 8 * (r >> 2) + 4 * hh; part[(wave * 32 + row) * 64 + r32] = c0[r]; part[(wave * 32 + row) * 64 + 32 + r32] = c1[r]; }
            __syncthreads();
            const int row = tid >> 4, c4 = (tid & 15) * 4; f32x4 a = {0.f, 0.f, 0.f, 0.f};
#pragma unroll
            for (int w = 0; w < 8; ++w) a += *(const LAS f32x4*)(part + (w * 32 + row) * 64 + c4);
            if (ct < 4) {
                float ss = (a[0] * a[0] + a[1] * a[1]) + (a[2] * a[2] + a[3] * a[3]);
                ss += __shfl_xor(ss, 1); ss += __shfl_xor(ss, 2); ss += __shfl_xor(ss, 4); ss += __shfl_xor(ss, 8);
                const float rstd = 1.0f / sqrtf(ss * (1.0f / 64.0f) + RMS_EPS); const f32x4 g = *(const f32x4*)(ka->in[I_MKN] + c4); a = a * rstd * g; }
            u32x2 o; o.x = cvt_pk_bf16(a[0], a[1]); o.y = cvt_pk_bf16(a[2], a[3]);
            *(u32x2*)(MKV + (size_t)(32 * rt + row) * 512 + 64 * ct + c4) = o;
        }
        __syncthreads();
    }
    SEAM(1);
    if (IN(2)) for (int rep_ = 0; rep_ < 1 + ((REPEAT_MASK >> 2) & 1); ++rep_) { KA; if (rep_) __syncthreads();
        using abf = attn_body::bf16;
        {
            const int bh = vcu >> 4, b = bh >> 2, h = bh & 3, s = vcu & 15; const size_t rb = (size_t)b * SEQ;
            const float lam = LAMP[0];
            const CvtJob J2{ka->in[I_WGU], ka->in[I_WD], (unsigned char*)WGU_T, (unsigned char*)WD_T, NGW, gw, lane};
            for (int i2 = 0; i2 < 4 * (1 + ((REPEAT_MASK >> 10) & 1)); ++i2) { const int ii = i2 & 3, c = ii & 1; const int qb = (ii < 2) ? s : 31 - s;
                attn_body::attn_unit2<true>(qb * 256, 4 * qb + 4, (const abf*)Qb + rb * 512 + (c * 4 + h) * 64, 512, (const abf*)Kb + rb * 512 + (c * 4 + h) * 64, 512,
                                            (const abf*)Vb + rb * 512 + h * 128, 512, (abf*)OC + rb * 1024 + (c * 4 + h) * 128, 1024, (char*)lds_raw);
                if (c == 1) {
                    asm volatile("s_waitcnt vmcnt(0)" ::: "memory");
#pragma unroll
                    for (int ps = 0; ps < 2; ++ps) {
                    const int row = ps * 16 + (lane >> 2), dq = (lane & 3) * 32; const size_t t = rb + (size_t)qb * 256 + wave * 32 + row;
                    const bf16_t* p0 = OC + t * 1024 + h * 128 + dq; const bf16_t* p1 = p0 + 512;
                    u32x4 a[4], bb[4];
#pragma unroll
                    for (int j = 0; j < 4; ++j) { a[j] = *(const u32x4*)(p0 + 8 * j); bb[j] = *(const u32x4*)(p1 + 8 * j); }
                    float ss = 0.f; f32x4 y[4][2];
#pragma unroll
                    for (int j = 0; j < 4; ++j) {
                        y[j][0] = (f32x4){bf_lo(a[j].x) - lam * bf_lo(bb[j].x), bf_hi(a[j].x) - lam * bf_hi(bb[j].x), bf_lo(a[j].y) - lam * bf_lo(bb[j].y), bf_hi(a[j].y) - lam * bf_hi(bb[j].y)};
                        y[j][1] = (f32x4){bf_lo(a[j].z) - lam * bf_lo(bb[j].z), bf_hi(a[j].z) - lam * bf_hi(bb[j].z), bf_lo(a[j].w) - lam * bf_lo(bb[j].w), bf_hi(a[j].w) - lam * bf_hi(bb[j].w)};
#pragma unroll
                        for (int q = 0; q < 4; ++q) ss += y[j][0][q] * y[j][0][q] + y[j][1][q] * y[j][1][q]; }
                    ss += __shfl_xor(ss, 1); ss += __shfl_xor(ss, 2);
                    const float rstd = 0.8f / sqrtf(ss * (1.0f / 128.0f) + RMS_EPS);
                    const float* sg = ka->in[I_SUBLN] + dq; bf16_t* yo = YCAT + t * 1024 + h * 128 + dq;
#pragma unroll
                    for (int j = 0; j < 4; ++j) { const f32x4 s0 = *(const f32x4*)(sg + 8 * j), s1 = *(const f32x4*)(sg + 8 * j + 4); pg8::store8(yo + 8 * j, y[j][0] * rstd * s0, y[j][1] * rstd * s1); }
                    }
                }
                if (ii < CVT_NB2) J2.item3(3 * ii);
            }
        }
        {
            for (int i = 0; i < 2; ++i) { const int idx = vcu * 2 + i; if (idx >= 512) break; const int b = idx >> 7, h = (idx >> 5) & 3, qb = idx & 31;
                attn_body::attn_unit<8, false>(qb * 256, 4, (const abf*)MQb + (size_t)b * SEQ * 256 + h * 64, 256, (const abf*)MKV + (size_t)b * MEMLEN * 512 + h * 64, 512,
                                               (const abf*)MKV + (size_t)b * MEMLEN * 512 + 256 + h * 64, 512, (abf*)YCAT + (size_t)b * SEQ * 1024 + 768 + h * 64, 1024, (char*)lds_raw); }
        }
        {
            LAS bf16_t* ul = (LAS bf16_t*)lds;
            LAS bf16_t* pb = (LAS bf16_t*)(lds + 24576);
            const int col = tid & 255, half = tid >> 8, w = 2 << (col >> 6);
            const int mg = wave & 3, mdh = wave >> 2, r32 = lane & 31, hh = lane >> 5;
            bf16x8 bw[4];
#pragma unroll
            for (int sx = 0; sx < 4; ++sx) { const float* wp = ka->in[I_WPOOL] + (size_t)(mg * 64 + 16 * sx + 8 * hh) * 64 + mdh * 32 + r32;
                u32x4 pk; pk.x = pk2(wp[0], wp[64]); pk.y = pk2(wp[128], wp[192]); pk.z = pk2(wp[256], wp[320]); pk.w = pk2(wp[384], wp[448]); bw[sx] = __builtin_bit_cast(bf16x8, pk); }
            const int ocol = mg * 64 + mdh * 32 + r32; const float psc = ka->in[I_PSCALE][ocol];
            u32x4 pre[3];
#define POOL_LOAD(tl) do { const int t0_ = (tl) * 32, p0_ = t0_ & (SEQ - 1); _Pragma("unroll") for (int k_ = 0; k_ < 3; ++k_) { const int pc = tid + 512 * k_, r = pc >> 5, ch = pc & 31; \
                pre[k_] = (u32x4){0u, 0u, 0u, 0u}; if (pc < 47 * 32 && p0_ - 15 + r >= 0) pre[k_] = *(const u32x4*)(Ub + (size_t)(t0_ - 15 + r) * 256 + ch * 8); } } while (0)
            if (vcu < T / 32) POOL_LOAD(vcu);
            for (int tile = vcu; tile < T / 32; tile += G) {
                const int t0 = tile * 32, p0 = t0 & (SEQ - 1);
                __syncthreads();
#pragma unroll
                for (int k = 0; k < 3; ++k) { const int pc = tid + 512 * k, r = pc >> 5, ch = pc & 31; if (pc < 47 * 32) *(LAS u32x4*)(ul + r * 256 + ch * 8) = pre[k]; }
                if (tile + G < T / 32) POOL_LOAD(tile + G);
                __syncthreads();
                {
                    float sum = 0.f; const int rbase = 15 + 16 * half;
                    for (int i = 1; i < w; ++i) sum += __uint_as_float((unsigned)ul[(rbase - i) * 256 + col] << 16);
#pragma unroll
                    for (int tk = 0; tk < 16; ++tk) { const float ucur = __uint_as_float((unsigned)ul[(rbase + tk) * 256 + col] << 16); sum += ucur;
                        const int pos = p0 + 16 * half + tk; const float cnt = (float)((pos + 1 < w) ? pos + 1 : w);
                        pb[(16 * half + tk) * 264 + col] = (bf16_t)f2bf(sum / cnt - ucur);
                        sum -= __uint_as_float((unsigned)ul[(rbase + tk - (w - 1)) * 256 + col] << 16); }
                }
                __syncthreads();
                f32x16 acc = f32x16{};
#pragma unroll
                for (int sx = 0; sx < 4; ++sx) { const bf16x8 af = *(const LAS bf16x8*)(pb + r32 * 264 + mg * 64 + 16 * sx + 8 * hh);
                    acc = __builtin_amdgcn_mfma_f32_32x32x16_bf16(af, bw[sx], acc, 0, 0, 0); }
#pragma unroll
                for (int r = 0; r < 16; ++r) { const int tok = t0 + (r & 3) + 8 * (r >> 2) + 4 * hh; YCAT[(size_t)tok * 1024 + 512 + ocol] = (bf16_t)f2bf(acc[r] * psc); }
            }
            __syncthreads();
        }
    }
    SEAM(2);
    if (IN(4)) for (int rep_ = 0; rep_ < 1 + ((REPEAT_MASK >> 4) & 1); ++rep_) { KA; if (rep_) __syncthreads();
        pg8::StaticOrder S0; S0.init(T, 1024, G, bx); const pg8::TableOrder S = pg8::build_unit_table(S0, (LAS int*)(lds + MISC_OFF + 2048));
        pg8::DenseProb P{YCAT, WBRD_T, 1024, 1024, 1024}; pg8::EpiMergeR E{GATES, MERGB};
        pg8::gemm_phase<pg8::EpiMergeR, pg8::DenseProb, pg8::TableOrder, ALIGN_EPI_SEL>(lds, P, S, E);
    }
    SEAM(4);
    if (IN(5)) for (int rep_ = 0; rep_ < 1 + ((REPEAT_MASK >> 5) & 1); ++rep_) { KA; if (rep_) __syncthreads();
        pg8::DenseProb P{MERGB, WOUT_T, 1024, 1024, 1024}; pg8::StaticOrder S0; S0.init(T, 1024, G, bx); const pg8::TableOrder S = pg8::build_unit_table(S0, (LAS int*)(lds + MISC_OFF + 2048));
        pg8::EpiWout E{ka->in[I_X], OUT, (unsigned char*)XG, ka->in[I_NORM2]};
        pg8::gemm_phase<pg8::EpiWout, pg8::DenseProb, pg8::TableOrder, ALIGN_EPI_SEL>(lds, P, S, E);
    }
    SEAM(5);
    if (IN(6)) { KA;
        LAS int* lcnt = (LAS int*)(lds + MISC_OFF); LAS int* lbase = lcnt + 32;
        const int ngroups = T / 16, rounds = (ngroups + NGW - 1) / NGW;
        for (int rd = 0; rd < rounds; ++rd) {
            const int grp = rd * NGW + gw; const bool valid = grp < ngroups;
            if (tid < 32) lcnt[tid] = 0;
            __syncthreads();
            int e_sel = 0, rank = 0; float w_sel = 0.f, rstd = 0.f; const int q = lane >> 4, tok = grp * 16 + (lane & 15);
            if (valid) {
                f32x4 d0 = {0.f, 0.f, 0.f, 0.f}, d1 = {0.f, 0.f, 0.f, 0.f}; float ss = 0.f;
                const float* xrow = OUT + (size_t)tok * 1024 + 4 * q; const f32x4* wr2 = (const f32x4*)WR2 + lane;
#pragma unroll 8
                for (int s = 0; s < 64; ++s) { const f32x4 xv = *(const f32x4*)(xrow + 16 * s); const f32x4 wa = wr2[(s * 2) * 64], wb = wr2[(s * 2 + 1) * 64];
                    ss += (xv[0] * xv[0] + xv[1] * xv[1]) + (xv[2] * xv[2] + xv[3] * xv[3]);
#pragma unroll
                    for (int j = 0; j < 4; ++j) { d0 = __builtin_amdgcn_mfma_f32_16x16x4f32(wa[j], xv[j], d0, 0, 0, 0); d1 = __builtin_amdgcn_mfma_f32_16x16x4f32(wb[j], xv[j], d1, 0, 0, 0); } }
                ss += __shfl_xor(ss, 16); ss += __shfl_xor(ss, 32);
                rstd = 1.0f / sqrtf(ss * (1.0f / 1024.f) + RMS_EPS);
                unsigned key[8];
#pragma unroll
                for (int r = 0; r < 8; ++r) { const int e = (r >> 2) * 16 + 4 * q + (r & 3); const float lg = ((r < 4) ? d0[r & 3] : d1[r & 3]) * rstd + ka->in[I_BROUTER][e];
                    unsigned u = __float_as_uint(lg); u ^= (u >> 31) ? 0xffffffffu : 0x80000000u; key[r] = (u & ~31u) | (unsigned)(31 - e); }
                unsigned win[4];
#pragma unroll
                for (int r = 0; r < 4; ++r) { unsigned m = key[0];
#pragma unroll
                    for (int j = 1; j < 8; ++j) m = m > key[j] ? m : key[j];
                    unsigned o = (unsigned)__shfl_xor((int)m, 16); m = m > o ? m : o; o = (unsigned)__shfl_xor((int)m, 32); m = m > o ? m : o; win[r] = m;
#pragma unroll
                    for (int j = 0; j < 8; ++j) key[j] = (key[j] == m) ? 0u : key[j]; }
                float val[4];
#pragma unroll
                for (int r = 0; r < 4; ++r) { unsigned u = win[r] & ~31u; u ^= (u >> 31) ? 0x80000000u : 0xffffffffu; val[r] = __uint_as_float(u); }
                const float p1 = expf(val[1] - val[0]), p2 = expf(val[2] - val[0]), p3 = expf(val[3] - val[0]); const float inv = 1.0f / (1.0f + p1 + p2 + p3);
                const unsigned wk = (q == 0) ? win[0] : (q == 1) ? win[1] : (q == 2) ? win[2] : win[3];
                w_sel = ((q == 0) ? 1.0f : (q == 1) ? p1 : (q == 2) ? p2 : p3) * inv; e_sel = 31 - (int)(wk & 31u);
                rank = __hip_atomic_fetch_add((int*)(lcnt + e_sel), 1, __ATOMIC_RELAXED, __HIP_MEMORY_SCOPE_WORKGROUP);
            }
            __syncthreads();
            if (tid < 32) lbase[tid] = (int)__hip_atomic_fetch_add(CNT + 64 * tid, (unsigned)lcnt[tid], __ATOMIC_RELAXED, __HIP_MEMORY_SCOPE_AGENT);
            __syncthreads();
            if (valid) { const int pos = lbase[e_sel] + rank; LIST[(size_t)e_sel * CAP + pos] = (u32x2){(unsigned)(tok * 4 + q), __float_as_uint(rstd)}; ROUTEW[tok * 4 + q] = w_sel; }
            __syncthreads();
        }
    }
    SEAM(6);
    if (IN(7) || IN(8)) { KA;
        LAS int* tp = (LAS int*)(lds + MISC_OFF + 256); LAS int* cn = tp + 40;
        if (tid < 64) {
            const int e = tid & 31; const int c = (int)__hip_atomic_load(CNT + 64 * e, __ATOMIC_RELAXED, __HIP_MEMORY_SCOPE_AGENT); const int tiles = (c + 255) >> 8; int x = tiles;
#pragma unroll
            for (int o = 1; o < 32; o <<= 1) { const int y = __shfl_up(x, o, 32); if (e >= o) x += y; }
            if (tid < 32) { cn[e] = c; tp[e] = x - tiles; if (e == 31) tp[NEXP] = x; } }
        __syncthreads();
        if (IN(7)) for (int rep_ = 0; rep_ < 1 + ((REPEAT_MASK >> 7) & 1); ++rep_) {
            pg8::GuProb P{(const unsigned char*)XG, (const unsigned char*)WGU_T, LIST, 1024, 1024, 1024}; pg8::GroupedOrder S0{tp, cn, 8, G, bx}; const pg8::TableOrder S = pg8::build_unit_table(S0, (LAS int*)(lds + MISC_OFF + 2048));
            pg8::EpiSwiglu E{(unsigned char*)ACT, LIST, ka->in[I_BGU], lds + MISC_OFF + 4096};
            pg8::gemm_phase<pg8::EpiSwiglu, pg8::GuProb, pg8::TableOrder, ALIGN_EPI_SEL>(lds, P, S, E);
        }
        SEAM(7);
        if (IN(8)) for (int rep_ = 0; rep_ < 1 + ((REPEAT_MASK >> 8) & 1); ++rep_) {
            pg8::DownProb P{(const unsigned char*)ACT, (const unsigned char*)WD_T, 1024, 1024, 1024}; pg8::GroupedOrder S0{tp, cn, 4, G, bx}; const pg8::TableOrder S = pg8::build_unit_table(S0, (LAS int*)(lds + MISC_OFF + 2048));
            pg8::EpiDown E{(unsigned char*)Y4, LIST, ka->in[I_BD], lds + MISC_OFF + 4096};
            pg8::gemm_phase<pg8::EpiDown, pg8::DownProb, pg8::TableOrder, ALIGN_EPI_SEL>(lds, P, S, E);
        }
    }
    SEAM(8);
    if (IN(9)) { KA;
        for (int i = bx * 512 + tid; i < T * 128; i += G * 512) { const int tok = i >> 7, c8 = (i & 127) * 8;
            const f32x4 w = *(const f32x4*)(ROUTEW + tok * 4); float* op = OUT + (size_t)tok * 1024 + c8;
            f32x4 o0 = *(const f32x4*)op, o1 = *(const f32x4*)(op + 4);
#pragma unroll
            for (int k = 0; k < 4; ++k) { const u32x2 y = *(const u32x2*)((const unsigned char*)Y4 + ((size_t)tok * 4 + k) * 1024 + c8); const float wk = w[k] * (1.0f / Y8_SCALE);
                const f32x2 p0 = __builtin_amdgcn_cvt_pk_f32_fp8((int)y.x, false), p1 = __builtin_amdgcn_cvt_pk_f32_fp8((int)y.x, true), p2 = __builtin_amdgcn_cvt_pk_f32_fp8((int)y.y, false), p3 = __builtin_amdgcn_cvt_pk_f32_fp8((int)y.y, true);
                o0[0] += wk * p0[0]; o0[1] += wk * p0[1]; o0[2] += wk * p1[0]; o0[3] += wk * p1[1];
                o1[0] += wk * p2[0]; o1[1] += wk * p2[1]; o1[2] += wk * p3[0]; o1[3] += wk * p3[1]; }
            *(f32x4*)op = o0; *(f32x4*)(op + 4) = o1; }
    }
#ifdef TAP
    if (lo <= 10 && 10 < hi) { KA; GSYNC();
        for (int i = bx * 512 + tid; i < T * 1024; i += G * 512) { const int t = i >> 10, c = i & 1023; float v = 0.f;
#define BFV(buf, pitch, col) __uint_as_float((unsigned)(buf)[(size_t)t * (pitch) + (col)] << 16)
            if (TAP == 1) v = BFV(Qb, 512, c & 511) + 2.f * BFV(Kb, 512, c & 511) + 4.f * BFV(Vb, 512, c & 511) + 8.f * BFV(Ub, 256, c & 255) + 16.f * BFV(MQb, 256, c & 255)
                            + 32.f * BFV(GATES, 3072, c) + 64.f * BFV(GATES, 3072, 1024 + c) + 128.f * BFV(GATES, 3072, 2048 + c);
            if (TAP == 2) v = BFV(OC, 1024, c) + 2.f * BFV(YCAT, 1024, c);
            if (TAP == 3) v = BFV(MERGB, 1024, c);
            if (TAP == 4) v = BFV(XN, 1024, c);
            if (TAP == 6) { const bf16_t* z = WSP(bf16_t, WS_B) + (size_t)t * 5120 + c; v = __uint_as_float((unsigned)z[0] << 16) + 2.f * __uint_as_float((unsigned)z[1024] << 16) + 4.f * __uint_as_float((unsigned)z[2048] << 16) + 8.f * __uint_as_float((unsigned)z[3072] << 16) + 16.f * __uint_as_float((unsigned)z[4096] << 16); }
            if (TAP == 5) { const bf16_t* wt = WIN_T; const int tt = t % 5120; v = __uint_as_float((unsigned)wt[(size_t)tt * 1024 + c] << 16) + ROPE[(t & 8191) * 32 + (c & 31)].x + 2.f * ROPE[(t & 8191) * 32 + (c & 31)].y; }
            OUT[i] = v; }
    }
#endif
#undef IN
#undef SEAM
}

extern "C" void kernel_launch(void* const* d_in, const int* in_sizes, int n_in, void* d_out, int out_size, void* d_ws, size_t ws_size, hipStream_t stream) {
    static int grid = 0;
    if (grid == 0) {
        if (n_in != 29 || in_sizes[0] != T * DMODEL || out_size != T * DMODEL || ws_size < WS_END) {
            fprintf(stderr, "kernel_launch: unexpected shapes: n_in %d in0 %d out %d ws %zu (need %zu)\n", n_in, n_in > 0 ? in_sizes[0] : -1, out_size, ws_size, (size_t)WS_END); grid = -1; return; }
        int dev = 0, cus = 0, per_cu = 0;
        (void)hipGetDevice(&dev); (void)hipDeviceGetAttribute(&cus, hipDeviceAttributeMultiprocessorCount, dev);
        (void)hipFuncSetAttribute((const void*)fwd_kernel, hipFuncAttributeMaxDynamicSharedMemorySize, LDS_BYTES);
        (void)hipOccupancyMaxActiveBlocksPerMultiprocessor(&per_cu, (const void*)fwd_kernel, NWAVES * 64, LDS_BYTES);
        (void)hipGetLastError();
        grid = cus;
        fprintf(stderr, "kernel_launch: cus %d occupancy %d/CU grid %d\n", cus, per_cu, grid);
        if (per_cu < 1) fprintf(stderr, "kernel_launch: occupancy query says the kernel does not fit\n");
    }
    if (grid < 0) return;
    (void)hipMemsetAsync((char*)d_ws + WS_CTL, 0, CTL_ZERO_BYTES, stream);
    Args a{};
    for (int i = 0; i < 29; ++i) a.in[i] = (const float*)d_in[i];
    a.out = (float*)d_out; a.ws = (unsigned char*)d_ws; a.ph_lo = 0; a.ph_hi = PH_HI;
    void* args[] = {&a};
    hipError_t e = hipLaunchCooperativeKernel((const void*)fwd_kernel, dim3(grid), dim3(NWAVES * 64), args, LDS_BYTES, stream);
    if (e != hipSuccess) fprintf(stderr, "cooperative launch failed: %s (grid %d)\n", hipGetErrorString(e), grid);
}
```

```cpp
#include <hip/hip_runtime.h>
#include <hip/hip_cooperative_groups.h>
#include <hip/hip_bf16.h>
#include <cstdio>
#include <cstdint>
#include <cmath>
namespace cg = cooperative_groups;

#define LAS __attribute__((address_space(3)))
#define GAS __attribute__((address_space(1)))
typedef unsigned short bf16_t;
typedef short bf16x8 __attribute__((ext_vector_type(8)));
typedef float f32x4 __attribute__((ext_vector_type(4)));
typedef float f32x2 __attribute__((ext_vector_type(2)));
typedef float f32x16 __attribute__((ext_vector_type(16)));
typedef unsigned u32x4 __attribute__((ext_vector_type(4)));
typedef unsigned u32x2 __attribute__((ext_vector_type(2)));

#define PH_HI 10
#define ALIGN_EPI_SEL true
#define F8MODE 2
#define USE_SETPRIO 1
#define ATTN_PRIO_A 1
#define ATTN_PRIO_B 1
#ifndef PHMASK
#define PHMASK 0x3ff
#endif
#define CVT_NB2 4
#define REPEAT_MASK 0x000
constexpr int BATCH = 4, SEQ = 8192, DMODEL = 1024, T = BATCH * SEQ, INW = 5120, NEXP = 32, MEMLEN = 256;
constexpr float RMS_EPS = 1e-6f;
constexpr float C2 = 0.125f * 1.4426950408889634f;
constexpr int CAP = T;

constexpr size_t MiB = 1u << 20;
constexpr size_t WS_CTL = 0, CTL_ZERO_BYTES = 32768;
constexpr int CW_BAR = 4096;
constexpr size_t WS_ROUTEW = 1 * MiB;
constexpr size_t WS_LAM = 1 * MiB + 768 * 1024;
constexpr size_t WS_ROPE = 2 * MiB;
constexpr size_t WS_WR2 = 4 * MiB;
constexpr size_t WS_MEMN = 5 * MiB;
constexpr size_t WS_MKV = 7 * MiB;
constexpr size_t WS_WIN_T = 8 * MiB;
constexpr size_t WS_WBRD_T = 18 * MiB;
constexpr size_t WS_WBRP_T = 19 * MiB;
constexpr size_t WS_WBRM_T = 19 * MiB + 512 * 1024;
constexpr size_t WS_WOUT_T = 20 * MiB;
constexpr size_t WS_WMKV_T = 22 * MiB;
constexpr size_t WS_WGU_T = 24 * MiB;
constexpr size_t WS_WD_T = 152 * MiB;
constexpr size_t WS_A = 216 * MiB;
constexpr size_t WS_XN = WS_A;
constexpr size_t WS_Q = WS_A + 64 * MiB, WS_K = WS_A + 96 * MiB, WS_V = WS_A + 128 * MiB;
constexpr size_t WS_U = WS_A + 160 * MiB, WS_MQ = WS_A + 176 * MiB;
constexpr size_t WS_OC = WS_A + 192 * MiB;
constexpr size_t WS_B = 488 * MiB;
constexpr size_t WS_GATES = WS_B;
constexpr size_t WS_YCAT = WS_B + 192 * MiB;
constexpr size_t WS_MERGF = 760 * MiB;
constexpr size_t WS_MERGB = 888 * MiB;
constexpr size_t WS_XG = 952 * MiB;
constexpr size_t WS_LIST = 1016 * MiB;
constexpr size_t WS_END = 1024 * MiB;

typedef __bf16 bf16x2_v __attribute__((ext_vector_type(2)));
__device__ __forceinline__ unsigned cvt_pk_bf16(float lo, float hi) { f32x2 v = {lo, hi}; bf16x2_v b = __builtin_convertvector(v, bf16x2_v); return __builtin_bit_cast(unsigned, b); }
__device__ __forceinline__ unsigned pk4_fp8(float a, float b, float c, float d) {
    a = fminf(fmaxf(a, -448.f), 448.f); b = fminf(fmaxf(b, -448.f), 448.f); c = fminf(fmaxf(c, -448.f), 448.f); d = fminf(fmaxf(d, -448.f), 448.f);
    int r = __builtin_amdgcn_cvt_pk_fp8_f32(a, b, 0, false); r = __builtin_amdgcn_cvt_pk_fp8_f32(c, d, r, true); return (unsigned)r; }
__device__ __forceinline__ unsigned pk4_i8(float a, float b, float c, float d) {
    const int q0 = (int)fminf(fmaxf(rintf(a), -127.f), 127.f), q1 = (int)fminf(fmaxf(rintf(b), -127.f), 127.f), q2 = (int)fminf(fmaxf(rintf(c), -127.f), 127.f), q3 = (int)fminf(fmaxf(rintf(d), -127.f), 127.f);
    return ((unsigned)q0 & 0xffu) | (((unsigned)q1 & 0xffu) << 8) | (((unsigned)q2 & 0xffu) << 16) | ((unsigned)q3 << 24); }
constexpr float WQ_IN = 127.0f * 32.0f / 4.0f;
constexpr float W8_SCALE = 64.0f;
constexpr float Y8_SCALE = 32.0f;
constexpr float A8_SCALE = 8.0f;
__device__ __forceinline__ float bf_lo(unsigned w) { return __uint_as_float(w << 16); }
__device__ __forceinline__ float bf_hi(unsigned w) { return __uint_as_float(w & 0xffff0000u); }
__device__ __forceinline__ float wave_sum(float v) {
#pragma unroll
    for (int o = 1; o < 64; o <<= 1) v += __shfl_xor(v, o);
    return v;
}
#define LDS_WAIT() asm volatile("s_waitcnt lgkmcnt(0)" ::: "memory")

namespace pg8 {
constexpr int BM = 256, BK = 64, HALF = 128, HTB = HALF * BK * 2, STAGE_BYTES = 8 * HTB, NXCD = 8, WGM = 8;
__host__ __device__ __forceinline__ int lds_byte(int r, int c) { const int st = (r >> 4) * 2 + (c >> 5), rr = r & 15, cc = c & 31, ob = rr * 64 + cc * 2; return st * 1024 + (ob ^ (((ob >> 9) & 1) << 5)); }
__host__ __device__ __forceinline__ void stage_rc(int b, int& R, int& C) { const int st = b / 1024, sb = b % 1024, swz = sb ^ (((sb >> 9) & 1) << 5); R = (st >> 1) * 16 + swz / 64; C = (st & 1) * 32 + (swz % 64) / 2; }
__host__ __device__ __forceinline__ int perm32(int rho) { const int n = rho >> 4, i = rho & 15; return 8 * (i >> 2) + 4 * n + (i & 3); }

typedef int i32x4_t __attribute__((ext_vector_type(4)));
typedef int i32x8_t __attribute__((ext_vector_type(8)));
typedef long i64x2_t __attribute__((ext_vector_type(2)));
struct Unit { int pm, pn, e, mt, cnt; };

template <int BMAP> __device__ __forceinline__ int brow(int R) { return BMAP == 0 ? ((R >> 5) * 64 + perm32(R & 31)) : BMAP == 1 ? ((R & ~31) + perm32(R & 31)) : ((R >> 5) * 64 + 16 * ((R & 15) >> 2) + 4 * ((R >> 4) & 1) + (R & 3)); }

struct StaticOrder {
    int nM, nN, nwg, G, c;
    __device__ void init(int M, int N, int G_, int c_) { nM = M / BM; nN = N / BM; nwg = nM * nN; G = G_; c = c_; }
    __device__ bool next(int i, Unit& u) const {
        const long L = (long)i * G + c; if (L >= nwg) return false;
        int wgid = (int)L; { const int q = nwg / NXCD, r = nwg % NXCD, xcd = wgid % NXCD, off = wgid / NXCD; wgid = (xcd < r ? xcd * (q + 1) : r * (q + 1) + (xcd - r) * q) + off; }
        const int nig = WGM * nN, gid = wgid / nig, fm = gid * WGM, gsz = (nM - fm) < WGM ? (nM - fm) : WGM;
        u.pm = fm + ((wgid % nig) % gsz); u.pn = (wgid % nig) / gsz; u.e = 0; u.mt = 0; u.cnt = 0; return true;
    }
    __device__ bool next_lane(int i, Unit& u) const { return next(i, u); }
};
struct GroupedOrder {
    const LAS int* tp; const LAS int* cn; int NTN, G, c;
    __device__ bool next_lane(int i, Unit& u) const {
        const int nwg = tp[NEXP] * NTN; const long L = (long)i * G + c; if (L >= nwg) return false;
        int wgid = (int)L; { const int q = nwg / NXCD, r = nwg % NXCD, xcd = wgid % NXCD, off = wgid / NXCD; wgid = (xcd < r ? xcd * (q + 1) : r * (q + 1) + (xcd - r) * q) + off; }
        int e = 0; while (e < NEXP - 1 && wgid >= tp[e + 1] * NTN) ++e;
        const int idx = wgid - tp[e] * NTN, tiles = tp[e + 1] - tp[e];
        const int nig = 4 * NTN, gid = idx / nig, fm = gid * 4, gsz = (tiles - fm) < 4 ? (tiles - fm) : 4;
        u.mt = fm + ((idx % nig) % gsz); u.pn = (idx % nig) / gsz; u.e = e; u.pm = tp[e] + u.mt; u.cnt = cn[e]; return true;
    }
};
struct TableOrder {
    const LAS int* tab; int n;
    __device__ __forceinline__ bool next(int i, Unit& u) const {
        if (i >= n) return false;
        const LAS int* t = tab + i * 8;
        u.pm = __builtin_amdgcn_readfirstlane(t[0]); u.pn = __builtin_amdgcn_readfirstlane(t[1]); u.e = __builtin_amdgcn_readfirstlane(t[2]);
        u.mt = __builtin_amdgcn_readfirstlane(t[3]); u.cnt = __builtin_amdgcn_readfirstlane(t[4]); return true;
    }
};
template <class Sched> __device__ __forceinline__ TableOrder build_unit_table(const Sched& S, LAS int* tab) {
    __syncthreads();
    if (threadIdx.x < 32) { Unit u; const bool ok = S.next_lane((int)threadIdx.x, u);
        if (ok) { LAS int* t = tab + threadIdx.x * 8; t[0] = u.pm; t[1] = u.pn; t[2] = u.e; t[3] = u.mt; t[4] = u.cnt; }
        const unsigned long long m = __ballot(ok); if (threadIdx.x == 0) tab[256] = __popcll(m); }
    __syncthreads();
    TableOrder T; T.tab = tab; T.n = __builtin_amdgcn_readfirstlane(tab[256]); return T;
}
struct DenseProb {
    static constexpr bool GATHER = false; static constexpr int BMAP = 0; static constexpr bool F8 = false; static constexpr bool I8 = false;
    const bf16_t* A; const bf16_t* Bt; int lda, ldb, K;
    __device__ __forceinline__ const char* a_base(const Unit& u) const { return (const char*)(A + (size_t)u.pm * BM * lda); }
    __device__ __forceinline__ const char* b_base(const Unit& u) const { return (const char*)(Bt + (size_t)u.pn * BM * ldb); }
    __device__ __forceinline__ size_t bhstep() const { return (size_t)32 * ldb * 2; }
    __device__ __forceinline__ unsigned a_off(const Unit&, int, int) const { return 0u; }
    __device__ __forceinline__ unsigned a_raw(const Unit&, int) const { return 0u; }
};
struct DenseProbI8 {
    static constexpr bool GATHER = false; static constexpr int BMAP = 0; static constexpr bool F8 = true; static constexpr bool I8 = true;
    const unsigned char* A; const unsigned char* Bt; int lda, ldb, K;
    __device__ __forceinline__ const char* a_base(const Unit& u) const { return (const char*)(A + (size_t)u.pm * BM * lda); }
    __device__ __forceinline__ const char* b_base(const Unit& u) const { return (const char*)(Bt + (size_t)u.pn * BM * ldb); }
    __device__ __forceinline__ size_t bhstep() const { return (size_t)32 * ldb; }
    __device__ __forceinline__ unsigned a_off(const Unit&, int, int) const { return 0u; }
    __device__ __forceinline__ unsigned a_raw(const Unit&, int) const { return 0u; }
};
struct GuProb {
    static constexpr bool GATHER = true; static constexpr int BMAP = 1; static constexpr bool F8 = true; static constexpr bool I8 = false;
    const unsigned char* XG; const unsigned char* Wt; const u32x2* list; int lda, ldb, K;
    __device__ __forceinline__ const char* a_base(const Unit&) const { return (const char*)XG; }
    __device__ __forceinline__ const char* b_base(const Unit& u) const { return (const char*)(Wt + ((size_t)u.e * 2048 + 128 * u.pn) * 1024); }
    __device__ __forceinline__ size_t bhstep() const { return (size_t)1024 * 1024; }
    __device__ __forceinline__ unsigned a_raw(const Unit& u, int r) const { const int rr = u.mt * BM + r, rc = rr < u.cnt ? rr : u.cnt - 1; return list[(size_t)u.e * CAP + rc].x; }
    __device__ __forceinline__ unsigned a_off(const Unit& u, int r, int C) const {
        const int rr = u.mt * BM + r, rc = rr < u.cnt ? rr : u.cnt - 1;
        const unsigned tok = list[(size_t)u.e * CAP + rc].x >> 2;
        return tok * 1024u + (unsigned)C * 2u;
    }
};
struct DownProb {
    static constexpr bool GATHER = false; static constexpr int BMAP = 2; static constexpr bool F8 = true; static constexpr bool I8 = false;
    const unsigned char* A; const unsigned char* Wt; int lda, ldb, K;
    __device__ __forceinline__ const char* a_base(const Unit& u) const { return (const char*)(A + (size_t)u.pm * BM * lda); }
    __device__ __forceinline__ const char* b_base(const Unit& u) const { return (const char*)(Wt + ((size_t)u.e * 1024 + 256 * u.pn) * 1024); }
    __device__ __forceinline__ size_t bhstep() const { return (size_t)8 * ldb; }
    __device__ __forceinline__ unsigned a_off(const Unit&, int, int) const { return 0u; }
    __device__ __forceinline__ unsigned a_raw(const Unit&, int) const { return 0u; }
};

template <class Prob> __device__ __forceinline__ void calc_aoff(const Prob& P, const Unit& u, const int (&Rr)[2], const int (&Cc)[2], unsigned (&o)[2][2]) {
#pragma unroll
    for (int h = 0; h < 2; ++h)
#pragma unroll
        for (int i = 0; i < 2; ++i) {
            if constexpr (Prob::GATHER) o[h][i] = P.a_off(u, h * HALF + Rr[i], Cc[i]);
            else o[h][i] = Prob::F8 ? (unsigned)((h * HALF + Rr[i]) * P.lda + Cc[i] * 2) : (unsigned)((h * HALF + Rr[i]) * P.lda + Cc[i]) * 2u;
        }
}

struct NoPost { __device__ __forceinline__ void operator()(int) const {} };
template <class Epi, class Prob, class Sched, bool ALIGN_EPI, class Post = NoPost>
__device__ __forceinline__ void gemm_phase(LAS unsigned char* lds, const Prob& P, const Sched& S, const Epi& E, const Post& PU = Post()) {
    const int tid = threadIdx.x, wid = __builtin_amdgcn_readfirstlane(tid >> 6), lane = tid & 63, wr = wid >> 2, wc = wid & 3, fr = lane & 15, fq = lane >> 4;
    const int K = P.K, nt = Prob::F8 ? K / 128 : K / BK;
    int Rr[2], Cc[2]; unsigned voffB[2];
#pragma unroll
    for (int i = 0; i < 2; ++i) { stage_rc(tid * 16 + i * 8192, Rr[i], Cc[i]); voffB[i] = Prob::F8 ? (unsigned)(brow<Prob::BMAP>(Rr[i]) * P.ldb + Cc[i] * 2) : (unsigned)(brow<Prob::BMAP>(Rr[i]) * P.ldb + Cc[i]) * 2u; }
    const size_t kstep = (size_t)(BK * 2);
    const size_t bhstep = P.bhstep();
    const unsigned ldsw = (unsigned)wid * 1024u;
    const int aoff = lds_byte(wr * 64 + fr, fq * 8), boff = lds_byte(wc * 32 + fr, fq * 8);
#define PG8_SA(b, h) (((b) * 2 + (h)) * HTB)
#define PG8_SB(b, h) ((4 + (b) * 2 + (h)) * HTB)
#define PG8_STG(bufoff, gptr, v0, v1) do { \
        __builtin_amdgcn_global_load_lds((const unsigned*)((const char*)(gptr) + (v0)), (LAS unsigned*)(lds + (bufoff) + ldsw), 16, 0, 0); \
        __builtin_amdgcn_global_load_lds((const unsigned*)((const char*)(gptr) + (v1)), (LAS unsigned*)(lds + (bufoff) + ldsw + 8192), 16, 0, 0); } while (0)
#define PG8_STGB(bufoff, gptr) PG8_STG(bufoff, gptr, voffB[0], voffB[1])
#define PG8_LDA(dst, b, h) do { _Pragma("unroll") for (int m = 0; m < 4; ++m) _Pragma("unroll") for (int k = 0; k < 2; ++k) dst[m][k] = *(const LAS bf16x8*)(lds + PG8_SA(b, h) + aoff + m * 2048 + k * 1024); } while (0)
#define PG8_LDB(dst, b, h) do { _Pragma("unroll") for (int n = 0; n < 2; ++n) _Pragma("unroll") for (int k = 0; k < 2; ++k) dst[n][k] = *(const LAS bf16x8*)(lds + PG8_SB(b, h) + boff + n * 2048 + k * 1024); } while (0)
#define PG8_MMAB(ai, bj, At, Bt) do { _Pragma("unroll") for (int m = 0; m < 4; ++m) _Pragma("unroll") for (int n = 0; n < 2; ++n) _Pragma("unroll") for (int k = 0; k < 2; ++k) \
        acc[ai][bj][m][n] = __builtin_amdgcn_mfma_f32_16x16x32_bf16(Bt[n][k], At[m][k], acc[ai][bj][m][n], 0, 0, 0); } while (0)
#define PG8_MMAQ(ai, bj, At, Bt) do { _Pragma("unroll") for (int m = 0; m < 4; ++m) _Pragma("unroll") for (int n = 0; n < 2; ++n) _Pragma("unroll") for (int k = 0; k < 2; ++k) { \
        const i64x2_t bq = __builtin_bit_cast(i64x2_t, Bt[n][k]), aq = __builtin_bit_cast(i64x2_t, At[m][k]); \
        acc[ai][bj][m][n] = __builtin_amdgcn_mfma_f32_16x16x32_fp8_fp8(bq[0], aq[0], acc[ai][bj][m][n], 0, 0, 0); \
        acc[ai][bj][m][n] = __builtin_amdgcn_mfma_f32_16x16x32_fp8_fp8(bq[1], aq[1], acc[ai][bj][m][n], 0, 0, 0); } } while (0)
#define PG8_MMA8(ai, bj, A8, B8) do { _Pragma("unroll") for (int m = 0; m < 4; ++m) _Pragma("unroll") for (int n = 0; n < 2; ++n) \
        asm volatile("v_mfma_f32_16x16x128_f8f6f4 %0, %1, %2, %0" : "+v"(acc[ai][bj][m][n]) : "v"(B8[n]), "v"(A8[m])); } while (0)
#define PG8_MMAI(ai, bj, At, Bt) do { _Pragma("unroll") for (int k = 0; k < 2; ++k) _Pragma("unroll") for (int m = 0; m < 4; ++m) _Pragma("unroll") for (int n = 0; n < 2; ++n) \
        asm volatile("v_mfma_i32_16x16x64_i8 %0, %1, %2, %0" : "+v"(acc[ai][bj][m][n]) : "v"(Bt[n][k]), "v"(At[m][k])); } while (0)
#define PG8_LDA8(dst, b, h) do { _Pragma("unroll") for (int m = 0; m < 4; ++m) { dst[m].lo = *(const LAS i32x4_t*)(lds + PG8_SA(b, h) + aoff + m * 2048); dst[m].hi = *(const LAS i32x4_t*)(lds + PG8_SA(b, h) + aoff + m * 2048 + 1024); } } while (0)
#define PG8_LDB8(dst, b, h) do { _Pragma("unroll") for (int n = 0; n < 2; ++n) { dst[n].lo = *(const LAS i32x4_t*)(lds + PG8_SB(b, h) + boff + n * 2048); dst[n].hi = *(const LAS i32x4_t*)(lds + PG8_SB(b, h) + boff + n * 2048 + 1024); } } while (0)
#define PG8_XLDA(b, h)  do { if constexpr (Prob::F8 && !Prob::I8 && F8MODE == 2) PG8_LDA8(At8, b, h); else PG8_LDA(At, b, h); } while (0)
#define PG8_XLDB0(b, h) do { if constexpr (Prob::F8 && !Prob::I8 && F8MODE == 2) PG8_LDB8(B08, b, h); else PG8_LDB(B0, b, h); } while (0)
#define PG8_XLDB1(b, h) do { if constexpr (Prob::F8 && !Prob::I8 && F8MODE == 2) PG8_LDB8(B18, b, h); else PG8_LDB(B1, b, h); } while (0)
#define PG8_XMMA0(ai, bj) do { if (USE_SETPRIO) __builtin_amdgcn_s_setprio(USE_SETPRIO); if constexpr (Prob::I8) PG8_MMAI(ai, bj, At, B0); else if constexpr (Prob::F8 && F8MODE == 2) PG8_MMA8(ai, bj, At8, B08); else if constexpr (Prob::F8) PG8_MMAQ(ai, bj, At, B0); else PG8_MMAB(ai, bj, At, B0); if (USE_SETPRIO) __builtin_amdgcn_s_setprio(0); } while (0)
#define PG8_XMMA1(ai, bj) do { if (USE_SETPRIO) __builtin_amdgcn_s_setprio(USE_SETPRIO); if constexpr (Prob::I8) PG8_MMAI(ai, bj, At, B1); else if constexpr (Prob::F8 && F8MODE == 2) PG8_MMA8(ai, bj, At8, B18); else if constexpr (Prob::F8) PG8_MMAQ(ai, bj, At, B1); else PG8_MMAB(ai, bj, At, B1); if (USE_SETPRIO) __builtin_amdgcn_s_setprio(0); } while (0)
#define PG8_WAIT_V(n) asm volatile("s_waitcnt vmcnt(" #n ")" ::: "memory")
#define PG8_WAIT_L(n) asm volatile("s_waitcnt lgkmcnt(" #n ")" ::: "memory")
#define PG8_BAR __builtin_amdgcn_s_barrier()
#define PG8_SCHED __builtin_amdgcn_sched_barrier(0)
    Unit cur, nxt; int ui = 0;
    if (!S.next(0, cur)) return;
    unsigned vo[2][2], nvo[2][2];
    calc_aoff(P, cur, Rr, Cc, vo);
    bool has_next = S.next(1, nxt);
    if constexpr (Prob::GATHER) { if (has_next) calc_aoff(P, nxt, Rr, Cc, nvo); else {
#pragma unroll
        for (int h = 0; h < 2; ++h)
#pragma unroll
            for (int i = 0; i < 2; ++i) nvo[h][i] = vo[h][i]; } }
    f32x4 acc[2][2][4][2];
#pragma unroll
    for (int a = 0; a < 2; ++a)
#pragma unroll
        for (int b = 0; b < 2; ++b)
#pragma unroll
            for (int m = 0; m < 4; ++m)
#pragma unroll
                for (int n = 0; n < 2; ++n) acc[a][b][m][n] = (f32x4){0.f, 0.f, 0.f, 0.f};
    bf16x8 At[4][2], B0[2][2], B1[2][2]; i32x8_t At8[4], B08[2], B18[2];
    const char* cA = P.a_base(cur); const char* cB = P.b_base(cur);
    if constexpr (Epi::HAS_PRE) E.pre(cur, 0, wid, lane);
    PG8_STGB(PG8_SB(0, 0), cB); PG8_STGB(PG8_SB(0, 1), cB + bhstep); PG8_STG(PG8_SA(0, 0), cA, vo[0][0], vo[0][1]); PG8_STG(PG8_SA(0, 1), cA, vo[1][0], vo[1][1]);
    if (wr == 1) PG8_BAR;
    PG8_WAIT_V(2); PG8_BAR;
    PG8_STGB(PG8_SB(1, 0), cB + kstep); PG8_STG(PG8_SA(1, 0), cA + kstep, vo[0][0], vo[0][1]); PG8_STGB(PG8_SB(1, 1), cB + bhstep + kstep);
    PG8_WAIT_V(6); PG8_BAR;
    for (;;) {
        const char* nA = has_next ? P.a_base(nxt) : cA; const char* nB = has_next ? P.b_base(nxt) : cB;
        for (int t = 0; t < nt; t += 2) {
            const bool last = (t == nt - 2);
            if constexpr (Epi::HAS_MID) { if (t == Epi::MID_T0 || t == Epi::MID_T1) { E.mid(acc, cur, wr, wc, fr, fq, t == Epi::MID_T0 ? 0 : 1); PG8_SCHED; } }
            const char* a1 = cA + (size_t)(t + 1) * kstep;
            const char* a2 = last ? nA : cA + (size_t)(t + 2) * kstep; const char* b2 = last ? nB : cB + (size_t)(t + 2) * kstep;
            const char* a3 = a2 + kstep; const char* b3 = b2 + kstep;
            unsigned x00 = vo[0][0], x01 = vo[0][1], x10 = vo[1][0], x11 = vo[1][1];
            if constexpr (Prob::GATHER) { if (last) { x00 = nvo[0][0]; x01 = nvo[0][1]; x10 = nvo[1][0]; x11 = nvo[1][1]; } }
            PG8_XLDB0(0, 0); PG8_XLDB1(0, 1); PG8_SCHED; PG8_XLDA(0, 0); PG8_STG(PG8_SA(1, 1), a1, vo[1][0], vo[1][1]);
            PG8_WAIT_V(8); PG8_WAIT_L(0); PG8_BAR; PG8_XMMA0(0, 0); PG8_XMMA1(0, 1); PG8_BAR; PG8_SCHED;
            PG8_XLDA(0, 1); PG8_STGB(PG8_SB(0, 0), b2); PG8_STGB(PG8_SB(0, 1), b2 + bhstep); PG8_STG(PG8_SA(0, 0), a2, x00, x01);
            PG8_WAIT_V(8); PG8_WAIT_L(0); PG8_BAR; PG8_XMMA0(1, 0); PG8_XMMA1(1, 1); PG8_BAR; PG8_SCHED;
            PG8_XLDB0(1, 0); PG8_XLDB1(1, 1); PG8_SCHED; PG8_XLDA(1, 0); PG8_STG(PG8_SA(0, 1), a2, x10, x11);
            PG8_WAIT_V(8); PG8_WAIT_L(0); PG8_BAR; PG8_XMMA0(0, 0); PG8_XMMA1(0, 1); PG8_BAR; PG8_SCHED;
            PG8_XLDA(1, 1); PG8_STGB(PG8_SB(1, 0), b3); PG8_STGB(PG8_SB(1, 1), b3 + bhstep); PG8_STG(PG8_SA(1, 0), a3, x00, x01);
            PG8_WAIT_V(8); PG8_WAIT_L(0); PG8_BAR; PG8_XMMA0(1, 0); PG8_XMMA1(1, 1); PG8_BAR; PG8_SCHED;
        }
        if constexpr (ALIGN_EPI) { if (wr == 0) PG8_BAR; }
        if constexpr ((Prob::F8 && F8MODE == 2) || Prob::I8) asm volatile("s_nop 15\n\ts_nop 15" ::: "memory");
        Unit nn; const bool has_nn = has_next && S.next(ui + 2, nn);
        if constexpr (Prob::GATHER) {
#pragma unroll
            for (int h = 0; h < 2; ++h)
#pragma unroll
                for (int i = 0; i < 2; ++i) vo[h][i] = nvo[h][i];
            if (has_nn) {
#pragma unroll
                for (int h = 0; h < 2; ++h)
#pragma unroll
                    for (int i = 0; i < 2; ++i) nvo[h][i] = P.a_raw(nn, h * HALF + Rr[i]); } }
        if constexpr (Epi::HAS_PRE) E(acc, cur, wr, wc, fr, fq, ui & 1); else E(acc, cur, wr, wc, fr, fq);
        PU(ui);
        if (!has_next) break;
#pragma unroll
        for (int a = 0; a < 2; ++a)
#pragma unroll
            for (int b = 0; b < 2; ++b)
#pragma unroll
                for (int m = 0; m < 4; ++m)
#pragma unroll
                    for (int n = 0; n < 2; ++n) acc[a][b][m][n] = (f32x4){0.f, 0.f, 0.f, 0.f};
        cur = nxt; cA = nA; cB = nB; ++ui;
        if constexpr (Epi::HAS_PRE) E.pre(cur, ui, wid, lane);
        has_next = has_nn; nxt = nn;
        if constexpr (Prob::GATHER) { if (has_next) {
#pragma unroll
            for (int h = 0; h < 2; ++h)
#pragma unroll
                for (int i = 0; i < 2; ++i) nvo[h][i] = (nvo[h][i] >> 2) * (Prob::F8 ? 1024u : 2048u) + (unsigned)Cc[i] * 2u;
            asm volatile("" : "+v"(nvo[0][0]), "+v"(nvo[0][1]), "+v"(nvo[1][0]), "+v"(nvo[1][1])); } }
        if constexpr (ALIGN_EPI) { if (wr == 1) PG8_BAR; }
    }
    PG8_WAIT_V(0);
    if constexpr (!ALIGN_EPI) { if (wr == 0) PG8_BAR; }
    PG8_BAR;
#undef PG8_SA
#undef PG8_SB
#undef PG8_STG
#undef PG8_STGB
#undef PG8_LDA
#undef PG8_LDB
#undef PG8_MMAB
#undef PG8_MMAQ
#undef PG8_MMA8
#undef PG8_MMAI
#undef PG8_LDA8
#undef PG8_LDB8
#undef PG8_XLDA
#undef PG8_XLDB0
#undef PG8_XLDB1
#undef PG8_XMMA0
#undef PG8_XMMA1
#undef PG8_WAIT_V
#undef PG8_WAIT_L
#undef PG8_BAR
#undef PG8_SCHED
}

typedef const f32x4 (&AccRef)[2][2][4][2];
__device__ __forceinline__ void dma4(const void* g, LAS unsigned char* dst) { __builtin_amdgcn_global_load_lds((const unsigned*)g, (LAS unsigned*)dst, 4, 0, 0); }

__device__ __forceinline__ void store8(bf16_t* p, const f32x4& a, const f32x4& b) {
    u32x4 w; w.x = cvt_pk_bf16(a[0], a[1]); w.y = cvt_pk_bf16(a[2], a[3]); w.z = cvt_pk_bf16(b[0], b[1]); w.w = cvt_pk_bf16(b[2], b[3]); *(u32x4*)p = w;
}
__device__ __forceinline__ float sigmoidf_(float v) { return __builtin_amdgcn_rcpf(1.0f + __builtin_amdgcn_exp2f(-1.4426950408889634f * v)); }

struct EpiInProj {
    static constexpr bool HAS_MID = false; static constexpr bool HAS_PRE = false;
    bf16_t *Q, *Kb, *V, *U, *MQ, *GT; const float *qn, *kn, *mqn, *bg; const f32x2* rope; const float* rs;
    __device__ __forceinline__ void operator()(AccRef acc, const Unit& u, int wr, int wc, int fr, int fq) const {
        const int pn = u.pn; const int row0 = u.pm * BM + wr * 64 + fr;
        float sc8[8];
#pragma unroll
        for (int q = 0; q < 8; ++q) sc8[q] = rs[row0 + (q >> 2) * HALF + (q & 3) * 16] * (1.0f / WQ_IN);
#define I2F(v) __builtin_convertvector(__builtin_bit_cast(i32x4_t, v), f32x4)
        bf16_t* const Q_ = Q; bf16_t* const K_ = Kb; bf16_t* const V_ = V; bf16_t* const U_ = U; bf16_t* const MQ_ = MQ; const float* const qn_ = qn; const float* const kn_ = kn; const float* const mqn_ = mqn;
        if (pn < 4 || pn == 7) {
            const bool rope_on = pn < 4; const float* gn = pn < 2 ? qn_ : (pn < 4 ? kn_ : mqn_);
            const float sc = (pn < 2 || pn == 7) ? C2 : 1.0f;
            bf16_t* O; int pitch, colb;
            if (pn < 2) { O = Q_; pitch = 512; colb = (pn * 4 + wc) * 64; } else if (pn < 4) { O = K_; pitch = 512; colb = ((pn - 2) * 4 + wc) * 64; } else { O = MQ_; pitch = 256; colb = wc * 64; }
            const f32x4 g00 = *(const f32x4*)(gn + 8 * fq), g01 = *(const f32x4*)(gn + 8 * fq + 4), g10 = *(const f32x4*)(gn + 32 + 8 * fq), g11 = *(const f32x4*)(gn + 32 + 8 * fq + 4);
#pragma unroll
            for (int ai = 0; ai < 2; ++ai)
#pragma unroll
                for (int m = 0; m < 4; ++m) {
                    const float rsc = sc8[ai * 4 + m]; const f32x4 a0 = I2F(acc[ai][0][m][0]) * rsc, a1 = I2F(acc[ai][0][m][1]) * rsc, b0 = I2F(acc[ai][1][m][0]) * rsc, b1 = I2F(acc[ai][1][m][1]) * rsc;
                    float ss = 0.f;
#pragma unroll
                    for (int j = 0; j < 4; ++j) ss += a0[j] * a0[j] + a1[j] * a1[j] + b0[j] * b0[j] + b1[j] * b1[j];
                    ss += __shfl_xor(ss, 16); ss += __shfl_xor(ss, 32);
                    const float rstd = 1.0f / sqrtf(ss * (1.0f / 64.0f) + RMS_EPS);
                    const int row = row0 + ai * HALF + m * 16;
                    f32x4 t10 = a0 * rstd * g00, t11 = a1 * rstd * g01, t20 = b0 * rstd * g10, t21 = b1 * rstd * g11;
                    f32x4 o10, o11, o20, o21;
                    if (rope_on) {
                        const f32x4* rp = (const f32x4*)(rope + (size_t)(row & (SEQ - 1)) * 32 + 8 * fq);
                        const f32x4 r0 = rp[0], r1 = rp[1], r2 = rp[2], r3 = rp[3];
                        const f32x4 cs0 = {r0[0], r0[2], r1[0], r1[2]}, sn0 = {r0[1], r0[3], r1[1], r1[3]}, cs1 = {r2[0], r2[2], r3[0], r3[2]}, sn1 = {r2[1], r2[3], r3[1], r3[3]};
                        o10 = (t10 * cs0 - t20 * sn0) * sc; o11 = (t11 * cs1 - t21 * sn1) * sc; o20 = (t20 * cs0 + t10 * sn0) * sc; o21 = (t21 * cs1 + t11 * sn1) * sc;
                    } else { o10 = t10 * sc; o11 = t11 * sc; o20 = t20 * sc; o21 = t21 * sc; }
                    bf16_t* rowp = O + (size_t)row * pitch + colb + 8 * fq;
                    store8(rowp, o10, o11); store8(rowp + 32, o20, o21);
                }
        } else if (pn < 7) {
            bf16_t* O; int pitch, colb;
            if (pn < 6) { O = V_; pitch = 512; colb = (pn - 4) * 256 + wc * 64; } else { O = U_; pitch = 256; colb = wc * 64; }
#pragma unroll
            for (int ai = 0; ai < 2; ++ai)
#pragma unroll
                for (int m = 0; m < 4; ++m) { bf16_t* rowp = O + (size_t)(row0 + ai * HALF + m * 16) * pitch + colb + 8 * fq;
                    const float sc = sc8[ai * 4 + m]; store8(rowp, I2F(acc[ai][0][m][0]) * sc, I2F(acc[ai][0][m][1]) * sc); store8(rowp + 32, I2F(acc[ai][1][m][0]) * sc, I2F(acc[ai][1][m][1]) * sc); }
        } else {
            const int gc = (pn - 8) * 256 + wc * 64 + 8 * fq;
            f32x4 bv[2][2];
#pragma unroll
            for (int bj = 0; bj < 2; ++bj)
#pragma unroll
                for (int n = 0; n < 2; ++n) bv[bj][n] = *(const f32x4*)(bg + gc + 32 * bj + 4 * n) * (-1.4426950408889634f);
#pragma unroll
            for (int ai = 0; ai < 2; ++ai)
#pragma unroll
                for (int m = 0; m < 4; ++m) {
                    unsigned char* blk = (unsigned char*)GT + ((size_t)(((pn - 8) >> 2) * 128 + u.pm) * 4 + ((pn - 8) & 3)) * 65536 + (size_t)((wr * 4 + wc) * 8 * 64 + (fq * 16 + fr)) * 16;
                    u32x4 w4 = {0u, 0u, 0u, 0u};
#pragma unroll
                    for (int bj = 0; bj < 2; ++bj) { const float scl = sc8[ai * 4 + m] * (-1.4426950408889634f); f32x4 v0 = I2F(acc[ai][bj][m][0]) * scl + bv[bj][0], v1 = I2F(acc[ai][bj][m][1]) * scl + bv[bj][1];
                        unsigned wx = 0u, wy = 0u;
#pragma unroll
                        for (int j = 0; j < 4; ++j) { const float g0 = __builtin_amdgcn_rcpf(1.0f + __builtin_amdgcn_exp2f(v0[j])), g1 = __builtin_amdgcn_rcpf(1.0f + __builtin_amdgcn_exp2f(v1[j]));
                            wx = __builtin_amdgcn_cvt_pk_u8_f32(fmaxf(g0 * 255.0f + 0.25f, 1.0f), j, wx); wy = __builtin_amdgcn_cvt_pk_u8_f32(fmaxf(g1 * 255.0f + 0.25f, 1.0f), j, wy); }
                        if (bj == 0) { w4.x = wx; w4.y = wy; } else { w4.z = wx; w4.w = wy; } }
                    *(u32x4*)(blk + (ai * 4 + m) * 1024) = w4; }
        }
    }
};
#undef I2F
struct EpiMemKV {
    static constexpr bool HAS_MID = false; static constexpr bool HAS_PRE = false;
    bf16_t* MKV; const float* mkn;
    __device__ __forceinline__ void operator()(AccRef acc, const Unit& u, int wr, int wc, int fr, int fq) const {
        const int row0 = u.pm * BM + wr * 64 + fr;
        f32x4 g00 = {1.f, 1.f, 1.f, 1.f}, g01 = g00, g10 = g00, g11 = g00;
        if (u.pn == 0) { g00 = *(const f32x4*)(mkn + 8 * fq); g01 = *(const f32x4*)(mkn + 8 * fq + 4); g10 = *(const f32x4*)(mkn + 32 + 8 * fq); g11 = *(const f32x4*)(mkn + 32 + 8 * fq + 4); }
#pragma unroll
        for (int ai = 0; ai < 2; ++ai)
#pragma unroll
            for (int m = 0; m < 4; ++m) {
                const f32x4 a0 = acc[ai][0][m][0], a1 = acc[ai][0][m][1], b0 = acc[ai][1][m][0], b1 = acc[ai][1][m][1];
                float rstd = 1.0f;
                if (u.pn == 0) { float ss = 0.f;
#pragma unroll
                    for (int j = 0; j < 4; ++j) ss += a0[j] * a0[j] + a1[j] * a1[j] + b0[j] * b0[j] + b1[j] * b1[j];
                    ss += __shfl_xor(ss, 16); ss += __shfl_xor(ss, 32); rstd = 1.0f / sqrtf(ss * (1.0f / 64.0f) + RMS_EPS); }
                bf16_t* rowp = MKV + (size_t)(row0 + ai * HALF + m * 16) * 512 + u.pn * 256 + wc * 64 + 8 * fq;
                store8(rowp, a0 * rstd * g00, a1 * rstd * g01); store8(rowp + 32, b0 * rstd * g10, b1 * rstd * g11);
            }
    }
};
template <int STAGE> struct EpiMerge {
    static constexpr bool HAS_MID = false; static constexpr bool HAS_PRE = false;
    const bf16_t* GT; float* MF; bf16_t* MB;
    __device__ __forceinline__ void operator()(AccRef acc, const Unit& u, int wr, int wc, int fr, int fq) const {
        const int row0 = u.pm * BM + wr * 64 + fr, col0 = u.pn * BM + wc * 64 + 8 * fq;
#pragma unroll
        for (int ai = 0; ai < 2; ++ai)
#pragma unroll
            for (int m = 0; m < 4; ++m) { const size_t row = (size_t)(row0 + ai * HALF + m * 16);
#pragma unroll
                for (int bj = 0; bj < 2; ++bj) { const int col = col0 + 32 * bj;
                    const u32x4 g = *(const u32x4*)(GT + row * 3072 + STAGE * 1024 + col);
                    const f32x4 ga = {bf_lo(g.x), bf_hi(g.x), bf_lo(g.y), bf_hi(g.y)}, gb = {bf_lo(g.z), bf_hi(g.z), bf_lo(g.w), bf_hi(g.w)};
                    f32x4 v0 = acc[ai][bj][m][0] * ga, v1 = acc[ai][bj][m][1] * gb;
                    float* mp = MF + row * 1024 + col;
                    if (STAGE > 0) { v0 += *(const f32x4*)mp; v1 += *(const f32x4*)(mp + 4); }
                    if (STAGE < 2) { *(f32x4*)mp = v0; *(f32x4*)(mp + 4) = v1; } else store8(MB + row * 1024 + col, v0, v1); }
                if (m & 1) asm volatile("" ::: "memory"); }
    }
};
__device__ __forceinline__ u32x4 pair16(const u32x2& a, const u32x2& b) {
    const auto rx = __builtin_amdgcn_permlane16_swap(a.x, b.x, false, false), ry = __builtin_amdgcn_permlane16_swap(a.y, b.y, false, false);
    return (u32x4){rx[0], ry[0], rx[1], ry[1]};
}
struct EpiWout {
    static constexpr bool HAS_MID = false; static constexpr bool HAS_PRE = false;
    const float* X; float* X2; unsigned char* XG; const float* n2;
    __device__ __forceinline__ void operator()(AccRef acc, const Unit& u, int wr, int wc, int fr, int fq) const {
        const int row0 = u.pm * BM + wr * 64 + fr, col0 = u.pn * BM + wc * 64 + 8 * fq;
        f32x4 nv[2][2];
#pragma unroll
        for (int bj = 0; bj < 2; ++bj)
#pragma unroll
            for (int n = 0; n < 2; ++n) nv[bj][n] = *(const f32x4*)(n2 + col0 + 32 * bj + 4 * n);
        const size_t xgoff = (size_t)(row0 + 16 * (fq & 1)) * 1024 + u.pn * BM + wc * 64 + 8 * (fq & 2);
#pragma unroll
        for (int ai = 0; ai < 2; ++ai) {
            f32x4 xv[4][2][2];
#pragma unroll
            for (int m = 0; m < 4; ++m)
#pragma unroll
                for (int bj = 0; bj < 2; ++bj) { const float* xp = X + (size_t)(row0 + ai * HALF + m * 16) * 1024 + col0 + 32 * bj; xv[m][bj][0] = *(const f32x4*)xp; xv[m][bj][1] = *(const f32x4*)(xp + 4); }
            asm volatile("" ::: "memory");
#pragma unroll
            for (int mp = 0; mp < 2; ++mp) { u32x2 w8[2][2];
#pragma unroll
                for (int mm = 0; mm < 2; ++mm) { const int m = 2 * mp + mm; const size_t off = (size_t)(row0 + ai * HALF + m * 16) * 1024 + col0;
#pragma unroll
                    for (int bj = 0; bj < 2; ++bj) { const f32x4 x0 = xv[m][bj][0] + acc[ai][bj][m][0], x1 = xv[m][bj][1] + acc[ai][bj][m][1];
                        *(f32x4*)(X2 + off + 32 * bj) = x0; *(f32x4*)(X2 + off + 32 * bj + 4) = x1;
                        const f32x4 y0 = x0 * nv[bj][0], y1 = x1 * nv[bj][1]; w8[mm][bj].x = pk4_fp8(y0[0], y0[1], y0[2], y0[3]); w8[mm][bj].y = pk4_fp8(y1[0], y1[1], y1[2], y1[3]); } }
#pragma unroll
                for (int bj = 0; bj < 2; ++bj) *(u32x4*)(XG + xgoff + (size_t)(ai * HALF + mp * 32) * 1024 + 32 * bj) = pair16(w8[0][bj], w8[1][bj]); }
            asm volatile("" ::: "memory"); }
    }
};
struct EpiSwiglu {
    static constexpr bool HAS_MID = false; static constexpr bool HAS_PRE = true;
    unsigned char* ACT; const u32x2* list; const float* bgu; LAS unsigned char* xb;
    __device__ __forceinline__ void pre(const Unit& u, int ui, int wid, int lane) const {
        LAS unsigned char* b = xb + (ui & 1) * 2048;
        if (wid < 4) { const int rr = u.mt * BM + 64 * wid + lane, rc = rr < u.cnt ? rr : u.cnt - 1; dma4((const unsigned*)(list + (size_t)u.e * CAP + rc) + 1, b + wid * 256); }
        else { const int j = 64 * (wid - 4) + lane; dma4(bgu + (size_t)u.e * 2048 + 128 * u.pn + (j < 128 ? j : 1024 + (j - 128)), b + 1024 + (wid - 4) * 256); }
    }
    __device__ __forceinline__ static unsigned swi4(const f32x4& ag, const f32x4& au, float rstd, const f32x4& bg, const f32x4& bu) {
        unsigned w = 0;
#pragma unroll
        for (int h = 0; h < 2; ++h) {
            const f32x2 a2 = {ag[2 * h], ag[2 * h + 1]}, u2 = {au[2 * h], au[2 * h + 1]}, bg2 = {bg[2 * h], bg[2 * h + 1]}, bu2 = {bu[2 * h], bu[2 * h + 1]};
            const f32x2 G = a2 * rstd + bg2, U = u2 * rstd + bu2;
            const f32x2 gg = {fminf(G[0], 7.0f), fminf(G[1], 7.0f)};
            const f32x2 t = gg * (-1.702f * 1.4426950408889634f);
            const f32x2 d = (f32x2){__builtin_amdgcn_exp2f(t[0]), __builtin_amdgcn_exp2f(t[1])} + 1.0f;
            const f32x2 r = {__builtin_amdgcn_rcpf(d[0]), __builtin_amdgcn_rcpf(d[1])};
            const f32x2 uu = {__builtin_amdgcn_fmed3f(U[0], -7.0f, 7.0f), __builtin_amdgcn_fmed3f(U[1], -7.0f, 7.0f)};
            const f32x2 o = (gg * r) * (uu * A8_SCALE + A8_SCALE);
            w = h ? (unsigned)__builtin_amdgcn_cvt_pk_fp8_f32(o[0], o[1], (int)w, true) : (unsigned)__builtin_amdgcn_cvt_pk_fp8_f32(o[0], o[1], (int)w, false);
        }
        return w;
    }
    __device__ __forceinline__ void operator()(AccRef acc, const Unit& u, int wr, int wc, int fr, int fq, int par) const {
        int z = 0; asm volatile("" : "+v"(z));
        const int col = 128 * u.pn + 32 * wc + 8 * fq + z; const LAS unsigned char* b = xb + par * 2048; const LAS unsigned char* bb = b + 1024 + (32 * wc + 8 * fq + z) * 4;
        const f32x4 bg0 = *(const LAS f32x4*)bb, bg1 = *(const LAS f32x4*)(bb + 16), bu0 = *(const LAS f32x4*)(bb + 512), bu1 = *(const LAS f32x4*)(bb + 528);
        unsigned char* const ap = ACT + (size_t)(u.pm * BM + wr * 64 + fr + 16 * (fq & 1)) * 1024 + 128 * u.pn + 32 * wc + 8 * (fq & 2) + z;
#pragma unroll
        for (int ai = 0; ai < 2; ++ai)
#pragma unroll
            for (int mp = 0; mp < 2; ++mp) { u32x2 w8[2];
#pragma unroll
                for (int mm = 0; mm < 2; ++mm) { const int m = 2 * mp + mm, r = ai * HALF + wr * 64 + m * 16 + fr;
                    const float rstd = *(const LAS float*)(b + (r + z) * 4) * (1.0f / W8_SCALE);
                    w8[mm].x = swi4(acc[ai][0][m][0], acc[ai][1][m][0], rstd, bg0, bu0); w8[mm].y = swi4(acc[ai][0][m][1], acc[ai][1][m][1], rstd, bg1, bu1); }
                *(u32x4*)(ap + (size_t)(ai * HALF + mp * 32) * 1024) = pair16(w8[0], w8[1]); }
    }
};
struct EpiDown {
    static constexpr bool HAS_MID = false; static constexpr bool HAS_PRE = true;
    unsigned char* Y4; const u32x2* list; const float* bd; LAS unsigned char* xb;
    __device__ __forceinline__ void pre(const Unit& u, int ui, int wid, int lane) const {
        LAS unsigned char* b = xb + (ui & 1) * 2048;
        if (wid < 4) { const int rr = u.mt * BM + 64 * wid + lane, rc = rr < u.cnt ? rr : u.cnt - 1; dma4((const unsigned*)(list + (size_t)u.e * CAP + rc), b + wid * 256); }
        else { const int j = 64 * (wid - 4) + lane; dma4(bd + (size_t)u.e * 1024 + u.pn * BM + j, b + 1024 + (wid - 4) * 256); }
    }
    __device__ __forceinline__ static unsigned dn4(const f32x4& a, const f32x4& b32) {
        const f32x4 y = a * (Y8_SCALE / (W8_SCALE * A8_SCALE)) + b32;
        return pk4_fp8(y[0], y[1], y[2], y[3]);
    }
    __device__ __forceinline__ void operator()(AccRef acc, const Unit& u, int wr, int wc, int fr, int fq, int par) const {
        int z = 0; asm volatile("" : "+v"(z));
        const int colw = wc * 64 + 16 * fq + z, col0 = u.pn * BM + colw;
        const LAS unsigned char* b = xb + par * 2048;
        f32x4 bv[2][2];
#pragma unroll
        for (int bj = 0; bj < 2; ++bj)
#pragma unroll
            for (int n = 0; n < 2; ++n) bv[bj][n] = *(const LAS f32x4*)(b + 1024 + (colw + 8 * bj + 4 * n) * 4) * Y8_SCALE;
#pragma unroll
        for (int ai = 0; ai < 2; ++ai)
#pragma unroll
            for (int m = 0; m < 4; ++m) { const int r = ai * HALF + wr * 64 + m * 16 + fr, rr = u.mt * BM + r;
                if (rr < u.cnt) { const unsigned tk = *(const LAS unsigned*)(b + (r + z) * 4);
                    u32x4 w8; w8.x = dn4(acc[ai][0][m][0], bv[0][0]); w8.y = dn4(acc[ai][0][m][1], bv[0][1]); w8.z = dn4(acc[ai][1][m][0], bv[1][0]); w8.w = dn4(acc[ai][1][m][1], bv[1][1]);
                    *(u32x4*)(Y4 + (size_t)tk * 1024 + col0) = w8; } }
    }
};
struct EpiMergeR {
    static constexpr bool HAS_MID = true; static constexpr bool HAS_PRE = false; static constexpr int MID_T0 = 8, MID_T1 = 12;
    const bf16_t* GT; bf16_t* MB;
    __device__ __forceinline__ void mid(f32x4 (&acc)[2][2][4][2], const Unit& u, int wr, int wc, int fr, int fq, int seam) const {
        int z = 0; asm volatile("" : "+v"(z));
        const unsigned char* gp0 = (const unsigned char*)GT + ((size_t)(seam * 128 + u.pm) * 4 + u.pn) * 65536 + (size_t)((wr * 4 + wc) * 8 * 64 + (fq * 16 + fr) + z) * 16;
        u32x4 gnv[8], gdv[8];
#pragma unroll
        for (int k = 0; k < 8; ++k) { gnv[k] = *(const u32x4*)(gp0 + k * 1024); gdv[k] = *(const u32x4*)(gp0 + k * 1024 + (size_t)128 * 4 * 65536); }
        asm volatile("" ::: "memory");
#pragma unroll
        for (int ai = 0; ai < 2; ++ai)
#pragma unroll
            for (int m = 0; m < 4; ++m) { const u32x4 gn = gnv[ai * 4 + m], gd = gdv[ai * 4 + m];
#pragma unroll
                for (int bj = 0; bj < 2; ++bj)
#pragma unroll
                    for (int n = 0; n < 2; ++n) { const unsigned wn = gn[bj * 2 + n], wd = gd[bj * 2 + n];
#pragma unroll
                        for (int j = 0; j < 4; ++j) acc[ai][bj][m][n][j] *= (float)((wn >> (8 * j)) & 0xffu) * __builtin_amdgcn_rcpf((float)((wd >> (8 * j)) & 0xffu)); } }
    }
    __device__ __forceinline__ void operator()(AccRef acc, const Unit& u, int wr, int wc, int fr, int fq) const {
        int z = 0; asm volatile("" : "+v"(z));
        const size_t off0 = (size_t)(u.pm * BM + wr * 64 + fr + z) * 1024 + u.pn * BM + wc * 64 + 8 * fq;
        const unsigned char* gp0 = (const unsigned char*)GT + ((size_t)(2 * 128 + u.pm) * 4 + u.pn) * 65536 + (size_t)((wr * 4 + wc) * 8 * 64 + (fq * 16 + fr) + z) * 16;
        u32x4 g4v[8];
#pragma unroll
        for (int k = 0; k < 8; ++k) g4v[k] = *(const u32x4*)(gp0 + k * 1024);
        asm volatile("" ::: "memory");
#pragma unroll
        for (int ai = 0; ai < 2; ++ai)
#pragma unroll
            for (int m = 0; m < 4; ++m) { const size_t ro = off0 + (size_t)(ai * HALF + m * 16) * 1024;
                const u32x4 g4 = g4v[ai * 4 + m];
#pragma unroll
                for (int bj = 0; bj < 2; ++bj) { const unsigned gx = g4[bj * 2], gy = g4[bj * 2 + 1];
                    f32x4 ga, gb;
#pragma unroll
                    for (int j = 0; j < 4; ++j) { ga[j] = (float)((gx >> (8 * j)) & 0xffu) * (1.0f / 255.0f); gb[j] = (float)((gy >> (8 * j)) & 0xffu) * (1.0f / 255.0f); }
                    store8(MB + ro + 32 * bj, acc[ai][bj][m][0] * ga, acc[ai][bj][m][1] * gb); } }
    }
};
struct EpiPlain {
    static constexpr bool HAS_MID = false; static constexpr bool HAS_PRE = false;
    bf16_t* Z; int ldz;
    __device__ __forceinline__ void operator()(AccRef acc, const Unit& u, int wr, int wc, int fr, int fq) const {
        const int row0 = u.pm * BM + wr * 64 + fr, col0 = u.pn * BM + wc * 64 + 8 * fq;
#pragma unroll
        for (int ai = 0; ai < 2; ++ai)
#pragma unroll
            for (int m = 0; m < 4; ++m) { bf16_t* rowp = Z + (size_t)(row0 + ai * HALF + m * 16) * ldz + col0;
                store8(rowp, acc[ai][0][m][0], acc[ai][0][m][1]); store8(rowp + 32, acc[ai][1][m][0], acc[ai][1][m][1]); }
    }
};
}

namespace attn_body {
using bf16 = __hip_bfloat16;
using s16x4 = __attribute__((ext_vector_type(4))) short;
constexpr int NW = 8, QBLK = 32, QB = QBLK * NW, KVBLK = 64, D = 64;
__device__ __forceinline__ int crow(int r, int hi) { return (r & 3) + 8 * (r >> 2) + 4 * hi; }
#define SBAR() __builtin_amdgcn_sched_barrier(0)
constexpr int NSLOT = 3, SLOTB = 8192;
constexpr int LDS_K = 0, LDS_V = NSLOT * SLOTB, LDS_WS = 2 * NSLOT * SLOTB, LDS_OST = LDS_WS + NW * 64 * 4, LDS_BYTES = LDS_OST + NW * 4096;
__device__ __forceinline__ void glds16(const void* gsrc, unsigned lds_dst) { unsigned keep;
    asm volatile("s_mov_b32 %0, m0\n\ts_mov_b32 m0, %2\n\ts_nop 0\n\tglobal_load_lds_dwordx4 %1, off\n\ts_mov_b32 m0, %0" : "=&s"(keep) : "v"(gsrc), "s"(lds_dst) : "memory"); }
__device__ __forceinline__ float max3f(float a, float b, float c) { float r; asm("v_max3_f32 %0, %1, %2, %3" : "=v"(r) : "v"(a), "v"(b), "v"(c)); return r; }
__device__ __forceinline__ float max2f(float a, float b) { float r; asm("v_max_f32_e32 %0, %1, %2" : "=v"(r) : "v"(a), "v"(b)); return r; }
__device__ __forceinline__ float fadd_s(float a, float b) { float r; asm("v_add_f32_e32 %0, %1, %2" : "=v"(r) : "v"(a), "v"(b)); return r; }
__device__ __forceinline__ float fsub_s(float a, float b) { float r; asm("v_sub_f32_e32 %0, %1, %2" : "=v"(r) : "v"(a), "v"(b)); return r; }
typedef float f32x2_t __attribute__((ext_vector_type(2))); typedef __bf16 bf16x2_t __attribute__((ext_vector_type(2)));
__device__ __forceinline__ unsigned cvtpk_s(float lo, float hi) { f32x2_t v = {lo, hi}; bf16x2_t b = __builtin_convertvector(v, bf16x2_t); return __builtin_bit_cast(unsigned, b); }
#define WAIT_BAR(N) asm volatile("s_waitcnt vmcnt(" #N ") lgkmcnt(0)\n\ts_barrier" ::: "memory")

__device__ __forceinline__ void qkt(f32x16& p0, f32x16& p1, const char* Kslot, const bf16x8* qr, const f32x16& negm, int r32, int hi) {
    const char* kb = Kslot + hi * 1024 + r32 * 16;
#pragma unroll
    for (int d0 = 0; d0 < 4; ++d0) {
        const bf16x8 b0 = *reinterpret_cast<const bf16x8*>(kb + d0 * 2048);
        const bf16x8 b1 = *reinterpret_cast<const bf16x8*>(kb + d0 * 2048 + 512);
        if (d0 == 0) { p0 = __builtin_amdgcn_mfma_f32_32x32x16_bf16(b0, qr[0], negm, 0, 0, 0); p1 = __builtin_amdgcn_mfma_f32_32x32x16_bf16(b1, qr[0], negm, 0, 0, 0); }
        else { p0 = __builtin_amdgcn_mfma_f32_32x32x16_bf16(b0, qr[d0], p0, 0, 0, 0); p1 = __builtin_amdgcn_mfma_f32_32x32x16_bf16(b1, qr[d0], p1, 0, 0, 0); } }
}
typedef __attribute__((address_space(3))) const char* lds_cptr;
typedef short v4i16_t __attribute__((ext_vector_type(4)));
__device__ __forceinline__ void kload8(bf16x8* kf, lds_cptr kp) {
    kf[0] = *(const __attribute__((address_space(3))) bf16x8*)(kp);        kf[1] = *(const __attribute__((address_space(3))) bf16x8*)(kp + 512);
    kf[2] = *(const __attribute__((address_space(3))) bf16x8*)(kp + 2048); kf[3] = *(const __attribute__((address_space(3))) bf16x8*)(kp + 2560);
    kf[4] = *(const __attribute__((address_space(3))) bf16x8*)(kp + 4096); kf[5] = *(const __attribute__((address_space(3))) bf16x8*)(kp + 4608);
    kf[6] = *(const __attribute__((address_space(3))) bf16x8*)(kp + 6144); kf[7] = *(const __attribute__((address_space(3))) bf16x8*)(kp + 6656);
}
__device__ __forceinline__ void kload2(bf16x8* kf, lds_cptr kp, int j) { kf[2 * j] = *(const __attribute__((address_space(3))) bf16x8*)(kp + j * 2048); kf[2 * j + 1] = *(const __attribute__((address_space(3))) bf16x8*)(kp + j * 2048 + 512); }
__device__ __forceinline__ s16x4 vtr(lds_cptr p) { return __builtin_bit_cast(s16x4, __builtin_amdgcn_ds_read_tr16_b64_v4i16((__attribute__((address_space(3))) v4i16_t*)p)); }
__device__ __forceinline__ float rowmax(const f32x16& p0, const f32x16& p1) {
    float a = max3f(p0[0], p0[1], p1[0]), b = max3f(p0[2], p0[3], p1[1]); a = max3f(a, p1[2], p1[3]);
#pragma unroll
    for (int r = 4; r < 16; r += 4) { a = max3f(a, p0[r], p0[r + 1]); b = max3f(b, p0[r + 2], p0[r + 3]); a = max3f(a, p1[r], p1[r + 1]); b = max3f(b, p1[r + 2], p1[r + 3]); }
    const float m = max2f(a, b);
    auto rr = __builtin_amdgcn_permlane32_swap(__float_as_uint(m), __float_as_uint(m), false, false);
    return max2f(__uint_as_float(rr[0]), __uint_as_float(rr[1]));
}
__device__ __forceinline__ void pv(f32x16* o, int vb, bf16x8 pa0, bf16x8 pa1, bf16x8 pa2, bf16x8 pa3) {
#pragma unroll
    for (int d0 = 0; d0 < 2; ++d0) { s16x4 lo[4], hi[4];
#pragma unroll
        for (int ks = 0; ks < 4; ++ks) {
            asm volatile("ds_read_b64_tr_b16 %0,%1 offset:%c2" : "=&v"(lo[ks]) : "v"(vb), "i"(d0 * 4096 + ks * 1024) : "memory");
            asm volatile("ds_read_b64_tr_b16 %0,%1 offset:%c2" : "=&v"(hi[ks]) : "v"(vb), "i"(d0 * 4096 + ks * 1024 + 512) : "memory"); }
        asm volatile("s_waitcnt lgkmcnt(0)" ::: "memory"); SBAR();
#define PK(k) (bf16x8){lo[k][0], lo[k][1], lo[k][2], lo[k][3], hi[k][0], hi[k][1], hi[k][2], hi[k][3]}
        o[d0] = __builtin_amdgcn_mfma_f32_32x32x16_bf16(pa0, PK(0), o[d0], 0, 0, 0);
        o[d0] = __builtin_amdgcn_mfma_f32_32x32x16_bf16(pa1, PK(1), o[d0], 0, 0, 0);
        o[d0] = __builtin_amdgcn_mfma_f32_32x32x16_bf16(pa2, PK(2), o[d0], 0, 0, 0);
        o[d0] = __builtin_amdgcn_mfma_f32_32x32x16_bf16(pa3, PK(3), o[d0], 0, 0, 0);
#undef PK
    }
}
__device__ __forceinline__ void cmask(f32x16& p0, f32x16& p1, int jb, int wid) {
    if (jb > (wid >> 1)) {
#pragma unroll
        for (int r = 0; r < 16; ++r) { p0[r] = -INFINITY; p1[r] = -INFINITY; } }
}
template <int THRL, bool MASK> __device__ __forceinline__ void attn_unit(int q0, int NT, const bf16* Qh, int qp, const bf16* __restrict__ Kh, int kp, const bf16* __restrict__ Vh, int vp, bf16* Oh, int op, char* shm) {
    const int tid = threadIdx.x, lane = tid & 63, r32 = lane & 31, hi = lane >> 5; const int wid = __builtin_amdgcn_readfirstlane(tid >> 6);
    const bf16* Qw = Qh + (long)(q0 + wid * QBLK) * qp;
    const unsigned lds0 = (unsigned)(uintptr_t)shm;
    float* wsf = (float*)(shm + LDS_WS) + wid * 64;
    const bf16* ksrc = Kh + (long)lane * kp + wid * 8;
    const bf16* vsrc = Vh + (long)(16 * (wid & 3) + (lane >> 2)) * vp + (wid >> 2) * 32 + (lane & 3) * 8;
    const unsigned kdst = lds0 + LDS_K + wid * 1024, vdst = lds0 + LDS_V + wid * 1024;
#define DMA_K(t, slot) glds16(ksrc + (long)(t) * KVBLK * kp, (unsigned)__builtin_amdgcn_readfirstlane(kdst + (slot)))
#define DMA_V(t, slot) glds16(vsrc + (long)(t) * KVBLK * vp, (unsigned)__builtin_amdgcn_readfirstlane(vdst + (slot)))
    const int vb0 = (int)(lds0 + LDS_V) + ((lane >> 4) & 1) * 32 + (lane & 3) * 8 + (4 * hi + ((lane & 15) >> 2)) * 64;
    const char* Kbase = shm + LDS_K; bf16x8 kf[8];
    const lds_cptr shm3 = (lds_cptr)shm; const lds_cptr kp0 = shm3 + LDS_K + hi * 1024 + r32 * 16; const lds_cptr vp0 = shm3 + LDS_V + ((lane >> 4) & 1) * 32 + (lane & 3) * 8 + (4 * hi + ((lane & 15) >> 2)) * 64;
    DMA_K(0, 0); DMA_V(0, 0); DMA_K(1, SLOTB);
    bf16x8 qr[4];
#pragma unroll
    for (int d0 = 0; d0 < 4; ++d0) qr[d0] = *reinterpret_cast<const bf16x8*>(&Qw[(long)r32 * qp + d0 * 16 + hi * 8]);
    float mhat = 0.f, l_reg = 0.f; f32x16 o[2]; o[0] = f32x16{}; o[1] = f32x16{}; f32x16 negm = f32x16{}; asm volatile("" : "+v"(negm));
#define CMASK(P0, P1, t) do { if (MASK) { int jb_ = (t) - (NT - 4); if (jb_ >= 0) cmask(P0, P1, jb_, wid); } } while (0)
    bool resc = false;
#define START(P0, P1) do { const float rm = rowmax(P0, P1); resc = false; \
    { const float dl = rm; mhat = fadd_s(mhat, dl); \
      _Pragma("unroll") for (int r = 0; r < 16; ++r) { P0[r] = fsub_s(P0[r], dl); P1[r] = fsub_s(P1[r], dl); } \
      _Pragma("unroll") for (int r = 0; r < 16; ++r) negm[r] = -mhat; asm volatile("" : "+v"(negm)); } \
    _Pragma("unroll") for (int r = 0; r < 16; ++r) P0[r] = __builtin_amdgcn_exp2f(P0[r]); } while (0)
#define RESC() do { if (resc) { asm volatile("s_waitcnt lgkmcnt(0)" ::: "memory"); \
      _Pragma("unroll") for (int d_ = 0; d_ < 2; ++d_) _Pragma("unroll") for (int r = 0; r < 16; ++r) o[d_][r] *= wsf[crow(r, hi)]; } } while (0)
    f32x16 pA0, pA1, pB0, pB1;
    int sl_prev = 0, sl_cur = 0, sl_next = SLOTB;
#define ROT() do { sl_prev = sl_cur; sl_cur = sl_next; sl_next = (sl_next == (NSLOT - 1) * SLOTB) ? 0 : sl_next + SLOTB; } while (0)
    DMA_K(2, 2 * SLOTB);
    WAIT_BAR(3);
    qkt(pA0, pA1, Kbase, qr, negm, r32, hi); asm volatile("s_nop 15\n\ts_nop 7" : "+v"(pA0), "+v"(pA1)); CMASK(pA0, pA1, 0);
    START(pA0, pA1);
    _Pragma("unroll") for (int r = 0; r < 16; ++r) pA1[r] = __builtin_amdgcn_exp2f(pA1[r]);
    WAIT_BAR(0);
    DMA_K(3, 0); DMA_V(1, SLOTB);
    ROT();
    kload8(kf, kp0 + sl_cur);
    WAIT_BAR(2);
    s16x4 vlo[8], vhi[8]; u32x4 pw0, pw1, pw2, pw3;
#define PKW(P, B) cvtpk_s(P[B], P[B + 1])
#define PAF(k) __builtin_bit_cast(bf16x8, pw##k)
#define VFR(i) (bf16x8){vlo[i][0], vlo[i][1], vlo[i][2], vlo[i][3], vhi[i][0], vhi[i][1], vhi[i][2], vhi[i][3]}
#define PIN(x) asm volatile("" : "+v"(x))
#define MX3(a, b, c) __builtin_fmaxf(__builtin_fmaxf((a), (b)), (c))
#define GAPA(MF, A0, A1, A2, A3, W0, W1, PW) do { MF; sacc += A0; sacc += A1; sacc += A2; sacc += A3; PIN(sacc); W0; W1; PIN(PW); SBAR(); } while (0)
#define EX(v) __builtin_amdgcn_exp2f(v)
#define GAPB(MF, X, B) do { MF; X[B] = EX(X[B]); X[B + 1] = EX(X[B + 1]); X[B + 2] = EX(X[B + 2]); X[B + 3] = EX(X[B + 3]); PIN(X); SBAR(); } while (0)
#define VRD(i) do { vlo[i] = vtr(vp_ + (((i) >> 2) * 4096 + ((i) & 3) * 1024)); vhi[i] = vtr(vp_ + (((i) >> 2) * 4096 + ((i) & 3) * 1024 + 512)); } while (0)
#define KRD(G, j) do { if (G) { kload2(kf, kp0 + sl_next, j); SBAR(); } } while (0)
#define STEP(C0, C1, P0, P1, t, GK, GV, GL) do { SBAR(); \
    const lds_cptr vp_ = vp0 + sl_prev; \
    VRD(0); SBAR(); float sacc = (P0[0] + P0[1]); \
    GAPA(C0 = __builtin_amdgcn_mfma_f32_32x32x16_bf16(kf[0], qr[0], negm, 0, 0, 0), P0[2], P0[3], P0[4], P0[5],     pw0[0] = PKW(P0, 0), pw0[1] = PKW(P0, 2), pw0); \
    VRD(4); SBAR(); GAPA(C1 = __builtin_amdgcn_mfma_f32_32x32x16_bf16(kf[1], qr[0], negm, 0, 0, 0), P0[6], P0[7], P0[8], P0[9],     pw0[2] = PKW(P0, 4), pw0[3] = PKW(P0, 6), pw0); \
    VRD(1); SBAR(); GAPA(C0 = __builtin_amdgcn_mfma_f32_32x32x16_bf16(kf[2], qr[1], C0, 0, 0, 0),   P0[10], P0[11], P0[12], P0[13], pw1[0] = PKW(P0, 8), pw1[1] = PKW(P0, 10), pw1); \
    VRD(5); SBAR(); GAPA(C1 = __builtin_amdgcn_mfma_f32_32x32x16_bf16(kf[3], qr[1], C1, 0, 0, 0),   P0[14], P0[15], P1[0], P1[1],   pw1[2] = PKW(P0, 12), pw1[3] = PKW(P0, 14), pw1); \
    VRD(2); SBAR(); GAPA(C0 = __builtin_amdgcn_mfma_f32_32x32x16_bf16(kf[4], qr[2], C0, 0, 0, 0),   P1[2], P1[3], P1[4], P1[5],     pw2[0] = PKW(P1, 0), pw2[1] = PKW(P1, 2), pw2); \
    VRD(6); SBAR(); GAPA(C1 = __builtin_amdgcn_mfma_f32_32x32x16_bf16(kf[5], qr[2], C1, 0, 0, 0),   P1[6], P1[7], P1[8], P1[9],     pw2[2] = PKW(P1, 4), pw2[3] = PKW(P1, 6), pw2); \
    VRD(3); SBAR(); GAPA(C0 = __builtin_amdgcn_mfma_f32_32x32x16_bf16(kf[6], qr[3], C0, 0, 0, 0),   P1[10], P1[11], P1[12], P1[13], pw3[0] = PKW(P1, 8), pw3[1] = PKW(P1, 10), pw3); \
    VRD(7); SBAR(); GAPA(C1 = __builtin_amdgcn_mfma_f32_32x32x16_bf16(kf[7], qr[3], C1, 0, 0, 0),   P1[14], P1[15], 0.f, 0.f,       pw3[2] = PKW(P1, 12), pw3[3] = PKW(P1, 14), pw3); \
    l_reg += sacc; \
    if (GK) { DMA_K((t) + 3, sl_cur); } if (GV) { DMA_V((t) + 1, sl_next); } \
    CMASK(C0, C1, t); \
    { float a = MX3(C0[0], C0[1], C1[0]), b = MX3(C0[2], C0[3], C1[1]); a = MX3(a, C1[2], C1[3]); \
      _Pragma("unroll") for (int r = 4; r < 16; r += 4) { a = MX3(a, C0[r], C0[r + 1]); b = MX3(b, C0[r + 2], C0[r + 3]); a = MX3(a, C1[r], C1[r + 1]); b = MX3(b, C1[r + 2], C1[r + 3]); } \
      float rm = __builtin_fmaxf(a, b); { auto rr = __builtin_amdgcn_permlane32_swap(__float_as_uint(rm), __float_as_uint(rm), false, false); rm = __builtin_fmaxf(__uint_as_float(rr[0]), __uint_as_float(rr[1])); } \
      resc = false; \
      if (__builtin_expect(__any(rm > (float)THRL), 0)) { const float dl = __builtin_fmaxf(rm, 0.f); mhat += dl; \
        _Pragma("unroll") for (int r = 0; r < 16; ++r) { C0[r] -= dl; C1[r] -= dl; } \
        _Pragma("unroll") for (int r = 0; r < 16; ++r) negm[r] = -mhat; asm volatile("" : "+v"(negm)); \
        const float f = __builtin_amdgcn_exp2f(-dl); l_reg *= f; if (hi == 0) wsf[r32] = f; resc = true; } } \
    SBAR(); \
    GAPB(o[0] = __builtin_amdgcn_mfma_f32_32x32x16_bf16(PAF(0), VFR(0), o[0], 0, 0, 0), C0, 0); \
    GAPB(o[1] = __builtin_amdgcn_mfma_f32_32x32x16_bf16(PAF(0), VFR(4), o[1], 0, 0, 0), C0, 4); \
    KRD(GL, 0); GAPB(o[0] = __builtin_amdgcn_mfma_f32_32x32x16_bf16(PAF(1), VFR(1), o[0], 0, 0, 0), C0, 8); \
    KRD(GL, 1); GAPB(o[1] = __builtin_amdgcn_mfma_f32_32x32x16_bf16(PAF(1), VFR(5), o[1], 0, 0, 0), C0, 12); \
    KRD(GL, 2); GAPB(o[0] = __builtin_amdgcn_mfma_f32_32x32x16_bf16(PAF(2), VFR(2), o[0], 0, 0, 0), C1, 0); \
    KRD(GL, 3); GAPB(o[1] = __builtin_amdgcn_mfma_f32_32x32x16_bf16(PAF(2), VFR(6), o[1], 0, 0, 0), C1, 4); \
    GAPB(o[0] = __builtin_amdgcn_mfma_f32_32x32x16_bf16(PAF(3), VFR(3), o[0], 0, 0, 0), C1, 8); \
    GAPB(o[1] = __builtin_amdgcn_mfma_f32_32x32x16_bf16(PAF(3), VFR(7), o[1], 0, 0, 0), C1, 12); \
    } while (0)
    int t = 1;
#undef CMASK
#define CMASK(P0, P1, t) do {} while (0)
    for (; t + 5 < NT; t += 2) {
        STEP(pB0, pB1, pA0, pA1, t, true, true, true);     WAIT_BAR(2); RESC(); ROT();
        STEP(pA0, pA1, pB0, pB1, t + 1, true, true, true); WAIT_BAR(2); RESC(); ROT();
    }
#undef CMASK
#define CMASK(P0, P1, t) do { if (MASK) { int jb_ = (t) - (NT - 4); if (jb_ >= 0) cmask(P0, P1, jb_, wid); } } while (0)
#define ENDW(tt) do { if ((tt) + 3 < NT) { WAIT_BAR(2); } else if ((tt) + 2 < NT) { WAIT_BAR(1); } else { WAIT_BAR(0); } } while (0)
    for (; t + 1 < NT; t += 2) {
        STEP(pB0, pB1, pA0, pA1, t, (t + 3 < NT), (t + 1 < NT), (t + 1 < NT));       ENDW(t);     RESC(); ROT();
        STEP(pA0, pA1, pB0, pB1, t + 1, (t + 4 < NT), (t + 2 < NT), (t + 2 < NT));   ENDW(t + 1); RESC(); ROT();
    }
    STEP(pB0, pB1, pA0, pA1, NT - 1, false, false, false); RESC();
    { float sacc = pB0[0] + pB0[1]; _Pragma("unroll") for (int r = 2; r < 16; ++r) sacc += pB0[r]; _Pragma("unroll") for (int r = 0; r < 16; ++r) sacc += pB1[r]; l_reg += sacc;
      pw0 = (u32x4){PKW(pB0, 0), PKW(pB0, 2), PKW(pB0, 4), PKW(pB0, 6)}; pw1 = (u32x4){PKW(pB0, 8), PKW(pB0, 10), PKW(pB0, 12), PKW(pB0, 14)}; pw2 = (u32x4){PKW(pB1, 0), PKW(pB1, 2), PKW(pB1, 4), PKW(pB1, 6)}; pw3 = (u32x4){PKW(pB1, 8), PKW(pB1, 10), PKW(pB1, 12), PKW(pB1, 14)};
      SBAR(); pv(o, vb0 + sl_cur, PAF(0), PAF(1), PAF(2), PAF(3)); }
#undef PKW
#undef PAF
#undef VFR
#undef PIN
#undef MX3
#undef GAPA
#undef GAPB
#undef EX
#undef VRD
#undef KRD
#undef STEP
#undef ENDW
    { auto rr = __builtin_amdgcn_permlane32_swap(__float_as_uint(l_reg), __float_as_uint(l_reg), false, false); l_reg = __uint_as_float(rr[0]) + __uint_as_float(rr[1]); }
    if (hi == 0) wsf[32 + r32] = l_reg; asm volatile("s_waitcnt lgkmcnt(0)" ::: "memory");
    float rli[16];
#pragma unroll
    for (int r = 0; r < 16; ++r) rli[r] = __builtin_amdgcn_rcpf(wsf[32 + crow(r, hi)]);
    bf16* Ow = Oh + (long)(q0 + wid * QBLK) * op;
    { bf16* stg = (bf16*)(shm + LDS_OST) + wid * 2048;
#pragma unroll
      for (int r = 0; r < 16; ++r) { const int orow = crow(r, hi);
#pragma unroll
        for (int d0 = 0; d0 < 2; ++d0) stg[orow * 64 + d0 * 32 + r32] = __float2bfloat16(o[d0][r] * rli[r]); }
      asm volatile("s_waitcnt lgkmcnt(0)" ::: "memory");
#pragma unroll
      for (int i = 0; i < 4; ++i) { const int row = i * 8 + (lane >> 3), ch = lane & 7; const u32x4 v = *(const u32x4*)(stg + row * 64 + ch * 8); *(u32x4*)(Ow + (long)row * op + ch * 8) = v; } }
    asm volatile("s_waitcnt lgkmcnt(0)\n\ts_barrier" ::: "memory");
#undef DMA_K
#undef DMA_V
#undef CMASK
#undef START
#undef RESC
#undef ROT
}

constexpr int L2_K = 0, L2_V = 3 * 8192, L2_WS = L2_V + 4 * 16384, L2_OST = L2_WS + NW * 64 * 4, L2_BYTES = L2_OST + NW * 4096;
template <bool MASK> __device__ __forceinline__ void attn_unit2(int q0, int NT, const bf16* Qh, int qp, const bf16* __restrict__ Kh, int kp, const bf16* __restrict__ Vh, int vp, bf16* Oh, int op, char* shm) {
    const int tid = threadIdx.x, lane = tid & 63, r32 = lane & 31, hi = lane >> 5; const int wid = __builtin_amdgcn_readfirstlane(tid >> 6);
    const bf16* Qw = Qh + (long)(q0 + wid * QBLK) * qp;
    const unsigned lds0 = (unsigned)(uintptr_t)shm;
    float* wsf = (float*)(shm + L2_WS) + wid * 64;
    const bf16* ksrc = Kh + (long)lane * kp + wid * 8;
    const bf16* vsrc = Vh + (long)(16 * (wid & 3) + (lane >> 2)) * vp + (wid >> 2) * 32 + (lane & 3) * 8;
    const unsigned kdst = lds0 + L2_K + wid * 1024, vdst = lds0 + L2_V + wid * 1024;
#define DMA_K(t, slot) glds16(ksrc + (long)(t) * KVBLK * kp, (unsigned)__builtin_amdgcn_readfirstlane(kdst + (slot)))
#define DMA_V(t, vslot) do { glds16(vsrc + (long)(t) * KVBLK * vp, (unsigned)__builtin_amdgcn_readfirstlane(vdst + (vslot))); \
                            glds16(vsrc + (long)(t) * KVBLK * vp + 64, (unsigned)__builtin_amdgcn_readfirstlane(vdst + (vslot) + 8192)); } while (0)
    const int vb0 = (int)(lds0 + L2_V) + ((lane >> 4) & 1) * 32 + (lane & 3) * 8 + (4 * hi + ((lane & 15) >> 2)) * 64;
    const char* Kbase = shm + L2_K; bf16x8 kf[8];
    const lds_cptr shm3 = (lds_cptr)shm; const lds_cptr kp0 = shm3 + L2_K + hi * 1024 + r32 * 16; const lds_cptr vp0 = shm3 + L2_V + ((lane >> 4) & 1) * 32 + (lane & 3) * 8 + (4 * hi + ((lane & 15) >> 2)) * 64;
    DMA_K(0, 0); DMA_V(0, 0); DMA_K(1, SLOTB);
    bf16x8 qr[4];
#pragma unroll
    for (int d0 = 0; d0 < 4; ++d0) qr[d0] = *reinterpret_cast<const bf16x8*>(&Qw[(long)r32 * qp + d0 * 16 + hi * 8]);
    float l_reg = 0.f; f32x16 o[4]; o[0] = f32x16{}; o[1] = f32x16{}; o[2] = f32x16{}; o[3] = f32x16{};
    const f32x16 zero16 = f32x16{};
#define CMASK(P0, P1, t) do { if (MASK) { int jb_ = (t) - (NT - 4); if (jb_ >= 0) cmask(P0, P1, jb_, wid); } } while (0)
    f32x16 pA0, pA1, pB0, pB1;
    int sl_prev = 0, sl_cur = 0, sl_next = SLOTB;
    int vs_rd = 0, vs_wr = 3 * 16384;
#define ROT() do { sl_prev = sl_cur; sl_cur = sl_next; sl_next = (sl_next == (NSLOT - 1) * SLOTB) ? 0 : sl_next + SLOTB; vs_rd = (vs_rd + 16384) & 65535; vs_wr = (vs_wr + 16384) & 65535; } while (0)
    DMA_K(2, 2 * SLOTB); DMA_V(1, 16384);
    WAIT_BAR(6);
    qkt(pA0, pA1, Kbase, qr, zero16, r32, hi); CMASK(pA0, pA1, 0);
    _Pragma("unroll") for (int r = 0; r < 16; ++r) { pA0[r] = __builtin_amdgcn_exp2f(pA0[r]); pA1[r] = __builtin_amdgcn_exp2f(pA1[r]); }
    WAIT_BAR(2);
    DMA_K(3, 0); DMA_V(2, 2 * 16384);
    sl_prev = sl_cur; sl_cur = sl_next; sl_next = 2 * SLOTB;
    kload8(kf, kp0 + sl_cur);
    WAIT_BAR(5);
    s16x4 f0lo, f0hi, f1lo, f1hi, f2lo, f2hi, f3lo, f3hi; u32x4 pw0, pw1, pw2, pw3;
#define PKW(P, B) cvtpk_s(P[B], P[B + 1])
#define PAF(k) __builtin_bit_cast(bf16x8, pw##k)
#define PIN(x) asm volatile("" : "+v"(x))
#define EX(v) __builtin_amdgcn_exp2f(v)
#define VOFF(id) ((((id) >> 2) * 4096) + (((id) & 3) * 1024))
#define VRD2(F, id) do { F##lo = vtr(vp_ + VOFF(id)); F##hi = vtr(vp_ + VOFF(id) + 512); } while (0)
#define VFR2(F) (bf16x8){F##lo[0], F##lo[1], F##lo[2], F##lo[3], F##hi[0], F##hi[1], F##hi[2], F##hi[3]}
#define GAPA(MF, A0, A1, A2, A3, W0, W1, PW) do { MF; sacc += A0; sacc += A1; sacc += A2; sacc += A3; PIN(sacc); W0; W1; PIN(PW); SBAR(); } while (0)
#define GAPB(MF, RD, X, B) do { MF; RD; X[B] = EX(X[B]); X[B + 1] = EX(X[B + 1]); PIN(X); SBAR(); } while (0)
#define KRD(G, j) do { if (G) { kload2(kf, kp0 + sl_next, j); SBAR(); } } while (0)
#define MF32(a, b, c) __builtin_amdgcn_mfma_f32_32x32x16_bf16(a, b, c, 0, 0, 0)
#define STEP(C0, C1, P0, P1, t, GK, GV, GL) do { SBAR(); __builtin_amdgcn_s_setprio(ATTN_PRIO_A); \
    const lds_cptr vp_ = vp0 + vs_rd; \
    float sacc = (P0[0] + P0[1]); \
    GAPA(C0 = MF32(kf[0], qr[0], zero16), P0[2], P0[3], P0[4], P0[5],     pw0[0] = PKW(P0, 0), pw0[1] = PKW(P0, 2), pw0); \
    GAPA(C1 = MF32(kf[1], qr[0], zero16), P0[6], P0[7], P0[8], P0[9],     pw0[2] = PKW(P0, 4), pw0[3] = PKW(P0, 6), pw0); \
    GAPA(C0 = MF32(kf[2], qr[1], C0),     P0[10], P0[11], P0[12], P0[13], pw1[0] = PKW(P0, 8), pw1[1] = PKW(P0, 10), pw1); \
    GAPA(C1 = MF32(kf[3], qr[1], C1),     P0[14], P0[15], P1[0], P1[1],   pw1[2] = PKW(P0, 12), pw1[3] = PKW(P0, 14), pw1); \
    VRD2(f0, 0); SBAR();  GAPA(C0 = MF32(kf[4], qr[2], C0), P1[2], P1[3], P1[4], P1[5],     pw2[0] = PKW(P1, 0), pw2[1] = PKW(P1, 2), pw2); \
    VRD2(f1, 4); SBAR();  GAPA(C1 = MF32(kf[5], qr[2], C1), P1[6], P1[7], P1[8], P1[9],     pw2[2] = PKW(P1, 4), pw2[3] = PKW(P1, 6), pw2); \
    VRD2(f2, 8); SBAR();  GAPA(C0 = MF32(kf[6], qr[3], C0), P1[10], P1[11], P1[12], P1[13], pw3[0] = PKW(P1, 8), pw3[1] = PKW(P1, 10), pw3); \
    VRD2(f3, 12); SBAR(); GAPA(C1 = MF32(kf[7], qr[3], C1), P1[14], P1[15], 0.f, 0.f,       pw3[2] = PKW(P1, 12), pw3[3] = PKW(P1, 14), pw3); \
    l_reg += sacc; __builtin_amdgcn_s_setprio(0); \
    if (GK) { DMA_K((t) + 3, sl_cur); } if (GV) { DMA_V((t) + 2, vs_wr); } \
    CMASK(C0, C1, t); \
    SBAR(); __builtin_amdgcn_s_setprio(ATTN_PRIO_B); \
    GAPB(o[0] = MF32(PAF(0), VFR2(f0), o[0]), VRD2(f0, 1),  C0, 0); \
    GAPB(o[1] = MF32(PAF(0), VFR2(f1), o[1]), VRD2(f1, 5),  C0, 2); \
    GAPB(o[2] = MF32(PAF(0), VFR2(f2), o[2]), VRD2(f2, 9),  C0, 4); \
    GAPB(o[3] = MF32(PAF(0), VFR2(f3), o[3]), VRD2(f3, 13), C0, 6); \
    KRD(GL, 0); GAPB(o[0] = MF32(PAF(1), VFR2(f0), o[0]), VRD2(f0, 2),  C0, 8); \
    GAPB(o[1] = MF32(PAF(1), VFR2(f1), o[1]), VRD2(f1, 6),  C0, 10); \
    KRD(GL, 1); GAPB(o[2] = MF32(PAF(1), VFR2(f2), o[2]), VRD2(f2, 10), C0, 12); \
    GAPB(o[3] = MF32(PAF(1), VFR2(f3), o[3]), VRD2(f3, 14), C0, 14); \
    KRD(GL, 2); GAPB(o[0] = MF32(PAF(2), VFR2(f0), o[0]), VRD2(f0, 3),  C1, 0); \
    GAPB(o[1] = MF32(PAF(2), VFR2(f1), o[1]), VRD2(f1, 7),  C1, 2); \
    KRD(GL, 3); GAPB(o[2] = MF32(PAF(2), VFR2(f2), o[2]), VRD2(f2, 11), C1, 4); \
    GAPB(o[3] = MF32(PAF(2), VFR2(f3), o[3]), VRD2(f3, 15), C1, 6); \
    GAPB(o[0] = MF32(PAF(3), VFR2(f0), o[0]), (void)0, C1, 8); \
    GAPB(o[1] = MF32(PAF(3), VFR2(f1), o[1]), (void)0, C1, 10); \
    GAPB(o[2] = MF32(PAF(3), VFR2(f2), o[2]), (void)0, C1, 12); \
    GAPB(o[3] = MF32(PAF(3), VFR2(f3), o[3]), (void)0, C1, 14); __builtin_amdgcn_s_setprio(0); \
    } while (0)
    int t = 1;
#undef CMASK
#define CMASK(P0, P1, t) do {} while (0)
    for (; t + 5 < NT; t += 2) {
        STEP(pB0, pB1, pA0, pA1, t, true, true, true);     WAIT_BAR(5); ROT();
        STEP(pA0, pA1, pB0, pB1, t + 1, true, true, true); WAIT_BAR(5); ROT();
    }
#undef CMASK
#define CMASK(P0, P1, t) do { if (MASK) { int jb_ = (t) - (NT - 4); if (jb_ >= 0) cmask(P0, P1, jb_, wid); } } while (0)
#define ENDW(tt) do { if ((tt) + 3 < NT) { WAIT_BAR(5); } else if ((tt) + 2 < NT) { WAIT_BAR(4); } else { WAIT_BAR(0); } } while (0)
    for (; t + 1 < NT; t += 2) {
        STEP(pB0, pB1, pA0, pA1, t, (t + 3 < NT), (t + 2 < NT), (t + 1 < NT));       ENDW(t);     ROT();
        STEP(pA0, pA1, pB0, pB1, t + 1, (t + 4 < NT), (t + 3 < NT), (t + 2 < NT));   ENDW(t + 1); ROT();
    }
    STEP(pB0, pB1, pA0, pA1, NT - 1, false, false, false);
    { float sacc = pB0[0] + pB0[1]; _Pragma("unroll") for (int r = 2; r < 16; ++r) sacc += pB0[r]; _Pragma("unroll") for (int r = 0; r < 16; ++r) sacc += pB1[r]; l_reg += sacc;
      pw0 = (u32x4){PKW(pB0, 0), PKW(pB0, 2), PKW(pB0, 4), PKW(pB0, 6)}; pw1 = (u32x4){PKW(pB0, 8), PKW(pB0, 10), PKW(pB0, 12), PKW(pB0, 14)}; pw2 = (u32x4){PKW(pB1, 0), PKW(pB1, 2), PKW(pB1, 4), PKW(pB1, 6)}; pw3 = (u32x4){PKW(pB1, 8), PKW(pB1, 10), PKW(pB1, 12), PKW(pB1, 14)};
      SBAR();
      const lds_cptr vp_ = vp0 + ((vs_rd + 16384) & 65535);
#pragma unroll
      for (int db = 0; db < 4; ++db) { VRD2(f0, db * 4 + 0); VRD2(f1, db * 4 + 1); VRD2(f2, db * 4 + 2); VRD2(f3, db * 4 + 3);
          o[db] = MF32(PAF(0), VFR2(f0), o[db]); o[db] = MF32(PAF(1), VFR2(f1), o[db]); o[db] = MF32(PAF(2), VFR2(f2), o[db]); o[db] = MF32(PAF(3), VFR2(f3), o[db]); } }
#undef PKW
#undef PAF
#undef PIN
#undef EX
#undef VOFF
#undef VRD2
#undef VFR2
#undef GAPA
#undef GAPB
#undef KRD
#undef MF32
#undef STEP
#undef ENDW
    { auto rr = __builtin_amdgcn_permlane32_swap(__float_as_uint(l_reg), __float_as_uint(l_reg), false, false); l_reg = __uint_as_float(rr[0]) + __uint_as_float(rr[1]); }
    if (hi == 0) wsf[32 + r32] = l_reg; asm volatile("s_waitcnt lgkmcnt(0)" ::: "memory");
    float rli[16];
#pragma unroll
    for (int r = 0; r < 16; ++r) rli[r] = __builtin_amdgcn_rcpf(wsf[32 + crow(r, hi)]);
    bf16* Ow = Oh + (long)(q0 + wid * QBLK) * op;
    { bf16* stg = (bf16*)(shm + L2_OST) + wid * 2048;
#pragma unroll
      for (int dh = 0; dh < 2; ++dh) {
#pragma unroll
        for (int r = 0; r < 16; ++r) { const int orow = crow(r, hi);
#pragma unroll
          for (int d0 = 0; d0 < 2; ++d0) stg[orow * 64 + d0 * 32 + r32] = __float2bfloat16(o[dh * 2 + d0][r] * rli[r]); }
        asm volatile("s_waitcnt lgkmcnt(0)" ::: "memory");
#pragma unroll
        for (int i = 0; i < 4; ++i) { const int row = i * 8 + (lane >> 3), ch = lane & 7; const u32x4 v = *(const u32x4*)(stg + row * 64 + ch * 8); *(u32x4*)(Ow + (long)row * op + dh * 64 + ch * 8) = v; }
        asm volatile("s_waitcnt lgkmcnt(0)" ::: "memory"); } }
    asm volatile("s_waitcnt lgkmcnt(0)\n\ts_barrier" ::: "memory");
#undef DMA_K
#undef DMA_V
#undef CMASK
#undef ROT
}
#undef SBAR
#undef WAIT_BAR
}

#define XB_TMO      128
#define XB_XCNT(j)  (256  + 64 * (j))
#define XB_XSUB(j)  (1280 + 64 * (j))
#define XB_XGEN(j)  (2304 + 64 * (j))
#define XB_TOP      3328
#define XB_TOPGEN   3392
#define XCD_BAR_WORDS 3456
#define XB_SPIN_CAP (1u << 22)
__device__ __forceinline__ unsigned xb_ld(unsigned* p)              { return __hip_atomic_load(p, __ATOMIC_RELAXED, __HIP_MEMORY_SCOPE_AGENT); }
__device__ __forceinline__ unsigned xb_add(unsigned* p, unsigned v) { return __hip_atomic_fetch_add(p, v, __ATOMIC_RELAXED, __HIP_MEMORY_SCOPE_AGENT); }
__device__ __forceinline__ unsigned xb_xcc_id() { return (unsigned)__builtin_amdgcn_s_getreg((3 << 11) | 20) & 0xFu; }
#define XB_SPIN(cond, bar) do { unsigned _sp = 0; while (cond) { __builtin_amdgcn_s_sleep(1); \
    if ((++_sp & 255u) == 0u) { if (xb_ld(&(bar)[XB_TMO])) break; if (_sp > XB_SPIN_CAP) { atomicAdd(&(bar)[XB_TMO], 1u); break; } } } } while (0)
struct XcdBarrier { unsigned* bar; unsigned x; volatile LAS unsigned* st; };
__device__ __forceinline__ XcdBarrier xcd_barrier_post(unsigned* bar, volatile LAS unsigned* st) {
    XcdBarrier b; b.bar = bar; b.x = xb_xcc_id(); b.st = st;
    if (threadIdx.x == 0) (void)xb_add(&bar[XB_XCNT(b.x)], 1u);
    return b;
}
__device__ __forceinline__ void xcd_barrier_complete(unsigned* bar, unsigned x, unsigned& nloc, unsigned& nx) {
    const unsigned G = gridDim.x * gridDim.y * gridDim.z;
    unsigned sum, cnt, mine, sp = 0u;
    for (;;) {
        sum = 0u; cnt = 0u; mine = 0u;
#pragma unroll
        for (unsigned j = 0; j < 16; ++j) { const unsigned c = xb_ld(&bar[XB_XCNT(j)]); sum += c; cnt += (c > 0u) ? 1u : 0u; mine = (j == x) ? c : mine; }
        if (sum == G) break;
        __builtin_amdgcn_s_sleep(1);
        if ((++sp & 255u) == 0u) { if (xb_ld(&bar[XB_TMO])) break; if (sp > XB_SPIN_CAP) { atomicAdd(&bar[XB_TMO], 1u); break; } }
    }
    nloc = mine > 0u ? mine : 1u; nx = cnt > 0u ? cnt : 1u;
}
__device__ __forceinline__ void xcd_barrier(const XcdBarrier& b) {
    asm volatile("s_waitcnt vmcnt(0)" ::: "memory");
    __syncthreads();
    if (threadIdx.x == 0) {
        unsigned* bar = b.bar;
        __builtin_amdgcn_s_waitcnt(0);
        unsigned nloc = b.st[0], nx = b.st[1];
        if (nloc == 0u) { xcd_barrier_complete(bar, b.x, nloc, nx); b.st[0] = nloc; b.st[1] = nx; }
        const unsigned old = xb_add(&bar[XB_XSUB(b.x)], 1u);
        const unsigned gen = old / nloc;
        if (old + 1u == (gen + 1u) * nloc) {
            __builtin_amdgcn_fence(__ATOMIC_RELEASE, "agent");
            asm volatile("s_waitcnt vmcnt(0)" ::: "memory");
            const unsigned og = xb_add(&bar[XB_TOP], 1u);
            const unsigned tg = og / nx;
            if (og + 1u == (tg + 1u) * nx) xb_add(&bar[XB_TOPGEN], 1u);
            else XB_SPIN(xb_ld(&bar[XB_TOPGEN]) == tg, bar);
            __builtin_amdgcn_fence(__ATOMIC_ACQUIRE, "agent");
            xb_add(&bar[XB_XGEN(b.x)], 1u);
            asm volatile("s_waitcnt vmcnt(0)" ::: "memory");
        } else {
            XB_SPIN(xb_ld(&bar[XB_XGEN(b.x)]) == gen, bar);
            __builtin_amdgcn_fence(__ATOMIC_ACQUIRE, "agent");
            asm volatile("s_waitcnt vmcnt(0)" ::: "memory");
        }
    }
    __syncthreads();
}

constexpr int RING_BYTES = 131072;
constexpr int MISC_OFF = RING_BYTES;
constexpr int LDS_BYTES = 147456;
constexpr int NWAVES = 8;

struct Args {
    const float* in[29]; float* out; unsigned char* ws; int ph_lo, ph_hi;
};
enum { I_X = 0, I_MEM, I_NORM1, I_WIN, I_BGATE, I_QN, I_KN, I_LQ1, I_LK1, I_LQ2, I_LK2, I_SUBLN, I_WPOOL, I_PSCALE, I_MEMNORM, I_WMKV, I_MQN, I_MKN, I_WBRD, I_WBRP, I_WBRM, I_WOUT, I_NORM2,
       I_WROUTER, I_BROUTER, I_WGU, I_BGU, I_WD, I_BD };

__device__ __forceinline__ unsigned f2bf(float f) { unsigned u = __builtin_bit_cast(unsigned, f); return (u + 0x7fffu + ((u >> 16) & 1u)) >> 16; }
__device__ __forceinline__ unsigned pk2(float lo, float hi) { return f2bf(lo) | (f2bf(hi) << 16); }
__device__ __forceinline__ void p0_transpose_item(const float* W, int K, int N, bf16_t* WT, LAS float* scr, int item, int lane, int ldo = 0, float qs = 0.f) {
    if (ldo == 0) ldo = K;
    const int nblk = N / 64, kb = item / nblk, nb = item % nblk, k0 = 64 * kb, n0 = 64 * nb;
    const int kr = lane >> 3, n4 = (lane & 7) * 4;
    f32x4 v[16];
#pragma unroll
    for (int i = 0; i < 16; ++i) v[i] = *(const f32x4*)(W + (size_t)(k0 + 8 * (i & 7) + kr) * N + n0 + 32 * (i >> 3) + n4);
#pragma unroll
    for (int h = 0; h < 2; ++h) {
#pragma unroll
        for (int i = 0; i < 8; ++i)
#pragma unroll
            for (int j = 0; j < 4; ++j) scr[(n4 + j) * 68 + 8 * i + kr] = v[h * 8 + i][j];
        LDS_WAIT(); asm volatile("" ::: "memory");
        const int c = lane & 7;
#pragma unroll
        for (int jj = 0; jj < 4; ++jj) { const int nrow = 8 * jj + (lane >> 3); const LAS f32x4* sp = (const LAS f32x4*)(scr + nrow * 68 + 8 * c);
            f32x4 a = sp[0], b = sp[1];
            if (qs != 0.f) { for (int q = 0; q < 4; ++q) { a[q] = fminf(fmaxf(rintf(a[q] * qs), -127.f), 127.f); b[q] = fminf(fmaxf(rintf(b[q] * qs), -127.f), 127.f); } }
            u32x4 o; o.x = pk2(a[0], a[1]); o.y = pk2(a[2], a[3]); o.z = pk2(b[0], b[1]); o.w = pk2(b[2], b[3]);
            *(u32x4*)(WT + (size_t)(n0 + 32 * h + nrow) * ldo + k0 + 8 * c) = o; }
        LDS_WAIT(); asm volatile("" ::: "memory");
    }
}
__device__ __forceinline__ void p0_transpose_item_f8(const float* W, int K, int N, unsigned char* WT, LAS float* scr, int item, int lane) {
    const int nblk = N / 64, kb = item / nblk, nb = item % nblk, k0 = 64 * kb, n0 = 64 * nb;
    const int kr = lane >> 3, n4 = (lane & 7) * 4;
    f32x4 v[16];
#pragma unroll
    for (int i = 0; i < 16; ++i) v[i] = *(const f32x4*)(W + (size_t)(k0 + 8 * (i & 7) + kr) * N + n0 + 32 * (i >> 3) + n4);
#pragma unroll
    for (int h = 0; h < 2; ++h) {
#pragma unroll
        for (int i = 0; i < 8; ++i)
#pragma unroll
            for (int j = 0; j < 4; ++j) scr[(n4 + j) * 68 + 8 * i + kr] = v[h * 8 + i][j];
        LDS_WAIT(); asm volatile("" ::: "memory");
        const int c = lane & 7;
#pragma unroll
        for (int jj = 0; jj < 4; ++jj) { const int nrow = 8 * jj + (lane >> 3); const LAS f32x4* sp = (const LAS f32x4*)(scr + nrow * 68 + 8 * c);
            const f32x4 a = sp[0] * W8_SCALE, b = sp[1] * W8_SCALE;
            u32x2 o; o.x = pk4_fp8(a[0], a[1], a[2], a[3]); o.y = pk4_fp8(b[0], b[1], b[2], b[3]);
            *(u32x2*)(WT + (size_t)(n0 + 32 * h + nrow) * K + k0 + 8 * c) = o; }
        LDS_WAIT(); asm volatile("" ::: "memory");
    }
}
__device__ __forceinline__ void p0_transpose_item_i8(const float* W, int K, int N, unsigned char* WT, LAS float* scr, int item, int lane, float qs) {
    const int nblk = N / 64, kb = item / nblk, nb = item % nblk, k0 = 64 * kb, n0 = 64 * nb;
    const int kr = lane >> 3, n4 = (lane & 7) * 4;
    f32x4 v[16];
#pragma unroll
    for (int i = 0; i < 16; ++i) v[i] = *(const f32x4*)(W + (size_t)(k0 + 8 * (i & 7) + kr) * N + n0 + 32 * (i >> 3) + n4);
#pragma unroll
    for (int h = 0; h < 2; ++h) {
#pragma unroll
        for (int i = 0; i < 8; ++i)
#pragma unroll
            for (int j = 0; j < 4; ++j) scr[(n4 + j) * 68 + 8 * i + kr] = v[h * 8 + i][j];
        LDS_WAIT(); asm volatile("" ::: "memory");
        const int c = lane & 7;
#pragma unroll
        for (int jj = 0; jj < 4; ++jj) { const int nrow = 8 * jj + (lane >> 3); const LAS f32x4* sp = (const LAS f32x4*)(scr + nrow * 68 + 8 * c);
            const f32x4 a = sp[0] * qs, b = sp[1] * qs;
            u32x2 o; o.x = pk4_i8(a[0], a[1], a[2], a[3]); o.y = pk4_i8(b[0], b[1], b[2], b[3]);
            *(u32x2*)(WT + (size_t)(n0 + 32 * h + nrow) * K + k0 + 8 * c) = o; }
        LDS_WAIT(); asm volatile("" ::: "memory");
    }
}
__device__ __forceinline__ void rms_row_to_q(const float* xrow, const float* gain, unsigned char* orow, float* rs, int lane) {
    const f32x4* xr = (const f32x4*)xrow + lane; const f32x4* gr = (const f32x4*)gain + lane;
    f32x4 v[4]; float s = 0.f;
#pragma unroll
    for (int j = 0; j < 4; ++j) { v[j] = xr[64 * j]; s += (v[j].x * v[j].x + v[j].y * v[j].y) + (v[j].z * v[j].z + v[j].w * v[j].w); }
    const float rstd = 1.f / sqrtf(wave_sum(s) * (1.f / 1024.f) + RMS_EPS);
    float am = 0.f;
#pragma unroll
    for (int j = 0; j < 4; ++j) { const f32x4 g = gr[64 * j]; v[j] = v[j] * rstd * g; am = fmaxf(am, fmaxf(fmaxf(fabsf(v[j].x), fabsf(v[j].y)), fmaxf(fabsf(v[j].z), fabsf(v[j].w)))); }
#pragma unroll
    for (int o = 1; o < 64; o <<= 1) am = fmaxf(am, __shfl_xor(am, o));
    am = fmaxf(am, 1e-20f); const float qi = 127.0f / am;
    unsigned* o4 = (unsigned*)orow + lane;
#pragma unroll
    for (int j = 0; j < 4; ++j) o4[64 * j] = pk4_i8(v[j].x * qi, v[j].y * qi, v[j].z * qi, v[j].w * qi);
    if (lane == 0) rs[0] = am * (1.0f / 127.0f);
}
__device__ __forceinline__ void rms_row_to_bf16(const float* xrow, const float* gain, bf16_t* orow, int lane) {
    const f32x4* xr = (const f32x4*)xrow + lane; const f32x4* gr = (const f32x4*)gain + lane;
    f32x4 v[4]; float s = 0.f;
#pragma unroll
    for (int j = 0; j < 4; ++j) { v[j] = xr[64 * j]; s += (v[j].x * v[j].x + v[j].y * v[j].y) + (v[j].z * v[j].z + v[j].w * v[j].w); }
    const float rstd = 1.f / sqrtf(wave_sum(s) * (1.f / 1024.f) + RMS_EPS);
    u32x2* o8 = (u32x2*)orow + lane;
#pragma unroll
    for (int j = 0; j < 4; ++j) { const f32x4 g = gr[64 * j]; u32x2 w; w.x = pk2(v[j].x * rstd * g.x, v[j].y * rstd * g.y); w.y = pk2(v[j].z * rstd * g.z, v[j].w * rstd * g.w); o8[64 * j] = w; }
}

__device__ __forceinline__ void cvt_item64_f8(const float* W, int K, int N, unsigned char* WT, int item, int lane) {
    const int nblk = N / 64, kb = item / nblk, nb = item % nblk, k0 = 64 * kb, n0 = 64 * nb;
    const char* base = (const char*)(W + (size_t)k0 * N + n0);
    unsigned off = (unsigned)lane * 4u; const unsigned rstep = (unsigned)N * 4u;
    float v[64];
#pragma unroll
    for (int j = 0; j < 64; ++j) { v[j] = __builtin_nontemporal_load((const float*)(base + off)); off += rstep; }
    unsigned char* dst = WT + (size_t)(n0 + lane) * K + k0;
#pragma unroll
    for (int c = 0; c < 4; ++c) { u32x4 o;
#pragma unroll
        for (int q = 0; q < 4; ++q) { int r = __builtin_amdgcn_cvt_pk_fp8_f32(v[16 * c + 4 * q] * W8_SCALE, v[16 * c + 4 * q + 1] * W8_SCALE, 0, false);
            r = __builtin_amdgcn_cvt_pk_fp8_f32(v[16 * c + 4 * q + 2] * W8_SCALE, v[16 * c + 4 * q + 3] * W8_SCALE, r, true); o[q] = (unsigned)r; }
        *(u32x4*)(dst + 16 * c) = o; }
}
struct CvtJob {
    const float* wgu; const float* wd; unsigned char* wgu_t; unsigned char* wd_t; int ngw, gw, lane;
    __device__ __forceinline__ void item(int j) const {
        const int it = gw + j * ngw; if (it >= 24576) return;
        const bool gu = it < 16384; const int r = gu ? it : it - 16384, e = gu ? (r >> 9) : (r >> 8), idx = gu ? (r & 511) : (r & 255), N = gu ? 2048 : 1024;
        const float* W = gu ? wgu + (size_t)e * 1024 * 2048 : wd + (size_t)e * 1024 * 1024; unsigned char* WT = gu ? wgu_t + (size_t)e * 2048 * 1024 : wd_t + (size_t)e * 1024 * 1024;
        cvt_item64_f8(W, 1024, N, WT, idx, lane);
    }
    __device__ __forceinline__ void item3(int j) const {
        const char* base[3]; unsigned char* dst[3]; unsigned rstep[3]; bool ok[3]; float v[3][64];
#pragma unroll
        for (int b = 0; b < 3; ++b) { const int it0 = gw + (j + b) * ngw; ok[b] = it0 < 24576; const int it = ok[b] ? it0 : gw;
            const bool gu = it < 16384; const int r = gu ? it : it - 16384, e = gu ? (r >> 9) : (r >> 8), idx = gu ? (r & 511) : (r & 255), N = gu ? 2048 : 1024;
            const float* W = gu ? wgu + (size_t)e * 1024 * 2048 : wd + (size_t)e * 1024 * 1024; unsigned char* WT = gu ? wgu_t + (size_t)e * 2048 * 1024 : wd_t + (size_t)e * 1024 * 1024;
            const int nblk = N / 64, kb = idx / nblk, nb = idx % nblk, k0 = 64 * kb, n0 = 64 * nb;
            base[b] = (const char*)(W + (size_t)k0 * N + n0); dst[b] = WT + (size_t)(n0 + lane) * 1024 + k0; rstep[b] = (unsigned)N * 4u; }
#pragma unroll
        for (int b = 0; b < 3; ++b) { unsigned off = (unsigned)lane * 4u;
#pragma unroll
            for (int q = 0; q < 64; ++q) { v[b][q] = __builtin_nontemporal_load((const float*)(base[b] + off)); off += rstep[b]; } }
#pragma unroll
        for (int b = 0; b < 3; ++b) if (ok[b]) {
#pragma unroll
            for (int c = 0; c < 4; ++c) { u32x4 o;
#pragma unroll
                for (int q = 0; q < 4; ++q) { int r = __builtin_amdgcn_cvt_pk_fp8_f32(v[b][16 * c + 4 * q] * W8_SCALE, v[b][16 * c + 4 * q + 1] * W8_SCALE, 0, false);
                    r = __builtin_amdgcn_cvt_pk_fp8_f32(v[b][16 * c + 4 * q + 2] * W8_SCALE, v[b][16 * c + 4 * q + 3] * W8_SCALE, r, true); o[q] = (unsigned)r; }
                *(u32x4*)(dst[b] + 16 * c) = o; } }
    }
};
struct PostCvt { CvtJob J; int jbase, jend; __device__ __forceinline__ void operator()(int ui) const { const int j = jbase + ui; if (j < jend) J.item(j); } };
struct Args;
typedef __attribute__((address_space(4))) const Args* kargs_t;
__device__ __forceinline__ kargs_t kargs() { kargs_t p = (kargs_t)__builtin_amdgcn_kernarg_segment_ptr(); asm volatile("" : "+s"(p)); return p; }
__global__ void __launch_bounds__(NWAVES * 64, 2) fwd_kernel(Args args) {
    extern __shared__ __attribute__((aligned(16))) unsigned char lds_raw[];
    cg::grid_group grid = cg::this_grid();
    LAS unsigned char* lds = (LAS unsigned char*)lds_raw;
    const int tid = threadIdx.x, lane = tid & 63, wave = __builtin_amdgcn_readfirstlane(tid >> 6);
    const int G = gridDim.x, bx = blockIdx.x; const int vcu = (G % 8 == 0) ? (bx % 8) * (G / 8) + bx / 8 : bx;
    const int gw = vcu * NWAVES + wave, NGW = G * NWAVES;
    const int lo = args.ph_lo, hi = args.ph_hi;
    if (tid < 64) ((LAS unsigned*)(lds + MISC_OFF + 1024))[tid] = 0u;
    __syncthreads();
    const XcdBarrier xbar = xcd_barrier_post((unsigned*)(args.ws + WS_CTL) + CW_BAR, (volatile LAS unsigned*)(lds + MISC_OFF + 1024));
#ifndef PHMASK
#define PHMASK 0x3ff
#endif
#define IN(k) (((PHMASK >> (k)) & 1) && lo <= (k) && (k) < hi)
#define GSYNC() do { asm volatile("s_waitcnt vmcnt(0) lgkmcnt(0)" ::: "memory"); __syncthreads(); grid.sync(); asm volatile("s_waitcnt vmcnt(0)" ::: "memory"); __syncthreads(); } while (0)
#define SEAM(k) do { if (lo <= (k) && (k) + 1 < hi) { xcd_barrier(xbar); } } while (0)
#define WSP(TY, off) ((TY*)(ka->ws + (off)))
#define WIN_T WSP(bf16_t, WS_WIN_T)
#define WBRD_T WSP(bf16_t, WS_WBRD_T)
#define WBRP_T WSP(bf16_t, WS_WBRP_T)
#define WBRM_T WSP(bf16_t, WS_WBRM_T)
#define WOUT_T WSP(bf16_t, WS_WOUT_T)
#define WMKV_T WSP(bf16_t, WS_WMKV_T)
#define WGU_T WSP(bf16_t, WS_WGU_T)
#define WD_T WSP(bf16_t, WS_WD_T)
#define XN WSP(bf16_t, WS_XN)
#define Qb WSP(bf16_t, WS_Q)
#define Kb WSP(bf16_t, WS_K)
#define Vb WSP(bf16_t, WS_V)
#define Ub WSP(bf16_t, WS_U)
#define MQb WSP(bf16_t, WS_MQ)
#define OC WSP(bf16_t, WS_OC)
#define GATES WSP(bf16_t, WS_GATES)
#define YCAT WSP(bf16_t, WS_YCAT)
#define MERGF WSP(float, WS_MERGF)
#define MERGB WSP(bf16_t, WS_MERGB)
#define XG WSP(bf16_t, WS_XG)
#define ACT WSP(bf16_t, WS_A)
#define Y4 WSP(bf16_t, WS_B)
#define MEMN WSP(bf16_t, WS_MEMN)
#define MKV WSP(bf16_t, WS_MKV)
#define ROPE WSP(f32x2, WS_ROPE)
#define WR2 WSP(float, WS_WR2)
#define ROUTEW WSP(float, WS_ROUTEW)
#define LAMP WSP(float, WS_LAM)
#define LIST WSP(u32x2, WS_LIST)
#define CNT WSP(unsigned, WS_CTL)
#define OUT (ka->out)
#define KA const kargs_t ka = kargs()

    if (lo > 1000) GSYNC();
    if (IN(0)) for (int rep_ = 0; rep_ < 1 + ((REPEAT_MASK >> 0) & 1); ++rep_) { KA; if (rep_) __syncthreads();
        LAS float* scr = (LAS float*)(lds + wave * 16384);
        constexpr int I0 = 16 * 80, I1 = 8 * 16, I2 = 4 * 16, I3 = 4 * 16, I4 = 16 * 16, I5 = 16 * 8, I6 = 0, I7 = 0;
        constexpr int NITEMS = I0 + I1 + I2 + I3 + I4 + I5 + I6 + I7;
        for (int it = gw; it < NITEMS; it += NGW) {
            int r = it;
            if (r < I0) { p0_transpose_item_i8(ka->in[I_WIN], 1024, 5120, (unsigned char*)WIN_T, scr, r, lane, WQ_IN); continue; } r -= I0;
            if (r < I1) { p0_transpose_item(ka->in[I_WBRD], 512, 1024, WBRD_T, scr, r, lane, 1024); continue; } r -= I1;
            if (r < I2) { p0_transpose_item(ka->in[I_WBRP], 256, 1024, WBRD_T + 512, scr, r, lane, 1024); continue; } r -= I2;
            if (r < I3) { p0_transpose_item(ka->in[I_WBRM], 256, 1024, WBRD_T + 768, scr, r, lane, 1024); continue; } r -= I3;
            if (r < I4) { p0_transpose_item(ka->in[I_WOUT], 1024, 1024, WOUT_T, scr, r, lane); continue; } r -= I4;
            p0_transpose_item(ka->in[I_WMKV], 1024, 512, WMKV_T, scr, r, lane);
        }
        for (int m = gw; m < T; m += NGW) rms_row_to_q(ka->in[I_X] + (size_t)m * 1024, ka->in[I_NORM1], (unsigned char*)XN + (size_t)m * 1024, WSP(float, WS_MERGF) + m, lane);
        for (int m = gw; m < BATCH * MEMLEN; m += NGW) rms_row_to_bf16(ka->in[I_MEM] + (size_t)m * 1024, ka->in[I_MEMNORM], MEMN + (size_t)m * 1024, lane);
        for (int i = bx * 512 + tid; i < SEQ * 32; i += G * 512) { const int pos = i >> 5, j = i & 31;
            const float inv = 1.0f / powf(10000.0f, (float)(2 * j) / 64.0f); const float ang = (float)pos * inv;
            const double a = (double)ang; const double k = rint(a * 0.15915494309189535); const float red = (float)(a - k * 6.283185307179586);
            ROPE[i] = (f32x2){cosf(red), sinf(red)}; }
        for (int i = bx * 512 + tid; i < 1024 * 32; i += G * 512) { const int ii = i & 3, e = (i >> 2) & 15, kq = (i >> 6) & 3, eb = (i >> 8) & 1, s = i >> 9; const int k = 16 * s + 4 * kq + ii;
            WR2[i] = ka->in[I_NORM2][k] * ka->in[I_WROUTER][k * 32 + eb * 16 + e]; }
        if (bx == 0 && wave == 0) { const float s1 = wave_sum(ka->in[I_LQ1][lane] * ka->in[I_LK1][lane]), s2 = wave_sum(ka->in[I_LQ2][lane] * ka->in[I_LK2][lane]);
            if (lane == 0) LAMP[0] = expf(s1) - expf(s2) + 0.2f; }
    }
    SEAM(0);
    if (IN(1)) for (int rep_ = 0; rep_ < 1 + ((REPEAT_MASK >> 1) & 1); ++rep_) { KA; if (rep_) __syncthreads();
#if defined(TAP) && TAP == 6
        { pg8::DenseProb P{XN, WIN_T, 1024, 1024, 1024}; pg8::StaticOrder S; S.init(T, INW, G, bx);
          pg8::EpiPlain E{WSP(bf16_t, WS_B), 5120};
          pg8::gemm_phase<pg8::EpiPlain, pg8::DenseProb, pg8::StaticOrder, true>(lds, P, S, E); }
#else
        const CvtJob J{ka->in[I_WGU], ka->in[I_WD], (unsigned char*)WGU_T, (unsigned char*)WD_T, NGW, gw, lane};
        const int kpre = (bx & 7) < 12 - 3 * CVT_NB2 ? (bx & 7) : 12 - 3 * CVT_NB2;
        for (int j = 0; j < kpre; ++j) J.item(3 * CVT_NB2 + j);
        { pg8::DenseProbI8 P{(const unsigned char*)XN, (const unsigned char*)WIN_T, 1024, 1024, 1024}; pg8::StaticOrder S0; S0.init(T, INW, G, bx); const pg8::TableOrder S = pg8::build_unit_table(S0, (LAS int*)(lds + MISC_OFF + 2048));
          pg8::EpiInProj E{Qb, Kb, Vb, Ub, MQb, GATES, ka->in[I_QN], ka->in[I_KN], ka->in[I_MQN], ka->in[I_BGATE], ROPE, WSP(float, WS_MERGF)};
          const PostCvt PU{J, 3 * CVT_NB2 + kpre, 12};
          pg8::gemm_phase<pg8::EpiInProj, pg8::DenseProbI8, pg8::TableOrder, ALIGN_EPI_SEL, PostCvt>(lds, P, S, E, PU); }
        for (int j = 3 * CVT_NB2 + kpre + 10; j < 12; ++j) J.item(j);
#endif
        for (int tile = bx; tile < 256; tile += G) {
            const int rt = tile >> 3, ct = tile & 7, r32 = lane & 31, hh = lane >> 5;
            const bf16_t* ap = MEMN + (size_t)(32 * rt + r32) * 1024 + 128 * wave + 8 * hh; const bf16_t* bp = WMKV_T + (size_t)(64 * ct + r32) * 1024 + 128 * wave + 8 * hh;
            bf16x8 af[8], b0[8], b1[8];
#pragma unroll
            for (int ks = 0; ks < 8; ++ks) { af[ks] = *(const bf16x8*)(ap + 16 * ks); b0[ks] = *(const bf16x8*)(bp + 16 * ks); b1[ks] = *(const bf16x8*)(bp + 32 * 1024 + 16 * ks); }
            f32x16 c0 = f32x16{}, c1 = f32x16{};
#pragma unroll
            for (int ks = 0; ks < 8; ++ks) { c0 = __builtin_amdgcn_mfma_f32_32x32x16_bf16(af[ks], b0[ks], c0, 0, 0, 0); c1 = __builtin_amdgcn_mfma_f32_32x32x16_bf16(af[ks], b1[ks], c1, 0, 0, 0); }
            LAS float* part = (LAS float*)lds;
            __syncthreads();
#pragma unroll
            for (int r = 0; r < 16; ++r) { const int row = (r & 3) + 8 * (r >> 2) + 4 * hh; part[(wave * 32 + row) * 64 + r32] = c0[r]; part[(wave * 32 + row) * 64 + 32 + r32] = c1[r]; }
            __syncthreads();
            const int row = tid >> 4, c4 = (tid & 15) * 4; f32x4 a = {0.f, 0.f, 0.f, 0.f};
#pragma unroll
            for (int w = 0; w < 8; ++w) a += *(const LAS f32x4*)(part + (w * 32 + row) * 64 + c4);
            if (ct < 4) {
                float ss = (a[0] * a[0] + a[1] * a[1]) + (a[2] * a[2] + a[3] * a[3]);
                ss += __shfl_xor(ss, 1); ss += __shfl_xor(ss, 2); ss += __shfl_xor(ss, 4); ss += __shfl_xor(ss, 8);
                const float rstd = 1.0f / sqrtf(ss * (1.0f / 64.0f) + RMS_EPS); const f32x4 g = *(const f32x4*)(ka->in[I_MKN] + c4); a = a * rstd * g; }
            u32x2 o; o.x = cvt_pk_bf16(a[0], a[1]); o.y = cvt_pk_bf16(a[2], a[3]);
            *(u32x2*)(MKV + (size_t)(32 * rt + row) * 512 + 64 * ct + c4) = o;
        }
        __syncthreads();
    }
    SEAM(1);
    if (IN(2)) for (int rep_ = 0; rep_ < 1 + ((REPEAT_MASK >> 2) & 1); ++rep_) { KA; if (rep_) __syncthreads();
        using abf = attn_body::bf16;
        {
            const int bh = vcu >> 4, b = bh >> 2, h = bh & 3, s = vcu & 15; const size_t rb = (size_t)b * SEQ;
            const float lam = LAMP[0];
            const CvtJob J2{ka->in[I_WGU], ka->in[I_WD], (unsigned char*)WGU_T, (unsigned char*)WD_T, NGW, gw, lane};
            for (int i2 = 0; i2 < 4 * (1 + ((REPEAT_MASK >> 10) & 1)); ++i2) { const int ii = i2 & 3, c = ii & 1; const int qb = (ii < 2) ? s : 31 - s;
                attn_body::attn_unit2<true>(qb * 256, 4 * qb + 4, (const abf*)Qb + rb * 512 + (c * 4 + h) * 64, 512, (const abf*)Kb + rb * 512 + (c * 4 + h) * 64, 512,
                                            (const abf*)Vb + rb * 512 + h * 128, 512, (abf*)OC + rb * 1024 + (c * 4 + h) * 128, 1024, (char*)lds_raw);
                if (c == 1) {
                    asm volatile("s_waitcnt vmcnt(0)" ::: "memory");
#pragma unroll
                    for (int ps = 0; ps < 2; ++ps) {
                    const int row = ps * 16 + (lane >> 2), dq = (lane & 3) * 32; const size_t t = rb + (size_t)qb * 256 + wave * 32 + row;
                    const bf16_t* p0 = OC + t * 1024 + h * 128 + dq; const bf16_t* p1 = p0 + 512;
                    u32x4 a[4], bb[4];
#pragma unroll
                    for (int j = 0; j < 4; ++j) { a[j] = *(const u32x4*)(p0 + 8 * j); bb[j] = *(const u32x4*)(p1 + 8 * j); }
                    float ss = 0.f; f32x4 y[4][2];
#pragma unroll
                    for (int j = 0; j < 4; ++j) {
                        y[j][0] = (f32x4){bf_lo(a[j].x) - lam * bf_lo(bb[j].x), bf_hi(a[j].x) - lam * bf_hi(bb[j].x), bf_lo(a[j].y) - lam * bf_lo(bb[j].y), bf_hi(a[j].y) - lam * bf_hi(bb[j].y)};
                        y[j][1] = (f32x4){bf_lo(a[j].z) - lam * bf_lo(bb[j].z), bf_hi(a[j].z) - lam * bf_hi(bb[j].z), bf_lo(a[j].w) - lam * bf_lo(bb[j].w), bf_hi(a[j].w) - lam * bf_hi(bb[j].w)};
#pragma unroll
                        for (int q = 0; q < 4; ++q) ss += y[j][0][q] * y[j][0][q] + y[j][1][q] * y[j][1][q]; }
                    ss += __shfl_xor(ss, 1); ss += __shfl_xor(ss, 2);
                    const float rstd = 0.8f / sqrtf(ss * (1.0f / 128.0f) + RMS_EPS);
                    const float* sg = ka->in[I_SUBLN] + dq; bf16_t* yo = YCAT + t * 1024 + h * 128 + dq;
#pragma unroll
                    for (int j = 0; j < 4; ++j) { const f32x4 s0 = *(const f32x4*)(sg + 8 * j), s1 = *(const f32x4*)(sg + 8 * j + 4); pg8::store8(yo + 8 * j, y[j][0] * rstd * s0, y[j][1] * rstd * s1); }
                    }
                }
                if (ii < CVT_NB2) J2.item3(3 * ii);
            }
        }
        {
            for (int i = 0; i < 2; ++i) { const int idx = vcu * 2 + i; if (idx >= 512) break; const int b = idx >> 7, h = (idx >> 5) & 3, qb = idx & 31;
                attn_body::attn_unit<8, false>(qb * 256, 4, (const abf*)MQb + (size_t)b * SEQ * 256 + h * 64, 256, (const abf*)MKV + (size_t)b * MEMLEN * 512 + h * 64, 512,
                                               (const abf*)MKV + (size_t)b * MEMLEN * 512 + 256 + h * 64, 512, (abf*)YCAT + (size_t)b * SEQ * 1024 + 768 + h * 64, 1024, (char*)lds_raw); }
        }
        {
            LAS bf16_t* ul = (LAS bf16_t*)lds;
            LAS bf16_t* pb = (LAS bf16_t*)(lds + 24576);
            const int col = tid & 255, half = tid >> 8, w = 2 << (col >> 6);
            const int mg = wave & 3, mdh = wave >> 2, r32 = lane & 31, hh = lane >> 5;
            bf16x8 bw[4];
#pragma unroll
            for (int sx = 0; sx < 4; ++sx) { const float* wp = ka->in[I_WPOOL] + (size_t)(mg * 64 + 16 * sx + 8 * hh) * 64 + mdh * 32 + r32;
                u32x4 pk; pk.x = pk2(wp[0], wp[64]); pk.y = pk2(wp[128], wp[192]); pk.z = pk2(wp[256], wp[320]); pk.w = pk2(wp[384], wp[448]); bw[sx] = __builtin_bit_cast(bf16x8, pk); }
            const int ocol = mg * 64 + mdh * 32 + r32; const float psc = ka->in[I_PSCALE][ocol];
            u32x4 pre[3];
#define POOL_LOAD(tl) do { const int t0_ = (tl) * 32, p0_ = t0_ & (SEQ - 1); _Pragma("unroll") for (int k_ = 0; k_ < 3; ++k_) { const int pc = tid + 512 * k_, r = pc >> 5, ch = pc & 31; \
                pre[k_] = (u32x4){0u, 0u, 0u, 0u}; if (pc < 47 * 32 && p0_ - 15 + r >= 0) pre[k_] = *(const u32x4*)(Ub + (size_t)(t0_ - 15 + r) * 256 + ch * 8); } } while (0)
            if (vcu < T / 32) POOL_LOAD(vcu);
            for (int tile = vcu; tile < T / 32; tile += G) {
                const int t0 = tile * 32, p0 = t0 & (SEQ - 1);
                __syncthreads();
#pragma unroll
                for (int k = 0; k < 3; ++k) { const int pc = tid + 512 * k, r = pc >> 5, ch = pc & 31; if (pc < 47 * 32) *(LAS u32x4*)(ul + r * 256 + ch * 8) = pre[k]; }
                if (tile + G < T / 32) POOL_LOAD(tile + G);
                __syncthreads();
                {
                    float sum = 0.f; const int rbase = 15 + 16 * half;
                    for (int i = 1; i < w; ++i) sum += __uint_as_float((unsigned)ul[(rbase - i) * 256 + col] << 16);
#pragma unroll
                    for (int tk = 0; tk < 16; ++tk) { const float ucur = __uint_as_float((unsigned)ul[(rbase + tk) * 256 + col] << 16); sum += ucur;
                        const int pos = p0 + 16 * half + tk; const float cnt = (float)((pos + 1 < w) ? pos + 1 : w);
                        pb[(16 * half + tk) * 264 + col] = (bf16_t)f2bf(sum / cnt - ucur);
                        sum -= __uint_as_float((unsigned)ul[(rbase + tk - (w - 1)) * 256 + col] << 16); }
                }
                __syncthreads();
                f32x16 acc = f32x16{};
#pragma unroll
                for (int sx = 0; sx < 4; ++sx) { const bf16x8 af = *(const LAS bf16x8*)(pb + r32 * 264 + mg * 64 + 16 * sx + 8 * hh);
                    acc = __builtin_amdgcn_mfma_f32_32x32x16_bf16(af, bw[sx], acc, 0, 0, 0); }
#pragma unroll
                for (int r = 0; r < 16; ++r) { const int tok = t0 + (r & 3) + 8 * (r >> 2) + 4 * hh; YCAT[(size_t)tok * 1024 + 512 + ocol] = (bf16_t)f2bf(acc[r] * psc); }
            }
            __syncthreads();
        }
    }
    SEAM(2);
    if (IN(4)) for (int rep_ = 0; rep_ < 1 + ((REPEAT_MASK >> 4) & 1); ++rep_) { KA; if (rep_) __syncthreads();
        pg8::StaticOrder S0; S0.init(T, 1024, G, bx); const pg8::TableOrder S = pg8::build_unit_table(S0, (LAS int*)(lds + MISC_OFF + 2048));
        pg8::DenseProb P{YCAT, WBRD_T, 1024, 1024, 1024}; pg8::EpiMergeR E{GATES, MERGB};
        pg8::gemm_phase<pg8::EpiMergeR, pg8::DenseProb, pg8::TableOrder, ALIGN_EPI_SEL>(lds, P, S, E);
    }
    SEAM(4);
    if (IN(5)) for (int rep_ = 0; rep_ < 1 + ((REPEAT_MASK >> 5) & 1); ++rep_) { KA; if (rep_) __syncthreads();
        pg8::DenseProb P{MERGB, WOUT_T, 1024, 1024, 1024}; pg8::StaticOrder S0; S0.init(T, 1024, G, bx); const pg8::TableOrder S = pg8::build_unit_table(S0, (LAS int*)(lds + MISC_OFF + 2048));
        pg8::EpiWout E{ka->in[I_X], OUT, (unsigned char*)XG, ka->in[I_NORM2]};
        pg8::gemm_phase<pg8::EpiWout, pg8::DenseProb, pg8::TableOrder, ALIGN_EPI_SEL>(lds, P, S, E);
    }
    SEAM(5);
    if (IN(6)) { KA;
        LAS int* lcnt = (LAS int*)(lds + MISC_OFF); LAS int* lbase = lcnt + 32;
        const int ngroups = T / 16, rounds = (ngroups + NGW - 1) / NGW;
        { LAS f32x4* wl = (LAS f32x4*)lds; const f32x4* wg = (const f32x4*)WR2;
          for (int i = tid; i < 8192; i += 512) wl[i] = wg[i]; }
        __syncthreads();
        for (int rd = 0; rd < rounds; ++rd) {
            const int grp = rd * NGW + gw; const bool valid = grp < ngroups;
            if (tid < 32) lcnt[tid] = 0;
            __syncthreads();
            int e_sel = 0, rank = 0; float w_sel = 0.f, rstd = 0.f; const int q = lane >> 4, tok = grp * 16 + (lane & 15);
            if (valid) {
                f32x4 d0 = {0.f, 0.f, 0.f, 0.f}, d1 = {0.f, 0.f, 0.f, 0.f}; float ss = 0.f;
                const float* xrow = OUT + (size_t)tok * 1024 + 4 * q; const LAS f32x4* wr2 = (const LAS f32x4*)lds + lane;
#pragma unroll 16
                for (int s = 0; s < 64; ++s) { const f32x4 xv = *(const f32x4*)(xrow + 16 * s); const f32x4 wa = wr2[(s * 2) * 64], wb = wr2[(s * 2 + 1) * 64];
                    ss += (xv[0] * xv[0] + xv[1] * xv[1]) + (xv[2] * xv[2] + xv[3] * xv[3]);
#pragma unroll
                    for (int j = 0; j < 4; ++j) { d0 = __builtin_amdgcn_mfma_f32_16x16x4f32(wa[j], xv[j], d0, 0, 0, 0); d1 = __builtin_amdgcn_mfma_f32_16x16x4f32(wb[j], xv[j], d1, 0, 0, 0); } }
                ss += __shfl_xor(ss, 16); ss += __shfl_xor(ss, 32);
                rstd = 1.0f / sqrtf(ss * (1.0f / 1024.f) + RMS_EPS);
                unsigned key[8];
#pragma unroll
                for (int r = 0; r < 8; ++r) { const int e = (r >> 2) * 16 + 4 * q + (r & 3); const float lg = ((r < 4) ? d0[r & 3] : d1[r & 3]) * rstd + ka->in[I_BROUTER][e];
                    unsigned u = __float_as_uint(lg); u ^= (u >> 31) ? 0xffffffffu : 0x80000000u; key[r] = (u & ~31u) | (unsigned)(31 - e); }
                unsigned win[4];
#pragma unroll
                for (int r = 0; r < 4; ++r) { unsigned m = key[0];
#pragma unroll
                    for (int j = 1; j < 8; ++j) m = m > key[j] ? m : key[j];
                    unsigned o = (unsigned)__shfl_xor((int)m, 16); m = m > o ? m : o; o = (unsigned)__shfl_xor((int)m, 32); m = m > o ? m : o; win[r] = m;
#pragma unroll
                    for (int j = 0; j < 8; ++j) key[j] = (key[j] == m) ? 0u : key[j]; }
                float val[4];
#pragma unroll
                for (int r = 0; r < 4; ++r) { unsigned u = win[r] & ~31u; u ^= (u >> 31) ? 0x80000000u : 0xffffffffu; val[r] = __uint_as_float(u); }
                const float p1 = expf(val[1] - val[0]), p2 = expf(val[2] - val[0]), p3 = expf(val[3] - val[0]); const float inv = 1.0f / (1.0f + p1 + p2 + p3);
                const unsigned wk = (q == 0) ? win[0] : (q == 1) ? win[1] : (q == 2) ? win[2] : win[3];
                w_sel = ((q == 0) ? 1.0f : (q == 1) ? p1 : (q == 2) ? p2 : p3) * inv; e_sel = 31 - (int)(wk & 31u);
                rank = __hip_atomic_fetch_add((int*)(lcnt + e_sel), 1, __ATOMIC_RELAXED, __HIP_MEMORY_SCOPE_WORKGROUP);
            }
            __syncthreads();
            if (tid < 32) lbase[tid] = (int)__hip_atomic_fetch_add(CNT + 64 * tid, (unsigned)lcnt[tid], __ATOMIC_RELAXED, __HIP_MEMORY_SCOPE_AGENT);
            __syncthreads();
            if (valid) { const int pos = lbase[e_sel] + rank; LIST[(size_t)e_sel * CAP + pos] = (u32x2){(unsigned)(tok * 4 + q), __float_as_uint(rstd)}; ROUTEW[tok * 4 + q] = w_sel; }
            __syncthreads();
        }
    }
    SEAM(6);
    if (IN(7) || IN(8)) { KA;
        LAS int* tp = (LAS int*)(lds + MISC_OFF + 256); LAS int* cn = tp + 40;
        if (tid < 64) {
            const int e = tid & 31; const int c = (int)__hip_atomic_load(CNT + 64 * e, __ATOMIC_RELAXED, __HIP_MEMORY_SCOPE_AGENT); const int tiles = (c + 255) >> 8; int x = tiles;
#pragma unroll
            for (int o = 1; o < 32; o <<= 1) { const int y = __shfl_up(x, o, 32); if (e >= o) x += y; }
            if (tid < 32) { cn[e] = c; tp[e] = x - tiles; if (e == 31) tp[NEXP] = x; } }
        __syncthreads();
        if (IN(7)) for (int rep_ = 0; rep_ < 1 + ((REPEAT_MASK >> 7) & 1); ++rep_) {
            pg8::GuProb P{(const unsigned char*)XG, (const unsigned char*)WGU_T, LIST, 1024, 1024, 1024}; pg8::GroupedOrder S0{tp, cn, 8, G, bx}; const pg8::TableOrder S = pg8::build_unit_table(S0, (LAS int*)(lds + MISC_OFF + 2048));
            pg8::EpiSwiglu E{(unsigned char*)ACT, LIST, ka->in[I_BGU], lds + MISC_OFF + 4096};
            pg8::gemm_phase<pg8::EpiSwiglu, pg8::GuProb, pg8::TableOrder, ALIGN_EPI_SEL>(lds, P, S, E);
        }
        SEAM(7);
        if (IN(8)) for (int rep_ = 0; rep_ < 1 + ((REPEAT_MASK >> 8) & 1); ++rep_) {
            pg8::DownProb P{(const unsigned char*)ACT, (const unsigned char*)WD_T, 1024, 1024, 1024}; pg8::GroupedOrder S0{tp, cn, 4, G, bx}; const pg8::TableOrder S = pg8::build_unit_table(S0, (LAS int*)(lds + MISC_OFF + 2048));
            pg8::EpiDown E{(unsigned char*)Y4, LIST, ka->in[I_BD], lds + MISC_OFF + 4096};
            pg8::gemm_phase<pg8::EpiDown, pg8::DownProb, pg8::TableOrder, ALIGN_EPI_SEL>(lds, P, S, E);
        }
    }
    SEAM(8);
    if (IN(9)) { KA;
        for (int i = bx * 512 + tid; i < T * 128; i += G * 512) { const int tok = i >> 7, c8 = (i & 127) * 8;
            const f32x4 w = *(const f32x4*)(ROUTEW + tok * 4); float* op = OUT + (size_t)tok * 1024 + c8;
            f32x4 o0 = *(const f32x4*)op, o1 = *(const f32x4*)(op + 4);
#pragma unroll
            for (int k = 0; k < 4; ++k) { const u32x2 y = *(const u32x2*)((const unsigned char*)Y4 + ((size_t)tok * 4 + k) * 1024 + c8); const float wk = w[k] * (1.0f / Y8_SCALE);
                const f32x2 p0 = __builtin_amdgcn_cvt_pk_f32_fp8((int)y.x, false), p1 = __builtin_amdgcn_cvt_pk_f32_fp8((int)y.x, true), p2 = __builtin_amdgcn_cvt_pk_f32_fp8((int)y.y, false), p3 = __builtin_amdgcn_cvt_pk_f32_fp8((int)y.y, true);
                o0[0] += wk * p0[0]; o0[1] += wk * p0[1]; o0[2] += wk * p1[0]; o0[3] += wk * p1[1];
                o1[0] += wk * p2[0]; o1[1] += wk * p2[1]; o1[2] += wk * p3[0]; o1[3] += wk * p3[1]; }
            *(f32x4*)op = o0; *(f32x4*)(op + 4) = o1; }
    }
#ifdef TAP
    if (lo <= 10 && 10 < hi) { KA; GSYNC();
        for (int i = bx * 512 + tid; i < T * 1024; i += G * 512) { const int t = i >> 10, c = i & 1023; float v = 0.f;
#define BFV(buf, pitch, col) __uint_as_float((unsigned)(buf)[(size_t)t * (pitch) + (col)] << 16)
            if (TAP == 1) v = BFV(Qb, 512, c & 511) + 2.f * BFV(Kb, 512, c & 511) + 4.f * BFV(Vb, 512, c & 511) + 8.f * BFV(Ub, 256, c & 255) + 16.f * BFV(MQb, 256, c & 255)
                            + 32.f * BFV(GATES, 3072, c) + 64.f * BFV(GATES, 3072, 1024 + c) + 128.f * BFV(GATES, 3072, 2048 + c);
            if (TAP == 2) v = BFV(OC, 1024, c) + 2.f * BFV(YCAT, 1024, c);
            if (TAP == 3) v = BFV(MERGB, 1024, c);
            if (TAP == 4) v = BFV(XN, 1024, c);
            if (TAP == 6) { const bf16_t* z = WSP(bf16_t, WS_B) + (size_t)t * 5120 + c; v = __uint_as_float((unsigned)z[0] << 16) + 2.f * __uint_as_float((unsigned)z[1024] << 16) + 4.f * __uint_as_float((unsigned)z[2048] << 16) + 8.f * __uint_as_float((unsigned)z[3072] << 16) + 16.f * __uint_as_float((unsigned)z[4096] << 16); }
            if (TAP == 5) { const bf16_t* wt = WIN_T; const int tt = t % 5120; v = __uint_as_float((unsigned)wt[(size_t)tt * 1024 + c] << 16) + ROPE[(t & 8191) * 32 + (c & 31)].x + 2.f * ROPE[(t & 8191) * 32 + (c & 31)].y; }
            OUT[i] = v; }
    }
#endif
#undef IN
#undef SEAM
}

extern "C" void kernel_launch(void* const* d_in, const int* in_sizes, int n_in, void* d_out, int out_size, void* d_ws, size_t ws_size, hipStream_t stream) {
    static int grid = 0;
    if (grid == 0) {
        if (n_in != 29 || in_sizes[0] != T * DMODEL || out_size != T * DMODEL || ws_size < WS_END) {
            fprintf(stderr, "kernel_launch: unexpected shapes: n_in %d in0 %d out %d ws %zu (need %zu)\n", n_in, n_in > 0 ? in_sizes[0] : -1, out_size, ws_size, (size_t)WS_END); grid = -1; return; }
        int dev = 0, cus = 0, per_cu = 0;
        (void)hipGetDevice(&dev); (void)hipDeviceGetAttribute(&cus, hipDeviceAttributeMultiprocessorCount, dev);
        (void)hipFuncSetAttribute((const void*)fwd_kernel, hipFuncAttributeMaxDynamicSharedMemorySize, LDS_BYTES);
        (void)hipOccupancyMaxActiveBlocksPerMultiprocessor(&per_cu, (const void*)fwd_kernel, NWAVES * 64, LDS_BYTES);
        (void)hipGetLastError();
        grid = cus;
        fprintf(stderr, "kernel_launch: cus %d occupancy %d/CU grid %d\n", cus, per_cu, grid);
        if (per_cu < 1) fprintf(stderr, "kernel_launch: occupancy query says the kernel does not fit\n");
    }
    if (grid < 0) return;
    (void)hipMemsetAsync((char*)d_ws + WS_CTL, 0, CTL_ZERO_BYTES, stream);
    Args a{};
    for (int i = 0; i < 29; ++i) a.in[i] = (const float*)d_in[i];
    a.out = (float*)d_out; a.ws = (unsigned char*)d_ws; a.ph_lo = 0; a.ph_hi = PH_HI;
    void* args[] = {&a};
    hipError_t e = hipLaunchCooperativeKernel((const void*)fwd_kernel, dim3(grid), dim3(NWAVES * 64), args, LDS_BYTES, stream);
    if (e != hipSuccess) fprintf(stderr, "cooperative launch failed: %s (grid %d)\n", hipGetErrorString(e), grid);
}
```
